# Optimizing an MI355X kernel written in HIP

```python
import jax, jax.numpy as jnp
from jax import lax
import numpy as np

D_MODEL = 1024
BATCH = 32
SEQ = 2048
DEPTH = 2

GRID_W = 64
CTX_LEN = 256
N_MOD = 6
EPS = 1e-6
ROPE_BASE = 10000.0
Q_BLOCK = 128
HEAD_DIM = 64
GQA_Q_HEADS = 6
GQA_KV_HEADS = 2
GQA_GROUP = GQA_Q_HEADS // GQA_KV_HEADS
GQA_WIDTH = GQA_Q_HEADS * HEAD_DIM
POOL_GROUPS = 4
POOL_WINDOWS = (2, 4, 8, 16)
POOL_WIDTH = D_MODEL // 4
POOL_GROUP_DIM = POOL_WIDTH // POOL_GROUPS
MLA_HEADS = 6
MLA_NOPE_DIM = 64
MLA_ROPE_DIM = 32
MLA_V_DIM = 64
MLA_Q_RANK = 384
MLA_KV_RANK = 256
MLA_WIDTH = MLA_HEADS * MLA_V_DIM
MIX_WIDTH = GQA_WIDTH + POOL_WIDTH + MLA_WIDTH
PROJ_SIZES = (GQA_WIDTH, GQA_KV_HEADS * HEAD_DIM, GQA_KV_HEADS * HEAD_DIM, POOL_WIDTH, MLA_Q_RANK, MLA_KV_RANK, MLA_ROPE_DIM)
IN_COLS = GQA_WIDTH + 4 * GQA_KV_HEADS * HEAD_DIM // 2 + POOL_WIDTH + MLA_Q_RANK + MLA_KV_RANK + MLA_ROPE_DIM
PEER_HEADS = 8
PEER_N_KEYS = 128
PEER_N_EXPERTS = PEER_N_KEYS * PEER_N_KEYS
PEER_TOPK = 16
PEER_QUERY_DIM = 256
PEER_HALF = PEER_QUERY_DIM // 2
PEER_CHUNK = 128

kernel_name = "hybrid_prefix_dit_gqa_pool_mla_peer"


def rms_norm(x, g):
    xf = x.astype(jnp.float32)
    y = xf * lax.rsqrt(jnp.mean(xf * xf, axis=-1, keepdims=True) + EPS)
    return (y * g.astype(jnp.float32)).astype(x.dtype)


def modulate(x, g, shift, scale):
    return rms_norm(x, g) * (1 + scale) + shift


def axial_rope(rows, rot_dim):
    row = jnp.repeat(jnp.arange(rows), GRID_W).astype(jnp.float32)
    col = jnp.tile(jnp.arange(GRID_W), rows).astype(jnp.float32)
    n = rot_dim // 4
    inv = ROPE_BASE ** (-jnp.arange(n, dtype=jnp.float32) / n)
    ang = jnp.concatenate([row[:, None] * inv, col[:, None] * inv], axis=-1)
    return jnp.cos(ang), jnp.sin(ang)


def apply_rope(x, cos, sin):
    L = x.shape[1]
    shape = (1, L) + (1,) * (x.ndim - 3) + (cos.shape[-1],)
    cos = cos.reshape(shape).astype(x.dtype)
    sin = sin.reshape(shape).astype(x.dtype)
    x1, x2 = jnp.split(x, 2, axis=-1)
    return jnp.concatenate([x1 * cos - x2 * sin, x1 * sin + x2 * cos], axis=-1)


def split_cols(p):
    outs = []
    o = 0
    for s in PROJ_SIZES:
        outs.append(p[..., o:o + s])
        o += s
    return outs


def blocked_attention(q, k, v, scale):
    B, Lq = q.shape[0], q.shape[1]
    nb = Lq // Q_BLOCK
    qb = q.reshape((B, nb, Q_BLOCK) + q.shape[2:]).swapaxes(0, 1)

    def one_block(qblk):
        s = jnp.einsum('bqhgd,bkhd->bhgqk', qblk, k, preferred_element_type=jnp.float32) * scale
        p = jax.nn.softmax(s, axis=-1).astype(v.dtype)
        return jnp.einsum('bhgqk,bkhd->bqhgd', p, v)

    o = lax.map(one_block, qb)
    return o.swapaxes(0, 1).reshape(B, Lq, -1)


def gqa_heads(q, k, v, qn_g, kn_g, rope):
    B, L, _ = q.shape
    q = rms_norm(q.reshape(B, L, GQA_KV_HEADS, GQA_GROUP, HEAD_DIM), qn_g)
    k = rms_norm(k.reshape(B, L, GQA_KV_HEADS, HEAD_DIM), kn_g)
    v = v.reshape(B, L, GQA_KV_HEADS, HEAD_DIM)
    if rope is not None:
        q = apply_rope(q, rope[0], rope[1])
        k = apply_rope(k, rope[0], rope[1])
    return q, k, v


def mla_heads(cq, ckv, kr, qn_g, kvn_g, w_uq, w_ukv, rope):
    B, L, _ = cq.shape
    q = (rms_norm(cq, qn_g) @ w_uq).reshape(B, L, MLA_HEADS, 1, MLA_NOPE_DIM + MLA_ROPE_DIM)
    kv = (rms_norm(ckv, kvn_g) @ w_ukv).reshape(B, L, MLA_HEADS, MLA_NOPE_DIM + MLA_V_DIM)
    q_nope, q_rope = q[..., :MLA_NOPE_DIM], q[..., MLA_NOPE_DIM:]
    k_nope, v = kv[..., :MLA_NOPE_DIM], kv[..., MLA_NOPE_DIM:]
    kr = kr[:, :, None, :]
    if rope is not None:
        q_rope = apply_rope(q_rope, rope[0], rope[1])
        kr = apply_rope(kr, rope[0], rope[1])
    q = jnp.concatenate([q_nope, q_rope], axis=-1)
    k = jnp.concatenate([k_nope, jnp.broadcast_to(kr, (B, L, MLA_HEADS, MLA_ROPE_DIM))], axis=-1)
    return q, k, v


def centred_mean_minus_self(x, w):
    B, L, C = x.shape
    xf = x.astype(jnp.float32)
    cs = jnp.concatenate([jnp.zeros((B, 1, C), jnp.float32), jnp.cumsum(xf, axis=1)], axis=1)
    t = jnp.arange(L)
    lo = jnp.clip(t - w // 2, 0, L)
    hi = jnp.clip(t - w // 2 + w, 0, L)
    cnt = (hi - lo).astype(jnp.float32)
    return ((cs[:, hi] - cs[:, lo]) / cnt[None, :, None] - xf).astype(x.dtype)


def pool_mixer(x, pool_w, pool_scale):
    B, L, _ = x.shape
    xg = x.reshape(B, L, POOL_GROUPS, POOL_GROUP_DIM)
    pooled = jnp.stack([centred_mean_minus_self(xg[:, :, i], POOL_WINDOWS[i]) for i in range(POOL_GROUPS)], axis=2)
    y = jnp.einsum('blgc,gcd->blgd', pooled, pool_w).reshape(B, L, POOL_WIDTH)
    return y * pool_scale


def peer_ffn(h, wq, subkeys, u_tab, v_tab):
    B, L, D = h.shape
    hc = h.reshape(B * L // PEER_CHUNK, PEER_CHUNK, D)

    def one_chunk(xc):
        C = xc.shape[0]
        q = (xc @ wq).reshape(C, PEER_HEADS, 2, PEER_HALF)
        s = jnp.einsum('chpd,hpnd->chpn', q, subkeys, preferred_element_type=jnp.float32)
        s1, i1 = lax.top_k(s[:, :, 0], PEER_TOPK)
        s2, i2 = lax.top_k(s[:, :, 1], PEER_TOPK)
        cand_s = (s1[..., :, None] + s2[..., None, :]).reshape(C, PEER_HEADS, PEER_TOPK * PEER_TOPK)
        cand_i = (i1[..., :, None] * PEER_N_KEYS + i2[..., None, :]).reshape(C, PEER_HEADS, PEER_TOPK * PEER_TOPK)
        top_s, pos = lax.top_k(cand_s, PEER_TOPK)
        eid = jnp.take_along_axis(cand_i, pos, axis=-1).reshape(C, PEER_HEADS * PEER_TOPK)
        gate = jax.nn.softmax(top_s, axis=-1).reshape(C, PEER_HEADS * PEER_TOPK)
        u = u_tab[eid]
        v = v_tab[eid]
        a = jnp.einsum('cd,ced->ce', xc, u, preferred_element_type=jnp.float32)
        wgt = (gate * jax.nn.gelu(a)).astype(xc.dtype)
        return jnp.einsum('ce,ced->cd', wgt, v)

    return lax.map(one_chunk, hc).reshape(B, L, D)


def mix_out(oa, ob, oc, w_out):
    return jnp.concatenate([oa, ob, oc], axis=-1) @ w_out


def trunk_layer(xl, xc, mod_l, mod_c, n1_g, n2_g, w_in, gqa_qn_g, gqa_kn_g, pool_w, pool_scale,
                mla_qn_g, mla_kvn_g, mla_w_uq, mla_w_ukv, w_out, peer_wq, peer_subkeys, peer_u, peer_v,
                rope_a, rope_c, update_ctx):
    shl, scl, gtl, shl2, scl2, gtl2 = [mod_l[:, i][:, None, :] for i in range(N_MOD)]
    shc, scc, gtc, shc2, scc2, gtc2 = [mod_c[i] for i in range(N_MOD)]
    hl = modulate(xl, n1_g, shl, scl)
    hc = modulate(xc, n1_g, shc, scc)
    aq_l, ak_l, av_l, b_l, cq_l, ckv_l, kr_l = split_cols(hl @ w_in)
    aq_c, ak_c, av_c, b_c, cq_c, ckv_c, kr_c = split_cols(hc @ w_in)
    qa_l, ka_l, va_l = gqa_heads(aq_l, ak_l, av_l, gqa_qn_g, gqa_kn_g, rope_a)
    qa_c, ka_c, va_c = gqa_heads(aq_c, ak_c, av_c, gqa_qn_g, gqa_kn_g, None)
    sa = HEAD_DIM ** -0.5
    oa_l = blocked_attention(qa_l, jnp.concatenate([ka_c, ka_l], axis=1), jnp.concatenate([va_c, va_l], axis=1), sa)
    qc_l, kc_l, vc_l = mla_heads(cq_l, ckv_l, kr_l, mla_qn_g, mla_kvn_g, mla_w_uq, mla_w_ukv, rope_c)
    qc_c, kc_c, vc_c = mla_heads(cq_c, ckv_c, kr_c, mla_qn_g, mla_kvn_g, mla_w_uq, mla_w_ukv, None)
    sc = (MLA_NOPE_DIM + MLA_ROPE_DIM) ** -0.5
    oc_l = blocked_attention(qc_l, jnp.concatenate([kc_c, kc_l], axis=1), jnp.concatenate([vc_c, vc_l], axis=1), sc)
    ob_l = pool_mixer(b_l, pool_w, pool_scale)
    xl_new = xl + gtl * mix_out(oa_l, ob_l, oc_l, w_out)
    xl_new = xl_new + gtl2 * peer_ffn(modulate(xl_new, n2_g, shl2, scl2), peer_wq, peer_subkeys, peer_u, peer_v)
    if update_ctx:
        oa_c = blocked_attention(qa_c, ka_c, va_c, sa)
        oc_c = blocked_attention(qc_c, kc_c, vc_c, sc)
        ob_c = pool_mixer(b_c, pool_w, pool_scale)
        xc_new = xc + gtc * mix_out(oa_c, ob_c, oc_c, w_out)
        xc_new = xc_new + gtc2 * peer_ffn(modulate(xc_new, n2_g, shc2, scc2), peer_wq, peer_subkeys, peer_u, peer_v)
    else:
        xc_new = xc
    return xl_new, xc_new


def setup_inputs(seed: int = 0) -> dict:
    key = jax.random.key(seed)
    ks = jax.random.split(key, 32)
    D = D_MODEL

    def nrm(k, shape, scale):
        return jax.random.normal(k, shape, jnp.float32) * scale

    def gain(k, shape):
        return 1.0 + 0.1 * jax.random.normal(k, shape, jnp.float32)

    return {
        "x": nrm(ks[0], (BATCH, SEQ, D), 1.0),
        "c": nrm(ks[1], (BATCH, D), 1.0),
        "ctx": nrm(ks[2], (BATCH, CTX_LEN, D), 1.0),
        "c_ctx": nrm(ks[3], (D,), 1.0),
        "ada_w": nrm(ks[4], (DEPTH, D, N_MOD * D), 0.5 * D ** -0.5),
        "ada_b": nrm(ks[5], (DEPTH, N_MOD * D), 0.02),
        "norm1_g": gain(ks[6], (DEPTH, D)),
        "norm2_g": gain(ks[7], (DEPTH, D)),
        "w_in": nrm(ks[8], (DEPTH, D, IN_COLS), D ** -0.5),
        "gqa_qn_g": gain(ks[9], (DEPTH, HEAD_DIM)),
        "gqa_kn_g": gain(ks[10], (DEPTH, HEAD_DIM)),
        "pool_w": nrm(ks[11], (DEPTH, POOL_GROUPS, POOL_GROUP_DIM, POOL_GROUP_DIM), POOL_GROUP_DIM ** -0.5),
        "pool_scale": gain(ks[12], (DEPTH, POOL_WIDTH)),
        "mla_qn_g": gain(ks[13], (DEPTH, MLA_Q_RANK)),
        "mla_kvn_g": gain(ks[14], (DEPTH, MLA_KV_RANK)),
        "mla_w_uq": nrm(ks[15], (DEPTH, MLA_Q_RANK, MLA_HEADS * (MLA_NOPE_DIM + MLA_ROPE_DIM)), MLA_Q_RANK ** -0.5),
        "mla_w_ukv": nrm(ks[16], (DEPTH, MLA_KV_RANK, MLA_HEADS * (MLA_NOPE_DIM + MLA_V_DIM)), MLA_KV_RANK ** -0.5),
        "w_out": nrm(ks[17], (DEPTH, MIX_WIDTH, D), MIX_WIDTH ** -0.5),
        "peer_wq": nrm(ks[18], (DEPTH, D, PEER_HEADS * PEER_QUERY_DIM), D ** -0.5),
        "peer_subkeys": nrm(ks[19], (DEPTH, PEER_HEADS, 2, PEER_N_KEYS, PEER_HALF), PEER_HALF ** -0.5),
        "peer_u": nrm(ks[20], (DEPTH, PEER_N_EXPERTS, D), D ** -0.5),
        "peer_v": nrm(ks[21], (DEPTH, PEER_N_EXPERTS, D), PEER_HEADS ** -0.5),
        "final_g": gain(ks[22], (D,)),
    }


def reference(x, c, ctx, c_ctx, ada_w, ada_b, norm1_g, norm2_g, w_in, gqa_qn_g, gqa_kn_g, pool_w, pool_scale,
              mla_qn_g, mla_kvn_g, mla_w_uq, mla_w_ukv, w_out, peer_wq, peer_subkeys, peer_u, peer_v, final_g):
    B, L, D = x.shape
    rows = L // GRID_W
    rope_a = axial_rope(rows, HEAD_DIM)
    rope_c = axial_rope(rows, MLA_ROPE_DIM)
    sc_lat = jax.nn.silu(c)
    sc_ctx = jax.nn.silu(c_ctx)
    xl, xc = x, ctx
    for layer in range(DEPTH):
        mod_l = (sc_lat @ ada_w[layer] + ada_b[layer]).reshape(B, N_MOD, D)
        mod_c = (sc_ctx @ ada_w[layer] + ada_b[layer]).reshape(N_MOD, D)
        xl, xc = trunk_layer(xl, xc, mod_l, mod_c, norm1_g[layer], norm2_g[layer], w_in[layer],
                             gqa_qn_g[layer], gqa_kn_g[layer], pool_w[layer], pool_scale[layer],
                             mla_qn_g[layer], mla_kvn_g[layer], mla_w_uq[layer], mla_w_ukv[layer], w_out[layer],
                             peer_wq[layer], peer_subkeys[layer], peer_u[layer], peer_v[layer],
                             rope_a, rope_c, layer < DEPTH - 1)
    return rms_norm(xl, final_g)
```

```cpp
#include <hip/hip_runtime.h>
#include <stdint.h>

typedef unsigned short bf16_t;

constexpr int D = 1024, NB = 32, S = 2048, CTX = 256, DEPTH = 2;
constexpr int NL = NB * S, NC = NB * CTX, NR = NL + NC;
constexpr int KEYS = CTX + S;
constexpr int INC = 1568;
constexpr int NE = 16384;
constexpr float EPS = 1e-6f;

__device__ __forceinline__ float bf2f(bf16_t v) { return __uint_as_float(((unsigned)v) << 16); }
__device__ __forceinline__ bf16_t f2bf(float f) { unsigned u = __float_as_uint(f); u += 0x7FFFu + ((u >> 16) & 1u); return (bf16_t)(u >> 16); }

__device__ __forceinline__ float wave_sum(float v) {
#pragma unroll
    for (int o = 32; o > 0; o >>= 1) v += __shfl_xor(v, o);
    return v;
}
__device__ __forceinline__ float gelu_tanh(float x) {
    const float u = 0.7978845608028654f * (x + 0.044715f * x * x * x);
    return 0.5f * x * (1.f + tanhf(u));
}

struct WS {
    bf16_t* H;
    bf16_t *Qg, *Qgc, *Kg, *Vg, *CQ, *CKV, *Bp, *KR;
    bf16_t *Qm, *Qmc, *Kmn, *Vm;
    unsigned* EG;
    float* XC;
    float* MOD;
    float2* ROPA;
    float2* ROPC;
    float *RSQ, *RSKV;
    bf16_t* P;
    bf16_t* TMP;
    bf16_t* PQ;
    bf16_t *WinT, *WuqT, *WukvT, *WoutT, *WqT, *SubK, *Ub, *Vb;
    float *SSQ, *SSKV;
};

static WS make_ws(void* d_ws) {
    WS w; char* p = (char*)d_ws; size_t off = 65536;
    auto take = [&](size_t bytes) { char* r = p + off; off += (bytes + 255) & ~(size_t)255; return r; };
    w.H = (bf16_t*)take((size_t)NR * 1024 * 2); w.TMP = w.H;
    char* regA = p + off;
    w.Qg = (bf16_t*)take((size_t)NL * 384 * 2);
    w.Qgc = (bf16_t*)take((size_t)NC * 384 * 2);
    w.Kg = (bf16_t*)take((size_t)NB * 2 * KEYS * 64 * 2);
    w.Vg = (bf16_t*)take((size_t)NB * 2 * KEYS * 64 * 2);
    w.CQ = (bf16_t*)take((size_t)NR * 384 * 2);
    w.CKV = (bf16_t*)take((size_t)NR * 256 * 2);
    w.Bp = (bf16_t*)take((size_t)NR * 256 * 2);
    w.KR = (bf16_t*)take((size_t)NB * KEYS * 32 * 2);
    char* regB = p + off;
    w.Qm = (bf16_t*)take((size_t)NL * 576 * 2);
    w.Qmc = (bf16_t*)take((size_t)NC * 576 * 2);
    w.Kmn = (bf16_t*)take((size_t)NB * 6 * KEYS * 64 * 2);
    w.Vm = (bf16_t*)take((size_t)NB * 6 * KEYS * 64 * 2);
    w.EG = (unsigned*)take((size_t)NR * 128 * 4);
    w.P = (bf16_t*)regB;
    w.PQ = (bf16_t*)regA;
    w.XC = (float*)take((size_t)NC * 1024 * 4);
    w.MOD = (float*)take((size_t)2 * 33 * 6144 * 4);
    w.ROPA = (float2*)take((size_t)2048 * 32 * 8);
    w.ROPC = (float2*)take((size_t)2048 * 16 * 8);
    w.RSQ = (float*)take((size_t)NR * 4);
    w.RSKV = (float*)take((size_t)NR * 4);
    w.WinT = (bf16_t*)take((size_t)2 * 1792 * 1024 * 2);
    w.WuqT = (bf16_t*)take((size_t)2 * 768 * 384 * 2);
    w.WukvT = (bf16_t*)take((size_t)2 * 768 * 256 * 2);
    w.WoutT = (bf16_t*)take((size_t)2 * 1024 * 1024 * 2);
    w.WqT = (bf16_t*)take((size_t)2 * 2048 * 1024 * 2);
    w.SubK = (bf16_t*)take((size_t)2 * 16 * 128 * 128 * 2);
    w.Ub = (bf16_t*)take((size_t)2 * NE * 1024 * 2);
    w.Vb = (bf16_t*)take((size_t)2 * NE * 1024 * 2);
    w.SSQ = (float*)take((size_t)NR * 8 * 4);
    w.SSKV = (float*)take((size_t)NR * 4 * 4);
    return w;
}

__global__ void k_mod(const float* __restrict__ c, const float* __restrict__ c_ctx, const float* __restrict__ ada_w, const float* __restrict__ ada_b, float* __restrict__ MOD) {
    __shared__ float sc[1024];
    const int r = blockIdx.y, l = blockIdx.z, n = blockIdx.x * 256 + threadIdx.x;
    const float* cv = r < 32 ? c + (size_t)r * 1024 : c_ctx;
    for (int k = threadIdx.x; k < 1024; k += 256) { const float v = cv[k]; sc[k] = v / (1.f + expf(-v)); }
    __syncthreads();
    const float* w = ada_w + (size_t)l * 1024 * 6144 + n;
    float acc = 0.f;
    for (int k = 0; k < 1024; ++k) acc += sc[k] * w[(size_t)k * 6144];
    MOD[((size_t)l * 33 + r) * 6144 + n] = acc + ada_b[(size_t)l * 6144 + n];
}
__global__ void k_rope_tab(float2* ROPA, float2* ROPC) {
    const int i = blockIdx.x * 256 + threadIdx.x;
    if (i < 2048 * 32) { const int t = i / 32, j = i % 32; const double inv = pow(10000.0, -(double)(j % 16) / 16.0); const double a = (double)(j < 16 ? t / 64 : t % 64) * inv; ROPA[i] = make_float2((float)cos(a), (float)sin(a)); }
    if (i < 2048 * 16) { const int t = i / 16, j = i % 16; const double inv = pow(10000.0, -(double)(j % 8) / 8.0); const double a = (double)(j < 8 ? t / 64 : t % 64) * inv; ROPC[i] = make_float2((float)cos(a), (float)sin(a)); }
}

__global__ void k_modulate(const float* __restrict__ X, bf16_t* __restrict__ Hout, const float* __restrict__ g, const float* __restrict__ MODl, int si, int rows_per_batch, int fixed) {
    __shared__ float red[4];
    const int row = blockIdx.x, tid = threadIdx.x;
    const float4 x = *(const float4*)(X + (size_t)row * 1024 + tid * 4);
    float ss = x.x * x.x + x.y * x.y + x.z * x.z + x.w * x.w;
    ss = wave_sum(ss); if ((tid & 63) == 0) red[tid >> 6] = ss; __syncthreads();
    ss = red[0] + red[1] + red[2] + red[3];
    const float rstd = rsqrtf(ss * (1.f / 1024.f) + EPS);
    const int mr = fixed >= 0 ? fixed : row / rows_per_batch;
    const float* sh = MODl + (size_t)mr * 6144 + si * 1024 + tid * 4; const float* sc = sh + 1024;
    const float4 gv = *(const float4*)(g + tid * 4), shv = *(const float4*)sh, scv = *(const float4*)sc;
    bf16_t o[4];
    o[0] = f2bf(x.x * rstd * gv.x * (1.f + scv.x) + shv.x); o[1] = f2bf(x.y * rstd * gv.y * (1.f + scv.y) + shv.y);
    o[2] = f2bf(x.z * rstd * gv.z * (1.f + scv.z) + shv.z); o[3] = f2bf(x.w * rstd * gv.w * (1.f + scv.w) + shv.w);
    *(uint2*)(Hout + (size_t)row * 1024 + tid * 4) = *(uint2*)o;
}

template <int MODE>
__global__ void __launch_bounds__(256) k_ngemm(const bf16_t* __restrict__ A, int lda, const float* __restrict__ W, int ldw, int M, int N, int K,
                                               const float* __restrict__ rowscale, const float* __restrict__ kgain,
                                               bf16_t* __restrict__ C, int ldc, float* __restrict__ Xf, const float* __restrict__ gate, int rows_per_batch, int fixed) {
    __shared__ float As[64][17];
    __shared__ float Ws[16][64];
    const int tid = threadIdx.x, tx = tid & 15, ty = tid >> 4;
    const int m0 = blockIdx.y * 64, n0 = blockIdx.x * 64;
    float acc[4][4];
#pragma unroll
    for (int i = 0; i < 4; ++i)
#pragma unroll
        for (int j = 0; j < 4; ++j) acc[i][j] = 0.f;
    const int ar = tid >> 2, ac = (tid & 3) * 4;
    const int wr = tid >> 4, wc = (tid & 15) * 4;
    for (int k0 = 0; k0 < K; k0 += 16) {
        { const uint2 raw = *(const uint2*)(A + (size_t)(m0 + ar) * lda + k0 + ac); const bf16_t* e = (const bf16_t*)&raw;
#pragma unroll
          for (int i = 0; i < 4; ++i) { float v = bf2f(e[i]); if (kgain) v *= kgain[k0 + ac + i]; As[ar][ac + i] = v; } }
        { float4 wv = make_float4(0.f, 0.f, 0.f, 0.f); if (n0 + wc < N) wv = *(const float4*)(W + (size_t)(k0 + wr) * ldw + n0 + wc); *(float4*)&Ws[wr][wc] = wv; }
        __syncthreads();
#pragma unroll
        for (int kk = 0; kk < 16; ++kk) {
            float a[4], b[4];
#pragma unroll
            for (int i = 0; i < 4; ++i) a[i] = As[ty * 4 + i][kk];
            const float4 bv = *(const float4*)&Ws[kk][tx * 4]; b[0] = bv.x; b[1] = bv.y; b[2] = bv.z; b[3] = bv.w;
#pragma unroll
            for (int i = 0; i < 4; ++i)
#pragma unroll
                for (int j = 0; j < 4; ++j) acc[i][j] += a[i] * b[j];
        }
        __syncthreads();
    }
    if (n0 + tx * 4 >= N) return;
#pragma unroll
    for (int i = 0; i < 4; ++i) {
        const int m = m0 + ty * 4 + i; const float rs = rowscale ? rowscale[m] : 1.f;
        if (MODE == 0) { bf16_t o[4];
#pragma unroll
            for (int j = 0; j < 4; ++j) o[j] = f2bf(acc[i][j] * rs);
            *(uint2*)(C + (size_t)m * ldc + n0 + tx * 4) = *(uint2*)o;
        } else {
            const int mr = fixed >= 0 ? fixed : m / rows_per_batch;
            float4 xv = *(float4*)(Xf + (size_t)m * 1024 + n0 + tx * 4); const float4 gv = *(const float4*)(gate + (size_t)mr * 6144 + n0 + tx * 4);
            xv.x += gv.x * acc[i][0]; xv.y += gv.y * acc[i][1]; xv.z += gv.z * acc[i][2]; xv.w += gv.w * acc[i][3];
            *(float4*)(Xf + (size_t)m * 1024 + n0 + tx * 4) = xv;
        }
    }
}

__global__ void __launch_bounds__(256) k_post_in(const bf16_t* __restrict__ P, WS w, const float* __restrict__ qn_g, const float* __restrict__ kn_g, int row0) {
    __shared__ float p[INC];
    const int row = row0 + blockIdx.x, tid = threadIdx.x, lane = tid & 63, wid = tid >> 6;
    const bool isctx = row >= NL; const int b = isctx ? (row - NL) / CTX : row / S, t = isctx ? (row - NL) % CTX : row % S;
    const int key = isctx ? t : CTX + t;
    for (int i = tid; i < INC; i += 256) p[i] = bf2f(P[(size_t)row * INC + i]);
    __syncthreads();
    for (int gI = wid; gI < 8; gI += 4) {
        const float x = p[gI * 64 + lane];
        const float ss = wave_sum(x * x);
        const float rstd = rsqrtf(ss * (1.f / 64.f) + EPS);
        float y = x * rstd * (gI < 6 ? qn_g[lane] : kn_g[lane]);
        if (!isctx) { const float o = __shfl_xor(y, 32); const float2 cs = w.ROPA[t * 32 + (lane & 31)];
            y = lane < 32 ? (y * cs.x - o * cs.y) : (o * cs.y + y * cs.x); }
        if (gI < 6) { bf16_t* dst = isctx ? w.Qgc + (((size_t)b * 6 + gI) * CTX + t) * 64 : w.Qg + (((size_t)b * 6 + gI) * S + t) * 64; dst[lane] = f2bf(y); }
        else { w.Kg[(((size_t)b * 2 + (gI - 6)) * KEYS + key) * 64 + lane] = f2bf(y); }
    }
    if (tid < 128) w.Vg[(((size_t)b * 2 + (tid >> 6)) * KEYS + key) * 64 + (tid & 63)] = f2bf(p[512 + tid]);
    w.Bp[(size_t)row * 256 + tid] = f2bf(p[640 + tid]);
    for (int i = tid; i < 384; i += 256) w.CQ[(size_t)row * 384 + i] = f2bf(p[896 + i]);
    w.CKV[(size_t)row * 256 + tid] = f2bf(p[1280 + tid]);
    if (wid == 0) { float ss = 0.f; for (int i = lane; i < 384; i += 64) ss += p[896 + i] * p[896 + i]; ss = wave_sum(ss); if (lane == 0) w.RSQ[row] = rsqrtf(ss * (1.f / 384.f) + EPS); }
    if (wid == 1) { float ss = 0.f; for (int i = lane; i < 256; i += 64) ss += p[1280 + i] * p[1280 + i]; ss = wave_sum(ss); if (lane == 0) w.RSKV[row] = rsqrtf(ss * (1.f / 256.f) + EPS); }
    if (wid == 2 && lane < 32) { float y = p[1536 + lane];
        if (!isctx) { const float o = __shfl_xor(y, 16); const float2 cs = w.ROPC[t * 16 + (lane & 15)]; y = lane < 16 ? (y * cs.x - o * cs.y) : (o * cs.y + y * cs.x); }
        w.KR[((size_t)b * KEYS + key) * 32 + lane] = f2bf(y); }
}
__global__ void __launch_bounds__(256) k_post_q(const bf16_t* __restrict__ T, WS w, int row0) {
    const int row = row0 + blockIdx.x, tid = threadIdx.x;
    const bool isctx = row >= NL; const int b = isctx ? (row - NL) / CTX : row / S, t = isctx ? (row - NL) % CTX : row % S;
    for (int i = tid; i < 576; i += 256) {
        const int h = i / 96, e = i % 96; float y = bf2f(T[(size_t)row * 576 + i]);
        if (e >= 64 && !isctx) { const int j = e - 64; const float o = bf2f(T[(size_t)row * 576 + h * 96 + 64 + (j ^ 16)]); const float2 cs = w.ROPC[t * 16 + (j & 15)];
            y = j < 16 ? (y * cs.x - o * cs.y) : (o * cs.y + y * cs.x); }
        bf16_t* dst = isctx ? w.Qmc + (((size_t)b * 6 + h) * CTX + t) * 96 : w.Qm + (((size_t)b * 6 + h) * S + t) * 96;
        dst[e] = f2bf(y);
    }
}
__global__ void __launch_bounds__(256) k_post_kv(const bf16_t* __restrict__ T, WS w, int row0) {
    const int row = row0 + blockIdx.x, tid = threadIdx.x;
    const bool isctx = row >= NL; const int b = isctx ? (row - NL) / CTX : row / S, t = isctx ? (row - NL) % CTX : row % S;
    const int key = isctx ? t : CTX + t;
    for (int i = tid; i < 768; i += 256) {
        const int h = i / 128, e = i % 128; const bf16_t v = T[(size_t)row * 768 + i];
        if (e < 64) w.Kmn[(((size_t)b * 6 + h) * KEYS + key) * 64 + e] = v; else w.Vm[(((size_t)b * 6 + h) * KEYS + key) * 64 + (e - 64)] = v;
    }
}

template <int DK>
__global__ void __launch_bounds__(256) k_nattn(const bf16_t* __restrict__ Q, const bf16_t* __restrict__ K1, const bf16_t* __restrict__ K2, const bf16_t* __restrict__ V,
                                               bf16_t* __restrict__ MIX, int H, int HK, int G, int LQ, int nkeys, float scale, int rowbase, int coff) {
    const int b = blockIdx.z, h = blockIdx.y, t = blockIdx.x * 256 + threadIdx.x, hk = h / G;
    float q[DK];
    { const bf16_t* qp = Q + (((size_t)b * H + h) * LQ + t) * DK;
#pragma unroll
      for (int d = 0; d < DK; d += 8) { const uint4 raw = *(const uint4*)(qp + d); const bf16_t* e = (const bf16_t*)&raw;
#pragma unroll
          for (int i = 0; i < 8; ++i) q[d + i] = bf2f(e[i]) * scale; } }
    float o[64];
#pragma unroll
    for (int d = 0; d < 64; ++d) o[d] = 0.f;
    float m = -INFINITY, l = 0.f;
    const bf16_t* k1 = K1 + ((size_t)b * HK + hk) * KEYS * 64; const bf16_t* k2 = K2 ? K2 + (size_t)b * KEYS * 32 : nullptr; const bf16_t* vp = V + ((size_t)b * HK + hk) * KEYS * 64;
    for (int k = 0; k < nkeys; ++k) {
        float s = 0.f;
#pragma unroll
        for (int d = 0; d < 64; d += 8) { const uint4 raw = *(const uint4*)(k1 + (size_t)k * 64 + d); const bf16_t* e = (const bf16_t*)&raw;
#pragma unroll
            for (int i = 0; i < 8; ++i) s += q[d + i] * bf2f(e[i]); }
        if (DK == 96) {
#pragma unroll
            for (int d = 0; d < 32; d += 8) { const uint4 raw = *(const uint4*)(k2 + (size_t)k * 32 + d); const bf16_t* e = (const bf16_t*)&raw;
#pragma unroll
                for (int i = 0; i < 8; ++i) s += q[(DK == 96 ? 64 : 0) + d + i] * bf2f(e[i]); }
        }
        if (s > m) { const float a = __expf(m - s); l *= a;
#pragma unroll
            for (int d = 0; d < 64; ++d) o[d] *= a;
            m = s; }
        const float pw = __expf(s - m); l += pw;
#pragma unroll
        for (int d = 0; d < 64; d += 8) { const uint4 raw = *(const uint4*)(vp + (size_t)k * 64 + d); const bf16_t* e = (const bf16_t*)&raw;
#pragma unroll
            for (int i = 0; i < 8; ++i) o[d + i] += pw * bf2f(e[i]); }
    }
    const float il = 1.f / l;
    bf16_t* dst = MIX + (size_t)(rowbase + b * LQ + t) * 1024 + coff + h * 64;
#pragma unroll
    for (int d = 0; d < 64; d += 8) { bf16_t ob[8];
#pragma unroll
        for (int i = 0; i < 8; ++i) ob[i] = f2bf(o[d + i] * il);
        *(uint4*)(dst + d) = *(uint4*)ob; }
}

__global__ void __launch_bounds__(256) k_npool(const bf16_t* __restrict__ Bp, bf16_t* __restrict__ MIX, const float* __restrict__ pool_w, const float* __restrict__ pool_scale, int row0) {
    __shared__ float pl[256];
    const int row = row0 + blockIdx.x, tid = threadIdx.x, gI = tid >> 6, c = tid & 63;
    const bool isctx = row >= NL; const int L = isctx ? CTX : S; const int t = isctx ? (row - NL) % CTX : row % S; const int base = row - t;
    const int wdw = 2 << gI;
    int lo = t - wdw / 2, hi = t - wdw / 2 + wdw; lo = lo < 0 ? 0 : lo; hi = hi > L ? L : hi;
    float sum = 0.f;
    for (int u = lo; u < hi; ++u) sum += bf2f(Bp[(size_t)(base + u) * 256 + tid]);
    pl[tid] = sum / (float)(hi - lo) - bf2f(Bp[(size_t)row * 256 + tid]);
    __syncthreads();
    float acc = 0.f; const float* wg = pool_w + (size_t)gI * 64 * 64 + c;
    for (int cc = 0; cc < 64; ++cc) acc += pl[gI * 64 + cc] * wg[cc * 64];
    MIX[(size_t)row * 1024 + 384 + tid] = f2bf(acc * pool_scale[tid]);
}

__global__ void __launch_bounds__(256) k_peer_select(const bf16_t* __restrict__ PQ, const float* __restrict__ subk, unsigned* __restrict__ EG, int row0) {
    __shared__ float q[2048];
    __shared__ float sc[16][128];
    __shared__ float ts[16][16]; __shared__ int ti[16][16];
    __shared__ float cs[8][16]; __shared__ int ci[8][16];
    const int row = row0 + blockIdx.x, tid = threadIdx.x;
    for (int i = tid; i < 2048; i += 256) q[i] = bf2f(PQ[(size_t)row * 2048 + i]);
    __syncthreads();
    for (int i = tid; i < 2048; i += 256) { const int gp = i >> 7, n = i & 127; const float* kp = subk + ((size_t)gp * 128 + n) * 128; const float* qp = q + gp * 128;
        float s = 0.f; for (int d = 0; d < 128; ++d) s += qp[d] * kp[d]; sc[gp][n] = s; }
    __syncthreads();
    for (int i = tid; i < 2048; i += 256) { const int gp = i >> 7, n = i & 127; const float v = sc[gp][n]; int rank = 0;
        for (int mI = 0; mI < 128; ++mI) { const float o = sc[gp][mI]; rank += (o > v || (o == v && mI < n)) ? 1 : 0; }
        if (rank < 16) { ts[gp][rank] = v; ti[gp][rank] = n; } }
    __syncthreads();
    { const int h = tid >> 5;
      for (int cI = (tid & 31); cI < 256; cI += 32) { const int a = cI >> 4, bb = cI & 15; const float v = ts[h * 2][a] + ts[h * 2 + 1][bb]; int rank = 0;
          for (int o = 0; o < 256; ++o) { const float ov = ts[h * 2][o >> 4] + ts[h * 2 + 1][o & 15]; rank += (ov > v || (ov == v && o < cI)) ? 1 : 0; }
          if (rank < 16) { cs[h][rank] = v; ci[h][rank] = ti[h * 2][a] * 128 + ti[h * 2 + 1][bb]; } } }
    __syncthreads();
    if (tid < 128) { const int h = tid >> 4, j = tid & 15; const float mx = cs[h][0]; float den = 0.f;
        for (int o = 0; o < 16; ++o) den += __expf(cs[h][o] - mx);
        const float gte = __expf(cs[h][j] - mx) / den;
        EG[(size_t)row * 128 + tid] = ((unsigned)ci[h][j] << 16) | (unsigned)f2bf(gte); }
}
__global__ void __launch_bounds__(256) k_peer_expert(const bf16_t* __restrict__ H2, const unsigned* __restrict__ EG, const float* __restrict__ U, const float* __restrict__ Vt, float* __restrict__ X,
                                                     const float* __restrict__ gate2, int rows_per_batch, int fixed, int hrow0) {
    __shared__ float h[1024]; __shared__ float wgt[128]; __shared__ int eid[128];
    const int row = blockIdx.x, tid = threadIdx.x, lane = tid & 63, wid = tid >> 6;
    for (int i = tid; i < 1024; i += 256) h[i] = bf2f(H2[(size_t)(hrow0 + row) * 1024 + i]);
    if (tid < 128) eid[tid] = (int)(EG[(size_t)(hrow0 + row) * 128 + tid] >> 16);
    __syncthreads();
    for (int e = wid; e < 128; e += 4) { const float* up = U + (size_t)eid[e] * 1024; float s = 0.f;
        for (int d = lane; d < 1024; d += 64) s += h[d] * up[d];
        s = wave_sum(s);
        if (lane == 0) wgt[e] = bf2f((bf16_t)(EG[(size_t)(hrow0 + row) * 128 + e] & 0xFFFFu)) * gelu_tanh(s); }
    __syncthreads();
    float4 acc = make_float4(0.f, 0.f, 0.f, 0.f);
    for (int e = 0; e < 128; ++e) { const float4 v = *(const float4*)(Vt + (size_t)eid[e] * 1024 + tid * 4); const float wv = wgt[e];
        acc.x += wv * v.x; acc.y += wv * v.y; acc.z += wv * v.z; acc.w += wv * v.w; }
    const int mr = fixed >= 0 ? fixed : row / rows_per_batch;
    const float4 gv = *(const float4*)(gate2 + (size_t)mr * 6144 + tid * 4);
    float4 xv = *(float4*)(X + (size_t)row * 1024 + tid * 4);
    xv.x += gv.x * acc.x; xv.y += gv.y * acc.y; xv.z += gv.z * acc.z; xv.w += gv.w * acc.w;
    *(float4*)(X + (size_t)row * 1024 + tid * 4) = xv;
}
__global__ void __launch_bounds__(256) k_final(float* __restrict__ X, const float* __restrict__ g) {
    __shared__ float red[4];
    const int row = blockIdx.x, tid = threadIdx.x;
    float4 x = *(const float4*)(X + (size_t)row * 1024 + tid * 4);
    float ss = x.x * x.x + x.y * x.y + x.z * x.z + x.w * x.w;
    ss = wave_sum(ss); if ((tid & 63) == 0) red[tid >> 6] = ss; __syncthreads();
    ss = red[0] + red[1] + red[2] + red[3];
    const float rstd = rsqrtf(ss * (1.f / 1024.f) + EPS);
    const float4 gv = *(const float4*)(g + tid * 4);
    x.x *= rstd * gv.x; x.y *= rstd * gv.y; x.z *= rstd * gv.z; x.w *= rstd * gv.w;
    *(float4*)(X + (size_t)row * 1024 + tid * 4) = x;
}

#define LAS __attribute__((address_space(3)))
typedef short bf16x8 __attribute__((ext_vector_type(8)));
typedef float f32x4 __attribute__((ext_vector_type(4)));
typedef float f32x16 __attribute__((ext_vector_type(16)));
typedef unsigned u32x4 __attribute__((ext_vector_type(4)));
typedef unsigned u32x2 __attribute__((ext_vector_type(2)));

__device__ __forceinline__ unsigned cvt_pk_bf16(float lo, float hi) { unsigned r; asm volatile("v_cvt_pk_bf16_f32 %0, %1, %2" : "=v"(r) : "v"(lo), "v"(hi)); return r; }

namespace pg8 {
constexpr int BM = 256, BK = 64, HALF = 128, HTB = HALF * BK * 2, STAGE_BYTES = 8 * HTB, NXCD = 8, WGM = 8;
__host__ __device__ __forceinline__ int lds_byte(int r, int c) { const int st = (r >> 4) * 2 + (c >> 5), rr = r & 15, cc = c & 31, ob = rr * 64 + cc * 2; return st * 1024 + (ob ^ (((ob >> 9) & 1) << 5)); }
__host__ __device__ __forceinline__ void stage_rc(int b, int& R, int& C) { const int st = b / 1024, sb = b % 1024, swz = sb ^ (((sb >> 9) & 1) << 5); R = (st >> 1) * 16 + swz / 64; C = (st & 1) * 32 + (swz % 64) / 2; }
__host__ __device__ __forceinline__ int perm32(int rho) { const int n = rho >> 4, i = rho & 15; return 8 * (i >> 2) + 4 * n + (i & 3); }
struct Unit { int pm, pn; };
struct Gemm { const bf16_t* A; const bf16_t* Bt; int M, N, K; };
struct StaticOrder {
    int nM, nN, nwg, G, c;
    __host__ __device__ void init(int M, int N, int G_, int c_) { nM = M / BM; nN = N / BM; nwg = nM * nN; G = G_; c = c_; }
    __host__ __device__ bool next(int i, Unit& u) const {
        const long L = (long)i * G + c; if (L >= nwg) return false;
        int wgid = (int)L; { const int q = nwg / NXCD, r = nwg % NXCD, xcd = wgid % NXCD, off = wgid / NXCD; wgid = (xcd < r ? xcd * (q + 1) : r * (q + 1) + (xcd - r) * q) + off; }
        const int nig = WGM * nN, gid = wgid / nig, fm = gid * WGM, gsz = (nM - fm) < WGM ? (nM - fm) : WGM;
        u.pm = fm + ((wgid % nig) % gsz); u.pn = (wgid % nig) / gsz; return true;
    }
};
template <class Epi, class Sched>
__device__ __forceinline__ void gemm_phase(LAS unsigned char* lds, const Gemm g, const Sched& S, const Epi& E) {
    int tid_ = threadIdx.x; asm volatile("" : "+v"(tid_));
    const int tid = tid_, wid = __builtin_amdgcn_readfirstlane(tid >> 6), lane = tid & 63, wr = wid >> 2, wc = wid & 3, fr = lane & 15, fq = lane >> 4;
    const int K = g.K, nt = K / BK;
    unsigned voffA[2], voffB[2];
#pragma unroll
    for (int i = 0; i < 2; ++i) { int R, C; stage_rc(tid * 16 + i * 8192, R, C); const int Rb = Epi::PERM ? ((R & ~31) + perm32(R & 31)) : R;
        voffA[i] = (unsigned)(R * K + C) * 2u; voffB[i] = (unsigned)(Rb * K + C) * 2u; }
    const size_t kstep = (size_t)(BK * 2);
    const size_t hstep = (size_t)HALF * K * 2;
    const size_t tstep = 2 * hstep;
    const unsigned ldsw = (unsigned)wid * 1024u;
    const int aoff = lds_byte(wr * 64 + fr, fq * 8), boff = lds_byte(wc * 32 + fr, fq * 8);
#define PG8_SA(b, h) (((b) * 2 + (h)) * HTB)
#define PG8_SB(b, h) ((4 + (b) * 2 + (h)) * HTB)
#define PG8_STAGE(bufoff, gbase, voff) do { _Pragma("unroll") for (int _i = 0; _i < 2; ++_i) \
        __builtin_amdgcn_global_load_lds((const unsigned*)((const char*)(gbase) + (voff)[_i]), (LAS unsigned*)(lds + (bufoff) + ldsw + _i * 8192), 16, 0, 0); } while (0)
#define PG8_LDA(dst, b, h) do { _Pragma("unroll") for (int m = 0; m < 4; ++m) _Pragma("unroll") for (int k = 0; k < 2; ++k) dst[m][k] = *(const LAS bf16x8*)(lds + PG8_SA(b, h) + aoff + m * 2048 + k * 1024); } while (0)
#define PG8_LDB(dst, b, h) do { _Pragma("unroll") for (int n = 0; n < 2; ++n) _Pragma("unroll") for (int k = 0; k < 2; ++k) dst[n][k] = *(const LAS bf16x8*)(lds + PG8_SB(b, h) + boff + n * 2048 + k * 1024); } while (0)
#define PG8_MMA(ai, bj, At, Bt) do { __builtin_amdgcn_s_setprio(1); _Pragma("unroll") for (int m = 0; m < 4; ++m) _Pragma("unroll") for (int n = 0; n < 2; ++n) _Pragma("unroll") for (int k = 0; k < 2; ++k) \
        acc[ai][bj][m][n] = __builtin_amdgcn_mfma_f32_16x16x32_bf16(Bt[n][k], At[m][k], acc[ai][bj][m][n], 0, 0, 0); __builtin_amdgcn_s_setprio(0); } while (0)
#define PG8_WAIT_V(n) asm volatile("s_waitcnt vmcnt(" #n ")" ::: "memory")
#define PG8_WAIT_L(n) asm volatile("s_waitcnt lgkmcnt(" #n ")" ::: "memory")
#define PG8_BAR __builtin_amdgcn_s_barrier()
#define PG8_SCHED __builtin_amdgcn_sched_barrier(0)
    Unit cur, nxt; int ui = 0;
    if (!S.next(0, cur)) return;
    f32x4 acc[2][2][4][2];
#pragma unroll
    for (int a = 0; a < 2; ++a)
#pragma unroll
        for (int b = 0; b < 2; ++b)
#pragma unroll
            for (int m = 0; m < 4; ++m)
#pragma unroll
                for (int n = 0; n < 2; ++n) acc[a][b][m][n] = (f32x4){0.f, 0.f, 0.f, 0.f};
    bf16x8 At[4][2], B0[2][2], B1[2][2];
    const char* cA = (const char*)g.A + (size_t)cur.pm * tstep; const char* cB = (const char*)g.Bt + (size_t)cur.pn * tstep;
    PG8_STAGE(PG8_SB(0, 0), cB, voffB); PG8_STAGE(PG8_SA(0, 0), cA, voffA); PG8_STAGE(PG8_SB(0, 1), cB + hstep, voffB); PG8_STAGE(PG8_SA(0, 1), cA + hstep, voffA);
    if (wr == 1) PG8_BAR;
    PG8_WAIT_V(4); PG8_BAR;
    PG8_STAGE(PG8_SB(1, 0), cB + kstep, voffB); PG8_STAGE(PG8_SA(1, 0), cA + kstep, voffA); PG8_STAGE(PG8_SB(1, 1), cB + hstep + kstep, voffB);
    PG8_WAIT_V(6); PG8_BAR;
    for (;;) {
        const bool has_next = S.next(ui + 1, nxt);
        const char* nA = has_next ? (const char*)g.A + (size_t)nxt.pm * tstep : cA; const char* nB = has_next ? (const char*)g.Bt + (size_t)nxt.pn * tstep : cB;
#pragma nounroll
        for (int t = 0; t < nt; t += 2) {
            const bool last = (t == nt - 2);
            const char* a1 = cA + (size_t)(t + 1) * kstep;
            const char* a2 = last ? nA : cA + (size_t)(t + 2) * kstep; const char* b2 = last ? nB : cB + (size_t)(t + 2) * kstep;
            const char* a3 = a2 + kstep; const char* b3 = b2 + kstep;
            PG8_LDB(B0, 0, 0); PG8_SCHED; PG8_LDA(At, 0, 0); PG8_STAGE(PG8_SA(1, 1), a1 + hstep, voffA);
            PG8_WAIT_L(8); PG8_BAR; PG8_WAIT_L(0); PG8_MMA(0, 0, At, B0); PG8_BAR; PG8_SCHED;
            PG8_LDB(B1, 0, 1); PG8_STAGE(PG8_SB(0, 0), b2, voffB);
            PG8_BAR; PG8_WAIT_L(0); PG8_MMA(0, 1, At, B1); PG8_BAR;
            PG8_LDA(At, 0, 1); PG8_STAGE(PG8_SA(0, 0), a2, voffA);
            PG8_BAR; PG8_WAIT_L(0); PG8_MMA(1, 0, At, B0); PG8_BAR; PG8_SCHED;
            PG8_STAGE(PG8_SB(0, 1), b2 + hstep, voffB);
            PG8_WAIT_V(6); PG8_BAR; PG8_MMA(1, 1, At, B1); PG8_BAR;
            PG8_LDB(B0, 1, 0); PG8_SCHED; PG8_LDA(At, 1, 0); PG8_STAGE(PG8_SA(0, 1), a2 + hstep, voffA);
            PG8_WAIT_L(8); PG8_BAR; PG8_WAIT_L(0); PG8_MMA(0, 0, At, B0); PG8_BAR; PG8_SCHED;
            PG8_LDB(B1, 1, 1); PG8_STAGE(PG8_SB(1, 0), b3, voffB);
            PG8_BAR; PG8_WAIT_L(0); PG8_MMA(0, 1, At, B1); PG8_BAR;
            PG8_LDA(At, 1, 1); PG8_STAGE(PG8_SA(1, 0), a3, voffA);
            PG8_BAR; PG8_WAIT_L(0); PG8_MMA(1, 0, At, B0); PG8_BAR; PG8_SCHED;
            PG8_STAGE(PG8_SB(1, 1), b3 + hstep, voffB);
            PG8_WAIT_V(6); PG8_BAR; PG8_MMA(1, 1, At, B1); PG8_BAR;
        }
        E(acc, cur, wr, wc, fr, fq);
        if (!has_next) break;
#pragma unroll
        for (int a = 0; a < 2; ++a)
#pragma unroll
            for (int b = 0; b < 2; ++b)
#pragma unroll
                for (int m = 0; m < 4; ++m)
#pragma unroll
                    for (int n = 0; n < 2; ++n) acc[a][b][m][n] = (f32x4){0.f, 0.f, 0.f, 0.f};
        cur = nxt; cA = nA; cB = nB; ++ui;
    }
    PG8_WAIT_V(0);
    if (wr == 0) PG8_BAR;
    PG8_BAR;
#undef PG8_SA
#undef PG8_SB
#undef PG8_STAGE
#undef PG8_LDA
#undef PG8_LDB
#undef PG8_MMA
#undef PG8_WAIT_V
#undef PG8_WAIT_L
#undef PG8_BAR
#undef PG8_SCHED
}
}

enum { GT_AQ = 0, GT_AK = 1, GT_AV = 2, GT_B = 3, GT_CQ = 4, GT_CKV = 5, GT_KR = 6, GT_PAD = 7 };
__host__ __device__ __forceinline__ void in_group(int g, int& type, int& sub) {
    if (g < 2) { type = GT_AK; sub = g; } else if (g < 4) { type = GT_AV; sub = g - 2; } else if (g < 8) { type = GT_CKV; sub = g - 4; }
    else if (g == 8) { type = GT_KR; sub = 0; } else if (g < 12) { type = GT_PAD; sub = 0; } else if (g < 18) { type = GT_AQ; sub = g - 12; }
    else if (g < 24) { type = GT_CQ; sub = g - 18; } else { type = GT_B; sub = g - 24; }
}
__device__ __forceinline__ int colmap(int mode, int r) {
    const int pn = r >> 8, ct = r & 255, bj = ct >> 7, wc = (ct >> 5) & 3, j = ct & 31, g = 4 * pn + wc, e = 32 * bj + j;
    if (mode == 0) {
        int type, sub; in_group(g, type, sub);
        switch (type) { case GT_AQ: return 64 * sub + e; case GT_AK: return 384 + 64 * sub + e; case GT_AV: return 512 + 64 * sub + e; case GT_B: return 640 + 64 * sub + e;
            case GT_CQ: return 896 + 64 * sub + e; case GT_CKV: return 1280 + 64 * sub + e; case GT_KR: return (j < 16) ? 1536 + 16 * bj + j : -1; default: return -1; }
    } else if (mode == 1) {
        if (g < 6) return 96 * g + e; if (g < 9) { const int head = 2 * (g - 6) + (j >> 4); return 96 * head + 64 + 16 * bj + (j & 15); } return -1;
    } else if (mode == 2) {
        return 64 * g + e;
    }
    return r;
}
__device__ __forceinline__ void cvt_weights_unit(LAS float* tile  , const float* __restrict__ W, int K, int N, bf16_t* __restrict__ dst, int mode, const float* __restrict__ kgain, int r0, int k0) {
    const int tid = threadIdx.x;
    const int jj = tid & 63; const int sc = colmap(mode, r0 + jj);
#pragma unroll
    for (int i = 0; i < 8; ++i) { const int kk = (tid >> 6) + 8 * i; float v = 0.f; if (sc >= 0) v = W[(size_t)(k0 + kk) * N + sc]; if (kgain) v *= kgain[k0 + kk]; tile[kk * 65 + jj] = v; }
    __syncthreads();
#pragma unroll
    for (int i = 0; i < 8; ++i) { const int rr = (tid >> 6) + 8 * i, kk = tid & 63; dst[(size_t)(r0 + rr) * K + k0 + kk] = f2bf(tile[kk * 65 + rr]); }
    __syncthreads();
}
struct CvtJob { const float* W; bf16_t* dst; const float* kgain; int K, N, Npad, mode; };
__device__ __forceinline__ void cvt_job(LAS float* tile, const CvtJob j, int vb, int nvb) {
    const int nk = j.K / 64, nr = j.Npad / 64;
    for (int u = vb; u < nk * nr; u += nvb) cvt_weights_unit(tile, j.W, j.K, j.N, j.dst, j.mode, j.kgain, (u / nk) * 64, (u % nk) * 64);
}
__device__ __forceinline__ void cvt_flat(const float* __restrict__ src, bf16_t* __restrict__ dst, size_t n, int vb, int nvb) {
    for (size_t i = ((size_t)vb * 512 + threadIdx.x) * 8; i < n; i += (size_t)nvb * 512 * 8) {
        const float4 a = *(const float4*)(src + i), b = *(const float4*)(src + i + 4);
        u32x4 o; o.x = cvt_pk_bf16(a.x, a.y); o.y = cvt_pk_bf16(a.z, a.w); o.z = cvt_pk_bf16(b.x, b.y); o.w = cvt_pk_bf16(b.z, b.w);
        *(u32x4*)(dst + i) = o;
    }
}
struct Inputs {
    const float *x, *c, *ctx, *c_ctx, *ada_w, *ada_b, *norm1_g, *norm2_g, *w_in, *gqa_qn_g, *gqa_kn_g, *pool_w, *pool_scale, *mla_qn_g, *mla_kvn_g, *mla_w_uq, *mla_w_ukv, *w_out, *peer_wq, *peer_subkeys, *peer_u, *peer_v, *final_g;
};
__device__ __forceinline__ void phase_cvt(LAS unsigned char* lds, const Inputs& in, const WS& w, int vb, int nvb) {
    LAS float* tile = (LAS float*)lds;
    for (int l = 0; l < 2; ++l) {
        cvt_job(tile, CvtJob{in.w_in + (size_t)l * 1024 * INC, w.WinT + (size_t)l * 1792 * 1024, nullptr, 1024, INC, 1792, 0}, vb, nvb);
        cvt_job(tile, CvtJob{in.mla_w_uq + (size_t)l * 384 * 576, w.WuqT + (size_t)l * 768 * 384, in.mla_qn_g + l * 384, 384, 576, 768, 1}, vb, nvb);
        cvt_job(tile, CvtJob{in.mla_w_ukv + (size_t)l * 256 * 768, w.WukvT + (size_t)l * 768 * 256, in.mla_kvn_g + l * 256, 256, 768, 768, 2}, vb, nvb);
        cvt_job(tile, CvtJob{in.w_out + (size_t)l * 1024 * 1024, w.WoutT + (size_t)l * 1024 * 1024, nullptr, 1024, 1024, 1024, 3}, vb, nvb);
        cvt_job(tile, CvtJob{in.peer_wq + (size_t)l * 1024 * 2048, w.WqT + (size_t)l * 2048 * 1024, nullptr, 1024, 2048, 2048, 3}, vb, nvb);
    }
    cvt_flat(in.peer_subkeys, w.SubK, (size_t)2 * 16 * 128 * 128, vb, nvb);
    cvt_flat(in.peer_u, w.Ub, (size_t)2 * NE * 1024, vb, nvb);
    cvt_flat(in.peer_v, w.Vb, (size_t)2 * NE * 1024, vb, nvb);
}

struct EpiIn {
    static constexpr bool PERM = true;
    WS w; const float* qn_g; const float* kn_g; int pm_base;
    __device__ __forceinline__ void operator()(const f32x4 (&acc)[2][2][4][2], const pg8::Unit& u, int wr, int wc, int fr, int fq) const {
        int type, sub; in_group(4 * u.pn + wc, type, sub);
        if (type == GT_PAD) return;
        const int pm = u.pm + pm_base; const bool isctx = pm >= 256; const int b = isctx ? pm - 256 : pm >> 3; const int t0 = isctx ? 0 : (pm & 7) * 256;
        const size_t rowbase = isctx ? (size_t)NL + (size_t)b * CTX : (size_t)b * S;
        const int keyoff = isctx ? 0 : CTX;
        float gain[2][8];
        if (type == GT_AQ) {
#pragma unroll
            for (int bj = 0; bj < 2; ++bj)
#pragma unroll
                for (int q = 0; q < 8; ++q) gain[bj][q] = qn_g[32 * bj + 8 * fq + q];
        } else if (type == GT_AK) {
#pragma unroll
            for (int bj = 0; bj < 2; ++bj)
#pragma unroll
                for (int q = 0; q < 8; ++q) gain[bj][q] = kn_g[32 * bj + 8 * fq + q];
        }
#pragma unroll
        for (int ai = 0; ai < 2; ++ai)
#pragma unroll
            for (int m = 0; m < 4; ++m) {
                const int t = t0 + 128 * ai + 64 * wr + 16 * m + fr; const size_t row = rowbase + t;
                float v[2][8];
#pragma unroll
                for (int bj = 0; bj < 2; ++bj)
#pragma unroll
                    for (int n = 0; n < 2; ++n)
#pragma unroll
                        for (int i = 0; i < 4; ++i) v[bj][4 * n + i] = acc[ai][bj][m][n][i];
                bf16_t* dst = nullptr;
                if (type == GT_AQ || type == GT_AK) {
                    float ss = 0.f;
#pragma unroll
                    for (int bj = 0; bj < 2; ++bj)
#pragma unroll
                        for (int q = 0; q < 8; ++q) ss += v[bj][q] * v[bj][q];
                    ss += __shfl_xor(ss, 16); ss += __shfl_xor(ss, 32);
                    const float rstd = rsqrtf(ss * (1.f / 64.f) + EPS);
#pragma unroll
                    for (int q = 0; q < 8; ++q) { float x1 = v[0][q] * rstd * gain[0][q], x2 = v[1][q] * rstd * gain[1][q];
                        if (!isctx) { const float2 cs = w.ROPA[t * 32 + 8 * fq + q]; const float y1 = x1 * cs.x - x2 * cs.y, y2 = x1 * cs.y + x2 * cs.x; x1 = y1; x2 = y2; }
                        v[0][q] = x1; v[1][q] = x2; }
                    if (type == GT_AQ) dst = isctx ? w.Qgc + (((size_t)b * 6 + sub) * CTX + t) * 64 : w.Qg + (((size_t)b * 6 + sub) * S + t) * 64;
                    else dst = w.Kg + (((size_t)b * 2 + sub) * KEYS + keyoff + t) * 64;
                } else if (type == GT_AV) { dst = w.Vg + (((size_t)b * 2 + sub) * KEYS + keyoff + t) * 64;
                } else if (type == GT_B) { dst = w.Bp + row * 256 + 64 * sub;
                } else if (type == GT_CQ || type == GT_CKV) {
                    float ss = 0.f;
#pragma unroll
                    for (int bj = 0; bj < 2; ++bj)
#pragma unroll
                        for (int q = 0; q < 8; ++q) ss += v[bj][q] * v[bj][q];
                    ss += __shfl_xor(ss, 16); ss += __shfl_xor(ss, 32);
                    if (type == GT_CQ) { if (fq == 0) w.SSQ[row * 8 + sub] = ss; dst = w.CQ + row * 384 + 64 * sub; }
                    else { if (fq == 0) w.SSKV[row * 4 + sub] = ss; dst = w.CKV + row * 256 + 64 * sub; }
                } else {
                    if (!isctx) {
#pragma unroll
                        for (int q = 0; q < 8; ++q) { const float2 cs = w.ROPC[t * 16 + ((8 * fq + q) & 15)]; const float x1 = v[0][q], x2 = v[1][q]; v[0][q] = x1 * cs.x - x2 * cs.y; v[1][q] = x1 * cs.y + x2 * cs.x; } }
                    if (fq < 2) { bf16_t* kd = w.KR + ((size_t)b * KEYS + keyoff + t) * 32;
#pragma unroll
                        for (int bj = 0; bj < 2; ++bj) { u32x4 o; o.x = cvt_pk_bf16(v[bj][0], v[bj][1]); o.y = cvt_pk_bf16(v[bj][2], v[bj][3]); o.z = cvt_pk_bf16(v[bj][4], v[bj][5]); o.w = cvt_pk_bf16(v[bj][6], v[bj][7]);
                            *(u32x4*)(kd + 16 * bj + 8 * fq) = o; } }
                    continue;
                }
#pragma unroll
                for (int bj = 0; bj < 2; ++bj) { u32x4 o; o.x = cvt_pk_bf16(v[bj][0], v[bj][1]); o.y = cvt_pk_bf16(v[bj][2], v[bj][3]); o.z = cvt_pk_bf16(v[bj][4], v[bj][5]); o.w = cvt_pk_bf16(v[bj][6], v[bj][7]);
                    *(u32x4*)(dst + 32 * bj + 8 * fq) = o; }
            }
    }
};
struct P1Order {
    pg8::StaticOrder so; int nctx_tiles, G, c;
    __device__ bool next(int i, pg8::Unit& u) const {
        const int L = i * G + c;
        if (L < 1792) return so.next(i, u);
        const int Lc = L - 1792; if (Lc >= 32 * nctx_tiles) return false;
        u.pm = 256 + (Lc & 31); u.pn = Lc >> 5; return true;
    }
};
__device__ __forceinline__ void phase_p1(LAS unsigned char* lds, const WS& w, const Inputs& in, int l, int vb, int nvb) {
    EpiIn E{w, in.gqa_qn_g + l * 64, in.gqa_kn_g + l * 64, 0};
    P1Order po; po.so.init(NL, 1792, nvb, vb); po.nctx_tiles = (l == 0) ? 7 : 3; po.G = nvb; po.c = vb;
    pg8::gemm_phase(lds, pg8::Gemm{w.H, w.WinT + (size_t)l * 1792 * 1024, NR, 1792, 1024}, po, E);
}

extern __shared__ __attribute__((aligned(16))) unsigned char dyn_lds[];
__global__ void __launch_bounds__(512, 2) k_cvt(Inputs in, WS w) { phase_cvt((LAS unsigned char*)dyn_lds, in, w, blockIdx.x, gridDim.x); }
__global__ void __launch_bounds__(512, 2) k_p1(Inputs in, WS w, int l) { phase_p1((LAS unsigned char*)dyn_lds, w, in, l, blockIdx.x, gridDim.x); }

struct EpiUq {
    static constexpr bool PERM = true;
    WS w;
    __device__ __forceinline__ void operator()(const f32x4 (&acc)[2][2][4][2], const pg8::Unit& u, int wr, int wc, int fr, int fq) const {
        const int g = 4 * u.pn + wc; if (g >= 9) return;
        const int pm = u.pm; const bool isctx = pm >= 256; const int b = isctx ? pm - 256 : pm >> 3; const int t0 = isctx ? 0 : (pm & 7) * 256;
        const size_t rowbase = isctx ? (size_t)NL + (size_t)b * CTX : (size_t)b * S;
        const int head = g < 6 ? g : 2 * (g - 6) + (fq >> 1);
#pragma unroll
        for (int ai = 0; ai < 2; ++ai)
#pragma unroll
            for (int m = 0; m < 4; ++m) {
                const int t = t0 + 128 * ai + 64 * wr + 16 * m + fr; const size_t row = rowbase + t;
                const float4 s0 = *(const float4*)(w.SSQ + row * 8), s1 = *(const float4*)(w.SSQ + row * 8 + 4);
                const float rstd = rsqrtf((s0.x + s0.y + s0.z + s0.w + s1.x + s1.y) * (1.f / 384.f) + EPS);
                float v[2][8];
#pragma unroll
                for (int bj = 0; bj < 2; ++bj)
#pragma unroll
                    for (int n = 0; n < 2; ++n)
#pragma unroll
                        for (int i = 0; i < 4; ++i) v[bj][4 * n + i] = acc[ai][bj][m][n][i] * rstd;
                bf16_t* hd = isctx ? w.Qmc + (((size_t)b * 6 + head) * CTX + t) * 96 : w.Qm + (((size_t)b * 6 + head) * S + t) * 96;
                if (g >= 6 && !isctx) {
#pragma unroll
                    for (int q = 0; q < 8; ++q) { const float2 cs = w.ROPC[t * 16 + 8 * (fq & 1) + q]; const float x1 = v[0][q], x2 = v[1][q]; v[0][q] = x1 * cs.x - x2 * cs.y; v[1][q] = x1 * cs.y + x2 * cs.x; } }
#pragma unroll
                for (int bj = 0; bj < 2; ++bj) { u32x4 o; o.x = cvt_pk_bf16(v[bj][0], v[bj][1]); o.y = cvt_pk_bf16(v[bj][2], v[bj][3]); o.z = cvt_pk_bf16(v[bj][4], v[bj][5]); o.w = cvt_pk_bf16(v[bj][6], v[bj][7]);
                    bf16_t* d = g < 6 ? hd + 32 * bj + 8 * fq : hd + 64 + 16 * bj + 8 * (fq & 1);
                    *(u32x4*)d = o; }
            }
    }
};
struct EpiUkv {
    static constexpr bool PERM = true;
    WS w;
    __device__ __forceinline__ void operator()(const f32x4 (&acc)[2][2][4][2], const pg8::Unit& u, int wr, int wc, int fr, int fq) const {
        const int g = 4 * u.pn + wc;
        const int pm = u.pm; const bool isctx = pm >= 256; const int b = isctx ? pm - 256 : pm >> 3; const int t0 = isctx ? 0 : (pm & 7) * 256;
        const size_t rowbase = isctx ? (size_t)NL + (size_t)b * CTX : (size_t)b * S; const int keyoff = isctx ? 0 : CTX;
        bf16_t* base = ((g & 1) ? w.Vm : w.Kmn) + ((size_t)b * 6 + (g >> 1)) * KEYS * 64;
#pragma unroll
        for (int ai = 0; ai < 2; ++ai)
#pragma unroll
            for (int m = 0; m < 4; ++m) {
                const int t = t0 + 128 * ai + 64 * wr + 16 * m + fr; const size_t row = rowbase + t;
                const float4 s0 = *(const float4*)(w.SSKV + row * 4);
                const float rstd = rsqrtf((s0.x + s0.y + s0.z + s0.w) * (1.f / 256.f) + EPS);
                bf16_t* d = base + (size_t)(keyoff + t) * 64;
#pragma unroll
                for (int bj = 0; bj < 2; ++bj) { const f32x4 a0 = acc[ai][bj][m][0] * rstd, a1 = acc[ai][bj][m][1] * rstd;
                    u32x4 o; o.x = cvt_pk_bf16(a0[0], a0[1]); o.y = cvt_pk_bf16(a0[2], a0[3]); o.z = cvt_pk_bf16(a1[0], a1[1]); o.w = cvt_pk_bf16(a1[2], a1[3]);
                    *(u32x4*)(d + 32 * bj + 8 * fq) = o; }
            }
    }
};
__device__ __forceinline__ void phase_pool(LAS unsigned char* lds, const WS& w, bf16_t* __restrict__ MIX, const float* __restrict__ pool_w, const float* __restrict__ pool_scale, int nrows, int vb, int nvb) {
    const int tid = threadIdx.x, lane = tid & 63, wid = tid >> 6, g = lane >> 4;
    LAS float* pl = (LAS float*)lds + wid * 256;
    const int wdw = 2 << g;
    for (int row = vb * 8 + wid; row < nrows; row += nvb * 8) {
        const bool isctx = row >= NL; const int L = isctx ? CTX : S; const int t = isctx ? (row - NL) % CTX : row % S; const int base = row - t;
        int lo = t - wdw / 2, hi = t - wdw / 2 + wdw; lo = lo < 0 ? 0 : lo; hi = hi > L ? L : hi;
        float s0 = 0.f, s1 = 0.f, s2 = 0.f, s3 = 0.f;
        for (int uu = lo; uu < hi; ++uu) { const uint2 raw = *(const uint2*)(w.Bp + (size_t)(base + uu) * 256 + 4 * lane);
            s0 += __uint_as_float(raw.x << 16); s1 += __uint_as_float(raw.x & 0xffff0000u); s2 += __uint_as_float(raw.y << 16); s3 += __uint_as_float(raw.y & 0xffff0000u); }
        const uint2 self = *(const uint2*)(w.Bp + (size_t)row * 256 + 4 * lane); const float ic = 1.f / (float)(hi - lo);
        f32x4 pv; pv[0] = s0 * ic - __uint_as_float(self.x << 16); pv[1] = s1 * ic - __uint_as_float(self.x & 0xffff0000u); pv[2] = s2 * ic - __uint_as_float(self.y << 16); pv[3] = s3 * ic - __uint_as_float(self.y & 0xffff0000u);
        *(LAS f32x4*)(pl + 4 * lane) = pv;
        __syncthreads();
        const int d0 = (lane & 15) * 4; const float* wg = pool_w + (size_t)g * 4096 + d0;
        f32x4 a = (f32x4){0.f, 0.f, 0.f, 0.f};
#pragma unroll 8
        for (int cc = 0; cc < 64; ++cc) { const float p = pl[g * 64 + cc]; const f32x4 wv = *(const f32x4*)(wg + cc * 64); a += p * wv; }
        const f32x4 sc = *(const f32x4*)(pool_scale + g * 64 + d0);
        u32x2 o; o.x = cvt_pk_bf16(a[0] * sc[0], a[1] * sc[1]); o.y = cvt_pk_bf16(a[2] * sc[2], a[3] * sc[3]);
        *(u32x2*)(MIX + (size_t)row * 1024 + 384 + g * 64 + d0) = o;
        __syncthreads();
    }
}
__device__ __forceinline__ void phase_p2(LAS unsigned char* lds, const WS& w, const Inputs& in, int l, int vb, int nvb) {
    pg8::StaticOrder so;
    { EpiUq E{w}; const int M = l == 0 ? NR : NL; so.init(M, 768, nvb, vb); pg8::gemm_phase(lds, pg8::Gemm{w.CQ, w.WuqT + (size_t)l * 768 * 384, M, 768, 384}, so, E); }
    { EpiUkv E{w}; so.init(NR, 768, nvb, vb); pg8::gemm_phase(lds, pg8::Gemm{w.CKV, w.WukvT + (size_t)l * 768 * 256, NR, 768, 256}, so, E); }
    phase_pool(lds, w, w.H, in.pool_w + (size_t)l * 4 * 64 * 64, in.pool_scale + l * 256, l == 0 ? NR : NL, vb, nvb);
}

struct EpiOut {
    static constexpr bool PERM = false;
    const float* xin_l; const float* xin_c; float* xout_l; float* xout_c; const float* gate;
    __device__ __forceinline__ void operator()(const f32x4 (&acc)[2][2][4][2], const pg8::Unit& u, int wr, int wc, int fr, int fq) const {
        const int pm = u.pm; const bool isctx = pm >= 256; const int mr = isctx ? 32 : pm >> 3;
        const size_t r0 = (isctx ? (size_t)(pm - 256) * 256 : (size_t)pm * 256) + wr * 64 + fr;
        const float* xi = isctx ? xin_c : xin_l; float* xo = isctx ? xout_c : xout_l;
        const int col0 = u.pn * 256 + wc * 32 + 4 * fq;
        f32x4 gv[2][2];
#pragma unroll
        for (int bj = 0; bj < 2; ++bj)
#pragma unroll
            for (int n = 0; n < 2; ++n) gv[bj][n] = *(const f32x4*)(gate + (size_t)mr * 6144 + col0 + bj * 128 + n * 16);
#pragma unroll
        for (int ai = 0; ai < 2; ++ai)
#pragma unroll
            for (int m = 0; m < 4; ++m) { const size_t off = (r0 + ai * 128 + m * 16) * 1024 + col0;
#pragma unroll
                for (int bj = 0; bj < 2; ++bj)
#pragma unroll
                    for (int n = 0; n < 2; ++n) { const f32x4 xv = *(const f32x4*)(xi + off + bj * 128 + n * 16); *(f32x4*)(xo + off + bj * 128 + n * 16) = xv + gv[bj][n] * acc[ai][bj][m][n]; } }
    }
};
__device__ __forceinline__ void phase_p4(LAS unsigned char* lds, const WS& w, const Inputs& in, float* XL, int l, int vb, int nvb) {
    const float* MODl = w.MOD + (size_t)l * 33 * 6144;
    EpiOut E{l == 0 ? in.x : XL, l == 0 ? in.ctx : w.XC, XL, w.XC, MODl + 2 * 1024};
    const int M = l == 0 ? NR : NL;
    pg8::StaticOrder so; so.init(M, 1024, nvb, vb);
    pg8::gemm_phase(lds, pg8::Gemm{w.H, w.WoutT + (size_t)l * 1024 * 1024, M, 1024, 1024}, so, E);
}

__device__ __forceinline__ void phase_modulate(const float* __restrict__ XLp, const float* __restrict__ XCp, bf16_t* __restrict__ Hout, const float* __restrict__ g, const float* __restrict__ MODl, int si, int nrows, int vb, int nvb) {
    const int tid = threadIdx.x, lane = tid & 63, wid = tid >> 6;
    f32x4 gv[4];
#pragma unroll
    for (int i = 0; i < 4; ++i) gv[i] = *(const f32x4*)(g + 256 * i + 4 * lane);
    for (int row = vb * 8 + wid; row < nrows; row += nvb * 8) {
        const bool isctx = row >= NL; const float* xp = isctx ? XCp + (size_t)(row - NL) * 1024 : XLp + (size_t)row * 1024; const int mr = isctx ? 32 : row / S;
        f32x4 x[4]; float ss = 0.f;
#pragma unroll
        for (int i = 0; i < 4; ++i) { x[i] = *(const f32x4*)(xp + 256 * i + 4 * lane); ss += x[i][0] * x[i][0] + x[i][1] * x[i][1] + x[i][2] * x[i][2] + x[i][3] * x[i][3]; }
        ss = wave_sum(ss); const float rstd = rsqrtf(ss * (1.f / 1024.f) + EPS);
        const float* sh = MODl + (size_t)mr * 6144 + si * 1024;
#pragma unroll
        for (int i = 0; i < 4; ++i) { const f32x4 shv = *(const f32x4*)(sh + 256 * i + 4 * lane), scv = *(const f32x4*)(sh + 1024 + 256 * i + 4 * lane);
            const f32x4 y = x[i] * rstd * gv[i] * (scv + 1.f) + shv;
            u32x2 o; o.x = cvt_pk_bf16(y[0], y[1]); o.y = cvt_pk_bf16(y[2], y[3]);
            *(u32x2*)(Hout + (size_t)row * 1024 + 256 * i + 4 * lane) = o; }
    }
}

struct EpiPQ {
    static constexpr bool PERM = true;
    bf16_t* PQ;
    __device__ __forceinline__ void operator()(const f32x4 (&acc)[2][2][4][2], const pg8::Unit& u, int wr, int wc, int fr, int fq) const {
        const size_t r0 = (size_t)u.pm * 256 + wr * 64 + fr; const int col0 = u.pn * 256 + wc * 32 + 8 * fq;
#pragma unroll
        for (int ai = 0; ai < 2; ++ai)
#pragma unroll
            for (int m = 0; m < 4; ++m) { bf16_t* d = PQ + (r0 + ai * 128 + m * 16) * 2048 + col0;
#pragma unroll
                for (int bj = 0; bj < 2; ++bj) { const f32x4 a0 = acc[ai][bj][m][0], a1 = acc[ai][bj][m][1];
                    u32x4 o; o.x = cvt_pk_bf16(a0[0], a0[1]); o.y = cvt_pk_bf16(a0[2], a0[3]); o.z = cvt_pk_bf16(a1[0], a1[1]); o.w = cvt_pk_bf16(a1[2], a1[3]);
                    *(u32x4*)(d + bj * 128) = o; } }
    }
};
__device__ __forceinline__ void phase_p6a(LAS unsigned char* lds, const WS& w, int l, int vb, int nvb) {
    EpiPQ E{w.PQ}; const int M = l == 0 ? NR : NL;
    pg8::StaticOrder so; so.init(M, 2048, nvb, vb);
    pg8::gemm_phase(lds, pg8::Gemm{w.H, w.WqT + (size_t)l * 2048 * 1024, M, 2048, 1024}, so, E);
}

__global__ void __launch_bounds__(512, 2) k_p2(Inputs in, WS w, int l) { phase_p2((LAS unsigned char*)dyn_lds, w, in, l, blockIdx.x, gridDim.x); }
__global__ void __launch_bounds__(512, 2) k_p4(Inputs in, WS w, float* XL, int l) { phase_p4((LAS unsigned char*)dyn_lds, w, in, XL, l, blockIdx.x, gridDim.x); }
__global__ void __launch_bounds__(512, 2) k_p5(WS w, const float* XL, const float* g, const float* MODl, int si, int nrows) { phase_modulate(XL, w.XC, w.H, g, MODl, si, nrows, blockIdx.x, gridDim.x); }
__global__ void __launch_bounds__(512, 2) k_p6a(WS w, int l) { phase_p6a((LAS unsigned char*)dyn_lds, w, l, blockIdx.x, gridDim.x); }

using bf16x2_t = __attribute__((ext_vector_type(2))) __bf16;
__device__ __forceinline__ float dot2bf(unsigned a, unsigned b, float acc) { return __builtin_amdgcn_fdot2_f32_bf16(__builtin_bit_cast(bf16x2_t, a), __builtin_bit_cast(bf16x2_t, b), acc, false); }
__device__ __forceinline__ float gelu_fast(float x) {
    const float u2 = 1.5957691216057308f * (x + 0.044715f * x * x * x);
    return x * __builtin_amdgcn_rcpf(1.f + __builtin_amdgcn_exp2f(-1.4426950408889634f * u2));
}
__device__ __forceinline__ float row16_allsum(float v) {
    v += __builtin_bit_cast(float, __builtin_amdgcn_update_dpp(0, __builtin_bit_cast(int, v), 0x128, 0xf, 0xf, true));
    v += __builtin_bit_cast(float, __builtin_amdgcn_update_dpp(0, __builtin_bit_cast(int, v), 0x124, 0xf, 0xf, true));
    v += __builtin_bit_cast(float, __builtin_amdgcn_update_dpp(0, __builtin_bit_cast(int, v), 0x122, 0xf, 0xf, true));
    v += __builtin_bit_cast(float, __builtin_amdgcn_update_dpp(0, __builtin_bit_cast(int, v), 0x121, 0xf, 0xf, true));
    return v;
}
__device__ __forceinline__ float reduce4(float p0, float p1, float p2, float p3) {
    auto s01 = __builtin_amdgcn_permlane32_swap(__float_as_uint(p0), __float_as_uint(p1), false, false);
    auto s23 = __builtin_amdgcn_permlane32_swap(__float_as_uint(p2), __float_as_uint(p3), false, false);
    const float q0 = __uint_as_float(s01[0]) + __uint_as_float(s01[1]);
    const float q1 = __uint_as_float(s23[0]) + __uint_as_float(s23[1]);
    auto s = __builtin_amdgcn_permlane16_swap(__float_as_uint(q0), __float_as_uint(q1), false, false);
    const float r = __uint_as_float(s[0]) + __uint_as_float(s[1]);
    return row16_allsum(r);
}
struct P7Args {
    const bf16_t* H2; const unsigned* EG; const bf16_t* U; const bf16_t* V;
    float* XL; float* XC; const float* gate2;
    int nrows;
    int mode;
    bf16_t* Hnext; const float* gnext; const float* MODnext;
    const float* final_g;
};
#define P7_LOADS(BUF, e0, e1, e2, e3) do { \
    const bf16_t* u0_ = a.U + (size_t)(e0) * 1024 + 8 * lane; const bf16_t* u1_ = a.U + (size_t)(e1) * 1024 + 8 * lane; const bf16_t* u2_ = a.U + (size_t)(e2) * 1024 + 8 * lane; const bf16_t* u3_ = a.U + (size_t)(e3) * 1024 + 8 * lane; \
    const bf16_t* v0_ = a.V + (size_t)(e0) * 1024 + 8 * lane; const bf16_t* v1_ = a.V + (size_t)(e1) * 1024 + 8 * lane; const bf16_t* v2_ = a.V + (size_t)(e2) * 1024 + 8 * lane; const bf16_t* v3_ = a.V + (size_t)(e3) * 1024 + 8 * lane; \
    BUF##u[0] = *(const u32x4*)u0_; BUF##u[1] = *(const u32x4*)(u0_ + 512); BUF##u[2] = *(const u32x4*)u1_; BUF##u[3] = *(const u32x4*)(u1_ + 512); \
    BUF##u[4] = *(const u32x4*)u2_; BUF##u[5] = *(const u32x4*)(u2_ + 512); BUF##u[6] = *(const u32x4*)u3_; BUF##u[7] = *(const u32x4*)(u3_ + 512); \
    BUF##v[0] = *(const u32x4*)v0_; BUF##v[1] = *(const u32x4*)(v0_ + 512); BUF##v[2] = *(const u32x4*)v1_; BUF##v[3] = *(const u32x4*)(v1_ + 512); \
    BUF##v[4] = *(const u32x4*)v2_; BUF##v[5] = *(const u32x4*)(v2_ + 512); BUF##v[6] = *(const u32x4*)v3_; BUF##v[7] = *(const u32x4*)(v3_ + 512); } while (0)
#define P7_DOT(BUF, j) (dot2bf(BUF##u[2*(j)][0], hq[0][0], dot2bf(BUF##u[2*(j)][1], hq[0][1], dot2bf(BUF##u[2*(j)][2], hq[0][2], dot2bf(BUF##u[2*(j)][3], hq[0][3], \
                        dot2bf(BUF##u[2*(j)+1][0], hq[1][0], dot2bf(BUF##u[2*(j)+1][1], hq[1][1], dot2bf(BUF##u[2*(j)+1][2], hq[1][2], dot2bf(BUF##u[2*(j)+1][3], hq[1][3], 0.f)))))))))
#define P7_AXPY(BUF, j, wj) do { _Pragma("unroll") for (int hh = 0; hh < 2; ++hh) _Pragma("unroll") for (int r = 0; r < 4; ++r) { const unsigned pk = BUF##v[2*(j)+hh][r]; \
        out[hh][2*r] = __builtin_fmaf(wj, __uint_as_float(pk << 16), out[hh][2*r]); out[hh][2*r+1] = __builtin_fmaf(wj, __uint_as_float(pk & 0xffff0000u), out[hh][2*r+1]); } } while (0)
#define P7_EID(c, j) ((int)(__builtin_amdgcn_readlane((int)((c) < 16 ? eg : eg2), (4 * (c) + (j)) & 63) >> 16) & 0xffff)
#define P7_COMPUTE(BUF, c) do { \
    const float r_ = reduce4(P7_DOT(BUF, 0), P7_DOT(BUF, 1), P7_DOT(BUF, 2), P7_DOT(BUF, 3)); \
      \
    const int mye_ = 4 * (c) + (((lane >> 4) & 1) * 2 + (lane >> 5)); \
    const unsigned ege_ = (unsigned)__shfl((int)((c) < 16 ? eg : eg2), mye_ & 63); \
    const float w_ = __uint_as_float(ege_ << 16) * gelu_fast(r_); \
    const int wi_ = __builtin_bit_cast(int, w_); const float w0_ = __builtin_bit_cast(float, __builtin_amdgcn_readlane(wi_, 0)), w1_ = __builtin_bit_cast(float, __builtin_amdgcn_readlane(wi_, 32)), w2_ = __builtin_bit_cast(float, __builtin_amdgcn_readlane(wi_, 16)), w3_ = __builtin_bit_cast(float, __builtin_amdgcn_readlane(wi_, 48)); \
    P7_AXPY(BUF, 0, w0_); P7_AXPY(BUF, 1, w1_); P7_AXPY(BUF, 2, w2_); P7_AXPY(BUF, 3, w3_); } while (0)

__device__ __forceinline__ void phase_p7(const P7Args& a, int vb, int nvb) {
    int tid_ = threadIdx.x; asm volatile("" : "+v"(tid_));
    const int lane = tid_ & 63, wid = __builtin_amdgcn_readfirstlane(tid_ >> 6);
    for (int row = vb * 8 + wid; row < a.nrows; row += nvb * 8) {
        const bool isctx = row >= NL; float* xp = isctx ? a.XC + (size_t)(row - NL) * 1024 : a.XL + (size_t)row * 1024; const int mr = isctx ? 32 : row / S;
        u32x4 hq[2]; hq[0] = *(const u32x4*)(a.H2 + (size_t)row * 1024 + 8 * lane); hq[1] = *(const u32x4*)(a.H2 + (size_t)row * 1024 + 512 + 8 * lane);
        const unsigned eg = a.EG[(size_t)row * 128 + lane], eg2 = a.EG[(size_t)row * 128 + 64 + lane];
        float out[2][8];
#pragma unroll
        for (int hh = 0; hh < 2; ++hh)
#pragma unroll
            for (int r = 0; r < 8; ++r) out[hh][r] = 0.f;
        u32x4 Au[8], Av[8], Bu[8], Bv[8];
        P7_LOADS(A, P7_EID(0, 0), P7_EID(0, 1), P7_EID(0, 2), P7_EID(0, 3));
#pragma unroll 1
        for (int c = 0; c < 32; c += 2) {
            P7_LOADS(B, P7_EID(c + 1, 0), P7_EID(c + 1, 1), P7_EID(c + 1, 2), P7_EID(c + 1, 3));
            P7_COMPUTE(A, c);
            if (c + 2 < 32) P7_LOADS(A, P7_EID(c + 2, 0), P7_EID(c + 2, 1), P7_EID(c + 2, 2), P7_EID(c + 2, 3));
            P7_COMPUTE(B, c + 1);
        }
        const float* gp = a.gate2 + (size_t)mr * 6144;
        f32x4 xv[2][2]; float ss = 0.f;
#pragma unroll
        for (int hh = 0; hh < 2; ++hh)
#pragma unroll
            for (int k = 0; k < 2; ++k) { const int col = 512 * hh + 8 * lane + 4 * k; const f32x4 x0 = *(const f32x4*)(xp + col), g0 = *(const f32x4*)(gp + col);
                f32x4 o; o[0] = out[hh][4 * k]; o[1] = out[hh][4 * k + 1]; o[2] = out[hh][4 * k + 2]; o[3] = out[hh][4 * k + 3];
                xv[hh][k] = x0 + g0 * o; ss += xv[hh][k][0] * xv[hh][k][0] + xv[hh][k][1] * xv[hh][k][1] + xv[hh][k][2] * xv[hh][k][2] + xv[hh][k][3] * xv[hh][k][3]; }
        if (a.mode != 2) {
#pragma unroll
            for (int hh = 0; hh < 2; ++hh)
#pragma unroll
                for (int k = 0; k < 2; ++k) *(f32x4*)(xp + 512 * hh + 8 * lane + 4 * k) = xv[hh][k];
        }
        if (a.mode != 0) {
            ss = wave_sum(ss); const float rstd = rsqrtf(ss * (1.f / 1024.f) + EPS);
            if (a.mode == 2) {
#pragma unroll
                for (int hh = 0; hh < 2; ++hh)
#pragma unroll
                    for (int k = 0; k < 2; ++k) { const int col = 512 * hh + 8 * lane + 4 * k; *(f32x4*)(xp + col) = xv[hh][k] * rstd * *(const f32x4*)(a.final_g + col); }
            } else {
                const float* sh = a.MODnext + (size_t)mr * 6144;
#pragma unroll
                for (int hh = 0; hh < 2; ++hh) { f32x4 y[2];
#pragma unroll
                    for (int k = 0; k < 2; ++k) { const int col = 512 * hh + 8 * lane + 4 * k; y[k] = xv[hh][k] * rstd * *(const f32x4*)(a.gnext + col) * (*(const f32x4*)(sh + 1024 + col) + 1.f) + *(const f32x4*)(sh + col); }
                    u32x4 o; o.x = cvt_pk_bf16(y[0][0], y[0][1]); o.y = cvt_pk_bf16(y[0][2], y[0][3]); o.z = cvt_pk_bf16(y[1][0], y[1][1]); o.w = cvt_pk_bf16(y[1][2], y[1][3]);
                    *(u32x4*)(a.Hnext + (size_t)row * 1024 + 512 * hh + 8 * lane) = o; }
            }
        }
    }
}
__global__ void __launch_bounds__(512, 2) k_p7(P7Args a) { phase_p7(a, blockIdx.x, gridDim.x); }

typedef short s16x4 __attribute__((ext_vector_type(4)));
__device__ __forceinline__ s16x4 lds_tr16(const LAS unsigned char* p) { return __builtin_bit_cast(s16x4, __builtin_amdgcn_ds_read_tr16_b64_v4i16((LAS s16x4*)p)); }
__device__ __forceinline__ f32x16 mfma32(bf16x8 a, bf16x8 b, f32x16 c) { return __builtin_amdgcn_mfma_f32_32x32x16_bf16(a, b, c, 0, 0, 0); }
constexpr int ATT_BUF = 20480;
template <int DK>
__device__ __forceinline__ void attn_unit(LAS unsigned char* lds, const bf16_t* __restrict__ Q, const bf16_t* __restrict__ K1, const bf16_t* __restrict__ K2, const bf16_t* __restrict__ V,
                                          int nkeys, float c2, bf16_t* __restrict__ out) {
    int tid_ = threadIdx.x; asm volatile("" : "+v"(tid_));
    const int tid = tid_, lane = tid & 63, wid = __builtin_amdgcn_readfirstlane(tid >> 6), r32 = lane & 31, hi = lane >> 5;
    constexpr int NS = DK / 16;
    bf16x8 qf[NS];
    { const bf16_t* qp = Q + (size_t)(wid * 32 + r32) * DK + 8 * hi;
#pragma unroll
      for (int s = 0; s < NS; ++s) qf[s] = *(const bf16x8*)(qp + 16 * s); }
    const int skey = tid >> 3, sch = tid & 7;
    const unsigned st_k1 = skey * 128 + ((sch ^ ((skey >> 1) & 7)) << 4);
    const unsigned st_v = 8192 + skey * 128 + (((sch << 4)) ^ (((skey >> 1) & 1) << 6));
    const int skey2 = (tid & 255) >> 2, sch2 = tid & 3;
    const unsigned st_k2 = 16384 + skey2 * 64 + ((sch2 ^ ((skey2 >> 2) & 3)) << 4);
    const bf16_t* gk1 = K1 + (size_t)skey * 64 + sch * 8; const bf16_t* gv = V + (size_t)skey * 64 + sch * 8;
    const bf16_t* gk2 = (DK == 96) ? K2 + (size_t)skey2 * 32 + sch2 * 8 : nullptr;
    unsigned ka[2][4];
#pragma unroll
    for (int kt = 0; kt < 2; ++kt)
#pragma unroll
        for (int s = 0; s < 4; ++s) { const int key = 32 * kt + r32; ka[kt][s] = key * 128 + (((2 * s + hi) ^ ((key >> 1) & 7)) << 4); }
    unsigned kb[2][2];
#pragma unroll
    for (int kt = 0; kt < 2; ++kt)
#pragma unroll
        for (int s = 0; s < 2; ++s) { const int key = 32 * kt + r32; kb[kt][s] = 16384 + key * 64 + (((2 * s + hi) ^ ((key >> 2) & 3)) << 4); }
    const int vq = (lane & 15) >> 2, vp = lane & 3, vg = (lane >> 4) & 1;
    unsigned va[2];
#pragma unroll
    for (int dvb = 0; dvb < 2; ++dvb) { const int key = 4 * hi + vq; va[dvb] = 8192 + key * 128 + ((((32 * dvb + 16 * vg + 4 * vp) * 2)) ^ (((key >> 1) & 1) << 6)); }
    float m = -1e30f, l = 0.f;
    f32x16 o0 = {}, o1 = {};
    const int NT = nkeys >> 6;
    u32x4 sk1, sv, sk2;
    sk1 = *(const u32x4*)gk1; sv = *(const u32x4*)gv; if (DK == 96) { if (tid < 256) sk2 = *(const u32x4*)gk2; }
    *(LAS u32x4*)(lds + st_k1) = sk1; *(LAS u32x4*)(lds + st_v) = sv; if (DK == 96) { if (tid < 256) *(LAS u32x4*)(lds + st_k2) = sk2; }
    __syncthreads();
    for (int t = 0; t < NT; ++t) {
        LAS unsigned char* buf = lds + (t & 1) * ATT_BUF;
        if (t + 1 < NT) { sk1 = *(const u32x4*)(gk1 + (size_t)(t + 1) * 64 * 64); sv = *(const u32x4*)(gv + (size_t)(t + 1) * 64 * 64); if (DK == 96) { if (tid < 256) sk2 = *(const u32x4*)(gk2 + (size_t)(t + 1) * 64 * 32); } }
        f32x16 p0 = {}, p1 = {};
#pragma unroll
        for (int s = 0; s < 4; ++s) { p0 = mfma32(*(const LAS bf16x8*)(buf + ka[0][s]), qf[s], p0); p1 = mfma32(*(const LAS bf16x8*)(buf + ka[1][s]), qf[s], p1); }
        if (DK == 96) {
#pragma unroll
            for (int s = 0; s < 2; ++s) { p0 = mfma32(*(const LAS bf16x8*)(buf + kb[0][s]), qf[4 + s], p0); p1 = mfma32(*(const LAS bf16x8*)(buf + kb[1][s]), qf[4 + s], p1); }
        }
        float mx = p0[0];
#pragma unroll
        for (int r = 1; r < 16; ++r) mx = fmaxf(mx, p0[r]);
#pragma unroll
        for (int r = 0; r < 16; ++r) mx = fmaxf(mx, p1[r]);
        { auto rr = __builtin_amdgcn_permlane32_swap(__float_as_uint(mx), __float_as_uint(mx), false, false); mx = fmaxf(__uint_as_float(rr[0]), __uint_as_float(rr[1])); }
        const float tm = mx * c2;
        if (__any(tm > m + 8.f)) {
            const float mn = fmaxf(m, tm), al = __builtin_amdgcn_exp2f(m - mn); m = mn; l *= al;
#pragma unroll
            for (int r = 0; r < 16; ++r) { o0[r] *= al; o1[r] *= al; }
        }
        const float nm = -m; float ls = 0.f;
#pragma unroll
        for (int r = 0; r < 16; ++r) { p0[r] = __builtin_amdgcn_exp2f(__builtin_fmaf(p0[r], c2, nm)); p1[r] = __builtin_amdgcn_exp2f(__builtin_fmaf(p1[r], c2, nm)); ls += p0[r] + p1[r]; }
        l += ls;
        bf16x8 pf[2][2];
#pragma unroll
        for (int sp = 0; sp < 2; ++sp) { u32x4 a, b;
            a.x = cvt_pk_bf16(p0[8 * sp], p0[8 * sp + 1]); a.y = cvt_pk_bf16(p0[8 * sp + 2], p0[8 * sp + 3]); a.z = cvt_pk_bf16(p0[8 * sp + 4], p0[8 * sp + 5]); a.w = cvt_pk_bf16(p0[8 * sp + 6], p0[8 * sp + 7]);
            b.x = cvt_pk_bf16(p1[8 * sp], p1[8 * sp + 1]); b.y = cvt_pk_bf16(p1[8 * sp + 2], p1[8 * sp + 3]); b.z = cvt_pk_bf16(p1[8 * sp + 4], p1[8 * sp + 5]); b.w = cvt_pk_bf16(p1[8 * sp + 6], p1[8 * sp + 7]);
            pf[0][sp] = __builtin_bit_cast(bf16x8, a); pf[1][sp] = __builtin_bit_cast(bf16x8, b); }
#pragma unroll
        for (int kt = 0; kt < 2; ++kt)
#pragma unroll
            for (int sp = 0; sp < 2; ++sp) { const int kofs = (32 * kt + 16 * sp) * 128;
                { const s16x4 lo = lds_tr16(buf + va[0] + kofs), hi4 = lds_tr16(buf + va[0] + kofs + 8 * 128);
                  const bf16x8 vf = (bf16x8){lo[0], lo[1], lo[2], lo[3], hi4[0], hi4[1], hi4[2], hi4[3]}; o0 = mfma32(vf, pf[kt][sp], o0); }
                { const s16x4 lo = lds_tr16(buf + va[1] + kofs), hi4 = lds_tr16(buf + va[1] + kofs + 8 * 128);
                  const bf16x8 vf = (bf16x8){lo[0], lo[1], lo[2], lo[3], hi4[0], hi4[1], hi4[2], hi4[3]}; o1 = mfma32(vf, pf[kt][sp], o1); } }
        if (t + 1 < NT) { LAS unsigned char* nb = lds + ((t + 1) & 1) * ATT_BUF; *(LAS u32x4*)(nb + st_k1) = sk1; *(LAS u32x4*)(nb + st_v) = sv; if (DK == 96) { if (tid < 256) *(LAS u32x4*)(nb + st_k2) = sk2; } }
        __syncthreads();
    }
    { auto rr = __builtin_amdgcn_permlane32_swap(__float_as_uint(l), __float_as_uint(l), false, false); l = __uint_as_float(rr[0]) + __uint_as_float(rr[1]); }
    const float il = 1.f / l;
    bf16_t* op = out + (size_t)(wid * 32 + r32) * 1024 + 4 * hi;
#pragma unroll
    for (int g = 0; g < 4; ++g) { u32x2 a, b;
        a.x = cvt_pk_bf16(o0[4 * g] * il, o0[4 * g + 1] * il); a.y = cvt_pk_bf16(o0[4 * g + 2] * il, o0[4 * g + 3] * il);
        b.x = cvt_pk_bf16(o1[4 * g] * il, o1[4 * g + 1] * il); b.y = cvt_pk_bf16(o1[4 * g + 2] * il, o1[4 * g + 3] * il);
        *(u32x2*)(op + 8 * g) = a; *(u32x2*)(op + 32 + 8 * g) = b; }
}
__device__ __forceinline__ void phase_p3(LAS unsigned char* lds, const WS& w, int l, int vb, int nvb) {
    const float c2g = 0.125f * 1.4426950408889634f, c2m = 0.10206207261596577f * 1.4426950408889634f;
    bf16_t* MIX = w.H;
    const int nlat = NB * 12 * 8, nctx = (l == 0) ? NB * 12 : 0;
    for (int u = vb; u < nlat + nctx; u += nvb) {
        if (u < nlat) {
            const int qb = u & 7, slot = (u >> 3) % 12, b = u / 96;
            bf16_t* out = MIX + ((size_t)b * S + qb * 256) * 1024;
            if (slot < 6) attn_unit<64>(lds, w.Qg + (((size_t)b * 6 + slot) * S + qb * 256) * 64, w.Kg + ((size_t)b * 2 + slot / 3) * KEYS * 64, nullptr, w.Vg + ((size_t)b * 2 + slot / 3) * KEYS * 64, KEYS, c2g, out + slot * 64);
            else { const int h = slot - 6; attn_unit<96>(lds, w.Qm + (((size_t)b * 6 + h) * S + qb * 256) * 96, w.Kmn + ((size_t)b * 6 + h) * KEYS * 64, w.KR + (size_t)b * KEYS * 32, w.Vm + ((size_t)b * 6 + h) * KEYS * 64, KEYS, c2m, out + 640 + h * 64); }
        } else {
            const int v = u - nlat, slot = v % 12, b = v / 12;
            bf16_t* out = MIX + ((size_t)NL + (size_t)b * CTX) * 1024;
            if (slot < 6) attn_unit<64>(lds, w.Qgc + ((size_t)b * 6 + slot) * CTX * 64, w.Kg + ((size_t)b * 2 + slot / 3) * KEYS * 64, nullptr, w.Vg + ((size_t)b * 2 + slot / 3) * KEYS * 64, CTX, c2g, out + slot * 64);
            else { const int h = slot - 6; attn_unit<96>(lds, w.Qmc + ((size_t)b * 6 + h) * CTX * 96, w.Kmn + ((size_t)b * 6 + h) * KEYS * 64, w.KR + (size_t)b * KEYS * 32, w.Vm + ((size_t)b * 6 + h) * KEYS * 64, CTX, c2m, out + 640 + h * 64); }
        }
    }
}
__global__ void __launch_bounds__(512, 2) k_p3(WS w, int l) { phase_p3((LAS unsigned char*)dyn_lds, w, l, blockIdx.x, gridDim.x); }

__device__ __forceinline__ unsigned fkey(float f, unsigned tag, unsigned mask) { unsigned u = __float_as_uint(f); u = (u & 0x80000000u) ? ~u : (u | 0x80000000u); return (u & ~mask) | tag; }
__device__ __forceinline__ float keyf(unsigned k, unsigned mask) { k &= ~mask; const unsigned u = (k & 0x80000000u) ? (k & 0x7fffffffu) : ~k; return __uint_as_float(u); }
__device__ __forceinline__ void ce_desc(unsigned& a, unsigned& b) { const unsigned hi_ = a > b ? a : b, lo_ = a > b ? b : a; a = hi_; b = lo_; }
template <int J, int K> __device__ __forceinline__ void bstage16(unsigned* a) {
#pragma unroll
    for (int i = 0; i < 16; ++i) { const int l = i ^ J; if (l > i) { const unsigned x = a[i], y = a[l]; const unsigned mx = x > y ? x : y, mn = x > y ? y : x; const bool desc = ((i & K) == 0); a[i] = desc ? mx : mn; a[l] = desc ? mn : mx; } }
}
__device__ __forceinline__ void sort16_desc(unsigned* a) {
    bstage16<1, 2>(a); bstage16<2, 4>(a); bstage16<1, 4>(a); bstage16<4, 8>(a); bstage16<2, 8>(a); bstage16<1, 8>(a); bstage16<8, 16>(a); bstage16<4, 16>(a); bstage16<2, 16>(a); bstage16<1, 16>(a);
}
__device__ __forceinline__ void bmerge16_desc(unsigned* c) { bstage16<8, 16>(c); bstage16<4, 16>(c); bstage16<2, 16>(c); bstage16<1, 16>(c); }
__device__ __forceinline__ void merge_top16(unsigned* a, const unsigned* b) {
#pragma unroll
    for (int i = 0; i < 16; ++i) a[i] = a[i] > b[15 - i] ? a[i] : b[15 - i];
    bmerge16_desc(a);
}
__device__ __forceinline__ void xlane_top16(unsigned* t, int hi) {
    unsigned r[16]; const unsigned msk = 0u - (unsigned)hi;
#pragma unroll
    for (int i = 0; i < 16; ++i) r[i] = t[i] ^ ((t[i] ^ t[15 - i]) & msk);
#pragma unroll
    for (int i = 0; i < 16; ++i) { auto s = __builtin_amdgcn_permlane32_swap(r[i], r[i], false, false); t[i] = s[0] > s[1] ? s[0] : s[1]; }
    bmerge16_desc(t);
}
__device__ __forceinline__ constexpr int cand_a(int c) { return c < 16 ? 0 : c < 24 ? 1 : c < 29 ? 2 : c < 33 ? 3 : c < 36 ? 4 : c < 38 ? 5 : c < 40 ? 6 : c < 42 ? 7 : c < 50 ? c - 34 : 0; }
__device__ __forceinline__ constexpr int cand_b(int c) { return c < 16 ? c : c < 24 ? c - 16 : c < 29 ? c - 24 : c < 33 ? c - 29 : c < 36 ? c - 33 : c < 38 ? c - 36 : c < 40 ? c - 38 : c < 42 ? c - 40 : 0; }

__device__ __forceinline__ void phase_p6b(LAS unsigned char* lds, const bf16_t* __restrict__ PQ, const bf16_t* __restrict__ SubKl, unsigned* __restrict__ EG, int nrows, int vb, int nvb) {
    int tid_ = threadIdx.x; asm volatile("" : "+v"(tid_));
    const int lane = tid_ & 63, wid = __builtin_amdgcn_readfirstlane(tid_ >> 6), r32 = lane & 31, hi = lane >> 5;
    LAS unsigned short* tab = (LAS unsigned short*)(lds + wid * 4096) + r32 * 64;
    const int nitems = (nrows >> 5) * 8;
    for (int it = vb * 8 + wid; it < nitems; it += nvb * 8) {
        const int h = it & 7, row0 = (it >> 3) << 5;
        unsigned top[2][16];
#pragma unroll
        for (int p = 0; p < 2; ++p) {
            bf16x8 qf[8];
            { const bf16_t* qp = PQ + (size_t)(row0 + r32) * 2048 + h * 256 + p * 128 + 8 * hi; asm volatile("" : "+v"(qp));
#pragma unroll
              for (int s = 0; s < 8; ++s) qf[s] = *(const bf16x8*)(qp + 16 * s); }
            const bf16_t* kp = SubKl + ((size_t)(h * 2 + p) * 128 + r32) * 128 + 8 * hi; asm volatile("" : "+v"(kp));
            f32x16 acc[4];
#pragma unroll
            for (int kt = 0; kt < 4; ++kt) { acc[kt] = f32x16{};
                bf16x8 kf[8];
#pragma unroll
                for (int s = 0; s < 8; ++s) kf[s] = *(const bf16x8*)(kp + (size_t)kt * 32 * 128 + 16 * s);
#pragma unroll
                for (int s = 0; s < 8; ++s) acc[kt] = mfma32(kf[s], qf[s], acc[kt]);
                asm volatile("" ::: "memory"); }
            unsigned key[64];
#pragma unroll
            for (int kt = 0; kt < 4; ++kt)
#pragma unroll
                for (int r = 0; r < 16; ++r) { const int n = 32 * kt + (r & 3) + 8 * (r >> 2) + 4 * hi; key[16 * kt + r] = fkey(acc[kt][r], 127u - (unsigned)n, 127u); }
            sort16_desc(key); sort16_desc(key + 16); sort16_desc(key + 32); sort16_desc(key + 48);
            merge_top16(key, key + 16); merge_top16(key + 32, key + 48); merge_top16(key, key + 32);
            xlane_top16(key, hi);
#pragma unroll
            for (int i = 0; i < 16; ++i) top[p][i] = key[i];
            asm volatile("" ::: "memory");
        }
        unsigned ck[64];
#pragma unroll
        for (int c = 0; c < 64; ++c) {
            if (c < 50) { const float sm = keyf(top[0][cand_a(c)], 127u) + keyf(top[1][cand_b(c)], 127u); ck[c] = fkey(sm, (unsigned)c, 63u); } else ck[c] = 0u;
        }
        if (hi == 0) {
#pragma unroll
            for (int c = 0; c < 50; c += 2) {
                const unsigned ea = (127u - (top[0][cand_a(c)] & 127u)) * 128u + (127u - (top[1][cand_b(c)] & 127u));
                const unsigned eb = (127u - (top[0][cand_a(c + 1)] & 127u)) * 128u + (127u - (top[1][cand_b(c + 1)] & 127u));
                *(LAS unsigned*)(tab + c) = ea | (eb << 16);
            }
        }
        sort16_desc(ck); sort16_desc(ck + 16); sort16_desc(ck + 32); sort16_desc(ck + 48);
        merge_top16(ck, ck + 16); merge_top16(ck + 32, ck + 48); merge_top16(ck, ck + 32);
        asm volatile("s_waitcnt lgkmcnt(0)" ::: "memory");
        const float mx = keyf(ck[0], 63u); float e[16], den = 0.f;
#pragma unroll
        for (int j = 0; j < 16; ++j) { e[j] = __builtin_amdgcn_exp2f((keyf(ck[j], 63u) - mx) * 1.4426950408889634f); den += e[j]; }
        const float iden = 1.f / den;
        if (hi == 0) {
            unsigned o[16];
#pragma unroll
            for (int j = 0; j < 16; ++j) { const unsigned eid = tab[ck[j] & 63u]; o[j] = (eid << 16) | (cvt_pk_bf16(e[j] * iden, 0.f) & 0xffffu); }
            unsigned* dst = EG + (size_t)(row0 + r32) * 128 + h * 16;
#pragma unroll
            for (int j = 0; j < 16; j += 4) *(u32x4*)(dst + j) = (u32x4){o[j], o[j + 1], o[j + 2], o[j + 3]};
        }
        asm volatile("s_waitcnt lgkmcnt(0)" ::: "memory");
    }
}
__global__ void __launch_bounds__(512, 2) k_p6b(WS w, int l, int nrows) { phase_p6b((LAS unsigned char*)dyn_lds, w.PQ, w.SubK + (size_t)l * 16 * 128 * 128, w.EG, nrows, blockIdx.x, gridDim.x); }

__global__ void k_rs_from_ss(WS w) {
    const int row = blockIdx.x * 256 + threadIdx.x; if (row >= NR) return;
    float a = 0.f; for (int i = 0; i < 6; ++i) a += w.SSQ[(size_t)row * 8 + i];
    float b = 0.f; for (int i = 0; i < 4; ++i) b += w.SSKV[(size_t)row * 4 + i];
    w.RSQ[row] = rsqrtf(a * (1.f / 384.f) + EPS); w.RSKV[row] = rsqrtf(b * (1.f / 256.f) + EPS);
}


#define XB_TMO      128
#define XB_XCNT(j)  (256  + 64 * (j))
#define XB_XSUB(j)  (1280 + 64 * (j))
#define XB_XGEN(j)  (2304 + 64 * (j))
#define XB_TOP      3328
#define XB_TOPGEN   3392
#define XCD_BAR_WORDS 3456
#define XB_SPIN_CAP (1u << 18)

__device__ __forceinline__ unsigned xb_ld(unsigned* p)              { return __hip_atomic_load(p, __ATOMIC_RELAXED, __HIP_MEMORY_SCOPE_AGENT); }
__device__ __forceinline__ unsigned xb_add(unsigned* p, unsigned v) { return __hip_atomic_fetch_add(p, v, __ATOMIC_RELAXED, __HIP_MEMORY_SCOPE_AGENT); }
__device__ __forceinline__ unsigned xb_xcc_id() { return (unsigned)__builtin_amdgcn_s_getreg((3 << 11) | 20) & 0xFu; }
#define XB_SPIN(cond, bar) do { unsigned _sp = 0; while (cond) { __builtin_amdgcn_s_sleep(1); \
    if ((++_sp & 255u) == 0u) { if (xb_ld(&(bar)[XB_TMO])) break; if (_sp > XB_SPIN_CAP) { atomicAdd(&(bar)[XB_TMO], 1u); break; } } } } while (0)

struct XcdBarrier {
    unsigned* bar; unsigned x;
    volatile LAS unsigned* st;
};

__device__ __forceinline__ XcdBarrier xcd_barrier_post(unsigned* bar, volatile LAS unsigned* st) {
    XcdBarrier b; b.bar = bar; b.x = xb_xcc_id(); b.st = st;
    if (threadIdx.x == 0) (void)xb_add(&bar[XB_XCNT(b.x)], 1u);
    return b;
}
__device__ __forceinline__ void xcd_barrier_complete(unsigned* bar, unsigned x, unsigned& nloc, unsigned& nx) {
    const unsigned G = gridDim.x * gridDim.y * gridDim.z;
    unsigned sum, cnt, mine, sp = 0u;
    for (;;) {
        sum = 0u; cnt = 0u; mine = 0u;
#pragma unroll
        for (unsigned j = 0; j < 16; ++j) { const unsigned c = xb_ld(&bar[XB_XCNT(j)]); sum += c; cnt += (c > 0u) ? 1u : 0u; mine = (j == x) ? c : mine; }
        if (sum == G) break;
        __builtin_amdgcn_s_sleep(1);
        if ((++sp & 255u) == 0u) { if (xb_ld(&bar[XB_TMO])) break; if (sp > XB_SPIN_CAP) { atomicAdd(&bar[XB_TMO], 1u); break; } }
    }
    nloc = mine > 0u ? mine : 1u; nx = cnt > 0u ? cnt : 1u;
}

__device__ __forceinline__ void xcd_barrier(const XcdBarrier& b) {
    asm volatile("s_waitcnt vmcnt(0)" ::: "memory");
    __syncthreads();
    if (threadIdx.x == 0) {
        unsigned* bar = b.bar;
        __builtin_amdgcn_s_waitcnt(0);
        unsigned nloc = b.st[0], nx = b.st[1];
        if (nloc == 0u) { xcd_barrier_complete(bar, b.x, nloc, nx); b.st[0] = nloc; b.st[1] = nx; }
        const unsigned old = xb_add(&bar[XB_XSUB(b.x)], 1u);
        const unsigned gen = old / nloc;
        if (old + 1u == (gen + 1u) * nloc) {
            __builtin_amdgcn_fence(__ATOMIC_RELEASE, "agent");
            asm volatile("s_waitcnt vmcnt(0)" ::: "memory");
            const unsigned og = xb_add(&bar[XB_TOP], 1u);
            const unsigned tg = og / nx;
            if (og + 1u == (tg + 1u) * nx) xb_add(&bar[XB_TOPGEN], 1u);
            else XB_SPIN(xb_ld(&bar[XB_TOPGEN]) == tg, bar);
            __builtin_amdgcn_fence(__ATOMIC_ACQUIRE, "agent");
            xb_add(&bar[XB_XGEN(b.x)], 1u);
            asm volatile("s_waitcnt vmcnt(0)" ::: "memory");
        } else {
            XB_SPIN(xb_ld(&bar[XB_XGEN(b.x)]) == gen, bar);
            __builtin_amdgcn_fence(__ATOMIC_ACQUIRE, "agent");
            asm volatile("s_waitcnt vmcnt(0)" ::: "memory");
        }
    }
    __syncthreads();
}

__device__ __forceinline__ void phase_mod(LAS unsigned char* lds, const Inputs& in, const WS& w, int vb) {
    if (vb >= 72) return;
    LAS float* sc = (LAS float*)lds;
    const int tid = threadIdx.x, idx = vb * 512 + tid, rg = idx / 12288, ln = idx % 12288, l = ln / 6144, n = ln % 6144;
    float acc[11];
#pragma unroll
    for (int i = 0; i < 11; ++i) acc[i] = 0.f;
    const float* wp = in.ada_w + (size_t)l * 1024 * 6144 + n;
    for (int kc = 0; kc < 4; ++kc) {
        for (int i = tid; i < 33 * 256; i += 512) { const int r = i >> 8, k = kc * 256 + (i & 255); const float v = r < 32 ? in.c[(size_t)r * 1024 + k] : in.c_ctx[k]; sc[i] = v / (1.f + __expf(-v)); }
        __syncthreads();
        for (int k = 0; k < 256; ++k) { const float wv = wp[(size_t)(kc * 256 + k) * 6144];
#pragma unroll
            for (int i = 0; i < 11; ++i) acc[i] += sc[(rg * 11 + i) * 256 + k] * wv; }
        __syncthreads();
    }
    const float bias = in.ada_b[(size_t)l * 6144 + n];
#pragma unroll
    for (int i = 0; i < 11; ++i) w.MOD[((size_t)l * 33 + rg * 11 + i) * 6144 + n] = acc[i] + bias;
}
__device__ __forceinline__ void phase_rope(const WS& w, int vb, int nvb) {
    for (int i = vb * 512 + threadIdx.x; i < 2048 * 32; i += nvb * 512) {
        { const int t = i / 32, j = i % 32; const double inv = pow(10000.0, -(double)(j % 16) / 16.0); const double a = (double)(j < 16 ? t / 64 : t % 64) * inv; w.ROPA[i] = make_float2((float)cos(a), (float)sin(a)); }
        if (i < 2048 * 16) { const int t = i / 16, j = i % 16; const double inv = pow(10000.0, -(double)(j % 8) / 8.0); const double a = (double)(j < 8 ? t / 64 : t % 64) * inv; w.ROPC[i] = make_float2((float)cos(a), (float)sin(a)); }
    }
}

struct MegaArgs { Inputs in; WS w; float* XL; unsigned* bar; };
constexpr int MEGA_LDS = 131072 + 16;
__global__ void __launch_bounds__(512, 2) k_mega(MegaArgs A) {
    LAS unsigned char* lds = (LAS unsigned char*)dyn_lds;
    const int vb = blockIdx.x, nvb = gridDim.x;
    volatile LAS unsigned* xbw = (volatile LAS unsigned*)(lds + 131072);
    if (threadIdx.x == 0) { xbw[0] = 0u; xbw[1] = 0u; xbw[2] = 0u; xbw[3] = 0u; }
    __syncthreads();
    XcdBarrier bar = xcd_barrier_post(A.bar, xbw);
    const WS& w = A.w; const Inputs& in = A.in;
    phase_mod(lds, in, w, vb);
    phase_rope(w, vb, nvb);
    phase_cvt(lds, in, w, vb, nvb);
    xcd_barrier(bar);
    phase_modulate(in.x, in.ctx, w.H, in.norm1_g, w.MOD, 0, NR, vb, nvb);
    xcd_barrier(bar);
    for (int l = 0; l < DEPTH; ++l) {
        const float* MODl = w.MOD + (size_t)l * 33 * 6144;
        const bool last = (l == DEPTH - 1);
        const int MR = last ? NL : NR;
        phase_p1(lds, w, in, l, vb, nvb);
        xcd_barrier(bar);
        phase_p2(lds, w, in, l, vb, nvb);
        xcd_barrier(bar);
        phase_p3(lds, w, l, vb, nvb);
        xcd_barrier(bar);
        phase_p4(lds, w, in, A.XL, l, vb, nvb);
        xcd_barrier(bar);
        phase_modulate(A.XL, w.XC, w.H, in.norm2_g + l * 1024, MODl, 3, MR, vb, nvb);
        xcd_barrier(bar);
        phase_p6a(lds, w, l, vb, nvb);
        xcd_barrier(bar);
        phase_p6b(lds, w.PQ, w.SubK + (size_t)l * 16 * 128 * 128, w.EG, MR, vb, nvb);
        xcd_barrier(bar);
        { P7Args a{w.H, w.EG, w.Ub + (size_t)l * NE * 1024, w.Vb + (size_t)l * NE * 1024, A.XL, w.XC, MODl + 5 * 1024, MR, last ? 2 : 1,
                   w.H, in.norm1_g + (last ? 0 : (l + 1) * 1024), w.MOD + (size_t)(last ? 0 : (l + 1)) * 33 * 6144, in.final_g};
          phase_p7(a, vb, nvb); }
        if (!last) xcd_barrier(bar);
    }
}

extern "C" void kernel_launch(void* const* d_in, const int* in_sizes, int n_in, void* d_out, int out_size, void* d_ws, size_t ws_size, hipStream_t stream) {
    const float* const* fin = (const float* const*)d_in;
    Inputs in{fin[0], fin[1], fin[2], fin[3], fin[4], fin[5], fin[6], fin[7], fin[8], fin[9], fin[10], fin[11], fin[12], fin[13], fin[14], fin[15], fin[16], fin[17], fin[18], fin[19], fin[20], fin[21], fin[22]};
    WS w = make_ws(d_ws);
    static int ok = 0;
    if (!ok) {
        if (hipFuncSetAttribute((const void*)k_mega, hipFuncAttributeMaxDynamicSharedMemorySize, MEGA_LDS) != hipSuccess) { ok = -1; }
        int per_cu = 0, cus = 0, dev = 0; (void)hipGetDevice(&dev); (void)hipDeviceGetAttribute(&cus, hipDeviceAttributeMultiprocessorCount, dev);
        if (hipOccupancyMaxActiveBlocksPerMultiprocessor(&per_cu, (const void*)k_mega, 512, MEGA_LDS) != hipSuccess || per_cu < 1 || cus < 256) ok = -1;
        if (ok == 0) ok = 1;
    }
    if (ok < 0) return;
    (void)hipMemsetAsync(d_ws, 0, 16384, stream);
    MegaArgs A{in, w, (float*)d_out, (unsigned*)d_ws};
    k_mega<<<256, 512, MEGA_LDS, stream>>>(A);
}
```

```cpp
#include <hip/hip_runtime.h>
#include <stdint.h>

typedef unsigned short bf16_t;

constexpr int D = 1024, NB = 32, S = 2048, CTX = 256, DEPTH = 2;
constexpr int NL = NB * S, NC = NB * CTX, NR = NL + NC;
constexpr int KEYS = CTX + S;
constexpr int INC = 1568;
constexpr int NE = 16384;
constexpr float EPS = 1e-6f;

__device__ __forceinline__ float bf2f(bf16_t v) { return __uint_as_float(((unsigned)v) << 16); }
__device__ __forceinline__ bf16_t f2bf(float f) { unsigned u = __float_as_uint(f); u += 0x7FFFu + ((u >> 16) & 1u); return (bf16_t)(u >> 16); }

__device__ __forceinline__ float wave_sum(float v) {
#pragma unroll
    for (int o = 32; o > 0; o >>= 1) v += __shfl_xor(v, o);
    return v;
}
__device__ __forceinline__ float gelu_tanh(float x) {
    const float u = 0.7978845608028654f * (x + 0.044715f * x * x * x);
    return 0.5f * x * (1.f + tanhf(u));
}

struct WS {
    bf16_t* H;
    bf16_t *Qg, *Qgc, *Kg, *Vg, *CQ, *CKV, *Bp, *KR;
    bf16_t *Qm, *Qmc, *Kmn, *Vm;
    unsigned* EG;
    float* XC;
    float* MOD;
    float2* ROPA;
    float2* ROPC;
    float *RSQ, *RSKV;
    bf16_t* P;
    bf16_t* TMP;
    bf16_t* PQ;
    bf16_t *WinT, *WuqT, *WukvT, *WoutT, *WqT, *SubK;
    unsigned char *U8, *V8; float *US, *VS;
    float *SSQ, *SSKV;
};

static WS make_ws(void* d_ws) {
    WS w; char* p = (char*)d_ws; size_t off = 65536;
    auto take = [&](size_t bytes) { char* r = p + off; off += (bytes + 255) & ~(size_t)255; return r; };
    w.H = (bf16_t*)take((size_t)NR * 1024 * 2); w.TMP = w.H;
    char* regA = p + off;
    w.Qg = (bf16_t*)take((size_t)NL * 384 * 2);
    w.Qgc = (bf16_t*)take((size_t)NC * 384 * 2);
    w.Kg = (bf16_t*)take((size_t)NB * 2 * KEYS * 64 * 2);
    w.Vg = (bf16_t*)take((size_t)NB * 2 * KEYS * 64 * 2);
    w.CQ = (bf16_t*)take((size_t)NR * 384 * 2);
    w.CKV = (bf16_t*)take((size_t)NR * 256 * 2);
    w.Bp = (bf16_t*)take((size_t)NR * 256 * 2);
    w.KR = (bf16_t*)take((size_t)NB * KEYS * 32 * 2);
    char* regB = p + off;
    w.Qm = (bf16_t*)take((size_t)NL * 576 * 2);
    w.Qmc = (bf16_t*)take((size_t)NC * 576 * 2);
    w.Kmn = (bf16_t*)take((size_t)NB * 6 * KEYS * 64 * 2);
    w.Vm = (bf16_t*)take((size_t)NB * 6 * KEYS * 64 * 2);
    w.EG = (unsigned*)take((size_t)NR * 128 * 4);
    w.P = (bf16_t*)regB;
    w.PQ = (bf16_t*)regA;
    w.XC = (float*)take((size_t)NC * 1024 * 4);
    w.MOD = (float*)take((size_t)2 * 33 * 6144 * 4);
    w.ROPA = (float2*)take((size_t)2048 * 32 * 8);
    w.ROPC = (float2*)take((size_t)2048 * 16 * 8);
    w.RSQ = (float*)take((size_t)NR * 4);
    w.RSKV = (float*)take((size_t)NR * 4);
    w.WinT = (bf16_t*)take((size_t)2 * 1792 * 1024 * 2);
    w.WuqT = (bf16_t*)take((size_t)2 * 768 * 384 * 2);
    w.WukvT = (bf16_t*)take((size_t)2 * 768 * 256 * 2);
    w.WoutT = (bf16_t*)take((size_t)2 * 1024 * 1024 * 2);
    w.WqT = (bf16_t*)take((size_t)2 * 2048 * 1024 * 2);
    w.SubK = (bf16_t*)take((size_t)2 * 16 * 128 * 128 * 2);
    w.U8 = (unsigned char*)take((size_t)2 * NE * 1024);
    w.V8 = (unsigned char*)take((size_t)2 * NE * 1024);
    w.US = (float*)take((size_t)2 * NE * 4);
    w.VS = (float*)take((size_t)2 * NE * 4);
    w.SSQ = (float*)take((size_t)NR * 8 * 4);
    w.SSKV = (float*)take((size_t)NR * 4 * 4);
    return w;
}

__global__ void k_mod(const float* __restrict__ c, const float* __restrict__ c_ctx, const float* __restrict__ ada_w, const float* __restrict__ ada_b, float* __restrict__ MOD) {
    __shared__ float sc[1024];
    const int r = blockIdx.y, l = blockIdx.z, n = blockIdx.x * 256 + threadIdx.x;
    const float* cv = r < 32 ? c + (size_t)r * 1024 : c_ctx;
    for (int k = threadIdx.x; k < 1024; k += 256) { const float v = cv[k]; sc[k] = v / (1.f + expf(-v)); }
    __syncthreads();
    const float* w = ada_w + (size_t)l * 1024 * 6144 + n;
    float acc = 0.f;
    for (int k = 0; k < 1024; ++k) acc += sc[k] * w[(size_t)k * 6144];
    MOD[((size_t)l * 33 + r) * 6144 + n] = acc + ada_b[(size_t)l * 6144 + n];
}
__global__ void k_rope_tab(float2* ROPA, float2* ROPC) {
    const int i = blockIdx.x * 256 + threadIdx.x;
    if (i < 2048 * 32) { const int t = i / 32, j = i % 32; const double inv = pow(10000.0, -(double)(j % 16) / 16.0); const double a = (double)(j < 16 ? t / 64 : t % 64) * inv; ROPA[i] = make_float2((float)cos(a), (float)sin(a)); }
    if (i < 2048 * 16) { const int t = i / 16, j = i % 16; const double inv = pow(10000.0, -(double)(j % 8) / 8.0); const double a = (double)(j < 8 ? t / 64 : t % 64) * inv; ROPC[i] = make_float2((float)cos(a), (float)sin(a)); }
}

__global__ void k_modulate(const float* __restrict__ X, bf16_t* __restrict__ Hout, const float* __restrict__ g, const float* __restrict__ MODl, int si, int rows_per_batch, int fixed) {
    __shared__ float red[4];
    const int row = blockIdx.x, tid = threadIdx.x;
    const float4 x = *(const float4*)(X + (size_t)row * 1024 + tid * 4);
    float ss = x.x * x.x + x.y * x.y + x.z * x.z + x.w * x.w;
    ss = wave_sum(ss); if ((tid & 63) == 0) red[tid >> 6] = ss; __syncthreads();
    ss = red[0] + red[1] + red[2] + red[3];
    const float rstd = rsqrtf(ss * (1.f / 1024.f) + EPS);
    const int mr = fixed >= 0 ? fixed : row / rows_per_batch;
    const float* sh = MODl + (size_t)mr * 6144 + si * 1024 + tid * 4; const float* sc = sh + 1024;
    const float4 gv = *(const float4*)(g + tid * 4), shv = *(const float4*)sh, scv = *(const float4*)sc;
    bf16_t o[4];
    o[0] = f2bf(x.x * rstd * gv.x * (1.f + scv.x) + shv.x); o[1] = f2bf(x.y * rstd * gv.y * (1.f + scv.y) + shv.y);
    o[2] = f2bf(x.z * rstd * gv.z * (1.f + scv.z) + shv.z); o[3] = f2bf(x.w * rstd * gv.w * (1.f + scv.w) + shv.w);
    *(uint2*)(Hout + (size_t)row * 1024 + tid * 4) = *(uint2*)o;
}

template <int MODE>
__global__ void __launch_bounds__(256) k_ngemm(const bf16_t* __restrict__ A, int lda, const float* __restrict__ W, int ldw, int M, int N, int K,
                                               const float* __restrict__ rowscale, const float* __restrict__ kgain,
                                               bf16_t* __restrict__ C, int ldc, float* __restrict__ Xf, const float* __restrict__ gate, int rows_per_batch, int fixed) {
    __shared__ float As[64][17];
    __shared__ float Ws[16][64];
    const int tid = threadIdx.x, tx = tid & 15, ty = tid >> 4;
    const int m0 = blockIdx.y * 64, n0 = blockIdx.x * 64;
    float acc[4][4];
#pragma unroll
    for (int i = 0; i < 4; ++i)
#pragma unroll
        for (int j = 0; j < 4; ++j) acc[i][j] = 0.f;
    const int ar = tid >> 2, ac = (tid & 3) * 4;
    const int wr = tid >> 4, wc = (tid & 15) * 4;
    for (int k0 = 0; k0 < K; k0 += 16) {
        { const uint2 raw = *(const uint2*)(A + (size_t)(m0 + ar) * lda + k0 + ac); const bf16_t* e = (const bf16_t*)&raw;
#pragma unroll
          for (int i = 0; i < 4; ++i) { float v = bf2f(e[i]); if (kgain) v *= kgain[k0 + ac + i]; As[ar][ac + i] = v; } }
        { float4 wv = make_float4(0.f, 0.f, 0.f, 0.f); if (n0 + wc < N) wv = *(const float4*)(W + (size_t)(k0 + wr) * ldw + n0 + wc); *(float4*)&Ws[wr][wc] = wv; }
        __syncthreads();
#pragma unroll
        for (int kk = 0; kk < 16; ++kk) {
            float a[4], b[4];
#pragma unroll
            for (int i = 0; i < 4; ++i) a[i] = As[ty * 4 + i][kk];
            const float4 bv = *(const float4*)&Ws[kk][tx * 4]; b[0] = bv.x; b[1] = bv.y; b[2] = bv.z; b[3] = bv.w;
#pragma unroll
            for (int i = 0; i < 4; ++i)
#pragma unroll
                for (int j = 0; j < 4; ++j) acc[i][j] += a[i] * b[j];
        }
        __syncthreads();
    }
    if (n0 + tx * 4 >= N) return;
#pragma unroll
    for (int i = 0; i < 4; ++i) {
        const int m = m0 + ty * 4 + i; const float rs = rowscale ? rowscale[m] : 1.f;
        if (MODE == 0) { bf16_t o[4];
#pragma unroll
            for (int j = 0; j < 4; ++j) o[j] = f2bf(acc[i][j] * rs);
            *(uint2*)(C + (size_t)m * ldc + n0 + tx * 4) = *(uint2*)o;
        } else {
            const int mr = fixed >= 0 ? fixed : m / rows_per_batch;
            float4 xv = *(float4*)(Xf + (size_t)m * 1024 + n0 + tx * 4); const float4 gv = *(const float4*)(gate + (size_t)mr * 6144 + n0 + tx * 4);
            xv.x += gv.x * acc[i][0]; xv.y += gv.y * acc[i][1]; xv.z += gv.z * acc[i][2]; xv.w += gv.w * acc[i][3];
            *(float4*)(Xf + (size_t)m * 1024 + n0 + tx * 4) = xv;
        }
    }
}

__global__ void __launch_bounds__(256) k_post_in(const bf16_t* __restrict__ P, WS w, const float* __restrict__ qn_g, const float* __restrict__ kn_g, int row0) {
    __shared__ float p[INC];
    const int row = row0 + blockIdx.x, tid = threadIdx.x, lane = tid & 63, wid = tid >> 6;
    const bool isctx = row >= NL; const int b = isctx ? (row - NL) / CTX : row / S, t = isctx ? (row - NL) % CTX : row % S;
    const int key = isctx ? t : CTX + t;
    for (int i = tid; i < INC; i += 256) p[i] = bf2f(P[(size_t)row * INC + i]);
    __syncthreads();
    for (int gI = wid; gI < 8; gI += 4) {
        const float x = p[gI * 64 + lane];
        const float ss = wave_sum(x * x);
        const float rstd = rsqrtf(ss * (1.f / 64.f) + EPS);
        float y = x * rstd * (gI < 6 ? qn_g[lane] : kn_g[lane]);
        if (!isctx) { const float o = __shfl_xor(y, 32); const float2 cs = w.ROPA[t * 32 + (lane & 31)];
            y = lane < 32 ? (y * cs.x - o * cs.y) : (o * cs.y + y * cs.x); }
        if (gI < 6) { bf16_t* dst = isctx ? w.Qgc + (((size_t)b * 6 + gI) * CTX + t) * 64 : w.Qg + (((size_t)b * 6 + gI) * S + t) * 64; dst[lane] = f2bf(y); }
        else { w.Kg[(((size_t)b * 2 + (gI - 6)) * KEYS + key) * 64 + lane] = f2bf(y); }
    }
    if (tid < 128) w.Vg[(((size_t)b * 2 + (tid >> 6)) * KEYS + key) * 64 + (tid & 63)] = f2bf(p[512 + tid]);
    w.Bp[(size_t)row * 256 + tid] = f2bf(p[640 + tid]);
    for (int i = tid; i < 384; i += 256) w.CQ[(size_t)row * 384 + i] = f2bf(p[896 + i]);
    w.CKV[(size_t)row * 256 + tid] = f2bf(p[1280 + tid]);
    if (wid == 0) { float ss = 0.f; for (int i = lane; i < 384; i += 64) ss += p[896 + i] * p[896 + i]; ss = wave_sum(ss); if (lane == 0) w.RSQ[row] = rsqrtf(ss * (1.f / 384.f) + EPS); }
    if (wid == 1) { float ss = 0.f; for (int i = lane; i < 256; i += 64) ss += p[1280 + i] * p[1280 + i]; ss = wave_sum(ss); if (lane == 0) w.RSKV[row] = rsqrtf(ss * (1.f / 256.f) + EPS); }
    if (wid == 2 && lane < 32) { float y = p[1536 + lane];
        if (!isctx) { const float o = __shfl_xor(y, 16); const float2 cs = w.ROPC[t * 16 + (lane & 15)]; y = lane < 16 ? (y * cs.x - o * cs.y) : (o * cs.y + y * cs.x); }
        w.KR[((size_t)b * KEYS + key) * 32 + lane] = f2bf(y); }
}
__global__ void __launch_bounds__(256) k_post_q(const bf16_t* __restrict__ T, WS w, int row0) {
    const int row = row0 + blockIdx.x, tid = threadIdx.x;
    const bool isctx = row >= NL; const int b = isctx ? (row - NL) / CTX : row / S, t = isctx ? (row - NL) % CTX : row % S;
    for (int i = tid; i < 576; i += 256) {
        const int h = i / 96, e = i % 96; float y = bf2f(T[(size_t)row * 576 + i]);
        if (e >= 64 && !isctx) { const int j = e - 64; const float o = bf2f(T[(size_t)row * 576 + h * 96 + 64 + (j ^ 16)]); const float2 cs = w.ROPC[t * 16 + (j & 15)];
            y = j < 16 ? (y * cs.x - o * cs.y) : (o * cs.y + y * cs.x); }
        bf16_t* dst = isctx ? w.Qmc + (((size_t)b * 6 + h) * CTX + t) * 96 : w.Qm + (((size_t)b * 6 + h) * S + t) * 96;
        dst[e] = f2bf(y);
    }
}
__global__ void __launch_bounds__(256) k_post_kv(const bf16_t* __restrict__ T, WS w, int row0) {
    const int row = row0 + blockIdx.x, tid = threadIdx.x;
    const bool isctx = row >= NL; const int b = isctx ? (row - NL) / CTX : row / S, t = isctx ? (row - NL) % CTX : row % S;
    const int key = isctx ? t : CTX + t;
    for (int i = tid; i < 768; i += 256) {
        const int h = i / 128, e = i % 128; const bf16_t v = T[(size_t)row * 768 + i];
        if (e < 64) w.Kmn[(((size_t)b * 6 + h) * KEYS + key) * 64 + e] = v; else w.Vm[(((size_t)b * 6 + h) * KEYS + key) * 64 + (e - 64)] = v;
    }
}

template <int DK>
__global__ void __launch_bounds__(256) k_nattn(const bf16_t* __restrict__ Q, const bf16_t* __restrict__ K1, const bf16_t* __restrict__ K2, const bf16_t* __restrict__ V,
                                               bf16_t* __restrict__ MIX, int H, int HK, int G, int LQ, int nkeys, float scale, int rowbase, int coff) {
    const int b = blockIdx.z, h = blockIdx.y, t = blockIdx.x * 256 + threadIdx.x, hk = h / G;
    float q[DK];
    { const bf16_t* qp = Q + (((size_t)b * H + h) * LQ + t) * DK;
#pragma unroll
      for (int d = 0; d < DK; d += 8) { const uint4 raw = *(const uint4*)(qp + d); const bf16_t* e = (const bf16_t*)&raw;
#pragma unroll
          for (int i = 0; i < 8; ++i) q[d + i] = bf2f(e[i]) * scale; } }
    float o[64];
#pragma unroll
    for (int d = 0; d < 64; ++d) o[d] = 0.f;
    float m = -INFINITY, l = 0.f;
    const bf16_t* k1 = K1 + ((size_t)b * HK + hk) * KEYS * 64; const bf16_t* k2 = K2 ? K2 + (size_t)b * KEYS * 32 : nullptr; const bf16_t* vp = V + ((size_t)b * HK + hk) * KEYS * 64;
    for (int k = 0; k < nkeys; ++k) {
        float s = 0.f;
#pragma unroll
        for (int d = 0; d < 64; d += 8) { const uint4 raw = *(const uint4*)(k1 + (size_t)k * 64 + d); const bf16_t* e = (const bf16_t*)&raw;
#pragma unroll
            for (int i = 0; i < 8; ++i) s += q[d + i] * bf2f(e[i]); }
        if (DK == 96) {
#pragma unroll
            for (int d = 0; d < 32; d += 8) { const uint4 raw = *(const uint4*)(k2 + (size_t)k * 32 + d); const bf16_t* e = (const bf16_t*)&raw;
#pragma unroll
                for (int i = 0; i < 8; ++i) s += q[(DK == 96 ? 64 : 0) + d + i] * bf2f(e[i]); }
        }
        if (s > m) { const float a = __expf(m - s); l *= a;
#pragma unroll
            for (int d = 0; d < 64; ++d) o[d] *= a;
            m = s; }
        const float pw = __expf(s - m); l += pw;
#pragma unroll
        for (int d = 0; d < 64; d += 8) { const uint4 raw = *(const uint4*)(vp + (size_t)k * 64 + d); const bf16_t* e = (const bf16_t*)&raw;
#pragma unroll
            for (int i = 0; i < 8; ++i) o[d + i] += pw * bf2f(e[i]); }
    }
    const float il = 1.f / l;
    bf16_t* dst = MIX + (size_t)(rowbase + b * LQ + t) * 1024 + coff + h * 64;
#pragma unroll
    for (int d = 0; d < 64; d += 8) { bf16_t ob[8];
#pragma unroll
        for (int i = 0; i < 8; ++i) ob[i] = f2bf(o[d + i] * il);
        *(uint4*)(dst + d) = *(uint4*)ob; }
}

__global__ void __launch_bounds__(256) k_npool(const bf16_t* __restrict__ Bp, bf16_t* __restrict__ MIX, const float* __restrict__ pool_w, const float* __restrict__ pool_scale, int row0) {
    __shared__ float pl[256];
    const int row = row0 + blockIdx.x, tid = threadIdx.x, gI = tid >> 6, c = tid & 63;
    const bool isctx = row >= NL; const int L = isctx ? CTX : S; const int t = isctx ? (row - NL) % CTX : row % S; const int base = row - t;
    const int wdw = 2 << gI;
    int lo = t - wdw / 2, hi = t - wdw / 2 + wdw; lo = lo < 0 ? 0 : lo; hi = hi > L ? L : hi;
    float sum = 0.f;
    for (int u = lo; u < hi; ++u) sum += bf2f(Bp[(size_t)(base + u) * 256 + tid]);
    pl[tid] = sum / (float)(hi - lo) - bf2f(Bp[(size_t)row * 256 + tid]);
    __syncthreads();
    float acc = 0.f; const float* wg = pool_w + (size_t)gI * 64 * 64 + c;
    for (int cc = 0; cc < 64; ++cc) acc += pl[gI * 64 + cc] * wg[cc * 64];
    MIX[(size_t)row * 1024 + 384 + tid] = f2bf(acc * pool_scale[tid]);
}

__global__ void __launch_bounds__(256) k_peer_select(const bf16_t* __restrict__ PQ, const float* __restrict__ subk, unsigned* __restrict__ EG, int row0) {
    __shared__ float q[2048];
    __shared__ float sc[16][128];
    __shared__ float ts[16][16]; __shared__ int ti[16][16];
    __shared__ float cs[8][16]; __shared__ int ci[8][16];
    const int row = row0 + blockIdx.x, tid = threadIdx.x;
    for (int i = tid; i < 2048; i += 256) q[i] = bf2f(PQ[(size_t)row * 2048 + i]);
    __syncthreads();
    for (int i = tid; i < 2048; i += 256) { const int gp = i >> 7, n = i & 127; const float* kp = subk + ((size_t)gp * 128 + n) * 128; const float* qp = q + gp * 128;
        float s = 0.f; for (int d = 0; d < 128; ++d) s += qp[d] * kp[d]; sc[gp][n] = s; }
    __syncthreads();
    for (int i = tid; i < 2048; i += 256) { const int gp = i >> 7, n = i & 127; const float v = sc[gp][n]; int rank = 0;
        for (int mI = 0; mI < 128; ++mI) { const float o = sc[gp][mI]; rank += (o > v || (o == v && mI < n)) ? 1 : 0; }
        if (rank < 16) { ts[gp][rank] = v; ti[gp][rank] = n; } }
    __syncthreads();
    { const int h = tid >> 5;
      for (int cI = (tid & 31); cI < 256; cI += 32) { const int a = cI >> 4, bb = cI & 15; const float v = ts[h * 2][a] + ts[h * 2 + 1][bb]; int rank = 0;
          for (int o = 0; o < 256; ++o) { const float ov = ts[h * 2][o >> 4] + ts[h * 2 + 1][o & 15]; rank += (ov > v || (ov == v && o < cI)) ? 1 : 0; }
          if (rank < 16) { cs[h][rank] = v; ci[h][rank] = ti[h * 2][a] * 128 + ti[h * 2 + 1][bb]; } } }
    __syncthreads();
    if (tid < 128) { const int h = tid >> 4, j = tid & 15; const float mx = cs[h][0]; float den = 0.f;
        for (int o = 0; o < 16; ++o) den += __expf(cs[h][o] - mx);
        const float gte = __expf(cs[h][j] - mx) / den;
        EG[(size_t)row * 128 + tid] = ((unsigned)ci[h][j] << 16) | (unsigned)f2bf(gte); }
}
__global__ void __launch_bounds__(256) k_peer_expert(const bf16_t* __restrict__ H2, const unsigned* __restrict__ EG, const float* __restrict__ U, const float* __restrict__ Vt, float* __restrict__ X,
                                                     const float* __restrict__ gate2, int rows_per_batch, int fixed, int hrow0) {
    __shared__ float h[1024]; __shared__ float wgt[128]; __shared__ int eid[128];
    const int row = blockIdx.x, tid = threadIdx.x, lane = tid & 63, wid = tid >> 6;
    for (int i = tid; i < 1024; i += 256) h[i] = bf2f(H2[(size_t)(hrow0 + row) * 1024 + i]);
    if (tid < 128) eid[tid] = (int)(EG[(size_t)(hrow0 + row) * 128 + tid] >> 16);
    __syncthreads();
    for (int e = wid; e < 128; e += 4) { const float* up = U + (size_t)eid[e] * 1024; float s = 0.f;
        for (int d = lane; d < 1024; d += 64) s += h[d] * up[d];
        s = wave_sum(s);
        if (lane == 0) wgt[e] = bf2f((bf16_t)(EG[(size_t)(hrow0 + row) * 128 + e] & 0xFFFFu)) * gelu_tanh(s); }
    __syncthreads();
    float4 acc = make_float4(0.f, 0.f, 0.f, 0.f);
    for (int e = 0; e < 128; ++e) { const float4 v = *(const float4*)(Vt + (size_t)eid[e] * 1024 + tid * 4); const float wv = wgt[e];
        acc.x += wv * v.x; acc.y += wv * v.y; acc.z += wv * v.z; acc.w += wv * v.w; }
    const int mr = fixed >= 0 ? fixed : row / rows_per_batch;
    const float4 gv = *(const float4*)(gate2 + (size_t)mr * 6144 + tid * 4);
    float4 xv = *(float4*)(X + (size_t)row * 1024 + tid * 4);
    xv.x += gv.x * acc.x; xv.y += gv.y * acc.y; xv.z += gv.z * acc.z; xv.w += gv.w * acc.w;
    *(float4*)(X + (size_t)row * 1024 + tid * 4) = xv;
}
__global__ void __launch_bounds__(256) k_final(float* __restrict__ X, const float* __restrict__ g) {
    __shared__ float red[4];
    const int row = blockIdx.x, tid = threadIdx.x;
    float4 x = *(const float4*)(X + (size_t)row * 1024 + tid * 4);
    float ss = x.x * x.x + x.y * x.y + x.z * x.z + x.w * x.w;
    ss = wave_sum(ss); if ((tid & 63) == 0) red[tid >> 6] = ss; __syncthreads();
    ss = red[0] + red[1] + red[2] + red[3];
    const float rstd = rsqrtf(ss * (1.f / 1024.f) + EPS);
    const float4 gv = *(const float4*)(g + tid * 4);
    x.x *= rstd * gv.x; x.y *= rstd * gv.y; x.z *= rstd * gv.z; x.w *= rstd * gv.w;
    *(float4*)(X + (size_t)row * 1024 + tid * 4) = x;
}

#define LAS __attribute__((address_space(3)))
typedef short bf16x8 __attribute__((ext_vector_type(8)));
typedef float f32x4 __attribute__((ext_vector_type(4)));
typedef float f32x16 __attribute__((ext_vector_type(16)));
typedef unsigned u32x4 __attribute__((ext_vector_type(4)));
typedef unsigned u32x2 __attribute__((ext_vector_type(2)));

__device__ __forceinline__ unsigned cvt_pk_bf16(float lo, float hi) { unsigned r; asm volatile("v_cvt_pk_bf16_f32 %0, %1, %2" : "=v"(r) : "v"(lo), "v"(hi)); return r; }

namespace pg8 {
constexpr int BM = 256, BK = 64, HALF = 128, HTB = HALF * BK * 2, STAGE_BYTES = 8 * HTB, NXCD = 8, WGM = 8;
__host__ __device__ __forceinline__ int lds_byte(int r, int c) { const int st = (r >> 4) * 2 + (c >> 5), rr = r & 15, cc = c & 31, ob = rr * 64 + cc * 2; return st * 1024 + (ob ^ (((ob >> 9) & 1) << 5)); }
__host__ __device__ __forceinline__ void stage_rc(int b, int& R, int& C) { const int st = b / 1024, sb = b % 1024, swz = sb ^ (((sb >> 9) & 1) << 5); R = (st >> 1) * 16 + swz / 64; C = (st & 1) * 32 + (swz % 64) / 2; }
__host__ __device__ __forceinline__ int perm32(int rho) { const int n = rho >> 4, i = rho & 15; return 8 * (i >> 2) + 4 * n + (i & 3); }
struct Unit { int pm, pn; };
struct Gemm { const bf16_t* A; const bf16_t* Bt; int M, N, K; };
struct StaticOrder {
    int nM, nN, nwg, G, c;
    __host__ __device__ void init(int M, int N, int G_, int c_) { nM = M / BM; nN = N / BM; nwg = nM * nN; G = G_; c = c_; }
    __host__ __device__ bool next(int i, Unit& u) const {
        const long L = (long)i * G + c; if (L >= nwg) return false;
        int wgid = (int)L; { const int q = nwg / NXCD, r = nwg % NXCD, xcd = wgid % NXCD, off = wgid / NXCD; wgid = (xcd < r ? xcd * (q + 1) : r * (q + 1) + (xcd - r) * q) + off; }
        const int nig = WGM * nN, gid = wgid / nig, fm = gid * WGM, gsz = (nM - fm) < WGM ? (nM - fm) : WGM;
        u.pm = fm + ((wgid % nig) % gsz); u.pn = (wgid % nig) / gsz; return true;
    }
};
template <class Epi, class Sched>
__device__ __forceinline__ void gemm_phase(LAS unsigned char* lds, const Gemm g, const Sched& S, const Epi& E) {
    int tid_ = threadIdx.x; asm volatile("" : "+v"(tid_));
    const int tid = tid_, wid = __builtin_amdgcn_readfirstlane(tid >> 6), lane = tid & 63, wr = wid >> 2, wc = wid & 3, fr = lane & 15, fq = lane >> 4;
    const int K = g.K, nt = K / BK;
    unsigned voffA[2], voffB[2];
#pragma unroll
    for (int i = 0; i < 2; ++i) { int R, C; stage_rc(tid * 16 + i * 8192, R, C); const int Rb = Epi::PERM ? ((R & ~31) + perm32(R & 31)) : R;
        voffA[i] = (unsigned)(R * K + C) * 2u; voffB[i] = (unsigned)(Rb * K + C) * 2u; }
    const size_t kstep = (size_t)(BK * 2);
    const size_t hstep = (size_t)HALF * K * 2;
    const size_t tstep = 2 * hstep;
    const unsigned ldsw = (unsigned)wid * 1024u;
    const int aoff = lds_byte(wr * 64 + fr, fq * 8), boff = lds_byte(wc * 32 + fr, fq * 8);
#define PG8_SA(b, h) (((b) * 2 + (h)) * HTB)
#define PG8_SB(b, h) ((4 + (b) * 2 + (h)) * HTB)
#define PG8_STAGE(bufoff, gbase, voff) do { _Pragma("unroll") for (int _i = 0; _i < 2; ++_i) \
        __builtin_amdgcn_global_load_lds((const unsigned*)((const char*)(gbase) + (voff)[_i]), (LAS unsigned*)(lds + (bufoff) + ldsw + _i * 8192), 16, 0, 0); } while (0)
#define PG8_LDA(dst, b, h) do { _Pragma("unroll") for (int m = 0; m < 4; ++m) _Pragma("unroll") for (int k = 0; k < 2; ++k) dst[m][k] = *(const LAS bf16x8*)(lds + PG8_SA(b, h) + aoff + m * 2048 + k * 1024); } while (0)
#define PG8_LDB(dst, b, h) do { _Pragma("unroll") for (int n = 0; n < 2; ++n) _Pragma("unroll") for (int k = 0; k < 2; ++k) dst[n][k] = *(const LAS bf16x8*)(lds + PG8_SB(b, h) + boff + n * 2048 + k * 1024); } while (0)
#define PG8_MMA(ai, bj, At, Bt) do { __builtin_amdgcn_s_setprio(1); _Pragma("unroll") for (int m = 0; m < 4; ++m) _Pragma("unroll") for (int n = 0; n < 2; ++n) _Pragma("unroll") for (int k = 0; k < 2; ++k) \
        acc[ai][bj][m][n] = __builtin_amdgcn_mfma_f32_16x16x32_bf16(Bt[n][k], At[m][k], acc[ai][bj][m][n], 0, 0, 0); __builtin_amdgcn_s_setprio(0); } while (0)
#define PG8_WAIT_V(n) asm volatile("s_waitcnt vmcnt(" #n ")" ::: "memory")
#define PG8_WAIT_L(n) asm volatile("s_waitcnt lgkmcnt(" #n ")" ::: "memory")
#define PG8_BAR __builtin_amdgcn_s_barrier()
#define PG8_SCHED __builtin_amdgcn_sched_barrier(0)
    Unit cur, nxt; int ui = 0;
    if (!S.next(0, cur)) return;
    f32x4 acc[2][2][4][2];
#pragma unroll
    for (int a = 0; a < 2; ++a)
#pragma unroll
        for (int b = 0; b < 2; ++b)
#pragma unroll
            for (int m = 0; m < 4; ++m)
#pragma unroll
                for (int n = 0; n < 2; ++n) acc[a][b][m][n] = (f32x4){0.f, 0.f, 0.f, 0.f};
    bf16x8 At[4][2], B0[2][2], B1[2][2];
    const char* cA = (const char*)g.A + (size_t)cur.pm * tstep; const char* cB = (const char*)g.Bt + (size_t)cur.pn * tstep;
    PG8_STAGE(PG8_SB(0, 0), cB, voffB); PG8_STAGE(PG8_SA(0, 0), cA, voffA); PG8_STAGE(PG8_SB(0, 1), cB + hstep, voffB); PG8_STAGE(PG8_SA(0, 1), cA + hstep, voffA);
    if (wr == 1) PG8_BAR;
    PG8_WAIT_V(4); PG8_BAR;
    PG8_STAGE(PG8_SB(1, 0), cB + kstep, voffB); PG8_STAGE(PG8_SA(1, 0), cA + kstep, voffA); PG8_STAGE(PG8_SB(1, 1), cB + hstep + kstep, voffB);
    PG8_WAIT_V(6); PG8_BAR;
    for (;;) {
        const bool has_next = S.next(ui + 1, nxt);
        const char* nA = has_next ? (const char*)g.A + (size_t)nxt.pm * tstep : cA; const char* nB = has_next ? (const char*)g.Bt + (size_t)nxt.pn * tstep : cB;
#pragma nounroll
        for (int t = 0; t < nt; t += 2) {
            const bool last = (t == nt - 2);
            const char* a1 = cA + (size_t)(t + 1) * kstep;
            const char* a2 = last ? nA : cA + (size_t)(t + 2) * kstep; const char* b2 = last ? nB : cB + (size_t)(t + 2) * kstep;
            const char* a3 = a2 + kstep; const char* b3 = b2 + kstep;
            PG8_LDB(B0, 0, 0); PG8_SCHED; PG8_LDA(At, 0, 0); PG8_STAGE(PG8_SA(1, 1), a1 + hstep, voffA);
            PG8_WAIT_L(8); PG8_BAR; PG8_WAIT_L(0); PG8_MMA(0, 0, At, B0); PG8_BAR; PG8_SCHED;
            PG8_LDB(B1, 0, 1); PG8_STAGE(PG8_SB(0, 0), b2, voffB);
            PG8_BAR; PG8_WAIT_L(0); PG8_MMA(0, 1, At, B1); PG8_BAR;
            PG8_LDA(At, 0, 1); PG8_STAGE(PG8_SA(0, 0), a2, voffA);
            PG8_BAR; PG8_WAIT_L(0); PG8_MMA(1, 0, At, B0); PG8_BAR; PG8_SCHED;
            PG8_STAGE(PG8_SB(0, 1), b2 + hstep, voffB);
            PG8_WAIT_V(6); PG8_BAR; PG8_MMA(1, 1, At, B1); PG8_BAR;
            PG8_LDB(B0, 1, 0); PG8_SCHED; PG8_LDA(At, 1, 0); PG8_STAGE(PG8_SA(0, 1), a2 + hstep, voffA);
            PG8_WAIT_L(8); PG8_BAR; PG8_WAIT_L(0); PG8_MMA(0, 0, At, B0); PG8_BAR; PG8_SCHED;
            PG8_LDB(B1, 1, 1); PG8_STAGE(PG8_SB(1, 0), b3, voffB);
            PG8_BAR; PG8_WAIT_L(0); PG8_MMA(0, 1, At, B1); PG8_BAR;
            PG8_LDA(At, 1, 1); PG8_STAGE(PG8_SA(1, 0), a3, voffA);
            PG8_BAR; PG8_WAIT_L(0); PG8_MMA(1, 0, At, B0); PG8_BAR; PG8_SCHED;
            PG8_STAGE(PG8_SB(1, 1), b3 + hstep, voffB);
            PG8_WAIT_V(6); PG8_BAR; PG8_MMA(1, 1, At, B1); PG8_BAR;
        }
        E(acc, cur, wr, wc, fr, fq);
        if (!has_next) break;
#pragma unroll
        for (int a = 0; a < 2; ++a)
#pragma unroll
            for (int b = 0; b < 2; ++b)
#pragma unroll
                for (int m = 0; m < 4; ++m)
#pragma unroll
                    for (int n = 0; n < 2; ++n) acc[a][b][m][n] = (f32x4){0.f, 0.f, 0.f, 0.f};
        cur = nxt; cA = nA; cB = nB; ++ui;
    }
    PG8_WAIT_V(0);
    if (wr == 0) PG8_BAR;
    PG8_BAR;
#undef PG8_SA
#undef PG8_SB
#undef PG8_STAGE
#undef PG8_LDA
#undef PG8_LDB
#undef PG8_MMA
#undef PG8_WAIT_V
#undef PG8_WAIT_L
#undef PG8_BAR
#undef PG8_SCHED
}
}

enum { GT_AQ = 0, GT_AK = 1, GT_AV = 2, GT_B = 3, GT_CQ = 4, GT_CKV = 5, GT_KR = 6, GT_PAD = 7 };
__host__ __device__ __forceinline__ void in_group(int g, int& type, int& sub) {
    if (g < 2) { type = GT_AK; sub = g; } else if (g < 4) { type = GT_AV; sub = g - 2; } else if (g < 8) { type = GT_CKV; sub = g - 4; }
    else if (g == 8) { type = GT_KR; sub = 0; } else if (g < 12) { type = GT_PAD; sub = 0; } else if (g < 18) { type = GT_AQ; sub = g - 12; }
    else if (g < 24) { type = GT_CQ; sub = g - 18; } else { type = GT_B; sub = g - 24; }
}
__device__ __forceinline__ int colmap(int mode, int r) {
    const int pn = r >> 8, ct = r & 255, bj = ct >> 7, wc = (ct >> 5) & 3, j = ct & 31, g = 4 * pn + wc, e = 32 * bj + j;
    if (mode == 0) {
        int type, sub; in_group(g, type, sub);
        switch (type) { case GT_AQ: return 64 * sub + e; case GT_AK: return 384 + 64 * sub + e; case GT_AV: return 512 + 64 * sub + e; case GT_B: return 640 + 64 * sub + e;
            case GT_CQ: return 896 + 64 * sub + e; case GT_CKV: return 1280 + 64 * sub + e; case GT_KR: return (j < 16) ? 1536 + 16 * bj + j : -1; default: return -1; }
    } else if (mode == 1) {
        if (g < 6) return 96 * g + e; if (g < 9) { const int head = 2 * (g - 6) + (j >> 4); return 96 * head + 64 + 16 * bj + (j & 15); } return -1;
    } else if (mode == 2) {
        return 64 * g + e;
    }
    return r;
}
__device__ __forceinline__ void cvt_weights_unit(LAS float* tile  , const float* __restrict__ W, int K, int N, bf16_t* __restrict__ dst, int mode, const float* __restrict__ kgain, int r0, int k0) {
    const int tid = threadIdx.x;
    const int jj = tid & 63; const int sc = colmap(mode, r0 + jj);
#pragma unroll
    for (int i = 0; i < 8; ++i) { const int kk = (tid >> 6) + 8 * i; float v = 0.f; if (sc >= 0) v = W[(size_t)(k0 + kk) * N + sc]; if (kgain) v *= kgain[k0 + kk]; tile[kk * 65 + jj] = v; }
    __syncthreads();
#pragma unroll
    for (int i = 0; i < 8; ++i) { const int rr = (tid >> 6) + 8 * i, kk = tid & 63; dst[(size_t)(r0 + rr) * K + k0 + kk] = f2bf(tile[kk * 65 + rr]); }
    __syncthreads();
}
struct CvtJob { const float* W; bf16_t* dst; const float* kgain; int K, N, Npad, mode; };
__device__ __forceinline__ void cvt_job(LAS float* tile, const CvtJob j, int vb, int nvb) {
    const int nk = j.K / 64, nr = j.Npad / 64;
    for (int u = vb; u < nk * nr; u += nvb) cvt_weights_unit(tile, j.W, j.K, j.N, j.dst, j.mode, j.kgain, (u / nk) * 64, (u % nk) * 64);
}
__device__ __forceinline__ void cvt_flat(const float* __restrict__ src, bf16_t* __restrict__ dst, size_t n, int vb, int nvb) {
    for (size_t i = ((size_t)vb * 512 + threadIdx.x) * 8; i < n; i += (size_t)nvb * 512 * 8) {
        const float4 a = *(const float4*)(src + i), b = *(const float4*)(src + i + 4);
        u32x4 o; o.x = cvt_pk_bf16(a.x, a.y); o.y = cvt_pk_bf16(a.z, a.w); o.z = cvt_pk_bf16(b.x, b.y); o.w = cvt_pk_bf16(b.z, b.w);
        *(u32x4*)(dst + i) = o;
    }
}
__device__ __forceinline__ void cvt_fp8_rows(const float* __restrict__ src, unsigned char* __restrict__ dst, float* __restrict__ scales, int nrows, int vb, int nvb) {
    const int lane = threadIdx.x & 63, wid = threadIdx.x >> 6;
    for (int row = vb * 8 + wid; row < nrows; row += nvb * 8) {
        const float* sp = src + (size_t)row * 1024 + 16 * lane;
        f32x4 v[4]; float am = 0.f;
#pragma unroll
        for (int k = 0; k < 4; ++k) { v[k] = *(const f32x4*)(sp + 4 * k); am = fmaxf(am, fmaxf(fmaxf(fabsf(v[k][0]), fabsf(v[k][1])), fmaxf(fabsf(v[k][2]), fabsf(v[k][3])))); }
#pragma unroll
        for (int o = 32; o > 0; o >>= 1) am = fmaxf(am, __shfl_xor(am, o));
        const float sc = am > 0.f ? am * (1.f / 416.f) : 1.f, inv = am > 0.f ? 416.f / am : 0.f;
        u32x4 o4;
#pragma unroll
        for (int k = 0; k < 4; ++k) { int p = __builtin_amdgcn_cvt_pk_fp8_f32(v[k][0] * inv, v[k][1] * inv, 0, false); p = __builtin_amdgcn_cvt_pk_fp8_f32(v[k][2] * inv, v[k][3] * inv, p, true); o4[k] = (unsigned)p; }
        *(u32x4*)(dst + (size_t)row * 1024 + 16 * lane) = o4;
        if (lane == 0) scales[row] = sc;
    }
}
struct Inputs {
    const float *x, *c, *ctx, *c_ctx, *ada_w, *ada_b, *norm1_g, *norm2_g, *w_in, *gqa_qn_g, *gqa_kn_g, *pool_w, *pool_scale, *mla_qn_g, *mla_kvn_g, *mla_w_uq, *mla_w_ukv, *w_out, *peer_wq, *peer_subkeys, *peer_u, *peer_v, *final_g;
};
__device__ __forceinline__ void phase_cvt(LAS unsigned char* lds, const Inputs& in, const WS& w, int vb, int nvb) {
    LAS float* tile = (LAS float*)lds;
    for (int l = 0; l < 2; ++l) {
        cvt_job(tile, CvtJob{in.w_in + (size_t)l * 1024 * INC, w.WinT + (size_t)l * 1792 * 1024, nullptr, 1024, INC, 1792, 0}, vb, nvb);
        cvt_job(tile, CvtJob{in.mla_w_uq + (size_t)l * 384 * 576, w.WuqT + (size_t)l * 768 * 384, in.mla_qn_g + l * 384, 384, 576, 768, 1}, vb, nvb);
        cvt_job(tile, CvtJob{in.mla_w_ukv + (size_t)l * 256 * 768, w.WukvT + (size_t)l * 768 * 256, in.mla_kvn_g + l * 256, 256, 768, 768, 2}, vb, nvb);
        cvt_job(tile, CvtJob{in.w_out + (size_t)l * 1024 * 1024, w.WoutT + (size_t)l * 1024 * 1024, nullptr, 1024, 1024, 1024, 3}, vb, nvb);
        cvt_job(tile, CvtJob{in.peer_wq + (size_t)l * 1024 * 2048, w.WqT + (size_t)l * 2048 * 1024, nullptr, 1024, 2048, 2048, 3}, vb, nvb);
    }
    cvt_flat(in.peer_subkeys, w.SubK, (size_t)2 * 16 * 128 * 128, vb, nvb);
    cvt_fp8_rows(in.peer_u, w.U8, w.US, 2 * NE, vb, nvb);
    cvt_fp8_rows(in.peer_v, w.V8, w.VS, 2 * NE, vb, nvb);
}

struct EpiIn {
    static constexpr bool PERM = true;
    WS w; const float* qn_g; const float* kn_g; int pm_base;
    __device__ __forceinline__ void operator()(const f32x4 (&acc)[2][2][4][2], const pg8::Unit& u, int wr, int wc, int fr, int fq) const {
        int type, sub; in_group(4 * u.pn + wc, type, sub);
        if (type == GT_PAD) return;
        const int pm = u.pm + pm_base; const bool isctx = pm >= 256; const int b = isctx ? pm - 256 : pm >> 3; const int t0 = isctx ? 0 : (pm & 7) * 256;
        const size_t rowbase = isctx ? (size_t)NL + (size_t)b * CTX : (size_t)b * S;
        const int keyoff = isctx ? 0 : CTX;
        float gain[2][8];
        if (type == GT_AQ) {
#pragma unroll
            for (int bj = 0; bj < 2; ++bj)
#pragma unroll
                for (int q = 0; q < 8; ++q) gain[bj][q] = qn_g[32 * bj + 8 * fq + q];
        } else if (type == GT_AK) {
#pragma unroll
            for (int bj = 0; bj < 2; ++bj)
#pragma unroll
                for (int q = 0; q < 8; ++q) gain[bj][q] = kn_g[32 * bj + 8 * fq + q];
        }
#pragma unroll
        for (int ai = 0; ai < 2; ++ai)
#pragma unroll
            for (int m = 0; m < 4; ++m) {
                const int t = t0 + 128 * ai + 64 * wr + 16 * m + fr; const size_t row = rowbase + t;
                float v[2][8];
#pragma unroll
                for (int bj = 0; bj < 2; ++bj)
#pragma unroll
                    for (int n = 0; n < 2; ++n)
#pragma unroll
                        for (int i = 0; i < 4; ++i) v[bj][4 * n + i] = acc[ai][bj][m][n][i];
                bf16_t* dst = nullptr;
                if (type == GT_AQ || type == GT_AK) {
                    float ss = 0.f;
#pragma unroll
                    for (int bj = 0; bj < 2; ++bj)
#pragma unroll
                        for (int q = 0; q < 8; ++q) ss += v[bj][q] * v[bj][q];
                    ss += __shfl_xor(ss, 16); ss += __shfl_xor(ss, 32);
                    const float rstd = rsqrtf(ss * (1.f / 64.f) + EPS);
#pragma unroll
                    for (int q = 0; q < 8; ++q) { float x1 = v[0][q] * rstd * gain[0][q], x2 = v[1][q] * rstd * gain[1][q];
                        if (!isctx) { const float2 cs = w.ROPA[t * 32 + 8 * fq + q]; const float y1 = x1 * cs.x - x2 * cs.y, y2 = x1 * cs.y + x2 * cs.x; x1 = y1; x2 = y2; }
                        v[0][q] = x1; v[1][q] = x2; }
                    if (type == GT_AQ) dst = isctx ? w.Qgc + (((size_t)b * 6 + sub) * CTX + t) * 64 : w.Qg + (((size_t)b * 6 + sub) * S + t) * 64;
                    else dst = w.Kg + (((size_t)b * 2 + sub) * KEYS + keyoff + t) * 64;
                } else if (type == GT_AV) { dst = w.Vg + (((size_t)b * 2 + sub) * KEYS + keyoff + t) * 64;
                } else if (type == GT_B) { dst = w.Bp + row * 256 + 64 * sub;
                } else if (type == GT_CQ || type == GT_CKV) {
                    float ss = 0.f;
#pragma unroll
                    for (int bj = 0; bj < 2; ++bj)
#pragma unroll
                        for (int q = 0; q < 8; ++q) ss += v[bj][q] * v[bj][q];
                    ss += __shfl_xor(ss, 16); ss += __shfl_xor(ss, 32);
                    if (type == GT_CQ) { if (fq == 0) w.SSQ[row * 8 + sub] = ss; dst = w.CQ + row * 384 + 64 * sub; }
                    else { if (fq == 0) w.SSKV[row * 4 + sub] = ss; dst = w.CKV + row * 256 + 64 * sub; }
                } else {
                    if (!isctx) {
#pragma unroll
                        for (int q = 0; q < 8; ++q) { const float2 cs = w.ROPC[t * 16 + ((8 * fq + q) & 15)]; const float x1 = v[0][q], x2 = v[1][q]; v[0][q] = x1 * cs.x - x2 * cs.y; v[1][q] = x1 * cs.y + x2 * cs.x; } }
                    if (fq < 2) { bf16_t* kd = w.KR + ((size_t)b * KEYS + keyoff + t) * 32;
#pragma unroll
                        for (int bj = 0; bj < 2; ++bj) { u32x4 o; o.x = cvt_pk_bf16(v[bj][0], v[bj][1]); o.y = cvt_pk_bf16(v[bj][2], v[bj][3]); o.z = cvt_pk_bf16(v[bj][4], v[bj][5]); o.w = cvt_pk_bf16(v[bj][6], v[bj][7]);
                            *(u32x4*)(kd + 16 * bj + 8 * fq) = o; } }
                    continue;
                }
#pragma unroll
                for (int bj = 0; bj < 2; ++bj) { u32x4 o; o.x = cvt_pk_bf16(v[bj][0], v[bj][1]); o.y = cvt_pk_bf16(v[bj][2], v[bj][3]); o.z = cvt_pk_bf16(v[bj][4], v[bj][5]); o.w = cvt_pk_bf16(v[bj][6], v[bj][7]);
                    *(u32x4*)(dst + 32 * bj + 8 * fq) = o; }
            }
    }
};
struct P1Order {
    pg8::StaticOrder so; int nctx_tiles, G, c;
    __device__ bool next(int i, pg8::Unit& u) const {
        const int L = i * G + c;
        if (L < 1792) return so.next(i, u);
        const int Lc = L - 1792; if (Lc >= 32 * nctx_tiles) return false;
        u.pm = 256 + (Lc & 31); u.pn = Lc >> 5; return true;
    }
};
__device__ __forceinline__ void phase_p1(LAS unsigned char* lds, const WS& w, const Inputs& in, int l, int vb, int nvb) {
    EpiIn E{w, in.gqa_qn_g + l * 64, in.gqa_kn_g + l * 64, 0};
    P1Order po; po.so.init(NL, 1792, nvb, vb); po.nctx_tiles = (l == 0) ? 7 : 3; po.G = nvb; po.c = vb;
    pg8::gemm_phase(lds, pg8::Gemm{w.H, w.WinT + (size_t)l * 1792 * 1024, NR, 1792, 1024}, po, E);
}

extern __shared__ __attribute__((aligned(16))) unsigned char dyn_lds[];
__global__ void __launch_bounds__(512, 2) k_cvt(Inputs in, WS w) { phase_cvt((LAS unsigned char*)dyn_lds, in, w, blockIdx.x, gridDim.x); }
__global__ void __launch_bounds__(512, 2) k_p1(Inputs in, WS w, int l) { phase_p1((LAS unsigned char*)dyn_lds, w, in, l, blockIdx.x, gridDim.x); }

struct EpiUq {
    static constexpr bool PERM = true;
    WS w;
    __device__ __forceinline__ void operator()(const f32x4 (&acc)[2][2][4][2], const pg8::Unit& u, int wr, int wc, int fr, int fq) const {
        const int g = 4 * u.pn + wc; if (g >= 9) return;
        const int pm = u.pm; const bool isctx = pm >= 256; const int b = isctx ? pm - 256 : pm >> 3; const int t0 = isctx ? 0 : (pm & 7) * 256;
        const size_t rowbase = isctx ? (size_t)NL + (size_t)b * CTX : (size_t)b * S;
        const int head = g < 6 ? g : 2 * (g - 6) + (fq >> 1);
#pragma unroll
        for (int ai = 0; ai < 2; ++ai)
#pragma unroll
            for (int m = 0; m < 4; ++m) {
                const int t = t0 + 128 * ai + 64 * wr + 16 * m + fr; const size_t row = rowbase + t;
                const float4 s0 = *(const float4*)(w.SSQ + row * 8), s1 = *(const float4*)(w.SSQ + row * 8 + 4);
                const float rstd = rsqrtf((s0.x + s0.y + s0.z + s0.w + s1.x + s1.y) * (1.f / 384.f) + EPS);
                float v[2][8];
#pragma unroll
                for (int bj = 0; bj < 2; ++bj)
#pragma unroll
                    for (int n = 0; n < 2; ++n)
#pragma unroll
                        for (int i = 0; i < 4; ++i) v[bj][4 * n + i] = acc[ai][bj][m][n][i] * rstd;
                bf16_t* hd = isctx ? w.Qmc + (((size_t)b * 6 + head) * CTX + t) * 96 : w.Qm + (((size_t)b * 6 + head) * S + t) * 96;
                if (g >= 6 && !isctx) {
#pragma unroll
                    for (int q = 0; q < 8; ++q) { const float2 cs = w.ROPC[t * 16 + 8 * (fq & 1) + q]; const float x1 = v[0][q], x2 = v[1][q]; v[0][q] = x1 * cs.x - x2 * cs.y; v[1][q] = x1 * cs.y + x2 * cs.x; } }
#pragma unroll
                for (int bj = 0; bj < 2; ++bj) { u32x4 o; o.x = cvt_pk_bf16(v[bj][0], v[bj][1]); o.y = cvt_pk_bf16(v[bj][2], v[bj][3]); o.z = cvt_pk_bf16(v[bj][4], v[bj][5]); o.w = cvt_pk_bf16(v[bj][6], v[bj][7]);
                    bf16_t* d = g < 6 ? hd + 32 * bj + 8 * fq : hd + 64 + 16 * bj + 8 * (fq & 1);
                    *(u32x4*)d = o; }
            }
    }
};
struct EpiUkv {
    static constexpr bool PERM = true;
    WS w;
    __device__ __forceinline__ void operator()(const f32x4 (&acc)[2][2][4][2], const pg8::Unit& u, int wr, int wc, int fr, int fq) const {
        const int g = 4 * u.pn + wc;
        const int pm = u.pm; const bool isctx = pm >= 256; const int b = isctx ? pm - 256 : pm >> 3; const int t0 = isctx ? 0 : (pm & 7) * 256;
        const size_t rowbase = isctx ? (size_t)NL + (size_t)b * CTX : (size_t)b * S; const int keyoff = isctx ? 0 : CTX;
        bf16_t* base = ((g & 1) ? w.Vm : w.Kmn) + ((size_t)b * 6 + (g >> 1)) * KEYS * 64;
#pragma unroll
        for (int ai = 0; ai < 2; ++ai)
#pragma unroll
            for (int m = 0; m < 4; ++m) {
                const int t = t0 + 128 * ai + 64 * wr + 16 * m + fr; const size_t row = rowbase + t;
                const float4 s0 = *(const float4*)(w.SSKV + row * 4);
                const float rstd = rsqrtf((s0.x + s0.y + s0.z + s0.w) * (1.f / 256.f) + EPS);
                bf16_t* d = base + (size_t)(keyoff + t) * 64;
#pragma unroll
                for (int bj = 0; bj < 2; ++bj) { const f32x4 a0 = acc[ai][bj][m][0] * rstd, a1 = acc[ai][bj][m][1] * rstd;
                    u32x4 o; o.x = cvt_pk_bf16(a0[0], a0[1]); o.y = cvt_pk_bf16(a0[2], a0[3]); o.z = cvt_pk_bf16(a1[0], a1[1]); o.w = cvt_pk_bf16(a1[2], a1[3]);
                    *(u32x4*)(d + 32 * bj + 8 * fq) = o; }
            }
    }
};
__device__ __forceinline__ void phase_pool(LAS unsigned char* lds, const WS& w, bf16_t* __restrict__ MIX, const float* __restrict__ pool_w, const float* __restrict__ pool_scale, int nrows, int vb, int nvb) {
    const int tid = threadIdx.x, lane = tid & 63, wid = tid >> 6, g = lane >> 4;
    LAS float* pl = (LAS float*)lds + wid * 256;
    const int wdw = 2 << g;
    for (int row = vb * 8 + wid; row < nrows; row += nvb * 8) {
        const bool isctx = row >= NL; const int L = isctx ? CTX : S; const int t = isctx ? (row - NL) % CTX : row % S; const int base = row - t;
        int lo = t - wdw / 2, hi = t - wdw / 2 + wdw; lo = lo < 0 ? 0 : lo; hi = hi > L ? L : hi;
        float s0 = 0.f, s1 = 0.f, s2 = 0.f, s3 = 0.f;
        for (int uu = lo; uu < hi; ++uu) { const uint2 raw = *(const uint2*)(w.Bp + (size_t)(base + uu) * 256 + 4 * lane);
            s0 += __uint_as_float(raw.x << 16); s1 += __uint_as_float(raw.x & 0xffff0000u); s2 += __uint_as_float(raw.y << 16); s3 += __uint_as_float(raw.y & 0xffff0000u); }
        const uint2 self = *(const uint2*)(w.Bp + (size_t)row * 256 + 4 * lane); const float ic = 1.f / (float)(hi - lo);
        f32x4 pv; pv[0] = s0 * ic - __uint_as_float(self.x << 16); pv[1] = s1 * ic - __uint_as_float(self.x & 0xffff0000u); pv[2] = s2 * ic - __uint_as_float(self.y << 16); pv[3] = s3 * ic - __uint_as_float(self.y & 0xffff0000u);
        *(LAS f32x4*)(pl + 4 * lane) = pv;
        __syncthreads();
        const int d0 = (lane & 15) * 4; const float* wg = pool_w + (size_t)g * 4096 + d0;
        f32x4 a = (f32x4){0.f, 0.f, 0.f, 0.f};
#pragma unroll 8
        for (int cc = 0; cc < 64; ++cc) { const float p = pl[g * 64 + cc]; const f32x4 wv = *(const f32x4*)(wg + cc * 64); a += p * wv; }
        const f32x4 sc = *(const f32x4*)(pool_scale + g * 64 + d0);
        u32x2 o; o.x = cvt_pk_bf16(a[0] * sc[0], a[1] * sc[1]); o.y = cvt_pk_bf16(a[2] * sc[2], a[3] * sc[3]);
        *(u32x2*)(MIX + (size_t)row * 1024 + 384 + g * 64 + d0) = o;
        __syncthreads();
    }
}
__device__ __forceinline__ void phase_p2(LAS unsigned char* lds, const WS& w, const Inputs& in, int l, int vb, int nvb) {
    pg8::StaticOrder so;
    { EpiUq E{w}; const int M = l == 0 ? NR : NL; so.init(M, 768, nvb, vb); pg8::gemm_phase(lds, pg8::Gemm{w.CQ, w.WuqT + (size_t)l * 768 * 384, M, 768, 384}, so, E); }
    { EpiUkv E{w}; so.init(NR, 768, nvb, vb); pg8::gemm_phase(lds, pg8::Gemm{w.CKV, w.WukvT + (size_t)l * 768 * 256, NR, 768, 256}, so, E); }
    phase_pool(lds, w, w.H, in.pool_w + (size_t)l * 4 * 64 * 64, in.pool_scale + l * 256, l == 0 ? NR : NL, vb, nvb);
}

struct EpiOut {
    static constexpr bool PERM = false;
    const float* xin_l; const float* xin_c; float* xout_l; float* xout_c; const float* gate;
    __device__ __forceinline__ void operator()(const f32x4 (&acc)[2][2][4][2], const pg8::Unit& u, int wr, int wc, int fr, int fq) const {
        const int pm = u.pm; const bool isctx = pm >= 256; const int mr = isctx ? 32 : pm >> 3;
        const size_t r0 = (isctx ? (size_t)(pm - 256) * 256 : (size_t)pm * 256) + wr * 64 + fr;
        const float* xi = isctx ? xin_c : xin_l; float* xo = isctx ? xout_c : xout_l;
        const int col0 = u.pn * 256 + wc * 32 + 4 * fq;
        f32x4 gv[2][2];
#pragma unroll
        for (int bj = 0; bj < 2; ++bj)
#pragma unroll
            for (int n = 0; n < 2; ++n) gv[bj][n] = *(const f32x4*)(gate + (size_t)mr * 6144 + col0 + bj * 128 + n * 16);
#pragma unroll
        for (int ai = 0; ai < 2; ++ai)
#pragma unroll
            for (int m = 0; m < 4; ++m) { const size_t off = (r0 + ai * 128 + m * 16) * 1024 + col0;
#pragma unroll
                for (int bj = 0; bj < 2; ++bj)
#pragma unroll
                    for (int n = 0; n < 2; ++n) { const f32x4 xv = *(const f32x4*)(xi + off + bj * 128 + n * 16); *(f32x4*)(xo + off + bj * 128 + n * 16) = xv + gv[bj][n] * acc[ai][bj][m][n]; } }
    }
};
__device__ __forceinline__ void phase_p4(LAS unsigned char* lds, const WS& w, const Inputs& in, float* XL, int l, int vb, int nvb) {
    const float* MODl = w.MOD + (size_t)l * 33 * 6144;
    EpiOut E{l == 0 ? in.x : XL, l == 0 ? in.ctx : w.XC, XL, w.XC, MODl + 2 * 1024};
    const int M = l == 0 ? NR : NL;
    pg8::StaticOrder so; so.init(M, 1024, nvb, vb);
    pg8::gemm_phase(lds, pg8::Gemm{w.H, w.WoutT + (size_t)l * 1024 * 1024, M, 1024, 1024}, so, E);
}

__device__ __forceinline__ void phase_modulate(const float* __restrict__ XLp, const float* __restrict__ XCp, bf16_t* __restrict__ Hout, const float* __restrict__ g, const float* __restrict__ MODl, int si, int nrows, int vb, int nvb) {
    const int tid = threadIdx.x, lane = tid & 63, wid = tid >> 6;
    f32x4 gv[4];
#pragma unroll
    for (int i = 0; i < 4; ++i) gv[i] = *(const f32x4*)(g + 256 * i + 4 * lane);
    for (int row = vb * 8 + wid; row < nrows; row += nvb * 8) {
        const bool isctx = row >= NL; const float* xp = isctx ? XCp + (size_t)(row - NL) * 1024 : XLp + (size_t)row * 1024; const int mr = isctx ? 32 : row / S;
        f32x4 x[4]; float ss = 0.f;
#pragma unroll
        for (int i = 0; i < 4; ++i) { x[i] = *(const f32x4*)(xp + 256 * i + 4 * lane); ss += x[i][0] * x[i][0] + x[i][1] * x[i][1] + x[i][2] * x[i][2] + x[i][3] * x[i][3]; }
        ss = wave_sum(ss); const float rstd = rsqrtf(ss * (1.f / 1024.f) + EPS);
        const float* sh = MODl + (size_t)mr * 6144 + si * 1024;
#pragma unroll
        for (int i = 0; i < 4; ++i) { const f32x4 shv = *(const f32x4*)(sh + 256 * i + 4 * lane), scv = *(const f32x4*)(sh + 1024 + 256 * i + 4 * lane);
            const f32x4 y = x[i] * rstd * gv[i] * (scv + 1.f) + shv;
            u32x2 o; o.x = cvt_pk_bf16(y[0], y[1]); o.y = cvt_pk_bf16(y[2], y[3]);
            *(u32x2*)(Hout + (size_t)row * 1024 + 256 * i + 4 * lane) = o; }
    }
}

struct EpiPQ {
    static constexpr bool PERM = true;
    bf16_t* PQ;
    __device__ __forceinline__ void operator()(const f32x4 (&acc)[2][2][4][2], const pg8::Unit& u, int wr, int wc, int fr, int fq) const {
        const size_t r0 = (size_t)u.pm * 256 + wr * 64 + fr; const int col0 = u.pn * 256 + wc * 32 + 8 * fq;
#pragma unroll
        for (int ai = 0; ai < 2; ++ai)
#pragma unroll
            for (int m = 0; m < 4; ++m) { bf16_t* d = PQ + (r0 + ai * 128 + m * 16) * 2048 + col0;
#pragma unroll
                for (int bj = 0; bj < 2; ++bj) { const f32x4 a0 = acc[ai][bj][m][0], a1 = acc[ai][bj][m][1];
                    u32x4 o; o.x = cvt_pk_bf16(a0[0], a0[1]); o.y = cvt_pk_bf16(a0[2], a0[3]); o.z = cvt_pk_bf16(a1[0], a1[1]); o.w = cvt_pk_bf16(a1[2], a1[3]);
                    *(u32x4*)(d + bj * 128) = o; } }
    }
};
__device__ __forceinline__ void phase_p6a(LAS unsigned char* lds, const WS& w, int l, int vb, int nvb) {
    EpiPQ E{w.PQ}; const int M = l == 0 ? NR : NL;
    pg8::StaticOrder so; so.init(M, 2048, nvb, vb);
    pg8::gemm_phase(lds, pg8::Gemm{w.H, w.WqT + (size_t)l * 2048 * 1024, M, 2048, 1024}, so, E);
}

__global__ void __launch_bounds__(512, 2) k_p2(Inputs in, WS w, int l) { phase_p2((LAS unsigned char*)dyn_lds, w, in, l, blockIdx.x, gridDim.x); }
__global__ void __launch_bounds__(512, 2) k_p4(Inputs in, WS w, float* XL, int l) { phase_p4((LAS unsigned char*)dyn_lds, w, in, XL, l, blockIdx.x, gridDim.x); }
__global__ void __launch_bounds__(512, 2) k_p5(WS w, const float* XL, const float* g, const float* MODl, int si, int nrows) { phase_modulate(XL, w.XC, w.H, g, MODl, si, nrows, blockIdx.x, gridDim.x); }
__global__ void __launch_bounds__(512, 2) k_p6a(WS w, int l) { phase_p6a((LAS unsigned char*)dyn_lds, w, l, blockIdx.x, gridDim.x); }

using bf16x2_t = __attribute__((ext_vector_type(2))) __bf16;
typedef float f32x2 __attribute__((ext_vector_type(2)));
__device__ __forceinline__ float gelu_fast(float x) {
    const float u2 = 1.5957691216057308f * (x + 0.044715f * x * x * x);
    return x * __builtin_amdgcn_rcpf(1.f + __builtin_amdgcn_exp2f(-1.4426950408889634f * u2));
}
#define DPPF(v, ctrl) __builtin_bit_cast(float, __builtin_amdgcn_update_dpp(0, __builtin_bit_cast(int, (v)), (ctrl), 0xf, 0xf, true))
__device__ __forceinline__ float reduce8(float p0, float p1, float p2, float p3, float p4, float p5, float p6, float p7, int lane) {
    auto s01 = __builtin_amdgcn_permlane32_swap(__float_as_uint(p0), __float_as_uint(p1), false, false);
    auto s23 = __builtin_amdgcn_permlane32_swap(__float_as_uint(p2), __float_as_uint(p3), false, false);
    auto s45 = __builtin_amdgcn_permlane32_swap(__float_as_uint(p4), __float_as_uint(p5), false, false);
    auto s67 = __builtin_amdgcn_permlane32_swap(__float_as_uint(p6), __float_as_uint(p7), false, false);
    const float q0 = __uint_as_float(s01[0]) + __uint_as_float(s01[1]), q1 = __uint_as_float(s23[0]) + __uint_as_float(s23[1]);
    const float q2 = __uint_as_float(s45[0]) + __uint_as_float(s45[1]), q3 = __uint_as_float(s67[0]) + __uint_as_float(s67[1]);
    auto t0 = __builtin_amdgcn_permlane16_swap(__float_as_uint(q0), __float_as_uint(q1), false, false);
    auto t1 = __builtin_amdgcn_permlane16_swap(__float_as_uint(q2), __float_as_uint(q3), false, false);
    float r0 = __uint_as_float(t0[0]) + __uint_as_float(t0[1]);
    float r1 = __uint_as_float(t1[0]) + __uint_as_float(t1[1]);
    r0 += DPPF(r0, 0x128); r1 += DPPF(r1, 0x128);
    float z = (lane & 8) ? r1 : r0;
    z += DPPF(z, 0x141);
    z += DPPF(z, 0xB1);
    z += DPPF(z, 0x4E);
    return z;
}
struct P7Args {
    const bf16_t* H2; const unsigned* EG; const unsigned char* U8; const unsigned char* V8; const float* US; const float* VS;
    float* XL; float* XC; const float* gate2;
    int nrows;
    int mode;
    bf16_t* Hnext; const float* gnext; const float* MODnext;
    const float* final_g;
};
__device__ __forceinline__ float reduce4(float p0, float p1, float p2, float p3) {
    auto s01 = __builtin_amdgcn_permlane32_swap(__float_as_uint(p0), __float_as_uint(p1), false, false);
    auto s23 = __builtin_amdgcn_permlane32_swap(__float_as_uint(p2), __float_as_uint(p3), false, false);
    const float q0 = __uint_as_float(s01[0]) + __uint_as_float(s01[1]), q1 = __uint_as_float(s23[0]) + __uint_as_float(s23[1]);
    auto s = __builtin_amdgcn_permlane16_swap(__float_as_uint(q0), __float_as_uint(q1), false, false);
    float r = __uint_as_float(s[0]) + __uint_as_float(s[1]);
    r += DPPF(r, 0x128); r += DPPF(r, 0x124); r += DPPF(r, 0x122); r += DPPF(r, 0x121);
    return r;
}
#define P7_EID(c, j) ((int)(__builtin_amdgcn_readlane((int)((c) < 16 ? eg : eg2), (4 * (c) + (j)) & 63) >> 16) & 0xffff)
#define P7_LOADS(BUF, c) do { _Pragma("unroll") for (int j_ = 0; j_ < 4; ++j_) { const size_t e_ = (size_t)P7_EID(c, j_) * 1024 + 16 * lane; \
        BUF##u[j_] = *(const u32x4*)(a.U8 + e_); BUF##v[j_] = *(const u32x4*)(a.V8 + e_); } } while (0)
__device__ __forceinline__ float p7_dot(const u32x4 u, const float (&h)[16]) {
    float s = 0.f;
#pragma unroll
    for (int k = 0; k < 4; ++k) { const f32x2 lo = __builtin_amdgcn_cvt_pk_f32_fp8((int)u[k], false), hi2 = __builtin_amdgcn_cvt_pk_f32_fp8((int)u[k], true);
        s = __builtin_fmaf(lo.x, h[4 * k], s); s = __builtin_fmaf(lo.y, h[4 * k + 1], s); s = __builtin_fmaf(hi2.x, h[4 * k + 2], s); s = __builtin_fmaf(hi2.y, h[4 * k + 3], s); }
    return s;
}
__device__ __forceinline__ void p7_axpy(const u32x4 v, float wj, float (&out)[16]) {
#pragma unroll
    for (int k = 0; k < 4; ++k) { const f32x2 lo = __builtin_amdgcn_cvt_pk_f32_fp8((int)v[k], false), hi2 = __builtin_amdgcn_cvt_pk_f32_fp8((int)v[k], true);
        out[4 * k] = __builtin_fmaf(wj, lo.x, out[4 * k]); out[4 * k + 1] = __builtin_fmaf(wj, lo.y, out[4 * k + 1]); out[4 * k + 2] = __builtin_fmaf(wj, hi2.x, out[4 * k + 2]); out[4 * k + 3] = __builtin_fmaf(wj, hi2.y, out[4 * k + 3]); }
}
#define P7_RL(x, l) __builtin_bit_cast(float, __builtin_amdgcn_readlane(__builtin_bit_cast(int, (x)), (l)))
#define P7_COMPUTE(BUF, c) do { \
    const float r_ = reduce4(p7_dot(BUF##u[0], h), p7_dot(BUF##u[1], h), p7_dot(BUF##u[2], h), p7_dot(BUF##u[3], h)); \
    const unsigned ege_ = (unsigned)__shfl((int)((c) < 16 ? eg : eg2), (4 * (c) + myk) & 63); const int eid_ = (int)(ege_ >> 16); \
    const float w_ = __uint_as_float(ege_ << 16) * gelu_fast(r_ * a.US[eid_]) * a.VS[eid_]; \
      \
    p7_axpy(BUF##v[0], P7_RL(w_, 0), out); p7_axpy(BUF##v[1], P7_RL(w_, 32), out); p7_axpy(BUF##v[2], P7_RL(w_, 16), out); p7_axpy(BUF##v[3], P7_RL(w_, 48), out); } while (0)

__device__ __forceinline__ void phase_p7(const P7Args& a, int vb, int nvb) {
    int tid_ = threadIdx.x; asm volatile("" : "+v"(tid_));
    const int lane = tid_ & 63, wid = __builtin_amdgcn_readfirstlane(tid_ >> 6);
    const int myk = (((lane >> 4) & 1) << 1) | (lane >> 5);
    for (int row = vb * 8 + wid; row < a.nrows; row += nvb * 8) {
        const bool isctx = row >= NL; float* xp = (isctx ? a.XC + (size_t)(row - NL) * 1024 : a.XL + (size_t)row * 1024) + 16 * lane; const int mr = isctx ? 32 : row / S;
        float h[16];
        { const u32x4 h0 = *(const u32x4*)(a.H2 + (size_t)row * 1024 + 16 * lane), h1 = *(const u32x4*)(a.H2 + (size_t)row * 1024 + 16 * lane + 8);
#pragma unroll
          for (int k = 0; k < 4; ++k) { h[2 * k] = __uint_as_float(h0[k] << 16); h[2 * k + 1] = __uint_as_float(h0[k] & 0xffff0000u); h[8 + 2 * k] = __uint_as_float(h1[k] << 16); h[8 + 2 * k + 1] = __uint_as_float(h1[k] & 0xffff0000u); } }
        const unsigned eg = a.EG[(size_t)row * 128 + lane], eg2 = a.EG[(size_t)row * 128 + 64 + lane];
        float out[16];
#pragma unroll
        for (int r = 0; r < 16; ++r) out[r] = 0.f;
        u32x4 Au[4], Av[4], Bu[4], Bv[4];
        P7_LOADS(A, 0);
#pragma unroll 1
        for (int c = 0; c < 32; c += 2) {
            P7_LOADS(B, c + 1);
            P7_COMPUTE(A, c);
            if (c + 2 < 32) P7_LOADS(A, c + 2);
            P7_COMPUTE(B, c + 1);
        }
        const float* gp = a.gate2 + (size_t)mr * 6144 + 16 * lane;
        f32x4 xv[4]; float ss = 0.f;
#pragma unroll
        for (int k = 0; k < 4; ++k) { const f32x4 x0 = *(const f32x4*)(xp + 4 * k), g0 = *(const f32x4*)(gp + 4 * k);
            f32x4 o; o[0] = out[4 * k]; o[1] = out[4 * k + 1]; o[2] = out[4 * k + 2]; o[3] = out[4 * k + 3];
            xv[k] = x0 + g0 * o; ss += xv[k][0] * xv[k][0] + xv[k][1] * xv[k][1] + xv[k][2] * xv[k][2] + xv[k][3] * xv[k][3]; }
        if (a.mode != 2) {
#pragma unroll
            for (int k = 0; k < 4; ++k) *(f32x4*)(xp + 4 * k) = xv[k];
        }
        if (a.mode != 0) {
            ss = wave_sum(ss); const float rstd = rsqrtf(ss * (1.f / 1024.f) + EPS);
            if (a.mode == 2) {
#pragma unroll
                for (int k = 0; k < 4; ++k) *(f32x4*)(xp + 4 * k) = xv[k] * rstd * *(const f32x4*)(a.final_g + 16 * lane + 4 * k);
            } else {
                const float* sh = a.MODnext + (size_t)mr * 6144 + 16 * lane; f32x4 y[4];
#pragma unroll
                for (int k = 0; k < 4; ++k) y[k] = xv[k] * rstd * *(const f32x4*)(a.gnext + 16 * lane + 4 * k) * (*(const f32x4*)(sh + 1024 + 4 * k) + 1.f) + *(const f32x4*)(sh + 4 * k);
                u32x4 o0, o1; o0.x = cvt_pk_bf16(y[0][0], y[0][1]); o0.y = cvt_pk_bf16(y[0][2], y[0][3]); o0.z = cvt_pk_bf16(y[1][0], y[1][1]); o0.w = cvt_pk_bf16(y[1][2], y[1][3]);
                o1.x = cvt_pk_bf16(y[2][0], y[2][1]); o1.y = cvt_pk_bf16(y[2][2], y[2][3]); o1.z = cvt_pk_bf16(y[3][0], y[3][1]); o1.w = cvt_pk_bf16(y[3][2], y[3][3]);
                *(u32x4*)(a.Hnext + (size_t)row * 1024 + 16 * lane) = o0; *(u32x4*)(a.Hnext + (size_t)row * 1024 + 16 * lane + 8) = o1;
            }
        }
    }
}
__global__ void __launch_bounds__(512, 2) k_p7(P7Args a) { phase_p7(a, blockIdx.x, gridDim.x); }

typedef short s16x4 __attribute__((ext_vector_type(4)));
__device__ __forceinline__ s16x4 lds_tr16(const LAS unsigned char* p) { return __builtin_bit_cast(s16x4, __builtin_amdgcn_ds_read_tr16_b64_v4i16((LAS s16x4*)p)); }
__device__ __forceinline__ f32x16 mfma32(bf16x8 a, bf16x8 b, f32x16 c) { return __builtin_amdgcn_mfma_f32_32x32x16_bf16(a, b, c, 0, 0, 0); }
constexpr int ATT_BUF = 20480;
template <int DK>
__device__ __forceinline__ void attn_unit(LAS unsigned char* lds, const bf16_t* __restrict__ Q, const bf16_t* __restrict__ K1, const bf16_t* __restrict__ K2, const bf16_t* __restrict__ V,
                                          int nkeys, float c2, bf16_t* __restrict__ out) {
    int tid_ = threadIdx.x; asm volatile("" : "+v"(tid_));
    const int tid = tid_, lane = tid & 63, wid = __builtin_amdgcn_readfirstlane(tid >> 6), r32 = lane & 31, hi = lane >> 5;
    constexpr int NS = DK / 16;
    bf16x8 qf[NS];
    { const bf16_t* qp = Q + (size_t)(wid * 32 + r32) * DK + 8 * hi;
#pragma unroll
      for (int s = 0; s < NS; ++s) qf[s] = *(const bf16x8*)(qp + 16 * s); }
    const int skey = tid >> 3, sch = tid & 7;
    const unsigned st_k1 = skey * 128 + ((sch ^ ((skey >> 1) & 7)) << 4);
    const unsigned st_v = 8192 + skey * 128 + (((sch << 4)) ^ (((skey >> 1) & 1) << 6));
    const int skey2 = (tid & 255) >> 2, sch2 = tid & 3;
    const unsigned st_k2 = 16384 + skey2 * 64 + ((sch2 ^ ((skey2 >> 2) & 3)) << 4);
    const bf16_t* gk1 = K1 + (size_t)skey * 64 + sch * 8; const bf16_t* gv = V + (size_t)skey * 64 + sch * 8;
    const bf16_t* gk2 = (DK == 96) ? K2 + (size_t)skey2 * 32 + sch2 * 8 : nullptr;
    unsigned ka[2][4];
#pragma unroll
    for (int kt = 0; kt < 2; ++kt)
#pragma unroll
        for (int s = 0; s < 4; ++s) { const int key = 32 * kt + r32; ka[kt][s] = key * 128 + (((2 * s + hi) ^ ((key >> 1) & 7)) << 4); }
    unsigned kb[2][2];
#pragma unroll
    for (int kt = 0; kt < 2; ++kt)
#pragma unroll
        for (int s = 0; s < 2; ++s) { const int key = 32 * kt + r32; kb[kt][s] = 16384 + key * 64 + (((2 * s + hi) ^ ((key >> 2) & 3)) << 4); }
    const int vq = (lane & 15) >> 2, vp = lane & 3, vg = (lane >> 4) & 1;
    unsigned va[2];
#pragma unroll
    for (int dvb = 0; dvb < 2; ++dvb) { const int key = 4 * hi + vq; va[dvb] = 8192 + key * 128 + ((((32 * dvb + 16 * vg + 4 * vp) * 2)) ^ (((key >> 1) & 1) << 6)); }
    float m = -1e30f, l = 0.f;
    f32x16 o0 = {}, o1 = {};
    const int NT = nkeys >> 6;
    u32x4 sk1, sv, sk2;
    sk1 = *(const u32x4*)gk1; sv = *(const u32x4*)gv; if (DK == 96) { if (tid < 256) sk2 = *(const u32x4*)gk2; }
    *(LAS u32x4*)(lds + st_k1) = sk1; *(LAS u32x4*)(lds + st_v) = sv; if (DK == 96) { if (tid < 256) *(LAS u32x4*)(lds + st_k2) = sk2; }
    __syncthreads();
    for (int t = 0; t < NT; ++t) {
        LAS unsigned char* buf = lds + (t & 1) * ATT_BUF;
        if (t + 1 < NT) { sk1 = *(const u32x4*)(gk1 + (size_t)(t + 1) * 64 * 64); sv = *(const u32x4*)(gv + (size_t)(t + 1) * 64 * 64); if (DK == 96) { if (tid < 256) sk2 = *(const u32x4*)(gk2 + (size_t)(t + 1) * 64 * 32); } }
        f32x16 p0 = {}, p1 = {};
#pragma unroll
        for (int s = 0; s < 4; ++s) { p0 = mfma32(*(const LAS bf16x8*)(buf + ka[0][s]), qf[s], p0); p1 = mfma32(*(const LAS bf16x8*)(buf + ka[1][s]), qf[s], p1); }
        if (DK == 96) {
#pragma unroll
            for (int s = 0; s < 2; ++s) { p0 = mfma32(*(const LAS bf16x8*)(buf + kb[0][s]), qf[4 + s], p0); p1 = mfma32(*(const LAS bf16x8*)(buf + kb[1][s]), qf[4 + s], p1); }
        }
        float mx = p0[0];
#pragma unroll
        for (int r = 1; r < 16; ++r) mx = fmaxf(mx, p0[r]);
#pragma unroll
        for (int r = 0; r < 16; ++r) mx = fmaxf(mx, p1[r]);
        { auto rr = __builtin_amdgcn_permlane32_swap(__float_as_uint(mx), __float_as_uint(mx), false, false); mx = fmaxf(__uint_as_float(rr[0]), __uint_as_float(rr[1])); }
        const float tm = mx * c2;
        if (__any(tm > m + 8.f)) {
            const float mn = fmaxf(m, tm), al = __builtin_amdgcn_exp2f(m - mn); m = mn; l *= al;
#pragma unroll
            for (int r = 0; r < 16; ++r) { o0[r] *= al; o1[r] *= al; }
        }
        const float nm = -m; float ls = 0.f;
#pragma unroll
        for (int r = 0; r < 16; ++r) { p0[r] = __builtin_amdgcn_exp2f(__builtin_fmaf(p0[r], c2, nm)); p1[r] = __builtin_amdgcn_exp2f(__builtin_fmaf(p1[r], c2, nm)); ls += p0[r] + p1[r]; }
        l += ls;
        bf16x8 pf[2][2];
#pragma unroll
        for (int sp = 0; sp < 2; ++sp) { u32x4 a, b;
            a.x = cvt_pk_bf16(p0[8 * sp], p0[8 * sp + 1]); a.y = cvt_pk_bf16(p0[8 * sp + 2], p0[8 * sp + 3]); a.z = cvt_pk_bf16(p0[8 * sp + 4], p0[8 * sp + 5]); a.w = cvt_pk_bf16(p0[8 * sp + 6], p0[8 * sp + 7]);
            b.x = cvt_pk_bf16(p1[8 * sp], p1[8 * sp + 1]); b.y = cvt_pk_bf16(p1[8 * sp + 2], p1[8 * sp + 3]); b.z = cvt_pk_bf16(p1[8 * sp + 4], p1[8 * sp + 5]); b.w = cvt_pk_bf16(p1[8 * sp + 6], p1[8 * sp + 7]);
            pf[0][sp] = __builtin_bit_cast(bf16x8, a); pf[1][sp] = __builtin_bit_cast(bf16x8, b); }
#pragma unroll
        for (int kt = 0; kt < 2; ++kt)
#pragma unroll
            for (int sp = 0; sp < 2; ++sp) { const int kofs = (32 * kt + 16 * sp) * 128;
                { const s16x4 lo = lds_tr16(buf + va[0] + kofs), hi4 = lds_tr16(buf + va[0] + kofs + 8 * 128);
                  const bf16x8 vf = (bf16x8){lo[0], lo[1], lo[2], lo[3], hi4[0], hi4[1], hi4[2], hi4[3]}; o0 = mfma32(vf, pf[kt][sp], o0); }
                { const s16x4 lo = lds_tr16(buf + va[1] + kofs), hi4 = lds_tr16(buf + va[1] + kofs + 8 * 128);
                  const bf16x8 vf = (bf16x8){lo[0], lo[1], lo[2], lo[3], hi4[0], hi4[1], hi4[2], hi4[3]}; o1 = mfma32(vf, pf[kt][sp], o1); } }
        if (t + 1 < NT) { LAS unsigned char* nb = lds + ((t + 1) & 1) * ATT_BUF; *(LAS u32x4*)(nb + st_k1) = sk1; *(LAS u32x4*)(nb + st_v) = sv; if (DK == 96) { if (tid < 256) *(LAS u32x4*)(nb + st_k2) = sk2; } }
        __syncthreads();
    }
    { auto rr = __builtin_amdgcn_permlane32_swap(__float_as_uint(l), __float_as_uint(l), false, false); l = __uint_as_float(rr[0]) + __uint_as_float(rr[1]); }
    const float il = 1.f / l;
    bf16_t* op = out + (size_t)(wid * 32 + r32) * 1024 + 4 * hi;
#pragma unroll
    for (int g = 0; g < 4; ++g) { u32x2 a, b;
        a.x = cvt_pk_bf16(o0[4 * g] * il, o0[4 * g + 1] * il); a.y = cvt_pk_bf16(o0[4 * g + 2] * il, o0[4 * g + 3] * il);
        b.x = cvt_pk_bf16(o1[4 * g] * il, o1[4 * g + 1] * il); b.y = cvt_pk_bf16(o1[4 * g + 2] * il, o1[4 * g + 3] * il);
        *(u32x2*)(op + 8 * g) = a; *(u32x2*)(op + 32 + 8 * g) = b; }
}
__device__ __forceinline__ void phase_p3(LAS unsigned char* lds, const WS& w, int l, int vb, int nvb) {
    const float c2g = 0.125f * 1.4426950408889634f, c2m = 0.10206207261596577f * 1.4426950408889634f;
    bf16_t* MIX = w.H;
    const int nlat = NB * 12 * 8, nctx = (l == 0) ? NB * 12 : 0;
    for (int u = vb; u < nlat + nctx; u += nvb) {
        if (u < nlat) {
            const int qb = u & 7, slot = (u >> 3) % 12, b = u / 96;
            bf16_t* out = MIX + ((size_t)b * S + qb * 256) * 1024;
            if (slot < 6) attn_unit<64>(lds, w.Qg + (((size_t)b * 6 + slot) * S + qb * 256) * 64, w.Kg + ((size_t)b * 2 + slot / 3) * KEYS * 64, nullptr, w.Vg + ((size_t)b * 2 + slot / 3) * KEYS * 64, KEYS, c2g, out + slot * 64);
            else { const int h = slot - 6; attn_unit<96>(lds, w.Qm + (((size_t)b * 6 + h) * S + qb * 256) * 96, w.Kmn + ((size_t)b * 6 + h) * KEYS * 64, w.KR + (size_t)b * KEYS * 32, w.Vm + ((size_t)b * 6 + h) * KEYS * 64, KEYS, c2m, out + 640 + h * 64); }
        } else {
            const int v = u - nlat, slot = v % 12, b = v / 12;
            bf16_t* out = MIX + ((size_t)NL + (size_t)b * CTX) * 1024;
            if (slot < 6) attn_unit<64>(lds, w.Qgc + ((size_t)b * 6 + slot) * CTX * 64, w.Kg + ((size_t)b * 2 + slot / 3) * KEYS * 64, nullptr, w.Vg + ((size_t)b * 2 + slot / 3) * KEYS * 64, CTX, c2g, out + slot * 64);
            else { const int h = slot - 6; attn_unit<96>(lds, w.Qmc + ((size_t)b * 6 + h) * CTX * 96, w.Kmn + ((size_t)b * 6 + h) * KEYS * 64, w.KR + (size_t)b * KEYS * 32, w.Vm + ((size_t)b * 6 + h) * KEYS * 64, CTX, c2m, out + 640 + h * 64); }
        }
    }
}
__global__ void __launch_bounds__(512, 2) k_p3(WS w, int l) { phase_p3((LAS unsigned char*)dyn_lds, w, l, blockIdx.x, gridDim.x); }

__device__ __forceinline__ unsigned fkey(float f, unsigned tag, unsigned mask) { unsigned u = __float_as_uint(f); u = (u & 0x80000000u) ? ~u : (u | 0x80000000u); return (u & ~mask) | tag; }
__device__ __forceinline__ float keyf(unsigned k, unsigned mask) { k &= ~mask; const unsigned u = (k & 0x80000000u) ? (k & 0x7fffffffu) : ~k; return __uint_as_float(u); }
__device__ __forceinline__ void ce_desc(unsigned& a, unsigned& b) { const unsigned hi_ = a > b ? a : b, lo_ = a > b ? b : a; a = hi_; b = lo_; }
template <int J, int K> __device__ __forceinline__ void bstage16(unsigned* a) {
#pragma unroll
    for (int i = 0; i < 16; ++i) { const int l = i ^ J; if (l > i) { const unsigned x = a[i], y = a[l]; const unsigned mx = x > y ? x : y, mn = x > y ? y : x; const bool desc = ((i & K) == 0); a[i] = desc ? mx : mn; a[l] = desc ? mn : mx; } }
}
__device__ __forceinline__ void sort16_desc(unsigned* a) {
    bstage16<1, 2>(a); bstage16<2, 4>(a); bstage16<1, 4>(a); bstage16<4, 8>(a); bstage16<2, 8>(a); bstage16<1, 8>(a); bstage16<8, 16>(a); bstage16<4, 16>(a); bstage16<2, 16>(a); bstage16<1, 16>(a);
}
__device__ __forceinline__ void bmerge16_desc(unsigned* c) { bstage16<8, 16>(c); bstage16<4, 16>(c); bstage16<2, 16>(c); bstage16<1, 16>(c); }
__device__ __forceinline__ void merge_top16(unsigned* a, const unsigned* b) {
#pragma unroll
    for (int i = 0; i < 16; ++i) a[i] = a[i] > b[15 - i] ? a[i] : b[15 - i];
    bmerge16_desc(a);
}
__device__ __forceinline__ void xlane_top16(unsigned* t, int hi) {
    unsigned r[16]; const unsigned msk = 0u - (unsigned)hi;
#pragma unroll
    for (int i = 0; i < 16; ++i) r[i] = t[i] ^ ((t[i] ^ t[15 - i]) & msk);
#pragma unroll
    for (int i = 0; i < 16; ++i) { auto s = __builtin_amdgcn_permlane32_swap(r[i], r[i], false, false); t[i] = s[0] > s[1] ? s[0] : s[1]; }
    bmerge16_desc(t);
}
__device__ __forceinline__ constexpr int cand_a(int c) { return c < 16 ? 0 : c < 24 ? 1 : c < 29 ? 2 : c < 33 ? 3 : c < 36 ? 4 : c < 38 ? 5 : c < 40 ? 6 : c < 42 ? 7 : c < 50 ? c - 34 : 0; }
__device__ __forceinline__ constexpr int cand_b(int c) { return c < 16 ? c : c < 24 ? c - 16 : c < 29 ? c - 24 : c < 33 ? c - 29 : c < 36 ? c - 33 : c < 38 ? c - 36 : c < 40 ? c - 38 : c < 42 ? c - 40 : 0; }

__device__ __forceinline__ void phase_p6b(LAS unsigned char* lds, const bf16_t* __restrict__ PQ, const bf16_t* __restrict__ SubKl, unsigned* __restrict__ EG, int nrows, int vb, int nvb) {
    int tid_ = threadIdx.x; asm volatile("" : "+v"(tid_));
    const int lane = tid_ & 63, wid = __builtin_amdgcn_readfirstlane(tid_ >> 6), r32 = lane & 31, hi = lane >> 5;
    LAS unsigned short* tab = (LAS unsigned short*)(lds + wid * 4096) + r32 * 64;
    const int nitems = (nrows >> 5) * 8;
    for (int it = vb * 8 + wid; it < nitems; it += nvb * 8) {
        const int h = it & 7, row0 = (it >> 3) << 5;
        unsigned top[2][16];
#pragma unroll
        for (int p = 0; p < 2; ++p) {
            bf16x8 qf[8];
            { const bf16_t* qp = PQ + (size_t)(row0 + r32) * 2048 + h * 256 + p * 128 + 8 * hi; asm volatile("" : "+v"(qp));
#pragma unroll
              for (int s = 0; s < 8; ++s) qf[s] = *(const bf16x8*)(qp + 16 * s); }
            const bf16_t* kp = SubKl + ((size_t)(h * 2 + p) * 128 + r32) * 128 + 8 * hi; asm volatile("" : "+v"(kp));
            f32x16 acc[4];
#pragma unroll
            for (int kt = 0; kt < 4; ++kt) { acc[kt] = f32x16{};
                bf16x8 kf[8];
#pragma unroll
                for (int s = 0; s < 8; ++s) kf[s] = *(const bf16x8*)(kp + (size_t)kt * 32 * 128 + 16 * s);
#pragma unroll
                for (int s = 0; s < 8; ++s) acc[kt] = mfma32(kf[s], qf[s], acc[kt]);
                asm volatile("" ::: "memory"); }
            unsigned key[64];
#pragma unroll
            for (int kt = 0; kt < 4; ++kt)
#pragma unroll
                for (int r = 0; r < 16; ++r) { const int n = 32 * kt + (r & 3) + 8 * (r >> 2) + 4 * hi; key[16 * kt + r] = fkey(acc[kt][r], 127u - (unsigned)n, 127u); }
            sort16_desc(key); sort16_desc(key + 16); sort16_desc(key + 32); sort16_desc(key + 48);
            merge_top16(key, key + 16); merge_top16(key + 32, key + 48); merge_top16(key, key + 32);
            xlane_top16(key, hi);
#pragma unroll
            for (int i = 0; i < 16; ++i) top[p][i] = key[i];
            asm volatile("" ::: "memory");
        }
        unsigned ck[64];
#pragma unroll
        for (int c = 0; c < 64; ++c) {
            if (c < 50) { const float sm = keyf(top[0][cand_a(c)], 127u) + keyf(top[1][cand_b(c)], 127u); ck[c] = fkey(sm, (unsigned)c, 63u); } else ck[c] = 0u;
        }
        if (hi == 0) {
#pragma unroll
            for (int c = 0; c < 50; c += 2) {
                const unsigned ea = (127u - (top[0][cand_a(c)] & 127u)) * 128u + (127u - (top[1][cand_b(c)] & 127u));
                const unsigned eb = (127u - (top[0][cand_a(c + 1)] & 127u)) * 128u + (127u - (top[1][cand_b(c + 1)] & 127u));
                *(LAS unsigned*)(tab + c) = ea | (eb << 16);
            }
        }
        sort16_desc(ck); sort16_desc(ck + 16); sort16_desc(ck + 32); sort16_desc(ck + 48);
        merge_top16(ck, ck + 16); merge_top16(ck + 32, ck + 48); merge_top16(ck, ck + 32);
        asm volatile("s_waitcnt lgkmcnt(0)" ::: "memory");
        const float mx = keyf(ck[0], 63u); float e[16], den = 0.f;
#pragma unroll
        for (int j = 0; j < 16; ++j) { e[j] = __builtin_amdgcn_exp2f((keyf(ck[j], 63u) - mx) * 1.4426950408889634f); den += e[j]; }
        const float iden = 1.f / den;
        if (hi == 0) {
            unsigned o[16];
#pragma unroll
            for (int j = 0; j < 16; ++j) { const unsigned eid = tab[ck[j] & 63u]; o[j] = (eid << 16) | (cvt_pk_bf16(e[j] * iden, 0.f) & 0xffffu); }
            unsigned* dst = EG + (size_t)(row0 + r32) * 128 + h * 16;
#pragma unroll
            for (int j = 0; j < 16; j += 4) *(u32x4*)(dst + j) = (u32x4){o[j], o[j + 1], o[j + 2], o[j + 3]};
        }
        asm volatile("s_waitcnt lgkmcnt(0)" ::: "memory");
    }
}
__global__ void __launch_bounds__(512, 2) k_p6b(WS w, int l, int nrows) { phase_p6b((LAS unsigned char*)dyn_lds, w.PQ, w.SubK + (size_t)l * 16 * 128 * 128, w.EG, nrows, blockIdx.x, gridDim.x); }

__global__ void k_rs_from_ss(WS w) {
    const int row = blockIdx.x * 256 + threadIdx.x; if (row >= NR) return;
    float a = 0.f; for (int i = 0; i < 6; ++i) a += w.SSQ[(size_t)row * 8 + i];
    float b = 0.f; for (int i = 0; i < 4; ++i) b += w.SSKV[(size_t)row * 4 + i];
    w.RSQ[row] = rsqrtf(a * (1.f / 384.f) + EPS); w.RSKV[row] = rsqrtf(b * (1.f / 256.f) + EPS);
}


#define XB_TMO      128
#define XB_XCNT(j)  (256  + 64 * (j))
#define XB_XSUB(j)  (1280 + 64 * (j))
#define XB_XGEN(j)  (2304 + 64 * (j))
#define XB_TOP      3328
#define XB_TOPGEN   3392
#define XCD_BAR_WORDS 3456
#define XB_SPIN_CAP (1u << 18)

__device__ __forceinline__ unsigned xb_ld(unsigned* p)              { return __hip_atomic_load(p, __ATOMIC_RELAXED, __HIP_MEMORY_SCOPE_AGENT); }
__device__ __forceinline__ unsigned xb_add(unsigned* p, unsigned v) { return __hip_atomic_fetch_add(p, v, __ATOMIC_RELAXED, __HIP_MEMORY_SCOPE_AGENT); }
__device__ __forceinline__ unsigned xb_xcc_id() { return (unsigned)__builtin_amdgcn_s_getreg((3 << 11) | 20) & 0xFu; }
#define XB_SPIN(cond, bar) do { unsigned _sp = 0; while (cond) { __builtin_amdgcn_s_sleep(1); \
    if ((++_sp & 255u) == 0u) { if (xb_ld(&(bar)[XB_TMO])) break; if (_sp > XB_SPIN_CAP) { atomicAdd(&(bar)[XB_TMO], 1u); break; } } } } while (0)

struct XcdBarrier {
    unsigned* bar; unsigned x;
    volatile LAS unsigned* st;
};

__device__ __forceinline__ XcdBarrier xcd_barrier_post(unsigned* bar, volatile LAS unsigned* st) {
    XcdBarrier b; b.bar = bar; b.x = xb_xcc_id(); b.st = st;
    if (threadIdx.x == 0) (void)xb_add(&bar[XB_XCNT(b.x)], 1u);
    return b;
}
__device__ __forceinline__ void xcd_barrier_complete(unsigned* bar, unsigned x, unsigned& nloc, unsigned& nx) {
    const unsigned G = gridDim.x * gridDim.y * gridDim.z;
    unsigned sum, cnt, mine, sp = 0u;
    for (;;) {
        sum = 0u; cnt = 0u; mine = 0u;
#pragma unroll
        for (unsigned j = 0; j < 16; ++j) { const unsigned c = xb_ld(&bar[XB_XCNT(j)]); sum += c; cnt += (c > 0u) ? 1u : 0u; mine = (j == x) ? c : mine; }
        if (sum == G) break;
        __builtin_amdgcn_s_sleep(1);
        if ((++sp & 255u) == 0u) { if (xb_ld(&bar[XB_TMO])) break; if (sp > XB_SPIN_CAP) { atomicAdd(&bar[XB_TMO], 1u); break; } }
    }
    nloc = mine > 0u ? mine : 1u; nx = cnt > 0u ? cnt : 1u;
}

__device__ __forceinline__ void xcd_barrier(const XcdBarrier& b) {
    asm volatile("s_waitcnt vmcnt(0)" ::: "memory");
    __syncthreads();
    if (threadIdx.x == 0) {
        unsigned* bar = b.bar;
        __builtin_amdgcn_s_waitcnt(0);
        unsigned nloc = b.st[0], nx = b.st[1];
        if (nloc == 0u) { xcd_barrier_complete(bar, b.x, nloc, nx); b.st[0] = nloc; b.st[1] = nx; }
        const unsigned old = xb_add(&bar[XB_XSUB(b.x)], 1u);
        const unsigned gen = old / nloc;
        if (old + 1u == (gen + 1u) * nloc) {
            __builtin_amdgcn_fence(__ATOMIC_RELEASE, "agent");
            asm volatile("s_waitcnt vmcnt(0)" ::: "memory");
            const unsigned og = xb_add(&bar[XB_TOP], 1u);
            const unsigned tg = og / nx;
            if (og + 1u == (tg + 1u) * nx) xb_add(&bar[XB_TOPGEN], 1u);
            else XB_SPIN(xb_ld(&bar[XB_TOPGEN]) == tg, bar);
            __builtin_amdgcn_fence(__ATOMIC_ACQUIRE, "agent");
            xb_add(&bar[XB_XGEN(b.x)], 1u);
            asm volatile("s_waitcnt vmcnt(0)" ::: "memory");
        } else {
            XB_SPIN(xb_ld(&bar[XB_XGEN(b.x)]) == gen, bar);
            __builtin_amdgcn_fence(__ATOMIC_ACQUIRE, "agent");
            asm volatile("s_waitcnt vmcnt(0)" ::: "memory");
        }
    }
    __syncthreads();
}

__device__ __forceinline__ void phase_mod(LAS unsigned char* lds, const Inputs& in, const WS& w, int vb) {
    if (vb >= 72) return;
    LAS float* sc = (LAS float*)lds;
    const int tid = threadIdx.x, idx = vb * 512 + tid, rg = idx / 12288, ln = idx % 12288, l = ln / 6144, n = ln % 6144;
    float acc[11];
#pragma unroll
    for (int i = 0; i < 11; ++i) acc[i] = 0.f;
    const float* wp = in.ada_w + (size_t)l * 1024 * 6144 + n;
    for (int kc = 0; kc < 4; ++kc) {
        for (int i = tid; i < 33 * 256; i += 512) { const int r = i >> 8, k = kc * 256 + (i & 255); const float v = r < 32 ? in.c[(size_t)r * 1024 + k] : in.c_ctx[k]; sc[i] = v / (1.f + __expf(-v)); }
        __syncthreads();
        for (int k = 0; k < 256; ++k) { const float wv = wp[(size_t)(kc * 256 + k) * 6144];
#pragma unroll
            for (int i = 0; i < 11; ++i) acc[i] += sc[(rg * 11 + i) * 256 + k] * wv; }
        __syncthreads();
    }
    const float bias = in.ada_b[(size_t)l * 6144 + n];
#pragma unroll
    for (int i = 0; i < 11; ++i) w.MOD[((size_t)l * 33 + rg * 11 + i) * 6144 + n] = acc[i] + bias;
}
__device__ __forceinline__ void phase_rope(const WS& w, int vb, int nvb) {
    for (int i = vb * 512 + threadIdx.x; i < 2048 * 32; i += nvb * 512) {
        { const int t = i / 32, j = i % 32; const double inv = pow(10000.0, -(double)(j % 16) / 16.0); const double a = (double)(j < 16 ? t / 64 : t % 64) * inv; w.ROPA[i] = make_float2((float)cos(a), (float)sin(a)); }
        if (i < 2048 * 16) { const int t = i / 16, j = i % 16; const double inv = pow(10000.0, -(double)(j % 8) / 8.0); const double a = (double)(j < 8 ? t / 64 : t % 64) * inv; w.ROPC[i] = make_float2((float)cos(a), (float)sin(a)); }
    }
}

struct MegaArgs { Inputs in; WS w; float* XL; unsigned* bar; };
constexpr int MEGA_LDS = 131072 + 16;
__global__ void __launch_bounds__(512, 2) k_mega(MegaArgs A) {
    LAS unsigned char* lds = (LAS unsigned char*)dyn_lds;
    const int vb = blockIdx.x, nvb = gridDim.x;
    volatile LAS unsigned* xbw = (volatile LAS unsigned*)(lds + 131072);
    if (threadIdx.x == 0) { xbw[0] = 0u; xbw[1] = 0u; xbw[2] = 0u; xbw[3] = 0u; }
    __syncthreads();
    XcdBarrier bar = xcd_barrier_post(A.bar, xbw);
    const WS& w = A.w; const Inputs& in = A.in;
    phase_mod(lds, in, w, vb);
    phase_rope(w, vb, nvb);
    phase_cvt(lds, in, w, vb, nvb);
    xcd_barrier(bar);
    phase_modulate(in.x, in.ctx, w.H, in.norm1_g, w.MOD, 0, NR, vb, nvb);
    xcd_barrier(bar);
    for (int l = 0; l < DEPTH; ++l) {
        const float* MODl = w.MOD + (size_t)l * 33 * 6144;
        const bool last = (l == DEPTH - 1);
        const int MR = last ? NL : NR;
        phase_p1(lds, w, in, l, vb, nvb);
        xcd_barrier(bar);
        phase_p2(lds, w, in, l, vb, nvb);
        xcd_barrier(bar);
        phase_p3(lds, w, l, vb, nvb);
        xcd_barrier(bar);
        phase_p4(lds, w, in, A.XL, l, vb, nvb);
        xcd_barrier(bar);
        phase_modulate(A.XL, w.XC, w.H, in.norm2_g + l * 1024, MODl, 3, MR, vb, nvb);
        xcd_barrier(bar);
        phase_p6a(lds, w, l, vb, nvb);
        xcd_barrier(bar);
        phase_p6b(lds, w.PQ, w.SubK + (size_t)l * 16 * 128 * 128, w.EG, MR, vb, nvb);
        xcd_barrier(bar);
        { P7Args a{w.H, w.EG, w.U8 + (size_t)l * NE * 1024, w.V8 + (size_t)l * NE * 1024, w.US + (size_t)l * NE, w.VS + (size_t)l * NE, A.XL, w.XC, MODl + 5 * 1024, MR, last ? 2 : 1,
                   w.H, in.norm1_g + (last ? 0 : (l + 1) * 1024), w.MOD + (size_t)(last ? 0 : (l + 1)) * 33 * 6144, in.final_g};
          phase_p7(a, vb, nvb); }
        if (!last) xcd_barrier(bar);
    }
}

extern "C" void kernel_launch(void* const* d_in, const int* in_sizes, int n_in, void* d_out, int out_size, void* d_ws, size_t ws_size, hipStream_t stream) {
    const float* const* fin = (const float* const*)d_in;
    Inputs in{fin[0], fin[1], fin[2], fin[3], fin[4], fin[5], fin[6], fin[7], fin[8], fin[9], fin[10], fin[11], fin[12], fin[13], fin[14], fin[15], fin[16], fin[17], fin[18], fin[19], fin[20], fin[21], fin[22]};
    WS w = make_ws(d_ws);
    static int ok = 0;
    if (!ok) {
        if (hipFuncSetAttribute((const void*)k_mega, hipFuncAttributeMaxDynamicSharedMemorySize, MEGA_LDS) != hipSuccess) { ok = -1; }
        int per_cu = 0, cus = 0, dev = 0; (void)hipGetDevice(&dev); (void)hipDeviceGetAttribute(&cus, hipDeviceAttributeMultiprocessorCount, dev);
        if (hipOccupancyMaxActiveBlocksPerMultiprocessor(&per_cu, (const void*)k_mega, 512, MEGA_LDS) != hipSuccess || per_cu < 1 || cus < 256) ok = -1;
        if (ok == 0) ok = 1;
    }
    if (ok < 0) return;
    (void)hipMemsetAsync(d_ws, 0, 16384, stream);
    MegaArgs A{in, w, (float*)d_out, (unsigned*)d_ws};
    k_mega<<<256, 512, MEGA_LDS, stream>>>(A);
}
```

```cpp
#include <hip/hip_runtime.h>
#include <stdint.h>

typedef unsigned short bf16_t;

constexpr int D = 1024, NB = 32, S = 2048, CTX = 256, DEPTH = 2;
constexpr int NL = NB * S, NC = NB * CTX, NR = NL + NC;
constexpr int KEYS = CTX + S;
constexpr int INC = 1568;
constexpr int NE = 16384;
constexpr float EPS = 1e-6f;

__device__ __forceinline__ float bf2f(bf16_t v) { return __uint_as_float(((unsigned)v) << 16); }
__device__ __forceinline__ bf16_t f2bf(float f) { unsigned u = __float_as_uint(f); u += 0x7FFFu + ((u >> 16) & 1u); return (bf16_t)(u >> 16); }

__device__ __forceinline__ float wave_sum(float v) {
#pragma unroll
    for (int o = 32; o > 0; o >>= 1) v += __shfl_xor(v, o);
    return v;
}
__device__ __forceinline__ float gelu_tanh(float x) {
    const float u = 0.7978845608028654f * (x + 0.044715f * x * x * x);
    return 0.5f * x * (1.f + tanhf(u));
}

struct WS {
    char* base;
    __host__ __device__ __forceinline__ bf16_t* H() const { return (bf16_t*)(base + 65536ull); }
    __host__ __device__ __forceinline__ bf16_t* Qg() const { return (bf16_t*)(base + 151060480ull); }
    __host__ __device__ __forceinline__ bf16_t* Qgc() const { return (bf16_t*)(base + 201392128ull); }
    __host__ __device__ __forceinline__ bf16_t* Kg() const { return (bf16_t*)(base + 207683584ull); }
    __host__ __device__ __forceinline__ bf16_t* Vg() const { return (bf16_t*)(base + 226557952ull); }
    __host__ __device__ __forceinline__ bf16_t* CQ() const { return (bf16_t*)(base + 245432320ull); }
    __host__ __device__ __forceinline__ bf16_t* CKV() const { return (bf16_t*)(base + 302055424ull); }
    __host__ __device__ __forceinline__ bf16_t* Bp() const { return (bf16_t*)(base + 339804160ull); }
    __host__ __device__ __forceinline__ bf16_t* KR() const { return (bf16_t*)(base + 377552896ull); }
    __host__ __device__ __forceinline__ bf16_t* Qm() const { return (bf16_t*)(base + 382271488ull); }
    __host__ __device__ __forceinline__ bf16_t* Qmc() const { return (bf16_t*)(base + 457768960ull); }
    __host__ __device__ __forceinline__ bf16_t* Kmn() const { return (bf16_t*)(base + 467206144ull); }
    __host__ __device__ __forceinline__ bf16_t* Vm() const { return (bf16_t*)(base + 523829248ull); }
    __host__ __device__ __forceinline__ unsigned* EG() const { return (unsigned*)(base + 580452352ull); }
    __host__ __device__ __forceinline__ bf16_t* P() const { return (bf16_t*)(base + 382271488ull); }
    __host__ __device__ __forceinline__ bf16_t* PQ() const { return (bf16_t*)(base + 151060480ull); }
    __host__ __device__ __forceinline__ bf16_t* TMP() const { return (bf16_t*)(base + 65536ull); }
    __host__ __device__ __forceinline__ float* XC() const { return (float*)(base + 618201088ull); }
    __host__ __device__ __forceinline__ float* MOD() const { return (float*)(base + 651755520ull); }
    __host__ __device__ __forceinline__ float2* ROPA() const { return (float2*)(base + 653377536ull); }
    __host__ __device__ __forceinline__ float2* ROPC() const { return (float2*)(base + 653901824ull); }
    __host__ __device__ __forceinline__ float* RSQ() const { return (float*)(base + 654163968ull); }
    __host__ __device__ __forceinline__ float* RSKV() const { return (float*)(base + 654458880ull); }
    __host__ __device__ __forceinline__ bf16_t* WinT() const { return (bf16_t*)(base + 654753792ull); }
    __host__ __device__ __forceinline__ bf16_t* WuqT() const { return (bf16_t*)(base + 662093824ull); }
    __host__ __device__ __forceinline__ bf16_t* WukvT() const { return (bf16_t*)(base + 663273472ull); }
    __host__ __device__ __forceinline__ bf16_t* WoutT() const { return (bf16_t*)(base + 664059904ull); }
    __host__ __device__ __forceinline__ bf16_t* WqT() const { return (bf16_t*)(base + 668254208ull); }
    __host__ __device__ __forceinline__ bf16_t* SubK() const { return (bf16_t*)(base + 676642816ull); }
    __host__ __device__ __forceinline__ unsigned char* U8() const { return (unsigned char*)(base + 677691392ull); }
    __host__ __device__ __forceinline__ unsigned char* V8() const { return (unsigned char*)(base + 711245824ull); }
    __host__ __device__ __forceinline__ float* US() const { return (float*)(base + 744800256ull); }
    __host__ __device__ __forceinline__ float* VS() const { return (float*)(base + 744931328ull); }
    __host__ __device__ __forceinline__ float* SSQ() const { return (float*)(base + 745062400ull); }
    __host__ __device__ __forceinline__ float* SSKV() const { return (float*)(base + 747421696ull); }
    __host__ __device__ __forceinline__ unsigned* WE() const { return (unsigned*)(base + 748601344ull); }
    __host__ __device__ __forceinline__ signed char* H8() const { return (signed char*)(base + 786350080ull); }
    __host__ __device__ __forceinline__ float* HS() const { return (float*)(base + 861847552ull); }
    __host__ __device__ __forceinline__ bf16_t* PoolWT() const { return (bf16_t*)(base + 862142464ull); }
};
constexpr size_t WS_BYTES = 862208000ull;
static WS make_ws(void* d_ws) { WS w; w.base = (char*)d_ws; return w; }

__global__ void k_mod(const float* __restrict__ c, const float* __restrict__ c_ctx, const float* __restrict__ ada_w, const float* __restrict__ ada_b, float* __restrict__ MOD) {
    __shared__ float sc[1024];
    const int r = blockIdx.y, l = blockIdx.z, n = blockIdx.x * 256 + threadIdx.x;
    const float* cv = r < 32 ? c + (size_t)r * 1024 : c_ctx;
    for (int k = threadIdx.x; k < 1024; k += 256) { const float v = cv[k]; sc[k] = v / (1.f + expf(-v)); }
    __syncthreads();
    const float* w = ada_w + (size_t)l * 1024 * 6144 + n;
    float acc = 0.f;
    for (int k = 0; k < 1024; ++k) acc += sc[k] * w[(size_t)k * 6144];
    MOD[((size_t)l * 33 + r) * 6144 + n] = acc + ada_b[(size_t)l * 6144 + n];
}
__global__ void k_rope_tab(float2* ROPA, float2* ROPC) {
    const int i = blockIdx.x * 256 + threadIdx.x;
    if (i < 2048 * 32) { const int t = i / 32, j = i % 32; const double inv = pow(10000.0, -(double)(j % 16) / 16.0); const double a = (double)(j < 16 ? t / 64 : t % 64) * inv; ROPA[i] = make_float2((float)cos(a), (float)sin(a)); }
    if (i < 2048 * 16) { const int t = i / 16, j = i % 16; const double inv = pow(10000.0, -(double)(j % 8) / 8.0); const double a = (double)(j < 8 ? t / 64 : t % 64) * inv; ROPC[i] = make_float2((float)cos(a), (float)sin(a)); }
}

__global__ void k_modulate(const float* __restrict__ X, bf16_t* __restrict__ Hout, const float* __restrict__ g, const float* __restrict__ MODl, int si, int rows_per_batch, int fixed) {
    __shared__ float red[4];
    const int row = blockIdx.x, tid = threadIdx.x;
    const float4 x = *(const float4*)(X + (size_t)row * 1024 + tid * 4);
    float ss = x.x * x.x + x.y * x.y + x.z * x.z + x.w * x.w;
    ss = wave_sum(ss); if ((tid & 63) == 0) red[tid >> 6] = ss; __syncthreads();
    ss = red[0] + red[1] + red[2] + red[3];
    const float rstd = rsqrtf(ss * (1.f / 1024.f) + EPS);
    const int mr = fixed >= 0 ? fixed : row / rows_per_batch;
    const float* sh = MODl + (size_t)mr * 6144 + si * 1024 + tid * 4; const float* sc = sh + 1024;
    const float4 gv = *(const float4*)(g + tid * 4), shv = *(const float4*)sh, scv = *(const float4*)sc;
    bf16_t o[4];
    o[0] = f2bf(x.x * rstd * gv.x * (1.f + scv.x) + shv.x); o[1] = f2bf(x.y * rstd * gv.y * (1.f + scv.y) + shv.y);
    o[2] = f2bf(x.z * rstd * gv.z * (1.f + scv.z) + shv.z); o[3] = f2bf(x.w * rstd * gv.w * (1.f + scv.w) + shv.w);
    *(uint2*)(Hout + (size_t)row * 1024 + tid * 4) = *(uint2*)o;
}

template <int MODE>
__global__ void __launch_bounds__(256) k_ngemm(const bf16_t* __restrict__ A, int lda, const float* __restrict__ W, int ldw, int M, int N, int K,
                                               const float* __restrict__ rowscale, const float* __restrict__ kgain,
                                               bf16_t* __restrict__ C, int ldc, float* __restrict__ Xf, const float* __restrict__ gate, int rows_per_batch, int fixed) {
    __shared__ float As[64][17];
    __shared__ float Ws[16][64];
    const int tid = threadIdx.x, tx = tid & 15, ty = tid >> 4;
    const int m0 = blockIdx.y * 64, n0 = blockIdx.x * 64;
    float acc[4][4];
#pragma unroll
    for (int i = 0; i < 4; ++i)
#pragma unroll
        for (int j = 0; j < 4; ++j) acc[i][j] = 0.f;
    const int ar = tid >> 2, ac = (tid & 3) * 4;
    const int wr = tid >> 4, wc = (tid & 15) * 4;
    for (int k0 = 0; k0 < K; k0 += 16) {
        { const uint2 raw = *(const uint2*)(A + (size_t)(m0 + ar) * lda + k0 + ac); const bf16_t* e = (const bf16_t*)&raw;
#pragma unroll
          for (int i = 0; i < 4; ++i) { float v = bf2f(e[i]); if (kgain) v *= kgain[k0 + ac + i]; As[ar][ac + i] = v; } }
        { float4 wv = make_float4(0.f, 0.f, 0.f, 0.f); if (n0 + wc < N) wv = *(const float4*)(W + (size_t)(k0 + wr) * ldw + n0 + wc); *(float4*)&Ws[wr][wc] = wv; }
        __syncthreads();
#pragma unroll
        for (int kk = 0; kk < 16; ++kk) {
            float a[4], b[4];
#pragma unroll
            for (int i = 0; i < 4; ++i) a[i] = As[ty * 4 + i][kk];
            const float4 bv = *(const float4*)&Ws[kk][tx * 4]; b[0] = bv.x; b[1] = bv.y; b[2] = bv.z; b[3] = bv.w;
#pragma unroll
            for (int i = 0; i < 4; ++i)
#pragma unroll
                for (int j = 0; j < 4; ++j) acc[i][j] += a[i] * b[j];
        }
        __syncthreads();
    }
    if (n0 + tx * 4 >= N) return;
#pragma unroll
    for (int i = 0; i < 4; ++i) {
        const int m = m0 + ty * 4 + i; const float rs = rowscale ? rowscale[m] : 1.f;
        if (MODE == 0) { bf16_t o[4];
#pragma unroll
            for (int j = 0; j < 4; ++j) o[j] = f2bf(acc[i][j] * rs);
            *(uint2*)(C + (size_t)m * ldc + n0 + tx * 4) = *(uint2*)o;
        } else {
            const int mr = fixed >= 0 ? fixed : m / rows_per_batch;
            float4 xv = *(float4*)(Xf + (size_t)m * 1024 + n0 + tx * 4); const float4 gv = *(const float4*)(gate + (size_t)mr * 6144 + n0 + tx * 4);
            xv.x += gv.x * acc[i][0]; xv.y += gv.y * acc[i][1]; xv.z += gv.z * acc[i][2]; xv.w += gv.w * acc[i][3];
            *(float4*)(Xf + (size_t)m * 1024 + n0 + tx * 4) = xv;
        }
    }
}

__global__ void __launch_bounds__(256) k_post_in(const bf16_t* __restrict__ P, WS w, const float* __restrict__ qn_g, const float* __restrict__ kn_g, int row0) {
    __shared__ float p[INC];
    const int row = row0 + blockIdx.x, tid = threadIdx.x, lane = tid & 63, wid = tid >> 6;
    const bool isctx = row >= NL; const int b = isctx ? (row - NL) / CTX : row / S, t = isctx ? (row - NL) % CTX : row % S;
    const int key = isctx ? t : CTX + t;
    for (int i = tid; i < INC; i += 256) p[i] = bf2f(P[(size_t)row * INC + i]);
    __syncthreads();
    for (int gI = wid; gI < 8; gI += 4) {
        const float x = p[gI * 64 + lane];
        const float ss = wave_sum(x * x);
        const float rstd = rsqrtf(ss * (1.f / 64.f) + EPS);
        float y = x * rstd * (gI < 6 ? qn_g[lane] : kn_g[lane]);
        if (!isctx) { const float o = __shfl_xor(y, 32); const float2 cs = w.ROPA()[t * 32 + (lane & 31)];
            y = lane < 32 ? (y * cs.x - o * cs.y) : (o * cs.y + y * cs.x); }
        if (gI < 6) { bf16_t* dst = isctx ? w.Qgc() + (((size_t)b * 6 + gI) * CTX + t) * 64 : w.Qg() + (((size_t)b * 6 + gI) * S + t) * 64; dst[lane] = f2bf(y); }
        else { w.Kg()[(((size_t)b * 2 + (gI - 6)) * KEYS + key) * 64 + lane] = f2bf(y); }
    }
    if (tid < 128) w.Vg()[(((size_t)b * 2 + (tid >> 6)) * KEYS + key) * 64 + (tid & 63)] = f2bf(p[512 + tid]);
    w.Bp()[(size_t)row * 256 + tid] = f2bf(p[640 + tid]);
    for (int i = tid; i < 384; i += 256) w.CQ()[(size_t)row * 384 + i] = f2bf(p[896 + i]);
    w.CKV()[(size_t)row * 256 + tid] = f2bf(p[1280 + tid]);
    if (wid == 0) { float ss = 0.f; for (int i = lane; i < 384; i += 64) ss += p[896 + i] * p[896 + i]; ss = wave_sum(ss); if (lane == 0) w.RSQ()[row] = rsqrtf(ss * (1.f / 384.f) + EPS); }
    if (wid == 1) { float ss = 0.f; for (int i = lane; i < 256; i += 64) ss += p[1280 + i] * p[1280 + i]; ss = wave_sum(ss); if (lane == 0) w.RSKV()[row] = rsqrtf(ss * (1.f / 256.f) + EPS); }
    if (wid == 2 && lane < 32) { float y = p[1536 + lane];
        if (!isctx) { const float o = __shfl_xor(y, 16); const float2 cs = w.ROPC()[t * 16 + (lane & 15)]; y = lane < 16 ? (y * cs.x - o * cs.y) : (o * cs.y + y * cs.x); }
        w.KR()[((size_t)b * KEYS + key) * 32 + lane] = f2bf(y); }
}
__global__ void __launch_bounds__(256) k_post_q(const bf16_t* __restrict__ T, WS w, int row0) {
    const int row = row0 + blockIdx.x, tid = threadIdx.x;
    const bool isctx = row >= NL; const int b = isctx ? (row - NL) / CTX : row / S, t = isctx ? (row - NL) % CTX : row % S;
    for (int i = tid; i < 576; i += 256) {
        const int h = i / 96, e = i % 96; float y = bf2f(T[(size_t)row * 576 + i]);
        if (e >= 64 && !isctx) { const int j = e - 64; const float o = bf2f(T[(size_t)row * 576 + h * 96 + 64 + (j ^ 16)]); const float2 cs = w.ROPC()[t * 16 + (j & 15)];
            y = j < 16 ? (y * cs.x - o * cs.y) : (o * cs.y + y * cs.x); }
        bf16_t* dst = isctx ? w.Qmc() + (((size_t)b * 6 + h) * CTX + t) * 96 : w.Qm() + (((size_t)b * 6 + h) * S + t) * 96;
        dst[e] = f2bf(y);
    }
}
__global__ void __launch_bounds__(256) k_post_kv(const bf16_t* __restrict__ T, WS w, int row0) {
    const int row = row0 + blockIdx.x, tid = threadIdx.x;
    const bool isctx = row >= NL; const int b = isctx ? (row - NL) / CTX : row / S, t = isctx ? (row - NL) % CTX : row % S;
    const int key = isctx ? t : CTX + t;
    for (int i = tid; i < 768; i += 256) {
        const int h = i / 128, e = i % 128; const bf16_t v = T[(size_t)row * 768 + i];
        if (e < 64) w.Kmn()[(((size_t)b * 6 + h) * KEYS + key) * 64 + e] = v; else w.Vm()[(((size_t)b * 6 + h) * KEYS + key) * 64 + (e - 64)] = v;
    }
}

template <int DK>
__global__ void __launch_bounds__(256) k_nattn(const bf16_t* __restrict__ Q, const bf16_t* __restrict__ K1, const bf16_t* __restrict__ K2, const bf16_t* __restrict__ V,
                                               bf16_t* __restrict__ MIX, int H, int HK, int G, int LQ, int nkeys, float scale, int rowbase, int coff) {
    const int b = blockIdx.z, h = blockIdx.y, t = blockIdx.x * 256 + threadIdx.x, hk = h / G;
    float q[DK];
    { const bf16_t* qp = Q + (((size_t)b * H + h) * LQ + t) * DK;
#pragma unroll
      for (int d = 0; d < DK; d += 8) { const uint4 raw = *(const uint4*)(qp + d); const bf16_t* e = (const bf16_t*)&raw;
#pragma unroll
          for (int i = 0; i < 8; ++i) q[d + i] = bf2f(e[i]) * scale; } }
    float o[64];
#pragma unroll
    for (int d = 0; d < 64; ++d) o[d] = 0.f;
    float m = -INFINITY, l = 0.f;
    const bf16_t* k1 = K1 + ((size_t)b * HK + hk) * KEYS * 64; const bf16_t* k2 = K2 ? K2 + (size_t)b * KEYS * 32 : nullptr; const bf16_t* vp = V + ((size_t)b * HK + hk) * KEYS * 64;
    for (int k = 0; k < nkeys; ++k) {
        float s = 0.f;
#pragma unroll
        for (int d = 0; d < 64; d += 8) { const uint4 raw = *(const uint4*)(k1 + (size_t)k * 64 + d); const bf16_t* e = (const bf16_t*)&raw;
#pragma unroll
            for (int i = 0; i < 8; ++i) s += q[d + i] * bf2f(e[i]); }
        if (DK == 96) {
#pragma unroll
            for (int d = 0; d < 32; d += 8) { const uint4 raw = *(const uint4*)(k2 + (size_t)k * 32 + d); const bf16_t* e = (const bf16_t*)&raw;
#pragma unroll
                for (int i = 0; i < 8; ++i) s += q[(DK == 96 ? 64 : 0) + d + i] * bf2f(e[i]); }
        }
        if (s > m) { const float a = __expf(m - s); l *= a;
#pragma unroll
            for (int d = 0; d < 64; ++d) o[d] *= a;
            m = s; }
        const float pw = __expf(s - m); l += pw;
#pragma unroll
        for (int d = 0; d < 64; d += 8) { const uint4 raw = *(const uint4*)(vp + (size_t)k * 64 + d); const bf16_t* e = (const bf16_t*)&raw;
#pragma unroll
            for (int i = 0; i < 8; ++i) o[d + i] += pw * bf2f(e[i]); }
    }
    const float il = 1.f / l;
    bf16_t* dst = MIX + (size_t)(rowbase + b * LQ + t) * 1024 + coff + h * 64;
#pragma unroll
    for (int d = 0; d < 64; d += 8) { bf16_t ob[8];
#pragma unroll
        for (int i = 0; i < 8; ++i) ob[i] = f2bf(o[d + i] * il);
        *(uint4*)(dst + d) = *(uint4*)ob; }
}

__global__ void __launch_bounds__(256) k_npool(const bf16_t* __restrict__ Bp, bf16_t* __restrict__ MIX, const float* __restrict__ pool_w, const float* __restrict__ pool_scale, int row0) {
    __shared__ float pl[256];
    const int row = row0 + blockIdx.x, tid = threadIdx.x, gI = tid >> 6, c = tid & 63;
    const bool isctx = row >= NL; const int L = isctx ? CTX : S; const int t = isctx ? (row - NL) % CTX : row % S; const int base = row - t;
    const int wdw = 2 << gI;
    int lo = t - wdw / 2, hi = t - wdw / 2 + wdw; lo = lo < 0 ? 0 : lo; hi = hi > L ? L : hi;
    float sum = 0.f;
    for (int u = lo; u < hi; ++u) sum += bf2f(Bp[(size_t)(base + u) * 256 + tid]);
    pl[tid] = sum / (float)(hi - lo) - bf2f(Bp[(size_t)row * 256 + tid]);
    __syncthreads();
    float acc = 0.f; const float* wg = pool_w + (size_t)gI * 64 * 64 + c;
    for (int cc = 0; cc < 64; ++cc) acc += pl[gI * 64 + cc] * wg[cc * 64];
    MIX[(size_t)row * 1024 + 384 + tid] = f2bf(acc * pool_scale[tid]);
}

__global__ void __launch_bounds__(256) k_peer_select(const bf16_t* __restrict__ PQ, const float* __restrict__ subk, unsigned* __restrict__ EG, int row0) {
    __shared__ float q[2048];
    __shared__ float sc[16][128];
    __shared__ float ts[16][16]; __shared__ int ti[16][16];
    __shared__ float cs[8][16]; __shared__ int ci[8][16];
    const int row = row0 + blockIdx.x, tid = threadIdx.x;
    for (int i = tid; i < 2048; i += 256) q[i] = bf2f(PQ[(size_t)row * 2048 + i]);
    __syncthreads();
    for (int i = tid; i < 2048; i += 256) { const int gp = i >> 7, n = i & 127; const float* kp = subk + ((size_t)gp * 128 + n) * 128; const float* qp = q + gp * 128;
        float s = 0.f; for (int d = 0; d < 128; ++d) s += qp[d] * kp[d]; sc[gp][n] = s; }
    __syncthreads();
    for (int i = tid; i < 2048; i += 256) { const int gp = i >> 7, n = i & 127; const float v = sc[gp][n]; int rank = 0;
        for (int mI = 0; mI < 128; ++mI) { const float o = sc[gp][mI]; rank += (o > v || (o == v && mI < n)) ? 1 : 0; }
        if (rank < 16) { ts[gp][rank] = v; ti[gp][rank] = n; } }
    __syncthreads();
    { const int h = tid >> 5;
      for (int cI = (tid & 31); cI < 256; cI += 32) { const int a = cI >> 4, bb = cI & 15; const float v = ts[h * 2][a] + ts[h * 2 + 1][bb]; int rank = 0;
          for (int o = 0; o < 256; ++o) { const float ov = ts[h * 2][o >> 4] + ts[h * 2 + 1][o & 15]; rank += (ov > v || (ov == v && o < cI)) ? 1 : 0; }
          if (rank < 16) { cs[h][rank] = v; ci[h][rank] = ti[h * 2][a] * 128 + ti[h * 2 + 1][bb]; } } }
    __syncthreads();
    if (tid < 128) { const int h = tid >> 4, j = tid & 15; const float mx = cs[h][0]; float den = 0.f;
        for (int o = 0; o < 16; ++o) den += __expf(cs[h][o] - mx);
        const float gte = __expf(cs[h][j] - mx) / den;
        EG[(size_t)row * 128 + tid] = ((unsigned)ci[h][j] << 16) | (unsigned)f2bf(gte); }
}
__global__ void __launch_bounds__(256) k_peer_expert(const bf16_t* __restrict__ H2, const unsigned* __restrict__ EG, const float* __restrict__ U, const float* __restrict__ Vt, float* __restrict__ X,
                                                     const float* __restrict__ gate2, int rows_per_batch, int fixed, int hrow0) {
    __shared__ float h[1024]; __shared__ float wgt[128]; __shared__ int eid[128];
    const int row = blockIdx.x, tid = threadIdx.x, lane = tid & 63, wid = tid >> 6;
    for (int i = tid; i < 1024; i += 256) h[i] = bf2f(H2[(size_t)(hrow0 + row) * 1024 + i]);
    if (tid < 128) eid[tid] = (int)(EG[(size_t)(hrow0 + row) * 128 + tid] >> 16);
    __syncthreads();
    for (int e = wid; e < 128; e += 4) { const float* up = U + (size_t)eid[e] * 1024; float s = 0.f;
        for (int d = lane; d < 1024; d += 64) s += h[d] * up[d];
        s = wave_sum(s);
        if (lane == 0) wgt[e] = bf2f((bf16_t)(EG[(size_t)(hrow0 + row) * 128 + e] & 0xFFFFu)) * gelu_tanh(s); }
    __syncthreads();
    float4 acc = make_float4(0.f, 0.f, 0.f, 0.f);
    for (int e = 0; e < 128; ++e) { const float4 v = *(const float4*)(Vt + (size_t)eid[e] * 1024 + tid * 4); const float wv = wgt[e];
        acc.x += wv * v.x; acc.y += wv * v.y; acc.z += wv * v.z; acc.w += wv * v.w; }
    const int mr = fixed >= 0 ? fixed : row / rows_per_batch;
    const float4 gv = *(const float4*)(gate2 + (size_t)mr * 6144 + tid * 4);
    float4 xv = *(float4*)(X + (size_t)row * 1024 + tid * 4);
    xv.x += gv.x * acc.x; xv.y += gv.y * acc.y; xv.z += gv.z * acc.z; xv.w += gv.w * acc.w;
    *(float4*)(X + (size_t)row * 1024 + tid * 4) = xv;
}
__global__ void __launch_bounds__(256) k_final(float* __restrict__ X, const float* __restrict__ g) {
    __shared__ float red[4];
    const int row = blockIdx.x, tid = threadIdx.x;
    float4 x = *(const float4*)(X + (size_t)row * 1024 + tid * 4);
    float ss = x.x * x.x + x.y * x.y + x.z * x.z + x.w * x.w;
    ss = wave_sum(ss); if ((tid & 63) == 0) red[tid >> 6] = ss; __syncthreads();
    ss = red[0] + red[1] + red[2] + red[3];
    const float rstd = rsqrtf(ss * (1.f / 1024.f) + EPS);
    const float4 gv = *(const float4*)(g + tid * 4);
    x.x *= rstd * gv.x; x.y *= rstd * gv.y; x.z *= rstd * gv.z; x.w *= rstd * gv.w;
    *(float4*)(X + (size_t)row * 1024 + tid * 4) = x;
}

#define LAS __attribute__((address_space(3)))
typedef short bf16x8 __attribute__((ext_vector_type(8)));
typedef float f32x4 __attribute__((ext_vector_type(4)));
typedef float f32x16 __attribute__((ext_vector_type(16)));
typedef unsigned u32x4 __attribute__((ext_vector_type(4)));
typedef unsigned u32x2 __attribute__((ext_vector_type(2)));

__device__ __forceinline__ f32x16 mfma32(bf16x8 a, bf16x8 b, f32x16 c) { return __builtin_amdgcn_mfma_f32_32x32x16_bf16(a, b, c, 0, 0, 0); }
__device__ __forceinline__ unsigned cvt_pk_bf16(float lo, float hi) { unsigned r; asm volatile("v_cvt_pk_bf16_f32 %0, %1, %2" : "=v"(r) : "v"(lo), "v"(hi)); return r; }

namespace pg8 {
constexpr int BM = 256, BK = 64, HALF = 128, HTB = HALF * BK * 2, STAGE_BYTES = 8 * HTB, NXCD = 8, WGM = 8;
__host__ __device__ __forceinline__ int lds_byte(int r, int c) { const int st = (r >> 4) * 2 + (c >> 5), rr = r & 15, cc = c & 31, ob = rr * 64 + cc * 2; return st * 1024 + (ob ^ (((ob >> 9) & 1) << 5)); }
__host__ __device__ __forceinline__ void stage_rc(int b, int& R, int& C) { const int st = b / 1024, sb = b % 1024, swz = sb ^ (((sb >> 9) & 1) << 5); R = (st >> 1) * 16 + swz / 64; C = (st & 1) * 32 + (swz % 64) / 2; }
__host__ __device__ __forceinline__ int perm32(int rho) { const int n = rho >> 4, i = rho & 15; return 8 * (i >> 2) + 4 * n + (i & 3); }
struct Unit { int pm, pn; };
struct Gemm { const bf16_t* A; const bf16_t* Bt; int M, N, K; };
struct StaticOrder {
    int nM, nN, nwg, G, c;
    __host__ __device__ void init(int M, int N, int G_, int c_) { nM = M / BM; nN = N / BM; nwg = nM * nN; G = G_; c = c_; }
    __host__ __device__ bool next(int i, Unit& u) const {
        const long L = (long)i * G + c; if (L >= nwg) return false;
        int wgid = (int)L; { const int q = nwg / NXCD, r = nwg % NXCD, xcd = wgid % NXCD, off = wgid / NXCD; wgid = (xcd < r ? xcd * (q + 1) : r * (q + 1) + (xcd - r) * q) + off; }
        const int nig = WGM * nN, gid = wgid / nig, fm = gid * WGM, gsz = (nM - fm) < WGM ? (nM - fm) : WGM;
        u.pm = fm + ((wgid % nig) % gsz); u.pn = (wgid % nig) / gsz; return true;
    }
};
template <class Epi, class Sched>
__device__ __forceinline__ void gemm_phase(LAS unsigned char* lds, const Gemm g, const Sched& S, const Epi& E) {
    int tid_ = threadIdx.x; asm volatile("" : "+v"(tid_));
    const int tid = tid_, wid = __builtin_amdgcn_readfirstlane(tid >> 6), lane = tid & 63, wr = wid >> 2, wc = wid & 3, fr = lane & 15, fq = lane >> 4;
    const int K = g.K, nt = K / BK;
    unsigned voffA[2], voffB[2];
#pragma unroll
    for (int i = 0; i < 2; ++i) { int R, C; stage_rc(tid * 16 + i * 8192, R, C); const int Rb = Epi::PERM ? ((R & ~31) + perm32(R & 31)) : R;
        voffA[i] = (unsigned)(R * K + C) * 2u; voffB[i] = (unsigned)(Rb * K + C) * 2u; }
    const size_t kstep = (size_t)(BK * 2);
    const size_t hstep = (size_t)HALF * K * 2;
    const size_t tstep = 2 * hstep;
    const unsigned ldsw = (unsigned)wid * 1024u;
    const int aoff = lds_byte(wr * 64 + fr, fq * 8), boff = lds_byte(wc * 32 + fr, fq * 8);
#define PG8_SA(b, h) (((b) * 2 + (h)) * HTB)
#define PG8_SB(b, h) ((4 + (b) * 2 + (h)) * HTB)
#define PG8_STAGE(bufoff, gbase, voff) do { _Pragma("unroll") for (int _i = 0; _i < 2; ++_i) \
        __builtin_amdgcn_global_load_lds((const unsigned*)((const char*)(gbase) + (voff)[_i]), (LAS unsigned*)(lds + (bufoff) + ldsw + _i * 8192), 16, 0, 0); } while (0)
#define PG8_LDA(dst, b, h) do { _Pragma("unroll") for (int m = 0; m < 4; ++m) _Pragma("unroll") for (int k = 0; k < 2; ++k) dst[m][k] = *(const LAS bf16x8*)(lds + PG8_SA(b, h) + aoff + m * 2048 + k * 1024); } while (0)
#define PG8_LDB(dst, b, h) do { _Pragma("unroll") for (int n = 0; n < 2; ++n) _Pragma("unroll") for (int k = 0; k < 2; ++k) dst[n][k] = *(const LAS bf16x8*)(lds + PG8_SB(b, h) + boff + n * 2048 + k * 1024); } while (0)
#define PG8_MMA(ai, bj, At, Bt) do { __builtin_amdgcn_s_setprio(1); _Pragma("unroll") for (int m = 0; m < 4; ++m) _Pragma("unroll") for (int n = 0; n < 2; ++n) _Pragma("unroll") for (int k = 0; k < 2; ++k) \
        acc[ai][bj][m][n] = __builtin_amdgcn_mfma_f32_16x16x32_bf16(Bt[n][k], At[m][k], acc[ai][bj][m][n], 0, 0, 0); __builtin_amdgcn_s_setprio(0); } while (0)
#define PG8_WAIT_V(n) asm volatile("s_waitcnt vmcnt(" #n ")" ::: "memory")
#define PG8_WAIT_L(n) asm volatile("s_waitcnt lgkmcnt(" #n ")" ::: "memory")
#define PG8_BAR __builtin_amdgcn_s_barrier()
#define PG8_SCHED __builtin_amdgcn_sched_barrier(0)
    Unit cur, nxt; int ui = 0;
    if (!S.next(0, cur)) return;
    f32x4 acc[2][2][4][2];
#pragma unroll
    for (int a = 0; a < 2; ++a)
#pragma unroll
        for (int b = 0; b < 2; ++b)
#pragma unroll
            for (int m = 0; m < 4; ++m)
#pragma unroll
                for (int n = 0; n < 2; ++n) acc[a][b][m][n] = (f32x4){0.f, 0.f, 0.f, 0.f};
    bf16x8 At[4][2], B0[2][2], B1[2][2];
    const char* cA = (const char*)g.A + (size_t)cur.pm * tstep; const char* cB = (const char*)g.Bt + (size_t)cur.pn * tstep;
    PG8_STAGE(PG8_SB(0, 0), cB, voffB); PG8_STAGE(PG8_SA(0, 0), cA, voffA); PG8_STAGE(PG8_SB(0, 1), cB + hstep, voffB); PG8_STAGE(PG8_SA(0, 1), cA + hstep, voffA);
    if (wr == 1) PG8_BAR;
    PG8_WAIT_V(4); PG8_BAR;
    PG8_STAGE(PG8_SB(1, 0), cB + kstep, voffB); PG8_STAGE(PG8_SA(1, 0), cA + kstep, voffA); PG8_STAGE(PG8_SB(1, 1), cB + hstep + kstep, voffB);
    PG8_WAIT_V(6); PG8_BAR;
    for (;;) {
        const bool has_next = S.next(ui + 1, nxt);
        const char* nA = has_next ? (const char*)g.A + (size_t)nxt.pm * tstep : cA; const char* nB = has_next ? (const char*)g.Bt + (size_t)nxt.pn * tstep : cB;
#pragma nounroll
        for (int t = 0; t < nt; t += 2) {
            const bool last = (t == nt - 2);
            const char* a1 = cA + (size_t)(t + 1) * kstep;
            const char* a2 = last ? nA : cA + (size_t)(t + 2) * kstep; const char* b2 = last ? nB : cB + (size_t)(t + 2) * kstep;
            const char* a3 = a2 + kstep; const char* b3 = b2 + kstep;
            PG8_LDB(B0, 0, 0); PG8_SCHED; PG8_LDA(At, 0, 0); PG8_STAGE(PG8_SA(1, 1), a1 + hstep, voffA);
            PG8_WAIT_L(8); PG8_BAR; PG8_WAIT_L(0); PG8_MMA(0, 0, At, B0); PG8_BAR; PG8_SCHED;
            PG8_LDB(B1, 0, 1); PG8_STAGE(PG8_SB(0, 0), b2, voffB);
            PG8_BAR; PG8_WAIT_L(0); PG8_MMA(0, 1, At, B1); PG8_BAR;
            PG8_LDA(At, 0, 1); PG8_STAGE(PG8_SA(0, 0), a2, voffA);
            PG8_BAR; PG8_WAIT_L(0); PG8_MMA(1, 0, At, B0); PG8_BAR; PG8_SCHED;
            PG8_STAGE(PG8_SB(0, 1), b2 + hstep, voffB);
            PG8_WAIT_V(6); PG8_BAR; PG8_MMA(1, 1, At, B1); PG8_BAR;
            PG8_LDB(B0, 1, 0); PG8_SCHED; PG8_LDA(At, 1, 0); PG8_STAGE(PG8_SA(0, 1), a2 + hstep, voffA);
            PG8_WAIT_L(8); PG8_BAR; PG8_WAIT_L(0); PG8_MMA(0, 0, At, B0); PG8_BAR; PG8_SCHED;
            PG8_LDB(B1, 1, 1); PG8_STAGE(PG8_SB(1, 0), b3, voffB);
            PG8_BAR; PG8_WAIT_L(0); PG8_MMA(0, 1, At, B1); PG8_BAR;
            PG8_LDA(At, 1, 1); PG8_STAGE(PG8_SA(1, 0), a3, voffA);
            PG8_BAR; PG8_WAIT_L(0); PG8_MMA(1, 0, At, B0); PG8_BAR; PG8_SCHED;
            PG8_STAGE(PG8_SB(1, 1), b3 + hstep, voffB);
            PG8_WAIT_V(6); PG8_BAR; PG8_MMA(1, 1, At, B1); PG8_BAR;
        }
        E(acc, cur, wr, wc, fr, fq);
        if (!has_next) break;
#pragma unroll
        for (int a = 0; a < 2; ++a)
#pragma unroll
            for (int b = 0; b < 2; ++b)
#pragma unroll
                for (int m = 0; m < 4; ++m)
#pragma unroll
                    for (int n = 0; n < 2; ++n) acc[a][b][m][n] = (f32x4){0.f, 0.f, 0.f, 0.f};
        cur = nxt; cA = nA; cB = nB; ++ui;
    }
    PG8_WAIT_V(0);
    if (wr == 0) PG8_BAR;
    PG8_BAR;
#undef PG8_SA
#undef PG8_SB
#undef PG8_STAGE
#undef PG8_LDA
#undef PG8_LDB
#undef PG8_MMA
#undef PG8_WAIT_V
#undef PG8_WAIT_L
#undef PG8_BAR
#undef PG8_SCHED
}
}

enum { GT_AQ = 0, GT_AK = 1, GT_AV = 2, GT_B = 3, GT_CQ = 4, GT_CKV = 5, GT_KR = 6, GT_PAD = 7 };
__host__ __device__ __forceinline__ void in_group(int g, int& type, int& sub) {
    if (g < 2) { type = GT_AK; sub = g; } else if (g < 4) { type = GT_AV; sub = g - 2; } else if (g < 8) { type = GT_CKV; sub = g - 4; }
    else if (g == 8) { type = GT_KR; sub = 0; } else if (g < 12) { type = GT_PAD; sub = 0; } else if (g < 18) { type = GT_AQ; sub = g - 12; }
    else if (g < 24) { type = GT_CQ; sub = g - 18; } else { type = GT_B; sub = g - 24; }
}
__device__ __forceinline__ int colmap(int mode, int r) {
    const int pn = r >> 8, ct = r & 255, bj = ct >> 7, wc = (ct >> 5) & 3, j = ct & 31, g = 4 * pn + wc, e = 32 * bj + j;
    if (mode == 0) {
        int type, sub; in_group(g, type, sub);
        switch (type) { case GT_AQ: return 64 * sub + e; case GT_AK: return 384 + 64 * sub + e; case GT_AV: return 512 + 64 * sub + e; case GT_B: return 640 + 64 * sub + e;
            case GT_CQ: return 896 + 64 * sub + e; case GT_CKV: return 1280 + 64 * sub + e; case GT_KR: return (j < 16) ? 1536 + 16 * bj + j : -1; default: return -1; }
    } else if (mode == 1) {
        if (g < 6) return 96 * g + e; if (g < 9) { const int head = 2 * (g - 6) + (j >> 4); return 96 * head + 64 + 16 * bj + (j & 15); } return -1;
    } else if (mode == 2) {
        return 64 * g + e;
    }
    return r;
}
__device__ __forceinline__ void cvt_weights_unit(LAS float* tile  , const float* __restrict__ W, int K, int N, bf16_t* __restrict__ dst, int mode, const float* __restrict__ kgain, int r0, int k0) {
    int tid_ = threadIdx.x; asm volatile("" : "+v"(tid_));
    const int tid = tid_;
    const int jj = tid & 63; const int sc = colmap(mode, r0 + jj);
#pragma unroll
    for (int i = 0; i < 8; ++i) { const int kk = (tid >> 6) + 8 * i; float v = 0.f; if (sc >= 0) v = W[(size_t)(k0 + kk) * N + sc]; if (kgain) v *= kgain[k0 + kk]; tile[kk * 65 + jj] = v; }
    __syncthreads();
#pragma unroll
    for (int i = 0; i < 8; ++i) { const int rr = (tid >> 6) + 8 * i, kk = tid & 63; dst[(size_t)(r0 + rr) * K + k0 + kk] = f2bf(tile[kk * 65 + rr]); }
    __syncthreads();
}
struct CvtJob { const float* W; bf16_t* dst; const float* kgain; int K, N, Npad, mode; };
__device__ __forceinline__ void cvt_job(LAS float* tile, const CvtJob j, int vb, int nvb) {
    const int nk = j.K / 64, nr = j.Npad / 64;
    for (int u = vb; u < nk * nr; u += nvb) cvt_weights_unit(tile, j.W, j.K, j.N, j.dst, j.mode, j.kgain, (u / nk) * 64, (u % nk) * 64);
}
__device__ __forceinline__ void cvt_flat(const float* __restrict__ src, bf16_t* __restrict__ dst, size_t n, int vb, int nvb) {
    int tid_ = threadIdx.x; asm volatile("" : "+v"(tid_));
    for (size_t i = ((size_t)vb * 512 + tid_) * 8; i < n; i += (size_t)nvb * 512 * 8) {
        const float4 a = *(const float4*)(src + i), b = *(const float4*)(src + i + 4);
        u32x4 o; o.x = cvt_pk_bf16(a.x, a.y); o.y = cvt_pk_bf16(a.z, a.w); o.z = cvt_pk_bf16(b.x, b.y); o.w = cvt_pk_bf16(b.z, b.w);
        *(u32x4*)(dst + i) = o;
    }
}
__device__ __forceinline__ void cvt_fp8_rows(const float* __restrict__ src, unsigned char* __restrict__ dst, float* __restrict__ scales, int nrows, int vb, int nvb) {
    int tid_ = threadIdx.x; asm volatile("" : "+v"(tid_));
    const int lane = tid_ & 63, wid = tid_ >> 6;
    for (int row = vb * 8 + wid; row < nrows; row += nvb * 8) {
        const float* sp = src + (size_t)row * 1024 + 16 * lane;
        f32x4 v[4]; float am = 0.f;
#pragma unroll
        for (int k = 0; k < 4; ++k) { v[k] = *(const f32x4*)(sp + 4 * k); am = fmaxf(am, fmaxf(fmaxf(fabsf(v[k][0]), fabsf(v[k][1])), fmaxf(fabsf(v[k][2]), fabsf(v[k][3])))); }
#pragma unroll
        for (int o = 32; o > 0; o >>= 1) am = fmaxf(am, __shfl_xor(am, o));
        const float sc = am > 0.f ? am * (1.f / 416.f) : 1.f, inv = am > 0.f ? 416.f / am : 0.f;
        u32x4 o4;
#pragma unroll
        for (int k = 0; k < 4; ++k) { int p = __builtin_amdgcn_cvt_pk_fp8_f32(v[k][0] * inv, v[k][1] * inv, 0, false); p = __builtin_amdgcn_cvt_pk_fp8_f32(v[k][2] * inv, v[k][3] * inv, p, true); o4[k] = (unsigned)p; }
        *(u32x4*)(dst + (size_t)row * 1024 + 16 * lane) = o4;
        if (lane == 0) scales[row] = sc;
    }
}
__device__ __forceinline__ void cvt_i8_rows(const float* __restrict__ src, signed char* __restrict__ dst, float* __restrict__ scales, int nrows, int vb, int nvb) {
    int tid_ = threadIdx.x; asm volatile("" : "+v"(tid_));
    const int lane = tid_ & 63, wid = tid_ >> 6;
    for (int row = vb * 8 + wid; row < nrows; row += nvb * 8) {
        const float* sp = src + (size_t)row * 1024 + 16 * lane;
        f32x4 v[4]; float am = 0.f;
#pragma unroll
        for (int k = 0; k < 4; ++k) { v[k] = *(const f32x4*)(sp + 4 * k); am = fmaxf(am, fmaxf(fmaxf(fabsf(v[k][0]), fabsf(v[k][1])), fmaxf(fabsf(v[k][2]), fabsf(v[k][3])))); }
#pragma unroll
        for (int o = 32; o > 0; o >>= 1) am = fmaxf(am, __shfl_xor(am, o));
        const float sc = am > 0.f ? am * (1.f / 127.f) : 1.f, inv = am > 0.f ? 127.f / am : 0.f;
        u32x4 o4;
#pragma unroll
        for (int k = 0; k < 4; ++k) { const int q0 = (int)rintf(v[k][0] * inv), q1 = (int)rintf(v[k][1] * inv), q2 = (int)rintf(v[k][2] * inv), q3 = (int)rintf(v[k][3] * inv);
            o4[k] = (unsigned)(q0 & 0xff) | ((unsigned)(q1 & 0xff) << 8) | ((unsigned)(q2 & 0xff) << 16) | ((unsigned)(q3 & 0xff) << 24); }
        *(u32x4*)(dst + (size_t)row * 1024 + 16 * lane) = o4;
        if (lane == 0) scales[row] = sc;
    }
}
struct Inputs {
    const float *x, *c, *ctx, *c_ctx, *ada_w, *ada_b, *norm1_g, *norm2_g, *w_in, *gqa_qn_g, *gqa_kn_g, *pool_w, *pool_scale, *mla_qn_g, *mla_kvn_g, *mla_w_uq, *mla_w_ukv, *w_out, *peer_wq, *peer_subkeys, *peer_u, *peer_v, *final_g;
};
__device__ __forceinline__ void phase_cvt(LAS unsigned char* lds, const Inputs& in, const WS& w, int vb, int nvb) {
    LAS float* tile = (LAS float*)lds;
    for (int l = 0; l < 2; ++l) {
        cvt_job(tile, CvtJob{in.w_in + (size_t)l * 1024 * INC, w.WinT() + (size_t)l * 1792 * 1024, nullptr, 1024, INC, 1792, 0}, vb, nvb);
        cvt_job(tile, CvtJob{in.mla_w_uq + (size_t)l * 384 * 576, w.WuqT() + (size_t)l * 768 * 384, in.mla_qn_g + l * 384, 384, 576, 768, 1}, vb, nvb);
        cvt_job(tile, CvtJob{in.mla_w_ukv + (size_t)l * 256 * 768, w.WukvT() + (size_t)l * 768 * 256, in.mla_kvn_g + l * 256, 256, 768, 768, 2}, vb, nvb);
        cvt_job(tile, CvtJob{in.w_out + (size_t)l * 1024 * 1024, w.WoutT() + (size_t)l * 1024 * 1024, nullptr, 1024, 1024, 1024, 3}, vb, nvb);
        cvt_job(tile, CvtJob{in.peer_wq + (size_t)l * 1024 * 2048, w.WqT() + (size_t)l * 2048 * 1024, nullptr, 1024, 2048, 2048, 3}, vb, nvb);
    }
    cvt_flat(in.peer_subkeys, w.SubK(), (size_t)2 * 16 * 128 * 128, vb, nvb);
    { int tp_ = threadIdx.x; asm volatile("" : "+v"(tp_));
      for (int i = vb * 512 + tp_; i < 2 * 4 * 64 * 64; i += nvb * 512) { const int c = i & 63, d = (i >> 6) & 63, lg = i >> 12; w.PoolWT()[i] = f2bf(in.pool_w[(size_t)lg * 4096 + c * 64 + d]); } }
    cvt_i8_rows(in.peer_u, (signed char*)w.U8(), w.US(), 2 * NE, vb, nvb);
    cvt_fp8_rows(in.peer_v, w.V8(), w.VS(), 2 * NE, vb, nvb);
}

struct EpiIn {
    static constexpr bool PERM = true;
    WS w; const float* qn_g; const float* kn_g; int pm_base;
    __device__ __forceinline__ void operator()(const f32x4 (&acc)[2][2][4][2], const pg8::Unit& u, int wr, int wc, int fr, int fq) const {
        int type, sub; in_group(4 * u.pn + wc, type, sub);
        if (type == GT_PAD) return;
        const int pm = u.pm + pm_base; const bool isctx = pm >= 256; const int b = isctx ? pm - 256 : pm >> 3; const int t0 = isctx ? 0 : (pm & 7) * 256;
        const size_t rowbase = isctx ? (size_t)NL + (size_t)b * CTX : (size_t)b * S;
        const int keyoff = isctx ? 0 : CTX;
        float gain[2][8];
        if (type == GT_AQ) {
#pragma unroll
            for (int bj = 0; bj < 2; ++bj)
#pragma unroll
                for (int q = 0; q < 8; ++q) gain[bj][q] = qn_g[32 * bj + 8 * fq + q];
        } else if (type == GT_AK) {
#pragma unroll
            for (int bj = 0; bj < 2; ++bj)
#pragma unroll
                for (int q = 0; q < 8; ++q) gain[bj][q] = kn_g[32 * bj + 8 * fq + q];
        }
#pragma unroll
        for (int ai = 0; ai < 2; ++ai)
#pragma unroll
            for (int m = 0; m < 4; ++m) {
                const int t = t0 + 128 * ai + 64 * wr + 16 * m + fr; const size_t row = rowbase + t;
                float v[2][8];
#pragma unroll
                for (int bj = 0; bj < 2; ++bj)
#pragma unroll
                    for (int n = 0; n < 2; ++n)
#pragma unroll
                        for (int i = 0; i < 4; ++i) v[bj][4 * n + i] = acc[ai][bj][m][n][i];
                bf16_t* dst = nullptr;
                if (type == GT_AQ || type == GT_AK) {
                    float ss = 0.f;
#pragma unroll
                    for (int bj = 0; bj < 2; ++bj)
#pragma unroll
                        for (int q = 0; q < 8; ++q) ss += v[bj][q] * v[bj][q];
                    ss += __shfl_xor(ss, 16); ss += __shfl_xor(ss, 32);
                    const float rstd = rsqrtf(ss * (1.f / 64.f) + EPS);
#pragma unroll
                    for (int q = 0; q < 8; ++q) { float x1 = v[0][q] * rstd * gain[0][q], x2 = v[1][q] * rstd * gain[1][q];
                        if (!isctx) { const float2 cs = w.ROPA()[t * 32 + 8 * fq + q]; const float y1 = x1 * cs.x - x2 * cs.y, y2 = x1 * cs.y + x2 * cs.x; x1 = y1; x2 = y2; }
                        v[0][q] = x1; v[1][q] = x2; }
                    if (type == GT_AQ) dst = isctx ? w.Qgc() + (((size_t)b * 6 + sub) * CTX + t) * 64 : w.Qg() + (((size_t)b * 6 + sub) * S + t) * 64;
                    else dst = w.Kg() + (((size_t)b * 2 + sub) * KEYS + keyoff + t) * 64;
                } else if (type == GT_AV) { dst = w.Vg() + (((size_t)b * 2 + sub) * KEYS + keyoff + t) * 64;
                } else if (type == GT_B) { dst = w.Bp() + row * 256 + 64 * sub;
                } else if (type == GT_CQ || type == GT_CKV) {
                    float ss = 0.f;
#pragma unroll
                    for (int bj = 0; bj < 2; ++bj)
#pragma unroll
                        for (int q = 0; q < 8; ++q) ss += v[bj][q] * v[bj][q];
                    ss += __shfl_xor(ss, 16); ss += __shfl_xor(ss, 32);
                    if (type == GT_CQ) { if (fq == 0) w.SSQ()[row * 8 + sub] = ss; dst = w.CQ() + row * 384 + 64 * sub; }
                    else { if (fq == 0) w.SSKV()[row * 4 + sub] = ss; dst = w.CKV() + row * 256 + 64 * sub; }
                } else {
                    if (!isctx) {
#pragma unroll
                        for (int q = 0; q < 8; ++q) { const float2 cs = w.ROPC()[t * 16 + ((8 * fq + q) & 15)]; const float x1 = v[0][q], x2 = v[1][q]; v[0][q] = x1 * cs.x - x2 * cs.y; v[1][q] = x1 * cs.y + x2 * cs.x; } }
                    if (fq < 2) { bf16_t* kd = w.KR() + ((size_t)b * KEYS + keyoff + t) * 32;
#pragma unroll
                        for (int bj = 0; bj < 2; ++bj) { u32x4 o; o.x = cvt_pk_bf16(v[bj][0], v[bj][1]); o.y = cvt_pk_bf16(v[bj][2], v[bj][3]); o.z = cvt_pk_bf16(v[bj][4], v[bj][5]); o.w = cvt_pk_bf16(v[bj][6], v[bj][7]);
                            *(u32x4*)(kd + 16 * bj + 8 * fq) = o; } }
                    continue;
                }
#pragma unroll
                for (int bj = 0; bj < 2; ++bj) { u32x4 o; o.x = cvt_pk_bf16(v[bj][0], v[bj][1]); o.y = cvt_pk_bf16(v[bj][2], v[bj][3]); o.z = cvt_pk_bf16(v[bj][4], v[bj][5]); o.w = cvt_pk_bf16(v[bj][6], v[bj][7]);
                    *(u32x4*)(dst + 32 * bj + 8 * fq) = o; }
            }
    }
};
struct P1Order {
    pg8::StaticOrder so; int nctx_tiles, G, c;
    __device__ bool next(int i, pg8::Unit& u) const {
        const int L = i * G + c;
        if (L < 1792) return so.next(i, u);
        const int Lc = L - 1792; if (Lc >= 32 * nctx_tiles) return false;
        u.pm = 256 + (Lc & 31); u.pn = Lc >> 5; return true;
    }
};
__device__ __forceinline__ void phase_p1(LAS unsigned char* lds, const WS& w, const Inputs& in, int l, int vb, int nvb) {
    EpiIn E{w, in.gqa_qn_g + l * 64, in.gqa_kn_g + l * 64, 0};
    P1Order po; po.so.init(NL, 1792, nvb, vb); po.nctx_tiles = (l == 0) ? 7 : 3; po.G = nvb; po.c = vb;
    pg8::gemm_phase(lds, pg8::Gemm{w.H(), w.WinT() + (size_t)l * 1792 * 1024, NR, 1792, 1024}, po, E);
}

extern __shared__ __attribute__((aligned(16))) unsigned char dyn_lds[];
__global__ void __launch_bounds__(512, 2) k_cvt(Inputs in, WS w) { phase_cvt((LAS unsigned char*)dyn_lds, in, w, blockIdx.x, gridDim.x); }
__global__ void __launch_bounds__(512, 2) k_p1(Inputs in, WS w, int l) { phase_p1((LAS unsigned char*)dyn_lds, w, in, l, blockIdx.x, gridDim.x); }

struct EpiUq {
    static constexpr bool PERM = true;
    WS w;
    __device__ __forceinline__ void operator()(const f32x4 (&acc)[2][2][4][2], const pg8::Unit& u, int wr, int wc, int fr, int fq) const {
        const int g = 4 * u.pn + wc; if (g >= 9) return;
        const int pm = u.pm; const bool isctx = pm >= 256; const int b = isctx ? pm - 256 : pm >> 3; const int t0 = isctx ? 0 : (pm & 7) * 256;
        const size_t rowbase = isctx ? (size_t)NL + (size_t)b * CTX : (size_t)b * S;
        const int head = g < 6 ? g : 2 * (g - 6) + (fq >> 1);
#pragma unroll
        for (int ai = 0; ai < 2; ++ai)
#pragma unroll
            for (int m = 0; m < 4; ++m) {
                const int t = t0 + 128 * ai + 64 * wr + 16 * m + fr; const size_t row = rowbase + t;
                const float4 s0 = *(const float4*)(w.SSQ() + row * 8), s1 = *(const float4*)(w.SSQ() + row * 8 + 4);
                const float rstd = rsqrtf((s0.x + s0.y + s0.z + s0.w + s1.x + s1.y) * (1.f / 384.f) + EPS);
                float v[2][8];
#pragma unroll
                for (int bj = 0; bj < 2; ++bj)
#pragma unroll
                    for (int n = 0; n < 2; ++n)
#pragma unroll
                        for (int i = 0; i < 4; ++i) v[bj][4 * n + i] = acc[ai][bj][m][n][i] * rstd;
                bf16_t* hd = isctx ? w.Qmc() + (((size_t)b * 6 + head) * CTX + t) * 96 : w.Qm() + (((size_t)b * 6 + head) * S + t) * 96;
                if (g >= 6 && !isctx) {
#pragma unroll
                    for (int q = 0; q < 8; ++q) { const float2 cs = w.ROPC()[t * 16 + 8 * (fq & 1) + q]; const float x1 = v[0][q], x2 = v[1][q]; v[0][q] = x1 * cs.x - x2 * cs.y; v[1][q] = x1 * cs.y + x2 * cs.x; } }
#pragma unroll
                for (int bj = 0; bj < 2; ++bj) { u32x4 o; o.x = cvt_pk_bf16(v[bj][0], v[bj][1]); o.y = cvt_pk_bf16(v[bj][2], v[bj][3]); o.z = cvt_pk_bf16(v[bj][4], v[bj][5]); o.w = cvt_pk_bf16(v[bj][6], v[bj][7]);
                    bf16_t* d = g < 6 ? hd + 32 * bj + 8 * fq : hd + 64 + 16 * bj + 8 * (fq & 1);
                    *(u32x4*)d = o; }
            }
    }
};
struct EpiUkv {
    static constexpr bool PERM = true;
    WS w;
    __device__ __forceinline__ void operator()(const f32x4 (&acc)[2][2][4][2], const pg8::Unit& u, int wr, int wc, int fr, int fq) const {
        const int g = 4 * u.pn + wc;
        const int pm = u.pm; const bool isctx = pm >= 256; const int b = isctx ? pm - 256 : pm >> 3; const int t0 = isctx ? 0 : (pm & 7) * 256;
        const size_t rowbase = isctx ? (size_t)NL + (size_t)b * CTX : (size_t)b * S; const int keyoff = isctx ? 0 : CTX;
        bf16_t* base = ((g & 1) ? w.Vm() : w.Kmn()) + ((size_t)b * 6 + (g >> 1)) * KEYS * 64;
#pragma unroll
        for (int ai = 0; ai < 2; ++ai)
#pragma unroll
            for (int m = 0; m < 4; ++m) {
                const int t = t0 + 128 * ai + 64 * wr + 16 * m + fr; const size_t row = rowbase + t;
                const float4 s0 = *(const float4*)(w.SSKV() + row * 4);
                const float rstd = rsqrtf((s0.x + s0.y + s0.z + s0.w) * (1.f / 256.f) + EPS);
                bf16_t* d = base + (size_t)(keyoff + t) * 64;
#pragma unroll
                for (int bj = 0; bj < 2; ++bj) { const f32x4 a0 = acc[ai][bj][m][0] * rstd, a1 = acc[ai][bj][m][1] * rstd;
                    u32x4 o; o.x = cvt_pk_bf16(a0[0], a0[1]); o.y = cvt_pk_bf16(a0[2], a0[3]); o.z = cvt_pk_bf16(a1[0], a1[1]); o.w = cvt_pk_bf16(a1[2], a1[3]);
                    *(u32x4*)(d + 32 * bj + 8 * fq) = o; }
            }
    }
};
constexpr int POOL_X = 0, POOL_P = 272 * 128, POOL_BYTES = 272 * 128 + 256 * 128;
__device__ __forceinline__ void phase_pool(LAS unsigned char* lds, const WS& w, bf16_t* __restrict__ MIX, const bf16_t* __restrict__ WT  , const float* __restrict__ pool_scale, int nrows, int vb, int nvb) {
    int tid_ = threadIdx.x; asm volatile("" : "+v"(tid_));
    const int tid = tid_, lane = tid & 63, wid = __builtin_amdgcn_readfirstlane(tid >> 6), r32 = lane & 31, hi = lane >> 5;
    const int nunits = nrows >> 8;
    for (int u = vb; u < nunits; u += nvb) {
        const int row0 = u << 8; const bool isctx = row0 >= NL; const int L = isctx ? CTX : S; const int t0 = isctx ? 0 : (row0 & (S - 1)); const int seq0 = row0 - t0;
#pragma unroll 1
        for (int g = 0; g < 4; ++g) {
            const int wdw = 2 << g, half = wdw >> 1;
            for (int i = tid; i < 272 * 8; i += 512) { const int rr = i >> 3, ch = i & 7; int t = t0 - 8 + rr; t = t < 0 ? 0 : (t >= L ? L - 1 : t);
                *(LAS u32x4*)(lds + POOL_X + rr * 128 + ch * 16) = *(const u32x4*)(w.Bp() + (size_t)(seq0 + t) * 256 + g * 64 + ch * 8); }
            __syncthreads();
            { const int c = tid & 63, seg = tid >> 6; const LAS bf16_t* X = (const LAS bf16_t*)(lds + POOL_X) + c;
              int t = t0 + seg * 32; int lo = t - half, hiw = t - half + wdw; lo = lo < 0 ? 0 : lo; hiw = hiw > L ? L : hiw;
              float sum = 0.f; for (int q = lo; q < hiw; ++q) sum += bf2f(X[(q - t0 + 8) * 64]);
#pragma unroll 4
              for (int k = 0; k < 32; ++k, ++t) {
                  const int clo = (t - half) < 0 ? 0 : (t - half), chi = (t - half + wdw) > L ? L : (t - half + wdw);
                  const float pv = sum / (float)(chi - clo) - bf2f(X[(t - t0 + 8) * 64]);
                  const int r = seg * 32 + k; *((LAS bf16_t*)(lds + POOL_P + r * 128 + (((c >> 3) ^ ((r >> 1) & 7)) << 4)) + (c & 7)) = f2bf(pv);
                  const int add = t + 1 - half + wdw - 1, drop = t - half;
                  if (add < L) sum += bf2f(X[(add - t0 + 8) * 64]);
                  if (drop >= 0) sum -= bf2f(X[(drop - t0 + 8) * 64]);
              } }
            __syncthreads();
            { f32x16 o0 = {}, o1 = {};
              const bf16_t* wt = WT + (size_t)g * 4096 + (size_t)r32 * 64 + 8 * hi;
#pragma unroll
              for (int s = 0; s < 4; ++s) { const int row = wid * 32 + r32; const bf16x8 pf = *(const LAS bf16x8*)(lds + POOL_P + row * 128 + (((2 * s + hi) ^ ((row >> 1) & 7)) << 4));
                  o0 = mfma32(*(const bf16x8*)(wt + 16 * s), pf, o0); o1 = mfma32(*(const bf16x8*)(wt + 32 * 64 + 16 * s), pf, o1); }
              bf16_t* op = MIX + (size_t)(row0 + wid * 32 + r32) * 1024 + 384 + g * 64 + 4 * hi; const float* ps = pool_scale + g * 64 + 4 * hi;
#pragma unroll
              for (int q = 0; q < 4; ++q) { const f32x4 s0 = *(const f32x4*)(ps + 8 * q), s1 = *(const f32x4*)(ps + 32 + 8 * q); u32x2 a, b;
                  a.x = cvt_pk_bf16(o0[4 * q] * s0[0], o0[4 * q + 1] * s0[1]); a.y = cvt_pk_bf16(o0[4 * q + 2] * s0[2], o0[4 * q + 3] * s0[3]);
                  b.x = cvt_pk_bf16(o1[4 * q] * s1[0], o1[4 * q + 1] * s1[1]); b.y = cvt_pk_bf16(o1[4 * q + 2] * s1[2], o1[4 * q + 3] * s1[3]);
                  *(u32x2*)(op + 8 * q) = a; *(u32x2*)(op + 32 + 8 * q) = b; } }
            __syncthreads();
        }
    }
}
__device__ __forceinline__ void phase_p2(LAS unsigned char* lds, const WS& w, const Inputs& in, int l, int vb, int nvb, int parts = 7) {
    pg8::StaticOrder so;
    if (parts & 1) { EpiUq E{w}; const int M = l == 0 ? NR : NL; so.init(M, 768, nvb, vb); pg8::gemm_phase(lds, pg8::Gemm{w.CQ(), w.WuqT() + (size_t)l * 768 * 384, M, 768, 384}, so, E); }
    if (parts & 2) { EpiUkv E{w}; so.init(NR, 768, nvb, vb); pg8::gemm_phase(lds, pg8::Gemm{w.CKV(), w.WukvT() + (size_t)l * 768 * 256, NR, 768, 256}, so, E); }
    if (parts & 4) phase_pool(lds, w, w.H(), w.PoolWT() + (size_t)l * 4 * 64 * 64, in.pool_scale + l * 256, l == 0 ? NR : NL, vb, nvb);
}

struct EpiOut {
    static constexpr bool PERM = false;
    const float* xin_l; const float* xin_c; float* xout_l; float* xout_c; const float* gate;
    __device__ __forceinline__ void operator()(const f32x4 (&acc)[2][2][4][2], const pg8::Unit& u, int wr, int wc, int fr, int fq) const {
        const int pm = u.pm; const bool isctx = pm >= 256; const int mr = isctx ? 32 : pm >> 3;
        const size_t r0 = (isctx ? (size_t)(pm - 256) * 256 : (size_t)pm * 256) + wr * 64 + fr;
        const float* xi = isctx ? xin_c : xin_l; float* xo = isctx ? xout_c : xout_l;
        const int col0 = u.pn * 256 + wc * 32 + 4 * fq;
        f32x4 gv[2][2];
#pragma unroll
        for (int bj = 0; bj < 2; ++bj)
#pragma unroll
            for (int n = 0; n < 2; ++n) gv[bj][n] = *(const f32x4*)(gate + (size_t)mr * 6144 + col0 + bj * 128 + n * 16);
#pragma unroll
        for (int ai = 0; ai < 2; ++ai)
#pragma unroll
            for (int m = 0; m < 4; ++m) { const size_t off = (r0 + ai * 128 + m * 16) * 1024 + col0;
#pragma unroll
                for (int bj = 0; bj < 2; ++bj)
#pragma unroll
                    for (int n = 0; n < 2; ++n) { const f32x4 xv = *(const f32x4*)(xi + off + bj * 128 + n * 16); *(f32x4*)(xo + off + bj * 128 + n * 16) = xv + gv[bj][n] * acc[ai][bj][m][n]; } }
    }
};
__device__ __forceinline__ void phase_p4(LAS unsigned char* lds, const WS& w, const Inputs& in, float* XL, int l, int vb, int nvb, bool shadow = false) {
    const float* MODl = w.MOD() + (size_t)l * 33 * 6144;
    EpiOut E{l == 0 ? in.x : XL, l == 0 ? in.ctx : w.XC(), shadow ? (float*)w.PQ() : XL, shadow ? (float*)w.PQ() + (size_t)NL * 1024 : w.XC(), MODl + 2 * 1024};
    const int M = l == 0 ? NR : NL;
    pg8::StaticOrder so; so.init(M, 1024, nvb, vb);
    pg8::gemm_phase(lds, pg8::Gemm{w.H(), w.WoutT() + (size_t)l * 1024 * 1024, M, 1024, 1024}, so, E);
}

__device__ __forceinline__ void phase_modulate(const float* __restrict__ XLp, const float* __restrict__ XCp, bf16_t* __restrict__ Hout, const float* __restrict__ g, const float* __restrict__ MODl, int si, int nrows, int vb, int nvb, signed char* __restrict__ H8 = nullptr, float* __restrict__ HS = nullptr) {
    int tid_ = threadIdx.x; asm volatile("" : "+v"(tid_));
    const int tid = tid_, lane = tid & 63, wid = tid >> 6;
    f32x4 gv[4];
#pragma unroll
    for (int i = 0; i < 4; ++i) gv[i] = *(const f32x4*)(g + 256 * i + 4 * lane);
    for (int row = vb * 8 + wid; row < nrows; row += nvb * 8) {
        const bool isctx = row >= NL; const float* xp = isctx ? XCp + (size_t)(row - NL) * 1024 : XLp + (size_t)row * 1024; const int mr = isctx ? 32 : row / S;
        f32x4 x[4]; float ss = 0.f;
#pragma unroll
        for (int i = 0; i < 4; ++i) { x[i] = *(const f32x4*)(xp + 256 * i + 4 * lane); ss += x[i][0] * x[i][0] + x[i][1] * x[i][1] + x[i][2] * x[i][2] + x[i][3] * x[i][3]; }
        ss = wave_sum(ss); const float rstd = rsqrtf(ss * (1.f / 1024.f) + EPS);
        const float* sh = MODl + (size_t)mr * 6144 + si * 1024;
        f32x4 y[4]; float am = 0.f;
#pragma unroll
        for (int i = 0; i < 4; ++i) { const f32x4 shv = *(const f32x4*)(sh + 256 * i + 4 * lane), scv = *(const f32x4*)(sh + 1024 + 256 * i + 4 * lane);
            y[i] = x[i] * rstd * gv[i] * (scv + 1.f) + shv;
            am = fmaxf(am, fmaxf(fmaxf(fabsf(y[i][0]), fabsf(y[i][1])), fmaxf(fabsf(y[i][2]), fabsf(y[i][3]))));
            u32x2 o; o.x = cvt_pk_bf16(y[i][0], y[i][1]); o.y = cvt_pk_bf16(y[i][2], y[i][3]);
            *(u32x2*)(Hout + (size_t)row * 1024 + 256 * i + 4 * lane) = o; }
        if (H8) {
#pragma unroll
            for (int o = 32; o > 0; o >>= 1) am = fmaxf(am, __shfl_xor(am, o));
            const float inv = am > 0.f ? 127.f / am : 0.f;
#pragma unroll
            for (int i = 0; i < 4; ++i) { const int q0 = (int)rintf(y[i][0] * inv), q1 = (int)rintf(y[i][1] * inv), q2 = (int)rintf(y[i][2] * inv), q3 = (int)rintf(y[i][3] * inv);
                *(unsigned*)(H8 + (size_t)row * 1024 + 256 * i + 4 * lane) = (unsigned)(q0 & 0xff) | ((unsigned)(q1 & 0xff) << 8) | ((unsigned)(q2 & 0xff) << 16) | ((unsigned)(q3 & 0xff) << 24); }
            if (lane == 0) HS[row] = am > 0.f ? am * (1.f / 127.f) : 1.f;
        }
    }
}

struct EpiPQ {
    static constexpr bool PERM = true;
    bf16_t* PQ;
    __device__ __forceinline__ void operator()(const f32x4 (&acc)[2][2][4][2], const pg8::Unit& u, int wr, int wc, int fr, int fq) const {
        const size_t r0 = (size_t)u.pm * 256 + wr * 64 + fr; const int col0 = u.pn * 256 + wc * 32 + 8 * fq;
#pragma unroll
        for (int ai = 0; ai < 2; ++ai)
#pragma unroll
            for (int m = 0; m < 4; ++m) { bf16_t* d = PQ + (r0 + ai * 128 + m * 16) * 2048 + col0;
#pragma unroll
                for (int bj = 0; bj < 2; ++bj) { const f32x4 a0 = acc[ai][bj][m][0], a1 = acc[ai][bj][m][1];
                    u32x4 o; o.x = cvt_pk_bf16(a0[0], a0[1]); o.y = cvt_pk_bf16(a0[2], a0[3]); o.z = cvt_pk_bf16(a1[0], a1[1]); o.w = cvt_pk_bf16(a1[2], a1[3]);
                    *(u32x4*)(d + bj * 128) = o; } }
    }
};
__device__ __forceinline__ void phase_p6a(LAS unsigned char* lds, const WS& w, int l, int vb, int nvb) {
    EpiPQ E{w.PQ()}; const int M = l == 0 ? NR : NL;
    pg8::StaticOrder so; so.init(M, 2048, nvb, vb);
    pg8::gemm_phase(lds, pg8::Gemm{w.H(), w.WqT() + (size_t)l * 2048 * 1024, M, 2048, 1024}, so, E);
}

__global__ void __launch_bounds__(512, 2) k_p2(Inputs in, WS w, int l) { phase_p2((LAS unsigned char*)dyn_lds, w, in, l, blockIdx.x, gridDim.x); }
__global__ void __launch_bounds__(512, 2) k_p4(Inputs in, WS w, float* XL, int l) { phase_p4((LAS unsigned char*)dyn_lds, w, in, XL, l, blockIdx.x, gridDim.x); }
__global__ void __launch_bounds__(512, 2) k_p5(WS w, const float* XL, const float* g, const float* MODl, int si, int nrows) { phase_modulate(XL, w.XC(), w.H(), g, MODl, si, nrows, blockIdx.x, gridDim.x); }
__global__ void __launch_bounds__(512, 2) k_p6a(WS w, int l) { phase_p6a((LAS unsigned char*)dyn_lds, w, l, blockIdx.x, gridDim.x); }

using bf16x2_t = __attribute__((ext_vector_type(2))) __bf16;
typedef float f32x2 __attribute__((ext_vector_type(2)));
__device__ __forceinline__ float gelu_fast(float x) {
    const float u2 = 1.5957691216057308f * (x + 0.044715f * x * x * x);
    return x * __builtin_amdgcn_rcpf(1.f + __builtin_amdgcn_exp2f(-1.4426950408889634f * u2));
}
#define DPPF(v, ctrl) __builtin_bit_cast(float, __builtin_amdgcn_update_dpp(0, __builtin_bit_cast(int, (v)), (ctrl), 0xf, 0xf, true))
__device__ __forceinline__ float reduce8(float p0, float p1, float p2, float p3, float p4, float p5, float p6, float p7, int lane) {
    auto s01 = __builtin_amdgcn_permlane32_swap(__float_as_uint(p0), __float_as_uint(p1), false, false);
    auto s23 = __builtin_amdgcn_permlane32_swap(__float_as_uint(p2), __float_as_uint(p3), false, false);
    auto s45 = __builtin_amdgcn_permlane32_swap(__float_as_uint(p4), __float_as_uint(p5), false, false);
    auto s67 = __builtin_amdgcn_permlane32_swap(__float_as_uint(p6), __float_as_uint(p7), false, false);
    const float q0 = __uint_as_float(s01[0]) + __uint_as_float(s01[1]), q1 = __uint_as_float(s23[0]) + __uint_as_float(s23[1]);
    const float q2 = __uint_as_float(s45[0]) + __uint_as_float(s45[1]), q3 = __uint_as_float(s67[0]) + __uint_as_float(s67[1]);
    auto t0 = __builtin_amdgcn_permlane16_swap(__float_as_uint(q0), __float_as_uint(q1), false, false);
    auto t1 = __builtin_amdgcn_permlane16_swap(__float_as_uint(q2), __float_as_uint(q3), false, false);
    float r0 = __uint_as_float(t0[0]) + __uint_as_float(t0[1]);
    float r1 = __uint_as_float(t1[0]) + __uint_as_float(t1[1]);
    r0 += DPPF(r0, 0x128); r1 += DPPF(r1, 0x128);
    float z = (lane & 8) ? r1 : r0;
    z += DPPF(z, 0x141);
    z += DPPF(z, 0xB1);
    z += DPPF(z, 0x4E);
    return z;
}
struct P7Args {
    const bf16_t* H2; const unsigned* EG; const unsigned char* U8; const unsigned char* V8; const float* US; const float* VS;
    float* XL; float* XC; const float* gate2;
    int nrows;
    int mode;
    bf16_t* Hnext; const float* gnext; const float* MODnext;
    const float* final_g;
};
__device__ __forceinline__ float reduce4(float p0, float p1, float p2, float p3) {
    auto s01 = __builtin_amdgcn_permlane32_swap(__float_as_uint(p0), __float_as_uint(p1), false, false);
    auto s23 = __builtin_amdgcn_permlane32_swap(__float_as_uint(p2), __float_as_uint(p3), false, false);
    const float q0 = __uint_as_float(s01[0]) + __uint_as_float(s01[1]), q1 = __uint_as_float(s23[0]) + __uint_as_float(s23[1]);
    auto s = __builtin_amdgcn_permlane16_swap(__float_as_uint(q0), __float_as_uint(q1), false, false);
    float r = __uint_as_float(s[0]) + __uint_as_float(s[1]);
    r += DPPF(r, 0x128); r += DPPF(r, 0x124); r += DPPF(r, 0x122); r += DPPF(r, 0x121);
    return r;
}
#define P7_EID(c, j) ((int)(__builtin_amdgcn_readlane((int)((c) < 16 ? eg : eg2), (4 * (c) + (j)) & 63) >> 16) & 0xffff)
#define P7_LOADS(BUF, c) do { _Pragma("unroll") for (int j_ = 0; j_ < 4; ++j_) { const size_t e_ = (size_t)P7_EID(c, j_) * 1024 + 16 * lane; \
        BUF##u[j_] = *(const u32x4*)(a.U8 + e_); BUF##v[j_] = *(const u32x4*)(a.V8 + e_); } } while (0)
__device__ __forceinline__ float p7_dot(const u32x4 u, const float (&h)[16]) {
    float s = 0.f;
#pragma unroll
    for (int k = 0; k < 4; ++k) { const f32x2 lo = __builtin_amdgcn_cvt_pk_f32_fp8((int)u[k], false), hi2 = __builtin_amdgcn_cvt_pk_f32_fp8((int)u[k], true);
        s = __builtin_fmaf(lo.x, h[4 * k], s); s = __builtin_fmaf(lo.y, h[4 * k + 1], s); s = __builtin_fmaf(hi2.x, h[4 * k + 2], s); s = __builtin_fmaf(hi2.y, h[4 * k + 3], s); }
    return s;
}
__device__ __forceinline__ void p7_axpy(const u32x4 v, float wj, float (&out)[16]) {
#pragma unroll
    for (int k = 0; k < 4; ++k) { const f32x2 lo = __builtin_amdgcn_cvt_pk_f32_fp8((int)v[k], false), hi2 = __builtin_amdgcn_cvt_pk_f32_fp8((int)v[k], true);
        out[4 * k] = __builtin_fmaf(wj, lo.x, out[4 * k]); out[4 * k + 1] = __builtin_fmaf(wj, lo.y, out[4 * k + 1]); out[4 * k + 2] = __builtin_fmaf(wj, hi2.x, out[4 * k + 2]); out[4 * k + 3] = __builtin_fmaf(wj, hi2.y, out[4 * k + 3]); }
}
#define P7_RL(x, l) __builtin_bit_cast(float, __builtin_amdgcn_readlane(__builtin_bit_cast(int, (x)), (l)))
#define P7_COMPUTE(BUF, c) do { \
    const float r_ = reduce4(p7_dot(BUF##u[0], h), p7_dot(BUF##u[1], h), p7_dot(BUF##u[2], h), p7_dot(BUF##u[3], h)); \
    const unsigned ege_ = (unsigned)__shfl((int)((c) < 16 ? eg : eg2), (4 * (c) + myk) & 63); const int eid_ = (int)(ege_ >> 16); \
    const float w_ = __uint_as_float(ege_ << 16) * gelu_fast(r_ * a.US[eid_]) * a.VS[eid_]; \
      \
    p7_axpy(BUF##v[0], P7_RL(w_, 0), out); p7_axpy(BUF##v[1], P7_RL(w_, 32), out); p7_axpy(BUF##v[2], P7_RL(w_, 16), out); p7_axpy(BUF##v[3], P7_RL(w_, 48), out); } while (0)

__device__ __forceinline__ void phase_p7(const P7Args& a, int vb, int nvb) {
    int tid_ = threadIdx.x; asm volatile("" : "+v"(tid_));
    const int lane = tid_ & 63, wid = __builtin_amdgcn_readfirstlane(tid_ >> 6);
    const int myk = (((lane >> 4) & 1) << 1) | (lane >> 5);
    for (int row = vb * 8 + wid; row < a.nrows; row += nvb * 8) {
        const bool isctx = row >= NL; float* xp = (isctx ? a.XC + (size_t)(row - NL) * 1024 : a.XL + (size_t)row * 1024) + 16 * lane; const int mr = isctx ? 32 : row / S;
        float h[16];
        { const u32x4 h0 = *(const u32x4*)(a.H2 + (size_t)row * 1024 + 16 * lane), h1 = *(const u32x4*)(a.H2 + (size_t)row * 1024 + 16 * lane + 8);
#pragma unroll
          for (int k = 0; k < 4; ++k) { h[2 * k] = __uint_as_float(h0[k] << 16); h[2 * k + 1] = __uint_as_float(h0[k] & 0xffff0000u); h[8 + 2 * k] = __uint_as_float(h1[k] << 16); h[8 + 2 * k + 1] = __uint_as_float(h1[k] & 0xffff0000u); } }
        const unsigned eg = a.EG[(size_t)row * 128 + lane], eg2 = a.EG[(size_t)row * 128 + 64 + lane];
        float out[16];
#pragma unroll
        for (int r = 0; r < 16; ++r) out[r] = 0.f;
        u32x4 Au[4], Av[4], Bu[4], Bv[4];
        P7_LOADS(A, 0);
#pragma unroll 1
        for (int c = 0; c < 32; c += 2) {
            P7_LOADS(B, c + 1);
            P7_COMPUTE(A, c);
            if (c + 2 < 32) P7_LOADS(A, c + 2);
            P7_COMPUTE(B, c + 1);
        }
        const float* gp = a.gate2 + (size_t)mr * 6144 + 16 * lane;
        f32x4 xv[4]; float ss = 0.f;
#pragma unroll
        for (int k = 0; k < 4; ++k) { const f32x4 x0 = *(const f32x4*)(xp + 4 * k), g0 = *(const f32x4*)(gp + 4 * k);
            f32x4 o; o[0] = out[4 * k]; o[1] = out[4 * k + 1]; o[2] = out[4 * k + 2]; o[3] = out[4 * k + 3];
            xv[k] = x0 + g0 * o; ss += xv[k][0] * xv[k][0] + xv[k][1] * xv[k][1] + xv[k][2] * xv[k][2] + xv[k][3] * xv[k][3]; }
        if (a.mode != 2) {
#pragma unroll
            for (int k = 0; k < 4; ++k) *(f32x4*)(xp + 4 * k) = xv[k];
        }
        if (a.mode != 0) {
            ss = wave_sum(ss); const float rstd = rsqrtf(ss * (1.f / 1024.f) + EPS);
            if (a.mode == 2) {
#pragma unroll
                for (int k = 0; k < 4; ++k) *(f32x4*)(xp + 4 * k) = xv[k] * rstd * *(const f32x4*)(a.final_g + 16 * lane + 4 * k);
            } else {
                const float* sh = a.MODnext + (size_t)mr * 6144 + 16 * lane; f32x4 y[4];
#pragma unroll
                for (int k = 0; k < 4; ++k) y[k] = xv[k] * rstd * *(const f32x4*)(a.gnext + 16 * lane + 4 * k) * (*(const f32x4*)(sh + 1024 + 4 * k) + 1.f) + *(const f32x4*)(sh + 4 * k);
                u32x4 o0, o1; o0.x = cvt_pk_bf16(y[0][0], y[0][1]); o0.y = cvt_pk_bf16(y[0][2], y[0][3]); o0.z = cvt_pk_bf16(y[1][0], y[1][1]); o0.w = cvt_pk_bf16(y[1][2], y[1][3]);
                o1.x = cvt_pk_bf16(y[2][0], y[2][1]); o1.y = cvt_pk_bf16(y[2][2], y[2][3]); o1.z = cvt_pk_bf16(y[3][0], y[3][1]); o1.w = cvt_pk_bf16(y[3][2], y[3][3]);
                *(u32x4*)(a.Hnext + (size_t)row * 1024 + 16 * lane) = o0; *(u32x4*)(a.Hnext + (size_t)row * 1024 + 16 * lane + 8) = o1;
            }
        }
    }
}
__device__ __forceinline__ int p7_doti(const u32x4 u, const u32x4 h) {
    int s = __builtin_amdgcn_sdot4((int)u[0], (int)h[0], 0, false); s = __builtin_amdgcn_sdot4((int)u[1], (int)h[1], s, false); s = __builtin_amdgcn_sdot4((int)u[2], (int)h[2], s, false); return __builtin_amdgcn_sdot4((int)u[3], (int)h[3], s, false);
}
#define DPPI(v, ctrl) __builtin_amdgcn_update_dpp(0, (v), (ctrl), 0xf, 0xf, true)
__device__ __forceinline__ int reduce8i(int p0, int p1, int p2, int p3, int p4, int p5, int p6, int p7, int lane) {
    auto s01 = __builtin_amdgcn_permlane32_swap((unsigned)p0, (unsigned)p1, false, false); auto s23 = __builtin_amdgcn_permlane32_swap((unsigned)p2, (unsigned)p3, false, false);
    auto s45 = __builtin_amdgcn_permlane32_swap((unsigned)p4, (unsigned)p5, false, false); auto s67 = __builtin_amdgcn_permlane32_swap((unsigned)p6, (unsigned)p7, false, false);
    const unsigned q0 = s01[0] + s01[1], q1 = s23[0] + s23[1], q2 = s45[0] + s45[1], q3 = s67[0] + s67[1];
    auto t0 = __builtin_amdgcn_permlane16_swap(q0, q1, false, false); auto t1 = __builtin_amdgcn_permlane16_swap(q2, q3, false, false);
    int r0 = (int)(t0[0] + t0[1]), r1 = (int)(t1[0] + t1[1]);
    r0 += DPPI(r0, 0x128); r1 += DPPI(r1, 0x128);
    int z = (lane & 8) ? r1 : r0;
    z += DPPI(z, 0x141); z += DPPI(z, 0xB1); z += DPPI(z, 0x4E);
    return z;
}
struct P7AArgs { const signed char* H8; const float* HS; const unsigned* EG; const unsigned char* U8; const float* US; const float* VS; unsigned* WE; int nrows; };
struct P7Chunk { u32x4 u[8]; u32x4 hq; float hs; unsigned ege; int entv; float us, vs; };
template <int PM>
__device__ __forceinline__ void phase_p7a(const P7AArgs& a, int part, int prank, int nvb) {
    int tid_ = threadIdx.x; asm volatile("" : "+v"(tid_));
    const int lane = tid_ & 63, wid = __builtin_amdgcn_readfirstlane(tid_ >> 6);
    const int nw = (nvb >> 3) * 8, wrank = prank * 8 + wid;
    const int myk = ((((lane >> 4) & 1) << 1) | (lane >> 5)) + 4 * ((lane >> 3) & 1);
    const int lastrow = a.nrows - 1;
    int tok = wrank;
    unsigned feg0 = a.EG[(size_t)tok * 128 + lane], feg1 = a.EG[(size_t)tok * 128 + 64 + lane];
    u32x4 fh0 = *(const u32x4*)(a.H8 + (size_t)tok * 1024 + 16 * lane); float fhs = a.HS[tok];
    unsigned long long m0 = __ballot((int)(feg0 >> 27) == part), m1 = __ballot((int)(feg1 >> 27) == part);
    unsigned neg0, neg1; u32x4 nh0; float nhs;
    { const int t2_ = (tok + nw < a.nrows) ? tok + nw : lastrow; neg0 = a.EG[(size_t)t2_ * 128 + lane]; neg1 = a.EG[(size_t)t2_ * 128 + 64 + lane]; nh0 = *(const u32x4*)(a.H8 + (size_t)t2_ * 1024 + 16 * lane); nhs = a.HS[t2_]; }
    P7Chunk A, B; int nA = 0, nB = 0, rowA = 0, rowB = 0; bool doneA = false, doneB = false;
#define P7A_ISSUE(X, nX, rowX, doneX) do { \
        const bool adv_ = (m0 == 0ull && m1 == 0ull) && (tok + nw < a.nrows); \
        doneX = (m0 == 0ull && m1 == 0ull) && !(tok + nw < a.nrows); \
        if (adv_) { tok += nw; feg0 = neg0; feg1 = neg1; fh0 = nh0; fhs = nhs; m0 = __ballot((int)(feg0 >> 27) == part); m1 = __ballot((int)(feg1 >> 27) == part); } \
        { const int t2_ = (tok + nw < a.nrows) ? tok + nw : lastrow;     \
          neg0 = a.EG[(size_t)t2_ * 128 + lane]; neg1 = a.EG[(size_t)t2_ * 128 + 64 + lane]; nh0 = *(const u32x4*)(a.H8 + (size_t)t2_ * 1024 + 16 * lane); nhs = a.HS[t2_]; } \
        rowX = tok; X.hq = fh0; X.hs = fhs; X.entv = 0; nX = 0; int e_ = 0; \
        _Pragma("unroll") for (int j_ = 0; j_ < 8; ++j_) { const bool has_ = (m0 != 0ull || m1 != 0ull); \
            if (has_) { if (m0 != 0ull) { e_ = __builtin_ctzll(m0); m0 &= m0 - 1ull; } else { e_ = 64 + __builtin_ctzll(m1); m1 &= m1 - 1ull; } nX = j_ + 1; } \
            const int eid_ = (int)((unsigned)__builtin_amdgcn_readlane((int)(e_ < 64 ? feg0 : feg1), e_ & 63) >> 16) & 16383;     \
            if (PM != 2) X.u[j_] = *(const u32x4*)(a.U8 + (size_t)eid_ * 1024 + 16 * lane); else { X.u[j_] = (u32x4){(unsigned)eid_, 0x38383838u, 0x38383838u, 0x38383838u}; } X.entv = (has_ && myk == j_) ? e_ : X.entv; } \
        { const unsigned eg0s_ = (unsigned)__shfl((int)feg0, X.entv & 63), eg1s_ = (unsigned)__shfl((int)feg1, X.entv & 63); X.ege = X.entv < 64 ? eg0s_ : eg1s_; \
          const int eidm_ = (int)(X.ege >> 16) & 16383; X.us = a.US[eidm_]; X.vs = a.VS[eidm_]; } } while (0)
#define P7A_COMPUTE(X, nX, rowX) do { \
        float r_; if (PM == 1) { unsigned x_ = 0; _Pragma("unroll") for (int j_ = 0; j_ < 8; ++j_) x_ ^= X.u[j_][0] ^ X.u[j_][1] ^ X.u[j_][2] ^ X.u[j_][3]; r_ = __uint_as_float(x_ & 0x3fffffffu) + X.hs; } \
        else r_ = (float)reduce8i(p7_doti(X.u[0], X.hq), p7_doti(X.u[1], X.hq), p7_doti(X.u[2], X.hq), p7_doti(X.u[3], X.hq), p7_doti(X.u[4], X.hq), p7_doti(X.u[5], X.hq), p7_doti(X.u[6], X.hq), p7_doti(X.u[7], X.hq), lane); \
        if (myk < nX && (lane & 7) == 0) { const float w_ = __uint_as_float(X.ege << 16) * gelu_fast(r_ * X.us * X.hs) * X.vs; \
            a.WE[(size_t)rowX * 128 + X.entv] = (X.ege & 0xffff0000u) | (cvt_pk_bf16(w_, 0.f) & 0xffffu); } } while (0)
    P7A_ISSUE(A, nA, rowA, doneA);
    for (;;) {
        P7A_ISSUE(B, nB, rowB, doneB);
        P7A_COMPUTE(A, nA, rowA);
        if (doneB) break;
        P7A_ISSUE(A, nA, rowA, doneA);
        P7A_COMPUTE(B, nB, rowB);
        if (doneA) break;
    }
#undef P7A_ISSUE
#undef P7A_COMPUTE
}

struct P7CArgs { const signed char* H8; const unsigned* EG; const unsigned char* U8; int* PART; int nrows; };
__device__ __forceinline__ void phase_p7c(LAS unsigned char* lds, const P7CArgs& a, int part, int prank, int nvb) {
    int tid_ = threadIdx.x; asm volatile("" : "+v"(tid_));
    const int lane = tid_ & 63, wid = __builtin_amdgcn_readfirstlane(tid_ >> 6);
    const int nw = (nvb >> 3) * 8, wrank = prank * 8 + wid;
    LAS unsigned* tab = (LAS unsigned*)(lds + wid * 1024);
    const int grp = lane >> 3, c = lane & 7, c16 = c * 16;
    const unsigned char* ubase = a.U8 + 128 * part + c16;
    const signed char* hbase = a.H8 + 128 * part + c16;
    int* pbase = a.PART + (size_t)part * a.nrows * 128;
    const int c2 = (c >> 2) & 1, c1 = (c >> 1) & 1, c0 = c & 1;
    const int ent0 = 8 * (8 * c2 + 4 * c0 + 2 * c1) + grp;
    u32x4 Av[16], Bv[16]; u32x4 Ah, Bh;
    unsigned pw0 = 0u, pw1 = 0u;
#define P7C_PREF(t) do { pw0 = a.EG[(size_t)(t) * 128 + lane]; pw1 = a.EG[(size_t)(t) * 128 + 64 + lane]; } while (0)
#define P7C_ISSUE(X, Xh, t, slot, tnext) do { LAS unsigned* tb_ = tab + (slot) * 128; \
        tb_[lane] = pw0; tb_[64 + lane] = pw1; \
        asm volatile("s_waitcnt lgkmcnt(0)" ::: "memory"); \
        _Pragma("unroll") for (int i_ = 0; i_ < 16; ++i_) { const unsigned e_ = tb_[8 * i_ + grp]; X[i_] = *(const u32x4*)(ubase + (size_t)(e_ >> 16) * 1024); } \
        Xh = *(const u32x4*)(hbase + (size_t)(t) * 1024); \
        P7C_PREF(tnext); } while (0)
#define P7C_X(v, ctrl) ((v) + DPPI((v), (ctrl)))
#define P7C_COMPUTE(X, Xh, t, valid) do { int d_[16]; \
        _Pragma("unroll") for (int i_ = 0; i_ < 16; ++i_) d_[i_] = p7_doti(X[i_], Xh); \
        int e8_[8]; _Pragma("unroll") for (int k = 0; k < 8; ++k) { const int send_ = c2 ? d_[k] : d_[k + 8], keep_ = c2 ? d_[k + 8] : d_[k]; e8_[k] = keep_ + DPPI(send_, 0x141); }            \
        int e4_[4]; _Pragma("unroll") for (int k = 0; k < 4; ++k) { const int send_ = c0 ? e8_[k] : e8_[k + 4], keep_ = c0 ? e8_[k + 4] : e8_[k]; e4_[k] = keep_ + DPPI(send_, 0xB1); }          \
        int e2_[2]; _Pragma("unroll") for (int k = 0; k < 2; ++k) { const int send_ = c1 ? e4_[k] : e4_[k + 2], keep_ = c1 ? e4_[k + 2] : e4_[k]; e2_[k] = keep_ + DPPI(send_, 0x4E); }          \
        if (valid) { int* pp_ = pbase + (size_t)(t) * 128 + ent0; pp_[0] = e2_[0]; pp_[8] = e2_[1]; } } while (0)
    const int lastrow = a.nrows - 1;
    int t = wrank;
    P7C_PREF(t);
    P7C_ISSUE(Av, Ah, t, 0, (t + nw < a.nrows ? t + nw : lastrow));
    while (t < a.nrows) {
        const int t1 = t + nw, t2 = t1 + nw, t3 = t2 + nw;
        const int k1 = t1 < a.nrows ? t1 : lastrow, k2 = t2 < a.nrows ? t2 : lastrow, k3 = t3 < a.nrows ? t3 : lastrow;
        P7C_ISSUE(Bv, Bh, k1, 1, k2);
        P7C_COMPUTE(Av, Ah, t, true);
        P7C_ISSUE(Av, Ah, k2, 0, k3);
        P7C_COMPUTE(Bv, Bh, k1, (t1 < a.nrows));
        t = t2;
    }
#undef P7C_PREF
#undef P7C_ISSUE
#undef P7C_COMPUTE
}
__device__ __forceinline__ void phase_p7d(const int* __restrict__ PART, const unsigned* __restrict__ EG, const float* __restrict__ US, const float* __restrict__ VS, const float* __restrict__ HS, unsigned* __restrict__ WE, int nrows, int vb, int nvb) {
    int tid_ = threadIdx.x; asm volatile("" : "+v"(tid_));
    const size_t n = (size_t)nrows * 128, pstride = n;
    for (size_t i = (size_t)vb * 512 + tid_; i < n; i += (size_t)nvb * 512) {
        int s = 0;
#pragma unroll
        for (int p = 0; p < 8; ++p) s += PART[p * pstride + i];
        const unsigned eg = EG[i]; const int eid = (int)(eg >> 16);
        const float av = (float)s * US[eid] * HS[i >> 7];
        const float wv = __uint_as_float(eg << 16) * gelu_fast(av) * VS[eid];
        WE[i] = (eg & 0xffff0000u) | (cvt_pk_bf16(wv, 0.f) & 0xffffu);
    }
}
struct P7BArgs { const unsigned* WE; const unsigned char* V8; float* XL; float* XC; const float* gate2; int nrows; };
template <int PM>
__device__ __forceinline__ void phase_p7b(LAS unsigned char* lds, const P7BArgs& a, int part, int prank, int nvb) {
    int tid_ = threadIdx.x; asm volatile("" : "+v"(tid_));
    const int lane = tid_ & 63, wid = __builtin_amdgcn_readfirstlane(tid_ >> 6);
    const int nw = (nvb >> 3) * 8, wrank = prank * 8 + wid;
    LAS unsigned* tab = (LAS unsigned*)(lds + wid * 1024);
    const int grp = lane >> 3, c16 = (lane & 7) * 16;
    const unsigned char* vbase = a.V8 + 128 * part + c16;
    const int colofs = 128 * part + c16 + 8 * (lane >> 5) + 4 * ((lane >> 4) & 1) + 2 * ((lane >> 3) & 1);
    u32x4 Av[16], Bv[16]; float Aw[16], Bw[16]; f32x2 Ax, Ag, Bx, Bg;
    unsigned pw0 = 0u, pw1 = 0u;
#define P7B_PREF(t) do { pw0 = a.WE[(size_t)(t) * 128 + lane]; pw1 = a.WE[(size_t)(t) * 128 + 64 + lane]; } while (0)
#define P7B_ISSUE(X, Xw, Xx, Xg, t, slot, tnext) do { LAS unsigned* tb_ = tab + (slot) * 128; \
        tb_[lane] = pw0; tb_[64 + lane] = pw1; \
        asm volatile("s_waitcnt lgkmcnt(0)" ::: "memory"); \
        _Pragma("unroll") for (int i_ = 0; i_ < 16; ++i_) { const unsigned we_ = tb_[8 * i_ + grp]; Xw[i_] = __uint_as_float(we_ << 16); if (PM != 2) X[i_] = *(const u32x4*)(vbase + (size_t)(we_ >> 16) * 1024); else X[i_] = (u32x4){we_, 0x38383838u, 0x38383838u, 0x38383838u}; } \
        { const bool isctx_ = (t) >= NL; const float* xp_ = (isctx_ ? a.XC + (size_t)((t) - NL) * 1024 : a.XL + (size_t)(t) * 1024) + colofs; const int mr_ = isctx_ ? 32 : (t) / S; \
          Xx = *(const f32x2*)xp_; Xg = *(const f32x2*)(a.gate2 + (size_t)mr_ * 6144 + colofs); } \
        P7B_PREF(tnext); } while (0)
#define P7B_COMPUTE(X, Xw, Xx, Xg, t, valid) do { float acc[16]; \
        _Pragma("unroll") for (int k = 0; k < 16; ++k) acc[k] = 0.f; \
        if (PM != 1) { _Pragma("unroll") for (int i_ = 0; i_ < 16; ++i_) p7_axpy(X[i_], Xw[i_], acc); } else { _Pragma("unroll") for (int i_ = 0; i_ < 16; ++i_) acc[i_] = __uint_as_float((X[i_][0] ^ X[i_][1] ^ X[i_][2] ^ X[i_][3]) & 0x3fffffffu) + Xw[i_]; } \
        float b_[8]; _Pragma("unroll") for (int k = 0; k < 8; ++k) { auto s_ = __builtin_amdgcn_permlane32_swap(__float_as_uint(acc[k]), __float_as_uint(acc[k + 8]), false, false); b_[k] = __uint_as_float(s_[0]) + __uint_as_float(s_[1]); } \
        float c_[4]; _Pragma("unroll") for (int k = 0; k < 4; ++k) { auto s_ = __builtin_amdgcn_permlane16_swap(__float_as_uint(b_[k]), __float_as_uint(b_[k + 4]), false, false); c_[k] = __uint_as_float(s_[0]) + __uint_as_float(s_[1]); } \
        float d_[2]; _Pragma("unroll") for (int k = 0; k < 2; ++k) { const float send_ = (lane & 8) ? c_[k] : c_[k + 2]; const float keep_ = (lane & 8) ? c_[k + 2] : c_[k]; d_[k] = keep_ + DPPF(send_, 0x128); } \
        const bool isctx_ = (t) >= NL; float* xp_ = (isctx_ ? a.XC + (size_t)((t) - NL) * 1024 : a.XL + (size_t)(t) * 1024) + colofs; \
        f32x2 x_ = Xx; x_.x += Xg.x * d_[0]; x_.y += Xg.y * d_[1]; if ((valid) && PM == 0) *(f32x2*)xp_ = x_; else if (PM != 0 && x_.x == 1.2345e30f) *(f32x2*)xp_ = x_; } while (0)
    const int lastrow = a.nrows - 1;
    int t = wrank;
    P7B_PREF(t);
    P7B_ISSUE(Av, Aw, Ax, Ag, t, 0, (t + nw < a.nrows ? t + nw : lastrow));
    while (t < a.nrows) {
        const int t1 = t + nw, t2 = t1 + nw, t3 = t2 + nw;
        const int c1 = t1 < a.nrows ? t1 : lastrow, c2 = t2 < a.nrows ? t2 : lastrow, c3 = t3 < a.nrows ? t3 : lastrow;
        P7B_ISSUE(Bv, Bw, Bx, Bg, c1, 1, c2);
        P7B_COMPUTE(Av, Aw, Ax, Ag, t, true);
        P7B_ISSUE(Av, Aw, Ax, Ag, c2, 0, c3);
        P7B_COMPUTE(Bv, Bw, Bx, Bg, c1, (t1 < a.nrows));
        t = t2;
    }
#undef P7B_PREF
#undef P7B_ISSUE
#undef P7B_COMPUTE
}
__device__ __forceinline__ void phase_final_norm(float* __restrict__ XLp, const float* __restrict__ g, int vb, int nvb) {
    int tid_ = threadIdx.x; asm volatile("" : "+v"(tid_));
    const int lane = tid_ & 63, wid = tid_ >> 6;
    for (int row = vb * 8 + wid; row < NL; row += nvb * 8) {
        float* xp = XLp + (size_t)row * 1024; f32x4 x[4]; float ss = 0.f;
#pragma unroll
        for (int i = 0; i < 4; ++i) { x[i] = *(const f32x4*)(xp + 256 * i + 4 * lane); ss += x[i][0] * x[i][0] + x[i][1] * x[i][1] + x[i][2] * x[i][2] + x[i][3] * x[i][3]; }
        ss = wave_sum(ss); const float rstd = rsqrtf(ss * (1.f / 1024.f) + EPS);
#pragma unroll
        for (int i = 0; i < 4; ++i) *(f32x4*)(xp + 256 * i + 4 * lane) = x[i] * rstd * *(const f32x4*)(g + 256 * i + 4 * lane);
    }
}
__global__ void __launch_bounds__(512, 2) k_p7(P7Args a) { phase_p7(a, blockIdx.x, gridDim.x); }

typedef short s16x4 __attribute__((ext_vector_type(4)));
__device__ __forceinline__ s16x4 lds_tr16(const LAS unsigned char* p) { return __builtin_bit_cast(s16x4, __builtin_amdgcn_ds_read_tr16_b64_v4i16((LAS s16x4*)p)); }
constexpr int ATT_BUF = 20480;
template <int DK>
__device__ __forceinline__ void attn_unit(LAS unsigned char* lds, const bf16_t* __restrict__ Q, const bf16_t* __restrict__ K1, const bf16_t* __restrict__ K2, const bf16_t* __restrict__ V,
                                          int nkeys, float c2, bf16_t* __restrict__ out) {
    int tid_ = threadIdx.x; asm volatile("" : "+v"(tid_));
    const int tid = tid_, lane = tid & 63, wid = __builtin_amdgcn_readfirstlane(tid >> 6), r32 = lane & 31, hi = lane >> 5;
    constexpr int NS = DK / 16;
    bf16x8 qf[NS];
    { const bf16_t* qp = Q + (size_t)(wid * 32 + r32) * DK + 8 * hi;
#pragma unroll
      for (int s = 0; s < NS; ++s) qf[s] = *(const bf16x8*)(qp + 16 * s); }
    const int skey = tid >> 3, sch = tid & 7;
    const unsigned st_k1 = skey * 128 + ((sch ^ ((skey >> 1) & 7)) << 4);
    const unsigned st_v = 8192 + skey * 128 + (((sch << 4)) ^ (((skey >> 1) & 1) << 6));
    const int skey2 = (tid & 255) >> 2, sch2 = tid & 3;
    const unsigned st_k2 = 16384 + skey2 * 64 + ((sch2 ^ ((skey2 >> 2) & 3)) << 4);
    const bf16_t* gk1 = K1 + (size_t)skey * 64 + sch * 8; const bf16_t* gv = V + (size_t)skey * 64 + sch * 8;
    const bf16_t* gk2 = (DK == 96) ? K2 + (size_t)skey2 * 32 + sch2 * 8 : nullptr;
    unsigned ka[2][4];
#pragma unroll
    for (int kt = 0; kt < 2; ++kt)
#pragma unroll
        for (int s = 0; s < 4; ++s) { const int key = 32 * kt + r32; ka[kt][s] = key * 128 + (((2 * s + hi) ^ ((key >> 1) & 7)) << 4); }
    unsigned kb[2][2];
#pragma unroll
    for (int kt = 0; kt < 2; ++kt)
#pragma unroll
        for (int s = 0; s < 2; ++s) { const int key = 32 * kt + r32; kb[kt][s] = 16384 + key * 64 + (((2 * s + hi) ^ ((key >> 2) & 3)) << 4); }
    const int vq = (lane & 15) >> 2, vp = lane & 3, vg = (lane >> 4) & 1;
    unsigned va[2];
#pragma unroll
    for (int dvb = 0; dvb < 2; ++dvb) { const int key = 4 * hi + vq; va[dvb] = 8192 + key * 128 + ((((32 * dvb + 16 * vg + 4 * vp) * 2)) ^ (((key >> 1) & 1) << 6)); }
    float m = -1e30f, l = 0.f;
    f32x16 o0 = {}, o1 = {};
    const int NT = nkeys >> 6;
    u32x4 sk1, sv, sk2;
    sk1 = *(const u32x4*)gk1; sv = *(const u32x4*)gv; if (DK == 96) { if (tid < 256) sk2 = *(const u32x4*)gk2; }
    *(LAS u32x4*)(lds + st_k1) = sk1; *(LAS u32x4*)(lds + st_v) = sv; if (DK == 96) { if (tid < 256) *(LAS u32x4*)(lds + st_k2) = sk2; }
    __syncthreads();
    for (int t = 0; t < NT; ++t) {
        LAS unsigned char* buf = lds + (t & 1) * ATT_BUF;
        if (t + 1 < NT) { sk1 = *(const u32x4*)(gk1 + (size_t)(t + 1) * 64 * 64); sv = *(const u32x4*)(gv + (size_t)(t + 1) * 64 * 64); if (DK == 96) { if (tid < 256) sk2 = *(const u32x4*)(gk2 + (size_t)(t + 1) * 64 * 32); } }
        f32x16 p0 = {}, p1 = {};
#pragma unroll
        for (int s = 0; s < 4; ++s) { p0 = mfma32(*(const LAS bf16x8*)(buf + ka[0][s]), qf[s], p0); p1 = mfma32(*(const LAS bf16x8*)(buf + ka[1][s]), qf[s], p1); }
        if (DK == 96) {
#pragma unroll
            for (int s = 0; s < 2; ++s) { p0 = mfma32(*(const LAS bf16x8*)(buf + kb[0][s]), qf[4 + s], p0); p1 = mfma32(*(const LAS bf16x8*)(buf + kb[1][s]), qf[4 + s], p1); }
        }
        float mx = p0[0];
#pragma unroll
        for (int r = 1; r < 16; ++r) mx = fmaxf(mx, p0[r]);
#pragma unroll
        for (int r = 0; r < 16; ++r) mx = fmaxf(mx, p1[r]);
        { auto rr = __builtin_amdgcn_permlane32_swap(__float_as_uint(mx), __float_as_uint(mx), false, false); mx = fmaxf(__uint_as_float(rr[0]), __uint_as_float(rr[1])); }
        const float tm = mx * c2;
        if (__any(tm > m + 8.f)) {
            const float mn = fmaxf(m, tm), al = __builtin_amdgcn_exp2f(m - mn); m = mn; l *= al;
#pragma unroll
            for (int r = 0; r < 16; ++r) { o0[r] *= al; o1[r] *= al; }
        }
        const float nm = -m; float ls = 0.f;
#pragma unroll
        for (int r = 0; r < 16; ++r) { p0[r] = __builtin_amdgcn_exp2f(__builtin_fmaf(p0[r], c2, nm)); p1[r] = __builtin_amdgcn_exp2f(__builtin_fmaf(p1[r], c2, nm)); ls += p0[r] + p1[r]; }
        l += ls;
        bf16x8 pf[2][2];
#pragma unroll
        for (int sp = 0; sp < 2; ++sp) { u32x4 a, b;
            a.x = cvt_pk_bf16(p0[8 * sp], p0[8 * sp + 1]); a.y = cvt_pk_bf16(p0[8 * sp + 2], p0[8 * sp + 3]); a.z = cvt_pk_bf16(p0[8 * sp + 4], p0[8 * sp + 5]); a.w = cvt_pk_bf16(p0[8 * sp + 6], p0[8 * sp + 7]);
            b.x = cvt_pk_bf16(p1[8 * sp], p1[8 * sp + 1]); b.y = cvt_pk_bf16(p1[8 * sp + 2], p1[8 * sp + 3]); b.z = cvt_pk_bf16(p1[8 * sp + 4], p1[8 * sp + 5]); b.w = cvt_pk_bf16(p1[8 * sp + 6], p1[8 * sp + 7]);
            pf[0][sp] = __builtin_bit_cast(bf16x8, a); pf[1][sp] = __builtin_bit_cast(bf16x8, b); }
#pragma unroll
        for (int kt = 0; kt < 2; ++kt)
#pragma unroll
            for (int sp = 0; sp < 2; ++sp) { const int kofs = (32 * kt + 16 * sp) * 128;
                { const s16x4 lo = lds_tr16(buf + va[0] + kofs), hi4 = lds_tr16(buf + va[0] + kofs + 8 * 128);
                  const bf16x8 vf = (bf16x8){lo[0], lo[1], lo[2], lo[3], hi4[0], hi4[1], hi4[2], hi4[3]}; o0 = mfma32(vf, pf[kt][sp], o0); }
                { const s16x4 lo = lds_tr16(buf + va[1] + kofs), hi4 = lds_tr16(buf + va[1] + kofs + 8 * 128);
                  const bf16x8 vf = (bf16x8){lo[0], lo[1], lo[2], lo[3], hi4[0], hi4[1], hi4[2], hi4[3]}; o1 = mfma32(vf, pf[kt][sp], o1); } }
        if (t + 1 < NT) { LAS unsigned char* nb = lds + ((t + 1) & 1) * ATT_BUF; *(LAS u32x4*)(nb + st_k1) = sk1; *(LAS u32x4*)(nb + st_v) = sv; if (DK == 96) { if (tid < 256) *(LAS u32x4*)(nb + st_k2) = sk2; } }
        __syncthreads();
    }
    { auto rr = __builtin_amdgcn_permlane32_swap(__float_as_uint(l), __float_as_uint(l), false, false); l = __uint_as_float(rr[0]) + __uint_as_float(rr[1]); }
    const float il = 1.f / l;
    bf16_t* op = out + (size_t)(wid * 32 + r32) * 1024 + 4 * hi;
#pragma unroll
    for (int g = 0; g < 4; ++g) { u32x2 a, b;
        a.x = cvt_pk_bf16(o0[4 * g] * il, o0[4 * g + 1] * il); a.y = cvt_pk_bf16(o0[4 * g + 2] * il, o0[4 * g + 3] * il);
        b.x = cvt_pk_bf16(o1[4 * g] * il, o1[4 * g + 1] * il); b.y = cvt_pk_bf16(o1[4 * g + 2] * il, o1[4 * g + 3] * il);
        *(u32x2*)(op + 8 * g) = a; *(u32x2*)(op + 32 + 8 * g) = b; }
}
__device__ __forceinline__ void phase_p3(LAS unsigned char* lds, const WS& w, int l, int vb, int nvb) {
    const float c2g = 0.125f * 1.4426950408889634f, c2m = 0.10206207261596577f * 1.4426950408889634f;
    bf16_t* MIX = w.H();
    const int nlat = NB * 12 * 8, nctx = (l == 0) ? NB * 12 : 0;
    for (int u = vb; u < nlat + nctx; u += nvb) {
        if (u < nlat) {
            const int qb = u & 7, slot = (u >> 3) % 12, b = u / 96;
            bf16_t* out = MIX + ((size_t)b * S + qb * 256) * 1024;
            if (slot < 6) attn_unit<64>(lds, w.Qg() + (((size_t)b * 6 + slot) * S + qb * 256) * 64, w.Kg() + ((size_t)b * 2 + slot / 3) * KEYS * 64, nullptr, w.Vg() + ((size_t)b * 2 + slot / 3) * KEYS * 64, KEYS, c2g, out + slot * 64);
            else { const int h = slot - 6; attn_unit<96>(lds, w.Qm() + (((size_t)b * 6 + h) * S + qb * 256) * 96, w.Kmn() + ((size_t)b * 6 + h) * KEYS * 64, w.KR() + (size_t)b * KEYS * 32, w.Vm() + ((size_t)b * 6 + h) * KEYS * 64, KEYS, c2m, out + 640 + h * 64); }
        } else {
            const int v = u - nlat, slot = v % 12, b = v / 12;
            bf16_t* out = MIX + ((size_t)NL + (size_t)b * CTX) * 1024;
            if (slot < 6) attn_unit<64>(lds, w.Qgc() + ((size_t)b * 6 + slot) * CTX * 64, w.Kg() + ((size_t)b * 2 + slot / 3) * KEYS * 64, nullptr, w.Vg() + ((size_t)b * 2 + slot / 3) * KEYS * 64, CTX, c2g, out + slot * 64);
            else { const int h = slot - 6; attn_unit<96>(lds, w.Qmc() + ((size_t)b * 6 + h) * CTX * 96, w.Kmn() + ((size_t)b * 6 + h) * KEYS * 64, w.KR() + (size_t)b * KEYS * 32, w.Vm() + ((size_t)b * 6 + h) * KEYS * 64, CTX, c2m, out + 640 + h * 64); }
        }
    }
}
__global__ void __launch_bounds__(512, 2) k_p3(WS w, int l) { phase_p3((LAS unsigned char*)dyn_lds, w, l, blockIdx.x, gridDim.x); }

__device__ __forceinline__ unsigned fkey(float f, unsigned tag, unsigned mask) { unsigned u = __float_as_uint(f); u = (u & 0x80000000u) ? ~u : (u | 0x80000000u); return (u & ~mask) | tag; }
__device__ __forceinline__ float keyf(unsigned k, unsigned mask) { k &= ~mask; const unsigned u = (k & 0x80000000u) ? (k & 0x7fffffffu) : ~k; return __uint_as_float(u); }
__device__ __forceinline__ void ce_desc(unsigned& a, unsigned& b) { const unsigned hi_ = a > b ? a : b, lo_ = a > b ? b : a; a = hi_; b = lo_; }
template <int J, int K> __device__ __forceinline__ void bstage16(unsigned* a) {
#pragma unroll
    for (int i = 0; i < 16; ++i) { const int l = i ^ J; if (l > i) { const unsigned x = a[i], y = a[l]; const unsigned mx = x > y ? x : y, mn = x > y ? y : x; const bool desc = ((i & K) == 0); a[i] = desc ? mx : mn; a[l] = desc ? mn : mx; } }
}
__device__ __forceinline__ void sort16_desc(unsigned* a) {
    bstage16<1, 2>(a); bstage16<2, 4>(a); bstage16<1, 4>(a); bstage16<4, 8>(a); bstage16<2, 8>(a); bstage16<1, 8>(a); bstage16<8, 16>(a); bstage16<4, 16>(a); bstage16<2, 16>(a); bstage16<1, 16>(a);
}
__device__ __forceinline__ void bmerge16_desc(unsigned* c) { bstage16<8, 16>(c); bstage16<4, 16>(c); bstage16<2, 16>(c); bstage16<1, 16>(c); }
__device__ __forceinline__ void merge_top16(unsigned* a, const unsigned* b) {
#pragma unroll
    for (int i = 0; i < 16; ++i) a[i] = a[i] > b[15 - i] ? a[i] : b[15 - i];
    bmerge16_desc(a);
}
__device__ __forceinline__ void xlane_top16(unsigned* t, int hi) {
    unsigned r[16]; const unsigned msk = 0u - (unsigned)hi;
#pragma unroll
    for (int i = 0; i < 16; ++i) r[i] = t[i] ^ ((t[i] ^ t[15 - i]) & msk);
#pragma unroll
    for (int i = 0; i < 16; ++i) { auto s = __builtin_amdgcn_permlane32_swap(r[i], r[i], false, false); t[i] = s[0] > s[1] ? s[0] : s[1]; }
    bmerge16_desc(t);
}
__device__ __forceinline__ constexpr int cand_a(int c) { return c < 16 ? 0 : c < 24 ? 1 : c < 29 ? 2 : c < 33 ? 3 : c < 36 ? 4 : c < 38 ? 5 : c < 40 ? 6 : c < 42 ? 7 : c < 50 ? c - 34 : 0; }
__device__ __forceinline__ constexpr int cand_b(int c) { return c < 16 ? c : c < 24 ? c - 16 : c < 29 ? c - 24 : c < 33 ? c - 29 : c < 36 ? c - 33 : c < 38 ? c - 36 : c < 40 ? c - 38 : c < 42 ? c - 40 : 0; }

__device__ __forceinline__ void phase_p6b(LAS unsigned char* lds, const bf16_t* __restrict__ PQ, const bf16_t* __restrict__ SubKl, unsigned* __restrict__ EG, int nrows, int vb, int nvb) {
    int tid_ = threadIdx.x; asm volatile("" : "+v"(tid_));
    const int lane = tid_ & 63, wid = __builtin_amdgcn_readfirstlane(tid_ >> 6), r32 = lane & 31, hi = lane >> 5;
    LAS unsigned short* tab = (LAS unsigned short*)(lds + wid * 4096) + r32 * 64;
    const int nitems = (nrows >> 5) * 8;
    for (int it = vb * 8 + wid; it < nitems; it += nvb * 8) {
        const int h = it & 7, row0 = (it >> 3) << 5;
        unsigned top[2][16];
#pragma unroll
        for (int p = 0; p < 2; ++p) {
            bf16x8 qf[8];
            { const bf16_t* qp = PQ + (size_t)(row0 + r32) * 2048 + h * 256 + p * 128 + 8 * hi; asm volatile("" : "+v"(qp));
#pragma unroll
              for (int s = 0; s < 8; ++s) qf[s] = *(const bf16x8*)(qp + 16 * s); }
            const bf16_t* kp = SubKl + ((size_t)(h * 2 + p) * 128 + r32) * 128 + 8 * hi; asm volatile("" : "+v"(kp));
            f32x16 acc[4];
#pragma unroll
            for (int kt = 0; kt < 4; ++kt) { acc[kt] = f32x16{};
                bf16x8 kf[8];
#pragma unroll
                for (int s = 0; s < 8; ++s) kf[s] = *(const bf16x8*)(kp + (size_t)kt * 32 * 128 + 16 * s);
#pragma unroll
                for (int s = 0; s < 8; ++s) acc[kt] = mfma32(kf[s], qf[s], acc[kt]);
                asm volatile("" ::: "memory"); }
            unsigned key[64];
#pragma unroll
            for (int kt = 0; kt < 4; ++kt)
#pragma unroll
                for (int r = 0; r < 16; ++r) { const int n = 32 * kt + (r & 3) + 8 * (r >> 2) + 4 * hi; key[16 * kt + r] = fkey(acc[kt][r], 127u - (unsigned)n, 127u); }
            sort16_desc(key); sort16_desc(key + 16); sort16_desc(key + 32); sort16_desc(key + 48);
            merge_top16(key, key + 16); merge_top16(key + 32, key + 48); merge_top16(key, key + 32);
            xlane_top16(key, hi);
#pragma unroll
            for (int i = 0; i < 16; ++i) top[p][i] = key[i];
            asm volatile("" ::: "memory");
        }
        unsigned ck[64];
#pragma unroll
        for (int c = 0; c < 64; ++c) {
            if (c < 50) { const float sm = keyf(top[0][cand_a(c)], 127u) + keyf(top[1][cand_b(c)], 127u); ck[c] = fkey(sm, (unsigned)c, 63u); } else ck[c] = 0u;
        }
        if (hi == 0) {
#pragma unroll
            for (int c = 0; c < 50; c += 2) {
                const unsigned ea = (127u - (top[0][cand_a(c)] & 127u)) * 128u + (127u - (top[1][cand_b(c)] & 127u));
                const unsigned eb = (127u - (top[0][cand_a(c + 1)] & 127u)) * 128u + (127u - (top[1][cand_b(c + 1)] & 127u));
                *(LAS unsigned*)(tab + c) = ea | (eb << 16);
            }
        }
        sort16_desc(ck); sort16_desc(ck + 16); sort16_desc(ck + 32); sort16_desc(ck + 48);
        merge_top16(ck, ck + 16); merge_top16(ck + 32, ck + 48); merge_top16(ck, ck + 32);
        asm volatile("s_waitcnt lgkmcnt(0)" ::: "memory");
        const float mx = keyf(ck[0], 63u); float e[16], den = 0.f;
#pragma unroll
        for (int j = 0; j < 16; ++j) { e[j] = __builtin_amdgcn_exp2f((keyf(ck[j], 63u) - mx) * 1.4426950408889634f); den += e[j]; }
        const float iden = 1.f / den;
        if (hi == 0) {
            unsigned o[16];
#pragma unroll
            for (int j = 0; j < 16; ++j) { const unsigned eid = tab[ck[j] & 63u]; o[j] = (eid << 16) | (cvt_pk_bf16(e[j] * iden, 0.f) & 0xffffu); }
            unsigned* dst = EG + (size_t)(row0 + r32) * 128 + h * 16;
#pragma unroll
            for (int j = 0; j < 16; j += 4) *(u32x4*)(dst + j) = (u32x4){o[j], o[j + 1], o[j + 2], o[j + 3]};
        }
        asm volatile("s_waitcnt lgkmcnt(0)" ::: "memory");
    }
}
__global__ void __launch_bounds__(512, 2) k_p6b(WS w, int l, int nrows) { phase_p6b((LAS unsigned char*)dyn_lds, w.PQ(), w.SubK() + (size_t)l * 16 * 128 * 128, w.EG(), nrows, blockIdx.x, gridDim.x); }

__global__ void k_rs_from_ss(WS w) {
    const int row = blockIdx.x * 256 + threadIdx.x; if (row >= NR) return;
    float a = 0.f; for (int i = 0; i < 6; ++i) a += w.SSQ()[(size_t)row * 8 + i];
    float b = 0.f; for (int i = 0; i < 4; ++i) b += w.SSKV()[(size_t)row * 4 + i];
    w.RSQ()[row] = rsqrtf(a * (1.f / 384.f) + EPS); w.RSKV()[row] = rsqrtf(b * (1.f / 256.f) + EPS);
}


#define XB_TMO      128
#define XB_XCNT(j)  (256  + 64 * (j))
#define XB_XSUB(j)  (1280 + 64 * (j))
#define XB_XGEN(j)  (2304 + 64 * (j))
#define XB_TOP      3328
#define XB_TOPGEN   3392
#define XCD_BAR_WORDS 3456
#define XB_SPIN_CAP (1u << 18)

__device__ __forceinline__ unsigned xb_ld(unsigned* p)              { return __hip_atomic_load(p, __ATOMIC_RELAXED, __HIP_MEMORY_SCOPE_AGENT); }
__device__ __forceinline__ unsigned xb_add(unsigned* p, unsigned v) { return __hip_atomic_fetch_add(p, v, __ATOMIC_RELAXED, __HIP_MEMORY_SCOPE_AGENT); }
__device__ __forceinline__ unsigned xb_xcc_id() { return (unsigned)__builtin_amdgcn_s_getreg((3 << 11) | 20) & 0xFu; }
#define XB_SPIN(cond, bar) do { unsigned _sp = 0; while (cond) { __builtin_amdgcn_s_sleep(1); \
    if ((++_sp & 255u) == 0u) { if (xb_ld(&(bar)[XB_TMO])) break; if (_sp > XB_SPIN_CAP) { atomicAdd(&(bar)[XB_TMO], 1u); break; } } } } while (0)

struct XcdBarrier {
    unsigned* bar; unsigned x;
    volatile LAS unsigned* st;
};

__device__ __forceinline__ XcdBarrier xcd_barrier_post(unsigned* bar, volatile LAS unsigned* st) {
    XcdBarrier b; b.bar = bar; b.x = xb_xcc_id(); b.st = st;
    if (threadIdx.x == 0) (void)xb_add(&bar[XB_XCNT(b.x)], 1u);
    return b;
}
__device__ __forceinline__ void xcd_barrier_complete(unsigned* bar, unsigned x, unsigned& nloc, unsigned& nx) {
    const unsigned G = gridDim.x * gridDim.y * gridDim.z;
    unsigned sum, cnt, mine, sp = 0u;
    for (;;) {
        sum = 0u; cnt = 0u; mine = 0u;
#pragma unroll
        for (unsigned j = 0; j < 16; ++j) { const unsigned c = xb_ld(&bar[XB_XCNT(j)]); sum += c; cnt += (c > 0u) ? 1u : 0u; mine = (j == x) ? c : mine; }
        if (sum == G) break;
        __builtin_amdgcn_s_sleep(1);
        if ((++sp & 255u) == 0u) { if (xb_ld(&bar[XB_TMO])) break; if (sp > XB_SPIN_CAP) { atomicAdd(&bar[XB_TMO], 1u); break; } }
    }
    nloc = mine > 0u ? mine : 1u; nx = cnt > 0u ? cnt : 1u;
}

__device__ __forceinline__ void xcd_barrier(const XcdBarrier& b) {
    asm volatile("s_waitcnt vmcnt(0)" ::: "memory");
    __syncthreads();
    if (threadIdx.x == 0) {
        unsigned* bar = b.bar;
        __builtin_amdgcn_s_waitcnt(0);
        unsigned nloc = b.st[0], nx = b.st[1];
        if (nloc == 0u) { xcd_barrier_complete(bar, b.x, nloc, nx); b.st[0] = nloc; b.st[1] = nx; }
        const unsigned old = xb_add(&bar[XB_XSUB(b.x)], 1u);
        const unsigned gen = old / nloc;
        if (old + 1u == (gen + 1u) * nloc) {
            __builtin_amdgcn_fence(__ATOMIC_RELEASE, "agent");
            asm volatile("s_waitcnt vmcnt(0)" ::: "memory");
            const unsigned og = xb_add(&bar[XB_TOP], 1u);
            const unsigned tg = og / nx;
            if (og + 1u == (tg + 1u) * nx) xb_add(&bar[XB_TOPGEN], 1u);
            else XB_SPIN(xb_ld(&bar[XB_TOPGEN]) == tg, bar);
            __builtin_amdgcn_fence(__ATOMIC_ACQUIRE, "agent");
            xb_add(&bar[XB_XGEN(b.x)], 1u);
            asm volatile("s_waitcnt vmcnt(0)" ::: "memory");
        } else {
            XB_SPIN(xb_ld(&bar[XB_XGEN(b.x)]) == gen, bar);
            __builtin_amdgcn_fence(__ATOMIC_ACQUIRE, "agent");
            asm volatile("s_waitcnt vmcnt(0)" ::: "memory");
        }
    }
    __syncthreads();
}

__device__ __forceinline__ void phase_mod(LAS unsigned char* lds, const Inputs& in, const WS& w, int vb) {
    if (vb >= 72) return;
    LAS float* sc = (LAS float*)lds;
    int tid_ = threadIdx.x; asm volatile("" : "+v"(tid_));
    const int tid = tid_, idx = vb * 512 + tid, rg = idx / 12288, ln = idx % 12288, l = ln / 6144, n = ln % 6144;
    float acc[11];
#pragma unroll
    for (int i = 0; i < 11; ++i) acc[i] = 0.f;
    const float* wp = in.ada_w + (size_t)l * 1024 * 6144 + n;
    for (int kc = 0; kc < 4; ++kc) {
        for (int i = tid; i < 33 * 256; i += 512) { const int r = i >> 8, k = kc * 256 + (i & 255); const float v = r < 32 ? in.c[(size_t)r * 1024 + k] : in.c_ctx[k]; sc[i] = v / (1.f + __expf(-v)); }
        __syncthreads();
        for (int k = 0; k < 256; ++k) { const float wv = wp[(size_t)(kc * 256 + k) * 6144];
#pragma unroll
            for (int i = 0; i < 11; ++i) acc[i] += sc[(rg * 11 + i) * 256 + k] * wv; }
        __syncthreads();
    }
    const float bias = in.ada_b[(size_t)l * 6144 + n];
#pragma unroll
    for (int i = 0; i < 11; ++i) w.MOD()[((size_t)l * 33 + rg * 11 + i) * 6144 + n] = acc[i] + bias;
}
__device__ __forceinline__ void phase_rope(const WS& w, int vb, int nvb) {
    int tid_ = threadIdx.x; asm volatile("" : "+v"(tid_));
    for (int i = vb * 512 + tid_; i < 2048 * 32; i += nvb * 512) {
        { const int t = i / 32, j = i % 32; const double inv = pow(10000.0, -(double)(j % 16) / 16.0); const double a = (double)(j < 16 ? t / 64 : t % 64) * inv; w.ROPA()[i] = make_float2((float)cos(a), (float)sin(a)); }
        if (i < 2048 * 16) { const int t = i / 16, j = i % 16; const double inv = pow(10000.0, -(double)(j % 8) / 8.0); const double a = (double)(j < 8 ? t / 64 : t % 64) * inv; w.ROPC()[i] = make_float2((float)cos(a), (float)sin(a)); }
    }
}

#ifndef PROBE_MASK
#define PROBE_MASK 0
#endif
struct MegaArgs { Inputs in; WS w; float* XL; unsigned* bar; };
constexpr int MEGA_LDS = 131072 + 16;
__global__ void __launch_bounds__(512, 2) k_mega(MegaArgs A) {
    LAS unsigned char* lds = (LAS unsigned char*)dyn_lds;
    const int vb = blockIdx.x, nvb = gridDim.x;
    volatile LAS unsigned* xbw = (volatile LAS unsigned*)(lds + 131072);
    if (threadIdx.x == 0) { xbw[0] = 0u; xbw[1] = 0u; xbw[2] = 0u; xbw[3] = 0u; }
    __syncthreads();
    XcdBarrier bar = xcd_barrier_post(A.bar, xbw);
    if (threadIdx.x == 0) xbw[2] = xb_add(&A.bar[3584 + 64 * bar.x], 1u);
    __syncthreads();
    const int xticket = __builtin_amdgcn_readfirstlane((int)xbw[2]);
    const WS& w = A.w; const Inputs& in = A.in;
    phase_mod(lds, in, w, vb);
    phase_rope(w, vb, nvb);
    phase_cvt(lds, in, w, vb, nvb);
    xcd_barrier(bar);
    phase_modulate(in.x, in.ctx, w.H(), in.norm1_g, w.MOD(), 0, NR, vb, nvb);
    xcd_barrier(bar);
#if (PROBE_MASK >> 0) & 1
    phase_mod(lds, in, w, vb);
    phase_rope(w, vb, nvb);
    phase_cvt(lds, in, w, vb, nvb);
    xcd_barrier(bar);
    phase_modulate(in.x, in.ctx, w.H(), in.norm1_g, w.MOD(), 0, NR, vb, nvb);
    xcd_barrier(bar);
#endif
    int xpart = vb & 7, xrank = vb >> 3;
    { bool okx = (bar.x < 8u); for (unsigned j = 0; j < 8; ++j) okx = okx && (xb_ld(&A.bar[XB_XCNT(j)]) == (unsigned)(nvb >> 3));
      if (okx) { xpart = (int)bar.x; xrank = xticket; } }
    for (int l = 0; l < DEPTH; ++l) {
        const float* MODl = w.MOD() + (size_t)l * 33 * 6144;
        const bool last = (l == DEPTH - 1);
        const int MR = last ? NL : NR;
        phase_p1(lds, w, in, l, vb, nvb); xcd_barrier(bar);
#if (PROBE_MASK >> 1) & 1
        phase_p1(lds, w, in, l, vb, nvb); xcd_barrier(bar);
#endif
        phase_p2(lds, w, in, l, vb, nvb); xcd_barrier(bar);
#if (PROBE_MASK >> 12) & 7
        phase_p2(lds, w, in, l, vb, nvb, (PROBE_MASK >> 12) & 7); xcd_barrier(bar);
#endif
        phase_p3(lds, w, l, vb, nvb); xcd_barrier(bar);
#if (PROBE_MASK >> 3) & 1
        phase_p3(lds, w, l, vb, nvb); xcd_barrier(bar);
#endif
        phase_p4(lds, w, in, A.XL, l, vb, nvb);
        xcd_barrier(bar);
#if (PROBE_MASK >> 4) & 1
        phase_p4(lds, w, in, A.XL, l, vb, nvb, true);
        xcd_barrier(bar);
#endif
        phase_modulate(A.XL, w.XC(), w.H(), in.norm2_g + l * 1024, MODl, 3, MR, vb, nvb, w.H8(), w.HS()); xcd_barrier(bar);
#if (PROBE_MASK >> 5) & 1
        phase_modulate(A.XL, w.XC(), w.H(), in.norm2_g + l * 1024, MODl, 3, MR, vb, nvb, w.H8(), w.HS()); xcd_barrier(bar);
#endif
        phase_p6a(lds, w, l, vb, nvb); xcd_barrier(bar);
#if (PROBE_MASK >> 6) & 1
        phase_p6a(lds, w, l, vb, nvb); xcd_barrier(bar);
#endif
        phase_p6b(lds, w.PQ(), w.SubK() + (size_t)l * 16 * 128 * 128, w.EG(), MR, vb, nvb); xcd_barrier(bar);
#if (PROBE_MASK >> 7) & 1
        phase_p6b(lds, w.PQ(), w.SubK() + (size_t)l * 16 * 128 * 128, w.EG(), MR, vb, nvb); xcd_barrier(bar);
#endif
        { P7CArgs a{w.H8(), w.EG(), w.U8() + (size_t)l * NE * 1024, (int*)w.PQ(), MR}; phase_p7c(lds, a, xpart, xrank, nvb); }
        xcd_barrier(bar);
        phase_p7d((const int*)w.PQ(), w.EG(), w.US() + (size_t)l * NE, w.VS() + (size_t)l * NE, w.HS(), w.WE(), MR, vb, nvb);
        xcd_barrier(bar);
        { P7BArgs a{w.WE(), w.V8() + (size_t)l * NE * 1024, A.XL, w.XC(), MODl + 5 * 1024, MR}; phase_p7b<0>(lds, a, xpart, xrank, nvb); }
        xcd_barrier(bar);
#if (PROBE_MASK >> 10) & 3
        { P7BArgs a{w.WE(), w.V8() + (size_t)l * NE * 1024, A.XL, w.XC(), MODl + 5 * 1024, MR}; phase_p7b<((PROBE_MASK >> 10) & 3)>(lds, a, xpart, xrank, nvb); }
        xcd_barrier(bar);
#endif
        if (last) phase_final_norm(A.XL, in.final_g, vb, nvb);
        else phase_modulate(A.XL, w.XC(), w.H(), in.norm1_g + (l + 1) * 1024, w.MOD() + (size_t)(l + 1) * 33 * 6144, 0, NR, vb, nvb);
        if (!last) xcd_barrier(bar);
    }
}

extern "C" void kernel_launch(void* const* d_in, const int* in_sizes, int n_in, void* d_out, int out_size, void* d_ws, size_t ws_size, hipStream_t stream) {
    const float* const* fin = (const float* const*)d_in;
    Inputs in{fin[0], fin[1], fin[2], fin[3], fin[4], fin[5], fin[6], fin[7], fin[8], fin[9], fin[10], fin[11], fin[12], fin[13], fin[14], fin[15], fin[16], fin[17], fin[18], fin[19], fin[20], fin[21], fin[22]};
    WS w = make_ws(d_ws);
    static int ok = 0;
    if (!ok) {
        if (hipFuncSetAttribute((const void*)k_mega, hipFuncAttributeMaxDynamicSharedMemorySize, MEGA_LDS) != hipSuccess) { ok = -1; }
        int per_cu = 0, cus = 0, dev = 0; (void)hipGetDevice(&dev); (void)hipDeviceGetAttribute(&cus, hipDeviceAttributeMultiprocessorCount, dev);
        if (hipOccupancyMaxActiveBlocksPerMultiprocessor(&per_cu, (const void*)k_mega, 512, MEGA_LDS) != hipSuccess || per_cu < 1 || cus < 256) ok = -1;
        if (ok == 0) ok = 1;
    }
    if (ok < 0) return;
    (void)hipMemsetAsync(d_ws, 0, 16384, stream);
    MegaArgs A{in, w, (float*)d_out, (unsigned*)d_ws};
    k_mega<<<256, 512, MEGA_LDS, stream>>>(A);
}
```

```cpp
#include <hip/hip_runtime.h>
#include <stdint.h>

typedef unsigned short bf16_t;

constexpr int D = 1024, NB = 32, S = 2048, CTX = 256, DEPTH = 2;
constexpr int NL = NB * S, NC = NB * CTX, NR = NL + NC;
constexpr int KEYS = CTX + S;
constexpr int INC = 1568;
constexpr int NE = 16384;
constexpr float EPS = 1e-6f;

__device__ __forceinline__ float bf2f(bf16_t v) { return __uint_as_float(((unsigned)v) << 16); }
__device__ __forceinline__ bf16_t f2bf(float f) { unsigned u = __float_as_uint(f); u += 0x7FFFu + ((u >> 16) & 1u); return (bf16_t)(u >> 16); }

__device__ __forceinline__ float wave_sum(float v) {
#pragma unroll
    for (int o = 32; o > 0; o >>= 1) v += __shfl_xor(v, o);
    return v;
}
__device__ __forceinline__ float gelu_tanh(float x) {
    const float u = 0.7978845608028654f * (x + 0.044715f * x * x * x);
    return 0.5f * x * (1.f + tanhf(u));
}

struct WS {
    char* base;
    __host__ __device__ __forceinline__ bf16_t* H() const { return (bf16_t*)(base + 65536ull); }
    __host__ __device__ __forceinline__ bf16_t* Qg() const { return (bf16_t*)(base + 151060480ull); }
    __host__ __device__ __forceinline__ bf16_t* Qgc() const { return (bf16_t*)(base + 201392128ull); }
    __host__ __device__ __forceinline__ bf16_t* Kg() const { return (bf16_t*)(base + 207683584ull); }
    __host__ __device__ __forceinline__ bf16_t* Vg() const { return (bf16_t*)(base + 226557952ull); }
    __host__ __device__ __forceinline__ bf16_t* CQ() const { return (bf16_t*)(base + 245432320ull); }
    __host__ __device__ __forceinline__ bf16_t* CKV() const { return (bf16_t*)(base + 302055424ull); }
    __host__ __device__ __forceinline__ bf16_t* Bp() const { return (bf16_t*)(base + 339804160ull); }
    __host__ __device__ __forceinline__ bf16_t* KR() const { return (bf16_t*)(base + 377552896ull); }
    __host__ __device__ __forceinline__ bf16_t* Qm() const { return (bf16_t*)(base + 382271488ull); }
    __host__ __device__ __forceinline__ bf16_t* Qmc() const { return (bf16_t*)(base + 457768960ull); }
    __host__ __device__ __forceinline__ bf16_t* Kmn() const { return (bf16_t*)(base + 467206144ull); }
    __host__ __device__ __forceinline__ bf16_t* Vm() const { return (bf16_t*)(base + 523829248ull); }
    __host__ __device__ __forceinline__ unsigned* EG() const { return (unsigned*)(base + 580452352ull); }
    __host__ __device__ __forceinline__ bf16_t* P() const { return (bf16_t*)(base + 382271488ull); }
    __host__ __device__ __forceinline__ bf16_t* PQ() const { return (bf16_t*)(base + 151060480ull); }
    __host__ __device__ __forceinline__ bf16_t* TMP() const { return (bf16_t*)(base + 65536ull); }
    __host__ __device__ __forceinline__ float* XC() const { return (float*)(base + 618201088ull); }
    __host__ __device__ __forceinline__ float* MOD() const { return (float*)(base + 651755520ull); }
    __host__ __device__ __forceinline__ float2* ROPA() const { return (float2*)(base + 653377536ull); }
    __host__ __device__ __forceinline__ float2* ROPC() const { return (float2*)(base + 653901824ull); }
    __host__ __device__ __forceinline__ float* RSQ() const { return (float*)(base + 654163968ull); }
    __host__ __device__ __forceinline__ float* RSKV() const { return (float*)(base + 654458880ull); }
    __host__ __device__ __forceinline__ bf16_t* WinT() const { return (bf16_t*)(base + 654753792ull); }
    __host__ __device__ __forceinline__ bf16_t* WuqT() const { return (bf16_t*)(base + 662093824ull); }
    __host__ __device__ __forceinline__ bf16_t* WukvT() const { return (bf16_t*)(base + 663273472ull); }
    __host__ __device__ __forceinline__ bf16_t* WoutT() const { return (bf16_t*)(base + 664059904ull); }
    __host__ __device__ __forceinline__ bf16_t* WqT() const { return (bf16_t*)(base + 668254208ull); }
    __host__ __device__ __forceinline__ bf16_t* SubK() const { return (bf16_t*)(base + 676642816ull); }
    __host__ __device__ __forceinline__ unsigned char* U8() const { return (unsigned char*)(base + 677691392ull); }
    __host__ __device__ __forceinline__ unsigned char* V8() const { return (unsigned char*)(base + 711245824ull); }
    __host__ __device__ __forceinline__ float* US() const { return (float*)(base + 744800256ull); }
    __host__ __device__ __forceinline__ float* VS() const { return (float*)(base + 744931328ull); }
    __host__ __device__ __forceinline__ float* SSQ() const { return (float*)(base + 745062400ull); }
    __host__ __device__ __forceinline__ float* SSKV() const { return (float*)(base + 747421696ull); }
    __host__ __device__ __forceinline__ unsigned* WE() const { return (unsigned*)(base + 748601344ull); }
    __host__ __device__ __forceinline__ signed char* H8() const { return (signed char*)(base + 786350080ull); }
    __host__ __device__ __forceinline__ float* HS() const { return (float*)(base + 861847552ull); }
    __host__ __device__ __forceinline__ bf16_t* PoolWT() const { return (bf16_t*)(base + 862142464ull); }
};
constexpr size_t WS_BYTES = 862208000ull;
static WS make_ws(void* d_ws) { WS w; w.base = (char*)d_ws; return w; }


#define LAS __attribute__((address_space(3)))
typedef short bf16x8 __attribute__((ext_vector_type(8)));
typedef float f32x4 __attribute__((ext_vector_type(4)));
typedef float f32x16 __attribute__((ext_vector_type(16)));
typedef unsigned u32x4 __attribute__((ext_vector_type(4)));
typedef unsigned u32x2 __attribute__((ext_vector_type(2)));

__device__ __forceinline__ f32x16 mfma32(bf16x8 a, bf16x8 b, f32x16 c) { return __builtin_amdgcn_mfma_f32_32x32x16_bf16(a, b, c, 0, 0, 0); }
__device__ __forceinline__ unsigned cvt_pk_bf16(float lo, float hi) { unsigned r; asm volatile("v_cvt_pk_bf16_f32 %0, %1, %2" : "=v"(r) : "v"(lo), "v"(hi)); return r; }

namespace pg8 {
constexpr int BM = 256, BK = 64, HALF = 128, HTB = HALF * BK * 2, STAGE_BYTES = 8 * HTB, NXCD = 8, WGM = 8;
__host__ __device__ __forceinline__ int lds_byte(int r, int c) { const int st = (r >> 4) * 2 + (c >> 5), rr = r & 15, cc = c & 31, ob = rr * 64 + cc * 2; return st * 1024 + (ob ^ (((ob >> 9) & 1) << 5)); }
__host__ __device__ __forceinline__ void stage_rc(int b, int& R, int& C) { const int st = b / 1024, sb = b % 1024, swz = sb ^ (((sb >> 9) & 1) << 5); R = (st >> 1) * 16 + swz / 64; C = (st & 1) * 32 + (swz % 64) / 2; }
__host__ __device__ __forceinline__ int perm32(int rho) { const int n = rho >> 4, i = rho & 15; return 8 * (i >> 2) + 4 * n + (i & 3); }
struct Unit { int pm, pn; };
struct Gemm { const bf16_t* A; const bf16_t* Bt; int M, N, K; };
struct StaticOrder {
    int nM, nN, nwg, G, c;
    __host__ __device__ void init(int M, int N, int G_, int c_) { nM = M / BM; nN = N / BM; nwg = nM * nN; G = G_; c = c_; }
    __host__ __device__ bool next(int i, Unit& u) const {
        const long L = (long)i * G + c; if (L >= nwg) return false;
        int wgid = (int)L; { const int q = nwg / NXCD, r = nwg % NXCD, xcd = wgid % NXCD, off = wgid / NXCD; wgid = (xcd < r ? xcd * (q + 1) : r * (q + 1) + (xcd - r) * q) + off; }
        const int nig = WGM * nN, gid = wgid / nig, fm = gid * WGM, gsz = (nM - fm) < WGM ? (nM - fm) : WGM;
        u.pm = fm + ((wgid % nig) % gsz); u.pn = (wgid % nig) / gsz; return true;
    }
};
template <class Epi, class Sched>
__device__ __forceinline__ void gemm_phase(LAS unsigned char* lds, const Gemm g, const Sched& S, const Epi& E) {
    int tid_ = threadIdx.x; asm volatile("" : "+v"(tid_));
    const int tid = tid_, wid = __builtin_amdgcn_readfirstlane(tid >> 6), lane = tid & 63, wr = wid >> 2, wc = wid & 3, fr = lane & 15, fq = lane >> 4;
    const int K = g.K, nt = K / BK;
    unsigned voffA[2], voffB[2];
#pragma unroll
    for (int i = 0; i < 2; ++i) { int R, C; stage_rc(tid * 16 + i * 8192, R, C); const int Rb = Epi::PERM ? ((R & ~31) + perm32(R & 31)) : R;
        voffA[i] = (unsigned)(R * K + C) * 2u; voffB[i] = (unsigned)(Rb * K + C) * 2u; }
    const size_t kstep = (size_t)(BK * 2);
    const size_t hstep = (size_t)HALF * K * 2;
    const size_t tstep = 2 * hstep;
    const unsigned ldsw = (unsigned)wid * 1024u;
    const int aoff = lds_byte(wr * 64 + fr, fq * 8), boff = lds_byte(wc * 32 + fr, fq * 8);
#define PG8_SA(b, h) (((b) * 2 + (h)) * HTB)
#define PG8_SB(b, h) ((4 + (b) * 2 + (h)) * HTB)
#define PG8_STAGE(bufoff, gbase, voff) do { _Pragma("unroll") for (int _i = 0; _i < 2; ++_i) \
        __builtin_amdgcn_global_load_lds((const unsigned*)((const char*)(gbase) + (voff)[_i]), (LAS unsigned*)(lds + (bufoff) + ldsw + _i * 8192), 16, 0, 0); } while (0)
#define PG8_LDA(dst, b, h) do { _Pragma("unroll") for (int m = 0; m < 4; ++m) _Pragma("unroll") for (int k = 0; k < 2; ++k) dst[m][k] = *(const LAS bf16x8*)(lds + PG8_SA(b, h) + aoff + m * 2048 + k * 1024); } while (0)
#define PG8_LDB(dst, b, h) do { _Pragma("unroll") for (int n = 0; n < 2; ++n) _Pragma("unroll") for (int k = 0; k < 2; ++k) dst[n][k] = *(const LAS bf16x8*)(lds + PG8_SB(b, h) + boff + n * 2048 + k * 1024); } while (0)
#define PG8_MMA(ai, bj, At, Bt) do { __builtin_amdgcn_s_setprio(1); _Pragma("unroll") for (int m = 0; m < 4; ++m) _Pragma("unroll") for (int n = 0; n < 2; ++n) _Pragma("unroll") for (int k = 0; k < 2; ++k) \
        acc[ai][bj][m][n] = __builtin_amdgcn_mfma_f32_16x16x32_bf16(Bt[n][k], At[m][k], acc[ai][bj][m][n], 0, 0, 0); __builtin_amdgcn_s_setprio(0); } while (0)
#define PG8_WAIT_V(n) asm volatile("s_waitcnt vmcnt(" #n ")" ::: "memory")
#define PG8_WAIT_L(n) asm volatile("s_waitcnt lgkmcnt(" #n ")" ::: "memory")
#define PG8_BAR __builtin_amdgcn_s_barrier()
#define PG8_SCHED __builtin_amdgcn_sched_barrier(0)
    Unit cur, nxt; int ui = 0;
    if (!S.next(0, cur)) return;
    f32x4 acc[2][2][4][2];
#pragma unroll
    for (int a = 0; a < 2; ++a)
#pragma unroll
        for (int b = 0; b < 2; ++b)
#pragma unroll
            for (int m = 0; m < 4; ++m)
#pragma unroll
                for (int n = 0; n < 2; ++n) acc[a][b][m][n] = (f32x4){0.f, 0.f, 0.f, 0.f};
    bf16x8 At[4][2], B0[2][2], B1[2][2];
    const char* cA = (const char*)g.A + (size_t)cur.pm * tstep; const char* cB = (const char*)g.Bt + (size_t)cur.pn * tstep;
    PG8_STAGE(PG8_SB(0, 0), cB, voffB); PG8_STAGE(PG8_SA(0, 0), cA, voffA); PG8_STAGE(PG8_SB(0, 1), cB + hstep, voffB); PG8_STAGE(PG8_SA(0, 1), cA + hstep, voffA);
    if (wr == 1) PG8_BAR;
    PG8_WAIT_V(4); PG8_BAR;
    PG8_STAGE(PG8_SB(1, 0), cB + kstep, voffB); PG8_STAGE(PG8_SA(1, 0), cA + kstep, voffA); PG8_STAGE(PG8_SB(1, 1), cB + hstep + kstep, voffB);
    PG8_WAIT_V(6); PG8_BAR;
    for (;;) {
        const bool has_next = S.next(ui + 1, nxt);
        const char* nA = has_next ? (const char*)g.A + (size_t)nxt.pm * tstep : cA; const char* nB = has_next ? (const char*)g.Bt + (size_t)nxt.pn * tstep : cB;
#pragma nounroll
        for (int t = 0; t < nt; t += 2) {
            const bool last = (t == nt - 2);
            const char* a1 = cA + (size_t)(t + 1) * kstep;
            const char* a2 = last ? nA : cA + (size_t)(t + 2) * kstep; const char* b2 = last ? nB : cB + (size_t)(t + 2) * kstep;
            const char* a3 = a2 + kstep; const char* b3 = b2 + kstep;
            PG8_LDB(B0, 0, 0); PG8_SCHED; PG8_LDA(At, 0, 0); PG8_STAGE(PG8_SA(1, 1), a1 + hstep, voffA);
            PG8_WAIT_L(8); PG8_BAR; PG8_WAIT_L(0); PG8_MMA(0, 0, At, B0); PG8_BAR; PG8_SCHED;
            PG8_LDB(B1, 0, 1); PG8_STAGE(PG8_SB(0, 0), b2, voffB);
            PG8_BAR; PG8_WAIT_L(0); PG8_MMA(0, 1, At, B1); PG8_BAR;
            PG8_LDA(At, 0, 1); PG8_STAGE(PG8_SA(0, 0), a2, voffA);
            PG8_BAR; PG8_WAIT_L(0); PG8_MMA(1, 0, At, B0); PG8_BAR; PG8_SCHED;
            PG8_STAGE(PG8_SB(0, 1), b2 + hstep, voffB);
            PG8_WAIT_V(6); PG8_BAR; PG8_MMA(1, 1, At, B1); PG8_BAR;
            PG8_LDB(B0, 1, 0); PG8_SCHED; PG8_LDA(At, 1, 0); PG8_STAGE(PG8_SA(0, 1), a2 + hstep, voffA);
            PG8_WAIT_L(8); PG8_BAR; PG8_WAIT_L(0); PG8_MMA(0, 0, At, B0); PG8_BAR; PG8_SCHED;
            PG8_LDB(B1, 1, 1); PG8_STAGE(PG8_SB(1, 0), b3, voffB);
            PG8_BAR; PG8_WAIT_L(0); PG8_MMA(0, 1, At, B1); PG8_BAR;
            PG8_LDA(At, 1, 1); PG8_STAGE(PG8_SA(1, 0), a3, voffA);
            PG8_BAR; PG8_WAIT_L(0); PG8_MMA(1, 0, At, B0); PG8_BAR; PG8_SCHED;
            PG8_STAGE(PG8_SB(1, 1), b3 + hstep, voffB);
            PG8_WAIT_V(6); PG8_BAR; PG8_MMA(1, 1, At, B1); PG8_BAR;
        }
        E(acc, cur, wr, wc, fr, fq);
        if (!has_next) break;
#pragma unroll
        for (int a = 0; a < 2; ++a)
#pragma unroll
            for (int b = 0; b < 2; ++b)
#pragma unroll
                for (int m = 0; m < 4; ++m)
#pragma unroll
                    for (int n = 0; n < 2; ++n) acc[a][b][m][n] = (f32x4){0.f, 0.f, 0.f, 0.f};
        cur = nxt; cA = nA; cB = nB; ++ui;
    }
    PG8_WAIT_V(0);
    if (wr == 0) PG8_BAR;
    PG8_BAR;
#undef PG8_SA
#undef PG8_SB
#undef PG8_STAGE
#undef PG8_LDA
#undef PG8_LDB
#undef PG8_MMA
#undef PG8_WAIT_V
#undef PG8_WAIT_L
#undef PG8_BAR
#undef PG8_SCHED
}
}

enum { GT_AQ = 0, GT_AK = 1, GT_AV = 2, GT_B = 3, GT_CQ = 4, GT_CKV = 5, GT_KR = 6, GT_PAD = 7 };
__host__ __device__ __forceinline__ void in_group(int g, int& type, int& sub) {
    if (g < 2) { type = GT_AK; sub = g; } else if (g < 4) { type = GT_AV; sub = g - 2; } else if (g < 8) { type = GT_CKV; sub = g - 4; }
    else if (g == 8) { type = GT_KR; sub = 0; } else if (g < 12) { type = GT_PAD; sub = 0; } else if (g < 18) { type = GT_AQ; sub = g - 12; }
    else if (g < 24) { type = GT_CQ; sub = g - 18; } else { type = GT_B; sub = g - 24; }
}
__device__ __forceinline__ int colmap(int mode, int r) {
    const int pn = r >> 8, ct = r & 255, bj = ct >> 7, wc = (ct >> 5) & 3, j = ct & 31, g = 4 * pn + wc, e = 32 * bj + j;
    if (mode == 0) {
        int type, sub; in_group(g, type, sub);
        switch (type) { case GT_AQ: return 64 * sub + e; case GT_AK: return 384 + 64 * sub + e; case GT_AV: return 512 + 64 * sub + e; case GT_B: return 640 + 64 * sub + e;
            case GT_CQ: return 896 + 64 * sub + e; case GT_CKV: return 1280 + 64 * sub + e; case GT_KR: return (j < 16) ? 1536 + 16 * bj + j : -1; default: return -1; }
    } else if (mode == 1) {
        if (g < 6) return 96 * g + e; if (g < 9) { const int head = 2 * (g - 6) + (j >> 4); return 96 * head + 64 + 16 * bj + (j & 15); } return -1;
    } else if (mode == 2) {
        return 64 * g + e;
    }
    return r;
}
__device__ __forceinline__ void cvt_weights_unit(LAS float* tile  , const float* __restrict__ W, int K, int N, bf16_t* __restrict__ dst, int mode, const float* __restrict__ kgain, int r0, int k0) {
    int tid_ = threadIdx.x; asm volatile("" : "+v"(tid_));
    const int tid = tid_;
    const int jj = tid & 63; const int sc = colmap(mode, r0 + jj);
#pragma unroll
    for (int i = 0; i < 8; ++i) { const int kk = (tid >> 6) + 8 * i; float v = 0.f; if (sc >= 0) v = W[(size_t)(k0 + kk) * N + sc]; if (kgain) v *= kgain[k0 + kk]; tile[kk * 65 + jj] = v; }
    __syncthreads();
#pragma unroll
    for (int i = 0; i < 8; ++i) { const int rr = (tid >> 6) + 8 * i, kk = tid & 63; dst[(size_t)(r0 + rr) * K + k0 + kk] = f2bf(tile[kk * 65 + rr]); }
    __syncthreads();
}
struct CvtJob { const float* W; bf16_t* dst; const float* kgain; int K, N, Npad, mode; };
__device__ __forceinline__ void cvt_job(LAS float* tile, const CvtJob j, int vb, int nvb) {
    const int nk = j.K / 64, nr = j.Npad / 64;
    for (int u = vb; u < nk * nr; u += nvb) cvt_weights_unit(tile, j.W, j.K, j.N, j.dst, j.mode, j.kgain, (u / nk) * 64, (u % nk) * 64);
}
__device__ __forceinline__ void cvt_flat(const float* __restrict__ src, bf16_t* __restrict__ dst, size_t n, int vb, int nvb) {
    int tid_ = threadIdx.x; asm volatile("" : "+v"(tid_));
    for (size_t i = ((size_t)vb * 512 + tid_) * 8; i < n; i += (size_t)nvb * 512 * 8) {
        const float4 a = *(const float4*)(src + i), b = *(const float4*)(src + i + 4);
        u32x4 o; o.x = cvt_pk_bf16(a.x, a.y); o.y = cvt_pk_bf16(a.z, a.w); o.z = cvt_pk_bf16(b.x, b.y); o.w = cvt_pk_bf16(b.z, b.w);
        *(u32x4*)(dst + i) = o;
    }
}
template <bool FP8>
__device__ __forceinline__ void cvt_q8_rows(const float* __restrict__ src, unsigned char* __restrict__ dst, float* __restrict__ scales, int nrows, int vb, int nvb) {
    int tid_ = threadIdx.x; asm volatile("" : "+v"(tid_));
    const int lane = tid_ & 63, wid = tid_ >> 6;
    const int stride = nvb * 8;
    for (int row0 = vb * 8 + wid; row0 < nrows; row0 += 4 * stride) {
        f32x4 v[4][4];
#pragma unroll
        for (int q = 0; q < 4; ++q) { const int row = row0 + q * stride < nrows ? row0 + q * stride : row0; const float* sp = src + (size_t)row * 1024 + 16 * lane;
#pragma unroll
            for (int k = 0; k < 4; ++k) v[q][k] = *(const f32x4*)(sp + 4 * k); }
#pragma unroll
        for (int q = 0; q < 4; ++q) { const int row = row0 + q * stride; if (row < nrows) {
            float am = 0.f;
#pragma unroll
            for (int k = 0; k < 4; ++k) am = fmaxf(am, fmaxf(fmaxf(fabsf(v[q][k][0]), fabsf(v[q][k][1])), fmaxf(fabsf(v[q][k][2]), fabsf(v[q][k][3]))));
#pragma unroll
            for (int o = 32; o > 0; o >>= 1) am = fmaxf(am, __shfl_xor(am, o));
            const float qmax = FP8 ? 416.f : 127.f;
            const float sc = am > 0.f ? am / qmax : 1.f, inv = am > 0.f ? qmax / am : 0.f;
            u32x4 o4;
#pragma unroll
            for (int k = 0; k < 4; ++k) {
                if (FP8) { int p = __builtin_amdgcn_cvt_pk_fp8_f32(v[q][k][0] * inv, v[q][k][1] * inv, 0, false); p = __builtin_amdgcn_cvt_pk_fp8_f32(v[q][k][2] * inv, v[q][k][3] * inv, p, true); o4[k] = (unsigned)p; }
                else { const int q0 = (int)rintf(v[q][k][0] * inv), q1 = (int)rintf(v[q][k][1] * inv), q2 = (int)rintf(v[q][k][2] * inv), q3 = (int)rintf(v[q][k][3] * inv);
                    o4[k] = (unsigned)(q0 & 0xff) | ((unsigned)(q1 & 0xff) << 8) | ((unsigned)(q2 & 0xff) << 16) | ((unsigned)(q3 & 0xff) << 24); } }
            *(u32x4*)(dst + (size_t)row * 1024 + 16 * lane) = o4;
            if (lane == 0) scales[row] = sc; } }
    }
}
struct Inputs {
    const float *x, *c, *ctx, *c_ctx, *ada_w, *ada_b, *norm1_g, *norm2_g, *w_in, *gqa_qn_g, *gqa_kn_g, *pool_w, *pool_scale, *mla_qn_g, *mla_kvn_g, *mla_w_uq, *mla_w_ukv, *w_out, *peer_wq, *peer_subkeys, *peer_u, *peer_v, *final_g;
};
__device__ __forceinline__ void phase_cvt(LAS unsigned char* lds, const Inputs& in, const WS& w, int vb, int nvb) {
    LAS float* tile = (LAS float*)lds;
    for (int l = 0; l < 2; ++l) {
        cvt_job(tile, CvtJob{in.w_in + (size_t)l * 1024 * INC, w.WinT() + (size_t)l * 1792 * 1024, nullptr, 1024, INC, 1792, 0}, vb, nvb);
        cvt_job(tile, CvtJob{in.mla_w_uq + (size_t)l * 384 * 576, w.WuqT() + (size_t)l * 768 * 384, in.mla_qn_g + l * 384, 384, 576, 768, 1}, vb, nvb);
        cvt_job(tile, CvtJob{in.mla_w_ukv + (size_t)l * 256 * 768, w.WukvT() + (size_t)l * 768 * 256, in.mla_kvn_g + l * 256, 256, 768, 768, 2}, vb, nvb);
        cvt_job(tile, CvtJob{in.w_out + (size_t)l * 1024 * 1024, w.WoutT() + (size_t)l * 1024 * 1024, nullptr, 1024, 1024, 1024, 3}, vb, nvb);
        cvt_job(tile, CvtJob{in.peer_wq + (size_t)l * 1024 * 2048, w.WqT() + (size_t)l * 2048 * 1024, nullptr, 1024, 2048, 2048, 3}, vb, nvb);
    }
    cvt_flat(in.peer_subkeys, w.SubK(), (size_t)2 * 16 * 128 * 128, vb, nvb);
    { int tp_ = threadIdx.x; asm volatile("" : "+v"(tp_));
      for (int i = vb * 512 + tp_; i < 2 * 4 * 64 * 64; i += nvb * 512) { const int c = i & 63, d = (i >> 6) & 63, lg = i >> 12; w.PoolWT()[i] = f2bf(in.pool_w[(size_t)lg * 4096 + c * 64 + d]); } }
    if (nvb > 144) { if (vb >= 72) { cvt_q8_rows<false>(in.peer_u, w.U8(), w.US(), 2 * NE, vb - 72, nvb - 72); cvt_q8_rows<true>(in.peer_v, w.V8(), w.VS(), 2 * NE, vb - 72, nvb - 72); } }
    else { cvt_q8_rows<false>(in.peer_u, w.U8(), w.US(), 2 * NE, vb, nvb); cvt_q8_rows<true>(in.peer_v, w.V8(), w.VS(), 2 * NE, vb, nvb); }
}

struct EpiIn {
    static constexpr bool PERM = true;
    WS w; const float* qn_g; const float* kn_g; int pm_base;
    __device__ __forceinline__ void operator()(const f32x4 (&acc)[2][2][4][2], const pg8::Unit& u, int wr, int wc, int fr, int fq) const {
        int type, sub; in_group(4 * u.pn + wc, type, sub);
        if (type == GT_PAD) return;
        const int pm = u.pm + pm_base; const bool isctx = pm >= 256; const int b = isctx ? pm - 256 : pm >> 3; const int t0 = isctx ? 0 : (pm & 7) * 256;
        const size_t rowbase = isctx ? (size_t)NL + (size_t)b * CTX : (size_t)b * S;
        const int keyoff = isctx ? 0 : CTX;
        float gain[2][8];
        if (type == GT_AQ) {
#pragma unroll
            for (int bj = 0; bj < 2; ++bj)
#pragma unroll
                for (int q = 0; q < 8; ++q) gain[bj][q] = qn_g[32 * bj + 8 * fq + q];
        } else if (type == GT_AK) {
#pragma unroll
            for (int bj = 0; bj < 2; ++bj)
#pragma unroll
                for (int q = 0; q < 8; ++q) gain[bj][q] = kn_g[32 * bj + 8 * fq + q];
        }
#pragma unroll
        for (int ai = 0; ai < 2; ++ai)
#pragma unroll
            for (int m = 0; m < 4; ++m) {
                const int t = t0 + 128 * ai + 64 * wr + 16 * m + fr; const size_t row = rowbase + t;
                float v[2][8];
#pragma unroll
                for (int bj = 0; bj < 2; ++bj)
#pragma unroll
                    for (int n = 0; n < 2; ++n)
#pragma unroll
                        for (int i = 0; i < 4; ++i) v[bj][4 * n + i] = acc[ai][bj][m][n][i];
                bf16_t* dst = nullptr;
                if (type == GT_AQ || type == GT_AK) {
                    float ss = 0.f;
#pragma unroll
                    for (int bj = 0; bj < 2; ++bj)
#pragma unroll
                        for (int q = 0; q < 8; ++q) ss += v[bj][q] * v[bj][q];
                    ss += __shfl_xor(ss, 16); ss += __shfl_xor(ss, 32);
                    const float rstd = rsqrtf(ss * (1.f / 64.f) + EPS);
#pragma unroll
                    for (int q = 0; q < 8; ++q) { float x1 = v[0][q] * rstd * gain[0][q], x2 = v[1][q] * rstd * gain[1][q];
                        if (!isctx) { const float2 cs = w.ROPA()[t * 32 + 8 * fq + q]; const float y1 = x1 * cs.x - x2 * cs.y, y2 = x1 * cs.y + x2 * cs.x; x1 = y1; x2 = y2; }
                        v[0][q] = x1; v[1][q] = x2; }
                    if (type == GT_AQ) dst = isctx ? w.Qgc() + (((size_t)b * 6 + sub) * CTX + t) * 64 : w.Qg() + (((size_t)b * 6 + sub) * S + t) * 64;
                    else dst = w.Kg() + (((size_t)b * 2 + sub) * KEYS + keyoff + t) * 64;
                } else if (type == GT_AV) { dst = w.Vg() + (((size_t)b * 2 + sub) * KEYS + keyoff + t) * 64;
                } else if (type == GT_B) { dst = w.Bp() + row * 256 + 64 * sub;
                } else if (type == GT_CQ || type == GT_CKV) {
                    float ss = 0.f;
#pragma unroll
                    for (int bj = 0; bj < 2; ++bj)
#pragma unroll
                        for (int q = 0; q < 8; ++q) ss += v[bj][q] * v[bj][q];
                    ss += __shfl_xor(ss, 16); ss += __shfl_xor(ss, 32);
                    if (type == GT_CQ) { if (fq == 0) w.SSQ()[row * 8 + sub] = ss; dst = w.CQ() + row * 384 + 64 * sub; }
                    else { if (fq == 0) w.SSKV()[row * 4 + sub] = ss; dst = w.CKV() + row * 256 + 64 * sub; }
                } else {
                    if (!isctx) {
#pragma unroll
                        for (int q = 0; q < 8; ++q) { const float2 cs = w.ROPC()[t * 16 + ((8 * fq + q) & 15)]; const float x1 = v[0][q], x2 = v[1][q]; v[0][q] = x1 * cs.x - x2 * cs.y; v[1][q] = x1 * cs.y + x2 * cs.x; } }
                    if (fq < 2) { bf16_t* kd = w.KR() + ((size_t)b * KEYS + keyoff + t) * 32;
#pragma unroll
                        for (int bj = 0; bj < 2; ++bj) { u32x4 o; o.x = cvt_pk_bf16(v[bj][0], v[bj][1]); o.y = cvt_pk_bf16(v[bj][2], v[bj][3]); o.z = cvt_pk_bf16(v[bj][4], v[bj][5]); o.w = cvt_pk_bf16(v[bj][6], v[bj][7]);
                            *(u32x4*)(kd + 16 * bj + 8 * fq) = o; } }
                    continue;
                }
#pragma unroll
                for (int bj = 0; bj < 2; ++bj) { u32x4 o; o.x = cvt_pk_bf16(v[bj][0], v[bj][1]); o.y = cvt_pk_bf16(v[bj][2], v[bj][3]); o.z = cvt_pk_bf16(v[bj][4], v[bj][5]); o.w = cvt_pk_bf16(v[bj][6], v[bj][7]);
                    *(u32x4*)(dst + 32 * bj + 8 * fq) = o; }
            }
    }
};
struct P1Order {
    pg8::StaticOrder so; int nctx_tiles, G, c;
    __device__ bool next(int i, pg8::Unit& u) const {
        const int L = i * G + c;
        if (L < 1792) return so.next(i, u);
        const int Lc = L - 1792; if (Lc >= 32 * nctx_tiles) return false;
        u.pm = 256 + (Lc & 31); u.pn = Lc >> 5; return true;
    }
};
__device__ __forceinline__ void phase_p1(LAS unsigned char* lds, const WS& w, const Inputs& in, int l, int vb, int nvb) {
    EpiIn E{w, in.gqa_qn_g + l * 64, in.gqa_kn_g + l * 64, 0};
    P1Order po; po.so.init(NL, 1792, nvb, vb); po.nctx_tiles = (l == 0) ? 7 : 3; po.G = nvb; po.c = vb;
    pg8::gemm_phase(lds, pg8::Gemm{w.H(), w.WinT() + (size_t)l * 1792 * 1024, NR, 1792, 1024}, po, E);
}

extern __shared__ __attribute__((aligned(16))) unsigned char dyn_lds[];

struct EpiUq {
    static constexpr bool PERM = true;
    WS w;
    __device__ __forceinline__ void operator()(const f32x4 (&acc)[2][2][4][2], const pg8::Unit& u, int wr, int wc, int fr, int fq) const {
        const int g = 4 * u.pn + wc; if (g >= 9) return;
        const int pm = u.pm; const bool isctx = pm >= 256; const int b = isctx ? pm - 256 : pm >> 3; const int t0 = isctx ? 0 : (pm & 7) * 256;
        const size_t rowbase = isctx ? (size_t)NL + (size_t)b * CTX : (size_t)b * S;
        const int head = g < 6 ? g : 2 * (g - 6) + (fq >> 1);
#pragma unroll
        for (int ai = 0; ai < 2; ++ai)
#pragma unroll
            for (int m = 0; m < 4; ++m) {
                const int t = t0 + 128 * ai + 64 * wr + 16 * m + fr; const size_t row = rowbase + t;
                const float4 s0 = *(const float4*)(w.SSQ() + row * 8), s1 = *(const float4*)(w.SSQ() + row * 8 + 4);
                const float rstd = rsqrtf((s0.x + s0.y + s0.z + s0.w + s1.x + s1.y) * (1.f / 384.f) + EPS);
                float v[2][8];
#pragma unroll
                for (int bj = 0; bj < 2; ++bj)
#pragma unroll
                    for (int n = 0; n < 2; ++n)
#pragma unroll
                        for (int i = 0; i < 4; ++i) v[bj][4 * n + i] = acc[ai][bj][m][n][i] * rstd;
                bf16_t* hd = isctx ? w.Qmc() + (((size_t)b * 6 + head) * CTX + t) * 96 : w.Qm() + (((size_t)b * 6 + head) * S + t) * 96;
                if (g >= 6 && !isctx) {
#pragma unroll
                    for (int q = 0; q < 8; ++q) { const float2 cs = w.ROPC()[t * 16 + 8 * (fq & 1) + q]; const float x1 = v[0][q], x2 = v[1][q]; v[0][q] = x1 * cs.x - x2 * cs.y; v[1][q] = x1 * cs.y + x2 * cs.x; } }
#pragma unroll
                for (int bj = 0; bj < 2; ++bj) { u32x4 o; o.x = cvt_pk_bf16(v[bj][0], v[bj][1]); o.y = cvt_pk_bf16(v[bj][2], v[bj][3]); o.z = cvt_pk_bf16(v[bj][4], v[bj][5]); o.w = cvt_pk_bf16(v[bj][6], v[bj][7]);
                    bf16_t* d = g < 6 ? hd + 32 * bj + 8 * fq : hd + 64 + 16 * bj + 8 * (fq & 1);
                    *(u32x4*)d = o; }
            }
    }
};
struct EpiUkv {
    static constexpr bool PERM = true;
    WS w;
    __device__ __forceinline__ void operator()(const f32x4 (&acc)[2][2][4][2], const pg8::Unit& u, int wr, int wc, int fr, int fq) const {
        const int g = 4 * u.pn + wc;
        const int pm = u.pm; const bool isctx = pm >= 256; const int b = isctx ? pm - 256 : pm >> 3; const int t0 = isctx ? 0 : (pm & 7) * 256;
        const size_t rowbase = isctx ? (size_t)NL + (size_t)b * CTX : (size_t)b * S; const int keyoff = isctx ? 0 : CTX;
        bf16_t* base = ((g & 1) ? w.Vm() : w.Kmn()) + ((size_t)b * 6 + (g >> 1)) * KEYS * 64;
#pragma unroll
        for (int ai = 0; ai < 2; ++ai)
#pragma unroll
            for (int m = 0; m < 4; ++m) {
                const int t = t0 + 128 * ai + 64 * wr + 16 * m + fr; const size_t row = rowbase + t;
                const float4 s0 = *(const float4*)(w.SSKV() + row * 4);
                const float rstd = rsqrtf((s0.x + s0.y + s0.z + s0.w) * (1.f / 256.f) + EPS);
                bf16_t* d = base + (size_t)(keyoff + t) * 64;
#pragma unroll
                for (int bj = 0; bj < 2; ++bj) { const f32x4 a0 = acc[ai][bj][m][0] * rstd, a1 = acc[ai][bj][m][1] * rstd;
                    u32x4 o; o.x = cvt_pk_bf16(a0[0], a0[1]); o.y = cvt_pk_bf16(a0[2], a0[3]); o.z = cvt_pk_bf16(a1[0], a1[1]); o.w = cvt_pk_bf16(a1[2], a1[3]);
                    *(u32x4*)(d + 32 * bj + 8 * fq) = o; }
            }
    }
};
constexpr int POOL_X = 0, POOL_P = 272 * 128, POOL_BYTES = 272 * 128 + 256 * 128;
__device__ __forceinline__ void phase_pool(LAS unsigned char* lds, const WS& w, bf16_t* __restrict__ MIX, const bf16_t* __restrict__ WT  , const float* __restrict__ pool_scale, int nrows, int vb, int nvb) {
    int tid_ = threadIdx.x; asm volatile("" : "+v"(tid_));
    const int tid = tid_, lane = tid & 63, wid = __builtin_amdgcn_readfirstlane(tid >> 6), r32 = lane & 31, hi = lane >> 5;
    const int nunits = nrows >> 8;
    for (int u = vb; u < nunits; u += nvb) {
        const int row0 = u << 8; const bool isctx = row0 >= NL; const int L = isctx ? CTX : S; const int t0 = isctx ? 0 : (row0 & (S - 1)); const int seq0 = row0 - t0;
#pragma unroll 1
        for (int g = 0; g < 4; ++g) {
            const int wdw = 2 << g, half = wdw >> 1;
            for (int i = tid; i < 272 * 8; i += 512) { const int rr = i >> 3, ch = i & 7; int t = t0 - 8 + rr; t = t < 0 ? 0 : (t >= L ? L - 1 : t);
                *(LAS u32x4*)(lds + POOL_X + rr * 128 + ch * 16) = *(const u32x4*)(w.Bp() + (size_t)(seq0 + t) * 256 + g * 64 + ch * 8); }
            __syncthreads();
            { const int c = tid & 63, seg = tid >> 6; const LAS bf16_t* X = (const LAS bf16_t*)(lds + POOL_X) + c;
              int t = t0 + seg * 32; int lo = t - half, hiw = t - half + wdw; lo = lo < 0 ? 0 : lo; hiw = hiw > L ? L : hiw;
              float sum = 0.f; for (int q = lo; q < hiw; ++q) sum += bf2f(X[(q - t0 + 8) * 64]);
#pragma unroll 4
              for (int k = 0; k < 32; ++k, ++t) {
                  const int clo = (t - half) < 0 ? 0 : (t - half), chi = (t - half + wdw) > L ? L : (t - half + wdw);
                  const float pv = sum / (float)(chi - clo) - bf2f(X[(t - t0 + 8) * 64]);
                  const int r = seg * 32 + k; *((LAS bf16_t*)(lds + POOL_P + r * 128 + (((c >> 3) ^ ((r >> 1) & 7)) << 4)) + (c & 7)) = f2bf(pv);
                  const int add = t + 1 - half + wdw - 1, drop = t - half;
                  if (add < L) sum += bf2f(X[(add - t0 + 8) * 64]);
                  if (drop >= 0) sum -= bf2f(X[(drop - t0 + 8) * 64]);
              } }
            __syncthreads();
            { f32x16 o0 = {}, o1 = {};
              const bf16_t* wt = WT + (size_t)g * 4096 + (size_t)r32 * 64 + 8 * hi;
#pragma unroll
              for (int s = 0; s < 4; ++s) { const int row = wid * 32 + r32; const bf16x8 pf = *(const LAS bf16x8*)(lds + POOL_P + row * 128 + (((2 * s + hi) ^ ((row >> 1) & 7)) << 4));
                  o0 = mfma32(*(const bf16x8*)(wt + 16 * s), pf, o0); o1 = mfma32(*(const bf16x8*)(wt + 32 * 64 + 16 * s), pf, o1); }
              bf16_t* op = MIX + (size_t)(row0 + wid * 32 + r32) * 1024 + 384 + g * 64 + 4 * hi; const float* ps = pool_scale + g * 64 + 4 * hi;
#pragma unroll
              for (int q = 0; q < 4; ++q) { const f32x4 s0 = *(const f32x4*)(ps + 8 * q), s1 = *(const f32x4*)(ps + 32 + 8 * q); u32x2 a, b;
                  a.x = cvt_pk_bf16(o0[4 * q] * s0[0], o0[4 * q + 1] * s0[1]); a.y = cvt_pk_bf16(o0[4 * q + 2] * s0[2], o0[4 * q + 3] * s0[3]);
                  b.x = cvt_pk_bf16(o1[4 * q] * s1[0], o1[4 * q + 1] * s1[1]); b.y = cvt_pk_bf16(o1[4 * q + 2] * s1[2], o1[4 * q + 3] * s1[3]);
                  *(u32x2*)(op + 8 * q) = a; *(u32x2*)(op + 32 + 8 * q) = b; } }
            __syncthreads();
        }
    }
}
__device__ __forceinline__ void phase_p2(LAS unsigned char* lds, const WS& w, const Inputs& in, int l, int vb, int nvb, int parts = 7) {
    pg8::StaticOrder so;
    if (parts & 1) { EpiUq E{w}; const int M = l == 0 ? NR : NL; so.init(M, 768, nvb, vb); pg8::gemm_phase(lds, pg8::Gemm{w.CQ(), w.WuqT() + (size_t)l * 768 * 384, M, 768, 384}, so, E); }
    if (parts & 2) { EpiUkv E{w}; so.init(NR, 768, nvb, vb); pg8::gemm_phase(lds, pg8::Gemm{w.CKV(), w.WukvT() + (size_t)l * 768 * 256, NR, 768, 256}, so, E); }
    if (parts & 4) phase_pool(lds, w, w.H(), w.PoolWT() + (size_t)l * 4 * 64 * 64, in.pool_scale + l * 256, l == 0 ? NR : NL, vb, nvb);
}

struct EpiOut {
    static constexpr bool PERM = true;
    bf16_t* DLT; const float* gate;
    __device__ __forceinline__ void operator()(const f32x4 (&acc)[2][2][4][2], const pg8::Unit& u, int wr, int wc, int fr, int fq) const {
        const int pm = u.pm; const int mr = pm >= 256 ? 32 : pm >> 3;
        const size_t r0 = (size_t)pm * 256 + wr * 64 + fr; const int col0 = u.pn * 256 + wc * 32 + 8 * fq;
        f32x4 gv[2][2];
#pragma unroll
        for (int bj = 0; bj < 2; ++bj)
#pragma unroll
            for (int n = 0; n < 2; ++n) gv[bj][n] = *(const f32x4*)(gate + (size_t)mr * 6144 + col0 + bj * 128 + 4 * n);
#pragma unroll
        for (int ai = 0; ai < 2; ++ai)
#pragma unroll
            for (int m = 0; m < 4; ++m) { bf16_t* d = DLT + (r0 + ai * 128 + m * 16) * 1024 + col0;
#pragma unroll
                for (int bj = 0; bj < 2; ++bj) { const f32x4 a0 = acc[ai][bj][m][0] * gv[bj][0], a1 = acc[ai][bj][m][1] * gv[bj][1];
                    u32x4 o; o.x = cvt_pk_bf16(a0[0], a0[1]); o.y = cvt_pk_bf16(a0[2], a0[3]); o.z = cvt_pk_bf16(a1[0], a1[1]); o.w = cvt_pk_bf16(a1[2], a1[3]);
                    *(u32x4*)(d + bj * 128) = o; } }
    }
};
__device__ __forceinline__ void phase_p4(LAS unsigned char* lds, const WS& w, const Inputs& in, int l, int vb, int nvb) {
    const float* MODl = w.MOD() + (size_t)l * 33 * 6144;
    EpiOut E{w.PQ(), MODl + 2 * 1024};
    const int M = l == 0 ? NR : NL;
    pg8::StaticOrder so; so.init(M, 1024, nvb, vb);
    pg8::gemm_phase(lds, pg8::Gemm{w.H(), w.WoutT() + (size_t)l * 1024 * 1024, M, 1024, 1024}, so, E);
}

__device__ __forceinline__ void phase_modulate(const float* __restrict__ XLp, const float* __restrict__ XCp, bf16_t* __restrict__ Hout, const float* __restrict__ g, const float* __restrict__ MODl, int si, int nrows, int vb, int nvb, signed char* __restrict__ H8 = nullptr, float* __restrict__ HS = nullptr,
                                               const bf16_t* __restrict__ DLT = nullptr, float* __restrict__ XLo = nullptr, float* __restrict__ XCo = nullptr) {
    int tid_ = threadIdx.x; asm volatile("" : "+v"(tid_));
    const int tid = tid_, lane = tid & 63, wid = tid >> 6;
    f32x4 gv[4];
#pragma unroll
    for (int i = 0; i < 4; ++i) gv[i] = *(const f32x4*)(g + 256 * i + 4 * lane);
    const int stride = nvb * 8, lastrow = nrows - 1;
    f32x4 nx[4]; u32x2 ndr[4];
#define PM_LOAD(r_) do { const int rr_ = (r_) < nrows ? (r_) : lastrow; const bool ic_ = rr_ >= NL; const float* xp_ = ic_ ? XCp + (size_t)(rr_ - NL) * 1024 : XLp + (size_t)rr_ * 1024; \
        _Pragma("unroll") for (int i = 0; i < 4; ++i) { nx[i] = *(const f32x4*)(xp_ + 256 * i + 4 * lane); if (DLT) ndr[i] = *(const u32x2*)(DLT + (size_t)rr_ * 1024 + 256 * i + 4 * lane); } } while (0)
    PM_LOAD(vb * 8 + wid);
    for (int row = vb * 8 + wid; row < nrows; row += stride) {
        const bool isctx = row >= NL; const int mr = isctx ? 32 : row / S;
        f32x4 x[4]; u32x2 dr4[4]; float ss = 0.f;
#pragma unroll
        for (int i = 0; i < 4; ++i) { x[i] = nx[i]; if (DLT) dr4[i] = ndr[i]; }
        PM_LOAD(row + stride);
#pragma unroll
        for (int i = 0; i < 4; ++i) {
            if (DLT) { const u32x2 dr = dr4[i];
                x[i][0] += __uint_as_float(dr.x << 16); x[i][1] += __uint_as_float(dr.x & 0xffff0000u); x[i][2] += __uint_as_float(dr.y << 16); x[i][3] += __uint_as_float(dr.y & 0xffff0000u);
                float* xo = isctx ? XCo + (size_t)(row - NL) * 1024 : XLo + (size_t)row * 1024; *(f32x4*)(xo + 256 * i + 4 * lane) = x[i]; }
            ss += x[i][0] * x[i][0] + x[i][1] * x[i][1] + x[i][2] * x[i][2] + x[i][3] * x[i][3]; }
        ss = wave_sum(ss); const float rstd = rsqrtf(ss * (1.f / 1024.f) + EPS);
        const float* sh = MODl + (size_t)mr * 6144 + si * 1024;
        f32x4 y[4]; float am = 0.f;
#pragma unroll
        for (int i = 0; i < 4; ++i) { const f32x4 shv = *(const f32x4*)(sh + 256 * i + 4 * lane), scv = *(const f32x4*)(sh + 1024 + 256 * i + 4 * lane);
            y[i] = x[i] * rstd * gv[i] * (scv + 1.f) + shv;
            am = fmaxf(am, fmaxf(fmaxf(fabsf(y[i][0]), fabsf(y[i][1])), fmaxf(fabsf(y[i][2]), fabsf(y[i][3]))));
            u32x2 o; o.x = cvt_pk_bf16(y[i][0], y[i][1]); o.y = cvt_pk_bf16(y[i][2], y[i][3]);
            *(u32x2*)(Hout + (size_t)row * 1024 + 256 * i + 4 * lane) = o; }
        if (H8) {
#pragma unroll
            for (int o = 32; o > 0; o >>= 1) am = fmaxf(am, __shfl_xor(am, o));
            const float inv = am > 0.f ? 127.f / am : 0.f;
#pragma unroll
            for (int i = 0; i < 4; ++i) { const int q0 = (int)rintf(y[i][0] * inv), q1 = (int)rintf(y[i][1] * inv), q2 = (int)rintf(y[i][2] * inv), q3 = (int)rintf(y[i][3] * inv);
                *(unsigned*)(H8 + (size_t)row * 1024 + 256 * i + 4 * lane) = (unsigned)(q0 & 0xff) | ((unsigned)(q1 & 0xff) << 8) | ((unsigned)(q2 & 0xff) << 16) | ((unsigned)(q3 & 0xff) << 24); }
            if (lane == 0) HS[row] = am > 0.f ? am * (1.f / 127.f) : 1.f;
        }
    }
#undef PM_LOAD
}

struct EpiPQ {
    static constexpr bool PERM = true;
    bf16_t* PQ;
    __device__ __forceinline__ void operator()(const f32x4 (&acc)[2][2][4][2], const pg8::Unit& u, int wr, int wc, int fr, int fq) const {
        const size_t r0 = (size_t)u.pm * 256 + wr * 64 + fr; const int col0 = u.pn * 256 + wc * 32 + 8 * fq;
#pragma unroll
        for (int ai = 0; ai < 2; ++ai)
#pragma unroll
            for (int m = 0; m < 4; ++m) { bf16_t* d = PQ + (r0 + ai * 128 + m * 16) * 2048 + col0;
#pragma unroll
                for (int bj = 0; bj < 2; ++bj) { const f32x4 a0 = acc[ai][bj][m][0], a1 = acc[ai][bj][m][1];
                    u32x4 o; o.x = cvt_pk_bf16(a0[0], a0[1]); o.y = cvt_pk_bf16(a0[2], a0[3]); o.z = cvt_pk_bf16(a1[0], a1[1]); o.w = cvt_pk_bf16(a1[2], a1[3]);
                    *(u32x4*)(d + bj * 128) = o; } }
    }
};
__device__ __forceinline__ void phase_p6a(LAS unsigned char* lds, const WS& w, int l, int vb, int nvb) {
    EpiPQ E{w.PQ()}; const int M = l == 0 ? NR : NL;
    pg8::StaticOrder so; so.init(M, 2048, nvb, vb);
    pg8::gemm_phase(lds, pg8::Gemm{w.H(), w.WqT() + (size_t)l * 2048 * 1024, M, 2048, 1024}, so, E);
}


using bf16x2_t = __attribute__((ext_vector_type(2))) __bf16;
typedef float f32x2 __attribute__((ext_vector_type(2)));
__device__ __forceinline__ float gelu_fast(float x) {
    const float u2 = 1.5957691216057308f * (x + 0.044715f * x * x * x);
    return x * __builtin_amdgcn_rcpf(1.f + __builtin_amdgcn_exp2f(-1.4426950408889634f * u2));
}
#define DPPF(v, ctrl) __builtin_bit_cast(float, __builtin_amdgcn_update_dpp(0, __builtin_bit_cast(int, (v)), (ctrl), 0xf, 0xf, true))
__device__ __forceinline__ float reduce8(float p0, float p1, float p2, float p3, float p4, float p5, float p6, float p7, int lane) {
    auto s01 = __builtin_amdgcn_permlane32_swap(__float_as_uint(p0), __float_as_uint(p1), false, false);
    auto s23 = __builtin_amdgcn_permlane32_swap(__float_as_uint(p2), __float_as_uint(p3), false, false);
    auto s45 = __builtin_amdgcn_permlane32_swap(__float_as_uint(p4), __float_as_uint(p5), false, false);
    auto s67 = __builtin_amdgcn_permlane32_swap(__float_as_uint(p6), __float_as_uint(p7), false, false);
    const float q0 = __uint_as_float(s01[0]) + __uint_as_float(s01[1]), q1 = __uint_as_float(s23[0]) + __uint_as_float(s23[1]);
    const float q2 = __uint_as_float(s45[0]) + __uint_as_float(s45[1]), q3 = __uint_as_float(s67[0]) + __uint_as_float(s67[1]);
    auto t0 = __builtin_amdgcn_permlane16_swap(__float_as_uint(q0), __float_as_uint(q1), false, false);
    auto t1 = __builtin_amdgcn_permlane16_swap(__float_as_uint(q2), __float_as_uint(q3), false, false);
    float r0 = __uint_as_float(t0[0]) + __uint_as_float(t0[1]);
    float r1 = __uint_as_float(t1[0]) + __uint_as_float(t1[1]);
    r0 += DPPF(r0, 0x128); r1 += DPPF(r1, 0x128);
    float z = (lane & 8) ? r1 : r0;
    z += DPPF(z, 0x141);
    z += DPPF(z, 0xB1);
    z += DPPF(z, 0x4E);
    return z;
}
__device__ __forceinline__ void p7_axpy(const u32x4 v, float wj, float (&out)[16]) {
#pragma unroll
    for (int k = 0; k < 4; ++k) { const f32x2 lo = __builtin_amdgcn_cvt_pk_f32_fp8((int)v[k], false), hi2 = __builtin_amdgcn_cvt_pk_f32_fp8((int)v[k], true);
        out[4 * k] = __builtin_fmaf(wj, lo.x, out[4 * k]); out[4 * k + 1] = __builtin_fmaf(wj, lo.y, out[4 * k + 1]); out[4 * k + 2] = __builtin_fmaf(wj, hi2.x, out[4 * k + 2]); out[4 * k + 3] = __builtin_fmaf(wj, hi2.y, out[4 * k + 3]); }
}
__device__ __forceinline__ int p7_doti(const u32x4 u, const u32x4 h) {
    int s = __builtin_amdgcn_sdot4((int)u[0], (int)h[0], 0, false); s = __builtin_amdgcn_sdot4((int)u[1], (int)h[1], s, false); s = __builtin_amdgcn_sdot4((int)u[2], (int)h[2], s, false); return __builtin_amdgcn_sdot4((int)u[3], (int)h[3], s, false);
}
#define DPPI(v, ctrl) __builtin_amdgcn_update_dpp(0, (v), (ctrl), 0xf, 0xf, true)
__device__ __forceinline__ int reduce8i(int p0, int p1, int p2, int p3, int p4, int p5, int p6, int p7, int lane) {
    auto s01 = __builtin_amdgcn_permlane32_swap((unsigned)p0, (unsigned)p1, false, false); auto s23 = __builtin_amdgcn_permlane32_swap((unsigned)p2, (unsigned)p3, false, false);
    auto s45 = __builtin_amdgcn_permlane32_swap((unsigned)p4, (unsigned)p5, false, false); auto s67 = __builtin_amdgcn_permlane32_swap((unsigned)p6, (unsigned)p7, false, false);
    const unsigned q0 = s01[0] + s01[1], q1 = s23[0] + s23[1], q2 = s45[0] + s45[1], q3 = s67[0] + s67[1];
    auto t0 = __builtin_amdgcn_permlane16_swap(q0, q1, false, false); auto t1 = __builtin_amdgcn_permlane16_swap(q2, q3, false, false);
    int r0 = (int)(t0[0] + t0[1]), r1 = (int)(t1[0] + t1[1]);
    r0 += DPPI(r0, 0x128); r1 += DPPI(r1, 0x128);
    int z = (lane & 8) ? r1 : r0;
    z += DPPI(z, 0x141); z += DPPI(z, 0xB1); z += DPPI(z, 0x4E);
    return z;
}

struct P7CArgs { const signed char* H8; const unsigned* EG; const unsigned char* U8; int* PART; int nrows; };
__device__ __forceinline__ void phase_p7c(LAS unsigned char* lds, const P7CArgs& a, int part, int prank, int nvb) {
    int tid_ = threadIdx.x; asm volatile("" : "+v"(tid_));
    const int lane = tid_ & 63, wid = __builtin_amdgcn_readfirstlane(tid_ >> 6);
    const int nw = (nvb >> 3) * 8, wrank = prank * 8 + wid;
    LAS unsigned* tab = (LAS unsigned*)(lds + wid * 1024);
    const int grp = lane >> 3, c = lane & 7, c16 = c * 16;
    const unsigned char* ubase = a.U8 + 128 * part + c16;
    const signed char* hbase = a.H8 + 128 * part + c16;
    int* pbase = a.PART + (size_t)part * a.nrows * 128;
    const int c2 = (c >> 2) & 1, c1 = (c >> 1) & 1, c0 = c & 1;
    const int ent0 = 8 * (8 * c2 + 4 * c0 + 2 * c1) + grp;
    u32x4 Av[16], Bv[16]; u32x4 Ah, Bh;
    unsigned pw0 = 0u, pw1 = 0u;
#define P7C_PREF(t) do { pw0 = a.EG[(size_t)(t) * 128 + lane]; pw1 = a.EG[(size_t)(t) * 128 + 64 + lane]; } while (0)
#define P7C_ISSUE(X, Xh, t, slot, tnext) do { LAS unsigned* tb_ = tab + (slot) * 128; \
        tb_[lane] = pw0; tb_[64 + lane] = pw1; \
        asm volatile("s_waitcnt lgkmcnt(0)" ::: "memory"); \
        _Pragma("unroll") for (int i_ = 0; i_ < 16; ++i_) { const unsigned e_ = tb_[8 * i_ + grp]; X[i_] = *(const u32x4*)(ubase + (size_t)(e_ >> 16) * 1024); } \
        Xh = *(const u32x4*)(hbase + (size_t)(t) * 1024); \
        P7C_PREF(tnext); } while (0)
#define P7C_X(v, ctrl) ((v) + DPPI((v), (ctrl)))
#define P7C_COMPUTE(X, Xh, t, valid) do { int d_[16]; \
        _Pragma("unroll") for (int i_ = 0; i_ < 16; ++i_) d_[i_] = p7_doti(X[i_], Xh); \
        int e8_[8]; _Pragma("unroll") for (int k = 0; k < 8; ++k) { const int send_ = c2 ? d_[k] : d_[k + 8], keep_ = c2 ? d_[k + 8] : d_[k]; e8_[k] = keep_ + DPPI(send_, 0x141); }            \
        int e4_[4]; _Pragma("unroll") for (int k = 0; k < 4; ++k) { const int send_ = c0 ? e8_[k] : e8_[k + 4], keep_ = c0 ? e8_[k + 4] : e8_[k]; e4_[k] = keep_ + DPPI(send_, 0xB1); }          \
        int e2_[2]; _Pragma("unroll") for (int k = 0; k < 2; ++k) { const int send_ = c1 ? e4_[k] : e4_[k + 2], keep_ = c1 ? e4_[k + 2] : e4_[k]; e2_[k] = keep_ + DPPI(send_, 0x4E); }          \
        if (valid) { int* pp_ = pbase + (size_t)(t) * 128 + ent0; pp_[0] = e2_[0]; pp_[8] = e2_[1]; } } while (0)
    const int lastrow = a.nrows - 1;
    int t = wrank;
    P7C_PREF(t);
    P7C_ISSUE(Av, Ah, t, 0, (t + nw < a.nrows ? t + nw : lastrow));
    while (t < a.nrows) {
        const int t1 = t + nw, t2 = t1 + nw, t3 = t2 + nw;
        const int k1 = t1 < a.nrows ? t1 : lastrow, k2 = t2 < a.nrows ? t2 : lastrow, k3 = t3 < a.nrows ? t3 : lastrow;
        P7C_ISSUE(Bv, Bh, k1, 1, k2);
        P7C_COMPUTE(Av, Ah, t, true);
        P7C_ISSUE(Av, Ah, k2, 0, k3);
        P7C_COMPUTE(Bv, Bh, k1, (t1 < a.nrows));
        t = t2;
    }
#undef P7C_PREF
#undef P7C_ISSUE
#undef P7C_COMPUTE
}
__device__ __forceinline__ void phase_p7d(const int* __restrict__ PART, const unsigned* __restrict__ EG, const float* __restrict__ US, const float* __restrict__ VS, const float* __restrict__ HS, unsigned* __restrict__ WE, int nrows, int vb, int nvb) {
    int tid_ = threadIdx.x; asm volatile("" : "+v"(tid_));
    typedef int i32x4 __attribute__((ext_vector_type(4)));
    const size_t n4 = (size_t)nrows * 32, pstride4 = n4;
    const i32x4* P4 = (const i32x4*)PART; const u32x4* EG4 = (const u32x4*)EG; u32x4* WE4 = (u32x4*)WE;
    for (size_t i = (size_t)vb * 512 + tid_; i < n4; i += (size_t)nvb * 512) {
        i32x4 s = P4[i];
#pragma unroll
        for (int p = 1; p < 8; ++p) s += P4[p * pstride4 + i];
        const u32x4 eg = EG4[i]; const float hs = HS[i >> 5];
        u32x4 o;
#pragma unroll
        for (int k = 0; k < 4; ++k) { const int eid = (int)(eg[k] >> 16);
            const float av = (float)s[k] * US[eid] * hs;
            const float wv = __uint_as_float(eg[k] << 16) * gelu_fast(av) * VS[eid];
            o[k] = (eg[k] & 0xffff0000u) | (cvt_pk_bf16(wv, 0.f) & 0xffffu); }
        WE4[i] = o;
    }
}
struct P7BArgs { const unsigned* WE; const unsigned char* V8; float* XL; float* XC; const float* gate2; int nrows; };
template <int PM>
__device__ __forceinline__ void phase_p7b(LAS unsigned char* lds, const P7BArgs& a, int part, int prank, int nvb) {
    int tid_ = threadIdx.x; asm volatile("" : "+v"(tid_));
    const int lane = tid_ & 63, wid = __builtin_amdgcn_readfirstlane(tid_ >> 6);
    const int nw = (nvb >> 3) * 8, wrank = prank * 8 + wid;
    LAS unsigned* tab = (LAS unsigned*)(lds + wid * 1024);
    const int grp = lane >> 3, c16 = (lane & 7) * 16;
    const unsigned char* vbase = a.V8 + 128 * part + c16;
    const int colofs = 128 * part + c16 + 8 * (lane >> 5) + 4 * ((lane >> 4) & 1) + 2 * ((lane >> 3) & 1);
    u32x4 Av[16], Bv[16]; float Aw[16], Bw[16]; f32x2 Ax, Ag, Bx, Bg;
    unsigned pw0 = 0u, pw1 = 0u;
#define P7B_PREF(t) do { pw0 = a.WE[(size_t)(t) * 128 + lane]; pw1 = a.WE[(size_t)(t) * 128 + 64 + lane]; } while (0)
#define P7B_ISSUE(X, Xw, Xx, Xg, t, slot, tnext) do { LAS unsigned* tb_ = tab + (slot) * 128; \
        tb_[lane] = pw0; tb_[64 + lane] = pw1; \
        asm volatile("s_waitcnt lgkmcnt(0)" ::: "memory"); \
        _Pragma("unroll") for (int i_ = 0; i_ < 16; ++i_) { const unsigned we_ = tb_[8 * i_ + grp]; Xw[i_] = __uint_as_float(we_ << 16); if (PM != 2) X[i_] = *(const u32x4*)(vbase + (size_t)(we_ >> 16) * 1024); else X[i_] = (u32x4){we_, 0x38383838u, 0x38383838u, 0x38383838u}; } \
        { const bool isctx_ = (t) >= NL; const float* xp_ = (isctx_ ? a.XC + (size_t)((t) - NL) * 1024 : a.XL + (size_t)(t) * 1024) + colofs; const int mr_ = isctx_ ? 32 : (t) / S; \
          Xx = *(const f32x2*)xp_; Xg = *(const f32x2*)(a.gate2 + (size_t)mr_ * 6144 + colofs); } \
        P7B_PREF(tnext); } while (0)
#define P7B_COMPUTE(X, Xw, Xx, Xg, t, valid) do { float acc[16]; \
        _Pragma("unroll") for (int k = 0; k < 16; ++k) acc[k] = 0.f; \
        if (PM != 1) { _Pragma("unroll") for (int i_ = 0; i_ < 16; ++i_) p7_axpy(X[i_], Xw[i_], acc); } else { _Pragma("unroll") for (int i_ = 0; i_ < 16; ++i_) acc[i_] = __uint_as_float((X[i_][0] ^ X[i_][1] ^ X[i_][2] ^ X[i_][3]) & 0x3fffffffu) + Xw[i_]; } \
        float b_[8]; _Pragma("unroll") for (int k = 0; k < 8; ++k) { auto s_ = __builtin_amdgcn_permlane32_swap(__float_as_uint(acc[k]), __float_as_uint(acc[k + 8]), false, false); b_[k] = __uint_as_float(s_[0]) + __uint_as_float(s_[1]); } \
        float c_[4]; _Pragma("unroll") for (int k = 0; k < 4; ++k) { auto s_ = __builtin_amdgcn_permlane16_swap(__float_as_uint(b_[k]), __float_as_uint(b_[k + 4]), false, false); c_[k] = __uint_as_float(s_[0]) + __uint_as_float(s_[1]); } \
        float d_[2]; _Pragma("unroll") for (int k = 0; k < 2; ++k) { const float send_ = (lane & 8) ? c_[k] : c_[k + 2]; const float keep_ = (lane & 8) ? c_[k + 2] : c_[k]; d_[k] = keep_ + DPPF(send_, 0x128); } \
        const bool isctx_ = (t) >= NL; float* xp_ = (isctx_ ? a.XC + (size_t)((t) - NL) * 1024 : a.XL + (size_t)(t) * 1024) + colofs; \
        f32x2 x_ = Xx; x_.x += Xg.x * d_[0]; x_.y += Xg.y * d_[1]; if ((valid) && PM == 0) *(f32x2*)xp_ = x_; else if (PM != 0 && x_.x == 1.2345e30f) *(f32x2*)xp_ = x_; } while (0)
    const int lastrow = a.nrows - 1;
    int t = wrank;
    P7B_PREF(t);
    P7B_ISSUE(Av, Aw, Ax, Ag, t, 0, (t + nw < a.nrows ? t + nw : lastrow));
    while (t < a.nrows) {
        const int t1 = t + nw, t2 = t1 + nw, t3 = t2 + nw;
        const int c1 = t1 < a.nrows ? t1 : lastrow, c2 = t2 < a.nrows ? t2 : lastrow, c3 = t3 < a.nrows ? t3 : lastrow;
        P7B_ISSUE(Bv, Bw, Bx, Bg, c1, 1, c2);
        P7B_COMPUTE(Av, Aw, Ax, Ag, t, true);
        P7B_ISSUE(Av, Aw, Ax, Ag, c2, 0, c3);
        P7B_COMPUTE(Bv, Bw, Bx, Bg, c1, (t1 < a.nrows));
        t = t2;
    }
#undef P7B_PREF
#undef P7B_ISSUE
#undef P7B_COMPUTE
}
__device__ __forceinline__ void phase_final_norm(float* __restrict__ XLp, const float* __restrict__ g, int vb, int nvb) {
    int tid_ = threadIdx.x; asm volatile("" : "+v"(tid_));
    const int lane = tid_ & 63, wid = tid_ >> 6;
    for (int row = vb * 8 + wid; row < NL; row += nvb * 8) {
        float* xp = XLp + (size_t)row * 1024; f32x4 x[4]; float ss = 0.f;
#pragma unroll
        for (int i = 0; i < 4; ++i) { x[i] = *(const f32x4*)(xp + 256 * i + 4 * lane); ss += x[i][0] * x[i][0] + x[i][1] * x[i][1] + x[i][2] * x[i][2] + x[i][3] * x[i][3]; }
        ss = wave_sum(ss); const float rstd = rsqrtf(ss * (1.f / 1024.f) + EPS);
#pragma unroll
        for (int i = 0; i < 4; ++i) *(f32x4*)(xp + 256 * i + 4 * lane) = x[i] * rstd * *(const f32x4*)(g + 256 * i + 4 * lane);
    }
}

typedef short s16x4 __attribute__((ext_vector_type(4)));
__device__ __forceinline__ s16x4 lds_tr16(const LAS unsigned char* p) { return __builtin_bit_cast(s16x4, __builtin_amdgcn_ds_read_tr16_b64_v4i16((LAS s16x4*)p)); }
constexpr int ATT_BUF = 20480;
template <int DK>
__device__ __forceinline__ void attn_unit(LAS unsigned char* lds, const bf16_t* __restrict__ Q, const bf16_t* __restrict__ K1, const bf16_t* __restrict__ K2, const bf16_t* __restrict__ V,
                                          int nkeys, float c2, bf16_t* __restrict__ out) {
    int tid_ = threadIdx.x; asm volatile("" : "+v"(tid_));
    const int tid = tid_, lane = tid & 63, wid = __builtin_amdgcn_readfirstlane(tid >> 6), r32 = lane & 31, hi = lane >> 5;
    constexpr int NS = DK / 16;
    bf16x8 qf[NS];
    { const bf16_t* qp = Q + (size_t)(wid * 32 + r32) * DK + 8 * hi;
#pragma unroll
      for (int s = 0; s < NS; ++s) qf[s] = *(const bf16x8*)(qp + 16 * s); }
    const int skey = tid >> 3, sch = tid & 7;
    const unsigned st_k1 = skey * 128 + ((sch ^ ((skey >> 1) & 7)) << 4);
    const unsigned st_v = 8192 + skey * 128 + (((sch << 4)) ^ (((skey >> 1) & 1) << 6));
    const int skey2 = (tid & 255) >> 2, sch2 = tid & 3;
    const unsigned st_k2 = 16384 + skey2 * 64 + ((sch2 ^ ((skey2 >> 2) & 3)) << 4);
    const bf16_t* gk1 = K1 + (size_t)skey * 64 + sch * 8; const bf16_t* gv = V + (size_t)skey * 64 + sch * 8;
    const bf16_t* gk2 = (DK == 96) ? K2 + (size_t)skey2 * 32 + sch2 * 8 : nullptr;
    unsigned ka[2][4];
#pragma unroll
    for (int kt = 0; kt < 2; ++kt)
#pragma unroll
        for (int s = 0; s < 4; ++s) { const int key = 32 * kt + r32; ka[kt][s] = key * 128 + (((2 * s + hi) ^ ((key >> 1) & 7)) << 4); }
    unsigned kb[2][2];
#pragma unroll
    for (int kt = 0; kt < 2; ++kt)
#pragma unroll
        for (int s = 0; s < 2; ++s) { const int key = 32 * kt + r32; kb[kt][s] = 16384 + key * 64 + (((2 * s + hi) ^ ((key >> 2) & 3)) << 4); }
    const int vq = (lane & 15) >> 2, vp = lane & 3, vg = (lane >> 4) & 1;
    unsigned va[2];
#pragma unroll
    for (int dvb = 0; dvb < 2; ++dvb) { const int key = 4 * hi + vq; va[dvb] = 8192 + key * 128 + ((((32 * dvb + 16 * vg + 4 * vp) * 2)) ^ (((key >> 1) & 1) << 6)); }
    float m = -1e30f, l = 0.f;
    f32x16 o0 = {}, o1 = {};
    const int NT = nkeys >> 6;
    u32x4 sk1, sv, sk2;
    sk1 = *(const u32x4*)gk1; sv = *(const u32x4*)gv; if (DK == 96) { if (tid < 256) sk2 = *(const u32x4*)gk2; }
    *(LAS u32x4*)(lds + st_k1) = sk1; *(LAS u32x4*)(lds + st_v) = sv; if (DK == 96) { if (tid < 256) *(LAS u32x4*)(lds + st_k2) = sk2; }
    __syncthreads();
    for (int t = 0; t < NT; ++t) {
        LAS unsigned char* buf = lds + (t & 1) * ATT_BUF;
        if (t + 1 < NT) { sk1 = *(const u32x4*)(gk1 + (size_t)(t + 1) * 64 * 64); sv = *(const u32x4*)(gv + (size_t)(t + 1) * 64 * 64); if (DK == 96) { if (tid < 256) sk2 = *(const u32x4*)(gk2 + (size_t)(t + 1) * 64 * 32); } }
        f32x16 p0 = {}, p1 = {};
#pragma unroll
        for (int s = 0; s < 4; ++s) { p0 = mfma32(*(const LAS bf16x8*)(buf + ka[0][s]), qf[s], p0); p1 = mfma32(*(const LAS bf16x8*)(buf + ka[1][s]), qf[s], p1); }
        if (DK == 96) {
#pragma unroll
            for (int s = 0; s < 2; ++s) { p0 = mfma32(*(const LAS bf16x8*)(buf + kb[0][s]), qf[4 + s], p0); p1 = mfma32(*(const LAS bf16x8*)(buf + kb[1][s]), qf[4 + s], p1); }
        }
        float mx = p0[0];
#pragma unroll
        for (int r = 1; r < 16; ++r) mx = fmaxf(mx, p0[r]);
#pragma unroll
        for (int r = 0; r < 16; ++r) mx = fmaxf(mx, p1[r]);
        { auto rr = __builtin_amdgcn_permlane32_swap(__float_as_uint(mx), __float_as_uint(mx), false, false); mx = fmaxf(__uint_as_float(rr[0]), __uint_as_float(rr[1])); }
        const float tm = mx * c2;
        if (__any(tm > m + 8.f)) {
            const float mn = fmaxf(m, tm), al = __builtin_amdgcn_exp2f(m - mn); m = mn; l *= al;
#pragma unroll
            for (int r = 0; r < 16; ++r) { o0[r] *= al; o1[r] *= al; }
        }
        const float nm = -m; float ls = 0.f;
#pragma unroll
        for (int r = 0; r < 16; ++r) { p0[r] = __builtin_amdgcn_exp2f(__builtin_fmaf(p0[r], c2, nm)); p1[r] = __builtin_amdgcn_exp2f(__builtin_fmaf(p1[r], c2, nm)); ls += p0[r] + p1[r]; }
        l += ls;
        bf16x8 pf[2][2];
#pragma unroll
        for (int sp = 0; sp < 2; ++sp) { u32x4 a, b;
            a.x = cvt_pk_bf16(p0[8 * sp], p0[8 * sp + 1]); a.y = cvt_pk_bf16(p0[8 * sp + 2], p0[8 * sp + 3]); a.z = cvt_pk_bf16(p0[8 * sp + 4], p0[8 * sp + 5]); a.w = cvt_pk_bf16(p0[8 * sp + 6], p0[8 * sp + 7]);
            b.x = cvt_pk_bf16(p1[8 * sp], p1[8 * sp + 1]); b.y = cvt_pk_bf16(p1[8 * sp + 2], p1[8 * sp + 3]); b.z = cvt_pk_bf16(p1[8 * sp + 4], p1[8 * sp + 5]); b.w = cvt_pk_bf16(p1[8 * sp + 6], p1[8 * sp + 7]);
            pf[0][sp] = __builtin_bit_cast(bf16x8, a); pf[1][sp] = __builtin_bit_cast(bf16x8, b); }
#pragma unroll
        for (int kt = 0; kt < 2; ++kt)
#pragma unroll
            for (int sp = 0; sp < 2; ++sp) { const int kofs = (32 * kt + 16 * sp) * 128;
                { const s16x4 lo = lds_tr16(buf + va[0] + kofs), hi4 = lds_tr16(buf + va[0] + kofs + 8 * 128);
                  const bf16x8 vf = (bf16x8){lo[0], lo[1], lo[2], lo[3], hi4[0], hi4[1], hi4[2], hi4[3]}; o0 = mfma32(vf, pf[kt][sp], o0); }
                { const s16x4 lo = lds_tr16(buf + va[1] + kofs), hi4 = lds_tr16(buf + va[1] + kofs + 8 * 128);
                  const bf16x8 vf = (bf16x8){lo[0], lo[1], lo[2], lo[3], hi4[0], hi4[1], hi4[2], hi4[3]}; o1 = mfma32(vf, pf[kt][sp], o1); } }
        if (t + 1 < NT) { LAS unsigned char* nb = lds + ((t + 1) & 1) * ATT_BUF; *(LAS u32x4*)(nb + st_k1) = sk1; *(LAS u32x4*)(nb + st_v) = sv; if (DK == 96) { if (tid < 256) *(LAS u32x4*)(nb + st_k2) = sk2; } }
        __syncthreads();
    }
    { auto rr = __builtin_amdgcn_permlane32_swap(__float_as_uint(l), __float_as_uint(l), false, false); l = __uint_as_float(rr[0]) + __uint_as_float(rr[1]); }
    const float il = 1.f / l;
    bf16_t* op = out + (size_t)(wid * 32 + r32) * 1024 + 4 * hi;
#pragma unroll
    for (int g = 0; g < 4; ++g) { u32x2 a, b;
        a.x = cvt_pk_bf16(o0[4 * g] * il, o0[4 * g + 1] * il); a.y = cvt_pk_bf16(o0[4 * g + 2] * il, o0[4 * g + 3] * il);
        b.x = cvt_pk_bf16(o1[4 * g] * il, o1[4 * g + 1] * il); b.y = cvt_pk_bf16(o1[4 * g + 2] * il, o1[4 * g + 3] * il);
        *(u32x2*)(op + 8 * g) = a; *(u32x2*)(op + 32 + 8 * g) = b; }
}
__device__ __forceinline__ void phase_p3(LAS unsigned char* lds, const WS& w, int l, int vb, int nvb) {
    const float c2g = 0.125f * 1.4426950408889634f, c2m = 0.10206207261596577f * 1.4426950408889634f;
    bf16_t* MIX = w.H();
    const int nlat = NB * 12 * 8, nctx = (l == 0) ? NB * 12 : 0;
    for (int u = vb; u < nlat + nctx; u += nvb) {
        if (u < nlat) {
            const int qb = u & 7, slot = (u >> 3) % 12, b = u / 96;
            bf16_t* out = MIX + ((size_t)b * S + qb * 256) * 1024;
            if (slot < 6) attn_unit<64>(lds, w.Qg() + (((size_t)b * 6 + slot) * S + qb * 256) * 64, w.Kg() + ((size_t)b * 2 + slot / 3) * KEYS * 64, nullptr, w.Vg() + ((size_t)b * 2 + slot / 3) * KEYS * 64, KEYS, c2g, out + slot * 64);
            else { const int h = slot - 6; attn_unit<96>(lds, w.Qm() + (((size_t)b * 6 + h) * S + qb * 256) * 96, w.Kmn() + ((size_t)b * 6 + h) * KEYS * 64, w.KR() + (size_t)b * KEYS * 32, w.Vm() + ((size_t)b * 6 + h) * KEYS * 64, KEYS, c2m, out + 640 + h * 64); }
        } else {
            const int v = u - nlat, slot = v % 12, b = v / 12;
            bf16_t* out = MIX + ((size_t)NL + (size_t)b * CTX) * 1024;
            if (slot < 6) attn_unit<64>(lds, w.Qgc() + ((size_t)b * 6 + slot) * CTX * 64, w.Kg() + ((size_t)b * 2 + slot / 3) * KEYS * 64, nullptr, w.Vg() + ((size_t)b * 2 + slot / 3) * KEYS * 64, CTX, c2g, out + slot * 64);
            else { const int h = slot - 6; attn_unit<96>(lds, w.Qmc() + ((size_t)b * 6 + h) * CTX * 96, w.Kmn() + ((size_t)b * 6 + h) * KEYS * 64, w.KR() + (size_t)b * KEYS * 32, w.Vm() + ((size_t)b * 6 + h) * KEYS * 64, CTX, c2m, out + 640 + h * 64); }
        }
    }
}

__device__ __forceinline__ unsigned fkey(float f, unsigned tag, unsigned mask) { unsigned u = __float_as_uint(f); u = (u & 0x80000000u) ? ~u : (u | 0x80000000u); return (u & ~mask) | tag; }
__device__ __forceinline__ float keyf(unsigned k, unsigned mask) { k &= ~mask; const unsigned u = (k & 0x80000000u) ? (k & 0x7fffffffu) : ~k; return __uint_as_float(u); }
__device__ __forceinline__ void ce_desc(unsigned& a, unsigned& b) { const unsigned hi_ = a > b ? a : b, lo_ = a > b ? b : a; a = hi_; b = lo_; }
template <int J, int K> __device__ __forceinline__ void bstage16(unsigned* a) {
#pragma unroll
    for (int i = 0; i < 16; ++i) { const int l = i ^ J; if (l > i) { const unsigned x = a[i], y = a[l]; const unsigned mx = x > y ? x : y, mn = x > y ? y : x; const bool desc = ((i & K) == 0); a[i] = desc ? mx : mn; a[l] = desc ? mn : mx; } }
}
__device__ __forceinline__ void sort16_desc(unsigned* a) {
    bstage16<1, 2>(a); bstage16<2, 4>(a); bstage16<1, 4>(a); bstage16<4, 8>(a); bstage16<2, 8>(a); bstage16<1, 8>(a); bstage16<8, 16>(a); bstage16<4, 16>(a); bstage16<2, 16>(a); bstage16<1, 16>(a);
}
__device__ __forceinline__ void bmerge16_desc(unsigned* c) { bstage16<8, 16>(c); bstage16<4, 16>(c); bstage16<2, 16>(c); bstage16<1, 16>(c); }
__device__ __forceinline__ void merge_top16(unsigned* a, const unsigned* b) {
#pragma unroll
    for (int i = 0; i < 16; ++i) a[i] = a[i] > b[15 - i] ? a[i] : b[15 - i];
    bmerge16_desc(a);
}
__device__ __forceinline__ void xlane_top16(unsigned* t, int hi) {
    unsigned r[16]; const unsigned msk = 0u - (unsigned)hi;
#pragma unroll
    for (int i = 0; i < 16; ++i) r[i] = t[i] ^ ((t[i] ^ t[15 - i]) & msk);
#pragma unroll
    for (int i = 0; i < 16; ++i) { auto s = __builtin_amdgcn_permlane32_swap(r[i], r[i], false, false); t[i] = s[0] > s[1] ? s[0] : s[1]; }
    bmerge16_desc(t);
}
__device__ __forceinline__ constexpr int cand_a(int c) { return c < 16 ? 0 : c < 24 ? 1 : c < 29 ? 2 : c < 33 ? 3 : c < 36 ? 4 : c < 38 ? 5 : c < 40 ? 6 : c < 42 ? 7 : c < 50 ? c - 34 : 0; }
__device__ __forceinline__ constexpr int cand_b(int c) { return c < 16 ? c : c < 24 ? c - 16 : c < 29 ? c - 24 : c < 33 ? c - 29 : c < 36 ? c - 33 : c < 38 ? c - 36 : c < 40 ? c - 38 : c < 42 ? c - 40 : 0; }

__device__ __forceinline__ void phase_p6b(LAS unsigned char* lds, const bf16_t* __restrict__ PQ, const bf16_t* __restrict__ SubKl, unsigned* __restrict__ EG, int nrows, int vb, int nvb) {
    int tid_ = threadIdx.x; asm volatile("" : "+v"(tid_));
    const int tid = tid_, lane = tid & 63, wid = __builtin_amdgcn_readfirstlane(tid >> 6), r32 = lane & 31, hi = lane >> 5;
    const int h = vb & 7, wrank = (vb >> 3) * 8 + wid, nwr = (nvb >> 3) * 8;
    LAS unsigned short* tab = (LAS unsigned short*)(lds + 65536 + wid * 4096) + r32 * 64;
#pragma unroll
    for (int i = 0; i < 8; ++i) { const int idx = i * 512 + tid, p = idx >> 11, key = (idx >> 4) & 127, ch = idx & 15;
        *(LAS u32x4*)(lds + p * 32768 + key * 256 + ((ch ^ (key & 15)) << 4)) = *(const u32x4*)(SubKl + ((size_t)(h * 2 + p) * 128 + key) * 128 + ch * 8); }
    __syncthreads();
    const int ngroups = nrows >> 5;
    for (int tg = wrank; tg < ngroups; tg += nwr) {
        const int row0 = tg << 5;
        bf16x8 qf[2][8];
        { const bf16_t* qp = PQ + (size_t)(row0 + r32) * 2048 + h * 256 + 8 * hi; asm volatile("" : "+v"(qp));
#pragma unroll
          for (int p = 0; p < 2; ++p)
#pragma unroll
              for (int s = 0; s < 8; ++s) qf[p][s] = *(const bf16x8*)(qp + p * 128 + 16 * s); }
        unsigned top[2][16];
#pragma unroll
        for (int p = 0; p < 2; ++p) {
            f32x16 acc[4];
#pragma unroll
            for (int kt = 0; kt < 4; ++kt) { acc[kt] = f32x16{}; const int key = 32 * kt + r32;
#pragma unroll
                for (int s = 0; s < 8; ++s) acc[kt] = mfma32(*(const LAS bf16x8*)(lds + p * 32768 + key * 256 + (((2 * s + hi) ^ (key & 15)) << 4)), qf[p][s], acc[kt]); }
            unsigned key[64];
#pragma unroll
            for (int kt = 0; kt < 4; ++kt)
#pragma unroll
                for (int r = 0; r < 16; ++r) { const int n = 32 * kt + (r & 3) + 8 * (r >> 2) + 4 * hi; key[16 * kt + r] = fkey(acc[kt][r], 127u - (unsigned)n, 127u); }
            sort16_desc(key); sort16_desc(key + 16); sort16_desc(key + 32); sort16_desc(key + 48);
            merge_top16(key, key + 16); merge_top16(key + 32, key + 48); merge_top16(key, key + 32);
            xlane_top16(key, hi);
#pragma unroll
            for (int i = 0; i < 16; ++i) top[p][i] = key[i];
        }
        unsigned ck[64];
#pragma unroll
        for (int c = 0; c < 64; ++c) {
            if (c < 50) { const float sm = keyf(top[0][cand_a(c)], 127u) + keyf(top[1][cand_b(c)], 127u); ck[c] = fkey(sm, (unsigned)c, 63u); } else ck[c] = 0u;
        }
        if (hi == 0) {
#pragma unroll
            for (int c = 0; c < 50; c += 2) {
                const unsigned ea = (127u - (top[0][cand_a(c)] & 127u)) * 128u + (127u - (top[1][cand_b(c)] & 127u));
                const unsigned eb = (127u - (top[0][cand_a(c + 1)] & 127u)) * 128u + (127u - (top[1][cand_b(c + 1)] & 127u));
                *(LAS unsigned*)(tab + c) = ea | (eb << 16);
            }
        }
        sort16_desc(ck); sort16_desc(ck + 16); sort16_desc(ck + 32); sort16_desc(ck + 48);
        merge_top16(ck, ck + 16); merge_top16(ck + 32, ck + 48); merge_top16(ck, ck + 32);
        asm volatile("s_waitcnt lgkmcnt(0)" ::: "memory");
        const float mx = keyf(ck[0], 63u); float e[16], den = 0.f;
#pragma unroll
        for (int j = 0; j < 16; ++j) { e[j] = __builtin_amdgcn_exp2f((keyf(ck[j], 63u) - mx) * 1.4426950408889634f); den += e[j]; }
        const float iden = 1.f / den;
        if (hi == 0) {
            unsigned o[16];
#pragma unroll
            for (int j = 0; j < 16; ++j) { const unsigned eid = tab[ck[j] & 63u]; o[j] = (eid << 16) | (cvt_pk_bf16(e[j] * iden, 0.f) & 0xffffu); }
            unsigned* dst = EG + (size_t)(row0 + r32) * 128 + h * 16;
#pragma unroll
            for (int j = 0; j < 16; j += 4) *(u32x4*)(dst + j) = (u32x4){o[j], o[j + 1], o[j + 2], o[j + 3]};
        }
        asm volatile("s_waitcnt lgkmcnt(0)" ::: "memory");
    }
}


#define XB_TMO      128
#define XB_XCNT(j)  (256  + 64 * (j))
#define XB_XSUB(j)  (1280 + 64 * (j))
#define XB_XGEN(j)  (2304 + 64 * (j))
#define XB_TOP      3328
#define XB_TOPGEN   3392
#define XCD_BAR_WORDS 3456
#define XB_SPIN_CAP (1u << 18)

__device__ __forceinline__ unsigned xb_ld(unsigned* p)              { return __hip_atomic_load(p, __ATOMIC_RELAXED, __HIP_MEMORY_SCOPE_AGENT); }
__device__ __forceinline__ unsigned xb_add(unsigned* p, unsigned v) { return __hip_atomic_fetch_add(p, v, __ATOMIC_RELAXED, __HIP_MEMORY_SCOPE_AGENT); }
__device__ __forceinline__ unsigned xb_xcc_id() { return (unsigned)__builtin_amdgcn_s_getreg((3 << 11) | 20) & 0xFu; }
#define XB_SPIN(cond, bar) do { unsigned _sp = 0; while (cond) { __builtin_amdgcn_s_sleep(1); \
    if ((++_sp & 255u) == 0u) { if (xb_ld(&(bar)[XB_TMO])) break; if (_sp > XB_SPIN_CAP) { atomicAdd(&(bar)[XB_TMO], 1u); break; } } } } while (0)

struct XcdBarrier {
    unsigned* bar; unsigned x;
    volatile LAS unsigned* st;
};

__device__ __forceinline__ XcdBarrier xcd_barrier_post(unsigned* bar, volatile LAS unsigned* st) {
    XcdBarrier b; b.bar = bar; b.x = xb_xcc_id(); b.st = st;
    if (threadIdx.x == 0) (void)xb_add(&bar[XB_XCNT(b.x)], 1u);
    return b;
}
__device__ __forceinline__ void xcd_barrier_complete(unsigned* bar, unsigned x, unsigned& nloc, unsigned& nx) {
    const unsigned G = gridDim.x * gridDim.y * gridDim.z;
    unsigned sum, cnt, mine, sp = 0u;
    for (;;) {
        sum = 0u; cnt = 0u; mine = 0u;
#pragma unroll
        for (unsigned j = 0; j < 16; ++j) { const unsigned c = xb_ld(&bar[XB_XCNT(j)]); sum += c; cnt += (c > 0u) ? 1u : 0u; mine = (j == x) ? c : mine; }
        if (sum == G) break;
        __builtin_amdgcn_s_sleep(1);
        if ((++sp & 255u) == 0u) { if (xb_ld(&bar[XB_TMO])) break; if (sp > XB_SPIN_CAP) { atomicAdd(&bar[XB_TMO], 1u); break; } }
    }
    nloc = mine > 0u ? mine : 1u; nx = cnt > 0u ? cnt : 1u;
}

__device__ __forceinline__ void xcd_barrier(const XcdBarrier& b) {
    asm volatile("s_waitcnt vmcnt(0)" ::: "memory");
    __syncthreads();
    if (threadIdx.x == 0) {
        unsigned* bar = b.bar;
        __builtin_amdgcn_s_waitcnt(0);
        unsigned nloc = b.st[0], nx = b.st[1];
        if (nloc == 0u) { xcd_barrier_complete(bar, b.x, nloc, nx); b.st[0] = nloc; b.st[1] = nx; }
        const unsigned old = xb_add(&bar[XB_XSUB(b.x)], 1u);
        const unsigned gen = old / nloc;
        if (old + 1u == (gen + 1u) * nloc) {
            __builtin_amdgcn_fence(__ATOMIC_RELEASE, "agent");
            asm volatile("s_waitcnt vmcnt(0)" ::: "memory");
            const unsigned og = xb_add(&bar[XB_TOP], 1u);
            const unsigned tg = og / nx;
            if (og + 1u == (tg + 1u) * nx) xb_add(&bar[XB_TOPGEN], 1u);
            else XB_SPIN(xb_ld(&bar[XB_TOPGEN]) == tg, bar);
            __builtin_amdgcn_fence(__ATOMIC_ACQUIRE, "agent");
            xb_add(&bar[XB_XGEN(b.x)], 1u);
            asm volatile("s_waitcnt vmcnt(0)" ::: "memory");
        } else {
            XB_SPIN(xb_ld(&bar[XB_XGEN(b.x)]) == gen, bar);
            __builtin_amdgcn_fence(__ATOMIC_ACQUIRE, "agent");
            asm volatile("s_waitcnt vmcnt(0)" ::: "memory");
        }
    }
    __syncthreads();
}

__device__ __forceinline__ void phase_mod(LAS unsigned char* lds, const Inputs& in, const WS& w, int vb) {
    if (vb >= 72) return;
    LAS float* sc = (LAS float*)lds;
    int tid_ = threadIdx.x; asm volatile("" : "+v"(tid_));
    const int tid = tid_, idx = vb * 512 + tid, rg = idx / 12288, ln = idx % 12288, l = ln / 6144, n = ln % 6144;
    float acc[11];
#pragma unroll
    for (int i = 0; i < 11; ++i) acc[i] = 0.f;
    const float* wp = in.ada_w + (size_t)l * 1024 * 6144 + n;
    for (int kc = 0; kc < 4; ++kc) {
        for (int i = tid; i < 33 * 256; i += 512) { const int r = i >> 8, k = kc * 256 + (i & 255); const float v = r < 32 ? in.c[(size_t)r * 1024 + k] : in.c_ctx[k]; sc[i] = v / (1.f + __expf(-v)); }
        __syncthreads();
        for (int k = 0; k < 256; ++k) { const float wv = wp[(size_t)(kc * 256 + k) * 6144];
#pragma unroll
            for (int i = 0; i < 11; ++i) acc[i] += sc[(rg * 11 + i) * 256 + k] * wv; }
        __syncthreads();
    }
    const float bias = in.ada_b[(size_t)l * 6144 + n];
#pragma unroll
    for (int i = 0; i < 11; ++i) w.MOD()[((size_t)l * 33 + rg * 11 + i) * 6144 + n] = acc[i] + bias;
}
__device__ __forceinline__ void phase_rope(const WS& w, int vb, int nvb) {
    int tid_ = threadIdx.x; asm volatile("" : "+v"(tid_));
    for (int i = vb * 512 + tid_; i < 2048 * 32; i += nvb * 512) {
        { const int t = i / 32, j = i % 32; const double inv = pow(10000.0, -(double)(j % 16) / 16.0); const double a = (double)(j < 16 ? t / 64 : t % 64) * inv; w.ROPA()[i] = make_float2((float)cos(a), (float)sin(a)); }
        if (i < 2048 * 16) { const int t = i / 16, j = i % 16; const double inv = pow(10000.0, -(double)(j % 8) / 8.0); const double a = (double)(j < 8 ? t / 64 : t % 64) * inv; w.ROPC()[i] = make_float2((float)cos(a), (float)sin(a)); }
    }
}

#ifndef PROBE_MASK
#define PROBE_MASK 0
#endif
struct MegaArgs { Inputs in; WS w; float* XL; unsigned* bar; };
constexpr int MEGA_LDS = 131072 + 16;
__global__ void __launch_bounds__(512, 2) k_mega(MegaArgs A) {
    LAS unsigned char* lds = (LAS unsigned char*)dyn_lds;
    const int vb = blockIdx.x, nvb = gridDim.x;
    volatile LAS unsigned* xbw = (volatile LAS unsigned*)(lds + 131072);
    if (threadIdx.x == 0) { xbw[0] = 0u; xbw[1] = 0u; xbw[2] = 0u; xbw[3] = 0u; }
    __syncthreads();
    XcdBarrier bar = xcd_barrier_post(A.bar, xbw);
    if (threadIdx.x == 0) xbw[2] = xb_add(&A.bar[3584 + 64 * bar.x], 1u);
    __syncthreads();
    const int xticket = __builtin_amdgcn_readfirstlane((int)xbw[2]);
    const WS& w = A.w; const Inputs& in = A.in;
    phase_mod(lds, in, w, vb);
    phase_rope(w, vb, nvb);
    phase_cvt(lds, in, w, vb, nvb);
    xcd_barrier(bar);
    phase_modulate(in.x, in.ctx, w.H(), in.norm1_g, w.MOD(), 0, NR, vb, nvb);
    xcd_barrier(bar);
#if (PROBE_MASK >> 0) & 1
    phase_mod(lds, in, w, vb);
    phase_rope(w, vb, nvb);
    phase_cvt(lds, in, w, vb, nvb);
    xcd_barrier(bar);
    phase_modulate(in.x, in.ctx, w.H(), in.norm1_g, w.MOD(), 0, NR, vb, nvb);
    xcd_barrier(bar);
#endif
    int xpart = vb & 7, xrank = vb >> 3;
    { bool okx = (bar.x < 8u); for (unsigned j = 0; j < 8; ++j) okx = okx && (xb_ld(&A.bar[XB_XCNT(j)]) == (unsigned)(nvb >> 3));
      if (okx) { xpart = (int)bar.x; xrank = xticket; } }
    for (int l = 0; l < DEPTH; ++l) {
        const float* MODl = w.MOD() + (size_t)l * 33 * 6144;
        const bool last = (l == DEPTH - 1);
        const int MR = last ? NL : NR;
        phase_p1(lds, w, in, l, vb, nvb); xcd_barrier(bar);
#if (PROBE_MASK >> 1) & 1
        phase_p1(lds, w, in, l, vb, nvb); xcd_barrier(bar);
#endif
        phase_p2(lds, w, in, l, vb, nvb); xcd_barrier(bar);
#if (PROBE_MASK >> 12) & 7
        phase_p2(lds, w, in, l, vb, nvb, (PROBE_MASK >> 12) & 7); xcd_barrier(bar);
#endif
        phase_p3(lds, w, l, vb, nvb); xcd_barrier(bar);
#if (PROBE_MASK >> 3) & 1
        phase_p3(lds, w, l, vb, nvb); xcd_barrier(bar);
#endif
        phase_p4(lds, w, in, l, vb, nvb);
        xcd_barrier(bar);
#if (PROBE_MASK >> 4) & 1
        phase_p4(lds, w, in, l, vb, nvb);
        xcd_barrier(bar);
#endif
        phase_modulate(l == 0 ? in.x : A.XL, l == 0 ? in.ctx : w.XC(), w.H(), in.norm2_g + l * 1024, MODl, 3, MR, vb, nvb, w.H8(), w.HS(), w.PQ(), A.XL, w.XC()); xcd_barrier(bar);
#if (PROBE_MASK >> 5) & 1
        phase_modulate(A.XL, w.XC(), w.H(), in.norm2_g + l * 1024, MODl, 3, MR, vb, nvb, w.H8(), w.HS()); xcd_barrier(bar);
#endif
        phase_p6a(lds, w, l, vb, nvb); xcd_barrier(bar);
#if (PROBE_MASK >> 6) & 1
        phase_p6a(lds, w, l, vb, nvb); xcd_barrier(bar);
#endif
        phase_p6b(lds, w.PQ(), w.SubK() + (size_t)l * 16 * 128 * 128, w.EG(), MR, vb, nvb); xcd_barrier(bar);
#if (PROBE_MASK >> 7) & 1
        phase_p6b(lds, w.PQ(), w.SubK() + (size_t)l * 16 * 128 * 128, w.EG(), MR, vb, nvb); xcd_barrier(bar);
#endif
        { P7CArgs a{w.H8(), w.EG(), w.U8() + (size_t)l * NE * 1024, (int*)w.PQ(), MR}; phase_p7c(lds, a, xpart, xrank, nvb); }
        xcd_barrier(bar);
#if (PROBE_MASK >> 8) & 1
        { P7CArgs a{w.H8(), w.EG(), w.U8() + (size_t)l * NE * 1024, (int*)w.PQ(), MR}; phase_p7c(lds, a, xpart, xrank, nvb); }
        xcd_barrier(bar);
#endif
        phase_p7d((const int*)w.PQ(), w.EG(), w.US() + (size_t)l * NE, w.VS() + (size_t)l * NE, w.HS(), w.WE(), MR, vb, nvb);
        xcd_barrier(bar);
#if (PROBE_MASK >> 9) & 1
        phase_p7d((const int*)w.PQ(), w.EG(), w.US() + (size_t)l * NE, w.VS() + (size_t)l * NE, w.HS(), w.WE(), MR, vb, nvb);
        xcd_barrier(bar);
#endif
        { P7BArgs a{w.WE(), w.V8() + (size_t)l * NE * 1024, A.XL, w.XC(), MODl + 5 * 1024, MR}; phase_p7b<0>(lds, a, xpart, xrank, nvb); }
        xcd_barrier(bar);
#if (PROBE_MASK >> 10) & 3
        { P7BArgs a{w.WE(), w.V8() + (size_t)l * NE * 1024, A.XL, w.XC(), MODl + 5 * 1024, MR}; phase_p7b<((PROBE_MASK >> 10) & 3)>(lds, a, xpart, xrank, nvb); }
        xcd_barrier(bar);
#endif
        if (last) phase_final_norm(A.XL, in.final_g, vb, nvb);
        else phase_modulate(A.XL, w.XC(), w.H(), in.norm1_g + (l + 1) * 1024, w.MOD() + (size_t)(l + 1) * 33 * 6144, 0, NR, vb, nvb);
        if (!last) xcd_barrier(bar);
    }
}

extern "C" void kernel_launch(void* const* d_in, const int* in_sizes, int n_in, void* d_out, int out_size, void* d_ws, size_t ws_size, hipStream_t stream) {
    const float* const* fin = (const float* const*)d_in;
    Inputs in{fin[0], fin[1], fin[2], fin[3], fin[4], fin[5], fin[6], fin[7], fin[8], fin[9], fin[10], fin[11], fin[12], fin[13], fin[14], fin[15], fin[16], fin[17], fin[18], fin[19], fin[20], fin[21], fin[22]};
    WS w = make_ws(d_ws);
    static int ok = 0;
    if (!ok) {
        if (hipFuncSetAttribute((const void*)k_mega, hipFuncAttributeMaxDynamicSharedMemorySize, MEGA_LDS) != hipSuccess) { ok = -1; }
        int per_cu = 0, cus = 0, dev = 0; (void)hipGetDevice(&dev); (void)hipDeviceGetAttribute(&cus, hipDeviceAttributeMultiprocessorCount, dev);
        if (hipOccupancyMaxActiveBlocksPerMultiprocessor(&per_cu, (const void*)k_mega, 512, MEGA_LDS) != hipSuccess || per_cu < 1 || cus < 256) ok = -1;
        if (ok == 0) ok = 1;
    }
    if (ok < 0) return;
    (void)hipMemsetAsync(d_ws, 0, 16384, stream);
    MegaArgs A{in, w, (float*)d_out, (unsigned*)d_ws};
    k_mega<<<256, 512, MEGA_LDS, stream>>>(A);
}
```

```cpp
#include <hip/hip_runtime.h>
#include <stdint.h>

typedef unsigned short bf16_t;

constexpr int D = 1024, NB = 32, S = 2048, CTX = 256, DEPTH = 2;
constexpr int NL = NB * S, NC = NB * CTX, NR = NL + NC;
constexpr int KEYS = CTX + S;
constexpr int INC = 1568;
constexpr int NE = 16384;
constexpr float EPS = 1e-6f;

__device__ __forceinline__ float bf2f(bf16_t v) { return __uint_as_float(((unsigned)v) << 16); }
__device__ __forceinline__ bf16_t f2bf(float f) { unsigned u = __float_as_uint(f); u += 0x7FFFu + ((u >> 16) & 1u); return (bf16_t)(u >> 16); }

__device__ __forceinline__ float wave_sum(float v) {
#pragma unroll
    for (int o = 32; o > 0; o >>= 1) v += __shfl_xor(v, o);
    return v;
}
__device__ __forceinline__ float gelu_tanh(float x) {
    const float u = 0.7978845608028654f * (x + 0.044715f * x * x * x);
    return 0.5f * x * (1.f + tanhf(u));
}

struct WS {
    char* base;
    __host__ __device__ __forceinline__ bf16_t* H() const { return (bf16_t*)(base + 65536ull); }
    __host__ __device__ __forceinline__ bf16_t* Qg() const { return (bf16_t*)(base + 151060480ull); }
    __host__ __device__ __forceinline__ bf16_t* Qgc() const { return (bf16_t*)(base + 201392128ull); }
    __host__ __device__ __forceinline__ bf16_t* Kg() const { return (bf16_t*)(base + 207683584ull); }
    __host__ __device__ __forceinline__ bf16_t* Vg() const { return (bf16_t*)(base + 226557952ull); }
    __host__ __device__ __forceinline__ bf16_t* CQ() const { return (bf16_t*)(base + 245432320ull); }
    __host__ __device__ __forceinline__ bf16_t* CKV() const { return (bf16_t*)(base + 302055424ull); }
    __host__ __device__ __forceinline__ bf16_t* Bp() const { return (bf16_t*)(base + 339804160ull); }
    __host__ __device__ __forceinline__ bf16_t* KR() const { return (bf16_t*)(base + 377552896ull); }
    __host__ __device__ __forceinline__ bf16_t* Qm() const { return (bf16_t*)(base + 382271488ull); }
    __host__ __device__ __forceinline__ bf16_t* Qmc() const { return (bf16_t*)(base + 457768960ull); }
    __host__ __device__ __forceinline__ bf16_t* Kmn() const { return (bf16_t*)(base + 467206144ull); }
    __host__ __device__ __forceinline__ bf16_t* Vm() const { return (bf16_t*)(base + 523829248ull); }
    __host__ __device__ __forceinline__ unsigned* EG() const { return (unsigned*)(base + 580452352ull); }
    __host__ __device__ __forceinline__ bf16_t* P() const { return (bf16_t*)(base + 382271488ull); }
    __host__ __device__ __forceinline__ bf16_t* PQ() const { return (bf16_t*)(base + 151060480ull); }
    __host__ __device__ __forceinline__ bf16_t* TMP() const { return (bf16_t*)(base + 65536ull); }
    __host__ __device__ __forceinline__ float* XC() const { return (float*)(base + 618201088ull); }
    __host__ __device__ __forceinline__ float* MOD() const { return (float*)(base + 651755520ull); }
    __host__ __device__ __forceinline__ float2* ROPA() const { return (float2*)(base + 653377536ull); }
    __host__ __device__ __forceinline__ float2* ROPC() const { return (float2*)(base + 653901824ull); }
    __host__ __device__ __forceinline__ float* RSQ() const { return (float*)(base + 654163968ull); }
    __host__ __device__ __forceinline__ float* RSKV() const { return (float*)(base + 654458880ull); }
    __host__ __device__ __forceinline__ bf16_t* WinT() const { return (bf16_t*)(base + 654753792ull); }
    __host__ __device__ __forceinline__ bf16_t* WuqT() const { return (bf16_t*)(base + 662093824ull); }
    __host__ __device__ __forceinline__ bf16_t* WukvT() const { return (bf16_t*)(base + 663273472ull); }
    __host__ __device__ __forceinline__ bf16_t* WoutT() const { return (bf16_t*)(base + 664059904ull); }
    __host__ __device__ __forceinline__ bf16_t* WqT() const { return (bf16_t*)(base + 668254208ull); }
    __host__ __device__ __forceinline__ bf16_t* SubK() const { return (bf16_t*)(base + 676642816ull); }
    __host__ __device__ __forceinline__ unsigned char* U8() const { return (unsigned char*)(base + 677691392ull); }
    __host__ __device__ __forceinline__ unsigned char* V8() const { return (unsigned char*)(base + 711245824ull); }
    __host__ __device__ __forceinline__ float* US() const { return (float*)(base + 744800256ull); }
    __host__ __device__ __forceinline__ float* VS() const { return (float*)(base + 744931328ull); }
    __host__ __device__ __forceinline__ float* SSQ() const { return (float*)(base + 745062400ull); }
    __host__ __device__ __forceinline__ float* SSKV() const { return (float*)(base + 747421696ull); }
    __host__ __device__ __forceinline__ unsigned* WE() const { return (unsigned*)(base + 748601344ull); }
    __host__ __device__ __forceinline__ signed char* H8() const { return (signed char*)(base + 786350080ull); }
    __host__ __device__ __forceinline__ float* HS() const { return (float*)(base + 861847552ull); }
    __host__ __device__ __forceinline__ bf16_t* PoolWT() const { return (bf16_t*)(base + 862142464ull); }
};
constexpr size_t WS_BYTES = 862208000ull;
static WS make_ws(void* d_ws) { WS w; w.base = (char*)d_ws; return w; }


#define LAS __attribute__((address_space(3)))
typedef short bf16x8 __attribute__((ext_vector_type(8)));
typedef float f32x4 __attribute__((ext_vector_type(4)));
typedef float f32x16 __attribute__((ext_vector_type(16)));
typedef unsigned u32x4 __attribute__((ext_vector_type(4)));
typedef unsigned u32x2 __attribute__((ext_vector_type(2)));

__device__ __forceinline__ f32x16 mfma32(bf16x8 a, bf16x8 b, f32x16 c) { return __builtin_amdgcn_mfma_f32_32x32x16_bf16(a, b, c, 0, 0, 0); }
__device__ __forceinline__ unsigned cvt_pk_bf16(float lo, float hi) { unsigned r; asm volatile("v_cvt_pk_bf16_f32 %0, %1, %2" : "=v"(r) : "v"(lo), "v"(hi)); return r; }

namespace pg8 {
constexpr int BM = 256, BK = 64, HALF = 128, HTB = HALF * BK * 2, STAGE_BYTES = 8 * HTB, NXCD = 8, WGM = 8;
__host__ __device__ __forceinline__ int lds_byte(int r, int c) { const int st = (r >> 4) * 2 + (c >> 5), rr = r & 15, cc = c & 31, ob = rr * 64 + cc * 2; return st * 1024 + (ob ^ (((ob >> 9) & 1) << 5)); }
__host__ __device__ __forceinline__ void stage_rc(int b, int& R, int& C) { const int st = b / 1024, sb = b % 1024, swz = sb ^ (((sb >> 9) & 1) << 5); R = (st >> 1) * 16 + swz / 64; C = (st & 1) * 32 + (swz % 64) / 2; }
__host__ __device__ __forceinline__ int perm32(int rho) { const int n = rho >> 4, i = rho & 15; return 8 * (i >> 2) + 4 * n + (i & 3); }
struct Unit { int pm, pn; };
struct Gemm { const bf16_t* A; const bf16_t* Bt; int M, N, K; };
struct StaticOrder {
    int nM, nN, nwg, G, c;
    __host__ __device__ void init(int M, int N, int G_, int c_) { nM = M / BM; nN = N / BM; nwg = nM * nN; G = G_; c = c_; }
    __host__ __device__ bool next(int i, Unit& u) const {
        const long L = (long)i * G + c; if (L >= nwg) return false;
        int wgid = (int)L; { const int q = nwg / NXCD, r = nwg % NXCD, xcd = wgid % NXCD, off = wgid / NXCD; wgid = (xcd < r ? xcd * (q + 1) : r * (q + 1) + (xcd - r) * q) + off; }
        const int nig = WGM * nN, gid = wgid / nig, fm = gid * WGM, gsz = (nM - fm) < WGM ? (nM - fm) : WGM;
        u.pm = fm + ((wgid % nig) % gsz); u.pn = (wgid % nig) / gsz; return true;
    }
};
template <class Epi, class Sched>
__device__ __forceinline__ void gemm_phase(LAS unsigned char* lds, const Gemm g, const Sched& S, const Epi& E) {
    int tid_ = threadIdx.x; asm volatile("" : "+v"(tid_));
    const int tid = tid_, wid = __builtin_amdgcn_readfirstlane(tid >> 6), lane = tid & 63, wr = wid >> 2, wc = wid & 3, fr = lane & 15, fq = lane >> 4;
    const int K = g.K, nt = K / BK;
    unsigned voffA[2], voffB[2];
#pragma unroll
    for (int i = 0; i < 2; ++i) { int R, C; stage_rc(tid * 16 + i * 8192, R, C); const int Rb = Epi::PERM ? ((R & ~31) + perm32(R & 31)) : R;
        voffA[i] = (unsigned)(R * K + C) * 2u; voffB[i] = (unsigned)(Rb * K + C) * 2u; }
    const size_t kstep = (size_t)(BK * 2);
    const size_t hstep = (size_t)HALF * K * 2;
    const size_t tstep = 2 * hstep;
    const unsigned ldsw = (unsigned)wid * 1024u;
    const int aoff = lds_byte(wr * 64 + fr, fq * 8), boff = lds_byte(wc * 32 + fr, fq * 8);
#define PG8_SA(b, h) (((b) * 2 + (h)) * HTB)
#define PG8_SB(b, h) ((4 + (b) * 2 + (h)) * HTB)
#define PG8_STAGE(bufoff, gbase, voff) do { _Pragma("unroll") for (int _i = 0; _i < 2; ++_i) \
        __builtin_amdgcn_global_load_lds((const unsigned*)((const char*)(gbase) + (voff)[_i]), (LAS unsigned*)(lds + (bufoff) + ldsw + _i * 8192), 16, 0, 0); } while (0)
#define PG8_LDA(dst, b, h) do { _Pragma("unroll") for (int m = 0; m < 4; ++m) _Pragma("unroll") for (int k = 0; k < 2; ++k) dst[m][k] = *(const LAS bf16x8*)(lds + PG8_SA(b, h) + aoff + m * 2048 + k * 1024); } while (0)
#define PG8_LDB(dst, b, h) do { _Pragma("unroll") for (int n = 0; n < 2; ++n) _Pragma("unroll") for (int k = 0; k < 2; ++k) dst[n][k] = *(const LAS bf16x8*)(lds + PG8_SB(b, h) + boff + n * 2048 + k * 1024); } while (0)
#define PG8_MMA(ai, bj, At, Bt) do { __builtin_amdgcn_s_setprio(1); _Pragma("unroll") for (int m = 0; m < 4; ++m) _Pragma("unroll") for (int n = 0; n < 2; ++n) _Pragma("unroll") for (int k = 0; k < 2; ++k) \
        acc[ai][bj][m][n] = __builtin_amdgcn_mfma_f32_16x16x32_bf16(Bt[n][k], At[m][k], acc[ai][bj][m][n], 0, 0, 0); __builtin_amdgcn_s_setprio(0); } while (0)
#define PG8_WAIT_V(n) asm volatile("s_waitcnt vmcnt(" #n ")" ::: "memory")
#define PG8_WAIT_L(n) asm volatile("s_waitcnt lgkmcnt(" #n ")" ::: "memory")
#define PG8_BAR __builtin_amdgcn_s_barrier()
#define PG8_SCHED __builtin_amdgcn_sched_barrier(0)
    Unit cur, nxt; int ui = 0;
    if (!S.next(0, cur)) return;
    f32x4 acc[2][2][4][2];
#pragma unroll
    for (int a = 0; a < 2; ++a)
#pragma unroll
        for (int b = 0; b < 2; ++b)
#pragma unroll
            for (int m = 0; m < 4; ++m)
#pragma unroll
                for (int n = 0; n < 2; ++n) acc[a][b][m][n] = (f32x4){0.f, 0.f, 0.f, 0.f};
    bf16x8 At[4][2], B0[2][2], B1[2][2];
    const char* cA = (const char*)g.A + (size_t)cur.pm * tstep; const char* cB = (const char*)g.Bt + (size_t)cur.pn * tstep;
    PG8_STAGE(PG8_SB(0, 0), cB, voffB); PG8_STAGE(PG8_SA(0, 0), cA, voffA); PG8_STAGE(PG8_SB(0, 1), cB + hstep, voffB); PG8_STAGE(PG8_SA(0, 1), cA + hstep, voffA);
    if (wr == 1) PG8_BAR;
    PG8_WAIT_V(4); PG8_BAR;
    PG8_STAGE(PG8_SB(1, 0), cB + kstep, voffB); PG8_STAGE(PG8_SA(1, 0), cA + kstep, voffA); PG8_STAGE(PG8_SB(1, 1), cB + hstep + kstep, voffB);
    PG8_WAIT_V(6); PG8_BAR;
    for (;;) {
        const bool has_next = S.next(ui + 1, nxt);
        const char* nA = has_next ? (const char*)g.A + (size_t)nxt.pm * tstep : cA; const char* nB = has_next ? (const char*)g.Bt + (size_t)nxt.pn * tstep : cB;
#pragma nounroll
        for (int t = 0; t < nt; t += 2) {
            const bool last = (t == nt - 2);
            const char* a1 = cA + (size_t)(t + 1) * kstep;
            const char* a2 = last ? nA : cA + (size_t)(t + 2) * kstep; const char* b2 = last ? nB : cB + (size_t)(t + 2) * kstep;
            const char* a3 = a2 + kstep; const char* b3 = b2 + kstep;
            PG8_LDB(B0, 0, 0); PG8_SCHED; PG8_LDA(At, 0, 0); PG8_STAGE(PG8_SA(1, 1), a1 + hstep, voffA);
            PG8_WAIT_L(8); PG8_BAR; PG8_WAIT_L(0); PG8_MMA(0, 0, At, B0); PG8_BAR; PG8_SCHED;
            PG8_LDB(B1, 0, 1); PG8_STAGE(PG8_SB(0, 0), b2, voffB);
            PG8_BAR; PG8_WAIT_L(0); PG8_MMA(0, 1, At, B1); PG8_BAR;
            PG8_LDA(At, 0, 1); PG8_STAGE(PG8_SA(0, 0), a2, voffA);
            PG8_BAR; PG8_WAIT_L(0); PG8_MMA(1, 0, At, B0); PG8_BAR; PG8_SCHED;
            PG8_STAGE(PG8_SB(0, 1), b2 + hstep, voffB);
            PG8_WAIT_V(6); PG8_BAR; PG8_MMA(1, 1, At, B1); PG8_BAR;
            PG8_LDB(B0, 1, 0); PG8_SCHED; PG8_LDA(At, 1, 0); PG8_STAGE(PG8_SA(0, 1), a2 + hstep, voffA);
            PG8_WAIT_L(8); PG8_BAR; PG8_WAIT_L(0); PG8_MMA(0, 0, At, B0); PG8_BAR; PG8_SCHED;
            PG8_LDB(B1, 1, 1); PG8_STAGE(PG8_SB(1, 0), b3, voffB);
            PG8_BAR; PG8_WAIT_L(0); PG8_MMA(0, 1, At, B1); PG8_BAR;
            PG8_LDA(At, 1, 1); PG8_STAGE(PG8_SA(1, 0), a3, voffA);
            PG8_BAR; PG8_WAIT_L(0); PG8_MMA(1, 0, At, B0); PG8_BAR; PG8_SCHED;
            PG8_STAGE(PG8_SB(1, 1), b3 + hstep, voffB);
            PG8_WAIT_V(6); PG8_BAR; PG8_MMA(1, 1, At, B1); PG8_BAR;
        }
        E(acc, cur, wr, wc, fr, fq);
        if (!has_next) break;
#pragma unroll
        for (int a = 0; a < 2; ++a)
#pragma unroll
            for (int b = 0; b < 2; ++b)
#pragma unroll
                for (int m = 0; m < 4; ++m)
#pragma unroll
                    for (int n = 0; n < 2; ++n) acc[a][b][m][n] = (f32x4){0.f, 0.f, 0.f, 0.f};
        cur = nxt; cA = nA; cB = nB; ++ui;
    }
    PG8_WAIT_V(0);
    if (wr == 0) PG8_BAR;
    PG8_BAR;
#undef PG8_SA
#undef PG8_SB
#undef PG8_STAGE
#undef PG8_LDA
#undef PG8_LDB
#undef PG8_MMA
#undef PG8_WAIT_V
#undef PG8_WAIT_L
#undef PG8_BAR
#undef PG8_SCHED
}
}

enum { GT_AQ = 0, GT_AK = 1, GT_AV = 2, GT_B = 3, GT_CQ = 4, GT_CKV = 5, GT_KR = 6, GT_PAD = 7 };
__host__ __device__ __forceinline__ void in_group(int g, int& type, int& sub) {
    if (g < 2) { type = GT_AK; sub = g; } else if (g < 4) { type = GT_AV; sub = g - 2; } else if (g < 8) { type = GT_CKV; sub = g - 4; }
    else if (g == 8) { type = GT_KR; sub = 0; } else if (g < 12) { type = GT_PAD; sub = 0; } else if (g < 18) { type = GT_AQ; sub = g - 12; }
    else if (g < 24) { type = GT_CQ; sub = g - 18; } else { type = GT_B; sub = g - 24; }
}
__device__ __forceinline__ int colmap(int mode, int r) {
    const int pn = r >> 8, ct = r & 255, bj = ct >> 7, wc = (ct >> 5) & 3, j = ct & 31, g = 4 * pn + wc, e = 32 * bj + j;
    if (mode == 0) {
        int type, sub; in_group(g, type, sub);
        switch (type) { case GT_AQ: return 64 * sub + e; case GT_AK: return 384 + 64 * sub + e; case GT_AV: return 512 + 64 * sub + e; case GT_B: return 640 + 64 * sub + e;
            case GT_CQ: return 896 + 64 * sub + e; case GT_CKV: return 1280 + 64 * sub + e; case GT_KR: return (j < 16) ? 1536 + 16 * bj + j : -1; default: return -1; }
    } else if (mode == 1) {
        if (g < 6) return 96 * g + e; if (g < 9) { const int head = 2 * (g - 6) + (j >> 4); return 96 * head + 64 + 16 * bj + (j & 15); } return -1;
    } else if (mode == 2) {
        return 64 * g + e;
    }
    return r;
}
__device__ __forceinline__ void cvt_weights_unit(LAS float* tile  , const float* __restrict__ W, int K, int N, bf16_t* __restrict__ dst, int mode, const float* __restrict__ kgain, int r0, int k0) {
    int tid_ = threadIdx.x; asm volatile("" : "+v"(tid_));
    const int tid = tid_;
    const int jj = tid & 63; const int sc = colmap(mode, r0 + jj);
#pragma unroll
    for (int i = 0; i < 8; ++i) { const int kk = (tid >> 6) + 8 * i; float v = 0.f; if (sc >= 0) v = W[(size_t)(k0 + kk) * N + sc]; if (kgain) v *= kgain[k0 + kk]; tile[kk * 65 + jj] = v; }
    __syncthreads();
#pragma unroll
    for (int i = 0; i < 8; ++i) { const int rr = (tid >> 6) + 8 * i, kk = tid & 63; dst[(size_t)(r0 + rr) * K + k0 + kk] = f2bf(tile[kk * 65 + rr]); }
    __syncthreads();
}
struct CvtJob { const float* W; bf16_t* dst; const float* kgain; int K, N, Npad, mode; };
__device__ __forceinline__ void cvt_job(LAS float* tile, const CvtJob j, int vb, int nvb) {
    const int nk = j.K / 64, nr = j.Npad / 64;
    for (int u = vb; u < nk * nr; u += nvb) cvt_weights_unit(tile, j.W, j.K, j.N, j.dst, j.mode, j.kgain, (u / nk) * 64, (u % nk) * 64);
}
__device__ __forceinline__ void cvt_flat(const float* __restrict__ src, bf16_t* __restrict__ dst, size_t n, int vb, int nvb) {
    int tid_ = threadIdx.x; asm volatile("" : "+v"(tid_));
    for (size_t i = ((size_t)vb * 512 + tid_) * 8; i < n; i += (size_t)nvb * 512 * 8) {
        const float4 a = *(const float4*)(src + i), b = *(const float4*)(src + i + 4);
        u32x4 o; o.x = cvt_pk_bf16(a.x, a.y); o.y = cvt_pk_bf16(a.z, a.w); o.z = cvt_pk_bf16(b.x, b.y); o.w = cvt_pk_bf16(b.z, b.w);
        *(u32x4*)(dst + i) = o;
    }
}
template <bool FP8>
__device__ __forceinline__ void cvt_q8_rows(const float* __restrict__ src, unsigned char* __restrict__ dst, float* __restrict__ scales, int nrows, int vb, int nvb) {
    int tid_ = threadIdx.x; asm volatile("" : "+v"(tid_));
    const int lane = tid_ & 63, wid = tid_ >> 6;
    const int stride = nvb * 8;
    for (int row0 = vb * 8 + wid; row0 < nrows; row0 += 4 * stride) {
        f32x4 v[4][4];
#pragma unroll
        for (int q = 0; q < 4; ++q) { const int row = row0 + q * stride < nrows ? row0 + q * stride : row0; const float* sp = src + (size_t)row * 1024 + 16 * lane;
#pragma unroll
            for (int k = 0; k < 4; ++k) v[q][k] = *(const f32x4*)(sp + 4 * k); }
#pragma unroll
        for (int q = 0; q < 4; ++q) { const int row = row0 + q * stride; if (row < nrows) {
            float am = 0.f;
#pragma unroll
            for (int k = 0; k < 4; ++k) am = fmaxf(am, fmaxf(fmaxf(fabsf(v[q][k][0]), fabsf(v[q][k][1])), fmaxf(fabsf(v[q][k][2]), fabsf(v[q][k][3]))));
#pragma unroll
            for (int o = 32; o > 0; o >>= 1) am = fmaxf(am, __shfl_xor(am, o));
            const float qmax = FP8 ? 416.f : 127.f;
            const float sc = am > 0.f ? am / qmax : 1.f, inv = am > 0.f ? qmax / am : 0.f;
            u32x4 o4;
#pragma unroll
            for (int k = 0; k < 4; ++k) {
                if (FP8) { int p = __builtin_amdgcn_cvt_pk_fp8_f32(v[q][k][0] * inv, v[q][k][1] * inv, 0, false); p = __builtin_amdgcn_cvt_pk_fp8_f32(v[q][k][2] * inv, v[q][k][3] * inv, p, true); o4[k] = (unsigned)p; }
                else { const int q0 = (int)rintf(v[q][k][0] * inv), q1 = (int)rintf(v[q][k][1] * inv), q2 = (int)rintf(v[q][k][2] * inv), q3 = (int)rintf(v[q][k][3] * inv);
                    o4[k] = (unsigned)(q0 & 0xff) | ((unsigned)(q1 & 0xff) << 8) | ((unsigned)(q2 & 0xff) << 16) | ((unsigned)(q3 & 0xff) << 24); } }
            *(u32x4*)(dst + (size_t)row * 1024 + 16 * lane) = o4;
            if (lane == 0) scales[row] = sc; } }
    }
}
struct Inputs {
    const float *x, *c, *ctx, *c_ctx, *ada_w, *ada_b, *norm1_g, *norm2_g, *w_in, *gqa_qn_g, *gqa_kn_g, *pool_w, *pool_scale, *mla_qn_g, *mla_kvn_g, *mla_w_uq, *mla_w_ukv, *w_out, *peer_wq, *peer_subkeys, *peer_u, *peer_v, *final_g;
};
__device__ __forceinline__ void phase_cvt(LAS unsigned char* lds, const Inputs& in, const WS& w, int vb, int nvb) {
    LAS float* tile = (LAS float*)lds;
    for (int l = 0; l < 2; ++l) {
        cvt_job(tile, CvtJob{in.w_in + (size_t)l * 1024 * INC, w.WinT() + (size_t)l * 1792 * 1024, nullptr, 1024, INC, 1792, 0}, vb, nvb);
        cvt_job(tile, CvtJob{in.mla_w_uq + (size_t)l * 384 * 576, w.WuqT() + (size_t)l * 768 * 384, in.mla_qn_g + l * 384, 384, 576, 768, 1}, vb, nvb);
        cvt_job(tile, CvtJob{in.mla_w_ukv + (size_t)l * 256 * 768, w.WukvT() + (size_t)l * 768 * 256, in.mla_kvn_g + l * 256, 256, 768, 768, 2}, vb, nvb);
        cvt_job(tile, CvtJob{in.w_out + (size_t)l * 1024 * 1024, w.WoutT() + (size_t)l * 1024 * 1024, nullptr, 1024, 1024, 1024, 3}, vb, nvb);
        cvt_job(tile, CvtJob{in.peer_wq + (size_t)l * 1024 * 2048, w.WqT() + (size_t)l * 2048 * 1024, nullptr, 1024, 2048, 2048, 3}, vb, nvb);
    }
    cvt_flat(in.peer_subkeys, w.SubK(), (size_t)2 * 16 * 128 * 128, vb, nvb);
    { int tp_ = threadIdx.x; asm volatile("" : "+v"(tp_));
      for (int i = vb * 512 + tp_; i < 2 * 4 * 64 * 64; i += nvb * 512) { const int c = i & 63, d = (i >> 6) & 63, lg = i >> 12; w.PoolWT()[i] = f2bf(in.pool_w[(size_t)lg * 4096 + c * 64 + d]); } }
    if (nvb > 144) { if (vb >= 72) { cvt_q8_rows<false>(in.peer_u, w.U8(), w.US(), 2 * NE, vb - 72, nvb - 72); cvt_q8_rows<true>(in.peer_v, w.V8(), w.VS(), 2 * NE, vb - 72, nvb - 72); } }
    else { cvt_q8_rows<false>(in.peer_u, w.U8(), w.US(), 2 * NE, vb, nvb); cvt_q8_rows<true>(in.peer_v, w.V8(), w.VS(), 2 * NE, vb, nvb); }
}

struct EpiIn {
    static constexpr bool PERM = true;
    WS w; const float* qn_g; const float* kn_g; int pm_base;
    __device__ __forceinline__ void operator()(const f32x4 (&acc)[2][2][4][2], const pg8::Unit& u, int wr, int wc, int fr, int fq) const {
        int type, sub; in_group(4 * u.pn + wc, type, sub);
        if (type == GT_PAD) return;
        const int pm = u.pm + pm_base; const bool isctx = pm >= 256; const int b = isctx ? pm - 256 : pm >> 3; const int t0 = isctx ? 0 : (pm & 7) * 256;
        const size_t rowbase = isctx ? (size_t)NL + (size_t)b * CTX : (size_t)b * S;
        const int keyoff = isctx ? 0 : CTX;
        float gain[2][8];
        if (type == GT_AQ) {
#pragma unroll
            for (int bj = 0; bj < 2; ++bj)
#pragma unroll
                for (int q = 0; q < 8; ++q) gain[bj][q] = qn_g[32 * bj + 8 * fq + q];
        } else if (type == GT_AK) {
#pragma unroll
            for (int bj = 0; bj < 2; ++bj)
#pragma unroll
                for (int q = 0; q < 8; ++q) gain[bj][q] = kn_g[32 * bj + 8 * fq + q];
        }
#pragma unroll
        for (int ai = 0; ai < 2; ++ai)
#pragma unroll
            for (int m = 0; m < 4; ++m) {
                const int t = t0 + 128 * ai + 64 * wr + 16 * m + fr; const size_t row = rowbase + t;
                float v[2][8];
#pragma unroll
                for (int bj = 0; bj < 2; ++bj)
#pragma unroll
                    for (int n = 0; n < 2; ++n)
#pragma unroll
                        for (int i = 0; i < 4; ++i) v[bj][4 * n + i] = acc[ai][bj][m][n][i];
                bf16_t* dst = nullptr;
                if (type == GT_AQ || type == GT_AK) {
                    float ss = 0.f;
#pragma unroll
                    for (int bj = 0; bj < 2; ++bj)
#pragma unroll
                        for (int q = 0; q < 8; ++q) ss += v[bj][q] * v[bj][q];
                    ss += __shfl_xor(ss, 16); ss += __shfl_xor(ss, 32);
                    const float rstd = rsqrtf(ss * (1.f / 64.f) + EPS);
#pragma unroll
                    for (int q = 0; q < 8; ++q) { float x1 = v[0][q] * rstd * gain[0][q], x2 = v[1][q] * rstd * gain[1][q];
                        if (!isctx) { const float2 cs = w.ROPA()[t * 32 + 8 * fq + q]; const float y1 = x1 * cs.x - x2 * cs.y, y2 = x1 * cs.y + x2 * cs.x; x1 = y1; x2 = y2; }
                        v[0][q] = x1; v[1][q] = x2; }
                    if (type == GT_AQ) dst = isctx ? w.Qgc() + (((size_t)b * 6 + sub) * CTX + t) * 64 : w.Qg() + (((size_t)b * 6 + sub) * S + t) * 64;
                    else dst = w.Kg() + (((size_t)b * 2 + sub) * KEYS + keyoff + t) * 64;
                } else if (type == GT_AV) { dst = w.Vg() + (((size_t)b * 2 + sub) * KEYS + keyoff + t) * 64;
                } else if (type == GT_B) { dst = w.Bp() + row * 256 + 64 * sub;
                } else if (type == GT_CQ || type == GT_CKV) {
                    float ss = 0.f;
#pragma unroll
                    for (int bj = 0; bj < 2; ++bj)
#pragma unroll
                        for (int q = 0; q < 8; ++q) ss += v[bj][q] * v[bj][q];
                    ss += __shfl_xor(ss, 16); ss += __shfl_xor(ss, 32);
                    if (type == GT_CQ) { if (fq == 0) w.SSQ()[row * 8 + sub] = ss; dst = w.CQ() + row * 384 + 64 * sub; }
                    else { if (fq == 0) w.SSKV()[row * 4 + sub] = ss; dst = w.CKV() + row * 256 + 64 * sub; }
                } else {
                    if (!isctx) {
#pragma unroll
                        for (int q = 0; q < 8; ++q) { const float2 cs = w.ROPC()[t * 16 + ((8 * fq + q) & 15)]; const float x1 = v[0][q], x2 = v[1][q]; v[0][q] = x1 * cs.x - x2 * cs.y; v[1][q] = x1 * cs.y + x2 * cs.x; } }
                    if (fq < 2) { bf16_t* kd = w.KR() + ((size_t)b * KEYS + keyoff + t) * 32;
#pragma unroll
                        for (int bj = 0; bj < 2; ++bj) { u32x4 o; o.x = cvt_pk_bf16(v[bj][0], v[bj][1]); o.y = cvt_pk_bf16(v[bj][2], v[bj][3]); o.z = cvt_pk_bf16(v[bj][4], v[bj][5]); o.w = cvt_pk_bf16(v[bj][6], v[bj][7]);
                            *(u32x4*)(kd + 16 * bj + 8 * fq) = o; } }
                    continue;
                }
#pragma unroll
                for (int bj = 0; bj < 2; ++bj) { u32x4 o; o.x = cvt_pk_bf16(v[bj][0], v[bj][1]); o.y = cvt_pk_bf16(v[bj][2], v[bj][3]); o.z = cvt_pk_bf16(v[bj][4], v[bj][5]); o.w = cvt_pk_bf16(v[bj][6], v[bj][7]);
                    *(u32x4*)(dst + 32 * bj + 8 * fq) = o; }
            }
    }
};
struct P1Order {
    pg8::StaticOrder so; int nctx_tiles, G, c;
    __device__ bool next(int i, pg8::Unit& u) const {
        const int L = i * G + c;
        if (L < 1792) return so.next(i, u);
        const int Lc = L - 1792; if (Lc >= 32 * nctx_tiles) return false;
        u.pm = 256 + (Lc & 31); u.pn = Lc >> 5; return true;
    }
};
__device__ __forceinline__ void phase_p1(LAS unsigned char* lds, const WS& w, const Inputs& in, int l, int vb, int nvb) {
    EpiIn E{w, in.gqa_qn_g + l * 64, in.gqa_kn_g + l * 64, 0};
    P1Order po; po.so.init(NL, 1792, nvb, vb); po.nctx_tiles = (l == 0) ? 7 : 3; po.G = nvb; po.c = vb;
    pg8::gemm_phase(lds, pg8::Gemm{w.H(), w.WinT() + (size_t)l * 1792 * 1024, NR, 1792, 1024}, po, E);
}

extern __shared__ __attribute__((aligned(16))) unsigned char dyn_lds[];

struct EpiUq {
    static constexpr bool PERM = true;
    WS w;
    __device__ __forceinline__ void operator()(const f32x4 (&acc)[2][2][4][2], const pg8::Unit& u, int wr, int wc, int fr, int fq) const {
        const int g = 4 * u.pn + wc; if (g >= 9) return;
        const int pm = u.pm; const bool isctx = pm >= 256; const int b = isctx ? pm - 256 : pm >> 3; const int t0 = isctx ? 0 : (pm & 7) * 256;
        const size_t rowbase = isctx ? (size_t)NL + (size_t)b * CTX : (size_t)b * S;
        const int head = g < 6 ? g : 2 * (g - 6) + (fq >> 1);
#pragma unroll
        for (int ai = 0; ai < 2; ++ai)
#pragma unroll
            for (int m = 0; m < 4; ++m) {
                const int t = t0 + 128 * ai + 64 * wr + 16 * m + fr; const size_t row = rowbase + t;
                const float4 s0 = *(const float4*)(w.SSQ() + row * 8), s1 = *(const float4*)(w.SSQ() + row * 8 + 4);
                const float rstd = rsqrtf((s0.x + s0.y + s0.z + s0.w + s1.x + s1.y) * (1.f / 384.f) + EPS);
                float v[2][8];
#pragma unroll
                for (int bj = 0; bj < 2; ++bj)
#pragma unroll
                    for (int n = 0; n < 2; ++n)
#pragma unroll
                        for (int i = 0; i < 4; ++i) v[bj][4 * n + i] = acc[ai][bj][m][n][i] * rstd;
                bf16_t* hd = isctx ? w.Qmc() + (((size_t)b * 6 + head) * CTX + t) * 96 : w.Qm() + (((size_t)b * 6 + head) * S + t) * 96;
                if (g >= 6 && !isctx) {
#pragma unroll
                    for (int q = 0; q < 8; ++q) { const float2 cs = w.ROPC()[t * 16 + 8 * (fq & 1) + q]; const float x1 = v[0][q], x2 = v[1][q]; v[0][q] = x1 * cs.x - x2 * cs.y; v[1][q] = x1 * cs.y + x2 * cs.x; } }
#pragma unroll
                for (int bj = 0; bj < 2; ++bj) { u32x4 o; o.x = cvt_pk_bf16(v[bj][0], v[bj][1]); o.y = cvt_pk_bf16(v[bj][2], v[bj][3]); o.z = cvt_pk_bf16(v[bj][4], v[bj][5]); o.w = cvt_pk_bf16(v[bj][6], v[bj][7]);
                    bf16_t* d = g < 6 ? hd + 32 * bj + 8 * fq : hd + 64 + 16 * bj + 8 * (fq & 1);
                    *(u32x4*)d = o; }
            }
    }
};
struct EpiUkv {
    static constexpr bool PERM = true;
    WS w;
    __device__ __forceinline__ void operator()(const f32x4 (&acc)[2][2][4][2], const pg8::Unit& u, int wr, int wc, int fr, int fq) const {
        const int g = 4 * u.pn + wc;
        const int pm = u.pm; const bool isctx = pm >= 256; const int b = isctx ? pm - 256 : pm >> 3; const int t0 = isctx ? 0 : (pm & 7) * 256;
        const size_t rowbase = isctx ? (size_t)NL + (size_t)b * CTX : (size_t)b * S; const int keyoff = isctx ? 0 : CTX;
        bf16_t* base = ((g & 1) ? w.Vm() : w.Kmn()) + ((size_t)b * 6 + (g >> 1)) * KEYS * 64;
#pragma unroll
        for (int ai = 0; ai < 2; ++ai)
#pragma unroll
            for (int m = 0; m < 4; ++m) {
                const int t = t0 + 128 * ai + 64 * wr + 16 * m + fr; const size_t row = rowbase + t;
                const float4 s0 = *(const float4*)(w.SSKV() + row * 4);
                const float rstd = rsqrtf((s0.x + s0.y + s0.z + s0.w) * (1.f / 256.f) + EPS);
                bf16_t* d = base + (size_t)(keyoff + t) * 64;
#pragma unroll
                for (int bj = 0; bj < 2; ++bj) { const f32x4 a0 = acc[ai][bj][m][0] * rstd, a1 = acc[ai][bj][m][1] * rstd;
                    u32x4 o; o.x = cvt_pk_bf16(a0[0], a0[1]); o.y = cvt_pk_bf16(a0[2], a0[3]); o.z = cvt_pk_bf16(a1[0], a1[1]); o.w = cvt_pk_bf16(a1[2], a1[3]);
                    *(u32x4*)(d + 32 * bj + 8 * fq) = o; }
            }
    }
};
constexpr int POOL_X = 0, POOL_P = 272 * 128, POOL_BYTES = 272 * 128 + 256 * 128;
__device__ __forceinline__ void phase_pool(LAS unsigned char* lds, const WS& w, bf16_t* __restrict__ MIX, const bf16_t* __restrict__ WT  , const float* __restrict__ pool_scale, int nrows, int vb, int nvb) {
    int tid_ = threadIdx.x; asm volatile("" : "+v"(tid_));
    const int tid = tid_, lane = tid & 63, wid = __builtin_amdgcn_readfirstlane(tid >> 6), r32 = lane & 31, hi = lane >> 5;
    const int nunits = nrows >> 8;
    for (int u = vb; u < nunits; u += nvb) {
        const int row0 = u << 8; const bool isctx = row0 >= NL; const int L = isctx ? CTX : S; const int t0 = isctx ? 0 : (row0 & (S - 1)); const int seq0 = row0 - t0;
#pragma unroll 1
        for (int g = 0; g < 4; ++g) {
            const int wdw = 2 << g, half = wdw >> 1;
            for (int i = tid; i < 272 * 8; i += 512) { const int rr = i >> 3, ch = i & 7; int t = t0 - 8 + rr; t = t < 0 ? 0 : (t >= L ? L - 1 : t);
                *(LAS u32x4*)(lds + POOL_X + rr * 128 + ch * 16) = *(const u32x4*)(w.Bp() + (size_t)(seq0 + t) * 256 + g * 64 + ch * 8); }
            __syncthreads();
            { const int c = tid & 63, seg = tid >> 6; const LAS bf16_t* X = (const LAS bf16_t*)(lds + POOL_X) + c;
              int t = t0 + seg * 32; int lo = t - half, hiw = t - half + wdw; lo = lo < 0 ? 0 : lo; hiw = hiw > L ? L : hiw;
              float sum = 0.f; for (int q = lo; q < hiw; ++q) sum += bf2f(X[(q - t0 + 8) * 64]);
#pragma unroll 4
              for (int k = 0; k < 32; ++k, ++t) {
                  const int clo = (t - half) < 0 ? 0 : (t - half), chi = (t - half + wdw) > L ? L : (t - half + wdw);
                  const float pv = sum / (float)(chi - clo) - bf2f(X[(t - t0 + 8) * 64]);
                  const int r = seg * 32 + k; *((LAS bf16_t*)(lds + POOL_P + r * 128 + (((c >> 3) ^ ((r >> 1) & 7)) << 4)) + (c & 7)) = f2bf(pv);
                  const int add = t + 1 - half + wdw - 1, drop = t - half;
                  if (add < L) sum += bf2f(X[(add - t0 + 8) * 64]);
                  if (drop >= 0) sum -= bf2f(X[(drop - t0 + 8) * 64]);
              } }
            __syncthreads();
            { f32x16 o0 = {}, o1 = {};
              const bf16_t* wt = WT + (size_t)g * 4096 + (size_t)r32 * 64 + 8 * hi;
#pragma unroll
              for (int s = 0; s < 4; ++s) { const int row = wid * 32 + r32; const bf16x8 pf = *(const LAS bf16x8*)(lds + POOL_P + row * 128 + (((2 * s + hi) ^ ((row >> 1) & 7)) << 4));
                  o0 = mfma32(*(const bf16x8*)(wt + 16 * s), pf, o0); o1 = mfma32(*(const bf16x8*)(wt + 32 * 64 + 16 * s), pf, o1); }
              bf16_t* op = MIX + (size_t)(row0 + wid * 32 + r32) * 1024 + 384 + g * 64 + 4 * hi; const float* ps = pool_scale + g * 64 + 4 * hi;
#pragma unroll
              for (int q = 0; q < 4; ++q) { const f32x4 s0 = *(const f32x4*)(ps + 8 * q), s1 = *(const f32x4*)(ps + 32 + 8 * q); u32x2 a, b;
                  a.x = cvt_pk_bf16(o0[4 * q] * s0[0], o0[4 * q + 1] * s0[1]); a.y = cvt_pk_bf16(o0[4 * q + 2] * s0[2], o0[4 * q + 3] * s0[3]);
                  b.x = cvt_pk_bf16(o1[4 * q] * s1[0], o1[4 * q + 1] * s1[1]); b.y = cvt_pk_bf16(o1[4 * q + 2] * s1[2], o1[4 * q + 3] * s1[3]);
                  *(u32x2*)(op + 8 * q) = a; *(u32x2*)(op + 32 + 8 * q) = b; } }
            __syncthreads();
        }
    }
}
__device__ __forceinline__ void phase_p2(LAS unsigned char* lds, const WS& w, const Inputs& in, int l, int vb, int nvb, int parts = 7) {
    pg8::StaticOrder so;
    if (parts & 1) { EpiUq E{w}; const int M = l == 0 ? NR : NL; so.init(M, 768, nvb, vb); pg8::gemm_phase(lds, pg8::Gemm{w.CQ(), w.WuqT() + (size_t)l * 768 * 384, M, 768, 384}, so, E); }
    if (parts & 2) { EpiUkv E{w}; so.init(NR, 768, nvb, vb); pg8::gemm_phase(lds, pg8::Gemm{w.CKV(), w.WukvT() + (size_t)l * 768 * 256, NR, 768, 256}, so, E); }
    if (parts & 4) phase_pool(lds, w, w.H(), w.PoolWT() + (size_t)l * 4 * 64 * 64, in.pool_scale + l * 256, l == 0 ? NR : NL, vb, nvb);
}

struct EpiOut {
    static constexpr bool PERM = true;
    bf16_t* DLT; const float* gate;
    __device__ __forceinline__ void operator()(const f32x4 (&acc)[2][2][4][2], const pg8::Unit& u, int wr, int wc, int fr, int fq) const {
        const int pm = u.pm; const int mr = pm >= 256 ? 32 : pm >> 3;
        const size_t r0 = (size_t)pm * 256 + wr * 64 + fr; const int col0 = u.pn * 256 + wc * 32 + 8 * fq;
        f32x4 gv[2][2];
#pragma unroll
        for (int bj = 0; bj < 2; ++bj)
#pragma unroll
            for (int n = 0; n < 2; ++n) gv[bj][n] = *(const f32x4*)(gate + (size_t)mr * 6144 + col0 + bj * 128 + 4 * n);
#pragma unroll
        for (int ai = 0; ai < 2; ++ai)
#pragma unroll
            for (int m = 0; m < 4; ++m) { bf16_t* d = DLT + (r0 + ai * 128 + m * 16) * 1024 + col0;
#pragma unroll
                for (int bj = 0; bj < 2; ++bj) { const f32x4 a0 = acc[ai][bj][m][0] * gv[bj][0], a1 = acc[ai][bj][m][1] * gv[bj][1];
                    u32x4 o; o.x = cvt_pk_bf16(a0[0], a0[1]); o.y = cvt_pk_bf16(a0[2], a0[3]); o.z = cvt_pk_bf16(a1[0], a1[1]); o.w = cvt_pk_bf16(a1[2], a1[3]);
                    *(u32x4*)(d + bj * 128) = o; } }
    }
};
__device__ __forceinline__ void phase_p4(LAS unsigned char* lds, const WS& w, const Inputs& in, int l, int vb, int nvb) {
    const float* MODl = w.MOD() + (size_t)l * 33 * 6144;
    EpiOut E{w.PQ(), MODl + 2 * 1024};
    const int M = l == 0 ? NR : NL;
    pg8::StaticOrder so; so.init(M, 1024, nvb, vb);
    pg8::gemm_phase(lds, pg8::Gemm{w.H(), w.WoutT() + (size_t)l * 1024 * 1024, M, 1024, 1024}, so, E);
}

__device__ __forceinline__ void phase_modulate(const float* __restrict__ XLp, const float* __restrict__ XCp, bf16_t* __restrict__ Hout, const float* __restrict__ g, const float* __restrict__ MODl, int si, int nrows, int vb, int nvb, signed char* __restrict__ H8 = nullptr, float* __restrict__ HS = nullptr,
                                               const bf16_t* __restrict__ DLT = nullptr, float* __restrict__ XLo = nullptr, float* __restrict__ XCo = nullptr) {
    int tid_ = threadIdx.x; asm volatile("" : "+v"(tid_));
    const int tid = tid_, lane = tid & 63, wid = tid >> 6;
    f32x4 gv[4];
#pragma unroll
    for (int i = 0; i < 4; ++i) gv[i] = *(const f32x4*)(g + 256 * i + 4 * lane);
    const int stride = nvb * 8, lastrow = nrows - 1;
    f32x4 nx[4]; u32x2 ndr[4];
#define PM_LOAD(r_) do { const int rr_ = (r_) < nrows ? (r_) : lastrow; const bool ic_ = rr_ >= NL; const float* xp_ = ic_ ? XCp + (size_t)(rr_ - NL) * 1024 : XLp + (size_t)rr_ * 1024; \
        _Pragma("unroll") for (int i = 0; i < 4; ++i) { nx[i] = *(const f32x4*)(xp_ + 256 * i + 4 * lane); if (DLT) ndr[i] = *(const u32x2*)(DLT + (size_t)rr_ * 1024 + 256 * i + 4 * lane); } } while (0)
    PM_LOAD(vb * 8 + wid);
    for (int row = vb * 8 + wid; row < nrows; row += stride) {
        const bool isctx = row >= NL; const int mr = isctx ? 32 : row / S;
        f32x4 x[4]; u32x2 dr4[4]; float ss = 0.f;
#pragma unroll
        for (int i = 0; i < 4; ++i) { x[i] = nx[i]; if (DLT) dr4[i] = ndr[i]; }
        PM_LOAD(row + stride);
#pragma unroll
        for (int i = 0; i < 4; ++i) {
            if (DLT) { const u32x2 dr = dr4[i];
                x[i][0] += __uint_as_float(dr.x << 16); x[i][1] += __uint_as_float(dr.x & 0xffff0000u); x[i][2] += __uint_as_float(dr.y << 16); x[i][3] += __uint_as_float(dr.y & 0xffff0000u);
                float* xo = isctx ? XCo + (size_t)(row - NL) * 1024 : XLo + (size_t)row * 1024; *(f32x4*)(xo + 256 * i + 4 * lane) = x[i]; }
            ss += x[i][0] * x[i][0] + x[i][1] * x[i][1] + x[i][2] * x[i][2] + x[i][3] * x[i][3]; }
        ss = wave_sum(ss); const float rstd = rsqrtf(ss * (1.f / 1024.f) + EPS);
        const float* sh = MODl + (size_t)mr * 6144 + si * 1024;
        f32x4 y[4]; float am = 0.f;
#pragma unroll
        for (int i = 0; i < 4; ++i) { const f32x4 shv = *(const f32x4*)(sh + 256 * i + 4 * lane), scv = *(const f32x4*)(sh + 1024 + 256 * i + 4 * lane);
            y[i] = x[i] * rstd * gv[i] * (scv + 1.f) + shv;
            am = fmaxf(am, fmaxf(fmaxf(fabsf(y[i][0]), fabsf(y[i][1])), fmaxf(fabsf(y[i][2]), fabsf(y[i][3]))));
            u32x2 o; o.x = cvt_pk_bf16(y[i][0], y[i][1]); o.y = cvt_pk_bf16(y[i][2], y[i][3]);
            *(u32x2*)(Hout + (size_t)row * 1024 + 256 * i + 4 * lane) = o; }
        if (H8) {
#pragma unroll
            for (int o = 32; o > 0; o >>= 1) am = fmaxf(am, __shfl_xor(am, o));
            const float inv = am > 0.f ? 127.f / am : 0.f;
#pragma unroll
            for (int i = 0; i < 4; ++i) { const int q0 = (int)rintf(y[i][0] * inv), q1 = (int)rintf(y[i][1] * inv), q2 = (int)rintf(y[i][2] * inv), q3 = (int)rintf(y[i][3] * inv);
                *(unsigned*)(H8 + (size_t)row * 1024 + 256 * i + 4 * lane) = (unsigned)(q0 & 0xff) | ((unsigned)(q1 & 0xff) << 8) | ((unsigned)(q2 & 0xff) << 16) | ((unsigned)(q3 & 0xff) << 24); }
            if (lane == 0) HS[row] = am > 0.f ? am * (1.f / 127.f) : 1.f;
        }
    }
#undef PM_LOAD
}

struct EpiPQ {
    static constexpr bool PERM = true;
    bf16_t* PQ;
    __device__ __forceinline__ void operator()(const f32x4 (&acc)[2][2][4][2], const pg8::Unit& u, int wr, int wc, int fr, int fq) const {
        const size_t r0 = (size_t)u.pm * 256 + wr * 64 + fr; const int col0 = u.pn * 256 + wc * 32 + 8 * fq;
#pragma unroll
        for (int ai = 0; ai < 2; ++ai)
#pragma unroll
            for (int m = 0; m < 4; ++m) { bf16_t* d = PQ + (r0 + ai * 128 + m * 16) * 2048 + col0;
#pragma unroll
                for (int bj = 0; bj < 2; ++bj) { const f32x4 a0 = acc[ai][bj][m][0], a1 = acc[ai][bj][m][1];
                    u32x4 o; o.x = cvt_pk_bf16(a0[0], a0[1]); o.y = cvt_pk_bf16(a0[2], a0[3]); o.z = cvt_pk_bf16(a1[0], a1[1]); o.w = cvt_pk_bf16(a1[2], a1[3]);
                    *(u32x4*)(d + bj * 128) = o; } }
    }
};
__device__ __forceinline__ void phase_p6a(LAS unsigned char* lds, const WS& w, int l, int vb, int nvb) {
    EpiPQ E{w.PQ()}; const int M = l == 0 ? NR : NL;
    pg8::StaticOrder so; so.init(M, 2048, nvb, vb);
    pg8::gemm_phase(lds, pg8::Gemm{w.H(), w.WqT() + (size_t)l * 2048 * 1024, M, 2048, 1024}, so, E);
}


using bf16x2_t = __attribute__((ext_vector_type(2))) __bf16;
typedef float f32x2 __attribute__((ext_vector_type(2)));
__device__ __forceinline__ float gelu_fast(float x) {
    const float u2 = 1.5957691216057308f * (x + 0.044715f * x * x * x);
    return x * __builtin_amdgcn_rcpf(1.f + __builtin_amdgcn_exp2f(-1.4426950408889634f * u2));
}
#define DPPF(v, ctrl) __builtin_bit_cast(float, __builtin_amdgcn_update_dpp(0, __builtin_bit_cast(int, (v)), (ctrl), 0xf, 0xf, true))
__device__ __forceinline__ float reduce8(float p0, float p1, float p2, float p3, float p4, float p5, float p6, float p7, int lane) {
    auto s01 = __builtin_amdgcn_permlane32_swap(__float_as_uint(p0), __float_as_uint(p1), false, false);
    auto s23 = __builtin_amdgcn_permlane32_swap(__float_as_uint(p2), __float_as_uint(p3), false, false);
    auto s45 = __builtin_amdgcn_permlane32_swap(__float_as_uint(p4), __float_as_uint(p5), false, false);
    auto s67 = __builtin_amdgcn_permlane32_swap(__float_as_uint(p6), __float_as_uint(p7), false, false);
    const float q0 = __uint_as_float(s01[0]) + __uint_as_float(s01[1]), q1 = __uint_as_float(s23[0]) + __uint_as_float(s23[1]);
    const float q2 = __uint_as_float(s45[0]) + __uint_as_float(s45[1]), q3 = __uint_as_float(s67[0]) + __uint_as_float(s67[1]);
    auto t0 = __builtin_amdgcn_permlane16_swap(__float_as_uint(q0), __float_as_uint(q1), false, false);
    auto t1 = __builtin_amdgcn_permlane16_swap(__float_as_uint(q2), __float_as_uint(q3), false, false);
    float r0 = __uint_as_float(t0[0]) + __uint_as_float(t0[1]);
    float r1 = __uint_as_float(t1[0]) + __uint_as_float(t1[1]);
    r0 += DPPF(r0, 0x128); r1 += DPPF(r1, 0x128);
    float z = (lane & 8) ? r1 : r0;
    z += DPPF(z, 0x141);
    z += DPPF(z, 0xB1);
    z += DPPF(z, 0x4E);
    return z;
}
__device__ __forceinline__ void p7_axpy(const u32x4 v, float wj, float (&out)[16]) {
#pragma unroll
    for (int k = 0; k < 4; ++k) { const f32x2 lo = __builtin_amdgcn_cvt_pk_f32_fp8((int)v[k], false), hi2 = __builtin_amdgcn_cvt_pk_f32_fp8((int)v[k], true);
        out[4 * k] = __builtin_fmaf(wj, lo.x, out[4 * k]); out[4 * k + 1] = __builtin_fmaf(wj, lo.y, out[4 * k + 1]); out[4 * k + 2] = __builtin_fmaf(wj, hi2.x, out[4 * k + 2]); out[4 * k + 3] = __builtin_fmaf(wj, hi2.y, out[4 * k + 3]); }
}
__device__ __forceinline__ int p7_doti(const u32x4 u, const u32x4 h) {
    int s = __builtin_amdgcn_sdot4((int)u[0], (int)h[0], 0, false); s = __builtin_amdgcn_sdot4((int)u[1], (int)h[1], s, false); s = __builtin_amdgcn_sdot4((int)u[2], (int)h[2], s, false); return __builtin_amdgcn_sdot4((int)u[3], (int)h[3], s, false);
}
#define DPPI(v, ctrl) __builtin_amdgcn_update_dpp(0, (v), (ctrl), 0xf, 0xf, true)
__device__ __forceinline__ int reduce8i(int p0, int p1, int p2, int p3, int p4, int p5, int p6, int p7, int lane) {
    auto s01 = __builtin_amdgcn_permlane32_swap((unsigned)p0, (unsigned)p1, false, false); auto s23 = __builtin_amdgcn_permlane32_swap((unsigned)p2, (unsigned)p3, false, false);
    auto s45 = __builtin_amdgcn_permlane32_swap((unsigned)p4, (unsigned)p5, false, false); auto s67 = __builtin_amdgcn_permlane32_swap((unsigned)p6, (unsigned)p7, false, false);
    const unsigned q0 = s01[0] + s01[1], q1 = s23[0] + s23[1], q2 = s45[0] + s45[1], q3 = s67[0] + s67[1];
    auto t0 = __builtin_amdgcn_permlane16_swap(q0, q1, false, false); auto t1 = __builtin_amdgcn_permlane16_swap(q2, q3, false, false);
    int r0 = (int)(t0[0] + t0[1]), r1 = (int)(t1[0] + t1[1]);
    r0 += DPPI(r0, 0x128); r1 += DPPI(r1, 0x128);
    int z = (lane & 8) ? r1 : r0;
    z += DPPI(z, 0x141); z += DPPI(z, 0xB1); z += DPPI(z, 0x4E);
    return z;
}

struct P7CArgs { const signed char* H8; const unsigned* EG; const unsigned char* U8; int* PART; int nrows; };
__device__ __forceinline__ void phase_p7c(LAS unsigned char* lds, const P7CArgs& a, int part, int prank, int nvb) {
    int tid_ = threadIdx.x; asm volatile("" : "+v"(tid_));
    const int lane = tid_ & 63, wid = __builtin_amdgcn_readfirstlane(tid_ >> 6);
    const int nw = (nvb >> 3) * 8, wrank = prank * 8 + wid;
    LAS unsigned* tab = (LAS unsigned*)(lds + wid * 1024);
    const int grp = lane >> 3, c = lane & 7, c16 = c * 16;
    const unsigned char* ubase = a.U8 + 128 * part + c16;
    const signed char* hbase = a.H8 + 128 * part + c16;
    int* pbase = a.PART + (size_t)part * a.nrows * 128;
    const int c2 = (c >> 2) & 1, c1 = (c >> 1) & 1, c0 = c & 1;
    const int ent0 = 8 * (8 * c2 + 4 * c0 + 2 * c1) + grp;
    u32x4 Av[16], Bv[16]; u32x4 Ah, Bh;
    unsigned pw0 = 0u, pw1 = 0u;
#define P7C_PREF(t) do { pw0 = a.EG[(size_t)(t) * 128 + lane]; pw1 = a.EG[(size_t)(t) * 128 + 64 + lane]; } while (0)
#define P7C_ISSUE(X, Xh, t, slot, tnext) do { LAS unsigned* tb_ = tab + (slot) * 128; \
        tb_[lane] = pw0; tb_[64 + lane] = pw1; \
        asm volatile("s_waitcnt lgkmcnt(0)" ::: "memory"); \
        _Pragma("unroll") for (int i_ = 0; i_ < 16; ++i_) { const unsigned e_ = tb_[8 * i_ + grp]; X[i_] = *(const u32x4*)(ubase + (size_t)(e_ >> 16) * 1024); } \
        Xh = *(const u32x4*)(hbase + (size_t)(t) * 1024); \
        P7C_PREF(tnext); } while (0)
#define P7C_X(v, ctrl) ((v) + DPPI((v), (ctrl)))
#define P7C_COMPUTE(X, Xh, t, valid) do { int d_[16]; \
        _Pragma("unroll") for (int i_ = 0; i_ < 16; ++i_) d_[i_] = p7_doti(X[i_], Xh); \
        int e8_[8]; _Pragma("unroll") for (int k = 0; k < 8; ++k) { const int send_ = c2 ? d_[k] : d_[k + 8], keep_ = c2 ? d_[k + 8] : d_[k]; e8_[k] = keep_ + DPPI(send_, 0x141); }            \
        int e4_[4]; _Pragma("unroll") for (int k = 0; k < 4; ++k) { const int send_ = c0 ? e8_[k] : e8_[k + 4], keep_ = c0 ? e8_[k + 4] : e8_[k]; e4_[k] = keep_ + DPPI(send_, 0xB1); }          \
        int e2_[2]; _Pragma("unroll") for (int k = 0; k < 2; ++k) { const int send_ = c1 ? e4_[k] : e4_[k + 2], keep_ = c1 ? e4_[k + 2] : e4_[k]; e2_[k] = keep_ + DPPI(send_, 0x4E); }          \
        if (valid) { int* pp_ = pbase + (size_t)(t) * 128 + ent0; pp_[0] = e2_[0]; pp_[8] = e2_[1]; } } while (0)
    const int lastrow = a.nrows - 1;
    int t = wrank;
    P7C_PREF(t);
    P7C_ISSUE(Av, Ah, t, 0, (t + nw < a.nrows ? t + nw : lastrow));
    while (t < a.nrows) {
        const int t1 = t + nw, t2 = t1 + nw, t3 = t2 + nw;
        const int k1 = t1 < a.nrows ? t1 : lastrow, k2 = t2 < a.nrows ? t2 : lastrow, k3 = t3 < a.nrows ? t3 : lastrow;
        P7C_ISSUE(Bv, Bh, k1, 1, k2);
        P7C_COMPUTE(Av, Ah, t, true);
        P7C_ISSUE(Av, Ah, k2, 0, k3);
        P7C_COMPUTE(Bv, Bh, k1, (t1 < a.nrows));
        t = t2;
    }
#undef P7C_PREF
#undef P7C_ISSUE
#undef P7C_COMPUTE
}
__device__ __forceinline__ void phase_p7d(const int* __restrict__ PART, const unsigned* __restrict__ EG, const float* __restrict__ US, const float* __restrict__ VS, const float* __restrict__ HS, unsigned* __restrict__ WE, int nrows, int vb, int nvb) {
    int tid_ = threadIdx.x; asm volatile("" : "+v"(tid_));
    typedef int i32x4 __attribute__((ext_vector_type(4)));
    const size_t n4 = (size_t)nrows * 32, pstride4 = n4;
    const i32x4* P4 = (const i32x4*)PART; const u32x4* EG4 = (const u32x4*)EG; u32x4* WE4 = (u32x4*)WE;
    for (size_t i = (size_t)vb * 512 + tid_; i < n4; i += (size_t)nvb * 512) {
        i32x4 s = P4[i];
#pragma unroll
        for (int p = 1; p < 8; ++p) s += P4[p * pstride4 + i];
        const u32x4 eg = EG4[i]; const float hs = HS[i >> 5];
        u32x4 o;
#pragma unroll
        for (int k = 0; k < 4; ++k) { const int eid = (int)(eg[k] >> 16);
            const float av = (float)s[k] * US[eid] * hs;
            const float wv = __uint_as_float(eg[k] << 16) * gelu_fast(av) * VS[eid];
            o[k] = (eg[k] & 0xffff0000u) | (cvt_pk_bf16(wv, 0.f) & 0xffffu); }
        WE4[i] = o;
    }
}
struct P7BArgs { const unsigned* WE; const unsigned char* V8; float* XL; float* XC; const float* gate2; int nrows; };
template <int PM>
__device__ __forceinline__ void phase_p7b(LAS unsigned char* lds, const P7BArgs& a, int part, int prank, int nvb) {
    int tid_ = threadIdx.x; asm volatile("" : "+v"(tid_));
    const int lane = tid_ & 63, wid = __builtin_amdgcn_readfirstlane(tid_ >> 6);
    const int nw = (nvb >> 3) * 8, wrank = prank * 8 + wid;
    LAS unsigned* tab = (LAS unsigned*)(lds + wid * 1024);
    const int grp = lane >> 3, c16 = (lane & 7) * 16;
    const unsigned char* vbase = a.V8 + 128 * part + c16;
    const int colofs = 128 * part + c16 + 8 * (lane >> 5) + 4 * ((lane >> 4) & 1) + 2 * ((lane >> 3) & 1);
    u32x4 Av[16], Bv[16]; float Aw[16], Bw[16]; f32x2 Ax, Ag, Bx, Bg;
    unsigned pw0 = 0u, pw1 = 0u;
#define P7B_PREF(t) do { pw0 = a.WE[(size_t)(t) * 128 + lane]; pw1 = a.WE[(size_t)(t) * 128 + 64 + lane]; } while (0)
#define P7B_ISSUE(X, Xw, Xx, Xg, t, slot, tnext) do { LAS unsigned* tb_ = tab + (slot) * 128; \
        tb_[lane] = pw0; tb_[64 + lane] = pw1; \
        asm volatile("s_waitcnt lgkmcnt(0)" ::: "memory"); \
        _Pragma("unroll") for (int i_ = 0; i_ < 16; ++i_) { const unsigned we_ = tb_[8 * i_ + grp]; Xw[i_] = __uint_as_float(we_ << 16); if (PM != 2) X[i_] = *(const u32x4*)(vbase + (size_t)(we_ >> 16) * 1024); else X[i_] = (u32x4){we_, 0x38383838u, 0x38383838u, 0x38383838u}; } \
        { const bool isctx_ = (t) >= NL; const float* xp_ = (isctx_ ? a.XC + (size_t)((t) - NL) * 1024 : a.XL + (size_t)(t) * 1024) + colofs; const int mr_ = isctx_ ? 32 : (t) / S; \
          Xx = *(const f32x2*)xp_; Xg = *(const f32x2*)(a.gate2 + (size_t)mr_ * 6144 + colofs); } \
        P7B_PREF(tnext); } while (0)
#define P7B_COMPUTE(X, Xw, Xx, Xg, t, valid) do { float acc[16]; \
        _Pragma("unroll") for (int k = 0; k < 16; ++k) acc[k] = 0.f; \
        if (PM != 1) { _Pragma("unroll") for (int i_ = 0; i_ < 16; ++i_) p7_axpy(X[i_], Xw[i_], acc); } else { _Pragma("unroll") for (int i_ = 0; i_ < 16; ++i_) acc[i_] = __uint_as_float((X[i_][0] ^ X[i_][1] ^ X[i_][2] ^ X[i_][3]) & 0x3fffffffu) + Xw[i_]; } \
        float b_[8]; _Pragma("unroll") for (int k = 0; k < 8; ++k) { auto s_ = __builtin_amdgcn_permlane32_swap(__float_as_uint(acc[k]), __float_as_uint(acc[k + 8]), false, false); b_[k] = __uint_as_float(s_[0]) + __uint_as_float(s_[1]); } \
        float c_[4]; _Pragma("unroll") for (int k = 0; k < 4; ++k) { auto s_ = __builtin_amdgcn_permlane16_swap(__float_as_uint(b_[k]), __float_as_uint(b_[k + 4]), false, false); c_[k] = __uint_as_float(s_[0]) + __uint_as_float(s_[1]); } \
        float d_[2]; _Pragma("unroll") for (int k = 0; k < 2; ++k) { const float send_ = (lane & 8) ? c_[k] : c_[k + 2]; const float keep_ = (lane & 8) ? c_[k + 2] : c_[k]; d_[k] = keep_ + DPPF(send_, 0x128); } \
        const bool isctx_ = (t) >= NL; float* xp_ = (isctx_ ? a.XC + (size_t)((t) - NL) * 1024 : a.XL + (size_t)(t) * 1024) + colofs; \
        f32x2 x_ = Xx; x_.x += Xg.x * d_[0]; x_.y += Xg.y * d_[1]; if ((valid) && PM == 0) *(f32x2*)xp_ = x_; else if (PM != 0 && x_.x == 1.2345e30f) *(f32x2*)xp_ = x_; } while (0)
    const int lastrow = a.nrows - 1;
    int t = wrank;
    P7B_PREF(t);
    P7B_ISSUE(Av, Aw, Ax, Ag, t, 0, (t + nw < a.nrows ? t + nw : lastrow));
    while (t < a.nrows) {
        const int t1 = t + nw, t2 = t1 + nw, t3 = t2 + nw;
        const int c1 = t1 < a.nrows ? t1 : lastrow, c2 = t2 < a.nrows ? t2 : lastrow, c3 = t3 < a.nrows ? t3 : lastrow;
        P7B_ISSUE(Bv, Bw, Bx, Bg, c1, 1, c2);
        P7B_COMPUTE(Av, Aw, Ax, Ag, t, true);
        P7B_ISSUE(Av, Aw, Ax, Ag, c2, 0, c3);
        P7B_COMPUTE(Bv, Bw, Bx, Bg, c1, (t1 < a.nrows));
        t = t2;
    }
#undef P7B_PREF
#undef P7B_ISSUE
#undef P7B_COMPUTE
}
__device__ __forceinline__ void phase_final_norm(float* __restrict__ XLp, const float* __restrict__ g, int vb, int nvb) {
    int tid_ = threadIdx.x; asm volatile("" : "+v"(tid_));
    const int lane = tid_ & 63, wid = tid_ >> 6;
    for (int row = vb * 8 + wid; row < NL; row += nvb * 8) {
        float* xp = XLp + (size_t)row * 1024; f32x4 x[4]; float ss = 0.f;
#pragma unroll
        for (int i = 0; i < 4; ++i) { x[i] = *(const f32x4*)(xp + 256 * i + 4 * lane); ss += x[i][0] * x[i][0] + x[i][1] * x[i][1] + x[i][2] * x[i][2] + x[i][3] * x[i][3]; }
        ss = wave_sum(ss); const float rstd = rsqrtf(ss * (1.f / 1024.f) + EPS);
#pragma unroll
        for (int i = 0; i < 4; ++i) *(f32x4*)(xp + 256 * i + 4 * lane) = x[i] * rstd * *(const f32x4*)(g + 256 * i + 4 * lane);
    }
}

typedef short s16x4 __attribute__((ext_vector_type(4)));
__device__ __forceinline__ s16x4 lds_tr16(const LAS unsigned char* p) { return __builtin_bit_cast(s16x4, __builtin_amdgcn_ds_read_tr16_b64_v4i16((LAS s16x4*)p)); }
constexpr int ATT_BUF = 20480;
template <int DK>
__device__ __forceinline__ void attn_unit(LAS unsigned char* lds, const bf16_t* __restrict__ Q, const bf16_t* __restrict__ K1, const bf16_t* __restrict__ K2, const bf16_t* __restrict__ V,
                                          int nkeys, float c2, bf16_t* __restrict__ out) {
    int tid_ = threadIdx.x; asm volatile("" : "+v"(tid_));
    const int tid = tid_, lane = tid & 63, wid = __builtin_amdgcn_readfirstlane(tid >> 6), r32 = lane & 31, hi = lane >> 5;
    constexpr int NS = DK / 16;
    bf16x8 qf[NS];
    { const bf16_t* qp = Q + (size_t)(wid * 32 + r32) * DK + 8 * hi;
#pragma unroll
      for (int s = 0; s < NS; ++s) qf[s] = *(const bf16x8*)(qp + 16 * s); }
    const int skey = tid >> 3, sch = tid & 7;
    const unsigned st_k1 = skey * 128 + ((sch ^ ((skey >> 1) & 7)) << 4);
    const unsigned st_v = 8192 + skey * 128 + (((sch << 4)) ^ (((skey >> 1) & 1) << 6));
    const int skey2 = (tid & 255) >> 2, sch2 = tid & 3;
    const unsigned st_k2 = 16384 + skey2 * 64 + ((sch2 ^ ((skey2 >> 2) & 3)) << 4);
    const bf16_t* gk1 = K1 + (size_t)skey * 64 + sch * 8; const bf16_t* gv = V + (size_t)skey * 64 + sch * 8;
    const bf16_t* gk2 = (DK == 96) ? K2 + (size_t)skey2 * 32 + sch2 * 8 : nullptr;
    unsigned ka[2][4];
#pragma unroll
    for (int kt = 0; kt < 2; ++kt)
#pragma unroll
        for (int s = 0; s < 4; ++s) { const int key = 32 * kt + r32; ka[kt][s] = key * 128 + (((2 * s + hi) ^ ((key >> 1) & 7)) << 4); }
    unsigned kb[2][2];
#pragma unroll
    for (int kt = 0; kt < 2; ++kt)
#pragma unroll
        for (int s = 0; s < 2; ++s) { const int key = 32 * kt + r32; kb[kt][s] = 16384 + key * 64 + (((2 * s + hi) ^ ((key >> 2) & 3)) << 4); }
    const int vq = (lane & 15) >> 2, vp = lane & 3, vg = (lane >> 4) & 1;
    unsigned va[2];
#pragma unroll
    for (int dvb = 0; dvb < 2; ++dvb) { const int key = 4 * hi + vq; va[dvb] = 8192 + key * 128 + ((((32 * dvb + 16 * vg + 4 * vp) * 2)) ^ (((key >> 1) & 1) << 6)); }
    float m = -1e30f, l = 0.f;
    f32x16 o0 = {}, o1 = {};
    const int NT = nkeys >> 6;
    u32x4 sk1, sv, sk2;
    sk1 = *(const u32x4*)gk1; sv = *(const u32x4*)gv; if (DK == 96) { if (tid < 256) sk2 = *(const u32x4*)gk2; }
    *(LAS u32x4*)(lds + st_k1) = sk1; *(LAS u32x4*)(lds + st_v) = sv; if (DK == 96) { if (tid < 256) *(LAS u32x4*)(lds + st_k2) = sk2; }
    __syncthreads();
    for (int t = 0; t < NT; ++t) {
        LAS unsigned char* buf = lds + (t & 1) * ATT_BUF;
        if (t + 1 < NT) { sk1 = *(const u32x4*)(gk1 + (size_t)(t + 1) * 64 * 64); sv = *(const u32x4*)(gv + (size_t)(t + 1) * 64 * 64); if (DK == 96) { if (tid < 256) sk2 = *(const u32x4*)(gk2 + (size_t)(t + 1) * 64 * 32); } }
        bf16x8 kf0[NS], kf1[NS];
#pragma unroll
        for (int s = 0; s < 4; ++s) { kf0[s] = *(const LAS bf16x8*)(buf + ka[0][s]); kf1[s] = *(const LAS bf16x8*)(buf + ka[1][s]); }
        if (DK == 96) {
#pragma unroll
            for (int s = 0; s < 2; ++s) { kf0[4 + s] = *(const LAS bf16x8*)(buf + kb[0][s]); kf1[4 + s] = *(const LAS bf16x8*)(buf + kb[1][s]); }
        }
        __builtin_amdgcn_sched_barrier(0);
        f32x16 p0 = {}, p1 = {};
#pragma unroll
        for (int s = 0; s < NS; ++s) { p0 = mfma32(kf0[s], qf[s], p0); p1 = mfma32(kf1[s], qf[s], p1); }
        __builtin_amdgcn_sched_barrier(0);
        s16x4 vlo[2][2][2], vhi[2][2][2];
#pragma unroll
        for (int kt = 0; kt < 2; ++kt)
#pragma unroll
            for (int sp = 0; sp < 2; ++sp) { const int kofs = (32 * kt + 16 * sp) * 128;
#pragma unroll
                for (int dvb = 0; dvb < 2; ++dvb) { vlo[dvb][kt][sp] = lds_tr16(buf + va[dvb] + kofs); vhi[dvb][kt][sp] = lds_tr16(buf + va[dvb] + kofs + 8 * 128); } }
        __builtin_amdgcn_sched_barrier(0);
        float mx = p0[0];
#pragma unroll
        for (int r = 1; r < 16; ++r) mx = fmaxf(mx, p0[r]);
#pragma unroll
        for (int r = 0; r < 16; ++r) mx = fmaxf(mx, p1[r]);
        { auto rr = __builtin_amdgcn_permlane32_swap(__float_as_uint(mx), __float_as_uint(mx), false, false); mx = fmaxf(__uint_as_float(rr[0]), __uint_as_float(rr[1])); }
        const float tm = mx * c2;
        if (__any(tm > m + 8.f)) {
            const float mn = fmaxf(m, tm), al = __builtin_amdgcn_exp2f(m - mn); m = mn; l *= al;
#pragma unroll
            for (int r = 0; r < 16; ++r) { o0[r] *= al; o1[r] *= al; }
        }
        const float nm = -m; float ls = 0.f;
#pragma unroll
        for (int r = 0; r < 16; ++r) { p0[r] = __builtin_amdgcn_exp2f(__builtin_fmaf(p0[r], c2, nm)); p1[r] = __builtin_amdgcn_exp2f(__builtin_fmaf(p1[r], c2, nm)); ls += p0[r] + p1[r]; }
        l += ls;
        bf16x8 pf[2][2];
#pragma unroll
        for (int sp = 0; sp < 2; ++sp) { u32x4 a, b;
            a.x = cvt_pk_bf16(p0[8 * sp], p0[8 * sp + 1]); a.y = cvt_pk_bf16(p0[8 * sp + 2], p0[8 * sp + 3]); a.z = cvt_pk_bf16(p0[8 * sp + 4], p0[8 * sp + 5]); a.w = cvt_pk_bf16(p0[8 * sp + 6], p0[8 * sp + 7]);
            b.x = cvt_pk_bf16(p1[8 * sp], p1[8 * sp + 1]); b.y = cvt_pk_bf16(p1[8 * sp + 2], p1[8 * sp + 3]); b.z = cvt_pk_bf16(p1[8 * sp + 4], p1[8 * sp + 5]); b.w = cvt_pk_bf16(p1[8 * sp + 6], p1[8 * sp + 7]);
            pf[0][sp] = __builtin_bit_cast(bf16x8, a); pf[1][sp] = __builtin_bit_cast(bf16x8, b); }
        __builtin_amdgcn_sched_barrier(0);
#pragma unroll
        for (int kt = 0; kt < 2; ++kt)
#pragma unroll
            for (int sp = 0; sp < 2; ++sp) {
                { const s16x4 lo = vlo[0][kt][sp], hi4 = vhi[0][kt][sp]; const bf16x8 vf = (bf16x8){lo[0], lo[1], lo[2], lo[3], hi4[0], hi4[1], hi4[2], hi4[3]}; o0 = mfma32(vf, pf[kt][sp], o0); }
                { const s16x4 lo = vlo[1][kt][sp], hi4 = vhi[1][kt][sp]; const bf16x8 vf = (bf16x8){lo[0], lo[1], lo[2], lo[3], hi4[0], hi4[1], hi4[2], hi4[3]}; o1 = mfma32(vf, pf[kt][sp], o1); } }
        __builtin_amdgcn_sched_barrier(0);
        if (t + 1 < NT) { LAS unsigned char* nb = lds + ((t + 1) & 1) * ATT_BUF; *(LAS u32x4*)(nb + st_k1) = sk1; *(LAS u32x4*)(nb + st_v) = sv; if (DK == 96) { if (tid < 256) *(LAS u32x4*)(nb + st_k2) = sk2; } }
        __syncthreads();
    }
    { auto rr = __builtin_amdgcn_permlane32_swap(__float_as_uint(l), __float_as_uint(l), false, false); l = __uint_as_float(rr[0]) + __uint_as_float(rr[1]); }
    const float il = 1.f / l;
    bf16_t* op = out + (size_t)(wid * 32 + r32) * 1024 + 4 * hi;
#pragma unroll
    for (int g = 0; g < 4; ++g) { u32x2 a, b;
        a.x = cvt_pk_bf16(o0[4 * g] * il, o0[4 * g + 1] * il); a.y = cvt_pk_bf16(o0[4 * g + 2] * il, o0[4 * g + 3] * il);
        b.x = cvt_pk_bf16(o1[4 * g] * il, o1[4 * g + 1] * il); b.y = cvt_pk_bf16(o1[4 * g + 2] * il, o1[4 * g + 3] * il);
        *(u32x2*)(op + 8 * g) = a; *(u32x2*)(op + 32 + 8 * g) = b; }
}
__device__ __forceinline__ void phase_p3(LAS unsigned char* lds, const WS& w, int l, int vb, int nvb) {
    const float c2g = 0.125f * 1.4426950408889634f, c2m = 0.10206207261596577f * 1.4426950408889634f;
    bf16_t* MIX = w.H();
    const int nlat = NB * 12 * 8, nctx = (l == 0) ? NB * 12 : 0;
    for (int u = vb; u < nlat + nctx; u += nvb) {
        if (u < nlat) {
            const int qb = u & 7, slot = (u >> 3) % 12, b = u / 96;
            bf16_t* out = MIX + ((size_t)b * S + qb * 256) * 1024;
            if (slot < 6) attn_unit<64>(lds, w.Qg() + (((size_t)b * 6 + slot) * S + qb * 256) * 64, w.Kg() + ((size_t)b * 2 + slot / 3) * KEYS * 64, nullptr, w.Vg() + ((size_t)b * 2 + slot / 3) * KEYS * 64, KEYS, c2g, out + slot * 64);
            else { const int h = slot - 6; attn_unit<96>(lds, w.Qm() + (((size_t)b * 6 + h) * S + qb * 256) * 96, w.Kmn() + ((size_t)b * 6 + h) * KEYS * 64, w.KR() + (size_t)b * KEYS * 32, w.Vm() + ((size_t)b * 6 + h) * KEYS * 64, KEYS, c2m, out + 640 + h * 64); }
        } else {
            const int v = u - nlat, slot = v % 12, b = v / 12;
            bf16_t* out = MIX + ((size_t)NL + (size_t)b * CTX) * 1024;
            if (slot < 6) attn_unit<64>(lds, w.Qgc() + ((size_t)b * 6 + slot) * CTX * 64, w.Kg() + ((size_t)b * 2 + slot / 3) * KEYS * 64, nullptr, w.Vg() + ((size_t)b * 2 + slot / 3) * KEYS * 64, CTX, c2g, out + slot * 64);
            else { const int h = slot - 6; attn_unit<96>(lds, w.Qmc() + ((size_t)b * 6 + h) * CTX * 96, w.Kmn() + ((size_t)b * 6 + h) * KEYS * 64, w.KR() + (size_t)b * KEYS * 32, w.Vm() + ((size_t)b * 6 + h) * KEYS * 64, CTX, c2m, out + 640 + h * 64); }
        }
    }
}

__device__ __forceinline__ unsigned fkey(float f, unsigned tag, unsigned mask) { unsigned u = __float_as_uint(f); u = (u & 0x80000000u) ? ~u : (u | 0x80000000u); return (u & ~mask) | tag; }
__device__ __forceinline__ float keyf(unsigned k, unsigned mask) { k &= ~mask; const unsigned u = (k & 0x80000000u) ? (k & 0x7fffffffu) : ~k; return __uint_as_float(u); }
__device__ __forceinline__ void ce_desc(unsigned& a, unsigned& b) { const unsigned hi_ = a > b ? a : b, lo_ = a > b ? b : a; a = hi_; b = lo_; }
template <int J, int K> __device__ __forceinline__ void bstage16(unsigned* a) {
#pragma unroll
    for (int i = 0; i < 16; ++i) { const int l = i ^ J; if (l > i) { const unsigned x = a[i], y = a[l]; const unsigned mx = x > y ? x : y, mn = x > y ? y : x; const bool desc = ((i & K) == 0); a[i] = desc ? mx : mn; a[l] = desc ? mn : mx; } }
}
__device__ __forceinline__ void sort16_desc(unsigned* a) {
    bstage16<1, 2>(a); bstage16<2, 4>(a); bstage16<1, 4>(a); bstage16<4, 8>(a); bstage16<2, 8>(a); bstage16<1, 8>(a); bstage16<8, 16>(a); bstage16<4, 16>(a); bstage16<2, 16>(a); bstage16<1, 16>(a);
}
__device__ __forceinline__ void bmerge16_desc(unsigned* c) { bstage16<8, 16>(c); bstage16<4, 16>(c); bstage16<2, 16>(c); bstage16<1, 16>(c); }
__device__ __forceinline__ void merge_top16(unsigned* a, const unsigned* b) {
#pragma unroll
    for (int i = 0; i < 16; ++i) a[i] = a[i] > b[15 - i] ? a[i] : b[15 - i];
    bmerge16_desc(a);
}
__device__ __forceinline__ void xlane_top16(unsigned* t, int hi) {
    unsigned r[16]; const unsigned msk = 0u - (unsigned)hi;
#pragma unroll
    for (int i = 0; i < 16; ++i) r[i] = t[i] ^ ((t[i] ^ t[15 - i]) & msk);
#pragma unroll
    for (int i = 0; i < 16; ++i) { auto s = __builtin_amdgcn_permlane32_swap(r[i], r[i], false, false); t[i] = s[0] > s[1] ? s[0] : s[1]; }
    bmerge16_desc(t);
}
__device__ __forceinline__ constexpr int cand_a(int c) { return c < 16 ? 0 : c < 24 ? 1 : c < 29 ? 2 : c < 33 ? 3 : c < 36 ? 4 : c < 38 ? 5 : c < 40 ? 6 : c < 42 ? 7 : c < 50 ? c - 34 : 0; }
__device__ __forceinline__ constexpr int cand_b(int c) { return c < 16 ? c : c < 24 ? c - 16 : c < 29 ? c - 24 : c < 33 ? c - 29 : c < 36 ? c - 33 : c < 38 ? c - 36 : c < 40 ? c - 38 : c < 42 ? c - 40 : 0; }

__device__ __forceinline__ void phase_p6b(LAS unsigned char* lds, const bf16_t* __restrict__ PQ, const bf16_t* __restrict__ SubKl, unsigned* __restrict__ EG, int nrows, int vb, int nvb) {
    int tid_ = threadIdx.x; asm volatile("" : "+v"(tid_));
    const int tid = tid_, lane = tid & 63, wid = __builtin_amdgcn_readfirstlane(tid >> 6), r32 = lane & 31, hi = lane >> 5;
    const int h = vb & 7, wrank = (vb >> 3) * 8 + wid, nwr = (nvb >> 3) * 8;
    LAS unsigned short* tab = (LAS unsigned short*)(lds + 65536 + wid * 4096) + r32 * 64;
#pragma unroll
    for (int i = 0; i < 8; ++i) { const int idx = i * 512 + tid, p = idx >> 11, key = (idx >> 4) & 127, ch = idx & 15;
        *(LAS u32x4*)(lds + p * 32768 + key * 256 + ((ch ^ (key & 15)) << 4)) = *(const u32x4*)(SubKl + ((size_t)(h * 2 + p) * 128 + key) * 128 + ch * 8); }
    __syncthreads();
    const int ngroups = nrows >> 5;
    for (int tg = wrank; tg < ngroups; tg += nwr) {
        const int row0 = tg << 5;
        bf16x8 qf[2][8];
        { const bf16_t* qp = PQ + (size_t)(row0 + r32) * 2048 + h * 256 + 8 * hi; asm volatile("" : "+v"(qp));
#pragma unroll
          for (int p = 0; p < 2; ++p)
#pragma unroll
              for (int s = 0; s < 8; ++s) qf[p][s] = *(const bf16x8*)(qp + p * 128 + 16 * s); }
        unsigned top[2][16];
#pragma unroll
        for (int p = 0; p < 2; ++p) {
            f32x16 acc[4];
#pragma unroll
            for (int kt = 0; kt < 4; ++kt) { acc[kt] = f32x16{}; const int key = 32 * kt + r32;
#pragma unroll
                for (int s = 0; s < 8; ++s) acc[kt] = mfma32(*(const LAS bf16x8*)(lds + p * 32768 + key * 256 + (((2 * s + hi) ^ (key & 15)) << 4)), qf[p][s], acc[kt]); }
            unsigned key[64];
#pragma unroll
            for (int kt = 0; kt < 4; ++kt)
#pragma unroll
                for (int r = 0; r < 16; ++r) { const int n = 32 * kt + (r & 3) + 8 * (r >> 2) + 4 * hi; key[16 * kt + r] = fkey(acc[kt][r], 127u - (unsigned)n, 127u); }
            sort16_desc(key); sort16_desc(key + 16); sort16_desc(key + 32); sort16_desc(key + 48);
            merge_top16(key, key + 16); merge_top16(key + 32, key + 48); merge_top16(key, key + 32);
            xlane_top16(key, hi);
#pragma unroll
            for (int i = 0; i < 16; ++i) top[p][i] = key[i];
        }
        unsigned ck[64];
#pragma unroll
        for (int c = 0; c < 64; ++c) {
            if (c < 50) { const float sm = keyf(top[0][cand_a(c)], 127u) + keyf(top[1][cand_b(c)], 127u); ck[c] = fkey(sm, (unsigned)c, 63u); } else ck[c] = 0u;
        }
        if (hi == 0) {
#pragma unroll
            for (int c = 0; c < 50; c += 2) {
                const unsigned ea = (127u - (top[0][cand_a(c)] & 127u)) * 128u + (127u - (top[1][cand_b(c)] & 127u));
                const unsigned eb = (127u - (top[0][cand_a(c + 1)] & 127u)) * 128u + (127u - (top[1][cand_b(c + 1)] & 127u));
                *(LAS unsigned*)(tab + c) = ea | (eb << 16);
            }
        }
        sort16_desc(ck); sort16_desc(ck + 16); sort16_desc(ck + 32); sort16_desc(ck + 48);
        merge_top16(ck, ck + 16); merge_top16(ck + 32, ck + 48); merge_top16(ck, ck + 32);
        asm volatile("s_waitcnt lgkmcnt(0)" ::: "memory");
        const float mx = keyf(ck[0], 63u); float e[16], den = 0.f;
#pragma unroll
        for (int j = 0; j < 16; ++j) { e[j] = __builtin_amdgcn_exp2f((keyf(ck[j], 63u) - mx) * 1.4426950408889634f); den += e[j]; }
        const float iden = 1.f / den;
        if (hi == 0) {
            unsigned o[16];
#pragma unroll
            for (int j = 0; j < 16; ++j) { const unsigned eid = tab[ck[j] & 63u]; o[j] = (eid << 16) | (cvt_pk_bf16(e[j] * iden, 0.f) & 0xffffu); }
            unsigned* dst = EG + (size_t)(row0 + r32) * 128 + h * 16;
#pragma unroll
            for (int j = 0; j < 16; j += 4) *(u32x4*)(dst + j) = (u32x4){o[j], o[j + 1], o[j + 2], o[j + 3]};
        }
        asm volatile("s_waitcnt lgkmcnt(0)" ::: "memory");
    }
}


#define XB_TMO      128
#define XB_XCNT(j)  (256  + 64 * (j))
#define XB_XSUB(j)  (1280 + 64 * (j))
#define XB_XGEN(j)  (2304 + 64 * (j))
#define XB_TOP      3328
#define XB_TOPGEN   3392
#define XCD_BAR_WORDS 3456
#define XB_SPIN_CAP (1u << 18)

__device__ __forceinline__ unsigned xb_ld(unsigned* p)              { return __hip_atomic_load(p, __ATOMIC_RELAXED, __HIP_MEMORY_SCOPE_AGENT); }
__device__ __forceinline__ unsigned xb_add(unsigned* p, unsigned v) { return __hip_atomic_fetch_add(p, v, __ATOMIC_RELAXED, __HIP_MEMORY_SCOPE_AGENT); }
__device__ __forceinline__ unsigned xb_xcc_id() { return (unsigned)__builtin_amdgcn_s_getreg((3 << 11) | 20) & 0xFu; }
#define XB_SPIN(cond, bar) do { unsigned _sp = 0; while (cond) { __builtin_amdgcn_s_sleep(1); \
    if ((++_sp & 255u) == 0u) { if (xb_ld(&(bar)[XB_TMO])) break; if (_sp > XB_SPIN_CAP) { atomicAdd(&(bar)[XB_TMO], 1u); break; } } } } while (0)

struct XcdBarrier {
    unsigned* bar; unsigned x;
    volatile LAS unsigned* st;
};

__device__ __forceinline__ XcdBarrier xcd_barrier_post(unsigned* bar, volatile LAS unsigned* st) {
    XcdBarrier b; b.bar = bar; b.x = xb_xcc_id(); b.st = st;
    if (threadIdx.x == 0) (void)xb_add(&bar[XB_XCNT(b.x)], 1u);
    return b;
}
__device__ __forceinline__ void xcd_barrier_complete(unsigned* bar, unsigned x, unsigned& nloc, unsigned& nx) {
    const unsigned G = gridDim.x * gridDim.y * gridDim.z;
    unsigned sum, cnt, mine, sp = 0u;
    for (;;) {
        sum = 0u; cnt = 0u; mine = 0u;
#pragma unroll
        for (unsigned j = 0; j < 16; ++j) { const unsigned c = xb_ld(&bar[XB_XCNT(j)]); sum += c; cnt += (c > 0u) ? 1u : 0u; mine = (j == x) ? c : mine; }
        if (sum == G) break;
        __builtin_amdgcn_s_sleep(1);
        if ((++sp & 255u) == 0u) { if (xb_ld(&bar[XB_TMO])) break; if (sp > XB_SPIN_CAP) { atomicAdd(&bar[XB_TMO], 1u); break; } }
    }
    nloc = mine > 0u ? mine : 1u; nx = cnt > 0u ? cnt : 1u;
}

__device__ __forceinline__ void xcd_barrier(const XcdBarrier& b) {
    asm volatile("s_waitcnt vmcnt(0)" ::: "memory");
    __syncthreads();
    if (threadIdx.x == 0) {
        unsigned* bar = b.bar;
        __builtin_amdgcn_s_waitcnt(0);
        unsigned nloc = b.st[0], nx = b.st[1];
        if (nloc == 0u) { xcd_barrier_complete(bar, b.x, nloc, nx); b.st[0] = nloc; b.st[1] = nx; }
        const unsigned old = xb_add(&bar[XB_XSUB(b.x)], 1u);
        const unsigned gen = old / nloc;
        if (old + 1u == (gen + 1u) * nloc) {
            __builtin_amdgcn_fence(__ATOMIC_RELEASE, "agent");
            asm volatile("s_waitcnt vmcnt(0)" ::: "memory");
            const unsigned og = xb_add(&bar[XB_TOP], 1u);
            const unsigned tg = og / nx;
            if (og + 1u == (tg + 1u) * nx) xb_add(&bar[XB_TOPGEN], 1u);
            else XB_SPIN(xb_ld(&bar[XB_TOPGEN]) == tg, bar);
            __builtin_amdgcn_fence(__ATOMIC_ACQUIRE, "agent");
            xb_add(&bar[XB_XGEN(b.x)], 1u);
            asm volatile("s_waitcnt vmcnt(0)" ::: "memory");
        } else {
            XB_SPIN(xb_ld(&bar[XB_XGEN(b.x)]) == gen, bar);
            __builtin_amdgcn_fence(__ATOMIC_ACQUIRE, "agent");
            asm volatile("s_waitcnt vmcnt(0)" ::: "memory");
        }
    }
    __syncthreads();
}

__device__ __forceinline__ void phase_mod(LAS unsigned char* lds, const Inputs& in, const WS& w, int vb) {
    if (vb >= 72) return;
    LAS float* sc = (LAS float*)lds;
    int tid_ = threadIdx.x; asm volatile("" : "+v"(tid_));
    const int tid = tid_, idx = vb * 512 + tid, rg = idx / 12288, ln = idx % 12288, l = ln / 6144, n = ln % 6144;
    float acc[11];
#pragma unroll
    for (int i = 0; i < 11; ++i) acc[i] = 0.f;
    const float* wp = in.ada_w + (size_t)l * 1024 * 6144 + n;
    for (int kc = 0; kc < 4; ++kc) {
        for (int i = tid; i < 33 * 256; i += 512) { const int r = i >> 8, k = kc * 256 + (i & 255); const float v = r < 32 ? in.c[(size_t)r * 1024 + k] : in.c_ctx[k]; sc[i] = v / (1.f + __expf(-v)); }
        __syncthreads();
        for (int k = 0; k < 256; ++k) { const float wv = wp[(size_t)(kc * 256 + k) * 6144];
#pragma unroll
            for (int i = 0; i < 11; ++i) acc[i] += sc[(rg * 11 + i) * 256 + k] * wv; }
        __syncthreads();
    }
    const float bias = in.ada_b[(size_t)l * 6144 + n];
#pragma unroll
    for (int i = 0; i < 11; ++i) w.MOD()[((size_t)l * 33 + rg * 11 + i) * 6144 + n] = acc[i] + bias;
}
__device__ __forceinline__ void phase_rope(const WS& w, int vb, int nvb) {
    int tid_ = threadIdx.x; asm volatile("" : "+v"(tid_));
    for (int i = vb * 512 + tid_; i < 2048 * 32; i += nvb * 512) {
        { const int t = i / 32, j = i % 32; const double inv = pow(10000.0, -(double)(j % 16) / 16.0); const double a = (double)(j < 16 ? t / 64 : t % 64) * inv; w.ROPA()[i] = make_float2((float)cos(a), (float)sin(a)); }
        if (i < 2048 * 16) { const int t = i / 16, j = i % 16; const double inv = pow(10000.0, -(double)(j % 8) / 8.0); const double a = (double)(j < 8 ? t / 64 : t % 64) * inv; w.ROPC()[i] = make_float2((float)cos(a), (float)sin(a)); }
    }
}

#ifndef PROBE_MASK
#define PROBE_MASK 0
#endif
struct MegaArgs { Inputs in; WS w; float* XL; unsigned* bar; };
constexpr int MEGA_LDS = 131072 + 16;
__global__ void __launch_bounds__(512, 2) k_mega(MegaArgs A) {
    LAS unsigned char* lds = (LAS unsigned char*)dyn_lds;
    const int vb = blockIdx.x, nvb = gridDim.x;
    volatile LAS unsigned* xbw = (volatile LAS unsigned*)(lds + 131072);
    if (threadIdx.x == 0) { xbw[0] = 0u; xbw[1] = 0u; xbw[2] = 0u; xbw[3] = 0u; }
    __syncthreads();
    XcdBarrier bar = xcd_barrier_post(A.bar, xbw);
    if (threadIdx.x == 0) xbw[2] = xb_add(&A.bar[3584 + 64 * bar.x], 1u);
    __syncthreads();
    const int xticket = __builtin_amdgcn_readfirstlane((int)xbw[2]);
    const WS& w = A.w; const Inputs& in = A.in;
    phase_mod(lds, in, w, vb);
    phase_rope(w, vb, nvb);
    phase_cvt(lds, in, w, vb, nvb);
    xcd_barrier(bar);
    phase_modulate(in.x, in.ctx, w.H(), in.norm1_g, w.MOD(), 0, NR, vb, nvb);
    xcd_barrier(bar);
#if (PROBE_MASK >> 0) & 1
    phase_mod(lds, in, w, vb);
    phase_rope(w, vb, nvb);
    phase_cvt(lds, in, w, vb, nvb);
    xcd_barrier(bar);
    phase_modulate(in.x, in.ctx, w.H(), in.norm1_g, w.MOD(), 0, NR, vb, nvb);
    xcd_barrier(bar);
#endif
    int xpart = vb & 7, xrank = vb >> 3;
    { bool okx = (bar.x < 8u); for (unsigned j = 0; j < 8; ++j) okx = okx && (xb_ld(&A.bar[XB_XCNT(j)]) == (unsigned)(nvb >> 3));
      if (okx) { xpart = (int)bar.x; xrank = xticket; } }
    for (int l = 0; l < DEPTH; ++l) {
        const float* MODl = w.MOD() + (size_t)l * 33 * 6144;
        const bool last = (l == DEPTH - 1);
        const int MR = last ? NL : NR;
        phase_p1(lds, w, in, l, vb, nvb); xcd_barrier(bar);
#if (PROBE_MASK >> 1) & 1
        phase_p1(lds, w, in, l, vb, nvb); xcd_barrier(bar);
#endif
        phase_p2(lds, w, in, l, vb, nvb); xcd_barrier(bar);
#if (PROBE_MASK >> 12) & 7
        phase_p2(lds, w, in, l, vb, nvb, (PROBE_MASK >> 12) & 7); xcd_barrier(bar);
#endif
        phase_p3(lds, w, l, vb, nvb); xcd_barrier(bar);
#if (PROBE_MASK >> 3) & 1
        phase_p3(lds, w, l, vb, nvb); xcd_barrier(bar);
#endif
        phase_p4(lds, w, in, l, vb, nvb);
        xcd_barrier(bar);
#if (PROBE_MASK >> 4) & 1
        phase_p4(lds, w, in, l, vb, nvb);
        xcd_barrier(bar);
#endif
        phase_modulate(l == 0 ? in.x : A.XL, l == 0 ? in.ctx : w.XC(), w.H(), in.norm2_g + l * 1024, MODl, 3, MR, vb, nvb, w.H8(), w.HS(), w.PQ(), A.XL, w.XC()); xcd_barrier(bar);
#if (PROBE_MASK >> 5) & 1
        phase_modulate(A.XL, w.XC(), w.H(), in.norm2_g + l * 1024, MODl, 3, MR, vb, nvb, w.H8(), w.HS()); xcd_barrier(bar);
#endif
        phase_p6a(lds, w, l, vb, nvb); xcd_barrier(bar);
#if (PROBE_MASK >> 6) & 1
        phase_p6a(lds, w, l, vb, nvb); xcd_barrier(bar);
#endif
        phase_p6b(lds, w.PQ(), w.SubK() + (size_t)l * 16 * 128 * 128, w.EG(), MR, vb, nvb); xcd_barrier(bar);
#if (PROBE_MASK >> 7) & 1
        phase_p6b(lds, w.PQ(), w.SubK() + (size_t)l * 16 * 128 * 128, w.EG(), MR, vb, nvb); xcd_barrier(bar);
#endif
        { P7CArgs a{w.H8(), w.EG(), w.U8() + (size_t)l * NE * 1024, (int*)w.PQ(), MR}; phase_p7c(lds, a, xpart, xrank, nvb); }
        xcd_barrier(bar);
#if (PROBE_MASK >> 8) & 1
        { P7CArgs a{w.H8(), w.EG(), w.U8() + (size_t)l * NE * 1024, (int*)w.PQ(), MR}; phase_p7c(lds, a, xpart, xrank, nvb); }
        xcd_barrier(bar);
#endif
        phase_p7d((const int*)w.PQ(), w.EG(), w.US() + (size_t)l * NE, w.VS() + (size_t)l * NE, w.HS(), w.WE(), MR, vb, nvb);
        xcd_barrier(bar);
#if (PROBE_MASK >> 9) & 1
        phase_p7d((const int*)w.PQ(), w.EG(), w.US() + (size_t)l * NE, w.VS() + (size_t)l * NE, w.HS(), w.WE(), MR, vb, nvb);
        xcd_barrier(bar);
#endif
        { P7BArgs a{w.WE(), w.V8() + (size_t)l * NE * 1024, A.XL, w.XC(), MODl + 5 * 1024, MR}; phase_p7b<0>(lds, a, xpart, xrank, nvb); }
        xcd_barrier(bar);
#if (PROBE_MASK >> 10) & 3
        { P7BArgs a{w.WE(), w.V8() + (size_t)l * NE * 1024, A.XL, w.XC(), MODl + 5 * 1024, MR}; phase_p7b<((PROBE_MASK >> 10) & 3)>(lds, a, xpart, xrank, nvb); }
        xcd_barrier(bar);
#endif
        if (last) phase_final_norm(A.XL, in.final_g, vb, nvb);
        else phase_modulate(A.XL, w.XC(), w.H(), in.norm1_g + (l + 1) * 1024, w.MOD() + (size_t)(l + 1) * 33 * 6144, 0, NR, vb, nvb);
        if (!last) xcd_barrier(bar);
    }
}

extern "C" void kernel_launch(void* const* d_in, const int* in_sizes, int n_in, void* d_out, int out_size, void* d_ws, size_t ws_size, hipStream_t stream) {
    const float* const* fin = (const float* const*)d_in;
    Inputs in{fin[0], fin[1], fin[2], fin[3], fin[4], fin[5], fin[6], fin[7], fin[8], fin[9], fin[10], fin[11], fin[12], fin[13], fin[14], fin[15], fin[16], fin[17], fin[18], fin[19], fin[20], fin[21], fin[22]};
    WS w = make_ws(d_ws);
    static int ok = 0;
    if (!ok) {
        if (hipFuncSetAttribute((const void*)k_mega, hipFuncAttributeMaxDynamicSharedMemorySize, MEGA_LDS) != hipSuccess) { ok = -1; }
        int per_cu = 0, cus = 0, dev = 0; (void)hipGetDevice(&dev); (void)hipDeviceGetAttribute(&cus, hipDeviceAttributeMultiprocessorCount, dev);
        if (hipOccupancyMaxActiveBlocksPerMultiprocessor(&per_cu, (const void*)k_mega, 512, MEGA_LDS) != hipSuccess || per_cu < 1 || cus < 256) ok = -1;
        if (ok == 0) ok = 1;
    }
    if (ok < 0) return;
    (void)hipMemsetAsync(d_ws, 0, 16384, stream);
    MegaArgs A{in, w, (float*)d_out, (unsigned*)d_ws};
    k_mega<<<256, 512, MEGA_LDS, stream>>>(A);
}
```

```cpp
#include <hip/hip_runtime.h>
#include <stdint.h>

typedef unsigned short bf16_t;

constexpr int D = 1024, NB = 32, S = 2048, CTX = 256, DEPTH = 2;
constexpr int NL = NB * S, NC = NB * CTX, NR = NL + NC;
constexpr int KEYS = CTX + S;
constexpr int INC = 1568;
constexpr int NE = 16384;
constexpr float EPS = 1e-6f;

__device__ __forceinline__ float bf2f(bf16_t v) { return __uint_as_float(((unsigned)v) << 16); }
__device__ __forceinline__ bf16_t f2bf(float f) { unsigned u = __float_as_uint(f); u += 0x7FFFu + ((u >> 16) & 1u); return (bf16_t)(u >> 16); }

__device__ __forceinline__ float wave_sum(float v) {
#pragma unroll
    for (int o = 32; o > 0; o >>= 1) v += __shfl_xor(v, o);
    return v;
}
__device__ __forceinline__ float gelu_tanh(float x) {
    const float u = 0.7978845608028654f * (x + 0.044715f * x * x * x);
    return 0.5f * x * (1.f + tanhf(u));
}

struct WS {
    char* base;
    __host__ __device__ __forceinline__ bf16_t* H() const { return (bf16_t*)(base + 65536ull); }
    __host__ __device__ __forceinline__ bf16_t* Qg() const { return (bf16_t*)(base + 151060480ull); }
    __host__ __device__ __forceinline__ bf16_t* Qgc() const { return (bf16_t*)(base + 201392128ull); }
    __host__ __device__ __forceinline__ bf16_t* Kg() const { return (bf16_t*)(base + 207683584ull); }
    __host__ __device__ __forceinline__ bf16_t* Vg() const { return (bf16_t*)(base + 226557952ull); }
    __host__ __device__ __forceinline__ bf16_t* CQ() const { return (bf16_t*)(base + 245432320ull); }
    __host__ __device__ __forceinline__ bf16_t* CKV() const { return (bf16_t*)(base + 302055424ull); }
    __host__ __device__ __forceinline__ bf16_t* Bp() const { return (bf16_t*)(base + 339804160ull); }
    __host__ __device__ __forceinline__ bf16_t* KR() const { return (bf16_t*)(base + 377552896ull); }
    __host__ __device__ __forceinline__ bf16_t* Qm() const { return (bf16_t*)(base + 382271488ull); }
    __host__ __device__ __forceinline__ bf16_t* Qmc() const { return (bf16_t*)(base + 457768960ull); }
    __host__ __device__ __forceinline__ bf16_t* Kmn() const { return (bf16_t*)(base + 467206144ull); }
    __host__ __device__ __forceinline__ bf16_t* Vm() const { return (bf16_t*)(base + 523829248ull); }
    __host__ __device__ __forceinline__ unsigned* EG() const { return (unsigned*)(base + 580452352ull); }
    __host__ __device__ __forceinline__ bf16_t* P() const { return (bf16_t*)(base + 382271488ull); }
    __host__ __device__ __forceinline__ bf16_t* PQ() const { return (bf16_t*)(base + 151060480ull); }
    __host__ __device__ __forceinline__ bf16_t* TMP() const { return (bf16_t*)(base + 65536ull); }
    __host__ __device__ __forceinline__ float* XC() const { return (float*)(base + 618201088ull); }
    __host__ __device__ __forceinline__ float* MOD() const { return (float*)(base + 651755520ull); }
    __host__ __device__ __forceinline__ float2* ROPA() const { return (float2*)(base + 653377536ull); }
    __host__ __device__ __forceinline__ float2* ROPC() const { return (float2*)(base + 653901824ull); }
    __host__ __device__ __forceinline__ float* RSQ() const { return (float*)(base + 654163968ull); }
    __host__ __device__ __forceinline__ float* RSKV() const { return (float*)(base + 654458880ull); }
    __host__ __device__ __forceinline__ bf16_t* WinT() const { return (bf16_t*)(base + 654753792ull); }
    __host__ __device__ __forceinline__ bf16_t* WuqT() const { return (bf16_t*)(base + 662093824ull); }
    __host__ __device__ __forceinline__ bf16_t* WukvT() const { return (bf16_t*)(base + 663273472ull); }
    __host__ __device__ __forceinline__ bf16_t* WoutT() const { return (bf16_t*)(base + 664059904ull); }
    __host__ __device__ __forceinline__ bf16_t* WqT() const { return (bf16_t*)(base + 668254208ull); }
    __host__ __device__ __forceinline__ bf16_t* SubK() const { return (bf16_t*)(base + 676642816ull); }
    __host__ __device__ __forceinline__ unsigned char* U8() const { return (unsigned char*)(base + 677691392ull); }
    __host__ __device__ __forceinline__ unsigned char* V8() const { return (unsigned char*)(base + 711245824ull); }
    __host__ __device__ __forceinline__ float* US() const { return (float*)(base + 744800256ull); }
    __host__ __device__ __forceinline__ float* VS() const { return (float*)(base + 744931328ull); }
    __host__ __device__ __forceinline__ float* SSQ() const { return (float*)(base + 745062400ull); }
    __host__ __device__ __forceinline__ float* SSKV() const { return (float*)(base + 747421696ull); }
    __host__ __device__ __forceinline__ unsigned* WE() const { return (unsigned*)(base + 748601344ull); }
    __host__ __device__ __forceinline__ signed char* H8() const { return (signed char*)(base + 786350080ull); }
    __host__ __device__ __forceinline__ float* HS() const { return (float*)(base + 861847552ull); }
    __host__ __device__ __forceinline__ bf16_t* PoolWT() const { return (bf16_t*)(base + 862142464ull); }
};
constexpr size_t WS_BYTES = 862208000ull;
static WS make_ws(void* d_ws) { WS w; w.base = (char*)d_ws; return w; }


#define LAS __attribute__((address_space(3)))
typedef short bf16x8 __attribute__((ext_vector_type(8)));
typedef float f32x4 __attribute__((ext_vector_type(4)));
typedef float f32x16 __attribute__((ext_vector_type(16)));
typedef unsigned u32x4 __attribute__((ext_vector_type(4)));
typedef unsigned u32x2 __attribute__((ext_vector_type(2)));

__device__ __forceinline__ f32x16 mfma32(bf16x8 a, bf16x8 b, f32x16 c) { return __builtin_amdgcn_mfma_f32_32x32x16_bf16(a, b, c, 0, 0, 0); }
__device__ __forceinline__ unsigned cvt_pk_bf16(float lo, float hi) { unsigned r; asm volatile("v_cvt_pk_bf16_f32 %0, %1, %2" : "=v"(r) : "v"(lo), "v"(hi)); return r; }

namespace pg8 {
constexpr int BM = 256, BK = 64, HALF = 128, HTB = HALF * BK * 2, STAGE_BYTES = 8 * HTB, NXCD = 8, WGM = 8;
__host__ __device__ __forceinline__ int lds_byte(int r, int c) { const int st = (r >> 4) * 2 + (c >> 5), rr = r & 15, cc = c & 31, ob = rr * 64 + cc * 2; return st * 1024 + (ob ^ (((ob >> 9) & 1) << 5)); }
__host__ __device__ __forceinline__ void stage_rc(int b, int& R, int& C) { const int st = b / 1024, sb = b % 1024, swz = sb ^ (((sb >> 9) & 1) << 5); R = (st >> 1) * 16 + swz / 64; C = (st & 1) * 32 + (swz % 64) / 2; }
__host__ __device__ __forceinline__ int perm32(int rho) { const int n = rho >> 4, i = rho & 15; return 8 * (i >> 2) + 4 * n + (i & 3); }
struct Unit { int pm, pn; };
struct Gemm { const bf16_t* A; const bf16_t* Bt; int M, N, K; };
struct StaticOrder {
    int nM, nN, nwg, G, c;
    __host__ __device__ void init(int M, int N, int G_, int c_) { nM = M / BM; nN = N / BM; nwg = nM * nN; G = G_; c = c_; }
    __host__ __device__ bool next(int i, Unit& u) const {
        const long L = (long)i * G + c; if (L >= nwg) return false;
        int wgid = (int)L; { const int q = nwg / NXCD, r = nwg % NXCD, xcd = wgid % NXCD, off = wgid / NXCD; wgid = (xcd < r ? xcd * (q + 1) : r * (q + 1) + (xcd - r) * q) + off; }
        const int nig = WGM * nN, gid = wgid / nig, fm = gid * WGM, gsz = (nM - fm) < WGM ? (nM - fm) : WGM;
        u.pm = fm + ((wgid % nig) % gsz); u.pn = (wgid % nig) / gsz; return true;
    }
};
template <class Epi, class Sched>
__device__ __forceinline__ void gemm_phase(LAS unsigned char* lds, const Gemm g, const Sched& S, const Epi& E) {
    int tid_ = threadIdx.x; asm volatile("" : "+v"(tid_));
    const int tid = tid_, wid = __builtin_amdgcn_readfirstlane(tid >> 6), lane = tid & 63, wr = wid >> 2, wc = wid & 3, fr = lane & 15, fq = lane >> 4;
    const int K = g.K, nt = K / BK;
    unsigned voffA[2], voffB[2];
#pragma unroll
    for (int i = 0; i < 2; ++i) { int R, C; stage_rc(tid * 16 + i * 8192, R, C); const int Rb = Epi::PERM ? ((R & ~31) + perm32(R & 31)) : R;
        voffA[i] = (unsigned)(R * K + C) * 2u; voffB[i] = (unsigned)(Rb * K + C) * 2u; }
    const size_t kstep = (size_t)(BK * 2);
    const size_t hstep = (size_t)HALF * K * 2;
    const size_t tstep = 2 * hstep;
    const unsigned ldsw = (unsigned)wid * 1024u;
    const int aoff = lds_byte(wr * 64 + fr, fq * 8), boff = lds_byte(wc * 32 + fr, fq * 8);
#define PG8_SA(b, h) (((b) * 2 + (h)) * HTB)
#define PG8_SB(b, h) ((4 + (b) * 2 + (h)) * HTB)
#define PG8_STAGE(bufoff, gbase, voff) do { _Pragma("unroll") for (int _i = 0; _i < 2; ++_i) \
        __builtin_amdgcn_global_load_lds((const unsigned*)((const char*)(gbase) + (voff)[_i]), (LAS unsigned*)(lds + (bufoff) + ldsw + _i * 8192), 16, 0, 0); } while (0)
#define PG8_LDA(dst, b, h) do { _Pragma("unroll") for (int m = 0; m < 4; ++m) _Pragma("unroll") for (int k = 0; k < 2; ++k) dst[m][k] = *(const LAS bf16x8*)(lds + PG8_SA(b, h) + aoff + m * 2048 + k * 1024); } while (0)
#define PG8_LDB(dst, b, h) do { _Pragma("unroll") for (int n = 0; n < 2; ++n) _Pragma("unroll") for (int k = 0; k < 2; ++k) dst[n][k] = *(const LAS bf16x8*)(lds + PG8_SB(b, h) + boff + n * 2048 + k * 1024); } while (0)
#define PG8_MMA(ai, bj, At, Bt) do { __builtin_amdgcn_s_setprio(1); _Pragma("unroll") for (int m = 0; m < 4; ++m) _Pragma("unroll") for (int n = 0; n < 2; ++n) _Pragma("unroll") for (int k = 0; k < 2; ++k) \
        acc[ai][bj][m][n] = __builtin_amdgcn_mfma_f32_16x16x32_bf16(Bt[n][k], At[m][k], acc[ai][bj][m][n], 0, 0, 0); __builtin_amdgcn_s_setprio(0); } while (0)
#define PG8_WAIT_V(n) asm volatile("s_waitcnt vmcnt(" #n ")" ::: "memory")
#define PG8_WAIT_L(n) asm volatile("s_waitcnt lgkmcnt(" #n ")" ::: "memory")
#define PG8_BAR __builtin_amdgcn_s_barrier()
#define PG8_SCHED __builtin_amdgcn_sched_barrier(0)
    Unit cur, nxt; int ui = 0;
    if (!S.next(0, cur)) return;
    f32x4 acc[2][2][4][2];
#pragma unroll
    for (int a = 0; a < 2; ++a)
#pragma unroll
        for (int b = 0; b < 2; ++b)
#pragma unroll
            for (int m = 0; m < 4; ++m)
#pragma unroll
                for (int n = 0; n < 2; ++n) acc[a][b][m][n] = (f32x4){0.f, 0.f, 0.f, 0.f};
    bf16x8 At[4][2], B0[2][2], B1[2][2];
    const char* cA = (const char*)g.A + (size_t)cur.pm * tstep; const char* cB = (const char*)g.Bt + (size_t)cur.pn * tstep;
    PG8_STAGE(PG8_SB(0, 0), cB, voffB); PG8_STAGE(PG8_SA(0, 0), cA, voffA); PG8_STAGE(PG8_SB(0, 1), cB + hstep, voffB); PG8_STAGE(PG8_SA(0, 1), cA + hstep, voffA);
    if (wr == 1) PG8_BAR;
    PG8_WAIT_V(4); PG8_BAR;
    PG8_STAGE(PG8_SB(1, 0), cB + kstep, voffB); PG8_STAGE(PG8_SA(1, 0), cA + kstep, voffA); PG8_STAGE(PG8_SB(1, 1), cB + hstep + kstep, voffB);
    PG8_WAIT_V(6); PG8_BAR;
    for (;;) {
        const bool has_next = S.next(ui + 1, nxt);
        const char* nA = has_next ? (const char*)g.A + (size_t)nxt.pm * tstep : cA; const char* nB = has_next ? (const char*)g.Bt + (size_t)nxt.pn * tstep : cB;
#pragma nounroll
        for (int t = 0; t < nt; t += 2) {
            const bool last = (t == nt - 2);
            const char* a1 = cA + (size_t)(t + 1) * kstep;
            const char* a2 = last ? nA : cA + (size_t)(t + 2) * kstep; const char* b2 = last ? nB : cB + (size_t)(t + 2) * kstep;
            const char* a3 = a2 + kstep; const char* b3 = b2 + kstep;
            PG8_LDB(B0, 0, 0); PG8_SCHED; PG8_LDA(At, 0, 0); PG8_STAGE(PG8_SA(1, 1), a1 + hstep, voffA);
            PG8_WAIT_L(8); PG8_BAR; PG8_WAIT_L(0); PG8_MMA(0, 0, At, B0); PG8_BAR; PG8_SCHED;
            PG8_LDB(B1, 0, 1); PG8_STAGE(PG8_SB(0, 0), b2, voffB);
            PG8_BAR; PG8_WAIT_L(0); PG8_MMA(0, 1, At, B1); PG8_BAR;
            PG8_LDA(At, 0, 1); PG8_STAGE(PG8_SA(0, 0), a2, voffA);
            PG8_BAR; PG8_WAIT_L(0); PG8_MMA(1, 0, At, B0); PG8_BAR; PG8_SCHED;
            PG8_STAGE(PG8_SB(0, 1), b2 + hstep, voffB);
            PG8_WAIT_V(6); PG8_BAR; PG8_MMA(1, 1, At, B1); PG8_BAR;
            PG8_LDB(B0, 1, 0); PG8_SCHED; PG8_LDA(At, 1, 0); PG8_STAGE(PG8_SA(0, 1), a2 + hstep, voffA);
            PG8_WAIT_L(8); PG8_BAR; PG8_WAIT_L(0); PG8_MMA(0, 0, At, B0); PG8_BAR; PG8_SCHED;
            PG8_LDB(B1, 1, 1); PG8_STAGE(PG8_SB(1, 0), b3, voffB);
            PG8_BAR; PG8_WAIT_L(0); PG8_MMA(0, 1, At, B1); PG8_BAR;
            PG8_LDA(At, 1, 1); PG8_STAGE(PG8_SA(1, 0), a3, voffA);
            PG8_BAR; PG8_WAIT_L(0); PG8_MMA(1, 0, At, B0); PG8_BAR; PG8_SCHED;
            PG8_STAGE(PG8_SB(1, 1), b3 + hstep, voffB);
            PG8_WAIT_V(6); PG8_BAR; PG8_MMA(1, 1, At, B1); PG8_BAR;
        }
        E(acc, cur, wr, wc, fr, fq);
        if (!has_next) break;
#pragma unroll
        for (int a = 0; a < 2; ++a)
#pragma unroll
            for (int b = 0; b < 2; ++b)
#pragma unroll
                for (int m = 0; m < 4; ++m)
#pragma unroll
                    for (int n = 0; n < 2; ++n) acc[a][b][m][n] = (f32x4){0.f, 0.f, 0.f, 0.f};
        cur = nxt; cA = nA; cB = nB; ++ui;
    }
    PG8_WAIT_V(0);
    if (wr == 0) PG8_BAR;
    PG8_BAR;
#undef PG8_SA
#undef PG8_SB
#undef PG8_STAGE
#undef PG8_LDA
#undef PG8_LDB
#undef PG8_MMA
#undef PG8_WAIT_V
#undef PG8_WAIT_L
#undef PG8_BAR
#undef PG8_SCHED
}
}

enum { GT_AQ = 0, GT_AK = 1, GT_AV = 2, GT_B = 3, GT_CQ = 4, GT_CKV = 5, GT_KR = 6, GT_PAD = 7 };
__host__ __device__ __forceinline__ void in_group(int g, int& type, int& sub) {
    if (g < 2) { type = GT_AK; sub = g; } else if (g < 4) { type = GT_AV; sub = g - 2; } else if (g < 8) { type = GT_CKV; sub = g - 4; }
    else if (g == 8) { type = GT_KR; sub = 0; } else if (g < 12) { type = GT_PAD; sub = 0; } else if (g < 18) { type = GT_AQ; sub = g - 12; }
    else if (g < 24) { type = GT_CQ; sub = g - 18; } else { type = GT_B; sub = g - 24; }
}
__device__ __forceinline__ int colmap(int mode, int r) {
    const int pn = r >> 8, ct = r & 255, bj = ct >> 7, wc = (ct >> 5) & 3, j = ct & 31, g = 4 * pn + wc, e = 32 * bj + j;
    if (mode == 0) {
        int type, sub; in_group(g, type, sub);
        switch (type) { case GT_AQ: return 64 * sub + e; case GT_AK: return 384 + 64 * sub + e; case GT_AV: return 512 + 64 * sub + e; case GT_B: return 640 + 64 * sub + e;
            case GT_CQ: return 896 + 64 * sub + e; case GT_CKV: return 1280 + 64 * sub + e; case GT_KR: return (j < 16) ? 1536 + 16 * bj + j : -1; default: return -1; }
    } else if (mode == 1) {
        if (g < 6) return 96 * g + e; if (g < 9) { const int head = 2 * (g - 6) + (j >> 4); return 96 * head + 64 + 16 * bj + (j & 15); } return -1;
    } else if (mode == 2) {
        return 64 * g + e;
    }
    return r;
}
__device__ __forceinline__ void cvt_weights_unit(LAS float* tile  , const float* __restrict__ W, int K, int N, bf16_t* __restrict__ dst, int mode, const float* __restrict__ kgain, int r0, int k0) {
    int tid_ = threadIdx.x; asm volatile("" : "+v"(tid_));
    const int tid = tid_;
    const int jj = tid & 63; const int sc = colmap(mode, r0 + jj);
#pragma unroll
    for (int i = 0; i < 8; ++i) { const int kk = (tid >> 6) + 8 * i; float v = 0.f; if (sc >= 0) v = W[(size_t)(k0 + kk) * N + sc]; if (kgain) v *= kgain[k0 + kk]; tile[kk * 65 + jj] = v; }
    __syncthreads();
#pragma unroll
    for (int i = 0; i < 8; ++i) { const int rr = (tid >> 6) + 8 * i, kk = tid & 63; dst[(size_t)(r0 + rr) * K + k0 + kk] = f2bf(tile[kk * 65 + rr]); }
    __syncthreads();
}
struct CvtJob { const float* W; bf16_t* dst; const float* kgain; int K, N, Npad, mode; };
__device__ __forceinline__ void cvt_job(LAS float* tile, const CvtJob j, int vb, int nvb) {
    const int nk = j.K / 64, nr = j.Npad / 64;
    for (int u = vb; u < nk * nr; u += nvb) cvt_weights_unit(tile, j.W, j.K, j.N, j.dst, j.mode, j.kgain, (u / nk) * 64, (u % nk) * 64);
}
__device__ __forceinline__ void cvt_flat(const float* __restrict__ src, bf16_t* __restrict__ dst, size_t n, int vb, int nvb) {
    int tid_ = threadIdx.x; asm volatile("" : "+v"(tid_));
    for (size_t i = ((size_t)vb * 512 + tid_) * 8; i < n; i += (size_t)nvb * 512 * 8) {
        const float4 a = *(const float4*)(src + i), b = *(const float4*)(src + i + 4);
        u32x4 o; o.x = cvt_pk_bf16(a.x, a.y); o.y = cvt_pk_bf16(a.z, a.w); o.z = cvt_pk_bf16(b.x, b.y); o.w = cvt_pk_bf16(b.z, b.w);
        *(u32x4*)(dst + i) = o;
    }
}
template <bool FP8>
__device__ __forceinline__ void cvt_q8_rows(const float* __restrict__ src, unsigned char* __restrict__ dst, float* __restrict__ scales, int nrows, int vb, int nvb) {
    int tid_ = threadIdx.x; asm volatile("" : "+v"(tid_));
    const int lane = tid_ & 63, wid = tid_ >> 6;
    const int stride = nvb * 8;
    for (int row0 = vb * 8 + wid; row0 < nrows; row0 += 4 * stride) {
        f32x4 v[4][4];
#pragma unroll
        for (int q = 0; q < 4; ++q) { const int row = row0 + q * stride < nrows ? row0 + q * stride : row0; const float* sp = src + (size_t)row * 1024 + 16 * lane;
#pragma unroll
            for (int k = 0; k < 4; ++k) v[q][k] = *(const f32x4*)(sp + 4 * k); }
#pragma unroll
        for (int q = 0; q < 4; ++q) { const int row = row0 + q * stride; if (row < nrows) {
            float am = 0.f;
#pragma unroll
            for (int k = 0; k < 4; ++k) am = fmaxf(am, fmaxf(fmaxf(fabsf(v[q][k][0]), fabsf(v[q][k][1])), fmaxf(fabsf(v[q][k][2]), fabsf(v[q][k][3]))));
#pragma unroll
            for (int o = 32; o > 0; o >>= 1) am = fmaxf(am, __shfl_xor(am, o));
            const float qmax = FP8 ? 416.f : 127.f;
            const float sc = am > 0.f ? am / qmax : 1.f, inv = am > 0.f ? qmax / am : 0.f;
            u32x4 o4;
#pragma unroll
            for (int k = 0; k < 4; ++k) {
                if (FP8) { int p = __builtin_amdgcn_cvt_pk_fp8_f32(v[q][k][0] * inv, v[q][k][1] * inv, 0, false); p = __builtin_amdgcn_cvt_pk_fp8_f32(v[q][k][2] * inv, v[q][k][3] * inv, p, true); o4[k] = (unsigned)p; }
                else { const int q0 = (int)rintf(v[q][k][0] * inv), q1 = (int)rintf(v[q][k][1] * inv), q2 = (int)rintf(v[q][k][2] * inv), q3 = (int)rintf(v[q][k][3] * inv);
                    o4[k] = (unsigned)(q0 & 0xff) | ((unsigned)(q1 & 0xff) << 8) | ((unsigned)(q2 & 0xff) << 16) | ((unsigned)(q3 & 0xff) << 24); } }
            *(u32x4*)(dst + (size_t)row * 1024 + 16 * lane) = o4;
            if (lane == 0) scales[row] = sc; } }
    }
}
struct Inputs {
    const float *x, *c, *ctx, *c_ctx, *ada_w, *ada_b, *norm1_g, *norm2_g, *w_in, *gqa_qn_g, *gqa_kn_g, *pool_w, *pool_scale, *mla_qn_g, *mla_kvn_g, *mla_w_uq, *mla_w_ukv, *w_out, *peer_wq, *peer_subkeys, *peer_u, *peer_v, *final_g;
};
__device__ __forceinline__ void phase_cvt(LAS unsigned char* lds, const Inputs& in, const WS& w, int vb, int nvb) {
    LAS float* tile = (LAS float*)lds;
    for (int l = 0; l < 2; ++l) {
        cvt_job(tile, CvtJob{in.w_in + (size_t)l * 1024 * INC, w.WinT() + (size_t)l * 1792 * 1024, nullptr, 1024, INC, 1792, 0}, vb, nvb);
        cvt_job(tile, CvtJob{in.mla_w_uq + (size_t)l * 384 * 576, w.WuqT() + (size_t)l * 768 * 384, in.mla_qn_g + l * 384, 384, 576, 768, 1}, vb, nvb);
        cvt_job(tile, CvtJob{in.mla_w_ukv + (size_t)l * 256 * 768, w.WukvT() + (size_t)l * 768 * 256, in.mla_kvn_g + l * 256, 256, 768, 768, 2}, vb, nvb);
        cvt_job(tile, CvtJob{in.w_out + (size_t)l * 1024 * 1024, w.WoutT() + (size_t)l * 1024 * 1024, nullptr, 1024, 1024, 1024, 3}, vb, nvb);
        cvt_job(tile, CvtJob{in.peer_wq + (size_t)l * 1024 * 2048, w.WqT() + (size_t)l * 2048 * 1024, nullptr, 1024, 2048, 2048, 3}, vb, nvb);
    }
    cvt_flat(in.peer_subkeys, w.SubK(), (size_t)2 * 16 * 128 * 128, vb, nvb);
    { int tp_ = threadIdx.x; asm volatile("" : "+v"(tp_));
      for (int i = vb * 512 + tp_; i < 2 * 4 * 64 * 64; i += nvb * 512) { const int c = i & 63, d = (i >> 6) & 63, lg = i >> 12; w.PoolWT()[i] = f2bf(in.pool_w[(size_t)lg * 4096 + c * 64 + d]); } }
    if (nvb > 144) { if (vb >= 72) { cvt_q8_rows<false>(in.peer_u, w.U8(), w.US(), 2 * NE, vb - 72, nvb - 72); cvt_q8_rows<true>(in.peer_v, w.V8(), w.VS(), 2 * NE, vb - 72, nvb - 72); } }
    else { cvt_q8_rows<false>(in.peer_u, w.U8(), w.US(), 2 * NE, vb, nvb); cvt_q8_rows<true>(in.peer_v, w.V8(), w.VS(), 2 * NE, vb, nvb); }
}

constexpr float ATT_C2G = 0.125f * 1.4426950408889634f, ATT_C2M = 0.10206207261596577f * 1.4426950408889634f;
struct EpiIn {
    static constexpr bool PERM = true;
    WS w; const float* qn_g; const float* kn_g; int pm_base;
    __device__ __forceinline__ void operator()(const f32x4 (&acc)[2][2][4][2], const pg8::Unit& u, int wr, int wc, int fr, int fq) const {
        int type, sub; in_group(4 * u.pn + wc, type, sub);
        if (type == GT_PAD) return;
        const int pm = u.pm + pm_base; const bool isctx = pm >= 256; const int b = isctx ? pm - 256 : pm >> 3; const int t0 = isctx ? 0 : (pm & 7) * 256;
        const size_t rowbase = isctx ? (size_t)NL + (size_t)b * CTX : (size_t)b * S;
        const int keyoff = isctx ? 0 : CTX;
        float gain[2][8];
        if (type == GT_AQ) {
#pragma unroll
            for (int bj = 0; bj < 2; ++bj)
#pragma unroll
                for (int q = 0; q < 8; ++q) gain[bj][q] = qn_g[32 * bj + 8 * fq + q] * ATT_C2G;
        } else if (type == GT_AK) {
#pragma unroll
            for (int bj = 0; bj < 2; ++bj)
#pragma unroll
                for (int q = 0; q < 8; ++q) gain[bj][q] = kn_g[32 * bj + 8 * fq + q];
        }
#pragma unroll
        for (int ai = 0; ai < 2; ++ai)
#pragma unroll
            for (int m = 0; m < 4; ++m) {
                const int t = t0 + 128 * ai + 64 * wr + 16 * m + fr; const size_t row = rowbase + t;
                float v[2][8];
#pragma unroll
                for (int bj = 0; bj < 2; ++bj)
#pragma unroll
                    for (int n = 0; n < 2; ++n)
#pragma unroll
                        for (int i = 0; i < 4; ++i) v[bj][4 * n + i] = acc[ai][bj][m][n][i];
                bf16_t* dst = nullptr;
                if (type == GT_AQ || type == GT_AK) {
                    float ss = 0.f;
#pragma unroll
                    for (int bj = 0; bj < 2; ++bj)
#pragma unroll
                        for (int q = 0; q < 8; ++q) ss += v[bj][q] * v[bj][q];
                    ss += __shfl_xor(ss, 16); ss += __shfl_xor(ss, 32);
                    const float rstd = rsqrtf(ss * (1.f / 64.f) + EPS);
#pragma unroll
                    for (int q = 0; q < 8; ++q) { float x1 = v[0][q] * rstd * gain[0][q], x2 = v[1][q] * rstd * gain[1][q];
                        if (!isctx) { const float2 cs = w.ROPA()[t * 32 + 8 * fq + q]; const float y1 = x1 * cs.x - x2 * cs.y, y2 = x1 * cs.y + x2 * cs.x; x1 = y1; x2 = y2; }
                        v[0][q] = x1; v[1][q] = x2; }
                    if (type == GT_AQ) dst = isctx ? w.Qgc() + (((size_t)b * 6 + sub) * CTX + t) * 64 : w.Qg() + (((size_t)b * 6 + sub) * S + t) * 64;
                    else dst = w.Kg() + (((size_t)b * 2 + sub) * KEYS + keyoff + t) * 64;
                } else if (type == GT_AV) { dst = w.Vg() + (((size_t)b * 2 + sub) * KEYS + keyoff + t) * 64;
                } else if (type == GT_B) { dst = w.Bp() + row * 256 + 64 * sub;
                } else if (type == GT_CQ || type == GT_CKV) {
                    float ss = 0.f;
#pragma unroll
                    for (int bj = 0; bj < 2; ++bj)
#pragma unroll
                        for (int q = 0; q < 8; ++q) ss += v[bj][q] * v[bj][q];
                    ss += __shfl_xor(ss, 16); ss += __shfl_xor(ss, 32);
                    if (type == GT_CQ) { if (fq == 0) w.SSQ()[row * 8 + sub] = ss; dst = w.CQ() + row * 384 + 64 * sub; }
                    else { if (fq == 0) w.SSKV()[row * 4 + sub] = ss; dst = w.CKV() + row * 256 + 64 * sub; }
                } else {
                    if (!isctx) {
#pragma unroll
                        for (int q = 0; q < 8; ++q) { const float2 cs = w.ROPC()[t * 16 + ((8 * fq + q) & 15)]; const float x1 = v[0][q], x2 = v[1][q]; v[0][q] = x1 * cs.x - x2 * cs.y; v[1][q] = x1 * cs.y + x2 * cs.x; } }
                    if (fq < 2) { bf16_t* kd = w.KR() + ((size_t)b * KEYS + keyoff + t) * 32;
#pragma unroll
                        for (int bj = 0; bj < 2; ++bj) { u32x4 o; o.x = cvt_pk_bf16(v[bj][0], v[bj][1]); o.y = cvt_pk_bf16(v[bj][2], v[bj][3]); o.z = cvt_pk_bf16(v[bj][4], v[bj][5]); o.w = cvt_pk_bf16(v[bj][6], v[bj][7]);
                            *(u32x4*)(kd + 16 * bj + 8 * fq) = o; } }
                    continue;
                }
#pragma unroll
                for (int bj = 0; bj < 2; ++bj) { u32x4 o; o.x = cvt_pk_bf16(v[bj][0], v[bj][1]); o.y = cvt_pk_bf16(v[bj][2], v[bj][3]); o.z = cvt_pk_bf16(v[bj][4], v[bj][5]); o.w = cvt_pk_bf16(v[bj][6], v[bj][7]);
                    *(u32x4*)(dst + 32 * bj + 8 * fq) = o; }
            }
    }
};
struct P1Order {
    pg8::StaticOrder so; int nctx_tiles, G, c;
    __device__ bool next(int i, pg8::Unit& u) const {
        const int L = i * G + c;
        if (L < 1792) return so.next(i, u);
        const int Lc = L - 1792; if (Lc >= 32 * nctx_tiles) return false;
        u.pm = 256 + (Lc & 31); u.pn = Lc >> 5; return true;
    }
};
__device__ __forceinline__ void phase_p1(LAS unsigned char* lds, const WS& w, const Inputs& in, int l, int vb, int nvb) {
    EpiIn E{w, in.gqa_qn_g + l * 64, in.gqa_kn_g + l * 64, 0};
    P1Order po; po.so.init(NL, 1792, nvb, vb); po.nctx_tiles = (l == 0) ? 7 : 3; po.G = nvb; po.c = vb;
    pg8::gemm_phase(lds, pg8::Gemm{w.H(), w.WinT() + (size_t)l * 1792 * 1024, NR, 1792, 1024}, po, E);
}

extern __shared__ __attribute__((aligned(16))) unsigned char dyn_lds[];

struct EpiUq {
    static constexpr bool PERM = true;
    WS w;
    __device__ __forceinline__ void operator()(const f32x4 (&acc)[2][2][4][2], const pg8::Unit& u, int wr, int wc, int fr, int fq) const {
        const int g = 4 * u.pn + wc; if (g >= 9) return;
        const int pm = u.pm; const bool isctx = pm >= 256; const int b = isctx ? pm - 256 : pm >> 3; const int t0 = isctx ? 0 : (pm & 7) * 256;
        const size_t rowbase = isctx ? (size_t)NL + (size_t)b * CTX : (size_t)b * S;
        const int head = g < 6 ? g : 2 * (g - 6) + (fq >> 1);
#pragma unroll
        for (int ai = 0; ai < 2; ++ai)
#pragma unroll
            for (int m = 0; m < 4; ++m) {
                const int t = t0 + 128 * ai + 64 * wr + 16 * m + fr; const size_t row = rowbase + t;
                const float4 s0 = *(const float4*)(w.SSQ() + row * 8), s1 = *(const float4*)(w.SSQ() + row * 8 + 4);
                const float rstd = rsqrtf((s0.x + s0.y + s0.z + s0.w + s1.x + s1.y) * (1.f / 384.f) + EPS) * ATT_C2M;
                float v[2][8];
#pragma unroll
                for (int bj = 0; bj < 2; ++bj)
#pragma unroll
                    for (int n = 0; n < 2; ++n)
#pragma unroll
                        for (int i = 0; i < 4; ++i) v[bj][4 * n + i] = acc[ai][bj][m][n][i] * rstd;
                bf16_t* hd = isctx ? w.Qmc() + (((size_t)b * 6 + head) * CTX + t) * 96 : w.Qm() + (((size_t)b * 6 + head) * S + t) * 96;
                if (g >= 6 && !isctx) {
#pragma unroll
                    for (int q = 0; q < 8; ++q) { const float2 cs = w.ROPC()[t * 16 + 8 * (fq & 1) + q]; const float x1 = v[0][q], x2 = v[1][q]; v[0][q] = x1 * cs.x - x2 * cs.y; v[1][q] = x1 * cs.y + x2 * cs.x; } }
#pragma unroll
                for (int bj = 0; bj < 2; ++bj) { u32x4 o; o.x = cvt_pk_bf16(v[bj][0], v[bj][1]); o.y = cvt_pk_bf16(v[bj][2], v[bj][3]); o.z = cvt_pk_bf16(v[bj][4], v[bj][5]); o.w = cvt_pk_bf16(v[bj][6], v[bj][7]);
                    bf16_t* d = g < 6 ? hd + 32 * bj + 8 * fq : hd + 64 + 16 * bj + 8 * (fq & 1);
                    *(u32x4*)d = o; }
            }
    }
};
struct EpiUkv {
    static constexpr bool PERM = true;
    WS w;
    __device__ __forceinline__ void operator()(const f32x4 (&acc)[2][2][4][2], const pg8::Unit& u, int wr, int wc, int fr, int fq) const {
        const int g = 4 * u.pn + wc;
        const int pm = u.pm; const bool isctx = pm >= 256; const int b = isctx ? pm - 256 : pm >> 3; const int t0 = isctx ? 0 : (pm & 7) * 256;
        const size_t rowbase = isctx ? (size_t)NL + (size_t)b * CTX : (size_t)b * S; const int keyoff = isctx ? 0 : CTX;
        bf16_t* base = ((g & 1) ? w.Vm() : w.Kmn()) + ((size_t)b * 6 + (g >> 1)) * KEYS * 64;
#pragma unroll
        for (int ai = 0; ai < 2; ++ai)
#pragma unroll
            for (int m = 0; m < 4; ++m) {
                const int t = t0 + 128 * ai + 64 * wr + 16 * m + fr; const size_t row = rowbase + t;
                const float4 s0 = *(const float4*)(w.SSKV() + row * 4);
                const float rstd = rsqrtf((s0.x + s0.y + s0.z + s0.w) * (1.f / 256.f) + EPS);
                bf16_t* d = base + (size_t)(keyoff + t) * 64;
#pragma unroll
                for (int bj = 0; bj < 2; ++bj) { const f32x4 a0 = acc[ai][bj][m][0] * rstd, a1 = acc[ai][bj][m][1] * rstd;
                    u32x4 o; o.x = cvt_pk_bf16(a0[0], a0[1]); o.y = cvt_pk_bf16(a0[2], a0[3]); o.z = cvt_pk_bf16(a1[0], a1[1]); o.w = cvt_pk_bf16(a1[2], a1[3]);
                    *(u32x4*)(d + 32 * bj + 8 * fq) = o; }
            }
    }
};
constexpr int POOL_X = 0, POOL_P = 272 * 128, POOL_BYTES = 272 * 128 + 256 * 128;
__device__ __forceinline__ void phase_pool(LAS unsigned char* lds, const WS& w, bf16_t* __restrict__ MIX, const bf16_t* __restrict__ WT  , const float* __restrict__ pool_scale, int nrows, int vb, int nvb) {
    int tid_ = threadIdx.x; asm volatile("" : "+v"(tid_));
    const int tid = tid_, lane = tid & 63, wid = __builtin_amdgcn_readfirstlane(tid >> 6), r32 = lane & 31, hi = lane >> 5;
    const int nunits = nrows >> 8;
    for (int u = vb; u < nunits; u += nvb) {
        const int row0 = u << 8; const bool isctx = row0 >= NL; const int L = isctx ? CTX : S; const int t0 = isctx ? 0 : (row0 & (S - 1)); const int seq0 = row0 - t0;
#pragma unroll 1
        for (int g = 0; g < 4; ++g) {
            const int wdw = 2 << g, half = wdw >> 1;
            for (int i = tid; i < 272 * 8; i += 512) { const int rr = i >> 3, ch = i & 7; int t = t0 - 8 + rr; t = t < 0 ? 0 : (t >= L ? L - 1 : t);
                *(LAS u32x4*)(lds + POOL_X + rr * 128 + ch * 16) = *(const u32x4*)(w.Bp() + (size_t)(seq0 + t) * 256 + g * 64 + ch * 8); }
            __syncthreads();
            { const int c = tid & 63, seg = tid >> 6; const LAS bf16_t* X = (const LAS bf16_t*)(lds + POOL_X) + c;
              int t = t0 + seg * 32; int lo = t - half, hiw = t - half + wdw; lo = lo < 0 ? 0 : lo; hiw = hiw > L ? L : hiw;
              float sum = 0.f; for (int q = lo; q < hiw; ++q) sum += bf2f(X[(q - t0 + 8) * 64]);
#pragma unroll 4
              for (int k = 0; k < 32; ++k, ++t) {
                  const int clo = (t - half) < 0 ? 0 : (t - half), chi = (t - half + wdw) > L ? L : (t - half + wdw);
                  const float pv = sum / (float)(chi - clo) - bf2f(X[(t - t0 + 8) * 64]);
                  const int r = seg * 32 + k; *((LAS bf16_t*)(lds + POOL_P + r * 128 + (((c >> 3) ^ ((r >> 1) & 7)) << 4)) + (c & 7)) = f2bf(pv);
                  const int add = t + 1 - half + wdw - 1, drop = t - half;
                  if (add < L) sum += bf2f(X[(add - t0 + 8) * 64]);
                  if (drop >= 0) sum -= bf2f(X[(drop - t0 + 8) * 64]);
              } }
            __syncthreads();
            { f32x16 o0 = {}, o1 = {};
              const bf16_t* wt = WT + (size_t)g * 4096 + (size_t)r32 * 64 + 8 * hi;
#pragma unroll
              for (int s = 0; s < 4; ++s) { const int row = wid * 32 + r32; const bf16x8 pf = *(const LAS bf16x8*)(lds + POOL_P + row * 128 + (((2 * s + hi) ^ ((row >> 1) & 7)) << 4));
                  o0 = mfma32(*(const bf16x8*)(wt + 16 * s), pf, o0); o1 = mfma32(*(const bf16x8*)(wt + 32 * 64 + 16 * s), pf, o1); }
              bf16_t* op = MIX + (size_t)(row0 + wid * 32 + r32) * 1024 + 384 + g * 64 + 4 * hi; const float* ps = pool_scale + g * 64 + 4 * hi;
#pragma unroll
              for (int q = 0; q < 4; ++q) { const f32x4 s0 = *(const f32x4*)(ps + 8 * q), s1 = *(const f32x4*)(ps + 32 + 8 * q); u32x2 a, b;
                  a.x = cvt_pk_bf16(o0[4 * q] * s0[0], o0[4 * q + 1] * s0[1]); a.y = cvt_pk_bf16(o0[4 * q + 2] * s0[2], o0[4 * q + 3] * s0[3]);
                  b.x = cvt_pk_bf16(o1[4 * q] * s1[0], o1[4 * q + 1] * s1[1]); b.y = cvt_pk_bf16(o1[4 * q + 2] * s1[2], o1[4 * q + 3] * s1[3]);
                  *(u32x2*)(op + 8 * q) = a; *(u32x2*)(op + 32 + 8 * q) = b; } }
            __syncthreads();
        }
    }
}
__device__ __forceinline__ void phase_p2(LAS unsigned char* lds, const WS& w, const Inputs& in, int l, int vb, int nvb, int parts = 7) {
    pg8::StaticOrder so;
    if (parts & 1) { EpiUq E{w}; const int M = l == 0 ? NR : NL; so.init(M, 768, nvb, vb); pg8::gemm_phase(lds, pg8::Gemm{w.CQ(), w.WuqT() + (size_t)l * 768 * 384, M, 768, 384}, so, E); }
    if (parts & 2) { EpiUkv E{w}; so.init(NR, 768, nvb, vb); pg8::gemm_phase(lds, pg8::Gemm{w.CKV(), w.WukvT() + (size_t)l * 768 * 256, NR, 768, 256}, so, E); }
    if (parts & 4) phase_pool(lds, w, w.H(), w.PoolWT() + (size_t)l * 4 * 64 * 64, in.pool_scale + l * 256, l == 0 ? NR : NL, vb, nvb);
}

struct EpiOut {
    static constexpr bool PERM = true;
    bf16_t* DLT; const float* gate;
    __device__ __forceinline__ void operator()(const f32x4 (&acc)[2][2][4][2], const pg8::Unit& u, int wr, int wc, int fr, int fq) const {
        const int pm = u.pm; const int mr = pm >= 256 ? 32 : pm >> 3;
        const size_t r0 = (size_t)pm * 256 + wr * 64 + fr; const int col0 = u.pn * 256 + wc * 32 + 8 * fq;
        f32x4 gv[2][2];
#pragma unroll
        for (int bj = 0; bj < 2; ++bj)
#pragma unroll
            for (int n = 0; n < 2; ++n) gv[bj][n] = *(const f32x4*)(gate + (size_t)mr * 6144 + col0 + bj * 128 + 4 * n);
#pragma unroll
        for (int ai = 0; ai < 2; ++ai)
#pragma unroll
            for (int m = 0; m < 4; ++m) { bf16_t* d = DLT + (r0 + ai * 128 + m * 16) * 1024 + col0;
#pragma unroll
                for (int bj = 0; bj < 2; ++bj) { const f32x4 a0 = acc[ai][bj][m][0] * gv[bj][0], a1 = acc[ai][bj][m][1] * gv[bj][1];
                    u32x4 o; o.x = cvt_pk_bf16(a0[0], a0[1]); o.y = cvt_pk_bf16(a0[2], a0[3]); o.z = cvt_pk_bf16(a1[0], a1[1]); o.w = cvt_pk_bf16(a1[2], a1[3]);
                    *(u32x4*)(d + bj * 128) = o; } }
    }
};
__device__ __forceinline__ void phase_p4(LAS unsigned char* lds, const WS& w, const Inputs& in, int l, int vb, int nvb) {
    const float* MODl = w.MOD() + (size_t)l * 33 * 6144;
    EpiOut E{w.PQ(), MODl + 2 * 1024};
    const int M = l == 0 ? NR : NL;
    pg8::StaticOrder so; so.init(M, 1024, nvb, vb);
    pg8::gemm_phase(lds, pg8::Gemm{w.H(), w.WoutT() + (size_t)l * 1024 * 1024, M, 1024, 1024}, so, E);
}

__device__ __forceinline__ void phase_modulate(const float* __restrict__ XLp, const float* __restrict__ XCp, bf16_t* __restrict__ Hout, const float* __restrict__ g, const float* __restrict__ MODl, int si, int nrows, int vb, int nvb, signed char* __restrict__ H8 = nullptr, float* __restrict__ HS = nullptr,
                                               const bf16_t* __restrict__ DLT = nullptr, float* __restrict__ XLo = nullptr, float* __restrict__ XCo = nullptr) {
    int tid_ = threadIdx.x; asm volatile("" : "+v"(tid_));
    const int tid = tid_, lane = tid & 63, wid = tid >> 6;
    f32x4 gv[4];
#pragma unroll
    for (int i = 0; i < 4; ++i) gv[i] = *(const f32x4*)(g + 256 * i + 4 * lane);
    const int stride = nvb * 8, lastrow = nrows - 1;
    f32x4 nx[4]; u32x2 ndr[4];
#define PM_LOAD(r_) do { const int rr_ = (r_) < nrows ? (r_) : lastrow; const bool ic_ = rr_ >= NL; const float* xp_ = ic_ ? XCp + (size_t)(rr_ - NL) * 1024 : XLp + (size_t)rr_ * 1024; \
        _Pragma("unroll") for (int i = 0; i < 4; ++i) { nx[i] = *(const f32x4*)(xp_ + 256 * i + 4 * lane); if (DLT) ndr[i] = *(const u32x2*)(DLT + (size_t)rr_ * 1024 + 256 * i + 4 * lane); } } while (0)
    PM_LOAD(vb * 8 + wid);
    for (int row = vb * 8 + wid; row < nrows; row += stride) {
        const bool isctx = row >= NL; const int mr = isctx ? 32 : row / S;
        f32x4 x[4]; u32x2 dr4[4]; float ss = 0.f;
#pragma unroll
        for (int i = 0; i < 4; ++i) { x[i] = nx[i]; if (DLT) dr4[i] = ndr[i]; }
        PM_LOAD(row + stride);
#pragma unroll
        for (int i = 0; i < 4; ++i) {
            if (DLT) { const u32x2 dr = dr4[i];
                x[i][0] += __uint_as_float(dr.x << 16); x[i][1] += __uint_as_float(dr.x & 0xffff0000u); x[i][2] += __uint_as_float(dr.y << 16); x[i][3] += __uint_as_float(dr.y & 0xffff0000u);
                float* xo = isctx ? XCo + (size_t)(row - NL) * 1024 : XLo + (size_t)row * 1024; *(f32x4*)(xo + 256 * i + 4 * lane) = x[i]; }
            ss += x[i][0] * x[i][0] + x[i][1] * x[i][1] + x[i][2] * x[i][2] + x[i][3] * x[i][3]; }
        ss = wave_sum(ss); const float rstd = rsqrtf(ss * (1.f / 1024.f) + EPS);
        const float* sh = MODl + (size_t)mr * 6144 + si * 1024;
        f32x4 y[4]; float am = 0.f;
#pragma unroll
        for (int i = 0; i < 4; ++i) { const f32x4 shv = *(const f32x4*)(sh + 256 * i + 4 * lane), scv = *(const f32x4*)(sh + 1024 + 256 * i + 4 * lane);
            y[i] = x[i] * rstd * gv[i] * (scv + 1.f) + shv;
            am = fmaxf(am, fmaxf(fmaxf(fabsf(y[i][0]), fabsf(y[i][1])), fmaxf(fabsf(y[i][2]), fabsf(y[i][3]))));
            u32x2 o; o.x = cvt_pk_bf16(y[i][0], y[i][1]); o.y = cvt_pk_bf16(y[i][2], y[i][3]);
            *(u32x2*)(Hout + (size_t)row * 1024 + 256 * i + 4 * lane) = o; }
        if (H8) {
#pragma unroll
            for (int o = 32; o > 0; o >>= 1) am = fmaxf(am, __shfl_xor(am, o));
            const float inv = am > 0.f ? 127.f / am : 0.f;
#pragma unroll
            for (int i = 0; i < 4; ++i) { const int q0 = (int)rintf(y[i][0] * inv), q1 = (int)rintf(y[i][1] * inv), q2 = (int)rintf(y[i][2] * inv), q3 = (int)rintf(y[i][3] * inv);
                *(unsigned*)(H8 + (size_t)row * 1024 + 256 * i + 4 * lane) = (unsigned)(q0 & 0xff) | ((unsigned)(q1 & 0xff) << 8) | ((unsigned)(q2 & 0xff) << 16) | ((unsigned)(q3 & 0xff) << 24); }
            if (lane == 0) HS[row] = am > 0.f ? am * (1.f / 127.f) : 1.f;
        }
    }
#undef PM_LOAD
}

struct EpiPQ {
    static constexpr bool PERM = true;
    bf16_t* PQ;
    __device__ __forceinline__ void operator()(const f32x4 (&acc)[2][2][4][2], const pg8::Unit& u, int wr, int wc, int fr, int fq) const {
        const size_t r0 = (size_t)u.pm * 256 + wr * 64 + fr; const int col0 = u.pn * 256 + wc * 32 + 8 * fq;
#pragma unroll
        for (int ai = 0; ai < 2; ++ai)
#pragma unroll
            for (int m = 0; m < 4; ++m) { bf16_t* d = PQ + (r0 + ai * 128 + m * 16) * 2048 + col0;
#pragma unroll
                for (int bj = 0; bj < 2; ++bj) { const f32x4 a0 = acc[ai][bj][m][0], a1 = acc[ai][bj][m][1];
                    u32x4 o; o.x = cvt_pk_bf16(a0[0], a0[1]); o.y = cvt_pk_bf16(a0[2], a0[3]); o.z = cvt_pk_bf16(a1[0], a1[1]); o.w = cvt_pk_bf16(a1[2], a1[3]);
                    *(u32x4*)(d + bj * 128) = o; } }
    }
};
__device__ __forceinline__ void phase_p6a(LAS unsigned char* lds, const WS& w, int l, int vb, int nvb) {
    EpiPQ E{w.PQ()}; const int M = l == 0 ? NR : NL;
    pg8::StaticOrder so; so.init(M, 2048, nvb, vb);
    pg8::gemm_phase(lds, pg8::Gemm{w.H(), w.WqT() + (size_t)l * 2048 * 1024, M, 2048, 1024}, so, E);
}


using bf16x2_t = __attribute__((ext_vector_type(2))) __bf16;
typedef float f32x2 __attribute__((ext_vector_type(2)));
__device__ __forceinline__ float gelu_fast(float x) {
    const float u2 = 1.5957691216057308f * (x + 0.044715f * x * x * x);
    return x * __builtin_amdgcn_rcpf(1.f + __builtin_amdgcn_exp2f(-1.4426950408889634f * u2));
}
#define DPPF(v, ctrl) __builtin_bit_cast(float, __builtin_amdgcn_update_dpp(0, __builtin_bit_cast(int, (v)), (ctrl), 0xf, 0xf, true))
__device__ __forceinline__ float reduce8(float p0, float p1, float p2, float p3, float p4, float p5, float p6, float p7, int lane) {
    auto s01 = __builtin_amdgcn_permlane32_swap(__float_as_uint(p0), __float_as_uint(p1), false, false);
    auto s23 = __builtin_amdgcn_permlane32_swap(__float_as_uint(p2), __float_as_uint(p3), false, false);
    auto s45 = __builtin_amdgcn_permlane32_swap(__float_as_uint(p4), __float_as_uint(p5), false, false);
    auto s67 = __builtin_amdgcn_permlane32_swap(__float_as_uint(p6), __float_as_uint(p7), false, false);
    const float q0 = __uint_as_float(s01[0]) + __uint_as_float(s01[1]), q1 = __uint_as_float(s23[0]) + __uint_as_float(s23[1]);
    const float q2 = __uint_as_float(s45[0]) + __uint_as_float(s45[1]), q3 = __uint_as_float(s67[0]) + __uint_as_float(s67[1]);
    auto t0 = __builtin_amdgcn_permlane16_swap(__float_as_uint(q0), __float_as_uint(q1), false, false);
    auto t1 = __builtin_amdgcn_permlane16_swap(__float_as_uint(q2), __float_as_uint(q3), false, false);
    float r0 = __uint_as_float(t0[0]) + __uint_as_float(t0[1]);
    float r1 = __uint_as_float(t1[0]) + __uint_as_float(t1[1]);
    r0 += DPPF(r0, 0x128); r1 += DPPF(r1, 0x128);
    float z = (lane & 8) ? r1 : r0;
    z += DPPF(z, 0x141);
    z += DPPF(z, 0xB1);
    z += DPPF(z, 0x4E);
    return z;
}
__device__ __forceinline__ void p7_axpy(const u32x4 v, float wj, f32x2 (&out)[8]) {
    const f32x2 w2 = {wj, wj};
#pragma unroll
    for (int k = 0; k < 4; ++k) { const f32x2 lo = __builtin_amdgcn_cvt_pk_f32_fp8((int)v[k], false), hi2 = __builtin_amdgcn_cvt_pk_f32_fp8((int)v[k], true);
        out[2 * k] = __builtin_elementwise_fma(w2, lo, out[2 * k]); out[2 * k + 1] = __builtin_elementwise_fma(w2, hi2, out[2 * k + 1]); }
}
__device__ __forceinline__ int p7_doti(const u32x4 u, const u32x4 h) {
    int s = __builtin_amdgcn_sdot4((int)u[0], (int)h[0], 0, false); s = __builtin_amdgcn_sdot4((int)u[1], (int)h[1], s, false); s = __builtin_amdgcn_sdot4((int)u[2], (int)h[2], s, false); return __builtin_amdgcn_sdot4((int)u[3], (int)h[3], s, false);
}
#define DPPI(v, ctrl) __builtin_amdgcn_update_dpp(0, (v), (ctrl), 0xf, 0xf, true)
__device__ __forceinline__ int reduce8i(int p0, int p1, int p2, int p3, int p4, int p5, int p6, int p7, int lane) {
    auto s01 = __builtin_amdgcn_permlane32_swap((unsigned)p0, (unsigned)p1, false, false); auto s23 = __builtin_amdgcn_permlane32_swap((unsigned)p2, (unsigned)p3, false, false);
    auto s45 = __builtin_amdgcn_permlane32_swap((unsigned)p4, (unsigned)p5, false, false); auto s67 = __builtin_amdgcn_permlane32_swap((unsigned)p6, (unsigned)p7, false, false);
    const unsigned q0 = s01[0] + s01[1], q1 = s23[0] + s23[1], q2 = s45[0] + s45[1], q3 = s67[0] + s67[1];
    auto t0 = __builtin_amdgcn_permlane16_swap(q0, q1, false, false); auto t1 = __builtin_amdgcn_permlane16_swap(q2, q3, false, false);
    int r0 = (int)(t0[0] + t0[1]), r1 = (int)(t1[0] + t1[1]);
    r0 += DPPI(r0, 0x128); r1 += DPPI(r1, 0x128);
    int z = (lane & 8) ? r1 : r0;
    z += DPPI(z, 0x141); z += DPPI(z, 0xB1); z += DPPI(z, 0x4E);
    return z;
}

struct P7CArgs { const signed char* H8; const unsigned* EG; const unsigned char* U8; int* PART; int nrows; };
__device__ __forceinline__ void phase_p7c(LAS unsigned char* lds, const P7CArgs& a, int part, int prank, int nvb) {
    int tid_ = threadIdx.x; asm volatile("" : "+v"(tid_));
    const int lane = tid_ & 63, wid = __builtin_amdgcn_readfirstlane(tid_ >> 6);
    const int nw = (nvb >> 3) * 8, wrank = prank * 8 + wid;
    LAS unsigned* tab = (LAS unsigned*)(lds + wid * 1024);
    const int grp = lane >> 3, c = lane & 7, c16 = c * 16;
    const unsigned char* ubase = a.U8 + 128 * part + c16;
    const signed char* hbase = a.H8 + 128 * part + c16;
    int* pbase = a.PART + (size_t)part * a.nrows * 128;
    const int c2 = (c >> 2) & 1, c1 = (c >> 1) & 1, c0 = c & 1;
    const int ent0 = 8 * (8 * c2 + 4 * c0 + 2 * c1) + grp;
    u32x4 Av[16], Bv[16]; u32x4 Ah, Bh;
    unsigned pw0 = 0u, pw1 = 0u;
#define P7C_PREF(t) do { pw0 = a.EG[(size_t)(t) * 128 + lane]; pw1 = a.EG[(size_t)(t) * 128 + 64 + lane]; } while (0)
#define P7C_ISSUE(X, Xh, t, slot, tnext) do { LAS unsigned* tb_ = tab + (slot) * 128; \
        tb_[lane] = pw0; tb_[64 + lane] = pw1; \
        asm volatile("s_waitcnt lgkmcnt(0)" ::: "memory"); \
        _Pragma("unroll") for (int i_ = 0; i_ < 16; ++i_) { const unsigned e_ = tb_[8 * i_ + grp]; X[i_] = *(const u32x4*)(ubase + (size_t)(e_ >> 16) * 1024); } \
        Xh = *(const u32x4*)(hbase + (size_t)(t) * 1024); \
        P7C_PREF(tnext); } while (0)
#define P7C_X(v, ctrl) ((v) + DPPI((v), (ctrl)))
#define P7C_COMPUTE(X, Xh, t, valid) do { int d_[16]; \
        _Pragma("unroll") for (int i_ = 0; i_ < 16; ++i_) d_[i_] = p7_doti(X[i_], Xh); \
        int e8_[8]; _Pragma("unroll") for (int k = 0; k < 8; ++k) { const int send_ = c2 ? d_[k] : d_[k + 8], keep_ = c2 ? d_[k + 8] : d_[k]; e8_[k] = keep_ + DPPI(send_, 0x141); }            \
        int e4_[4]; _Pragma("unroll") for (int k = 0; k < 4; ++k) { const int send_ = c0 ? e8_[k] : e8_[k + 4], keep_ = c0 ? e8_[k + 4] : e8_[k]; e4_[k] = keep_ + DPPI(send_, 0xB1); }          \
        int e2_[2]; _Pragma("unroll") for (int k = 0; k < 2; ++k) { const int send_ = c1 ? e4_[k] : e4_[k + 2], keep_ = c1 ? e4_[k + 2] : e4_[k]; e2_[k] = keep_ + DPPI(send_, 0x4E); }          \
        if (valid) { int* pp_ = pbase + (size_t)(t) * 128 + ent0; pp_[0] = e2_[0]; pp_[8] = e2_[1]; } } while (0)
    const int lastrow = a.nrows - 1;
    int t = wrank;
    P7C_PREF(t);
    P7C_ISSUE(Av, Ah, t, 0, (t + nw < a.nrows ? t + nw : lastrow));
    while (t < a.nrows) {
        const int t1 = t + nw, t2 = t1 + nw, t3 = t2 + nw;
        const int k1 = t1 < a.nrows ? t1 : lastrow, k2 = t2 < a.nrows ? t2 : lastrow, k3 = t3 < a.nrows ? t3 : lastrow;
        P7C_ISSUE(Bv, Bh, k1, 1, k2);
        P7C_COMPUTE(Av, Ah, t, true);
        P7C_ISSUE(Av, Ah, k2, 0, k3);
        P7C_COMPUTE(Bv, Bh, k1, (t1 < a.nrows));
        t = t2;
    }
#undef P7C_PREF
#undef P7C_ISSUE
#undef P7C_COMPUTE
}
__device__ __forceinline__ void phase_p7d(const int* __restrict__ PART, const unsigned* __restrict__ EG, const float* __restrict__ US, const float* __restrict__ VS, const float* __restrict__ HS, unsigned* __restrict__ WE, int nrows, int vb, int nvb) {
    int tid_ = threadIdx.x; asm volatile("" : "+v"(tid_));
    typedef int i32x4 __attribute__((ext_vector_type(4)));
    const size_t n4 = (size_t)nrows * 32, pstride4 = n4;
    const i32x4* P4 = (const i32x4*)PART; const u32x4* EG4 = (const u32x4*)EG; u32x4* WE4 = (u32x4*)WE;
    for (size_t i = (size_t)vb * 512 + tid_; i < n4; i += (size_t)nvb * 512) {
        i32x4 s = P4[i];
#pragma unroll
        for (int p = 1; p < 8; ++p) s += P4[p * pstride4 + i];
        const u32x4 eg = EG4[i]; const float hs = HS[i >> 5];
        u32x4 o;
#pragma unroll
        for (int k = 0; k < 4; ++k) { const int eid = (int)(eg[k] >> 16);
            const float av = (float)s[k] * US[eid] * hs;
            const float wv = __uint_as_float(eg[k] << 16) * gelu_fast(av) * VS[eid];
            o[k] = (eg[k] & 0xffff0000u) | (cvt_pk_bf16(wv, 0.f) & 0xffffu); }
        WE4[i] = o;
    }
}
struct P7BArgs { const unsigned* WE; const unsigned char* V8; float* XL; float* XC; const float* gate2; int nrows; };
template <int PM>
__device__ __forceinline__ void phase_p7b(LAS unsigned char* lds, const P7BArgs& a, int part, int prank, int nvb) {
    int tid_ = threadIdx.x; asm volatile("" : "+v"(tid_));
    const int lane = tid_ & 63, wid = __builtin_amdgcn_readfirstlane(tid_ >> 6);
    const int nw = (nvb >> 3) * 8, wrank = prank * 8 + wid;
    LAS unsigned* tab = (LAS unsigned*)(lds + wid * 1024);
    const int grp = lane >> 3, c16 = (lane & 7) * 16;
    const unsigned char* vbase = a.V8 + 128 * part + c16;
    const int colofs = 128 * part + c16 + 8 * (lane >> 5) + 4 * ((lane >> 4) & 1) + 2 * ((lane >> 3) & 1);
    u32x4 Av[16], Bv[16]; float Aw[16], Bw[16]; f32x2 Ax, Ag, Bx, Bg;
    unsigned pw0 = 0u, pw1 = 0u;
#define P7B_PREF(t) do { pw0 = a.WE[(size_t)(t) * 128 + lane]; pw1 = a.WE[(size_t)(t) * 128 + 64 + lane]; } while (0)
#define P7B_ISSUE(X, Xw, Xx, Xg, t, slot, tnext) do { LAS unsigned* tb_ = tab + (slot) * 128; \
        tb_[lane] = pw0; tb_[64 + lane] = pw1; \
        asm volatile("s_waitcnt lgkmcnt(0)" ::: "memory"); \
        _Pragma("unroll") for (int i_ = 0; i_ < 16; ++i_) { const unsigned we_ = tb_[8 * i_ + grp]; Xw[i_] = __uint_as_float(we_ << 16); if (PM != 2) X[i_] = *(const u32x4*)(vbase + (size_t)(we_ >> 16) * 1024); else X[i_] = (u32x4){we_, 0x38383838u, 0x38383838u, 0x38383838u}; } \
        { const bool isctx_ = (t) >= NL; const float* xp_ = (isctx_ ? a.XC + (size_t)((t) - NL) * 1024 : a.XL + (size_t)(t) * 1024) + colofs; const int mr_ = isctx_ ? 32 : (t) / S; \
          Xx = *(const f32x2*)xp_; Xg = *(const f32x2*)(a.gate2 + (size_t)mr_ * 6144 + colofs); } \
        P7B_PREF(tnext); } while (0)
#define P7B_COMPUTE(X, Xw, Xx, Xg, t, valid) do { f32x2 acc2[8]; \
        _Pragma("unroll") for (int k = 0; k < 8; ++k) acc2[k] = (f32x2){0.f, 0.f}; \
        if (PM != 1) { _Pragma("unroll") for (int i_ = 0; i_ < 16; ++i_) p7_axpy(X[i_], Xw[i_], acc2); } else { _Pragma("unroll") for (int i_ = 0; i_ < 16; ++i_) acc2[i_ >> 1][i_ & 1] = __uint_as_float((X[i_][0] ^ X[i_][1] ^ X[i_][2] ^ X[i_][3]) & 0x3fffffffu) + Xw[i_]; } \
        float b_[8]; _Pragma("unroll") for (int k = 0; k < 8; ++k) { auto s_ = __builtin_amdgcn_permlane32_swap(__float_as_uint(acc2[k >> 1][k & 1]), __float_as_uint(acc2[(k + 8) >> 1][k & 1]), false, false); b_[k] = __uint_as_float(s_[0]) + __uint_as_float(s_[1]); } \
        float c_[4]; _Pragma("unroll") for (int k = 0; k < 4; ++k) { auto s_ = __builtin_amdgcn_permlane16_swap(__float_as_uint(b_[k]), __float_as_uint(b_[k + 4]), false, false); c_[k] = __uint_as_float(s_[0]) + __uint_as_float(s_[1]); } \
        float d_[2]; _Pragma("unroll") for (int k = 0; k < 2; ++k) { const float send_ = (lane & 8) ? c_[k] : c_[k + 2]; const float keep_ = (lane & 8) ? c_[k + 2] : c_[k]; d_[k] = keep_ + DPPF(send_, 0x128); } \
        const bool isctx_ = (t) >= NL; float* xp_ = (isctx_ ? a.XC + (size_t)((t) - NL) * 1024 : a.XL + (size_t)(t) * 1024) + colofs; \
        f32x2 x_ = Xx; x_.x += Xg.x * d_[0]; x_.y += Xg.y * d_[1]; if ((valid) && PM == 0) *(f32x2*)xp_ = x_; else if (PM != 0 && x_.x == 1.2345e30f) *(f32x2*)xp_ = x_; } while (0)
    const int lastrow = a.nrows - 1;
    int t = wrank;
    P7B_PREF(t);
    P7B_ISSUE(Av, Aw, Ax, Ag, t, 0, (t + nw < a.nrows ? t + nw : lastrow));
    while (t < a.nrows) {
        const int t1 = t + nw, t2 = t1 + nw, t3 = t2 + nw;
        const int c1 = t1 < a.nrows ? t1 : lastrow, c2 = t2 < a.nrows ? t2 : lastrow, c3 = t3 < a.nrows ? t3 : lastrow;
        P7B_ISSUE(Bv, Bw, Bx, Bg, c1, 1, c2);
        P7B_COMPUTE(Av, Aw, Ax, Ag, t, true);
        P7B_ISSUE(Av, Aw, Ax, Ag, c2, 0, c3);
        P7B_COMPUTE(Bv, Bw, Bx, Bg, c1, (t1 < a.nrows));
        t = t2;
    }
#undef P7B_PREF
#undef P7B_ISSUE
#undef P7B_COMPUTE
}
__device__ __forceinline__ void phase_final_norm(float* __restrict__ XLp, const float* __restrict__ g, int vb, int nvb) {
    int tid_ = threadIdx.x; asm volatile("" : "+v"(tid_));
    const int lane = tid_ & 63, wid = tid_ >> 6;
    for (int row = vb * 8 + wid; row < NL; row += nvb * 8) {
        float* xp = XLp + (size_t)row * 1024; f32x4 x[4]; float ss = 0.f;
#pragma unroll
        for (int i = 0; i < 4; ++i) { x[i] = *(const f32x4*)(xp + 256 * i + 4 * lane); ss += x[i][0] * x[i][0] + x[i][1] * x[i][1] + x[i][2] * x[i][2] + x[i][3] * x[i][3]; }
        ss = wave_sum(ss); const float rstd = rsqrtf(ss * (1.f / 1024.f) + EPS);
#pragma unroll
        for (int i = 0; i < 4; ++i) *(f32x4*)(xp + 256 * i + 4 * lane) = x[i] * rstd * *(const f32x4*)(g + 256 * i + 4 * lane);
    }
}

typedef short s16x4 __attribute__((ext_vector_type(4)));
__device__ __forceinline__ s16x4 lds_tr16(const LAS unsigned char* p) { return __builtin_bit_cast(s16x4, __builtin_amdgcn_ds_read_tr16_b64_v4i16((LAS s16x4*)p)); }
constexpr int ATT_BUF = 20480;
template <int DK>
__device__ __forceinline__ void attn_unit(LAS unsigned char* lds, const bf16_t* __restrict__ Q, const bf16_t* __restrict__ K1, const bf16_t* __restrict__ K2, const bf16_t* __restrict__ V,
                                          int nkeys, float c2, bf16_t* __restrict__ out) {
    int tid_ = threadIdx.x; asm volatile("" : "+v"(tid_));
    const int tid = tid_, lane = tid & 63, wid = __builtin_amdgcn_readfirstlane(tid >> 6), r32 = lane & 31, hi = lane >> 5;
    constexpr int NS = DK / 16;
    bf16x8 qf[NS];
    { const bf16_t* qp = Q + (size_t)(wid * 32 + r32) * DK + 8 * hi;
#pragma unroll
      for (int s = 0; s < NS; ++s) qf[s] = *(const bf16x8*)(qp + 16 * s); }
    const int skey = tid >> 3, sch = tid & 7;
    const unsigned st_k1 = skey * 128 + ((sch ^ ((skey >> 1) & 7)) << 4);
    const unsigned st_v = 8192 + skey * 128 + (((sch << 4)) ^ (((skey >> 1) & 1) << 6));
    const int skey2 = (tid & 255) >> 2, sch2 = tid & 3;
    const unsigned st_k2 = 16384 + skey2 * 64 + ((sch2 ^ ((skey2 >> 2) & 3)) << 4);
    const bf16_t* gk1 = K1 + (size_t)skey * 64 + sch * 8; const bf16_t* gv = V + (size_t)skey * 64 + sch * 8;
    const bf16_t* gk2 = (DK == 96) ? K2 + (size_t)skey2 * 32 + sch2 * 8 : nullptr;
    unsigned ka[2][4];
#pragma unroll
    for (int kt = 0; kt < 2; ++kt)
#pragma unroll
        for (int s = 0; s < 4; ++s) { const int key = 32 * kt + r32; ka[kt][s] = key * 128 + (((2 * s + hi) ^ ((key >> 1) & 7)) << 4); }
    unsigned kb[2][2];
#pragma unroll
    for (int kt = 0; kt < 2; ++kt)
#pragma unroll
        for (int s = 0; s < 2; ++s) { const int key = 32 * kt + r32; kb[kt][s] = 16384 + key * 64 + (((2 * s + hi) ^ ((key >> 2) & 3)) << 4); }
    const int vq = (lane & 15) >> 2, vp = lane & 3, vg = (lane >> 4) & 1;
    unsigned va[2];
#pragma unroll
    for (int dvb = 0; dvb < 2; ++dvb) { const int key = 4 * hi + vq; va[dvb] = 8192 + key * 128 + ((((32 * dvb + 16 * vg + 4 * vp) * 2)) ^ (((key >> 1) & 1) << 6)); }
    float m = 0.f, l = 0.f;
    f32x16 o0 = {}, o1 = {}, negm = {};
    const int NT = nkeys >> 6;
    u32x4 sk1, sv, sk2;
    sk1 = *(const u32x4*)gk1; sv = *(const u32x4*)gv; if (DK == 96) { if (tid < 256) sk2 = *(const u32x4*)gk2; }
    *(LAS u32x4*)(lds + st_k1) = sk1; *(LAS u32x4*)(lds + st_v) = sv; if (DK == 96) { if (tid < 256) *(LAS u32x4*)(lds + st_k2) = sk2; }
    __syncthreads();
    for (int t = 0; t < NT; ++t) {
        LAS unsigned char* buf = lds + (t & 1) * ATT_BUF;
        if (t + 1 < NT) { sk1 = *(const u32x4*)(gk1 + (size_t)(t + 1) * 64 * 64); sv = *(const u32x4*)(gv + (size_t)(t + 1) * 64 * 64); if (DK == 96) { if (tid < 256) sk2 = *(const u32x4*)(gk2 + (size_t)(t + 1) * 64 * 32); } }
        bf16x8 kf0[NS], kf1[NS];
#pragma unroll
        for (int s = 0; s < 4; ++s) { kf0[s] = *(const LAS bf16x8*)(buf + ka[0][s]); kf1[s] = *(const LAS bf16x8*)(buf + ka[1][s]); }
        if (DK == 96) {
#pragma unroll
            for (int s = 0; s < 2; ++s) { kf0[4 + s] = *(const LAS bf16x8*)(buf + kb[0][s]); kf1[4 + s] = *(const LAS bf16x8*)(buf + kb[1][s]); }
        }
        __builtin_amdgcn_sched_barrier(0);
        f32x16 p0 = mfma32(kf0[0], qf[0], negm), p1 = mfma32(kf1[0], qf[0], negm);
#pragma unroll
        for (int s = 1; s < NS; ++s) { p0 = mfma32(kf0[s], qf[s], p0); p1 = mfma32(kf1[s], qf[s], p1); }
        __builtin_amdgcn_sched_barrier(0);
        s16x4 vlo[2][2][2], vhi[2][2][2];
#pragma unroll
        for (int kt = 0; kt < 2; ++kt)
#pragma unroll
            for (int sp = 0; sp < 2; ++sp) { const int kofs = (32 * kt + 16 * sp) * 128;
#pragma unroll
                for (int dvb = 0; dvb < 2; ++dvb) { vlo[dvb][kt][sp] = lds_tr16(buf + va[dvb] + kofs); vhi[dvb][kt][sp] = lds_tr16(buf + va[dvb] + kofs + 8 * 128); } }
        __builtin_amdgcn_sched_barrier(0);
        float mx = p0[0];
#pragma unroll
        for (int r = 1; r < 16; ++r) mx = fmaxf(mx, p0[r]);
#pragma unroll
        for (int r = 0; r < 16; ++r) mx = fmaxf(mx, p1[r]);
        { auto rr = __builtin_amdgcn_permlane32_swap(__float_as_uint(mx), __float_as_uint(mx), false, false); mx = fmaxf(__uint_as_float(rr[0]), __uint_as_float(rr[1])); }
        if (t == 0 || __any(mx > 8.f)) {
            const float dn = (t == 0) ? mx : fmaxf(mx, 0.f), al = (t == 0) ? 1.f : __builtin_amdgcn_exp2f(-dn); m += dn; l *= al;
#pragma unroll
            for (int r = 0; r < 16; ++r) { o0[r] *= al; o1[r] *= al; p0[r] -= dn; p1[r] -= dn; negm[r] = -m; }
            asm volatile("" : "+v"(negm));
        }
        f32x2 ls2 = {0.f, 0.f};
#pragma unroll
        for (int r = 0; r < 16; ++r) { p0[r] = __builtin_amdgcn_exp2f(p0[r]); p1[r] = __builtin_amdgcn_exp2f(p1[r]); }
#pragma unroll
        for (int r = 0; r < 16; r += 2) { ls2 += (f32x2){p0[r], p0[r + 1]}; ls2 += (f32x2){p1[r], p1[r + 1]}; }
        const float ls = ls2.x + ls2.y;
        l += ls;
        bf16x8 pf[2][2];
#pragma unroll
        for (int sp = 0; sp < 2; ++sp) { u32x4 a, b;
            a.x = cvt_pk_bf16(p0[8 * sp], p0[8 * sp + 1]); a.y = cvt_pk_bf16(p0[8 * sp + 2], p0[8 * sp + 3]); a.z = cvt_pk_bf16(p0[8 * sp + 4], p0[8 * sp + 5]); a.w = cvt_pk_bf16(p0[8 * sp + 6], p0[8 * sp + 7]);
            b.x = cvt_pk_bf16(p1[8 * sp], p1[8 * sp + 1]); b.y = cvt_pk_bf16(p1[8 * sp + 2], p1[8 * sp + 3]); b.z = cvt_pk_bf16(p1[8 * sp + 4], p1[8 * sp + 5]); b.w = cvt_pk_bf16(p1[8 * sp + 6], p1[8 * sp + 7]);
            pf[0][sp] = __builtin_bit_cast(bf16x8, a); pf[1][sp] = __builtin_bit_cast(bf16x8, b); }
        __builtin_amdgcn_sched_barrier(0);
#pragma unroll
        for (int kt = 0; kt < 2; ++kt)
#pragma unroll
            for (int sp = 0; sp < 2; ++sp) {
                { const s16x4 lo = vlo[0][kt][sp], hi4 = vhi[0][kt][sp]; const bf16x8 vf = (bf16x8){lo[0], lo[1], lo[2], lo[3], hi4[0], hi4[1], hi4[2], hi4[3]}; o0 = mfma32(vf, pf[kt][sp], o0); }
                { const s16x4 lo = vlo[1][kt][sp], hi4 = vhi[1][kt][sp]; const bf16x8 vf = (bf16x8){lo[0], lo[1], lo[2], lo[3], hi4[0], hi4[1], hi4[2], hi4[3]}; o1 = mfma32(vf, pf[kt][sp], o1); } }
        __builtin_amdgcn_sched_barrier(0);
        if (t + 1 < NT) { LAS unsigned char* nb = lds + ((t + 1) & 1) * ATT_BUF; *(LAS u32x4*)(nb + st_k1) = sk1; *(LAS u32x4*)(nb + st_v) = sv; if (DK == 96) { if (tid < 256) *(LAS u32x4*)(nb + st_k2) = sk2; } }
        __syncthreads();
    }
    { auto rr = __builtin_amdgcn_permlane32_swap(__float_as_uint(l), __float_as_uint(l), false, false); l = __uint_as_float(rr[0]) + __uint_as_float(rr[1]); }
    const float il = 1.f / l;
    bf16_t* op = out + (size_t)(wid * 32 + r32) * 1024 + 4 * hi;
#pragma unroll
    for (int g = 0; g < 4; ++g) { u32x2 a, b;
        a.x = cvt_pk_bf16(o0[4 * g] * il, o0[4 * g + 1] * il); a.y = cvt_pk_bf16(o0[4 * g + 2] * il, o0[4 * g + 3] * il);
        b.x = cvt_pk_bf16(o1[4 * g] * il, o1[4 * g + 1] * il); b.y = cvt_pk_bf16(o1[4 * g + 2] * il, o1[4 * g + 3] * il);
        *(u32x2*)(op + 8 * g) = a; *(u32x2*)(op + 32 + 8 * g) = b; }
}
__device__ __forceinline__ void phase_p3(LAS unsigned char* lds, const WS& w, int l, int vb, int nvb) {
    const float c2g = 0.125f * 1.4426950408889634f, c2m = 0.10206207261596577f * 1.4426950408889634f;
    bf16_t* MIX = w.H();
    const int nlat = NB * 12 * 8, nctx = (l == 0) ? NB * 12 : 0;
    for (int u = vb; u < nlat + nctx; u += nvb) {
        if (u < nlat) {
            const int qb = u & 7, slot = (u >> 3) % 12, b = u / 96;
            bf16_t* out = MIX + ((size_t)b * S + qb * 256) * 1024;
            if (slot < 6) attn_unit<64>(lds, w.Qg() + (((size_t)b * 6 + slot) * S + qb * 256) * 64, w.Kg() + ((size_t)b * 2 + slot / 3) * KEYS * 64, nullptr, w.Vg() + ((size_t)b * 2 + slot / 3) * KEYS * 64, KEYS, c2g, out + slot * 64);
            else { const int h = slot - 6; attn_unit<96>(lds, w.Qm() + (((size_t)b * 6 + h) * S + qb * 256) * 96, w.Kmn() + ((size_t)b * 6 + h) * KEYS * 64, w.KR() + (size_t)b * KEYS * 32, w.Vm() + ((size_t)b * 6 + h) * KEYS * 64, KEYS, c2m, out + 640 + h * 64); }
        } else {
            const int v = u - nlat, slot = v % 12, b = v / 12;
            bf16_t* out = MIX + ((size_t)NL + (size_t)b * CTX) * 1024;
            if (slot < 6) attn_unit<64>(lds, w.Qgc() + ((size_t)b * 6 + slot) * CTX * 64, w.Kg() + ((size_t)b * 2 + slot / 3) * KEYS * 64, nullptr, w.Vg() + ((size_t)b * 2 + slot / 3) * KEYS * 64, CTX, c2g, out + slot * 64);
            else { const int h = slot - 6; attn_unit<96>(lds, w.Qmc() + ((size_t)b * 6 + h) * CTX * 96, w.Kmn() + ((size_t)b * 6 + h) * KEYS * 64, w.KR() + (size_t)b * KEYS * 32, w.Vm() + ((size_t)b * 6 + h) * KEYS * 64, CTX, c2m, out + 640 + h * 64); }
        }
    }
}

__device__ __forceinline__ unsigned fkey(float f, unsigned tag, unsigned mask) { unsigned u = __float_as_uint(f); u = (u & 0x80000000u) ? ~u : (u | 0x80000000u); return (u & ~mask) | tag; }
__device__ __forceinline__ float keyf(unsigned k, unsigned mask) { k &= ~mask; const unsigned u = (k & 0x80000000u) ? (k & 0x7fffffffu) : ~k; return __uint_as_float(u); }
__device__ __forceinline__ void ce_desc(unsigned& a, unsigned& b) { const unsigned hi_ = a > b ? a : b, lo_ = a > b ? b : a; a = hi_; b = lo_; }
template <int J, int K> __device__ __forceinline__ void bstage16(unsigned* a) {
#pragma unroll
    for (int i = 0; i < 16; ++i) { const int l = i ^ J; if (l > i) { const unsigned x = a[i], y = a[l]; const unsigned mx = x > y ? x : y, mn = x > y ? y : x; const bool desc = ((i & K) == 0); a[i] = desc ? mx : mn; a[l] = desc ? mn : mx; } }
}
__device__ __forceinline__ void sort16_desc(unsigned* a) {
    bstage16<1, 2>(a); bstage16<2, 4>(a); bstage16<1, 4>(a); bstage16<4, 8>(a); bstage16<2, 8>(a); bstage16<1, 8>(a); bstage16<8, 16>(a); bstage16<4, 16>(a); bstage16<2, 16>(a); bstage16<1, 16>(a);
}
__device__ __forceinline__ void bmerge16_desc(unsigned* c) { bstage16<8, 16>(c); bstage16<4, 16>(c); bstage16<2, 16>(c); bstage16<1, 16>(c); }
__device__ __forceinline__ void merge_top16(unsigned* a, const unsigned* b) {
#pragma unroll
    for (int i = 0; i < 16; ++i) a[i] = a[i] > b[15 - i] ? a[i] : b[15 - i];
    bmerge16_desc(a);
}
__device__ __forceinline__ void xlane_top16(unsigned* t, int hi) {
    unsigned r[16]; const unsigned msk = 0u - (unsigned)hi;
#pragma unroll
    for (int i = 0; i < 16; ++i) r[i] = t[i] ^ ((t[i] ^ t[15 - i]) & msk);
#pragma unroll
    for (int i = 0; i < 16; ++i) { auto s = __builtin_amdgcn_permlane32_swap(r[i], r[i], false, false); t[i] = s[0] > s[1] ? s[0] : s[1]; }
    bmerge16_desc(t);
}
__device__ __forceinline__ constexpr int cand_a(int c) { return c < 16 ? 0 : c < 24 ? 1 : c < 29 ? 2 : c < 33 ? 3 : c < 36 ? 4 : c < 38 ? 5 : c < 40 ? 6 : c < 42 ? 7 : c < 50 ? c - 34 : 0; }
__device__ __forceinline__ constexpr int cand_b(int c) { return c < 16 ? c : c < 24 ? c - 16 : c < 29 ? c - 24 : c < 33 ? c - 29 : c < 36 ? c - 33 : c < 38 ? c - 36 : c < 40 ? c - 38 : c < 42 ? c - 40 : 0; }

__device__ __forceinline__ void phase_p6b(LAS unsigned char* lds, const bf16_t* __restrict__ PQ, const bf16_t* __restrict__ SubKl, unsigned* __restrict__ EG, int nrows, int vb, int nvb) {
    int tid_ = threadIdx.x; asm volatile("" : "+v"(tid_));
    const int tid = tid_, lane = tid & 63, wid = __builtin_amdgcn_readfirstlane(tid >> 6), r32 = lane & 31, hi = lane >> 5;
    const int h = vb & 7, wrank = (vb >> 3) * 8 + wid, nwr = (nvb >> 3) * 8;
    LAS unsigned short* tab = (LAS unsigned short*)(lds + 65536 + wid * 4096) + r32 * 64;
#pragma unroll
    for (int i = 0; i < 8; ++i) { const int idx = i * 512 + tid, p = idx >> 11, key = (idx >> 4) & 127, ch = idx & 15;
        *(LAS u32x4*)(lds + p * 32768 + key * 256 + ((ch ^ (key & 15)) << 4)) = *(const u32x4*)(SubKl + ((size_t)(h * 2 + p) * 128 + key) * 128 + ch * 8); }
    __syncthreads();
    const int ngroups = nrows >> 5;
    for (int tg = wrank; tg < ngroups; tg += nwr) {
        const int row0 = tg << 5;
        bf16x8 qf[2][8];
        { const bf16_t* qp = PQ + (size_t)(row0 + r32) * 2048 + h * 256 + 8 * hi; asm volatile("" : "+v"(qp));
#pragma unroll
          for (int p = 0; p < 2; ++p)
#pragma unroll
              for (int s = 0; s < 8; ++s) qf[p][s] = *(const bf16x8*)(qp + p * 128 + 16 * s); }
        unsigned top[2][16];
#pragma unroll
        for (int p = 0; p < 2; ++p) {
            f32x16 acc[4];
#pragma unroll
            for (int kt = 0; kt < 4; ++kt) { acc[kt] = f32x16{}; const int key = 32 * kt + r32;
#pragma unroll
                for (int s = 0; s < 8; ++s) acc[kt] = mfma32(*(const LAS bf16x8*)(lds + p * 32768 + key * 256 + (((2 * s + hi) ^ (key & 15)) << 4)), qf[p][s], acc[kt]); }
            unsigned key[64];
#pragma unroll
            for (int kt = 0; kt < 4; ++kt)
#pragma unroll
                for (int r = 0; r < 16; ++r) { const int n = 32 * kt + (r & 3) + 8 * (r >> 2) + 4 * hi; key[16 * kt + r] = fkey(acc[kt][r], 127u - (unsigned)n, 127u); }
            sort16_desc(key); sort16_desc(key + 16); sort16_desc(key + 32); sort16_desc(key + 48);
            merge_top16(key, key + 16); merge_top16(key + 32, key + 48); merge_top16(key, key + 32);
            xlane_top16(key, hi);
#pragma unroll
            for (int i = 0; i < 16; ++i) top[p][i] = key[i];
        }
        unsigned ck[64];
#pragma unroll
        for (int c = 0; c < 64; ++c) {
            if (c < 50) { const float sm = keyf(top[0][cand_a(c)], 127u) + keyf(top[1][cand_b(c)], 127u); ck[c] = fkey(sm, (unsigned)c, 63u); } else ck[c] = 0u;
        }
        if (hi == 0) {
#pragma unroll
            for (int c = 0; c < 50; c += 2) {
                const unsigned ea = (127u - (top[0][cand_a(c)] & 127u)) * 128u + (127u - (top[1][cand_b(c)] & 127u));
                const unsigned eb = (127u - (top[0][cand_a(c + 1)] & 127u)) * 128u + (127u - (top[1][cand_b(c + 1)] & 127u));
                *(LAS unsigned*)(tab + c) = ea | (eb << 16);
            }
        }
        sort16_desc(ck); sort16_desc(ck + 16); sort16_desc(ck + 32); sort16_desc(ck + 48);
        merge_top16(ck, ck + 16); merge_top16(ck + 32, ck + 48); merge_top16(ck, ck + 32);
        asm volatile("s_waitcnt lgkmcnt(0)" ::: "memory");
        const float mx = keyf(ck[0], 63u); float e[16], den = 0.f;
#pragma unroll
        for (int j = 0; j < 16; ++j) { e[j] = __builtin_amdgcn_exp2f((keyf(ck[j], 63u) - mx) * 1.4426950408889634f); den += e[j]; }
        const float iden = 1.f / den;
        if (hi == 0) {
            unsigned o[16];
#pragma unroll
            for (int j = 0; j < 16; ++j) { const unsigned eid = tab[ck[j] & 63u]; o[j] = (eid << 16) | (cvt_pk_bf16(e[j] * iden, 0.f) & 0xffffu); }
            unsigned* dst = EG + (size_t)(row0 + r32) * 128 + h * 16;
#pragma unroll
            for (int j = 0; j < 16; j += 4) *(u32x4*)(dst + j) = (u32x4){o[j], o[j + 1], o[j + 2], o[j + 3]};
        }
        asm volatile("s_waitcnt lgkmcnt(0)" ::: "memory");
    }
}


#define XB_TMO      128
#define XB_XCNT(j)  (256  + 64 * (j))
#define XB_XSUB(j)  (1280 + 64 * (j))
#define XB_XGEN(j)  (2304 + 64 * (j))
#define XB_TOP      3328
#define XB_TOPGEN   3392
#define XCD_BAR_WORDS 3456
#define XB_SPIN_CAP (1u << 18)

__device__ __forceinline__ unsigned xb_ld(unsigned* p)              { return __hip_atomic_load(p, __ATOMIC_RELAXED, __HIP_MEMORY_SCOPE_AGENT); }
__device__ __forceinline__ unsigned xb_add(unsigned* p, unsigned v) { return __hip_atomic_fetch_add(p, v, __ATOMIC_RELAXED, __HIP_MEMORY_SCOPE_AGENT); }
__device__ __forceinline__ unsigned xb_xcc_id() { return (unsigned)__builtin_amdgcn_s_getreg((3 << 11) | 20) & 0xFu; }
#define XB_SPIN(cond, bar) do { unsigned _sp = 0; while (cond) { __builtin_amdgcn_s_sleep(1); \
    if ((++_sp & 255u) == 0u) { if (xb_ld(&(bar)[XB_TMO])) break; if (_sp > XB_SPIN_CAP) { atomicAdd(&(bar)[XB_TMO], 1u); break; } } } } while (0)

struct XcdBarrier {
    unsigned* bar; unsigned x;
    volatile LAS unsigned* st;
};

__device__ __forceinline__ XcdBarrier xcd_barrier_post(unsigned* bar, volatile LAS unsigned* st) {
    XcdBarrier b; b.bar = bar; b.x = xb_xcc_id(); b.st = st;
    if (threadIdx.x == 0) (void)xb_add(&bar[XB_XCNT(b.x)], 1u);
    return b;
}
__device__ __forceinline__ void xcd_barrier_complete(unsigned* bar, unsigned x, unsigned& nloc, unsigned& nx) {
    const unsigned G = gridDim.x * gridDim.y * gridDim.z;
    unsigned sum, cnt, mine, sp = 0u;
    for (;;) {
        sum = 0u; cnt = 0u; mine = 0u;
#pragma unroll
        for (unsigned j = 0; j < 16; ++j) { const unsigned c = xb_ld(&bar[XB_XCNT(j)]); sum += c; cnt += (c > 0u) ? 1u : 0u; mine = (j == x) ? c : mine; }
        if (sum == G) break;
        __builtin_amdgcn_s_sleep(1);
        if ((++sp & 255u) == 0u) { if (xb_ld(&bar[XB_TMO])) break; if (sp > XB_SPIN_CAP) { atomicAdd(&bar[XB_TMO], 1u); break; } }
    }
    nloc = mine > 0u ? mine : 1u; nx = cnt > 0u ? cnt : 1u;
}

__device__ __forceinline__ void xcd_barrier(const XcdBarrier& b) {
    asm volatile("s_waitcnt vmcnt(0)" ::: "memory");
    __syncthreads();
    if (threadIdx.x == 0) {
        unsigned* bar = b.bar;
        __builtin_amdgcn_s_waitcnt(0);
        unsigned nloc = b.st[0], nx = b.st[1];
        if (nloc == 0u) { xcd_barrier_complete(bar, b.x, nloc, nx); b.st[0] = nloc; b.st[1] = nx; }
        const unsigned old = xb_add(&bar[XB_XSUB(b.x)], 1u);
        const unsigned gen = old / nloc;
        if (old + 1u == (gen + 1u) * nloc) {
            __builtin_amdgcn_fence(__ATOMIC_RELEASE, "agent");
            asm volatile("s_waitcnt vmcnt(0)" ::: "memory");
            const unsigned og = xb_add(&bar[XB_TOP], 1u);
            const unsigned tg = og / nx;
            if (og + 1u == (tg + 1u) * nx) xb_add(&bar[XB_TOPGEN], 1u);
            else XB_SPIN(xb_ld(&bar[XB_TOPGEN]) == tg, bar);
            __builtin_amdgcn_fence(__ATOMIC_ACQUIRE, "agent");
            xb_add(&bar[XB_XGEN(b.x)], 1u);
            asm volatile("s_waitcnt vmcnt(0)" ::: "memory");
        } else {
            XB_SPIN(xb_ld(&bar[XB_XGEN(b.x)]) == gen, bar);
            __builtin_amdgcn_fence(__ATOMIC_ACQUIRE, "agent");
            asm volatile("s_waitcnt vmcnt(0)" ::: "memory");
        }
    }
    __syncthreads();
}

__device__ __forceinline__ void phase_mod(LAS unsigned char* lds, const Inputs& in, const WS& w, int vb) {
    if (vb >= 72) return;
    LAS float* sc = (LAS float*)lds;
    int tid_ = threadIdx.x; asm volatile("" : "+v"(tid_));
    const int tid = tid_, idx = vb * 512 + tid, rg = idx / 12288, ln = idx % 12288, l = ln / 6144, n = ln % 6144;
    float acc[11];
#pragma unroll
    for (int i = 0; i < 11; ++i) acc[i] = 0.f;
    const float* wp = in.ada_w + (size_t)l * 1024 * 6144 + n;
    for (int kc = 0; kc < 4; ++kc) {
        for (int i = tid; i < 33 * 256; i += 512) { const int r = i >> 8, k = kc * 256 + (i & 255); const float v = r < 32 ? in.c[(size_t)r * 1024 + k] : in.c_ctx[k]; sc[i] = v / (1.f + __expf(-v)); }
        __syncthreads();
        for (int k = 0; k < 256; ++k) { const float wv = wp[(size_t)(kc * 256 + k) * 6144];
#pragma unroll
            for (int i = 0; i < 11; ++i) acc[i] += sc[(rg * 11 + i) * 256 + k] * wv; }
        __syncthreads();
    }
    const float bias = in.ada_b[(size_t)l * 6144 + n];
#pragma unroll
    for (int i = 0; i < 11; ++i) w.MOD()[((size_t)l * 33 + rg * 11 + i) * 6144 + n] = acc[i] + bias;
}
__device__ __forceinline__ void phase_rope(const WS& w, int vb, int nvb) {
    int tid_ = threadIdx.x; asm volatile("" : "+v"(tid_));
    for (int i = vb * 512 + tid_; i < 2048 * 32; i += nvb * 512) {
        { const int t = i / 32, j = i % 32; const double inv = pow(10000.0, -(double)(j % 16) / 16.0); const double a = (double)(j < 16 ? t / 64 : t % 64) * inv; w.ROPA()[i] = make_float2((float)cos(a), (float)sin(a)); }
        if (i < 2048 * 16) { const int t = i / 16, j = i % 16; const double inv = pow(10000.0, -(double)(j % 8) / 8.0); const double a = (double)(j < 8 ? t / 64 : t % 64) * inv; w.ROPC()[i] = make_float2((float)cos(a), (float)sin(a)); }
    }
}

#ifndef PROBE_MASK
#define PROBE_MASK 0
#endif
struct MegaArgs { Inputs in; WS w; float* XL; unsigned* bar; };
constexpr int MEGA_LDS = 131072 + 16;
__global__ void __launch_bounds__(512, 2) k_mega(MegaArgs A) {
    LAS unsigned char* lds = (LAS unsigned char*)dyn_lds;
    const int vb = blockIdx.x, nvb = gridDim.x;
    volatile LAS unsigned* xbw = (volatile LAS unsigned*)(lds + 131072);
    if (threadIdx.x == 0) { xbw[0] = 0u; xbw[1] = 0u; xbw[2] = 0u; xbw[3] = 0u; }
    __syncthreads();
    XcdBarrier bar = xcd_barrier_post(A.bar, xbw);
    if (threadIdx.x == 0) xbw[2] = xb_add(&A.bar[3584 + 64 * bar.x], 1u);
    __syncthreads();
    const int xticket = __builtin_amdgcn_readfirstlane((int)xbw[2]);
    const WS& w = A.w; const Inputs& in = A.in;
    phase_mod(lds, in, w, vb);
    phase_rope(w, vb, nvb);
    phase_cvt(lds, in, w, vb, nvb);
    xcd_barrier(bar);
    phase_modulate(in.x, in.ctx, w.H(), in.norm1_g, w.MOD(), 0, NR, vb, nvb);
    xcd_barrier(bar);
#if (PROBE_MASK >> 0) & 1
    phase_mod(lds, in, w, vb);
    phase_rope(w, vb, nvb);
    phase_cvt(lds, in, w, vb, nvb);
    xcd_barrier(bar);
    phase_modulate(in.x, in.ctx, w.H(), in.norm1_g, w.MOD(), 0, NR, vb, nvb);
    xcd_barrier(bar);
#endif
    int xpart = vb & 7, xrank = vb >> 3;
    { bool okx = (bar.x < 8u); for (unsigned j = 0; j < 8; ++j) okx = okx && (xb_ld(&A.bar[XB_XCNT(j)]) == (unsigned)(nvb >> 3));
      if (okx) { xpart = (int)bar.x; xrank = xticket; } }
    for (int l = 0; l < DEPTH; ++l) {
        const float* MODl = w.MOD() + (size_t)l * 33 * 6144;
        const bool last = (l == DEPTH - 1);
        const int MR = last ? NL : NR;
        phase_p1(lds, w, in, l, vb, nvb); xcd_barrier(bar);
#if (PROBE_MASK >> 1) & 1
        phase_p1(lds, w, in, l, vb, nvb); xcd_barrier(bar);
#endif
        phase_p2(lds, w, in, l, vb, nvb); xcd_barrier(bar);
#if (PROBE_MASK >> 12) & 7
        phase_p2(lds, w, in, l, vb, nvb, (PROBE_MASK >> 12) & 7); xcd_barrier(bar);
#endif
        phase_p3(lds, w, l, vb, nvb); xcd_barrier(bar);
#if (PROBE_MASK >> 3) & 1
        phase_p3(lds, w, l, vb, nvb); xcd_barrier(bar);
#endif
        phase_p4(lds, w, in, l, vb, nvb);
        xcd_barrier(bar);
#if (PROBE_MASK >> 4) & 1
        phase_p4(lds, w, in, l, vb, nvb);
        xcd_barrier(bar);
#endif
        phase_modulate(l == 0 ? in.x : A.XL, l == 0 ? in.ctx : w.XC(), w.H(), in.norm2_g + l * 1024, MODl, 3, MR, vb, nvb, w.H8(), w.HS(), w.PQ(), A.XL, w.XC()); xcd_barrier(bar);
#if (PROBE_MASK >> 5) & 1
        phase_modulate(A.XL, w.XC(), w.H(), in.norm2_g + l * 1024, MODl, 3, MR, vb, nvb, w.H8(), w.HS()); xcd_barrier(bar);
#endif
        phase_p6a(lds, w, l, vb, nvb); xcd_barrier(bar);
#if (PROBE_MASK >> 6) & 1
        phase_p6a(lds, w, l, vb, nvb); xcd_barrier(bar);
#endif
        phase_p6b(lds, w.PQ(), w.SubK() + (size_t)l * 16 * 128 * 128, w.EG(), MR, vb, nvb); xcd_barrier(bar);
#if (PROBE_MASK >> 7) & 1
        phase_p6b(lds, w.PQ(), w.SubK() + (size_t)l * 16 * 128 * 128, w.EG(), MR, vb, nvb); xcd_barrier(bar);
#endif
        { P7CArgs a{w.H8(), w.EG(), w.U8() + (size_t)l * NE * 1024, (int*)w.PQ(), MR}; phase_p7c(lds, a, xpart, xrank, nvb); }
        xcd_barrier(bar);
#if (PROBE_MASK >> 8) & 1
        { P7CArgs a{w.H8(), w.EG(), w.U8() + (size_t)l * NE * 1024, (int*)w.PQ(), MR}; phase_p7c(lds, a, xpart, xrank, nvb); }
        xcd_barrier(bar);
#endif
        phase_p7d((const int*)w.PQ(), w.EG(), w.US() + (size_t)l * NE, w.VS() + (size_t)l * NE, w.HS(), w.WE(), MR, vb, nvb);
        xcd_barrier(bar);
#if (PROBE_MASK >> 9) & 1
        phase_p7d((const int*)w.PQ(), w.EG(), w.US() + (size_t)l * NE, w.VS() + (size_t)l * NE, w.HS(), w.WE(), MR, vb, nvb);
        xcd_barrier(bar);
#endif
        { P7BArgs a{w.WE(), w.V8() + (size_t)l * NE * 1024, A.XL, w.XC(), MODl + 5 * 1024, MR}; phase_p7b<0>(lds, a, xpart, xrank, nvb); }
        xcd_barrier(bar);
#if (PROBE_MASK >> 10) & 3
        { P7BArgs a{w.WE(), w.V8() + (size_t)l * NE * 1024, A.XL, w.XC(), MODl + 5 * 1024, MR}; phase_p7b<((PROBE_MASK >> 10) & 3)>(lds, a, xpart, xrank, nvb); }
        xcd_barrier(bar);
#endif
        if (last) phase_final_norm(A.XL, in.final_g, vb, nvb);
        else phase_modulate(A.XL, w.XC(), w.H(), in.norm1_g + (l + 1) * 1024, w.MOD() + (size_t)(l + 1) * 33 * 6144, 0, NR, vb, nvb);
        if (!last) xcd_barrier(bar);
    }
}

extern "C" void kernel_launch(void* const* d_in, const int* in_sizes, int n_in, void* d_out, int out_size, void* d_ws, size_t ws_size, hipStream_t stream) {
    const float* const* fin = (const float* const*)d_in;
    Inputs in{fin[0], fin[1], fin[2], fin[3], fin[4], fin[5], fin[6], fin[7], fin[8], fin[9], fin[10], fin[11], fin[12], fin[13], fin[14], fin[15], fin[16], fin[17], fin[18], fin[19], fin[20], fin[21], fin[22]};
    WS w = make_ws(d_ws);
    static int ok = 0;
    if (!ok) {
        if (hipFuncSetAttribute((const void*)k_mega, hipFuncAttributeMaxDynamicSharedMemorySize, MEGA_LDS) != hipSuccess) { ok = -1; }
        int per_cu = 0, cus = 0, dev = 0; (void)hipGetDevice(&dev); (void)hipDeviceGetAttribute(&cus, hipDeviceAttributeMultiprocessorCount, dev);
        if (hipOccupancyMaxActiveBlocksPerMultiprocessor(&per_cu, (const void*)k_mega, 512, MEGA_LDS) != hipSuccess || per_cu < 1 || cus < 256) ok = -1;
        if (ok == 0) ok = 1;
    }
    if (ok < 0) return;
    (void)hipMemsetAsync(d_ws, 0, 16384, stream);
    MegaArgs A{in, w, (float*)d_out, (unsigned*)d_ws};
    k_mega<<<256, 512, MEGA_LDS, stream>>>(A);
}
```

```cpp
#include <hip/hip_runtime.h>
#include <stdint.h>

typedef unsigned short bf16_t;

constexpr int D = 1024, NB = 32, S = 2048, CTX = 256, DEPTH = 2;
constexpr int NL = NB * S, NC = NB * CTX, NR = NL + NC;
constexpr int KEYS = CTX + S;
constexpr int INC = 1568;
constexpr int NE = 16384;
constexpr float EPS = 1e-6f;

__device__ __forceinline__ float bf2f(bf16_t v) { return __uint_as_float(((unsigned)v) << 16); }
__device__ __forceinline__ bf16_t f2bf(float f) { unsigned u = __float_as_uint(f); u += 0x7FFFu + ((u >> 16) & 1u); return (bf16_t)(u >> 16); }

__device__ __forceinline__ float wave_sum(float v) {
#pragma unroll
    for (int o = 32; o > 0; o >>= 1) v += __shfl_xor(v, o);
    return v;
}
__device__ __forceinline__ float gelu_tanh(float x) {
    const float u = 0.7978845608028654f * (x + 0.044715f * x * x * x);
    return 0.5f * x * (1.f + tanhf(u));
}

struct WS {
    char* base;
    __host__ __device__ __forceinline__ bf16_t* H() const { return (bf16_t*)(base + 65536ull); }
    __host__ __device__ __forceinline__ bf16_t* Qg() const { return (bf16_t*)(base + 151060480ull); }
    __host__ __device__ __forceinline__ bf16_t* Qgc() const { return (bf16_t*)(base + 201392128ull); }
    __host__ __device__ __forceinline__ bf16_t* Kg() const { return (bf16_t*)(base + 207683584ull); }
    __host__ __device__ __forceinline__ bf16_t* Vg() const { return (bf16_t*)(base + 226557952ull); }
    __host__ __device__ __forceinline__ bf16_t* CQ() const { return (bf16_t*)(base + 245432320ull); }
    __host__ __device__ __forceinline__ bf16_t* CKV() const { return (bf16_t*)(base + 302055424ull); }
    __host__ __device__ __forceinline__ bf16_t* Bp() const { return (bf16_t*)(base + 339804160ull); }
    __host__ __device__ __forceinline__ bf16_t* KR() const { return (bf16_t*)(base + 377552896ull); }
    __host__ __device__ __forceinline__ bf16_t* Qm() const { return (bf16_t*)(base + 382271488ull); }
    __host__ __device__ __forceinline__ bf16_t* Qmc() const { return (bf16_t*)(base + 457768960ull); }
    __host__ __device__ __forceinline__ bf16_t* Kmn() const { return (bf16_t*)(base + 467206144ull); }
    __host__ __device__ __forceinline__ bf16_t* Vm() const { return (bf16_t*)(base + 523829248ull); }
    __host__ __device__ __forceinline__ unsigned* EG() const { return (unsigned*)(base + 580452352ull); }
    __host__ __device__ __forceinline__ bf16_t* P() const { return (bf16_t*)(base + 382271488ull); }
    __host__ __device__ __forceinline__ bf16_t* PQ() const { return (bf16_t*)(base + 151060480ull); }
    __host__ __device__ __forceinline__ bf16_t* TMP() const { return (bf16_t*)(base + 65536ull); }
    __host__ __device__ __forceinline__ float* XC() const { return (float*)(base + 618201088ull); }
    __host__ __device__ __forceinline__ float* MOD() const { return (float*)(base + 651755520ull); }
    __host__ __device__ __forceinline__ float2* ROPA() const { return (float2*)(base + 653377536ull); }
    __host__ __device__ __forceinline__ float2* ROPC() const { return (float2*)(base + 653901824ull); }
    __host__ __device__ __forceinline__ float* RSQ() const { return (float*)(base + 654163968ull); }
    __host__ __device__ __forceinline__ float* RSKV() const { return (float*)(base + 654458880ull); }
    __host__ __device__ __forceinline__ bf16_t* WinT() const { return (bf16_t*)(base + 654753792ull); }
    __host__ __device__ __forceinline__ bf16_t* WuqT() const { return (bf16_t*)(base + 662093824ull); }
    __host__ __device__ __forceinline__ bf16_t* WukvT() const { return (bf16_t*)(base + 663273472ull); }
    __host__ __device__ __forceinline__ bf16_t* WoutT() const { return (bf16_t*)(base + 664059904ull); }
    __host__ __device__ __forceinline__ bf16_t* WqT() const { return (bf16_t*)(base + 668254208ull); }
    __host__ __device__ __forceinline__ bf16_t* SubK() const { return (bf16_t*)(base + 676642816ull); }
    __host__ __device__ __forceinline__ unsigned char* U8() const { return (unsigned char*)(base + 677691392ull); }
    __host__ __device__ __forceinline__ unsigned char* V8() const { return (unsigned char*)(base + 711245824ull); }
    __host__ __device__ __forceinline__ float* US() const { return (float*)(base + 744800256ull); }
    __host__ __device__ __forceinline__ float* VS() const { return (float*)(base + 744931328ull); }
    __host__ __device__ __forceinline__ float* SSQ() const { return (float*)(base + 745062400ull); }
    __host__ __device__ __forceinline__ float* SSKV() const { return (float*)(base + 747421696ull); }
    __host__ __device__ __forceinline__ unsigned* WE() const { return (unsigned*)(base + 748601344ull); }
    __host__ __device__ __forceinline__ signed char* H8() const { return (signed char*)(base + 786350080ull); }
    __host__ __device__ __forceinline__ float* HS() const { return (float*)(base + 861847552ull); }
    __host__ __device__ __forceinline__ bf16_t* PoolWT() const { return (bf16_t*)(base + 862142464ull); }
    __host__ __device__ __forceinline__ bf16_t* XB() const { return (bf16_t*)(base + 862208000ull); }
};
constexpr size_t WS_BYTES = 862208000ull + (size_t)NR * 1024 * 2;
static WS make_ws(void* d_ws) { WS w; w.base = (char*)d_ws; return w; }


#define LAS __attribute__((address_space(3)))
typedef short bf16x8 __attribute__((ext_vector_type(8)));
typedef float f32x4 __attribute__((ext_vector_type(4)));
typedef float f32x16 __attribute__((ext_vector_type(16)));
typedef unsigned u32x4 __attribute__((ext_vector_type(4)));
typedef unsigned u32x2 __attribute__((ext_vector_type(2)));

__device__ __forceinline__ f32x16 mfma32(bf16x8 a, bf16x8 b, f32x16 c) { return __builtin_amdgcn_mfma_f32_32x32x16_bf16(a, b, c, 0, 0, 0); }
__device__ __forceinline__ unsigned cvt_pk_bf16(float lo, float hi) { unsigned r; asm volatile("v_cvt_pk_bf16_f32 %0, %1, %2" : "=v"(r) : "v"(lo), "v"(hi)); return r; }

namespace pg8 {
constexpr int BM = 256, BK = 64, HALF = 128, HTB = HALF * BK * 2, STAGE_BYTES = 8 * HTB, NXCD = 8, WGM = 8;
__host__ __device__ __forceinline__ int lds_byte(int r, int c) { const int st = (r >> 4) * 2 + (c >> 5), rr = r & 15, cc = c & 31, ob = rr * 64 + cc * 2; return st * 1024 + (ob ^ (((ob >> 9) & 1) << 5)); }
__host__ __device__ __forceinline__ void stage_rc(int b, int& R, int& C) { const int st = b / 1024, sb = b % 1024, swz = sb ^ (((sb >> 9) & 1) << 5); R = (st >> 1) * 16 + swz / 64; C = (st & 1) * 32 + (swz % 64) / 2; }
__host__ __device__ __forceinline__ int perm32(int rho) { const int n = rho >> 4, i = rho & 15; return 8 * (i >> 2) + 4 * n + (i & 3); }
struct Unit { int pm, pn; };
struct Gemm { const bf16_t* A; const bf16_t* Bt; int M, N, K; };
struct StaticOrder {
    int nM, nN, nwg, G, c;
    __host__ __device__ void init(int M, int N, int G_, int c_) { nM = M / BM; nN = N / BM; nwg = nM * nN; G = G_; c = c_; }
    __host__ __device__ bool next(int i, Unit& u) const {
        const long L = (long)i * G + c; if (L >= nwg) return false;
        int wgid = (int)L; { const int q = nwg / NXCD, r = nwg % NXCD, xcd = wgid % NXCD, off = wgid / NXCD; wgid = (xcd < r ? xcd * (q + 1) : r * (q + 1) + (xcd - r) * q) + off; }
        const int nig = WGM * nN, gid = wgid / nig, fm = gid * WGM, gsz = (nM - fm) < WGM ? (nM - fm) : WGM;
        u.pm = fm + ((wgid % nig) % gsz); u.pn = (wgid % nig) / gsz; return true;
    }
};
template <class Epi, class Sched>
__device__ __forceinline__ void gemm_phase(LAS unsigned char* lds, const Gemm g, const Sched& S, const Epi& E) {
    int tid_ = threadIdx.x; asm volatile("" : "+v"(tid_));
    const int tid = tid_, wid = __builtin_amdgcn_readfirstlane(tid >> 6), lane = tid & 63, wr = wid >> 2, wc = wid & 3, fr = lane & 15, fq = lane >> 4;
    const int K = g.K, nt = K / BK;
    unsigned voffA[2], voffB[2];
#pragma unroll
    for (int i = 0; i < 2; ++i) { int R, C; stage_rc(tid * 16 + i * 8192, R, C); const int Rb = Epi::PERM ? ((R & ~31) + perm32(R & 31)) : R;
        voffA[i] = (unsigned)(R * K + C) * 2u; voffB[i] = (unsigned)(Rb * K + C) * 2u; }
    const size_t kstep = (size_t)(BK * 2);
    const size_t hstep = (size_t)HALF * K * 2;
    const size_t tstep = 2 * hstep;
    const unsigned ldsw = (unsigned)wid * 1024u;
    const int aoff = lds_byte(wr * 64 + fr, fq * 8), boff = lds_byte(wc * 32 + fr, fq * 8);
#define PG8_SA(b, h) (((b) * 2 + (h)) * HTB)
#define PG8_SB(b, h) ((4 + (b) * 2 + (h)) * HTB)
#define PG8_STAGE(bufoff, gbase, voff) do { _Pragma("unroll") for (int _i = 0; _i < 2; ++_i) \
        __builtin_amdgcn_global_load_lds((const unsigned*)((const char*)(gbase) + (voff)[_i]), (LAS unsigned*)(lds + (bufoff) + ldsw + _i * 8192), 16, 0, 0); } while (0)
#define PG8_LDA(dst, b, h) do { _Pragma("unroll") for (int m = 0; m < 4; ++m) _Pragma("unroll") for (int k = 0; k < 2; ++k) dst[m][k] = *(const LAS bf16x8*)(lds + PG8_SA(b, h) + aoff + m * 2048 + k * 1024); } while (0)
#define PG8_LDB(dst, b, h) do { _Pragma("unroll") for (int n = 0; n < 2; ++n) _Pragma("unroll") for (int k = 0; k < 2; ++k) dst[n][k] = *(const LAS bf16x8*)(lds + PG8_SB(b, h) + boff + n * 2048 + k * 1024); } while (0)
#define PG8_MMA(ai, bj, At, Bt) do { __builtin_amdgcn_s_setprio(1); _Pragma("unroll") for (int m = 0; m < 4; ++m) _Pragma("unroll") for (int n = 0; n < 2; ++n) _Pragma("unroll") for (int k = 0; k < 2; ++k) \
        acc[ai][bj][m][n] = __builtin_amdgcn_mfma_f32_16x16x32_bf16(Bt[n][k], At[m][k], acc[ai][bj][m][n], 0, 0, 0); __builtin_amdgcn_s_setprio(0); } while (0)
#define PG8_WAIT_V(n) asm volatile("s_waitcnt vmcnt(" #n ")" ::: "memory")
#define PG8_WAIT_L(n) asm volatile("s_waitcnt lgkmcnt(" #n ")" ::: "memory")
#define PG8_BAR __builtin_amdgcn_s_barrier()
#define PG8_SCHED __builtin_amdgcn_sched_barrier(0)
    Unit cur, nxt; int ui = 0;
    if (!S.next(0, cur)) return;
    f32x4 acc[2][2][4][2];
#pragma unroll
    for (int a = 0; a < 2; ++a)
#pragma unroll
        for (int b = 0; b < 2; ++b)
#pragma unroll
            for (int m = 0; m < 4; ++m)
#pragma unroll
                for (int n = 0; n < 2; ++n) acc[a][b][m][n] = (f32x4){0.f, 0.f, 0.f, 0.f};
    bf16x8 At[4][2], B0[2][2], B1[2][2];
    const char* cA = (const char*)g.A + (size_t)cur.pm * tstep; const char* cB = (const char*)g.Bt + (size_t)cur.pn * tstep;
    PG8_STAGE(PG8_SB(0, 0), cB, voffB); PG8_STAGE(PG8_SA(0, 0), cA, voffA); PG8_STAGE(PG8_SB(0, 1), cB + hstep, voffB); PG8_STAGE(PG8_SA(0, 1), cA + hstep, voffA);
    if (wr == 1) PG8_BAR;
    PG8_WAIT_V(4); PG8_BAR;
    PG8_STAGE(PG8_SB(1, 0), cB + kstep, voffB); PG8_STAGE(PG8_SA(1, 0), cA + kstep, voffA); PG8_STAGE(PG8_SB(1, 1), cB + hstep + kstep, voffB);
    PG8_WAIT_V(6); PG8_BAR;
    for (;;) {
        const bool has_next = S.next(ui + 1, nxt);
        const char* nA = has_next ? (const char*)g.A + (size_t)nxt.pm * tstep : cA; const char* nB = has_next ? (const char*)g.Bt + (size_t)nxt.pn * tstep : cB;
#pragma nounroll
        for (int t = 0; t < nt; t += 2) {
            const bool last = (t == nt - 2);
            const char* a1 = cA + (size_t)(t + 1) * kstep;
            const char* a2 = last ? nA : cA + (size_t)(t + 2) * kstep; const char* b2 = last ? nB : cB + (size_t)(t + 2) * kstep;
            const char* a3 = a2 + kstep; const char* b3 = b2 + kstep;
            PG8_LDB(B0, 0, 0); PG8_SCHED; PG8_LDA(At, 0, 0); PG8_STAGE(PG8_SA(1, 1), a1 + hstep, voffA);
            PG8_WAIT_L(8); PG8_BAR; PG8_WAIT_L(0); PG8_MMA(0, 0, At, B0); PG8_BAR; PG8_SCHED;
            PG8_LDB(B1, 0, 1); PG8_STAGE(PG8_SB(0, 0), b2, voffB);
            PG8_BAR; PG8_WAIT_L(0); PG8_MMA(0, 1, At, B1); PG8_BAR;
            PG8_LDA(At, 0, 1); PG8_STAGE(PG8_SA(0, 0), a2, voffA);
            PG8_BAR; PG8_WAIT_L(0); PG8_MMA(1, 0, At, B0); PG8_BAR; PG8_SCHED;
            PG8_STAGE(PG8_SB(0, 1), b2 + hstep, voffB);
            PG8_WAIT_V(6); PG8_BAR; PG8_MMA(1, 1, At, B1); PG8_BAR;
            PG8_LDB(B0, 1, 0); PG8_SCHED; PG8_LDA(At, 1, 0); PG8_STAGE(PG8_SA(0, 1), a2 + hstep, voffA);
            PG8_WAIT_L(8); PG8_BAR; PG8_WAIT_L(0); PG8_MMA(0, 0, At, B0); PG8_BAR; PG8_SCHED;
            PG8_LDB(B1, 1, 1); PG8_STAGE(PG8_SB(1, 0), b3, voffB);
            PG8_BAR; PG8_WAIT_L(0); PG8_MMA(0, 1, At, B1); PG8_BAR;
            PG8_LDA(At, 1, 1); PG8_STAGE(PG8_SA(1, 0), a3, voffA);
            PG8_BAR; PG8_WAIT_L(0); PG8_MMA(1, 0, At, B0); PG8_BAR; PG8_SCHED;
            PG8_STAGE(PG8_SB(1, 1), b3 + hstep, voffB);
            PG8_WAIT_V(6); PG8_BAR; PG8_MMA(1, 1, At, B1); PG8_BAR;
        }
        E(acc, cur, wr, wc, fr, fq);
        if (!has_next) break;
#pragma unroll
        for (int a = 0; a < 2; ++a)
#pragma unroll
            for (int b = 0; b < 2; ++b)
#pragma unroll
                for (int m = 0; m < 4; ++m)
#pragma unroll
                    for (int n = 0; n < 2; ++n) acc[a][b][m][n] = (f32x4){0.f, 0.f, 0.f, 0.f};
        cur = nxt; cA = nA; cB = nB; ++ui;
    }
    PG8_WAIT_V(0);
    if (wr == 0) PG8_BAR;
    PG8_BAR;
#undef PG8_SA
#undef PG8_SB
#undef PG8_STAGE
#undef PG8_LDA
#undef PG8_LDB
#undef PG8_MMA
#undef PG8_WAIT_V
#undef PG8_WAIT_L
#undef PG8_BAR
#undef PG8_SCHED
}
}

enum { GT_AQ = 0, GT_AK = 1, GT_AV = 2, GT_B = 3, GT_CQ = 4, GT_CKV = 5, GT_KR = 6, GT_PAD = 7 };
__host__ __device__ __forceinline__ void in_group(int g, int& type, int& sub) {
    if (g < 2) { type = GT_AK; sub = g; } else if (g < 4) { type = GT_AV; sub = g - 2; } else if (g < 8) { type = GT_CKV; sub = g - 4; }
    else if (g == 8) { type = GT_KR; sub = 0; } else if (g < 12) { type = GT_PAD; sub = 0; } else if (g < 18) { type = GT_AQ; sub = g - 12; }
    else if (g < 24) { type = GT_CQ; sub = g - 18; } else { type = GT_B; sub = g - 24; }
}
__device__ __forceinline__ int colmap(int mode, int r) {
    const int pn = r >> 8, ct = r & 255, bj = ct >> 7, wc = (ct >> 5) & 3, j = ct & 31, g = 4 * pn + wc, e = 32 * bj + j;
    if (mode == 0) {
        int type, sub; in_group(g, type, sub);
        switch (type) { case GT_AQ: return 64 * sub + e; case GT_AK: return 384 + 64 * sub + e; case GT_AV: return 512 + 64 * sub + e; case GT_B: return 640 + 64 * sub + e;
            case GT_CQ: return 896 + 64 * sub + e; case GT_CKV: return 1280 + 64 * sub + e; case GT_KR: return (j < 16) ? 1536 + 16 * bj + j : -1; default: return -1; }
    } else if (mode == 1) {
        if (g < 6) return 96 * g + e; if (g < 9) { const int head = 2 * (g - 6) + (j >> 4); return 96 * head + 64 + 16 * bj + (j & 15); } return -1;
    } else if (mode == 2) {
        return 64 * g + e;
    }
    return r;
}
__device__ __forceinline__ void cvt_weights_unit(LAS float* tile  , const float* __restrict__ W, int K, int N, bf16_t* __restrict__ dst, int mode, const float* __restrict__ kgain, int r0, int k0) {
    int tid_ = threadIdx.x; asm volatile("" : "+v"(tid_));
    const int tid = tid_;
    const int jj = tid & 63; const int sc = colmap(mode, r0 + jj);
#pragma unroll
    for (int i = 0; i < 8; ++i) { const int kk = (tid >> 6) + 8 * i; float v = 0.f; if (sc >= 0) v = W[(size_t)(k0 + kk) * N + sc]; if (kgain) v *= kgain[k0 + kk]; tile[kk * 65 + jj] = v; }
    __syncthreads();
#pragma unroll
    for (int i = 0; i < 8; ++i) { const int rr = (tid >> 6) + 8 * i, kk = tid & 63; dst[(size_t)(r0 + rr) * K + k0 + kk] = f2bf(tile[kk * 65 + rr]); }
    __syncthreads();
}
struct CvtJob { const float* W; bf16_t* dst; const float* kgain; int K, N, Npad, mode; };
__device__ __forceinline__ void cvt_job(LAS float* tile, const CvtJob j, int vb, int nvb) {
    const int nk = j.K / 64, nr = j.Npad / 64;
    for (int u = vb; u < nk * nr; u += nvb) cvt_weights_unit(tile, j.W, j.K, j.N, j.dst, j.mode, j.kgain, (u / nk) * 64, (u % nk) * 64);
}
__device__ __forceinline__ void cvt_flat(const float* __restrict__ src, bf16_t* __restrict__ dst, size_t n, int vb, int nvb) {
    int tid_ = threadIdx.x; asm volatile("" : "+v"(tid_));
    for (size_t i = ((size_t)vb * 512 + tid_) * 8; i < n; i += (size_t)nvb * 512 * 8) {
        const float4 a = *(const float4*)(src + i), b = *(const float4*)(src + i + 4);
        u32x4 o; o.x = cvt_pk_bf16(a.x, a.y); o.y = cvt_pk_bf16(a.z, a.w); o.z = cvt_pk_bf16(b.x, b.y); o.w = cvt_pk_bf16(b.z, b.w);
        *(u32x4*)(dst + i) = o;
    }
}
template <bool FP8>
__device__ __forceinline__ void cvt_q8_rows(const float* __restrict__ src, unsigned char* __restrict__ dst, float* __restrict__ scales, int nrows, int vb, int nvb) {
    int tid_ = threadIdx.x; asm volatile("" : "+v"(tid_));
    const int lane = tid_ & 63, wid = tid_ >> 6;
    const int stride = nvb * 8;
    for (int row0 = vb * 8 + wid; row0 < nrows; row0 += 4 * stride) {
        f32x4 v[4][4];
#pragma unroll
        for (int q = 0; q < 4; ++q) { const int row = row0 + q * stride < nrows ? row0 + q * stride : row0; const float* sp = src + (size_t)row * 1024 + 16 * lane;
#pragma unroll
            for (int k = 0; k < 4; ++k) v[q][k] = *(const f32x4*)(sp + 4 * k); }
#pragma unroll
        for (int q = 0; q < 4; ++q) { const int row = row0 + q * stride; if (row < nrows) {
            float am = 0.f;
#pragma unroll
            for (int k = 0; k < 4; ++k) am = fmaxf(am, fmaxf(fmaxf(fabsf(v[q][k][0]), fabsf(v[q][k][1])), fmaxf(fabsf(v[q][k][2]), fabsf(v[q][k][3]))));
#pragma unroll
            for (int o = 32; o > 0; o >>= 1) am = fmaxf(am, __shfl_xor(am, o));
            const float qmax = FP8 ? 416.f : 127.f;
            const float sc = am > 0.f ? am / qmax : 1.f, inv = am > 0.f ? qmax / am : 0.f;
            u32x4 o4;
#pragma unroll
            for (int k = 0; k < 4; ++k) {
                if (FP8) { int p = __builtin_amdgcn_cvt_pk_fp8_f32(v[q][k][0] * inv, v[q][k][1] * inv, 0, false); p = __builtin_amdgcn_cvt_pk_fp8_f32(v[q][k][2] * inv, v[q][k][3] * inv, p, true); o4[k] = (unsigned)p; }
                else { const int q0 = (int)rintf(v[q][k][0] * inv), q1 = (int)rintf(v[q][k][1] * inv), q2 = (int)rintf(v[q][k][2] * inv), q3 = (int)rintf(v[q][k][3] * inv);
                    o4[k] = (unsigned)(q0 & 0xff) | ((unsigned)(q1 & 0xff) << 8) | ((unsigned)(q2 & 0xff) << 16) | ((unsigned)(q3 & 0xff) << 24); } }
            *(u32x4*)(dst + (size_t)row * 1024 + 16 * lane) = o4;
            if (lane == 0) scales[row] = sc; } }
    }
}
struct Inputs {
    const float *x, *c, *ctx, *c_ctx, *ada_w, *ada_b, *norm1_g, *norm2_g, *w_in, *gqa_qn_g, *gqa_kn_g, *pool_w, *pool_scale, *mla_qn_g, *mla_kvn_g, *mla_w_uq, *mla_w_ukv, *w_out, *peer_wq, *peer_subkeys, *peer_u, *peer_v, *final_g;
};
__device__ __forceinline__ void phase_cvt(LAS unsigned char* lds, const Inputs& in, const WS& w, int vb, int nvb) {
    LAS float* tile = (LAS float*)lds;
    for (int l = 0; l < 2; ++l) {
        cvt_job(tile, CvtJob{in.w_in + (size_t)l * 1024 * INC, w.WinT() + (size_t)l * 1792 * 1024, nullptr, 1024, INC, 1792, 0}, vb, nvb);
        cvt_job(tile, CvtJob{in.mla_w_uq + (size_t)l * 384 * 576, w.WuqT() + (size_t)l * 768 * 384, in.mla_qn_g + l * 384, 384, 576, 768, 1}, vb, nvb);
        cvt_job(tile, CvtJob{in.mla_w_ukv + (size_t)l * 256 * 768, w.WukvT() + (size_t)l * 768 * 256, in.mla_kvn_g + l * 256, 256, 768, 768, 2}, vb, nvb);
        cvt_job(tile, CvtJob{in.w_out + (size_t)l * 1024 * 1024, w.WoutT() + (size_t)l * 1024 * 1024, nullptr, 1024, 1024, 1024, 3}, vb, nvb);
        cvt_job(tile, CvtJob{in.peer_wq + (size_t)l * 1024 * 2048, w.WqT() + (size_t)l * 2048 * 1024, nullptr, 1024, 2048, 2048, 3}, vb, nvb);
    }
    cvt_flat(in.peer_subkeys, w.SubK(), (size_t)2 * 16 * 128 * 128, vb, nvb);
    { int tp_ = threadIdx.x; asm volatile("" : "+v"(tp_));
      for (int i = vb * 512 + tp_; i < 2 * 4 * 64 * 64; i += nvb * 512) { const int c = i & 63, d = (i >> 6) & 63, lg = i >> 12; w.PoolWT()[i] = f2bf(in.pool_w[(size_t)lg * 4096 + c * 64 + d]); } }
    if (nvb > 144) { if (vb >= 72) { cvt_q8_rows<false>(in.peer_u, w.U8(), w.US(), 2 * NE, vb - 72, nvb - 72); cvt_q8_rows<true>(in.peer_v, w.V8(), w.VS(), 2 * NE, vb - 72, nvb - 72); } }
    else { cvt_q8_rows<false>(in.peer_u, w.U8(), w.US(), 2 * NE, vb, nvb); cvt_q8_rows<true>(in.peer_v, w.V8(), w.VS(), 2 * NE, vb, nvb); }
}

constexpr float ATT_C2G = 0.125f * 1.4426950408889634f, ATT_C2M = 0.10206207261596577f * 1.4426950408889634f;
struct EpiIn {
    static constexpr bool PERM = true;
    WS w; const float* qn_g; const float* kn_g; int pm_base;
    __device__ __forceinline__ void operator()(const f32x4 (&acc)[2][2][4][2], const pg8::Unit& u, int wr, int wc, int fr, int fq) const {
        int type, sub; in_group(4 * u.pn + wc, type, sub);
        if (type == GT_PAD) return;
        const int pm = u.pm + pm_base; const bool isctx = pm >= 256; const int b = isctx ? pm - 256 : pm >> 3; const int t0 = isctx ? 0 : (pm & 7) * 256;
        const size_t rowbase = isctx ? (size_t)NL + (size_t)b * CTX : (size_t)b * S;
        const int keyoff = isctx ? 0 : CTX;
        float gain[2][8];
        if (type == GT_AQ) {
#pragma unroll
            for (int bj = 0; bj < 2; ++bj)
#pragma unroll
                for (int q = 0; q < 8; ++q) gain[bj][q] = qn_g[32 * bj + 8 * fq + q] * ATT_C2G;
        } else if (type == GT_AK) {
#pragma unroll
            for (int bj = 0; bj < 2; ++bj)
#pragma unroll
                for (int q = 0; q < 8; ++q) gain[bj][q] = kn_g[32 * bj + 8 * fq + q];
        }
#pragma unroll
        for (int ai = 0; ai < 2; ++ai)
#pragma unroll
            for (int m = 0; m < 4; ++m) {
                const int t = t0 + 128 * ai + 64 * wr + 16 * m + fr; const size_t row = rowbase + t;
                float v[2][8];
#pragma unroll
                for (int bj = 0; bj < 2; ++bj)
#pragma unroll
                    for (int n = 0; n < 2; ++n)
#pragma unroll
                        for (int i = 0; i < 4; ++i) v[bj][4 * n + i] = acc[ai][bj][m][n][i];
                bf16_t* dst = nullptr;
                if (type == GT_AQ || type == GT_AK) {
                    float ss = 0.f;
#pragma unroll
                    for (int bj = 0; bj < 2; ++bj)
#pragma unroll
                        for (int q = 0; q < 8; ++q) ss += v[bj][q] * v[bj][q];
                    ss += __shfl_xor(ss, 16); ss += __shfl_xor(ss, 32);
                    const float rstd = rsqrtf(ss * (1.f / 64.f) + EPS);
#pragma unroll
                    for (int q = 0; q < 8; ++q) { float x1 = v[0][q] * rstd * gain[0][q], x2 = v[1][q] * rstd * gain[1][q];
                        if (!isctx) { const float2 cs = w.ROPA()[t * 32 + 8 * fq + q]; const float y1 = x1 * cs.x - x2 * cs.y, y2 = x1 * cs.y + x2 * cs.x; x1 = y1; x2 = y2; }
                        v[0][q] = x1; v[1][q] = x2; }
                    if (type == GT_AQ) dst = isctx ? w.Qgc() + (((size_t)b * 6 + sub) * CTX + t) * 64 : w.Qg() + (((size_t)b * 6 + sub) * S + t) * 64;
                    else dst = w.Kg() + (((size_t)b * 2 + sub) * KEYS + keyoff + t) * 64;
                } else if (type == GT_AV) { dst = w.Vg() + (((size_t)b * 2 + sub) * KEYS + keyoff + t) * 64;
                } else if (type == GT_B) { dst = w.Bp() + row * 256 + 64 * sub;
                } else if (type == GT_CQ || type == GT_CKV) {
                    float ss = 0.f;
#pragma unroll
                    for (int bj = 0; bj < 2; ++bj)
#pragma unroll
                        for (int q = 0; q < 8; ++q) ss += v[bj][q] * v[bj][q];
                    ss += __shfl_xor(ss, 16); ss += __shfl_xor(ss, 32);
                    if (type == GT_CQ) { if (fq == 0) w.SSQ()[row * 8 + sub] = ss; dst = w.CQ() + row * 384 + 64 * sub; }
                    else { if (fq == 0) w.SSKV()[row * 4 + sub] = ss; dst = w.CKV() + row * 256 + 64 * sub; }
                } else {
                    if (!isctx) {
#pragma unroll
                        for (int q = 0; q < 8; ++q) { const float2 cs = w.ROPC()[t * 16 + ((8 * fq + q) & 15)]; const float x1 = v[0][q], x2 = v[1][q]; v[0][q] = x1 * cs.x - x2 * cs.y; v[1][q] = x1 * cs.y + x2 * cs.x; } }
                    if (fq < 2) { bf16_t* kd = w.KR() + ((size_t)b * KEYS + keyoff + t) * 32;
#pragma unroll
                        for (int bj = 0; bj < 2; ++bj) { u32x4 o; o.x = cvt_pk_bf16(v[bj][0], v[bj][1]); o.y = cvt_pk_bf16(v[bj][2], v[bj][3]); o.z = cvt_pk_bf16(v[bj][4], v[bj][5]); o.w = cvt_pk_bf16(v[bj][6], v[bj][7]);
                            *(u32x4*)(kd + 16 * bj + 8 * fq) = o; } }
                    continue;
                }
#pragma unroll
                for (int bj = 0; bj < 2; ++bj) { u32x4 o; o.x = cvt_pk_bf16(v[bj][0], v[bj][1]); o.y = cvt_pk_bf16(v[bj][2], v[bj][3]); o.z = cvt_pk_bf16(v[bj][4], v[bj][5]); o.w = cvt_pk_bf16(v[bj][6], v[bj][7]);
                    *(u32x4*)(dst + 32 * bj + 8 * fq) = o; }
            }
    }
};
struct P1Order {
    pg8::StaticOrder so; int nctx_tiles, G, c;
    __device__ bool next(int i, pg8::Unit& u) const {
        const int L = i * G + c;
        if (L < 1792) return so.next(i, u);
        const int Lc = L - 1792; if (Lc >= 32 * nctx_tiles) return false;
        u.pm = 256 + (Lc & 31); u.pn = Lc >> 5; return true;
    }
};
__device__ __forceinline__ void phase_p1(LAS unsigned char* lds, const WS& w, const Inputs& in, int l, int vb, int nvb) {
    EpiIn E{w, in.gqa_qn_g + l * 64, in.gqa_kn_g + l * 64, 0};
    P1Order po; po.so.init(NL, 1792, nvb, vb); po.nctx_tiles = (l == 0) ? 7 : 3; po.G = nvb; po.c = vb;
    pg8::gemm_phase(lds, pg8::Gemm{w.H(), w.WinT() + (size_t)l * 1792 * 1024, NR, 1792, 1024}, po, E);
}

extern __shared__ __attribute__((aligned(16))) unsigned char dyn_lds[];

struct EpiUq {
    static constexpr bool PERM = true;
    WS w;
    __device__ __forceinline__ void operator()(const f32x4 (&acc)[2][2][4][2], const pg8::Unit& u, int wr, int wc, int fr, int fq) const {
        const int g = 4 * u.pn + wc; if (g >= 9) return;
        const int pm = u.pm; const bool isctx = pm >= 256; const int b = isctx ? pm - 256 : pm >> 3; const int t0 = isctx ? 0 : (pm & 7) * 256;
        const size_t rowbase = isctx ? (size_t)NL + (size_t)b * CTX : (size_t)b * S;
        const int head = g < 6 ? g : 2 * (g - 6) + (fq >> 1);
#pragma unroll
        for (int ai = 0; ai < 2; ++ai)
#pragma unroll
            for (int m = 0; m < 4; ++m) {
                const int t = t0 + 128 * ai + 64 * wr + 16 * m + fr; const size_t row = rowbase + t;
                const float4 s0 = *(const float4*)(w.SSQ() + row * 8), s1 = *(const float4*)(w.SSQ() + row * 8 + 4);
                const float rstd = rsqrtf((s0.x + s0.y + s0.z + s0.w + s1.x + s1.y) * (1.f / 384.f) + EPS) * ATT_C2M;
                float v[2][8];
#pragma unroll
                for (int bj = 0; bj < 2; ++bj)
#pragma unroll
                    for (int n = 0; n < 2; ++n)
#pragma unroll
                        for (int i = 0; i < 4; ++i) v[bj][4 * n + i] = acc[ai][bj][m][n][i] * rstd;
                bf16_t* hd = isctx ? w.Qmc() + (((size_t)b * 6 + head) * CTX + t) * 96 : w.Qm() + (((size_t)b * 6 + head) * S + t) * 96;
                if (g >= 6 && !isctx) {
#pragma unroll
                    for (int q = 0; q < 8; ++q) { const float2 cs = w.ROPC()[t * 16 + 8 * (fq & 1) + q]; const float x1 = v[0][q], x2 = v[1][q]; v[0][q] = x1 * cs.x - x2 * cs.y; v[1][q] = x1 * cs.y + x2 * cs.x; } }
#pragma unroll
                for (int bj = 0; bj < 2; ++bj) { u32x4 o; o.x = cvt_pk_bf16(v[bj][0], v[bj][1]); o.y = cvt_pk_bf16(v[bj][2], v[bj][3]); o.z = cvt_pk_bf16(v[bj][4], v[bj][5]); o.w = cvt_pk_bf16(v[bj][6], v[bj][7]);
                    bf16_t* d = g < 6 ? hd + 32 * bj + 8 * fq : hd + 64 + 16 * bj + 8 * (fq & 1);
                    *(u32x4*)d = o; }
            }
    }
};
struct EpiUkv {
    static constexpr bool PERM = true;
    WS w;
    __device__ __forceinline__ void operator()(const f32x4 (&acc)[2][2][4][2], const pg8::Unit& u, int wr, int wc, int fr, int fq) const {
        const int g = 4 * u.pn + wc;
        const int pm = u.pm; const bool isctx = pm >= 256; const int b = isctx ? pm - 256 : pm >> 3; const int t0 = isctx ? 0 : (pm & 7) * 256;
        const size_t rowbase = isctx ? (size_t)NL + (size_t)b * CTX : (size_t)b * S; const int keyoff = isctx ? 0 : CTX;
        bf16_t* base = ((g & 1) ? w.Vm() : w.Kmn()) + ((size_t)b * 6 + (g >> 1)) * KEYS * 64;
#pragma unroll
        for (int ai = 0; ai < 2; ++ai)
#pragma unroll
            for (int m = 0; m < 4; ++m) {
                const int t = t0 + 128 * ai + 64 * wr + 16 * m + fr; const size_t row = rowbase + t;
                const float4 s0 = *(const float4*)(w.SSKV() + row * 4);
                const float rstd = rsqrtf((s0.x + s0.y + s0.z + s0.w) * (1.f / 256.f) + EPS);
                bf16_t* d = base + (size_t)(keyoff + t) * 64;
#pragma unroll
                for (int bj = 0; bj < 2; ++bj) { const f32x4 a0 = acc[ai][bj][m][0] * rstd, a1 = acc[ai][bj][m][1] * rstd;
                    u32x4 o; o.x = cvt_pk_bf16(a0[0], a0[1]); o.y = cvt_pk_bf16(a0[2], a0[3]); o.z = cvt_pk_bf16(a1[0], a1[1]); o.w = cvt_pk_bf16(a1[2], a1[3]);
                    *(u32x4*)(d + 32 * bj + 8 * fq) = o; }
            }
    }
};
constexpr int POOL_X = 0, POOL_P = 272 * 128, POOL_BYTES = 272 * 128 + 256 * 128;
__device__ __forceinline__ void phase_pool(LAS unsigned char* lds, const WS& w, bf16_t* __restrict__ MIX, const bf16_t* __restrict__ WT  , const float* __restrict__ pool_scale, int nrows, int vb, int nvb) {
    int tid_ = threadIdx.x; asm volatile("" : "+v"(tid_));
    const int tid = tid_, lane = tid & 63, wid = __builtin_amdgcn_readfirstlane(tid >> 6), r32 = lane & 31, hi = lane >> 5;
    const int nunits = nrows >> 8;
    for (int u = vb; u < nunits; u += nvb) {
        const int row0 = u << 8; const bool isctx = row0 >= NL; const int L = isctx ? CTX : S; const int t0 = isctx ? 0 : (row0 & (S - 1)); const int seq0 = row0 - t0;
#pragma unroll 1
        for (int g = 0; g < 4; ++g) {
            const int wdw = 2 << g, half = wdw >> 1;
            for (int i = tid; i < 272 * 8; i += 512) { const int rr = i >> 3, ch = i & 7; int t = t0 - 8 + rr; t = t < 0 ? 0 : (t >= L ? L - 1 : t);
                *(LAS u32x4*)(lds + POOL_X + rr * 128 + ch * 16) = *(const u32x4*)(w.Bp() + (size_t)(seq0 + t) * 256 + g * 64 + ch * 8); }
            __syncthreads();
            { const int c = tid & 63, seg = tid >> 6; const LAS bf16_t* X = (const LAS bf16_t*)(lds + POOL_X) + c;
              int t = t0 + seg * 32; int lo = t - half, hiw = t - half + wdw; lo = lo < 0 ? 0 : lo; hiw = hiw > L ? L : hiw;
              float sum = 0.f; for (int q = lo; q < hiw; ++q) sum += bf2f(X[(q - t0 + 8) * 64]);
#pragma unroll 4
              for (int k = 0; k < 32; ++k, ++t) {
                  const int clo = (t - half) < 0 ? 0 : (t - half), chi = (t - half + wdw) > L ? L : (t - half + wdw);
                  const float pv = sum / (float)(chi - clo) - bf2f(X[(t - t0 + 8) * 64]);
                  const int r = seg * 32 + k; *((LAS bf16_t*)(lds + POOL_P + r * 128 + (((c >> 3) ^ ((r >> 1) & 7)) << 4)) + (c & 7)) = f2bf(pv);
                  const int add = t + 1 - half + wdw - 1, drop = t - half;
                  if (add < L) sum += bf2f(X[(add - t0 + 8) * 64]);
                  if (drop >= 0) sum -= bf2f(X[(drop - t0 + 8) * 64]);
              } }
            __syncthreads();
            { f32x16 o0 = {}, o1 = {};
              const bf16_t* wt = WT + (size_t)g * 4096 + (size_t)r32 * 64 + 8 * hi;
#pragma unroll
              for (int s = 0; s < 4; ++s) { const int row = wid * 32 + r32; const bf16x8 pf = *(const LAS bf16x8*)(lds + POOL_P + row * 128 + (((2 * s + hi) ^ ((row >> 1) & 7)) << 4));
                  o0 = mfma32(*(const bf16x8*)(wt + 16 * s), pf, o0); o1 = mfma32(*(const bf16x8*)(wt + 32 * 64 + 16 * s), pf, o1); }
              bf16_t* op = MIX + (size_t)(row0 + wid * 32 + r32) * 1024 + 384 + g * 64 + 4 * hi; const float* ps = pool_scale + g * 64 + 4 * hi;
#pragma unroll
              for (int q = 0; q < 4; ++q) { const f32x4 s0 = *(const f32x4*)(ps + 8 * q), s1 = *(const f32x4*)(ps + 32 + 8 * q); u32x2 a, b;
                  a.x = cvt_pk_bf16(o0[4 * q] * s0[0], o0[4 * q + 1] * s0[1]); a.y = cvt_pk_bf16(o0[4 * q + 2] * s0[2], o0[4 * q + 3] * s0[3]);
                  b.x = cvt_pk_bf16(o1[4 * q] * s1[0], o1[4 * q + 1] * s1[1]); b.y = cvt_pk_bf16(o1[4 * q + 2] * s1[2], o1[4 * q + 3] * s1[3]);
                  *(u32x2*)(op + 8 * q) = a; *(u32x2*)(op + 32 + 8 * q) = b; } }
            __syncthreads();
        }
    }
}
__device__ __forceinline__ void phase_p2(LAS unsigned char* lds, const WS& w, const Inputs& in, int l, int vb, int nvb, int parts = 7) {
    pg8::StaticOrder so;
    if (parts & 1) { EpiUq E{w}; const int M = l == 0 ? NR : NL; so.init(M, 768, nvb, vb); pg8::gemm_phase(lds, pg8::Gemm{w.CQ(), w.WuqT() + (size_t)l * 768 * 384, M, 768, 384}, so, E); }
    if (parts & 2) { EpiUkv E{w}; so.init(NR, 768, nvb, vb); pg8::gemm_phase(lds, pg8::Gemm{w.CKV(), w.WukvT() + (size_t)l * 768 * 256, NR, 768, 256}, so, E); }
    if (parts & 4) phase_pool(lds, w, w.H(), w.PoolWT() + (size_t)l * 4 * 64 * 64, in.pool_scale + l * 256, l == 0 ? NR : NL, vb, nvb);
}

struct EpiOut {
    static constexpr bool PERM = true;
    bf16_t* DLT; const float* gate;
    __device__ __forceinline__ void operator()(const f32x4 (&acc)[2][2][4][2], const pg8::Unit& u, int wr, int wc, int fr, int fq) const {
        const int pm = u.pm; const int mr = pm >= 256 ? 32 : pm >> 3;
        const size_t r0 = (size_t)pm * 256 + wr * 64 + fr; const int col0 = u.pn * 256 + wc * 32 + 8 * fq;
        f32x4 gv[2][2];
#pragma unroll
        for (int bj = 0; bj < 2; ++bj)
#pragma unroll
            for (int n = 0; n < 2; ++n) gv[bj][n] = *(const f32x4*)(gate + (size_t)mr * 6144 + col0 + bj * 128 + 4 * n);
#pragma unroll
        for (int ai = 0; ai < 2; ++ai)
#pragma unroll
            for (int m = 0; m < 4; ++m) { bf16_t* d = DLT + (r0 + ai * 128 + m * 16) * 1024 + col0;
#pragma unroll
                for (int bj = 0; bj < 2; ++bj) { const f32x4 a0 = acc[ai][bj][m][0] * gv[bj][0], a1 = acc[ai][bj][m][1] * gv[bj][1];
                    u32x4 o; o.x = cvt_pk_bf16(a0[0], a0[1]); o.y = cvt_pk_bf16(a0[2], a0[3]); o.z = cvt_pk_bf16(a1[0], a1[1]); o.w = cvt_pk_bf16(a1[2], a1[3]);
                    *(u32x4*)(d + bj * 128) = o; } }
    }
};
__device__ __forceinline__ void phase_p4(LAS unsigned char* lds, const WS& w, const Inputs& in, int l, int vb, int nvb) {
    const float* MODl = w.MOD() + (size_t)l * 33 * 6144;
    EpiOut E{w.PQ(), MODl + 2 * 1024};
    const int M = l == 0 ? NR : NL;
    pg8::StaticOrder so; so.init(M, 1024, nvb, vb);
    pg8::gemm_phase(lds, pg8::Gemm{w.H(), w.WoutT() + (size_t)l * 1024 * 1024, M, 1024, 1024}, so, E);
}

template <bool INBF>
__device__ __forceinline__ void phase_modulate(const float* __restrict__ XLp, const float* __restrict__ XCp, const bf16_t* __restrict__ XBp, bf16_t* __restrict__ Hout, const float* __restrict__ g, const float* __restrict__ MODl, int si, int nrows, int vb, int nvb,
                                               signed char* __restrict__ H8 = nullptr, float* __restrict__ HS = nullptr, const bf16_t* __restrict__ DLT = nullptr, bf16_t* __restrict__ XBo = nullptr) {
    int tid_ = threadIdx.x; asm volatile("" : "+v"(tid_));
    const int tid = tid_, lane = tid & 63, wid = tid >> 6;
    f32x4 gv[4];
#pragma unroll
    for (int i = 0; i < 4; ++i) gv[i] = *(const f32x4*)(g + 256 * i + 4 * lane);
    const int stride = nvb * 8, lastrow = nrows - 1;
    f32x4 nx[4]; u32x2 nxb[4], ndr[4];
#define PM_LOAD(r_) do { const int rr_ = (r_) < nrows ? (r_) : lastrow; const bool ic_ = rr_ >= NL; const float* xp_ = ic_ ? XCp + (size_t)(rr_ - NL) * 1024 : XLp + (size_t)rr_ * 1024; \
        _Pragma("unroll") for (int i = 0; i < 4; ++i) { if (INBF) nxb[i] = *(const u32x2*)(XBp + (size_t)rr_ * 1024 + 256 * i + 4 * lane); else nx[i] = *(const f32x4*)(xp_ + 256 * i + 4 * lane); \
            if (DLT) ndr[i] = *(const u32x2*)(DLT + (size_t)rr_ * 1024 + 256 * i + 4 * lane); } } while (0)
    PM_LOAD(vb * 8 + wid);
    for (int row = vb * 8 + wid; row < nrows; row += stride) {
        const bool isctx = row >= NL; const int mr = isctx ? 32 : row / S;
        f32x4 x[4]; u32x2 dr4[4]; float ss = 0.f;
#pragma unroll
        for (int i = 0; i < 4; ++i) { if (INBF) x[i] = (f32x4){__uint_as_float(nxb[i].x << 16), __uint_as_float(nxb[i].x & 0xffff0000u), __uint_as_float(nxb[i].y << 16), __uint_as_float(nxb[i].y & 0xffff0000u)}; else x[i] = nx[i];
            if (DLT) dr4[i] = ndr[i]; }
        PM_LOAD(row + stride);
#pragma unroll
        for (int i = 0; i < 4; ++i) {
            if (DLT) { const u32x2 dr = dr4[i];
                x[i][0] += __uint_as_float(dr.x << 16); x[i][1] += __uint_as_float(dr.x & 0xffff0000u); x[i][2] += __uint_as_float(dr.y << 16); x[i][3] += __uint_as_float(dr.y & 0xffff0000u);
                u32x2 xo; xo.x = cvt_pk_bf16(x[i][0], x[i][1]); xo.y = cvt_pk_bf16(x[i][2], x[i][3]); *(u32x2*)(XBo + (size_t)row * 1024 + 256 * i + 4 * lane) = xo; }
            ss += x[i][0] * x[i][0] + x[i][1] * x[i][1] + x[i][2] * x[i][2] + x[i][3] * x[i][3]; }
        ss = wave_sum(ss); const float rstd = rsqrtf(ss * (1.f / 1024.f) + EPS);
        const float* sh = MODl + (size_t)mr * 6144 + si * 1024;
        f32x4 y[4]; float am = 0.f;
#pragma unroll
        for (int i = 0; i < 4; ++i) { const f32x4 shv = *(const f32x4*)(sh + 256 * i + 4 * lane), scv = *(const f32x4*)(sh + 1024 + 256 * i + 4 * lane);
            y[i] = x[i] * rstd * gv[i] * (scv + 1.f) + shv;
            am = fmaxf(am, fmaxf(fmaxf(fabsf(y[i][0]), fabsf(y[i][1])), fmaxf(fabsf(y[i][2]), fabsf(y[i][3]))));
            u32x2 o; o.x = cvt_pk_bf16(y[i][0], y[i][1]); o.y = cvt_pk_bf16(y[i][2], y[i][3]);
            *(u32x2*)(Hout + (size_t)row * 1024 + 256 * i + 4 * lane) = o; }
        if (H8) {
#pragma unroll
            for (int o = 32; o > 0; o >>= 1) am = fmaxf(am, __shfl_xor(am, o));
            const float inv = am > 0.f ? 127.f / am : 0.f;
#pragma unroll
            for (int i = 0; i < 4; ++i) { const int q0 = (int)rintf(y[i][0] * inv), q1 = (int)rintf(y[i][1] * inv), q2 = (int)rintf(y[i][2] * inv), q3 = (int)rintf(y[i][3] * inv);
                *(unsigned*)(H8 + (size_t)row * 1024 + 256 * i + 4 * lane) = (unsigned)(q0 & 0xff) | ((unsigned)(q1 & 0xff) << 8) | ((unsigned)(q2 & 0xff) << 16) | ((unsigned)(q3 & 0xff) << 24); }
            if (lane == 0) HS[row] = am > 0.f ? am * (1.f / 127.f) : 1.f;
        }
    }
#undef PM_LOAD
}

struct EpiPQ {
    static constexpr bool PERM = true;
    bf16_t* PQ;
    __device__ __forceinline__ void operator()(const f32x4 (&acc)[2][2][4][2], const pg8::Unit& u, int wr, int wc, int fr, int fq) const {
        const size_t r0 = (size_t)u.pm * 256 + wr * 64 + fr; const int col0 = u.pn * 256 + wc * 32 + 8 * fq;
#pragma unroll
        for (int ai = 0; ai < 2; ++ai)
#pragma unroll
            for (int m = 0; m < 4; ++m) { bf16_t* d = PQ + (r0 + ai * 128 + m * 16) * 2048 + col0;
#pragma unroll
                for (int bj = 0; bj < 2; ++bj) { const f32x4 a0 = acc[ai][bj][m][0], a1 = acc[ai][bj][m][1];
                    u32x4 o; o.x = cvt_pk_bf16(a0[0], a0[1]); o.y = cvt_pk_bf16(a0[2], a0[3]); o.z = cvt_pk_bf16(a1[0], a1[1]); o.w = cvt_pk_bf16(a1[2], a1[3]);
                    *(u32x4*)(d + bj * 128) = o; } }
    }
};
__device__ __forceinline__ void phase_p6a(LAS unsigned char* lds, const WS& w, int l, int vb, int nvb) {
    EpiPQ E{w.PQ()}; const int M = l == 0 ? NR : NL;
    pg8::StaticOrder so; so.init(M, 2048, nvb, vb);
    pg8::gemm_phase(lds, pg8::Gemm{w.H(), w.WqT() + (size_t)l * 2048 * 1024, M, 2048, 1024}, so, E);
}


using bf16x2_t = __attribute__((ext_vector_type(2))) __bf16;
typedef float f32x2 __attribute__((ext_vector_type(2)));
__device__ __forceinline__ float gelu_fast(float x) {
    const float u2 = 1.5957691216057308f * (x + 0.044715f * x * x * x);
    return x * __builtin_amdgcn_rcpf(1.f + __builtin_amdgcn_exp2f(-1.4426950408889634f * u2));
}
#define DPPF(v, ctrl) __builtin_bit_cast(float, __builtin_amdgcn_update_dpp(0, __builtin_bit_cast(int, (v)), (ctrl), 0xf, 0xf, true))
__device__ __forceinline__ float reduce8(float p0, float p1, float p2, float p3, float p4, float p5, float p6, float p7, int lane) {
    auto s01 = __builtin_amdgcn_permlane32_swap(__float_as_uint(p0), __float_as_uint(p1), false, false);
    auto s23 = __builtin_amdgcn_permlane32_swap(__float_as_uint(p2), __float_as_uint(p3), false, false);
    auto s45 = __builtin_amdgcn_permlane32_swap(__float_as_uint(p4), __float_as_uint(p5), false, false);
    auto s67 = __builtin_amdgcn_permlane32_swap(__float_as_uint(p6), __float_as_uint(p7), false, false);
    const float q0 = __uint_as_float(s01[0]) + __uint_as_float(s01[1]), q1 = __uint_as_float(s23[0]) + __uint_as_float(s23[1]);
    const float q2 = __uint_as_float(s45[0]) + __uint_as_float(s45[1]), q3 = __uint_as_float(s67[0]) + __uint_as_float(s67[1]);
    auto t0 = __builtin_amdgcn_permlane16_swap(__float_as_uint(q0), __float_as_uint(q1), false, false);
    auto t1 = __builtin_amdgcn_permlane16_swap(__float_as_uint(q2), __float_as_uint(q3), false, false);
    float r0 = __uint_as_float(t0[0]) + __uint_as_float(t0[1]);
    float r1 = __uint_as_float(t1[0]) + __uint_as_float(t1[1]);
    r0 += DPPF(r0, 0x128); r1 += DPPF(r1, 0x128);
    float z = (lane & 8) ? r1 : r0;
    z += DPPF(z, 0x141);
    z += DPPF(z, 0xB1);
    z += DPPF(z, 0x4E);
    return z;
}
__device__ __forceinline__ void p7_axpy(const u32x4 v, float wj, f32x2 (&out)[8]) {
    const f32x2 w2 = {wj, wj};
#pragma unroll
    for (int k = 0; k < 4; ++k) { const f32x2 lo = __builtin_amdgcn_cvt_pk_f32_fp8((int)v[k], false), hi2 = __builtin_amdgcn_cvt_pk_f32_fp8((int)v[k], true);
        out[2 * k] = __builtin_elementwise_fma(w2, lo, out[2 * k]); out[2 * k + 1] = __builtin_elementwise_fma(w2, hi2, out[2 * k + 1]); }
}
__device__ __forceinline__ int p7_doti(const u32x4 u, const u32x4 h) {
    int s = __builtin_amdgcn_sdot4((int)u[0], (int)h[0], 0, false); s = __builtin_amdgcn_sdot4((int)u[1], (int)h[1], s, false); s = __builtin_amdgcn_sdot4((int)u[2], (int)h[2], s, false); return __builtin_amdgcn_sdot4((int)u[3], (int)h[3], s, false);
}
#define DPPI(v, ctrl) __builtin_amdgcn_update_dpp(0, (v), (ctrl), 0xf, 0xf, true)
__device__ __forceinline__ int reduce8i(int p0, int p1, int p2, int p3, int p4, int p5, int p6, int p7, int lane) {
    auto s01 = __builtin_amdgcn_permlane32_swap((unsigned)p0, (unsigned)p1, false, false); auto s23 = __builtin_amdgcn_permlane32_swap((unsigned)p2, (unsigned)p3, false, false);
    auto s45 = __builtin_amdgcn_permlane32_swap((unsigned)p4, (unsigned)p5, false, false); auto s67 = __builtin_amdgcn_permlane32_swap((unsigned)p6, (unsigned)p7, false, false);
    const unsigned q0 = s01[0] + s01[1], q1 = s23[0] + s23[1], q2 = s45[0] + s45[1], q3 = s67[0] + s67[1];
    auto t0 = __builtin_amdgcn_permlane16_swap(q0, q1, false, false); auto t1 = __builtin_amdgcn_permlane16_swap(q2, q3, false, false);
    int r0 = (int)(t0[0] + t0[1]), r1 = (int)(t1[0] + t1[1]);
    r0 += DPPI(r0, 0x128); r1 += DPPI(r1, 0x128);
    int z = (lane & 8) ? r1 : r0;
    z += DPPI(z, 0x141); z += DPPI(z, 0xB1); z += DPPI(z, 0x4E);
    return z;
}

struct P7CArgs { const signed char* H8; const unsigned* EG; const unsigned char* U8; int* PART; int nrows; };
__device__ __forceinline__ void phase_p7c(LAS unsigned char* lds, const P7CArgs& a, int part, int prank, int nvb) {
    int tid_ = threadIdx.x; asm volatile("" : "+v"(tid_));
    const int lane = tid_ & 63, wid = __builtin_amdgcn_readfirstlane(tid_ >> 6);
    const int nw = (nvb >> 3) * 8, wrank = prank * 8 + wid;
    LAS unsigned* tab = (LAS unsigned*)(lds + wid * 1024);
    const int grp = lane >> 3, c = lane & 7, c16 = c * 16;
    const unsigned char* ubase = a.U8 + 128 * part + c16;
    const signed char* hbase = a.H8 + 128 * part + c16;
    int* pbase = a.PART + (size_t)part * a.nrows * 128;
    const int c2 = (c >> 2) & 1, c1 = (c >> 1) & 1, c0 = c & 1;
    const int ent0 = 8 * (8 * c2 + 4 * c0 + 2 * c1) + grp;
    u32x4 Av[16], Bv[16]; u32x4 Ah, Bh;
    unsigned pw0 = 0u, pw1 = 0u;
#define P7C_PREF(t) do { pw0 = a.EG[(size_t)(t) * 128 + lane]; pw1 = a.EG[(size_t)(t) * 128 + 64 + lane]; } while (0)
#define P7C_ISSUE(X, Xh, t, slot, tnext) do { LAS unsigned* tb_ = tab + (slot) * 128; \
        tb_[lane] = pw0; tb_[64 + lane] = pw1; \
        asm volatile("s_waitcnt lgkmcnt(0)" ::: "memory"); \
        _Pragma("unroll") for (int i_ = 0; i_ < 16; ++i_) { const unsigned e_ = tb_[8 * i_ + grp]; X[i_] = *(const u32x4*)(ubase + (size_t)(e_ >> 16) * 1024); } \
        Xh = *(const u32x4*)(hbase + (size_t)(t) * 1024); \
        P7C_PREF(tnext); } while (0)
#define P7C_X(v, ctrl) ((v) + DPPI((v), (ctrl)))
#define P7C_COMPUTE(X, Xh, t, valid) do { int d_[16]; \
        _Pragma("unroll") for (int i_ = 0; i_ < 16; ++i_) d_[i_] = p7_doti(X[i_], Xh); \
        int e8_[8]; _Pragma("unroll") for (int k = 0; k < 8; ++k) { const int send_ = c2 ? d_[k] : d_[k + 8], keep_ = c2 ? d_[k + 8] : d_[k]; e8_[k] = keep_ + DPPI(send_, 0x141); }            \
        int e4_[4]; _Pragma("unroll") for (int k = 0; k < 4; ++k) { const int send_ = c0 ? e8_[k] : e8_[k + 4], keep_ = c0 ? e8_[k + 4] : e8_[k]; e4_[k] = keep_ + DPPI(send_, 0xB1); }          \
        int e2_[2]; _Pragma("unroll") for (int k = 0; k < 2; ++k) { const int send_ = c1 ? e4_[k] : e4_[k + 2], keep_ = c1 ? e4_[k + 2] : e4_[k]; e2_[k] = keep_ + DPPI(send_, 0x4E); }          \
        if (valid) { int* pp_ = pbase + (size_t)(t) * 128 + ent0; pp_[0] = e2_[0]; pp_[8] = e2_[1]; } } while (0)
    const int lastrow = a.nrows - 1;
    int t = wrank;
    P7C_PREF(t);
    P7C_ISSUE(Av, Ah, t, 0, (t + nw < a.nrows ? t + nw : lastrow));
    while (t < a.nrows) {
        const int t1 = t + nw, t2 = t1 + nw, t3 = t2 + nw;
        const int k1 = t1 < a.nrows ? t1 : lastrow, k2 = t2 < a.nrows ? t2 : lastrow, k3 = t3 < a.nrows ? t3 : lastrow;
        P7C_ISSUE(Bv, Bh, k1, 1, k2);
        P7C_COMPUTE(Av, Ah, t, true);
        P7C_ISSUE(Av, Ah, k2, 0, k3);
        P7C_COMPUTE(Bv, Bh, k1, (t1 < a.nrows));
        t = t2;
    }
#undef P7C_PREF
#undef P7C_ISSUE
#undef P7C_COMPUTE
}
__device__ __forceinline__ void phase_p7d(const int* __restrict__ PART, const unsigned* __restrict__ EG, const float* __restrict__ US, const float* __restrict__ VS, const float* __restrict__ HS, unsigned* __restrict__ WE, int nrows, int vb, int nvb) {
    int tid_ = threadIdx.x; asm volatile("" : "+v"(tid_));
    typedef int i32x4 __attribute__((ext_vector_type(4)));
    const size_t n4 = (size_t)nrows * 32, pstride4 = n4;
    const i32x4* P4 = (const i32x4*)PART; const u32x4* EG4 = (const u32x4*)EG; u32x4* WE4 = (u32x4*)WE;
    for (size_t i = (size_t)vb * 512 + tid_; i < n4; i += (size_t)nvb * 512) {
        i32x4 s = P4[i];
#pragma unroll
        for (int p = 1; p < 8; ++p) s += P4[p * pstride4 + i];
        const u32x4 eg = EG4[i]; const float hs = HS[i >> 5];
        u32x4 o;
#pragma unroll
        for (int k = 0; k < 4; ++k) { const int eid = (int)(eg[k] >> 16);
            const float av = (float)s[k] * US[eid] * hs;
            const float wv = __uint_as_float(eg[k] << 16) * gelu_fast(av) * VS[eid];
            o[k] = (eg[k] & 0xffff0000u) | (cvt_pk_bf16(wv, 0.f) & 0xffffu); }
        WE4[i] = o;
    }
}
struct P7BArgs { const unsigned* WE; const unsigned char* V8; bf16_t* XB; const float* gate2; int nrows; };
template <int PM>
__device__ __forceinline__ void phase_p7b(LAS unsigned char* lds, const P7BArgs& a, int part, int prank, int nvb) {
    int tid_ = threadIdx.x; asm volatile("" : "+v"(tid_));
    const int lane = tid_ & 63, wid = __builtin_amdgcn_readfirstlane(tid_ >> 6);
    const int nw = (nvb >> 3) * 8, wrank = prank * 8 + wid;
    LAS unsigned* tab = (LAS unsigned*)(lds + wid * 1024);
    const int grp = lane >> 3, c16 = (lane & 7) * 16;
    const unsigned char* vbase = a.V8 + 128 * part + c16;
    const int colofs = 128 * part + c16 + 8 * (lane >> 5) + 4 * ((lane >> 4) & 1) + 2 * ((lane >> 3) & 1);
    u32x4 Av[16], Bv[16]; float Aw[16], Bw[16]; unsigned Ax, Bx; f32x2 Ag, Bg;
    unsigned pw0 = 0u, pw1 = 0u;
#define P7B_PREF(t) do { pw0 = a.WE[(size_t)(t) * 128 + lane]; pw1 = a.WE[(size_t)(t) * 128 + 64 + lane]; } while (0)
#define P7B_ISSUE(X, Xw, Xx, Xg, t, slot, tnext) do { LAS unsigned* tb_ = tab + (slot) * 128; \
        tb_[lane] = pw0; tb_[64 + lane] = pw1; \
        asm volatile("s_waitcnt lgkmcnt(0)" ::: "memory"); \
        _Pragma("unroll") for (int i_ = 0; i_ < 16; ++i_) { const unsigned we_ = tb_[8 * i_ + grp]; Xw[i_] = __uint_as_float(we_ << 16); if (PM != 2) X[i_] = *(const u32x4*)(vbase + (size_t)(we_ >> 16) * 1024); else X[i_] = (u32x4){we_, 0x38383838u, 0x38383838u, 0x38383838u}; } \
        { const int mr_ = (t) >= NL ? 32 : (t) / S; \
          Xx = *(const unsigned*)(a.XB + (size_t)(t) * 1024 + colofs); Xg = *(const f32x2*)(a.gate2 + (size_t)mr_ * 6144 + colofs); } \
        P7B_PREF(tnext); } while (0)
#define P7B_COMPUTE(X, Xw, Xx, Xg, t, valid) do { f32x2 acc2[8]; \
        _Pragma("unroll") for (int k = 0; k < 8; ++k) acc2[k] = (f32x2){0.f, 0.f}; \
        if (PM != 1) { _Pragma("unroll") for (int i_ = 0; i_ < 16; ++i_) p7_axpy(X[i_], Xw[i_], acc2); } else { _Pragma("unroll") for (int i_ = 0; i_ < 16; ++i_) acc2[i_ >> 1][i_ & 1] = __uint_as_float((X[i_][0] ^ X[i_][1] ^ X[i_][2] ^ X[i_][3]) & 0x3fffffffu) + Xw[i_]; } \
        float b_[8]; _Pragma("unroll") for (int k = 0; k < 8; ++k) { auto s_ = __builtin_amdgcn_permlane32_swap(__float_as_uint(acc2[k >> 1][k & 1]), __float_as_uint(acc2[(k + 8) >> 1][k & 1]), false, false); b_[k] = __uint_as_float(s_[0]) + __uint_as_float(s_[1]); } \
        float c_[4]; _Pragma("unroll") for (int k = 0; k < 4; ++k) { auto s_ = __builtin_amdgcn_permlane16_swap(__float_as_uint(b_[k]), __float_as_uint(b_[k + 4]), false, false); c_[k] = __uint_as_float(s_[0]) + __uint_as_float(s_[1]); } \
        float d_[2]; _Pragma("unroll") for (int k = 0; k < 2; ++k) { const float send_ = (lane & 8) ? c_[k] : c_[k + 2]; const float keep_ = (lane & 8) ? c_[k + 2] : c_[k]; d_[k] = keep_ + DPPF(send_, 0x128); } \
        unsigned* xp_ = (unsigned*)(a.XB + (size_t)(t) * 1024 + colofs); \
        f32x2 x_ = {__uint_as_float(Xx << 16), __uint_as_float(Xx & 0xffff0000u)}; x_.x += Xg.x * d_[0]; x_.y += Xg.y * d_[1]; if ((valid) && PM == 0) *xp_ = cvt_pk_bf16(x_.x, x_.y); else if (PM != 0 && x_.x == 1.2345e30f) *xp_ = cvt_pk_bf16(x_.x, x_.y); } while (0)
    const int lastrow = a.nrows - 1;
    int t = wrank;
    P7B_PREF(t);
    P7B_ISSUE(Av, Aw, Ax, Ag, t, 0, (t + nw < a.nrows ? t + nw : lastrow));
    while (t < a.nrows) {
        const int t1 = t + nw, t2 = t1 + nw, t3 = t2 + nw;
        const int c1 = t1 < a.nrows ? t1 : lastrow, c2 = t2 < a.nrows ? t2 : lastrow, c3 = t3 < a.nrows ? t3 : lastrow;
        P7B_ISSUE(Bv, Bw, Bx, Bg, c1, 1, c2);
        P7B_COMPUTE(Av, Aw, Ax, Ag, t, true);
        P7B_ISSUE(Av, Aw, Ax, Ag, c2, 0, c3);
        P7B_COMPUTE(Bv, Bw, Bx, Bg, c1, (t1 < a.nrows));
        t = t2;
    }
#undef P7B_PREF
#undef P7B_ISSUE
#undef P7B_COMPUTE
}
__device__ __forceinline__ void phase_final_norm(const bf16_t* __restrict__ XBp, float* __restrict__ OUT, const float* __restrict__ g, int vb, int nvb) {
    int tid_ = threadIdx.x; asm volatile("" : "+v"(tid_));
    const int lane = tid_ & 63, wid = tid_ >> 6;
    for (int row = vb * 8 + wid; row < NL; row += nvb * 8) {
        const bf16_t* xp = XBp + (size_t)row * 1024; f32x4 x[4]; float ss = 0.f;
#pragma unroll
        for (int i = 0; i < 4; ++i) { const u32x2 r = *(const u32x2*)(xp + 256 * i + 4 * lane); x[i] = (f32x4){__uint_as_float(r.x << 16), __uint_as_float(r.x & 0xffff0000u), __uint_as_float(r.y << 16), __uint_as_float(r.y & 0xffff0000u)};
            ss += x[i][0] * x[i][0] + x[i][1] * x[i][1] + x[i][2] * x[i][2] + x[i][3] * x[i][3]; }
        ss = wave_sum(ss); const float rstd = rsqrtf(ss * (1.f / 1024.f) + EPS);
#pragma unroll
        for (int i = 0; i < 4; ++i) *(f32x4*)(OUT + (size_t)row * 1024 + 256 * i + 4 * lane) = x[i] * rstd * *(const f32x4*)(g + 256 * i + 4 * lane);
    }
}

typedef short s16x4 __attribute__((ext_vector_type(4)));
__device__ __forceinline__ s16x4 lds_tr16(const LAS unsigned char* p) { return __builtin_bit_cast(s16x4, __builtin_amdgcn_ds_read_tr16_b64_v4i16((LAS s16x4*)p)); }
constexpr int ATT_BUF = 20480;
template <int DK>
__device__ __forceinline__ void attn_unit(LAS unsigned char* lds, const bf16_t* __restrict__ Q, const bf16_t* __restrict__ K1, const bf16_t* __restrict__ K2, const bf16_t* __restrict__ V,
                                          int nkeys, float c2, bf16_t* __restrict__ out) {
    int tid_ = threadIdx.x; asm volatile("" : "+v"(tid_));
    const int tid = tid_, lane = tid & 63, wid = __builtin_amdgcn_readfirstlane(tid >> 6), r32 = lane & 31, hi = lane >> 5;
    constexpr int NS = DK / 16;
    bf16x8 qf[NS];
    { const bf16_t* qp = Q + (size_t)(wid * 32 + r32) * DK + 8 * hi;
#pragma unroll
      for (int s = 0; s < NS; ++s) qf[s] = *(const bf16x8*)(qp + 16 * s); }
    const int skey = tid >> 3, sch = tid & 7;
    const unsigned st_k1 = skey * 128 + ((sch ^ ((skey >> 1) & 7)) << 4);
    const unsigned st_v = 8192 + skey * 128 + (((sch << 4)) ^ (((skey >> 1) & 1) << 6));
    const int skey2 = (tid & 255) >> 2, sch2 = tid & 3;
    const unsigned st_k2 = 16384 + skey2 * 64 + ((sch2 ^ ((skey2 >> 2) & 3)) << 4);
    const bf16_t* gk1 = K1 + (size_t)skey * 64 + sch * 8; const bf16_t* gv = V + (size_t)skey * 64 + sch * 8;
    const bf16_t* gk2 = (DK == 96) ? K2 + (size_t)skey2 * 32 + sch2 * 8 : nullptr;
    unsigned ka[2][4];
#pragma unroll
    for (int kt = 0; kt < 2; ++kt)
#pragma unroll
        for (int s = 0; s < 4; ++s) { const int key = 32 * kt + r32; ka[kt][s] = key * 128 + (((2 * s + hi) ^ ((key >> 1) & 7)) << 4); }
    unsigned kb[2][2];
#pragma unroll
    for (int kt = 0; kt < 2; ++kt)
#pragma unroll
        for (int s = 0; s < 2; ++s) { const int key = 32 * kt + r32; kb[kt][s] = 16384 + key * 64 + (((2 * s + hi) ^ ((key >> 2) & 3)) << 4); }
    const int vq = (lane & 15) >> 2, vp = lane & 3, vg = (lane >> 4) & 1;
    unsigned va[2];
#pragma unroll
    for (int dvb = 0; dvb < 2; ++dvb) { const int key = 4 * hi + vq; va[dvb] = 8192 + key * 128 + ((((32 * dvb + 16 * vg + 4 * vp) * 2)) ^ (((key >> 1) & 1) << 6)); }
    float m = 0.f, l = 0.f;
    f32x16 o0 = {}, o1 = {}, negm = {};
    const int NT = nkeys >> 6;
    u32x4 sk1, sv, sk2;
    sk1 = *(const u32x4*)gk1; sv = *(const u32x4*)gv; if (DK == 96) { if (tid < 256) sk2 = *(const u32x4*)gk2; }
    *(LAS u32x4*)(lds + st_k1) = sk1; *(LAS u32x4*)(lds + st_v) = sv; if (DK == 96) { if (tid < 256) *(LAS u32x4*)(lds + st_k2) = sk2; }
    __syncthreads();
    for (int t = 0; t < NT; ++t) {
        LAS unsigned char* buf = lds + (t & 1) * ATT_BUF;
        if (t + 1 < NT) { sk1 = *(const u32x4*)(gk1 + (size_t)(t + 1) * 64 * 64); sv = *(const u32x4*)(gv + (size_t)(t + 1) * 64 * 64); if (DK == 96) { if (tid < 256) sk2 = *(const u32x4*)(gk2 + (size_t)(t + 1) * 64 * 32); } }
        bf16x8 kf0[NS], kf1[NS];
#pragma unroll
        for (int s = 0; s < 4; ++s) { kf0[s] = *(const LAS bf16x8*)(buf + ka[0][s]); kf1[s] = *(const LAS bf16x8*)(buf + ka[1][s]); }
        if (DK == 96) {
#pragma unroll
            for (int s = 0; s < 2; ++s) { kf0[4 + s] = *(const LAS bf16x8*)(buf + kb[0][s]); kf1[4 + s] = *(const LAS bf16x8*)(buf + kb[1][s]); }
        }
        __builtin_amdgcn_sched_barrier(0);
        f32x16 p0 = mfma32(kf0[0], qf[0], negm), p1 = mfma32(kf1[0], qf[0], negm);
#pragma unroll
        for (int s = 1; s < NS; ++s) { p0 = mfma32(kf0[s], qf[s], p0); p1 = mfma32(kf1[s], qf[s], p1); }
        __builtin_amdgcn_sched_barrier(0);
        s16x4 vlo[2][2][2], vhi[2][2][2];
#pragma unroll
        for (int kt = 0; kt < 2; ++kt)
#pragma unroll
            for (int sp = 0; sp < 2; ++sp) { const int kofs = (32 * kt + 16 * sp) * 128;
#pragma unroll
                for (int dvb = 0; dvb < 2; ++dvb) { vlo[dvb][kt][sp] = lds_tr16(buf + va[dvb] + kofs); vhi[dvb][kt][sp] = lds_tr16(buf + va[dvb] + kofs + 8 * 128); } }
        __builtin_amdgcn_sched_barrier(0);
        float mx = p0[0];
#pragma unroll
        for (int r = 1; r < 16; ++r) mx = fmaxf(mx, p0[r]);
#pragma unroll
        for (int r = 0; r < 16; ++r) mx = fmaxf(mx, p1[r]);
        { auto rr = __builtin_amdgcn_permlane32_swap(__float_as_uint(mx), __float_as_uint(mx), false, false); mx = fmaxf(__uint_as_float(rr[0]), __uint_as_float(rr[1])); }
        if (t == 0 || __any(mx > 8.f)) {
            const float dn = (t == 0) ? mx : fmaxf(mx, 0.f), al = (t == 0) ? 1.f : __builtin_amdgcn_exp2f(-dn); m += dn; l *= al;
#pragma unroll
            for (int r = 0; r < 16; ++r) { o0[r] *= al; o1[r] *= al; p0[r] -= dn; p1[r] -= dn; negm[r] = -m; }
            asm volatile("" : "+v"(negm));
        }
        f32x2 ls2 = {0.f, 0.f};
#pragma unroll
        for (int r = 0; r < 16; ++r) { p0[r] = __builtin_amdgcn_exp2f(p0[r]); p1[r] = __builtin_amdgcn_exp2f(p1[r]); }
#pragma unroll
        for (int r = 0; r < 16; r += 2) { ls2 += (f32x2){p0[r], p0[r + 1]}; ls2 += (f32x2){p1[r], p1[r + 1]}; }
        const float ls = ls2.x + ls2.y;
        l += ls;
        bf16x8 pf[2][2];
#pragma unroll
        for (int sp = 0; sp < 2; ++sp) { u32x4 a, b;
            a.x = cvt_pk_bf16(p0[8 * sp], p0[8 * sp + 1]); a.y = cvt_pk_bf16(p0[8 * sp + 2], p0[8 * sp + 3]); a.z = cvt_pk_bf16(p0[8 * sp + 4], p0[8 * sp + 5]); a.w = cvt_pk_bf16(p0[8 * sp + 6], p0[8 * sp + 7]);
            b.x = cvt_pk_bf16(p1[8 * sp], p1[8 * sp + 1]); b.y = cvt_pk_bf16(p1[8 * sp + 2], p1[8 * sp + 3]); b.z = cvt_pk_bf16(p1[8 * sp + 4], p1[8 * sp + 5]); b.w = cvt_pk_bf16(p1[8 * sp + 6], p1[8 * sp + 7]);
            pf[0][sp] = __builtin_bit_cast(bf16x8, a); pf[1][sp] = __builtin_bit_cast(bf16x8, b); }
        __builtin_amdgcn_sched_barrier(0);
#pragma unroll
        for (int kt = 0; kt < 2; ++kt)
#pragma unroll
            for (int sp = 0; sp < 2; ++sp) {
                { const s16x4 lo = vlo[0][kt][sp], hi4 = vhi[0][kt][sp]; const bf16x8 vf = (bf16x8){lo[0], lo[1], lo[2], lo[3], hi4[0], hi4[1], hi4[2], hi4[3]}; o0 = mfma32(vf, pf[kt][sp], o0); }
                { const s16x4 lo = vlo[1][kt][sp], hi4 = vhi[1][kt][sp]; const bf16x8 vf = (bf16x8){lo[0], lo[1], lo[2], lo[3], hi4[0], hi4[1], hi4[2], hi4[3]}; o1 = mfma32(vf, pf[kt][sp], o1); } }
        __builtin_amdgcn_sched_barrier(0);
        if (t + 1 < NT) { LAS unsigned char* nb = lds + ((t + 1) & 1) * ATT_BUF; *(LAS u32x4*)(nb + st_k1) = sk1; *(LAS u32x4*)(nb + st_v) = sv; if (DK == 96) { if (tid < 256) *(LAS u32x4*)(nb + st_k2) = sk2; } }
        __syncthreads();
    }
    { auto rr = __builtin_amdgcn_permlane32_swap(__float_as_uint(l), __float_as_uint(l), false, false); l = __uint_as_float(rr[0]) + __uint_as_float(rr[1]); }
    const float il = 1.f / l;
    bf16_t* op = out + (size_t)(wid * 32 + r32) * 1024 + 4 * hi;
#pragma unroll
    for (int g = 0; g < 4; ++g) { u32x2 a, b;
        a.x = cvt_pk_bf16(o0[4 * g] * il, o0[4 * g + 1] * il); a.y = cvt_pk_bf16(o0[4 * g + 2] * il, o0[4 * g + 3] * il);
        b.x = cvt_pk_bf16(o1[4 * g] * il, o1[4 * g + 1] * il); b.y = cvt_pk_bf16(o1[4 * g + 2] * il, o1[4 * g + 3] * il);
        *(u32x2*)(op + 8 * g) = a; *(u32x2*)(op + 32 + 8 * g) = b; }
}
__device__ __forceinline__ void phase_p3(LAS unsigned char* lds, const WS& w, int l, int vb, int nvb) {
    const float c2g = 0.125f * 1.4426950408889634f, c2m = 0.10206207261596577f * 1.4426950408889634f;
    bf16_t* MIX = w.H();
    const int nlat = NB * 12 * 8, nctx = (l == 0) ? NB * 12 : 0;
    for (int u = vb; u < nlat + nctx; u += nvb) {
        if (u < nlat) {
            const int qb = u & 7, slot = (u >> 3) % 12, b = u / 96;
            bf16_t* out = MIX + ((size_t)b * S + qb * 256) * 1024;
            if (slot < 6) attn_unit<64>(lds, w.Qg() + (((size_t)b * 6 + slot) * S + qb * 256) * 64, w.Kg() + ((size_t)b * 2 + slot / 3) * KEYS * 64, nullptr, w.Vg() + ((size_t)b * 2 + slot / 3) * KEYS * 64, KEYS, c2g, out + slot * 64);
            else { const int h = slot - 6; attn_unit<96>(lds, w.Qm() + (((size_t)b * 6 + h) * S + qb * 256) * 96, w.Kmn() + ((size_t)b * 6 + h) * KEYS * 64, w.KR() + (size_t)b * KEYS * 32, w.Vm() + ((size_t)b * 6 + h) * KEYS * 64, KEYS, c2m, out + 640 + h * 64); }
        } else {
            const int v = u - nlat, slot = v % 12, b = v / 12;
            bf16_t* out = MIX + ((size_t)NL + (size_t)b * CTX) * 1024;
            if (slot < 6) attn_unit<64>(lds, w.Qgc() + ((size_t)b * 6 + slot) * CTX * 64, w.Kg() + ((size_t)b * 2 + slot / 3) * KEYS * 64, nullptr, w.Vg() + ((size_t)b * 2 + slot / 3) * KEYS * 64, CTX, c2g, out + slot * 64);
            else { const int h = slot - 6; attn_unit<96>(lds, w.Qmc() + ((size_t)b * 6 + h) * CTX * 96, w.Kmn() + ((size_t)b * 6 + h) * KEYS * 64, w.KR() + (size_t)b * KEYS * 32, w.Vm() + ((size_t)b * 6 + h) * KEYS * 64, CTX, c2m, out + 640 + h * 64); }
        }
    }
}

__device__ __forceinline__ unsigned fkey(float f, unsigned tag, unsigned mask) { unsigned u = __float_as_uint(f); u = (u & 0x80000000u) ? ~u : (u | 0x80000000u); return (u & ~mask) | tag; }
__device__ __forceinline__ float keyf(unsigned k, unsigned mask) { k &= ~mask; const unsigned u = (k & 0x80000000u) ? (k & 0x7fffffffu) : ~k; return __uint_as_float(u); }
__device__ __forceinline__ void ce_desc(unsigned& a, unsigned& b) { const unsigned hi_ = a > b ? a : b, lo_ = a > b ? b : a; a = hi_; b = lo_; }
template <int J, int K> __device__ __forceinline__ void bstage16(unsigned* a) {
#pragma unroll
    for (int i = 0; i < 16; ++i) { const int l = i ^ J; if (l > i) { const unsigned x = a[i], y = a[l]; const unsigned mx = x > y ? x : y, mn = x > y ? y : x; const bool desc = ((i & K) == 0); a[i] = desc ? mx : mn; a[l] = desc ? mn : mx; } }
}
__device__ __forceinline__ void sort16_desc(unsigned* a) {
    bstage16<1, 2>(a); bstage16<2, 4>(a); bstage16<1, 4>(a); bstage16<4, 8>(a); bstage16<2, 8>(a); bstage16<1, 8>(a); bstage16<8, 16>(a); bstage16<4, 16>(a); bstage16<2, 16>(a); bstage16<1, 16>(a);
}
__device__ __forceinline__ void bmerge16_desc(unsigned* c) { bstage16<8, 16>(c); bstage16<4, 16>(c); bstage16<2, 16>(c); bstage16<1, 16>(c); }
__device__ __forceinline__ void merge_top16(unsigned* a, const unsigned* b) {
#pragma unroll
    for (int i = 0; i < 16; ++i) a[i] = a[i] > b[15 - i] ? a[i] : b[15 - i];
    bmerge16_desc(a);
}
__device__ __forceinline__ void xlane_top16(unsigned* t, int hi) {
    unsigned r[16]; const unsigned msk = 0u - (unsigned)hi;
#pragma unroll
    for (int i = 0; i < 16; ++i) r[i] = t[i] ^ ((t[i] ^ t[15 - i]) & msk);
#pragma unroll
    for (int i = 0; i < 16; ++i) { auto s = __builtin_amdgcn_permlane32_swap(r[i], r[i], false, false); t[i] = s[0] > s[1] ? s[0] : s[1]; }
    bmerge16_desc(t);
}
__device__ __forceinline__ constexpr int cand_a(int c) { return c < 16 ? 0 : c < 24 ? 1 : c < 29 ? 2 : c < 33 ? 3 : c < 36 ? 4 : c < 38 ? 5 : c < 40 ? 6 : c < 42 ? 7 : c < 50 ? c - 34 : 0; }
__device__ __forceinline__ constexpr int cand_b(int c) { return c < 16 ? c : c < 24 ? c - 16 : c < 29 ? c - 24 : c < 33 ? c - 29 : c < 36 ? c - 33 : c < 38 ? c - 36 : c < 40 ? c - 38 : c < 42 ? c - 40 : 0; }

__device__ __forceinline__ void phase_p6b(LAS unsigned char* lds, const bf16_t* __restrict__ PQ, const bf16_t* __restrict__ SubKl, unsigned* __restrict__ EG, int nrows, int vb, int nvb) {
    int tid_ = threadIdx.x; asm volatile("" : "+v"(tid_));
    const int tid = tid_, lane = tid & 63, wid = __builtin_amdgcn_readfirstlane(tid >> 6), r32 = lane & 31, hi = lane >> 5;
    const int h = vb & 7, wrank = (vb >> 3) * 8 + wid, nwr = (nvb >> 3) * 8;
    LAS unsigned short* tab = (LAS unsigned short*)(lds + 65536 + wid * 4096) + r32 * 64;
#pragma unroll
    for (int i = 0; i < 8; ++i) { const int idx = i * 512 + tid, p = idx >> 11, key = (idx >> 4) & 127, ch = idx & 15;
        *(LAS u32x4*)(lds + p * 32768 + key * 256 + ((ch ^ (key & 15)) << 4)) = *(const u32x4*)(SubKl + ((size_t)(h * 2 + p) * 128 + key) * 128 + ch * 8); }
    __syncthreads();
    const int ngroups = nrows >> 5;
    for (int tg = wrank; tg < ngroups; tg += nwr) {
        const int row0 = tg << 5;
        bf16x8 qf[2][8];
        { const bf16_t* qp = PQ + (size_t)(row0 + r32) * 2048 + h * 256 + 8 * hi; asm volatile("" : "+v"(qp));
#pragma unroll
          for (int p = 0; p < 2; ++p)
#pragma unroll
              for (int s = 0; s < 8; ++s) qf[p][s] = *(const bf16x8*)(qp + p * 128 + 16 * s); }
        unsigned top[2][16];
#pragma unroll
        for (int p = 0; p < 2; ++p) {
            f32x16 acc[4];
#pragma unroll
            for (int kt = 0; kt < 4; ++kt) { acc[kt] = f32x16{}; const int key = 32 * kt + r32;
#pragma unroll
                for (int s = 0; s < 8; ++s) acc[kt] = mfma32(*(const LAS bf16x8*)(lds + p * 32768 + key * 256 + (((2 * s + hi) ^ (key & 15)) << 4)), qf[p][s], acc[kt]); }
            unsigned key[64];
#pragma unroll
            for (int kt = 0; kt < 4; ++kt)
#pragma unroll
                for (int r = 0; r < 16; ++r) { const int n = 32 * kt + (r & 3) + 8 * (r >> 2) + 4 * hi; key[16 * kt + r] = fkey(acc[kt][r], 127u - (unsigned)n, 127u); }
            sort16_desc(key); sort16_desc(key + 16); sort16_desc(key + 32); sort16_desc(key + 48);
            merge_top16(key, key + 16); merge_top16(key + 32, key + 48); merge_top16(key, key + 32);
            xlane_top16(key, hi);
#pragma unroll
            for (int i = 0; i < 16; ++i) top[p][i] = key[i];
        }
        unsigned ck[64];
#pragma unroll
        for (int c = 0; c < 64; ++c) {
            if (c < 50) { const float sm = keyf(top[0][cand_a(c)], 127u) + keyf(top[1][cand_b(c)], 127u); ck[c] = fkey(sm, (unsigned)c, 63u); } else ck[c] = 0u;
        }
        if (hi == 0) {
#pragma unroll
            for (int c = 0; c < 50; c += 2) {
                const unsigned ea = (127u - (top[0][cand_a(c)] & 127u)) * 128u + (127u - (top[1][cand_b(c)] & 127u));
                const unsigned eb = (127u - (top[0][cand_a(c + 1)] & 127u)) * 128u + (127u - (top[1][cand_b(c + 1)] & 127u));
                *(LAS unsigned*)(tab + c) = ea | (eb << 16);
            }
        }
        sort16_desc(ck); sort16_desc(ck + 16); sort16_desc(ck + 32); sort16_desc(ck + 48);
        merge_top16(ck, ck + 16); merge_top16(ck + 32, ck + 48); merge_top16(ck, ck + 32);
        asm volatile("s_waitcnt lgkmcnt(0)" ::: "memory");
        const float mx = keyf(ck[0], 63u); float e[16], den = 0.f;
#pragma unroll
        for (int j = 0; j < 16; ++j) { e[j] = __builtin_amdgcn_exp2f((keyf(ck[j], 63u) - mx) * 1.4426950408889634f); den += e[j]; }
        const float iden = 1.f / den;
        if (hi == 0) {
            unsigned o[16];
#pragma unroll
            for (int j = 0; j < 16; ++j) { const unsigned eid = tab[ck[j] & 63u]; o[j] = (eid << 16) | (cvt_pk_bf16(e[j] * iden, 0.f) & 0xffffu); }
            unsigned* dst = EG + (size_t)(row0 + r32) * 128 + h * 16;
#pragma unroll
            for (int j = 0; j < 16; j += 4) *(u32x4*)(dst + j) = (u32x4){o[j], o[j + 1], o[j + 2], o[j + 3]};
        }
        asm volatile("s_waitcnt lgkmcnt(0)" ::: "memory");
    }
}


#define XB_TMO      128
#define XB_XCNT(j)  (256  + 64 * (j))
#define XB_XSUB(j)  (1280 + 64 * (j))
#define XB_XGEN(j)  (2304 + 64 * (j))
#define XB_TOP      3328
#define XB_TOPGEN   3392
#define XCD_BAR_WORDS 3456
#define XB_SPIN_CAP (1u << 18)

__device__ __forceinline__ unsigned xb_ld(unsigned* p)              { return __hip_atomic_load(p, __ATOMIC_RELAXED, __HIP_MEMORY_SCOPE_AGENT); }
__device__ __forceinline__ unsigned xb_add(unsigned* p, unsigned v) { return __hip_atomic_fetch_add(p, v, __ATOMIC_RELAXED, __HIP_MEMORY_SCOPE_AGENT); }
__device__ __forceinline__ unsigned xb_xcc_id() { return (unsigned)__builtin_amdgcn_s_getreg((3 << 11) | 20) & 0xFu; }
#define XB_SPIN(cond, bar) do { unsigned _sp = 0; while (cond) { __builtin_amdgcn_s_sleep(1); \
    if ((++_sp & 255u) == 0u) { if (xb_ld(&(bar)[XB_TMO])) break; if (_sp > XB_SPIN_CAP) { atomicAdd(&(bar)[XB_TMO], 1u); break; } } } } while (0)

struct XcdBarrier {
    unsigned* bar; unsigned x;
    volatile LAS unsigned* st;
};

__device__ __forceinline__ XcdBarrier xcd_barrier_post(unsigned* bar, volatile LAS unsigned* st) {
    XcdBarrier b; b.bar = bar; b.x = xb_xcc_id(); b.st = st;
    if (threadIdx.x == 0) (void)xb_add(&bar[XB_XCNT(b.x)], 1u);
    return b;
}
__device__ __forceinline__ void xcd_barrier_complete(unsigned* bar, unsigned x, unsigned& nloc, unsigned& nx) {
    const unsigned G = gridDim.x * gridDim.y * gridDim.z;
    unsigned sum, cnt, mine, sp = 0u;
    for (;;) {
        sum = 0u; cnt = 0u; mine = 0u;
#pragma unroll
        for (unsigned j = 0; j < 16; ++j) { const unsigned c = xb_ld(&bar[XB_XCNT(j)]); sum += c; cnt += (c > 0u) ? 1u : 0u; mine = (j == x) ? c : mine; }
        if (sum == G) break;
        __builtin_amdgcn_s_sleep(1);
        if ((++sp & 255u) == 0u) { if (xb_ld(&bar[XB_TMO])) break; if (sp > XB_SPIN_CAP) { atomicAdd(&bar[XB_TMO], 1u); break; } }
    }
    nloc = mine > 0u ? mine : 1u; nx = cnt > 0u ? cnt : 1u;
}

__device__ __forceinline__ void xcd_barrier(const XcdBarrier& b) {
    asm volatile("s_waitcnt vmcnt(0)" ::: "memory");
    __syncthreads();
    if (threadIdx.x == 0) {
        unsigned* bar = b.bar;
        __builtin_amdgcn_s_waitcnt(0);
        unsigned nloc = b.st[0], nx = b.st[1];
        if (nloc == 0u) { xcd_barrier_complete(bar, b.x, nloc, nx); b.st[0] = nloc; b.st[1] = nx; }
        const unsigned old = xb_add(&bar[XB_XSUB(b.x)], 1u);
        const unsigned gen = old / nloc;
        if (old + 1u == (gen + 1u) * nloc) {
            __builtin_amdgcn_fence(__ATOMIC_RELEASE, "agent");
            asm volatile("s_waitcnt vmcnt(0)" ::: "memory");
            const unsigned og = xb_add(&bar[XB_TOP], 1u);
            const unsigned tg = og / nx;
            if (og + 1u == (tg + 1u) * nx) xb_add(&bar[XB_TOPGEN], 1u);
            else XB_SPIN(xb_ld(&bar[XB_TOPGEN]) == tg, bar);
            __builtin_amdgcn_fence(__ATOMIC_ACQUIRE, "agent");
            xb_add(&bar[XB_XGEN(b.x)], 1u);
            asm volatile("s_waitcnt vmcnt(0)" ::: "memory");
        } else {
            XB_SPIN(xb_ld(&bar[XB_XGEN(b.x)]) == gen, bar);
            __builtin_amdgcn_fence(__ATOMIC_ACQUIRE, "agent");
            asm volatile("s_waitcnt vmcnt(0)" ::: "memory");
        }
    }
    __syncthreads();
}

__device__ __forceinline__ void phase_mod(LAS unsigned char* lds, const Inputs& in, const WS& w, int vb) {
    if (vb >= 72) return;
    LAS float* sc = (LAS float*)lds;
    int tid_ = threadIdx.x; asm volatile("" : "+v"(tid_));
    const int tid = tid_, idx = vb * 512 + tid, rg = idx / 12288, ln = idx % 12288, l = ln / 6144, n = ln % 6144;
    float acc[11];
#pragma unroll
    for (int i = 0; i < 11; ++i) acc[i] = 0.f;
    const float* wp = in.ada_w + (size_t)l * 1024 * 6144 + n;
    for (int kc = 0; kc < 4; ++kc) {
        for (int i = tid; i < 33 * 256; i += 512) { const int r = i >> 8, k = kc * 256 + (i & 255); const float v = r < 32 ? in.c[(size_t)r * 1024 + k] : in.c_ctx[k]; sc[i] = v / (1.f + __expf(-v)); }
        __syncthreads();
        for (int k = 0; k < 256; ++k) { const float wv = wp[(size_t)(kc * 256 + k) * 6144];
#pragma unroll
            for (int i = 0; i < 11; ++i) acc[i] += sc[(rg * 11 + i) * 256 + k] * wv; }
        __syncthreads();
    }
    const float bias = in.ada_b[(size_t)l * 6144 + n];
#pragma unroll
    for (int i = 0; i < 11; ++i) w.MOD()[((size_t)l * 33 + rg * 11 + i) * 6144 + n] = acc[i] + bias;
}
__device__ __forceinline__ void phase_rope(const WS& w, int vb, int nvb) {
    int tid_ = threadIdx.x; asm volatile("" : "+v"(tid_));
    for (int i = vb * 512 + tid_; i < 2048 * 32; i += nvb * 512) {
        { const int t = i / 32, j = i % 32; const double inv = pow(10000.0, -(double)(j % 16) / 16.0); const double a = (double)(j < 16 ? t / 64 : t % 64) * inv; w.ROPA()[i] = make_float2((float)cos(a), (float)sin(a)); }
        if (i < 2048 * 16) { const int t = i / 16, j = i % 16; const double inv = pow(10000.0, -(double)(j % 8) / 8.0); const double a = (double)(j < 8 ? t / 64 : t % 64) * inv; w.ROPC()[i] = make_float2((float)cos(a), (float)sin(a)); }
    }
}

#ifndef PROBE_MASK
#define PROBE_MASK 0
#endif
struct MegaArgs { Inputs in; WS w; float* XL; unsigned* bar; };
constexpr int MEGA_LDS = 131072 + 16;
__global__ void __launch_bounds__(512, 2) k_mega(MegaArgs A) {
    LAS unsigned char* lds = (LAS unsigned char*)dyn_lds;
    const int vb = blockIdx.x, nvb = gridDim.x;
    volatile LAS unsigned* xbw = (volatile LAS unsigned*)(lds + 131072);
    if (threadIdx.x == 0) { xbw[0] = 0u; xbw[1] = 0u; xbw[2] = 0u; xbw[3] = 0u; }
    __syncthreads();
    XcdBarrier bar = xcd_barrier_post(A.bar, xbw);
    if (threadIdx.x == 0) xbw[2] = xb_add(&A.bar[3584 + 64 * bar.x], 1u);
    __syncthreads();
    const int xticket = __builtin_amdgcn_readfirstlane((int)xbw[2]);
    const WS& w = A.w; const Inputs& in = A.in;
    phase_mod(lds, in, w, vb);
    phase_rope(w, vb, nvb);
    phase_cvt(lds, in, w, vb, nvb);
    xcd_barrier(bar);
    phase_modulate<false>(in.x, in.ctx, nullptr, w.H(), in.norm1_g, w.MOD(), 0, NR, vb, nvb);
    xcd_barrier(bar);
#if (PROBE_MASK >> 0) & 1
    phase_mod(lds, in, w, vb);
    phase_rope(w, vb, nvb);
    phase_cvt(lds, in, w, vb, nvb);
    xcd_barrier(bar);
    phase_modulate<false>(in.x, in.ctx, nullptr, w.H(), in.norm1_g, w.MOD(), 0, NR, vb, nvb);
    xcd_barrier(bar);
#endif
    int xpart = vb & 7, xrank = vb >> 3;
    { bool okx = (bar.x < 8u); for (unsigned j = 0; j < 8; ++j) okx = okx && (xb_ld(&A.bar[XB_XCNT(j)]) == (unsigned)(nvb >> 3));
      if (okx) { xpart = (int)bar.x; xrank = xticket; } }
    for (int l = 0; l < DEPTH; ++l) {
        const float* MODl = w.MOD() + (size_t)l * 33 * 6144;
        const bool last = (l == DEPTH - 1);
        const int MR = last ? NL : NR;
        phase_p1(lds, w, in, l, vb, nvb); xcd_barrier(bar);
#if (PROBE_MASK >> 1) & 1
        phase_p1(lds, w, in, l, vb, nvb); xcd_barrier(bar);
#endif
        phase_p2(lds, w, in, l, vb, nvb); xcd_barrier(bar);
#if (PROBE_MASK >> 12) & 7
        phase_p2(lds, w, in, l, vb, nvb, (PROBE_MASK >> 12) & 7); xcd_barrier(bar);
#endif
        phase_p3(lds, w, l, vb, nvb); xcd_barrier(bar);
#if (PROBE_MASK >> 3) & 1
        phase_p3(lds, w, l, vb, nvb); xcd_barrier(bar);
#endif
        phase_p4(lds, w, in, l, vb, nvb);
        xcd_barrier(bar);
#if (PROBE_MASK >> 4) & 1
        phase_p4(lds, w, in, l, vb, nvb);
        xcd_barrier(bar);
#endif
        if (l == 0) phase_modulate<false>(in.x, in.ctx, nullptr, w.H(), in.norm2_g + l * 1024, MODl, 3, MR, vb, nvb, w.H8(), w.HS(), w.PQ(), w.XB());
        else phase_modulate<true>(nullptr, nullptr, w.XB(), w.H(), in.norm2_g + l * 1024, MODl, 3, MR, vb, nvb, w.H8(), w.HS(), w.PQ(), w.XB());
        xcd_barrier(bar);
#if (PROBE_MASK >> 5) & 1
        phase_modulate<true>(nullptr, nullptr, w.XB(), w.H(), in.norm2_g + l * 1024, MODl, 3, MR, vb, nvb, w.H8(), w.HS()); xcd_barrier(bar);
#endif
        phase_p6a(lds, w, l, vb, nvb); xcd_barrier(bar);
#if (PROBE_MASK >> 6) & 1
        phase_p6a(lds, w, l, vb, nvb); xcd_barrier(bar);
#endif
        phase_p6b(lds, w.PQ(), w.SubK() + (size_t)l * 16 * 128 * 128, w.EG(), MR, vb, nvb); xcd_barrier(bar);
#if (PROBE_MASK >> 7) & 1
        phase_p6b(lds, w.PQ(), w.SubK() + (size_t)l * 16 * 128 * 128, w.EG(), MR, vb, nvb); xcd_barrier(bar);
#endif
        { P7CArgs a{w.H8(), w.EG(), w.U8() + (size_t)l * NE * 1024, (int*)w.PQ(), MR}; phase_p7c(lds, a, xpart, xrank, nvb); }
        xcd_barrier(bar);
#if (PROBE_MASK >> 8) & 1
        { P7CArgs a{w.H8(), w.EG(), w.U8() + (size_t)l * NE * 1024, (int*)w.PQ(), MR}; phase_p7c(lds, a, xpart, xrank, nvb); }
        xcd_barrier(bar);
#endif
        phase_p7d((const int*)w.PQ(), w.EG(), w.US() + (size_t)l * NE, w.VS() + (size_t)l * NE, w.HS(), w.WE(), MR, vb, nvb);
        xcd_barrier(bar);
#if (PROBE_MASK >> 9) & 1
        phase_p7d((const int*)w.PQ(), w.EG(), w.US() + (size_t)l * NE, w.VS() + (size_t)l * NE, w.HS(), w.WE(), MR, vb, nvb);
        xcd_barrier(bar);
#endif
        { P7BArgs a{w.WE(), w.V8() + (size_t)l * NE * 1024, w.XB(), MODl + 5 * 1024, MR}; phase_p7b<0>(lds, a, xpart, xrank, nvb); }
        xcd_barrier(bar);
#if (PROBE_MASK >> 10) & 3
        { P7BArgs a{w.WE(), w.V8() + (size_t)l * NE * 1024, w.XB(), MODl + 5 * 1024, MR}; phase_p7b<((PROBE_MASK >> 10) & 3)>(lds, a, xpart, xrank, nvb); }
        xcd_barrier(bar);
#endif
        if (last) phase_final_norm(w.XB(), A.XL, in.final_g, vb, nvb);
        else phase_modulate<true>(nullptr, nullptr, w.XB(), w.H(), in.norm1_g + (l + 1) * 1024, w.MOD() + (size_t)(l + 1) * 33 * 6144, 0, NR, vb, nvb);
        if (!last) xcd_barrier(bar);
    }
}

extern "C" void kernel_launch(void* const* d_in, const int* in_sizes, int n_in, void* d_out, int out_size, void* d_ws, size_t ws_size, hipStream_t stream) {
    const float* const* fin = (const float* const*)d_in;
    Inputs in{fin[0], fin[1], fin[2], fin[3], fin[4], fin[5], fin[6], fin[7], fin[8], fin[9], fin[10], fin[11], fin[12], fin[13], fin[14], fin[15], fin[16], fin[17], fin[18], fin[19], fin[20], fin[21], fin[22]};
    WS w = make_ws(d_ws);
    static int ok = 0;
    if (!ok) {
        if (hipFuncSetAttribute((const void*)k_mega, hipFuncAttributeMaxDynamicSharedMemorySize, MEGA_LDS) != hipSuccess) { ok = -1; }
        int per_cu = 0, cus = 0, dev = 0; (void)hipGetDevice(&dev); (void)hipDeviceGetAttribute(&cus, hipDeviceAttributeMultiprocessorCount, dev);
        if (hipOccupancyMaxActiveBlocksPerMultiprocessor(&per_cu, (const void*)k_mega, 512, MEGA_LDS) != hipSuccess || per_cu < 1 || cus < 256) ok = -1;
        if (ok == 0) ok = 1;
    }
    if (ok < 0) return;
    (void)hipMemsetAsync(d_ws, 0, 16384, stream);
    MegaArgs A{in, w, (float*)d_out, (unsigned*)d_ws};
    k_mega<<<256, 512, MEGA_LDS, stream>>>(A);
}
```

```cpp
#include <hip/hip_runtime.h>
#include <stdint.h>

typedef unsigned short bf16_t;

constexpr int D = 1024, NB = 32, S = 2048, CTX = 256, DEPTH = 2;
constexpr int NL = NB * S, NC = NB * CTX, NR = NL + NC;
constexpr int KEYS = CTX + S;
constexpr int INC = 1568;
constexpr int NE = 16384;
constexpr float EPS = 1e-6f;

__device__ __forceinline__ float bf2f(bf16_t v) { return __uint_as_float(((unsigned)v) << 16); }
__device__ __forceinline__ bf16_t f2bf(float f) { unsigned u = __float_as_uint(f); u += 0x7FFFu + ((u >> 16) & 1u); return (bf16_t)(u >> 16); }

__device__ __forceinline__ float wave_sum(float v) {
#pragma unroll
    for (int o = 32; o > 0; o >>= 1) v += __shfl_xor(v, o);
    return v;
}
__device__ __forceinline__ float gelu_tanh(float x) {
    const float u = 0.7978845608028654f * (x + 0.044715f * x * x * x);
    return 0.5f * x * (1.f + tanhf(u));
}

struct WS {
    char* base;
    __host__ __device__ __forceinline__ bf16_t* H() const { return (bf16_t*)(base + 65536ull); }
    __host__ __device__ __forceinline__ bf16_t* Qg() const { return (bf16_t*)(base + 151060480ull); }
    __host__ __device__ __forceinline__ bf16_t* Qgc() const { return (bf16_t*)(base + 201392128ull); }
    __host__ __device__ __forceinline__ bf16_t* Kg() const { return (bf16_t*)(base + 207683584ull); }
    __host__ __device__ __forceinline__ bf16_t* Vg() const { return (bf16_t*)(base + 226557952ull); }
    __host__ __device__ __forceinline__ bf16_t* CQ() const { return (bf16_t*)(base + 245432320ull); }
    __host__ __device__ __forceinline__ bf16_t* CKV() const { return (bf16_t*)(base + 302055424ull); }
    __host__ __device__ __forceinline__ bf16_t* Bp() const { return (bf16_t*)(base + 339804160ull); }
    __host__ __device__ __forceinline__ bf16_t* KR() const { return (bf16_t*)(base + 377552896ull); }
    __host__ __device__ __forceinline__ bf16_t* Qm() const { return (bf16_t*)(base + 382271488ull); }
    __host__ __device__ __forceinline__ bf16_t* Qmc() const { return (bf16_t*)(base + 457768960ull); }
    __host__ __device__ __forceinline__ bf16_t* Kmn() const { return (bf16_t*)(base + 467206144ull); }
    __host__ __device__ __forceinline__ bf16_t* Vm() const { return (bf16_t*)(base + 523829248ull); }
    __host__ __device__ __forceinline__ unsigned* EG() const { return (unsigned*)(base + 580452352ull); }
    __host__ __device__ __forceinline__ bf16_t* P() const { return (bf16_t*)(base + 382271488ull); }
    __host__ __device__ __forceinline__ bf16_t* PQ() const { return (bf16_t*)(base + 151060480ull); }
    __host__ __device__ __forceinline__ bf16_t* TMP() const { return (bf16_t*)(base + 65536ull); }
    __host__ __device__ __forceinline__ float* XC() const { return (float*)(base + 618201088ull); }
    __host__ __device__ __forceinline__ float* MOD() const { return (float*)(base + 651755520ull); }
    __host__ __device__ __forceinline__ float2* ROPA() const { return (float2*)(base + 653377536ull); }
    __host__ __device__ __forceinline__ float2* ROPC() const { return (float2*)(base + 653901824ull); }
    __host__ __device__ __forceinline__ float* RSQ() const { return (float*)(base + 654163968ull); }
    __host__ __device__ __forceinline__ float* RSKV() const { return (float*)(base + 654458880ull); }
    __host__ __device__ __forceinline__ bf16_t* WinT() const { return (bf16_t*)(base + 654753792ull); }
    __host__ __device__ __forceinline__ bf16_t* WuqT() const { return (bf16_t*)(base + 662093824ull); }
    __host__ __device__ __forceinline__ bf16_t* WukvT() const { return (bf16_t*)(base + 663273472ull); }
    __host__ __device__ __forceinline__ bf16_t* WoutT() const { return (bf16_t*)(base + 664059904ull); }
    __host__ __device__ __forceinline__ bf16_t* WqT() const { return (bf16_t*)(base + 668254208ull); }
    __host__ __device__ __forceinline__ bf16_t* SubK() const { return (bf16_t*)(base + 676642816ull); }
    __host__ __device__ __forceinline__ unsigned char* U8() const { return (unsigned char*)(base + 677691392ull); }
    __host__ __device__ __forceinline__ unsigned char* V8() const { return (unsigned char*)(base + 711245824ull); }
    __host__ __device__ __forceinline__ float* US() const { return (float*)(base + 744800256ull); }
    __host__ __device__ __forceinline__ float* VS() const { return (float*)(base + 744931328ull); }
    __host__ __device__ __forceinline__ float* SSQ() const { return (float*)(base + 745062400ull); }
    __host__ __device__ __forceinline__ float* SSKV() const { return (float*)(base + 747421696ull); }
    __host__ __device__ __forceinline__ unsigned* WE() const { return (unsigned*)(base + 748601344ull); }
    __host__ __device__ __forceinline__ signed char* H8() const { return (signed char*)(base + 786350080ull); }
    __host__ __device__ __forceinline__ float* HS() const { return (float*)(base + 861847552ull); }
    __host__ __device__ __forceinline__ bf16_t* PoolWT() const { return (bf16_t*)(base + 862142464ull); }
    __host__ __device__ __forceinline__ bf16_t* XB() const { return (bf16_t*)(base + 862208000ull); }
};
constexpr size_t WS_BYTES = 862208000ull + (size_t)NR * 1024 * 2;
static WS make_ws(void* d_ws) { WS w; w.base = (char*)d_ws; return w; }


#define LAS __attribute__((address_space(3)))
typedef short bf16x8 __attribute__((ext_vector_type(8)));
typedef float f32x4 __attribute__((ext_vector_type(4)));
typedef float f32x16 __attribute__((ext_vector_type(16)));
typedef unsigned u32x4 __attribute__((ext_vector_type(4)));
typedef unsigned u32x2 __attribute__((ext_vector_type(2)));

__device__ __forceinline__ f32x16 mfma32(bf16x8 a, bf16x8 b, f32x16 c) { return __builtin_amdgcn_mfma_f32_32x32x16_bf16(a, b, c, 0, 0, 0); }
__device__ __forceinline__ unsigned cvt_pk_bf16(float lo, float hi) { unsigned r; asm volatile("v_cvt_pk_bf16_f32 %0, %1, %2" : "=v"(r) : "v"(lo), "v"(hi)); return r; }

namespace pg8 {
constexpr int BM = 256, BK = 64, HALF = 128, HTB = HALF * BK * 2, STAGE_BYTES = 8 * HTB, NXCD = 8, WGM = 8;
__host__ __device__ __forceinline__ int lds_byte(int r, int c) { const int st = (r >> 4) * 2 + (c >> 5), rr = r & 15, cc = c & 31, ob = rr * 64 + cc * 2; return st * 1024 + (ob ^ (((ob >> 9) & 1) << 5)); }
__host__ __device__ __forceinline__ void stage_rc(int b, int& R, int& C) { const int st = b / 1024, sb = b % 1024, swz = sb ^ (((sb >> 9) & 1) << 5); R = (st >> 1) * 16 + swz / 64; C = (st & 1) * 32 + (swz % 64) / 2; }
__host__ __device__ __forceinline__ int perm32(int rho) { const int n = rho >> 4, i = rho & 15; return 8 * (i >> 2) + 4 * n + (i & 3); }
struct Unit { int pm, pn; };
struct Gemm { const bf16_t* A; const bf16_t* Bt; int M, N, K; };
struct StaticOrder {
    int nM, nN, nwg, G, c;
    __host__ __device__ void init(int M, int N, int G_, int c_) { nM = M / BM; nN = N / BM; nwg = nM * nN; G = G_; c = c_; }
    __host__ __device__ bool next(int i, Unit& u) const {
        const long L = (long)i * G + c; if (L >= nwg) return false;
        int wgid = (int)L; { const int q = nwg / NXCD, r = nwg % NXCD, xcd = wgid % NXCD, off = wgid / NXCD; wgid = (xcd < r ? xcd * (q + 1) : r * (q + 1) + (xcd - r) * q) + off; }
        const int nig = WGM * nN, gid = wgid / nig, fm = gid * WGM, gsz = (nM - fm) < WGM ? (nM - fm) : WGM;
        u.pm = fm + ((wgid % nig) % gsz); u.pn = (wgid % nig) / gsz; return true;
    }
};
template <class Epi, class Sched>
__device__ __forceinline__ void gemm_phase(LAS unsigned char* lds, const Gemm g, const Sched& S, const Epi& E) {
    int tid_ = threadIdx.x; asm volatile("" : "+v"(tid_));
    const int tid = tid_, wid = __builtin_amdgcn_readfirstlane(tid >> 6), lane = tid & 63, wr = wid >> 2, wc = wid & 3, fr = lane & 15, fq = lane >> 4;
    const int K = g.K, nt = K / BK;
    unsigned voffA[2], voffB[2];
#pragma unroll
    for (int i = 0; i < 2; ++i) { int R, C; stage_rc(tid * 16 + i * 8192, R, C); const int Rb = Epi::PERM ? ((R & ~31) + perm32(R & 31)) : R;
        voffA[i] = (unsigned)(R * K + C) * 2u; voffB[i] = (unsigned)(Rb * K + C) * 2u; }
    const size_t kstep = (size_t)(BK * 2);
    const size_t hstep = (size_t)HALF * K * 2;
    const size_t tstep = 2 * hstep;
    const unsigned ldsw = (unsigned)wid * 1024u;
    const int aoff = lds_byte(wr * 64 + fr, fq * 8), boff = lds_byte(wc * 32 + fr, fq * 8);
#define PG8_SA(b, h) (((b) * 2 + (h)) * HTB)
#define PG8_SB(b, h) ((4 + (b) * 2 + (h)) * HTB)
#define PG8_STAGE(bufoff, gbase, voff) do { _Pragma("unroll") for (int _i = 0; _i < 2; ++_i) \
        __builtin_amdgcn_global_load_lds((const unsigned*)((const char*)(gbase) + (voff)[_i]), (LAS unsigned*)(lds + (bufoff) + ldsw + _i * 8192), 16, 0, 0); } while (0)
#define PG8_LDA(dst, b, h) do { _Pragma("unroll") for (int m = 0; m < 4; ++m) _Pragma("unroll") for (int k = 0; k < 2; ++k) dst[m][k] = *(const LAS bf16x8*)(lds + PG8_SA(b, h) + aoff + m * 2048 + k * 1024); } while (0)
#define PG8_LDB(dst, b, h) do { _Pragma("unroll") for (int n = 0; n < 2; ++n) _Pragma("unroll") for (int k = 0; k < 2; ++k) dst[n][k] = *(const LAS bf16x8*)(lds + PG8_SB(b, h) + boff + n * 2048 + k * 1024); } while (0)
#define PG8_MMA(ai, bj, At, Bt) do { __builtin_amdgcn_s_setprio(1); _Pragma("unroll") for (int m = 0; m < 4; ++m) _Pragma("unroll") for (int n = 0; n < 2; ++n) _Pragma("unroll") for (int k = 0; k < 2; ++k) \
        acc[ai][bj][m][n] = __builtin_amdgcn_mfma_f32_16x16x32_bf16(Bt[n][k], At[m][k], acc[ai][bj][m][n], 0, 0, 0); __builtin_amdgcn_s_setprio(0); } while (0)
#define PG8_WAIT_V(n) asm volatile("s_waitcnt vmcnt(" #n ")" ::: "memory")
#define PG8_WAIT_L(n) asm volatile("s_waitcnt lgkmcnt(" #n ")" ::: "memory")
#define PG8_BAR __builtin_amdgcn_s_barrier()
#define PG8_SCHED __builtin_amdgcn_sched_barrier(0)
    Unit cur, nxt; int ui = 0;
    if (!S.next(0, cur)) return;
    f32x4 acc[2][2][4][2];
#pragma unroll
    for (int a = 0; a < 2; ++a)
#pragma unroll
        for (int b = 0; b < 2; ++b)
#pragma unroll
            for (int m = 0; m < 4; ++m)
#pragma unroll
                for (int n = 0; n < 2; ++n) acc[a][b][m][n] = (f32x4){0.f, 0.f, 0.f, 0.f};
    bf16x8 At[4][2], B0[2][2], B1[2][2];
    const char* cA = (const char*)g.A + (size_t)cur.pm * tstep; const char* cB = (const char*)g.Bt + (size_t)cur.pn * tstep;
    PG8_STAGE(PG8_SB(0, 0), cB, voffB); PG8_STAGE(PG8_SA(0, 0), cA, voffA); PG8_STAGE(PG8_SB(0, 1), cB + hstep, voffB); PG8_STAGE(PG8_SA(0, 1), cA + hstep, voffA);
    if (wr == 1) PG8_BAR;
    PG8_WAIT_V(4); PG8_BAR;
    PG8_STAGE(PG8_SB(1, 0), cB + kstep, voffB); PG8_STAGE(PG8_SA(1, 0), cA + kstep, voffA); PG8_STAGE(PG8_SB(1, 1), cB + hstep + kstep, voffB);
    PG8_WAIT_V(6); PG8_BAR;
    for (;;) {
        const bool has_next = S.next(ui + 1, nxt);
        const char* nA = has_next ? (const char*)g.A + (size_t)nxt.pm * tstep : cA; const char* nB = has_next ? (const char*)g.Bt + (size_t)nxt.pn * tstep : cB;
#pragma nounroll
        for (int t = 0; t < nt; t += 2) {
            const bool last = (t == nt - 2);
            const char* a1 = cA + (size_t)(t + 1) * kstep;
            const char* a2 = last ? nA : cA + (size_t)(t + 2) * kstep; const char* b2 = last ? nB : cB + (size_t)(t + 2) * kstep;
            const char* a3 = a2 + kstep; const char* b3 = b2 + kstep;
            PG8_LDB(B0, 0, 0); PG8_SCHED; PG8_LDA(At, 0, 0); PG8_STAGE(PG8_SA(1, 1), a1 + hstep, voffA);
            PG8_WAIT_L(8); PG8_BAR; PG8_WAIT_L(0); PG8_MMA(0, 0, At, B0); PG8_BAR; PG8_SCHED;
            PG8_LDB(B1, 0, 1); PG8_STAGE(PG8_SB(0, 0), b2, voffB);
            PG8_BAR; PG8_WAIT_L(0); PG8_MMA(0, 1, At, B1); PG8_BAR;
            PG8_LDA(At, 0, 1); PG8_STAGE(PG8_SA(0, 0), a2, voffA);
            PG8_BAR; PG8_WAIT_L(0); PG8_MMA(1, 0, At, B0); PG8_BAR; PG8_SCHED;
            PG8_STAGE(PG8_SB(0, 1), b2 + hstep, voffB);
            PG8_WAIT_V(6); PG8_BAR; PG8_MMA(1, 1, At, B1); PG8_BAR;
            PG8_LDB(B0, 1, 0); PG8_SCHED; PG8_LDA(At, 1, 0); PG8_STAGE(PG8_SA(0, 1), a2 + hstep, voffA);
            PG8_WAIT_L(8); PG8_BAR; PG8_WAIT_L(0); PG8_MMA(0, 0, At, B0); PG8_BAR; PG8_SCHED;
            PG8_LDB(B1, 1, 1); PG8_STAGE(PG8_SB(1, 0), b3, voffB);
            PG8_BAR; PG8_WAIT_L(0); PG8_MMA(0, 1, At, B1); PG8_BAR;
            PG8_LDA(At, 1, 1); PG8_STAGE(PG8_SA(1, 0), a3, voffA);
            PG8_BAR; PG8_WAIT_L(0); PG8_MMA(1, 0, At, B0); PG8_BAR; PG8_SCHED;
            PG8_STAGE(PG8_SB(1, 1), b3 + hstep, voffB);
            PG8_WAIT_V(6); PG8_BAR; PG8_MMA(1, 1, At, B1); PG8_BAR;
        }
        E(acc, cur, wr, wc, fr, fq);
        if (!has_next) break;
#pragma unroll
        for (int a = 0; a < 2; ++a)
#pragma unroll
            for (int b = 0; b < 2; ++b)
#pragma unroll
                for (int m = 0; m < 4; ++m)
#pragma unroll
                    for (int n = 0; n < 2; ++n) acc[a][b][m][n] = (f32x4){0.f, 0.f, 0.f, 0.f};
        cur = nxt; cA = nA; cB = nB; ++ui;
    }
    PG8_WAIT_V(0);
    if (wr == 0) PG8_BAR;
    PG8_BAR;
#undef PG8_SA
#undef PG8_SB
#undef PG8_STAGE
#undef PG8_LDA
#undef PG8_LDB
#undef PG8_MMA
#undef PG8_WAIT_V
#undef PG8_WAIT_L
#undef PG8_BAR
#undef PG8_SCHED
}
}

enum { GT_AQ = 0, GT_AK = 1, GT_AV = 2, GT_B = 3, GT_CQ = 4, GT_CKV = 5, GT_KR = 6, GT_PAD = 7 };
__host__ __device__ __forceinline__ void in_group(int g, int& type, int& sub) {
    if (g < 2) { type = GT_AK; sub = g; } else if (g < 4) { type = GT_AV; sub = g - 2; } else if (g < 8) { type = GT_CKV; sub = g - 4; }
    else if (g == 8) { type = GT_KR; sub = 0; } else if (g < 12) { type = GT_PAD; sub = 0; } else if (g < 18) { type = GT_AQ; sub = g - 12; }
    else if (g < 24) { type = GT_CQ; sub = g - 18; } else { type = GT_B; sub = g - 24; }
}
__device__ __forceinline__ int colmap(int mode, int r) {
    const int pn = r >> 8, ct = r & 255, bj = ct >> 7, wc = (ct >> 5) & 3, j = ct & 31, g = 4 * pn + wc, e = 32 * bj + j;
    if (mode == 0) {
        int type, sub; in_group(g, type, sub);
        switch (type) { case GT_AQ: return 64 * sub + e; case GT_AK: return 384 + 64 * sub + e; case GT_AV: return 512 + 64 * sub + e; case GT_B: return 640 + 64 * sub + e;
            case GT_CQ: return 896 + 64 * sub + e; case GT_CKV: return 1280 + 64 * sub + e; case GT_KR: return (j < 16) ? 1536 + 16 * bj + j : -1; default: return -1; }
    } else if (mode == 1) {
        if (g < 6) return 96 * g + e; if (g < 9) { const int head = 2 * (g - 6) + (j >> 4); return 96 * head + 64 + 16 * bj + (j & 15); } return -1;
    } else if (mode == 2) {
        return 64 * g + e;
    }
    return r;
}
__device__ __forceinline__ void cvt_weights_unit(LAS float* tile  , const float* __restrict__ W, int K, int N, bf16_t* __restrict__ dst, int mode, const float* __restrict__ kgain, int r0, int k0) {
    int tid_ = threadIdx.x; asm volatile("" : "+v"(tid_));
    const int tid = tid_;
    const int jj = tid & 63; const int sc = colmap(mode, r0 + jj);
#pragma unroll
    for (int i = 0; i < 8; ++i) { const int kk = (tid >> 6) + 8 * i; float v = 0.f; if (sc >= 0) v = W[(size_t)(k0 + kk) * N + sc]; if (kgain) v *= kgain[k0 + kk]; tile[kk * 65 + jj] = v; }
    __syncthreads();
#pragma unroll
    for (int i = 0; i < 8; ++i) { const int rr = (tid >> 6) + 8 * i, kk = tid & 63; dst[(size_t)(r0 + rr) * K + k0 + kk] = f2bf(tile[kk * 65 + rr]); }
    __syncthreads();
}
struct CvtJob { const float* W; bf16_t* dst; const float* kgain; int K, N, Npad, mode; };
__device__ __forceinline__ void cvt_job(LAS float* tile, const CvtJob j, int vb, int nvb) {
    const int nk = j.K / 64, nr = j.Npad / 64;
    for (int u = vb; u < nk * nr; u += nvb) cvt_weights_unit(tile, j.W, j.K, j.N, j.dst, j.mode, j.kgain, (u / nk) * 64, (u % nk) * 64);
}
__device__ __forceinline__ void cvt_flat(const float* __restrict__ src, bf16_t* __restrict__ dst, size_t n, int vb, int nvb) {
    int tid_ = threadIdx.x; asm volatile("" : "+v"(tid_));
    for (size_t i = ((size_t)vb * 512 + tid_) * 8; i < n; i += (size_t)nvb * 512 * 8) {
        const float4 a = *(const float4*)(src + i), b = *(const float4*)(src + i + 4);
        u32x4 o; o.x = cvt_pk_bf16(a.x, a.y); o.y = cvt_pk_bf16(a.z, a.w); o.z = cvt_pk_bf16(b.x, b.y); o.w = cvt_pk_bf16(b.z, b.w);
        *(u32x4*)(dst + i) = o;
    }
}
template <bool FP8>
__device__ __forceinline__ void cvt_q8_rows(const float* __restrict__ src, unsigned char* __restrict__ dst, float* __restrict__ scales, int nrows, int vb, int nvb) {
    int tid_ = threadIdx.x; asm volatile("" : "+v"(tid_));
    const int lane = tid_ & 63, wid = tid_ >> 6;
    const int stride = nvb * 8;
    for (int row0 = vb * 8 + wid; row0 < nrows; row0 += 4 * stride) {
        f32x4 v[4][4];
#pragma unroll
        for (int q = 0; q < 4; ++q) { const int row = row0 + q * stride < nrows ? row0 + q * stride : row0; const float* sp = src + (size_t)row * 1024 + 16 * lane;
#pragma unroll
            for (int k = 0; k < 4; ++k) v[q][k] = *(const f32x4*)(sp + 4 * k); }
#pragma unroll
        for (int q = 0; q < 4; ++q) { const int row = row0 + q * stride; if (row < nrows) {
            float am = 0.f;
#pragma unroll
            for (int k = 0; k < 4; ++k) am = fmaxf(am, fmaxf(fmaxf(fabsf(v[q][k][0]), fabsf(v[q][k][1])), fmaxf(fabsf(v[q][k][2]), fabsf(v[q][k][3]))));
#pragma unroll
            for (int o = 32; o > 0; o >>= 1) am = fmaxf(am, __shfl_xor(am, o));
            const float qmax = FP8 ? 416.f : 127.f;
            const float sc = am > 0.f ? am / qmax : 1.f, inv = am > 0.f ? qmax / am : 0.f;
            u32x4 o4;
#pragma unroll
            for (int k = 0; k < 4; ++k) {
                if (FP8) { int p = __builtin_amdgcn_cvt_pk_fp8_f32(v[q][k][0] * inv, v[q][k][1] * inv, 0, false); p = __builtin_amdgcn_cvt_pk_fp8_f32(v[q][k][2] * inv, v[q][k][3] * inv, p, true); o4[k] = (unsigned)p; }
                else { const int q0 = (int)rintf(v[q][k][0] * inv), q1 = (int)rintf(v[q][k][1] * inv), q2 = (int)rintf(v[q][k][2] * inv), q3 = (int)rintf(v[q][k][3] * inv);
                    o4[k] = (unsigned)(q0 & 0xff) | ((unsigned)(q1 & 0xff) << 8) | ((unsigned)(q2 & 0xff) << 16) | ((unsigned)(q3 & 0xff) << 24); } }
            *(u32x4*)(dst + (size_t)row * 1024 + 16 * lane) = o4;
            if (lane == 0) scales[row] = sc; } }
    }
}
struct Inputs {
    const float *x, *c, *ctx, *c_ctx, *ada_w, *ada_b, *norm1_g, *norm2_g, *w_in, *gqa_qn_g, *gqa_kn_g, *pool_w, *pool_scale, *mla_qn_g, *mla_kvn_g, *mla_w_uq, *mla_w_ukv, *w_out, *peer_wq, *peer_subkeys, *peer_u, *peer_v, *final_g;
};
__device__ __forceinline__ void phase_cvt(LAS unsigned char* lds, const Inputs& in, const WS& w, int vb, int nvb) {
    LAS float* tile = (LAS float*)lds;
    for (int l = 0; l < 2; ++l) {
        cvt_job(tile, CvtJob{in.w_in + (size_t)l * 1024 * INC, w.WinT() + (size_t)l * 1792 * 1024, nullptr, 1024, INC, 1792, 0}, vb, nvb);
        cvt_job(tile, CvtJob{in.mla_w_uq + (size_t)l * 384 * 576, w.WuqT() + (size_t)l * 768 * 384, in.mla_qn_g + l * 384, 384, 576, 768, 1}, vb, nvb);
        cvt_job(tile, CvtJob{in.mla_w_ukv + (size_t)l * 256 * 768, w.WukvT() + (size_t)l * 768 * 256, in.mla_kvn_g + l * 256, 256, 768, 768, 2}, vb, nvb);
        cvt_job(tile, CvtJob{in.w_out + (size_t)l * 1024 * 1024, w.WoutT() + (size_t)l * 1024 * 1024, nullptr, 1024, 1024, 1024, 3}, vb, nvb);
        cvt_job(tile, CvtJob{in.peer_wq + (size_t)l * 1024 * 2048, w.WqT() + (size_t)l * 2048 * 1024, nullptr, 1024, 2048, 2048, 3}, vb, nvb);
    }
    cvt_flat(in.peer_subkeys, w.SubK(), (size_t)2 * 16 * 128 * 128, vb, nvb);
    { int tp_ = threadIdx.x; asm volatile("" : "+v"(tp_));
      for (int i = vb * 512 + tp_; i < 2 * 4 * 64 * 64; i += nvb * 512) { const int c = i & 63, d = (i >> 6) & 63, lg = i >> 12; w.PoolWT()[i] = f2bf(in.pool_w[(size_t)lg * 4096 + c * 64 + d]); } }
    if (nvb > 144) { if (vb >= 72) { cvt_q8_rows<false>(in.peer_u, w.U8(), w.US(), 2 * NE, vb - 72, nvb - 72); cvt_q8_rows<true>(in.peer_v, w.V8(), w.VS(), 2 * NE, vb - 72, nvb - 72); } }
    else { cvt_q8_rows<false>(in.peer_u, w.U8(), w.US(), 2 * NE, vb, nvb); cvt_q8_rows<true>(in.peer_v, w.V8(), w.VS(), 2 * NE, vb, nvb); }
}

constexpr float ATT_C2G = 0.125f * 1.4426950408889634f, ATT_C2M = 0.10206207261596577f * 1.4426950408889634f;
struct EpiIn {
    static constexpr bool PERM = true;
    WS w; const float* qn_g; const float* kn_g; int pm_base;
    __device__ __forceinline__ void operator()(const f32x4 (&acc)[2][2][4][2], const pg8::Unit& u, int wr, int wc, int fr, int fq) const {
        int type, sub; in_group(4 * u.pn + wc, type, sub);
        if (type == GT_PAD) return;
        const int pm = u.pm + pm_base; const bool isctx = pm >= 256; const int b = isctx ? pm - 256 : pm >> 3; const int t0 = isctx ? 0 : (pm & 7) * 256;
        const size_t rowbase = isctx ? (size_t)NL + (size_t)b * CTX : (size_t)b * S;
        const int keyoff = isctx ? 0 : CTX;
        float gain[2][8];
        if (type == GT_AQ) {
#pragma unroll
            for (int bj = 0; bj < 2; ++bj)
#pragma unroll
                for (int q = 0; q < 8; ++q) gain[bj][q] = qn_g[32 * bj + 8 * fq + q] * ATT_C2G;
        } else if (type == GT_AK) {
#pragma unroll
            for (int bj = 0; bj < 2; ++bj)
#pragma unroll
                for (int q = 0; q < 8; ++q) gain[bj][q] = kn_g[32 * bj + 8 * fq + q];
        }
#pragma unroll
        for (int ai = 0; ai < 2; ++ai)
#pragma unroll
            for (int m = 0; m < 4; ++m) {
                const int t = t0 + 128 * ai + 64 * wr + 16 * m + fr; const size_t row = rowbase + t;
                float v[2][8];
#pragma unroll
                for (int bj = 0; bj < 2; ++bj)
#pragma unroll
                    for (int n = 0; n < 2; ++n)
#pragma unroll
                        for (int i = 0; i < 4; ++i) v[bj][4 * n + i] = acc[ai][bj][m][n][i];
                bf16_t* dst = nullptr;
                if (type == GT_AQ || type == GT_AK) {
                    float ss = 0.f;
#pragma unroll
                    for (int bj = 0; bj < 2; ++bj)
#pragma unroll
                        for (int q = 0; q < 8; ++q) ss += v[bj][q] * v[bj][q];
                    ss += __shfl_xor(ss, 16); ss += __shfl_xor(ss, 32);
                    const float rstd = rsqrtf(ss * (1.f / 64.f) + EPS);
#pragma unroll
                    for (int q = 0; q < 8; ++q) { float x1 = v[0][q] * rstd * gain[0][q], x2 = v[1][q] * rstd * gain[1][q];
                        if (!isctx) { const float2 cs = w.ROPA()[t * 32 + 8 * fq + q]; const float y1 = x1 * cs.x - x2 * cs.y, y2 = x1 * cs.y + x2 * cs.x; x1 = y1; x2 = y2; }
                        v[0][q] = x1; v[1][q] = x2; }
                    if (type == GT_AQ) dst = isctx ? w.Qgc() + (((size_t)b * 6 + sub) * CTX + t) * 64 : w.Qg() + (((size_t)b * 6 + sub) * S + t) * 64;
                    else dst = w.Kg() + (((size_t)b * 2 + sub) * KEYS + keyoff + t) * 64;
                } else if (type == GT_AV) { dst = w.Vg() + (((size_t)b * 2 + sub) * KEYS + keyoff + t) * 64;
                } else if (type == GT_B) { dst = w.Bp() + row * 256 + 64 * sub;
                } else if (type == GT_CQ || type == GT_CKV) {
                    float ss = 0.f;
#pragma unroll
                    for (int bj = 0; bj < 2; ++bj)
#pragma unroll
                        for (int q = 0; q < 8; ++q) ss += v[bj][q] * v[bj][q];
                    ss += __shfl_xor(ss, 16); ss += __shfl_xor(ss, 32);
                    if (type == GT_CQ) { if (fq == 0) w.SSQ()[row * 8 + sub] = ss; dst = w.CQ() + row * 384 + 64 * sub; }
                    else { if (fq == 0) w.SSKV()[row * 4 + sub] = ss; dst = w.CKV() + row * 256 + 64 * sub; }
                } else {
                    if (!isctx) {
#pragma unroll
                        for (int q = 0; q < 8; ++q) { const float2 cs = w.ROPC()[t * 16 + ((8 * fq + q) & 15)]; const float x1 = v[0][q], x2 = v[1][q]; v[0][q] = x1 * cs.x - x2 * cs.y; v[1][q] = x1 * cs.y + x2 * cs.x; } }
                    if (fq < 2) { bf16_t* kd = w.KR() + ((size_t)b * KEYS + keyoff + t) * 32;
#pragma unroll
                        for (int bj = 0; bj < 2; ++bj) { u32x4 o; o.x = cvt_pk_bf16(v[bj][0], v[bj][1]); o.y = cvt_pk_bf16(v[bj][2], v[bj][3]); o.z = cvt_pk_bf16(v[bj][4], v[bj][5]); o.w = cvt_pk_bf16(v[bj][6], v[bj][7]);
                            *(u32x4*)(kd + 16 * bj + 8 * fq) = o; } }
                    continue;
                }
#pragma unroll
                for (int bj = 0; bj < 2; ++bj) { u32x4 o; o.x = cvt_pk_bf16(v[bj][0], v[bj][1]); o.y = cvt_pk_bf16(v[bj][2], v[bj][3]); o.z = cvt_pk_bf16(v[bj][4], v[bj][5]); o.w = cvt_pk_bf16(v[bj][6], v[bj][7]);
                    *(u32x4*)(dst + 32 * bj + 8 * fq) = o; }
            }
    }
};
struct P1Order {
    pg8::StaticOrder so; int nctx_tiles, G, c;
    __device__ bool next(int i, pg8::Unit& u) const {
        const int L = i * G + c;
        if (L < 1792) return so.next(i, u);
        const int Lc = L - 1792; if (Lc >= 32 * nctx_tiles) return false;
        u.pm = 256 + (Lc & 31); u.pn = Lc >> 5; return true;
    }
};
__device__ __forceinline__ void phase_p1(LAS unsigned char* lds, const WS& w, const Inputs& in, int l, int vb, int nvb) {
    EpiIn E{w, in.gqa_qn_g + l * 64, in.gqa_kn_g + l * 64, 0};
    P1Order po; po.so.init(NL, 1792, nvb, vb); po.nctx_tiles = (l == 0) ? 7 : 3; po.G = nvb; po.c = vb;
    pg8::gemm_phase(lds, pg8::Gemm{w.H(), w.WinT() + (size_t)l * 1792 * 1024, NR, 1792, 1024}, po, E);
}

extern __shared__ __attribute__((aligned(16))) unsigned char dyn_lds[];

struct EpiUq {
    static constexpr bool PERM = true;
    WS w;
    __device__ __forceinline__ void operator()(const f32x4 (&acc)[2][2][4][2], const pg8::Unit& u, int wr, int wc, int fr, int fq) const {
        const int g = 4 * u.pn + wc; if (g >= 9) return;
        const int pm = u.pm; const bool isctx = pm >= 256; const int b = isctx ? pm - 256 : pm >> 3; const int t0 = isctx ? 0 : (pm & 7) * 256;
        const size_t rowbase = isctx ? (size_t)NL + (size_t)b * CTX : (size_t)b * S;
        const int head = g < 6 ? g : 2 * (g - 6) + (fq >> 1);
#pragma unroll
        for (int ai = 0; ai < 2; ++ai)
#pragma unroll
            for (int m = 0; m < 4; ++m) {
                const int t = t0 + 128 * ai + 64 * wr + 16 * m + fr; const size_t row = rowbase + t;
                const float4 s0 = *(const float4*)(w.SSQ() + row * 8), s1 = *(const float4*)(w.SSQ() + row * 8 + 4);
                const float rstd = rsqrtf((s0.x + s0.y + s0.z + s0.w + s1.x + s1.y) * (1.f / 384.f) + EPS) * ATT_C2M;
                float v[2][8];
#pragma unroll
                for (int bj = 0; bj < 2; ++bj)
#pragma unroll
                    for (int n = 0; n < 2; ++n)
#pragma unroll
                        for (int i = 0; i < 4; ++i) v[bj][4 * n + i] = acc[ai][bj][m][n][i] * rstd;
                bf16_t* hd = isctx ? w.Qmc() + (((size_t)b * 6 + head) * CTX + t) * 96 : w.Qm() + (((size_t)b * 6 + head) * S + t) * 96;
                if (g >= 6 && !isctx) {
#pragma unroll
                    for (int q = 0; q < 8; ++q) { const float2 cs = w.ROPC()[t * 16 + 8 * (fq & 1) + q]; const float x1 = v[0][q], x2 = v[1][q]; v[0][q] = x1 * cs.x - x2 * cs.y; v[1][q] = x1 * cs.y + x2 * cs.x; } }
#pragma unroll
                for (int bj = 0; bj < 2; ++bj) { u32x4 o; o.x = cvt_pk_bf16(v[bj][0], v[bj][1]); o.y = cvt_pk_bf16(v[bj][2], v[bj][3]); o.z = cvt_pk_bf16(v[bj][4], v[bj][5]); o.w = cvt_pk_bf16(v[bj][6], v[bj][7]);
                    bf16_t* d = g < 6 ? hd + 32 * bj + 8 * fq : hd + 64 + 16 * bj + 8 * (fq & 1);
                    *(u32x4*)d = o; }
            }
    }
};
struct EpiUkv {
    static constexpr bool PERM = true;
    WS w;
    __device__ __forceinline__ void operator()(const f32x4 (&acc)[2][2][4][2], const pg8::Unit& u, int wr, int wc, int fr, int fq) const {
        const int g = 4 * u.pn + wc;
        const int pm = u.pm; const bool isctx = pm >= 256; const int b = isctx ? pm - 256 : pm >> 3; const int t0 = isctx ? 0 : (pm & 7) * 256;
        const size_t rowbase = isctx ? (size_t)NL + (size_t)b * CTX : (size_t)b * S; const int keyoff = isctx ? 0 : CTX;
        bf16_t* base = ((g & 1) ? w.Vm() : w.Kmn()) + ((size_t)b * 6 + (g >> 1)) * KEYS * 64;
#pragma unroll
        for (int ai = 0; ai < 2; ++ai)
#pragma unroll
            for (int m = 0; m < 4; ++m) {
                const int t = t0 + 128 * ai + 64 * wr + 16 * m + fr; const size_t row = rowbase + t;
                const float4 s0 = *(const float4*)(w.SSKV() + row * 4);
                const float rstd = rsqrtf((s0.x + s0.y + s0.z + s0.w) * (1.f / 256.f) + EPS);
                bf16_t* d = base + (size_t)(keyoff + t) * 64;
#pragma unroll
                for (int bj = 0; bj < 2; ++bj) { const f32x4 a0 = acc[ai][bj][m][0] * rstd, a1 = acc[ai][bj][m][1] * rstd;
                    u32x4 o; o.x = cvt_pk_bf16(a0[0], a0[1]); o.y = cvt_pk_bf16(a0[2], a0[3]); o.z = cvt_pk_bf16(a1[0], a1[1]); o.w = cvt_pk_bf16(a1[2], a1[3]);
                    *(u32x4*)(d + 32 * bj + 8 * fq) = o; }
            }
    }
};
constexpr int POOL_X = 0, POOL_P = 272 * 128, POOL_BYTES = 272 * 128 + 256 * 128;
__device__ __forceinline__ void phase_pool(LAS unsigned char* lds, const WS& w, bf16_t* __restrict__ MIX, const bf16_t* __restrict__ WT  , const float* __restrict__ pool_scale, int nrows, int vb, int nvb) {
    int tid_ = threadIdx.x; asm volatile("" : "+v"(tid_));
    const int tid = tid_, lane = tid & 63, wid = __builtin_amdgcn_readfirstlane(tid >> 6), r32 = lane & 31, hi = lane >> 5;
    const int nunits = nrows >> 8;
    for (int u = vb; u < nunits; u += nvb) {
        const int row0 = u << 8; const bool isctx = row0 >= NL; const int L = isctx ? CTX : S; const int t0 = isctx ? 0 : (row0 & (S - 1)); const int seq0 = row0 - t0;
#pragma unroll 1
        for (int g = 0; g < 4; ++g) {
            const int wdw = 2 << g, half = wdw >> 1;
            for (int i = tid; i < 272 * 8; i += 512) { const int rr = i >> 3, ch = i & 7; int t = t0 - 8 + rr; t = t < 0 ? 0 : (t >= L ? L - 1 : t);
                *(LAS u32x4*)(lds + POOL_X + rr * 128 + ch * 16) = *(const u32x4*)(w.Bp() + (size_t)(seq0 + t) * 256 + g * 64 + ch * 8); }
            __syncthreads();
            { const int c = tid & 63, seg = tid >> 6; const LAS bf16_t* X = (const LAS bf16_t*)(lds + POOL_X) + c;
              int t = t0 + seg * 32; int lo = t - half, hiw = t - half + wdw; lo = lo < 0 ? 0 : lo; hiw = hiw > L ? L : hiw;
              float sum = 0.f; for (int q = lo; q < hiw; ++q) sum += bf2f(X[(q - t0 + 8) * 64]);
#pragma unroll 4
              for (int k = 0; k < 32; ++k, ++t) {
                  const int clo = (t - half) < 0 ? 0 : (t - half), chi = (t - half + wdw) > L ? L : (t - half + wdw);
                  const float pv = sum / (float)(chi - clo) - bf2f(X[(t - t0 + 8) * 64]);
                  const int r = seg * 32 + k; *((LAS bf16_t*)(lds + POOL_P + r * 128 + (((c >> 3) ^ ((r >> 1) & 7)) << 4)) + (c & 7)) = f2bf(pv);
                  const int add = t + 1 - half + wdw - 1, drop = t - half;
                  if (add < L) sum += bf2f(X[(add - t0 + 8) * 64]);
                  if (drop >= 0) sum -= bf2f(X[(drop - t0 + 8) * 64]);
              } }
            __syncthreads();
            { f32x16 o0 = {}, o1 = {};
              const bf16_t* wt = WT + (size_t)g * 4096 + (size_t)r32 * 64 + 8 * hi;
#pragma unroll
              for (int s = 0; s < 4; ++s) { const int row = wid * 32 + r32; const bf16x8 pf = *(const LAS bf16x8*)(lds + POOL_P + row * 128 + (((2 * s + hi) ^ ((row >> 1) & 7)) << 4));
                  o0 = mfma32(*(const bf16x8*)(wt + 16 * s), pf, o0); o1 = mfma32(*(const bf16x8*)(wt + 32 * 64 + 16 * s), pf, o1); }
              bf16_t* op = MIX + (size_t)(row0 + wid * 32 + r32) * 1024 + 384 + g * 64 + 4 * hi; const float* ps = pool_scale + g * 64 + 4 * hi;
#pragma unroll
              for (int q = 0; q < 4; ++q) { const f32x4 s0 = *(const f32x4*)(ps + 8 * q), s1 = *(const f32x4*)(ps + 32 + 8 * q); u32x2 a, b;
                  a.x = cvt_pk_bf16(o0[4 * q] * s0[0], o0[4 * q + 1] * s0[1]); a.y = cvt_pk_bf16(o0[4 * q + 2] * s0[2], o0[4 * q + 3] * s0[3]);
                  b.x = cvt_pk_bf16(o1[4 * q] * s1[0], o1[4 * q + 1] * s1[1]); b.y = cvt_pk_bf16(o1[4 * q + 2] * s1[2], o1[4 * q + 3] * s1[3]);
                  *(u32x2*)(op + 8 * q) = a; *(u32x2*)(op + 32 + 8 * q) = b; } }
            __syncthreads();
        }
    }
}
__device__ __forceinline__ void phase_p2(LAS unsigned char* lds, const WS& w, const Inputs& in, int l, int vb, int nvb, int parts = 7) {
    pg8::StaticOrder so;
    if (parts & 1) { EpiUq E{w}; const int M = l == 0 ? NR : NL; so.init(M, 768, nvb, vb); pg8::gemm_phase(lds, pg8::Gemm{w.CQ(), w.WuqT() + (size_t)l * 768 * 384, M, 768, 384}, so, E); }
    if (parts & 2) { EpiUkv E{w}; so.init(NR, 768, nvb, vb); pg8::gemm_phase(lds, pg8::Gemm{w.CKV(), w.WukvT() + (size_t)l * 768 * 256, NR, 768, 256}, so, E); }
    if (parts & 4) phase_pool(lds, w, w.H(), w.PoolWT() + (size_t)l * 4 * 64 * 64, in.pool_scale + l * 256, l == 0 ? NR : NL, vb, nvb);
}

struct EpiOut {
    static constexpr bool PERM = true;
    bf16_t* DLT; const float* gate;
    __device__ __forceinline__ void operator()(const f32x4 (&acc)[2][2][4][2], const pg8::Unit& u, int wr, int wc, int fr, int fq) const {
        const int pm = u.pm; const int mr = pm >= 256 ? 32 : pm >> 3;
        const size_t r0 = (size_t)pm * 256 + wr * 64 + fr; const int col0 = u.pn * 256 + wc * 32 + 8 * fq;
        f32x4 gv[2][2];
#pragma unroll
        for (int bj = 0; bj < 2; ++bj)
#pragma unroll
            for (int n = 0; n < 2; ++n) gv[bj][n] = *(const f32x4*)(gate + (size_t)mr * 6144 + col0 + bj * 128 + 4 * n);
#pragma unroll
        for (int ai = 0; ai < 2; ++ai)
#pragma unroll
            for (int m = 0; m < 4; ++m) { bf16_t* d = DLT + (r0 + ai * 128 + m * 16) * 1024 + col0;
#pragma unroll
                for (int bj = 0; bj < 2; ++bj) { const f32x4 a0 = acc[ai][bj][m][0] * gv[bj][0], a1 = acc[ai][bj][m][1] * gv[bj][1];
                    u32x4 o; o.x = cvt_pk_bf16(a0[0], a0[1]); o.y = cvt_pk_bf16(a0[2], a0[3]); o.z = cvt_pk_bf16(a1[0], a1[1]); o.w = cvt_pk_bf16(a1[2], a1[3]);
                    *(u32x4*)(d + bj * 128) = o; } }
    }
};
__device__ __forceinline__ void phase_p4(LAS unsigned char* lds, const WS& w, const Inputs& in, int l, int vb, int nvb) {
    const float* MODl = w.MOD() + (size_t)l * 33 * 6144;
    EpiOut E{w.PQ(), MODl + 2 * 1024};
    const int M = l == 0 ? NR : NL;
    pg8::StaticOrder so; so.init(M, 1024, nvb, vb);
    pg8::gemm_phase(lds, pg8::Gemm{w.H(), w.WoutT() + (size_t)l * 1024 * 1024, M, 1024, 1024}, so, E);
}

template <bool INBF>
__device__ __forceinline__ void phase_modulate(const float* __restrict__ XLp, const float* __restrict__ XCp, const bf16_t* __restrict__ XBp, bf16_t* __restrict__ Hout, const float* __restrict__ g, const float* __restrict__ MODl, int si, int nrows, int vb, int nvb,
                                               signed char* __restrict__ H8 = nullptr, float* __restrict__ HS = nullptr, const bf16_t* __restrict__ DLT = nullptr, bf16_t* __restrict__ XBo = nullptr) {
    int tid_ = threadIdx.x; asm volatile("" : "+v"(tid_));
    const int tid = tid_, lane = tid & 63, wid = tid >> 6;
    f32x4 gv[4];
#pragma unroll
    for (int i = 0; i < 4; ++i) gv[i] = *(const f32x4*)(g + 256 * i + 4 * lane);
    const int stride = nvb * 8, lastrow = nrows - 1;
    f32x4 nx[4]; u32x2 nxb[4], ndr[4];
#define PM_LOAD(r_) do { const int rr_ = (r_) < nrows ? (r_) : lastrow; const bool ic_ = rr_ >= NL; const float* xp_ = ic_ ? XCp + (size_t)(rr_ - NL) * 1024 : XLp + (size_t)rr_ * 1024; \
        _Pragma("unroll") for (int i = 0; i < 4; ++i) { if (INBF) nxb[i] = *(const u32x2*)(XBp + (size_t)rr_ * 1024 + 256 * i + 4 * lane); else nx[i] = *(const f32x4*)(xp_ + 256 * i + 4 * lane); \
            if (DLT) ndr[i] = *(const u32x2*)(DLT + (size_t)rr_ * 1024 + 256 * i + 4 * lane); } } while (0)
    PM_LOAD(vb * 8 + wid);
    for (int row = vb * 8 + wid; row < nrows; row += stride) {
        const bool isctx = row >= NL; const int mr = isctx ? 32 : row / S;
        f32x4 x[4]; u32x2 dr4[4]; float ss = 0.f;
#pragma unroll
        for (int i = 0; i < 4; ++i) { if (INBF) x[i] = (f32x4){__uint_as_float(nxb[i].x << 16), __uint_as_float(nxb[i].x & 0xffff0000u), __uint_as_float(nxb[i].y << 16), __uint_as_float(nxb[i].y & 0xffff0000u)}; else x[i] = nx[i];
            if (DLT) dr4[i] = ndr[i]; }
        PM_LOAD(row + stride);
#pragma unroll
        for (int i = 0; i < 4; ++i) {
            if (DLT) { const u32x2 dr = dr4[i];
                x[i][0] += __uint_as_float(dr.x << 16); x[i][1] += __uint_as_float(dr.x & 0xffff0000u); x[i][2] += __uint_as_float(dr.y << 16); x[i][3] += __uint_as_float(dr.y & 0xffff0000u);
                u32x2 xo; xo.x = cvt_pk_bf16(x[i][0], x[i][1]); xo.y = cvt_pk_bf16(x[i][2], x[i][3]); *(u32x2*)(XBo + (size_t)row * 1024 + 256 * i + 4 * lane) = xo; }
            ss += x[i][0] * x[i][0] + x[i][1] * x[i][1] + x[i][2] * x[i][2] + x[i][3] * x[i][3]; }
        ss = wave_sum(ss); const float rstd = rsqrtf(ss * (1.f / 1024.f) + EPS);
        const float* sh = MODl + (size_t)mr * 6144 + si * 1024;
        f32x4 y[4]; float am = 0.f;
#pragma unroll
        for (int i = 0; i < 4; ++i) { const f32x4 shv = *(const f32x4*)(sh + 256 * i + 4 * lane), scv = *(const f32x4*)(sh + 1024 + 256 * i + 4 * lane);
            y[i] = x[i] * rstd * gv[i] * (scv + 1.f) + shv;
            am = fmaxf(am, fmaxf(fmaxf(fabsf(y[i][0]), fabsf(y[i][1])), fmaxf(fabsf(y[i][2]), fabsf(y[i][3]))));
            u32x2 o; o.x = cvt_pk_bf16(y[i][0], y[i][1]); o.y = cvt_pk_bf16(y[i][2], y[i][3]);
            *(u32x2*)(Hout + (size_t)row * 1024 + 256 * i + 4 * lane) = o; }
        if (H8) {
#pragma unroll
            for (int o = 32; o > 0; o >>= 1) am = fmaxf(am, __shfl_xor(am, o));
            const float inv = am > 0.f ? 127.f / am : 0.f;
#pragma unroll
            for (int i = 0; i < 4; ++i) { const int q0 = (int)rintf(y[i][0] * inv), q1 = (int)rintf(y[i][1] * inv), q2 = (int)rintf(y[i][2] * inv), q3 = (int)rintf(y[i][3] * inv);
                *(unsigned*)(H8 + (size_t)row * 1024 + 256 * i + 4 * lane) = (unsigned)(q0 & 0xff) | ((unsigned)(q1 & 0xff) << 8) | ((unsigned)(q2 & 0xff) << 16) | ((unsigned)(q3 & 0xff) << 24); }
            if (lane == 0) HS[row] = am > 0.f ? am * (1.f / 127.f) : 1.f;
        }
    }
#undef PM_LOAD
}

struct EpiPQ {
    static constexpr bool PERM = true;
    bf16_t* PQ;
    __device__ __forceinline__ void operator()(const f32x4 (&acc)[2][2][4][2], const pg8::Unit& u, int wr, int wc, int fr, int fq) const {
        const size_t r0 = (size_t)u.pm * 256 + wr * 64 + fr; const int col0 = u.pn * 256 + wc * 32 + 8 * fq;
#pragma unroll
        for (int ai = 0; ai < 2; ++ai)
#pragma unroll
            for (int m = 0; m < 4; ++m) { bf16_t* d = PQ + (r0 + ai * 128 + m * 16) * 2048 + col0;
#pragma unroll
                for (int bj = 0; bj < 2; ++bj) { const f32x4 a0 = acc[ai][bj][m][0], a1 = acc[ai][bj][m][1];
                    u32x4 o; o.x = cvt_pk_bf16(a0[0], a0[1]); o.y = cvt_pk_bf16(a0[2], a0[3]); o.z = cvt_pk_bf16(a1[0], a1[1]); o.w = cvt_pk_bf16(a1[2], a1[3]);
                    *(u32x4*)(d + bj * 128) = o; } }
    }
};
__device__ __forceinline__ void phase_p6a(LAS unsigned char* lds, const WS& w, int l, int vb, int nvb) {
    EpiPQ E{w.PQ()}; const int M = l == 0 ? NR : NL;
    pg8::StaticOrder so; so.init(M, 2048, nvb, vb);
    pg8::gemm_phase(lds, pg8::Gemm{w.H(), w.WqT() + (size_t)l * 2048 * 1024, M, 2048, 1024}, so, E);
}


using bf16x2_t = __attribute__((ext_vector_type(2))) __bf16;
typedef float f32x2 __attribute__((ext_vector_type(2)));
__device__ __forceinline__ float gelu_fast(float x) {
    const float u2 = 1.5957691216057308f * (x + 0.044715f * x * x * x);
    return x * __builtin_amdgcn_rcpf(1.f + __builtin_amdgcn_exp2f(-1.4426950408889634f * u2));
}
#define DPPF(v, ctrl) __builtin_bit_cast(float, __builtin_amdgcn_update_dpp(0, __builtin_bit_cast(int, (v)), (ctrl), 0xf, 0xf, true))
__device__ __forceinline__ float reduce8(float p0, float p1, float p2, float p3, float p4, float p5, float p6, float p7, int lane) {
    auto s01 = __builtin_amdgcn_permlane32_swap(__float_as_uint(p0), __float_as_uint(p1), false, false);
    auto s23 = __builtin_amdgcn_permlane32_swap(__float_as_uint(p2), __float_as_uint(p3), false, false);
    auto s45 = __builtin_amdgcn_permlane32_swap(__float_as_uint(p4), __float_as_uint(p5), false, false);
    auto s67 = __builtin_amdgcn_permlane32_swap(__float_as_uint(p6), __float_as_uint(p7), false, false);
    const float q0 = __uint_as_float(s01[0]) + __uint_as_float(s01[1]), q1 = __uint_as_float(s23[0]) + __uint_as_float(s23[1]);
    const float q2 = __uint_as_float(s45[0]) + __uint_as_float(s45[1]), q3 = __uint_as_float(s67[0]) + __uint_as_float(s67[1]);
    auto t0 = __builtin_amdgcn_permlane16_swap(__float_as_uint(q0), __float_as_uint(q1), false, false);
    auto t1 = __builtin_amdgcn_permlane16_swap(__float_as_uint(q2), __float_as_uint(q3), false, false);
    float r0 = __uint_as_float(t0[0]) + __uint_as_float(t0[1]);
    float r1 = __uint_as_float(t1[0]) + __uint_as_float(t1[1]);
    r0 += DPPF(r0, 0x128); r1 += DPPF(r1, 0x128);
    float z = (lane & 8) ? r1 : r0;
    z += DPPF(z, 0x141);
    z += DPPF(z, 0xB1);
    z += DPPF(z, 0x4E);
    return z;
}
__device__ __forceinline__ void p7_axpy(const u32x4 v, float wj, f32x2 (&out)[8]) {
    const f32x2 w2 = {wj, wj};
#pragma unroll
    for (int k = 0; k < 4; ++k) { const f32x2 lo = __builtin_amdgcn_cvt_pk_f32_fp8((int)v[k], false), hi2 = __builtin_amdgcn_cvt_pk_f32_fp8((int)v[k], true);
        out[2 * k] = __builtin_elementwise_fma(w2, lo, out[2 * k]); out[2 * k + 1] = __builtin_elementwise_fma(w2, hi2, out[2 * k + 1]); }
}
__device__ __forceinline__ int p7_doti(const u32x4 u, const u32x4 h) {
    int s = __builtin_amdgcn_sdot4((int)u[0], (int)h[0], 0, false); s = __builtin_amdgcn_sdot4((int)u[1], (int)h[1], s, false); s = __builtin_amdgcn_sdot4((int)u[2], (int)h[2], s, false); return __builtin_amdgcn_sdot4((int)u[3], (int)h[3], s, false);
}
#define DPPI(v, ctrl) __builtin_amdgcn_update_dpp(0, (v), (ctrl), 0xf, 0xf, true)
__device__ __forceinline__ int reduce8i(int p0, int p1, int p2, int p3, int p4, int p5, int p6, int p7, int lane) {
    auto s01 = __builtin_amdgcn_permlane32_swap((unsigned)p0, (unsigned)p1, false, false); auto s23 = __builtin_amdgcn_permlane32_swap((unsigned)p2, (unsigned)p3, false, false);
    auto s45 = __builtin_amdgcn_permlane32_swap((unsigned)p4, (unsigned)p5, false, false); auto s67 = __builtin_amdgcn_permlane32_swap((unsigned)p6, (unsigned)p7, false, false);
    const unsigned q0 = s01[0] + s01[1], q1 = s23[0] + s23[1], q2 = s45[0] + s45[1], q3 = s67[0] + s67[1];
    auto t0 = __builtin_amdgcn_permlane16_swap(q0, q1, false, false); auto t1 = __builtin_amdgcn_permlane16_swap(q2, q3, false, false);
    int r0 = (int)(t0[0] + t0[1]), r1 = (int)(t1[0] + t1[1]);
    r0 += DPPI(r0, 0x128); r1 += DPPI(r1, 0x128);
    int z = (lane & 8) ? r1 : r0;
    z += DPPI(z, 0x141); z += DPPI(z, 0xB1); z += DPPI(z, 0x4E);
    return z;
}

struct P7CArgs { const signed char* H8; const unsigned* EG; const unsigned char* U8; int* PART; int nrows; };
__device__ __forceinline__ void phase_p7c(LAS unsigned char* lds, const P7CArgs& a, int part, int prank, int nvb) {
    int tid_ = threadIdx.x; asm volatile("" : "+v"(tid_));
    const int lane = tid_ & 63, wid = __builtin_amdgcn_readfirstlane(tid_ >> 6);
    const int nw = (nvb >> 3) * 8, wrank = prank * 8 + wid;
    LAS unsigned* tab = (LAS unsigned*)(lds + wid * 1024);
    const int grp = lane >> 3, c = lane & 7, c16 = c * 16;
    const unsigned char* ubase = a.U8 + 128 * part + c16;
    const signed char* hbase = a.H8 + 128 * part + c16;
    unsigned* pbase = (unsigned*)a.PART + (size_t)part * a.nrows * 64;
    const int c2 = (c >> 2) & 1, c1 = (c >> 1) & 1, c0 = c & 1;
    const int ent0 = 8 * (4 * c2 + 2 * c0 + c1) + grp;
    u32x4 Av[16], Bv[16]; u32x4 Ah, Bh;
    unsigned pw0 = 0u, pw1 = 0u;
#define P7C_PREF(t) do { pw0 = a.EG[(size_t)(t) * 128 + lane]; pw1 = a.EG[(size_t)(t) * 128 + 64 + lane]; } while (0)
#define P7C_ISSUE(X, Xh, t, slot, tnext) do { LAS unsigned* tb_ = tab + (slot) * 128; \
        tb_[lane] = pw0; tb_[64 + lane] = pw1; \
        asm volatile("s_waitcnt lgkmcnt(0)" ::: "memory"); \
        _Pragma("unroll") for (int i_ = 0; i_ < 16; ++i_) { const unsigned e_ = tb_[8 * i_ + grp]; X[i_] = *(const u32x4*)(ubase + (size_t)(e_ >> 16) * 1024); } \
        Xh = *(const u32x4*)(hbase + (size_t)(t) * 1024); \
        P7C_PREF(tnext); } while (0)
#define P7C_X(v, ctrl) ((v) + DPPI((v), (ctrl)))
#define P7C_COMPUTE(X, Xh, t, valid) do { int d_[16]; \
        _Pragma("unroll") for (int i_ = 0; i_ < 16; ++i_) d_[i_] = p7_doti(X[i_], Xh); \
        int e8_[8]; _Pragma("unroll") for (int k = 0; k < 8; ++k) { const int send_ = c2 ? d_[k] : d_[k + 8], keep_ = c2 ? d_[k + 8] : d_[k]; e8_[k] = keep_ + DPPI(send_, 0x141); }            \
        int e4_[4]; _Pragma("unroll") for (int k = 0; k < 4; ++k) { const int send_ = c0 ? e8_[k] : e8_[k + 4], keep_ = c0 ? e8_[k + 4] : e8_[k]; e4_[k] = keep_ + DPPI(send_, 0xB1); }          \
        int e2_[2]; _Pragma("unroll") for (int k = 0; k < 2; ++k) { const int send_ = c1 ? e4_[k] : e4_[k + 2], keep_ = c1 ? e4_[k + 2] : e4_[k]; e2_[k] = keep_ + DPPI(send_, 0x4E); }          \
        if (valid) pbase[(size_t)(t) * 64 + ent0] = __builtin_bit_cast(unsigned, __builtin_amdgcn_cvt_pk_i16((e2_[0] + 8) >> 4, (e2_[1] + 8) >> 4)); } while (0)
    const int lastrow = a.nrows - 1;
    int t = wrank;
    P7C_PREF(t);
    P7C_ISSUE(Av, Ah, t, 0, (t + nw < a.nrows ? t + nw : lastrow));
    while (t < a.nrows) {
        const int t1 = t + nw, t2 = t1 + nw, t3 = t2 + nw;
        const int k1 = t1 < a.nrows ? t1 : lastrow, k2 = t2 < a.nrows ? t2 : lastrow, k3 = t3 < a.nrows ? t3 : lastrow;
        P7C_ISSUE(Bv, Bh, k1, 1, k2);
        P7C_COMPUTE(Av, Ah, t, true);
        P7C_ISSUE(Av, Ah, k2, 0, k3);
        P7C_COMPUTE(Bv, Bh, k1, (t1 < a.nrows));
        t = t2;
    }
#undef P7C_PREF
#undef P7C_ISSUE
#undef P7C_COMPUTE
}
__device__ __forceinline__ void phase_p7d(const int* __restrict__ PART, const unsigned* __restrict__ EG, const float* __restrict__ US, const float* __restrict__ VS, const float* __restrict__ HS, unsigned* __restrict__ WE, int nrows, int vb, int nvb) {
    int tid_ = threadIdx.x; asm volatile("" : "+v"(tid_));
    typedef int i32x4 __attribute__((ext_vector_type(4)));
    const size_t n16 = (size_t)nrows * 16, pstride4 = n16;
    const u32x4* P4 = (const u32x4*)PART; const u32x4* EG4 = (const u32x4*)EG; u32x4* WE4 = (u32x4*)WE;
    for (size_t j = (size_t)vb * 512 + tid_; j < n16; j += (size_t)nvb * 512) {
        const size_t row = j >> 4; const int P = (int)(j >> 1) & 7, gq = (int)j & 1;
        i32x4 slo = {0, 0, 0, 0}, shi = {0, 0, 0, 0};
#pragma unroll
        for (int p = 0; p < 8; ++p) { const u32x4 d = P4[p * pstride4 + j];
#pragma unroll
            for (int k = 0; k < 4; ++k) { slo[k] += (int)(d[k] << 16) >> 16; shi[k] += (int)d[k] >> 16; } }
        const float hs = HS[row] * 16.f;
#pragma unroll
        for (int half = 0; half < 2; ++half) {
            const size_t ei = row * 32 + 4 * P + 2 * half + gq;
            const u32x4 eg = EG4[ei]; u32x4 o;
#pragma unroll
            for (int k = 0; k < 4; ++k) { const int eid = (int)(eg[k] >> 16);
                const float av = (float)(half ? shi[k] : slo[k]) * US[eid] * hs;
                const float wv = __uint_as_float(eg[k] << 16) * gelu_fast(av) * VS[eid];
                o[k] = (eg[k] & 0xffff0000u) | (cvt_pk_bf16(wv, 0.f) & 0xffffu); }
            WE4[ei] = o;
        }
    }
}
struct P7BArgs { const unsigned* WE; const unsigned char* V8; bf16_t* XB; const float* gate2; int nrows; };
template <int PM>
__device__ __forceinline__ void phase_p7b(LAS unsigned char* lds, const P7BArgs& a, int part, int prank, int nvb) {
    int tid_ = threadIdx.x; asm volatile("" : "+v"(tid_));
    const int lane = tid_ & 63, wid = __builtin_amdgcn_readfirstlane(tid_ >> 6);
    const int nw = (nvb >> 3) * 8, wrank = prank * 8 + wid;
    LAS unsigned* tab = (LAS unsigned*)(lds + wid * 1024);
    const int grp = lane >> 3, c16 = (lane & 7) * 16;
    const unsigned char* vbase = a.V8 + 128 * part + c16;
    const int colofs = 128 * part + c16 + 8 * (lane >> 5) + 4 * ((lane >> 4) & 1) + 2 * ((lane >> 3) & 1);
    u32x4 Av[16], Bv[16]; float Aw[16], Bw[16]; unsigned Ax, Bx; f32x2 Ag, Bg;
    unsigned pw0 = 0u, pw1 = 0u;
#define P7B_PREF(t) do { pw0 = a.WE[(size_t)(t) * 128 + lane]; pw1 = a.WE[(size_t)(t) * 128 + 64 + lane]; } while (0)
#define P7B_ISSUE(X, Xw, Xx, Xg, t, slot, tnext) do { LAS unsigned* tb_ = tab + (slot) * 128; \
        tb_[lane] = pw0; tb_[64 + lane] = pw1; \
        asm volatile("s_waitcnt lgkmcnt(0)" ::: "memory"); \
        _Pragma("unroll") for (int i_ = 0; i_ < 16; ++i_) { const unsigned we_ = tb_[8 * i_ + grp]; Xw[i_] = __uint_as_float(we_ << 16); if (PM != 2) X[i_] = *(const u32x4*)(vbase + (size_t)(we_ >> 16) * 1024); else X[i_] = (u32x4){we_, 0x38383838u, 0x38383838u, 0x38383838u}; } \
        { const int mr_ = (t) >= NL ? 32 : (t) / S; \
          Xx = *(const unsigned*)(a.XB + (size_t)(t) * 1024 + colofs); Xg = *(const f32x2*)(a.gate2 + (size_t)mr_ * 6144 + colofs); } \
        P7B_PREF(tnext); } while (0)
#define P7B_COMPUTE(X, Xw, Xx, Xg, t, valid) do { f32x2 acc2[8]; \
        _Pragma("unroll") for (int k = 0; k < 8; ++k) acc2[k] = (f32x2){0.f, 0.f}; \
        if (PM != 1) { _Pragma("unroll") for (int i_ = 0; i_ < 16; ++i_) p7_axpy(X[i_], Xw[i_], acc2); } else { _Pragma("unroll") for (int i_ = 0; i_ < 16; ++i_) acc2[i_ >> 1][i_ & 1] = __uint_as_float((X[i_][0] ^ X[i_][1] ^ X[i_][2] ^ X[i_][3]) & 0x3fffffffu) + Xw[i_]; } \
        float b_[8]; _Pragma("unroll") for (int k = 0; k < 8; ++k) { auto s_ = __builtin_amdgcn_permlane32_swap(__float_as_uint(acc2[k >> 1][k & 1]), __float_as_uint(acc2[(k + 8) >> 1][k & 1]), false, false); b_[k] = __uint_as_float(s_[0]) + __uint_as_float(s_[1]); } \
        float c_[4]; _Pragma("unroll") for (int k = 0; k < 4; ++k) { auto s_ = __builtin_amdgcn_permlane16_swap(__float_as_uint(b_[k]), __float_as_uint(b_[k + 4]), false, false); c_[k] = __uint_as_float(s_[0]) + __uint_as_float(s_[1]); } \
        float d_[2]; _Pragma("unroll") for (int k = 0; k < 2; ++k) { const float send_ = (lane & 8) ? c_[k] : c_[k + 2]; const float keep_ = (lane & 8) ? c_[k + 2] : c_[k]; d_[k] = keep_ + DPPF(send_, 0x128); } \
        unsigned* xp_ = (unsigned*)(a.XB + (size_t)(t) * 1024 + colofs); \
        f32x2 x_ = {__uint_as_float(Xx << 16), __uint_as_float(Xx & 0xffff0000u)}; x_.x += Xg.x * d_[0]; x_.y += Xg.y * d_[1]; if ((valid) && PM == 0) *xp_ = cvt_pk_bf16(x_.x, x_.y); else if (PM != 0 && x_.x == 1.2345e30f) *xp_ = cvt_pk_bf16(x_.x, x_.y); } while (0)
    const int lastrow = a.nrows - 1;
    int t = wrank;
    P7B_PREF(t);
    P7B_ISSUE(Av, Aw, Ax, Ag, t, 0, (t + nw < a.nrows ? t + nw : lastrow));
    while (t < a.nrows) {
        const int t1 = t + nw, t2 = t1 + nw, t3 = t2 + nw;
        const int c1 = t1 < a.nrows ? t1 : lastrow, c2 = t2 < a.nrows ? t2 : lastrow, c3 = t3 < a.nrows ? t3 : lastrow;
        P7B_ISSUE(Bv, Bw, Bx, Bg, c1, 1, c2);
        P7B_COMPUTE(Av, Aw, Ax, Ag, t, true);
        P7B_ISSUE(Av, Aw, Ax, Ag, c2, 0, c3);
        P7B_COMPUTE(Bv, Bw, Bx, Bg, c1, (t1 < a.nrows));
        t = t2;
    }
#undef P7B_PREF
#undef P7B_ISSUE
#undef P7B_COMPUTE
}
__device__ __forceinline__ void phase_final_norm(const bf16_t* __restrict__ XBp, float* __restrict__ OUT, const float* __restrict__ g, int vb, int nvb) {
    int tid_ = threadIdx.x; asm volatile("" : "+v"(tid_));
    const int lane = tid_ & 63, wid = tid_ >> 6;
    for (int row = vb * 8 + wid; row < NL; row += nvb * 8) {
        const bf16_t* xp = XBp + (size_t)row * 1024; f32x4 x[4]; float ss = 0.f;
#pragma unroll
        for (int i = 0; i < 4; ++i) { const u32x2 r = *(const u32x2*)(xp + 256 * i + 4 * lane); x[i] = (f32x4){__uint_as_float(r.x << 16), __uint_as_float(r.x & 0xffff0000u), __uint_as_float(r.y << 16), __uint_as_float(r.y & 0xffff0000u)};
            ss += x[i][0] * x[i][0] + x[i][1] * x[i][1] + x[i][2] * x[i][2] + x[i][3] * x[i][3]; }
        ss = wave_sum(ss); const float rstd = rsqrtf(ss * (1.f / 1024.f) + EPS);
#pragma unroll
        for (int i = 0; i < 4; ++i) *(f32x4*)(OUT + (size_t)row * 1024 + 256 * i + 4 * lane) = x[i] * rstd * *(const f32x4*)(g + 256 * i + 4 * lane);
    }
}

typedef short s16x4 __attribute__((ext_vector_type(4)));
__device__ __forceinline__ s16x4 lds_tr16(const LAS unsigned char* p) { return __builtin_bit_cast(s16x4, __builtin_amdgcn_ds_read_tr16_b64_v4i16((LAS s16x4*)p)); }
constexpr int ATT_BUF = 20480;
template <int DK>
__device__ __forceinline__ void attn_unit(LAS unsigned char* lds, const bf16_t* __restrict__ Q, const bf16_t* __restrict__ K1, const bf16_t* __restrict__ K2, const bf16_t* __restrict__ V,
                                          int nkeys, float c2, bf16_t* __restrict__ out) {
    int tid_ = threadIdx.x; asm volatile("" : "+v"(tid_));
    const int tid = tid_, lane = tid & 63, wid = __builtin_amdgcn_readfirstlane(tid >> 6), r32 = lane & 31, hi = lane >> 5;
    constexpr int NS = DK / 16;
    bf16x8 qf[NS];
    { const bf16_t* qp = Q + (size_t)(wid * 32 + r32) * DK + 8 * hi;
#pragma unroll
      for (int s = 0; s < NS; ++s) qf[s] = *(const bf16x8*)(qp + 16 * s); }
    const int skey = tid >> 3, sch = tid & 7;
    const unsigned st_k1 = skey * 128 + ((sch ^ ((skey >> 1) & 7)) << 4);
    const unsigned st_v = 8192 + skey * 128 + (((sch << 4)) ^ (((skey >> 1) & 1) << 6));
    const int skey2 = (tid & 255) >> 2, sch2 = tid & 3;
    const unsigned st_k2 = 16384 + skey2 * 64 + ((sch2 ^ ((skey2 >> 2) & 3)) << 4);
    const bf16_t* gk1 = K1 + (size_t)skey * 64 + sch * 8; const bf16_t* gv = V + (size_t)skey * 64 + sch * 8;
    const bf16_t* gk2 = (DK == 96) ? K2 + (size_t)skey2 * 32 + sch2 * 8 : nullptr;
    unsigned ka[2][4];
#pragma unroll
    for (int kt = 0; kt < 2; ++kt)
#pragma unroll
        for (int s = 0; s < 4; ++s) { const int key = 32 * kt + r32; ka[kt][s] = key * 128 + (((2 * s + hi) ^ ((key >> 1) & 7)) << 4); }
    unsigned kb[2][2];
#pragma unroll
    for (int kt = 0; kt < 2; ++kt)
#pragma unroll
        for (int s = 0; s < 2; ++s) { const int key = 32 * kt + r32; kb[kt][s] = 16384 + key * 64 + (((2 * s + hi) ^ ((key >> 2) & 3)) << 4); }
    const int vq = (lane & 15) >> 2, vp = lane & 3, vg = (lane >> 4) & 1;
    unsigned va[2];
#pragma unroll
    for (int dvb = 0; dvb < 2; ++dvb) { const int key = 4 * hi + vq; va[dvb] = 8192 + key * 128 + ((((32 * dvb + 16 * vg + 4 * vp) * 2)) ^ (((key >> 1) & 1) << 6)); }
    float m = 0.f, l = 0.f;
    f32x16 o0 = {}, o1 = {}, negm = {};
    const int NT = nkeys >> 6;
    u32x4 sk1, sv, sk2;
    sk1 = *(const u32x4*)gk1; sv = *(const u32x4*)gv; if (DK == 96) { if (tid < 256) sk2 = *(const u32x4*)gk2; }
    *(LAS u32x4*)(lds + st_k1) = sk1; *(LAS u32x4*)(lds + st_v) = sv; if (DK == 96) { if (tid < 256) *(LAS u32x4*)(lds + st_k2) = sk2; }
    __syncthreads();
    for (int t = 0; t < NT; ++t) {
        LAS unsigned char* buf = lds + (t & 1) * ATT_BUF;
        if (t + 1 < NT) { sk1 = *(const u32x4*)(gk1 + (size_t)(t + 1) * 64 * 64); sv = *(const u32x4*)(gv + (size_t)(t + 1) * 64 * 64); if (DK == 96) { if (tid < 256) sk2 = *(const u32x4*)(gk2 + (size_t)(t + 1) * 64 * 32); } }
        bf16x8 kf0[NS], kf1[NS];
#pragma unroll
        for (int s = 0; s < 4; ++s) { kf0[s] = *(const LAS bf16x8*)(buf + ka[0][s]); kf1[s] = *(const LAS bf16x8*)(buf + ka[1][s]); }
        if (DK == 96) {
#pragma unroll
            for (int s = 0; s < 2; ++s) { kf0[4 + s] = *(const LAS bf16x8*)(buf + kb[0][s]); kf1[4 + s] = *(const LAS bf16x8*)(buf + kb[1][s]); }
        }
        __builtin_amdgcn_sched_barrier(0);
        f32x16 p0 = mfma32(kf0[0], qf[0], negm), p1 = mfma32(kf1[0], qf[0], negm);
#pragma unroll
        for (int s = 1; s < NS; ++s) { p0 = mfma32(kf0[s], qf[s], p0); p1 = mfma32(kf1[s], qf[s], p1); }
        __builtin_amdgcn_sched_barrier(0);
        s16x4 vlo[2][2][2], vhi[2][2][2];
#pragma unroll
        for (int kt = 0; kt < 2; ++kt)
#pragma unroll
            for (int sp = 0; sp < 2; ++sp) { const int kofs = (32 * kt + 16 * sp) * 128;
#pragma unroll
                for (int dvb = 0; dvb < 2; ++dvb) { vlo[dvb][kt][sp] = lds_tr16(buf + va[dvb] + kofs); vhi[dvb][kt][sp] = lds_tr16(buf + va[dvb] + kofs + 8 * 128); } }
        __builtin_amdgcn_sched_barrier(0);
        float mx = p0[0];
#pragma unroll
        for (int r = 1; r < 16; ++r) mx = fmaxf(mx, p0[r]);
#pragma unroll
        for (int r = 0; r < 16; ++r) mx = fmaxf(mx, p1[r]);
        { auto rr = __builtin_amdgcn_permlane32_swap(__float_as_uint(mx), __float_as_uint(mx), false, false); mx = fmaxf(__uint_as_float(rr[0]), __uint_as_float(rr[1])); }
        if (t == 0 || __any(mx > 8.f)) {
            const float dn = (t == 0) ? mx : fmaxf(mx, 0.f), al = (t == 0) ? 1.f : __builtin_amdgcn_exp2f(-dn); m += dn; l *= al;
#pragma unroll
            for (int r = 0; r < 16; ++r) { o0[r] *= al; o1[r] *= al; p0[r] -= dn; p1[r] -= dn; negm[r] = -m; }
            asm volatile("" : "+v"(negm));
        }
        f32x2 ls2 = {0.f, 0.f};
#pragma unroll
        for (int r = 0; r < 16; ++r) { p0[r] = __builtin_amdgcn_exp2f(p0[r]); p1[r] = __builtin_amdgcn_exp2f(p1[r]); }
#pragma unroll
        for (int r = 0; r < 16; r += 2) { ls2 += (f32x2){p0[r], p0[r + 1]}; ls2 += (f32x2){p1[r], p1[r + 1]}; }
        const float ls = ls2.x + ls2.y;
        l += ls;
        bf16x8 pf[2][2];
#pragma unroll
        for (int sp = 0; sp < 2; ++sp) { u32x4 a, b;
            a.x = cvt_pk_bf16(p0[8 * sp], p0[8 * sp + 1]); a.y = cvt_pk_bf16(p0[8 * sp + 2], p0[8 * sp + 3]); a.z = cvt_pk_bf16(p0[8 * sp + 4], p0[8 * sp + 5]); a.w = cvt_pk_bf16(p0[8 * sp + 6], p0[8 * sp + 7]);
            b.x = cvt_pk_bf16(p1[8 * sp], p1[8 * sp + 1]); b.y = cvt_pk_bf16(p1[8 * sp + 2], p1[8 * sp + 3]); b.z = cvt_pk_bf16(p1[8 * sp + 4], p1[8 * sp + 5]); b.w = cvt_pk_bf16(p1[8 * sp + 6], p1[8 * sp + 7]);
            pf[0][sp] = __builtin_bit_cast(bf16x8, a); pf[1][sp] = __builtin_bit_cast(bf16x8, b); }
        __builtin_amdgcn_sched_barrier(0);
#pragma unroll
        for (int kt = 0; kt < 2; ++kt)
#pragma unroll
            for (int sp = 0; sp < 2; ++sp) {
                { const s16x4 lo = vlo[0][kt][sp], hi4 = vhi[0][kt][sp]; const bf16x8 vf = (bf16x8){lo[0], lo[1], lo[2], lo[3], hi4[0], hi4[1], hi4[2], hi4[3]}; o0 = mfma32(vf, pf[kt][sp], o0); }
                { const s16x4 lo = vlo[1][kt][sp], hi4 = vhi[1][kt][sp]; const bf16x8 vf = (bf16x8){lo[0], lo[1], lo[2], lo[3], hi4[0], hi4[1], hi4[2], hi4[3]}; o1 = mfma32(vf, pf[kt][sp], o1); } }
        __builtin_amdgcn_sched_barrier(0);
        if (t + 1 < NT) { LAS unsigned char* nb = lds + ((t + 1) & 1) * ATT_BUF; *(LAS u32x4*)(nb + st_k1) = sk1; *(LAS u32x4*)(nb + st_v) = sv; if (DK == 96) { if (tid < 256) *(LAS u32x4*)(nb + st_k2) = sk2; } }
        __syncthreads();
    }
    { auto rr = __builtin_amdgcn_permlane32_swap(__float_as_uint(l), __float_as_uint(l), false, false); l = __uint_as_float(rr[0]) + __uint_as_float(rr[1]); }
    const float il = 1.f / l;
    bf16_t* op = out + (size_t)(wid * 32 + r32) * 1024 + 4 * hi;
#pragma unroll
    for (int g = 0; g < 4; ++g) { u32x2 a, b;
        a.x = cvt_pk_bf16(o0[4 * g] * il, o0[4 * g + 1] * il); a.y = cvt_pk_bf16(o0[4 * g + 2] * il, o0[4 * g + 3] * il);
        b.x = cvt_pk_bf16(o1[4 * g] * il, o1[4 * g + 1] * il); b.y = cvt_pk_bf16(o1[4 * g + 2] * il, o1[4 * g + 3] * il);
        *(u32x2*)(op + 8 * g) = a; *(u32x2*)(op + 32 + 8 * g) = b; }
}
__device__ __forceinline__ void phase_p3(LAS unsigned char* lds, const WS& w, int l, int vb, int nvb) {
    const float c2g = 0.125f * 1.4426950408889634f, c2m = 0.10206207261596577f * 1.4426950408889634f;
    bf16_t* MIX = w.H();
    const int nlat = NB * 12 * 8, nctx = (l == 0) ? NB * 12 : 0;
    for (int u = vb; u < nlat + nctx; u += nvb) {
        if (u < nlat) {
            const int qb = u & 7, slot = (u >> 3) % 12, b = u / 96;
            bf16_t* out = MIX + ((size_t)b * S + qb * 256) * 1024;
            if (slot < 6) attn_unit<64>(lds, w.Qg() + (((size_t)b * 6 + slot) * S + qb * 256) * 64, w.Kg() + ((size_t)b * 2 + slot / 3) * KEYS * 64, nullptr, w.Vg() + ((size_t)b * 2 + slot / 3) * KEYS * 64, KEYS, c2g, out + slot * 64);
            else { const int h = slot - 6; attn_unit<96>(lds, w.Qm() + (((size_t)b * 6 + h) * S + qb * 256) * 96, w.Kmn() + ((size_t)b * 6 + h) * KEYS * 64, w.KR() + (size_t)b * KEYS * 32, w.Vm() + ((size_t)b * 6 + h) * KEYS * 64, KEYS, c2m, out + 640 + h * 64); }
        } else {
            const int v = u - nlat, slot = v % 12, b = v / 12;
            bf16_t* out = MIX + ((size_t)NL + (size_t)b * CTX) * 1024;
            if (slot < 6) attn_unit<64>(lds, w.Qgc() + ((size_t)b * 6 + slot) * CTX * 64, w.Kg() + ((size_t)b * 2 + slot / 3) * KEYS * 64, nullptr, w.Vg() + ((size_t)b * 2 + slot / 3) * KEYS * 64, CTX, c2g, out + slot * 64);
            else { const int h = slot - 6; attn_unit<96>(lds, w.Qmc() + ((size_t)b * 6 + h) * CTX * 96, w.Kmn() + ((size_t)b * 6 + h) * KEYS * 64, w.KR() + (size_t)b * KEYS * 32, w.Vm() + ((size_t)b * 6 + h) * KEYS * 64, CTX, c2m, out + 640 + h * 64); }
        }
    }
}

__device__ __forceinline__ unsigned fkey(float f, unsigned tag, unsigned mask) { unsigned u = __float_as_uint(f); u = (u & 0x80000000u) ? ~u : (u | 0x80000000u); return (u & ~mask) | tag; }
__device__ __forceinline__ float keyf(unsigned k, unsigned mask) { k &= ~mask; const unsigned u = (k & 0x80000000u) ? (k & 0x7fffffffu) : ~k; return __uint_as_float(u); }
__device__ __forceinline__ void ce_desc(unsigned& a, unsigned& b) { const unsigned hi_ = a > b ? a : b, lo_ = a > b ? b : a; a = hi_; b = lo_; }
template <int J, int K> __device__ __forceinline__ void bstage16(unsigned* a) {
#pragma unroll
    for (int i = 0; i < 16; ++i) { const int l = i ^ J; if (l > i) { const unsigned x = a[i], y = a[l]; const unsigned mx = x > y ? x : y, mn = x > y ? y : x; const bool desc = ((i & K) == 0); a[i] = desc ? mx : mn; a[l] = desc ? mn : mx; } }
}
__device__ __forceinline__ void sort16_desc(unsigned* a) {
    bstage16<1, 2>(a); bstage16<2, 4>(a); bstage16<1, 4>(a); bstage16<4, 8>(a); bstage16<2, 8>(a); bstage16<1, 8>(a); bstage16<8, 16>(a); bstage16<4, 16>(a); bstage16<2, 16>(a); bstage16<1, 16>(a);
}
__device__ __forceinline__ void bmerge16_desc(unsigned* c) { bstage16<8, 16>(c); bstage16<4, 16>(c); bstage16<2, 16>(c); bstage16<1, 16>(c); }
__device__ __forceinline__ void merge_top16(unsigned* a, const unsigned* b) {
#pragma unroll
    for (int i = 0; i < 16; ++i) a[i] = a[i] > b[15 - i] ? a[i] : b[15 - i];
    bmerge16_desc(a);
}
__device__ __forceinline__ void xlane_top16(unsigned* t, int hi) {
    unsigned r[16]; const unsigned msk = 0u - (unsigned)hi;
#pragma unroll
    for (int i = 0; i < 16; ++i) r[i] = t[i] ^ ((t[i] ^ t[15 - i]) & msk);
#pragma unroll
    for (int i = 0; i < 16; ++i) { auto s = __builtin_amdgcn_permlane32_swap(r[i], r[i], false, false); t[i] = s[0] > s[1] ? s[0] : s[1]; }
    bmerge16_desc(t);
}
__device__ __forceinline__ constexpr int cand_a(int c) { return c < 16 ? 0 : c < 24 ? 1 : c < 29 ? 2 : c < 33 ? 3 : c < 36 ? 4 : c < 38 ? 5 : c < 40 ? 6 : c < 42 ? 7 : c < 50 ? c - 34 : 0; }
__device__ __forceinline__ constexpr int cand_b(int c) { return c < 16 ? c : c < 24 ? c - 16 : c < 29 ? c - 24 : c < 33 ? c - 29 : c < 36 ? c - 33 : c < 38 ? c - 36 : c < 40 ? c - 38 : c < 42 ? c - 40 : 0; }

__device__ __forceinline__ void phase_p6b(LAS unsigned char* lds, const bf16_t* __restrict__ PQ, const bf16_t* __restrict__ SubKl, unsigned* __restrict__ EG, int nrows, int vb, int nvb) {
    int tid_ = threadIdx.x; asm volatile("" : "+v"(tid_));
    const int tid = tid_, lane = tid & 63, wid = __builtin_amdgcn_readfirstlane(tid >> 6), r32 = lane & 31, hi = lane >> 5;
    const int h = vb & 7, wrank = (vb >> 3) * 8 + wid, nwr = (nvb >> 3) * 8;
    LAS unsigned short* tab = (LAS unsigned short*)(lds + 65536 + wid * 4096) + r32 * 64;
#pragma unroll
    for (int i = 0; i < 8; ++i) { const int idx = i * 512 + tid, p = idx >> 11, key = (idx >> 4) & 127, ch = idx & 15;
        *(LAS u32x4*)(lds + p * 32768 + key * 256 + ((ch ^ (key & 15)) << 4)) = *(const u32x4*)(SubKl + ((size_t)(h * 2 + p) * 128 + key) * 128 + ch * 8); }
    __syncthreads();
    const int ngroups = nrows >> 5;
    for (int tg = wrank; tg < ngroups; tg += nwr) {
        const int row0 = tg << 5;
        bf16x8 qf[2][8];
        { const bf16_t* qp = PQ + (size_t)(row0 + r32) * 2048 + h * 256 + 8 * hi; asm volatile("" : "+v"(qp));
#pragma unroll
          for (int p = 0; p < 2; ++p)
#pragma unroll
              for (int s = 0; s < 8; ++s) qf[p][s] = *(const bf16x8*)(qp + p * 128 + 16 * s); }
        unsigned top[2][16];
#pragma unroll
        for (int p = 0; p < 2; ++p) {
            f32x16 acc[4];
#pragma unroll
            for (int kt = 0; kt < 4; ++kt) { acc[kt] = f32x16{}; const int key = 32 * kt + r32;
#pragma unroll
                for (int s = 0; s < 8; ++s) acc[kt] = mfma32(*(const LAS bf16x8*)(lds + p * 32768 + key * 256 + (((2 * s + hi) ^ (key & 15)) << 4)), qf[p][s], acc[kt]); }
            unsigned key[64];
#pragma unroll
            for (int kt = 0; kt < 4; ++kt)
#pragma unroll
                for (int r = 0; r < 16; ++r) { const int n = 32 * kt + (r & 3) + 8 * (r >> 2) + 4 * hi; key[16 * kt + r] = fkey(acc[kt][r], 127u - (unsigned)n, 127u); }
            sort16_desc(key); sort16_desc(key + 16); sort16_desc(key + 32); sort16_desc(key + 48);
            merge_top16(key, key + 16); merge_top16(key + 32, key + 48); merge_top16(key, key + 32);
            xlane_top16(key, hi);
#pragma unroll
            for (int i = 0; i < 16; ++i) top[p][i] = key[i];
        }
        unsigned ck[64];
#pragma unroll
        for (int c = 0; c < 64; ++c) {
            if (c < 50) { const float sm = keyf(top[0][cand_a(c)], 127u) + keyf(top[1][cand_b(c)], 127u); ck[c] = fkey(sm, (unsigned)c, 63u); } else ck[c] = 0u;
        }
        if (hi == 0) {
#pragma unroll
            for (int c = 0; c < 50; c += 2) {
                const unsigned ea = (127u - (top[0][cand_a(c)] & 127u)) * 128u + (127u - (top[1][cand_b(c)] & 127u));
                const unsigned eb = (127u - (top[0][cand_a(c + 1)] & 127u)) * 128u + (127u - (top[1][cand_b(c + 1)] & 127u));
                *(LAS unsigned*)(tab + c) = ea | (eb << 16);
            }
        }
        sort16_desc(ck); sort16_desc(ck + 16); sort16_desc(ck + 32); sort16_desc(ck + 48);
        merge_top16(ck, ck + 16); merge_top16(ck + 32, ck + 48); merge_top16(ck, ck + 32);
        asm volatile("s_waitcnt lgkmcnt(0)" ::: "memory");
        const float mx = keyf(ck[0], 63u); float e[16], den = 0.f;
#pragma unroll
        for (int j = 0; j < 16; ++j) { e[j] = __builtin_amdgcn_exp2f((keyf(ck[j], 63u) - mx) * 1.4426950408889634f); den += e[j]; }
        const float iden = 1.f / den;
        if (hi == 0) {
            unsigned o[16];
#pragma unroll
            for (int j = 0; j < 16; ++j) { const unsigned eid = tab[ck[j] & 63u]; o[j] = (eid << 16) | (cvt_pk_bf16(e[j] * iden, 0.f) & 0xffffu); }
            unsigned* dst = EG + (size_t)(row0 + r32) * 128 + h * 16;
#pragma unroll
            for (int j = 0; j < 16; j += 4) *(u32x4*)(dst + j) = (u32x4){o[j], o[j + 1], o[j + 2], o[j + 3]};
        }
        asm volatile("s_waitcnt lgkmcnt(0)" ::: "memory");
    }
}


#define XB_TMO      128
#define XB_XCNT(j)  (256  + 64 * (j))
#define XB_XSUB(j)  (1280 + 64 * (j))
#define XB_XGEN(j)  (2304 + 64 * (j))
#define XB_TOP      3328
#define XB_TOPGEN   3392
#define XCD_BAR_WORDS 3456
#define XB_SPIN_CAP (1u << 18)

__device__ __forceinline__ unsigned xb_ld(unsigned* p)              { return __hip_atomic_load(p, __ATOMIC_RELAXED, __HIP_MEMORY_SCOPE_AGENT); }
__device__ __forceinline__ unsigned xb_add(unsigned* p, unsigned v) { return __hip_atomic_fetch_add(p, v, __ATOMIC_RELAXED, __HIP_MEMORY_SCOPE_AGENT); }
__device__ __forceinline__ unsigned xb_xcc_id() { return (unsigned)__builtin_amdgcn_s_getreg((3 << 11) | 20) & 0xFu; }
#define XB_SPIN(cond, bar) do { unsigned _sp = 0; while (cond) { __builtin_amdgcn_s_sleep(1); \
    if ((++_sp & 255u) == 0u) { if (xb_ld(&(bar)[XB_TMO])) break; if (_sp > XB_SPIN_CAP) { atomicAdd(&(bar)[XB_TMO], 1u); break; } } } } while (0)

struct XcdBarrier {
    unsigned* bar; unsigned x;
    volatile LAS unsigned* st;
};

__device__ __forceinline__ XcdBarrier xcd_barrier_post(unsigned* bar, volatile LAS unsigned* st) {
    XcdBarrier b; b.bar = bar; b.x = xb_xcc_id(); b.st = st;
    if (threadIdx.x == 0) (void)xb_add(&bar[XB_XCNT(b.x)], 1u);
    return b;
}
__device__ __forceinline__ void xcd_barrier_complete(unsigned* bar, unsigned x, unsigned& nloc, unsigned& nx) {
    const unsigned G = gridDim.x * gridDim.y * gridDim.z;
    unsigned sum, cnt, mine, sp = 0u;
    for (;;) {
        sum = 0u; cnt = 0u; mine = 0u;
#pragma unroll
        for (unsigned j = 0; j < 16; ++j) { const unsigned c = xb_ld(&bar[XB_XCNT(j)]); sum += c; cnt += (c > 0u) ? 1u : 0u; mine = (j == x) ? c : mine; }
        if (sum == G) break;
        __builtin_amdgcn_s_sleep(1);
        if ((++sp & 255u) == 0u) { if (xb_ld(&bar[XB_TMO])) break; if (sp > XB_SPIN_CAP) { atomicAdd(&bar[XB_TMO], 1u); break; } }
    }
    nloc = mine > 0u ? mine : 1u; nx = cnt > 0u ? cnt : 1u;
}

__device__ __forceinline__ void xcd_barrier(const XcdBarrier& b) {
    asm volatile("s_waitcnt vmcnt(0)" ::: "memory");
    __syncthreads();
    if (threadIdx.x == 0) {
        unsigned* bar = b.bar;
        __builtin_amdgcn_s_waitcnt(0);
        unsigned nloc = b.st[0], nx = b.st[1];
        if (nloc == 0u) { xcd_barrier_complete(bar, b.x, nloc, nx); b.st[0] = nloc; b.st[1] = nx; }
        const unsigned old = xb_add(&bar[XB_XSUB(b.x)], 1u);
        const unsigned gen = old / nloc;
        if (old + 1u == (gen + 1u) * nloc) {
            __builtin_amdgcn_fence(__ATOMIC_RELEASE, "agent");
            asm volatile("s_waitcnt vmcnt(0)" ::: "memory");
            const unsigned og = xb_add(&bar[XB_TOP], 1u);
            const unsigned tg = og / nx;
            if (og + 1u == (tg + 1u) * nx) xb_add(&bar[XB_TOPGEN], 1u);
            else XB_SPIN(xb_ld(&bar[XB_TOPGEN]) == tg, bar);
            __builtin_amdgcn_fence(__ATOMIC_ACQUIRE, "agent");
            xb_add(&bar[XB_XGEN(b.x)], 1u);
            asm volatile("s_waitcnt vmcnt(0)" ::: "memory");
        } else {
            XB_SPIN(xb_ld(&bar[XB_XGEN(b.x)]) == gen, bar);
            __builtin_amdgcn_fence(__ATOMIC_ACQUIRE, "agent");
            asm volatile("s_waitcnt vmcnt(0)" ::: "memory");
        }
    }
    __syncthreads();
}

__device__ __forceinline__ void phase_mod(LAS unsigned char* lds, const Inputs& in, const WS& w, int vb) {
    if (vb >= 72) return;
    LAS float* sc = (LAS float*)lds;
    int tid_ = threadIdx.x; asm volatile("" : "+v"(tid_));
    const int tid = tid_, idx = vb * 512 + tid, rg = idx / 12288, ln = idx % 12288, l = ln / 6144, n = ln % 6144;
    float acc[11];
#pragma unroll
    for (int i = 0; i < 11; ++i) acc[i] = 0.f;
    const float* wp = in.ada_w + (size_t)l * 1024 * 6144 + n;
    for (int kc = 0; kc < 4; ++kc) {
        for (int i = tid; i < 33 * 256; i += 512) { const int r = i >> 8, k = kc * 256 + (i & 255); const float v = r < 32 ? in.c[(size_t)r * 1024 + k] : in.c_ctx[k]; sc[i] = v / (1.f + __expf(-v)); }
        __syncthreads();
        for (int k = 0; k < 256; ++k) { const float wv = wp[(size_t)(kc * 256 + k) * 6144];
#pragma unroll
            for (int i = 0; i < 11; ++i) acc[i] += sc[(rg * 11 + i) * 256 + k] * wv; }
        __syncthreads();
    }
    const float bias = in.ada_b[(size_t)l * 6144 + n];
#pragma unroll
    for (int i = 0; i < 11; ++i) w.MOD()[((size_t)l * 33 + rg * 11 + i) * 6144 + n] = acc[i] + bias;
}
__device__ __forceinline__ void phase_rope(const WS& w, int vb, int nvb) {
    int tid_ = threadIdx.x; asm volatile("" : "+v"(tid_));
    for (int i = vb * 512 + tid_; i < 2048 * 32; i += nvb * 512) {
        { const int t = i / 32, j = i % 32; const double inv = pow(10000.0, -(double)(j % 16) / 16.0); const double a = (double)(j < 16 ? t / 64 : t % 64) * inv; w.ROPA()[i] = make_float2((float)cos(a), (float)sin(a)); }
        if (i < 2048 * 16) { const int t = i / 16, j = i % 16; const double inv = pow(10000.0, -(double)(j % 8) / 8.0); const double a = (double)(j < 8 ? t / 64 : t % 64) * inv; w.ROPC()[i] = make_float2((float)cos(a), (float)sin(a)); }
    }
}

#ifndef PROBE_MASK
#define PROBE_MASK 0
#endif
struct MegaArgs { Inputs in; WS w; float* XL; unsigned* bar; };
constexpr int MEGA_LDS = 131072 + 16;
__global__ void __launch_bounds__(512, 2) k_mega(MegaArgs A) {
    LAS unsigned char* lds = (LAS unsigned char*)dyn_lds;
    const int vb = blockIdx.x, nvb = gridDim.x;
    volatile LAS unsigned* xbw = (volatile LAS unsigned*)(lds + 131072);
    if (threadIdx.x == 0) { xbw[0] = 0u; xbw[1] = 0u; xbw[2] = 0u; xbw[3] = 0u; }
    __syncthreads();
    XcdBarrier bar = xcd_barrier_post(A.bar, xbw);
    if (threadIdx.x == 0) xbw[2] = xb_add(&A.bar[3584 + 64 * bar.x], 1u);
    __syncthreads();
    const int xticket = __builtin_amdgcn_readfirstlane((int)xbw[2]);
    const WS& w = A.w; const Inputs& in = A.in;
    phase_mod(lds, in, w, vb);
    phase_rope(w, vb, nvb);
    phase_cvt(lds, in, w, vb, nvb);
    xcd_barrier(bar);
    phase_modulate<false>(in.x, in.ctx, nullptr, w.H(), in.norm1_g, w.MOD(), 0, NR, vb, nvb);
    xcd_barrier(bar);
#if (PROBE_MASK >> 0) & 1
    phase_mod(lds, in, w, vb);
    phase_rope(w, vb, nvb);
    phase_cvt(lds, in, w, vb, nvb);
    xcd_barrier(bar);
    phase_modulate<false>(in.x, in.ctx, nullptr, w.H(), in.norm1_g, w.MOD(), 0, NR, vb, nvb);
    xcd_barrier(bar);
#endif
    int xpart = vb & 7, xrank = vb >> 3;
    { bool okx = (bar.x < 8u); for (unsigned j = 0; j < 8; ++j) okx = okx && (xb_ld(&A.bar[XB_XCNT(j)]) == (unsigned)(nvb >> 3));
      if (okx) { xpart = (int)bar.x; xrank = xticket; } }
    for (int l = 0; l < DEPTH; ++l) {
        const float* MODl = w.MOD() + (size_t)l * 33 * 6144;
        const bool last = (l == DEPTH - 1);
        const int MR = last ? NL : NR;
        phase_p1(lds, w, in, l, vb, nvb); xcd_barrier(bar);
#if (PROBE_MASK >> 1) & 1
        phase_p1(lds, w, in, l, vb, nvb); xcd_barrier(bar);
#endif
        phase_p2(lds, w, in, l, vb, nvb); xcd_barrier(bar);
#if (PROBE_MASK >> 12) & 7
        phase_p2(lds, w, in, l, vb, nvb, (PROBE_MASK >> 12) & 7); xcd_barrier(bar);
#endif
        phase_p3(lds, w, l, vb, nvb); xcd_barrier(bar);
#if (PROBE_MASK >> 3) & 1
        phase_p3(lds, w, l, vb, nvb); xcd_barrier(bar);
#endif
        phase_p4(lds, w, in, l, vb, nvb);
        xcd_barrier(bar);
#if (PROBE_MASK >> 4) & 1
        phase_p4(lds, w, in, l, vb, nvb);
        xcd_barrier(bar);
#endif
        if (l == 0) phase_modulate<false>(in.x, in.ctx, nullptr, w.H(), in.norm2_g + l * 1024, MODl, 3, MR, vb, nvb, w.H8(), w.HS(), w.PQ(), w.XB());
        else phase_modulate<true>(nullptr, nullptr, w.XB(), w.H(), in.norm2_g + l * 1024, MODl, 3, MR, vb, nvb, w.H8(), w.HS(), w.PQ(), w.XB());
        xcd_barrier(bar);
#if (PROBE_MASK >> 5) & 1
        phase_modulate<true>(nullptr, nullptr, w.XB(), w.H(), in.norm2_g + l * 1024, MODl, 3, MR, vb, nvb, w.H8(), w.HS()); xcd_barrier(bar);
#endif
        phase_p6a(lds, w, l, vb, nvb); xcd_barrier(bar);
#if (PROBE_MASK >> 6) & 1
        phase_p6a(lds, w, l, vb, nvb); xcd_barrier(bar);
#endif
        phase_p6b(lds, w.PQ(), w.SubK() + (size_t)l * 16 * 128 * 128, w.EG(), MR, vb, nvb); xcd_barrier(bar);
#if (PROBE_MASK >> 7) & 1
        phase_p6b(lds, w.PQ(), w.SubK() + (size_t)l * 16 * 128 * 128, w.EG(), MR, vb, nvb); xcd_barrier(bar);
#endif
        { P7CArgs a{w.H8(), w.EG(), w.U8() + (size_t)l * NE * 1024, (int*)w.PQ(), MR}; phase_p7c(lds, a, xpart, xrank, nvb); }
        xcd_barrier(bar);
#if (PROBE_MASK >> 8) & 1
        { P7CArgs a{w.H8(), w.EG(), w.U8() + (size_t)l * NE * 1024, (int*)w.PQ(), MR}; phase_p7c(lds, a, xpart, xrank, nvb); }
        xcd_barrier(bar);
#endif
        phase_p7d((const int*)w.PQ(), w.EG(), w.US() + (size_t)l * NE, w.VS() + (size_t)l * NE, w.HS(), w.WE(), MR, vb, nvb);
        xcd_barrier(bar);
#if (PROBE_MASK >> 9) & 1
        phase_p7d((const int*)w.PQ(), w.EG(), w.US() + (size_t)l * NE, w.VS() + (size_t)l * NE, w.HS(), w.WE(), MR, vb, nvb);
        xcd_barrier(bar);
#endif
        { P7BArgs a{w.WE(), w.V8() + (size_t)l * NE * 1024, w.XB(), MODl + 5 * 1024, MR}; phase_p7b<0>(lds, a, xpart, xrank, nvb); }
        xcd_barrier(bar);
#if (PROBE_MASK >> 10) & 3
        { P7BArgs a{w.WE(), w.V8() + (size_t)l * NE * 1024, w.XB(), MODl + 5 * 1024, MR}; phase_p7b<((PROBE_MASK >> 10) & 3)>(lds, a, xpart, xrank, nvb); }
        xcd_barrier(bar);
#endif
        if (last) phase_final_norm(w.XB(), A.XL, in.final_g, vb, nvb);
        else phase_modulate<true>(nullptr, nullptr, w.XB(), w.H(), in.norm1_g + (l + 1) * 1024, w.MOD() + (size_t)(l + 1) * 33 * 6144, 0, NR, vb, nvb);
        if (!last) xcd_barrier(bar);
    }
}

extern "C" void kernel_launch(void* const* d_in, const int* in_sizes, int n_in, void* d_out, int out_size, void* d_ws, size_t ws_size, hipStream_t stream) {
    const float* const* fin = (const float* const*)d_in;
    Inputs in{fin[0], fin[1], fin[2], fin[3], fin[4], fin[5], fin[6], fin[7], fin[8], fin[9], fin[10], fin[11], fin[12], fin[13], fin[14], fin[15], fin[16], fin[17], fin[18], fin[19], fin[20], fin[21], fin[22]};
    WS w = make_ws(d_ws);
    static int ok = 0;
    if (!ok) {
        if (hipFuncSetAttribute((const void*)k_mega, hipFuncAttributeMaxDynamicSharedMemorySize, MEGA_LDS) != hipSuccess) { ok = -1; }
        int per_cu = 0, cus = 0, dev = 0; (void)hipGetDevice(&dev); (void)hipDeviceGetAttribute(&cus, hipDeviceAttributeMultiprocessorCount, dev);
        if (hipOccupancyMaxActiveBlocksPerMultiprocessor(&per_cu, (const void*)k_mega, 512, MEGA_LDS) != hipSuccess || per_cu < 1 || cus < 256) ok = -1;
        if (ok == 0) ok = 1;
    }
    if (ok < 0) return;
    (void)hipMemsetAsync(d_ws, 0, 16384, stream);
    MegaArgs A{in, w, (float*)d_out, (unsigned*)d_ws};
    k_mega<<<256, 512, MEGA_LDS, stream>>>(A);
}
```

```cpp
#include <hip/hip_runtime.h>
#include <stdint.h>

typedef unsigned short bf16_t;

constexpr int D = 1024, NB = 32, S = 2048, CTX = 256, DEPTH = 2;
constexpr int NL = NB * S, NC = NB * CTX, NR = NL + NC;
constexpr int KEYS = CTX + S;
constexpr int INC = 1568;
constexpr int NE = 16384;
constexpr float EPS = 1e-6f;

__device__ __forceinline__ float bf2f(bf16_t v) { return __uint_as_float(((unsigned)v) << 16); }
__device__ __forceinline__ bf16_t f2bf(float f) { unsigned u = __float_as_uint(f); u += 0x7FFFu + ((u >> 16) & 1u); return (bf16_t)(u >> 16); }

__device__ __forceinline__ float wave_sum(float v) {
#pragma unroll
    for (int o = 32; o > 0; o >>= 1) v += __shfl_xor(v, o);
    return v;
}
__device__ __forceinline__ float gelu_tanh(float x) {
    const float u = 0.7978845608028654f * (x + 0.044715f * x * x * x);
    return 0.5f * x * (1.f + tanhf(u));
}

struct WS {
    char* base;
    __host__ __device__ __forceinline__ bf16_t* H() const { return (bf16_t*)(base + 65536ull); }
    __host__ __device__ __forceinline__ bf16_t* Qg() const { return (bf16_t*)(base + 151060480ull); }
    __host__ __device__ __forceinline__ bf16_t* Qgc() const { return (bf16_t*)(base + 201392128ull); }
    __host__ __device__ __forceinline__ bf16_t* Kg() const { return (bf16_t*)(base + 207683584ull); }
    __host__ __device__ __forceinline__ bf16_t* Vg() const { return (bf16_t*)(base + 226557952ull); }
    __host__ __device__ __forceinline__ bf16_t* CQ() const { return (bf16_t*)(base + 245432320ull); }
    __host__ __device__ __forceinline__ bf16_t* CKV() const { return (bf16_t*)(base + 302055424ull); }
    __host__ __device__ __forceinline__ bf16_t* Bp() const { return (bf16_t*)(base + 339804160ull); }
    __host__ __device__ __forceinline__ bf16_t* KR() const { return (bf16_t*)(base + 377552896ull); }
    __host__ __device__ __forceinline__ bf16_t* Qm() const { return (bf16_t*)(base + 382271488ull); }
    __host__ __device__ __forceinline__ bf16_t* Qmc() const { return (bf16_t*)(base + 457768960ull); }
    __host__ __device__ __forceinline__ bf16_t* Kmn() const { return (bf16_t*)(base + 467206144ull); }
    __host__ __device__ __forceinline__ bf16_t* Vm() const { return (bf16_t*)(base + 523829248ull); }
    __host__ __device__ __forceinline__ unsigned* EG() const { return (unsigned*)(base + 580452352ull); }
    __host__ __device__ __forceinline__ bf16_t* P() const { return (bf16_t*)(base + 382271488ull); }
    __host__ __device__ __forceinline__ bf16_t* PQ() const { return (bf16_t*)(base + 151060480ull); }
    __host__ __device__ __forceinline__ bf16_t* TMP() const { return (bf16_t*)(base + 65536ull); }
    __host__ __device__ __forceinline__ float* XC() const { return (float*)(base + 618201088ull); }
    __host__ __device__ __forceinline__ float* MOD() const { return (float*)(base + 651755520ull); }
    __host__ __device__ __forceinline__ float2* ROPA() const { return (float2*)(base + 653377536ull); }
    __host__ __device__ __forceinline__ float2* ROPC() const { return (float2*)(base + 653901824ull); }
    __host__ __device__ __forceinline__ float* RSQ() const { return (float*)(base + 654163968ull); }
    __host__ __device__ __forceinline__ float* RSKV() const { return (float*)(base + 654458880ull); }
    __host__ __device__ __forceinline__ bf16_t* WinT() const { return (bf16_t*)(base + 654753792ull); }
    __host__ __device__ __forceinline__ bf16_t* WuqT() const { return (bf16_t*)(base + 662093824ull); }
    __host__ __device__ __forceinline__ bf16_t* WukvT() const { return (bf16_t*)(base + 663273472ull); }
    __host__ __device__ __forceinline__ bf16_t* WoutT() const { return (bf16_t*)(base + 664059904ull); }
    __host__ __device__ __forceinline__ bf16_t* WqT() const { return (bf16_t*)(base + 668254208ull); }
    __host__ __device__ __forceinline__ bf16_t* SubK() const { return (bf16_t*)(base + 676642816ull); }
    __host__ __device__ __forceinline__ unsigned char* U8() const { return (unsigned char*)(base + 677691392ull); }
    __host__ __device__ __forceinline__ unsigned char* V8() const { return (unsigned char*)(base + 711245824ull); }
    __host__ __device__ __forceinline__ float* US() const { return (float*)(base + 744800256ull); }
    __host__ __device__ __forceinline__ float* VS() const { return (float*)(base + 744931328ull); }
    __host__ __device__ __forceinline__ float* SSQ() const { return (float*)(base + 745062400ull); }
    __host__ __device__ __forceinline__ float* SSKV() const { return (float*)(base + 747421696ull); }
    __host__ __device__ __forceinline__ unsigned* WE() const { return (unsigned*)(base + 748601344ull); }
    __host__ __device__ __forceinline__ signed char* H8() const { return (signed char*)(base + 786350080ull); }
    __host__ __device__ __forceinline__ float* HS() const { return (float*)(base + 861847552ull); }
    __host__ __device__ __forceinline__ bf16_t* PoolWT() const { return (bf16_t*)(base + 862142464ull); }
    __host__ __device__ __forceinline__ bf16_t* XB() const { return (bf16_t*)(base + 862208000ull); }
};
constexpr size_t WS_BYTES = 862208000ull + (size_t)NR * 1024 * 2;
static WS make_ws(void* d_ws) { WS w; w.base = (char*)d_ws; return w; }


#define LAS __attribute__((address_space(3)))
typedef short bf16x8 __attribute__((ext_vector_type(8)));
typedef float f32x4 __attribute__((ext_vector_type(4)));
typedef float f32x16 __attribute__((ext_vector_type(16)));
typedef unsigned u32x4 __attribute__((ext_vector_type(4)));
typedef unsigned u32x2 __attribute__((ext_vector_type(2)));

__device__ __forceinline__ f32x16 mfma32(bf16x8 a, bf16x8 b, f32x16 c) { return __builtin_amdgcn_mfma_f32_32x32x16_bf16(a, b, c, 0, 0, 0); }
__device__ __forceinline__ unsigned cvt_pk_bf16(float lo, float hi) { unsigned r; asm volatile("v_cvt_pk_bf16_f32 %0, %1, %2" : "=v"(r) : "v"(lo), "v"(hi)); return r; }

namespace pg8 {
constexpr int BM = 256, BK = 64, HALF = 128, HTB = HALF * BK * 2, STAGE_BYTES = 8 * HTB, NXCD = 8, WGM = 8;
__host__ __device__ __forceinline__ int lds_byte(int r, int c) { const int st = (r >> 4) * 2 + (c >> 5), rr = r & 15, cc = c & 31, ob = rr * 64 + cc * 2; return st * 1024 + (ob ^ (((ob >> 9) & 1) << 5)); }
__host__ __device__ __forceinline__ void stage_rc(int b, int& R, int& C) { const int st = b / 1024, sb = b % 1024, swz = sb ^ (((sb >> 9) & 1) << 5); R = (st >> 1) * 16 + swz / 64; C = (st & 1) * 32 + (swz % 64) / 2; }
__host__ __device__ __forceinline__ int perm32(int rho) { const int n = rho >> 4, i = rho & 15; return 8 * (i >> 2) + 4 * n + (i & 3); }
struct Unit { int pm, pn; };
struct Gemm { const bf16_t* A; const bf16_t* Bt; int M, N, K; };
struct StaticOrder {
    int nM, nN, nwg, G, c;
    __host__ __device__ void init(int M, int N, int G_, int c_) { nM = M / BM; nN = N / BM; nwg = nM * nN; G = G_; c = c_; }
    __host__ __device__ bool next(int i, Unit& u) const {
        const long L = (long)i * G + c; if (L >= nwg) return false;
        int wgid = (int)L; { const int q = nwg / NXCD, r = nwg % NXCD, xcd = wgid % NXCD, off = wgid / NXCD; wgid = (xcd < r ? xcd * (q + 1) : r * (q + 1) + (xcd - r) * q) + off; }
        const int nig = WGM * nN, gid = wgid / nig, fm = gid * WGM, gsz = (nM - fm) < WGM ? (nM - fm) : WGM;
        u.pm = fm + ((wgid % nig) % gsz); u.pn = (wgid % nig) / gsz; return true;
    }
};
template <class Epi, class Sched>
__device__ __forceinline__ void gemm_phase(LAS unsigned char* lds, const Gemm g, const Sched& S, const Epi& E) {
    int tid_ = threadIdx.x; asm volatile("" : "+v"(tid_));
    const int tid = tid_, wid = __builtin_amdgcn_readfirstlane(tid >> 6), lane = tid & 63, wr = wid >> 2, wc = wid & 3, fr = lane & 15, fq = lane >> 4;
    const int K = g.K, nt = K / BK;
    unsigned voffA[2], voffB[2];
#pragma unroll
    for (int i = 0; i < 2; ++i) { int R, C; stage_rc(tid * 16 + i * 8192, R, C); const int Rb = Epi::PERM ? ((R & ~31) + perm32(R & 31)) : R;
        voffA[i] = (unsigned)(R * K + C) * 2u; voffB[i] = (unsigned)(Rb * K + C) * 2u; }
    const size_t kstep = (size_t)(BK * 2);
    const size_t hstep = (size_t)HALF * K * 2;
    const size_t tstep = 2 * hstep;
    const unsigned ldsw = (unsigned)wid * 1024u;
    const int aoff = lds_byte(wr * 64 + fr, fq * 8), boff = lds_byte(wc * 32 + fr, fq * 8);
#define PG8_SA(b, h) (((b) * 2 + (h)) * HTB)
#define PG8_SB(b, h) ((4 + (b) * 2 + (h)) * HTB)
#define PG8_STAGE(bufoff, gbase, voff) do { _Pragma("unroll") for (int _i = 0; _i < 2; ++_i) \
        __builtin_amdgcn_global_load_lds((const unsigned*)((const char*)(gbase) + (voff)[_i]), (LAS unsigned*)(lds + (bufoff) + ldsw + _i * 8192), 16, 0, 0); } while (0)
#define PG8_LDA(dst, b, h) do { _Pragma("unroll") for (int m = 0; m < 4; ++m) _Pragma("unroll") for (int k = 0; k < 2; ++k) dst[m][k] = *(const LAS bf16x8*)(lds + PG8_SA(b, h) + aoff + m * 2048 + k * 1024); } while (0)
#define PG8_LDB(dst, b, h) do { _Pragma("unroll") for (int n = 0; n < 2; ++n) _Pragma("unroll") for (int k = 0; k < 2; ++k) dst[n][k] = *(const LAS bf16x8*)(lds + PG8_SB(b, h) + boff + n * 2048 + k * 1024); } while (0)
#define PG8_MMA(ai, bj, At, Bt) do { __builtin_amdgcn_s_setprio(1); _Pragma("unroll") for (int m = 0; m < 4; ++m) _Pragma("unroll") for (int n = 0; n < 2; ++n) _Pragma("unroll") for (int k = 0; k < 2; ++k) \
        acc[ai][bj][m][n] = __builtin_amdgcn_mfma_f32_16x16x32_bf16(Bt[n][k], At[m][k], acc[ai][bj][m][n], 0, 0, 0); __builtin_amdgcn_s_setprio(0); } while (0)
#define PG8_WAIT_V(n) asm volatile("s_waitcnt vmcnt(" #n ")" ::: "memory")
#define PG8_WAIT_L(n) asm volatile("s_waitcnt lgkmcnt(" #n ")" ::: "memory")
#define PG8_BAR __builtin_amdgcn_s_barrier()
#define PG8_SCHED __builtin_amdgcn_sched_barrier(0)
    Unit cur, nxt; int ui = 0;
    if (!S.next(0, cur)) return;
    f32x4 acc[2][2][4][2];
#pragma unroll
    for (int a = 0; a < 2; ++a)
#pragma unroll
        for (int b = 0; b < 2; ++b)
#pragma unroll
            for (int m = 0; m < 4; ++m)
#pragma unroll
                for (int n = 0; n < 2; ++n) acc[a][b][m][n] = (f32x4){0.f, 0.f, 0.f, 0.f};
    bf16x8 At[4][2], B0[2][2], B1[2][2];
    const char* cA = (const char*)g.A + (size_t)cur.pm * tstep; const char* cB = (const char*)g.Bt + (size_t)cur.pn * tstep;
    PG8_STAGE(PG8_SB(0, 0), cB, voffB); PG8_STAGE(PG8_SA(0, 0), cA, voffA); PG8_STAGE(PG8_SB(0, 1), cB + hstep, voffB); PG8_STAGE(PG8_SA(0, 1), cA + hstep, voffA);
    if (wr == 1) PG8_BAR;
    PG8_WAIT_V(4); PG8_BAR;
    PG8_STAGE(PG8_SB(1, 0), cB + kstep, voffB); PG8_STAGE(PG8_SA(1, 0), cA + kstep, voffA); PG8_STAGE(PG8_SB(1, 1), cB + hstep + kstep, voffB);
    PG8_WAIT_V(6); PG8_BAR;
    for (;;) {
        const bool has_next = S.next(ui + 1, nxt);
        const char* nA = has_next ? (const char*)g.A + (size_t)nxt.pm * tstep : cA; const char* nB = has_next ? (const char*)g.Bt + (size_t)nxt.pn * tstep : cB;
#pragma nounroll
        for (int t = 0; t < nt; t += 2) {
            const bool last = (t == nt - 2);
            const char* a1 = cA + (size_t)(t + 1) * kstep;
            const char* a2 = last ? nA : cA + (size_t)(t + 2) * kstep; const char* b2 = last ? nB : cB + (size_t)(t + 2) * kstep;
            const char* a3 = a2 + kstep; const char* b3 = b2 + kstep;
            PG8_LDB(B0, 0, 0); PG8_SCHED; PG8_LDA(At, 0, 0); PG8_STAGE(PG8_SA(1, 1), a1 + hstep, voffA);
            PG8_WAIT_L(8); PG8_BAR; PG8_WAIT_L(0); PG8_MMA(0, 0, At, B0); PG8_BAR; PG8_SCHED;
            PG8_LDB(B1, 0, 1); PG8_STAGE(PG8_SB(0, 0), b2, voffB);
            PG8_BAR; PG8_WAIT_L(0); PG8_MMA(0, 1, At, B1); PG8_BAR;
            PG8_LDA(At, 0, 1); PG8_STAGE(PG8_SA(0, 0), a2, voffA);
            PG8_BAR; PG8_WAIT_L(0); PG8_MMA(1, 0, At, B0); PG8_BAR; PG8_SCHED;
            PG8_STAGE(PG8_SB(0, 1), b2 + hstep, voffB);
            PG8_WAIT_V(6); PG8_BAR; PG8_MMA(1, 1, At, B1); PG8_BAR;
            PG8_LDB(B0, 1, 0); PG8_SCHED; PG8_LDA(At, 1, 0); PG8_STAGE(PG8_SA(0, 1), a2 + hstep, voffA);
            PG8_WAIT_L(8); PG8_BAR; PG8_WAIT_L(0); PG8_MMA(0, 0, At, B0); PG8_BAR; PG8_SCHED;
            PG8_LDB(B1, 1, 1); PG8_STAGE(PG8_SB(1, 0), b3, voffB);
            PG8_BAR; PG8_WAIT_L(0); PG8_MMA(0, 1, At, B1); PG8_BAR;
            PG8_LDA(At, 1, 1); PG8_STAGE(PG8_SA(1, 0), a3, voffA);
            PG8_BAR; PG8_WAIT_L(0); PG8_MMA(1, 0, At, B0); PG8_BAR; PG8_SCHED;
            PG8_STAGE(PG8_SB(1, 1), b3 + hstep, voffB);
            PG8_WAIT_V(6); PG8_BAR; PG8_MMA(1, 1, At, B1); PG8_BAR;
        }
        E(acc, cur, wr, wc, fr, fq);
        if (!has_next) break;
#pragma unroll
        for (int a = 0; a < 2; ++a)
#pragma unroll
            for (int b = 0; b < 2; ++b)
#pragma unroll
                for (int m = 0; m < 4; ++m)
#pragma unroll
                    for (int n = 0; n < 2; ++n) acc[a][b][m][n] = (f32x4){0.f, 0.f, 0.f, 0.f};
        cur = nxt; cA = nA; cB = nB; ++ui;
    }
    PG8_WAIT_V(0);
    if (wr == 0) PG8_BAR;
    PG8_BAR;
#undef PG8_SA
#undef PG8_SB
#undef PG8_STAGE
#undef PG8_LDA
#undef PG8_LDB
#undef PG8_MMA
#undef PG8_WAIT_V
#undef PG8_WAIT_L
#undef PG8_BAR
#undef PG8_SCHED
}
}

enum { GT_AQ = 0, GT_AK = 1, GT_AV = 2, GT_B = 3, GT_CQ = 4, GT_CKV = 5, GT_KR = 6, GT_PAD = 7 };
__host__ __device__ __forceinline__ void in_group(int g, int& type, int& sub) {
    if (g < 2) { type = GT_AK; sub = g; } else if (g < 4) { type = GT_AV; sub = g - 2; } else if (g < 8) { type = GT_CKV; sub = g - 4; }
    else if (g == 8) { type = GT_KR; sub = 0; } else if (g < 12) { type = GT_PAD; sub = 0; } else if (g < 18) { type = GT_AQ; sub = g - 12; }
    else if (g < 24) { type = GT_CQ; sub = g - 18; } else { type = GT_B; sub = g - 24; }
}
__device__ __forceinline__ int colmap(int mode, int r) {
    const int pn = r >> 8, ct = r & 255, bj = ct >> 7, wc = (ct >> 5) & 3, j = ct & 31, g = 4 * pn + wc, e = 32 * bj + j;
    if (mode == 0) {
        int type, sub; in_group(g, type, sub);
        switch (type) { case GT_AQ: return 64 * sub + e; case GT_AK: return 384 + 64 * sub + e; case GT_AV: return 512 + 64 * sub + e; case GT_B: return 640 + 64 * sub + e;
            case GT_CQ: return 896 + 64 * sub + e; case GT_CKV: return 1280 + 64 * sub + e; case GT_KR: return (j < 16) ? 1536 + 16 * bj + j : -1; default: return -1; }
    } else if (mode == 1) {
        if (g < 6) return 96 * g + e; if (g < 9) { const int head = 2 * (g - 6) + (j >> 4); return 96 * head + 64 + 16 * bj + (j & 15); } return -1;
    } else if (mode == 2) {
        return 64 * g + e;
    }
    return r;
}
__device__ __forceinline__ void cvt_weights_unit(LAS float* tile  , const float* __restrict__ W, int K, int N, bf16_t* __restrict__ dst, int mode, const float* __restrict__ kgain, int r0, int k0) {
    int tid_ = threadIdx.x; asm volatile("" : "+v"(tid_));
    const int tid = tid_;
    const int jj = tid & 63; const int sc = colmap(mode, r0 + jj);
#pragma unroll
    for (int i = 0; i < 8; ++i) { const int kk = (tid >> 6) + 8 * i; float v = 0.f; if (sc >= 0) v = W[(size_t)(k0 + kk) * N + sc]; if (kgain) v *= kgain[k0 + kk]; tile[kk * 65 + jj] = v; }
    __syncthreads();
#pragma unroll
    for (int i = 0; i < 8; ++i) { const int rr = (tid >> 6) + 8 * i, kk = tid & 63; dst[(size_t)(r0 + rr) * K + k0 + kk] = f2bf(tile[kk * 65 + rr]); }
    __syncthreads();
}
struct CvtJob { const float* W; bf16_t* dst; const float* kgain; int K, N, Npad, mode; };
__device__ __forceinline__ void cvt_job(LAS float* tile, const CvtJob j, int vb, int nvb) {
    const int nk = j.K / 64, nr = j.Npad / 64;
    for (int u = vb; u < nk * nr; u += nvb) cvt_weights_unit(tile, j.W, j.K, j.N, j.dst, j.mode, j.kgain, (u / nk) * 64, (u % nk) * 64);
}
__device__ __forceinline__ void cvt_flat(const float* __restrict__ src, bf16_t* __restrict__ dst, size_t n, int vb, int nvb) {
    int tid_ = threadIdx.x; asm volatile("" : "+v"(tid_));
    for (size_t i = ((size_t)vb * 512 + tid_) * 8; i < n; i += (size_t)nvb * 512 * 8) {
        const float4 a = *(const float4*)(src + i), b = *(const float4*)(src + i + 4);
        u32x4 o; o.x = cvt_pk_bf16(a.x, a.y); o.y = cvt_pk_bf16(a.z, a.w); o.z = cvt_pk_bf16(b.x, b.y); o.w = cvt_pk_bf16(b.z, b.w);
        *(u32x4*)(dst + i) = o;
    }
}
template <bool FP8>
__device__ __forceinline__ void cvt_q8_rows(const float* __restrict__ src, unsigned char* __restrict__ dst, float* __restrict__ scales, int nrows, int vb, int nvb) {
    int tid_ = threadIdx.x; asm volatile("" : "+v"(tid_));
    const int lane = tid_ & 63, wid = tid_ >> 6;
    const int stride = nvb * 8;
    for (int row0 = vb * 8 + wid; row0 < nrows; row0 += 4 * stride) {
        f32x4 v[4][4];
#pragma unroll
        for (int q = 0; q < 4; ++q) { const int row = row0 + q * stride < nrows ? row0 + q * stride : row0; const float* sp = src + (size_t)row * 1024 + 16 * lane;
#pragma unroll
            for (int k = 0; k < 4; ++k) v[q][k] = *(const f32x4*)(sp + 4 * k); }
#pragma unroll
        for (int q = 0; q < 4; ++q) { const int row = row0 + q * stride; if (row < nrows) {
            float am = 0.f;
#pragma unroll
            for (int k = 0; k < 4; ++k) am = fmaxf(am, fmaxf(fmaxf(fabsf(v[q][k][0]), fabsf(v[q][k][1])), fmaxf(fabsf(v[q][k][2]), fabsf(v[q][k][3]))));
#pragma unroll
            for (int o = 32; o > 0; o >>= 1) am = fmaxf(am, __shfl_xor(am, o));
            const float qmax = FP8 ? 416.f : 127.f;
            const float sc = am > 0.f ? am / qmax : 1.f, inv = am > 0.f ? qmax / am : 0.f;
            u32x4 o4;
#pragma unroll
            for (int k = 0; k < 4; ++k) {
                if (FP8) { int p = __builtin_amdgcn_cvt_pk_fp8_f32(v[q][k][0] * inv, v[q][k][1] * inv, 0, false); p = __builtin_amdgcn_cvt_pk_fp8_f32(v[q][k][2] * inv, v[q][k][3] * inv, p, true); o4[k] = (unsigned)p; }
                else { const int q0 = (int)rintf(v[q][k][0] * inv), q1 = (int)rintf(v[q][k][1] * inv), q2 = (int)rintf(v[q][k][2] * inv), q3 = (int)rintf(v[q][k][3] * inv);
                    o4[k] = (unsigned)(q0 & 0xff) | ((unsigned)(q1 & 0xff) << 8) | ((unsigned)(q2 & 0xff) << 16) | ((unsigned)(q3 & 0xff) << 24); } }
            *(u32x4*)(dst + (size_t)row * 1024 + 16 * lane) = o4;
            if (lane == 0) scales[row] = sc; } }
    }
}
struct Inputs {
    const float *x, *c, *ctx, *c_ctx, *ada_w, *ada_b, *norm1_g, *norm2_g, *w_in, *gqa_qn_g, *gqa_kn_g, *pool_w, *pool_scale, *mla_qn_g, *mla_kvn_g, *mla_w_uq, *mla_w_ukv, *w_out, *peer_wq, *peer_subkeys, *peer_u, *peer_v, *final_g;
};
__device__ __forceinline__ void phase_cvt(LAS unsigned char* lds, const Inputs& in, const WS& w, int vb, int nvb) {
    LAS float* tile = (LAS float*)lds;
    for (int l = 0; l < 2; ++l) {
        cvt_job(tile, CvtJob{in.w_in + (size_t)l * 1024 * INC, w.WinT() + (size_t)l * 1792 * 1024, nullptr, 1024, INC, 1792, 0}, vb, nvb);
        cvt_job(tile, CvtJob{in.mla_w_uq + (size_t)l * 384 * 576, w.WuqT() + (size_t)l * 768 * 384, in.mla_qn_g + l * 384, 384, 576, 768, 1}, vb, nvb);
        cvt_job(tile, CvtJob{in.mla_w_ukv + (size_t)l * 256 * 768, w.WukvT() + (size_t)l * 768 * 256, in.mla_kvn_g + l * 256, 256, 768, 768, 2}, vb, nvb);
        cvt_job(tile, CvtJob{in.w_out + (size_t)l * 1024 * 1024, w.WoutT() + (size_t)l * 1024 * 1024, nullptr, 1024, 1024, 1024, 3}, vb, nvb);
        cvt_job(tile, CvtJob{in.peer_wq + (size_t)l * 1024 * 2048, w.WqT() + (size_t)l * 2048 * 1024, nullptr, 1024, 2048, 2048, 3}, vb, nvb);
    }
    cvt_flat(in.peer_subkeys, w.SubK(), (size_t)2 * 16 * 128 * 128, vb, nvb);
    { int tp_ = threadIdx.x; asm volatile("" : "+v"(tp_));
      for (int i = vb * 512 + tp_; i < 2 * 4 * 64 * 64; i += nvb * 512) { const int c = i & 63, d = (i >> 6) & 63, lg = i >> 12; w.PoolWT()[i] = f2bf(in.pool_w[(size_t)lg * 4096 + c * 64 + d]); } }
    if (nvb > 144) { if (vb >= 72) { cvt_q8_rows<false>(in.peer_u, w.U8(), w.US(), 2 * NE, vb - 72, nvb - 72); cvt_q8_rows<true>(in.peer_v, w.V8(), w.VS(), 2 * NE, vb - 72, nvb - 72); } }
    else { cvt_q8_rows<false>(in.peer_u, w.U8(), w.US(), 2 * NE, vb, nvb); cvt_q8_rows<true>(in.peer_v, w.V8(), w.VS(), 2 * NE, vb, nvb); }
}

constexpr float ATT_C2G = 0.125f * 1.4426950408889634f, ATT_C2M = 0.10206207261596577f * 1.4426950408889634f;
struct EpiIn {
    static constexpr bool PERM = true;
    WS w; const float* qn_g; const float* kn_g; int pm_base;
    __device__ __forceinline__ void operator()(const f32x4 (&acc)[2][2][4][2], const pg8::Unit& u, int wr, int wc, int fr, int fq) const {
        int type, sub; in_group(4 * u.pn + wc, type, sub);
        if (type == GT_PAD) return;
        const int pm = u.pm + pm_base; const bool isctx = pm >= 256; const int b = isctx ? pm - 256 : pm >> 3; const int t0 = isctx ? 0 : (pm & 7) * 256;
        const size_t rowbase = isctx ? (size_t)NL + (size_t)b * CTX : (size_t)b * S;
        const int keyoff = isctx ? 0 : CTX;
        float gain[2][8];
        if (type == GT_AQ) {
#pragma unroll
            for (int bj = 0; bj < 2; ++bj)
#pragma unroll
                for (int q = 0; q < 8; ++q) gain[bj][q] = qn_g[32 * bj + 8 * fq + q] * ATT_C2G;
        } else if (type == GT_AK) {
#pragma unroll
            for (int bj = 0; bj < 2; ++bj)
#pragma unroll
                for (int q = 0; q < 8; ++q) gain[bj][q] = kn_g[32 * bj + 8 * fq + q];
        }
#pragma unroll
        for (int ai = 0; ai < 2; ++ai)
#pragma unroll
            for (int m = 0; m < 4; ++m) {
                const int t = t0 + 128 * ai + 64 * wr + 16 * m + fr; const size_t row = rowbase + t;
                float v[2][8];
#pragma unroll
                for (int bj = 0; bj < 2; ++bj)
#pragma unroll
                    for (int n = 0; n < 2; ++n)
#pragma unroll
                        for (int i = 0; i < 4; ++i) v[bj][4 * n + i] = acc[ai][bj][m][n][i];
                bf16_t* dst = nullptr;
                if (type == GT_AQ || type == GT_AK) {
                    float ss = 0.f;
#pragma unroll
                    for (int bj = 0; bj < 2; ++bj)
#pragma unroll
                        for (int q = 0; q < 8; ++q) ss += v[bj][q] * v[bj][q];
                    ss += __shfl_xor(ss, 16); ss += __shfl_xor(ss, 32);
                    const float rstd = rsqrtf(ss * (1.f / 64.f) + EPS);
#pragma unroll
                    for (int q = 0; q < 8; ++q) { float x1 = v[0][q] * rstd * gain[0][q], x2 = v[1][q] * rstd * gain[1][q];
                        if (!isctx) { const float2 cs = w.ROPA()[t * 32 + 8 * fq + q]; const float y1 = x1 * cs.x - x2 * cs.y, y2 = x1 * cs.y + x2 * cs.x; x1 = y1; x2 = y2; }
                        v[0][q] = x1; v[1][q] = x2; }
                    if (type == GT_AQ) dst = isctx ? w.Qgc() + (((size_t)b * 6 + sub) * CTX + t) * 64 : w.Qg() + (((size_t)b * 6 + sub) * S + t) * 64;
                    else dst = w.Kg() + (((size_t)b * 2 + sub) * KEYS + keyoff + t) * 64;
                } else if (type == GT_AV) { dst = w.Vg() + (((size_t)b * 2 + sub) * KEYS + keyoff + t) * 64;
                } else if (type == GT_B) { dst = w.Bp() + row * 256 + 64 * sub;
                } else if (type == GT_CQ || type == GT_CKV) {
                    float ss = 0.f;
#pragma unroll
                    for (int bj = 0; bj < 2; ++bj)
#pragma unroll
                        for (int q = 0; q < 8; ++q) ss += v[bj][q] * v[bj][q];
                    ss += __shfl_xor(ss, 16); ss += __shfl_xor(ss, 32);
                    if (type == GT_CQ) { if (fq == 0) w.SSQ()[row * 8 + sub] = ss; dst = w.CQ() + row * 384 + 64 * sub; }
                    else { if (fq == 0) w.SSKV()[row * 4 + sub] = ss; dst = w.CKV() + row * 256 + 64 * sub; }
                } else {
                    if (!isctx) {
#pragma unroll
                        for (int q = 0; q < 8; ++q) { const float2 cs = w.ROPC()[t * 16 + ((8 * fq + q) & 15)]; const float x1 = v[0][q], x2 = v[1][q]; v[0][q] = x1 * cs.x - x2 * cs.y; v[1][q] = x1 * cs.y + x2 * cs.x; } }
                    if (fq < 2) { bf16_t* kd = w.KR() + ((size_t)b * KEYS + keyoff + t) * 32;
#pragma unroll
                        for (int bj = 0; bj < 2; ++bj) { u32x4 o; o.x = cvt_pk_bf16(v[bj][0], v[bj][1]); o.y = cvt_pk_bf16(v[bj][2], v[bj][3]); o.z = cvt_pk_bf16(v[bj][4], v[bj][5]); o.w = cvt_pk_bf16(v[bj][6], v[bj][7]);
                            *(u32x4*)(kd + 16 * bj + 8 * fq) = o; } }
                    continue;
                }
#pragma unroll
                for (int bj = 0; bj < 2; ++bj) { u32x4 o; o.x = cvt_pk_bf16(v[bj][0], v[bj][1]); o.y = cvt_pk_bf16(v[bj][2], v[bj][3]); o.z = cvt_pk_bf16(v[bj][4], v[bj][5]); o.w = cvt_pk_bf16(v[bj][6], v[bj][7]);
                    *(u32x4*)(dst + 32 * bj + 8 * fq) = o; }
            }
    }
};
struct P1Order {
    pg8::StaticOrder so; int nctx_tiles, G, c;
    __device__ bool next(int i, pg8::Unit& u) const {
        const int L = i * G + c;
        if (L < 1792) return so.next(i, u);
        const int Lc = L - 1792; if (Lc >= 32 * nctx_tiles) return false;
        u.pm = 256 + (Lc & 31); u.pn = Lc >> 5; return true;
    }
};
__device__ __forceinline__ void phase_p1(LAS unsigned char* lds, const WS& w, const Inputs& in, int l, int vb, int nvb) {
    EpiIn E{w, in.gqa_qn_g + l * 64, in.gqa_kn_g + l * 64, 0};
    P1Order po; po.so.init(NL, 1792, nvb, vb); po.nctx_tiles = (l == 0) ? 7 : 3; po.G = nvb; po.c = vb;
    pg8::gemm_phase(lds, pg8::Gemm{w.H(), w.WinT() + (size_t)l * 1792 * 1024, NR, 1792, 1024}, po, E);
}

extern __shared__ __attribute__((aligned(16))) unsigned char dyn_lds[];

struct EpiUq {
    static constexpr bool PERM = true;
    WS w;
    __device__ __forceinline__ void operator()(const f32x4 (&acc)[2][2][4][2], const pg8::Unit& u, int wr, int wc, int fr, int fq) const {
        const int g = 4 * u.pn + wc; if (g >= 9) return;
        const int pm = u.pm; const bool isctx = pm >= 256; const int b = isctx ? pm - 256 : pm >> 3; const int t0 = isctx ? 0 : (pm & 7) * 256;
        const size_t rowbase = isctx ? (size_t)NL + (size_t)b * CTX : (size_t)b * S;
        const int head = g < 6 ? g : 2 * (g - 6) + (fq >> 1);
#pragma unroll
        for (int ai = 0; ai < 2; ++ai)
#pragma unroll
            for (int m = 0; m < 4; ++m) {
                const int t = t0 + 128 * ai + 64 * wr + 16 * m + fr; const size_t row = rowbase + t;
                const float4 s0 = *(const float4*)(w.SSQ() + row * 8), s1 = *(const float4*)(w.SSQ() + row * 8 + 4);
                const float rstd = rsqrtf((s0.x + s0.y + s0.z + s0.w + s1.x + s1.y) * (1.f / 384.f) + EPS) * ATT_C2M;
                float v[2][8];
#pragma unroll
                for (int bj = 0; bj < 2; ++bj)
#pragma unroll
                    for (int n = 0; n < 2; ++n)
#pragma unroll
                        for (int i = 0; i < 4; ++i) v[bj][4 * n + i] = acc[ai][bj][m][n][i] * rstd;
                bf16_t* hd = isctx ? w.Qmc() + (((size_t)b * 6 + head) * CTX + t) * 96 : w.Qm() + (((size_t)b * 6 + head) * S + t) * 96;
                if (g >= 6 && !isctx) {
#pragma unroll
                    for (int q = 0; q < 8; ++q) { const float2 cs = w.ROPC()[t * 16 + 8 * (fq & 1) + q]; const float x1 = v[0][q], x2 = v[1][q]; v[0][q] = x1 * cs.x - x2 * cs.y; v[1][q] = x1 * cs.y + x2 * cs.x; } }
#pragma unroll
                for (int bj = 0; bj < 2; ++bj) { u32x4 o; o.x = cvt_pk_bf16(v[bj][0], v[bj][1]); o.y = cvt_pk_bf16(v[bj][2], v[bj][3]); o.z = cvt_pk_bf16(v[bj][4], v[bj][5]); o.w = cvt_pk_bf16(v[bj][6], v[bj][7]);
                    bf16_t* d = g < 6 ? hd + 32 * bj + 8 * fq : hd + 64 + 16 * bj + 8 * (fq & 1);
                    *(u32x4*)d = o; }
            }
    }
};
struct EpiUkv {
    static constexpr bool PERM = true;
    WS w;
    __device__ __forceinline__ void operator()(const f32x4 (&acc)[2][2][4][2], const pg8::Unit& u, int wr, int wc, int fr, int fq) const {
        const int g = 4 * u.pn + wc;
        const int pm = u.pm; const bool isctx = pm >= 256; const int b = isctx ? pm - 256 : pm >> 3; const int t0 = isctx ? 0 : (pm & 7) * 256;
        const size_t rowbase = isctx ? (size_t)NL + (size_t)b * CTX : (size_t)b * S; const int keyoff = isctx ? 0 : CTX;
        bf16_t* base = ((g & 1) ? w.Vm() : w.Kmn()) + ((size_t)b * 6 + (g >> 1)) * KEYS * 64;
#pragma unroll
        for (int ai = 0; ai < 2; ++ai)
#pragma unroll
            for (int m = 0; m < 4; ++m) {
                const int t = t0 + 128 * ai + 64 * wr + 16 * m + fr; const size_t row = rowbase + t;
                const float4 s0 = *(const float4*)(w.SSKV() + row * 4);
                const float rstd = rsqrtf((s0.x + s0.y + s0.z + s0.w) * (1.f / 256.f) + EPS);
                bf16_t* d = base + (size_t)(keyoff + t) * 64;
#pragma unroll
                for (int bj = 0; bj < 2; ++bj) { const f32x4 a0 = acc[ai][bj][m][0] * rstd, a1 = acc[ai][bj][m][1] * rstd;
                    u32x4 o; o.x = cvt_pk_bf16(a0[0], a0[1]); o.y = cvt_pk_bf16(a0[2], a0[3]); o.z = cvt_pk_bf16(a1[0], a1[1]); o.w = cvt_pk_bf16(a1[2], a1[3]);
                    *(u32x4*)(d + 32 * bj + 8 * fq) = o; }
            }
    }
};
constexpr int POOL_X = 0, POOL_P = 272 * 128, POOL_BYTES = 272 * 128 + 256 * 128;
__device__ __forceinline__ void phase_pool(LAS unsigned char* lds, const WS& w, bf16_t* __restrict__ MIX, const bf16_t* __restrict__ WT  , const float* __restrict__ pool_scale, int nrows, int vb, int nvb) {
    int tid_ = threadIdx.x; asm volatile("" : "+v"(tid_));
    const int tid = tid_, lane = tid & 63, wid = __builtin_amdgcn_readfirstlane(tid >> 6), r32 = lane & 31, hi = lane >> 5;
    const int nunits = nrows >> 8;
    for (int u = vb; u < nunits; u += nvb) {
        const int row0 = u << 8; const bool isctx = row0 >= NL; const int L = isctx ? CTX : S; const int t0 = isctx ? 0 : (row0 & (S - 1)); const int seq0 = row0 - t0;
#pragma unroll 1
        for (int g = 0; g < 4; ++g) {
            const int wdw = 2 << g, half = wdw >> 1;
            for (int i = tid; i < 272 * 8; i += 512) { const int rr = i >> 3, ch = i & 7; int t = t0 - 8 + rr; t = t < 0 ? 0 : (t >= L ? L - 1 : t);
                *(LAS u32x4*)(lds + POOL_X + rr * 128 + ch * 16) = *(const u32x4*)(w.Bp() + (size_t)(seq0 + t) * 256 + g * 64 + ch * 8); }
            __syncthreads();
            { const int c = tid & 63, seg = tid >> 6; const LAS bf16_t* X = (const LAS bf16_t*)(lds + POOL_X) + c;
              int t = t0 + seg * 32; int lo = t - half, hiw = t - half + wdw; lo = lo < 0 ? 0 : lo; hiw = hiw > L ? L : hiw;
              float sum = 0.f; for (int q = lo; q < hiw; ++q) sum += bf2f(X[(q - t0 + 8) * 64]);
#pragma unroll 4
              for (int k = 0; k < 32; ++k, ++t) {
                  const int clo = (t - half) < 0 ? 0 : (t - half), chi = (t - half + wdw) > L ? L : (t - half + wdw);
                  const float pv = sum / (float)(chi - clo) - bf2f(X[(t - t0 + 8) * 64]);
                  const int r = seg * 32 + k; *((LAS bf16_t*)(lds + POOL_P + r * 128 + (((c >> 3) ^ ((r >> 1) & 7)) << 4)) + (c & 7)) = f2bf(pv);
                  const int add = t + 1 - half + wdw - 1, drop = t - half;
                  if (add < L) sum += bf2f(X[(add - t0 + 8) * 64]);
                  if (drop >= 0) sum -= bf2f(X[(drop - t0 + 8) * 64]);
              } }
            __syncthreads();
            { f32x16 o0 = {}, o1 = {};
              const bf16_t* wt = WT + (size_t)g * 4096 + (size_t)r32 * 64 + 8 * hi;
#pragma unroll
              for (int s = 0; s < 4; ++s) { const int row = wid * 32 + r32; const bf16x8 pf = *(const LAS bf16x8*)(lds + POOL_P + row * 128 + (((2 * s + hi) ^ ((row >> 1) & 7)) << 4));
                  o0 = mfma32(*(const bf16x8*)(wt + 16 * s), pf, o0); o1 = mfma32(*(const bf16x8*)(wt + 32 * 64 + 16 * s), pf, o1); }
              bf16_t* op = MIX + (size_t)(row0 + wid * 32 + r32) * 1024 + 384 + g * 64 + 4 * hi; const float* ps = pool_scale + g * 64 + 4 * hi;
#pragma unroll
              for (int q = 0; q < 4; ++q) { const f32x4 s0 = *(const f32x4*)(ps + 8 * q), s1 = *(const f32x4*)(ps + 32 + 8 * q); u32x2 a, b;
                  a.x = cvt_pk_bf16(o0[4 * q] * s0[0], o0[4 * q + 1] * s0[1]); a.y = cvt_pk_bf16(o0[4 * q + 2] * s0[2], o0[4 * q + 3] * s0[3]);
                  b.x = cvt_pk_bf16(o1[4 * q] * s1[0], o1[4 * q + 1] * s1[1]); b.y = cvt_pk_bf16(o1[4 * q + 2] * s1[2], o1[4 * q + 3] * s1[3]);
                  *(u32x2*)(op + 8 * q) = a; *(u32x2*)(op + 32 + 8 * q) = b; } }
            __syncthreads();
        }
    }
}
__device__ __forceinline__ void phase_p2(LAS unsigned char* lds, const WS& w, const Inputs& in, int l, int vb, int nvb, int parts = 7) {
    pg8::StaticOrder so;
    if (parts & 1) { EpiUq E{w}; const int M = l == 0 ? NR : NL; so.init(M, 768, nvb, vb); pg8::gemm_phase(lds, pg8::Gemm{w.CQ(), w.WuqT() + (size_t)l * 768 * 384, M, 768, 384}, so, E); }
    if (parts & 2) { EpiUkv E{w}; so.init(NR, 768, nvb, vb); pg8::gemm_phase(lds, pg8::Gemm{w.CKV(), w.WukvT() + (size_t)l * 768 * 256, NR, 768, 256}, so, E); }
    if (parts & 4) phase_pool(lds, w, w.H(), w.PoolWT() + (size_t)l * 4 * 64 * 64, in.pool_scale + l * 256, l == 0 ? NR : NL, vb, nvb);
}

struct EpiOut {
    static constexpr bool PERM = true;
    bf16_t* DLT; const float* gate;
    __device__ __forceinline__ void operator()(const f32x4 (&acc)[2][2][4][2], const pg8::Unit& u, int wr, int wc, int fr, int fq) const {
        const int pm = u.pm; const int mr = pm >= 256 ? 32 : pm >> 3;
        const size_t r0 = (size_t)pm * 256 + wr * 64 + fr; const int col0 = u.pn * 256 + wc * 32 + 8 * fq;
        f32x4 gv[2][2];
#pragma unroll
        for (int bj = 0; bj < 2; ++bj)
#pragma unroll
            for (int n = 0; n < 2; ++n) gv[bj][n] = *(const f32x4*)(gate + (size_t)mr * 6144 + col0 + bj * 128 + 4 * n);
#pragma unroll
        for (int ai = 0; ai < 2; ++ai)
#pragma unroll
            for (int m = 0; m < 4; ++m) { bf16_t* d = DLT + (r0 + ai * 128 + m * 16) * 1024 + col0;
#pragma unroll
                for (int bj = 0; bj < 2; ++bj) { const f32x4 a0 = acc[ai][bj][m][0] * gv[bj][0], a1 = acc[ai][bj][m][1] * gv[bj][1];
                    u32x4 o; o.x = cvt_pk_bf16(a0[0], a0[1]); o.y = cvt_pk_bf16(a0[2], a0[3]); o.z = cvt_pk_bf16(a1[0], a1[1]); o.w = cvt_pk_bf16(a1[2], a1[3]);
                    *(u32x4*)(d + bj * 128) = o; } }
    }
};
__device__ __forceinline__ void phase_p4(LAS unsigned char* lds, const WS& w, const Inputs& in, int l, int vb, int nvb) {
    const float* MODl = w.MOD() + (size_t)l * 33 * 6144;
    EpiOut E{w.PQ(), MODl + 2 * 1024};
    const int M = l == 0 ? NR : NL;
    pg8::StaticOrder so; so.init(M, 1024, nvb, vb);
    pg8::gemm_phase(lds, pg8::Gemm{w.H(), w.WoutT() + (size_t)l * 1024 * 1024, M, 1024, 1024}, so, E);
}

template <bool INBF>
__device__ __forceinline__ void phase_modulate(const float* __restrict__ XLp, const float* __restrict__ XCp, const bf16_t* __restrict__ XBp, bf16_t* __restrict__ Hout, const float* __restrict__ g, const float* __restrict__ MODl, int si, int nrows, int vb, int nvb,
                                               signed char* __restrict__ H8 = nullptr, float* __restrict__ HS = nullptr, const bf16_t* __restrict__ DLT = nullptr, bf16_t* __restrict__ XBo = nullptr) {
    int tid_ = threadIdx.x; asm volatile("" : "+v"(tid_));
    const int tid = tid_, lane = tid & 63, wid = tid >> 6;
    f32x4 gv[4];
#pragma unroll
    for (int i = 0; i < 4; ++i) gv[i] = *(const f32x4*)(g + 256 * i + 4 * lane);
    const int stride = nvb * 8, lastrow = nrows - 1;
    f32x4 nx[4]; u32x2 nxb[4], ndr[4];
#define PM_LOAD(r_) do { const int rr_ = (r_) < nrows ? (r_) : lastrow; const bool ic_ = rr_ >= NL; const float* xp_ = ic_ ? XCp + (size_t)(rr_ - NL) * 1024 : XLp + (size_t)rr_ * 1024; \
        _Pragma("unroll") for (int i = 0; i < 4; ++i) { if (INBF) nxb[i] = *(const u32x2*)(XBp + (size_t)rr_ * 1024 + 256 * i + 4 * lane); else nx[i] = *(const f32x4*)(xp_ + 256 * i + 4 * lane); \
            if (DLT) ndr[i] = *(const u32x2*)(DLT + (size_t)rr_ * 1024 + 256 * i + 4 * lane); } } while (0)
    PM_LOAD(vb * 8 + wid);
    for (int row = vb * 8 + wid; row < nrows; row += stride) {
        const bool isctx = row >= NL; const int mr = isctx ? 32 : row / S;
        f32x4 x[4]; u32x2 dr4[4]; float ss = 0.f;
#pragma unroll
        for (int i = 0; i < 4; ++i) { if (INBF) x[i] = (f32x4){__uint_as_float(nxb[i].x << 16), __uint_as_float(nxb[i].x & 0xffff0000u), __uint_as_float(nxb[i].y << 16), __uint_as_float(nxb[i].y & 0xffff0000u)}; else x[i] = nx[i];
            if (DLT) dr4[i] = ndr[i]; }
        PM_LOAD(row + stride);
#pragma unroll
        for (int i = 0; i < 4; ++i) {
            if (DLT) { const u32x2 dr = dr4[i];
                x[i][0] += __uint_as_float(dr.x << 16); x[i][1] += __uint_as_float(dr.x & 0xffff0000u); x[i][2] += __uint_as_float(dr.y << 16); x[i][3] += __uint_as_float(dr.y & 0xffff0000u);
                u32x2 xo; xo.x = cvt_pk_bf16(x[i][0], x[i][1]); xo.y = cvt_pk_bf16(x[i][2], x[i][3]); *(u32x2*)(XBo + (size_t)row * 1024 + 256 * i + 4 * lane) = xo; }
            ss += x[i][0] * x[i][0] + x[i][1] * x[i][1] + x[i][2] * x[i][2] + x[i][3] * x[i][3]; }
        ss = wave_sum(ss); const float rstd = rsqrtf(ss * (1.f / 1024.f) + EPS);
        const float* sh = MODl + (size_t)mr * 6144 + si * 1024;
        f32x4 y[4]; float am = 0.f;
#pragma unroll
        for (int i = 0; i < 4; ++i) { const f32x4 shv = *(const f32x4*)(sh + 256 * i + 4 * lane), scv = *(const f32x4*)(sh + 1024 + 256 * i + 4 * lane);
            y[i] = x[i] * rstd * gv[i] * (scv + 1.f) + shv;
            am = fmaxf(am, fmaxf(fmaxf(fabsf(y[i][0]), fabsf(y[i][1])), fmaxf(fabsf(y[i][2]), fabsf(y[i][3]))));
            u32x2 o; o.x = cvt_pk_bf16(y[i][0], y[i][1]); o.y = cvt_pk_bf16(y[i][2], y[i][3]);
            *(u32x2*)(Hout + (size_t)row * 1024 + 256 * i + 4 * lane) = o; }
        if (H8) {
#pragma unroll
            for (int o = 32; o > 0; o >>= 1) am = fmaxf(am, __shfl_xor(am, o));
            const float inv = am > 0.f ? 127.f / am : 0.f;
#pragma unroll
            for (int i = 0; i < 4; ++i) { const int q0 = (int)rintf(y[i][0] * inv), q1 = (int)rintf(y[i][1] * inv), q2 = (int)rintf(y[i][2] * inv), q3 = (int)rintf(y[i][3] * inv);
                *(unsigned*)(H8 + (size_t)row * 1024 + 256 * i + 4 * lane) = (unsigned)(q0 & 0xff) | ((unsigned)(q1 & 0xff) << 8) | ((unsigned)(q2 & 0xff) << 16) | ((unsigned)(q3 & 0xff) << 24); }
            if (lane == 0) HS[row] = am > 0.f ? am * (1.f / 127.f) : 1.f;
        }
    }
#undef PM_LOAD
}

struct EpiPQ {
    static constexpr bool PERM = true;
    bf16_t* PQ;
    __device__ __forceinline__ void operator()(const f32x4 (&acc)[2][2][4][2], const pg8::Unit& u, int wr, int wc, int fr, int fq) const {
        const size_t r0 = (size_t)u.pm * 256 + wr * 64 + fr; const int col0 = u.pn * 256 + wc * 32 + 8 * fq;
#pragma unroll
        for (int ai = 0; ai < 2; ++ai)
#pragma unroll
            for (int m = 0; m < 4; ++m) { bf16_t* d = PQ + (r0 + ai * 128 + m * 16) * 2048 + col0;
#pragma unroll
                for (int bj = 0; bj < 2; ++bj) { const f32x4 a0 = acc[ai][bj][m][0], a1 = acc[ai][bj][m][1];
                    u32x4 o; o.x = cvt_pk_bf16(a0[0], a0[1]); o.y = cvt_pk_bf16(a0[2], a0[3]); o.z = cvt_pk_bf16(a1[0], a1[1]); o.w = cvt_pk_bf16(a1[2], a1[3]);
                    *(u32x4*)(d + bj * 128) = o; } }
    }
};
__device__ __forceinline__ void phase_p6a(LAS unsigned char* lds, const WS& w, int l, int vb, int nvb) {
    EpiPQ E{w.PQ()}; const int M = l == 0 ? NR : NL;
    pg8::StaticOrder so; so.init(M, 2048, nvb, vb);
    pg8::gemm_phase(lds, pg8::Gemm{w.H(), w.WqT() + (size_t)l * 2048 * 1024, M, 2048, 1024}, so, E);
}


using bf16x2_t = __attribute__((ext_vector_type(2))) __bf16;
typedef float f32x2 __attribute__((ext_vector_type(2)));
__device__ __forceinline__ float gelu_fast(float x) {
    const float u2 = 1.5957691216057308f * (x + 0.044715f * x * x * x);
    return x * __builtin_amdgcn_rcpf(1.f + __builtin_amdgcn_exp2f(-1.4426950408889634f * u2));
}
#define DPPF(v, ctrl) __builtin_bit_cast(float, __builtin_amdgcn_update_dpp(0, __builtin_bit_cast(int, (v)), (ctrl), 0xf, 0xf, true))
__device__ __forceinline__ float reduce8(float p0, float p1, float p2, float p3, float p4, float p5, float p6, float p7, int lane) {
    auto s01 = __builtin_amdgcn_permlane32_swap(__float_as_uint(p0), __float_as_uint(p1), false, false);
    auto s23 = __builtin_amdgcn_permlane32_swap(__float_as_uint(p2), __float_as_uint(p3), false, false);
    auto s45 = __builtin_amdgcn_permlane32_swap(__float_as_uint(p4), __float_as_uint(p5), false, false);
    auto s67 = __builtin_amdgcn_permlane32_swap(__float_as_uint(p6), __float_as_uint(p7), false, false);
    const float q0 = __uint_as_float(s01[0]) + __uint_as_float(s01[1]), q1 = __uint_as_float(s23[0]) + __uint_as_float(s23[1]);
    const float q2 = __uint_as_float(s45[0]) + __uint_as_float(s45[1]), q3 = __uint_as_float(s67[0]) + __uint_as_float(s67[1]);
    auto t0 = __builtin_amdgcn_permlane16_swap(__float_as_uint(q0), __float_as_uint(q1), false, false);
    auto t1 = __builtin_amdgcn_permlane16_swap(__float_as_uint(q2), __float_as_uint(q3), false, false);
    float r0 = __uint_as_float(t0[0]) + __uint_as_float(t0[1]);
    float r1 = __uint_as_float(t1[0]) + __uint_as_float(t1[1]);
    r0 += DPPF(r0, 0x128); r1 += DPPF(r1, 0x128);
    float z = (lane & 8) ? r1 : r0;
    z += DPPF(z, 0x141);
    z += DPPF(z, 0xB1);
    z += DPPF(z, 0x4E);
    return z;
}
__device__ __forceinline__ void p7_axpy(const u32x4 v, float wj, f32x2 (&out)[8]) {
    const f32x2 w2 = {wj, wj};
#pragma unroll
    for (int k = 0; k < 4; ++k) { const f32x2 lo = __builtin_amdgcn_cvt_pk_f32_fp8((int)v[k], false), hi2 = __builtin_amdgcn_cvt_pk_f32_fp8((int)v[k], true);
        out[2 * k] = __builtin_elementwise_fma(w2, lo, out[2 * k]); out[2 * k + 1] = __builtin_elementwise_fma(w2, hi2, out[2 * k + 1]); }
}
__device__ __forceinline__ int p7_doti(const u32x4 u, const u32x4 h) {
    int s = __builtin_amdgcn_sdot4((int)u[0], (int)h[0], 0, false); s = __builtin_amdgcn_sdot4((int)u[1], (int)h[1], s, false); s = __builtin_amdgcn_sdot4((int)u[2], (int)h[2], s, false); return __builtin_amdgcn_sdot4((int)u[3], (int)h[3], s, false);
}
#define DPPI(v, ctrl) __builtin_amdgcn_update_dpp(0, (v), (ctrl), 0xf, 0xf, true)
__device__ __forceinline__ int reduce8i(int p0, int p1, int p2, int p3, int p4, int p5, int p6, int p7, int lane) {
    auto s01 = __builtin_amdgcn_permlane32_swap((unsigned)p0, (unsigned)p1, false, false); auto s23 = __builtin_amdgcn_permlane32_swap((unsigned)p2, (unsigned)p3, false, false);
    auto s45 = __builtin_amdgcn_permlane32_swap((unsigned)p4, (unsigned)p5, false, false); auto s67 = __builtin_amdgcn_permlane32_swap((unsigned)p6, (unsigned)p7, false, false);
    const unsigned q0 = s01[0] + s01[1], q1 = s23[0] + s23[1], q2 = s45[0] + s45[1], q3 = s67[0] + s67[1];
    auto t0 = __builtin_amdgcn_permlane16_swap(q0, q1, false, false); auto t1 = __builtin_amdgcn_permlane16_swap(q2, q3, false, false);
    int r0 = (int)(t0[0] + t0[1]), r1 = (int)(t1[0] + t1[1]);
    r0 += DPPI(r0, 0x128); r1 += DPPI(r1, 0x128);
    int z = (lane & 8) ? r1 : r0;
    z += DPPI(z, 0x141); z += DPPI(z, 0xB1); z += DPPI(z, 0x4E);
    return z;
}

struct P7CArgs { const signed char* H8; const unsigned* EG; const unsigned char* U8; int* PART; int nrows; };
__device__ __forceinline__ void phase_p7c(LAS unsigned char* lds, const P7CArgs& a, int part, int prank, int nvb) {
    int tid_ = threadIdx.x; asm volatile("" : "+v"(tid_));
    const int lane = tid_ & 63, wid = __builtin_amdgcn_readfirstlane(tid_ >> 6);
    const int nw = (nvb >> 3) * 8, wrank = prank * 8 + wid;
    LAS unsigned* tab = (LAS unsigned*)(lds + wid * 1024);
    const int grp = lane >> 3, c = lane & 7, c16 = c * 16;
    const unsigned char* ubase = a.U8 + 128 * part + c16;
    const signed char* hbase = a.H8 + 128 * part + c16;
    unsigned* pbase = (unsigned*)a.PART + (size_t)part * a.nrows * 64;
    const int c2 = (c >> 2) & 1, c1 = (c >> 1) & 1, c0 = c & 1;
    const int ent0 = 8 * (4 * c2 + 2 * c0 + c1) + grp;
    u32x4 Av[16], Bv[16]; u32x4 Ah, Bh;
    unsigned pw0 = 0u, pw1 = 0u;
#define P7C_PREF(t) do { pw0 = a.EG[(size_t)(t) * 128 + lane]; pw1 = a.EG[(size_t)(t) * 128 + 64 + lane]; } while (0)
#define P7C_ISSUE(X, Xh, t, slot, tnext) do { LAS unsigned* tb_ = tab + (slot) * 128; \
        tb_[lane] = pw0; tb_[64 + lane] = pw1; \
        asm volatile("s_waitcnt lgkmcnt(0)" ::: "memory"); \
        _Pragma("unroll") for (int i_ = 0; i_ < 16; ++i_) { const unsigned e_ = tb_[8 * i_ + grp]; X[i_] = *(const u32x4*)(ubase + (size_t)(e_ >> 16) * 1024); } \
        Xh = *(const u32x4*)(hbase + (size_t)(t) * 1024); \
        P7C_PREF(tnext); } while (0)
#define P7C_X(v, ctrl) ((v) + DPPI((v), (ctrl)))
#define P7C_COMPUTE(X, Xh, t, valid) do { int d_[16]; \
        _Pragma("unroll") for (int i_ = 0; i_ < 16; ++i_) d_[i_] = p7_doti(X[i_], Xh); \
        int e8_[8]; _Pragma("unroll") for (int k = 0; k < 8; ++k) { const int send_ = c2 ? d_[k] : d_[k + 8], keep_ = c2 ? d_[k + 8] : d_[k]; e8_[k] = keep_ + DPPI(send_, 0x141); }            \
        int e4_[4]; _Pragma("unroll") for (int k = 0; k < 4; ++k) { const int send_ = c0 ? e8_[k] : e8_[k + 4], keep_ = c0 ? e8_[k + 4] : e8_[k]; e4_[k] = keep_ + DPPI(send_, 0xB1); }          \
        int e2_[2]; _Pragma("unroll") for (int k = 0; k < 2; ++k) { const int send_ = c1 ? e4_[k] : e4_[k + 2], keep_ = c1 ? e4_[k + 2] : e4_[k]; e2_[k] = keep_ + DPPI(send_, 0x4E); }          \
        if (valid) pbase[(size_t)(t) * 64 + ent0] = __builtin_bit_cast(unsigned, __builtin_amdgcn_cvt_pk_i16((e2_[0] + 8) >> 4, (e2_[1] + 8) >> 4)); } while (0)
    const int lastrow = a.nrows - 1;
    int t = wrank;
    P7C_PREF(t);
    P7C_ISSUE(Av, Ah, t, 0, (t + nw < a.nrows ? t + nw : lastrow));
    while (t < a.nrows) {
        const int t1 = t + nw, t2 = t1 + nw, t3 = t2 + nw;
        const int k1 = t1 < a.nrows ? t1 : lastrow, k2 = t2 < a.nrows ? t2 : lastrow, k3 = t3 < a.nrows ? t3 : lastrow;
        P7C_ISSUE(Bv, Bh, k1, 1, k2);
        P7C_COMPUTE(Av, Ah, t, true);
        P7C_ISSUE(Av, Ah, k2, 0, k3);
        P7C_COMPUTE(Bv, Bh, k1, (t1 < a.nrows));
        t = t2;
    }
#undef P7C_PREF
#undef P7C_ISSUE
#undef P7C_COMPUTE
}
__device__ __forceinline__ void phase_p7d(const int* __restrict__ PART, const unsigned* __restrict__ EG, const float* __restrict__ US, const float* __restrict__ VS, const float* __restrict__ HS, unsigned* __restrict__ WE, int nrows, int vb, int nvb) {
    int tid_ = threadIdx.x; asm volatile("" : "+v"(tid_));
    typedef int i32x4 __attribute__((ext_vector_type(4)));
    const size_t n16 = (size_t)nrows * 16, pstride4 = n16;
    const u32x4* P4 = (const u32x4*)PART; const u32x4* EG4 = (const u32x4*)EG; u32x4* WE4 = (u32x4*)WE;
    for (size_t j = (size_t)vb * 512 + tid_; j < n16; j += (size_t)nvb * 512) {
        const size_t row = j >> 4; const int P = (int)(j >> 1) & 7, gq = (int)j & 1;
        i32x4 slo = {0, 0, 0, 0}, shi = {0, 0, 0, 0};
#pragma unroll
        for (int p = 0; p < 8; ++p) { const u32x4 d = P4[p * pstride4 + j];
#pragma unroll
            for (int k = 0; k < 4; ++k) { slo[k] += (int)(d[k] << 16) >> 16; shi[k] += (int)d[k] >> 16; } }
        const float hs = HS[row] * 16.f;
#pragma unroll
        for (int half = 0; half < 2; ++half) {
            const size_t ei = row * 32 + 4 * P + 2 * half + gq;
            const u32x4 eg = EG4[ei]; u32x4 o;
#pragma unroll
            for (int k = 0; k < 4; ++k) { const int eid = (int)(eg[k] >> 16);
                const float av = (float)(half ? shi[k] : slo[k]) * US[eid] * hs;
                const float wv = __uint_as_float(eg[k] << 16) * gelu_fast(av) * VS[eid];
                o[k] = (eg[k] & 0xffff0000u) | (cvt_pk_bf16(wv, 0.f) & 0xffffu); }
            WE4[ei] = o;
        }
    }
}
struct P7BArgs { const unsigned* WE; const unsigned char* V8; bf16_t* XB; const float* gate2; int nrows; };
template <int PM>
__device__ __forceinline__ void phase_p7b(LAS unsigned char* lds, const P7BArgs& a, int part, int prank, int nvb) {
    int tid_ = threadIdx.x; asm volatile("" : "+v"(tid_));
    const int lane = tid_ & 63, wid = __builtin_amdgcn_readfirstlane(tid_ >> 6);
    const int nw = (nvb >> 3) * 8, wrank = prank * 8 + wid;
    LAS unsigned* tab = (LAS unsigned*)(lds + wid * 1024);
    const int grp = lane >> 3, c16 = (lane & 7) * 16;
    const unsigned char* vbase = a.V8 + 128 * part + c16;
    const int colofs = 128 * part + c16 + 8 * (lane >> 5) + 4 * ((lane >> 4) & 1) + 2 * ((lane >> 3) & 1);
    u32x4 Av[16], Bv[16]; float Aw[16], Bw[16]; unsigned Ax, Bx; f32x2 Ag, Bg;
    unsigned pw0 = 0u, pw1 = 0u;
#define P7B_PREF(t) do { pw0 = a.WE[(size_t)(t) * 128 + lane]; pw1 = a.WE[(size_t)(t) * 128 + 64 + lane]; } while (0)
#define P7B_ISSUE(X, Xw, Xx, Xg, t, slot, tnext) do { LAS unsigned* tb_ = tab + (slot) * 128; \
        tb_[lane] = pw0; tb_[64 + lane] = pw1; \
        asm volatile("s_waitcnt lgkmcnt(0)" ::: "memory"); \
        _Pragma("unroll") for (int i_ = 0; i_ < 16; ++i_) { const unsigned we_ = tb_[8 * i_ + grp]; Xw[i_] = __uint_as_float(we_ << 16); if (PM != 2) X[i_] = *(const u32x4*)(vbase + (size_t)(we_ >> 16) * 1024); else X[i_] = (u32x4){we_, 0x38383838u, 0x38383838u, 0x38383838u}; } \
        { const int mr_ = (t) >= NL ? 32 : (t) / S; \
          Xx = *(const unsigned*)(a.XB + (size_t)(t) * 1024 + colofs); Xg = *(const f32x2*)(a.gate2 + (size_t)mr_ * 6144 + colofs); } \
        P7B_PREF(tnext); } while (0)
#define P7B_COMPUTE(X, Xw, Xx, Xg, t, valid) do { f32x2 acc2[8]; \
        _Pragma("unroll") for (int k = 0; k < 8; ++k) acc2[k] = (f32x2){0.f, 0.f}; \
        if (PM != 1) { _Pragma("unroll") for (int i_ = 0; i_ < 16; ++i_) p7_axpy(X[i_], Xw[i_], acc2); } else { _Pragma("unroll") for (int i_ = 0; i_ < 16; ++i_) acc2[i_ >> 1][i_ & 1] = __uint_as_float((X[i_][0] ^ X[i_][1] ^ X[i_][2] ^ X[i_][3]) & 0x3fffffffu) + Xw[i_]; } \
        float b_[8]; _Pragma("unroll") for (int k = 0; k < 8; ++k) { auto s_ = __builtin_amdgcn_permlane32_swap(__float_as_uint(acc2[k >> 1][k & 1]), __float_as_uint(acc2[(k + 8) >> 1][k & 1]), false, false); b_[k] = __uint_as_float(s_[0]) + __uint_as_float(s_[1]); } \
        float c_[4]; _Pragma("unroll") for (int k = 0; k < 4; ++k) { auto s_ = __builtin_amdgcn_permlane16_swap(__float_as_uint(b_[k]), __float_as_uint(b_[k + 4]), false, false); c_[k] = __uint_as_float(s_[0]) + __uint_as_float(s_[1]); } \
        float d_[2]; _Pragma("unroll") for (int k = 0; k < 2; ++k) { const float send_ = (lane & 8) ? c_[k] : c_[k + 2]; const float keep_ = (lane & 8) ? c_[k + 2] : c_[k]; d_[k] = keep_ + DPPF(send_, 0x128); } \
        unsigned* xp_ = (unsigned*)(a.XB + (size_t)(t) * 1024 + colofs); \
        f32x2 x_ = {__uint_as_float(Xx << 16), __uint_as_float(Xx & 0xffff0000u)}; x_.x += Xg.x * d_[0]; x_.y += Xg.y * d_[1]; if ((valid) && PM == 0) *xp_ = cvt_pk_bf16(x_.x, x_.y); else if (PM != 0 && x_.x == 1.2345e30f) *xp_ = cvt_pk_bf16(x_.x, x_.y); } while (0)
    const int lastrow = a.nrows - 1;
    int t = wrank;
    P7B_PREF(t);
    P7B_ISSUE(Av, Aw, Ax, Ag, t, 0, (t + nw < a.nrows ? t + nw : lastrow));
    while (t < a.nrows) {
        const int t1 = t + nw, t2 = t1 + nw, t3 = t2 + nw;
        const int c1 = t1 < a.nrows ? t1 : lastrow, c2 = t2 < a.nrows ? t2 : lastrow, c3 = t3 < a.nrows ? t3 : lastrow;
        P7B_ISSUE(Bv, Bw, Bx, Bg, c1, 1, c2);
        P7B_COMPUTE(Av, Aw, Ax, Ag, t, true);
        P7B_ISSUE(Av, Aw, Ax, Ag, c2, 0, c3);
        P7B_COMPUTE(Bv, Bw, Bx, Bg, c1, (t1 < a.nrows));
        t = t2;
    }
#undef P7B_PREF
#undef P7B_ISSUE
#undef P7B_COMPUTE
}
__device__ __forceinline__ void phase_final_norm(const bf16_t* __restrict__ XBp, float* __restrict__ OUT, const float* __restrict__ g, int vb, int nvb) {
    int tid_ = threadIdx.x; asm volatile("" : "+v"(tid_));
    const int lane = tid_ & 63, wid = tid_ >> 6;
    for (int row = vb * 8 + wid; row < NL; row += nvb * 8) {
        const bf16_t* xp = XBp + (size_t)row * 1024; f32x4 x[4]; float ss = 0.f;
#pragma unroll
        for (int i = 0; i < 4; ++i) { const u32x2 r = *(const u32x2*)(xp + 256 * i + 4 * lane); x[i] = (f32x4){__uint_as_float(r.x << 16), __uint_as_float(r.x & 0xffff0000u), __uint_as_float(r.y << 16), __uint_as_float(r.y & 0xffff0000u)};
            ss += x[i][0] * x[i][0] + x[i][1] * x[i][1] + x[i][2] * x[i][2] + x[i][3] * x[i][3]; }
        ss = wave_sum(ss); const float rstd = rsqrtf(ss * (1.f / 1024.f) + EPS);
#pragma unroll
        for (int i = 0; i < 4; ++i) *(f32x4*)(OUT + (size_t)row * 1024 + 256 * i + 4 * lane) = x[i] * rstd * *(const f32x4*)(g + 256 * i + 4 * lane);
    }
}

typedef short s16x4 __attribute__((ext_vector_type(4)));
__device__ __forceinline__ s16x4 lds_tr16(const LAS unsigned char* p) { return __builtin_bit_cast(s16x4, __builtin_amdgcn_ds_read_tr16_b64_v4i16((LAS s16x4*)p)); }
constexpr int ATT_BUF = 20480;
template <int DK>
__device__ __forceinline__ void attn_unit(LAS unsigned char* lds, const bf16_t* __restrict__ Q, const bf16_t* __restrict__ K1, const bf16_t* __restrict__ K2, const bf16_t* __restrict__ V,
                                          int nkeys, float c2, bf16_t* __restrict__ out) {
    int tid_ = threadIdx.x; asm volatile("" : "+v"(tid_));
    const int tid = tid_, lane = tid & 63, wid = __builtin_amdgcn_readfirstlane(tid >> 6), r32 = lane & 31, hi = lane >> 5;
    constexpr int NS = DK / 16;
    bf16x8 qf[NS];
    { const bf16_t* qp = Q + (size_t)(wid * 32 + r32) * DK + 8 * hi;
#pragma unroll
      for (int s = 0; s < NS; ++s) qf[s] = *(const bf16x8*)(qp + 16 * s); }
    const int skey = tid >> 3, sch = tid & 7;
    const unsigned st_k1 = skey * 128 + ((sch ^ ((skey >> 1) & 7)) << 4);
    const unsigned st_v = 8192 + skey * 128 + (((sch << 4)) ^ (((skey >> 1) & 1) << 6));
    const int skey2 = (tid & 255) >> 2, sch2 = tid & 3;
    const unsigned st_k2 = 16384 + skey2 * 64 + ((sch2 ^ ((skey2 >> 2) & 3)) << 4);
    const bf16_t* gk1 = K1 + (size_t)skey * 64 + sch * 8; const bf16_t* gv = V + (size_t)skey * 64 + sch * 8;
    const bf16_t* gk2 = (DK == 96) ? K2 + (size_t)skey2 * 32 + sch2 * 8 : nullptr;
    unsigned ka[2][4];
#pragma unroll
    for (int kt = 0; kt < 2; ++kt)
#pragma unroll
        for (int s = 0; s < 4; ++s) { const int key = 32 * kt + r32; ka[kt][s] = key * 128 + (((2 * s + hi) ^ ((key >> 1) & 7)) << 4); }
    unsigned kb[2][2];
#pragma unroll
    for (int kt = 0; kt < 2; ++kt)
#pragma unroll
        for (int s = 0; s < 2; ++s) { const int key = 32 * kt + r32; kb[kt][s] = 16384 + key * 64 + (((2 * s + hi) ^ ((key >> 2) & 3)) << 4); }
    const int vq = (lane & 15) >> 2, vp = lane & 3, vg = (lane >> 4) & 1;
    unsigned va[2];
#pragma unroll
    for (int dvb = 0; dvb < 2; ++dvb) { const int key = 4 * hi + vq; va[dvb] = 8192 + key * 128 + ((((32 * dvb + 16 * vg + 4 * vp) * 2)) ^ (((key >> 1) & 1) << 6)); }
    float m = 0.f, l = 0.f;
    f32x16 o0 = {}, o1 = {}, negm = {};
    const int NT = nkeys >> 6;
    u32x4 sk1, sv, sk2;
    sk1 = *(const u32x4*)gk1; sv = *(const u32x4*)gv; if (DK == 96) { if (tid < 256) sk2 = *(const u32x4*)gk2; }
    *(LAS u32x4*)(lds + st_k1) = sk1; *(LAS u32x4*)(lds + st_v) = sv; if (DK == 96) { if (tid < 256) *(LAS u32x4*)(lds + st_k2) = sk2; }
    __syncthreads();
    for (int t = 0; t < NT; ++t) {
        LAS unsigned char* buf = lds + (t & 1) * ATT_BUF;
        if (t + 1 < NT) { sk1 = *(const u32x4*)(gk1 + (size_t)(t + 1) * 64 * 64); sv = *(const u32x4*)(gv + (size_t)(t + 1) * 64 * 64); if (DK == 96) { if (tid < 256) sk2 = *(const u32x4*)(gk2 + (size_t)(t + 1) * 64 * 32); } }
        bf16x8 kf0[NS], kf1[NS];
#pragma unroll
        for (int s = 0; s < 4; ++s) { kf0[s] = *(const LAS bf16x8*)(buf + ka[0][s]); kf1[s] = *(const LAS bf16x8*)(buf + ka[1][s]); }
        if (DK == 96) {
#pragma unroll
            for (int s = 0; s < 2; ++s) { kf0[4 + s] = *(const LAS bf16x8*)(buf + kb[0][s]); kf1[4 + s] = *(const LAS bf16x8*)(buf + kb[1][s]); }
        }
        __builtin_amdgcn_sched_barrier(0);
        f32x16 p0 = mfma32(kf0[0], qf[0], negm), p1 = mfma32(kf1[0], qf[0], negm);
#pragma unroll
        for (int s = 1; s < NS; ++s) { p0 = mfma32(kf0[s], qf[s], p0); p1 = mfma32(kf1[s], qf[s], p1); }
        __builtin_amdgcn_sched_barrier(0);
        s16x4 vlo[2][2][2], vhi[2][2][2];
#pragma unroll
        for (int kt = 0; kt < 2; ++kt)
#pragma unroll
            for (int sp = 0; sp < 2; ++sp) { const int kofs = (32 * kt + 16 * sp) * 128;
#pragma unroll
                for (int dvb = 0; dvb < 2; ++dvb) { vlo[dvb][kt][sp] = lds_tr16(buf + va[dvb] + kofs); vhi[dvb][kt][sp] = lds_tr16(buf + va[dvb] + kofs + 8 * 128); } }
        __builtin_amdgcn_sched_barrier(0);
        float mx = p0[0];
#pragma unroll
        for (int r = 1; r < 16; ++r) mx = fmaxf(mx, p0[r]);
#pragma unroll
        for (int r = 0; r < 16; ++r) mx = fmaxf(mx, p1[r]);
        { auto rr = __builtin_amdgcn_permlane32_swap(__float_as_uint(mx), __float_as_uint(mx), false, false); mx = fmaxf(__uint_as_float(rr[0]), __uint_as_float(rr[1])); }
        if (t == 0 || __any(mx > 8.f)) {
            const float dn = (t == 0) ? mx : fmaxf(mx, 0.f), al = (t == 0) ? 1.f : __builtin_amdgcn_exp2f(-dn); m += dn; l *= al;
#pragma unroll
            for (int r = 0; r < 16; ++r) { o0[r] *= al; o1[r] *= al; p0[r] -= dn; p1[r] -= dn; negm[r] = -m; }
            asm volatile("" : "+v"(negm));
        }
        f32x2 ls2 = {0.f, 0.f};
#pragma unroll
        for (int r = 0; r < 16; ++r) { p0[r] = __builtin_amdgcn_exp2f(p0[r]); p1[r] = __builtin_amdgcn_exp2f(p1[r]); }
#pragma unroll
        for (int r = 0; r < 16; r += 2) { ls2 += (f32x2){p0[r], p0[r + 1]}; ls2 += (f32x2){p1[r], p1[r + 1]}; }
        const float ls = ls2.x + ls2.y;
        l += ls;
        bf16x8 pf[2][2];
#pragma unroll
        for (int sp = 0; sp < 2; ++sp) { u32x4 a, b;
            a.x = cvt_pk_bf16(p0[8 * sp], p0[8 * sp + 1]); a.y = cvt_pk_bf16(p0[8 * sp + 2], p0[8 * sp + 3]); a.z = cvt_pk_bf16(p0[8 * sp + 4], p0[8 * sp + 5]); a.w = cvt_pk_bf16(p0[8 * sp + 6], p0[8 * sp + 7]);
            b.x = cvt_pk_bf16(p1[8 * sp], p1[8 * sp + 1]); b.y = cvt_pk_bf16(p1[8 * sp + 2], p1[8 * sp + 3]); b.z = cvt_pk_bf16(p1[8 * sp + 4], p1[8 * sp + 5]); b.w = cvt_pk_bf16(p1[8 * sp + 6], p1[8 * sp + 7]);
            pf[0][sp] = __builtin_bit_cast(bf16x8, a); pf[1][sp] = __builtin_bit_cast(bf16x8, b); }
        __builtin_amdgcn_sched_barrier(0);
#pragma unroll
        for (int kt = 0; kt < 2; ++kt)
#pragma unroll
            for (int sp = 0; sp < 2; ++sp) {
                { const s16x4 lo = vlo[0][kt][sp], hi4 = vhi[0][kt][sp]; const bf16x8 vf = (bf16x8){lo[0], lo[1], lo[2], lo[3], hi4[0], hi4[1], hi4[2], hi4[3]}; o0 = mfma32(vf, pf[kt][sp], o0); }
                { const s16x4 lo = vlo[1][kt][sp], hi4 = vhi[1][kt][sp]; const bf16x8 vf = (bf16x8){lo[0], lo[1], lo[2], lo[3], hi4[0], hi4[1], hi4[2], hi4[3]}; o1 = mfma32(vf, pf[kt][sp], o1); } }
        __builtin_amdgcn_sched_barrier(0);
        if (t + 1 < NT) { LAS unsigned char* nb = lds + ((t + 1) & 1) * ATT_BUF; *(LAS u32x4*)(nb + st_k1) = sk1; *(LAS u32x4*)(nb + st_v) = sv; if (DK == 96) { if (tid < 256) *(LAS u32x4*)(nb + st_k2) = sk2; } }
        __syncthreads();
    }
    { auto rr = __builtin_amdgcn_permlane32_swap(__float_as_uint(l), __float_as_uint(l), false, false); l = __uint_as_float(rr[0]) + __uint_as_float(rr[1]); }
    const float il = 1.f / l;
    bf16_t* op = out + (size_t)(wid * 32 + r32) * 1024 + 4 * hi;
#pragma unroll
    for (int g = 0; g < 4; ++g) { u32x2 a, b;
        a.x = cvt_pk_bf16(o0[4 * g] * il, o0[4 * g + 1] * il); a.y = cvt_pk_bf16(o0[4 * g + 2] * il, o0[4 * g + 3] * il);
        b.x = cvt_pk_bf16(o1[4 * g] * il, o1[4 * g + 1] * il); b.y = cvt_pk_bf16(o1[4 * g + 2] * il, o1[4 * g + 3] * il);
        *(u32x2*)(op + 8 * g) = a; *(u32x2*)(op + 32 + 8 * g) = b; }
}
__device__ __forceinline__ void phase_p3(LAS unsigned char* lds, const WS& w, int l, int vb, int nvb) {
    const float c2g = 0.125f * 1.4426950408889634f, c2m = 0.10206207261596577f * 1.4426950408889634f;
    bf16_t* MIX = w.H();
    const int nlat = NB * 12 * 8, nctx = (l == 0) ? NB * 12 : 0;
    for (int u = vb; u < nlat + nctx; u += nvb) {
        if (u < nlat) {
            const int qb = u & 7, slot = (u >> 3) % 12, b = u / 96;
            bf16_t* out = MIX + ((size_t)b * S + qb * 256) * 1024;
            if (slot < 6) attn_unit<64>(lds, w.Qg() + (((size_t)b * 6 + slot) * S + qb * 256) * 64, w.Kg() + ((size_t)b * 2 + slot / 3) * KEYS * 64, nullptr, w.Vg() + ((size_t)b * 2 + slot / 3) * KEYS * 64, KEYS, c2g, out + slot * 64);
            else { const int h = slot - 6; attn_unit<96>(lds, w.Qm() + (((size_t)b * 6 + h) * S + qb * 256) * 96, w.Kmn() + ((size_t)b * 6 + h) * KEYS * 64, w.KR() + (size_t)b * KEYS * 32, w.Vm() + ((size_t)b * 6 + h) * KEYS * 64, KEYS, c2m, out + 640 + h * 64); }
        } else {
            const int v = u - nlat, slot = v % 12, b = v / 12;
            bf16_t* out = MIX + ((size_t)NL + (size_t)b * CTX) * 1024;
            if (slot < 6) attn_unit<64>(lds, w.Qgc() + ((size_t)b * 6 + slot) * CTX * 64, w.Kg() + ((size_t)b * 2 + slot / 3) * KEYS * 64, nullptr, w.Vg() + ((size_t)b * 2 + slot / 3) * KEYS * 64, CTX, c2g, out + slot * 64);
            else { const int h = slot - 6; attn_unit<96>(lds, w.Qmc() + ((size_t)b * 6 + h) * CTX * 96, w.Kmn() + ((size_t)b * 6 + h) * KEYS * 64, w.KR() + (size_t)b * KEYS * 32, w.Vm() + ((size_t)b * 6 + h) * KEYS * 64, CTX, c2m, out + 640 + h * 64); }
        }
    }
}

__device__ __forceinline__ unsigned fkey(float f, unsigned tag, unsigned mask) { return (__float_as_uint(f) & ~mask) | tag; }
__device__ __forceinline__ float keyf(unsigned k, unsigned mask) { return __uint_as_float(k & ~mask); }
__device__ __forceinline__ unsigned fmax_u(unsigned a, unsigned b) { unsigned r; asm("v_max_f32 %0, %1, %2" : "=v"(r) : "v"(a), "v"(b)); return r; }
__device__ __forceinline__ unsigned fmin_u(unsigned a, unsigned b) { unsigned r; asm("v_min_f32 %0, %1, %2" : "=v"(r) : "v"(a), "v"(b)); return r; }
__device__ __forceinline__ void ce_desc(unsigned& a, unsigned& b) { const unsigned hi_ = fmax_u(a, b), lo_ = fmin_u(a, b); a = hi_; b = lo_; }
template <int J> __device__ __forceinline__ void bstage16(unsigned* a) {
#pragma unroll
    for (int i = 0; i < 16; ++i) { const int l = i ^ J; if (l > i) ce_desc(a[i], a[l]); }
}
__device__ __forceinline__ void sort16_desc(unsigned* a) {
#define CE_(i, j) ce_desc(a[i], a[j]);
    CE_(0, 13) CE_(1, 12) CE_(2, 15) CE_(3, 14) CE_(4, 8) CE_(5, 6) CE_(7, 11) CE_(9, 10)
    CE_(0, 5) CE_(1, 7) CE_(2, 9) CE_(3, 4) CE_(6, 13) CE_(8, 14) CE_(10, 15) CE_(11, 12)
    CE_(0, 1) CE_(2, 3) CE_(4, 5) CE_(6, 8) CE_(7, 9) CE_(10, 11) CE_(12, 13) CE_(14, 15)
    CE_(0, 2) CE_(1, 3) CE_(4, 10) CE_(5, 11) CE_(6, 7) CE_(8, 9) CE_(12, 14) CE_(13, 15)
    CE_(1, 2) CE_(3, 12) CE_(4, 6) CE_(5, 7) CE_(8, 10) CE_(9, 11) CE_(13, 14)
    CE_(1, 4) CE_(2, 6) CE_(5, 8) CE_(7, 10) CE_(9, 13) CE_(11, 14)
    CE_(2, 4) CE_(3, 6) CE_(9, 12) CE_(11, 13)
    CE_(3, 5) CE_(6, 8) CE_(7, 9) CE_(10, 12)
    CE_(3, 4) CE_(5, 6) CE_(7, 8) CE_(9, 10) CE_(11, 12)
    CE_(6, 7) CE_(8, 9)
#undef CE_
}
__device__ __forceinline__ void bmerge16_desc(unsigned* c) { bstage16<8>(c); bstage16<4>(c); bstage16<2>(c); bstage16<1>(c); }
__device__ __forceinline__ void merge_top16(unsigned* a, const unsigned* b) {
#pragma unroll
    for (int i = 0; i < 16; ++i) a[i] = fmax_u(a[i], b[15 - i]);
    bmerge16_desc(a);
}
__device__ __forceinline__ void xlane_top16(unsigned* t, int hi) {
    unsigned r[16]; const unsigned msk = 0u - (unsigned)hi;
#pragma unroll
    for (int i = 0; i < 16; ++i) r[i] = t[i] ^ ((t[i] ^ t[15 - i]) & msk);
#pragma unroll
    for (int i = 0; i < 16; ++i) { auto s = __builtin_amdgcn_permlane32_swap(r[i], r[i], false, false); t[i] = fmax_u(s[0], s[1]); }
    bmerge16_desc(t);
}
__device__ __forceinline__ constexpr int cand_a(int c) { return c < 16 ? 0 : c < 24 ? 1 : c < 32 ? 39 - c : c < 37 ? 2 : c < 41 ? 3 : c < 44 ? 4 : c < 46 ? 5 : c < 48 ? 6 : 7; }
__device__ __forceinline__ constexpr int cand_b(int c) { return c < 16 ? c : c < 24 ? c - 16 : c < 32 ? 0 : c < 37 ? c - 32 : c < 41 ? c - 37 : c < 44 ? c - 41 : c < 46 ? c - 44 : c < 48 ? c - 46 : c - 48; }

__device__ __forceinline__ void phase_p6b(LAS unsigned char* lds, const bf16_t* __restrict__ PQ, const bf16_t* __restrict__ SubKl, unsigned* __restrict__ EG, int nrows, int vb, int nvb) {
    int tid_ = threadIdx.x; asm volatile("" : "+v"(tid_));
    const int tid = tid_, lane = tid & 63, wid = __builtin_amdgcn_readfirstlane(tid >> 6), r32 = lane & 31, hi = lane >> 5;
    const int h = vb & 7, wrank = (vb >> 3) * 8 + wid, nwr = (nvb >> 3) * 8;
    LAS unsigned short* tab = (LAS unsigned short*)(lds + 65536 + wid * 4096) + r32 * 64;
#pragma unroll
    for (int i = 0; i < 8; ++i) { const int idx = i * 512 + tid, p = idx >> 11, key = (idx >> 4) & 127, ch = idx & 15;
        *(LAS u32x4*)(lds + p * 32768 + key * 256 + ((ch ^ (key & 15)) << 4)) = *(const u32x4*)(SubKl + ((size_t)(h * 2 + p) * 128 + key) * 128 + ch * 8); }
    __syncthreads();
    const int ngroups = nrows >> 5;
    for (int tg = wrank; tg < ngroups; tg += nwr) {
        const int row0 = tg << 5;
        bf16x8 qf[2][8];
        { const bf16_t* qp = PQ + (size_t)(row0 + r32) * 2048 + h * 256 + 8 * hi; asm volatile("" : "+v"(qp));
#pragma unroll
          for (int p = 0; p < 2; ++p)
#pragma unroll
              for (int s = 0; s < 8; ++s) qf[p][s] = *(const bf16x8*)(qp + p * 128 + 16 * s); }
        unsigned top[2][16];
#pragma unroll
        for (int p = 0; p < 2; ++p) {
            f32x16 acc[4];
#pragma unroll
            for (int kt = 0; kt < 4; ++kt) { acc[kt] = f32x16{}; const int key = 32 * kt + r32;
#pragma unroll
                for (int s = 0; s < 8; ++s) acc[kt] = mfma32(*(const LAS bf16x8*)(lds + p * 32768 + key * 256 + (((2 * s + hi) ^ (key & 15)) << 4)), qf[p][s], acc[kt]); }
            unsigned key[64];
#pragma unroll
            for (int kt = 0; kt < 4; ++kt)
#pragma unroll
                for (int r = 0; r < 16; ++r) { const int n = 32 * kt + (r & 3) + 8 * (r >> 2) + 4 * hi; key[16 * kt + r] = fkey(acc[kt][r], 127u - (unsigned)n, 127u); }
            sort16_desc(key); sort16_desc(key + 16); sort16_desc(key + 32); sort16_desc(key + 48);
            merge_top16(key, key + 16); merge_top16(key + 32, key + 48); merge_top16(key, key + 32);
            xlane_top16(key, hi);
#pragma unroll
            for (int i = 0; i < 16; ++i) top[p][i] = key[i];
        }
        float t0f[16], t1f[16];
#pragma unroll
        for (int i = 0; i < 16; ++i) { t0f[i] = keyf(top[0][i], 127u); t1f[i] = keyf(top[1][i], 127u); }
        unsigned ck[50];
#pragma unroll
        for (int c = 0; c < 50; ++c) ck[c] = fkey(t0f[cand_a(c)] + t1f[cand_b(c)], (unsigned)c, 63u);
        if (hi == 0) {
#pragma unroll
            for (int c = 0; c < 50; c += 2) {
                const unsigned ea = (127u - (top[0][cand_a(c)] & 127u)) * 128u + (127u - (top[1][cand_b(c)] & 127u));
                const unsigned eb = (127u - (top[0][cand_a(c + 1)] & 127u)) * 128u + (127u - (top[1][cand_b(c + 1)] & 127u));
                *(LAS unsigned*)(tab + c) = ea | (eb << 16);
            }
        }
        bmerge16_desc(ck + 16); sort16_desc(ck + 32);
        merge_top16(ck, ck + 16); merge_top16(ck, ck + 32);
        ck[15] = fmax_u(ck[15], ck[48]); ck[14] = fmax_u(ck[14], ck[49]); bmerge16_desc(ck);
        asm volatile("s_waitcnt lgkmcnt(0)" ::: "memory");
        const float mx = keyf(ck[0], 63u); float e[16], den = 0.f;
#pragma unroll
        for (int j = 0; j < 16; ++j) { e[j] = __builtin_amdgcn_exp2f((keyf(ck[j], 63u) - mx) * 1.4426950408889634f); den += e[j]; }
        const float iden = 1.f / den;
        if (hi == 0) {
            unsigned o[16];
#pragma unroll
            for (int j = 0; j < 16; ++j) { const unsigned eid = tab[ck[j] & 63u]; o[j] = (eid << 16) | (cvt_pk_bf16(e[j] * iden, 0.f) & 0xffffu); }
            unsigned* dst = EG + (size_t)(row0 + r32) * 128 + h * 16;
#pragma unroll
            for (int j = 0; j < 16; j += 4) *(u32x4*)(dst + j) = (u32x4){o[j], o[j + 1], o[j + 2], o[j + 3]};
        }
        asm volatile("s_waitcnt lgkmcnt(0)" ::: "memory");
    }
}


#define XB_TMO      128
#define XB_XCNT(j)  (256  + 64 * (j))
#define XB_XSUB(j)  (1280 + 64 * (j))
#define XB_XGEN(j)  (2304 + 64 * (j))
#define XB_TOP      3328
#define XB_TOPGEN   3392
#define XCD_BAR_WORDS 3456
#define XB_SPIN_CAP (1u << 18)

__device__ __forceinline__ unsigned xb_ld(unsigned* p)              { return __hip_atomic_load(p, __ATOMIC_RELAXED, __HIP_MEMORY_SCOPE_AGENT); }
__device__ __forceinline__ unsigned xb_add(unsigned* p, unsigned v) { return __hip_atomic_fetch_add(p, v, __ATOMIC_RELAXED, __HIP_MEMORY_SCOPE_AGENT); }
__device__ __forceinline__ unsigned xb_xcc_id() { return (unsigned)__builtin_amdgcn_s_getreg((3 << 11) | 20) & 0xFu; }
#define XB_SPIN(cond, bar) do { unsigned _sp = 0; while (cond) { __builtin_amdgcn_s_sleep(1); \
    if ((++_sp & 255u) == 0u) { if (xb_ld(&(bar)[XB_TMO])) break; if (_sp > XB_SPIN_CAP) { atomicAdd(&(bar)[XB_TMO], 1u); break; } } } } while (0)

struct XcdBarrier {
    unsigned* bar; unsigned x;
    volatile LAS unsigned* st;
};

__device__ __forceinline__ XcdBarrier xcd_barrier_post(unsigned* bar, volatile LAS unsigned* st) {
    XcdBarrier b; b.bar = bar; b.x = xb_xcc_id(); b.st = st;
    if (threadIdx.x == 0) (void)xb_add(&bar[XB_XCNT(b.x)], 1u);
    return b;
}
__device__ __forceinline__ void xcd_barrier_complete(unsigned* bar, unsigned x, unsigned& nloc, unsigned& nx) {
    const unsigned G = gridDim.x * gridDim.y * gridDim.z;
    unsigned sum, cnt, mine, sp = 0u;
    for (;;) {
        sum = 0u; cnt = 0u; mine = 0u;
#pragma unroll
        for (unsigned j = 0; j < 16; ++j) { const unsigned c = xb_ld(&bar[XB_XCNT(j)]); sum += c; cnt += (c > 0u) ? 1u : 0u; mine = (j == x) ? c : mine; }
        if (sum == G) break;
        __builtin_amdgcn_s_sleep(1);
        if ((++sp & 255u) == 0u) { if (xb_ld(&bar[XB_TMO])) break; if (sp > XB_SPIN_CAP) { atomicAdd(&bar[XB_TMO], 1u); break; } }
    }
    nloc = mine > 0u ? mine : 1u; nx = cnt > 0u ? cnt : 1u;
}

__device__ __forceinline__ void xcd_barrier(const XcdBarrier& b) {
    asm volatile("s_waitcnt vmcnt(0)" ::: "memory");
    __syncthreads();
    if (threadIdx.x == 0) {
        unsigned* bar = b.bar;
        __builtin_amdgcn_s_waitcnt(0);
        unsigned nloc = b.st[0], nx = b.st[1];
        if (nloc == 0u) { xcd_barrier_complete(bar, b.x, nloc, nx); b.st[0] = nloc; b.st[1] = nx; }
        const unsigned old = xb_add(&bar[XB_XSUB(b.x)], 1u);
        const unsigned gen = old / nloc;
        if (old + 1u == (gen + 1u) * nloc) {
            __builtin_amdgcn_fence(__ATOMIC_RELEASE, "agent");
            asm volatile("s_waitcnt vmcnt(0)" ::: "memory");
            const unsigned og = xb_add(&bar[XB_TOP], 1u);
            const unsigned tg = og / nx;
            if (og + 1u == (tg + 1u) * nx) xb_add(&bar[XB_TOPGEN], 1u);
            else XB_SPIN(xb_ld(&bar[XB_TOPGEN]) == tg, bar);
            __builtin_amdgcn_fence(__ATOMIC_ACQUIRE, "agent");
            xb_add(&bar[XB_XGEN(b.x)], 1u);
            asm volatile("s_waitcnt vmcnt(0)" ::: "memory");
        } else {
            XB_SPIN(xb_ld(&bar[XB_XGEN(b.x)]) == gen, bar);
            __builtin_amdgcn_fence(__ATOMIC_ACQUIRE, "agent");
            asm volatile("s_waitcnt vmcnt(0)" ::: "memory");
        }
    }
    __syncthreads();
}

__device__ __forceinline__ void phase_mod(LAS unsigned char* lds, const Inputs& in, const WS& w, int vb) {
    if (vb >= 72) return;
    LAS float* sc = (LAS float*)lds;
    int tid_ = threadIdx.x; asm volatile("" : "+v"(tid_));
    const int tid = tid_, idx = vb * 512 + tid, rg = idx / 12288, ln = idx % 12288, l = ln / 6144, n = ln % 6144;
    float acc[11];
#pragma unroll
    for (int i = 0; i < 11; ++i) acc[i] = 0.f;
    const float* wp = in.ada_w + (size_t)l * 1024 * 6144 + n;
    for (int kc = 0; kc < 4; ++kc) {
        for (int i = tid; i < 33 * 256; i += 512) { const int r = i >> 8, k = kc * 256 + (i & 255); const float v = r < 32 ? in.c[(size_t)r * 1024 + k] : in.c_ctx[k]; sc[i] = v / (1.f + __expf(-v)); }
        __syncthreads();
        for (int k = 0; k < 256; ++k) { const float wv = wp[(size_t)(kc * 256 + k) * 6144];
#pragma unroll
            for (int i = 0; i < 11; ++i) acc[i] += sc[(rg * 11 + i) * 256 + k] * wv; }
        __syncthreads();
    }
    const float bias = in.ada_b[(size_t)l * 6144 + n];
#pragma unroll
    for (int i = 0; i < 11; ++i) w.MOD()[((size_t)l * 33 + rg * 11 + i) * 6144 + n] = acc[i] + bias;
}
__device__ __forceinline__ void phase_rope(const WS& w, int vb, int nvb) {
    int tid_ = threadIdx.x; asm volatile("" : "+v"(tid_));
    for (int i = vb * 512 + tid_; i < 2048 * 32; i += nvb * 512) {
        { const int t = i / 32, j = i % 32; const double inv = pow(10000.0, -(double)(j % 16) / 16.0); const double a = (double)(j < 16 ? t / 64 : t % 64) * inv; w.ROPA()[i] = make_float2((float)cos(a), (float)sin(a)); }
        if (i < 2048 * 16) { const int t = i / 16, j = i % 16; const double inv = pow(10000.0, -(double)(j % 8) / 8.0); const double a = (double)(j < 8 ? t / 64 : t % 64) * inv; w.ROPC()[i] = make_float2((float)cos(a), (float)sin(a)); }
    }
}

#ifndef PROBE_MASK
#define PROBE_MASK 0
#endif
struct MegaArgs { Inputs in; WS w; float* XL; unsigned* bar; };
constexpr int MEGA_LDS = 131072 + 16;
__global__ void __launch_bounds__(512, 2) k_mega(MegaArgs A) {
    LAS unsigned char* lds = (LAS unsigned char*)dyn_lds;
    const int vb = blockIdx.x, nvb = gridDim.x;
    volatile LAS unsigned* xbw = (volatile LAS unsigned*)(lds + 131072);
    if (threadIdx.x == 0) { xbw[0] = 0u; xbw[1] = 0u; xbw[2] = 0u; xbw[3] = 0u; }
    __syncthreads();
    XcdBarrier bar = xcd_barrier_post(A.bar, xbw);
    if (threadIdx.x == 0) xbw[2] = xb_add(&A.bar[3584 + 64 * bar.x], 1u);
    __syncthreads();
    const int xticket = __builtin_amdgcn_readfirstlane((int)xbw[2]);
    const WS& w = A.w; const Inputs& in = A.in;
    phase_mod(lds, in, w, vb);
    phase_rope(w, vb, nvb);
    phase_cvt(lds, in, w, vb, nvb);
    xcd_barrier(bar);
    phase_modulate<false>(in.x, in.ctx, nullptr, w.H(), in.norm1_g, w.MOD(), 0, NR, vb, nvb);
    xcd_barrier(bar);
#if (PROBE_MASK >> 0) & 1
    phase_mod(lds, in, w, vb);
    phase_rope(w, vb, nvb);
    phase_cvt(lds, in, w, vb, nvb);
    xcd_barrier(bar);
    phase_modulate<false>(in.x, in.ctx, nullptr, w.H(), in.norm1_g, w.MOD(), 0, NR, vb, nvb);
    xcd_barrier(bar);
#endif
    int xpart = vb & 7, xrank = vb >> 3;
    { bool okx = (bar.x < 8u); for (unsigned j = 0; j < 8; ++j) okx = okx && (xb_ld(&A.bar[XB_XCNT(j)]) == (unsigned)(nvb >> 3));
      if (okx) { xpart = (int)bar.x; xrank = xticket; } }
    for (int l = 0; l < DEPTH; ++l) {
        const float* MODl = w.MOD() + (size_t)l * 33 * 6144;
        const bool last = (l == DEPTH - 1);
        const int MR = last ? NL : NR;
        phase_p1(lds, w, in, l, vb, nvb); xcd_barrier(bar);
#if (PROBE_MASK >> 1) & 1
        phase_p1(lds, w, in, l, vb, nvb); xcd_barrier(bar);
#endif
        phase_p2(lds, w, in, l, vb, nvb); xcd_barrier(bar);
#if (PROBE_MASK >> 12) & 7
        phase_p2(lds, w, in, l, vb, nvb, (PROBE_MASK >> 12) & 7); xcd_barrier(bar);
#endif
        phase_p3(lds, w, l, vb, nvb); xcd_barrier(bar);
#if (PROBE_MASK >> 3) & 1
        phase_p3(lds, w, l, vb, nvb); xcd_barrier(bar);
#endif
        phase_p4(lds, w, in, l, vb, nvb);
        xcd_barrier(bar);
#if (PROBE_MASK >> 4) & 1
        phase_p4(lds, w, in, l, vb, nvb);
        xcd_barrier(bar);
#endif
        if (l == 0) phase_modulate<false>(in.x, in.ctx, nullptr, w.H(), in.norm2_g + l * 1024, MODl, 3, MR, vb, nvb, w.H8(), w.HS(), w.PQ(), w.XB());
        else phase_modulate<true>(nullptr, nullptr, w.XB(), w.H(), in.norm2_g + l * 1024, MODl, 3, MR, vb, nvb, w.H8(), w.HS(), w.PQ(), w.XB());
        xcd_barrier(bar);
#if (PROBE_MASK >> 5) & 1
        phase_modulate<true>(nullptr, nullptr, w.XB(), w.H(), in.norm2_g + l * 1024, MODl, 3, MR, vb, nvb, w.H8(), w.HS()); xcd_barrier(bar);
#endif
        phase_p6a(lds, w, l, vb, nvb); xcd_barrier(bar);
#if (PROBE_MASK >> 6) & 1
        phase_p6a(lds, w, l, vb, nvb); xcd_barrier(bar);
#endif
        phase_p6b(lds, w.PQ(), w.SubK() + (size_t)l * 16 * 128 * 128, w.EG(), MR, vb, nvb); xcd_barrier(bar);
#if (PROBE_MASK >> 7) & 1
        phase_p6b(lds, w.PQ(), w.SubK() + (size_t)l * 16 * 128 * 128, w.EG(), MR, vb, nvb); xcd_barrier(bar);
#endif
        { P7CArgs a{w.H8(), w.EG(), w.U8() + (size_t)l * NE * 1024, (int*)w.PQ(), MR}; phase_p7c(lds, a, xpart, xrank, nvb); }
        xcd_barrier(bar);
#if (PROBE_MASK >> 8) & 1
        { P7CArgs a{w.H8(), w.EG(), w.U8() + (size_t)l * NE * 1024, (int*)w.PQ(), MR}; phase_p7c(lds, a, xpart, xrank, nvb); }
        xcd_barrier(bar);
#endif
        phase_p7d((const int*)w.PQ(), w.EG(), w.US() + (size_t)l * NE, w.VS() + (size_t)l * NE, w.HS(), w.WE(), MR, vb, nvb);
        xcd_barrier(bar);
#if (PROBE_MASK >> 9) & 1
        phase_p7d((const int*)w.PQ(), w.EG(), w.US() + (size_t)l * NE, w.VS() + (size_t)l * NE, w.HS(), w.WE(), MR, vb, nvb);
        xcd_barrier(bar);
#endif
        { P7BArgs a{w.WE(), w.V8() + (size_t)l * NE * 1024, w.XB(), MODl + 5 * 1024, MR}; phase_p7b<0>(lds, a, xpart, xrank, nvb); }
        xcd_barrier(bar);
#if (PROBE_MASK >> 10) & 3
        { P7BArgs a{w.WE(), w.V8() + (size_t)l * NE * 1024, w.XB(), MODl + 5 * 1024, MR}; phase_p7b<((PROBE_MASK >> 10) & 3)>(lds, a, xpart, xrank, nvb); }
        xcd_barrier(bar);
#endif
        if (last) phase_final_norm(w.XB(), A.XL, in.final_g, vb, nvb);
        else phase_modulate<true>(nullptr, nullptr, w.XB(), w.H(), in.norm1_g + (l + 1) * 1024, w.MOD() + (size_t)(l + 1) * 33 * 6144, 0, NR, vb, nvb);
        if (!last) xcd_barrier(bar);
    }
}

extern "C" void kernel_launch(void* const* d_in, const int* in_sizes, int n_in, void* d_out, int out_size, void* d_ws, size_t ws_size, hipStream_t stream) {
    const float* const* fin = (const float* const*)d_in;
    Inputs in{fin[0], fin[1], fin[2], fin[3], fin[4], fin[5], fin[6], fin[7], fin[8], fin[9], fin[10], fin[11], fin[12], fin[13], fin[14], fin[15], fin[16], fin[17], fin[18], fin[19], fin[20], fin[21], fin[22]};
    WS w = make_ws(d_ws);
    static int ok = 0;
    if (!ok) {
        if (hipFuncSetAttribute((const void*)k_mega, hipFuncAttributeMaxDynamicSharedMemorySize, MEGA_LDS) != hipSuccess) { ok = -1; }
        int per_cu = 0, cus = 0, dev = 0; (void)hipGetDevice(&dev); (void)hipDeviceGetAttribute(&cus, hipDeviceAttributeMultiprocessorCount, dev);
        if (hipOccupancyMaxActiveBlocksPerMultiprocessor(&per_cu, (const void*)k_mega, 512, MEGA_LDS) != hipSuccess || per_cu < 1 || cus < 256) ok = -1;
        if (ok == 0) ok = 1;
    }
    if (ok < 0) return;
    (void)hipMemsetAsync(d_ws, 0, 16384, stream);
    MegaArgs A{in, w, (float*)d_out, (unsigned*)d_ws};
    k_mega<<<256, 512, MEGA_LDS, stream>>>(A);
}
```

```cpp
#include <hip/hip_runtime.h>
#include <stdint.h>

typedef unsigned short bf16_t;

constexpr int D = 1024, NB = 32, S = 2048, CTX = 256, DEPTH = 2;
constexpr int NL = NB * S, NC = NB * CTX, NR = NL + NC;
constexpr int KEYS = CTX + S;
constexpr int INC = 1568;
constexpr int NE = 16384;
constexpr float EPS = 1e-6f;

__device__ __forceinline__ float bf2f(bf16_t v) { return __uint_as_float(((unsigned)v) << 16); }
__device__ __forceinline__ bf16_t f2bf(float f) { unsigned u = __float_as_uint(f); u += 0x7FFFu + ((u >> 16) & 1u); return (bf16_t)(u >> 16); }

__device__ __forceinline__ float wave_sum(float v) {
#pragma unroll
    for (int o = 32; o > 0; o >>= 1) v += __shfl_xor(v, o);
    return v;
}
__device__ __forceinline__ float gelu_tanh(float x) {
    const float u = 0.7978845608028654f * (x + 0.044715f * x * x * x);
    return 0.5f * x * (1.f + tanhf(u));
}

struct WS {
    char* base;
    __host__ __device__ __forceinline__ bf16_t* H() const { return (bf16_t*)(base + 65536ull); }
    __host__ __device__ __forceinline__ bf16_t* Qg() const { return (bf16_t*)(base + 151060480ull); }
    __host__ __device__ __forceinline__ bf16_t* Qgc() const { return (bf16_t*)(base + 201392128ull); }
    __host__ __device__ __forceinline__ bf16_t* Kg() const { return (bf16_t*)(base + 207683584ull); }
    __host__ __device__ __forceinline__ bf16_t* Vg() const { return (bf16_t*)(base + 226557952ull); }
    __host__ __device__ __forceinline__ bf16_t* CQ() const { return (bf16_t*)(base + 245432320ull); }
    __host__ __device__ __forceinline__ bf16_t* CKV() const { return (bf16_t*)(base + 302055424ull); }
    __host__ __device__ __forceinline__ bf16_t* Bp() const { return (bf16_t*)(base + 339804160ull); }
    __host__ __device__ __forceinline__ bf16_t* KR() const { return (bf16_t*)(base + 377552896ull); }
    __host__ __device__ __forceinline__ bf16_t* Qm() const { return (bf16_t*)(base + 382271488ull); }
    __host__ __device__ __forceinline__ bf16_t* Qmc() const { return (bf16_t*)(base + 457768960ull); }
    __host__ __device__ __forceinline__ bf16_t* Kmn() const { return (bf16_t*)(base + 467206144ull); }
    __host__ __device__ __forceinline__ bf16_t* Vm() const { return (bf16_t*)(base + 523829248ull); }
    __host__ __device__ __forceinline__ unsigned* EG() const { return (unsigned*)(base + 580452352ull); }
    __host__ __device__ __forceinline__ bf16_t* P() const { return (bf16_t*)(base + 382271488ull); }
    __host__ __device__ __forceinline__ bf16_t* PQ() const { return (bf16_t*)(base + 151060480ull); }
    __host__ __device__ __forceinline__ bf16_t* TMP() const { return (bf16_t*)(base + 65536ull); }
    __host__ __device__ __forceinline__ float* XC() const { return (float*)(base + 618201088ull); }
    __host__ __device__ __forceinline__ float* MOD() const { return (float*)(base + 651755520ull); }
    __host__ __device__ __forceinline__ float2* ROPA() const { return (float2*)(base + 653377536ull); }
    __host__ __device__ __forceinline__ float2* ROPC() const { return (float2*)(base + 653901824ull); }
    __host__ __device__ __forceinline__ float* RSQ() const { return (float*)(base + 654163968ull); }
    __host__ __device__ __forceinline__ float* RSKV() const { return (float*)(base + 654458880ull); }
    __host__ __device__ __forceinline__ bf16_t* WinT() const { return (bf16_t*)(base + 654753792ull); }
    __host__ __device__ __forceinline__ bf16_t* WuqT() const { return (bf16_t*)(base + 662093824ull); }
    __host__ __device__ __forceinline__ bf16_t* WukvT() const { return (bf16_t*)(base + 663273472ull); }
    __host__ __device__ __forceinline__ bf16_t* WoutT() const { return (bf16_t*)(base + 664059904ull); }
    __host__ __device__ __forceinline__ bf16_t* WqT() const { return (bf16_t*)(base + 668254208ull); }
    __host__ __device__ __forceinline__ bf16_t* SubK() const { return (bf16_t*)(base + 676642816ull); }
    __host__ __device__ __forceinline__ unsigned char* U8() const { return (unsigned char*)(base + 677691392ull); }
    __host__ __device__ __forceinline__ unsigned char* V8() const { return (unsigned char*)(base + 711245824ull); }
    __host__ __device__ __forceinline__ float* US() const { return (float*)(base + 744800256ull); }
    __host__ __device__ __forceinline__ float* VS() const { return (float*)(base + 744931328ull); }
    __host__ __device__ __forceinline__ float* SSQ() const { return (float*)(base + 745062400ull); }
    __host__ __device__ __forceinline__ float* SSKV() const { return (float*)(base + 747421696ull); }
    __host__ __device__ __forceinline__ unsigned* WE() const { return (unsigned*)(base + 748601344ull); }
    __host__ __device__ __forceinline__ signed char* H8() const { return (signed char*)(base + 786350080ull); }
    __host__ __device__ __forceinline__ float* HS() const { return (float*)(base + 861847552ull); }
    __host__ __device__ __forceinline__ bf16_t* PoolWT() const { return (bf16_t*)(base + 862142464ull); }
    __host__ __device__ __forceinline__ bf16_t* XB() const { return (bf16_t*)(base + 862208000ull); }
};
constexpr size_t WS_BYTES = 862208000ull + (size_t)NR * 1024 * 2;
static WS make_ws(void* d_ws) { WS w; w.base = (char*)d_ws; return w; }


#define LAS __attribute__((address_space(3)))
typedef short bf16x8 __attribute__((ext_vector_type(8)));
typedef float f32x4 __attribute__((ext_vector_type(4)));
typedef float f32x16 __attribute__((ext_vector_type(16)));
typedef unsigned u32x4 __attribute__((ext_vector_type(4)));
typedef unsigned u32x2 __attribute__((ext_vector_type(2)));

__device__ __forceinline__ f32x16 mfma32(bf16x8 a, bf16x8 b, f32x16 c) { return __builtin_amdgcn_mfma_f32_32x32x16_bf16(a, b, c, 0, 0, 0); }
__device__ __forceinline__ unsigned cvt_pk_bf16(float lo, float hi) { unsigned r; asm volatile("v_cvt_pk_bf16_f32 %0, %1, %2" : "=v"(r) : "v"(lo), "v"(hi)); return r; }

namespace pg8 {
constexpr int BM = 256, BK = 64, HALF = 128, HTB = HALF * BK * 2, STAGE_BYTES = 8 * HTB, NXCD = 8, WGM = 8;
__host__ __device__ __forceinline__ int lds_byte(int r, int c) { const int st = (r >> 4) * 2 + (c >> 5), rr = r & 15, cc = c & 31, ob = rr * 64 + cc * 2; return st * 1024 + (ob ^ (((ob >> 9) & 1) << 5)); }
__host__ __device__ __forceinline__ void stage_rc(int b, int& R, int& C) { const int st = b / 1024, sb = b % 1024, swz = sb ^ (((sb >> 9) & 1) << 5); R = (st >> 1) * 16 + swz / 64; C = (st & 1) * 32 + (swz % 64) / 2; }
__host__ __device__ __forceinline__ int perm32(int rho) { const int n = rho >> 4, i = rho & 15; return 8 * (i >> 2) + 4 * n + (i & 3); }
struct Unit { int pm, pn; };
struct Gemm { const bf16_t* A; const bf16_t* Bt; int M, N, K; };
struct StaticOrder {
    int nM, nN, nwg, G, c;
    __host__ __device__ void init(int M, int N, int G_, int c_) { nM = M / BM; nN = N / BM; nwg = nM * nN; G = G_; c = c_; }
    __host__ __device__ bool next(int i, Unit& u) const {
        const long L = (long)i * G + c; if (L >= nwg) return false;
        int wgid = (int)L; { const int q = nwg / NXCD, r = nwg % NXCD, xcd = wgid % NXCD, off = wgid / NXCD; wgid = (xcd < r ? xcd * (q + 1) : r * (q + 1) + (xcd - r) * q) + off; }
        const int nig = WGM * nN, gid = wgid / nig, fm = gid * WGM, gsz = (nM - fm) < WGM ? (nM - fm) : WGM;
        u.pm = fm + ((wgid % nig) % gsz); u.pn = (wgid % nig) / gsz; return true;
    }
};
template <class Epi, class Sched>
__device__ __forceinline__ void gemm_phase(LAS unsigned char* lds, const Gemm g, const Sched& S, const Epi& E) {
    int tid_ = threadIdx.x; asm volatile("" : "+v"(tid_));
    const int tid = tid_, wid = __builtin_amdgcn_readfirstlane(tid >> 6), lane = tid & 63, wr = wid >> 2, wc = wid & 3, fr = lane & 15, fq = lane >> 4;
    const int K = g.K, nt = K / BK;
    unsigned voffA[2], voffB[2];
#pragma unroll
    for (int i = 0; i < 2; ++i) { int R, C; stage_rc(tid * 16 + i * 8192, R, C); const int Rb = Epi::PERM ? ((R & ~31) + perm32(R & 31)) : R;
        voffA[i] = (unsigned)(R * K + C) * 2u; voffB[i] = (unsigned)(Rb * K + C) * 2u; }
    const size_t kstep = (size_t)(BK * 2);
    const size_t hstep = (size_t)HALF * K * 2;
    const size_t tstep = 2 * hstep;
    const unsigned ldsw = (unsigned)wid * 1024u;
    const int aoff = lds_byte(wr * 64 + fr, fq * 8), boff = lds_byte(wc * 32 + fr, fq * 8);
#define PG8_SA(b, h) (((b) * 2 + (h)) * HTB)
#define PG8_SB(b, h) ((4 + (b) * 2 + (h)) * HTB)
#define PG8_STAGE(bufoff, gbase, voff) do { _Pragma("unroll") for (int _i = 0; _i < 2; ++_i) \
        __builtin_amdgcn_global_load_lds((const unsigned*)((const char*)(gbase) + (voff)[_i]), (LAS unsigned*)(lds + (bufoff) + ldsw + _i * 8192), 16, 0, 0); } while (0)
#define PG8_LDA(dst, b, h) do { _Pragma("unroll") for (int m = 0; m < 4; ++m) _Pragma("unroll") for (int k = 0; k < 2; ++k) dst[m][k] = *(const LAS bf16x8*)(lds + PG8_SA(b, h) + aoff + m * 2048 + k * 1024); } while (0)
#define PG8_LDB(dst, b, h) do { _Pragma("unroll") for (int n = 0; n < 2; ++n) _Pragma("unroll") for (int k = 0; k < 2; ++k) dst[n][k] = *(const LAS bf16x8*)(lds + PG8_SB(b, h) + boff + n * 2048 + k * 1024); } while (0)
#define PG8_MMA(ai, bj, At, Bt) do { __builtin_amdgcn_s_setprio(1); _Pragma("unroll") for (int m = 0; m < 4; ++m) _Pragma("unroll") for (int n = 0; n < 2; ++n) _Pragma("unroll") for (int k = 0; k < 2; ++k) \
        acc[ai][bj][m][n] = __builtin_amdgcn_mfma_f32_16x16x32_bf16(Bt[n][k], At[m][k], acc[ai][bj][m][n], 0, 0, 0); __builtin_amdgcn_s_setprio(0); } while (0)
#define PG8_WAIT_V(n) asm volatile("s_waitcnt vmcnt(" #n ")" ::: "memory")
#define PG8_WAIT_L(n) asm volatile("s_waitcnt lgkmcnt(" #n ")" ::: "memory")
#define PG8_BAR __builtin_amdgcn_s_barrier()
#define PG8_SCHED __builtin_amdgcn_sched_barrier(0)
    Unit cur, nxt; int ui = 0;
    if (!S.next(0, cur)) return;
    f32x4 acc[2][2][4][2];
#pragma unroll
    for (int a = 0; a < 2; ++a)
#pragma unroll
        for (int b = 0; b < 2; ++b)
#pragma unroll
            for (int m = 0; m < 4; ++m)
#pragma unroll
                for (int n = 0; n < 2; ++n) acc[a][b][m][n] = (f32x4){0.f, 0.f, 0.f, 0.f};
    bf16x8 At[4][2], B0[2][2], B1[2][2];
    const char* cA = (const char*)g.A + (size_t)cur.pm * tstep; const char* cB = (const char*)g.Bt + (size_t)cur.pn * tstep;
    PG8_STAGE(PG8_SB(0, 0), cB, voffB); PG8_STAGE(PG8_SA(0, 0), cA, voffA); PG8_STAGE(PG8_SB(0, 1), cB + hstep, voffB); PG8_STAGE(PG8_SA(0, 1), cA + hstep, voffA);
    if (wr == 1) PG8_BAR;
    PG8_WAIT_V(4); PG8_BAR;
    PG8_STAGE(PG8_SB(1, 0), cB + kstep, voffB); PG8_STAGE(PG8_SA(1, 0), cA + kstep, voffA); PG8_STAGE(PG8_SB(1, 1), cB + hstep + kstep, voffB);
    PG8_WAIT_V(6); PG8_BAR;
    for (;;) {
        const bool has_next = S.next(ui + 1, nxt);
        const char* nA = has_next ? (const char*)g.A + (size_t)nxt.pm * tstep : cA; const char* nB = has_next ? (const char*)g.Bt + (size_t)nxt.pn * tstep : cB;
#pragma nounroll
        for (int t = 0; t < nt; t += 2) {
            const bool last = (t == nt - 2);
            const char* a1 = cA + (size_t)(t + 1) * kstep;
            const char* a2 = last ? nA : cA + (size_t)(t + 2) * kstep; const char* b2 = last ? nB : cB + (size_t)(t + 2) * kstep;
            const char* a3 = a2 + kstep; const char* b3 = b2 + kstep;
            PG8_LDB(B0, 0, 0); PG8_SCHED; PG8_LDA(At, 0, 0); PG8_STAGE(PG8_SA(1, 1), a1 + hstep, voffA);
            PG8_WAIT_L(8); PG8_BAR; PG8_WAIT_L(0); PG8_MMA(0, 0, At, B0); PG8_BAR; PG8_SCHED;
            PG8_LDB(B1, 0, 1); PG8_STAGE(PG8_SB(0, 0), b2, voffB);
            PG8_BAR; PG8_WAIT_L(0); PG8_MMA(0, 1, At, B1); PG8_BAR;
            PG8_LDA(At, 0, 1); PG8_STAGE(PG8_SA(0, 0), a2, voffA);
            PG8_BAR; PG8_WAIT_L(0); PG8_MMA(1, 0, At, B0); PG8_BAR; PG8_SCHED;
            PG8_STAGE(PG8_SB(0, 1), b2 + hstep, voffB);
            PG8_WAIT_V(6); PG8_BAR; PG8_MMA(1, 1, At, B1); PG8_BAR;
            PG8_LDB(B0, 1, 0); PG8_SCHED; PG8_LDA(At, 1, 0); PG8_STAGE(PG8_SA(0, 1), a2 + hstep, voffA);
            PG8_WAIT_L(8); PG8_BAR; PG8_WAIT_L(0); PG8_MMA(0, 0, At, B0); PG8_BAR; PG8_SCHED;
            PG8_LDB(B1, 1, 1); PG8_STAGE(PG8_SB(1, 0), b3, voffB);
            PG8_BAR; PG8_WAIT_L(0); PG8_MMA(0, 1, At, B1); PG8_BAR;
            PG8_LDA(At, 1, 1); PG8_STAGE(PG8_SA(1, 0), a3, voffA);
            PG8_BAR; PG8_WAIT_L(0); PG8_MMA(1, 0, At, B0); PG8_BAR; PG8_SCHED;
            PG8_STAGE(PG8_SB(1, 1), b3 + hstep, voffB);
            PG8_WAIT_V(6); PG8_BAR; PG8_MMA(1, 1, At, B1); PG8_BAR;
        }
        E(acc, cur, wr, wc, fr, fq);
        if (!has_next) break;
#pragma unroll
        for (int a = 0; a < 2; ++a)
#pragma unroll
            for (int b = 0; b < 2; ++b)
#pragma unroll
                for (int m = 0; m < 4; ++m)
#pragma unroll
                    for (int n = 0; n < 2; ++n) acc[a][b][m][n] = (f32x4){0.f, 0.f, 0.f, 0.f};
        cur = nxt; cA = nA; cB = nB; ++ui;
    }
    PG8_WAIT_V(0);
    if (wr == 0) PG8_BAR;
    PG8_BAR;
#undef PG8_SA
#undef PG8_SB
#undef PG8_STAGE
#undef PG8_LDA
#undef PG8_LDB
#undef PG8_MMA
#undef PG8_WAIT_V
#undef PG8_WAIT_L
#undef PG8_BAR
#undef PG8_SCHED
}
}

enum { GT_AQ = 0, GT_AK = 1, GT_AV = 2, GT_B = 3, GT_CQ = 4, GT_CKV = 5, GT_KR = 6, GT_PAD = 7 };
__host__ __device__ __forceinline__ void in_group(int g, int& type, int& sub) {
    if (g < 2) { type = GT_AK; sub = g; } else if (g < 4) { type = GT_AV; sub = g - 2; } else if (g < 8) { type = GT_CKV; sub = g - 4; }
    else if (g == 8) { type = GT_KR; sub = 0; } else if (g < 12) { type = GT_PAD; sub = 0; } else if (g < 18) { type = GT_AQ; sub = g - 12; }
    else if (g < 24) { type = GT_CQ; sub = g - 18; } else { type = GT_B; sub = g - 24; }
}
__device__ __forceinline__ int colmap(int mode, int r) {
    const int pn = r >> 8, ct = r & 255, bj = ct >> 7, wc = (ct >> 5) & 3, j = ct & 31, g = 4 * pn + wc, e = 32 * bj + j;
    if (mode == 0) {
        int type, sub; in_group(g, type, sub);
        switch (type) { case GT_AQ: return 64 * sub + e; case GT_AK: return 384 + 64 * sub + e; case GT_AV: return 512 + 64 * sub + e; case GT_B: return 640 + 64 * sub + e;
            case GT_CQ: return 896 + 64 * sub + e; case GT_CKV: return 1280 + 64 * sub + e; case GT_KR: return (j < 16) ? 1536 + 16 * bj + j : -1; default: return -1; }
    } else if (mode == 1) {
        if (g < 6) return 96 * g + e; if (g < 9) { const int head = 2 * (g - 6) + (j >> 4); return 96 * head + 64 + 16 * bj + (j & 15); } return -1;
    } else if (mode == 2) {
        return 64 * g + e;
    }
    return r;
}
__device__ __forceinline__ void cvt_weights_unit(LAS float* tile  , const float* __restrict__ W, int K, int N, bf16_t* __restrict__ dst, int mode, const float* __restrict__ kgain, int r0, int k0) {
    int tid_ = threadIdx.x; asm volatile("" : "+v"(tid_));
    const int tid = tid_;
    const int jj = tid & 63; const int sc = colmap(mode, r0 + jj);
#pragma unroll
    for (int i = 0; i < 8; ++i) { const int kk = (tid >> 6) + 8 * i; float v = 0.f; if (sc >= 0) v = W[(size_t)(k0 + kk) * N + sc]; if (kgain) v *= kgain[k0 + kk]; tile[kk * 65 + jj] = v; }
    __syncthreads();
#pragma unroll
    for (int i = 0; i < 8; ++i) { const int rr = (tid >> 6) + 8 * i, kk = tid & 63; dst[(size_t)(r0 + rr) * K + k0 + kk] = f2bf(tile[kk * 65 + rr]); }
    __syncthreads();
}
struct CvtJob { const float* W; bf16_t* dst; const float* kgain; int K, N, Npad, mode; };
__device__ __forceinline__ void cvt_job(LAS float* tile, const CvtJob j, int vb, int nvb) {
    const int nk = j.K / 64, nr = j.Npad / 64;
    for (int u = vb; u < nk * nr; u += nvb) cvt_weights_unit(tile, j.W, j.K, j.N, j.dst, j.mode, j.kgain, (u / nk) * 64, (u % nk) * 64);
}
__device__ __forceinline__ void cvt_flat(const float* __restrict__ src, bf16_t* __restrict__ dst, size_t n, int vb, int nvb) {
    int tid_ = threadIdx.x; asm volatile("" : "+v"(tid_));
    for (size_t i = ((size_t)vb * 512 + tid_) * 8; i < n; i += (size_t)nvb * 512 * 8) {
        const float4 a = *(const float4*)(src + i), b = *(const float4*)(src + i + 4);
        u32x4 o; o.x = cvt_pk_bf16(a.x, a.y); o.y = cvt_pk_bf16(a.z, a.w); o.z = cvt_pk_bf16(b.x, b.y); o.w = cvt_pk_bf16(b.z, b.w);
        *(u32x4*)(dst + i) = o;
    }
}
template <bool FP8>
__device__ __forceinline__ void cvt_q8_rows(const float* __restrict__ src, unsigned char* __restrict__ dst, float* __restrict__ scales, int nrows, int vb, int nvb) {
    int tid_ = threadIdx.x; asm volatile("" : "+v"(tid_));
    const int lane = tid_ & 63, wid = tid_ >> 6;
    const int stride = nvb * 8;
    for (int row0 = vb * 8 + wid; row0 < nrows; row0 += 4 * stride) {
        f32x4 v[4][4];
#pragma unroll
        for (int q = 0; q < 4; ++q) { const int row = row0 + q * stride < nrows ? row0 + q * stride : row0; const float* sp = src + (size_t)row * 1024 + 16 * lane;
#pragma unroll
            for (int k = 0; k < 4; ++k) v[q][k] = *(const f32x4*)(sp + 4 * k); }
#pragma unroll
        for (int q = 0; q < 4; ++q) { const int row = row0 + q * stride; if (row < nrows) {
            float am = 0.f;
#pragma unroll
            for (int k = 0; k < 4; ++k) am = fmaxf(am, fmaxf(fmaxf(fabsf(v[q][k][0]), fabsf(v[q][k][1])), fmaxf(fabsf(v[q][k][2]), fabsf(v[q][k][3]))));
#pragma unroll
            for (int o = 32; o > 0; o >>= 1) am = fmaxf(am, __shfl_xor(am, o));
            const float qmax = FP8 ? 416.f : 127.f;
            const float sc = am > 0.f ? am / qmax : 1.f, inv = am > 0.f ? qmax / am : 0.f;
            u32x4 o4;
#pragma unroll
            for (int k = 0; k < 4; ++k) {
                if (FP8) { int p = __builtin_amdgcn_cvt_pk_fp8_f32(v[q][k][0] * inv, v[q][k][1] * inv, 0, false); p = __builtin_amdgcn_cvt_pk_fp8_f32(v[q][k][2] * inv, v[q][k][3] * inv, p, true); o4[k] = (unsigned)p; }
                else { const int q0 = (int)rintf(v[q][k][0] * inv), q1 = (int)rintf(v[q][k][1] * inv), q2 = (int)rintf(v[q][k][2] * inv), q3 = (int)rintf(v[q][k][3] * inv);
                    o4[k] = (unsigned)(q0 & 0xff) | ((unsigned)(q1 & 0xff) << 8) | ((unsigned)(q2 & 0xff) << 16) | ((unsigned)(q3 & 0xff) << 24); } }
            *(u32x4*)(dst + (size_t)row * 1024 + 16 * lane) = o4;
            if (lane == 0) scales[row] = sc; } }
    }
}
struct Inputs {
    const float *x, *c, *ctx, *c_ctx, *ada_w, *ada_b, *norm1_g, *norm2_g, *w_in, *gqa_qn_g, *gqa_kn_g, *pool_w, *pool_scale, *mla_qn_g, *mla_kvn_g, *mla_w_uq, *mla_w_ukv, *w_out, *peer_wq, *peer_subkeys, *peer_u, *peer_v, *final_g;
};
__device__ __forceinline__ void phase_cvt(LAS unsigned char* lds, const Inputs& in, const WS& w, int vb, int nvb) {
    LAS float* tile = (LAS float*)lds;
    for (int l = 0; l < 2; ++l) {
        cvt_job(tile, CvtJob{in.w_in + (size_t)l * 1024 * INC, w.WinT() + (size_t)l * 1792 * 1024, nullptr, 1024, INC, 1792, 0}, vb, nvb);
        cvt_job(tile, CvtJob{in.mla_w_uq + (size_t)l * 384 * 576, w.WuqT() + (size_t)l * 768 * 384, in.mla_qn_g + l * 384, 384, 576, 768, 1}, vb, nvb);
        cvt_job(tile, CvtJob{in.mla_w_ukv + (size_t)l * 256 * 768, w.WukvT() + (size_t)l * 768 * 256, in.mla_kvn_g + l * 256, 256, 768, 768, 2}, vb, nvb);
        cvt_job(tile, CvtJob{in.w_out + (size_t)l * 1024 * 1024, w.WoutT() + (size_t)l * 1024 * 1024, nullptr, 1024, 1024, 1024, 3}, vb, nvb);
        cvt_job(tile, CvtJob{in.peer_wq + (size_t)l * 1024 * 2048, w.WqT() + (size_t)l * 2048 * 1024, nullptr, 1024, 2048, 2048, 3}, vb, nvb);
    }
    cvt_flat(in.peer_subkeys, w.SubK(), (size_t)2 * 16 * 128 * 128, vb, nvb);
    { int tp_ = threadIdx.x; asm volatile("" : "+v"(tp_));
      for (int i = vb * 512 + tp_; i < 2 * 4 * 64 * 64; i += nvb * 512) { const int c = i & 63, d = (i >> 6) & 63, lg = i >> 12; w.PoolWT()[i] = f2bf(in.pool_w[(size_t)lg * 4096 + c * 64 + d]); } }
    if (nvb > 144) { if (vb >= 72) { cvt_q8_rows<false>(in.peer_u, w.U8(), w.US(), 2 * NE, vb - 72, nvb - 72); cvt_q8_rows<true>(in.peer_v, w.V8(), w.VS(), 2 * NE, vb - 72, nvb - 72); } }
    else { cvt_q8_rows<false>(in.peer_u, w.U8(), w.US(), 2 * NE, vb, nvb); cvt_q8_rows<true>(in.peer_v, w.V8(), w.VS(), 2 * NE, vb, nvb); }
}

constexpr float ATT_C2G = 0.125f * 1.4426950408889634f, ATT_C2M = 0.10206207261596577f * 1.4426950408889634f;
struct EpiIn {
    static constexpr bool PERM = true;
    WS w; const float* qn_g; const float* kn_g; int pm_base;
    __device__ __forceinline__ void operator()(const f32x4 (&acc)[2][2][4][2], const pg8::Unit& u, int wr, int wc, int fr, int fq) const {
        int type, sub; in_group(4 * u.pn + wc, type, sub);
        if (type == GT_PAD) return;
        const int pm = u.pm + pm_base; const bool isctx = pm >= 256; const int b = isctx ? pm - 256 : pm >> 3; const int t0 = isctx ? 0 : (pm & 7) * 256;
        const size_t rowbase = isctx ? (size_t)NL + (size_t)b * CTX : (size_t)b * S;
        const int keyoff = isctx ? 0 : CTX;
        float gain[2][8];
        if (type == GT_AQ) {
#pragma unroll
            for (int bj = 0; bj < 2; ++bj)
#pragma unroll
                for (int q = 0; q < 8; ++q) gain[bj][q] = qn_g[32 * bj + 8 * fq + q] * ATT_C2G;
        } else if (type == GT_AK) {
#pragma unroll
            for (int bj = 0; bj < 2; ++bj)
#pragma unroll
                for (int q = 0; q < 8; ++q) gain[bj][q] = kn_g[32 * bj + 8 * fq + q];
        }
#pragma unroll
        for (int ai = 0; ai < 2; ++ai)
#pragma unroll
            for (int m = 0; m < 4; ++m) {
                const int t = t0 + 128 * ai + 64 * wr + 16 * m + fr; const size_t row = rowbase + t;
                float v[2][8];
#pragma unroll
                for (int bj = 0; bj < 2; ++bj)
#pragma unroll
                    for (int n = 0; n < 2; ++n)
#pragma unroll
                        for (int i = 0; i < 4; ++i) v[bj][4 * n + i] = acc[ai][bj][m][n][i];
                bf16_t* dst = nullptr;
                if (type == GT_AQ || type == GT_AK) {
                    float ss = 0.f;
#pragma unroll
                    for (int bj = 0; bj < 2; ++bj)
#pragma unroll
                        for (int q = 0; q < 8; ++q) ss += v[bj][q] * v[bj][q];
                    ss += __shfl_xor(ss, 16); ss += __shfl_xor(ss, 32);
                    const float rstd = rsqrtf(ss * (1.f / 64.f) + EPS);
#pragma unroll
                    for (int q = 0; q < 8; ++q) { float x1 = v[0][q] * rstd * gain[0][q], x2 = v[1][q] * rstd * gain[1][q];
                        if (!isctx) { const float2 cs = w.ROPA()[t * 32 + 8 * fq + q]; const float y1 = x1 * cs.x - x2 * cs.y, y2 = x1 * cs.y + x2 * cs.x; x1 = y1; x2 = y2; }
                        v[0][q] = x1; v[1][q] = x2; }
                    if (type == GT_AQ) dst = isctx ? w.Qgc() + (((size_t)b * 6 + sub) * CTX + t) * 64 : w.Qg() + (((size_t)b * 6 + sub) * S + t) * 64;
                    else dst = w.Kg() + (((size_t)b * 2 + sub) * KEYS + keyoff + t) * 64;
                } else if (type == GT_AV) { dst = w.Vg() + (((size_t)b * 2 + sub) * KEYS + keyoff + t) * 64;
                } else if (type == GT_B) { dst = w.Bp() + row * 256 + 64 * sub;
                } else if (type == GT_CQ || type == GT_CKV) {
                    float ss = 0.f;
#pragma unroll
                    for (int bj = 0; bj < 2; ++bj)
#pragma unroll
                        for (int q = 0; q < 8; ++q) ss += v[bj][q] * v[bj][q];
                    ss += __shfl_xor(ss, 16); ss += __shfl_xor(ss, 32);
                    if (type == GT_CQ) { if (fq == 0) w.SSQ()[row * 8 + sub] = ss; dst = w.CQ() + row * 384 + 64 * sub; }
                    else { if (fq == 0) w.SSKV()[row * 4 + sub] = ss; dst = w.CKV() + row * 256 + 64 * sub; }
                } else {
                    if (!isctx) {
#pragma unroll
                        for (int q = 0; q < 8; ++q) { const float2 cs = w.ROPC()[t * 16 + ((8 * fq + q) & 15)]; const float x1 = v[0][q], x2 = v[1][q]; v[0][q] = x1 * cs.x - x2 * cs.y; v[1][q] = x1 * cs.y + x2 * cs.x; } }
                    if (fq < 2) { bf16_t* kd = w.KR() + ((size_t)b * KEYS + keyoff + t) * 32;
#pragma unroll
                        for (int bj = 0; bj < 2; ++bj) { u32x4 o; o.x = cvt_pk_bf16(v[bj][0], v[bj][1]); o.y = cvt_pk_bf16(v[bj][2], v[bj][3]); o.z = cvt_pk_bf16(v[bj][4], v[bj][5]); o.w = cvt_pk_bf16(v[bj][6], v[bj][7]);
                            *(u32x4*)(kd + 16 * bj + 8 * fq) = o; } }
                    continue;
                }
#pragma unroll
                for (int bj = 0; bj < 2; ++bj) { u32x4 o; o.x = cvt_pk_bf16(v[bj][0], v[bj][1]); o.y = cvt_pk_bf16(v[bj][2], v[bj][3]); o.z = cvt_pk_bf16(v[bj][4], v[bj][5]); o.w = cvt_pk_bf16(v[bj][6], v[bj][7]);
                    *(u32x4*)(dst + 32 * bj + 8 * fq) = o; }
            }
    }
};
struct P1Order {
    pg8::StaticOrder so; int nctx_tiles, G, c;
    __device__ bool next(int i, pg8::Unit& u) const {
        const int L = i * G + c;
        if (L < 1792) return so.next(i, u);
        const int Lc = L - 1792; if (Lc >= 32 * nctx_tiles) return false;
        u.pm = 256 + (Lc & 31); u.pn = Lc >> 5; return true;
    }
};
__device__ __forceinline__ void phase_p1(LAS unsigned char* lds, const WS& w, const Inputs& in, int l, int vb, int nvb) {
    EpiIn E{w, in.gqa_qn_g + l * 64, in.gqa_kn_g + l * 64, 0};
    P1Order po; po.so.init(NL, 1792, nvb, vb); po.nctx_tiles = (l == 0) ? 7 : 3; po.G = nvb; po.c = vb;
    pg8::gemm_phase(lds, pg8::Gemm{w.H(), w.WinT() + (size_t)l * 1792 * 1024, NR, 1792, 1024}, po, E);
}

extern __shared__ __attribute__((aligned(16))) unsigned char dyn_lds[];

struct EpiUq {
    static constexpr bool PERM = true;
    WS w;
    __device__ __forceinline__ void operator()(const f32x4 (&acc)[2][2][4][2], const pg8::Unit& u, int wr, int wc, int fr, int fq) const {
        const int g = 4 * u.pn + wc; if (g >= 9) return;
        const int pm = u.pm; const bool isctx = pm >= 256; const int b = isctx ? pm - 256 : pm >> 3; const int t0 = isctx ? 0 : (pm & 7) * 256;
        const size_t rowbase = isctx ? (size_t)NL + (size_t)b * CTX : (size_t)b * S;
        const int head = g < 6 ? g : 2 * (g - 6) + (fq >> 1);
#pragma unroll
        for (int ai = 0; ai < 2; ++ai)
#pragma unroll
            for (int m = 0; m < 4; ++m) {
                const int t = t0 + 128 * ai + 64 * wr + 16 * m + fr; const size_t row = rowbase + t;
                const float4 s0 = *(const float4*)(w.SSQ() + row * 8), s1 = *(const float4*)(w.SSQ() + row * 8 + 4);
                const float rstd = rsqrtf((s0.x + s0.y + s0.z + s0.w + s1.x + s1.y) * (1.f / 384.f) + EPS) * ATT_C2M;
                float v[2][8];
#pragma unroll
                for (int bj = 0; bj < 2; ++bj)
#pragma unroll
                    for (int n = 0; n < 2; ++n)
#pragma unroll
                        for (int i = 0; i < 4; ++i) v[bj][4 * n + i] = acc[ai][bj][m][n][i] * rstd;
                bf16_t* hd = isctx ? w.Qmc() + (((size_t)b * 6 + head) * CTX + t) * 96 : w.Qm() + (((size_t)b * 6 + head) * S + t) * 96;
                if (g >= 6 && !isctx) {
#pragma unroll
                    for (int q = 0; q < 8; ++q) { const float2 cs = w.ROPC()[t * 16 + 8 * (fq & 1) + q]; const float x1 = v[0][q], x2 = v[1][q]; v[0][q] = x1 * cs.x - x2 * cs.y; v[1][q] = x1 * cs.y + x2 * cs.x; } }
#pragma unroll
                for (int bj = 0; bj < 2; ++bj) { u32x4 o; o.x = cvt_pk_bf16(v[bj][0], v[bj][1]); o.y = cvt_pk_bf16(v[bj][2], v[bj][3]); o.z = cvt_pk_bf16(v[bj][4], v[bj][5]); o.w = cvt_pk_bf16(v[bj][6], v[bj][7]);
                    bf16_t* d = g < 6 ? hd + 32 * bj + 8 * fq : hd + 64 + 16 * bj + 8 * (fq & 1);
                    *(u32x4*)d = o; }
            }
    }
};
struct EpiUkv {
    static constexpr bool PERM = true;
    WS w;
    __device__ __forceinline__ void operator()(const f32x4 (&acc)[2][2][4][2], const pg8::Unit& u, int wr, int wc, int fr, int fq) const {
        const int g = 4 * u.pn + wc;
        const int pm = u.pm; const bool isctx = pm >= 256; const int b = isctx ? pm - 256 : pm >> 3; const int t0 = isctx ? 0 : (pm & 7) * 256;
        const size_t rowbase = isctx ? (size_t)NL + (size_t)b * CTX : (size_t)b * S; const int keyoff = isctx ? 0 : CTX;
        bf16_t* base = ((g & 1) ? w.Vm() : w.Kmn()) + ((size_t)b * 6 + (g >> 1)) * KEYS * 64;
#pragma unroll
        for (int ai = 0; ai < 2; ++ai)
#pragma unroll
            for (int m = 0; m < 4; ++m) {
                const int t = t0 + 128 * ai + 64 * wr + 16 * m + fr; const size_t row = rowbase + t;
                const float4 s0 = *(const float4*)(w.SSKV() + row * 4);
                const float rstd = rsqrtf((s0.x + s0.y + s0.z + s0.w) * (1.f / 256.f) + EPS);
                bf16_t* d = base + (size_t)(keyoff + t) * 64;
#pragma unroll
                for (int bj = 0; bj < 2; ++bj) { const f32x4 a0 = acc[ai][bj][m][0] * rstd, a1 = acc[ai][bj][m][1] * rstd;
                    u32x4 o; o.x = cvt_pk_bf16(a0[0], a0[1]); o.y = cvt_pk_bf16(a0[2], a0[3]); o.z = cvt_pk_bf16(a1[0], a1[1]); o.w = cvt_pk_bf16(a1[2], a1[3]);
                    *(u32x4*)(d + 32 * bj + 8 * fq) = o; }
            }
    }
};
constexpr int POOL_X = 0, POOL_P = 272 * 128, POOL_BYTES = 272 * 128 + 256 * 128;
__device__ __forceinline__ void phase_pool(LAS unsigned char* lds, const WS& w, bf16_t* __restrict__ MIX, const bf16_t* __restrict__ WT  , const float* __restrict__ pool_scale, int nrows, int vb, int nvb) {
    int tid_ = threadIdx.x; asm volatile("" : "+v"(tid_));
    const int tid = tid_, lane = tid & 63, wid = __builtin_amdgcn_readfirstlane(tid >> 6), r32 = lane & 31, hi = lane >> 5;
    const int nunits = nrows >> 8;
    for (int u = vb; u < nunits; u += nvb) {
        const int row0 = u << 8; const bool isctx = row0 >= NL; const int L = isctx ? CTX : S; const int t0 = isctx ? 0 : (row0 & (S - 1)); const int seq0 = row0 - t0;
#pragma unroll 1
        for (int g = 0; g < 4; ++g) {
            const int wdw = 2 << g, half = wdw >> 1;
            for (int i = tid; i < 272 * 8; i += 512) { const int rr = i >> 3, ch = i & 7; int t = t0 - 8 + rr; t = t < 0 ? 0 : (t >= L ? L - 1 : t);
                *(LAS u32x4*)(lds + POOL_X + rr * 128 + ch * 16) = *(const u32x4*)(w.Bp() + (size_t)(seq0 + t) * 256 + g * 64 + ch * 8); }
            __syncthreads();
            { const int c = tid & 63, seg = tid >> 6; const LAS bf16_t* X = (const LAS bf16_t*)(lds + POOL_X) + c;
              int t = t0 + seg * 32; int lo = t - half, hiw = t - half + wdw; lo = lo < 0 ? 0 : lo; hiw = hiw > L ? L : hiw;
              float sum = 0.f; for (int q = lo; q < hiw; ++q) sum += bf2f(X[(q - t0 + 8) * 64]);
#pragma unroll 4
              for (int k = 0; k < 32; ++k, ++t) {
                  const int clo = (t - half) < 0 ? 0 : (t - half), chi = (t - half + wdw) > L ? L : (t - half + wdw);
                  const float pv = sum / (float)(chi - clo) - bf2f(X[(t - t0 + 8) * 64]);
                  const int r = seg * 32 + k; *((LAS bf16_t*)(lds + POOL_P + r * 128 + (((c >> 3) ^ ((r >> 1) & 7)) << 4)) + (c & 7)) = f2bf(pv);
                  const int add = t + 1 - half + wdw - 1, drop = t - half;
                  if (add < L) sum += bf2f(X[(add - t0 + 8) * 64]);
                  if (drop >= 0) sum -= bf2f(X[(drop - t0 + 8) * 64]);
              } }
            __syncthreads();
            { f32x16 o0 = {}, o1 = {};
              const bf16_t* wt = WT + (size_t)g * 4096 + (size_t)r32 * 64 + 8 * hi;
#pragma unroll
              for (int s = 0; s < 4; ++s) { const int row = wid * 32 + r32; const bf16x8 pf = *(const LAS bf16x8*)(lds + POOL_P + row * 128 + (((2 * s + hi) ^ ((row >> 1) & 7)) << 4));
                  o0 = mfma32(*(const bf16x8*)(wt + 16 * s), pf, o0); o1 = mfma32(*(const bf16x8*)(wt + 32 * 64 + 16 * s), pf, o1); }
              bf16_t* op = MIX + (size_t)(row0 + wid * 32 + r32) * 1024 + 384 + g * 64 + 4 * hi; const float* ps = pool_scale + g * 64 + 4 * hi;
#pragma unroll
              for (int q = 0; q < 4; ++q) { const f32x4 s0 = *(const f32x4*)(ps + 8 * q), s1 = *(const f32x4*)(ps + 32 + 8 * q); u32x2 a, b;
                  a.x = cvt_pk_bf16(o0[4 * q] * s0[0], o0[4 * q + 1] * s0[1]); a.y = cvt_pk_bf16(o0[4 * q + 2] * s0[2], o0[4 * q + 3] * s0[3]);
                  b.x = cvt_pk_bf16(o1[4 * q] * s1[0], o1[4 * q + 1] * s1[1]); b.y = cvt_pk_bf16(o1[4 * q + 2] * s1[2], o1[4 * q + 3] * s1[3]);
                  *(u32x2*)(op + 8 * q) = a; *(u32x2*)(op + 32 + 8 * q) = b; } }
            __syncthreads();
        }
    }
}
__device__ __forceinline__ void phase_p2(LAS unsigned char* lds, const WS& w, const Inputs& in, int l, int vb, int nvb, int parts = 7) {
    pg8::StaticOrder so;
    if (parts & 1) { EpiUq E{w}; const int M = l == 0 ? NR : NL; so.init(M, 768, nvb, vb); pg8::gemm_phase(lds, pg8::Gemm{w.CQ(), w.WuqT() + (size_t)l * 768 * 384, M, 768, 384}, so, E); }
    if (parts & 2) { EpiUkv E{w}; so.init(NR, 768, nvb, vb); pg8::gemm_phase(lds, pg8::Gemm{w.CKV(), w.WukvT() + (size_t)l * 768 * 256, NR, 768, 256}, so, E); }
    if (parts & 4) phase_pool(lds, w, w.H(), w.PoolWT() + (size_t)l * 4 * 64 * 64, in.pool_scale + l * 256, l == 0 ? NR : NL, vb, nvb);
}

struct EpiOut {
    static constexpr bool PERM = true;
    bf16_t* DLT; const float* gate;
    __device__ __forceinline__ void operator()(const f32x4 (&acc)[2][2][4][2], const pg8::Unit& u, int wr, int wc, int fr, int fq) const {
        const int pm = u.pm; const int mr = pm >= 256 ? 32 : pm >> 3;
        const size_t r0 = (size_t)pm * 256 + wr * 64 + fr; const int col0 = u.pn * 256 + wc * 32 + 8 * fq;
        f32x4 gv[2][2];
#pragma unroll
        for (int bj = 0; bj < 2; ++bj)
#pragma unroll
            for (int n = 0; n < 2; ++n) gv[bj][n] = *(const f32x4*)(gate + (size_t)mr * 6144 + col0 + bj * 128 + 4 * n);
#pragma unroll
        for (int ai = 0; ai < 2; ++ai)
#pragma unroll
            for (int m = 0; m < 4; ++m) { bf16_t* d = DLT + (r0 + ai * 128 + m * 16) * 1024 + col0;
#pragma unroll
                for (int bj = 0; bj < 2; ++bj) { const f32x4 a0 = acc[ai][bj][m][0] * gv[bj][0], a1 = acc[ai][bj][m][1] * gv[bj][1];
                    u32x4 o; o.x = cvt_pk_bf16(a0[0], a0[1]); o.y = cvt_pk_bf16(a0[2], a0[3]); o.z = cvt_pk_bf16(a1[0], a1[1]); o.w = cvt_pk_bf16(a1[2], a1[3]);
                    *(u32x4*)(d + bj * 128) = o; } }
    }
};
__device__ __forceinline__ void phase_p4(LAS unsigned char* lds, const WS& w, const Inputs& in, int l, int vb, int nvb) {
    const float* MODl = w.MOD() + (size_t)l * 33 * 6144;
    EpiOut E{w.PQ(), MODl + 2 * 1024};
    const int M = l == 0 ? NR : NL;
    pg8::StaticOrder so; so.init(M, 1024, nvb, vb);
    pg8::gemm_phase(lds, pg8::Gemm{w.H(), w.WoutT() + (size_t)l * 1024 * 1024, M, 1024, 1024}, so, E);
}

template <bool INBF>
__device__ __forceinline__ void phase_modulate(const float* __restrict__ XLp, const float* __restrict__ XCp, const bf16_t* __restrict__ XBp, bf16_t* __restrict__ Hout, const float* __restrict__ g, const float* __restrict__ MODl, int si, int nrows, int vb, int nvb,
                                               signed char* __restrict__ H8 = nullptr, float* __restrict__ HS = nullptr, const bf16_t* __restrict__ DLT = nullptr, bf16_t* __restrict__ XBo = nullptr) {
    int tid_ = threadIdx.x; asm volatile("" : "+v"(tid_));
    const int tid = tid_, lane = tid & 63, wid = tid >> 6;
    f32x4 gv[4];
#pragma unroll
    for (int i = 0; i < 4; ++i) gv[i] = *(const f32x4*)(g + 256 * i + 4 * lane);
    const int stride = nvb * 8, lastrow = nrows - 1;
    f32x4 nx[4]; u32x2 nxb[4], ndr[4];
#define PM_LOAD(r_) do { const int rr_ = (r_) < nrows ? (r_) : lastrow; const bool ic_ = rr_ >= NL; const float* xp_ = ic_ ? XCp + (size_t)(rr_ - NL) * 1024 : XLp + (size_t)rr_ * 1024; \
        _Pragma("unroll") for (int i = 0; i < 4; ++i) { if (INBF) nxb[i] = *(const u32x2*)(XBp + (size_t)rr_ * 1024 + 256 * i + 4 * lane); else nx[i] = *(const f32x4*)(xp_ + 256 * i + 4 * lane); \
            if (DLT) ndr[i] = *(const u32x2*)(DLT + (size_t)rr_ * 1024 + 256 * i + 4 * lane); } } while (0)
    PM_LOAD(vb * 8 + wid);
    for (int row = vb * 8 + wid; row < nrows; row += stride) {
        const bool isctx = row >= NL; const int mr = isctx ? 32 : row / S;
        f32x4 x[4]; u32x2 dr4[4]; float ss = 0.f;
#pragma unroll
        for (int i = 0; i < 4; ++i) { if (INBF) x[i] = (f32x4){__uint_as_float(nxb[i].x << 16), __uint_as_float(nxb[i].x & 0xffff0000u), __uint_as_float(nxb[i].y << 16), __uint_as_float(nxb[i].y & 0xffff0000u)}; else x[i] = nx[i];
            if (DLT) dr4[i] = ndr[i]; }
        PM_LOAD(row + stride);
#pragma unroll
        for (int i = 0; i < 4; ++i) {
            if (DLT) { const u32x2 dr = dr4[i];
                x[i][0] += __uint_as_float(dr.x << 16); x[i][1] += __uint_as_float(dr.x & 0xffff0000u); x[i][2] += __uint_as_float(dr.y << 16); x[i][3] += __uint_as_float(dr.y & 0xffff0000u);
                u32x2 xo; xo.x = cvt_pk_bf16(x[i][0], x[i][1]); xo.y = cvt_pk_bf16(x[i][2], x[i][3]); *(u32x2*)(XBo + (size_t)row * 1024 + 256 * i + 4 * lane) = xo; }
            ss += x[i][0] * x[i][0] + x[i][1] * x[i][1] + x[i][2] * x[i][2] + x[i][3] * x[i][3]; }
        ss = wave_sum(ss); const float rstd = rsqrtf(ss * (1.f / 1024.f) + EPS);
        const float* sh = MODl + (size_t)mr * 6144 + si * 1024;
        f32x4 y[4]; float am = 0.f;
#pragma unroll
        for (int i = 0; i < 4; ++i) { const f32x4 shv = *(const f32x4*)(sh + 256 * i + 4 * lane), scv = *(const f32x4*)(sh + 1024 + 256 * i + 4 * lane);
            y[i] = x[i] * rstd * gv[i] * (scv + 1.f) + shv;
            am = fmaxf(am, fmaxf(fmaxf(fabsf(y[i][0]), fabsf(y[i][1])), fmaxf(fabsf(y[i][2]), fabsf(y[i][3]))));
            u32x2 o; o.x = cvt_pk_bf16(y[i][0], y[i][1]); o.y = cvt_pk_bf16(y[i][2], y[i][3]);
            *(u32x2*)(Hout + (size_t)row * 1024 + 256 * i + 4 * lane) = o; }
        if (H8) {
#pragma unroll
            for (int o = 32; o > 0; o >>= 1) am = fmaxf(am, __shfl_xor(am, o));
            const float inv = am > 0.f ? 127.f / am : 0.f;
#pragma unroll
            for (int i = 0; i < 4; ++i) { const int q0 = (int)rintf(y[i][0] * inv), q1 = (int)rintf(y[i][1] * inv), q2 = (int)rintf(y[i][2] * inv), q3 = (int)rintf(y[i][3] * inv);
                *(unsigned*)(H8 + (size_t)row * 1024 + 256 * i + 4 * lane) = (unsigned)(q0 & 0xff) | ((unsigned)(q1 & 0xff) << 8) | ((unsigned)(q2 & 0xff) << 16) | ((unsigned)(q3 & 0xff) << 24); }
            if (lane == 0) HS[row] = am > 0.f ? am * (1.f / 127.f) : 1.f;
        }
    }
#undef PM_LOAD
}

struct EpiPQ {
    static constexpr bool PERM = true;
    bf16_t* PQ;
    __device__ __forceinline__ void operator()(const f32x4 (&acc)[2][2][4][2], const pg8::Unit& u, int wr, int wc, int fr, int fq) const {
        const size_t r0 = (size_t)u.pm * 256 + wr * 64 + fr; const int col0 = u.pn * 256 + wc * 32 + 8 * fq;
#pragma unroll
        for (int ai = 0; ai < 2; ++ai)
#pragma unroll
            for (int m = 0; m < 4; ++m) { bf16_t* d = PQ + (r0 + ai * 128 + m * 16) * 2048 + col0;
#pragma unroll
                for (int bj = 0; bj < 2; ++bj) { const f32x4 a0 = acc[ai][bj][m][0], a1 = acc[ai][bj][m][1];
                    u32x4 o; o.x = cvt_pk_bf16(a0[0], a0[1]); o.y = cvt_pk_bf16(a0[2], a0[3]); o.z = cvt_pk_bf16(a1[0], a1[1]); o.w = cvt_pk_bf16(a1[2], a1[3]);
                    *(u32x4*)(d + bj * 128) = o; } }
    }
};
__device__ __forceinline__ void phase_p6a(LAS unsigned char* lds, const WS& w, int l, int vb, int nvb) {
    EpiPQ E{w.PQ()}; const int M = l == 0 ? NR : NL;
    pg8::StaticOrder so; so.init(M, 2048, nvb, vb);
    pg8::gemm_phase(lds, pg8::Gemm{w.H(), w.WqT() + (size_t)l * 2048 * 1024, M, 2048, 1024}, so, E);
}


using bf16x2_t = __attribute__((ext_vector_type(2))) __bf16;
typedef float f32x2 __attribute__((ext_vector_type(2)));
__device__ __forceinline__ float gelu_fast(float x) {
    const float u2 = 1.5957691216057308f * (x + 0.044715f * x * x * x);
    return x * __builtin_amdgcn_rcpf(1.f + __builtin_amdgcn_exp2f(-1.4426950408889634f * u2));
}
#define DPPF(v, ctrl) __builtin_bit_cast(float, __builtin_amdgcn_update_dpp(0, __builtin_bit_cast(int, (v)), (ctrl), 0xf, 0xf, true))
__device__ __forceinline__ float reduce8(float p0, float p1, float p2, float p3, float p4, float p5, float p6, float p7, int lane) {
    auto s01 = __builtin_amdgcn_permlane32_swap(__float_as_uint(p0), __float_as_uint(p1), false, false);
    auto s23 = __builtin_amdgcn_permlane32_swap(__float_as_uint(p2), __float_as_uint(p3), false, false);
    auto s45 = __builtin_amdgcn_permlane32_swap(__float_as_uint(p4), __float_as_uint(p5), false, false);
    auto s67 = __builtin_amdgcn_permlane32_swap(__float_as_uint(p6), __float_as_uint(p7), false, false);
    const float q0 = __uint_as_float(s01[0]) + __uint_as_float(s01[1]), q1 = __uint_as_float(s23[0]) + __uint_as_float(s23[1]);
    const float q2 = __uint_as_float(s45[0]) + __uint_as_float(s45[1]), q3 = __uint_as_float(s67[0]) + __uint_as_float(s67[1]);
    auto t0 = __builtin_amdgcn_permlane16_swap(__float_as_uint(q0), __float_as_uint(q1), false, false);
    auto t1 = __builtin_amdgcn_permlane16_swap(__float_as_uint(q2), __float_as_uint(q3), false, false);
    float r0 = __uint_as_float(t0[0]) + __uint_as_float(t0[1]);
    float r1 = __uint_as_float(t1[0]) + __uint_as_float(t1[1]);
    r0 += DPPF(r0, 0x128); r1 += DPPF(r1, 0x128);
    float z = (lane & 8) ? r1 : r0;
    z += DPPF(z, 0x141);
    z += DPPF(z, 0xB1);
    z += DPPF(z, 0x4E);
    return z;
}
__device__ __forceinline__ void p7_axpy(const u32x4 v, float wj, f32x2 (&out)[8]) {
    const f32x2 w2 = {wj, wj};
#pragma unroll
    for (int k = 0; k < 4; ++k) { const f32x2 lo = __builtin_amdgcn_cvt_pk_f32_fp8((int)v[k], false), hi2 = __builtin_amdgcn_cvt_pk_f32_fp8((int)v[k], true);
        out[2 * k] = __builtin_elementwise_fma(w2, lo, out[2 * k]); out[2 * k + 1] = __builtin_elementwise_fma(w2, hi2, out[2 * k + 1]); }
}
__device__ __forceinline__ int p7_doti(const u32x4 u, const u32x4 h) {
    int s = __builtin_amdgcn_sdot4((int)u[0], (int)h[0], 0, false); s = __builtin_amdgcn_sdot4((int)u[1], (int)h[1], s, false); s = __builtin_amdgcn_sdot4((int)u[2], (int)h[2], s, false); return __builtin_amdgcn_sdot4((int)u[3], (int)h[3], s, false);
}
#define DPPI(v, ctrl) __builtin_amdgcn_update_dpp(0, (v), (ctrl), 0xf, 0xf, true)
__device__ __forceinline__ int reduce8i(int p0, int p1, int p2, int p3, int p4, int p5, int p6, int p7, int lane) {
    auto s01 = __builtin_amdgcn_permlane32_swap((unsigned)p0, (unsigned)p1, false, false); auto s23 = __builtin_amdgcn_permlane32_swap((unsigned)p2, (unsigned)p3, false, false);
    auto s45 = __builtin_amdgcn_permlane32_swap((unsigned)p4, (unsigned)p5, false, false); auto s67 = __builtin_amdgcn_permlane32_swap((unsigned)p6, (unsigned)p7, false, false);
    const unsigned q0 = s01[0] + s01[1], q1 = s23[0] + s23[1], q2 = s45[0] + s45[1], q3 = s67[0] + s67[1];
    auto t0 = __builtin_amdgcn_permlane16_swap(q0, q1, false, false); auto t1 = __builtin_amdgcn_permlane16_swap(q2, q3, false, false);
    int r0 = (int)(t0[0] + t0[1]), r1 = (int)(t1[0] + t1[1]);
    r0 += DPPI(r0, 0x128); r1 += DPPI(r1, 0x128);
    int z = (lane & 8) ? r1 : r0;
    z += DPPI(z, 0x141); z += DPPI(z, 0xB1); z += DPPI(z, 0x4E);
    return z;
}

struct P7CArgs { const signed char* H8; const unsigned* EG; const unsigned char* U8; int* PART; int nrows; };
__device__ __forceinline__ void phase_p7c(LAS unsigned char* lds, const P7CArgs& a, int part, int prank, int nvb) {
    int tid_ = threadIdx.x; asm volatile("" : "+v"(tid_));
    const int lane = tid_ & 63, wid = __builtin_amdgcn_readfirstlane(tid_ >> 6);
    const int nw = (nvb >> 3) * 8, wrank = prank * 8 + wid;
    LAS unsigned* tab = (LAS unsigned*)(lds + wid * 1024);
    const int grp = lane >> 3, c = lane & 7, c16 = c * 16;
    const unsigned char* ubase = a.U8 + 128 * part + c16;
    const signed char* hbase = a.H8 + 128 * part + c16;
    unsigned* pbase = (unsigned*)a.PART + (size_t)part * a.nrows * 64;
    const int c2 = (c >> 2) & 1, c1 = (c >> 1) & 1, c0 = c & 1;
    const int ent0 = 8 * (4 * c2 + 2 * c0 + c1) + grp;
    u32x4 Av[16], Bv[16]; u32x4 Ah, Bh;
    unsigned pw0 = 0u, pw1 = 0u;
#define P7C_PREF(t) do { pw0 = a.EG[(size_t)(t) * 128 + lane]; pw1 = a.EG[(size_t)(t) * 128 + 64 + lane]; } while (0)
#define P7C_ISSUE(X, Xh, t, slot, tnext) do { LAS unsigned* tb_ = tab + (slot) * 128; \
        tb_[lane] = pw0; tb_[64 + lane] = pw1; \
        asm volatile("s_waitcnt lgkmcnt(0)" ::: "memory"); \
        _Pragma("unroll") for (int i_ = 0; i_ < 16; ++i_) { const unsigned e_ = tb_[8 * i_ + grp]; X[i_] = *(const u32x4*)(ubase + (size_t)(e_ >> 16) * 1024); } \
        Xh = *(const u32x4*)(hbase + (size_t)(t) * 1024); \
        P7C_PREF(tnext); } while (0)
#define P7C_X(v, ctrl) ((v) + DPPI((v), (ctrl)))
#define P7C_COMPUTE(X, Xh, t, valid) do { int d_[16]; \
        _Pragma("unroll") for (int i_ = 0; i_ < 16; ++i_) d_[i_] = p7_doti(X[i_], Xh); \
        int e8_[8]; _Pragma("unroll") for (int k = 0; k < 8; ++k) { const int send_ = c2 ? d_[k] : d_[k + 8], keep_ = c2 ? d_[k + 8] : d_[k]; e8_[k] = keep_ + DPPI(send_, 0x141); }            \
        int e4_[4]; _Pragma("unroll") for (int k = 0; k < 4; ++k) { const int send_ = c0 ? e8_[k] : e8_[k + 4], keep_ = c0 ? e8_[k + 4] : e8_[k]; e4_[k] = keep_ + DPPI(send_, 0xB1); }          \
        int e2_[2]; _Pragma("unroll") for (int k = 0; k < 2; ++k) { const int send_ = c1 ? e4_[k] : e4_[k + 2], keep_ = c1 ? e4_[k + 2] : e4_[k]; e2_[k] = keep_ + DPPI(send_, 0x4E); }          \
        if (valid) pbase[(size_t)(t) * 64 + ent0] = __builtin_bit_cast(unsigned, __builtin_amdgcn_cvt_pk_i16((e2_[0] + 8) >> 4, (e2_[1] + 8) >> 4)); } while (0)
    const int lastrow = a.nrows - 1;
    int t = wrank;
    P7C_PREF(t);
    P7C_ISSUE(Av, Ah, t, 0, (t + nw < a.nrows ? t + nw : lastrow));
    while (t < a.nrows) {
        const int t1 = t + nw, t2 = t1 + nw, t3 = t2 + nw;
        const int k1 = t1 < a.nrows ? t1 : lastrow, k2 = t2 < a.nrows ? t2 : lastrow, k3 = t3 < a.nrows ? t3 : lastrow;
        P7C_ISSUE(Bv, Bh, k1, 1, k2);
        P7C_COMPUTE(Av, Ah, t, true);
        P7C_ISSUE(Av, Ah, k2, 0, k3);
        P7C_COMPUTE(Bv, Bh, k1, (t1 < a.nrows));
        t = t2;
    }
#undef P7C_PREF
#undef P7C_ISSUE
#undef P7C_COMPUTE
}
__device__ __forceinline__ void phase_p7d(const int* __restrict__ PART, const unsigned* __restrict__ EG, const float* __restrict__ US, const float* __restrict__ VS, const float* __restrict__ HS, unsigned* __restrict__ WE, int nrows, int vb, int nvb) {
    int tid_ = threadIdx.x; asm volatile("" : "+v"(tid_));
    typedef int i32x4 __attribute__((ext_vector_type(4)));
    const size_t n16 = (size_t)nrows * 16, pstride4 = n16;
    const u32x4* P4 = (const u32x4*)PART; const u32x4* EG4 = (const u32x4*)EG; u32x4* WE4 = (u32x4*)WE;
    for (size_t j = (size_t)vb * 512 + tid_; j < n16; j += (size_t)nvb * 512) {
        const size_t row = j >> 4; const int P = (int)(j >> 1) & 7, gq = (int)j & 1;
        i32x4 slo = {0, 0, 0, 0}, shi = {0, 0, 0, 0};
#pragma unroll
        for (int p = 0; p < 8; ++p) { const u32x4 d = P4[p * pstride4 + j];
#pragma unroll
            for (int k = 0; k < 4; ++k) { slo[k] += (int)(d[k] << 16) >> 16; shi[k] += (int)d[k] >> 16; } }
        const float hs = HS[row] * 16.f;
#pragma unroll
        for (int half = 0; half < 2; ++half) {
            const size_t ei = row * 32 + 4 * P + 2 * half + gq;
            const u32x4 eg = EG4[ei]; u32x4 o;
#pragma unroll
            for (int k = 0; k < 4; ++k) { const int eid = (int)(eg[k] >> 16);
                const float av = (float)(half ? shi[k] : slo[k]) * US[eid] * hs;
                const float wv = __uint_as_float(eg[k] << 16) * gelu_fast(av) * VS[eid];
                o[k] = (eg[k] & 0xffff0000u) | (cvt_pk_bf16(wv, 0.f) & 0xffffu); }
            WE4[ei] = o;
        }
    }
}
struct P7BArgs { const unsigned* WE; const unsigned char* V8; bf16_t* XB; const float* gate2; int nrows; };
template <int PM>
__device__ __forceinline__ void phase_p7b(LAS unsigned char* lds, const P7BArgs& a, int part, int prank, int nvb) {
    int tid_ = threadIdx.x; asm volatile("" : "+v"(tid_));
    const int lane = tid_ & 63, wid = __builtin_amdgcn_readfirstlane(tid_ >> 6);
    const int nw = (nvb >> 3) * 8, wrank = prank * 8 + wid;
    LAS unsigned* tab = (LAS unsigned*)(lds + wid * 1024);
    const int grp = lane >> 3, c16 = (lane & 7) * 16;
    const unsigned char* vbase = a.V8 + 128 * part + c16;
    const int colofs = 128 * part + c16 + 8 * (lane >> 5) + 4 * ((lane >> 4) & 1) + 2 * ((lane >> 3) & 1);
    u32x4 Av[16], Bv[16]; float Aw[16], Bw[16]; unsigned Ax, Bx; f32x2 Ag, Bg;
    unsigned pw0 = 0u, pw1 = 0u;
#define P7B_PREF(t) do { pw0 = a.WE[(size_t)(t) * 128 + lane]; pw1 = a.WE[(size_t)(t) * 128 + 64 + lane]; } while (0)
#define P7B_ISSUE(X, Xw, Xx, Xg, t, slot, tnext) do { LAS unsigned* tb_ = tab + (slot) * 128; \
        tb_[lane] = pw0; tb_[64 + lane] = pw1; \
        asm volatile("s_waitcnt lgkmcnt(0)" ::: "memory"); \
        _Pragma("unroll") for (int i_ = 0; i_ < 16; ++i_) { const unsigned we_ = tb_[8 * i_ + grp]; Xw[i_] = __uint_as_float(we_ << 16); if (PM != 2) X[i_] = *(const u32x4*)(vbase + (size_t)(we_ >> 16) * 1024); else X[i_] = (u32x4){we_, 0x38383838u, 0x38383838u, 0x38383838u}; } \
        { const int mr_ = (t) >= NL ? 32 : (t) / S; \
          Xx = *(const unsigned*)(a.XB + (size_t)(t) * 1024 + colofs); Xg = *(const f32x2*)(a.gate2 + (size_t)mr_ * 6144 + colofs); } \
        P7B_PREF(tnext); } while (0)
#define P7B_COMPUTE(X, Xw, Xx, Xg, t, valid) do { f32x2 acc2[8]; \
        _Pragma("unroll") for (int k = 0; k < 8; ++k) acc2[k] = (f32x2){0.f, 0.f}; \
        if (PM != 1) { _Pragma("unroll") for (int i_ = 0; i_ < 16; ++i_) p7_axpy(X[i_], Xw[i_], acc2); } else { _Pragma("unroll") for (int i_ = 0; i_ < 16; ++i_) acc2[i_ >> 1][i_ & 1] = __uint_as_float((X[i_][0] ^ X[i_][1] ^ X[i_][2] ^ X[i_][3]) & 0x3fffffffu) + Xw[i_]; } \
        float b_[8]; _Pragma("unroll") for (int k = 0; k < 8; ++k) { auto s_ = __builtin_amdgcn_permlane32_swap(__float_as_uint(acc2[k >> 1][k & 1]), __float_as_uint(acc2[(k + 8) >> 1][k & 1]), false, false); b_[k] = __uint_as_float(s_[0]) + __uint_as_float(s_[1]); } \
        float c_[4]; _Pragma("unroll") for (int k = 0; k < 4; ++k) { auto s_ = __builtin_amdgcn_permlane16_swap(__float_as_uint(b_[k]), __float_as_uint(b_[k + 4]), false, false); c_[k] = __uint_as_float(s_[0]) + __uint_as_float(s_[1]); } \
        float d_[2]; _Pragma("unroll") for (int k = 0; k < 2; ++k) { const float send_ = (lane & 8) ? c_[k] : c_[k + 2]; const float keep_ = (lane & 8) ? c_[k + 2] : c_[k]; d_[k] = keep_ + DPPF(send_, 0x128); } \
        unsigned* xp_ = (unsigned*)(a.XB + (size_t)(t) * 1024 + colofs); \
        f32x2 x_ = {__uint_as_float(Xx << 16), __uint_as_float(Xx & 0xffff0000u)}; x_.x += Xg.x * d_[0]; x_.y += Xg.y * d_[1]; if ((valid) && PM == 0) *xp_ = cvt_pk_bf16(x_.x, x_.y); else if (PM != 0 && x_.x == 1.2345e30f) *xp_ = cvt_pk_bf16(x_.x, x_.y); } while (0)
    const int lastrow = a.nrows - 1;
    int t = wrank;
    P7B_PREF(t);
    P7B_ISSUE(Av, Aw, Ax, Ag, t, 0, (t + nw < a.nrows ? t + nw : lastrow));
    while (t < a.nrows) {
        const int t1 = t + nw, t2 = t1 + nw, t3 = t2 + nw;
        const int c1 = t1 < a.nrows ? t1 : lastrow, c2 = t2 < a.nrows ? t2 : lastrow, c3 = t3 < a.nrows ? t3 : lastrow;
        P7B_ISSUE(Bv, Bw, Bx, Bg, c1, 1, c2);
        P7B_COMPUTE(Av, Aw, Ax, Ag, t, true);
        P7B_ISSUE(Av, Aw, Ax, Ag, c2, 0, c3);
        P7B_COMPUTE(Bv, Bw, Bx, Bg, c1, (t1 < a.nrows));
        t = t2;
    }
#undef P7B_PREF
#undef P7B_ISSUE
#undef P7B_COMPUTE
}
__device__ __forceinline__ void phase_final_norm(const bf16_t* __restrict__ XBp, float* __restrict__ OUT, const float* __restrict__ g, int vb, int nvb) {
    int tid_ = threadIdx.x; asm volatile("" : "+v"(tid_));
    const int lane = tid_ & 63, wid = tid_ >> 6;
    for (int row = vb * 8 + wid; row < NL; row += nvb * 8) {
        const bf16_t* xp = XBp + (size_t)row * 1024; f32x4 x[4]; float ss = 0.f;
#pragma unroll
        for (int i = 0; i < 4; ++i) { const u32x2 r = *(const u32x2*)(xp + 256 * i + 4 * lane); x[i] = (f32x4){__uint_as_float(r.x << 16), __uint_as_float(r.x & 0xffff0000u), __uint_as_float(r.y << 16), __uint_as_float(r.y & 0xffff0000u)};
            ss += x[i][0] * x[i][0] + x[i][1] * x[i][1] + x[i][2] * x[i][2] + x[i][3] * x[i][3]; }
        ss = wave_sum(ss); const float rstd = rsqrtf(ss * (1.f / 1024.f) + EPS);
#pragma unroll
        for (int i = 0; i < 4; ++i) *(f32x4*)(OUT + (size_t)row * 1024 + 256 * i + 4 * lane) = x[i] * rstd * *(const f32x4*)(g + 256 * i + 4 * lane);
    }
}

template <int V_> struct IC { static constexpr int value = V_; };
typedef short s16x4 __attribute__((ext_vector_type(4)));
__device__ __forceinline__ s16x4 lds_tr16(const LAS unsigned char* p) { return __builtin_bit_cast(s16x4, __builtin_amdgcn_ds_read_tr16_b64_v4i16((LAS s16x4*)p)); }
constexpr int ATT_BUF = 20480;
template <int DK>
__device__ __forceinline__ void attn_unit(LAS unsigned char* lds, const bf16_t* __restrict__ Q, const bf16_t* __restrict__ K1, const bf16_t* __restrict__ K2, const bf16_t* __restrict__ V,
                                          int nkeys, float c2, bf16_t* __restrict__ out) {
    int tid_ = threadIdx.x; asm volatile("" : "+v"(tid_));
    const int tid = tid_, lane = tid & 63, wid = __builtin_amdgcn_readfirstlane(tid >> 6), r32 = lane & 31, hi = lane >> 5;
    constexpr int NS = DK / 16;
    bf16x8 qf[NS];
    { const bf16_t* qp = Q + (size_t)(wid * 32 + r32) * DK + 8 * hi;
#pragma unroll
      for (int s = 0; s < NS; ++s) qf[s] = *(const bf16x8*)(qp + 16 * s); }
    const int skey = tid >> 3, sch = tid & 7;
    const unsigned st_k1 = skey * 128 + ((sch ^ ((skey >> 1) & 7)) << 4);
    const unsigned st_v = 8192 + skey * 128 + (((sch << 4)) ^ (((skey >> 1) & 1) << 6));
    const int skey2 = (tid & 255) >> 2, sch2 = tid & 3;
    const unsigned st_k2 = 16384 + skey2 * 64 + ((sch2 ^ ((skey2 >> 2) & 3)) << 4);
    const bf16_t* gk1 = K1 + (size_t)skey * 64 + sch * 8; const bf16_t* gv = V + (size_t)skey * 64 + sch * 8;
    const bf16_t* gk2 = (DK == 96) ? K2 + (size_t)skey2 * 32 + sch2 * 8 : nullptr;
    unsigned ka[2][4];
#pragma unroll
    for (int kt = 0; kt < 2; ++kt)
#pragma unroll
        for (int s = 0; s < 4; ++s) { const int key = 32 * kt + r32; ka[kt][s] = key * 128 + (((2 * s + hi) ^ ((key >> 1) & 7)) << 4); }
    unsigned kb[2][2];
#pragma unroll
    for (int kt = 0; kt < 2; ++kt)
#pragma unroll
        for (int s = 0; s < 2; ++s) { const int key = 32 * kt + r32; kb[kt][s] = 16384 + key * 64 + (((2 * s + hi) ^ ((key >> 2) & 3)) << 4); }
    const int vq = (lane & 15) >> 2, vp = lane & 3, vg = (lane >> 4) & 1;
    unsigned va[2];
#pragma unroll
    for (int dvb = 0; dvb < 2; ++dvb) { const int key = 4 * hi + vq; va[dvb] = 8192 + key * 128 + ((((32 * dvb + 16 * vg + 4 * vp) * 2)) ^ (((key >> 1) & 1) << 6)); }
    float m = 0.f, l = 0.f;
    f32x16 o0 = {}, o1 = {}, negm = {};
    const int NT = nkeys >> 6;
    u32x4 sa1, sav, sa2, sb1, sbv, sb2;
    sa1 = *(const u32x4*)gk1; sav = *(const u32x4*)gv; if (DK == 96) sa2 = *(const u32x4*)gk2;
    *(LAS u32x4*)(lds + st_k1) = sa1; *(LAS u32x4*)(lds + st_v) = sav; if (DK == 96) *(LAS u32x4*)(lds + st_k2) = sa2;
    sb1 = *(const u32x4*)(gk1 + (size_t)4096); sbv = *(const u32x4*)(gv + (size_t)4096); if (DK == 96) sb2 = *(const u32x4*)(gk2 + (size_t)2048);
    __syncthreads();
    auto tile = [&](auto cur_, int t, u32x4& l1, u32x4& lv, u32x4& l2, const u32x4& w1, const u32x4& wv, const u32x4& w2) __attribute__((always_inline)) {
        constexpr int CUR = decltype(cur_)::value;
        LAS unsigned char* buf = lds + CUR * ATT_BUF;
        { const int tn = t + 2 < NT ? t + 2 : NT - 1;
          l1 = *(const u32x4*)(gk1 + (size_t)tn * 4096); lv = *(const u32x4*)(gv + (size_t)tn * 4096); if (DK == 96) l2 = *(const u32x4*)(gk2 + (size_t)tn * 2048); }
        bf16x8 kf0[NS], kf1[NS];
#pragma unroll
        for (int s = 0; s < 4; ++s) { kf0[s] = *(const LAS bf16x8*)(buf + ka[0][s]); kf1[s] = *(const LAS bf16x8*)(buf + ka[1][s]); }
        if (DK == 96) {
#pragma unroll
            for (int s = 0; s < 2; ++s) { kf0[4 + s] = *(const LAS bf16x8*)(buf + kb[0][s]); kf1[4 + s] = *(const LAS bf16x8*)(buf + kb[1][s]); }
        }
        __builtin_amdgcn_sched_barrier(0);
        f32x16 p0 = mfma32(kf0[0], qf[0], negm), p1 = mfma32(kf1[0], qf[0], negm);
#pragma unroll
        for (int s = 1; s < NS; ++s) { p0 = mfma32(kf0[s], qf[s], p0); p1 = mfma32(kf1[s], qf[s], p1); }
        __builtin_amdgcn_sched_barrier(0);
        s16x4 vlo[2][2][2], vhi[2][2][2];
#pragma unroll
        for (int kt = 0; kt < 2; ++kt)
#pragma unroll
            for (int sp = 0; sp < 2; ++sp) { const int kofs = (32 * kt + 16 * sp) * 128;
#pragma unroll
                for (int dvb = 0; dvb < 2; ++dvb) { vlo[dvb][kt][sp] = lds_tr16(buf + va[dvb] + kofs); vhi[dvb][kt][sp] = lds_tr16(buf + va[dvb] + kofs + 8 * 128); } }
        __builtin_amdgcn_sched_barrier(0);
        float mx = p0[0];
#pragma unroll
        for (int r = 1; r < 16; ++r) mx = fmaxf(mx, p0[r]);
#pragma unroll
        for (int r = 0; r < 16; ++r) mx = fmaxf(mx, p1[r]);
        { auto rr = __builtin_amdgcn_permlane32_swap(__float_as_uint(mx), __float_as_uint(mx), false, false); mx = fmaxf(__uint_as_float(rr[0]), __uint_as_float(rr[1])); }
        if (t == 0 || __any(mx > 8.f)) {
            const float dn = (t == 0) ? mx : fmaxf(mx, 0.f), al = (t == 0) ? 1.f : __builtin_amdgcn_exp2f(-dn); m += dn; l *= al;
#pragma unroll
            for (int r = 0; r < 16; ++r) { o0[r] *= al; o1[r] *= al; p0[r] -= dn; p1[r] -= dn; negm[r] = -m; }
            asm volatile("" : "+v"(negm));
        }
        f32x2 ls2 = {0.f, 0.f};
#pragma unroll
        for (int r = 0; r < 16; ++r) { p0[r] = __builtin_amdgcn_exp2f(p0[r]); p1[r] = __builtin_amdgcn_exp2f(p1[r]); }
#pragma unroll
        for (int r = 0; r < 16; r += 2) { ls2 += (f32x2){p0[r], p0[r + 1]}; ls2 += (f32x2){p1[r], p1[r + 1]}; }
        const float ls = ls2.x + ls2.y;
        l += ls;
        bf16x8 pf[2][2];
#pragma unroll
        for (int sp = 0; sp < 2; ++sp) { u32x4 a, b;
            a.x = cvt_pk_bf16(p0[8 * sp], p0[8 * sp + 1]); a.y = cvt_pk_bf16(p0[8 * sp + 2], p0[8 * sp + 3]); a.z = cvt_pk_bf16(p0[8 * sp + 4], p0[8 * sp + 5]); a.w = cvt_pk_bf16(p0[8 * sp + 6], p0[8 * sp + 7]);
            b.x = cvt_pk_bf16(p1[8 * sp], p1[8 * sp + 1]); b.y = cvt_pk_bf16(p1[8 * sp + 2], p1[8 * sp + 3]); b.z = cvt_pk_bf16(p1[8 * sp + 4], p1[8 * sp + 5]); b.w = cvt_pk_bf16(p1[8 * sp + 6], p1[8 * sp + 7]);
            pf[0][sp] = __builtin_bit_cast(bf16x8, a); pf[1][sp] = __builtin_bit_cast(bf16x8, b); }
        __builtin_amdgcn_sched_barrier(0);
#pragma unroll
        for (int kt = 0; kt < 2; ++kt)
#pragma unroll
            for (int sp = 0; sp < 2; ++sp) {
                { const s16x4 lo = vlo[0][kt][sp], hi4 = vhi[0][kt][sp]; const bf16x8 vf = (bf16x8){lo[0], lo[1], lo[2], lo[3], hi4[0], hi4[1], hi4[2], hi4[3]}; o0 = mfma32(vf, pf[kt][sp], o0); }
                { const s16x4 lo = vlo[1][kt][sp], hi4 = vhi[1][kt][sp]; const bf16x8 vf = (bf16x8){lo[0], lo[1], lo[2], lo[3], hi4[0], hi4[1], hi4[2], hi4[3]}; o1 = mfma32(vf, pf[kt][sp], o1); } }
        __builtin_amdgcn_sched_barrier(0);
        { LAS unsigned char* nb = lds + (CUR ^ 1) * ATT_BUF;
          *(LAS u32x4*)(nb + st_k1) = w1; *(LAS u32x4*)(nb + st_v) = wv; if (DK == 96) *(LAS u32x4*)(nb + st_k2) = w2; }
        __syncthreads();
    };
    for (int t = 0; t < NT; t += 2) {
        tile(IC<0>{}, t, sa1, sav, sa2, sb1, sbv, sb2);
        tile(IC<1>{}, t + 1, sb1, sbv, sb2, sa1, sav, sa2);
    }
    { auto rr = __builtin_amdgcn_permlane32_swap(__float_as_uint(l), __float_as_uint(l), false, false); l = __uint_as_float(rr[0]) + __uint_as_float(rr[1]); }
    const float il = 1.f / l;
    bf16_t* op = out + (size_t)(wid * 32 + r32) * 1024 + 4 * hi;
#pragma unroll
    for (int g = 0; g < 4; ++g) { u32x2 a, b;
        a.x = cvt_pk_bf16(o0[4 * g] * il, o0[4 * g + 1] * il); a.y = cvt_pk_bf16(o0[4 * g + 2] * il, o0[4 * g + 3] * il);
        b.x = cvt_pk_bf16(o1[4 * g] * il, o1[4 * g + 1] * il); b.y = cvt_pk_bf16(o1[4 * g + 2] * il, o1[4 * g + 3] * il);
        *(u32x2*)(op + 8 * g) = a; *(u32x2*)(op + 32 + 8 * g) = b; }
}
__device__ __forceinline__ void phase_p3(LAS unsigned char* lds, const WS& w, int l, int vb, int nvb) {
    const float c2g = 0.125f * 1.4426950408889634f, c2m = 0.10206207261596577f * 1.4426950408889634f;
    bf16_t* MIX = w.H();
    const int nlat = NB * 12 * 8, nctx = (l == 0) ? NB * 12 : 0;
    for (int u = vb; u < nlat + nctx; u += nvb) {
        if (u < nlat) {
            const int qb = u & 7, slot = (u >> 3) % 12, b = u / 96;
            bf16_t* out = MIX + ((size_t)b * S + qb * 256) * 1024;
            if (slot < 6) attn_unit<64>(lds, w.Qg() + (((size_t)b * 6 + slot) * S + qb * 256) * 64, w.Kg() + ((size_t)b * 2 + slot / 3) * KEYS * 64, nullptr, w.Vg() + ((size_t)b * 2 + slot / 3) * KEYS * 64, KEYS, c2g, out + slot * 64);
            else { const int h = slot - 6; attn_unit<96>(lds, w.Qm() + (((size_t)b * 6 + h) * S + qb * 256) * 96, w.Kmn() + ((size_t)b * 6 + h) * KEYS * 64, w.KR() + (size_t)b * KEYS * 32, w.Vm() + ((size_t)b * 6 + h) * KEYS * 64, KEYS, c2m, out + 640 + h * 64); }
        } else {
            const int v = u - nlat, slot = v % 12, b = v / 12;
            bf16_t* out = MIX + ((size_t)NL + (size_t)b * CTX) * 1024;
            if (slot < 6) attn_unit<64>(lds, w.Qgc() + ((size_t)b * 6 + slot) * CTX * 64, w.Kg() + ((size_t)b * 2 + slot / 3) * KEYS * 64, nullptr, w.Vg() + ((size_t)b * 2 + slot / 3) * KEYS * 64, CTX, c2g, out + slot * 64);
            else { const int h = slot - 6; attn_unit<96>(lds, w.Qmc() + ((size_t)b * 6 + h) * CTX * 96, w.Kmn() + ((size_t)b * 6 + h) * KEYS * 64, w.KR() + (size_t)b * KEYS * 32, w.Vm() + ((size_t)b * 6 + h) * KEYS * 64, CTX, c2m, out + 640 + h * 64); }
        }
    }
}

__device__ __forceinline__ unsigned fkey(float f, unsigned tag, unsigned mask) { return (__float_as_uint(f) & ~mask) | tag; }
__device__ __forceinline__ float keyf(unsigned k, unsigned mask) { return __uint_as_float(k & ~mask); }
__device__ __forceinline__ unsigned fmax_u(unsigned a, unsigned b) { unsigned r; asm("v_max_f32 %0, %1, %2" : "=v"(r) : "v"(a), "v"(b)); return r; }
__device__ __forceinline__ unsigned fmin_u(unsigned a, unsigned b) { unsigned r; asm("v_min_f32 %0, %1, %2" : "=v"(r) : "v"(a), "v"(b)); return r; }
__device__ __forceinline__ void ce_desc(unsigned& a, unsigned& b) { const unsigned hi_ = fmax_u(a, b), lo_ = fmin_u(a, b); a = hi_; b = lo_; }
template <int J> __device__ __forceinline__ void bstage16(unsigned* a) {
#pragma unroll
    for (int i = 0; i < 16; ++i) { const int l = i ^ J; if (l > i) ce_desc(a[i], a[l]); }
}
__device__ __forceinline__ void sort16_desc(unsigned* a) {
#define CE_(i, j) ce_desc(a[i], a[j]);
    CE_(0, 13) CE_(1, 12) CE_(2, 15) CE_(3, 14) CE_(4, 8) CE_(5, 6) CE_(7, 11) CE_(9, 10)
    CE_(0, 5) CE_(1, 7) CE_(2, 9) CE_(3, 4) CE_(6, 13) CE_(8, 14) CE_(10, 15) CE_(11, 12)
    CE_(0, 1) CE_(2, 3) CE_(4, 5) CE_(6, 8) CE_(7, 9) CE_(10, 11) CE_(12, 13) CE_(14, 15)
    CE_(0, 2) CE_(1, 3) CE_(4, 10) CE_(5, 11) CE_(6, 7) CE_(8, 9) CE_(12, 14) CE_(13, 15)
    CE_(1, 2) CE_(3, 12) CE_(4, 6) CE_(5, 7) CE_(8, 10) CE_(9, 11) CE_(13, 14)
    CE_(1, 4) CE_(2, 6) CE_(5, 8) CE_(7, 10) CE_(9, 13) CE_(11, 14)
    CE_(2, 4) CE_(3, 6) CE_(9, 12) CE_(11, 13)
    CE_(3, 5) CE_(6, 8) CE_(7, 9) CE_(10, 12)
    CE_(3, 4) CE_(5, 6) CE_(7, 8) CE_(9, 10) CE_(11, 12)
    CE_(6, 7) CE_(8, 9)
#undef CE_
}
__device__ __forceinline__ void bmerge16_desc(unsigned* c) { bstage16<8>(c); bstage16<4>(c); bstage16<2>(c); bstage16<1>(c); }
__device__ __forceinline__ void merge_top16(unsigned* a, const unsigned* b) {
#pragma unroll
    for (int i = 0; i < 16; ++i) a[i] = fmax_u(a[i], b[15 - i]);
    bmerge16_desc(a);
}
__device__ __forceinline__ void xlane_top16(unsigned* t, int hi) {
    unsigned r[16]; const unsigned msk = 0u - (unsigned)hi;
#pragma unroll
    for (int i = 0; i < 16; ++i) r[i] = t[i] ^ ((t[i] ^ t[15 - i]) & msk);
#pragma unroll
    for (int i = 0; i < 16; ++i) { auto s = __builtin_amdgcn_permlane32_swap(r[i], r[i], false, false); t[i] = fmax_u(s[0], s[1]); }
    bmerge16_desc(t);
}
__device__ __forceinline__ constexpr int cand_a(int c) { return c < 16 ? 0 : c < 24 ? 1 : c < 32 ? 39 - c : c < 37 ? 2 : c < 41 ? 3 : c < 44 ? 4 : c < 46 ? 5 : c < 48 ? 6 : 7; }
__device__ __forceinline__ constexpr int cand_b(int c) { return c < 16 ? c : c < 24 ? c - 16 : c < 32 ? 0 : c < 37 ? c - 32 : c < 41 ? c - 37 : c < 44 ? c - 41 : c < 46 ? c - 44 : c < 48 ? c - 46 : c - 48; }

__device__ __forceinline__ void phase_p6b(LAS unsigned char* lds, const bf16_t* __restrict__ PQ, const bf16_t* __restrict__ SubKl, unsigned* __restrict__ EG, int nrows, int vb, int nvb) {
    int tid_ = threadIdx.x; asm volatile("" : "+v"(tid_));
    const int tid = tid_, lane = tid & 63, wid = __builtin_amdgcn_readfirstlane(tid >> 6), r32 = lane & 31, hi = lane >> 5;
    const int h = vb & 7, wrank = (vb >> 3) * 8 + wid, nwr = (nvb >> 3) * 8;
    LAS unsigned short* tab = (LAS unsigned short*)(lds + 65536 + wid * 4096) + r32 * 64;
#pragma unroll
    for (int i = 0; i < 8; ++i) { const int idx = i * 512 + tid, p = idx >> 11, key = (idx >> 4) & 127, ch = idx & 15;
        *(LAS u32x4*)(lds + p * 32768 + key * 256 + ((ch ^ (key & 15)) << 4)) = *(const u32x4*)(SubKl + ((size_t)(h * 2 + p) * 128 + key) * 128 + ch * 8); }
    __syncthreads();
    const int ngroups = nrows >> 5;
    for (int tg = wrank; tg < ngroups; tg += nwr) {
        const int row0 = tg << 5;
        bf16x8 qf[2][8];
        { const bf16_t* qp = PQ + (size_t)(row0 + r32) * 2048 + h * 256 + 8 * hi; asm volatile("" : "+v"(qp));
#pragma unroll
          for (int p = 0; p < 2; ++p)
#pragma unroll
              for (int s = 0; s < 8; ++s) qf[p][s] = *(const bf16x8*)(qp + p * 128 + 16 * s); }
        unsigned top[2][16];
#pragma unroll
        for (int p = 0; p < 2; ++p) {
            f32x16 acc[4];
#pragma unroll
            for (int kt = 0; kt < 4; ++kt) { acc[kt] = f32x16{}; const int key = 32 * kt + r32;
#pragma unroll
                for (int s = 0; s < 8; ++s) acc[kt] = mfma32(*(const LAS bf16x8*)(lds + p * 32768 + key * 256 + (((2 * s + hi) ^ (key & 15)) << 4)), qf[p][s], acc[kt]); }
            unsigned key[64];
#pragma unroll
            for (int kt = 0; kt < 4; ++kt)
#pragma unroll
                for (int r = 0; r < 16; ++r) { const int n = 32 * kt + (r & 3) + 8 * (r >> 2) + 4 * hi; key[16 * kt + r] = fkey(acc[kt][r], 127u - (unsigned)n, 127u); }
            sort16_desc(key); sort16_desc(key + 16); sort16_desc(key + 32); sort16_desc(key + 48);
            merge_top16(key, key + 16); merge_top16(key + 32, key + 48); merge_top16(key, key + 32);
            xlane_top16(key, hi);
#pragma unroll
            for (int i = 0; i < 16; ++i) top[p][i] = key[i];
        }
        float t0f[16], t1f[16];
#pragma unroll
        for (int i = 0; i < 16; ++i) { t0f[i] = keyf(top[0][i], 127u); t1f[i] = keyf(top[1][i], 127u); }
        unsigned ck[50];
#pragma unroll
        for (int c = 0; c < 50; ++c) ck[c] = fkey(t0f[cand_a(c)] + t1f[cand_b(c)], (unsigned)c, 63u);
        if (hi == 0) {
#pragma unroll
            for (int c = 0; c < 50; c += 2) {
                const unsigned ea = (127u - (top[0][cand_a(c)] & 127u)) * 128u + (127u - (top[1][cand_b(c)] & 127u));
                const unsigned eb = (127u - (top[0][cand_a(c + 1)] & 127u)) * 128u + (127u - (top[1][cand_b(c + 1)] & 127u));
                *(LAS unsigned*)(tab + c) = ea | (eb << 16);
            }
        }
        bmerge16_desc(ck + 16); sort16_desc(ck + 32);
        merge_top16(ck, ck + 16); merge_top16(ck, ck + 32);
        ck[15] = fmax_u(ck[15], ck[48]); ck[14] = fmax_u(ck[14], ck[49]); bmerge16_desc(ck);
        asm volatile("s_waitcnt lgkmcnt(0)" ::: "memory");
        const float mx = keyf(ck[0], 63u); float e[16], den = 0.f;
#pragma unroll
        for (int j = 0; j < 16; ++j) { e[j] = __builtin_amdgcn_exp2f((keyf(ck[j], 63u) - mx) * 1.4426950408889634f); den += e[j]; }
        const float iden = 1.f / den;
        if (hi == 0) {
            unsigned o[16];
#pragma unroll
            for (int j = 0; j < 16; ++j) { const unsigned eid = tab[ck[j] & 63u]; o[j] = (eid << 16) | (cvt_pk_bf16(e[j] * iden, 0.f) & 0xffffu); }
            unsigned* dst = EG + (size_t)(row0 + r32) * 128 + h * 16;
#pragma unroll
            for (int j = 0; j < 16; j += 4) *(u32x4*)(dst + j) = (u32x4){o[j], o[j + 1], o[j + 2], o[j + 3]};
        }
        asm volatile("s_waitcnt lgkmcnt(0)" ::: "memory");
    }
}


#define XB_TMO      128
#define XB_XCNT(j)  (256  + 64 * (j))
#define XB_XSUB(j)  (1280 + 64 * (j))
#define XB_XGEN(j)  (2304 + 64 * (j))
#define XB_TOP      3328
#define XB_TOPGEN   3392
#define XCD_BAR_WORDS 3456
#define XB_SPIN_CAP (1u << 18)

__device__ __forceinline__ unsigned xb_ld(unsigned* p)              { return __hip_atomic_load(p, __ATOMIC_RELAXED, __HIP_MEMORY_SCOPE_AGENT); }
__device__ __forceinline__ unsigned xb_add(unsigned* p, unsigned v) { return __hip_atomic_fetch_add(p, v, __ATOMIC_RELAXED, __HIP_MEMORY_SCOPE_AGENT); }
__device__ __forceinline__ unsigned xb_xcc_id() { return (unsigned)__builtin_amdgcn_s_getreg((3 << 11) | 20) & 0xFu; }
#define XB_SPIN(cond, bar) do { unsigned _sp = 0; while (cond) { __builtin_amdgcn_s_sleep(1); \
    if ((++_sp & 255u) == 0u) { if (xb_ld(&(bar)[XB_TMO])) break; if (_sp > XB_SPIN_CAP) { atomicAdd(&(bar)[XB_TMO], 1u); break; } } } } while (0)

struct XcdBarrier {
    unsigned* bar; unsigned x;
    volatile LAS unsigned* st;
};

__device__ __forceinline__ XcdBarrier xcd_barrier_post(unsigned* bar, volatile LAS unsigned* st) {
    XcdBarrier b; b.bar = bar; b.x = xb_xcc_id(); b.st = st;
    if (threadIdx.x == 0) (void)xb_add(&bar[XB_XCNT(b.x)], 1u);
    return b;
}
__device__ __forceinline__ void xcd_barrier_complete(unsigned* bar, unsigned x, unsigned& nloc, unsigned& nx) {
    const unsigned G = gridDim.x * gridDim.y * gridDim.z;
    unsigned sum, cnt, mine, sp = 0u;
    for (;;) {
        sum = 0u; cnt = 0u; mine = 0u;
#pragma unroll
        for (unsigned j = 0; j < 16; ++j) { const unsigned c = xb_ld(&bar[XB_XCNT(j)]); sum += c; cnt += (c > 0u) ? 1u : 0u; mine = (j == x) ? c : mine; }
        if (sum == G) break;
        __builtin_amdgcn_s_sleep(1);
        if ((++sp & 255u) == 0u) { if (xb_ld(&bar[XB_TMO])) break; if (sp > XB_SPIN_CAP) { atomicAdd(&bar[XB_TMO], 1u); break; } }
    }
    nloc = mine > 0u ? mine : 1u; nx = cnt > 0u ? cnt : 1u;
}

__device__ __forceinline__ void xcd_barrier(const XcdBarrier& b) {
    asm volatile("s_waitcnt vmcnt(0)" ::: "memory");
    __syncthreads();
    if (threadIdx.x == 0) {
        unsigned* bar = b.bar;
        __builtin_amdgcn_s_waitcnt(0);
        unsigned nloc = b.st[0], nx = b.st[1];
        if (nloc == 0u) { xcd_barrier_complete(bar, b.x, nloc, nx); b.st[0] = nloc; b.st[1] = nx; }
        const unsigned old = xb_add(&bar[XB_XSUB(b.x)], 1u);
        const unsigned gen = old / nloc;
        if (old + 1u == (gen + 1u) * nloc) {
            __builtin_amdgcn_fence(__ATOMIC_RELEASE, "agent");
            asm volatile("s_waitcnt vmcnt(0)" ::: "memory");
            const unsigned og = xb_add(&bar[XB_TOP], 1u);
            const unsigned tg = og / nx;
            if (og + 1u == (tg + 1u) * nx) xb_add(&bar[XB_TOPGEN], 1u);
            else XB_SPIN(xb_ld(&bar[XB_TOPGEN]) == tg, bar);
            __builtin_amdgcn_fence(__ATOMIC_ACQUIRE, "agent");
            xb_add(&bar[XB_XGEN(b.x)], 1u);
            asm volatile("s_waitcnt vmcnt(0)" ::: "memory");
        } else {
            XB_SPIN(xb_ld(&bar[XB_XGEN(b.x)]) == gen, bar);
            __builtin_amdgcn_fence(__ATOMIC_ACQUIRE, "agent");
            asm volatile("s_waitcnt vmcnt(0)" ::: "memory");
        }
    }
    __syncthreads();
}

__device__ __forceinline__ void phase_mod(LAS unsigned char* lds, const Inputs& in, const WS& w, int vb) {
    if (vb >= 72) return;
    LAS float* sc = (LAS float*)lds;
    int tid_ = threadIdx.x; asm volatile("" : "+v"(tid_));
    const int tid = tid_, idx = vb * 512 + tid, rg = idx / 12288, ln = idx % 12288, l = ln / 6144, n = ln % 6144;
    float acc[11];
#pragma unroll
    for (int i = 0; i < 11; ++i) acc[i] = 0.f;
    const float* wp = in.ada_w + (size_t)l * 1024 * 6144 + n;
    for (int kc = 0; kc < 4; ++kc) {
        for (int i = tid; i < 33 * 256; i += 512) { const int r = i >> 8, k = kc * 256 + (i & 255); const float v = r < 32 ? in.c[(size_t)r * 1024 + k] : in.c_ctx[k]; sc[i] = v / (1.f + __expf(-v)); }
        __syncthreads();
        for (int k = 0; k < 256; ++k) { const float wv = wp[(size_t)(kc * 256 + k) * 6144];
#pragma unroll
            for (int i = 0; i < 11; ++i) acc[i] += sc[(rg * 11 + i) * 256 + k] * wv; }
        __syncthreads();
    }
    const float bias = in.ada_b[(size_t)l * 6144 + n];
#pragma unroll
    for (int i = 0; i < 11; ++i) w.MOD()[((size_t)l * 33 + rg * 11 + i) * 6144 + n] = acc[i] + bias;
}
__device__ __forceinline__ void phase_rope(const WS& w, int vb, int nvb) {
    int tid_ = threadIdx.x; asm volatile("" : "+v"(tid_));
    for (int i = vb * 512 + tid_; i < 2048 * 32; i += nvb * 512) {
        { const int t = i / 32, j = i % 32; const double inv = pow(10000.0, -(double)(j % 16) / 16.0); const double a = (double)(j < 16 ? t / 64 : t % 64) * inv; w.ROPA()[i] = make_float2((float)cos(a), (float)sin(a)); }
        if (i < 2048 * 16) { const int t = i / 16, j = i % 16; const double inv = pow(10000.0, -(double)(j % 8) / 8.0); const double a = (double)(j < 8 ? t / 64 : t % 64) * inv; w.ROPC()[i] = make_float2((float)cos(a), (float)sin(a)); }
    }
}

#ifndef PROBE_MASK
#define PROBE_MASK 0
#endif
#ifndef BENCH_MODE
#define BENCH_MODE 0
#endif
#if BENCH_MODE
__device__ __forceinline__ void phase_bench(float* sink) {
    int tid_ = threadIdx.x; asm volatile("" : "+v"(tid_));
    float x[16];
#pragma unroll
    for (int i = 0; i < 16; ++i) x[i] = (float)(tid_ + i) * 0.001f;
    f32x16 acc[4] = {};
    bf16x8 a = (bf16x8){(short)tid_, 1, 2, 3, 4, 5, 6, 7}, b = (bf16x8){7, 6, 5, 4, 3, 2, 1, (short)tid_};
#pragma nounroll
    for (int it = 0; it < ((BENCH_MODE & 7) ? 2048 : 0); ++it) {
#pragma unroll
        for (int k = 0; k < 8; ++k) {
            if (BENCH_MODE & 2) { acc[k & 3] = mfma32(a, b, acc[k & 3]); }
            __builtin_amdgcn_sched_barrier(0);
            if (BENCH_MODE & 1) { asm volatile("v_exp_f32 %0, -|%0|" : "+v"(x[2 * k])); asm volatile("v_exp_f32 %0, -|%0|" : "+v"(x[2 * k + 1])); }
            if (BENCH_MODE & 4) {
#pragma unroll
                for (int j = 0; j < 8; ++j) asm volatile("v_fma_f32 %0, %0, %0, %0" : "+v"(x[(2 * k + j) & 15]));
            }
            __builtin_amdgcn_sched_barrier(0);
        }
    }
    if (BENCH_MODE & 24) {
        const int lane = tid_ & 63, r32 = lane & 31, hi = lane >> 5;
        unsigned ka[2][4];
#pragma unroll
        for (int kt = 0; kt < 2; ++kt)
#pragma unroll
            for (int s_ = 0; s_ < 4; ++s_) { const int key = 32 * kt + r32; ka[kt][s_] = key * 128 + (((2 * s_ + hi) ^ ((key >> 1) & 7)) << 4); }
        const int vq = (lane & 15) >> 2, vp = lane & 3, vg = (lane >> 4) & 1;
        unsigned va[2];
#pragma unroll
        for (int dvb = 0; dvb < 2; ++dvb) { const int key = 4 * hi + vq; va[dvb] = 8192 + key * 128 + ((((32 * dvb + 16 * vg + 4 * vp) * 2)) ^ (((key >> 1) & 1) << 6)); }
        u32x4 kr[8]; u32x2 vr[16];
#pragma nounroll
        for (int it = 0; it < 2048; ++it) {
            if (BENCH_MODE & 8) {
#pragma unroll
                for (int kt = 0; kt < 2; ++kt)
#pragma unroll
                    for (int s_ = 0; s_ < 4; ++s_) asm volatile("ds_read_b128 %0, %1" : "=v"(kr[kt * 4 + s_]) : "v"(ka[kt][s_]));
            }
            if (BENCH_MODE & 16) {
#pragma unroll
                for (int q = 0; q < 4; ++q)
#pragma unroll
                    for (int dvb = 0; dvb < 2; ++dvb) { asm volatile("ds_read_b64_tr_b16 %0, %1" : "=v"(vr[q * 4 + dvb * 2]) : "v"(va[dvb] + q * 2048)); asm volatile("ds_read_b64_tr_b16 %0, %1 offset:1024" : "=v"(vr[q * 4 + dvb * 2 + 1]) : "v"(va[dvb] + q * 2048)); }
            }
            asm volatile("s_waitcnt lgkmcnt(0)" ::: "memory");
        }
        if (BENCH_MODE & 8) {
#pragma unroll
            for (int i = 0; i < 8; ++i) x[i] += __uint_as_float(kr[i][0] ^ kr[i][1] ^ kr[i][2] ^ kr[i][3]);
        }
        if (BENCH_MODE & 16) {
#pragma unroll
            for (int i = 0; i < 16; ++i) x[i] += __uint_as_float(vr[i][0] ^ vr[i][1]);
        }
    }
    float r = 0.f;
#pragma unroll
    for (int i = 0; i < 16; ++i) r += x[i];
#pragma unroll
    for (int k = 0; k < 4; ++k)
#pragma unroll
        for (int i = 0; i < 16; ++i) r += acc[k][i];
    if (r == 1.2345e30f) sink[tid_] = r;
}
#endif
struct MegaArgs { Inputs in; WS w; float* XL; unsigned* bar; };
constexpr int MEGA_LDS = 131072 + 16;
__global__ void __launch_bounds__(512, 2) k_mega(MegaArgs A) {
    LAS unsigned char* lds = (LAS unsigned char*)dyn_lds;
    const int vb = blockIdx.x, nvb = gridDim.x;
    volatile LAS unsigned* xbw = (volatile LAS unsigned*)(lds + 131072);
    if (threadIdx.x == 0) { xbw[0] = 0u; xbw[1] = 0u; xbw[2] = 0u; xbw[3] = 0u; }
    __syncthreads();
    XcdBarrier bar = xcd_barrier_post(A.bar, xbw);
    if (threadIdx.x == 0) xbw[2] = xb_add(&A.bar[3584 + 64 * bar.x], 1u);
    __syncthreads();
    const int xticket = __builtin_amdgcn_readfirstlane((int)xbw[2]);
    const WS& w = A.w; const Inputs& in = A.in;
    phase_mod(lds, in, w, vb);
    phase_rope(w, vb, nvb);
    phase_cvt(lds, in, w, vb, nvb);
    xcd_barrier(bar);
    phase_modulate<false>(in.x, in.ctx, nullptr, w.H(), in.norm1_g, w.MOD(), 0, NR, vb, nvb);
    xcd_barrier(bar);
#if (PROBE_MASK >> 0) & 1
    phase_mod(lds, in, w, vb);
    phase_rope(w, vb, nvb);
    phase_cvt(lds, in, w, vb, nvb);
    xcd_barrier(bar);
    phase_modulate<false>(in.x, in.ctx, nullptr, w.H(), in.norm1_g, w.MOD(), 0, NR, vb, nvb);
    xcd_barrier(bar);
#endif
#if BENCH_MODE
    phase_bench((float*)w.RSQ());
#endif
    int xpart = vb & 7, xrank = vb >> 3;
    { bool okx = (bar.x < 8u); for (unsigned j = 0; j < 8; ++j) okx = okx && (xb_ld(&A.bar[XB_XCNT(j)]) == (unsigned)(nvb >> 3));
      if (okx) { xpart = (int)bar.x; xrank = xticket; } }
    for (int l = 0; l < DEPTH; ++l) {
        const float* MODl = w.MOD() + (size_t)l * 33 * 6144;
        const bool last = (l == DEPTH - 1);
        const int MR = last ? NL : NR;
        phase_p1(lds, w, in, l, vb, nvb); xcd_barrier(bar);
#if (PROBE_MASK >> 1) & 1
        phase_p1(lds, w, in, l, vb, nvb); xcd_barrier(bar);
#endif
        phase_p2(lds, w, in, l, vb, nvb); xcd_barrier(bar);
#if (PROBE_MASK >> 12) & 7
        phase_p2(lds, w, in, l, vb, nvb, (PROBE_MASK >> 12) & 7); xcd_barrier(bar);
#endif
        phase_p3(lds, w, l, vb, nvb); xcd_barrier(bar);
#if (PROBE_MASK >> 3) & 1
        phase_p3(lds, w, l, vb, nvb); xcd_barrier(bar);
#endif
        phase_p4(lds, w, in, l, vb, nvb);
        xcd_barrier(bar);
#if (PROBE_MASK >> 4) & 1
        phase_p4(lds, w, in, l, vb, nvb);
        xcd_barrier(bar);
#endif
        if (l == 0) phase_modulate<false>(in.x, in.ctx, nullptr, w.H(), in.norm2_g + l * 1024, MODl, 3, MR, vb, nvb, w.H8(), w.HS(), w.PQ(), w.XB());
        else phase_modulate<true>(nullptr, nullptr, w.XB(), w.H(), in.norm2_g + l * 1024, MODl, 3, MR, vb, nvb, w.H8(), w.HS(), w.PQ(), w.XB());
        xcd_barrier(bar);
#if (PROBE_MASK >> 5) & 1
        phase_modulate<true>(nullptr, nullptr, w.XB(), w.H(), in.norm2_g + l * 1024, MODl, 3, MR, vb, nvb, w.H8(), w.HS()); xcd_barrier(bar);
#endif
        phase_p6a(lds, w, l, vb, nvb); xcd_barrier(bar);
#if (PROBE_MASK >> 6) & 1
        phase_p6a(lds, w, l, vb, nvb); xcd_barrier(bar);
#endif
        phase_p6b(lds, w.PQ(), w.SubK() + (size_t)l * 16 * 128 * 128, w.EG(), MR, vb, nvb); xcd_barrier(bar);
#if (PROBE_MASK >> 7) & 1
        phase_p6b(lds, w.PQ(), w.SubK() + (size_t)l * 16 * 128 * 128, w.EG(), MR, vb, nvb); xcd_barrier(bar);
#endif
        { P7CArgs a{w.H8(), w.EG(), w.U8() + (size_t)l * NE * 1024, (int*)w.PQ(), MR}; phase_p7c(lds, a, xpart, xrank, nvb); }
        xcd_barrier(bar);
#if (PROBE_MASK >> 8) & 1
        { P7CArgs a{w.H8(), w.EG(), w.U8() + (size_t)l * NE * 1024, (int*)w.PQ(), MR}; phase_p7c(lds, a, xpart, xrank, nvb); }
        xcd_barrier(bar);
#endif
        phase_p7d((const int*)w.PQ(), w.EG(), w.US() + (size_t)l * NE, w.VS() + (size_t)l * NE, w.HS(), w.WE(), MR, vb, nvb);
        xcd_barrier(bar);
#if (PROBE_MASK >> 9) & 1
        phase_p7d((const int*)w.PQ(), w.EG(), w.US() + (size_t)l * NE, w.VS() + (size_t)l * NE, w.HS(), w.WE(), MR, vb, nvb);
        xcd_barrier(bar);
#endif
        { P7BArgs a{w.WE(), w.V8() + (size_t)l * NE * 1024, w.XB(), MODl + 5 * 1024, MR}; phase_p7b<0>(lds, a, xpart, xrank, nvb); }
        xcd_barrier(bar);
#if (PROBE_MASK >> 10) & 3
        { P7BArgs a{w.WE(), w.V8() + (size_t)l * NE * 1024, w.XB(), MODl + 5 * 1024, MR}; phase_p7b<((PROBE_MASK >> 10) & 3)>(lds, a, xpart, xrank, nvb); }
        xcd_barrier(bar);
#endif
        if (last) phase_final_norm(w.XB(), A.XL, in.final_g, vb, nvb);
        else phase_modulate<true>(nullptr, nullptr, w.XB(), w.H(), in.norm1_g + (l + 1) * 1024, w.MOD() + (size_t)(l + 1) * 33 * 6144, 0, NR, vb, nvb);
        if (!last) xcd_barrier(bar);
    }
}

extern "C" void kernel_launch(void* const* d_in, const int* in_sizes, int n_in, void* d_out, int out_size, void* d_ws, size_t ws_size, hipStream_t stream) {
    const float* const* fin = (const float* const*)d_in;
    Inputs in{fin[0], fin[1], fin[2], fin[3], fin[4], fin[5], fin[6], fin[7], fin[8], fin[9], fin[10], fin[11], fin[12], fin[13], fin[14], fin[15], fin[16], fin[17], fin[18], fin[19], fin[20], fin[21], fin[22]};
    WS w = make_ws(d_ws);
    static int ok = 0;
    if (!ok) {
        if (hipFuncSetAttribute((const void*)k_mega, hipFuncAttributeMaxDynamicSharedMemorySize, MEGA_LDS) != hipSuccess) { ok = -1; }
        int per_cu = 0, cus = 0, dev = 0; (void)hipGetDevice(&dev); (void)hipDeviceGetAttribute(&cus, hipDeviceAttributeMultiprocessorCount, dev);
        if (hipOccupancyMaxActiveBlocksPerMultiprocessor(&per_cu, (const void*)k_mega, 512, MEGA_LDS) != hipSuccess || per_cu < 1 || cus < 256) ok = -1;
        if (ok == 0) ok = 1;
    }
    if (ok < 0) return;
    (void)hipMemsetAsync(d_ws, 0, 16384, stream);
    MegaArgs A{in, w, (float*)d_out, (unsigned*)d_ws};
    k_mega<<<256, 512, MEGA_LDS, stream>>>(A);
}
```

```cpp
#include <hip/hip_runtime.h>
#include <stdint.h>

typedef unsigned short bf16_t;

constexpr int D = 1024, NB = 32, S = 2048, CTX = 256, DEPTH = 2;
constexpr int NL = NB * S, NC = NB * CTX, NR = NL + NC;
constexpr int KEYS = CTX + S;
constexpr int INC = 1568;
constexpr int NE = 16384;
constexpr float EPS = 1e-6f;

__device__ __forceinline__ float bf2f(bf16_t v) { return __uint_as_float(((unsigned)v) << 16); }
__device__ __forceinline__ bf16_t f2bf(float f) { unsigned u = __float_as_uint(f); u += 0x7FFFu + ((u >> 16) & 1u); return (bf16_t)(u >> 16); }

__device__ __forceinline__ float wave_sum(float v) {
#pragma unroll
    for (int o = 32; o > 0; o >>= 1) v += __shfl_xor(v, o);
    return v;
}
__device__ __forceinline__ float gelu_tanh(float x) {
    const float u = 0.7978845608028654f * (x + 0.044715f * x * x * x);
    return 0.5f * x * (1.f + tanhf(u));
}

struct WS {
    char* base;
    __host__ __device__ __forceinline__ bf16_t* H() const { return (bf16_t*)(base + 65536ull); }
    __host__ __device__ __forceinline__ bf16_t* Qg() const { return (bf16_t*)(base + 151060480ull); }
    __host__ __device__ __forceinline__ bf16_t* Qgc() const { return (bf16_t*)(base + 201392128ull); }
    __host__ __device__ __forceinline__ bf16_t* Kg() const { return (bf16_t*)(base + 207683584ull); }
    __host__ __device__ __forceinline__ bf16_t* Vg() const { return (bf16_t*)(base + 226557952ull); }
    __host__ __device__ __forceinline__ bf16_t* CQ() const { return (bf16_t*)(base + 245432320ull); }
    __host__ __device__ __forceinline__ bf16_t* CKV() const { return (bf16_t*)(base + 302055424ull); }
    __host__ __device__ __forceinline__ bf16_t* Bp() const { return (bf16_t*)(base + 339804160ull); }
    __host__ __device__ __forceinline__ bf16_t* KR() const { return (bf16_t*)(base + 377552896ull); }
    __host__ __device__ __forceinline__ bf16_t* Qm() const { return (bf16_t*)(base + 382271488ull); }
    __host__ __device__ __forceinline__ bf16_t* Qmc() const { return (bf16_t*)(base + 457768960ull); }
    __host__ __device__ __forceinline__ bf16_t* Kmn() const { return (bf16_t*)(base + 467206144ull); }
    __host__ __device__ __forceinline__ bf16_t* Vm() const { return (bf16_t*)(base + 523829248ull); }
    __host__ __device__ __forceinline__ unsigned* EG() const { return (unsigned*)(base + 580452352ull); }
    __host__ __device__ __forceinline__ bf16_t* P() const { return (bf16_t*)(base + 382271488ull); }
    __host__ __device__ __forceinline__ bf16_t* PQ() const { return (bf16_t*)(base + 151060480ull); }
    __host__ __device__ __forceinline__ bf16_t* TMP() const { return (bf16_t*)(base + 65536ull); }
    __host__ __device__ __forceinline__ float* XC() const { return (float*)(base + 618201088ull); }
    __host__ __device__ __forceinline__ float* MOD() const { return (float*)(base + 651755520ull); }
    __host__ __device__ __forceinline__ float2* ROPA() const { return (float2*)(base + 653377536ull); }
    __host__ __device__ __forceinline__ float2* ROPC() const { return (float2*)(base + 653901824ull); }
    __host__ __device__ __forceinline__ float* RSQ() const { return (float*)(base + 654163968ull); }
    __host__ __device__ __forceinline__ float* RSKV() const { return (float*)(base + 654458880ull); }
    __host__ __device__ __forceinline__ bf16_t* WinT() const { return (bf16_t*)(base + 654753792ull); }
    __host__ __device__ __forceinline__ bf16_t* WuqT() const { return (bf16_t*)(base + 662093824ull); }
    __host__ __device__ __forceinline__ bf16_t* WukvT() const { return (bf16_t*)(base + 663273472ull); }
    __host__ __device__ __forceinline__ bf16_t* WoutT() const { return (bf16_t*)(base + 664059904ull); }
    __host__ __device__ __forceinline__ bf16_t* WqT() const { return (bf16_t*)(base + 668254208ull); }
    __host__ __device__ __forceinline__ bf16_t* SubK() const { return (bf16_t*)(base + 676642816ull); }
    __host__ __device__ __forceinline__ unsigned char* U8() const { return (unsigned char*)(base + 677691392ull); }
    __host__ __device__ __forceinline__ unsigned char* V8() const { return (unsigned char*)(base + 711245824ull); }
    __host__ __device__ __forceinline__ float* US() const { return (float*)(base + 744800256ull); }
    __host__ __device__ __forceinline__ float* VS() const { return (float*)(base + 744931328ull); }
    __host__ __device__ __forceinline__ float* SSQ() const { return (float*)(base + 745062400ull); }
    __host__ __device__ __forceinline__ float* SSKV() const { return (float*)(base + 747421696ull); }
    __host__ __device__ __forceinline__ unsigned* WE() const { return (unsigned*)(base + 748601344ull); }
    __host__ __device__ __forceinline__ signed char* H8() const { return (signed char*)(base + 786350080ull); }
    __host__ __device__ __forceinline__ float* HS() const { return (float*)(base + 861847552ull); }
    __host__ __device__ __forceinline__ bf16_t* PoolWT() const { return (bf16_t*)(base + 862142464ull); }
    __host__ __device__ __forceinline__ bf16_t* XB() const { return (bf16_t*)(base + 862208000ull); }
};
constexpr size_t WS_BYTES = 862208000ull + (size_t)NR * 1024 * 2;
static WS make_ws(void* d_ws) { WS w; w.base = (char*)d_ws; return w; }


#define LAS __attribute__((address_space(3)))
typedef short bf16x8 __attribute__((ext_vector_type(8)));
typedef float f32x4 __attribute__((ext_vector_type(4)));
typedef float f32x16 __attribute__((ext_vector_type(16)));
typedef unsigned u32x4 __attribute__((ext_vector_type(4)));
typedef unsigned u32x2 __attribute__((ext_vector_type(2)));

__device__ __forceinline__ f32x16 mfma32(bf16x8 a, bf16x8 b, f32x16 c) { return __builtin_amdgcn_mfma_f32_32x32x16_bf16(a, b, c, 0, 0, 0); }
__device__ __forceinline__ unsigned cvt_pk_bf16(float lo, float hi) { unsigned r; asm volatile("v_cvt_pk_bf16_f32 %0, %1, %2" : "=v"(r) : "v"(lo), "v"(hi)); return r; }

namespace pg8 {
constexpr int BM = 256, BK = 64, HALF = 128, HTB = HALF * BK * 2, STAGE_BYTES = 8 * HTB, NXCD = 8, WGM = 8;
__host__ __device__ __forceinline__ int lds_byte(int r, int c) { const int st = (r >> 4) * 2 + (c >> 5), rr = r & 15, cc = c & 31, ob = rr * 64 + cc * 2; return st * 1024 + (ob ^ (((ob >> 9) & 1) << 5)); }
__host__ __device__ __forceinline__ void stage_rc(int b, int& R, int& C) { const int st = b / 1024, sb = b % 1024, swz = sb ^ (((sb >> 9) & 1) << 5); R = (st >> 1) * 16 + swz / 64; C = (st & 1) * 32 + (swz % 64) / 2; }
__host__ __device__ __forceinline__ int perm32(int rho) { const int n = rho >> 4, i = rho & 15; return 8 * (i >> 2) + 4 * n + (i & 3); }
struct Unit { int pm, pn; };
struct Gemm { const bf16_t* A; const bf16_t* Bt; int M, N, K; };
struct StaticOrder {
    int nM, nN, nwg, G, c;
    __host__ __device__ void init(int M, int N, int G_, int c_) { nM = M / BM; nN = N / BM; nwg = nM * nN; G = G_; c = c_; }
    __host__ __device__ bool next(int i, Unit& u) const {
        const long L = (long)i * G + c; if (L >= nwg) return false;
        int wgid = (int)L; { const int q = nwg / NXCD, r = nwg % NXCD, xcd = wgid % NXCD, off = wgid / NXCD; wgid = (xcd < r ? xcd * (q + 1) : r * (q + 1) + (xcd - r) * q) + off; }
        const int nig = WGM * nN, gid = wgid / nig, fm = gid * WGM, gsz = (nM - fm) < WGM ? (nM - fm) : WGM;
        u.pm = fm + ((wgid % nig) % gsz); u.pn = (wgid % nig) / gsz; return true;
    }
};
template <class Epi, class Sched>
__device__ __forceinline__ void gemm_phase(LAS unsigned char* lds, const Gemm g, const Sched& S, const Epi& E) {
    int tid_ = threadIdx.x; asm volatile("" : "+v"(tid_));
    const int tid = tid_, wid = __builtin_amdgcn_readfirstlane(tid >> 6), lane = tid & 63, wr = wid >> 2, wc = wid & 3, fr = lane & 15, fq = lane >> 4;
    const int K = g.K, nt = K / BK;
    unsigned voffA[2], voffB[2];
#pragma unroll
    for (int i = 0; i < 2; ++i) { int R, C; stage_rc(tid * 16 + i * 8192, R, C); const int Rb = Epi::PERM ? ((R & ~31) + perm32(R & 31)) : R;
        voffA[i] = (unsigned)(R * K + C) * 2u; voffB[i] = (unsigned)(Rb * K + C) * 2u; }
    const size_t kstep = (size_t)(BK * 2);
    const size_t hstep = (size_t)HALF * K * 2;
    const size_t tstep = 2 * hstep;
    const unsigned ldsw = (unsigned)wid * 1024u;
    const int aoff = lds_byte(wr * 64 + fr, fq * 8), boff = lds_byte(wc * 32 + fr, fq * 8);
#define PG8_SA(b, h) (((b) * 2 + (h)) * HTB)
#define PG8_SB(b, h) ((4 + (b) * 2 + (h)) * HTB)
#define PG8_STAGE(bufoff, gbase, voff) do { _Pragma("unroll") for (int _i = 0; _i < 2; ++_i) \
        __builtin_amdgcn_global_load_lds((const unsigned*)((const char*)(gbase) + (voff)[_i]), (LAS unsigned*)(lds + (bufoff) + ldsw + _i * 8192), 16, 0, 0); } while (0)
#define PG8_LDA(dst, b, h) do { _Pragma("unroll") for (int m = 0; m < 4; ++m) _Pragma("unroll") for (int k = 0; k < 2; ++k) dst[m][k] = *(const LAS bf16x8*)(lds + PG8_SA(b, h) + aoff + m * 2048 + k * 1024); } while (0)
#define PG8_LDB(dst, b, h) do { _Pragma("unroll") for (int n = 0; n < 2; ++n) _Pragma("unroll") for (int k = 0; k < 2; ++k) dst[n][k] = *(const LAS bf16x8*)(lds + PG8_SB(b, h) + boff + n * 2048 + k * 1024); } while (0)
#define PG8_MMA(ai, bj, At, Bt) do { __builtin_amdgcn_s_setprio(1); _Pragma("unroll") for (int m = 0; m < 4; ++m) _Pragma("unroll") for (int n = 0; n < 2; ++n) _Pragma("unroll") for (int k = 0; k < 2; ++k) \
        acc[ai][bj][m][n] = __builtin_amdgcn_mfma_f32_16x16x32_bf16(Bt[n][k], At[m][k], acc[ai][bj][m][n], 0, 0, 0); __builtin_amdgcn_s_setprio(0); } while (0)
#define PG8_WAIT_V(n) asm volatile("s_waitcnt vmcnt(" #n ")" ::: "memory")
#define PG8_WAIT_L(n) asm volatile("s_waitcnt lgkmcnt(" #n ")" ::: "memory")
#define PG8_BAR __builtin_amdgcn_s_barrier()
#define PG8_SCHED __builtin_amdgcn_sched_barrier(0)
    Unit cur, nxt; int ui = 0;
    if (!S.next(0, cur)) return;
    f32x4 acc[2][2][4][2];
#pragma unroll
    for (int a = 0; a < 2; ++a)
#pragma unroll
        for (int b = 0; b < 2; ++b)
#pragma unroll
            for (int m = 0; m < 4; ++m)
#pragma unroll
                for (int n = 0; n < 2; ++n) acc[a][b][m][n] = (f32x4){0.f, 0.f, 0.f, 0.f};
    bf16x8 At[4][2], B0[2][2], B1[2][2];
    const char* cA = (const char*)g.A + (size_t)cur.pm * tstep; const char* cB = (const char*)g.Bt + (size_t)cur.pn * tstep;
    PG8_STAGE(PG8_SB(0, 0), cB, voffB); PG8_STAGE(PG8_SA(0, 0), cA, voffA); PG8_STAGE(PG8_SB(0, 1), cB + hstep, voffB); PG8_STAGE(PG8_SA(0, 1), cA + hstep, voffA);
    if (wr == 1) PG8_BAR;
    PG8_WAIT_V(4); PG8_BAR;
    PG8_STAGE(PG8_SB(1, 0), cB + kstep, voffB); PG8_STAGE(PG8_SA(1, 0), cA + kstep, voffA); PG8_STAGE(PG8_SB(1, 1), cB + hstep + kstep, voffB);
    PG8_WAIT_V(6); PG8_BAR;
    for (;;) {
        const bool has_next = S.next(ui + 1, nxt);
        const char* nA = has_next ? (const char*)g.A + (size_t)nxt.pm * tstep : cA; const char* nB = has_next ? (const char*)g.Bt + (size_t)nxt.pn * tstep : cB;
#pragma nounroll
        for (int t = 0; t < nt; t += 2) {
            const bool last = (t == nt - 2);
            const char* a1 = cA + (size_t)(t + 1) * kstep;
            const char* a2 = last ? nA : cA + (size_t)(t + 2) * kstep; const char* b2 = last ? nB : cB + (size_t)(t + 2) * kstep;
            const char* a3 = a2 + kstep; const char* b3 = b2 + kstep;
            PG8_LDB(B0, 0, 0); PG8_SCHED; PG8_LDA(At, 0, 0); PG8_STAGE(PG8_SA(1, 1), a1 + hstep, voffA);
            PG8_WAIT_L(8); PG8_BAR; PG8_WAIT_L(0); PG8_MMA(0, 0, At, B0); PG8_BAR; PG8_SCHED;
            PG8_LDB(B1, 0, 1); PG8_STAGE(PG8_SB(0, 0), b2, voffB);
            PG8_BAR; PG8_WAIT_L(0); PG8_MMA(0, 1, At, B1); PG8_BAR;
            PG8_LDA(At, 0, 1); PG8_STAGE(PG8_SA(0, 0), a2, voffA);
            PG8_BAR; PG8_WAIT_L(0); PG8_MMA(1, 0, At, B0); PG8_BAR; PG8_SCHED;
            PG8_STAGE(PG8_SB(0, 1), b2 + hstep, voffB);
            PG8_WAIT_V(6); PG8_BAR; PG8_MMA(1, 1, At, B1); PG8_BAR;
            PG8_LDB(B0, 1, 0); PG8_SCHED; PG8_LDA(At, 1, 0); PG8_STAGE(PG8_SA(0, 1), a2 + hstep, voffA);
            PG8_WAIT_L(8); PG8_BAR; PG8_WAIT_L(0); PG8_MMA(0, 0, At, B0); PG8_BAR; PG8_SCHED;
            PG8_LDB(B1, 1, 1); PG8_STAGE(PG8_SB(1, 0), b3, voffB);
            PG8_BAR; PG8_WAIT_L(0); PG8_MMA(0, 1, At, B1); PG8_BAR;
            PG8_LDA(At, 1, 1); PG8_STAGE(PG8_SA(1, 0), a3, voffA);
            PG8_BAR; PG8_WAIT_L(0); PG8_MMA(1, 0, At, B0); PG8_BAR; PG8_SCHED;
            PG8_STAGE(PG8_SB(1, 1), b3 + hstep, voffB);
            PG8_WAIT_V(6); PG8_BAR; PG8_MMA(1, 1, At, B1); PG8_BAR;
        }
        E(acc, cur, wr, wc, fr, fq);
        if (!has_next) break;
#pragma unroll
        for (int a = 0; a < 2; ++a)
#pragma unroll
            for (int b = 0; b < 2; ++b)
#pragma unroll
                for (int m = 0; m < 4; ++m)
#pragma unroll
                    for (int n = 0; n < 2; ++n) acc[a][b][m][n] = (f32x4){0.f, 0.f, 0.f, 0.f};
        cur = nxt; cA = nA; cB = nB; ++ui;
    }
    PG8_WAIT_V(0);
    if (wr == 0) PG8_BAR;
    PG8_BAR;
#undef PG8_SA
#undef PG8_SB
#undef PG8_STAGE
#undef PG8_LDA
#undef PG8_LDB
#undef PG8_MMA
#undef PG8_WAIT_V
#undef PG8_WAIT_L
#undef PG8_BAR
#undef PG8_SCHED
}
}

enum { GT_AQ = 0, GT_AK = 1, GT_AV = 2, GT_B = 3, GT_CQ = 4, GT_CKV = 5, GT_KR = 6, GT_PAD = 7 };
__host__ __device__ __forceinline__ void in_group(int g, int& type, int& sub) {
    if (g < 2) { type = GT_AK; sub = g; } else if (g < 4) { type = GT_AV; sub = g - 2; } else if (g < 8) { type = GT_CKV; sub = g - 4; }
    else if (g == 8) { type = GT_KR; sub = 0; } else if (g < 12) { type = GT_PAD; sub = 0; } else if (g < 18) { type = GT_AQ; sub = g - 12; }
    else if (g < 24) { type = GT_CQ; sub = g - 18; } else { type = GT_B; sub = g - 24; }
}
__device__ __forceinline__ int colmap(int mode, int r) {
    const int pn = r >> 8, ct = r & 255, bj = ct >> 7, wc = (ct >> 5) & 3, j = ct & 31, g = 4 * pn + wc, e = 32 * bj + j;
    if (mode == 0) {
        int type, sub; in_group(g, type, sub);
        switch (type) { case GT_AQ: return 64 * sub + e; case GT_AK: return 384 + 64 * sub + e; case GT_AV: return 512 + 64 * sub + e; case GT_B: return 640 + 64 * sub + e;
            case GT_CQ: return 896 + 64 * sub + e; case GT_CKV: return 1280 + 64 * sub + e; case GT_KR: return (j < 16) ? 1536 + 16 * bj + j : -1; default: return -1; }
    } else if (mode == 1) {
        if (g < 6) return 96 * g + e; if (g < 9) { const int head = 2 * (g - 6) + (j >> 4); return 96 * head + 64 + 16 * bj + (j & 15); } return -1;
    } else if (mode == 2) {
        return 64 * g + e;
    }
    return r;
}
__device__ __forceinline__ void cvt_weights_unit(LAS float* tile  , const float* __restrict__ W, int K, int N, bf16_t* __restrict__ dst, int mode, const float* __restrict__ kgain, int r0, int k0) {
    int tid_ = threadIdx.x; asm volatile("" : "+v"(tid_));
    const int tid = tid_;
    const int jj = tid & 63; const int sc = colmap(mode, r0 + jj);
#pragma unroll
    for (int i = 0; i < 8; ++i) { const int kk = (tid >> 6) + 8 * i; float v = 0.f; if (sc >= 0) v = W[(size_t)(k0 + kk) * N + sc]; if (kgain) v *= kgain[k0 + kk]; tile[kk * 65 + jj] = v; }
    __syncthreads();
#pragma unroll
    for (int i = 0; i < 8; ++i) { const int rr = (tid >> 6) + 8 * i, kk = tid & 63; dst[(size_t)(r0 + rr) * K + k0 + kk] = f2bf(tile[kk * 65 + rr]); }
    __syncthreads();
}
struct CvtJob { const float* W; bf16_t* dst; const float* kgain; int K, N, Npad, mode; };
__device__ __forceinline__ void cvt_job(LAS float* tile, const CvtJob j, int vb, int nvb) {
    const int nk = j.K / 64, nr = j.Npad / 64;
    for (int u = vb; u < nk * nr; u += nvb) cvt_weights_unit(tile, j.W, j.K, j.N, j.dst, j.mode, j.kgain, (u / nk) * 64, (u % nk) * 64);
}
__device__ __forceinline__ void cvt_flat(const float* __restrict__ src, bf16_t* __restrict__ dst, size_t n, int vb, int nvb) {
    int tid_ = threadIdx.x; asm volatile("" : "+v"(tid_));
    for (size_t i = ((size_t)vb * 512 + tid_) * 8; i < n; i += (size_t)nvb * 512 * 8) {
        const float4 a = *(const float4*)(src + i), b = *(const float4*)(src + i + 4);
        u32x4 o; o.x = cvt_pk_bf16(a.x, a.y); o.y = cvt_pk_bf16(a.z, a.w); o.z = cvt_pk_bf16(b.x, b.y); o.w = cvt_pk_bf16(b.z, b.w);
        *(u32x4*)(dst + i) = o;
    }
}
template <bool FP8>
__device__ __forceinline__ void cvt_q8_rows(const float* __restrict__ src, unsigned char* __restrict__ dst, float* __restrict__ scales, int nrows, int vb, int nvb) {
    int tid_ = threadIdx.x; asm volatile("" : "+v"(tid_));
    const int lane = tid_ & 63, wid = tid_ >> 6;
    const int stride = nvb * 8;
    for (int row0 = vb * 8 + wid; row0 < nrows; row0 += 4 * stride) {
        f32x4 v[4][4];
#pragma unroll
        for (int q = 0; q < 4; ++q) { const int row = row0 + q * stride < nrows ? row0 + q * stride : row0; const float* sp = src + (size_t)row * 1024 + 16 * lane;
#pragma unroll
            for (int k = 0; k < 4; ++k) v[q][k] = *(const f32x4*)(sp + 4 * k); }
#pragma unroll
        for (int q = 0; q < 4; ++q) { const int row = row0 + q * stride; if (row < nrows) {
            float am = 0.f;
#pragma unroll
            for (int k = 0; k < 4; ++k) am = fmaxf(am, fmaxf(fmaxf(fabsf(v[q][k][0]), fabsf(v[q][k][1])), fmaxf(fabsf(v[q][k][2]), fabsf(v[q][k][3]))));
#pragma unroll
            for (int o = 32; o > 0; o >>= 1) am = fmaxf(am, __shfl_xor(am, o));
            const float qmax = FP8 ? 416.f : 127.f;
            const float sc = am > 0.f ? am / qmax : 1.f, inv = am > 0.f ? qmax / am : 0.f;
            u32x4 o4;
#pragma unroll
            for (int k = 0; k < 4; ++k) {
                if (FP8) { int p = __builtin_amdgcn_cvt_pk_fp8_f32(v[q][k][0] * inv, v[q][k][1] * inv, 0, false); p = __builtin_amdgcn_cvt_pk_fp8_f32(v[q][k][2] * inv, v[q][k][3] * inv, p, true); o4[k] = (unsigned)p; }
                else { const int q0 = (int)rintf(v[q][k][0] * inv), q1 = (int)rintf(v[q][k][1] * inv), q2 = (int)rintf(v[q][k][2] * inv), q3 = (int)rintf(v[q][k][3] * inv);
                    o4[k] = (unsigned)(q0 & 0xff) | ((unsigned)(q1 & 0xff) << 8) | ((unsigned)(q2 & 0xff) << 16) | ((unsigned)(q3 & 0xff) << 24); } }
            *(u32x4*)(dst + (size_t)row * 1024 + 16 * lane) = o4;
            if (lane == 0) scales[row] = sc; } }
    }
}
struct Inputs {
    const float *x, *c, *ctx, *c_ctx, *ada_w, *ada_b, *norm1_g, *norm2_g, *w_in, *gqa_qn_g, *gqa_kn_g, *pool_w, *pool_scale, *mla_qn_g, *mla_kvn_g, *mla_w_uq, *mla_w_ukv, *w_out, *peer_wq, *peer_subkeys, *peer_u, *peer_v, *final_g;
};
__device__ __forceinline__ void phase_cvt(LAS unsigned char* lds, const Inputs& in, const WS& w, int vb, int nvb) {
    LAS float* tile = (LAS float*)lds;
    for (int l = 0; l < 2; ++l) {
        cvt_job(tile, CvtJob{in.w_in + (size_t)l * 1024 * INC, w.WinT() + (size_t)l * 1792 * 1024, nullptr, 1024, INC, 1792, 0}, vb, nvb);
        cvt_job(tile, CvtJob{in.mla_w_uq + (size_t)l * 384 * 576, w.WuqT() + (size_t)l * 768 * 384, in.mla_qn_g + l * 384, 384, 576, 768, 1}, vb, nvb);
        cvt_job(tile, CvtJob{in.mla_w_ukv + (size_t)l * 256 * 768, w.WukvT() + (size_t)l * 768 * 256, in.mla_kvn_g + l * 256, 256, 768, 768, 2}, vb, nvb);
        cvt_job(tile, CvtJob{in.w_out + (size_t)l * 1024 * 1024, w.WoutT() + (size_t)l * 1024 * 1024, nullptr, 1024, 1024, 1024, 3}, vb, nvb);
        cvt_job(tile, CvtJob{in.peer_wq + (size_t)l * 1024 * 2048, w.WqT() + (size_t)l * 2048 * 1024, nullptr, 1024, 2048, 2048, 3}, vb, nvb);
    }
    cvt_flat(in.peer_subkeys, w.SubK(), (size_t)2 * 16 * 128 * 128, vb, nvb);
    { int tp_ = threadIdx.x; asm volatile("" : "+v"(tp_));
      for (int i = vb * 512 + tp_; i < 2 * 4 * 64 * 64; i += nvb * 512) { const int c = i & 63, d = (i >> 6) & 63, lg = i >> 12; w.PoolWT()[i] = f2bf(in.pool_w[(size_t)lg * 4096 + c * 64 + d]); } }
    if (nvb > 144) { if (vb >= 72) { cvt_q8_rows<false>(in.peer_u, w.U8(), w.US(), 2 * NE, vb - 72, nvb - 72); cvt_q8_rows<true>(in.peer_v, w.V8(), w.VS(), 2 * NE, vb - 72, nvb - 72); } }
    else { cvt_q8_rows<false>(in.peer_u, w.U8(), w.US(), 2 * NE, vb, nvb); cvt_q8_rows<true>(in.peer_v, w.V8(), w.VS(), 2 * NE, vb, nvb); }
}

constexpr float ATT_C2G = 0.125f * 1.4426950408889634f, ATT_C2M = 0.10206207261596577f * 1.4426950408889634f;
struct EpiIn {
    static constexpr bool PERM = true;
    WS w; const float* qn_g; const float* kn_g; int pm_base;
    __device__ __forceinline__ void operator()(const f32x4 (&acc)[2][2][4][2], const pg8::Unit& u, int wr, int wc, int fr, int fq) const {
        int type, sub; in_group(4 * u.pn + wc, type, sub);
        if (type == GT_PAD) return;
        const int pm = u.pm + pm_base; const bool isctx = pm >= 256; const int b = isctx ? pm - 256 : pm >> 3; const int t0 = isctx ? 0 : (pm & 7) * 256;
        const size_t rowbase = isctx ? (size_t)NL + (size_t)b * CTX : (size_t)b * S;
        const int keyoff = isctx ? 0 : CTX;
        float gain[2][8];
        if (type == GT_AQ) {
#pragma unroll
            for (int bj = 0; bj < 2; ++bj)
#pragma unroll
                for (int q = 0; q < 8; ++q) gain[bj][q] = qn_g[32 * bj + 8 * fq + q] * ATT_C2G;
        } else if (type == GT_AK) {
#pragma unroll
            for (int bj = 0; bj < 2; ++bj)
#pragma unroll
                for (int q = 0; q < 8; ++q) gain[bj][q] = kn_g[32 * bj + 8 * fq + q];
        }
#pragma unroll
        for (int ai = 0; ai < 2; ++ai)
#pragma unroll
            for (int m = 0; m < 4; ++m) {
                const int t = t0 + 128 * ai + 64 * wr + 16 * m + fr; const size_t row = rowbase + t;
                float v[2][8];
#pragma unroll
                for (int bj = 0; bj < 2; ++bj)
#pragma unroll
                    for (int n = 0; n < 2; ++n)
#pragma unroll
                        for (int i = 0; i < 4; ++i) v[bj][4 * n + i] = acc[ai][bj][m][n][i];
                bf16_t* dst = nullptr;
                if (type == GT_AQ || type == GT_AK) {
                    float ss = 0.f;
#pragma unroll
                    for (int bj = 0; bj < 2; ++bj)
#pragma unroll
                        for (int q = 0; q < 8; ++q) ss += v[bj][q] * v[bj][q];
                    ss += __shfl_xor(ss, 16); ss += __shfl_xor(ss, 32);
                    const float rstd = rsqrtf(ss * (1.f / 64.f) + EPS);
#pragma unroll
                    for (int q = 0; q < 8; ++q) { float x1 = v[0][q] * rstd * gain[0][q], x2 = v[1][q] * rstd * gain[1][q];
                        if (!isctx) { const float2 cs = w.ROPA()[t * 32 + 8 * fq + q]; const float y1 = x1 * cs.x - x2 * cs.y, y2 = x1 * cs.y + x2 * cs.x; x1 = y1; x2 = y2; }
                        v[0][q] = x1; v[1][q] = x2; }
                    if (type == GT_AQ) dst = isctx ? w.Qgc() + (((size_t)b * 6 + sub) * CTX + t) * 64 : w.Qg() + (((size_t)b * 6 + sub) * S + t) * 64;
                    else dst = w.Kg() + (((size_t)b * 2 + sub) * KEYS + keyoff + t) * 64;
                } else if (type == GT_AV) { dst = w.Vg() + (((size_t)b * 2 + sub) * KEYS + keyoff + t) * 64;
                } else if (type == GT_B) { dst = w.Bp() + row * 256 + 64 * sub;
                } else if (type == GT_CQ || type == GT_CKV) {
                    float ss = 0.f;
#pragma unroll
                    for (int bj = 0; bj < 2; ++bj)
#pragma unroll
                        for (int q = 0; q < 8; ++q) ss += v[bj][q] * v[bj][q];
                    ss += __shfl_xor(ss, 16); ss += __shfl_xor(ss, 32);
                    if (type == GT_CQ) { if (fq == 0) w.SSQ()[row * 8 + sub] = ss; dst = w.CQ() + row * 384 + 64 * sub; }
                    else { if (fq == 0) w.SSKV()[row * 4 + sub] = ss; dst = w.CKV() + row * 256 + 64 * sub; }
                } else {
                    if (!isctx) {
#pragma unroll
                        for (int q = 0; q < 8; ++q) { const float2 cs = w.ROPC()[t * 16 + ((8 * fq + q) & 15)]; const float x1 = v[0][q], x2 = v[1][q]; v[0][q] = x1 * cs.x - x2 * cs.y; v[1][q] = x1 * cs.y + x2 * cs.x; } }
                    if (fq < 2) { bf16_t* kd = w.KR() + ((size_t)b * KEYS + keyoff + t) * 32;
#pragma unroll
                        for (int bj = 0; bj < 2; ++bj) { u32x4 o; o.x = cvt_pk_bf16(v[bj][0], v[bj][1]); o.y = cvt_pk_bf16(v[bj][2], v[bj][3]); o.z = cvt_pk_bf16(v[bj][4], v[bj][5]); o.w = cvt_pk_bf16(v[bj][6], v[bj][7]);
                            *(u32x4*)(kd + 16 * bj + 8 * fq) = o; } }
                    continue;
                }
#pragma unroll
                for (int bj = 0; bj < 2; ++bj) { u32x4 o; o.x = cvt_pk_bf16(v[bj][0], v[bj][1]); o.y = cvt_pk_bf16(v[bj][2], v[bj][3]); o.z = cvt_pk_bf16(v[bj][4], v[bj][5]); o.w = cvt_pk_bf16(v[bj][6], v[bj][7]);
                    *(u32x4*)(dst + 32 * bj + 8 * fq) = o; }
            }
    }
};
struct P1Order {
    pg8::StaticOrder so; int nctx_tiles, G, c;
    __device__ bool next(int i, pg8::Unit& u) const {
        const int L = i * G + c;
        if (L < 1792) return so.next(i, u);
        const int Lc = L - 1792; if (Lc >= 32 * nctx_tiles) return false;
        u.pm = 256 + (Lc & 31); u.pn = Lc >> 5; return true;
    }
};
__device__ __forceinline__ void phase_p1(LAS unsigned char* lds, const WS& w, const Inputs& in, int l, int vb, int nvb) {
    EpiIn E{w, in.gqa_qn_g + l * 64, in.gqa_kn_g + l * 64, 0};
    P1Order po; po.so.init(NL, 1792, nvb, vb); po.nctx_tiles = (l == 0) ? 7 : 3; po.G = nvb; po.c = vb;
    pg8::gemm_phase(lds, pg8::Gemm{w.H(), w.WinT() + (size_t)l * 1792 * 1024, NR, 1792, 1024}, po, E);
}

extern __shared__ __attribute__((aligned(16))) unsigned char dyn_lds[];

struct EpiUq {
    static constexpr bool PERM = true;
    WS w;
    __device__ __forceinline__ void operator()(const f32x4 (&acc)[2][2][4][2], const pg8::Unit& u, int wr, int wc, int fr, int fq) const {
        const int g = 4 * u.pn + wc; if (g >= 9) return;
        const int pm = u.pm; const bool isctx = pm >= 256; const int b = isctx ? pm - 256 : pm >> 3; const int t0 = isctx ? 0 : (pm & 7) * 256;
        const size_t rowbase = isctx ? (size_t)NL + (size_t)b * CTX : (size_t)b * S;
        const int head = g < 6 ? g : 2 * (g - 6) + (fq >> 1);
#pragma unroll
        for (int ai = 0; ai < 2; ++ai)
#pragma unroll
            for (int m = 0; m < 4; ++m) {
                const int t = t0 + 128 * ai + 64 * wr + 16 * m + fr; const size_t row = rowbase + t;
                const float4 s0 = *(const float4*)(w.SSQ() + row * 8), s1 = *(const float4*)(w.SSQ() + row * 8 + 4);
                const float rstd = rsqrtf((s0.x + s0.y + s0.z + s0.w + s1.x + s1.y) * (1.f / 384.f) + EPS) * ATT_C2M;
                float v[2][8];
#pragma unroll
                for (int bj = 0; bj < 2; ++bj)
#pragma unroll
                    for (int n = 0; n < 2; ++n)
#pragma unroll
                        for (int i = 0; i < 4; ++i) v[bj][4 * n + i] = acc[ai][bj][m][n][i] * rstd;
                bf16_t* hd = isctx ? w.Qmc() + (((size_t)b * 6 + head) * CTX + t) * 96 : w.Qm() + (((size_t)b * 6 + head) * S + t) * 96;
                if (g >= 6 && !isctx) {
#pragma unroll
                    for (int q = 0; q < 8; ++q) { const float2 cs = w.ROPC()[t * 16 + 8 * (fq & 1) + q]; const float x1 = v[0][q], x2 = v[1][q]; v[0][q] = x1 * cs.x - x2 * cs.y; v[1][q] = x1 * cs.y + x2 * cs.x; } }
#pragma unroll
                for (int bj = 0; bj < 2; ++bj) { u32x4 o; o.x = cvt_pk_bf16(v[bj][0], v[bj][1]); o.y = cvt_pk_bf16(v[bj][2], v[bj][3]); o.z = cvt_pk_bf16(v[bj][4], v[bj][5]); o.w = cvt_pk_bf16(v[bj][6], v[bj][7]);
                    bf16_t* d = g < 6 ? hd + 32 * bj + 8 * fq : hd + 64 + 16 * bj + 8 * (fq & 1);
                    *(u32x4*)d = o; }
            }
    }
};
struct EpiUkv {
    static constexpr bool PERM = true;
    WS w;
    __device__ __forceinline__ void operator()(const f32x4 (&acc)[2][2][4][2], const pg8::Unit& u, int wr, int wc, int fr, int fq) const {
        const int g = 4 * u.pn + wc;
        const int pm = u.pm; const bool isctx = pm >= 256; const int b = isctx ? pm - 256 : pm >> 3; const int t0 = isctx ? 0 : (pm & 7) * 256;
        const size_t rowbase = isctx ? (size_t)NL + (size_t)b * CTX : (size_t)b * S; const int keyoff = isctx ? 0 : CTX;
        bf16_t* base = ((g & 1) ? w.Vm() : w.Kmn()) + ((size_t)b * 6 + (g >> 1)) * KEYS * 64;
#pragma unroll
        for (int ai = 0; ai < 2; ++ai)
#pragma unroll
            for (int m = 0; m < 4; ++m) {
                const int t = t0 + 128 * ai + 64 * wr + 16 * m + fr; const size_t row = rowbase + t;
                const float4 s0 = *(const float4*)(w.SSKV() + row * 4);
                const float rstd = rsqrtf((s0.x + s0.y + s0.z + s0.w) * (1.f / 256.f) + EPS);
                bf16_t* d = base + (size_t)(keyoff + t) * 64;
#pragma unroll
                for (int bj = 0; bj < 2; ++bj) { const f32x4 a0 = acc[ai][bj][m][0] * rstd, a1 = acc[ai][bj][m][1] * rstd;
                    u32x4 o; o.x = cvt_pk_bf16(a0[0], a0[1]); o.y = cvt_pk_bf16(a0[2], a0[3]); o.z = cvt_pk_bf16(a1[0], a1[1]); o.w = cvt_pk_bf16(a1[2], a1[3]);
                    *(u32x4*)(d + 32 * bj + 8 * fq) = o; }
            }
    }
};
constexpr int POOL_X = 0, POOL_P = 272 * 128, POOL_BYTES = 272 * 128 + 256 * 128;
__device__ __forceinline__ void phase_pool(LAS unsigned char* lds, const WS& w, bf16_t* __restrict__ MIX, const bf16_t* __restrict__ WT  , const float* __restrict__ pool_scale, int nrows, int vb, int nvb) {
    int tid_ = threadIdx.x; asm volatile("" : "+v"(tid_));
    const int tid = tid_, lane = tid & 63, wid = __builtin_amdgcn_readfirstlane(tid >> 6), r32 = lane & 31, hi = lane >> 5;
    const int nunits = nrows >> 8;
    for (int u = vb; u < nunits; u += nvb) {
        const int row0 = u << 8; const bool isctx = row0 >= NL; const int L = isctx ? CTX : S; const int t0 = isctx ? 0 : (row0 & (S - 1)); const int seq0 = row0 - t0;
#pragma unroll 1
        for (int g = 0; g < 4; ++g) {
            const int wdw = 2 << g, half = wdw >> 1;
            for (int i = tid; i < 272 * 8; i += 512) { const int rr = i >> 3, ch = i & 7; int t = t0 - 8 + rr; t = t < 0 ? 0 : (t >= L ? L - 1 : t);
                *(LAS u32x4*)(lds + POOL_X + rr * 128 + ch * 16) = *(const u32x4*)(w.Bp() + (size_t)(seq0 + t) * 256 + g * 64 + ch * 8); }
            __syncthreads();
            { const int c = tid & 63, seg = tid >> 6; const LAS bf16_t* X = (const LAS bf16_t*)(lds + POOL_X) + c;
              int t = t0 + seg * 32; int lo = t - half, hiw = t - half + wdw; lo = lo < 0 ? 0 : lo; hiw = hiw > L ? L : hiw;
              float sum = 0.f; for (int q = lo; q < hiw; ++q) sum += bf2f(X[(q - t0 + 8) * 64]);
#pragma unroll 4
              for (int k = 0; k < 32; ++k, ++t) {
                  const int clo = (t - half) < 0 ? 0 : (t - half), chi = (t - half + wdw) > L ? L : (t - half + wdw);
                  const float pv = sum / (float)(chi - clo) - bf2f(X[(t - t0 + 8) * 64]);
                  const int r = seg * 32 + k; *((LAS bf16_t*)(lds + POOL_P + r * 128 + (((c >> 3) ^ ((r >> 1) & 7)) << 4)) + (c & 7)) = f2bf(pv);
                  const int add = t + 1 - half + wdw - 1, drop = t - half;
                  if (add < L) sum += bf2f(X[(add - t0 + 8) * 64]);
                  if (drop >= 0) sum -= bf2f(X[(drop - t0 + 8) * 64]);
              } }
            __syncthreads();
            { f32x16 o0 = {}, o1 = {};
              const bf16_t* wt = WT + (size_t)g * 4096 + (size_t)r32 * 64 + 8 * hi;
#pragma unroll
              for (int s = 0; s < 4; ++s) { const int row = wid * 32 + r32; const bf16x8 pf = *(const LAS bf16x8*)(lds + POOL_P + row * 128 + (((2 * s + hi) ^ ((row >> 1) & 7)) << 4));
                  o0 = mfma32(*(const bf16x8*)(wt + 16 * s), pf, o0); o1 = mfma32(*(const bf16x8*)(wt + 32 * 64 + 16 * s), pf, o1); }
              bf16_t* op = MIX + (size_t)(row0 + wid * 32 + r32) * 1024 + 384 + g * 64 + 4 * hi; const float* ps = pool_scale + g * 64 + 4 * hi;
#pragma unroll
              for (int q = 0; q < 4; ++q) { const f32x4 s0 = *(const f32x4*)(ps + 8 * q), s1 = *(const f32x4*)(ps + 32 + 8 * q); u32x2 a, b;
                  a.x = cvt_pk_bf16(o0[4 * q] * s0[0], o0[4 * q + 1] * s0[1]); a.y = cvt_pk_bf16(o0[4 * q + 2] * s0[2], o0[4 * q + 3] * s0[3]);
                  b.x = cvt_pk_bf16(o1[4 * q] * s1[0], o1[4 * q + 1] * s1[1]); b.y = cvt_pk_bf16(o1[4 * q + 2] * s1[2], o1[4 * q + 3] * s1[3]);
                  *(u32x2*)(op + 8 * q) = a; *(u32x2*)(op + 32 + 8 * q) = b; } }
            __syncthreads();
        }
    }
}
__device__ __forceinline__ void phase_p2(LAS unsigned char* lds, const WS& w, const Inputs& in, int l, int vb, int nvb, int parts = 7) {
    pg8::StaticOrder so;
    if (parts & 1) { EpiUq E{w}; const int M = l == 0 ? NR : NL; so.init(M, 768, nvb, vb); pg8::gemm_phase(lds, pg8::Gemm{w.CQ(), w.WuqT() + (size_t)l * 768 * 384, M, 768, 384}, so, E); }
    if (parts & 2) { EpiUkv E{w}; so.init(NR, 768, nvb, vb); pg8::gemm_phase(lds, pg8::Gemm{w.CKV(), w.WukvT() + (size_t)l * 768 * 256, NR, 768, 256}, so, E); }
    if (parts & 4) phase_pool(lds, w, w.H(), w.PoolWT() + (size_t)l * 4 * 64 * 64, in.pool_scale + l * 256, l == 0 ? NR : NL, vb, nvb);
}

struct EpiOut {
    static constexpr bool PERM = true;
    bf16_t* DLT; const float* gate;
    __device__ __forceinline__ void operator()(const f32x4 (&acc)[2][2][4][2], const pg8::Unit& u, int wr, int wc, int fr, int fq) const {
        const int pm = u.pm; const int mr = pm >= 256 ? 32 : pm >> 3;
        const size_t r0 = (size_t)pm * 256 + wr * 64 + fr; const int col0 = u.pn * 256 + wc * 32 + 8 * fq;
        f32x4 gv[2][2];
#pragma unroll
        for (int bj = 0; bj < 2; ++bj)
#pragma unroll
            for (int n = 0; n < 2; ++n) gv[bj][n] = *(const f32x4*)(gate + (size_t)mr * 6144 + col0 + bj * 128 + 4 * n);
#pragma unroll
        for (int ai = 0; ai < 2; ++ai)
#pragma unroll
            for (int m = 0; m < 4; ++m) { bf16_t* d = DLT + (r0 + ai * 128 + m * 16) * 1024 + col0;
#pragma unroll
                for (int bj = 0; bj < 2; ++bj) { const f32x4 a0 = acc[ai][bj][m][0] * gv[bj][0], a1 = acc[ai][bj][m][1] * gv[bj][1];
                    u32x4 o; o.x = cvt_pk_bf16(a0[0], a0[1]); o.y = cvt_pk_bf16(a0[2], a0[3]); o.z = cvt_pk_bf16(a1[0], a1[1]); o.w = cvt_pk_bf16(a1[2], a1[3]);
                    *(u32x4*)(d + bj * 128) = o; } }
    }
};
__device__ __forceinline__ void phase_p4(LAS unsigned char* lds, const WS& w, const Inputs& in, int l, int vb, int nvb) {
    const float* MODl = w.MOD() + (size_t)l * 33 * 6144;
    EpiOut E{w.PQ(), MODl + 2 * 1024};
    const int M = l == 0 ? NR : NL;
    pg8::StaticOrder so; so.init(M, 1024, nvb, vb);
    pg8::gemm_phase(lds, pg8::Gemm{w.H(), w.WoutT() + (size_t)l * 1024 * 1024, M, 1024, 1024}, so, E);
}

template <bool INBF>
__device__ __forceinline__ void phase_modulate(const float* __restrict__ XLp, const float* __restrict__ XCp, const bf16_t* __restrict__ XBp, bf16_t* __restrict__ Hout, const float* __restrict__ g, const float* __restrict__ MODl, int si, int nrows, int vb, int nvb,
                                               signed char* __restrict__ H8 = nullptr, float* __restrict__ HS = nullptr, const bf16_t* __restrict__ DLT = nullptr, bf16_t* __restrict__ XBo = nullptr) {
    int tid_ = threadIdx.x; asm volatile("" : "+v"(tid_));
    const int tid = tid_, lane = tid & 63, wid = tid >> 6;
    f32x4 gv[4];
#pragma unroll
    for (int i = 0; i < 4; ++i) gv[i] = *(const f32x4*)(g + 256 * i + 4 * lane);
    const int stride = nvb * 8, lastrow = nrows - 1;
    f32x4 nx[4]; u32x2 nxb[4], ndr[4];
#define PM_LOAD(r_) do { const int rr_ = (r_) < nrows ? (r_) : lastrow; const bool ic_ = rr_ >= NL; const float* xp_ = ic_ ? XCp + (size_t)(rr_ - NL) * 1024 : XLp + (size_t)rr_ * 1024; \
        _Pragma("unroll") for (int i = 0; i < 4; ++i) { if (INBF) nxb[i] = *(const u32x2*)(XBp + (size_t)rr_ * 1024 + 256 * i + 4 * lane); else nx[i] = *(const f32x4*)(xp_ + 256 * i + 4 * lane); \
            if (DLT) ndr[i] = *(const u32x2*)(DLT + (size_t)rr_ * 1024 + 256 * i + 4 * lane); } } while (0)
    PM_LOAD(vb * 8 + wid);
    for (int row = vb * 8 + wid; row < nrows; row += stride) {
        const bool isctx = row >= NL; const int mr = isctx ? 32 : row / S;
        f32x4 x[4]; u32x2 dr4[4]; float ss = 0.f;
#pragma unroll
        for (int i = 0; i < 4; ++i) { if (INBF) x[i] = (f32x4){__uint_as_float(nxb[i].x << 16), __uint_as_float(nxb[i].x & 0xffff0000u), __uint_as_float(nxb[i].y << 16), __uint_as_float(nxb[i].y & 0xffff0000u)}; else x[i] = nx[i];
            if (DLT) dr4[i] = ndr[i]; }
        PM_LOAD(row + stride);
#pragma unroll
        for (int i = 0; i < 4; ++i) {
            if (DLT) { const u32x2 dr = dr4[i];
                x[i][0] += __uint_as_float(dr.x << 16); x[i][1] += __uint_as_float(dr.x & 0xffff0000u); x[i][2] += __uint_as_float(dr.y << 16); x[i][3] += __uint_as_float(dr.y & 0xffff0000u);
                u32x2 xo; xo.x = cvt_pk_bf16(x[i][0], x[i][1]); xo.y = cvt_pk_bf16(x[i][2], x[i][3]); *(u32x2*)(XBo + (size_t)row * 1024 + 256 * i + 4 * lane) = xo; }
            ss += x[i][0] * x[i][0] + x[i][1] * x[i][1] + x[i][2] * x[i][2] + x[i][3] * x[i][3]; }
        ss = wave_sum(ss); const float rstd = rsqrtf(ss * (1.f / 1024.f) + EPS);
        const float* sh = MODl + (size_t)mr * 6144 + si * 1024;
        f32x4 y[4]; float am = 0.f;
#pragma unroll
        for (int i = 0; i < 4; ++i) { const f32x4 shv = *(const f32x4*)(sh + 256 * i + 4 * lane), scv = *(const f32x4*)(sh + 1024 + 256 * i + 4 * lane);
            y[i] = x[i] * rstd * gv[i] * (scv + 1.f) + shv;
            am = fmaxf(am, fmaxf(fmaxf(fabsf(y[i][0]), fabsf(y[i][1])), fmaxf(fabsf(y[i][2]), fabsf(y[i][3]))));
            u32x2 o; o.x = cvt_pk_bf16(y[i][0], y[i][1]); o.y = cvt_pk_bf16(y[i][2], y[i][3]);
            *(u32x2*)(Hout + (size_t)row * 1024 + 256 * i + 4 * lane) = o; }
        if (H8) {
#pragma unroll
            for (int o = 32; o > 0; o >>= 1) am = fmaxf(am, __shfl_xor(am, o));
            const float inv = am > 0.f ? 127.f / am : 0.f;
#pragma unroll
            for (int i = 0; i < 4; ++i) { const int q0 = (int)rintf(y[i][0] * inv), q1 = (int)rintf(y[i][1] * inv), q2 = (int)rintf(y[i][2] * inv), q3 = (int)rintf(y[i][3] * inv);
                *(unsigned*)(H8 + (size_t)row * 1024 + 256 * i + 4 * lane) = (unsigned)(q0 & 0xff) | ((unsigned)(q1 & 0xff) << 8) | ((unsigned)(q2 & 0xff) << 16) | ((unsigned)(q3 & 0xff) << 24); }
            if (lane == 0) HS[row] = am > 0.f ? am * (1.f / 127.f) : 1.f;
        }
    }
#undef PM_LOAD
}

struct EpiPQ {
    static constexpr bool PERM = true;
    bf16_t* PQ;
    __device__ __forceinline__ void operator()(const f32x4 (&acc)[2][2][4][2], const pg8::Unit& u, int wr, int wc, int fr, int fq) const {
        const size_t r0 = (size_t)u.pm * 256 + wr * 64 + fr; const int col0 = u.pn * 256 + wc * 32 + 8 * fq;
#pragma unroll
        for (int ai = 0; ai < 2; ++ai)
#pragma unroll
            for (int m = 0; m < 4; ++m) { bf16_t* d = PQ + (r0 + ai * 128 + m * 16) * 2048 + col0;
#pragma unroll
                for (int bj = 0; bj < 2; ++bj) { const f32x4 a0 = acc[ai][bj][m][0], a1 = acc[ai][bj][m][1];
                    u32x4 o; o.x = cvt_pk_bf16(a0[0], a0[1]); o.y = cvt_pk_bf16(a0[2], a0[3]); o.z = cvt_pk_bf16(a1[0], a1[1]); o.w = cvt_pk_bf16(a1[2], a1[3]);
                    *(u32x4*)(d + bj * 128) = o; } }
    }
};
__device__ __forceinline__ void phase_p6a(LAS unsigned char* lds, const WS& w, int l, int vb, int nvb) {
    EpiPQ E{w.PQ()}; const int M = l == 0 ? NR : NL;
    pg8::StaticOrder so; so.init(M, 2048, nvb, vb);
    pg8::gemm_phase(lds, pg8::Gemm{w.H(), w.WqT() + (size_t)l * 2048 * 1024, M, 2048, 1024}, so, E);
}


using bf16x2_t = __attribute__((ext_vector_type(2))) __bf16;
typedef float f32x2 __attribute__((ext_vector_type(2)));
__device__ __forceinline__ float gelu_fast(float x) {
    const float u2 = 1.5957691216057308f * (x + 0.044715f * x * x * x);
    return x * __builtin_amdgcn_rcpf(1.f + __builtin_amdgcn_exp2f(-1.4426950408889634f * u2));
}
#define DPPF(v, ctrl) __builtin_bit_cast(float, __builtin_amdgcn_update_dpp(0, __builtin_bit_cast(int, (v)), (ctrl), 0xf, 0xf, true))
__device__ __forceinline__ float reduce8(float p0, float p1, float p2, float p3, float p4, float p5, float p6, float p7, int lane) {
    auto s01 = __builtin_amdgcn_permlane32_swap(__float_as_uint(p0), __float_as_uint(p1), false, false);
    auto s23 = __builtin_amdgcn_permlane32_swap(__float_as_uint(p2), __float_as_uint(p3), false, false);
    auto s45 = __builtin_amdgcn_permlane32_swap(__float_as_uint(p4), __float_as_uint(p5), false, false);
    auto s67 = __builtin_amdgcn_permlane32_swap(__float_as_uint(p6), __float_as_uint(p7), false, false);
    const float q0 = __uint_as_float(s01[0]) + __uint_as_float(s01[1]), q1 = __uint_as_float(s23[0]) + __uint_as_float(s23[1]);
    const float q2 = __uint_as_float(s45[0]) + __uint_as_float(s45[1]), q3 = __uint_as_float(s67[0]) + __uint_as_float(s67[1]);
    auto t0 = __builtin_amdgcn_permlane16_swap(__float_as_uint(q0), __float_as_uint(q1), false, false);
    auto t1 = __builtin_amdgcn_permlane16_swap(__float_as_uint(q2), __float_as_uint(q3), false, false);
    float r0 = __uint_as_float(t0[0]) + __uint_as_float(t0[1]);
    float r1 = __uint_as_float(t1[0]) + __uint_as_float(t1[1]);
    r0 += DPPF(r0, 0x128); r1 += DPPF(r1, 0x128);
    float z = (lane & 8) ? r1 : r0;
    z += DPPF(z, 0x141);
    z += DPPF(z, 0xB1);
    z += DPPF(z, 0x4E);
    return z;
}
__device__ __forceinline__ void p7_axpy(const u32x4 v, float wj, f32x2 (&out)[8]) {
    const f32x2 w2 = {wj, wj};
#pragma unroll
    for (int k = 0; k < 4; ++k) { const f32x2 lo = __builtin_amdgcn_cvt_pk_f32_fp8((int)v[k], false), hi2 = __builtin_amdgcn_cvt_pk_f32_fp8((int)v[k], true);
        out[2 * k] = __builtin_elementwise_fma(w2, lo, out[2 * k]); out[2 * k + 1] = __builtin_elementwise_fma(w2, hi2, out[2 * k + 1]); }
}
__device__ __forceinline__ int p7_doti(const u32x4 u, const u32x4 h) {
    int s = __builtin_amdgcn_sdot4((int)u[0], (int)h[0], 0, false); s = __builtin_amdgcn_sdot4((int)u[1], (int)h[1], s, false); s = __builtin_amdgcn_sdot4((int)u[2], (int)h[2], s, false); return __builtin_amdgcn_sdot4((int)u[3], (int)h[3], s, false);
}
#define DPPI(v, ctrl) __builtin_amdgcn_update_dpp(0, (v), (ctrl), 0xf, 0xf, true)
__device__ __forceinline__ int reduce8i(int p0, int p1, int p2, int p3, int p4, int p5, int p6, int p7, int lane) {
    auto s01 = __builtin_amdgcn_permlane32_swap((unsigned)p0, (unsigned)p1, false, false); auto s23 = __builtin_amdgcn_permlane32_swap((unsigned)p2, (unsigned)p3, false, false);
    auto s45 = __builtin_amdgcn_permlane32_swap((unsigned)p4, (unsigned)p5, false, false); auto s67 = __builtin_amdgcn_permlane32_swap((unsigned)p6, (unsigned)p7, false, false);
    const unsigned q0 = s01[0] + s01[1], q1 = s23[0] + s23[1], q2 = s45[0] + s45[1], q3 = s67[0] + s67[1];
    auto t0 = __builtin_amdgcn_permlane16_swap(q0, q1, false, false); auto t1 = __builtin_amdgcn_permlane16_swap(q2, q3, false, false);
    int r0 = (int)(t0[0] + t0[1]), r1 = (int)(t1[0] + t1[1]);
    r0 += DPPI(r0, 0x128); r1 += DPPI(r1, 0x128);
    int z = (lane & 8) ? r1 : r0;
    z += DPPI(z, 0x141); z += DPPI(z, 0xB1); z += DPPI(z, 0x4E);
    return z;
}

struct P7CArgs { const signed char* H8; const unsigned* EG; const unsigned char* U8; int* PART; int nrows; };
__device__ __forceinline__ void phase_p7c(LAS unsigned char* lds, const P7CArgs& a, int part, int prank, int nvb) {
    int tid_ = threadIdx.x; asm volatile("" : "+v"(tid_));
    const int lane = tid_ & 63, wid = __builtin_amdgcn_readfirstlane(tid_ >> 6);
    const int nw = (nvb >> 3) * 8, wrank = prank * 8 + wid;
    LAS unsigned* tab = (LAS unsigned*)(lds + wid * 1024);
    const int grp = lane >> 3, c = lane & 7, c16 = c * 16;
    const unsigned char* ubase = a.U8 + 128 * part + c16;
    const signed char* hbase = a.H8 + 128 * part + c16;
    unsigned* pbase = (unsigned*)a.PART + (size_t)part * a.nrows * 64;
    const int c2 = (c >> 2) & 1, c1 = (c >> 1) & 1, c0 = c & 1;
    const int ent0 = 8 * (4 * c2 + 2 * c0 + c1) + grp;
    u32x4 Av[16], Bv[16]; u32x4 Ah, Bh;
    unsigned pw0 = 0u, pw1 = 0u;
#define P7C_PREF(t) do { pw0 = a.EG[(size_t)(t) * 128 + lane]; pw1 = a.EG[(size_t)(t) * 128 + 64 + lane]; } while (0)
#define P7C_ISSUE(X, Xh, t, slot, tnext) do { LAS unsigned* tb_ = tab + (slot) * 128; \
        tb_[lane] = pw0; tb_[64 + lane] = pw1; \
        asm volatile("s_waitcnt lgkmcnt(0)" ::: "memory"); \
        _Pragma("unroll") for (int i_ = 0; i_ < 16; ++i_) { const unsigned e_ = tb_[8 * i_ + grp]; X[i_] = *(const u32x4*)(ubase + (size_t)(e_ >> 16) * 1024); } \
        Xh = *(const u32x4*)(hbase + (size_t)(t) * 1024); \
        P7C_PREF(tnext); } while (0)
#define P7C_X(v, ctrl) ((v) + DPPI((v), (ctrl)))
#define P7C_COMPUTE(X, Xh, t, valid) do { int d_[16]; \
        _Pragma("unroll") for (int i_ = 0; i_ < 16; ++i_) d_[i_] = p7_doti(X[i_], Xh); \
        int e8_[8]; _Pragma("unroll") for (int k = 0; k < 8; ++k) { const int send_ = c2 ? d_[k] : d_[k + 8], keep_ = c2 ? d_[k + 8] : d_[k]; e8_[k] = keep_ + DPPI(send_, 0x141); }            \
        int e4_[4]; _Pragma("unroll") for (int k = 0; k < 4; ++k) { const int send_ = c0 ? e8_[k] : e8_[k + 4], keep_ = c0 ? e8_[k + 4] : e8_[k]; e4_[k] = keep_ + DPPI(send_, 0xB1); }          \
        int e2_[2]; _Pragma("unroll") for (int k = 0; k < 2; ++k) { const int send_ = c1 ? e4_[k] : e4_[k + 2], keep_ = c1 ? e4_[k + 2] : e4_[k]; e2_[k] = keep_ + DPPI(send_, 0x4E); }          \
        if (valid) pbase[(size_t)(t) * 64 + ent0] = __builtin_bit_cast(unsigned, __builtin_amdgcn_cvt_pk_i16((e2_[0] + 8) >> 4, (e2_[1] + 8) >> 4)); } while (0)
    const int lastrow = a.nrows - 1;
    int t = wrank;
    P7C_PREF(t);
    P7C_ISSUE(Av, Ah, t, 0, (t + nw < a.nrows ? t + nw : lastrow));
    while (t < a.nrows) {
        const int t1 = t + nw, t2 = t1 + nw, t3 = t2 + nw;
        const int k1 = t1 < a.nrows ? t1 : lastrow, k2 = t2 < a.nrows ? t2 : lastrow, k3 = t3 < a.nrows ? t3 : lastrow;
        P7C_ISSUE(Bv, Bh, k1, 1, k2);
        P7C_COMPUTE(Av, Ah, t, true);
        P7C_ISSUE(Av, Ah, k2, 0, k3);
        P7C_COMPUTE(Bv, Bh, k1, (t1 < a.nrows));
        t = t2;
    }
#undef P7C_PREF
#undef P7C_ISSUE
#undef P7C_COMPUTE
}
__device__ __forceinline__ void phase_p7d(const int* __restrict__ PART, const unsigned* __restrict__ EG, const float* __restrict__ US, const float* __restrict__ VS, const float* __restrict__ HS, unsigned* __restrict__ WE, int nrows, int vb, int nvb) {
    int tid_ = threadIdx.x; asm volatile("" : "+v"(tid_));
    typedef int i32x4 __attribute__((ext_vector_type(4)));
    const size_t n16 = (size_t)nrows * 16, pstride4 = n16;
    const u32x4* P4 = (const u32x4*)PART; const u32x4* EG4 = (const u32x4*)EG; u32x4* WE4 = (u32x4*)WE;
    for (size_t j = (size_t)vb * 512 + tid_; j < n16; j += (size_t)nvb * 512) {
        const size_t row = j >> 4; const int P = (int)(j >> 1) & 7, gq = (int)j & 1;
        i32x4 slo = {0, 0, 0, 0}, shi = {0, 0, 0, 0};
#pragma unroll
        for (int p = 0; p < 8; ++p) { const u32x4 d = P4[p * pstride4 + j];
#pragma unroll
            for (int k = 0; k < 4; ++k) { slo[k] += (int)(d[k] << 16) >> 16; shi[k] += (int)d[k] >> 16; } }
        const float hs = HS[row] * 16.f;
#pragma unroll
        for (int half = 0; half < 2; ++half) {
            const size_t ei = row * 32 + 4 * P + 2 * half + gq;
            const u32x4 eg = EG4[ei]; u32x4 o;
#pragma unroll
            for (int k = 0; k < 4; ++k) { const int eid = (int)(eg[k] >> 16);
                const float av = (float)(half ? shi[k] : slo[k]) * US[eid] * hs;
                const float wv = __uint_as_float(eg[k] << 16) * gelu_fast(av) * VS[eid];
                o[k] = (eg[k] & 0xffff0000u) | (cvt_pk_bf16(wv, 0.f) & 0xffffu); }
            WE4[ei] = o;
        }
    }
}
struct P7BArgs { const unsigned* WE; const unsigned char* V8; bf16_t* XB; const float* gate2; int nrows; };
template <int PM>
__device__ __forceinline__ void phase_p7b(LAS unsigned char* lds, const P7BArgs& a, int part, int prank, int nvb) {
    int tid_ = threadIdx.x; asm volatile("" : "+v"(tid_));
    const int lane = tid_ & 63, wid = __builtin_amdgcn_readfirstlane(tid_ >> 6);
    const int nw = (nvb >> 3) * 8, wrank = prank * 8 + wid;
    LAS unsigned* tab = (LAS unsigned*)(lds + wid * 1024);
    const int grp = lane >> 3, c16 = (lane & 7) * 16;
    const unsigned char* vbase = a.V8 + 128 * part + c16;
    const int colofs = 128 * part + c16 + 8 * (lane >> 5) + 4 * ((lane >> 4) & 1) + 2 * ((lane >> 3) & 1);
    u32x4 Av[16], Bv[16]; float Aw[16], Bw[16]; unsigned Ax, Bx; f32x2 Ag, Bg;
    unsigned pw0 = 0u, pw1 = 0u;
#define P7B_PREF(t) do { pw0 = a.WE[(size_t)(t) * 128 + lane]; pw1 = a.WE[(size_t)(t) * 128 + 64 + lane]; } while (0)
#define P7B_ISSUE(X, Xw, Xx, Xg, t, slot, tnext) do { LAS unsigned* tb_ = tab + (slot) * 128; \
        tb_[lane] = pw0; tb_[64 + lane] = pw1; \
        asm volatile("s_waitcnt lgkmcnt(0)" ::: "memory"); \
        _Pragma("unroll") for (int i_ = 0; i_ < 16; ++i_) { const unsigned we_ = tb_[8 * i_ + grp]; Xw[i_] = __uint_as_float(we_ << 16); if (PM != 2) X[i_] = *(const u32x4*)(vbase + (size_t)(we_ >> 16) * 1024); else X[i_] = (u32x4){we_, 0x38383838u, 0x38383838u, 0x38383838u}; } \
        { const int mr_ = (t) >= NL ? 32 : (t) / S; \
          Xx = *(const unsigned*)(a.XB + (size_t)(t) * 1024 + colofs); Xg = *(const f32x2*)(a.gate2 + (size_t)mr_ * 6144 + colofs); } \
        P7B_PREF(tnext); } while (0)
#define P7B_COMPUTE(X, Xw, Xx, Xg, t, valid) do { f32x2 acc2[8]; \
        _Pragma("unroll") for (int k = 0; k < 8; ++k) acc2[k] = (f32x2){0.f, 0.f}; \
        if (PM != 1) { _Pragma("unroll") for (int i_ = 0; i_ < 16; ++i_) p7_axpy(X[i_], Xw[i_], acc2); } else { _Pragma("unroll") for (int i_ = 0; i_ < 16; ++i_) acc2[i_ >> 1][i_ & 1] = __uint_as_float((X[i_][0] ^ X[i_][1] ^ X[i_][2] ^ X[i_][3]) & 0x3fffffffu) + Xw[i_]; } \
        float b_[8]; _Pragma("unroll") for (int k = 0; k < 8; ++k) { auto s_ = __builtin_amdgcn_permlane32_swap(__float_as_uint(acc2[k >> 1][k & 1]), __float_as_uint(acc2[(k + 8) >> 1][k & 1]), false, false); b_[k] = __uint_as_float(s_[0]) + __uint_as_float(s_[1]); } \
        float c_[4]; _Pragma("unroll") for (int k = 0; k < 4; ++k) { auto s_ = __builtin_amdgcn_permlane16_swap(__float_as_uint(b_[k]), __float_as_uint(b_[k + 4]), false, false); c_[k] = __uint_as_float(s_[0]) + __uint_as_float(s_[1]); } \
        float d_[2]; _Pragma("unroll") for (int k = 0; k < 2; ++k) { const float send_ = (lane & 8) ? c_[k] : c_[k + 2]; const float keep_ = (lane & 8) ? c_[k + 2] : c_[k]; d_[k] = keep_ + DPPF(send_, 0x128); } \
        unsigned* xp_ = (unsigned*)(a.XB + (size_t)(t) * 1024 + colofs); \
        f32x2 x_ = {__uint_as_float(Xx << 16), __uint_as_float(Xx & 0xffff0000u)}; x_.x += Xg.x * d_[0]; x_.y += Xg.y * d_[1]; if ((valid) && PM == 0) *xp_ = cvt_pk_bf16(x_.x, x_.y); else if (PM != 0 && x_.x == 1.2345e30f) *xp_ = cvt_pk_bf16(x_.x, x_.y); } while (0)
    const int lastrow = a.nrows - 1;
    int t = wrank;
    P7B_PREF(t);
    P7B_ISSUE(Av, Aw, Ax, Ag, t, 0, (t + nw < a.nrows ? t + nw : lastrow));
    while (t < a.nrows) {
        const int t1 = t + nw, t2 = t1 + nw, t3 = t2 + nw;
        const int c1 = t1 < a.nrows ? t1 : lastrow, c2 = t2 < a.nrows ? t2 : lastrow, c3 = t3 < a.nrows ? t3 : lastrow;
        P7B_ISSUE(Bv, Bw, Bx, Bg, c1, 1, c2);
        P7B_COMPUTE(Av, Aw, Ax, Ag, t, true);
        P7B_ISSUE(Av, Aw, Ax, Ag, c2, 0, c3);
        P7B_COMPUTE(Bv, Bw, Bx, Bg, c1, (t1 < a.nrows));
        t = t2;
    }
#undef P7B_PREF
#undef P7B_ISSUE
#undef P7B_COMPUTE
}
__device__ __forceinline__ void phase_final_norm(const bf16_t* __restrict__ XBp, float* __restrict__ OUT, const float* __restrict__ g, int vb, int nvb) {
    int tid_ = threadIdx.x; asm volatile("" : "+v"(tid_));
    const int lane = tid_ & 63, wid = tid_ >> 6;
    for (int row = vb * 8 + wid; row < NL; row += nvb * 8) {
        const bf16_t* xp = XBp + (size_t)row * 1024; f32x4 x[4]; float ss = 0.f;
#pragma unroll
        for (int i = 0; i < 4; ++i) { const u32x2 r = *(const u32x2*)(xp + 256 * i + 4 * lane); x[i] = (f32x4){__uint_as_float(r.x << 16), __uint_as_float(r.x & 0xffff0000u), __uint_as_float(r.y << 16), __uint_as_float(r.y & 0xffff0000u)};
            ss += x[i][0] * x[i][0] + x[i][1] * x[i][1] + x[i][2] * x[i][2] + x[i][3] * x[i][3]; }
        ss = wave_sum(ss); const float rstd = rsqrtf(ss * (1.f / 1024.f) + EPS);
#pragma unroll
        for (int i = 0; i < 4; ++i) *(f32x4*)(OUT + (size_t)row * 1024 + 256 * i + 4 * lane) = x[i] * rstd * *(const f32x4*)(g + 256 * i + 4 * lane);
    }
}

template <int V_> struct IC { static constexpr int value = V_; };
typedef short s16x4 __attribute__((ext_vector_type(4)));
__device__ __forceinline__ s16x4 lds_tr16(const LAS unsigned char* p) { return __builtin_bit_cast(s16x4, __builtin_amdgcn_ds_read_tr16_b64_v4i16((LAS s16x4*)p)); }
constexpr int ATT_BUF = 20480;
__device__ __forceinline__ void glds16(const void* g, unsigned lds_base) {
    unsigned sv; asm volatile("s_mov_b32 %0, m0\n\ts_mov_b32 m0, %2\n\ts_nop 0\n\tglobal_load_lds_dwordx4 %1, off\n\ts_mov_b32 m0, %0" : "=&s"(sv) : "v"(g), "s"(lds_base) : "memory"); }
template <int DK>
__device__ __forceinline__ void attn_unit(LAS unsigned char* lds, const bf16_t* __restrict__ Q, const bf16_t* __restrict__ K1, const bf16_t* __restrict__ K2, const bf16_t* __restrict__ V,
                                          int nkeys, float c2, bf16_t* __restrict__ out) {
    int tid_ = threadIdx.x; asm volatile("" : "+v"(tid_));
    const int tid = tid_, lane = tid & 63, wid = __builtin_amdgcn_readfirstlane(tid >> 6), r32 = lane & 31, hi = lane >> 5;
    constexpr int NS = DK / 16, NM = 2 * NS;
    bf16x8 qf[NS];
    { const bf16_t* qp = Q + (size_t)(wid * 32 + r32) * DK + 8 * hi;
#pragma unroll
      for (int s = 0; s < NS; ++s) qf[s] = *(const bf16x8*)(qp + 16 * s); }
    const int dkey = 8 * wid + (lane >> 3), dkey2 = 16 * (wid & 3) + (lane >> 2);
    const bf16_t* gk1 = K1 + (size_t)dkey * 64 + (((lane & 7) ^ ((dkey >> 1) & 7)) << 3);
    const bf16_t* gv = V + (size_t)dkey * 64 + (((lane & 7) ^ (((dkey >> 1) & 1) << 2)) << 3);
    const bf16_t* gk2 = (DK == 96) ? K2 + (size_t)dkey2 * 32 + (((lane & 3) ^ ((dkey2 >> 2) & 3)) << 3) : nullptr;
    const unsigned lds0 = (unsigned)(size_t)lds;
    const unsigned d_k1 = lds0 + wid * 1024, d_v = lds0 + 8192 + wid * 1024, d_k2 = lds0 + 16384 + (wid & 3) * 1024;
#define ATT_DMA(tile_, slot_) do { const int tt_ = (tile_); glds16(gk1 + (size_t)tt_ * 4096, (unsigned)__builtin_amdgcn_readfirstlane(d_k1 + (slot_) * ATT_BUF)); \
        glds16(gv + (size_t)tt_ * 4096, (unsigned)__builtin_amdgcn_readfirstlane(d_v + (slot_) * ATT_BUF)); \
        if (DK == 96) glds16(gk2 + (size_t)tt_ * 2048, (unsigned)__builtin_amdgcn_readfirstlane(d_k2 + (slot_) * ATT_BUF)); } while (0)
#define ATT_WAIT_BAR() do { if (DK == 96) asm volatile("s_waitcnt vmcnt(3) lgkmcnt(0)\n\ts_barrier" ::: "memory"); else asm volatile("s_waitcnt vmcnt(2) lgkmcnt(0)\n\ts_barrier" ::: "memory"); } while (0)
    unsigned ka[2][4];
#pragma unroll
    for (int kt = 0; kt < 2; ++kt)
#pragma unroll
        for (int s = 0; s < 4; ++s) { const int key = 32 * kt + r32; ka[kt][s] = key * 128 + (((2 * s + hi) ^ ((key >> 1) & 7)) << 4); }
    unsigned kb[2][2];
#pragma unroll
    for (int kt = 0; kt < 2; ++kt)
#pragma unroll
        for (int s = 0; s < 2; ++s) { const int key = 32 * kt + r32; kb[kt][s] = 16384 + key * 64 + (((2 * s + hi) ^ ((key >> 2) & 3)) << 4); }
    const int vq = (lane & 15) >> 2, vp = lane & 3, vg = (lane >> 4) & 1;
    unsigned va[2];
#pragma unroll
    for (int dvb = 0; dvb < 2; ++dvb) { const int key = 4 * hi + vq; va[dvb] = 8192 + key * 128 + ((((32 * dvb + 16 * vg + 4 * vp) * 2)) ^ (((key >> 1) & 1) << 6)); }
    float m = -1e30f, l = 0.f, mx;
    f32x16 o0 = {}, o1 = {};
    const int NT = nkeys >> 6;
    ATT_DMA(0, 0); ATT_DMA(NT > 1 ? 1 : 0, 1); ATT_DMA(NT > 2 ? 2 : NT - 1, 2);
    asm volatile("s_waitcnt vmcnt(0) lgkmcnt(0)\n\ts_barrier" ::: "memory");
    f32x16 pa0 = {}, pa1 = {}, pb0 = {}, pb1 = {};
    {
        bf16x8 kf0[NS], kf1[NS];
#pragma unroll
        for (int s = 0; s < 4; ++s) { kf0[s] = *(const LAS bf16x8*)(lds + ka[0][s]); kf1[s] = *(const LAS bf16x8*)(lds + ka[1][s]); }
        if (DK == 96) {
#pragma unroll
            for (int s = 0; s < 2; ++s) { kf0[4 + s] = *(const LAS bf16x8*)(lds + kb[0][s]); kf1[4 + s] = *(const LAS bf16x8*)(lds + kb[1][s]); }
        }
#pragma unroll
        for (int s = 0; s < NS; ++s) { pa0 = mfma32(kf0[s], qf[s], pa0); pa1 = mfma32(kf1[s], qf[s], pa1); }
        mx = pa0[0];
#pragma unroll
        for (int r = 1; r < 16; ++r) mx = fmaxf(mx, pa0[r]);
#pragma unroll
        for (int r = 0; r < 16; ++r) mx = fmaxf(mx, pa1[r]);
    }
    auto step = [&](auto bc_, auto bn_, auto bw_, f32x16& pc0, f32x16& pc1, f32x16& pn0, f32x16& pn1, int t) __attribute__((always_inline)) {
        constexpr int BC = decltype(bc_)::value * ATT_BUF, BN = decltype(bn_)::value * ATT_BUF;
        ATT_DMA((t + 3 < NT) ? t + 3 : NT - 1, decltype(bw_)::value);
        bf16x8 kf0[NS], kf1[NS];
#pragma unroll
        for (int s = 0; s < 4; ++s) { kf0[s] = *(const LAS bf16x8*)(lds + BN + ka[0][s]); kf1[s] = *(const LAS bf16x8*)(lds + BN + ka[1][s]); }
        if (DK == 96) {
#pragma unroll
            for (int s = 0; s < 2; ++s) { kf0[4 + s] = *(const LAS bf16x8*)(lds + BN + kb[0][s]); kf1[4 + s] = *(const LAS bf16x8*)(lds + BN + kb[1][s]); }
        }
        __builtin_amdgcn_sched_barrier(0);
        { auto rr = __builtin_amdgcn_permlane32_swap(__float_as_uint(mx), __float_as_uint(mx), false, false); mx = fmaxf(__uint_as_float(rr[0]), __uint_as_float(rr[1])); }
        const float tm = mx;
        if (__any(tm > m + 8.f)) {
            const float mn = fmaxf(m, tm), al = __builtin_amdgcn_exp2f(m - mn); m = mn; l *= al;
#pragma unroll
            for (int r = 0; r < 16; ++r) { o0[r] *= al; o1[r] *= al; }
        }
        const float nm = -m; float ls = 0.f;
        pn0 = f32x16{}; pn1 = f32x16{};
        unsigned pw[16];
        s16x4 vlo[2][2][2], vhi[2][2][2];
#pragma unroll
        for (int c = 0; c < 8; ++c) {
            __builtin_amdgcn_sched_barrier(0);
#pragma unroll
            for (int j = 0; j < NM; ++j) if (j >= c * NM / 8 && j < (c + 1) * NM / 8) { if (j & 1) pn1 = mfma32(kf1[j >> 1], qf[j >> 1], pn1); else pn0 = mfma32(kf0[j >> 1], qf[j >> 1], pn0); }
            if (c == 4) {
#pragma unroll
                for (int kt = 0; kt < 2; ++kt)
#pragma unroll
                    for (int sp = 0; sp < 2; ++sp) { const int kofs = (32 * kt + 16 * sp) * 128;
#pragma unroll
                        for (int dvb = 0; dvb < 2; ++dvb) { vlo[dvb][kt][sp] = lds_tr16(lds + BC + va[dvb] + kofs); vhi[dvb][kt][sp] = lds_tr16(lds + BC + va[dvb] + kofs + 8 * 128); } }
            }
            __builtin_amdgcn_sched_barrier(0);
            if (c < 4) {
#pragma unroll
                for (int i = 0; i < 4; ++i) { const int r = 4 * c + i; pc0[r] = __builtin_amdgcn_exp2f(pc0[r] + nm); ls += pc0[r]; }
                pw[2 * c] = cvt_pk_bf16(pc0[4 * c], pc0[4 * c + 1]); pw[2 * c + 1] = cvt_pk_bf16(pc0[4 * c + 2], pc0[4 * c + 3]);
            } else {
#pragma unroll
                for (int i = 0; i < 4; ++i) { const int r = 4 * (c - 4) + i; pc1[r] = __builtin_amdgcn_exp2f(pc1[r] + nm); ls += pc1[r]; }
                pw[8 + 2 * (c - 4)] = cvt_pk_bf16(pc1[4 * (c - 4)], pc1[4 * (c - 4) + 1]); pw[8 + 2 * (c - 4) + 1] = cvt_pk_bf16(pc1[4 * (c - 4) + 2], pc1[4 * (c - 4) + 3]);
            }
        }
        __builtin_amdgcn_sched_barrier(0);
        l += ls;
        float mxn = -3.0e38f;
#pragma unroll
        for (int k = 0; k < 8; ++k) { const int kt = k >> 2, sp = (k >> 1) & 1, dvb = k & 1;
            const u32x4 pq = (u32x4){pw[8 * kt + 4 * sp], pw[8 * kt + 4 * sp + 1], pw[8 * kt + 4 * sp + 2], pw[8 * kt + 4 * sp + 3]};
            const s16x4 lo = vlo[dvb][kt][sp], hi4 = vhi[dvb][kt][sp]; const bf16x8 vf = (bf16x8){lo[0], lo[1], lo[2], lo[3], hi4[0], hi4[1], hi4[2], hi4[3]};
            if (dvb == 0) o0 = mfma32(vf, __builtin_bit_cast(bf16x8, pq), o0); else o1 = mfma32(vf, __builtin_bit_cast(bf16x8, pq), o1);
            __builtin_amdgcn_sched_barrier(0);
            if (k < 4) { mxn = fmaxf(fmaxf(mxn, pn0[4 * k]), fmaxf(pn0[4 * k + 1], fmaxf(pn0[4 * k + 2], pn0[4 * k + 3]))); }
            else { mxn = fmaxf(fmaxf(mxn, pn1[4 * (k - 4)]), fmaxf(pn1[4 * (k - 4) + 1], fmaxf(pn1[4 * (k - 4) + 2], pn1[4 * (k - 4) + 3]))); }
            __builtin_amdgcn_sched_barrier(0);
        }
        mx = mxn;
        ATT_WAIT_BAR();
    };
    for (int t = 0; t < NT; t += 4) {
        step(IC<0>{}, IC<1>{}, IC<3>{}, pa0, pa1, pb0, pb1, t);
        step(IC<1>{}, IC<2>{}, IC<0>{}, pb0, pb1, pa0, pa1, t + 1);
        step(IC<2>{}, IC<3>{}, IC<1>{}, pa0, pa1, pb0, pb1, t + 2);
        step(IC<3>{}, IC<0>{}, IC<2>{}, pb0, pb1, pa0, pa1, t + 3);
    }
    { auto rr = __builtin_amdgcn_permlane32_swap(__float_as_uint(l), __float_as_uint(l), false, false); l = __uint_as_float(rr[0]) + __uint_as_float(rr[1]); }
    const float il = 1.f / l;
    bf16_t* op = out + (size_t)(wid * 32 + r32) * 1024 + 4 * hi;
#pragma unroll
    for (int g = 0; g < 4; ++g) { u32x2 a, b;
        a.x = cvt_pk_bf16(o0[4 * g] * il, o0[4 * g + 1] * il); a.y = cvt_pk_bf16(o0[4 * g + 2] * il, o0[4 * g + 3] * il);
        b.x = cvt_pk_bf16(o1[4 * g] * il, o1[4 * g + 1] * il); b.y = cvt_pk_bf16(o1[4 * g + 2] * il, o1[4 * g + 3] * il);
        *(u32x2*)(op + 8 * g) = a; *(u32x2*)(op + 32 + 8 * g) = b; }
}
#undef ATT_DMA
#undef ATT_WAIT_BAR
__device__ __forceinline__ void phase_p3(LAS unsigned char* lds, const WS& w, int l, int vb, int nvb, int xpart, int xrank) {
    const float c2g = 0.125f * 1.4426950408889634f, c2m = 0.10206207261596577f * 1.4426950408889634f;
    bf16_t* MIX = w.H();
    const int nlat = NB * 12 * 8, nctx = (l == 0) ? NB * 12 : 0;
    const bool xl = (nvb == 256);
    for (int u = vb; u < nlat + nctx; u += nvb) {
        if (u < nlat) {
            int qb, slot, b;
            if (xl) { const int grp = (u >> 8) * 32 + 4 * xpart + (xrank >> 3); qb = xrank & 7; slot = grp % 12; b = grp / 12; }
            else { qb = u & 7; slot = (u >> 3) % 12; b = u / 96; }
            bf16_t* out = MIX + ((size_t)b * S + qb * 256) * 1024;
            if (slot < 6) attn_unit<64>(lds, w.Qg() + (((size_t)b * 6 + slot) * S + qb * 256) * 64, w.Kg() + ((size_t)b * 2 + slot / 3) * KEYS * 64, nullptr, w.Vg() + ((size_t)b * 2 + slot / 3) * KEYS * 64, KEYS, c2g, out + slot * 64);
            else { const int h = slot - 6; attn_unit<96>(lds, w.Qm() + (((size_t)b * 6 + h) * S + qb * 256) * 96, w.Kmn() + ((size_t)b * 6 + h) * KEYS * 64, w.KR() + (size_t)b * KEYS * 32, w.Vm() + ((size_t)b * 6 + h) * KEYS * 64, KEYS, c2m, out + 640 + h * 64); }
        } else {
            const int v = u - nlat, slot = v % 12, b = v / 12;
            bf16_t* out = MIX + ((size_t)NL + (size_t)b * CTX) * 1024;
            if (slot < 6) attn_unit<64>(lds, w.Qgc() + ((size_t)b * 6 + slot) * CTX * 64, w.Kg() + ((size_t)b * 2 + slot / 3) * KEYS * 64, nullptr, w.Vg() + ((size_t)b * 2 + slot / 3) * KEYS * 64, CTX, c2g, out + slot * 64);
            else { const int h = slot - 6; attn_unit<96>(lds, w.Qmc() + ((size_t)b * 6 + h) * CTX * 96, w.Kmn() + ((size_t)b * 6 + h) * KEYS * 64, w.KR() + (size_t)b * KEYS * 32, w.Vm() + ((size_t)b * 6 + h) * KEYS * 64, CTX, c2m, out + 640 + h * 64); }
        }
    }
}

__device__ __forceinline__ unsigned fkey(float f, unsigned tag, unsigned mask) { return (__float_as_uint(f) & ~mask) | tag; }
__device__ __forceinline__ float keyf(unsigned k, unsigned mask) { return __uint_as_float(k & ~mask); }
__device__ __forceinline__ unsigned fmax_u(unsigned a, unsigned b) { unsigned r; asm("v_max_f32 %0, %1, %2" : "=v"(r) : "v"(a), "v"(b)); return r; }
__device__ __forceinline__ unsigned fmin_u(unsigned a, unsigned b) { unsigned r; asm("v_min_f32 %0, %1, %2" : "=v"(r) : "v"(a), "v"(b)); return r; }
__device__ __forceinline__ void ce_desc(unsigned& a, unsigned& b) { const unsigned hi_ = fmax_u(a, b), lo_ = fmin_u(a, b); a = hi_; b = lo_; }
template <int J> __device__ __forceinline__ void bstage16(unsigned* a) {
#pragma unroll
    for (int i = 0; i < 16; ++i) { const int l = i ^ J; if (l > i) ce_desc(a[i], a[l]); }
}
__device__ __forceinline__ void sort16_desc(unsigned* a) {
#define CE_(i, j) ce_desc(a[i], a[j]);
    CE_(0, 13) CE_(1, 12) CE_(2, 15) CE_(3, 14) CE_(4, 8) CE_(5, 6) CE_(7, 11) CE_(9, 10)
    CE_(0, 5) CE_(1, 7) CE_(2, 9) CE_(3, 4) CE_(6, 13) CE_(8, 14) CE_(10, 15) CE_(11, 12)
    CE_(0, 1) CE_(2, 3) CE_(4, 5) CE_(6, 8) CE_(7, 9) CE_(10, 11) CE_(12, 13) CE_(14, 15)
    CE_(0, 2) CE_(1, 3) CE_(4, 10) CE_(5, 11) CE_(6, 7) CE_(8, 9) CE_(12, 14) CE_(13, 15)
    CE_(1, 2) CE_(3, 12) CE_(4, 6) CE_(5, 7) CE_(8, 10) CE_(9, 11) CE_(13, 14)
    CE_(1, 4) CE_(2, 6) CE_(5, 8) CE_(7, 10) CE_(9, 13) CE_(11, 14)
    CE_(2, 4) CE_(3, 6) CE_(9, 12) CE_(11, 13)
    CE_(3, 5) CE_(6, 8) CE_(7, 9) CE_(10, 12)
    CE_(3, 4) CE_(5, 6) CE_(7, 8) CE_(9, 10) CE_(11, 12)
    CE_(6, 7) CE_(8, 9)
#undef CE_
}
__device__ __forceinline__ void bmerge16_desc(unsigned* c) { bstage16<8>(c); bstage16<4>(c); bstage16<2>(c); bstage16<1>(c); }
__device__ __forceinline__ void merge_top16(unsigned* a, const unsigned* b) {
#pragma unroll
    for (int i = 0; i < 16; ++i) a[i] = fmax_u(a[i], b[15 - i]);
    bmerge16_desc(a);
}
__device__ __forceinline__ void xlane_top16(unsigned* t, int hi) {
    unsigned r[16]; const unsigned msk = 0u - (unsigned)hi;
#pragma unroll
    for (int i = 0; i < 16; ++i) r[i] = t[i] ^ ((t[i] ^ t[15 - i]) & msk);
#pragma unroll
    for (int i = 0; i < 16; ++i) { auto s = __builtin_amdgcn_permlane32_swap(r[i], r[i], false, false); t[i] = fmax_u(s[0], s[1]); }
    bmerge16_desc(t);
}
__device__ __forceinline__ constexpr int cand_a(int c) { return c < 16 ? 0 : c < 24 ? 1 : c < 32 ? 39 - c : c < 37 ? 2 : c < 41 ? 3 : c < 44 ? 4 : c < 46 ? 5 : c < 48 ? 6 : 7; }
__device__ __forceinline__ constexpr int cand_b(int c) { return c < 16 ? c : c < 24 ? c - 16 : c < 32 ? 0 : c < 37 ? c - 32 : c < 41 ? c - 37 : c < 44 ? c - 41 : c < 46 ? c - 44 : c < 48 ? c - 46 : c - 48; }

__device__ __forceinline__ void phase_p6b(LAS unsigned char* lds, const bf16_t* __restrict__ PQ, const bf16_t* __restrict__ SubKl, unsigned* __restrict__ EG, int nrows, int vb, int nvb) {
    int tid_ = threadIdx.x; asm volatile("" : "+v"(tid_));
    const int tid = tid_, lane = tid & 63, wid = __builtin_amdgcn_readfirstlane(tid >> 6), r32 = lane & 31, hi = lane >> 5;
    const int h = vb & 7, wrank = (vb >> 3) * 8 + wid, nwr = (nvb >> 3) * 8;
    LAS unsigned short* tab = (LAS unsigned short*)(lds + 65536 + wid * 4096) + r32 * 64;
#pragma unroll
    for (int i = 0; i < 8; ++i) { const int idx = i * 512 + tid, p = idx >> 11, key = (idx >> 4) & 127, ch = idx & 15;
        *(LAS u32x4*)(lds + p * 32768 + key * 256 + ((ch ^ (key & 15)) << 4)) = *(const u32x4*)(SubKl + ((size_t)(h * 2 + p) * 128 + key) * 128 + ch * 8); }
    __syncthreads();
    const int ngroups = nrows >> 5;
    for (int tg = wrank; tg < ngroups; tg += nwr) {
        const int row0 = tg << 5;
        bf16x8 qf[2][8];
        { const bf16_t* qp = PQ + (size_t)(row0 + r32) * 2048 + h * 256 + 8 * hi; asm volatile("" : "+v"(qp));
#pragma unroll
          for (int p = 0; p < 2; ++p)
#pragma unroll
              for (int s = 0; s < 8; ++s) qf[p][s] = *(const bf16x8*)(qp + p * 128 + 16 * s); }
        unsigned top[2][16];
#pragma unroll
        for (int p = 0; p < 2; ++p) {
            f32x16 acc[4];
#pragma unroll
            for (int kt = 0; kt < 4; ++kt) { acc[kt] = f32x16{}; const int key = 32 * kt + r32;
#pragma unroll
                for (int s = 0; s < 8; ++s) acc[kt] = mfma32(*(const LAS bf16x8*)(lds + p * 32768 + key * 256 + (((2 * s + hi) ^ (key & 15)) << 4)), qf[p][s], acc[kt]); }
            unsigned key[64];
#pragma unroll
            for (int kt = 0; kt < 4; ++kt)
#pragma unroll
                for (int r = 0; r < 16; ++r) { const int n = 32 * kt + (r & 3) + 8 * (r >> 2) + 4 * hi; key[16 * kt + r] = fkey(acc[kt][r], 127u - (unsigned)n, 127u); }
            sort16_desc(key); sort16_desc(key + 16); sort16_desc(key + 32); sort16_desc(key + 48);
            merge_top16(key, key + 16); merge_top16(key + 32, key + 48); merge_top16(key, key + 32);
            xlane_top16(key, hi);
#pragma unroll
            for (int i = 0; i < 16; ++i) top[p][i] = key[i];
        }
        float t0f[16], t1f[16];
#pragma unroll
        for (int i = 0; i < 16; ++i) { t0f[i] = keyf(top[0][i], 127u); t1f[i] = keyf(top[1][i], 127u); }
        unsigned ck[50];
#pragma unroll
        for (int c = 0; c < 50; ++c) ck[c] = fkey(t0f[cand_a(c)] + t1f[cand_b(c)], (unsigned)c, 63u);
        if (hi == 0) {
#pragma unroll
            for (int c = 0; c < 50; c += 2) {
                const unsigned ea = (127u - (top[0][cand_a(c)] & 127u)) * 128u + (127u - (top[1][cand_b(c)] & 127u));
                const unsigned eb = (127u - (top[0][cand_a(c + 1)] & 127u)) * 128u + (127u - (top[1][cand_b(c + 1)] & 127u));
                *(LAS unsigned*)(tab + c) = ea | (eb << 16);
            }
        }
        bmerge16_desc(ck + 16); sort16_desc(ck + 32);
        merge_top16(ck, ck + 16); merge_top16(ck, ck + 32);
        ck[15] = fmax_u(ck[15], ck[48]); ck[14] = fmax_u(ck[14], ck[49]); bmerge16_desc(ck);
        asm volatile("s_waitcnt lgkmcnt(0)" ::: "memory");
        const float mx = keyf(ck[0], 63u); float e[16], den = 0.f;
#pragma unroll
        for (int j = 0; j < 16; ++j) { e[j] = __builtin_amdgcn_exp2f((keyf(ck[j], 63u) - mx) * 1.4426950408889634f); den += e[j]; }
        const float iden = 1.f / den;
        if (hi == 0) {
            unsigned o[16];
#pragma unroll
            for (int j = 0; j < 16; ++j) { const unsigned eid = tab[ck[j] & 63u]; o[j] = (eid << 16) | (cvt_pk_bf16(e[j] * iden, 0.f) & 0xffffu); }
            unsigned* dst = EG + (size_t)(row0 + r32) * 128 + h * 16;
#pragma unroll
            for (int j = 0; j < 16; j += 4) *(u32x4*)(dst + j) = (u32x4){o[j], o[j + 1], o[j + 2], o[j + 3]};
        }
        asm volatile("s_waitcnt lgkmcnt(0)" ::: "memory");
    }
}


#define XB_TMO      128
#define XB_XCNT(j)  (256  + 64 * (j))
#define XB_XSUB(j)  (1280 + 64 * (j))
#define XB_XGEN(j)  (2304 + 64 * (j))
#define XB_TOP      3328
#define XB_TOPGEN   3392
#define XCD_BAR_WORDS 3456
#define XB_SPIN_CAP (1u << 18)

__device__ __forceinline__ unsigned xb_ld(unsigned* p)              { return __hip_atomic_load(p, __ATOMIC_RELAXED, __HIP_MEMORY_SCOPE_AGENT); }
__device__ __forceinline__ unsigned xb_add(unsigned* p, unsigned v) { return __hip_atomic_fetch_add(p, v, __ATOMIC_RELAXED, __HIP_MEMORY_SCOPE_AGENT); }
__device__ __forceinline__ unsigned xb_xcc_id() { return (unsigned)__builtin_amdgcn_s_getreg((3 << 11) | 20) & 0xFu; }
#define XB_SPIN(cond, bar) do { unsigned _sp = 0; while (cond) { __builtin_amdgcn_s_sleep(1); \
    if ((++_sp & 255u) == 0u) { if (xb_ld(&(bar)[XB_TMO])) break; if (_sp > XB_SPIN_CAP) { atomicAdd(&(bar)[XB_TMO], 1u); break; } } } } while (0)

struct XcdBarrier {
    unsigned* bar; unsigned x;
    volatile LAS unsigned* st;
};

__device__ __forceinline__ XcdBarrier xcd_barrier_post(unsigned* bar, volatile LAS unsigned* st) {
    XcdBarrier b; b.bar = bar; b.x = xb_xcc_id(); b.st = st;
    if (threadIdx.x == 0) (void)xb_add(&bar[XB_XCNT(b.x)], 1u);
    return b;
}
__device__ __forceinline__ void xcd_barrier_complete(unsigned* bar, unsigned x, unsigned& nloc, unsigned& nx) {
    const unsigned G = gridDim.x * gridDim.y * gridDim.z;
    unsigned sum, cnt, mine, sp = 0u;
    for (;;) {
        sum = 0u; cnt = 0u; mine = 0u;
#pragma unroll
        for (unsigned j = 0; j < 16; ++j) { const unsigned c = xb_ld(&bar[XB_XCNT(j)]); sum += c; cnt += (c > 0u) ? 1u : 0u; mine = (j == x) ? c : mine; }
        if (sum == G) break;
        __builtin_amdgcn_s_sleep(1);
        if ((++sp & 255u) == 0u) { if (xb_ld(&bar[XB_TMO])) break; if (sp > XB_SPIN_CAP) { atomicAdd(&bar[XB_TMO], 1u); break; } }
    }
    nloc = mine > 0u ? mine : 1u; nx = cnt > 0u ? cnt : 1u;
}

__device__ __forceinline__ void xcd_barrier(const XcdBarrier& b) {
    asm volatile("s_waitcnt vmcnt(0)" ::: "memory");
    __syncthreads();
    if (threadIdx.x == 0) {
        unsigned* bar = b.bar;
        __builtin_amdgcn_s_waitcnt(0);
        unsigned nloc = b.st[0], nx = b.st[1];
        if (nloc == 0u) { xcd_barrier_complete(bar, b.x, nloc, nx); b.st[0] = nloc; b.st[1] = nx; }
        const unsigned old = xb_add(&bar[XB_XSUB(b.x)], 1u);
        const unsigned gen = old / nloc;
        if (old + 1u == (gen + 1u) * nloc) {
            __builtin_amdgcn_fence(__ATOMIC_RELEASE, "agent");
            asm volatile("s_waitcnt vmcnt(0)" ::: "memory");
            const unsigned og = xb_add(&bar[XB_TOP], 1u);
            const unsigned tg = og / nx;
            if (og + 1u == (tg + 1u) * nx) xb_add(&bar[XB_TOPGEN], 1u);
            else XB_SPIN(xb_ld(&bar[XB_TOPGEN]) == tg, bar);
            __builtin_amdgcn_fence(__ATOMIC_ACQUIRE, "agent");
            xb_add(&bar[XB_XGEN(b.x)], 1u);
            asm volatile("s_waitcnt vmcnt(0)" ::: "memory");
        } else {
            XB_SPIN(xb_ld(&bar[XB_XGEN(b.x)]) == gen, bar);
            __builtin_amdgcn_fence(__ATOMIC_ACQUIRE, "agent");
            asm volatile("s_waitcnt vmcnt(0)" ::: "memory");
        }
    }
    __syncthreads();
}

__device__ __forceinline__ void phase_mod(LAS unsigned char* lds, const Inputs& in, const WS& w, int vb) {
    if (vb >= 72) return;
    LAS float* sc = (LAS float*)lds;
    int tid_ = threadIdx.x; asm volatile("" : "+v"(tid_));
    const int tid = tid_, idx = vb * 512 + tid, rg = idx / 12288, ln = idx % 12288, l = ln / 6144, n = ln % 6144;
    float acc[11];
#pragma unroll
    for (int i = 0; i < 11; ++i) acc[i] = 0.f;
    const float* wp = in.ada_w + (size_t)l * 1024 * 6144 + n;
    for (int kc = 0; kc < 4; ++kc) {
        for (int i = tid; i < 33 * 256; i += 512) { const int r = i >> 8, k = kc * 256 + (i & 255); const float v = r < 32 ? in.c[(size_t)r * 1024 + k] : in.c_ctx[k]; sc[i] = v / (1.f + __expf(-v)); }
        __syncthreads();
        for (int k = 0; k < 256; ++k) { const float wv = wp[(size_t)(kc * 256 + k) * 6144];
#pragma unroll
            for (int i = 0; i < 11; ++i) acc[i] += sc[(rg * 11 + i) * 256 + k] * wv; }
        __syncthreads();
    }
    const float bias = in.ada_b[(size_t)l * 6144 + n];
#pragma unroll
    for (int i = 0; i < 11; ++i) w.MOD()[((size_t)l * 33 + rg * 11 + i) * 6144 + n] = acc[i] + bias;
}
__device__ __forceinline__ void phase_rope(const WS& w, int vb, int nvb) {
    int tid_ = threadIdx.x; asm volatile("" : "+v"(tid_));
    for (int i = vb * 512 + tid_; i < 2048 * 32; i += nvb * 512) {
        { const int t = i / 32, j = i % 32; const double inv = pow(10000.0, -(double)(j % 16) / 16.0); const double a = (double)(j < 16 ? t / 64 : t % 64) * inv; w.ROPA()[i] = make_float2((float)cos(a), (float)sin(a)); }
        if (i < 2048 * 16) { const int t = i / 16, j = i % 16; const double inv = pow(10000.0, -(double)(j % 8) / 8.0); const double a = (double)(j < 8 ? t / 64 : t % 64) * inv; w.ROPC()[i] = make_float2((float)cos(a), (float)sin(a)); }
    }
}

#ifndef PROBE_MASK
#define PROBE_MASK 0
#endif
#ifndef BENCH_MODE
#define BENCH_MODE 0
#endif
#if BENCH_MODE
__device__ __forceinline__ void phase_bench(float* sink) {
    int tid_ = threadIdx.x; asm volatile("" : "+v"(tid_));
    float x[16];
#pragma unroll
    for (int i = 0; i < 16; ++i) x[i] = (float)(tid_ + i) * 0.001f;
    f32x16 acc[4] = {};
    bf16x8 a = (bf16x8){(short)tid_, 1, 2, 3, 4, 5, 6, 7}, b = (bf16x8){7, 6, 5, 4, 3, 2, 1, (short)tid_};
#pragma nounroll
    for (int it = 0; it < ((BENCH_MODE & 7) ? 2048 : 0); ++it) {
#pragma unroll
        for (int k = 0; k < 8; ++k) {
            if (BENCH_MODE & 2) { acc[k & 3] = mfma32(a, b, acc[k & 3]); }
            __builtin_amdgcn_sched_barrier(0);
            if (BENCH_MODE & 1) { asm volatile("v_exp_f32 %0, -|%0|" : "+v"(x[2 * k])); asm volatile("v_exp_f32 %0, -|%0|" : "+v"(x[2 * k + 1])); }
            if (BENCH_MODE & 4) {
#pragma unroll
                for (int j = 0; j < 8; ++j) asm volatile("v_fma_f32 %0, %0, %0, %0" : "+v"(x[(2 * k + j) & 15]));
            }
            __builtin_amdgcn_sched_barrier(0);
        }
    }
    if (BENCH_MODE & 24) {
        const int lane = tid_ & 63, r32 = lane & 31, hi = lane >> 5;
        unsigned ka[2][4];
#pragma unroll
        for (int kt = 0; kt < 2; ++kt)
#pragma unroll
            for (int s_ = 0; s_ < 4; ++s_) { const int key = 32 * kt + r32; ka[kt][s_] = key * 128 + (((2 * s_ + hi) ^ ((key >> 1) & 7)) << 4); }
        const int vq = (lane & 15) >> 2, vp = lane & 3, vg = (lane >> 4) & 1;
        unsigned va[2];
#pragma unroll
        for (int dvb = 0; dvb < 2; ++dvb) { const int key = 4 * hi + vq; va[dvb] = 8192 + key * 128 + ((((32 * dvb + 16 * vg + 4 * vp) * 2)) ^ (((key >> 1) & 1) << 6)); }
        u32x4 kr[8]; u32x2 vr[16];
#pragma nounroll
        for (int it = 0; it < 2048; ++it) {
            if (BENCH_MODE & 8) {
#pragma unroll
                for (int kt = 0; kt < 2; ++kt)
#pragma unroll
                    for (int s_ = 0; s_ < 4; ++s_) asm volatile("ds_read_b128 %0, %1" : "=v"(kr[kt * 4 + s_]) : "v"(ka[kt][s_]));
            }
            if (BENCH_MODE & 16) {
#pragma unroll
                for (int q = 0; q < 4; ++q)
#pragma unroll
                    for (int dvb = 0; dvb < 2; ++dvb) { asm volatile("ds_read_b64_tr_b16 %0, %1" : "=v"(vr[q * 4 + dvb * 2]) : "v"(va[dvb] + q * 2048)); asm volatile("ds_read_b64_tr_b16 %0, %1 offset:1024" : "=v"(vr[q * 4 + dvb * 2 + 1]) : "v"(va[dvb] + q * 2048)); }
            }
            asm volatile("s_waitcnt lgkmcnt(0)" ::: "memory");
        }
        if (BENCH_MODE & 8) {
#pragma unroll
            for (int i = 0; i < 8; ++i) x[i] += __uint_as_float(kr[i][0] ^ kr[i][1] ^ kr[i][2] ^ kr[i][3]);
        }
        if (BENCH_MODE & 16) {
#pragma unroll
            for (int i = 0; i < 16; ++i) x[i] += __uint_as_float(vr[i][0] ^ vr[i][1]);
        }
    }
    float r = 0.f;
#pragma unroll
    for (int i = 0; i < 16; ++i) r += x[i];
#pragma unroll
    for (int k = 0; k < 4; ++k)
#pragma unroll
        for (int i = 0; i < 16; ++i) r += acc[k][i];
    if (r == 1.2345e30f) sink[tid_] = r;
}
#endif
struct MegaArgs { Inputs in; WS w; float* XL; unsigned* bar; };
constexpr int MEGA_LDS = 131072 + 16;
__global__ void __launch_bounds__(512, 2) k_mega(MegaArgs A) {
    LAS unsigned char* lds = (LAS unsigned char*)dyn_lds;
    const int vb = blockIdx.x, nvb = gridDim.x;
    volatile LAS unsigned* xbw = (volatile LAS unsigned*)(lds + 131072);
    if (threadIdx.x == 0) { xbw[0] = 0u; xbw[1] = 0u; xbw[2] = 0u; xbw[3] = 0u; }
    __syncthreads();
    XcdBarrier bar = xcd_barrier_post(A.bar, xbw);
    if (threadIdx.x == 0) xbw[2] = xb_add(&A.bar[3584 + 64 * bar.x], 1u);
    __syncthreads();
    const int xticket = __builtin_amdgcn_readfirstlane((int)xbw[2]);
    const WS& w = A.w; const Inputs& in = A.in;
    phase_mod(lds, in, w, vb);
    phase_rope(w, vb, nvb);
    phase_cvt(lds, in, w, vb, nvb);
    xcd_barrier(bar);
    phase_modulate<false>(in.x, in.ctx, nullptr, w.H(), in.norm1_g, w.MOD(), 0, NR, vb, nvb);
    xcd_barrier(bar);
#if (PROBE_MASK >> 0) & 1
    phase_mod(lds, in, w, vb);
    phase_rope(w, vb, nvb);
    phase_cvt(lds, in, w, vb, nvb);
    xcd_barrier(bar);
    phase_modulate<false>(in.x, in.ctx, nullptr, w.H(), in.norm1_g, w.MOD(), 0, NR, vb, nvb);
    xcd_barrier(bar);
#endif
#if BENCH_MODE
    phase_bench((float*)w.RSQ());
#endif
    int xpart = vb & 7, xrank = vb >> 3;
    { bool okx = (bar.x < 8u); for (unsigned j = 0; j < 8; ++j) okx = okx && (xb_ld(&A.bar[XB_XCNT(j)]) == (unsigned)(nvb >> 3));
      if (okx) { xpart = (int)bar.x; xrank = xticket; } }
    for (int l = 0; l < DEPTH; ++l) {
        const float* MODl = w.MOD() + (size_t)l * 33 * 6144;
        const bool last = (l == DEPTH - 1);
        const int MR = last ? NL : NR;
        phase_p1(lds, w, in, l, vb, nvb); xcd_barrier(bar);
#if (PROBE_MASK >> 1) & 1
        phase_p1(lds, w, in, l, vb, nvb); xcd_barrier(bar);
#endif
        phase_p2(lds, w, in, l, vb, nvb); xcd_barrier(bar);
#if (PROBE_MASK >> 12) & 7
        phase_p2(lds, w, in, l, vb, nvb, (PROBE_MASK >> 12) & 7); xcd_barrier(bar);
#endif
        phase_p3(lds, w, l, vb, nvb, xpart, xrank); xcd_barrier(bar);
#if (PROBE_MASK >> 3) & 1
        phase_p3(lds, w, l, vb, nvb, xpart, xrank); xcd_barrier(bar);
#endif
        phase_p4(lds, w, in, l, vb, nvb);
        xcd_barrier(bar);
#if (PROBE_MASK >> 4) & 1
        phase_p4(lds, w, in, l, vb, nvb);
        xcd_barrier(bar);
#endif
        if (l == 0) phase_modulate<false>(in.x, in.ctx, nullptr, w.H(), in.norm2_g + l * 1024, MODl, 3, MR, vb, nvb, w.H8(), w.HS(), w.PQ(), w.XB());
        else phase_modulate<true>(nullptr, nullptr, w.XB(), w.H(), in.norm2_g + l * 1024, MODl, 3, MR, vb, nvb, w.H8(), w.HS(), w.PQ(), w.XB());
        xcd_barrier(bar);
#if (PROBE_MASK >> 5) & 1
        phase_modulate<true>(nullptr, nullptr, w.XB(), w.H(), in.norm2_g + l * 1024, MODl, 3, MR, vb, nvb, w.H8(), w.HS()); xcd_barrier(bar);
#endif
        phase_p6a(lds, w, l, vb, nvb); xcd_barrier(bar);
#if (PROBE_MASK >> 6) & 1
        phase_p6a(lds, w, l, vb, nvb); xcd_barrier(bar);
#endif
        phase_p6b(lds, w.PQ(), w.SubK() + (size_t)l * 16 * 128 * 128, w.EG(), MR, vb, nvb); xcd_barrier(bar);
#if (PROBE_MASK >> 7) & 1
        phase_p6b(lds, w.PQ(), w.SubK() + (size_t)l * 16 * 128 * 128, w.EG(), MR, vb, nvb); xcd_barrier(bar);
#endif
        { P7CArgs a{w.H8(), w.EG(), w.U8() + (size_t)l * NE * 1024, (int*)w.PQ(), MR}; phase_p7c(lds, a, xpart, xrank, nvb); }
        xcd_barrier(bar);
#if (PROBE_MASK >> 8) & 1
        { P7CArgs a{w.H8(), w.EG(), w.U8() + (size_t)l * NE * 1024, (int*)w.PQ(), MR}; phase_p7c(lds, a, xpart, xrank, nvb); }
        xcd_barrier(bar);
#endif
        phase_p7d((const int*)w.PQ(), w.EG(), w.US() + (size_t)l * NE, w.VS() + (size_t)l * NE, w.HS(), w.WE(), MR, vb, nvb);
        xcd_barrier(bar);
#if (PROBE_MASK >> 9) & 1
        phase_p7d((const int*)w.PQ(), w.EG(), w.US() + (size_t)l * NE, w.VS() + (size_t)l * NE, w.HS(), w.WE(), MR, vb, nvb);
        xcd_barrier(bar);
#endif
        { P7BArgs a{w.WE(), w.V8() + (size_t)l * NE * 1024, w.XB(), MODl + 5 * 1024, MR}; phase_p7b<0>(lds, a, xpart, xrank, nvb); }
        xcd_barrier(bar);
#if (PROBE_MASK >> 10) & 3
        { P7BArgs a{w.WE(), w.V8() + (size_t)l * NE * 1024, w.XB(), MODl + 5 * 1024, MR}; phase_p7b<((PROBE_MASK >> 10) & 3)>(lds, a, xpart, xrank, nvb); }
        xcd_barrier(bar);
#endif
        if (last) phase_final_norm(w.XB(), A.XL, in.final_g, vb, nvb);
        else phase_modulate<true>(nullptr, nullptr, w.XB(), w.H(), in.norm1_g + (l + 1) * 1024, w.MOD() + (size_t)(l + 1) * 33 * 6144, 0, NR, vb, nvb);
        if (!last) xcd_barrier(bar);
    }
}

extern "C" void kernel_launch(void* const* d_in, const int* in_sizes, int n_in, void* d_out, int out_size, void* d_ws, size_t ws_size, hipStream_t stream) {
    const float* const* fin = (const float* const*)d_in;
    Inputs in{fin[0], fin[1], fin[2], fin[3], fin[4], fin[5], fin[6], fin[7], fin[8], fin[9], fin[10], fin[11], fin[12], fin[13], fin[14], fin[15], fin[16], fin[17], fin[18], fin[19], fin[20], fin[21], fin[22]};
    WS w = make_ws(d_ws);
    static int ok = 0;
    if (!ok) {
        if (hipFuncSetAttribute((const void*)k_mega, hipFuncAttributeMaxDynamicSharedMemorySize, MEGA_LDS) != hipSuccess) { ok = -1; }
        int per_cu = 0, cus = 0, dev = 0; (void)hipGetDevice(&dev); (void)hipDeviceGetAttribute(&cus, hipDeviceAttributeMultiprocessorCount, dev);
        if (hipOccupancyMaxActiveBlocksPerMultiprocessor(&per_cu, (const void*)k_mega, 512, MEGA_LDS) != hipSuccess || per_cu < 1 || cus < 256) ok = -1;
        if (ok == 0) ok = 1;
    }
    if (ok < 0) return;
    (void)hipMemsetAsync(d_ws, 0, 16384, stream);
    MegaArgs A{in, w, (float*)d_out, (unsigned*)d_ws};
    k_mega<<<256, 512, MEGA_LDS, stream>>>(A);
}
```

```cpp
#include <hip/hip_runtime.h>
#include <stdint.h>

typedef unsigned short bf16_t;

constexpr int D = 1024, NB = 32, S = 2048, CTX = 256, DEPTH = 2;
constexpr int NL = NB * S, NC = NB * CTX, NR = NL + NC;
constexpr int KEYS = CTX + S;
constexpr int INC = 1568;
constexpr int NE = 16384;
constexpr float EPS = 1e-6f;

__device__ __forceinline__ float bf2f(bf16_t v) { return __uint_as_float(((unsigned)v) << 16); }
__device__ __forceinline__ bf16_t f2bf(float f) { unsigned u = __float_as_uint(f); u += 0x7FFFu + ((u >> 16) & 1u); return (bf16_t)(u >> 16); }

__device__ __forceinline__ float wave_sum(float v) {
#pragma unroll
    for (int o = 32; o > 0; o >>= 1) v += __shfl_xor(v, o);
    return v;
}
__device__ __forceinline__ float gelu_tanh(float x) {
    const float u = 0.7978845608028654f * (x + 0.044715f * x * x * x);
    return 0.5f * x * (1.f + tanhf(u));
}

struct WS {
    char* base;
    __host__ __device__ __forceinline__ bf16_t* H() const { return (bf16_t*)(base + 65536ull); }
    __host__ __device__ __forceinline__ bf16_t* Qg() const { return (bf16_t*)(base + 151060480ull); }
    __host__ __device__ __forceinline__ bf16_t* Qgc() const { return (bf16_t*)(base + 201392128ull); }
    __host__ __device__ __forceinline__ bf16_t* Kg() const { return (bf16_t*)(base + 207683584ull); }
    __host__ __device__ __forceinline__ bf16_t* Vg() const { return (bf16_t*)(base + 226557952ull); }
    __host__ __device__ __forceinline__ bf16_t* CQ() const { return (bf16_t*)(base + 245432320ull); }
    __host__ __device__ __forceinline__ bf16_t* CKV() const { return (bf16_t*)(base + 302055424ull); }
    __host__ __device__ __forceinline__ bf16_t* Bp() const { return (bf16_t*)(base + 339804160ull); }
    __host__ __device__ __forceinline__ bf16_t* KR() const { return (bf16_t*)(base + 377552896ull); }
    __host__ __device__ __forceinline__ bf16_t* Qm() const { return (bf16_t*)(base + 382271488ull); }
    __host__ __device__ __forceinline__ bf16_t* Qmc() const { return (bf16_t*)(base + 457768960ull); }
    __host__ __device__ __forceinline__ bf16_t* Kmn() const { return (bf16_t*)(base + 467206144ull); }
    __host__ __device__ __forceinline__ bf16_t* Vm() const { return (bf16_t*)(base + 523829248ull); }
    __host__ __device__ __forceinline__ unsigned* EG() const { return (unsigned*)(base + 580452352ull); }
    __host__ __device__ __forceinline__ bf16_t* P() const { return (bf16_t*)(base + 382271488ull); }
    __host__ __device__ __forceinline__ bf16_t* PQ() const { return (bf16_t*)(base + 151060480ull); }
    __host__ __device__ __forceinline__ bf16_t* TMP() const { return (bf16_t*)(base + 65536ull); }
    __host__ __device__ __forceinline__ float* XC() const { return (float*)(base + 618201088ull); }
    __host__ __device__ __forceinline__ float* MOD() const { return (float*)(base + 651755520ull); }
    __host__ __device__ __forceinline__ float2* ROPA() const { return (float2*)(base + 653377536ull); }
    __host__ __device__ __forceinline__ float2* ROPC() const { return (float2*)(base + 653901824ull); }
    __host__ __device__ __forceinline__ float* RSQ() const { return (float*)(base + 654163968ull); }
    __host__ __device__ __forceinline__ float* RSKV() const { return (float*)(base + 654458880ull); }
    __host__ __device__ __forceinline__ bf16_t* WinT() const { return (bf16_t*)(base + 654753792ull); }
    __host__ __device__ __forceinline__ bf16_t* WuqT() const { return (bf16_t*)(base + 662093824ull); }
    __host__ __device__ __forceinline__ bf16_t* WukvT() const { return (bf16_t*)(base + 663273472ull); }
    __host__ __device__ __forceinline__ bf16_t* WoutT() const { return (bf16_t*)(base + 664059904ull); }
    __host__ __device__ __forceinline__ bf16_t* WqT() const { return (bf16_t*)(base + 668254208ull); }
    __host__ __device__ __forceinline__ bf16_t* SubK() const { return (bf16_t*)(base + 676642816ull); }
    __host__ __device__ __forceinline__ unsigned char* U8() const { return (unsigned char*)(base + 677691392ull); }
    __host__ __device__ __forceinline__ unsigned char* V8() const { return (unsigned char*)(base + 711245824ull); }
    __host__ __device__ __forceinline__ float* US() const { return (float*)(base + 744800256ull); }
    __host__ __device__ __forceinline__ float* VS() const { return (float*)(base + 744931328ull); }
    __host__ __device__ __forceinline__ float* SSQ() const { return (float*)(base + 745062400ull); }
    __host__ __device__ __forceinline__ float* SSKV() const { return (float*)(base + 747421696ull); }
    __host__ __device__ __forceinline__ unsigned* WE() const { return (unsigned*)(base + 748601344ull); }
    __host__ __device__ __forceinline__ signed char* H8() const { return (signed char*)(base + 786350080ull); }
    __host__ __device__ __forceinline__ float* HS() const { return (float*)(base + 861847552ull); }
    __host__ __device__ __forceinline__ bf16_t* PoolWT() const { return (bf16_t*)(base + 862142464ull); }
    __host__ __device__ __forceinline__ bf16_t* XB() const { return (bf16_t*)(base + 862208000ull); }
};
constexpr size_t WS_BYTES = 862208000ull + (size_t)NR * 1024 * 2;
static WS make_ws(void* d_ws) { WS w; w.base = (char*)d_ws; return w; }


#define LAS __attribute__((address_space(3)))
typedef short bf16x8 __attribute__((ext_vector_type(8)));
typedef float f32x4 __attribute__((ext_vector_type(4)));
typedef float f32x16 __attribute__((ext_vector_type(16)));
typedef unsigned u32x4 __attribute__((ext_vector_type(4)));
typedef unsigned u32x2 __attribute__((ext_vector_type(2)));

__device__ __forceinline__ f32x16 mfma32(bf16x8 a, bf16x8 b, f32x16 c) { return __builtin_amdgcn_mfma_f32_32x32x16_bf16(a, b, c, 0, 0, 0); }
__device__ __forceinline__ unsigned cvt_pk_bf16(float lo, float hi) { unsigned r; asm volatile("v_cvt_pk_bf16_f32 %0, %1, %2" : "=v"(r) : "v"(lo), "v"(hi)); return r; }

namespace pg8 {
constexpr int BM = 256, BK = 64, HALF = 128, HTB = HALF * BK * 2, STAGE_BYTES = 8 * HTB, NXCD = 8, WGM = 8;
__host__ __device__ __forceinline__ int lds_byte(int r, int c) { const int st = (r >> 4) * 2 + (c >> 5), rr = r & 15, cc = c & 31, ob = rr * 64 + cc * 2; return st * 1024 + (ob ^ (((ob >> 9) & 1) << 5)); }
__host__ __device__ __forceinline__ void stage_rc(int b, int& R, int& C) { const int st = b / 1024, sb = b % 1024, swz = sb ^ (((sb >> 9) & 1) << 5); R = (st >> 1) * 16 + swz / 64; C = (st & 1) * 32 + (swz % 64) / 2; }
__host__ __device__ __forceinline__ int perm32(int rho) { const int n = rho >> 4, i = rho & 15; return 8 * (i >> 2) + 4 * n + (i & 3); }
struct Unit { int pm, pn; };
struct Gemm { const bf16_t* A; const bf16_t* Bt; int M, N, K; };
struct StaticOrder {
    int nM, nN, nwg, G, c;
    __host__ __device__ void init(int M, int N, int G_, int c_) { nM = M / BM; nN = N / BM; nwg = nM * nN; G = G_; c = c_; }
    __host__ __device__ bool next(int i, Unit& u) const {
        const long L = (long)i * G + c; if (L >= nwg) return false;
        int wgid = (int)L; { const int q = nwg / NXCD, r = nwg % NXCD, xcd = wgid % NXCD, off = wgid / NXCD; wgid = (xcd < r ? xcd * (q + 1) : r * (q + 1) + (xcd - r) * q) + off; }
        const int nig = WGM * nN, gid = wgid / nig, fm = gid * WGM, gsz = (nM - fm) < WGM ? (nM - fm) : WGM;
        u.pm = fm + ((wgid % nig) % gsz); u.pn = (wgid % nig) / gsz; return true;
    }
};
template <class Epi, class Sched>
__device__ __forceinline__ void gemm_phase(LAS unsigned char* lds, const Gemm g, const Sched& S, const Epi& E) {
    int tid_ = threadIdx.x; asm volatile("" : "+v"(tid_));
    const int tid = tid_, wid = __builtin_amdgcn_readfirstlane(tid >> 6), lane = tid & 63, wr = wid >> 2, wc = wid & 3, fr = lane & 15, fq = lane >> 4;
    const int K = g.K, nt = K / BK;
    unsigned voffA[2], voffB[2];
#pragma unroll
    for (int i = 0; i < 2; ++i) { int R, C; stage_rc(tid * 16 + i * 8192, R, C); const int Rb = Epi::PERM ? ((R & ~31) + perm32(R & 31)) : R;
        voffA[i] = (unsigned)(R * K + C) * 2u; voffB[i] = (unsigned)(Rb * K + C) * 2u; }
    const size_t kstep = (size_t)(BK * 2);
    const size_t hstep = (size_t)HALF * K * 2;
    const size_t tstep = 2 * hstep;
    const unsigned ldsw = (unsigned)wid * 1024u;
    const int aoff = lds_byte(wr * 64 + fr, fq * 8), boff = lds_byte(wc * 32 + fr, fq * 8);
#define PG8_SA(b, h) (((b) * 2 + (h)) * HTB)
#define PG8_SB(b, h) ((4 + (b) * 2 + (h)) * HTB)
#define PG8_STAGE(bufoff, gbase, voff) do { _Pragma("unroll") for (int _i = 0; _i < 2; ++_i) \
        __builtin_amdgcn_global_load_lds((const unsigned*)((const char*)(gbase) + (voff)[_i]), (LAS unsigned*)(lds + (bufoff) + ldsw + _i * 8192), 16, 0, 0); } while (0)
#define PG8_LDA(dst, b, h) do { _Pragma("unroll") for (int m = 0; m < 4; ++m) _Pragma("unroll") for (int k = 0; k < 2; ++k) dst[m][k] = *(const LAS bf16x8*)(lds + PG8_SA(b, h) + aoff + m * 2048 + k * 1024); } while (0)
#define PG8_LDB(dst, b, h) do { _Pragma("unroll") for (int n = 0; n < 2; ++n) _Pragma("unroll") for (int k = 0; k < 2; ++k) dst[n][k] = *(const LAS bf16x8*)(lds + PG8_SB(b, h) + boff + n * 2048 + k * 1024); } while (0)
#define PG8_MMA(ai, bj, At, Bt) do { __builtin_amdgcn_s_setprio(1); _Pragma("unroll") for (int m = 0; m < 4; ++m) _Pragma("unroll") for (int n = 0; n < 2; ++n) _Pragma("unroll") for (int k = 0; k < 2; ++k) \
        acc[ai][bj][m][n] = __builtin_amdgcn_mfma_f32_16x16x32_bf16(Bt[n][k], At[m][k], acc[ai][bj][m][n], 0, 0, 0); __builtin_amdgcn_s_setprio(0); } while (0)
#define PG8_WAIT_V(n) asm volatile("s_waitcnt vmcnt(" #n ")" ::: "memory")
#define PG8_WAIT_L(n) asm volatile("s_waitcnt lgkmcnt(" #n ")" ::: "memory")
#define PG8_BAR __builtin_amdgcn_s_barrier()
#define PG8_SCHED __builtin_amdgcn_sched_barrier(0)
    Unit cur, nxt; int ui = 0;
    if (!S.next(0, cur)) return;
    f32x4 acc[2][2][4][2];
#pragma unroll
    for (int a = 0; a < 2; ++a)
#pragma unroll
        for (int b = 0; b < 2; ++b)
#pragma unroll
            for (int m = 0; m < 4; ++m)
#pragma unroll
                for (int n = 0; n < 2; ++n) acc[a][b][m][n] = (f32x4){0.f, 0.f, 0.f, 0.f};
    bf16x8 At[4][2], B0[2][2], B1[2][2];
    const char* cA = (const char*)g.A + (size_t)cur.pm * tstep; const char* cB = (const char*)g.Bt + (size_t)cur.pn * tstep;
    PG8_STAGE(PG8_SB(0, 0), cB, voffB); PG8_STAGE(PG8_SA(0, 0), cA, voffA); PG8_STAGE(PG8_SB(0, 1), cB + hstep, voffB); PG8_STAGE(PG8_SA(0, 1), cA + hstep, voffA);
    if (wr == 1) PG8_BAR;
    PG8_WAIT_V(4); PG8_BAR;
    PG8_STAGE(PG8_SB(1, 0), cB + kstep, voffB); PG8_STAGE(PG8_SA(1, 0), cA + kstep, voffA); PG8_STAGE(PG8_SB(1, 1), cB + hstep + kstep, voffB);
    PG8_WAIT_V(6); PG8_BAR;
    for (;;) {
        const bool has_next = S.next(ui + 1, nxt);
        const char* nA = has_next ? (const char*)g.A + (size_t)nxt.pm * tstep : cA; const char* nB = has_next ? (const char*)g.Bt + (size_t)nxt.pn * tstep : cB;
#pragma nounroll
        for (int t = 0; t < nt; t += 2) {
            const bool last = (t == nt - 2);
            const char* a1 = cA + (size_t)(t + 1) * kstep;
            const char* a2 = last ? nA : cA + (size_t)(t + 2) * kstep; const char* b2 = last ? nB : cB + (size_t)(t + 2) * kstep;
            const char* a3 = a2 + kstep; const char* b3 = b2 + kstep;
            PG8_LDB(B0, 0, 0); PG8_SCHED; PG8_LDA(At, 0, 0); PG8_STAGE(PG8_SA(1, 1), a1 + hstep, voffA);
            PG8_WAIT_L(8); PG8_BAR; PG8_WAIT_L(0); PG8_MMA(0, 0, At, B0); PG8_BAR; PG8_SCHED;
            PG8_LDB(B1, 0, 1); PG8_STAGE(PG8_SB(0, 0), b2, voffB);
            PG8_BAR; PG8_WAIT_L(0); PG8_MMA(0, 1, At, B1); PG8_BAR;
            PG8_LDA(At, 0, 1); PG8_STAGE(PG8_SA(0, 0), a2, voffA);
            PG8_BAR; PG8_WAIT_L(0); PG8_MMA(1, 0, At, B0); PG8_BAR; PG8_SCHED;
            PG8_STAGE(PG8_SB(0, 1), b2 + hstep, voffB);
            PG8_WAIT_V(6); PG8_BAR; PG8_MMA(1, 1, At, B1); PG8_BAR;
            PG8_LDB(B0, 1, 0); PG8_SCHED; PG8_LDA(At, 1, 0); PG8_STAGE(PG8_SA(0, 1), a2 + hstep, voffA);
            PG8_WAIT_L(8); PG8_BAR; PG8_WAIT_L(0); PG8_MMA(0, 0, At, B0); PG8_BAR; PG8_SCHED;
            PG8_LDB(B1, 1, 1); PG8_STAGE(PG8_SB(1, 0), b3, voffB);
            PG8_BAR; PG8_WAIT_L(0); PG8_MMA(0, 1, At, B1); PG8_BAR;
            PG8_LDA(At, 1, 1); PG8_STAGE(PG8_SA(1, 0), a3, voffA);
            PG8_BAR; PG8_WAIT_L(0); PG8_MMA(1, 0, At, B0); PG8_BAR; PG8_SCHED;
            PG8_STAGE(PG8_SB(1, 1), b3 + hstep, voffB);
            PG8_WAIT_V(6); PG8_BAR; PG8_MMA(1, 1, At, B1); PG8_BAR;
        }
        E(acc, cur, wr, wc, fr, fq);
        if (!has_next) break;
#pragma unroll
        for (int a = 0; a < 2; ++a)
#pragma unroll
            for (int b = 0; b < 2; ++b)
#pragma unroll
                for (int m = 0; m < 4; ++m)
#pragma unroll
                    for (int n = 0; n < 2; ++n) acc[a][b][m][n] = (f32x4){0.f, 0.f, 0.f, 0.f};
        cur = nxt; cA = nA; cB = nB; ++ui;
    }
    PG8_WAIT_V(0);
    if (wr == 0) PG8_BAR;
    PG8_BAR;
#undef PG8_SA
#undef PG8_SB
#undef PG8_STAGE
#undef PG8_LDA
#undef PG8_LDB
#undef PG8_MMA
#undef PG8_WAIT_V
#undef PG8_WAIT_L
#undef PG8_BAR
#undef PG8_SCHED
}
}

enum { GT_AQ = 0, GT_AK = 1, GT_AV = 2, GT_B = 3, GT_CQ = 4, GT_CKV = 5, GT_KR = 6, GT_PAD = 7 };
__host__ __device__ __forceinline__ void in_group(int g, int& type, int& sub) {
    if (g < 2) { type = GT_AK; sub = g; } else if (g < 4) { type = GT_AV; sub = g - 2; } else if (g < 8) { type = GT_CKV; sub = g - 4; }
    else if (g == 8) { type = GT_KR; sub = 0; } else if (g < 12) { type = GT_PAD; sub = 0; } else if (g < 18) { type = GT_AQ; sub = g - 12; }
    else if (g < 24) { type = GT_CQ; sub = g - 18; } else { type = GT_B; sub = g - 24; }
}
__device__ __forceinline__ int colmap(int mode, int r) {
    const int pn = r >> 8, ct = r & 255, bj = ct >> 7, wc = (ct >> 5) & 3, j = ct & 31, g = 4 * pn + wc, e = 32 * bj + j;
    if (mode == 0) {
        int type, sub; in_group(g, type, sub);
        switch (type) { case GT_AQ: return 64 * sub + e; case GT_AK: return 384 + 64 * sub + e; case GT_AV: return 512 + 64 * sub + e; case GT_B: return 640 + 64 * sub + e;
            case GT_CQ: return 896 + 64 * sub + e; case GT_CKV: return 1280 + 64 * sub + e; case GT_KR: return (j < 16) ? 1536 + 16 * bj + j : -1; default: return -1; }
    } else if (mode == 1) {
        if (g < 6) return 96 * g + e; if (g < 9) { const int head = 2 * (g - 6) + (j >> 4); return 96 * head + 64 + 16 * bj + (j & 15); } return -1;
    } else if (mode == 2) {
        return 64 * g + e;
    }
    return r;
}
__device__ __forceinline__ void cvt_weights_unit(LAS float* tile  , const float* __restrict__ W, int K, int N, bf16_t* __restrict__ dst, int mode, const float* __restrict__ kgain, int r0, int k0) {
    int tid_ = threadIdx.x; asm volatile("" : "+v"(tid_));
    const int tid = tid_;
    const int jj = tid & 63; const int sc = colmap(mode, r0 + jj);
#pragma unroll
    for (int i = 0; i < 8; ++i) { const int kk = (tid >> 6) + 8 * i; float v = 0.f; if (sc >= 0) v = W[(size_t)(k0 + kk) * N + sc]; if (kgain) v *= kgain[k0 + kk]; tile[kk * 65 + jj] = v; }
    __syncthreads();
#pragma unroll
    for (int i = 0; i < 8; ++i) { const int rr = (tid >> 6) + 8 * i, kk = tid & 63; dst[(size_t)(r0 + rr) * K + k0 + kk] = f2bf(tile[kk * 65 + rr]); }
    __syncthreads();
}
struct CvtJob { const float* W; bf16_t* dst; const float* kgain; int K, N, Npad, mode; };
__device__ __forceinline__ void cvt_job(LAS float* tile, const CvtJob j, int vb, int nvb) {
    const int nk = j.K / 64, nr = j.Npad / 64;
    for (int u = vb; u < nk * nr; u += nvb) cvt_weights_unit(tile, j.W, j.K, j.N, j.dst, j.mode, j.kgain, (u / nk) * 64, (u % nk) * 64);
}
__device__ __forceinline__ void cvt_flat(const float* __restrict__ src, bf16_t* __restrict__ dst, size_t n, int vb, int nvb) {
    int tid_ = threadIdx.x; asm volatile("" : "+v"(tid_));
    for (size_t i = ((size_t)vb * 512 + tid_) * 8; i < n; i += (size_t)nvb * 512 * 8) {
        const float4 a = *(const float4*)(src + i), b = *(const float4*)(src + i + 4);
        u32x4 o; o.x = cvt_pk_bf16(a.x, a.y); o.y = cvt_pk_bf16(a.z, a.w); o.z = cvt_pk_bf16(b.x, b.y); o.w = cvt_pk_bf16(b.z, b.w);
        *(u32x4*)(dst + i) = o;
    }
}
template <bool FP8>
__device__ __forceinline__ void cvt_q8_rows(const float* __restrict__ src, unsigned char* __restrict__ dst, float* __restrict__ scales, int nrows, int vb, int nvb) {
    int tid_ = threadIdx.x; asm volatile("" : "+v"(tid_));
    const int lane = tid_ & 63, wid = tid_ >> 6;
    const int stride = nvb * 8;
    for (int row0 = vb * 8 + wid; row0 < nrows; row0 += 4 * stride) {
        f32x4 v[4][4];
#pragma unroll
        for (int q = 0; q < 4; ++q) { const int row = row0 + q * stride < nrows ? row0 + q * stride : row0; const float* sp = src + (size_t)row * 1024 + 16 * lane;
#pragma unroll
            for (int k = 0; k < 4; ++k) v[q][k] = *(const f32x4*)(sp + 4 * k); }
#pragma unroll
        for (int q = 0; q < 4; ++q) { const int row = row0 + q * stride; if (row < nrows) {
            float am = 0.f;
#pragma unroll
            for (int k = 0; k < 4; ++k) am = fmaxf(am, fmaxf(fmaxf(fabsf(v[q][k][0]), fabsf(v[q][k][1])), fmaxf(fabsf(v[q][k][2]), fabsf(v[q][k][3]))));
#pragma unroll
            for (int o = 32; o > 0; o >>= 1) am = fmaxf(am, __shfl_xor(am, o));
            const float qmax = FP8 ? 416.f : 127.f;
            const float sc = am > 0.f ? am / qmax : 1.f, inv = am > 0.f ? qmax / am : 0.f;
            u32x4 o4;
#pragma unroll
            for (int k = 0; k < 4; ++k) {
                if (FP8) { int p = __builtin_amdgcn_cvt_pk_fp8_f32(v[q][k][0] * inv, v[q][k][1] * inv, 0, false); p = __builtin_amdgcn_cvt_pk_fp8_f32(v[q][k][2] * inv, v[q][k][3] * inv, p, true); o4[k] = (unsigned)p; }
                else { const int q0 = (int)rintf(v[q][k][0] * inv), q1 = (int)rintf(v[q][k][1] * inv), q2 = (int)rintf(v[q][k][2] * inv), q3 = (int)rintf(v[q][k][3] * inv);
                    o4[k] = (unsigned)(q0 & 0xff) | ((unsigned)(q1 & 0xff) << 8) | ((unsigned)(q2 & 0xff) << 16) | ((unsigned)(q3 & 0xff) << 24); } }
            *(u32x4*)(dst + (size_t)row * 1024 + 16 * lane) = o4;
            if (lane == 0) scales[row] = sc; } }
    }
}
struct Inputs {
    const float *x, *c, *ctx, *c_ctx, *ada_w, *ada_b, *norm1_g, *norm2_g, *w_in, *gqa_qn_g, *gqa_kn_g, *pool_w, *pool_scale, *mla_qn_g, *mla_kvn_g, *mla_w_uq, *mla_w_ukv, *w_out, *peer_wq, *peer_subkeys, *peer_u, *peer_v, *final_g;
};
__device__ __forceinline__ void phase_cvt(LAS unsigned char* lds, const Inputs& in, const WS& w, int vb, int nvb) {
    LAS float* tile = (LAS float*)lds;
    for (int l = 0; l < 2; ++l) {
        cvt_job(tile, CvtJob{in.w_in + (size_t)l * 1024 * INC, w.WinT() + (size_t)l * 1792 * 1024, nullptr, 1024, INC, 1792, 0}, vb, nvb);
        cvt_job(tile, CvtJob{in.mla_w_uq + (size_t)l * 384 * 576, w.WuqT() + (size_t)l * 768 * 384, in.mla_qn_g + l * 384, 384, 576, 768, 1}, vb, nvb);
        cvt_job(tile, CvtJob{in.mla_w_ukv + (size_t)l * 256 * 768, w.WukvT() + (size_t)l * 768 * 256, in.mla_kvn_g + l * 256, 256, 768, 768, 2}, vb, nvb);
        cvt_job(tile, CvtJob{in.w_out + (size_t)l * 1024 * 1024, w.WoutT() + (size_t)l * 1024 * 1024, nullptr, 1024, 1024, 1024, 3}, vb, nvb);
        cvt_job(tile, CvtJob{in.peer_wq + (size_t)l * 1024 * 2048, w.WqT() + (size_t)l * 2048 * 1024, nullptr, 1024, 2048, 2048, 3}, vb, nvb);
    }
    cvt_flat(in.peer_subkeys, w.SubK(), (size_t)2 * 16 * 128 * 128, vb, nvb);
    { int tp_ = threadIdx.x; asm volatile("" : "+v"(tp_));
      for (int i = vb * 512 + tp_; i < 2 * 4 * 64 * 64; i += nvb * 512) { const int c = i & 63, d = (i >> 6) & 63, lg = i >> 12; w.PoolWT()[i] = f2bf(in.pool_w[(size_t)lg * 4096 + c * 64 + d]); } }
    if (nvb > 144) { if (vb >= 72) { cvt_q8_rows<false>(in.peer_u, w.U8(), w.US(), 2 * NE, vb - 72, nvb - 72); cvt_q8_rows<true>(in.peer_v, w.V8(), w.VS(), 2 * NE, vb - 72, nvb - 72); } }
    else { cvt_q8_rows<false>(in.peer_u, w.U8(), w.US(), 2 * NE, vb, nvb); cvt_q8_rows<true>(in.peer_v, w.V8(), w.VS(), 2 * NE, vb, nvb); }
}

constexpr float ATT_C2G = 0.125f * 1.4426950408889634f, ATT_C2M = 0.10206207261596577f * 1.4426950408889634f;
struct EpiIn {
    static constexpr bool PERM = true;
    WS w; const float* qn_g; const float* kn_g; int pm_base;
    __device__ __forceinline__ void operator()(const f32x4 (&acc)[2][2][4][2], const pg8::Unit& u, int wr, int wc, int fr, int fq) const {
        int type, sub; in_group(4 * u.pn + wc, type, sub);
        if (type == GT_PAD) return;
        const int pm = u.pm + pm_base; const bool isctx = pm >= 256; const int b = isctx ? pm - 256 : pm >> 3; const int t0 = isctx ? 0 : (pm & 7) * 256;
        const size_t rowbase = isctx ? (size_t)NL + (size_t)b * CTX : (size_t)b * S;
        const int keyoff = isctx ? 0 : CTX;
        float gain[2][8];
        if (type == GT_AQ) {
#pragma unroll
            for (int bj = 0; bj < 2; ++bj)
#pragma unroll
                for (int q = 0; q < 8; ++q) gain[bj][q] = qn_g[32 * bj + 8 * fq + q] * ATT_C2G;
        } else if (type == GT_AK) {
#pragma unroll
            for (int bj = 0; bj < 2; ++bj)
#pragma unroll
                for (int q = 0; q < 8; ++q) gain[bj][q] = kn_g[32 * bj + 8 * fq + q];
        }
#pragma unroll
        for (int ai = 0; ai < 2; ++ai)
#pragma unroll
            for (int m = 0; m < 4; ++m) {
                const int t = t0 + 128 * ai + 64 * wr + 16 * m + fr; const size_t row = rowbase + t;
                float v[2][8];
#pragma unroll
                for (int bj = 0; bj < 2; ++bj)
#pragma unroll
                    for (int n = 0; n < 2; ++n)
#pragma unroll
                        for (int i = 0; i < 4; ++i) v[bj][4 * n + i] = acc[ai][bj][m][n][i];
                bf16_t* dst = nullptr;
                if (type == GT_AQ || type == GT_AK) {
                    float ss = 0.f;
#pragma unroll
                    for (int bj = 0; bj < 2; ++bj)
#pragma unroll
                        for (int q = 0; q < 8; ++q) ss += v[bj][q] * v[bj][q];
                    ss += __shfl_xor(ss, 16); ss += __shfl_xor(ss, 32);
                    const float rstd = rsqrtf(ss * (1.f / 64.f) + EPS);
#pragma unroll
                    for (int q = 0; q < 8; ++q) { float x1 = v[0][q] * rstd * gain[0][q], x2 = v[1][q] * rstd * gain[1][q];
                        if (!isctx) { const float2 cs = w.ROPA()[t * 32 + 8 * fq + q]; const float y1 = x1 * cs.x - x2 * cs.y, y2 = x1 * cs.y + x2 * cs.x; x1 = y1; x2 = y2; }
                        v[0][q] = x1; v[1][q] = x2; }
                    if (type == GT_AQ) dst = isctx ? w.Qgc() + (((size_t)b * 6 + sub) * CTX + t) * 64 : w.Qg() + (((size_t)b * 6 + sub) * S + t) * 64;
                    else dst = w.Kg() + (((size_t)b * 2 + sub) * KEYS + keyoff + t) * 64;
                } else if (type == GT_AV) { dst = w.Vg() + (((size_t)b * 2 + sub) * KEYS + keyoff + t) * 64;
                } else if (type == GT_B) { dst = w.Bp() + row * 256 + 64 * sub;
                } else if (type == GT_CQ || type == GT_CKV) {
                    float ss = 0.f;
#pragma unroll
                    for (int bj = 0; bj < 2; ++bj)
#pragma unroll
                        for (int q = 0; q < 8; ++q) ss += v[bj][q] * v[bj][q];
                    ss += __shfl_xor(ss, 16); ss += __shfl_xor(ss, 32);
                    if (type == GT_CQ) { if (fq == 0) w.SSQ()[row * 8 + sub] = ss; dst = w.CQ() + row * 384 + 64 * sub; }
                    else { if (fq == 0) w.SSKV()[row * 4 + sub] = ss; dst = w.CKV() + row * 256 + 64 * sub; }
                } else {
                    if (!isctx) {
#pragma unroll
                        for (int q = 0; q < 8; ++q) { const float2 cs = w.ROPC()[t * 16 + ((8 * fq + q) & 15)]; const float x1 = v[0][q], x2 = v[1][q]; v[0][q] = x1 * cs.x - x2 * cs.y; v[1][q] = x1 * cs.y + x2 * cs.x; } }
                    if (fq < 2) { bf16_t* kd = w.KR() + ((size_t)b * KEYS + keyoff + t) * 32;
#pragma unroll
                        for (int bj = 0; bj < 2; ++bj) { u32x4 o; o.x = cvt_pk_bf16(v[bj][0], v[bj][1]); o.y = cvt_pk_bf16(v[bj][2], v[bj][3]); o.z = cvt_pk_bf16(v[bj][4], v[bj][5]); o.w = cvt_pk_bf16(v[bj][6], v[bj][7]);
                            *(u32x4*)(kd + 16 * bj + 8 * fq) = o; } }
                    continue;
                }
#pragma unroll
                for (int bj = 0; bj < 2; ++bj) { u32x4 o; o.x = cvt_pk_bf16(v[bj][0], v[bj][1]); o.y = cvt_pk_bf16(v[bj][2], v[bj][3]); o.z = cvt_pk_bf16(v[bj][4], v[bj][5]); o.w = cvt_pk_bf16(v[bj][6], v[bj][7]);
                    *(u32x4*)(dst + 32 * bj + 8 * fq) = o; }
            }
    }
};
struct P1Order {
    pg8::StaticOrder so; int nctx_tiles, G, c;
    __device__ bool next(int i, pg8::Unit& u) const {
        const int L = i * G + c;
        if (L < 1792) return so.next(i, u);
        const int Lc = L - 1792; if (Lc >= 32 * nctx_tiles) return false;
        u.pm = 256 + (Lc & 31); u.pn = Lc >> 5; return true;
    }
};
__device__ __forceinline__ void phase_p1(LAS unsigned char* lds, const WS& w, const Inputs& in, int l, int vb, int nvb) {
    EpiIn E{w, in.gqa_qn_g + l * 64, in.gqa_kn_g + l * 64, 0};
    P1Order po; po.so.init(NL, 1792, nvb, vb); po.nctx_tiles = (l == 0) ? 7 : 3; po.G = nvb; po.c = vb;
    pg8::gemm_phase(lds, pg8::Gemm{w.H(), w.WinT() + (size_t)l * 1792 * 1024, NR, 1792, 1024}, po, E);
}

extern __shared__ __attribute__((aligned(16))) unsigned char dyn_lds[];

struct EpiUq {
    static constexpr bool PERM = true;
    WS w;
    __device__ __forceinline__ void operator()(const f32x4 (&acc)[2][2][4][2], const pg8::Unit& u, int wr, int wc, int fr, int fq) const {
        const int g = 4 * u.pn + wc; if (g >= 9) return;
        const int pm = u.pm; const bool isctx = pm >= 256; const int b = isctx ? pm - 256 : pm >> 3; const int t0 = isctx ? 0 : (pm & 7) * 256;
        const size_t rowbase = isctx ? (size_t)NL + (size_t)b * CTX : (size_t)b * S;
        const int head = g < 6 ? g : 2 * (g - 6) + (fq >> 1);
#pragma unroll
        for (int ai = 0; ai < 2; ++ai)
#pragma unroll
            for (int m = 0; m < 4; ++m) {
                const int t = t0 + 128 * ai + 64 * wr + 16 * m + fr; const size_t row = rowbase + t;
                const float4 s0 = *(const float4*)(w.SSQ() + row * 8), s1 = *(const float4*)(w.SSQ() + row * 8 + 4);
                const float rstd = rsqrtf((s0.x + s0.y + s0.z + s0.w + s1.x + s1.y) * (1.f / 384.f) + EPS) * ATT_C2M;
                float v[2][8];
#pragma unroll
                for (int bj = 0; bj < 2; ++bj)
#pragma unroll
                    for (int n = 0; n < 2; ++n)
#pragma unroll
                        for (int i = 0; i < 4; ++i) v[bj][4 * n + i] = acc[ai][bj][m][n][i] * rstd;
                bf16_t* hd = isctx ? w.Qmc() + (((size_t)b * 6 + head) * CTX + t) * 96 : w.Qm() + (((size_t)b * 6 + head) * S + t) * 96;
                if (g >= 6 && !isctx) {
#pragma unroll
                    for (int q = 0; q < 8; ++q) { const float2 cs = w.ROPC()[t * 16 + 8 * (fq & 1) + q]; const float x1 = v[0][q], x2 = v[1][q]; v[0][q] = x1 * cs.x - x2 * cs.y; v[1][q] = x1 * cs.y + x2 * cs.x; } }
#pragma unroll
                for (int bj = 0; bj < 2; ++bj) { u32x4 o; o.x = cvt_pk_bf16(v[bj][0], v[bj][1]); o.y = cvt_pk_bf16(v[bj][2], v[bj][3]); o.z = cvt_pk_bf16(v[bj][4], v[bj][5]); o.w = cvt_pk_bf16(v[bj][6], v[bj][7]);
                    bf16_t* d = g < 6 ? hd + 32 * bj + 8 * fq : hd + 64 + 16 * bj + 8 * (fq & 1);
                    *(u32x4*)d = o; }
            }
    }
};
struct EpiUkv {
    static constexpr bool PERM = true;
    WS w;
    __device__ __forceinline__ void operator()(const f32x4 (&acc)[2][2][4][2], const pg8::Unit& u, int wr, int wc, int fr, int fq) const {
        const int g = 4 * u.pn + wc;
        const int pm = u.pm; const bool isctx = pm >= 256; const int b = isctx ? pm - 256 : pm >> 3; const int t0 = isctx ? 0 : (pm & 7) * 256;
        const size_t rowbase = isctx ? (size_t)NL + (size_t)b * CTX : (size_t)b * S; const int keyoff = isctx ? 0 : CTX;
        bf16_t* base = ((g & 1) ? w.Vm() : w.Kmn()) + ((size_t)b * 6 + (g >> 1)) * KEYS * 64;
#pragma unroll
        for (int ai = 0; ai < 2; ++ai)
#pragma unroll
            for (int m = 0; m < 4; ++m) {
                const int t = t0 + 128 * ai + 64 * wr + 16 * m + fr; const size_t row = rowbase + t;
                const float4 s0 = *(const float4*)(w.SSKV() + row * 4);
                const float rstd = rsqrtf((s0.x + s0.y + s0.z + s0.w) * (1.f / 256.f) + EPS);
                bf16_t* d = base + (size_t)(keyoff + t) * 64;
#pragma unroll
                for (int bj = 0; bj < 2; ++bj) { const f32x4 a0 = acc[ai][bj][m][0] * rstd, a1 = acc[ai][bj][m][1] * rstd;
                    u32x4 o; o.x = cvt_pk_bf16(a0[0], a0[1]); o.y = cvt_pk_bf16(a0[2], a0[3]); o.z = cvt_pk_bf16(a1[0], a1[1]); o.w = cvt_pk_bf16(a1[2], a1[3]);
                    *(u32x4*)(d + 32 * bj + 8 * fq) = o; }
            }
    }
};
constexpr int POOL_X = 0, POOL_P = 272 * 128, POOL_BYTES = 272 * 128 + 256 * 128;
template <int G>
__device__ __forceinline__ void pool_sums(LAS unsigned char* lds, int tid, int t0, int L) {
    constexpr int wdw = 2 << G, half = wdw >> 1, NX = 32 + wdw - 1;
    const int c = tid & 63, seg = tid >> 6; const LAS bf16_t* X = (const LAS bf16_t*)(lds + POOL_X) + c + (seg * 32 + 8 - half) * 64;
    const int tb = t0 + seg * 32;
    float xr[NX], xm[NX];
#pragma unroll
    for (int j = 0; j < NX; ++j) xr[j] = bf2f(X[j * 64]);
#pragma unroll
    for (int j = 0; j < NX; ++j) { const int row = tb - half + j; xm[j] = (row >= 0 && row < L) ? xr[j] : 0.f; }
    float sum = 0.f;
#pragma unroll
    for (int j = 0; j < wdw; ++j) sum += xm[j];
#pragma unroll
    for (int k = 0; k < 32; ++k) {
        const int t = tb + k; const int clo = (t - half) < 0 ? 0 : (t - half), chi = (t - half + wdw) > L ? L : (t - half + wdw);
        const float pv = sum / (float)(chi - clo) - xr[k + half];
        const int r = seg * 32 + k; *((LAS bf16_t*)(lds + POOL_P + r * 128 + (((c >> 3) ^ ((r >> 1) & 7)) << 4)) + (c & 7)) = f2bf(pv);
        if (k < 31) sum += xm[k + wdw] - xm[k];
    }
}
__device__ __forceinline__ void phase_pool(LAS unsigned char* lds, const WS& w, bf16_t* __restrict__ MIX, const bf16_t* __restrict__ WT  , const float* __restrict__ pool_scale, int nrows, int vb, int nvb) {
    int tid_ = threadIdx.x; asm volatile("" : "+v"(tid_));
    const int tid = tid_, lane = tid & 63, wid = __builtin_amdgcn_readfirstlane(tid >> 6), r32 = lane & 31, hi = lane >> 5;
    const int nunits = nrows >> 8;
    const int nmine = vb < nunits ? ((nunits - 1 - vb) / nvb + 1) * 4 : 0;
    u32x4 st[5];
#define POOL_FETCH(it_) do { const int u_ = vb + ((it_) >> 2) * nvb, g_ = (it_) & 3; const int row0_ = u_ << 8; const bool ic_ = row0_ >= NL; const int L_ = ic_ ? CTX : S; const int t0_ = ic_ ? 0 : (row0_ & (S - 1)); const int seq0_ = row0_ - t0_; \
        _Pragma("unroll") for (int k_ = 0; k_ < 5; ++k_) { int i_ = tid + 512 * k_; i_ = i_ < 272 * 8 ? i_ : 272 * 8 - 1; const int rr_ = i_ >> 3, ch_ = i_ & 7; int t_ = t0_ - 8 + rr_; t_ = t_ < 0 ? 0 : (t_ >= L_ ? L_ - 1 : t_); \
            st[k_] = *(const u32x4*)(w.Bp() + (size_t)(seq0_ + t_) * 256 + g_ * 64 + ch_ * 8); } } while (0)
    if (nmine > 0) POOL_FETCH(0);
    for (int it = 0; it < nmine; ++it) {
        const int u = vb + (it >> 2) * nvb, g = it & 3;
        const int row0 = u << 8; const bool isctx = row0 >= NL; const int L = isctx ? CTX : S; const int t0 = isctx ? 0 : (row0 & (S - 1));
        {
#pragma unroll
            for (int k = 0; k < 5; ++k) { const int i = tid + 512 * k; if (i < 272 * 8) *(LAS u32x4*)(lds + POOL_X + (i >> 3) * 128 + (i & 7) * 16) = st[k]; }
            { const int nx = it + 1 < nmine ? it + 1 : it; POOL_FETCH(nx); }
            __syncthreads();
            if (g == 0) pool_sums<0>(lds, tid, t0, L); else if (g == 1) pool_sums<1>(lds, tid, t0, L); else if (g == 2) pool_sums<2>(lds, tid, t0, L); else pool_sums<3>(lds, tid, t0, L);
            __syncthreads();
            { f32x16 o0 = {}, o1 = {};
              const bf16_t* wt = WT + (size_t)g * 4096 + (size_t)r32 * 64 + 8 * hi;
#pragma unroll
              for (int s = 0; s < 4; ++s) { const int row = wid * 32 + r32; const bf16x8 pf = *(const LAS bf16x8*)(lds + POOL_P + row * 128 + (((2 * s + hi) ^ ((row >> 1) & 7)) << 4));
                  o0 = mfma32(*(const bf16x8*)(wt + 16 * s), pf, o0); o1 = mfma32(*(const bf16x8*)(wt + 32 * 64 + 16 * s), pf, o1); }
              bf16_t* op = MIX + (size_t)(row0 + wid * 32 + r32) * 1024 + 384 + g * 64 + 4 * hi; const float* ps = pool_scale + g * 64 + 4 * hi;
#pragma unroll
              for (int q = 0; q < 4; ++q) { const f32x4 s0 = *(const f32x4*)(ps + 8 * q), s1 = *(const f32x4*)(ps + 32 + 8 * q); u32x2 a, b;
                  a.x = cvt_pk_bf16(o0[4 * q] * s0[0], o0[4 * q + 1] * s0[1]); a.y = cvt_pk_bf16(o0[4 * q + 2] * s0[2], o0[4 * q + 3] * s0[3]);
                  b.x = cvt_pk_bf16(o1[4 * q] * s1[0], o1[4 * q + 1] * s1[1]); b.y = cvt_pk_bf16(o1[4 * q + 2] * s1[2], o1[4 * q + 3] * s1[3]);
                  *(u32x2*)(op + 8 * q) = a; *(u32x2*)(op + 32 + 8 * q) = b; } }
            __syncthreads();
        }
    }
#undef POOL_FETCH
}
__device__ __forceinline__ void phase_p2(LAS unsigned char* lds, const WS& w, const Inputs& in, int l, int vb, int nvb, int parts = 7) {
    pg8::StaticOrder so;
    if (parts & 1) { EpiUq E{w}; const int M = l == 0 ? NR : NL; so.init(M, 768, nvb, vb); pg8::gemm_phase(lds, pg8::Gemm{w.CQ(), w.WuqT() + (size_t)l * 768 * 384, M, 768, 384}, so, E); }
    if (parts & 2) { EpiUkv E{w}; so.init(NR, 768, nvb, vb); pg8::gemm_phase(lds, pg8::Gemm{w.CKV(), w.WukvT() + (size_t)l * 768 * 256, NR, 768, 256}, so, E); }
    if (parts & 4) phase_pool(lds, w, w.H(), w.PoolWT() + (size_t)l * 4 * 64 * 64, in.pool_scale + l * 256, l == 0 ? NR : NL, vb, nvb);
}

struct EpiOut {
    static constexpr bool PERM = true;
    bf16_t* DLT; const float* gate;
    __device__ __forceinline__ void operator()(const f32x4 (&acc)[2][2][4][2], const pg8::Unit& u, int wr, int wc, int fr, int fq) const {
        const int pm = u.pm; const int mr = pm >= 256 ? 32 : pm >> 3;
        const size_t r0 = (size_t)pm * 256 + wr * 64 + fr; const int col0 = u.pn * 256 + wc * 32 + 8 * fq;
        f32x4 gv[2][2];
#pragma unroll
        for (int bj = 0; bj < 2; ++bj)
#pragma unroll
            for (int n = 0; n < 2; ++n) gv[bj][n] = *(const f32x4*)(gate + (size_t)mr * 6144 + col0 + bj * 128 + 4 * n);
#pragma unroll
        for (int ai = 0; ai < 2; ++ai)
#pragma unroll
            for (int m = 0; m < 4; ++m) { bf16_t* d = DLT + (r0 + ai * 128 + m * 16) * 1024 + col0;
#pragma unroll
                for (int bj = 0; bj < 2; ++bj) { const f32x4 a0 = acc[ai][bj][m][0] * gv[bj][0], a1 = acc[ai][bj][m][1] * gv[bj][1];
                    u32x4 o; o.x = cvt_pk_bf16(a0[0], a0[1]); o.y = cvt_pk_bf16(a0[2], a0[3]); o.z = cvt_pk_bf16(a1[0], a1[1]); o.w = cvt_pk_bf16(a1[2], a1[3]);
                    *(u32x4*)(d + bj * 128) = o; } }
    }
};
__device__ __forceinline__ void phase_p4(LAS unsigned char* lds, const WS& w, const Inputs& in, int l, int vb, int nvb) {
    const float* MODl = w.MOD() + (size_t)l * 33 * 6144;
    EpiOut E{w.PQ(), MODl + 2 * 1024};
    const int M = l == 0 ? NR : NL;
    pg8::StaticOrder so; so.init(M, 1024, nvb, vb);
    pg8::gemm_phase(lds, pg8::Gemm{w.H(), w.WoutT() + (size_t)l * 1024 * 1024, M, 1024, 1024}, so, E);
}

template <bool INBF>
__device__ __forceinline__ void phase_modulate(const float* __restrict__ XLp, const float* __restrict__ XCp, const bf16_t* __restrict__ XBp, bf16_t* __restrict__ Hout, const float* __restrict__ g, const float* __restrict__ MODl, int si, int nrows, int vb, int nvb,
                                               signed char* __restrict__ H8 = nullptr, float* __restrict__ HS = nullptr, const bf16_t* __restrict__ DLT = nullptr, bf16_t* __restrict__ XBo = nullptr) {
    int tid_ = threadIdx.x; asm volatile("" : "+v"(tid_));
    const int tid = tid_, lane = tid & 63, wid = tid >> 6;
    f32x4 gv[4];
#pragma unroll
    for (int i = 0; i < 4; ++i) gv[i] = *(const f32x4*)(g + 256 * i + 4 * lane);
    const int stride = nvb * 8, lastrow = nrows - 1;
    f32x4 nx[4]; u32x2 nxb[4], ndr[4];
#define PM_LOAD(r_) do { const int rr_ = (r_) < nrows ? (r_) : lastrow; const bool ic_ = rr_ >= NL; const float* xp_ = ic_ ? XCp + (size_t)(rr_ - NL) * 1024 : XLp + (size_t)rr_ * 1024; \
        _Pragma("unroll") for (int i = 0; i < 4; ++i) { if (INBF) nxb[i] = *(const u32x2*)(XBp + (size_t)rr_ * 1024 + 256 * i + 4 * lane); else nx[i] = *(const f32x4*)(xp_ + 256 * i + 4 * lane); \
            if (DLT) ndr[i] = *(const u32x2*)(DLT + (size_t)rr_ * 1024 + 256 * i + 4 * lane); } } while (0)
    PM_LOAD(vb * 8 + wid);
    for (int row = vb * 8 + wid; row < nrows; row += stride) {
        const bool isctx = row >= NL; const int mr = isctx ? 32 : row / S;
        f32x4 x[4]; u32x2 dr4[4]; float ss = 0.f;
#pragma unroll
        for (int i = 0; i < 4; ++i) { if (INBF) x[i] = (f32x4){__uint_as_float(nxb[i].x << 16), __uint_as_float(nxb[i].x & 0xffff0000u), __uint_as_float(nxb[i].y << 16), __uint_as_float(nxb[i].y & 0xffff0000u)}; else x[i] = nx[i];
            if (DLT) dr4[i] = ndr[i]; }
        PM_LOAD(row + stride);
#pragma unroll
        for (int i = 0; i < 4; ++i) {
            if (DLT) { const u32x2 dr = dr4[i];
                x[i][0] += __uint_as_float(dr.x << 16); x[i][1] += __uint_as_float(dr.x & 0xffff0000u); x[i][2] += __uint_as_float(dr.y << 16); x[i][3] += __uint_as_float(dr.y & 0xffff0000u);
                u32x2 xo; xo.x = cvt_pk_bf16(x[i][0], x[i][1]); xo.y = cvt_pk_bf16(x[i][2], x[i][3]); *(u32x2*)(XBo + (size_t)row * 1024 + 256 * i + 4 * lane) = xo; }
            ss += x[i][0] * x[i][0] + x[i][1] * x[i][1] + x[i][2] * x[i][2] + x[i][3] * x[i][3]; }
        ss = wave_sum(ss); const float rstd = rsqrtf(ss * (1.f / 1024.f) + EPS);
        const float* sh = MODl + (size_t)mr * 6144 + si * 1024;
        f32x4 y[4]; float am = 0.f;
#pragma unroll
        for (int i = 0; i < 4; ++i) { const f32x4 shv = *(const f32x4*)(sh + 256 * i + 4 * lane), scv = *(const f32x4*)(sh + 1024 + 256 * i + 4 * lane);
            y[i] = x[i] * rstd * gv[i] * (scv + 1.f) + shv;
            am = fmaxf(am, fmaxf(fmaxf(fabsf(y[i][0]), fabsf(y[i][1])), fmaxf(fabsf(y[i][2]), fabsf(y[i][3]))));
            u32x2 o; o.x = cvt_pk_bf16(y[i][0], y[i][1]); o.y = cvt_pk_bf16(y[i][2], y[i][3]);
            *(u32x2*)(Hout + (size_t)row * 1024 + 256 * i + 4 * lane) = o; }
        if (H8) {
#pragma unroll
            for (int o = 32; o > 0; o >>= 1) am = fmaxf(am, __shfl_xor(am, o));
            const float inv = am > 0.f ? 127.f / am : 0.f;
#pragma unroll
            for (int i = 0; i < 4; ++i) { const int q0 = (int)rintf(y[i][0] * inv), q1 = (int)rintf(y[i][1] * inv), q2 = (int)rintf(y[i][2] * inv), q3 = (int)rintf(y[i][3] * inv);
                *(unsigned*)(H8 + (size_t)row * 1024 + 256 * i + 4 * lane) = (unsigned)(q0 & 0xff) | ((unsigned)(q1 & 0xff) << 8) | ((unsigned)(q2 & 0xff) << 16) | ((unsigned)(q3 & 0xff) << 24); }
            if (lane == 0) HS[row] = am > 0.f ? am * (1.f / 127.f) : 1.f;
        }
    }
#undef PM_LOAD
}

struct EpiPQ {
    static constexpr bool PERM = true;
    bf16_t* PQ;
    __device__ __forceinline__ void operator()(const f32x4 (&acc)[2][2][4][2], const pg8::Unit& u, int wr, int wc, int fr, int fq) const {
        const size_t r0 = (size_t)u.pm * 256 + wr * 64 + fr; const int col0 = u.pn * 256 + wc * 32 + 8 * fq;
#pragma unroll
        for (int ai = 0; ai < 2; ++ai)
#pragma unroll
            for (int m = 0; m < 4; ++m) { bf16_t* d = PQ + (r0 + ai * 128 + m * 16) * 2048 + col0;
#pragma unroll
                for (int bj = 0; bj < 2; ++bj) { const f32x4 a0 = acc[ai][bj][m][0], a1 = acc[ai][bj][m][1];
                    u32x4 o; o.x = cvt_pk_bf16(a0[0], a0[1]); o.y = cvt_pk_bf16(a0[2], a0[3]); o.z = cvt_pk_bf16(a1[0], a1[1]); o.w = cvt_pk_bf16(a1[2], a1[3]);
                    *(u32x4*)(d + bj * 128) = o; } }
    }
};
__device__ __forceinline__ void phase_p6a(LAS unsigned char* lds, const WS& w, int l, int vb, int nvb) {
    EpiPQ E{w.PQ()}; const int M = l == 0 ? NR : NL;
    pg8::StaticOrder so; so.init(M, 2048, nvb, vb);
    pg8::gemm_phase(lds, pg8::Gemm{w.H(), w.WqT() + (size_t)l * 2048 * 1024, M, 2048, 1024}, so, E);
}


using bf16x2_t = __attribute__((ext_vector_type(2))) __bf16;
typedef float f32x2 __attribute__((ext_vector_type(2)));
__device__ __forceinline__ float gelu_fast(float x) {
    const float u2 = 1.5957691216057308f * (x + 0.044715f * x * x * x);
    return x * __builtin_amdgcn_rcpf(1.f + __builtin_amdgcn_exp2f(-1.4426950408889634f * u2));
}
#define DPPF(v, ctrl) __builtin_bit_cast(float, __builtin_amdgcn_update_dpp(0, __builtin_bit_cast(int, (v)), (ctrl), 0xf, 0xf, true))
__device__ __forceinline__ float reduce8(float p0, float p1, float p2, float p3, float p4, float p5, float p6, float p7, int lane) {
    auto s01 = __builtin_amdgcn_permlane32_swap(__float_as_uint(p0), __float_as_uint(p1), false, false);
    auto s23 = __builtin_amdgcn_permlane32_swap(__float_as_uint(p2), __float_as_uint(p3), false, false);
    auto s45 = __builtin_amdgcn_permlane32_swap(__float_as_uint(p4), __float_as_uint(p5), false, false);
    auto s67 = __builtin_amdgcn_permlane32_swap(__float_as_uint(p6), __float_as_uint(p7), false, false);
    const float q0 = __uint_as_float(s01[0]) + __uint_as_float(s01[1]), q1 = __uint_as_float(s23[0]) + __uint_as_float(s23[1]);
    const float q2 = __uint_as_float(s45[0]) + __uint_as_float(s45[1]), q3 = __uint_as_float(s67[0]) + __uint_as_float(s67[1]);
    auto t0 = __builtin_amdgcn_permlane16_swap(__float_as_uint(q0), __float_as_uint(q1), false, false);
    auto t1 = __builtin_amdgcn_permlane16_swap(__float_as_uint(q2), __float_as_uint(q3), false, false);
    float r0 = __uint_as_float(t0[0]) + __uint_as_float(t0[1]);
    float r1 = __uint_as_float(t1[0]) + __uint_as_float(t1[1]);
    r0 += DPPF(r0, 0x128); r1 += DPPF(r1, 0x128);
    float z = (lane & 8) ? r1 : r0;
    z += DPPF(z, 0x141);
    z += DPPF(z, 0xB1);
    z += DPPF(z, 0x4E);
    return z;
}
__device__ __forceinline__ void p7_axpy(const u32x4 v, float wj, f32x2 (&out)[8]) {
    const f32x2 w2 = {wj, wj};
#pragma unroll
    for (int k = 0; k < 4; ++k) { const f32x2 lo = __builtin_amdgcn_cvt_pk_f32_fp8((int)v[k], false), hi2 = __builtin_amdgcn_cvt_pk_f32_fp8((int)v[k], true);
        out[2 * k] = __builtin_elementwise_fma(w2, lo, out[2 * k]); out[2 * k + 1] = __builtin_elementwise_fma(w2, hi2, out[2 * k + 1]); }
}
__device__ __forceinline__ int p7_doti(const u32x4 u, const u32x4 h) {
    int s = __builtin_amdgcn_sdot4((int)u[0], (int)h[0], 0, false); s = __builtin_amdgcn_sdot4((int)u[1], (int)h[1], s, false); s = __builtin_amdgcn_sdot4((int)u[2], (int)h[2], s, false); return __builtin_amdgcn_sdot4((int)u[3], (int)h[3], s, false);
}
#define DPPI(v, ctrl) __builtin_amdgcn_update_dpp(0, (v), (ctrl), 0xf, 0xf, true)
__device__ __forceinline__ int reduce8i(int p0, int p1, int p2, int p3, int p4, int p5, int p6, int p7, int lane) {
    auto s01 = __builtin_amdgcn_permlane32_swap((unsigned)p0, (unsigned)p1, false, false); auto s23 = __builtin_amdgcn_permlane32_swap((unsigned)p2, (unsigned)p3, false, false);
    auto s45 = __builtin_amdgcn_permlane32_swap((unsigned)p4, (unsigned)p5, false, false); auto s67 = __builtin_amdgcn_permlane32_swap((unsigned)p6, (unsigned)p7, false, false);
    const unsigned q0 = s01[0] + s01[1], q1 = s23[0] + s23[1], q2 = s45[0] + s45[1], q3 = s67[0] + s67[1];
    auto t0 = __builtin_amdgcn_permlane16_swap(q0, q1, false, false); auto t1 = __builtin_amdgcn_permlane16_swap(q2, q3, false, false);
    int r0 = (int)(t0[0] + t0[1]), r1 = (int)(t1[0] + t1[1]);
    r0 += DPPI(r0, 0x128); r1 += DPPI(r1, 0x128);
    int z = (lane & 8) ? r1 : r0;
    z += DPPI(z, 0x141); z += DPPI(z, 0xB1); z += DPPI(z, 0x4E);
    return z;
}

struct P7CArgs { const signed char* H8; const unsigned* EG; const unsigned char* U8; int* PART; int nrows; };
__device__ __forceinline__ void phase_p7c(LAS unsigned char* lds, const P7CArgs& a, int part, int prank, int nvb) {
    int tid_ = threadIdx.x; asm volatile("" : "+v"(tid_));
    const int lane = tid_ & 63, wid = __builtin_amdgcn_readfirstlane(tid_ >> 6);
    const int nw = (nvb >> 3) * 8, wrank = prank * 8 + wid;
    LAS unsigned* tab = (LAS unsigned*)(lds + wid * 1024);
    const int grp = lane >> 3, c = lane & 7, c16 = c * 16;
    const unsigned char* ubase = a.U8 + 128 * part + c16;
    const signed char* hbase = a.H8 + 128 * part + c16;
    unsigned* pbase = (unsigned*)a.PART + (size_t)part * a.nrows * 64;
    const int c2 = (c >> 2) & 1, c1 = (c >> 1) & 1, c0 = c & 1;
    const int ent0 = 8 * (4 * c2 + 2 * c0 + c1) + grp;
    u32x4 Av[16], Bv[16]; u32x4 Ah, Bh;
    unsigned pw0 = 0u, pw1 = 0u;
#define P7C_PREF(t) do { pw0 = a.EG[(size_t)(t) * 128 + lane]; pw1 = a.EG[(size_t)(t) * 128 + 64 + lane]; } while (0)
#define P7C_ISSUE(X, Xh, t, slot, tnext) do { LAS unsigned* tb_ = tab + (slot) * 128; \
        tb_[lane] = pw0; tb_[64 + lane] = pw1; \
        asm volatile("s_waitcnt lgkmcnt(0)" ::: "memory"); \
        _Pragma("unroll") for (int i_ = 0; i_ < 16; ++i_) { const unsigned e_ = tb_[8 * i_ + grp]; X[i_] = *(const u32x4*)(ubase + (size_t)(e_ >> 16) * 1024); } \
        Xh = *(const u32x4*)(hbase + (size_t)(t) * 1024); \
        P7C_PREF(tnext); } while (0)
#define P7C_X(v, ctrl) ((v) + DPPI((v), (ctrl)))
#define P7C_COMPUTE(X, Xh, t, valid) do { int d_[16]; \
        _Pragma("unroll") for (int i_ = 0; i_ < 16; ++i_) d_[i_] = p7_doti(X[i_], Xh); \
        int e8_[8]; _Pragma("unroll") for (int k = 0; k < 8; ++k) { const int send_ = c2 ? d_[k] : d_[k + 8], keep_ = c2 ? d_[k + 8] : d_[k]; e8_[k] = keep_ + DPPI(send_, 0x141); }            \
        int e4_[4]; _Pragma("unroll") for (int k = 0; k < 4; ++k) { const int send_ = c0 ? e8_[k] : e8_[k + 4], keep_ = c0 ? e8_[k + 4] : e8_[k]; e4_[k] = keep_ + DPPI(send_, 0xB1); }          \
        int e2_[2]; _Pragma("unroll") for (int k = 0; k < 2; ++k) { const int send_ = c1 ? e4_[k] : e4_[k + 2], keep_ = c1 ? e4_[k + 2] : e4_[k]; e2_[k] = keep_ + DPPI(send_, 0x4E); }          \
        if (valid) pbase[(size_t)(t) * 64 + ent0] = __builtin_bit_cast(unsigned, __builtin_amdgcn_cvt_pk_i16((e2_[0] + 8) >> 4, (e2_[1] + 8) >> 4)); } while (0)
    const int lastrow = a.nrows - 1;
    int t = wrank;
    P7C_PREF(t);
    P7C_ISSUE(Av, Ah, t, 0, (t + nw < a.nrows ? t + nw : lastrow));
    while (t < a.nrows) {
        const int t1 = t + nw, t2 = t1 + nw, t3 = t2 + nw;
        const int k1 = t1 < a.nrows ? t1 : lastrow, k2 = t2 < a.nrows ? t2 : lastrow, k3 = t3 < a.nrows ? t3 : lastrow;
        P7C_ISSUE(Bv, Bh, k1, 1, k2);
        P7C_COMPUTE(Av, Ah, t, true);
        P7C_ISSUE(Av, Ah, k2, 0, k3);
        P7C_COMPUTE(Bv, Bh, k1, (t1 < a.nrows));
        t = t2;
    }
#undef P7C_PREF
#undef P7C_ISSUE
#undef P7C_COMPUTE
}
__device__ __forceinline__ void phase_p7d(const int* __restrict__ PART, const unsigned* __restrict__ EG, const float* __restrict__ US, const float* __restrict__ VS, const float* __restrict__ HS, unsigned* __restrict__ WE, int nrows, int vb, int nvb) {
    int tid_ = threadIdx.x; asm volatile("" : "+v"(tid_));
    typedef int i32x4 __attribute__((ext_vector_type(4)));
    const size_t n16 = (size_t)nrows * 16, pstride4 = n16;
    const u32x4* P4 = (const u32x4*)PART; const u32x4* EG4 = (const u32x4*)EG; u32x4* WE4 = (u32x4*)WE;
    for (size_t j = (size_t)vb * 512 + tid_; j < n16; j += (size_t)nvb * 512) {
        const size_t row = j >> 4; const int P = (int)(j >> 1) & 7, gq = (int)j & 1;
        i32x4 slo = {0, 0, 0, 0}, shi = {0, 0, 0, 0};
#pragma unroll
        for (int p = 0; p < 8; ++p) { const u32x4 d = P4[p * pstride4 + j];
#pragma unroll
            for (int k = 0; k < 4; ++k) { slo[k] += (int)(d[k] << 16) >> 16; shi[k] += (int)d[k] >> 16; } }
        const float hs = HS[row] * 16.f;
#pragma unroll
        for (int half = 0; half < 2; ++half) {
            const size_t ei = row * 32 + 4 * P + 2 * half + gq;
            const u32x4 eg = EG4[ei]; u32x4 o;
#pragma unroll
            for (int k = 0; k < 4; ++k) { const int eid = (int)(eg[k] >> 16);
                const float av = (float)(half ? shi[k] : slo[k]) * US[eid] * hs;
                const float wv = __uint_as_float(eg[k] << 16) * gelu_fast(av) * VS[eid];
                o[k] = (eg[k] & 0xffff0000u) | (cvt_pk_bf16(wv, 0.f) & 0xffffu); }
            WE4[ei] = o;
        }
    }
}
struct P7BArgs { const unsigned* WE; const unsigned char* V8; bf16_t* XB; const float* gate2; int nrows; };
template <int PM>
__device__ __forceinline__ void phase_p7b(LAS unsigned char* lds, const P7BArgs& a, int part, int prank, int nvb) {
    int tid_ = threadIdx.x; asm volatile("" : "+v"(tid_));
    const int lane = tid_ & 63, wid = __builtin_amdgcn_readfirstlane(tid_ >> 6);
    const int nw = (nvb >> 3) * 8, wrank = prank * 8 + wid;
    LAS unsigned* tab = (LAS unsigned*)(lds + wid * 1024);
    const int grp = lane >> 3, c16 = (lane & 7) * 16;
    const unsigned char* vbase = a.V8 + 128 * part + c16;
    const int colofs = 128 * part + c16 + 8 * (lane >> 5) + 4 * ((lane >> 4) & 1) + 2 * ((lane >> 3) & 1);
    u32x4 Av[16], Bv[16]; float Aw[16], Bw[16]; unsigned Ax, Bx; f32x2 Ag, Bg;
    unsigned pw0 = 0u, pw1 = 0u;
#define P7B_PREF(t) do { pw0 = a.WE[(size_t)(t) * 128 + lane]; pw1 = a.WE[(size_t)(t) * 128 + 64 + lane]; } while (0)
#define P7B_ISSUE(X, Xw, Xx, Xg, t, slot, tnext) do { LAS unsigned* tb_ = tab + (slot) * 128; \
        tb_[lane] = pw0; tb_[64 + lane] = pw1; \
        asm volatile("s_waitcnt lgkmcnt(0)" ::: "memory"); \
        _Pragma("unroll") for (int i_ = 0; i_ < 16; ++i_) { const unsigned we_ = tb_[8 * i_ + grp]; Xw[i_] = __uint_as_float(we_ << 16); if (PM != 2) X[i_] = *(const u32x4*)(vbase + (size_t)(we_ >> 16) * 1024); else X[i_] = (u32x4){we_, 0x38383838u, 0x38383838u, 0x38383838u}; } \
        { const int mr_ = (t) >= NL ? 32 : (t) / S; \
          Xx = *(const unsigned*)(a.XB + (size_t)(t) * 1024 + colofs); Xg = *(const f32x2*)(a.gate2 + (size_t)mr_ * 6144 + colofs); } \
        P7B_PREF(tnext); } while (0)
#define P7B_COMPUTE(X, Xw, Xx, Xg, t, valid) do { f32x2 acc2[8]; \
        _Pragma("unroll") for (int k = 0; k < 8; ++k) acc2[k] = (f32x2){0.f, 0.f}; \
        if (PM != 1) { _Pragma("unroll") for (int i_ = 0; i_ < 16; ++i_) p7_axpy(X[i_], Xw[i_], acc2); } else { _Pragma("unroll") for (int i_ = 0; i_ < 16; ++i_) acc2[i_ >> 1][i_ & 1] = __uint_as_float((X[i_][0] ^ X[i_][1] ^ X[i_][2] ^ X[i_][3]) & 0x3fffffffu) + Xw[i_]; } \
        float b_[8]; _Pragma("unroll") for (int k = 0; k < 8; ++k) { auto s_ = __builtin_amdgcn_permlane32_swap(__float_as_uint(acc2[k >> 1][k & 1]), __float_as_uint(acc2[(k + 8) >> 1][k & 1]), false, false); b_[k] = __uint_as_float(s_[0]) + __uint_as_float(s_[1]); } \
        float c_[4]; _Pragma("unroll") for (int k = 0; k < 4; ++k) { auto s_ = __builtin_amdgcn_permlane16_swap(__float_as_uint(b_[k]), __float_as_uint(b_[k + 4]), false, false); c_[k] = __uint_as_float(s_[0]) + __uint_as_float(s_[1]); } \
        float d_[2]; _Pragma("unroll") for (int k = 0; k < 2; ++k) { const float send_ = (lane & 8) ? c_[k] : c_[k + 2]; const float keep_ = (lane & 8) ? c_[k + 2] : c_[k]; d_[k] = keep_ + DPPF(send_, 0x128); } \
        unsigned* xp_ = (unsigned*)(a.XB + (size_t)(t) * 1024 + colofs); \
        f32x2 x_ = {__uint_as_float(Xx << 16), __uint_as_float(Xx & 0xffff0000u)}; x_.x += Xg.x * d_[0]; x_.y += Xg.y * d_[1]; if ((valid) && PM == 0) *xp_ = cvt_pk_bf16(x_.x, x_.y); else if (PM != 0 && x_.x == 1.2345e30f) *xp_ = cvt_pk_bf16(x_.x, x_.y); } while (0)
    const int lastrow = a.nrows - 1;
    int t = wrank;
    P7B_PREF(t);
    P7B_ISSUE(Av, Aw, Ax, Ag, t, 0, (t + nw < a.nrows ? t + nw : lastrow));
    while (t < a.nrows) {
        const int t1 = t + nw, t2 = t1 + nw, t3 = t2 + nw;
        const int c1 = t1 < a.nrows ? t1 : lastrow, c2 = t2 < a.nrows ? t2 : lastrow, c3 = t3 < a.nrows ? t3 : lastrow;
        P7B_ISSUE(Bv, Bw, Bx, Bg, c1, 1, c2);
        P7B_COMPUTE(Av, Aw, Ax, Ag, t, true);
        P7B_ISSUE(Av, Aw, Ax, Ag, c2, 0, c3);
        P7B_COMPUTE(Bv, Bw, Bx, Bg, c1, (t1 < a.nrows));
        t = t2;
    }
#undef P7B_PREF
#undef P7B_ISSUE
#undef P7B_COMPUTE
}
__device__ __forceinline__ void phase_final_norm(const bf16_t* __restrict__ XBp, float* __restrict__ OUT, const float* __restrict__ g, int vb, int nvb) {
    int tid_ = threadIdx.x; asm volatile("" : "+v"(tid_));
    const int lane = tid_ & 63, wid = tid_ >> 6;
    for (int row = vb * 8 + wid; row < NL; row += nvb * 8) {
        const bf16_t* xp = XBp + (size_t)row * 1024; f32x4 x[4]; float ss = 0.f;
#pragma unroll
        for (int i = 0; i < 4; ++i) { const u32x2 r = *(const u32x2*)(xp + 256 * i + 4 * lane); x[i] = (f32x4){__uint_as_float(r.x << 16), __uint_as_float(r.x & 0xffff0000u), __uint_as_float(r.y << 16), __uint_as_float(r.y & 0xffff0000u)};
            ss += x[i][0] * x[i][0] + x[i][1] * x[i][1] + x[i][2] * x[i][2] + x[i][3] * x[i][3]; }
        ss = wave_sum(ss); const float rstd = rsqrtf(ss * (1.f / 1024.f) + EPS);
#pragma unroll
        for (int i = 0; i < 4; ++i) *(f32x4*)(OUT + (size_t)row * 1024 + 256 * i + 4 * lane) = x[i] * rstd * *(const f32x4*)(g + 256 * i + 4 * lane);
    }
}

template <int V_> struct IC { static constexpr int value = V_; };
typedef short s16x4 __attribute__((ext_vector_type(4)));
__device__ __forceinline__ s16x4 lds_tr16(const LAS unsigned char* p) { return __builtin_bit_cast(s16x4, __builtin_amdgcn_ds_read_tr16_b64_v4i16((LAS s16x4*)p)); }
constexpr int ATT_BUF = 20480;
__device__ __forceinline__ void glds16(const void* g, unsigned lds_base) {
    unsigned sv; asm volatile("s_mov_b32 %0, m0\n\ts_mov_b32 m0, %2\n\ts_nop 0\n\tglobal_load_lds_dwordx4 %1, off\n\ts_mov_b32 m0, %0" : "=&s"(sv) : "v"(g), "s"(lds_base) : "memory"); }
template <int DK>
__device__ __forceinline__ void attn_unit(LAS unsigned char* lds, const bf16_t* __restrict__ Q, const bf16_t* __restrict__ K1, const bf16_t* __restrict__ K2, const bf16_t* __restrict__ V,
                                          int nkeys, float c2, bf16_t* __restrict__ out) {
    int tid_ = threadIdx.x; asm volatile("" : "+v"(tid_));
    const int tid = tid_, lane = tid & 63, wid = __builtin_amdgcn_readfirstlane(tid >> 6), r32 = lane & 31, hi = lane >> 5;
    constexpr int NS = DK / 16, NM = 2 * NS;
    bf16x8 qf[NS];
    { const bf16_t* qp = Q + (size_t)(wid * 32 + r32) * DK + 8 * hi;
#pragma unroll
      for (int s = 0; s < NS; ++s) qf[s] = *(const bf16x8*)(qp + 16 * s); }
    const int dkey = 8 * wid + (lane >> 3), dkey2 = 16 * (wid & 3) + (lane >> 2);
    const bf16_t* gk1 = K1 + (size_t)dkey * 64 + (((lane & 7) ^ ((dkey >> 1) & 7)) << 3);
    const bf16_t* gv = V + (size_t)dkey * 64 + (((lane & 7) ^ (((dkey >> 1) & 1) << 2)) << 3);
    const bf16_t* gk2 = (DK == 96) ? K2 + (size_t)dkey2 * 32 + (((lane & 3) ^ ((dkey2 >> 2) & 3)) << 3) : nullptr;
    const unsigned lds0 = (unsigned)(size_t)lds;
    const unsigned d_k1 = lds0 + wid * 1024, d_v = lds0 + 8192 + wid * 1024, d_k2 = lds0 + 16384 + (wid & 3) * 1024;
#define ATT_DMA(tile_, slot_) do { const int tt_ = (tile_); glds16(gk1 + (size_t)tt_ * 4096, (unsigned)__builtin_amdgcn_readfirstlane(d_k1 + (slot_) * ATT_BUF)); \
        glds16(gv + (size_t)tt_ * 4096, (unsigned)__builtin_amdgcn_readfirstlane(d_v + (slot_) * ATT_BUF)); \
        if (DK == 96) glds16(gk2 + (size_t)tt_ * 2048, (unsigned)__builtin_amdgcn_readfirstlane(d_k2 + (slot_) * ATT_BUF)); } while (0)
#define ATT_WAIT_BAR() do { if (DK == 96) asm volatile("s_waitcnt vmcnt(3) lgkmcnt(0)\n\ts_barrier" ::: "memory"); else asm volatile("s_waitcnt vmcnt(2) lgkmcnt(0)\n\ts_barrier" ::: "memory"); } while (0)
    unsigned ka[2][4];
#pragma unroll
    for (int kt = 0; kt < 2; ++kt)
#pragma unroll
        for (int s = 0; s < 4; ++s) { const int key = 32 * kt + r32; ka[kt][s] = key * 128 + (((2 * s + hi) ^ ((key >> 1) & 7)) << 4); }
    unsigned kb[2][2];
#pragma unroll
    for (int kt = 0; kt < 2; ++kt)
#pragma unroll
        for (int s = 0; s < 2; ++s) { const int key = 32 * kt + r32; kb[kt][s] = 16384 + key * 64 + (((2 * s + hi) ^ ((key >> 2) & 3)) << 4); }
    const int vq = (lane & 15) >> 2, vp = lane & 3, vg = (lane >> 4) & 1;
    unsigned va[2];
#pragma unroll
    for (int dvb = 0; dvb < 2; ++dvb) { const int key = 4 * hi + vq; va[dvb] = 8192 + key * 128 + ((((32 * dvb + 16 * vg + 4 * vp) * 2)) ^ (((key >> 1) & 1) << 6)); }
    float m = -1e30f, l = 0.f, mx;
    f32x16 o0 = {}, o1 = {};
    const int NT = nkeys >> 6;
    ATT_DMA(0, 0); ATT_DMA(NT > 1 ? 1 : 0, 1); ATT_DMA(NT > 2 ? 2 : NT - 1, 2);
    asm volatile("s_waitcnt vmcnt(0) lgkmcnt(0)\n\ts_barrier" ::: "memory");
    f32x16 pa0 = {}, pa1 = {}, pb0 = {}, pb1 = {};
    {
        bf16x8 kf0[NS], kf1[NS];
#pragma unroll
        for (int s = 0; s < 4; ++s) { kf0[s] = *(const LAS bf16x8*)(lds + ka[0][s]); kf1[s] = *(const LAS bf16x8*)(lds + ka[1][s]); }
        if (DK == 96) {
#pragma unroll
            for (int s = 0; s < 2; ++s) { kf0[4 + s] = *(const LAS bf16x8*)(lds + kb[0][s]); kf1[4 + s] = *(const LAS bf16x8*)(lds + kb[1][s]); }
        }
#pragma unroll
        for (int s = 0; s < NS; ++s) { pa0 = mfma32(kf0[s], qf[s], pa0); pa1 = mfma32(kf1[s], qf[s], pa1); }
        mx = pa0[0];
#pragma unroll
        for (int r = 1; r < 16; ++r) mx = fmaxf(mx, pa0[r]);
#pragma unroll
        for (int r = 0; r < 16; ++r) mx = fmaxf(mx, pa1[r]);
    }
    auto step = [&](auto bc_, auto bn_, auto bw_, f32x16& pc0, f32x16& pc1, f32x16& pn0, f32x16& pn1, int t) __attribute__((always_inline)) {
        constexpr int BC = decltype(bc_)::value * ATT_BUF, BN = decltype(bn_)::value * ATT_BUF;
        ATT_DMA((t + 3 < NT) ? t + 3 : NT - 1, decltype(bw_)::value);
        bf16x8 kf0[NS], kf1[NS];
#pragma unroll
        for (int s = 0; s < 4; ++s) { kf0[s] = *(const LAS bf16x8*)(lds + BN + ka[0][s]); kf1[s] = *(const LAS bf16x8*)(lds + BN + ka[1][s]); }
        if (DK == 96) {
#pragma unroll
            for (int s = 0; s < 2; ++s) { kf0[4 + s] = *(const LAS bf16x8*)(lds + BN + kb[0][s]); kf1[4 + s] = *(const LAS bf16x8*)(lds + BN + kb[1][s]); }
        }
        __builtin_amdgcn_sched_barrier(0);
        { auto rr = __builtin_amdgcn_permlane32_swap(__float_as_uint(mx), __float_as_uint(mx), false, false); mx = fmaxf(__uint_as_float(rr[0]), __uint_as_float(rr[1])); }
        const float tm = mx;
        if (__any(tm > m + 8.f)) {
            const float mn = fmaxf(m, tm), al = __builtin_amdgcn_exp2f(m - mn); m = mn; l *= al;
#pragma unroll
            for (int r = 0; r < 16; ++r) { o0[r] *= al; o1[r] *= al; }
        }
        const float nm = -m; float ls = 0.f;
        pn0 = f32x16{}; pn1 = f32x16{};
        unsigned pw[16];
        s16x4 vlo[2][2][2], vhi[2][2][2];
#pragma unroll
        for (int c = 0; c < 8; ++c) {
            __builtin_amdgcn_sched_barrier(0);
#pragma unroll
            for (int j = 0; j < NM; ++j) if (j >= c * NM / 8 && j < (c + 1) * NM / 8) { if (j & 1) pn1 = mfma32(kf1[j >> 1], qf[j >> 1], pn1); else pn0 = mfma32(kf0[j >> 1], qf[j >> 1], pn0); }
            if (c == 4) {
#pragma unroll
                for (int kt = 0; kt < 2; ++kt)
#pragma unroll
                    for (int sp = 0; sp < 2; ++sp) { const int kofs = (32 * kt + 16 * sp) * 128;
#pragma unroll
                        for (int dvb = 0; dvb < 2; ++dvb) { vlo[dvb][kt][sp] = lds_tr16(lds + BC + va[dvb] + kofs); vhi[dvb][kt][sp] = lds_tr16(lds + BC + va[dvb] + kofs + 8 * 128); } }
            }
            __builtin_amdgcn_sched_barrier(0);
            if (c < 4) {
#pragma unroll
                for (int i = 0; i < 4; ++i) { const int r = 4 * c + i; pc0[r] = __builtin_amdgcn_exp2f(pc0[r] + nm); ls += pc0[r]; }
                pw[2 * c] = cvt_pk_bf16(pc0[4 * c], pc0[4 * c + 1]); pw[2 * c + 1] = cvt_pk_bf16(pc0[4 * c + 2], pc0[4 * c + 3]);
            } else {
#pragma unroll
                for (int i = 0; i < 4; ++i) { const int r = 4 * (c - 4) + i; pc1[r] = __builtin_amdgcn_exp2f(pc1[r] + nm); ls += pc1[r]; }
                pw[8 + 2 * (c - 4)] = cvt_pk_bf16(pc1[4 * (c - 4)], pc1[4 * (c - 4) + 1]); pw[8 + 2 * (c - 4) + 1] = cvt_pk_bf16(pc1[4 * (c - 4) + 2], pc1[4 * (c - 4) + 3]);
            }
        }
        __builtin_amdgcn_sched_barrier(0);
        l += ls;
        float mxn = -3.0e38f;
#pragma unroll
        for (int k = 0; k < 8; ++k) { const int kt = k >> 2, sp = (k >> 1) & 1, dvb = k & 1;
            const u32x4 pq = (u32x4){pw[8 * kt + 4 * sp], pw[8 * kt + 4 * sp + 1], pw[8 * kt + 4 * sp + 2], pw[8 * kt + 4 * sp + 3]};
            const s16x4 lo = vlo[dvb][kt][sp], hi4 = vhi[dvb][kt][sp]; const bf16x8 vf = (bf16x8){lo[0], lo[1], lo[2], lo[3], hi4[0], hi4[1], hi4[2], hi4[3]};
            if (dvb == 0) o0 = mfma32(vf, __builtin_bit_cast(bf16x8, pq), o0); else o1 = mfma32(vf, __builtin_bit_cast(bf16x8, pq), o1);
            __builtin_amdgcn_sched_barrier(0);
            if (k < 4) { mxn = fmaxf(fmaxf(mxn, pn0[4 * k]), fmaxf(pn0[4 * k + 1], fmaxf(pn0[4 * k + 2], pn0[4 * k + 3]))); }
            else { mxn = fmaxf(fmaxf(mxn, pn1[4 * (k - 4)]), fmaxf(pn1[4 * (k - 4) + 1], fmaxf(pn1[4 * (k - 4) + 2], pn1[4 * (k - 4) + 3]))); }
            __builtin_amdgcn_sched_barrier(0);
        }
        mx = mxn;
        ATT_WAIT_BAR();
    };
    for (int t = 0; t < NT; t += 4) {
        step(IC<0>{}, IC<1>{}, IC<3>{}, pa0, pa1, pb0, pb1, t);
        step(IC<1>{}, IC<2>{}, IC<0>{}, pb0, pb1, pa0, pa1, t + 1);
        step(IC<2>{}, IC<3>{}, IC<1>{}, pa0, pa1, pb0, pb1, t + 2);
        step(IC<3>{}, IC<0>{}, IC<2>{}, pb0, pb1, pa0, pa1, t + 3);
    }
    { auto rr = __builtin_amdgcn_permlane32_swap(__float_as_uint(l), __float_as_uint(l), false, false); l = __uint_as_float(rr[0]) + __uint_as_float(rr[1]); }
    const float il = 1.f / l;
    bf16_t* op = out + (size_t)(wid * 32 + r32) * 1024 + 4 * hi;
#pragma unroll
    for (int g = 0; g < 4; ++g) { u32x2 a, b;
        a.x = cvt_pk_bf16(o0[4 * g] * il, o0[4 * g + 1] * il); a.y = cvt_pk_bf16(o0[4 * g + 2] * il, o0[4 * g + 3] * il);
        b.x = cvt_pk_bf16(o1[4 * g] * il, o1[4 * g + 1] * il); b.y = cvt_pk_bf16(o1[4 * g + 2] * il, o1[4 * g + 3] * il);
        *(u32x2*)(op + 8 * g) = a; *(u32x2*)(op + 32 + 8 * g) = b; }
}
#undef ATT_DMA
#undef ATT_WAIT_BAR
__device__ __forceinline__ void phase_p3(LAS unsigned char* lds, const WS& w, int l, int vb, int nvb, int xpart, int xrank) {
    const float c2g = 0.125f * 1.4426950408889634f, c2m = 0.10206207261596577f * 1.4426950408889634f;
    bf16_t* MIX = w.H();
    const int nlat = NB * 12 * 8, nctx = (l == 0) ? NB * 12 : 0;
    const bool xl = (nvb == 256);
    for (int u = vb; u < nlat + nctx; u += nvb) {
        if (u < nlat) {
            int qb, slot, b;
            if (xl) { const int grp = (u >> 8) * 32 + 4 * xpart + (xrank >> 3); qb = xrank & 7; slot = grp % 12; b = grp / 12; }
            else { qb = u & 7; slot = (u >> 3) % 12; b = u / 96; }
            bf16_t* out = MIX + ((size_t)b * S + qb * 256) * 1024;
            if (slot < 6) attn_unit<64>(lds, w.Qg() + (((size_t)b * 6 + slot) * S + qb * 256) * 64, w.Kg() + ((size_t)b * 2 + slot / 3) * KEYS * 64, nullptr, w.Vg() + ((size_t)b * 2 + slot / 3) * KEYS * 64, KEYS, c2g, out + slot * 64);
            else { const int h = slot - 6; attn_unit<96>(lds, w.Qm() + (((size_t)b * 6 + h) * S + qb * 256) * 96, w.Kmn() + ((size_t)b * 6 + h) * KEYS * 64, w.KR() + (size_t)b * KEYS * 32, w.Vm() + ((size_t)b * 6 + h) * KEYS * 64, KEYS, c2m, out + 640 + h * 64); }
        } else {
            const int v = u - nlat, slot = v % 12, b = v / 12;
            bf16_t* out = MIX + ((size_t)NL + (size_t)b * CTX) * 1024;
            if (slot < 6) attn_unit<64>(lds, w.Qgc() + ((size_t)b * 6 + slot) * CTX * 64, w.Kg() + ((size_t)b * 2 + slot / 3) * KEYS * 64, nullptr, w.Vg() + ((size_t)b * 2 + slot / 3) * KEYS * 64, CTX, c2g, out + slot * 64);
            else { const int h = slot - 6; attn_unit<96>(lds, w.Qmc() + ((size_t)b * 6 + h) * CTX * 96, w.Kmn() + ((size_t)b * 6 + h) * KEYS * 64, w.KR() + (size_t)b * KEYS * 32, w.Vm() + ((size_t)b * 6 + h) * KEYS * 64, CTX, c2m, out + 640 + h * 64); }
        }
    }
}

__device__ __forceinline__ unsigned fkey(float f, unsigned tag, unsigned mask) { return (__float_as_uint(f) & ~mask) | tag; }
__device__ __forceinline__ float keyf(unsigned k, unsigned mask) { return __uint_as_float(k & ~mask); }
__device__ __forceinline__ unsigned fmax_u(unsigned a, unsigned b) { unsigned r; asm("v_max_f32 %0, %1, %2" : "=v"(r) : "v"(a), "v"(b)); return r; }
__device__ __forceinline__ unsigned fmin_u(unsigned a, unsigned b) { unsigned r; asm("v_min_f32 %0, %1, %2" : "=v"(r) : "v"(a), "v"(b)); return r; }
__device__ __forceinline__ void ce_desc(unsigned& a, unsigned& b) { const unsigned hi_ = fmax_u(a, b), lo_ = fmin_u(a, b); a = hi_; b = lo_; }
template <int J> __device__ __forceinline__ void bstage16(unsigned* a) {
#pragma unroll
    for (int i = 0; i < 16; ++i) { const int l = i ^ J; if (l > i) ce_desc(a[i], a[l]); }
}
__device__ __forceinline__ void sort16_desc(unsigned* a) {
#define CE_(i, j) ce_desc(a[i], a[j]);
    CE_(0, 13) CE_(1, 12) CE_(2, 15) CE_(3, 14) CE_(4, 8) CE_(5, 6) CE_(7, 11) CE_(9, 10)
    CE_(0, 5) CE_(1, 7) CE_(2, 9) CE_(3, 4) CE_(6, 13) CE_(8, 14) CE_(10, 15) CE_(11, 12)
    CE_(0, 1) CE_(2, 3) CE_(4, 5) CE_(6, 8) CE_(7, 9) CE_(10, 11) CE_(12, 13) CE_(14, 15)
    CE_(0, 2) CE_(1, 3) CE_(4, 10) CE_(5, 11) CE_(6, 7) CE_(8, 9) CE_(12, 14) CE_(13, 15)
    CE_(1, 2) CE_(3, 12) CE_(4, 6) CE_(5, 7) CE_(8, 10) CE_(9, 11) CE_(13, 14)
    CE_(1, 4) CE_(2, 6) CE_(5, 8) CE_(7, 10) CE_(9, 13) CE_(11, 14)
    CE_(2, 4) CE_(3, 6) CE_(9, 12) CE_(11, 13)
    CE_(3, 5) CE_(6, 8) CE_(7, 9) CE_(10, 12)
    CE_(3, 4) CE_(5, 6) CE_(7, 8) CE_(9, 10) CE_(11, 12)
    CE_(6, 7) CE_(8, 9)
#undef CE_
}
__device__ __forceinline__ void bmerge16_desc(unsigned* c) { bstage16<8>(c); bstage16<4>(c); bstage16<2>(c); bstage16<1>(c); }
__device__ __forceinline__ void merge_top16(unsigned* a, const unsigned* b) {
#pragma unroll
    for (int i = 0; i < 16; ++i) a[i] = fmax_u(a[i], b[15 - i]);
    bmerge16_desc(a);
}
__device__ __forceinline__ void xlane_top16(unsigned* t, int hi) {
    unsigned r[16]; const unsigned msk = 0u - (unsigned)hi;
#pragma unroll
    for (int i = 0; i < 16; ++i) r[i] = t[i] ^ ((t[i] ^ t[15 - i]) & msk);
#pragma unroll
    for (int i = 0; i < 16; ++i) { auto s = __builtin_amdgcn_permlane32_swap(r[i], r[i], false, false); t[i] = fmax_u(s[0], s[1]); }
    bmerge16_desc(t);
}
__device__ __forceinline__ constexpr int cand_a(int c) { return c < 16 ? 0 : c < 24 ? 1 : c < 32 ? 39 - c : c < 37 ? 2 : c < 41 ? 3 : c < 44 ? 4 : c < 46 ? 5 : c < 48 ? 6 : 7; }
__device__ __forceinline__ constexpr int cand_b(int c) { return c < 16 ? c : c < 24 ? c - 16 : c < 32 ? 0 : c < 37 ? c - 32 : c < 41 ? c - 37 : c < 44 ? c - 41 : c < 46 ? c - 44 : c < 48 ? c - 46 : c - 48; }

__device__ __forceinline__ void phase_p6b(LAS unsigned char* lds, const bf16_t* __restrict__ PQ, const bf16_t* __restrict__ SubKl, unsigned* __restrict__ EG, int nrows, int vb, int nvb) {
    int tid_ = threadIdx.x; asm volatile("" : "+v"(tid_));
    const int tid = tid_, lane = tid & 63, wid = __builtin_amdgcn_readfirstlane(tid >> 6), r32 = lane & 31, hi = lane >> 5;
    const int h = vb & 7, wrank = (vb >> 3) * 8 + wid, nwr = (nvb >> 3) * 8;
    LAS unsigned short* tab = (LAS unsigned short*)(lds + 65536 + wid * 4096) + r32 * 64;
#pragma unroll
    for (int i = 0; i < 8; ++i) { const int idx = i * 512 + tid, p = idx >> 11, key = (idx >> 4) & 127, ch = idx & 15;
        *(LAS u32x4*)(lds + p * 32768 + key * 256 + ((ch ^ (key & 15)) << 4)) = *(const u32x4*)(SubKl + ((size_t)(h * 2 + p) * 128 + key) * 128 + ch * 8); }
    __syncthreads();
    const int ngroups = nrows >> 5;
    for (int tg = wrank; tg < ngroups; tg += nwr) {
        const int row0 = tg << 5;
        bf16x8 qf[2][8];
        { const bf16_t* qp = PQ + (size_t)(row0 + r32) * 2048 + h * 256 + 8 * hi; asm volatile("" : "+v"(qp));
#pragma unroll
          for (int p = 0; p < 2; ++p)
#pragma unroll
              for (int s = 0; s < 8; ++s) qf[p][s] = *(const bf16x8*)(qp + p * 128 + 16 * s); }
        unsigned top[2][16];
#pragma unroll
        for (int p = 0; p < 2; ++p) {
            f32x16 acc[4];
#pragma unroll
            for (int kt = 0; kt < 4; ++kt) { acc[kt] = f32x16{}; const int key = 32 * kt + r32;
#pragma unroll
                for (int s = 0; s < 8; ++s) acc[kt] = mfma32(*(const LAS bf16x8*)(lds + p * 32768 + key * 256 + (((2 * s + hi) ^ (key & 15)) << 4)), qf[p][s], acc[kt]); }
            unsigned key[64];
#pragma unroll
            for (int kt = 0; kt < 4; ++kt)
#pragma unroll
                for (int r = 0; r < 16; ++r) { const int n = 32 * kt + (r & 3) + 8 * (r >> 2) + 4 * hi; key[16 * kt + r] = fkey(acc[kt][r], 127u - (unsigned)n, 127u); }
            sort16_desc(key); sort16_desc(key + 16); sort16_desc(key + 32); sort16_desc(key + 48);
            merge_top16(key, key + 16); merge_top16(key + 32, key + 48); merge_top16(key, key + 32);
            xlane_top16(key, hi);
#pragma unroll
            for (int i = 0; i < 16; ++i) top[p][i] = key[i];
        }
        float t0f[16], t1f[16];
#pragma unroll
        for (int i = 0; i < 16; ++i) { t0f[i] = keyf(top[0][i], 127u); t1f[i] = keyf(top[1][i], 127u); }
        unsigned ck[50];
#pragma unroll
        for (int c = 0; c < 50; ++c) ck[c] = fkey(t0f[cand_a(c)] + t1f[cand_b(c)], (unsigned)c, 63u);
        if (hi == 0) {
#pragma unroll
            for (int c = 0; c < 50; c += 2) {
                const unsigned ea = (127u - (top[0][cand_a(c)] & 127u)) * 128u + (127u - (top[1][cand_b(c)] & 127u));
                const unsigned eb = (127u - (top[0][cand_a(c + 1)] & 127u)) * 128u + (127u - (top[1][cand_b(c + 1)] & 127u));
                *(LAS unsigned*)(tab + c) = ea | (eb << 16);
            }
        }
        bmerge16_desc(ck + 16); sort16_desc(ck + 32);
        merge_top16(ck, ck + 16); merge_top16(ck, ck + 32);
        ck[15] = fmax_u(ck[15], ck[48]); ck[14] = fmax_u(ck[14], ck[49]); bmerge16_desc(ck);
        asm volatile("s_waitcnt lgkmcnt(0)" ::: "memory");
        const float mx = keyf(ck[0], 63u); float e[16], den = 0.f;
#pragma unroll
        for (int j = 0; j < 16; ++j) { e[j] = __builtin_amdgcn_exp2f((keyf(ck[j], 63u) - mx) * 1.4426950408889634f); den += e[j]; }
        const float iden = 1.f / den;
        if (hi == 0) {
            unsigned o[16];
#pragma unroll
            for (int j = 0; j < 16; ++j) { const unsigned eid = tab[ck[j] & 63u]; o[j] = (eid << 16) | (cvt_pk_bf16(e[j] * iden, 0.f) & 0xffffu); }
            unsigned* dst = EG + (size_t)(row0 + r32) * 128 + h * 16;
#pragma unroll
            for (int j = 0; j < 16; j += 4) *(u32x4*)(dst + j) = (u32x4){o[j], o[j + 1], o[j + 2], o[j + 3]};
        }
        asm volatile("s_waitcnt lgkmcnt(0)" ::: "memory");
    }
}


#define XB_TMO      128
#define XB_XCNT(j)  (256  + 64 * (j))
#define XB_XSUB(j)  (1280 + 64 * (j))
#define XB_XGEN(j)  (2304 + 64 * (j))
#define XB_TOP      3328
#define XB_TOPGEN   3392
#define XCD_BAR_WORDS 3456
#define XB_SPIN_CAP (1u << 18)

__device__ __forceinline__ unsigned xb_ld(unsigned* p)              { return __hip_atomic_load(p, __ATOMIC_RELAXED, __HIP_MEMORY_SCOPE_AGENT); }
__device__ __forceinline__ unsigned xb_add(unsigned* p, unsigned v) { return __hip_atomic_fetch_add(p, v, __ATOMIC_RELAXED, __HIP_MEMORY_SCOPE_AGENT); }
__device__ __forceinline__ unsigned xb_xcc_id() { return (unsigned)__builtin_amdgcn_s_getreg((3 << 11) | 20) & 0xFu; }
#define XB_SPIN(cond, bar) do { unsigned _sp = 0; while (cond) { __builtin_amdgcn_s_sleep(1); \
    if ((++_sp & 255u) == 0u) { if (xb_ld(&(bar)[XB_TMO])) break; if (_sp > XB_SPIN_CAP) { atomicAdd(&(bar)[XB_TMO], 1u); break; } } } } while (0)

struct XcdBarrier {
    unsigned* bar; unsigned x;
    volatile LAS unsigned* st;
};

__device__ __forceinline__ XcdBarrier xcd_barrier_post(unsigned* bar, volatile LAS unsigned* st) {
    XcdBarrier b; b.bar = bar; b.x = xb_xcc_id(); b.st = st;
    if (threadIdx.x == 0) (void)xb_add(&bar[XB_XCNT(b.x)], 1u);
    return b;
}
__device__ __forceinline__ void xcd_barrier_complete(unsigned* bar, unsigned x, unsigned& nloc, unsigned& nx) {
    const unsigned G = gridDim.x * gridDim.y * gridDim.z;
    unsigned sum, cnt, mine, sp = 0u;
    for (;;) {
        sum = 0u; cnt = 0u; mine = 0u;
#pragma unroll
        for (unsigned j = 0; j < 16; ++j) { const unsigned c = xb_ld(&bar[XB_XCNT(j)]); sum += c; cnt += (c > 0u) ? 1u : 0u; mine = (j == x) ? c : mine; }
        if (sum == G) break;
        __builtin_amdgcn_s_sleep(1);
        if ((++sp & 255u) == 0u) { if (xb_ld(&bar[XB_TMO])) break; if (sp > XB_SPIN_CAP) { atomicAdd(&bar[XB_TMO], 1u); break; } }
    }
    nloc = mine > 0u ? mine : 1u; nx = cnt > 0u ? cnt : 1u;
}

__device__ __forceinline__ void xcd_barrier(const XcdBarrier& b) {
    asm volatile("s_waitcnt vmcnt(0)" ::: "memory");
    __syncthreads();
    if (threadIdx.x == 0) {
        unsigned* bar = b.bar;
        __builtin_amdgcn_s_waitcnt(0);
        unsigned nloc = b.st[0], nx = b.st[1];
        if (nloc == 0u) { xcd_barrier_complete(bar, b.x, nloc, nx); b.st[0] = nloc; b.st[1] = nx; }
        const unsigned old = xb_add(&bar[XB_XSUB(b.x)], 1u);
        const unsigned gen = old / nloc;
        if (old + 1u == (gen + 1u) * nloc) {
            __builtin_amdgcn_fence(__ATOMIC_RELEASE, "agent");
            asm volatile("s_waitcnt vmcnt(0)" ::: "memory");
            const unsigned og = xb_add(&bar[XB_TOP], 1u);
            const unsigned tg = og / nx;
            if (og + 1u == (tg + 1u) * nx) xb_add(&bar[XB_TOPGEN], 1u);
            else XB_SPIN(xb_ld(&bar[XB_TOPGEN]) == tg, bar);
            __builtin_amdgcn_fence(__ATOMIC_ACQUIRE, "agent");
            xb_add(&bar[XB_XGEN(b.x)], 1u);
            asm volatile("s_waitcnt vmcnt(0)" ::: "memory");
        } else {
            XB_SPIN(xb_ld(&bar[XB_XGEN(b.x)]) == gen, bar);
            __builtin_amdgcn_fence(__ATOMIC_ACQUIRE, "agent");
            asm volatile("s_waitcnt vmcnt(0)" ::: "memory");
        }
    }
    __syncthreads();
}

__device__ __forceinline__ void phase_mod(LAS unsigned char* lds, const Inputs& in, const WS& w, int vb) {
    if (vb >= 72) return;
    LAS float* sc = (LAS float*)lds;
    int tid_ = threadIdx.x; asm volatile("" : "+v"(tid_));
    const int tid = tid_, idx = vb * 512 + tid, rg = idx / 12288, ln = idx % 12288, l = ln / 6144, n = ln % 6144;
    float acc[11];
#pragma unroll
    for (int i = 0; i < 11; ++i) acc[i] = 0.f;
    const float* wp = in.ada_w + (size_t)l * 1024 * 6144 + n;
    for (int kc = 0; kc < 4; ++kc) {
        for (int i = tid; i < 33 * 256; i += 512) { const int r = i >> 8, k = kc * 256 + (i & 255); const float v = r < 32 ? in.c[(size_t)r * 1024 + k] : in.c_ctx[k]; sc[i] = v / (1.f + __expf(-v)); }
        __syncthreads();
        for (int k = 0; k < 256; ++k) { const float wv = wp[(size_t)(kc * 256 + k) * 6144];
#pragma unroll
            for (int i = 0; i < 11; ++i) acc[i] += sc[(rg * 11 + i) * 256 + k] * wv; }
        __syncthreads();
    }
    const float bias = in.ada_b[(size_t)l * 6144 + n];
#pragma unroll
    for (int i = 0; i < 11; ++i) w.MOD()[((size_t)l * 33 + rg * 11 + i) * 6144 + n] = acc[i] + bias;
}
__device__ __forceinline__ void phase_rope(const WS& w, int vb, int nvb) {
    int tid_ = threadIdx.x; asm volatile("" : "+v"(tid_));
    for (int i = vb * 512 + tid_; i < 2048 * 32; i += nvb * 512) {
        { const int t = i / 32, j = i % 32; const double inv = pow(10000.0, -(double)(j % 16) / 16.0); const double a = (double)(j < 16 ? t / 64 : t % 64) * inv; w.ROPA()[i] = make_float2((float)cos(a), (float)sin(a)); }
        if (i < 2048 * 16) { const int t = i / 16, j = i % 16; const double inv = pow(10000.0, -(double)(j % 8) / 8.0); const double a = (double)(j < 8 ? t / 64 : t % 64) * inv; w.ROPC()[i] = make_float2((float)cos(a), (float)sin(a)); }
    }
}

#ifndef PROBE_MASK
#define PROBE_MASK 0
#endif
#ifndef BENCH_MODE
#define BENCH_MODE 0
#endif
#if BENCH_MODE
__device__ __forceinline__ void phase_bench(float* sink) {
    int tid_ = threadIdx.x; asm volatile("" : "+v"(tid_));
    float x[16];
#pragma unroll
    for (int i = 0; i < 16; ++i) x[i] = (float)(tid_ + i) * 0.001f;
    f32x16 acc[4] = {};
    bf16x8 a = (bf16x8){(short)tid_, 1, 2, 3, 4, 5, 6, 7}, b = (bf16x8){7, 6, 5, 4, 3, 2, 1, (short)tid_};
#pragma nounroll
    for (int it = 0; it < ((BENCH_MODE & 7) ? 2048 : 0); ++it) {
#pragma unroll
        for (int k = 0; k < 8; ++k) {
            if (BENCH_MODE & 2) { acc[k & 3] = mfma32(a, b, acc[k & 3]); }
            __builtin_amdgcn_sched_barrier(0);
            if (BENCH_MODE & 1) { asm volatile("v_exp_f32 %0, -|%0|" : "+v"(x[2 * k])); asm volatile("v_exp_f32 %0, -|%0|" : "+v"(x[2 * k + 1])); }
            if (BENCH_MODE & 4) {
#pragma unroll
                for (int j = 0; j < 8; ++j) asm volatile("v_fma_f32 %0, %0, %0, %0" : "+v"(x[(2 * k + j) & 15]));
            }
            __builtin_amdgcn_sched_barrier(0);
        }
    }
    if (BENCH_MODE & 24) {
        const int lane = tid_ & 63, r32 = lane & 31, hi = lane >> 5;
        unsigned ka[2][4];
#pragma unroll
        for (int kt = 0; kt < 2; ++kt)
#pragma unroll
            for (int s_ = 0; s_ < 4; ++s_) { const int key = 32 * kt + r32; ka[kt][s_] = key * 128 + (((2 * s_ + hi) ^ ((key >> 1) & 7)) << 4); }
        const int vq = (lane & 15) >> 2, vp = lane & 3, vg = (lane >> 4) & 1;
        unsigned va[2];
#pragma unroll
        for (int dvb = 0; dvb < 2; ++dvb) { const int key = 4 * hi + vq; va[dvb] = 8192 + key * 128 + ((((32 * dvb + 16 * vg + 4 * vp) * 2)) ^ (((key >> 1) & 1) << 6)); }
        u32x4 kr[8]; u32x2 vr[16];
#pragma nounroll
        for (int it = 0; it < 2048; ++it) {
            if (BENCH_MODE & 8) {
#pragma unroll
                for (int kt = 0; kt < 2; ++kt)
#pragma unroll
                    for (int s_ = 0; s_ < 4; ++s_) asm volatile("ds_read_b128 %0, %1" : "=v"(kr[kt * 4 + s_]) : "v"(ka[kt][s_]));
            }
            if (BENCH_MODE & 16) {
#pragma unroll
                for (int q = 0; q < 4; ++q)
#pragma unroll
                    for (int dvb = 0; dvb < 2; ++dvb) { asm volatile("ds_read_b64_tr_b16 %0, %1" : "=v"(vr[q * 4 + dvb * 2]) : "v"(va[dvb] + q * 2048)); asm volatile("ds_read_b64_tr_b16 %0, %1 offset:1024" : "=v"(vr[q * 4 + dvb * 2 + 1]) : "v"(va[dvb] + q * 2048)); }
            }
            asm volatile("s_waitcnt lgkmcnt(0)" ::: "memory");
        }
        if (BENCH_MODE & 8) {
#pragma unroll
            for (int i = 0; i < 8; ++i) x[i] += __uint_as_float(kr[i][0] ^ kr[i][1] ^ kr[i][2] ^ kr[i][3]);
        }
        if (BENCH_MODE & 16) {
#pragma unroll
            for (int i = 0; i < 16; ++i) x[i] += __uint_as_float(vr[i][0] ^ vr[i][1]);
        }
    }
    float r = 0.f;
#pragma unroll
    for (int i = 0; i < 16; ++i) r += x[i];
#pragma unroll
    for (int k = 0; k < 4; ++k)
#pragma unroll
        for (int i = 0; i < 16; ++i) r += acc[k][i];
    if (r == 1.2345e30f) sink[tid_] = r;
}
#endif
struct MegaArgs { Inputs in; WS w; float* XL; unsigned* bar; };
constexpr int MEGA_LDS = 131072 + 16;
__global__ void __launch_bounds__(512, 2) k_mega(MegaArgs A) {
    LAS unsigned char* lds = (LAS unsigned char*)dyn_lds;
    const int vb = blockIdx.x, nvb = gridDim.x;
    volatile LAS unsigned* xbw = (volatile LAS unsigned*)(lds + 131072);
    if (threadIdx.x == 0) { xbw[0] = 0u; xbw[1] = 0u; xbw[2] = 0u; xbw[3] = 0u; }
    __syncthreads();
    XcdBarrier bar = xcd_barrier_post(A.bar, xbw);
    if (threadIdx.x == 0) xbw[2] = xb_add(&A.bar[3584 + 64 * bar.x], 1u);
    __syncthreads();
    const int xticket = __builtin_amdgcn_readfirstlane((int)xbw[2]);
    const WS& w = A.w; const Inputs& in = A.in;
    phase_mod(lds, in, w, vb);
    phase_rope(w, vb, nvb);
    phase_cvt(lds, in, w, vb, nvb);
    xcd_barrier(bar);
    phase_modulate<false>(in.x, in.ctx, nullptr, w.H(), in.norm1_g, w.MOD(), 0, NR, vb, nvb);
    xcd_barrier(bar);
#if (PROBE_MASK >> 0) & 1
    phase_mod(lds, in, w, vb);
    phase_rope(w, vb, nvb);
    phase_cvt(lds, in, w, vb, nvb);
    xcd_barrier(bar);
    phase_modulate<false>(in.x, in.ctx, nullptr, w.H(), in.norm1_g, w.MOD(), 0, NR, vb, nvb);
    xcd_barrier(bar);
#endif
#if BENCH_MODE
    phase_bench((float*)w.RSQ());
#endif
    int xpart = vb & 7, xrank = vb >> 3;
    { bool okx = (bar.x < 8u); for (unsigned j = 0; j < 8; ++j) okx = okx && (xb_ld(&A.bar[XB_XCNT(j)]) == (unsigned)(nvb >> 3));
      if (okx) { xpart = (int)bar.x; xrank = xticket; } }
    for (int l = 0; l < DEPTH; ++l) {
        const float* MODl = w.MOD() + (size_t)l * 33 * 6144;
        const bool last = (l == DEPTH - 1);
        const int MR = last ? NL : NR;
        phase_p1(lds, w, in, l, vb, nvb); xcd_barrier(bar);
#if (PROBE_MASK >> 1) & 1
        phase_p1(lds, w, in, l, vb, nvb); xcd_barrier(bar);
#endif
        phase_p2(lds, w, in, l, vb, nvb); xcd_barrier(bar);
#if (PROBE_MASK >> 12) & 7
        phase_p2(lds, w, in, l, vb, nvb, (PROBE_MASK >> 12) & 7); xcd_barrier(bar);
#endif
        phase_p3(lds, w, l, vb, nvb, xpart, xrank); xcd_barrier(bar);
#if (PROBE_MASK >> 3) & 1
        phase_p3(lds, w, l, vb, nvb, xpart, xrank); xcd_barrier(bar);
#endif
        phase_p4(lds, w, in, l, vb, nvb);
        xcd_barrier(bar);
#if (PROBE_MASK >> 4) & 1
        phase_p4(lds, w, in, l, vb, nvb);
        xcd_barrier(bar);
#endif
        if (l == 0) phase_modulate<false>(in.x, in.ctx, nullptr, w.H(), in.norm2_g + l * 1024, MODl, 3, MR, vb, nvb, w.H8(), w.HS(), w.PQ(), w.XB());
        else phase_modulate<true>(nullptr, nullptr, w.XB(), w.H(), in.norm2_g + l * 1024, MODl, 3, MR, vb, nvb, w.H8(), w.HS(), w.PQ(), w.XB());
        xcd_barrier(bar);
#if (PROBE_MASK >> 5) & 1
        phase_modulate<true>(nullptr, nullptr, w.XB(), w.H(), in.norm2_g + l * 1024, MODl, 3, MR, vb, nvb, w.H8(), w.HS()); xcd_barrier(bar);
#endif
        phase_p6a(lds, w, l, vb, nvb); xcd_barrier(bar);
#if (PROBE_MASK >> 6) & 1
        phase_p6a(lds, w, l, vb, nvb); xcd_barrier(bar);
#endif
        phase_p6b(lds, w.PQ(), w.SubK() + (size_t)l * 16 * 128 * 128, w.EG(), MR, vb, nvb); xcd_barrier(bar);
#if (PROBE_MASK >> 7) & 1
        phase_p6b(lds, w.PQ(), w.SubK() + (size_t)l * 16 * 128 * 128, w.EG(), MR, vb, nvb); xcd_barrier(bar);
#endif
        { P7CArgs a{w.H8(), w.EG(), w.U8() + (size_t)l * NE * 1024, (int*)w.PQ(), MR}; phase_p7c(lds, a, xpart, xrank, nvb); }
        xcd_barrier(bar);
#if (PROBE_MASK >> 8) & 1
        { P7CArgs a{w.H8(), w.EG(), w.U8() + (size_t)l * NE * 1024, (int*)w.PQ(), MR}; phase_p7c(lds, a, xpart, xrank, nvb); }
        xcd_barrier(bar);
#endif
        phase_p7d((const int*)w.PQ(), w.EG(), w.US() + (size_t)l * NE, w.VS() + (size_t)l * NE, w.HS(), w.WE(), MR, vb, nvb);
        xcd_barrier(bar);
#if (PROBE_MASK >> 9) & 1
        phase_p7d((const int*)w.PQ(), w.EG(), w.US() + (size_t)l * NE, w.VS() + (size_t)l * NE, w.HS(), w.WE(), MR, vb, nvb);
        xcd_barrier(bar);
#endif
        { P7BArgs a{w.WE(), w.V8() + (size_t)l * NE * 1024, w.XB(), MODl + 5 * 1024, MR}; phase_p7b<0>(lds, a, xpart, xrank, nvb); }
        xcd_barrier(bar);
#if (PROBE_MASK >> 10) & 3
        { P7BArgs a{w.WE(), w.V8() + (size_t)l * NE * 1024, w.XB(), MODl + 5 * 1024, MR}; phase_p7b<((PROBE_MASK >> 10) & 3)>(lds, a, xpart, xrank, nvb); }
        xcd_barrier(bar);
#endif
        if (last) phase_final_norm(w.XB(), A.XL, in.final_g, vb, nvb);
        else phase_modulate<true>(nullptr, nullptr, w.XB(), w.H(), in.norm1_g + (l + 1) * 1024, w.MOD() + (size_t)(l + 1) * 33 * 6144, 0, NR, vb, nvb);
        if (!last) xcd_barrier(bar);
    }
}

extern "C" void kernel_launch(void* const* d_in, const int* in_sizes, int n_in, void* d_out, int out_size, void* d_ws, size_t ws_size, hipStream_t stream) {
    const float* const* fin = (const float* const*)d_in;
    Inputs in{fin[0], fin[1], fin[2], fin[3], fin[4], fin[5], fin[6], fin[7], fin[8], fin[9], fin[10], fin[11], fin[12], fin[13], fin[14], fin[15], fin[16], fin[17], fin[18], fin[19], fin[20], fin[21], fin[22]};
    WS w = make_ws(d_ws);
    static int ok = 0;
    if (!ok) {
        if (hipFuncSetAttribute((const void*)k_mega, hipFuncAttributeMaxDynamicSharedMemorySize, MEGA_LDS) != hipSuccess) { ok = -1; }
        int per_cu = 0, cus = 0, dev = 0; (void)hipGetDevice(&dev); (void)hipDeviceGetAttribute(&cus, hipDeviceAttributeMultiprocessorCount, dev);
        if (hipOccupancyMaxActiveBlocksPerMultiprocessor(&per_cu, (const void*)k_mega, 512, MEGA_LDS) != hipSuccess || per_cu < 1 || cus < 256) ok = -1;
        if (ok == 0) ok = 1;
    }
    if (ok < 0) return;
    (void)hipMemsetAsync(d_ws, 0, 16384, stream);
    MegaArgs A{in, w, (float*)d_out, (unsigned*)d_ws};
    k_mega<<<256, 512, MEGA_LDS, stream>>>(A);
}
```

```cpp
#include <hip/hip_runtime.h>
#include <stdint.h>

typedef unsigned short bf16_t;

constexpr int D = 1024, NB = 32, S = 2048, CTX = 256, DEPTH = 2;
constexpr int NL = NB * S, NC = NB * CTX, NR = NL + NC;
constexpr int KEYS = CTX + S;
constexpr int INC = 1568;
constexpr int NE = 16384;
constexpr float EPS = 1e-6f;

__device__ __forceinline__ float bf2f(bf16_t v) { return __uint_as_float(((unsigned)v) << 16); }
__device__ __forceinline__ bf16_t f2bf(float f) { unsigned u = __float_as_uint(f); u += 0x7FFFu + ((u >> 16) & 1u); return (bf16_t)(u >> 16); }

__device__ __forceinline__ float wave_sum(float v) {
#pragma unroll
    for (int o = 32; o > 0; o >>= 1) v += __shfl_xor(v, o);
    return v;
}
__device__ __forceinline__ float gelu_tanh(float x) {
    const float u = 0.7978845608028654f * (x + 0.044715f * x * x * x);
    return 0.5f * x * (1.f + tanhf(u));
}

struct WS {
    char* base;
    __host__ __device__ __forceinline__ bf16_t* H() const { return (bf16_t*)(base + 65536ull); }
    __host__ __device__ __forceinline__ bf16_t* Qg() const { return (bf16_t*)(base + 151060480ull); }
    __host__ __device__ __forceinline__ bf16_t* Qgc() const { return (bf16_t*)(base + 201392128ull); }
    __host__ __device__ __forceinline__ bf16_t* Kg() const { return (bf16_t*)(base + 207683584ull); }
    __host__ __device__ __forceinline__ bf16_t* Vg() const { return (bf16_t*)(base + 226557952ull); }
    __host__ __device__ __forceinline__ bf16_t* CQ() const { return (bf16_t*)(base + 245432320ull); }
    __host__ __device__ __forceinline__ bf16_t* CKV() const { return (bf16_t*)(base + 302055424ull); }
    __host__ __device__ __forceinline__ bf16_t* Bp() const { return (bf16_t*)(base + 339804160ull); }
    __host__ __device__ __forceinline__ bf16_t* KR() const { return (bf16_t*)(base + 377552896ull); }
    __host__ __device__ __forceinline__ bf16_t* Qm() const { return (bf16_t*)(base + 382271488ull); }
    __host__ __device__ __forceinline__ bf16_t* Qmc() const { return (bf16_t*)(base + 457768960ull); }
    __host__ __device__ __forceinline__ bf16_t* Kmn() const { return (bf16_t*)(base + 467206144ull); }
    __host__ __device__ __forceinline__ bf16_t* Vm() const { return (bf16_t*)(base + 523829248ull); }
    __host__ __device__ __forceinline__ unsigned* EG() const { return (unsigned*)(base + 580452352ull); }
    __host__ __device__ __forceinline__ bf16_t* P() const { return (bf16_t*)(base + 382271488ull); }
    __host__ __device__ __forceinline__ bf16_t* PQ() const { return (bf16_t*)(base + 151060480ull); }
    __host__ __device__ __forceinline__ bf16_t* TMP() const { return (bf16_t*)(base + 65536ull); }
    __host__ __device__ __forceinline__ float* XC() const { return (float*)(base + 618201088ull); }
    __host__ __device__ __forceinline__ float* MOD() const { return (float*)(base + 651755520ull); }
    __host__ __device__ __forceinline__ float2* ROPA() const { return (float2*)(base + 653377536ull); }
    __host__ __device__ __forceinline__ float2* ROPC() const { return (float2*)(base + 653901824ull); }
    __host__ __device__ __forceinline__ float* RSQ() const { return (float*)(base + 654163968ull); }
    __host__ __device__ __forceinline__ float* RSKV() const { return (float*)(base + 654458880ull); }
    __host__ __device__ __forceinline__ bf16_t* WinT() const { return (bf16_t*)(base + 654753792ull); }
    __host__ __device__ __forceinline__ bf16_t* WuqT() const { return (bf16_t*)(base + 662093824ull); }
    __host__ __device__ __forceinline__ bf16_t* WukvT() const { return (bf16_t*)(base + 663273472ull); }
    __host__ __device__ __forceinline__ bf16_t* WoutT() const { return (bf16_t*)(base + 664059904ull); }
    __host__ __device__ __forceinline__ bf16_t* WqT() const { return (bf16_t*)(base + 668254208ull); }
    __host__ __device__ __forceinline__ bf16_t* SubK() const { return (bf16_t*)(base + 676642816ull); }
    __host__ __device__ __forceinline__ unsigned char* U8() const { return (unsigned char*)(base + 677691392ull); }
    __host__ __device__ __forceinline__ unsigned char* V8() const { return (unsigned char*)(base + 711245824ull); }
    __host__ __device__ __forceinline__ float* US() const { return (float*)(base + 744800256ull); }
    __host__ __device__ __forceinline__ float* VS() const { return (float*)(base + 744931328ull); }
    __host__ __device__ __forceinline__ float* SSQ() const { return (float*)(base + 745062400ull); }
    __host__ __device__ __forceinline__ float* SSKV() const { return (float*)(base + 747421696ull); }
    __host__ __device__ __forceinline__ unsigned* WE() const { return (unsigned*)(base + 748601344ull); }
    __host__ __device__ __forceinline__ signed char* H8() const { return (signed char*)(base + 786350080ull); }
    __host__ __device__ __forceinline__ float* HS() const { return (float*)(base + 861847552ull); }
    __host__ __device__ __forceinline__ bf16_t* PoolWT() const { return (bf16_t*)(base + 862142464ull); }
    __host__ __device__ __forceinline__ bf16_t* XB() const { return (bf16_t*)(base + 862208000ull); }
};
constexpr size_t WS_BYTES = 862208000ull + (size_t)NR * 1024 * 2;
static WS make_ws(void* d_ws) { WS w; w.base = (char*)d_ws; return w; }


#define LAS __attribute__((address_space(3)))
typedef short bf16x8 __attribute__((ext_vector_type(8)));
typedef float f32x4 __attribute__((ext_vector_type(4)));
typedef float f32x16 __attribute__((ext_vector_type(16)));
typedef unsigned u32x4 __attribute__((ext_vector_type(4)));
typedef unsigned u32x2 __attribute__((ext_vector_type(2)));

__device__ __forceinline__ f32x16 mfma32(bf16x8 a, bf16x8 b, f32x16 c) { return __builtin_amdgcn_mfma_f32_32x32x16_bf16(a, b, c, 0, 0, 0); }
__device__ __forceinline__ unsigned cvt_pk_bf16(float lo, float hi) { unsigned r; asm volatile("v_cvt_pk_bf16_f32 %0, %1, %2" : "=v"(r) : "v"(lo), "v"(hi)); return r; }

namespace pg8 {
constexpr int BM = 256, BK = 64, HALF = 128, HTB = HALF * BK * 2, STAGE_BYTES = 8 * HTB, NXCD = 8, WGM = 8;
__host__ __device__ __forceinline__ int lds_byte(int r, int c) { const int st = (r >> 4) * 2 + (c >> 5), rr = r & 15, cc = c & 31, ob = rr * 64 + cc * 2; return st * 1024 + (ob ^ (((ob >> 9) & 1) << 5)); }
__host__ __device__ __forceinline__ void stage_rc(int b, int& R, int& C) { const int st = b / 1024, sb = b % 1024, swz = sb ^ (((sb >> 9) & 1) << 5); R = (st >> 1) * 16 + swz / 64; C = (st & 1) * 32 + (swz % 64) / 2; }
__host__ __device__ __forceinline__ int perm32(int rho) { const int n = rho >> 4, i = rho & 15; return 8 * (i >> 2) + 4 * n + (i & 3); }
struct Unit { int pm, pn; };
struct Gemm { const bf16_t* A; const bf16_t* Bt; int M, N, K; };
struct StaticOrder {
    int nM, nN, nwg, G, c;
    __host__ __device__ void init(int M, int N, int G_, int c_) { nM = M / BM; nN = N / BM; nwg = nM * nN; G = G_; c = c_; }
    __host__ __device__ bool next(int i, Unit& u) const {
        const long L = (long)i * G + c; if (L >= nwg) return false;
        int wgid = (int)L; { const int q = nwg / NXCD, r = nwg % NXCD, xcd = wgid % NXCD, off = wgid / NXCD; wgid = (xcd < r ? xcd * (q + 1) : r * (q + 1) + (xcd - r) * q) + off; }
        const int nig = WGM * nN, gid = wgid / nig, fm = gid * WGM, gsz = (nM - fm) < WGM ? (nM - fm) : WGM;
        u.pm = fm + ((wgid % nig) % gsz); u.pn = (wgid % nig) / gsz; return true;
    }
};
template <class Epi, class Sched>
__device__ __forceinline__ void gemm_phase(LAS unsigned char* lds, const Gemm g, const Sched& S, const Epi& E) {
    int tid_ = threadIdx.x; asm volatile("" : "+v"(tid_));
    const int tid = tid_, wid = __builtin_amdgcn_readfirstlane(tid >> 6), lane = tid & 63, wr = wid >> 2, wc = wid & 3, fr = lane & 15, fq = lane >> 4;
    const int K = g.K, nt = K / BK;
    unsigned voffA[2], voffB[2];
#pragma unroll
    for (int i = 0; i < 2; ++i) { int R, C; stage_rc(tid * 16 + i * 8192, R, C); const int Rb = Epi::PERM ? ((R & ~31) + perm32(R & 31)) : R;
        voffA[i] = (unsigned)(R * K + C) * 2u; voffB[i] = (unsigned)(Rb * K + C) * 2u; }
    const size_t kstep = (size_t)(BK * 2);
    const size_t hstep = (size_t)HALF * K * 2;
    const size_t tstep = 2 * hstep;
    const unsigned ldsw = (unsigned)wid * 1024u;
    const int aoff = lds_byte(wr * 64 + fr, fq * 8), boff = lds_byte(wc * 32 + fr, fq * 8);
#define PG8_SA(b, h) (((b) * 2 + (h)) * HTB)
#define PG8_SB(b, h) ((4 + (b) * 2 + (h)) * HTB)
#define PG8_STAGE(bufoff, gbase, voff) do { _Pragma("unroll") for (int _i = 0; _i < 2; ++_i) \
        __builtin_amdgcn_global_load_lds((const unsigned*)((const char*)(gbase) + (voff)[_i]), (LAS unsigned*)(lds + (bufoff) + ldsw + _i * 8192), 16, 0, 0); } while (0)
#define PG8_LDA(dst, b, h) do { _Pragma("unroll") for (int m = 0; m < 4; ++m) _Pragma("unroll") for (int k = 0; k < 2; ++k) dst[m][k] = *(const LAS bf16x8*)(lds + PG8_SA(b, h) + aoff + m * 2048 + k * 1024); } while (0)
#define PG8_LDB(dst, b, h) do { _Pragma("unroll") for (int n = 0; n < 2; ++n) _Pragma("unroll") for (int k = 0; k < 2; ++k) dst[n][k] = *(const LAS bf16x8*)(lds + PG8_SB(b, h) + boff + n * 2048 + k * 1024); } while (0)
#define PG8_MMA(ai, bj, At, Bt) do { __builtin_amdgcn_s_setprio(1); _Pragma("unroll") for (int m = 0; m < 4; ++m) _Pragma("unroll") for (int n = 0; n < 2; ++n) _Pragma("unroll") for (int k = 0; k < 2; ++k) \
        acc[ai][bj][m][n] = __builtin_amdgcn_mfma_f32_16x16x32_bf16(Bt[n][k], At[m][k], acc[ai][bj][m][n], 0, 0, 0); __builtin_amdgcn_s_setprio(0); } while (0)
#define PG8_WAIT_V(n) asm volatile("s_waitcnt vmcnt(" #n ")" ::: "memory")
#define PG8_WAIT_L(n) asm volatile("s_waitcnt lgkmcnt(" #n ")" ::: "memory")
#define PG8_BAR __builtin_amdgcn_s_barrier()
#define PG8_SCHED __builtin_amdgcn_sched_barrier(0)
    Unit cur, nxt; int ui = 0;
    if (!S.next(0, cur)) return;
    f32x4 acc[2][2][4][2];
#pragma unroll
    for (int a = 0; a < 2; ++a)
#pragma unroll
        for (int b = 0; b < 2; ++b)
#pragma unroll
            for (int m = 0; m < 4; ++m)
#pragma unroll
                for (int n = 0; n < 2; ++n) acc[a][b][m][n] = (f32x4){0.f, 0.f, 0.f, 0.f};
    bf16x8 At[4][2], B0[2][2], B1[2][2];
    const char* cA = (const char*)g.A + (size_t)cur.pm * tstep; const char* cB = (const char*)g.Bt + (size_t)cur.pn * tstep;
    PG8_STAGE(PG8_SB(0, 0), cB, voffB); PG8_STAGE(PG8_SA(0, 0), cA, voffA); PG8_STAGE(PG8_SB(0, 1), cB + hstep, voffB); PG8_STAGE(PG8_SA(0, 1), cA + hstep, voffA);
    if (wr == 1) PG8_BAR;
    PG8_WAIT_V(4); PG8_BAR;
    PG8_STAGE(PG8_SB(1, 0), cB + kstep, voffB); PG8_STAGE(PG8_SA(1, 0), cA + kstep, voffA); PG8_STAGE(PG8_SB(1, 1), cB + hstep + kstep, voffB);
    PG8_WAIT_V(6); PG8_BAR;
    for (;;) {
        const bool has_next = S.next(ui + 1, nxt);
        const char* nA = has_next ? (const char*)g.A + (size_t)nxt.pm * tstep : cA; const char* nB = has_next ? (const char*)g.Bt + (size_t)nxt.pn * tstep : cB;
#pragma nounroll
        for (int t = 0; t < nt; t += 2) {
            const bool last = (t == nt - 2);
            const char* a1 = cA + (size_t)(t + 1) * kstep;
            const char* a2 = last ? nA : cA + (size_t)(t + 2) * kstep; const char* b2 = last ? nB : cB + (size_t)(t + 2) * kstep;
            const char* a3 = a2 + kstep; const char* b3 = b2 + kstep;
            PG8_LDB(B0, 0, 0); PG8_SCHED; PG8_LDA(At, 0, 0); PG8_STAGE(PG8_SA(1, 1), a1 + hstep, voffA);
            PG8_WAIT_L(8); PG8_BAR; PG8_WAIT_L(0); PG8_MMA(0, 0, At, B0); PG8_BAR; PG8_SCHED;
            PG8_LDB(B1, 0, 1); PG8_STAGE(PG8_SB(0, 0), b2, voffB);
            PG8_BAR; PG8_WAIT_L(0); PG8_MMA(0, 1, At, B1); PG8_BAR;
            PG8_LDA(At, 0, 1); PG8_STAGE(PG8_SA(0, 0), a2, voffA);
            PG8_BAR; PG8_WAIT_L(0); PG8_MMA(1, 0, At, B0); PG8_BAR; PG8_SCHED;
            PG8_STAGE(PG8_SB(0, 1), b2 + hstep, voffB);
            PG8_WAIT_V(6); PG8_BAR; PG8_MMA(1, 1, At, B1); PG8_BAR;
            PG8_LDB(B0, 1, 0); PG8_SCHED; PG8_LDA(At, 1, 0); PG8_STAGE(PG8_SA(0, 1), a2 + hstep, voffA);
            PG8_WAIT_L(8); PG8_BAR; PG8_WAIT_L(0); PG8_MMA(0, 0, At, B0); PG8_BAR; PG8_SCHED;
            PG8_LDB(B1, 1, 1); PG8_STAGE(PG8_SB(1, 0), b3, voffB);
            PG8_BAR; PG8_WAIT_L(0); PG8_MMA(0, 1, At, B1); PG8_BAR;
            PG8_LDA(At, 1, 1); PG8_STAGE(PG8_SA(1, 0), a3, voffA);
            PG8_BAR; PG8_WAIT_L(0); PG8_MMA(1, 0, At, B0); PG8_BAR; PG8_SCHED;
            PG8_STAGE(PG8_SB(1, 1), b3 + hstep, voffB);
            PG8_WAIT_V(6); PG8_BAR; PG8_MMA(1, 1, At, B1); PG8_BAR;
        }
        E(acc, cur, wr, wc, fr, fq);
        if (!has_next) break;
#pragma unroll
        for (int a = 0; a < 2; ++a)
#pragma unroll
            for (int b = 0; b < 2; ++b)
#pragma unroll
                for (int m = 0; m < 4; ++m)
#pragma unroll
                    for (int n = 0; n < 2; ++n) acc[a][b][m][n] = (f32x4){0.f, 0.f, 0.f, 0.f};
        cur = nxt; cA = nA; cB = nB; ++ui;
    }
    PG8_WAIT_V(0);
    if (wr == 0) PG8_BAR;
    PG8_BAR;
#undef PG8_SA
#undef PG8_SB
#undef PG8_STAGE
#undef PG8_LDA
#undef PG8_LDB
#undef PG8_MMA
#undef PG8_WAIT_V
#undef PG8_WAIT_L
#undef PG8_BAR
#undef PG8_SCHED
}
}

enum { GT_AQ = 0, GT_AK = 1, GT_AV = 2, GT_B = 3, GT_CQ = 4, GT_CKV = 5, GT_KR = 6, GT_PAD = 7 };
__host__ __device__ __forceinline__ void in_group(int g, int& type, int& sub) {
    if (g < 2) { type = GT_AK; sub = g; } else if (g < 4) { type = GT_AV; sub = g - 2; } else if (g < 8) { type = GT_CKV; sub = g - 4; }
    else if (g == 8) { type = GT_KR; sub = 0; } else if (g < 12) { type = GT_PAD; sub = 0; } else if (g < 18) { type = GT_AQ; sub = g - 12; }
    else if (g < 24) { type = GT_CQ; sub = g - 18; } else { type = GT_B; sub = g - 24; }
}
__device__ __forceinline__ int colmap(int mode, int r) {
    const int pn = r >> 8, ct = r & 255, bj = ct >> 7, wc = (ct >> 5) & 3, j = ct & 31, g = 4 * pn + wc, e = 32 * bj + j;
    if (mode == 0) {
        int type, sub; in_group(g, type, sub);
        switch (type) { case GT_AQ: return 64 * sub + e; case GT_AK: return 384 + 64 * sub + e; case GT_AV: return 512 + 64 * sub + e; case GT_B: return 640 + 64 * sub + e;
            case GT_CQ: return 896 + 64 * sub + e; case GT_CKV: return 1280 + 64 * sub + e; case GT_KR: return (j < 16) ? 1536 + 16 * bj + j : -1; default: return -1; }
    } else if (mode == 1) {
        if (g < 6) return 96 * g + e; if (g < 9) { const int head = 2 * (g - 6) + (j >> 4); return 96 * head + 64 + 16 * bj + (j & 15); } return -1;
    } else if (mode == 2) {
        return 64 * g + e;
    }
    return r;
}
__device__ __forceinline__ void cvt_weights_unit(LAS float* tile  , const float* __restrict__ W, int K, int N, bf16_t* __restrict__ dst, int mode, const float* __restrict__ kgain, int r0, int k0) {
    int tid_ = threadIdx.x; asm volatile("" : "+v"(tid_));
    const int tid = tid_;
    const int jj = tid & 63; const int sc = colmap(mode, r0 + jj);
#pragma unroll
    for (int i = 0; i < 8; ++i) { const int kk = (tid >> 6) + 8 * i; float v = 0.f; if (sc >= 0) v = W[(size_t)(k0 + kk) * N + sc]; if (kgain) v *= kgain[k0 + kk]; tile[kk * 65 + jj] = v; }
    __syncthreads();
#pragma unroll
    for (int i = 0; i < 8; ++i) { const int rr = (tid >> 6) + 8 * i, kk = tid & 63; dst[(size_t)(r0 + rr) * K + k0 + kk] = f2bf(tile[kk * 65 + rr]); }
    __syncthreads();
}
struct CvtJob { const float* W; bf16_t* dst; const float* kgain; int K, N, Npad, mode; };
__device__ __forceinline__ void cvt_job(LAS float* tile, const CvtJob j, int vb, int nvb) {
    const int nk = j.K / 64, nr = j.Npad / 64;
    for (int u = vb; u < nk * nr; u += nvb) cvt_weights_unit(tile, j.W, j.K, j.N, j.dst, j.mode, j.kgain, (u / nk) * 64, (u % nk) * 64);
}
__device__ __forceinline__ void cvt_flat(const float* __restrict__ src, bf16_t* __restrict__ dst, size_t n, int vb, int nvb) {
    int tid_ = threadIdx.x; asm volatile("" : "+v"(tid_));
    for (size_t i = ((size_t)vb * 512 + tid_) * 8; i < n; i += (size_t)nvb * 512 * 8) {
        const float4 a = *(const float4*)(src + i), b = *(const float4*)(src + i + 4);
        u32x4 o; o.x = cvt_pk_bf16(a.x, a.y); o.y = cvt_pk_bf16(a.z, a.w); o.z = cvt_pk_bf16(b.x, b.y); o.w = cvt_pk_bf16(b.z, b.w);
        *(u32x4*)(dst + i) = o;
    }
}
template <bool FP8>
__device__ __forceinline__ void cvt_q8_rows(const float* __restrict__ src, unsigned char* __restrict__ dst, float* __restrict__ scales, int nrows, int vb, int nvb) {
    int tid_ = threadIdx.x; asm volatile("" : "+v"(tid_));
    const int lane = tid_ & 63, wid = tid_ >> 6;
    const int stride = nvb * 8;
    for (int row0 = vb * 8 + wid; row0 < nrows; row0 += 4 * stride) {
        f32x4 v[4][4];
#pragma unroll
        for (int q = 0; q < 4; ++q) { const int row = row0 + q * stride < nrows ? row0 + q * stride : row0; const float* sp = src + (size_t)row * 1024 + 16 * lane;
#pragma unroll
            for (int k = 0; k < 4; ++k) v[q][k] = *(const f32x4*)(sp + 4 * k); }
#pragma unroll
        for (int q = 0; q < 4; ++q) { const int row = row0 + q * stride; if (row < nrows) {
            float am = 0.f;
#pragma unroll
            for (int k = 0; k < 4; ++k) am = fmaxf(am, fmaxf(fmaxf(fabsf(v[q][k][0]), fabsf(v[q][k][1])), fmaxf(fabsf(v[q][k][2]), fabsf(v[q][k][3]))));
#pragma unroll
            for (int o = 32; o > 0; o >>= 1) am = fmaxf(am, __shfl_xor(am, o));
            const float qmax = FP8 ? 416.f : 127.f;
            const float sc = am > 0.f ? am / qmax : 1.f, inv = am > 0.f ? qmax / am : 0.f;
            u32x4 o4;
#pragma unroll
            for (int k = 0; k < 4; ++k) {
                if (FP8) { int p = __builtin_amdgcn_cvt_pk_fp8_f32(v[q][k][0] * inv, v[q][k][1] * inv, 0, false); p = __builtin_amdgcn_cvt_pk_fp8_f32(v[q][k][2] * inv, v[q][k][3] * inv, p, true); o4[k] = (unsigned)p; }
                else { const int q0 = (int)rintf(v[q][k][0] * inv), q1 = (int)rintf(v[q][k][1] * inv), q2 = (int)rintf(v[q][k][2] * inv), q3 = (int)rintf(v[q][k][3] * inv);
                    o4[k] = (unsigned)(q0 & 0xff) | ((unsigned)(q1 & 0xff) << 8) | ((unsigned)(q2 & 0xff) << 16) | ((unsigned)(q3 & 0xff) << 24); } }
            *(u32x4*)(dst + (size_t)row * 1024 + 16 * lane) = o4;
            if (lane == 0) scales[row] = sc; } }
    }
}
struct Inputs {
    const float *x, *c, *ctx, *c_ctx, *ada_w, *ada_b, *norm1_g, *norm2_g, *w_in, *gqa_qn_g, *gqa_kn_g, *pool_w, *pool_scale, *mla_qn_g, *mla_kvn_g, *mla_w_uq, *mla_w_ukv, *w_out, *peer_wq, *peer_subkeys, *peer_u, *peer_v, *final_g;
};
__device__ __forceinline__ void phase_cvt(LAS unsigned char* lds, const Inputs& in, const WS& w, int vb, int nvb) {
    LAS float* tile = (LAS float*)lds;
    for (int l = 0; l < 2; ++l) {
        cvt_job(tile, CvtJob{in.w_in + (size_t)l * 1024 * INC, w.WinT() + (size_t)l * 1792 * 1024, nullptr, 1024, INC, 1792, 0}, vb, nvb);
        cvt_job(tile, CvtJob{in.mla_w_uq + (size_t)l * 384 * 576, w.WuqT() + (size_t)l * 768 * 384, in.mla_qn_g + l * 384, 384, 576, 768, 1}, vb, nvb);
        cvt_job(tile, CvtJob{in.mla_w_ukv + (size_t)l * 256 * 768, w.WukvT() + (size_t)l * 768 * 256, in.mla_kvn_g + l * 256, 256, 768, 768, 2}, vb, nvb);
        cvt_job(tile, CvtJob{in.w_out + (size_t)l * 1024 * 1024, w.WoutT() + (size_t)l * 1024 * 1024, nullptr, 1024, 1024, 1024, 3}, vb, nvb);
        cvt_job(tile, CvtJob{in.peer_wq + (size_t)l * 1024 * 2048, w.WqT() + (size_t)l * 2048 * 1024, nullptr, 1024, 2048, 2048, 3}, vb, nvb);
    }
    cvt_flat(in.peer_subkeys, w.SubK(), (size_t)2 * 16 * 128 * 128, vb, nvb);
    { int tp_ = threadIdx.x; asm volatile("" : "+v"(tp_));
      for (int i = vb * 512 + tp_; i < 2 * 4 * 64 * 64; i += nvb * 512) { const int c = i & 63, d = (i >> 6) & 63, lg = i >> 12; w.PoolWT()[i] = f2bf(in.pool_w[(size_t)lg * 4096 + c * 64 + d]); } }
    if (nvb > 144) { if (vb >= 72) { cvt_q8_rows<false>(in.peer_u, w.U8(), w.US(), 2 * NE, vb - 72, nvb - 72); cvt_q8_rows<true>(in.peer_v, w.V8(), w.VS(), 2 * NE, vb - 72, nvb - 72); } }
    else { cvt_q8_rows<false>(in.peer_u, w.U8(), w.US(), 2 * NE, vb, nvb); cvt_q8_rows<true>(in.peer_v, w.V8(), w.VS(), 2 * NE, vb, nvb); }
}

constexpr float ATT_C2G = 0.125f * 1.4426950408889634f, ATT_C2M = 0.10206207261596577f * 1.4426950408889634f;
struct EpiIn {
    static constexpr bool PERM = true;
    WS w; const float* qn_g; const float* kn_g; int pm_base;
    __device__ __forceinline__ void operator()(const f32x4 (&acc)[2][2][4][2], const pg8::Unit& u, int wr, int wc, int fr, int fq) const {
        int type, sub; in_group(4 * u.pn + wc, type, sub);
        if (type == GT_PAD) return;
        const int pm = u.pm + pm_base; const bool isctx = pm >= 256; const int b = isctx ? pm - 256 : pm >> 3; const int t0 = isctx ? 0 : (pm & 7) * 256;
        const size_t rowbase = isctx ? (size_t)NL + (size_t)b * CTX : (size_t)b * S;
        const int keyoff = isctx ? 0 : CTX;
        float gain[2][8];
        if (type == GT_AQ) {
#pragma unroll
            for (int bj = 0; bj < 2; ++bj)
#pragma unroll
                for (int q = 0; q < 8; ++q) gain[bj][q] = qn_g[32 * bj + 8 * fq + q] * ATT_C2G;
        } else if (type == GT_AK) {
#pragma unroll
            for (int bj = 0; bj < 2; ++bj)
#pragma unroll
                for (int q = 0; q < 8; ++q) gain[bj][q] = kn_g[32 * bj + 8 * fq + q];
        }
#pragma unroll
        for (int ai = 0; ai < 2; ++ai)
#pragma unroll
            for (int m = 0; m < 4; ++m) {
                const int t = t0 + 128 * ai + 64 * wr + 16 * m + fr; const size_t row = rowbase + t;
                float v[2][8];
#pragma unroll
                for (int bj = 0; bj < 2; ++bj)
#pragma unroll
                    for (int n = 0; n < 2; ++n)
#pragma unroll
                        for (int i = 0; i < 4; ++i) v[bj][4 * n + i] = acc[ai][bj][m][n][i];
                bf16_t* dst = nullptr;
                if (type == GT_AQ || type == GT_AK) {
                    float ss = 0.f;
#pragma unroll
                    for (int bj = 0; bj < 2; ++bj)
#pragma unroll
                        for (int q = 0; q < 8; ++q) ss += v[bj][q] * v[bj][q];
                    ss += __shfl_xor(ss, 16); ss += __shfl_xor(ss, 32);
                    const float rstd = rsqrtf(ss * (1.f / 64.f) + EPS);
#pragma unroll
                    for (int q = 0; q < 8; ++q) { float x1 = v[0][q] * rstd * gain[0][q], x2 = v[1][q] * rstd * gain[1][q];
                        if (!isctx) { const float2 cs = w.ROPA()[t * 32 + 8 * fq + q]; const float y1 = x1 * cs.x - x2 * cs.y, y2 = x1 * cs.y + x2 * cs.x; x1 = y1; x2 = y2; }
                        v[0][q] = x1; v[1][q] = x2; }
                    if (type == GT_AQ) dst = isctx ? w.Qgc() + (((size_t)b * 6 + sub) * CTX + t) * 64 : w.Qg() + (((size_t)b * 6 + sub) * S + t) * 64;
                    else dst = w.Kg() + (((size_t)b * 2 + sub) * KEYS + keyoff + t) * 64;
                } else if (type == GT_AV) { dst = w.Vg() + (((size_t)b * 2 + sub) * KEYS + keyoff + t) * 64;
                } else if (type == GT_B) { dst = w.Bp() + row * 256 + 64 * sub;
                } else if (type == GT_CQ || type == GT_CKV) {
                    float ss = 0.f;
#pragma unroll
                    for (int bj = 0; bj < 2; ++bj)
#pragma unroll
                        for (int q = 0; q < 8; ++q) ss += v[bj][q] * v[bj][q];
                    ss += __shfl_xor(ss, 16); ss += __shfl_xor(ss, 32);
                    if (type == GT_CQ) { if (fq == 0) w.SSQ()[row * 8 + sub] = ss; dst = w.CQ() + row * 384 + 64 * sub; }
                    else { if (fq == 0) w.SSKV()[row * 4 + sub] = ss; dst = w.CKV() + row * 256 + 64 * sub; }
                } else {
                    if (!isctx) {
#pragma unroll
                        for (int q = 0; q < 8; ++q) { const float2 cs = w.ROPC()[t * 16 + ((8 * fq + q) & 15)]; const float x1 = v[0][q], x2 = v[1][q]; v[0][q] = x1 * cs.x - x2 * cs.y; v[1][q] = x1 * cs.y + x2 * cs.x; } }
                    if (fq < 2) { bf16_t* kd = w.KR() + ((size_t)b * KEYS + keyoff + t) * 32;
#pragma unroll
                        for (int bj = 0; bj < 2; ++bj) { u32x4 o; o.x = cvt_pk_bf16(v[bj][0], v[bj][1]); o.y = cvt_pk_bf16(v[bj][2], v[bj][3]); o.z = cvt_pk_bf16(v[bj][4], v[bj][5]); o.w = cvt_pk_bf16(v[bj][6], v[bj][7]);
                            *(u32x4*)(kd + 16 * bj + 8 * fq) = o; } }
                    continue;
                }
#pragma unroll
                for (int bj = 0; bj < 2; ++bj) { u32x4 o; o.x = cvt_pk_bf16(v[bj][0], v[bj][1]); o.y = cvt_pk_bf16(v[bj][2], v[bj][3]); o.z = cvt_pk_bf16(v[bj][4], v[bj][5]); o.w = cvt_pk_bf16(v[bj][6], v[bj][7]);
                    *(u32x4*)(dst + 32 * bj + 8 * fq) = o; }
            }
    }
};
struct P1Order {
    pg8::StaticOrder so; int nctx_tiles, G, c;
    __device__ bool next(int i, pg8::Unit& u) const {
        const int L = i * G + c;
        if (L < 1792) return so.next(i, u);
        const int Lc = L - 1792; if (Lc >= 32 * nctx_tiles) return false;
        u.pm = 256 + (Lc & 31); u.pn = Lc >> 5; return true;
    }
};
__device__ __forceinline__ void phase_p1(LAS unsigned char* lds, const WS& w, const Inputs& in, int l, int vb, int nvb) {
    EpiIn E{w, in.gqa_qn_g + l * 64, in.gqa_kn_g + l * 64, 0};
    P1Order po; po.so.init(NL, 1792, nvb, vb); po.nctx_tiles = (l == 0) ? 7 : 3; po.G = nvb; po.c = vb;
    pg8::gemm_phase(lds, pg8::Gemm{w.H(), w.WinT() + (size_t)l * 1792 * 1024, NR, 1792, 1024}, po, E);
}

extern __shared__ __attribute__((aligned(16))) unsigned char dyn_lds[];

struct EpiUq {
    static constexpr bool PERM = true;
    WS w;
    __device__ __forceinline__ void operator()(const f32x4 (&acc)[2][2][4][2], const pg8::Unit& u, int wr, int wc, int fr, int fq) const {
        const int g = 4 * u.pn + wc; if (g >= 9) return;
        const int pm = u.pm; const bool isctx = pm >= 256; const int b = isctx ? pm - 256 : pm >> 3; const int t0 = isctx ? 0 : (pm & 7) * 256;
        const size_t rowbase = isctx ? (size_t)NL + (size_t)b * CTX : (size_t)b * S;
        const int head = g < 6 ? g : 2 * (g - 6) + (fq >> 1);
#pragma unroll
        for (int ai = 0; ai < 2; ++ai)
#pragma unroll
            for (int m = 0; m < 4; ++m) {
                const int t = t0 + 128 * ai + 64 * wr + 16 * m + fr; const size_t row = rowbase + t;
                const float4 s0 = *(const float4*)(w.SSQ() + row * 8), s1 = *(const float4*)(w.SSQ() + row * 8 + 4);
                const float rstd = rsqrtf((s0.x + s0.y + s0.z + s0.w + s1.x + s1.y) * (1.f / 384.f) + EPS) * ATT_C2M;
                float v[2][8];
#pragma unroll
                for (int bj = 0; bj < 2; ++bj)
#pragma unroll
                    for (int n = 0; n < 2; ++n)
#pragma unroll
                        for (int i = 0; i < 4; ++i) v[bj][4 * n + i] = acc[ai][bj][m][n][i] * rstd;
                bf16_t* hd = isctx ? w.Qmc() + (((size_t)b * 6 + head) * CTX + t) * 96 : w.Qm() + (((size_t)b * 6 + head) * S + t) * 96;
                if (g >= 6 && !isctx) {
#pragma unroll
                    for (int q = 0; q < 8; ++q) { const float2 cs = w.ROPC()[t * 16 + 8 * (fq & 1) + q]; const float x1 = v[0][q], x2 = v[1][q]; v[0][q] = x1 * cs.x - x2 * cs.y; v[1][q] = x1 * cs.y + x2 * cs.x; } }
#pragma unroll
                for (int bj = 0; bj < 2; ++bj) { u32x4 o; o.x = cvt_pk_bf16(v[bj][0], v[bj][1]); o.y = cvt_pk_bf16(v[bj][2], v[bj][3]); o.z = cvt_pk_bf16(v[bj][4], v[bj][5]); o.w = cvt_pk_bf16(v[bj][6], v[bj][7]);
                    bf16_t* d = g < 6 ? hd + 32 * bj + 8 * fq : hd + 64 + 16 * bj + 8 * (fq & 1);
                    *(u32x4*)d = o; }
            }
    }
};
struct EpiUkv {
    static constexpr bool PERM = true;
    WS w;
    __device__ __forceinline__ void operator()(const f32x4 (&acc)[2][2][4][2], const pg8::Unit& u, int wr, int wc, int fr, int fq) const {
        const int g = 4 * u.pn + wc;
        const int pm = u.pm; const bool isctx = pm >= 256; const int b = isctx ? pm - 256 : pm >> 3; const int t0 = isctx ? 0 : (pm & 7) * 256;
        const size_t rowbase = isctx ? (size_t)NL + (size_t)b * CTX : (size_t)b * S; const int keyoff = isctx ? 0 : CTX;
        bf16_t* base = ((g & 1) ? w.Vm() : w.Kmn()) + ((size_t)b * 6 + (g >> 1)) * KEYS * 64;
#pragma unroll
        for (int ai = 0; ai < 2; ++ai)
#pragma unroll
            for (int m = 0; m < 4; ++m) {
                const int t = t0 + 128 * ai + 64 * wr + 16 * m + fr; const size_t row = rowbase + t;
                const float4 s0 = *(const float4*)(w.SSKV() + row * 4);
                const float rstd = rsqrtf((s0.x + s0.y + s0.z + s0.w) * (1.f / 256.f) + EPS);
                bf16_t* d = base + (size_t)(keyoff + t) * 64;
#pragma unroll
                for (int bj = 0; bj < 2; ++bj) { const f32x4 a0 = acc[ai][bj][m][0] * rstd, a1 = acc[ai][bj][m][1] * rstd;
                    u32x4 o; o.x = cvt_pk_bf16(a0[0], a0[1]); o.y = cvt_pk_bf16(a0[2], a0[3]); o.z = cvt_pk_bf16(a1[0], a1[1]); o.w = cvt_pk_bf16(a1[2], a1[3]);
                    *(u32x4*)(d + 32 * bj + 8 * fq) = o; }
            }
    }
};
constexpr int POOL_X = 0, POOL_P = 272 * 128, POOL_BYTES = 272 * 128 + 256 * 128;
template <int G>
__device__ __forceinline__ void pool_sums(LAS unsigned char* lds, int tid, int t0, int L) {
    constexpr int wdw = 2 << G, half = wdw >> 1, NX = 32 + wdw - 1;
    const int c = tid & 63, seg = tid >> 6; const LAS bf16_t* X = (const LAS bf16_t*)(lds + POOL_X) + c + (seg * 32 + 8 - half) * 64;
    const int tb = t0 + seg * 32;
    float xr[NX], xm[NX];
#pragma unroll
    for (int j = 0; j < NX; ++j) xr[j] = bf2f(X[j * 64]);
#pragma unroll
    for (int j = 0; j < NX; ++j) { const int row = tb - half + j; xm[j] = (row >= 0 && row < L) ? xr[j] : 0.f; }
    float sum = 0.f;
#pragma unroll
    for (int j = 0; j < wdw; ++j) sum += xm[j];
#pragma unroll
    for (int k = 0; k < 32; ++k) {
        const int t = tb + k; const int clo = (t - half) < 0 ? 0 : (t - half), chi = (t - half + wdw) > L ? L : (t - half + wdw);
        const float pv = sum / (float)(chi - clo) - xr[k + half];
        const int r = seg * 32 + k; *((LAS bf16_t*)(lds + POOL_P + r * 128 + (((c >> 3) ^ ((r >> 1) & 7)) << 4)) + (c & 7)) = f2bf(pv);
        if (k < 31) sum += xm[k + wdw] - xm[k];
    }
}
__device__ __forceinline__ void phase_pool(LAS unsigned char* lds, const WS& w, bf16_t* __restrict__ MIX, const bf16_t* __restrict__ WT  , const float* __restrict__ pool_scale, int nrows, int vb, int nvb) {
    int tid_ = threadIdx.x; asm volatile("" : "+v"(tid_));
    const int tid = tid_, lane = tid & 63, wid = __builtin_amdgcn_readfirstlane(tid >> 6), r32 = lane & 31, hi = lane >> 5;
    const int nunits = nrows >> 8;
    const int nmine = vb < nunits ? ((nunits - 1 - vb) / nvb + 1) * 4 : 0;
    u32x4 st[5];
#define POOL_FETCH(it_) do { const int u_ = vb + ((it_) >> 2) * nvb, g_ = (it_) & 3; const int row0_ = u_ << 8; const bool ic_ = row0_ >= NL; const int L_ = ic_ ? CTX : S; const int t0_ = ic_ ? 0 : (row0_ & (S - 1)); const int seq0_ = row0_ - t0_; \
        _Pragma("unroll") for (int k_ = 0; k_ < 5; ++k_) { int i_ = tid + 512 * k_; i_ = i_ < 272 * 8 ? i_ : 272 * 8 - 1; const int rr_ = i_ >> 3, ch_ = i_ & 7; int t_ = t0_ - 8 + rr_; t_ = t_ < 0 ? 0 : (t_ >= L_ ? L_ - 1 : t_); \
            st[k_] = *(const u32x4*)(w.Bp() + (size_t)(seq0_ + t_) * 256 + g_ * 64 + ch_ * 8); } } while (0)
    if (nmine > 0) POOL_FETCH(0);
    for (int it = 0; it < nmine; ++it) {
        const int u = vb + (it >> 2) * nvb, g = it & 3;
        const int row0 = u << 8; const bool isctx = row0 >= NL; const int L = isctx ? CTX : S; const int t0 = isctx ? 0 : (row0 & (S - 1));
        {
#pragma unroll
            for (int k = 0; k < 5; ++k) { const int i = tid + 512 * k; if (i < 272 * 8) *(LAS u32x4*)(lds + POOL_X + (i >> 3) * 128 + (i & 7) * 16) = st[k]; }
            { const int nx = it + 1 < nmine ? it + 1 : it; POOL_FETCH(nx); }
            __syncthreads();
            if (g == 0) pool_sums<0>(lds, tid, t0, L); else if (g == 1) pool_sums<1>(lds, tid, t0, L); else if (g == 2) pool_sums<2>(lds, tid, t0, L); else pool_sums<3>(lds, tid, t0, L);
            __syncthreads();
            { f32x16 o0 = {}, o1 = {};
              const bf16_t* wt = WT + (size_t)g * 4096 + (size_t)r32 * 64 + 8 * hi;
#pragma unroll
              for (int s = 0; s < 4; ++s) { const int row = wid * 32 + r32; const bf16x8 pf = *(const LAS bf16x8*)(lds + POOL_P + row * 128 + (((2 * s + hi) ^ ((row >> 1) & 7)) << 4));
                  o0 = mfma32(*(const bf16x8*)(wt + 16 * s), pf, o0); o1 = mfma32(*(const bf16x8*)(wt + 32 * 64 + 16 * s), pf, o1); }
              bf16_t* op = MIX + (size_t)(row0 + wid * 32 + r32) * 1024 + 384 + g * 64 + 4 * hi; const float* ps = pool_scale + g * 64 + 4 * hi;
#pragma unroll
              for (int q = 0; q < 4; ++q) { const f32x4 s0 = *(const f32x4*)(ps + 8 * q), s1 = *(const f32x4*)(ps + 32 + 8 * q); u32x2 a, b;
                  a.x = cvt_pk_bf16(o0[4 * q] * s0[0], o0[4 * q + 1] * s0[1]); a.y = cvt_pk_bf16(o0[4 * q + 2] * s0[2], o0[4 * q + 3] * s0[3]);
                  b.x = cvt_pk_bf16(o1[4 * q] * s1[0], o1[4 * q + 1] * s1[1]); b.y = cvt_pk_bf16(o1[4 * q + 2] * s1[2], o1[4 * q + 3] * s1[3]);
                  *(u32x2*)(op + 8 * q) = a; *(u32x2*)(op + 32 + 8 * q) = b; } }
            __syncthreads();
        }
    }
#undef POOL_FETCH
}
__device__ __forceinline__ void phase_p2(LAS unsigned char* lds, const WS& w, const Inputs& in, int l, int vb, int nvb, int parts = 7) {
    pg8::StaticOrder so;
    if (parts & 1) { EpiUq E{w}; const int M = l == 0 ? NR : NL; so.init(M, 768, nvb, vb); pg8::gemm_phase(lds, pg8::Gemm{w.CQ(), w.WuqT() + (size_t)l * 768 * 384, M, 768, 384}, so, E); }
    if (parts & 2) { EpiUkv E{w}; so.init(NR, 768, nvb, vb); pg8::gemm_phase(lds, pg8::Gemm{w.CKV(), w.WukvT() + (size_t)l * 768 * 256, NR, 768, 256}, so, E); }
    if (parts & 4) phase_pool(lds, w, w.H(), w.PoolWT() + (size_t)l * 4 * 64 * 64, in.pool_scale + l * 256, l == 0 ? NR : NL, vb, nvb);
}

struct EpiOut {
    static constexpr bool PERM = true;
    bf16_t* XB; const float* xl; const float* xc; const float* gate; bool inbf;
    __device__ __forceinline__ void operator()(const f32x4 (&acc)[2][2][4][2], const pg8::Unit& u, int wr, int wc, int fr, int fq) const {
        const int pm = u.pm; const bool isctx = pm >= 256; const int mr = isctx ? 32 : pm >> 3;
        const size_t r0 = (size_t)pm * 256 + wr * 64 + fr; const int col0 = u.pn * 256 + wc * 32 + 8 * fq;
        f32x4 gv[2][2];
#pragma unroll
        for (int bj = 0; bj < 2; ++bj)
#pragma unroll
            for (int n = 0; n < 2; ++n) gv[bj][n] = *(const f32x4*)(gate + (size_t)mr * 6144 + col0 + bj * 128 + 4 * n);
#pragma unroll
        for (int ai = 0; ai < 2; ++ai) {
            f32x4 xv[4][2][2];
#pragma unroll
            for (int m = 0; m < 4; ++m) { const size_t row = r0 + ai * 128 + m * 16;
#pragma unroll
                for (int bj = 0; bj < 2; ++bj) {
                    if (inbf) { const u32x4 r = *(const u32x4*)(XB + row * 1024 + col0 + bj * 128);
                        xv[m][bj][0] = (f32x4){__uint_as_float(r.x << 16), __uint_as_float(r.x & 0xffff0000u), __uint_as_float(r.y << 16), __uint_as_float(r.y & 0xffff0000u)};
                        xv[m][bj][1] = (f32x4){__uint_as_float(r.z << 16), __uint_as_float(r.z & 0xffff0000u), __uint_as_float(r.w << 16), __uint_as_float(r.w & 0xffff0000u)}; }
                    else { const float* xp = (isctx ? xc + (row - NL) * 1024 : xl + row * 1024) + col0 + bj * 128; xv[m][bj][0] = *(const f32x4*)xp; xv[m][bj][1] = *(const f32x4*)(xp + 4); } } }
#pragma unroll
            for (int m = 0; m < 4; ++m) { bf16_t* d = XB + (r0 + ai * 128 + m * 16) * 1024 + col0;
#pragma unroll
                for (int bj = 0; bj < 2; ++bj) { const f32x4 a0 = xv[m][bj][0] + acc[ai][bj][m][0] * gv[bj][0], a1 = xv[m][bj][1] + acc[ai][bj][m][1] * gv[bj][1];
                    u32x4 o; o.x = cvt_pk_bf16(a0[0], a0[1]); o.y = cvt_pk_bf16(a0[2], a0[3]); o.z = cvt_pk_bf16(a1[0], a1[1]); o.w = cvt_pk_bf16(a1[2], a1[3]);
                    *(u32x4*)(d + bj * 128) = o; } }
        }
    }
};
__device__ __forceinline__ void phase_p4(LAS unsigned char* lds, const WS& w, const Inputs& in, int l, int vb, int nvb) {
    const float* MODl = w.MOD() + (size_t)l * 33 * 6144;
    EpiOut E{w.XB(), in.x, in.ctx, MODl + 2 * 1024, l != 0};
    const int M = l == 0 ? NR : NL;
    pg8::StaticOrder so; so.init(M, 1024, nvb, vb);
    pg8::gemm_phase(lds, pg8::Gemm{w.H(), w.WoutT() + (size_t)l * 1024 * 1024, M, 1024, 1024}, so, E);
}

template <bool INBF>
__device__ __forceinline__ void phase_modulate(const float* __restrict__ XLp, const float* __restrict__ XCp, const bf16_t* __restrict__ XBp, bf16_t* __restrict__ Hout, const float* __restrict__ g, const float* __restrict__ MODl, int si, int nrows, int vb, int nvb,
                                               signed char* __restrict__ H8 = nullptr, float* __restrict__ HS = nullptr, const bf16_t* __restrict__ DLT = nullptr, bf16_t* __restrict__ XBo = nullptr) {
    int tid_ = threadIdx.x; asm volatile("" : "+v"(tid_));
    const int tid = tid_, lane = tid & 63, wid = tid >> 6;
    f32x4 gv[4];
#pragma unroll
    for (int i = 0; i < 4; ++i) gv[i] = *(const f32x4*)(g + 256 * i + 4 * lane);
    const int stride = nvb * 8, lastrow = nrows - 1;
    f32x4 nx[4]; u32x2 nxb[4], ndr[4];
#define PM_LOAD(r_) do { const int rr_ = (r_) < nrows ? (r_) : lastrow; const bool ic_ = rr_ >= NL; const float* xp_ = ic_ ? XCp + (size_t)(rr_ - NL) * 1024 : XLp + (size_t)rr_ * 1024; \
        _Pragma("unroll") for (int i = 0; i < 4; ++i) { if (INBF) nxb[i] = *(const u32x2*)(XBp + (size_t)rr_ * 1024 + 256 * i + 4 * lane); else nx[i] = *(const f32x4*)(xp_ + 256 * i + 4 * lane); \
            if (DLT) ndr[i] = *(const u32x2*)(DLT + (size_t)rr_ * 1024 + 256 * i + 4 * lane); } } while (0)
    PM_LOAD(vb * 8 + wid);
    for (int row = vb * 8 + wid; row < nrows; row += stride) {
        const bool isctx = row >= NL; const int mr = isctx ? 32 : row / S;
        f32x4 x[4]; u32x2 dr4[4]; float ss = 0.f;
#pragma unroll
        for (int i = 0; i < 4; ++i) { if (INBF) x[i] = (f32x4){__uint_as_float(nxb[i].x << 16), __uint_as_float(nxb[i].x & 0xffff0000u), __uint_as_float(nxb[i].y << 16), __uint_as_float(nxb[i].y & 0xffff0000u)}; else x[i] = nx[i];
            if (DLT) dr4[i] = ndr[i]; }
        PM_LOAD(row + stride);
#pragma unroll
        for (int i = 0; i < 4; ++i) {
            if (DLT) { const u32x2 dr = dr4[i];
                x[i][0] += __uint_as_float(dr.x << 16); x[i][1] += __uint_as_float(dr.x & 0xffff0000u); x[i][2] += __uint_as_float(dr.y << 16); x[i][3] += __uint_as_float(dr.y & 0xffff0000u);
                u32x2 xo; xo.x = cvt_pk_bf16(x[i][0], x[i][1]); xo.y = cvt_pk_bf16(x[i][2], x[i][3]); *(u32x2*)(XBo + (size_t)row * 1024 + 256 * i + 4 * lane) = xo; }
            ss += x[i][0] * x[i][0] + x[i][1] * x[i][1] + x[i][2] * x[i][2] + x[i][3] * x[i][3]; }
        ss = wave_sum(ss); const float rstd = rsqrtf(ss * (1.f / 1024.f) + EPS);
        const float* sh = MODl + (size_t)mr * 6144 + si * 1024;
        f32x4 y[4]; float am = 0.f;
#pragma unroll
        for (int i = 0; i < 4; ++i) { const f32x4 shv = *(const f32x4*)(sh + 256 * i + 4 * lane), scv = *(const f32x4*)(sh + 1024 + 256 * i + 4 * lane);
            y[i] = x[i] * rstd * gv[i] * (scv + 1.f) + shv;
            am = fmaxf(am, fmaxf(fmaxf(fabsf(y[i][0]), fabsf(y[i][1])), fmaxf(fabsf(y[i][2]), fabsf(y[i][3]))));
            u32x2 o; o.x = cvt_pk_bf16(y[i][0], y[i][1]); o.y = cvt_pk_bf16(y[i][2], y[i][3]);
            *(u32x2*)(Hout + (size_t)row * 1024 + 256 * i + 4 * lane) = o; }
        if (H8) {
#pragma unroll
            for (int o = 32; o > 0; o >>= 1) am = fmaxf(am, __shfl_xor(am, o));
            const float inv = am > 0.f ? 127.f / am : 0.f;
#pragma unroll
            for (int i = 0; i < 4; ++i) { const int q0 = (int)rintf(y[i][0] * inv), q1 = (int)rintf(y[i][1] * inv), q2 = (int)rintf(y[i][2] * inv), q3 = (int)rintf(y[i][3] * inv);
                *(unsigned*)(H8 + (size_t)row * 1024 + 256 * i + 4 * lane) = (unsigned)(q0 & 0xff) | ((unsigned)(q1 & 0xff) << 8) | ((unsigned)(q2 & 0xff) << 16) | ((unsigned)(q3 & 0xff) << 24); }
            if (lane == 0) HS[row] = am > 0.f ? am * (1.f / 127.f) : 1.f;
        }
    }
#undef PM_LOAD
}

struct EpiPQ {
    static constexpr bool PERM = true;
    bf16_t* PQ;
    __device__ __forceinline__ void operator()(const f32x4 (&acc)[2][2][4][2], const pg8::Unit& u, int wr, int wc, int fr, int fq) const {
        const size_t r0 = (size_t)u.pm * 256 + wr * 64 + fr; const int col0 = u.pn * 256 + wc * 32 + 8 * fq;
#pragma unroll
        for (int ai = 0; ai < 2; ++ai)
#pragma unroll
            for (int m = 0; m < 4; ++m) { bf16_t* d = PQ + (r0 + ai * 128 + m * 16) * 2048 + col0;
#pragma unroll
                for (int bj = 0; bj < 2; ++bj) { const f32x4 a0 = acc[ai][bj][m][0], a1 = acc[ai][bj][m][1];
                    u32x4 o; o.x = cvt_pk_bf16(a0[0], a0[1]); o.y = cvt_pk_bf16(a0[2], a0[3]); o.z = cvt_pk_bf16(a1[0], a1[1]); o.w = cvt_pk_bf16(a1[2], a1[3]);
                    *(u32x4*)(d + bj * 128) = o; } }
    }
};
__device__ __forceinline__ void phase_p6a(LAS unsigned char* lds, const WS& w, int l, int vb, int nvb) {
    EpiPQ E{w.PQ()}; const int M = l == 0 ? NR : NL;
    pg8::StaticOrder so; so.init(M, 2048, nvb, vb);
    pg8::gemm_phase(lds, pg8::Gemm{w.H(), w.WqT() + (size_t)l * 2048 * 1024, M, 2048, 1024}, so, E);
}


using bf16x2_t = __attribute__((ext_vector_type(2))) __bf16;
typedef float f32x2 __attribute__((ext_vector_type(2)));
__device__ __forceinline__ float gelu_fast(float x) {
    const float u2 = 1.5957691216057308f * (x + 0.044715f * x * x * x);
    return x * __builtin_amdgcn_rcpf(1.f + __builtin_amdgcn_exp2f(-1.4426950408889634f * u2));
}
#define DPPF(v, ctrl) __builtin_bit_cast(float, __builtin_amdgcn_update_dpp(0, __builtin_bit_cast(int, (v)), (ctrl), 0xf, 0xf, true))
__device__ __forceinline__ float reduce8(float p0, float p1, float p2, float p3, float p4, float p5, float p6, float p7, int lane) {
    auto s01 = __builtin_amdgcn_permlane32_swap(__float_as_uint(p0), __float_as_uint(p1), false, false);
    auto s23 = __builtin_amdgcn_permlane32_swap(__float_as_uint(p2), __float_as_uint(p3), false, false);
    auto s45 = __builtin_amdgcn_permlane32_swap(__float_as_uint(p4), __float_as_uint(p5), false, false);
    auto s67 = __builtin_amdgcn_permlane32_swap(__float_as_uint(p6), __float_as_uint(p7), false, false);
    const float q0 = __uint_as_float(s01[0]) + __uint_as_float(s01[1]), q1 = __uint_as_float(s23[0]) + __uint_as_float(s23[1]);
    const float q2 = __uint_as_float(s45[0]) + __uint_as_float(s45[1]), q3 = __uint_as_float(s67[0]) + __uint_as_float(s67[1]);
    auto t0 = __builtin_amdgcn_permlane16_swap(__float_as_uint(q0), __float_as_uint(q1), false, false);
    auto t1 = __builtin_amdgcn_permlane16_swap(__float_as_uint(q2), __float_as_uint(q3), false, false);
    float r0 = __uint_as_float(t0[0]) + __uint_as_float(t0[1]);
    float r1 = __uint_as_float(t1[0]) + __uint_as_float(t1[1]);
    r0 += DPPF(r0, 0x128); r1 += DPPF(r1, 0x128);
    float z = (lane & 8) ? r1 : r0;
    z += DPPF(z, 0x141);
    z += DPPF(z, 0xB1);
    z += DPPF(z, 0x4E);
    return z;
}
__device__ __forceinline__ void p7_axpy(const u32x4 v, float wj, f32x2 (&out)[8]) {
    const f32x2 w2 = {wj, wj};
#pragma unroll
    for (int k = 0; k < 4; ++k) { const f32x2 lo = __builtin_amdgcn_cvt_pk_f32_fp8((int)v[k], false), hi2 = __builtin_amdgcn_cvt_pk_f32_fp8((int)v[k], true);
        out[2 * k] = __builtin_elementwise_fma(w2, lo, out[2 * k]); out[2 * k + 1] = __builtin_elementwise_fma(w2, hi2, out[2 * k + 1]); }
}
__device__ __forceinline__ int p7_doti(const u32x4 u, const u32x4 h) {
    int s = __builtin_amdgcn_sdot4((int)u[0], (int)h[0], 0, false); s = __builtin_amdgcn_sdot4((int)u[1], (int)h[1], s, false); s = __builtin_amdgcn_sdot4((int)u[2], (int)h[2], s, false); return __builtin_amdgcn_sdot4((int)u[3], (int)h[3], s, false);
}
#define DPPI(v, ctrl) __builtin_amdgcn_update_dpp(0, (v), (ctrl), 0xf, 0xf, true)
__device__ __forceinline__ int reduce8i(int p0, int p1, int p2, int p3, int p4, int p5, int p6, int p7, int lane) {
    auto s01 = __builtin_amdgcn_permlane32_swap((unsigned)p0, (unsigned)p1, false, false); auto s23 = __builtin_amdgcn_permlane32_swap((unsigned)p2, (unsigned)p3, false, false);
    auto s45 = __builtin_amdgcn_permlane32_swap((unsigned)p4, (unsigned)p5, false, false); auto s67 = __builtin_amdgcn_permlane32_swap((unsigned)p6, (unsigned)p7, false, false);
    const unsigned q0 = s01[0] + s01[1], q1 = s23[0] + s23[1], q2 = s45[0] + s45[1], q3 = s67[0] + s67[1];
    auto t0 = __builtin_amdgcn_permlane16_swap(q0, q1, false, false); auto t1 = __builtin_amdgcn_permlane16_swap(q2, q3, false, false);
    int r0 = (int)(t0[0] + t0[1]), r1 = (int)(t1[0] + t1[1]);
    r0 += DPPI(r0, 0x128); r1 += DPPI(r1, 0x128);
    int z = (lane & 8) ? r1 : r0;
    z += DPPI(z, 0x141); z += DPPI(z, 0xB1); z += DPPI(z, 0x4E);
    return z;
}

struct P7CArgs { const signed char* H8; const unsigned* EG; const unsigned char* U8; int* PART; int nrows; };
__device__ __forceinline__ void phase_p7c(LAS unsigned char* lds, const P7CArgs& a, int part, int prank, int nvb) {
    int tid_ = threadIdx.x; asm volatile("" : "+v"(tid_));
    const int lane = tid_ & 63, wid = __builtin_amdgcn_readfirstlane(tid_ >> 6);
    const int nw = (nvb >> 3) * 8, wrank = prank * 8 + wid;
    LAS unsigned* tab = (LAS unsigned*)(lds + wid * 1024);
    const int grp = lane >> 3, c = lane & 7, c16 = c * 16;
    const unsigned char* ubase = a.U8 + 128 * part + c16;
    const signed char* hbase = a.H8 + 128 * part + c16;
    unsigned* pbase = (unsigned*)a.PART + (size_t)part * a.nrows * 64;
    const int c2 = (c >> 2) & 1, c1 = (c >> 1) & 1, c0 = c & 1;
    const int ent0 = 8 * (4 * c2 + 2 * c0 + c1) + grp;
    u32x4 Av[16], Bv[16]; u32x4 Ah, Bh;
    unsigned pw0 = 0u, pw1 = 0u;
#define P7C_PREF(t) do { pw0 = a.EG[(size_t)(t) * 128 + lane]; pw1 = a.EG[(size_t)(t) * 128 + 64 + lane]; } while (0)
#define P7C_ISSUE(X, Xh, t, slot, tnext) do { LAS unsigned* tb_ = tab + (slot) * 128; \
        tb_[lane] = pw0; tb_[64 + lane] = pw1; \
        asm volatile("s_waitcnt lgkmcnt(0)" ::: "memory"); \
        _Pragma("unroll") for (int i_ = 0; i_ < 16; ++i_) { const unsigned e_ = tb_[8 * i_ + grp]; X[i_] = *(const u32x4*)(ubase + (size_t)(e_ >> 16) * 1024); } \
        Xh = *(const u32x4*)(hbase + (size_t)(t) * 1024); \
        P7C_PREF(tnext); } while (0)
#define P7C_X(v, ctrl) ((v) + DPPI((v), (ctrl)))
#define P7C_COMPUTE(X, Xh, t, valid) do { int d_[16]; \
        _Pragma("unroll") for (int i_ = 0; i_ < 16; ++i_) d_[i_] = p7_doti(X[i_], Xh); \
        int e8_[8]; _Pragma("unroll") for (int k = 0; k < 8; ++k) { const int send_ = c2 ? d_[k] : d_[k + 8], keep_ = c2 ? d_[k + 8] : d_[k]; e8_[k] = keep_ + DPPI(send_, 0x141); }            \
        int e4_[4]; _Pragma("unroll") for (int k = 0; k < 4; ++k) { const int send_ = c0 ? e8_[k] : e8_[k + 4], keep_ = c0 ? e8_[k + 4] : e8_[k]; e4_[k] = keep_ + DPPI(send_, 0xB1); }          \
        int e2_[2]; _Pragma("unroll") for (int k = 0; k < 2; ++k) { const int send_ = c1 ? e4_[k] : e4_[k + 2], keep_ = c1 ? e4_[k + 2] : e4_[k]; e2_[k] = keep_ + DPPI(send_, 0x4E); }          \
        if (valid) pbase[(size_t)(t) * 64 + ent0] = __builtin_bit_cast(unsigned, __builtin_amdgcn_cvt_pk_i16((e2_[0] + 8) >> 4, (e2_[1] + 8) >> 4)); } while (0)
    const int lastrow = a.nrows - 1;
    int t = wrank;
    P7C_PREF(t);
    P7C_ISSUE(Av, Ah, t, 0, (t + nw < a.nrows ? t + nw : lastrow));
    while (t < a.nrows) {
        const int t1 = t + nw, t2 = t1 + nw, t3 = t2 + nw;
        const int k1 = t1 < a.nrows ? t1 : lastrow, k2 = t2 < a.nrows ? t2 : lastrow, k3 = t3 < a.nrows ? t3 : lastrow;
        P7C_ISSUE(Bv, Bh, k1, 1, k2);
        P7C_COMPUTE(Av, Ah, t, true);
        P7C_ISSUE(Av, Ah, k2, 0, k3);
        P7C_COMPUTE(Bv, Bh, k1, (t1 < a.nrows));
        t = t2;
    }
#undef P7C_PREF
#undef P7C_ISSUE
#undef P7C_COMPUTE
}
__device__ __forceinline__ void phase_p7d(const int* __restrict__ PART, const unsigned* __restrict__ EG, const float* __restrict__ US, const float* __restrict__ VS, const float* __restrict__ HS, unsigned* __restrict__ WE, int nrows, int vb, int nvb) {
    int tid_ = threadIdx.x; asm volatile("" : "+v"(tid_));
    typedef int i32x4 __attribute__((ext_vector_type(4)));
    const size_t n16 = (size_t)nrows * 16, pstride4 = n16;
    const u32x4* P4 = (const u32x4*)PART; const u32x4* EG4 = (const u32x4*)EG; u32x4* WE4 = (u32x4*)WE;
    for (size_t j = (size_t)vb * 512 + tid_; j < n16; j += (size_t)nvb * 512) {
        const size_t row = j >> 4; const int P = (int)(j >> 1) & 7, gq = (int)j & 1;
        i32x4 slo = {0, 0, 0, 0}, shi = {0, 0, 0, 0};
#pragma unroll
        for (int p = 0; p < 8; ++p) { const u32x4 d = P4[p * pstride4 + j];
#pragma unroll
            for (int k = 0; k < 4; ++k) { slo[k] += (int)(d[k] << 16) >> 16; shi[k] += (int)d[k] >> 16; } }
        const float hs = HS[row] * 16.f;
#pragma unroll
        for (int half = 0; half < 2; ++half) {
            const size_t ei = row * 32 + 4 * P + 2 * half + gq;
            const u32x4 eg = EG4[ei]; u32x4 o;
#pragma unroll
            for (int k = 0; k < 4; ++k) { const int eid = (int)(eg[k] >> 16);
                const float av = (float)(half ? shi[k] : slo[k]) * US[eid] * hs;
                const float wv = __uint_as_float(eg[k] << 16) * gelu_fast(av) * VS[eid];
                o[k] = (eg[k] & 0xffff0000u) | (cvt_pk_bf16(wv, 0.f) & 0xffffu); }
            WE4[ei] = o;
        }
    }
}
struct P7BArgs { const unsigned* WE; const unsigned char* V8; bf16_t* XB; const float* gate2; int nrows; };
template <int PM>
__device__ __forceinline__ void phase_p7b(LAS unsigned char* lds, const P7BArgs& a, int part, int prank, int nvb) {
    int tid_ = threadIdx.x; asm volatile("" : "+v"(tid_));
    const int lane = tid_ & 63, wid = __builtin_amdgcn_readfirstlane(tid_ >> 6);
    const int nw = (nvb >> 3) * 8, wrank = prank * 8 + wid;
    LAS unsigned* tab = (LAS unsigned*)(lds + wid * 1024);
    const int grp = lane >> 3, c16 = (lane & 7) * 16;
    const unsigned char* vbase = a.V8 + 128 * part + c16;
    const int colofs = 128 * part + c16 + 8 * (lane >> 5) + 4 * ((lane >> 4) & 1) + 2 * ((lane >> 3) & 1);
    u32x4 Av[16], Bv[16]; float Aw[16], Bw[16]; unsigned Ax, Bx; f32x2 Ag, Bg;
    unsigned pw0 = 0u, pw1 = 0u;
#define P7B_PREF(t) do { pw0 = a.WE[(size_t)(t) * 128 + lane]; pw1 = a.WE[(size_t)(t) * 128 + 64 + lane]; } while (0)
#define P7B_ISSUE(X, Xw, Xx, Xg, t, slot, tnext) do { LAS unsigned* tb_ = tab + (slot) * 128; \
        tb_[lane] = pw0; tb_[64 + lane] = pw1; \
        asm volatile("s_waitcnt lgkmcnt(0)" ::: "memory"); \
        _Pragma("unroll") for (int i_ = 0; i_ < 16; ++i_) { const unsigned we_ = tb_[8 * i_ + grp]; Xw[i_] = __uint_as_float(we_ << 16); if (PM != 2) X[i_] = *(const u32x4*)(vbase + (size_t)(we_ >> 16) * 1024); else X[i_] = (u32x4){we_, 0x38383838u, 0x38383838u, 0x38383838u}; } \
        { const int mr_ = (t) >= NL ? 32 : (t) / S; \
          Xx = *(const unsigned*)(a.XB + (size_t)(t) * 1024 + colofs); Xg = *(const f32x2*)(a.gate2 + (size_t)mr_ * 6144 + colofs); } \
        P7B_PREF(tnext); } while (0)
#define P7B_COMPUTE(X, Xw, Xx, Xg, t, valid) do { f32x2 acc2[8]; \
        _Pragma("unroll") for (int k = 0; k < 8; ++k) acc2[k] = (f32x2){0.f, 0.f}; \
        if (PM != 1) { _Pragma("unroll") for (int i_ = 0; i_ < 16; ++i_) p7_axpy(X[i_], Xw[i_], acc2); } else { _Pragma("unroll") for (int i_ = 0; i_ < 16; ++i_) acc2[i_ >> 1][i_ & 1] = __uint_as_float((X[i_][0] ^ X[i_][1] ^ X[i_][2] ^ X[i_][3]) & 0x3fffffffu) + Xw[i_]; } \
        float b_[8]; _Pragma("unroll") for (int k = 0; k < 8; ++k) { auto s_ = __builtin_amdgcn_permlane32_swap(__float_as_uint(acc2[k >> 1][k & 1]), __float_as_uint(acc2[(k + 8) >> 1][k & 1]), false, false); b_[k] = __uint_as_float(s_[0]) + __uint_as_float(s_[1]); } \
        float c_[4]; _Pragma("unroll") for (int k = 0; k < 4; ++k) { auto s_ = __builtin_amdgcn_permlane16_swap(__float_as_uint(b_[k]), __float_as_uint(b_[k + 4]), false, false); c_[k] = __uint_as_float(s_[0]) + __uint_as_float(s_[1]); } \
        float d_[2]; _Pragma("unroll") for (int k = 0; k < 2; ++k) { const float send_ = (lane & 8) ? c_[k] : c_[k + 2]; const float keep_ = (lane & 8) ? c_[k + 2] : c_[k]; d_[k] = keep_ + DPPF(send_, 0x128); } \
        unsigned* xp_ = (unsigned*)(a.XB + (size_t)(t) * 1024 + colofs); \
        f32x2 x_ = {__uint_as_float(Xx << 16), __uint_as_float(Xx & 0xffff0000u)}; x_.x += Xg.x * d_[0]; x_.y += Xg.y * d_[1]; if ((valid) && PM == 0) *xp_ = cvt_pk_bf16(x_.x, x_.y); else if (PM != 0 && x_.x == 1.2345e30f) *xp_ = cvt_pk_bf16(x_.x, x_.y); } while (0)
    const int lastrow = a.nrows - 1;
    int t = wrank;
    P7B_PREF(t);
    P7B_ISSUE(Av, Aw, Ax, Ag, t, 0, (t + nw < a.nrows ? t + nw : lastrow));
    while (t < a.nrows) {
        const int t1 = t + nw, t2 = t1 + nw, t3 = t2 + nw;
        const int c1 = t1 < a.nrows ? t1 : lastrow, c2 = t2 < a.nrows ? t2 : lastrow, c3 = t3 < a.nrows ? t3 : lastrow;
        P7B_ISSUE(Bv, Bw, Bx, Bg, c1, 1, c2);
        P7B_COMPUTE(Av, Aw, Ax, Ag, t, true);
        P7B_ISSUE(Av, Aw, Ax, Ag, c2, 0, c3);
        P7B_COMPUTE(Bv, Bw, Bx, Bg, c1, (t1 < a.nrows));
        t = t2;
    }
#undef P7B_PREF
#undef P7B_ISSUE
#undef P7B_COMPUTE
}
__device__ __forceinline__ void phase_final_norm(const bf16_t* __restrict__ XBp, float* __restrict__ OUT, const float* __restrict__ g, int vb, int nvb) {
    int tid_ = threadIdx.x; asm volatile("" : "+v"(tid_));
    const int lane = tid_ & 63, wid = tid_ >> 6;
    for (int row = vb * 8 + wid; row < NL; row += nvb * 8) {
        const bf16_t* xp = XBp + (size_t)row * 1024; f32x4 x[4]; float ss = 0.f;
#pragma unroll
        for (int i = 0; i < 4; ++i) { const u32x2 r = *(const u32x2*)(xp + 256 * i + 4 * lane); x[i] = (f32x4){__uint_as_float(r.x << 16), __uint_as_float(r.x & 0xffff0000u), __uint_as_float(r.y << 16), __uint_as_float(r.y & 0xffff0000u)};
            ss += x[i][0] * x[i][0] + x[i][1] * x[i][1] + x[i][2] * x[i][2] + x[i][3] * x[i][3]; }
        ss = wave_sum(ss); const float rstd = rsqrtf(ss * (1.f / 1024.f) + EPS);
#pragma unroll
        for (int i = 0; i < 4; ++i) *(f32x4*)(OUT + (size_t)row * 1024 + 256 * i + 4 * lane) = x[i] * rstd * *(const f32x4*)(g + 256 * i + 4 * lane);
    }
}

template <int V_> struct IC { static constexpr int value = V_; };
typedef short s16x4 __attribute__((ext_vector_type(4)));
__device__ __forceinline__ s16x4 lds_tr16(const LAS unsigned char* p) { return __builtin_bit_cast(s16x4, __builtin_amdgcn_ds_read_tr16_b64_v4i16((LAS s16x4*)p)); }
constexpr int ATT_BUF = 20480;
__device__ __forceinline__ void glds16(const void* g, unsigned lds_base) {
    unsigned sv; asm volatile("s_mov_b32 %0, m0\n\ts_mov_b32 m0, %2\n\ts_nop 0\n\tglobal_load_lds_dwordx4 %1, off\n\ts_mov_b32 m0, %0" : "=&s"(sv) : "v"(g), "s"(lds_base) : "memory"); }
template <int DK>
__device__ __forceinline__ void attn_unit(LAS unsigned char* lds, const bf16_t* __restrict__ Q, const bf16_t* __restrict__ K1, const bf16_t* __restrict__ K2, const bf16_t* __restrict__ V,
                                          int nkeys, float c2, bf16_t* __restrict__ out) {
    int tid_ = threadIdx.x; asm volatile("" : "+v"(tid_));
    const int tid = tid_, lane = tid & 63, wid = __builtin_amdgcn_readfirstlane(tid >> 6), r32 = lane & 31, hi = lane >> 5;
    constexpr int NS = DK / 16, NM = 2 * NS;
    bf16x8 qf[NS];
    { const bf16_t* qp = Q + (size_t)(wid * 32 + r32) * DK + 8 * hi;
#pragma unroll
      for (int s = 0; s < NS; ++s) qf[s] = *(const bf16x8*)(qp + 16 * s); }
    const int dkey = 8 * wid + (lane >> 3), dkey2 = 16 * (wid & 3) + (lane >> 2);
    const bf16_t* gk1 = K1 + (size_t)dkey * 64 + (((lane & 7) ^ ((dkey >> 1) & 7)) << 3);
    const bf16_t* gv = V + (size_t)dkey * 64 + (((lane & 7) ^ (((dkey >> 1) & 1) << 2)) << 3);
    const bf16_t* gk2 = (DK == 96) ? K2 + (size_t)dkey2 * 32 + (((lane & 3) ^ ((dkey2 >> 2) & 3)) << 3) : nullptr;
    const unsigned lds0 = (unsigned)(size_t)lds;
    const unsigned d_k1 = lds0 + wid * 1024, d_v = lds0 + 8192 + wid * 1024, d_k2 = lds0 + 16384 + (wid & 3) * 1024;
#define ATT_DMA(tile_, slot_) do { const int tt_ = (tile_); glds16(gk1 + (size_t)tt_ * 4096, (unsigned)__builtin_amdgcn_readfirstlane(d_k1 + (slot_) * ATT_BUF)); \
        glds16(gv + (size_t)tt_ * 4096, (unsigned)__builtin_amdgcn_readfirstlane(d_v + (slot_) * ATT_BUF)); \
        if (DK == 96) glds16(gk2 + (size_t)tt_ * 2048, (unsigned)__builtin_amdgcn_readfirstlane(d_k2 + (slot_) * ATT_BUF)); } while (0)
#define ATT_WAIT_BAR() do { if (DK == 96) asm volatile("s_waitcnt vmcnt(3) lgkmcnt(0)\n\ts_barrier" ::: "memory"); else asm volatile("s_waitcnt vmcnt(2) lgkmcnt(0)\n\ts_barrier" ::: "memory"); } while (0)
    unsigned ka[2][4];
#pragma unroll
    for (int kt = 0; kt < 2; ++kt)
#pragma unroll
        for (int s = 0; s < 4; ++s) { const int key = 32 * kt + r32; ka[kt][s] = key * 128 + (((2 * s + hi) ^ ((key >> 1) & 7)) << 4); }
    unsigned kb[2][2];
#pragma unroll
    for (int kt = 0; kt < 2; ++kt)
#pragma unroll
        for (int s = 0; s < 2; ++s) { const int key = 32 * kt + r32; kb[kt][s] = 16384 + key * 64 + (((2 * s + hi) ^ ((key >> 2) & 3)) << 4); }
    const int vq = (lane & 15) >> 2, vp = lane & 3, vg = (lane >> 4) & 1;
    unsigned va[2];
#pragma unroll
    for (int dvb = 0; dvb < 2; ++dvb) { const int key = 4 * hi + vq; va[dvb] = 8192 + key * 128 + ((((32 * dvb + 16 * vg + 4 * vp) * 2)) ^ (((key >> 1) & 1) << 6)); }
    float m = -1e30f, l = 0.f, mx;
    f32x16 o0 = {}, o1 = {};
    const int NT = nkeys >> 6;
    ATT_DMA(0, 0); ATT_DMA(NT > 1 ? 1 : 0, 1); ATT_DMA(NT > 2 ? 2 : NT - 1, 2);
    asm volatile("s_waitcnt vmcnt(0) lgkmcnt(0)\n\ts_barrier" ::: "memory");
    f32x16 pa0 = {}, pa1 = {}, pb0 = {}, pb1 = {};
    {
        bf16x8 kf0[NS], kf1[NS];
#pragma unroll
        for (int s = 0; s < 4; ++s) { kf0[s] = *(const LAS bf16x8*)(lds + ka[0][s]); kf1[s] = *(const LAS bf16x8*)(lds + ka[1][s]); }
        if (DK == 96) {
#pragma unroll
            for (int s = 0; s < 2; ++s) { kf0[4 + s] = *(const LAS bf16x8*)(lds + kb[0][s]); kf1[4 + s] = *(const LAS bf16x8*)(lds + kb[1][s]); }
        }
#pragma unroll
        for (int s = 0; s < NS; ++s) { pa0 = mfma32(kf0[s], qf[s], pa0); pa1 = mfma32(kf1[s], qf[s], pa1); }
        mx = pa0[0];
#pragma unroll
        for (int r = 1; r < 16; ++r) mx = fmaxf(mx, pa0[r]);
#pragma unroll
        for (int r = 0; r < 16; ++r) mx = fmaxf(mx, pa1[r]);
    }
    auto step = [&](auto bc_, auto bn_, auto bw_, f32x16& pc0, f32x16& pc1, f32x16& pn0, f32x16& pn1, int t) __attribute__((always_inline)) {
        constexpr int BC = decltype(bc_)::value * ATT_BUF, BN = decltype(bn_)::value * ATT_BUF;
        ATT_DMA((t + 3 < NT) ? t + 3 : NT - 1, decltype(bw_)::value);
        bf16x8 kf0[NS], kf1[NS];
#pragma unroll
        for (int s = 0; s < 4; ++s) { kf0[s] = *(const LAS bf16x8*)(lds + BN + ka[0][s]); kf1[s] = *(const LAS bf16x8*)(lds + BN + ka[1][s]); }
        if (DK == 96) {
#pragma unroll
            for (int s = 0; s < 2; ++s) { kf0[4 + s] = *(const LAS bf16x8*)(lds + BN + kb[0][s]); kf1[4 + s] = *(const LAS bf16x8*)(lds + BN + kb[1][s]); }
        }
        __builtin_amdgcn_sched_barrier(0);
        { auto rr = __builtin_amdgcn_permlane32_swap(__float_as_uint(mx), __float_as_uint(mx), false, false); mx = fmaxf(__uint_as_float(rr[0]), __uint_as_float(rr[1])); }
        const float tm = mx;
        if (__any(tm > m + 8.f)) {
            const float mn = fmaxf(m, tm), al = __builtin_amdgcn_exp2f(m - mn); m = mn; l *= al;
#pragma unroll
            for (int r = 0; r < 16; ++r) { o0[r] *= al; o1[r] *= al; }
        }
        const float nm = -m; float ls = 0.f;
        pn0 = f32x16{}; pn1 = f32x16{};
        unsigned pw[16];
        s16x4 vlo[2][2][2], vhi[2][2][2];
#pragma unroll
        for (int c = 0; c < 8; ++c) {
            __builtin_amdgcn_sched_barrier(0);
#pragma unroll
            for (int j = 0; j < NM; ++j) if (j >= c * NM / 8 && j < (c + 1) * NM / 8) { if (j & 1) pn1 = mfma32(kf1[j >> 1], qf[j >> 1], pn1); else pn0 = mfma32(kf0[j >> 1], qf[j >> 1], pn0); }
            if (c == 4) {
#pragma unroll
                for (int kt = 0; kt < 2; ++kt)
#pragma unroll
                    for (int sp = 0; sp < 2; ++sp) { const int kofs = (32 * kt + 16 * sp) * 128;
#pragma unroll
                        for (int dvb = 0; dvb < 2; ++dvb) { vlo[dvb][kt][sp] = lds_tr16(lds + BC + va[dvb] + kofs); vhi[dvb][kt][sp] = lds_tr16(lds + BC + va[dvb] + kofs + 8 * 128); } }
            }
            __builtin_amdgcn_sched_barrier(0);
            if (c < 4) {
#pragma unroll
                for (int i = 0; i < 4; ++i) { const int r = 4 * c + i; pc0[r] = __builtin_amdgcn_exp2f(pc0[r] + nm); ls += pc0[r]; }
                pw[2 * c] = cvt_pk_bf16(pc0[4 * c], pc0[4 * c + 1]); pw[2 * c + 1] = cvt_pk_bf16(pc0[4 * c + 2], pc0[4 * c + 3]);
            } else {
#pragma unroll
                for (int i = 0; i < 4; ++i) { const int r = 4 * (c - 4) + i; pc1[r] = __builtin_amdgcn_exp2f(pc1[r] + nm); ls += pc1[r]; }
                pw[8 + 2 * (c - 4)] = cvt_pk_bf16(pc1[4 * (c - 4)], pc1[4 * (c - 4) + 1]); pw[8 + 2 * (c - 4) + 1] = cvt_pk_bf16(pc1[4 * (c - 4) + 2], pc1[4 * (c - 4) + 3]);
            }
        }
        __builtin_amdgcn_sched_barrier(0);
        l += ls;
        float mxn = -3.0e38f;
#pragma unroll
        for (int k = 0; k < 8; ++k) { const int kt = k >> 2, sp = (k >> 1) & 1, dvb = k & 1;
            const u32x4 pq = (u32x4){pw[8 * kt + 4 * sp], pw[8 * kt + 4 * sp + 1], pw[8 * kt + 4 * sp + 2], pw[8 * kt + 4 * sp + 3]};
            const s16x4 lo = vlo[dvb][kt][sp], hi4 = vhi[dvb][kt][sp]; const bf16x8 vf = (bf16x8){lo[0], lo[1], lo[2], lo[3], hi4[0], hi4[1], hi4[2], hi4[3]};
            if (dvb == 0) o0 = mfma32(vf, __builtin_bit_cast(bf16x8, pq), o0); else o1 = mfma32(vf, __builtin_bit_cast(bf16x8, pq), o1);
            __builtin_amdgcn_sched_barrier(0);
            if (k < 4) { mxn = fmaxf(fmaxf(mxn, pn0[4 * k]), fmaxf(pn0[4 * k + 1], fmaxf(pn0[4 * k + 2], pn0[4 * k + 3]))); }
            else { mxn = fmaxf(fmaxf(mxn, pn1[4 * (k - 4)]), fmaxf(pn1[4 * (k - 4) + 1], fmaxf(pn1[4 * (k - 4) + 2], pn1[4 * (k - 4) + 3]))); }
            __builtin_amdgcn_sched_barrier(0);
        }
        mx = mxn;
        ATT_WAIT_BAR();
    };
    for (int t = 0; t < NT; t += 4) {
        step(IC<0>{}, IC<1>{}, IC<3>{}, pa0, pa1, pb0, pb1, t);
        step(IC<1>{}, IC<2>{}, IC<0>{}, pb0, pb1, pa0, pa1, t + 1);
        step(IC<2>{}, IC<3>{}, IC<1>{}, pa0, pa1, pb0, pb1, t + 2);
        step(IC<3>{}, IC<0>{}, IC<2>{}, pb0, pb1, pa0, pa1, t + 3);
    }
    { auto rr = __builtin_amdgcn_permlane32_swap(__float_as_uint(l), __float_as_uint(l), false, false); l = __uint_as_float(rr[0]) + __uint_as_float(rr[1]); }
    const float il = 1.f / l;
    bf16_t* op = out + (size_t)(wid * 32 + r32) * 1024 + 4 * hi;
#pragma unroll
    for (int g = 0; g < 4; ++g) { u32x2 a, b;
        a.x = cvt_pk_bf16(o0[4 * g] * il, o0[4 * g + 1] * il); a.y = cvt_pk_bf16(o0[4 * g + 2] * il, o0[4 * g + 3] * il);
        b.x = cvt_pk_bf16(o1[4 * g] * il, o1[4 * g + 1] * il); b.y = cvt_pk_bf16(o1[4 * g + 2] * il, o1[4 * g + 3] * il);
        *(u32x2*)(op + 8 * g) = a; *(u32x2*)(op + 32 + 8 * g) = b; }
}
#undef ATT_DMA
#undef ATT_WAIT_BAR
__device__ __forceinline__ void phase_p3(LAS unsigned char* lds, const WS& w, int l, int vb, int nvb, int xpart, int xrank) {
    const float c2g = 0.125f * 1.4426950408889634f, c2m = 0.10206207261596577f * 1.4426950408889634f;
    bf16_t* MIX = w.H();
    const int nlat = NB * 12 * 8, nctx = (l == 0) ? NB * 12 : 0;
    const bool xl = (nvb == 256);
    for (int u = vb; u < nlat + nctx; u += nvb) {
        if (u < nlat) {
            int qb, slot, b;
            if (xl) { const int grp = (u >> 8) * 32 + 4 * xpart + (xrank >> 3); qb = xrank & 7; slot = grp % 12; b = grp / 12; }
            else { qb = u & 7; slot = (u >> 3) % 12; b = u / 96; }
            bf16_t* out = MIX + ((size_t)b * S + qb * 256) * 1024;
            if (slot < 6) attn_unit<64>(lds, w.Qg() + (((size_t)b * 6 + slot) * S + qb * 256) * 64, w.Kg() + ((size_t)b * 2 + slot / 3) * KEYS * 64, nullptr, w.Vg() + ((size_t)b * 2 + slot / 3) * KEYS * 64, KEYS, c2g, out + slot * 64);
            else { const int h = slot - 6; attn_unit<96>(lds, w.Qm() + (((size_t)b * 6 + h) * S + qb * 256) * 96, w.Kmn() + ((size_t)b * 6 + h) * KEYS * 64, w.KR() + (size_t)b * KEYS * 32, w.Vm() + ((size_t)b * 6 + h) * KEYS * 64, KEYS, c2m, out + 640 + h * 64); }
        } else {
            const int v = u - nlat, slot = v % 12, b = v / 12;
            bf16_t* out = MIX + ((size_t)NL + (size_t)b * CTX) * 1024;
            if (slot < 6) attn_unit<64>(lds, w.Qgc() + ((size_t)b * 6 + slot) * CTX * 64, w.Kg() + ((size_t)b * 2 + slot / 3) * KEYS * 64, nullptr, w.Vg() + ((size_t)b * 2 + slot / 3) * KEYS * 64, CTX, c2g, out + slot * 64);
            else { const int h = slot - 6; attn_unit<96>(lds, w.Qmc() + ((size_t)b * 6 + h) * CTX * 96, w.Kmn() + ((size_t)b * 6 + h) * KEYS * 64, w.KR() + (size_t)b * KEYS * 32, w.Vm() + ((size_t)b * 6 + h) * KEYS * 64, CTX, c2m, out + 640 + h * 64); }
        }
    }
}

__device__ __forceinline__ unsigned fkey(float f, unsigned tag, unsigned mask) { return (__float_as_uint(f) & ~mask) | tag; }
__device__ __forceinline__ float keyf(unsigned k, unsigned mask) { return __uint_as_float(k & ~mask); }
__device__ __forceinline__ unsigned fmax_u(unsigned a, unsigned b) { unsigned r; asm("v_max_f32 %0, %1, %2" : "=v"(r) : "v"(a), "v"(b)); return r; }
__device__ __forceinline__ unsigned fmin_u(unsigned a, unsigned b) { unsigned r; asm("v_min_f32 %0, %1, %2" : "=v"(r) : "v"(a), "v"(b)); return r; }
__device__ __forceinline__ void ce_desc(unsigned& a, unsigned& b) { const unsigned hi_ = fmax_u(a, b), lo_ = fmin_u(a, b); a = hi_; b = lo_; }
template <int J> __device__ __forceinline__ void bstage16(unsigned* a) {
#pragma unroll
    for (int i = 0; i < 16; ++i) { const int l = i ^ J; if (l > i) ce_desc(a[i], a[l]); }
}
__device__ __forceinline__ void sort16_desc(unsigned* a) {
#define CE_(i, j) ce_desc(a[i], a[j]);
    CE_(0, 13) CE_(1, 12) CE_(2, 15) CE_(3, 14) CE_(4, 8) CE_(5, 6) CE_(7, 11) CE_(9, 10)
    CE_(0, 5) CE_(1, 7) CE_(2, 9) CE_(3, 4) CE_(6, 13) CE_(8, 14) CE_(10, 15) CE_(11, 12)
    CE_(0, 1) CE_(2, 3) CE_(4, 5) CE_(6, 8) CE_(7, 9) CE_(10, 11) CE_(12, 13) CE_(14, 15)
    CE_(0, 2) CE_(1, 3) CE_(4, 10) CE_(5, 11) CE_(6, 7) CE_(8, 9) CE_(12, 14) CE_(13, 15)
    CE_(1, 2) CE_(3, 12) CE_(4, 6) CE_(5, 7) CE_(8, 10) CE_(9, 11) CE_(13, 14)
    CE_(1, 4) CE_(2, 6) CE_(5, 8) CE_(7, 10) CE_(9, 13) CE_(11, 14)
    CE_(2, 4) CE_(3, 6) CE_(9, 12) CE_(11, 13)
    CE_(3, 5) CE_(6, 8) CE_(7, 9) CE_(10, 12)
    CE_(3, 4) CE_(5, 6) CE_(7, 8) CE_(9, 10) CE_(11, 12)
    CE_(6, 7) CE_(8, 9)
#undef CE_
}
__device__ __forceinline__ void bmerge16_desc(unsigned* c) { bstage16<8>(c); bstage16<4>(c); bstage16<2>(c); bstage16<1>(c); }
__device__ __forceinline__ void merge_top16(unsigned* a, const unsigned* b) {
#pragma unroll
    for (int i = 0; i < 16; ++i) a[i] = fmax_u(a[i], b[15 - i]);
    bmerge16_desc(a);
}
__device__ __forceinline__ void xlane_top16(unsigned* t, int hi) {
    unsigned r[16]; const unsigned msk = 0u - (unsigned)hi;
#pragma unroll
    for (int i = 0; i < 16; ++i) r[i] = t[i] ^ ((t[i] ^ t[15 - i]) & msk);
#pragma unroll
    for (int i = 0; i < 16; ++i) { auto s = __builtin_amdgcn_permlane32_swap(r[i], r[i], false, false); t[i] = fmax_u(s[0], s[1]); }
    bmerge16_desc(t);
}
__device__ __forceinline__ constexpr int cand_a(int c) { return c < 16 ? 0 : c < 24 ? 1 : c < 32 ? 39 - c : c < 37 ? 2 : c < 41 ? 3 : c < 44 ? 4 : c < 46 ? 5 : c < 48 ? 6 : 7; }
__device__ __forceinline__ constexpr int cand_b(int c) { return c < 16 ? c : c < 24 ? c - 16 : c < 32 ? 0 : c < 37 ? c - 32 : c < 41 ? c - 37 : c < 44 ? c - 41 : c < 46 ? c - 44 : c < 48 ? c - 46 : c - 48; }

__device__ __forceinline__ void phase_p6b(LAS unsigned char* lds, const bf16_t* __restrict__ PQ, const bf16_t* __restrict__ SubKl, unsigned* __restrict__ EG, int nrows, int vb, int nvb) {
    int tid_ = threadIdx.x; asm volatile("" : "+v"(tid_));
    const int tid = tid_, lane = tid & 63, wid = __builtin_amdgcn_readfirstlane(tid >> 6), r32 = lane & 31, hi = lane >> 5;
    const int h = vb & 7, wrank = (vb >> 3) * 8 + wid, nwr = (nvb >> 3) * 8;
    LAS unsigned short* tab = (LAS unsigned short*)(lds + 65536 + wid * 4096) + r32 * 64;
#pragma unroll
    for (int i = 0; i < 8; ++i) { const int idx = i * 512 + tid, p = idx >> 11, key = (idx >> 4) & 127, ch = idx & 15;
        *(LAS u32x4*)(lds + p * 32768 + key * 256 + ((ch ^ (key & 15)) << 4)) = *(const u32x4*)(SubKl + ((size_t)(h * 2 + p) * 128 + key) * 128 + ch * 8); }
    __syncthreads();
    const int ngroups = nrows >> 5;
    for (int tg = wrank; tg < ngroups; tg += nwr) {
        const int row0 = tg << 5;
        bf16x8 qf[2][8];
        { const bf16_t* qp = PQ + (size_t)(row0 + r32) * 2048 + h * 256 + 8 * hi; asm volatile("" : "+v"(qp));
#pragma unroll
          for (int p = 0; p < 2; ++p)
#pragma unroll
              for (int s = 0; s < 8; ++s) qf[p][s] = *(const bf16x8*)(qp + p * 128 + 16 * s); }
        unsigned top[2][16];
#pragma unroll
        for (int p = 0; p < 2; ++p) {
            f32x16 acc[4];
#pragma unroll
            for (int kt = 0; kt < 4; ++kt) { acc[kt] = f32x16{}; const int key = 32 * kt + r32;
#pragma unroll
                for (int s = 0; s < 8; ++s) acc[kt] = mfma32(*(const LAS bf16x8*)(lds + p * 32768 + key * 256 + (((2 * s + hi) ^ (key & 15)) << 4)), qf[p][s], acc[kt]); }
            unsigned key[64];
#pragma unroll
            for (int kt = 0; kt < 4; ++kt)
#pragma unroll
                for (int r = 0; r < 16; ++r) { const int n = 32 * kt + (r & 3) + 8 * (r >> 2) + 4 * hi; key[16 * kt + r] = fkey(acc[kt][r], 127u - (unsigned)n, 127u); }
            sort16_desc(key); sort16_desc(key + 16); sort16_desc(key + 32); sort16_desc(key + 48);
            merge_top16(key, key + 16); merge_top16(key + 32, key + 48); merge_top16(key, key + 32);
            xlane_top16(key, hi);
#pragma unroll
            for (int i = 0; i < 16; ++i) top[p][i] = key[i];
        }
        float t0f[16], t1f[16];
#pragma unroll
        for (int i = 0; i < 16; ++i) { t0f[i] = keyf(top[0][i], 127u); t1f[i] = keyf(top[1][i], 127u); }
        unsigned ck[50];
#pragma unroll
        for (int c = 0; c < 50; ++c) ck[c] = fkey(t0f[cand_a(c)] + t1f[cand_b(c)], (unsigned)c, 63u);
        if (hi == 0) {
#pragma unroll
            for (int c = 0; c < 50; c += 2) {
                const unsigned ea = (127u - (top[0][cand_a(c)] & 127u)) * 128u + (127u - (top[1][cand_b(c)] & 127u));
                const unsigned eb = (127u - (top[0][cand_a(c + 1)] & 127u)) * 128u + (127u - (top[1][cand_b(c + 1)] & 127u));
                *(LAS unsigned*)(tab + c) = ea | (eb << 16);
            }
        }
        bmerge16_desc(ck + 16); sort16_desc(ck + 32);
        merge_top16(ck, ck + 16); merge_top16(ck, ck + 32);
        ck[15] = fmax_u(ck[15], ck[48]); ck[14] = fmax_u(ck[14], ck[49]); bmerge16_desc(ck);
        asm volatile("s_waitcnt lgkmcnt(0)" ::: "memory");
        const float mx = keyf(ck[0], 63u); float e[16], den = 0.f;
#pragma unroll
        for (int j = 0; j < 16; ++j) { e[j] = __builtin_amdgcn_exp2f((keyf(ck[j], 63u) - mx) * 1.4426950408889634f); den += e[j]; }
        const float iden = 1.f / den;
        if (hi == 0) {
            unsigned o[16];
#pragma unroll
            for (int j = 0; j < 16; ++j) { const unsigned eid = tab[ck[j] & 63u]; o[j] = (eid << 16) | (cvt_pk_bf16(e[j] * iden, 0.f) & 0xffffu); }
            unsigned* dst = EG + (size_t)(row0 + r32) * 128 + h * 16;
#pragma unroll
            for (int j = 0; j < 16; j += 4) *(u32x4*)(dst + j) = (u32x4){o[j], o[j + 1], o[j + 2], o[j + 3]};
        }
        asm volatile("s_waitcnt lgkmcnt(0)" ::: "memory");
    }
}


#define XB_TMO      128
#define XB_XCNT(j)  (256  + 64 * (j))
#define XB_XSUB(j)  (1280 + 64 * (j))
#define XB_XGEN(j)  (2304 + 64 * (j))
#define XB_TOP      3328
#define XB_TOPGEN   3392
#define XCD_BAR_WORDS 3456
#define XB_SPIN_CAP (1u << 18)

__device__ __forceinline__ unsigned xb_ld(unsigned* p)              { return __hip_atomic_load(p, __ATOMIC_RELAXED, __HIP_MEMORY_SCOPE_AGENT); }
__device__ __forceinline__ unsigned xb_add(unsigned* p, unsigned v) { return __hip_atomic_fetch_add(p, v, __ATOMIC_RELAXED, __HIP_MEMORY_SCOPE_AGENT); }
__device__ __forceinline__ unsigned xb_xcc_id() { return (unsigned)__builtin_amdgcn_s_getreg((3 << 11) | 20) & 0xFu; }
#define XB_SPIN(cond, bar) do { unsigned _sp = 0; while (cond) { __builtin_amdgcn_s_sleep(1); \
    if ((++_sp & 255u) == 0u) { if (xb_ld(&(bar)[XB_TMO])) break; if (_sp > XB_SPIN_CAP) { atomicAdd(&(bar)[XB_TMO], 1u); break; } } } } while (0)

struct XcdBarrier {
    unsigned* bar; unsigned x;
    volatile LAS unsigned* st;
};

__device__ __forceinline__ XcdBarrier xcd_barrier_post(unsigned* bar, volatile LAS unsigned* st) {
    XcdBarrier b; b.bar = bar; b.x = xb_xcc_id(); b.st = st;
    if (threadIdx.x == 0) (void)xb_add(&bar[XB_XCNT(b.x)], 1u);
    return b;
}
__device__ __forceinline__ void xcd_barrier_complete(unsigned* bar, unsigned x, unsigned& nloc, unsigned& nx) {
    const unsigned G = gridDim.x * gridDim.y * gridDim.z;
    unsigned sum, cnt, mine, sp = 0u;
    for (;;) {
        sum = 0u; cnt = 0u; mine = 0u;
#pragma unroll
        for (unsigned j = 0; j < 16; ++j) { const unsigned c = xb_ld(&bar[XB_XCNT(j)]); sum += c; cnt += (c > 0u) ? 1u : 0u; mine = (j == x) ? c : mine; }
        if (sum == G) break;
        __builtin_amdgcn_s_sleep(1);
        if ((++sp & 255u) == 0u) { if (xb_ld(&bar[XB_TMO])) break; if (sp > XB_SPIN_CAP) { atomicAdd(&bar[XB_TMO], 1u); break; } }
    }
    nloc = mine > 0u ? mine : 1u; nx = cnt > 0u ? cnt : 1u;
}

__device__ __forceinline__ void xcd_barrier(const XcdBarrier& b) {
    asm volatile("s_waitcnt vmcnt(0)" ::: "memory");
    __syncthreads();
    if (threadIdx.x == 0) {
        unsigned* bar = b.bar;
        __builtin_amdgcn_s_waitcnt(0);
        unsigned nloc = b.st[0], nx = b.st[1];
        if (nloc == 0u) { xcd_barrier_complete(bar, b.x, nloc, nx); b.st[0] = nloc; b.st[1] = nx; }
        const unsigned old = xb_add(&bar[XB_XSUB(b.x)], 1u);
        const unsigned gen = old / nloc;
        if (old + 1u == (gen + 1u) * nloc) {
            __builtin_amdgcn_fence(__ATOMIC_RELEASE, "agent");
            asm volatile("s_waitcnt vmcnt(0)" ::: "memory");
            const unsigned og = xb_add(&bar[XB_TOP], 1u);
            const unsigned tg = og / nx;
            if (og + 1u == (tg + 1u) * nx) xb_add(&bar[XB_TOPGEN], 1u);
            else XB_SPIN(xb_ld(&bar[XB_TOPGEN]) == tg, bar);
            __builtin_amdgcn_fence(__ATOMIC_ACQUIRE, "agent");
            xb_add(&bar[XB_XGEN(b.x)], 1u);
            asm volatile("s_waitcnt vmcnt(0)" ::: "memory");
        } else {
            XB_SPIN(xb_ld(&bar[XB_XGEN(b.x)]) == gen, bar);
            __builtin_amdgcn_fence(__ATOMIC_ACQUIRE, "agent");
            asm volatile("s_waitcnt vmcnt(0)" ::: "memory");
        }
    }
    __syncthreads();
}

__device__ __forceinline__ void phase_mod(LAS unsigned char* lds, const Inputs& in, const WS& w, int vb) {
    if (vb >= 72) return;
    LAS float* sc = (LAS float*)lds;
    int tid_ = threadIdx.x; asm volatile("" : "+v"(tid_));
    const int tid = tid_, idx = vb * 512 + tid, rg = idx / 12288, ln = idx % 12288, l = ln / 6144, n = ln % 6144;
    float acc[11];
#pragma unroll
    for (int i = 0; i < 11; ++i) acc[i] = 0.f;
    const float* wp = in.ada_w + (size_t)l * 1024 * 6144 + n;
    for (int kc = 0; kc < 4; ++kc) {
        for (int i = tid; i < 33 * 256; i += 512) { const int r = i >> 8, k = kc * 256 + (i & 255); const float v = r < 32 ? in.c[(size_t)r * 1024 + k] : in.c_ctx[k]; sc[i] = v / (1.f + __expf(-v)); }
        __syncthreads();
        for (int k = 0; k < 256; ++k) { const float wv = wp[(size_t)(kc * 256 + k) * 6144];
#pragma unroll
            for (int i = 0; i < 11; ++i) acc[i] += sc[(rg * 11 + i) * 256 + k] * wv; }
        __syncthreads();
    }
    const float bias = in.ada_b[(size_t)l * 6144 + n];
#pragma unroll
    for (int i = 0; i < 11; ++i) w.MOD()[((size_t)l * 33 + rg * 11 + i) * 6144 + n] = acc[i] + bias;
}
__device__ __forceinline__ void phase_rope(const WS& w, int vb, int nvb) {
    int tid_ = threadIdx.x; asm volatile("" : "+v"(tid_));
    for (int i = vb * 512 + tid_; i < 2048 * 32; i += nvb * 512) {
        { const int t = i / 32, j = i % 32; const double inv = pow(10000.0, -(double)(j % 16) / 16.0); const double a = (double)(j < 16 ? t / 64 : t % 64) * inv; w.ROPA()[i] = make_float2((float)cos(a), (float)sin(a)); }
        if (i < 2048 * 16) { const int t = i / 16, j = i % 16; const double inv = pow(10000.0, -(double)(j % 8) / 8.0); const double a = (double)(j < 8 ? t / 64 : t % 64) * inv; w.ROPC()[i] = make_float2((float)cos(a), (float)sin(a)); }
    }
}

#ifndef PROBE_MASK
#define PROBE_MASK 0
#endif
#ifndef BENCH_MODE
#define BENCH_MODE 0
#endif
#if BENCH_MODE
__device__ __forceinline__ void phase_bench(float* sink) {
    int tid_ = threadIdx.x; asm volatile("" : "+v"(tid_));
    float x[16];
#pragma unroll
    for (int i = 0; i < 16; ++i) x[i] = (float)(tid_ + i) * 0.001f;
    f32x16 acc[4] = {};
    bf16x8 a = (bf16x8){(short)tid_, 1, 2, 3, 4, 5, 6, 7}, b = (bf16x8){7, 6, 5, 4, 3, 2, 1, (short)tid_};
#pragma nounroll
    for (int it = 0; it < ((BENCH_MODE & 7) ? 2048 : 0); ++it) {
#pragma unroll
        for (int k = 0; k < 8; ++k) {
            if (BENCH_MODE & 2) { acc[k & 3] = mfma32(a, b, acc[k & 3]); }
            __builtin_amdgcn_sched_barrier(0);
            if (BENCH_MODE & 1) { asm volatile("v_exp_f32 %0, -|%0|" : "+v"(x[2 * k])); asm volatile("v_exp_f32 %0, -|%0|" : "+v"(x[2 * k + 1])); }
            if (BENCH_MODE & 4) {
#pragma unroll
                for (int j = 0; j < 8; ++j) asm volatile("v_fma_f32 %0, %0, %0, %0" : "+v"(x[(2 * k + j) & 15]));
            }
            __builtin_amdgcn_sched_barrier(0);
        }
    }
    if (BENCH_MODE & 24) {
        const int lane = tid_ & 63, r32 = lane & 31, hi = lane >> 5;
        unsigned ka[2][4];
#pragma unroll
        for (int kt = 0; kt < 2; ++kt)
#pragma unroll
            for (int s_ = 0; s_ < 4; ++s_) { const int key = 32 * kt + r32; ka[kt][s_] = key * 128 + (((2 * s_ + hi) ^ ((key >> 1) & 7)) << 4); }
        const int vq = (lane & 15) >> 2, vp = lane & 3, vg = (lane >> 4) & 1;
        unsigned va[2];
#pragma unroll
        for (int dvb = 0; dvb < 2; ++dvb) { const int key = 4 * hi + vq; va[dvb] = 8192 + key * 128 + ((((32 * dvb + 16 * vg + 4 * vp) * 2)) ^ (((key >> 1) & 1) << 6)); }
        u32x4 kr[8]; u32x2 vr[16];
#pragma nounroll
        for (int it = 0; it < 2048; ++it) {
            if (BENCH_MODE & 8) {
#pragma unroll
                for (int kt = 0; kt < 2; ++kt)
#pragma unroll
                    for (int s_ = 0; s_ < 4; ++s_) asm volatile("ds_read_b128 %0, %1" : "=v"(kr[kt * 4 + s_]) : "v"(ka[kt][s_]));
            }
            if (BENCH_MODE & 16) {
#pragma unroll
                for (int q = 0; q < 4; ++q)
#pragma unroll
                    for (int dvb = 0; dvb < 2; ++dvb) { asm volatile("ds_read_b64_tr_b16 %0, %1" : "=v"(vr[q * 4 + dvb * 2]) : "v"(va[dvb] + q * 2048)); asm volatile("ds_read_b64_tr_b16 %0, %1 offset:1024" : "=v"(vr[q * 4 + dvb * 2 + 1]) : "v"(va[dvb] + q * 2048)); }
            }
            asm volatile("s_waitcnt lgkmcnt(0)" ::: "memory");
        }
        if (BENCH_MODE & 8) {
#pragma unroll
            for (int i = 0; i < 8; ++i) x[i] += __uint_as_float(kr[i][0] ^ kr[i][1] ^ kr[i][2] ^ kr[i][3]);
        }
        if (BENCH_MODE & 16) {
#pragma unroll
            for (int i = 0; i < 16; ++i) x[i] += __uint_as_float(vr[i][0] ^ vr[i][1]);
        }
    }
    float r = 0.f;
#pragma unroll
    for (int i = 0; i < 16; ++i) r += x[i];
#pragma unroll
    for (int k = 0; k < 4; ++k)
#pragma unroll
        for (int i = 0; i < 16; ++i) r += acc[k][i];
    if (r == 1.2345e30f) sink[tid_] = r;
}
#endif
struct MegaArgs { Inputs in; WS w; float* XL; unsigned* bar; };
constexpr int MEGA_LDS = 131072 + 16;
__global__ void __launch_bounds__(512, 2) k_mega(MegaArgs A) {
    LAS unsigned char* lds = (LAS unsigned char*)dyn_lds;
    const int vb = blockIdx.x, nvb = gridDim.x;
    volatile LAS unsigned* xbw = (volatile LAS unsigned*)(lds + 131072);
    if (threadIdx.x == 0) { xbw[0] = 0u; xbw[1] = 0u; xbw[2] = 0u; xbw[3] = 0u; }
    __syncthreads();
    XcdBarrier bar = xcd_barrier_post(A.bar, xbw);
    if (threadIdx.x == 0) xbw[2] = xb_add(&A.bar[3584 + 64 * bar.x], 1u);
    __syncthreads();
    const int xticket = __builtin_amdgcn_readfirstlane((int)xbw[2]);
    const WS& w = A.w; const Inputs& in = A.in;
    phase_mod(lds, in, w, vb);
    phase_rope(w, vb, nvb);
    phase_cvt(lds, in, w, vb, nvb);
    xcd_barrier(bar);
    phase_modulate<false>(in.x, in.ctx, nullptr, w.H(), in.norm1_g, w.MOD(), 0, NR, vb, nvb);
    xcd_barrier(bar);
#if (PROBE_MASK >> 0) & 1
    phase_mod(lds, in, w, vb);
    phase_rope(w, vb, nvb);
    phase_cvt(lds, in, w, vb, nvb);
    xcd_barrier(bar);
    phase_modulate<false>(in.x, in.ctx, nullptr, w.H(), in.norm1_g, w.MOD(), 0, NR, vb, nvb);
    xcd_barrier(bar);
#endif
#if BENCH_MODE
    phase_bench((float*)w.RSQ());
#endif
    int xpart = vb & 7, xrank = vb >> 3;
    { bool okx = (bar.x < 8u); for (unsigned j = 0; j < 8; ++j) okx = okx && (xb_ld(&A.bar[XB_XCNT(j)]) == (unsigned)(nvb >> 3));
      if (okx) { xpart = (int)bar.x; xrank = xticket; } }
    for (int l = 0; l < DEPTH; ++l) {
        const float* MODl = w.MOD() + (size_t)l * 33 * 6144;
        const bool last = (l == DEPTH - 1);
        const int MR = last ? NL : NR;
        phase_p1(lds, w, in, l, vb, nvb); xcd_barrier(bar);
#if (PROBE_MASK >> 1) & 1
        phase_p1(lds, w, in, l, vb, nvb); xcd_barrier(bar);
#endif
        phase_p2(lds, w, in, l, vb, nvb); xcd_barrier(bar);
#if (PROBE_MASK >> 12) & 7
        phase_p2(lds, w, in, l, vb, nvb, (PROBE_MASK >> 12) & 7); xcd_barrier(bar);
#endif
        phase_p3(lds, w, l, vb, nvb, xpart, xrank); xcd_barrier(bar);
#if (PROBE_MASK >> 3) & 1
        phase_p3(lds, w, l, vb, nvb, xpart, xrank); xcd_barrier(bar);
#endif
        phase_p4(lds, w, in, l, vb, nvb);
        xcd_barrier(bar);
#if (PROBE_MASK >> 4) & 1
        phase_p4(lds, w, in, l, vb, nvb);
        xcd_barrier(bar);
#endif
        phase_modulate<true>(nullptr, nullptr, w.XB(), w.H(), in.norm2_g + l * 1024, MODl, 3, MR, vb, nvb, w.H8(), w.HS()); xcd_barrier(bar);
#if (PROBE_MASK >> 5) & 1
        phase_modulate<true>(nullptr, nullptr, w.XB(), w.H(), in.norm2_g + l * 1024, MODl, 3, MR, vb, nvb, w.H8(), w.HS()); xcd_barrier(bar);
#endif
        phase_p6a(lds, w, l, vb, nvb); xcd_barrier(bar);
#if (PROBE_MASK >> 6) & 1
        phase_p6a(lds, w, l, vb, nvb); xcd_barrier(bar);
#endif
        phase_p6b(lds, w.PQ(), w.SubK() + (size_t)l * 16 * 128 * 128, w.EG(), MR, vb, nvb); xcd_barrier(bar);
#if (PROBE_MASK >> 7) & 1
        phase_p6b(lds, w.PQ(), w.SubK() + (size_t)l * 16 * 128 * 128, w.EG(), MR, vb, nvb); xcd_barrier(bar);
#endif
        { P7CArgs a{w.H8(), w.EG(), w.U8() + (size_t)l * NE * 1024, (int*)w.PQ(), MR}; phase_p7c(lds, a, xpart, xrank, nvb); }
        xcd_barrier(bar);
#if (PROBE_MASK >> 8) & 1
        { P7CArgs a{w.H8(), w.EG(), w.U8() + (size_t)l * NE * 1024, (int*)w.PQ(), MR}; phase_p7c(lds, a, xpart, xrank, nvb); }
        xcd_barrier(bar);
#endif
        phase_p7d((const int*)w.PQ(), w.EG(), w.US() + (size_t)l * NE, w.VS() + (size_t)l * NE, w.HS(), w.WE(), MR, vb, nvb);
        xcd_barrier(bar);
#if (PROBE_MASK >> 9) & 1
        phase_p7d((const int*)w.PQ(), w.EG(), w.US() + (size_t)l * NE, w.VS() + (size_t)l * NE, w.HS(), w.WE(), MR, vb, nvb);
        xcd_barrier(bar);
#endif
        { P7BArgs a{w.WE(), w.V8() + (size_t)l * NE * 1024, w.XB(), MODl + 5 * 1024, MR}; phase_p7b<0>(lds, a, xpart, xrank, nvb); }
        xcd_barrier(bar);
#if (PROBE_MASK >> 10) & 3
        { P7BArgs a{w.WE(), w.V8() + (size_t)l * NE * 1024, w.XB(), MODl + 5 * 1024, MR}; phase_p7b<((PROBE_MASK >> 10) & 3)>(lds, a, xpart, xrank, nvb); }
        xcd_barrier(bar);
#endif
        if (last) phase_final_norm(w.XB(), A.XL, in.final_g, vb, nvb);
        else phase_modulate<true>(nullptr, nullptr, w.XB(), w.H(), in.norm1_g + (l + 1) * 1024, w.MOD() + (size_t)(l + 1) * 33 * 6144, 0, NR, vb, nvb);
        if (!last) xcd_barrier(bar);
    }
}

extern "C" void kernel_launch(void* const* d_in, const int* in_sizes, int n_in, void* d_out, int out_size, void* d_ws, size_t ws_size, hipStream_t stream) {
    const float* const* fin = (const float* const*)d_in;
    Inputs in{fin[0], fin[1], fin[2], fin[3], fin[4], fin[5], fin[6], fin[7], fin[8], fin[9], fin[10], fin[11], fin[12], fin[13], fin[14], fin[15], fin[16], fin[17], fin[18], fin[19], fin[20], fin[21], fin[22]};
    WS w = make_ws(d_ws);
    static int ok = 0;
    if (!ok) {
        if (hipFuncSetAttribute((const void*)k_mega, hipFuncAttributeMaxDynamicSharedMemorySize, MEGA_LDS) != hipSuccess) { ok = -1; }
        int per_cu = 0, cus = 0, dev = 0; (void)hipGetDevice(&dev); (void)hipDeviceGetAttribute(&cus, hipDeviceAttributeMultiprocessorCount, dev);
        if (hipOccupancyMaxActiveBlocksPerMultiprocessor(&per_cu, (const void*)k_mega, 512, MEGA_LDS) != hipSuccess || per_cu < 1 || cus < 256) ok = -1;
        if (ok == 0) ok = 1;
    }
    if (ok < 0) return;
    (void)hipMemsetAsync(d_ws, 0, 16384, stream);
    MegaArgs A{in, w, (float*)d_out, (unsigned*)d_ws};
    k_mega<<<256, 512, MEGA_LDS, stream>>>(A);
}
```

```cpp
#include <hip/hip_runtime.h>
#include <stdint.h>

typedef unsigned short bf16_t;

constexpr int D = 1024, NB = 32, S = 2048, CTX = 256, DEPTH = 2;
constexpr int NL = NB * S, NC = NB * CTX, NR = NL + NC;
constexpr int KEYS = CTX + S;
constexpr int INC = 1568;
constexpr int NE = 16384;
constexpr float EPS = 1e-6f;

__device__ __forceinline__ float bf2f(bf16_t v) { return __uint_as_float(((unsigned)v) << 16); }
__device__ __forceinline__ bf16_t f2bf(float f) { unsigned u = __float_as_uint(f); u += 0x7FFFu + ((u >> 16) & 1u); return (bf16_t)(u >> 16); }

__device__ __forceinline__ float wave_sum(float v) {
#pragma unroll
    for (int o = 32; o > 0; o >>= 1) v += __shfl_xor(v, o);
    return v;
}
__device__ __forceinline__ float gelu_tanh(float x) {
    const float u = 0.7978845608028654f * (x + 0.044715f * x * x * x);
    return 0.5f * x * (1.f + tanhf(u));
}

struct WS {
    char* base;
    __host__ __device__ __forceinline__ bf16_t* H() const { return (bf16_t*)(base + 65536ull); }
    __host__ __device__ __forceinline__ bf16_t* Qg() const { return (bf16_t*)(base + 151060480ull); }
    __host__ __device__ __forceinline__ bf16_t* Qgc() const { return (bf16_t*)(base + 201392128ull); }
    __host__ __device__ __forceinline__ bf16_t* Kg() const { return (bf16_t*)(base + 207683584ull); }
    __host__ __device__ __forceinline__ bf16_t* Vg() const { return (bf16_t*)(base + 226557952ull); }
    __host__ __device__ __forceinline__ bf16_t* CQ() const { return (bf16_t*)(base + 245432320ull); }
    __host__ __device__ __forceinline__ bf16_t* CKV() const { return (bf16_t*)(base + 302055424ull); }
    __host__ __device__ __forceinline__ bf16_t* Bp() const { return (bf16_t*)(base + 339804160ull); }
    __host__ __device__ __forceinline__ bf16_t* KR() const { return (bf16_t*)(base + 377552896ull); }
    __host__ __device__ __forceinline__ bf16_t* Qm() const { return (bf16_t*)(base + 382271488ull); }
    __host__ __device__ __forceinline__ bf16_t* Qmc() const { return (bf16_t*)(base + 457768960ull); }
    __host__ __device__ __forceinline__ bf16_t* Kmn() const { return (bf16_t*)(base + 467206144ull); }
    __host__ __device__ __forceinline__ bf16_t* Vm() const { return (bf16_t*)(base + 523829248ull); }
    __host__ __device__ __forceinline__ unsigned* EG() const { return (unsigned*)(base + 580452352ull); }
    __host__ __device__ __forceinline__ bf16_t* P() const { return (bf16_t*)(base + 382271488ull); }
    __host__ __device__ __forceinline__ bf16_t* PQ() const { return (bf16_t*)(base + 151060480ull); }
    __host__ __device__ __forceinline__ bf16_t* TMP() const { return (bf16_t*)(base + 65536ull); }
    __host__ __device__ __forceinline__ float* XC() const { return (float*)(base + 618201088ull); }
    __host__ __device__ __forceinline__ float* MOD() const { return (float*)(base + 651755520ull); }
    __host__ __device__ __forceinline__ float2* ROPA() const { return (float2*)(base + 653377536ull); }
    __host__ __device__ __forceinline__ float2* ROPC() const { return (float2*)(base + 653901824ull); }
    __host__ __device__ __forceinline__ float* RSQ() const { return (float*)(base + 654163968ull); }
    __host__ __device__ __forceinline__ float* RSKV() const { return (float*)(base + 654458880ull); }
    __host__ __device__ __forceinline__ bf16_t* WinT() const { return (bf16_t*)(base + 654753792ull); }
    __host__ __device__ __forceinline__ bf16_t* WuqT() const { return (bf16_t*)(base + 662093824ull); }
    __host__ __device__ __forceinline__ bf16_t* WukvT() const { return (bf16_t*)(base + 663273472ull); }
    __host__ __device__ __forceinline__ bf16_t* WoutT() const { return (bf16_t*)(base + 664059904ull); }
    __host__ __device__ __forceinline__ bf16_t* WqT() const { return (bf16_t*)(base + 668254208ull); }
    __host__ __device__ __forceinline__ bf16_t* SubK() const { return (bf16_t*)(base + 676642816ull); }
    __host__ __device__ __forceinline__ unsigned char* U8() const { return (unsigned char*)(base + 677691392ull); }
    __host__ __device__ __forceinline__ unsigned char* V8() const { return (unsigned char*)(base + 711245824ull); }
    __host__ __device__ __forceinline__ float* US() const { return (float*)(base + 744800256ull); }
    __host__ __device__ __forceinline__ float* VS() const { return (float*)(base + 744931328ull); }
    __host__ __device__ __forceinline__ float* SSQ() const { return (float*)(base + 745062400ull); }
    __host__ __device__ __forceinline__ float* SSKV() const { return (float*)(base + 747421696ull); }
    __host__ __device__ __forceinline__ unsigned* WE() const { return (unsigned*)(base + 748601344ull); }
    __host__ __device__ __forceinline__ signed char* H8() const { return (signed char*)(base + 786350080ull); }
    __host__ __device__ __forceinline__ float* HS() const { return (float*)(base + 861847552ull); }
    __host__ __device__ __forceinline__ bf16_t* PoolWT() const { return (bf16_t*)(base + 862142464ull); }
    __host__ __device__ __forceinline__ bf16_t* XB() const { return (bf16_t*)(base + 862208000ull); }
};
constexpr size_t WS_BYTES = 862208000ull + (size_t)NR * 1024 * 2;
static WS make_ws(void* d_ws) { WS w; w.base = (char*)d_ws; return w; }


#define LAS __attribute__((address_space(3)))
typedef short bf16x8 __attribute__((ext_vector_type(8)));
typedef float f32x4 __attribute__((ext_vector_type(4)));
typedef float f32x16 __attribute__((ext_vector_type(16)));
typedef unsigned u32x4 __attribute__((ext_vector_type(4)));
typedef unsigned u32x2 __attribute__((ext_vector_type(2)));

__device__ __forceinline__ f32x16 mfma32(bf16x8 a, bf16x8 b, f32x16 c) { return __builtin_amdgcn_mfma_f32_32x32x16_bf16(a, b, c, 0, 0, 0); }
__device__ __forceinline__ unsigned cvt_pk_bf16(float lo, float hi) { unsigned r; asm volatile("v_cvt_pk_bf16_f32 %0, %1, %2" : "=v"(r) : "v"(lo), "v"(hi)); return r; }

namespace pg8 {
constexpr int BM = 256, BK = 64, HALF = 128, HTB = HALF * BK * 2, STAGE_BYTES = 8 * HTB, NXCD = 8, WGM = 8;
__host__ __device__ __forceinline__ int lds_byte(int r, int c) { const int st = (r >> 4) * 2 + (c >> 5), rr = r & 15, cc = c & 31, ob = rr * 64 + cc * 2; return st * 1024 + (ob ^ (((ob >> 9) & 1) << 5)); }
__host__ __device__ __forceinline__ void stage_rc(int b, int& R, int& C) { const int st = b / 1024, sb = b % 1024, swz = sb ^ (((sb >> 9) & 1) << 5); R = (st >> 1) * 16 + swz / 64; C = (st & 1) * 32 + (swz % 64) / 2; }
__host__ __device__ __forceinline__ int perm32(int rho) { const int n = rho >> 4, i = rho & 15; return 8 * (i >> 2) + 4 * n + (i & 3); }
struct Unit { int pm, pn; };
struct Gemm { const bf16_t* A; const bf16_t* Bt; int M, N, K; };
struct StaticOrder {
    int nM, nN, nwg, G, c;
    __host__ __device__ void init(int M, int N, int G_, int c_) { nM = M / BM; nN = N / BM; nwg = nM * nN; G = G_; c = c_; }
    __host__ __device__ bool next(int i, Unit& u) const {
        const long L = (long)i * G + c; if (L >= nwg) return false;
        int wgid = (int)L; { const int q = nwg / NXCD, r = nwg % NXCD, xcd = wgid % NXCD, off = wgid / NXCD; wgid = (xcd < r ? xcd * (q + 1) : r * (q + 1) + (xcd - r) * q) + off; }
        const int nig = WGM * nN, gid = wgid / nig, fm = gid * WGM, gsz = (nM - fm) < WGM ? (nM - fm) : WGM;
        u.pm = fm + ((wgid % nig) % gsz); u.pn = (wgid % nig) / gsz; return true;
    }
};
template <class Epi, class Sched>
__device__ __forceinline__ void gemm_phase(LAS unsigned char* lds, const Gemm g, const Sched& S, const Epi& E) {
    int tid_ = threadIdx.x; asm volatile("" : "+v"(tid_));
    const int tid = tid_, wid = __builtin_amdgcn_readfirstlane(tid >> 6), lane = tid & 63, wr = wid >> 2, wc = wid & 3, fr = lane & 15, fq = lane >> 4;
    const int K = g.K, nt = K / BK;
    unsigned voffA[2], voffB[2];
#pragma unroll
    for (int i = 0; i < 2; ++i) { int R, C; stage_rc(tid * 16 + i * 8192, R, C); const int Rb = Epi::PERM ? ((R & ~31) + perm32(R & 31)) : R;
        voffA[i] = (unsigned)(R * K + C) * 2u; voffB[i] = (unsigned)(Rb * K + C) * 2u; }
    const size_t kstep = (size_t)(BK * 2);
    const size_t hstep = (size_t)HALF * K * 2;
    const size_t tstep = 2 * hstep;
    const unsigned ldsw = (unsigned)wid * 1024u;
    const int aoff = lds_byte(wr * 64 + fr, fq * 8), boff = lds_byte(wc * 32 + fr, fq * 8);
#define PG8_SA(b, h) (((b) * 2 + (h)) * HTB)
#define PG8_SB(b, h) ((4 + (b) * 2 + (h)) * HTB)
#define PG8_STAGE(bufoff, gbase, voff) do { _Pragma("unroll") for (int _i = 0; _i < 2; ++_i) \
        __builtin_amdgcn_global_load_lds((const unsigned*)((const char*)(gbase) + (voff)[_i]), (LAS unsigned*)(lds + (bufoff) + ldsw + _i * 8192), 16, 0, 0); } while (0)
#define PG8_LDA(dst, b, h) do { _Pragma("unroll") for (int m = 0; m < 4; ++m) _Pragma("unroll") for (int k = 0; k < 2; ++k) dst[m][k] = *(const LAS bf16x8*)(lds + PG8_SA(b, h) + aoff + m * 2048 + k * 1024); } while (0)
#define PG8_LDB(dst, b, h) do { _Pragma("unroll") for (int n = 0; n < 2; ++n) _Pragma("unroll") for (int k = 0; k < 2; ++k) dst[n][k] = *(const LAS bf16x8*)(lds + PG8_SB(b, h) + boff + n * 2048 + k * 1024); } while (0)
#define PG8_MMA(ai, bj, At, Bt) do { __builtin_amdgcn_s_setprio(1); _Pragma("unroll") for (int m = 0; m < 4; ++m) _Pragma("unroll") for (int n = 0; n < 2; ++n) _Pragma("unroll") for (int k = 0; k < 2; ++k) \
        acc[ai][bj][m][n] = __builtin_amdgcn_mfma_f32_16x16x32_bf16(Bt[n][k], At[m][k], acc[ai][bj][m][n], 0, 0, 0); __builtin_amdgcn_s_setprio(0); } while (0)
#define PG8_WAIT_V(n) asm volatile("s_waitcnt vmcnt(" #n ")" ::: "memory")
#define PG8_WAIT_L(n) asm volatile("s_waitcnt lgkmcnt(" #n ")" ::: "memory")
#define PG8_BAR __builtin_amdgcn_s_barrier()
#define PG8_SCHED __builtin_amdgcn_sched_barrier(0)
    Unit cur, nxt; int ui = 0;
    if (!S.next(0, cur)) return;
    f32x4 acc[2][2][4][2];
#pragma unroll
    for (int a = 0; a < 2; ++a)
#pragma unroll
        for (int b = 0; b < 2; ++b)
#pragma unroll
            for (int m = 0; m < 4; ++m)
#pragma unroll
                for (int n = 0; n < 2; ++n) acc[a][b][m][n] = (f32x4){0.f, 0.f, 0.f, 0.f};
    bf16x8 At[4][2], B0[2][2], B1[2][2];
    const char* cA = (const char*)g.A + (size_t)cur.pm * tstep; const char* cB = (const char*)g.Bt + (size_t)cur.pn * tstep;
    PG8_STAGE(PG8_SB(0, 0), cB, voffB); PG8_STAGE(PG8_SA(0, 0), cA, voffA); PG8_STAGE(PG8_SB(0, 1), cB + hstep, voffB); PG8_STAGE(PG8_SA(0, 1), cA + hstep, voffA);
    if (wr == 1) PG8_BAR;
    PG8_WAIT_V(4); PG8_BAR;
    PG8_STAGE(PG8_SB(1, 0), cB + kstep, voffB); PG8_STAGE(PG8_SA(1, 0), cA + kstep, voffA); PG8_STAGE(PG8_SB(1, 1), cB + hstep + kstep, voffB);
    PG8_WAIT_V(6); PG8_BAR;
    for (;;) {
        const bool has_next = S.next(ui + 1, nxt);
        const char* nA = has_next ? (const char*)g.A + (size_t)nxt.pm * tstep : cA; const char* nB = has_next ? (const char*)g.Bt + (size_t)nxt.pn * tstep : cB;
#pragma nounroll
        for (int t = 0; t < nt; t += 2) {
            const bool last = (t == nt - 2);
            const char* a1 = cA + (size_t)(t + 1) * kstep;
            const char* a2 = last ? nA : cA + (size_t)(t + 2) * kstep; const char* b2 = last ? nB : cB + (size_t)(t + 2) * kstep;
            const char* a3 = a2 + kstep; const char* b3 = b2 + kstep;
            PG8_LDB(B0, 0, 0); PG8_SCHED; PG8_LDA(At, 0, 0); PG8_STAGE(PG8_SA(1, 1), a1 + hstep, voffA);
            PG8_WAIT_L(8); PG8_BAR; PG8_WAIT_L(0); PG8_MMA(0, 0, At, B0); PG8_BAR; PG8_SCHED;
            PG8_LDB(B1, 0, 1); PG8_STAGE(PG8_SB(0, 0), b2, voffB);
            PG8_BAR; PG8_WAIT_L(0); PG8_MMA(0, 1, At, B1); PG8_BAR;
            PG8_LDA(At, 0, 1); PG8_STAGE(PG8_SA(0, 0), a2, voffA);
            PG8_BAR; PG8_WAIT_L(0); PG8_MMA(1, 0, At, B0); PG8_BAR; PG8_SCHED;
            PG8_STAGE(PG8_SB(0, 1), b2 + hstep, voffB);
            PG8_WAIT_V(6); PG8_BAR; PG8_MMA(1, 1, At, B1); PG8_BAR;
            PG8_LDB(B0, 1, 0); PG8_SCHED; PG8_LDA(At, 1, 0); PG8_STAGE(PG8_SA(0, 1), a2 + hstep, voffA);
            PG8_WAIT_L(8); PG8_BAR; PG8_WAIT_L(0); PG8_MMA(0, 0, At, B0); PG8_BAR; PG8_SCHED;
            PG8_LDB(B1, 1, 1); PG8_STAGE(PG8_SB(1, 0), b3, voffB);
            PG8_BAR; PG8_WAIT_L(0); PG8_MMA(0, 1, At, B1); PG8_BAR;
            PG8_LDA(At, 1, 1); PG8_STAGE(PG8_SA(1, 0), a3, voffA);
            PG8_BAR; PG8_WAIT_L(0); PG8_MMA(1, 0, At, B0); PG8_BAR; PG8_SCHED;
            PG8_STAGE(PG8_SB(1, 1), b3 + hstep, voffB);
            PG8_WAIT_V(6); PG8_BAR; PG8_MMA(1, 1, At, B1); PG8_BAR;
        }
        E(acc, cur, wr, wc, fr, fq);
        if (!has_next) break;
#pragma unroll
        for (int a = 0; a < 2; ++a)
#pragma unroll
            for (int b = 0; b < 2; ++b)
#pragma unroll
                for (int m = 0; m < 4; ++m)
#pragma unroll
                    for (int n = 0; n < 2; ++n) acc[a][b][m][n] = (f32x4){0.f, 0.f, 0.f, 0.f};
        cur = nxt; cA = nA; cB = nB; ++ui;
    }
    PG8_WAIT_V(0);
    if (wr == 0) PG8_BAR;
    PG8_BAR;
#undef PG8_SA
#undef PG8_SB
#undef PG8_STAGE
#undef PG8_LDA
#undef PG8_LDB
#undef PG8_MMA
#undef PG8_WAIT_V
#undef PG8_WAIT_L
#undef PG8_BAR
#undef PG8_SCHED
}
}

enum { GT_AQ = 0, GT_AK = 1, GT_AV = 2, GT_B = 3, GT_CQ = 4, GT_CKV = 5, GT_KR = 6, GT_PAD = 7 };
__host__ __device__ __forceinline__ void in_group(int g, int& type, int& sub) {
    if (g < 2) { type = GT_AK; sub = g; } else if (g < 4) { type = GT_AV; sub = g - 2; } else if (g < 8) { type = GT_CKV; sub = g - 4; }
    else if (g == 8) { type = GT_KR; sub = 0; } else if (g < 12) { type = GT_PAD; sub = 0; } else if (g < 18) { type = GT_AQ; sub = g - 12; }
    else if (g < 24) { type = GT_CQ; sub = g - 18; } else { type = GT_B; sub = g - 24; }
}
__device__ __forceinline__ int colmap(int mode, int r) {
    const int pn = r >> 8, ct = r & 255, bj = ct >> 7, wc = (ct >> 5) & 3, j = ct & 31, g = 4 * pn + wc, e = 32 * bj + j;
    if (mode == 0) {
        int type, sub; in_group(g, type, sub);
        switch (type) { case GT_AQ: return 64 * sub + e; case GT_AK: return 384 + 64 * sub + e; case GT_AV: return 512 + 64 * sub + e; case GT_B: return 640 + 64 * sub + e;
            case GT_CQ: return 896 + 64 * sub + e; case GT_CKV: return 1280 + 64 * sub + e; case GT_KR: return (j < 16) ? 1536 + 16 * bj + j : -1; default: return -1; }
    } else if (mode == 1) {
        if (g < 6) return 96 * g + e; if (g < 9) { const int head = 2 * (g - 6) + (j >> 4); return 96 * head + 64 + 16 * bj + (j & 15); } return -1;
    } else if (mode == 2) {
        return 64 * g + e;
    }
    return r;
}
__device__ __forceinline__ void cvt_weights_unit(LAS float* tile  , const float* __restrict__ W, int K, int N, bf16_t* __restrict__ dst, int mode, const float* __restrict__ kgain, int r0, int k0) {
    int tid_ = threadIdx.x; asm volatile("" : "+v"(tid_));
    const int tid = tid_;
    const int jj = tid & 63; const int sc = colmap(mode, r0 + jj);
#pragma unroll
    for (int i = 0; i < 8; ++i) { const int kk = (tid >> 6) + 8 * i; float v = 0.f; if (sc >= 0) v = W[(size_t)(k0 + kk) * N + sc]; if (kgain) v *= kgain[k0 + kk]; tile[kk * 65 + jj] = v; }
    __syncthreads();
#pragma unroll
    for (int i = 0; i < 8; ++i) { const int rr = (tid >> 6) + 8 * i, kk = tid & 63; dst[(size_t)(r0 + rr) * K + k0 + kk] = f2bf(tile[kk * 65 + rr]); }
    __syncthreads();
}
struct CvtJob { const float* W; bf16_t* dst; const float* kgain; int K, N, Npad, mode; };
__device__ __forceinline__ void cvt_job(LAS float* tile, const CvtJob j, int vb, int nvb) {
    const int nk = j.K / 64, nr = j.Npad / 64;
    for (int u = vb; u < nk * nr; u += nvb) cvt_weights_unit(tile, j.W, j.K, j.N, j.dst, j.mode, j.kgain, (u / nk) * 64, (u % nk) * 64);
}
__device__ __forceinline__ void cvt_flat(const float* __restrict__ src, bf16_t* __restrict__ dst, size_t n, int vb, int nvb) {
    int tid_ = threadIdx.x; asm volatile("" : "+v"(tid_));
    for (size_t i = ((size_t)vb * 512 + tid_) * 8; i < n; i += (size_t)nvb * 512 * 8) {
        const float4 a = *(const float4*)(src + i), b = *(const float4*)(src + i + 4);
        u32x4 o; o.x = cvt_pk_bf16(a.x, a.y); o.y = cvt_pk_bf16(a.z, a.w); o.z = cvt_pk_bf16(b.x, b.y); o.w = cvt_pk_bf16(b.z, b.w);
        *(u32x4*)(dst + i) = o;
    }
}
template <bool FP8>
__device__ __forceinline__ void cvt_q8_rows(const float* __restrict__ src, unsigned char* __restrict__ dst, float* __restrict__ scales, int nrows, int vb, int nvb) {
    int tid_ = threadIdx.x; asm volatile("" : "+v"(tid_));
    const int lane = tid_ & 63, wid = tid_ >> 6;
    const int stride = nvb * 8;
    for (int row0 = vb * 8 + wid; row0 < nrows; row0 += 4 * stride) {
        f32x4 v[4][4];
#pragma unroll
        for (int q = 0; q < 4; ++q) { const int row = row0 + q * stride < nrows ? row0 + q * stride : row0; const float* sp = src + (size_t)row * 1024 + 16 * lane;
#pragma unroll
            for (int k = 0; k < 4; ++k) v[q][k] = *(const f32x4*)(sp + 4 * k); }
#pragma unroll
        for (int q = 0; q < 4; ++q) { const int row = row0 + q * stride; if (row < nrows) {
            float am = 0.f;
#pragma unroll
            for (int k = 0; k < 4; ++k) am = fmaxf(am, fmaxf(fmaxf(fabsf(v[q][k][0]), fabsf(v[q][k][1])), fmaxf(fabsf(v[q][k][2]), fabsf(v[q][k][3]))));
#pragma unroll
            for (int o = 32; o > 0; o >>= 1) am = fmaxf(am, __shfl_xor(am, o));
            const float qmax = FP8 ? 416.f : 127.f;
            const float sc = am > 0.f ? am / qmax : 1.f, inv = am > 0.f ? qmax / am : 0.f;
            u32x4 o4;
#pragma unroll
            for (int k = 0; k < 4; ++k) {
                if (FP8) { int p = __builtin_amdgcn_cvt_pk_fp8_f32(v[q][k][0] * inv, v[q][k][1] * inv, 0, false); p = __builtin_amdgcn_cvt_pk_fp8_f32(v[q][k][2] * inv, v[q][k][3] * inv, p, true); o4[k] = (unsigned)p; }
                else { const int q0 = (int)rintf(v[q][k][0] * inv), q1 = (int)rintf(v[q][k][1] * inv), q2 = (int)rintf(v[q][k][2] * inv), q3 = (int)rintf(v[q][k][3] * inv);
                    o4[k] = (unsigned)(q0 & 0xff) | ((unsigned)(q1 & 0xff) << 8) | ((unsigned)(q2 & 0xff) << 16) | ((unsigned)(q3 & 0xff) << 24); } }
            *(u32x4*)(dst + (size_t)row * 1024 + 16 * lane) = o4;
            if (lane == 0) scales[row] = sc; } }
    }
}
struct Inputs {
    const float *x, *c, *ctx, *c_ctx, *ada_w, *ada_b, *norm1_g, *norm2_g, *w_in, *gqa_qn_g, *gqa_kn_g, *pool_w, *pool_scale, *mla_qn_g, *mla_kvn_g, *mla_w_uq, *mla_w_ukv, *w_out, *peer_wq, *peer_subkeys, *peer_u, *peer_v, *final_g;
};
__device__ __forceinline__ void phase_cvt(LAS unsigned char* lds, const Inputs& in, const WS& w, int vb, int nvb) {
    LAS float* tile = (LAS float*)lds;
    for (int l = 0; l < 2; ++l) {
        cvt_job(tile, CvtJob{in.w_in + (size_t)l * 1024 * INC, w.WinT() + (size_t)l * 1792 * 1024, nullptr, 1024, INC, 1792, 0}, vb, nvb);
        cvt_job(tile, CvtJob{in.mla_w_uq + (size_t)l * 384 * 576, w.WuqT() + (size_t)l * 768 * 384, in.mla_qn_g + l * 384, 384, 576, 768, 1}, vb, nvb);
        cvt_job(tile, CvtJob{in.mla_w_ukv + (size_t)l * 256 * 768, w.WukvT() + (size_t)l * 768 * 256, in.mla_kvn_g + l * 256, 256, 768, 768, 2}, vb, nvb);
        cvt_job(tile, CvtJob{in.w_out + (size_t)l * 1024 * 1024, w.WoutT() + (size_t)l * 1024 * 1024, nullptr, 1024, 1024, 1024, 3}, vb, nvb);
        cvt_job(tile, CvtJob{in.peer_wq + (size_t)l * 1024 * 2048, w.WqT() + (size_t)l * 2048 * 1024, nullptr, 1024, 2048, 2048, 3}, vb, nvb);
    }
    cvt_flat(in.peer_subkeys, w.SubK(), (size_t)2 * 16 * 128 * 128, vb, nvb);
    { int tp_ = threadIdx.x; asm volatile("" : "+v"(tp_));
      for (int i = vb * 512 + tp_; i < 2 * 4 * 64 * 64; i += nvb * 512) { const int c = i & 63, d = (i >> 6) & 63, lg = i >> 12; w.PoolWT()[i] = f2bf(in.pool_w[(size_t)lg * 4096 + c * 64 + d]); } }
    if (nvb > 144) { if (vb >= 72) { cvt_q8_rows<false>(in.peer_u, w.U8(), w.US(), 2 * NE, vb - 72, nvb - 72); cvt_q8_rows<true>(in.peer_v, w.V8(), w.VS(), 2 * NE, vb - 72, nvb - 72); } }
    else { cvt_q8_rows<false>(in.peer_u, w.U8(), w.US(), 2 * NE, vb, nvb); cvt_q8_rows<true>(in.peer_v, w.V8(), w.VS(), 2 * NE, vb, nvb); }
}

constexpr float ATT_C2G = 0.125f * 1.4426950408889634f, ATT_C2M = 0.10206207261596577f * 1.4426950408889634f;
struct EpiIn {
    static constexpr bool PERM = true;
    WS w; const float* qn_g; const float* kn_g; int pm_base;
    __device__ __forceinline__ void operator()(const f32x4 (&acc)[2][2][4][2], const pg8::Unit& u, int wr, int wc, int fr, int fq) const {
        int type, sub; in_group(4 * u.pn + wc, type, sub);
        if (type == GT_PAD) return;
        const int pm = u.pm + pm_base; const bool isctx = pm >= 256; const int b = isctx ? pm - 256 : pm >> 3; const int t0 = isctx ? 0 : (pm & 7) * 256;
        const size_t rowbase = isctx ? (size_t)NL + (size_t)b * CTX : (size_t)b * S;
        const int keyoff = isctx ? 0 : CTX;
        float gain[2][8];
        if (type == GT_AQ) {
#pragma unroll
            for (int bj = 0; bj < 2; ++bj)
#pragma unroll
                for (int q = 0; q < 8; ++q) gain[bj][q] = qn_g[32 * bj + 8 * fq + q] * ATT_C2G;
        } else if (type == GT_AK) {
#pragma unroll
            for (int bj = 0; bj < 2; ++bj)
#pragma unroll
                for (int q = 0; q < 8; ++q) gain[bj][q] = kn_g[32 * bj + 8 * fq + q];
        }
#pragma unroll
        for (int ai = 0; ai < 2; ++ai)
#pragma unroll
            for (int m = 0; m < 4; ++m) {
                const int t = t0 + 128 * ai + 64 * wr + 16 * m + fr; const size_t row = rowbase + t;
                float v[2][8];
#pragma unroll
                for (int bj = 0; bj < 2; ++bj)
#pragma unroll
                    for (int n = 0; n < 2; ++n)
#pragma unroll
                        for (int i = 0; i < 4; ++i) v[bj][4 * n + i] = acc[ai][bj][m][n][i];
                bf16_t* dst = nullptr;
                if (type == GT_AQ || type == GT_AK) {
                    float ss = 0.f;
#pragma unroll
                    for (int bj = 0; bj < 2; ++bj)
#pragma unroll
                        for (int q = 0; q < 8; ++q) ss += v[bj][q] * v[bj][q];
                    ss += __shfl_xor(ss, 16); ss += __shfl_xor(ss, 32);
                    const float rstd = rsqrtf(ss * (1.f / 64.f) + EPS);
#pragma unroll
                    for (int q = 0; q < 8; ++q) { float x1 = v[0][q] * rstd * gain[0][q], x2 = v[1][q] * rstd * gain[1][q];
                        if (!isctx) { const float2 cs = w.ROPA()[t * 32 + 8 * fq + q]; const float y1 = x1 * cs.x - x2 * cs.y, y2 = x1 * cs.y + x2 * cs.x; x1 = y1; x2 = y2; }
                        v[0][q] = x1; v[1][q] = x2; }
                    if (type == GT_AQ) dst = isctx ? w.Qgc() + (((size_t)b * 6 + sub) * CTX + t) * 64 : w.Qg() + (((size_t)b * 6 + sub) * S + t) * 64;
                    else dst = w.Kg() + (((size_t)b * 2 + sub) * KEYS + keyoff + t) * 64;
                } else if (type == GT_AV) { dst = w.Vg() + (((size_t)b * 2 + sub) * KEYS + keyoff + t) * 64;
                } else if (type == GT_B) { dst = w.Bp() + row * 256 + 64 * sub;
                } else if (type == GT_CQ || type == GT_CKV) {
                    float ss = 0.f;
#pragma unroll
                    for (int bj = 0; bj < 2; ++bj)
#pragma unroll
                        for (int q = 0; q < 8; ++q) ss += v[bj][q] * v[bj][q];
                    ss += __shfl_xor(ss, 16); ss += __shfl_xor(ss, 32);
                    if (type == GT_CQ) { if (fq == 0) w.SSQ()[row * 8 + sub] = ss; dst = w.CQ() + row * 384 + 64 * sub; }
                    else { if (fq == 0) w.SSKV()[row * 4 + sub] = ss; dst = w.CKV() + row * 256 + 64 * sub; }
                } else {
                    if (!isctx) {
#pragma unroll
                        for (int q = 0; q < 8; ++q) { const float2 cs = w.ROPC()[t * 16 + ((8 * fq + q) & 15)]; const float x1 = v[0][q], x2 = v[1][q]; v[0][q] = x1 * cs.x - x2 * cs.y; v[1][q] = x1 * cs.y + x2 * cs.x; } }
                    if (fq < 2) { bf16_t* kd = w.KR() + ((size_t)b * KEYS + keyoff + t) * 32;
#pragma unroll
                        for (int bj = 0; bj < 2; ++bj) { u32x4 o; o.x = cvt_pk_bf16(v[bj][0], v[bj][1]); o.y = cvt_pk_bf16(v[bj][2], v[bj][3]); o.z = cvt_pk_bf16(v[bj][4], v[bj][5]); o.w = cvt_pk_bf16(v[bj][6], v[bj][7]);
                            *(u32x4*)(kd + 16 * bj + 8 * fq) = o; } }
                    continue;
                }
#pragma unroll
                for (int bj = 0; bj < 2; ++bj) { u32x4 o; o.x = cvt_pk_bf16(v[bj][0], v[bj][1]); o.y = cvt_pk_bf16(v[bj][2], v[bj][3]); o.z = cvt_pk_bf16(v[bj][4], v[bj][5]); o.w = cvt_pk_bf16(v[bj][6], v[bj][7]);
                    *(u32x4*)(dst + 32 * bj + 8 * fq) = o; }
            }
    }
};
struct P1Order {
    pg8::StaticOrder so; int nctx_tiles, G, c;
    __device__ bool next(int i, pg8::Unit& u) const {
        const int L = i * G + c;
        if (L < 1792) return so.next(i, u);
        const int Lc = L - 1792; if (Lc >= 32 * nctx_tiles) return false;
        u.pm = 256 + (Lc & 31); u.pn = Lc >> 5; return true;
    }
};
__device__ __forceinline__ void phase_p1(LAS unsigned char* lds, const WS& w, const Inputs& in, int l, int vb, int nvb) {
    EpiIn E{w, in.gqa_qn_g + l * 64, in.gqa_kn_g + l * 64, 0};
    P1Order po; po.so.init(NL, 1792, nvb, vb); po.nctx_tiles = (l == 0) ? 7 : 3; po.G = nvb; po.c = vb;
    pg8::gemm_phase(lds, pg8::Gemm{w.H(), w.WinT() + (size_t)l * 1792 * 1024, NR, 1792, 1024}, po, E);
}

extern __shared__ __attribute__((aligned(16))) unsigned char dyn_lds[];

struct EpiUq {
    static constexpr bool PERM = true;
    WS w;
    __device__ __forceinline__ void operator()(const f32x4 (&acc)[2][2][4][2], const pg8::Unit& u, int wr, int wc, int fr, int fq) const {
        const int g = 4 * u.pn + wc; if (g >= 9) return;
        const int pm = u.pm; const bool isctx = pm >= 256; const int b = isctx ? pm - 256 : pm >> 3; const int t0 = isctx ? 0 : (pm & 7) * 256;
        const size_t rowbase = isctx ? (size_t)NL + (size_t)b * CTX : (size_t)b * S;
        const int head = g < 6 ? g : 2 * (g - 6) + (fq >> 1);
#pragma unroll
        for (int ai = 0; ai < 2; ++ai)
#pragma unroll
            for (int m = 0; m < 4; ++m) {
                const int t = t0 + 128 * ai + 64 * wr + 16 * m + fr; const size_t row = rowbase + t;
                const float4 s0 = *(const float4*)(w.SSQ() + row * 8), s1 = *(const float4*)(w.SSQ() + row * 8 + 4);
                const float rstd = rsqrtf((s0.x + s0.y + s0.z + s0.w + s1.x + s1.y) * (1.f / 384.f) + EPS) * ATT_C2M;
                float v[2][8];
#pragma unroll
                for (int bj = 0; bj < 2; ++bj)
#pragma unroll
                    for (int n = 0; n < 2; ++n)
#pragma unroll
                        for (int i = 0; i < 4; ++i) v[bj][4 * n + i] = acc[ai][bj][m][n][i] * rstd;
                bf16_t* hd = isctx ? w.Qmc() + (((size_t)b * 6 + head) * CTX + t) * 96 : w.Qm() + (((size_t)b * 6 + head) * S + t) * 96;
                if (g >= 6 && !isctx) {
#pragma unroll
                    for (int q = 0; q < 8; ++q) { const float2 cs = w.ROPC()[t * 16 + 8 * (fq & 1) + q]; const float x1 = v[0][q], x2 = v[1][q]; v[0][q] = x1 * cs.x - x2 * cs.y; v[1][q] = x1 * cs.y + x2 * cs.x; } }
#pragma unroll
                for (int bj = 0; bj < 2; ++bj) { u32x4 o; o.x = cvt_pk_bf16(v[bj][0], v[bj][1]); o.y = cvt_pk_bf16(v[bj][2], v[bj][3]); o.z = cvt_pk_bf16(v[bj][4], v[bj][5]); o.w = cvt_pk_bf16(v[bj][6], v[bj][7]);
                    bf16_t* d = g < 6 ? hd + 32 * bj + 8 * fq : hd + 64 + 16 * bj + 8 * (fq & 1);
                    *(u32x4*)d = o; }
            }
    }
};
struct EpiUkv {
    static constexpr bool PERM = true;
    WS w;
    __device__ __forceinline__ void operator()(const f32x4 (&acc)[2][2][4][2], const pg8::Unit& u, int wr, int wc, int fr, int fq) const {
        const int g = 4 * u.pn + wc;
        const int pm = u.pm; const bool isctx = pm >= 256; const int b = isctx ? pm - 256 : pm >> 3; const int t0 = isctx ? 0 : (pm & 7) * 256;
        const size_t rowbase = isctx ? (size_t)NL + (size_t)b * CTX : (size_t)b * S; const int keyoff = isctx ? 0 : CTX;
        bf16_t* base = ((g & 1) ? w.Vm() : w.Kmn()) + ((size_t)b * 6 + (g >> 1)) * KEYS * 64;
#pragma unroll
        for (int ai = 0; ai < 2; ++ai)
#pragma unroll
            for (int m = 0; m < 4; ++m) {
                const int t = t0 + 128 * ai + 64 * wr + 16 * m + fr; const size_t row = rowbase + t;
                const float4 s0 = *(const float4*)(w.SSKV() + row * 4);
                const float rstd = rsqrtf((s0.x + s0.y + s0.z + s0.w) * (1.f / 256.f) + EPS);
                bf16_t* d = base + (size_t)(keyoff + t) * 64;
#pragma unroll
                for (int bj = 0; bj < 2; ++bj) { const f32x4 a0 = acc[ai][bj][m][0] * rstd, a1 = acc[ai][bj][m][1] * rstd;
                    u32x4 o; o.x = cvt_pk_bf16(a0[0], a0[1]); o.y = cvt_pk_bf16(a0[2], a0[3]); o.z = cvt_pk_bf16(a1[0], a1[1]); o.w = cvt_pk_bf16(a1[2], a1[3]);
                    *(u32x4*)(d + 32 * bj + 8 * fq) = o; }
            }
    }
};
constexpr int POOL_X = 0, POOL_P = 272 * 128, POOL_BYTES = 272 * 128 + 256 * 128;
template <int G>
__device__ __forceinline__ void pool_sums(LAS unsigned char* lds, int tid, int t0, int L) {
    constexpr int wdw = 2 << G, half = wdw >> 1, NX = 32 + wdw - 1;
    const int c = tid & 63, seg = tid >> 6; const LAS bf16_t* X = (const LAS bf16_t*)(lds + POOL_X) + c + (seg * 32 + 8 - half) * 64;
    const int tb = t0 + seg * 32;
    float xr[NX], xm[NX];
#pragma unroll
    for (int j = 0; j < NX; ++j) xr[j] = bf2f(X[j * 64]);
#pragma unroll
    for (int j = 0; j < NX; ++j) { const int row = tb - half + j; xm[j] = (row >= 0 && row < L) ? xr[j] : 0.f; }
    float sum = 0.f;
#pragma unroll
    for (int j = 0; j < wdw; ++j) sum += xm[j];
#pragma unroll
    for (int k = 0; k < 32; ++k) {
        const int t = tb + k; const int clo = (t - half) < 0 ? 0 : (t - half), chi = (t - half + wdw) > L ? L : (t - half + wdw);
        const float pv = sum / (float)(chi - clo) - xr[k + half];
        const int r = seg * 32 + k; *((LAS bf16_t*)(lds + POOL_P + r * 128 + (((c >> 3) ^ ((r >> 1) & 7)) << 4)) + (c & 7)) = f2bf(pv);
        if (k < 31) sum += xm[k + wdw] - xm[k];
    }
}
__device__ __forceinline__ void phase_pool(LAS unsigned char* lds, const WS& w, bf16_t* __restrict__ MIX, const bf16_t* __restrict__ WT  , const float* __restrict__ pool_scale, int nrows, int vb, int nvb) {
    int tid_ = threadIdx.x; asm volatile("" : "+v"(tid_));
    const int tid = tid_, lane = tid & 63, wid = __builtin_amdgcn_readfirstlane(tid >> 6), r32 = lane & 31, hi = lane >> 5;
    const int nunits = nrows >> 8;
    const int nmine = vb < nunits ? ((nunits - 1 - vb) / nvb + 1) * 4 : 0;
    u32x4 st[5];
#define POOL_FETCH(it_) do { const int u_ = vb + ((it_) >> 2) * nvb, g_ = (it_) & 3; const int row0_ = u_ << 8; const bool ic_ = row0_ >= NL; const int L_ = ic_ ? CTX : S; const int t0_ = ic_ ? 0 : (row0_ & (S - 1)); const int seq0_ = row0_ - t0_; \
        _Pragma("unroll") for (int k_ = 0; k_ < 5; ++k_) { int i_ = tid + 512 * k_; i_ = i_ < 272 * 8 ? i_ : 272 * 8 - 1; const int rr_ = i_ >> 3, ch_ = i_ & 7; int t_ = t0_ - 8 + rr_; t_ = t_ < 0 ? 0 : (t_ >= L_ ? L_ - 1 : t_); \
            st[k_] = *(const u32x4*)(w.Bp() + (size_t)(seq0_ + t_) * 256 + g_ * 64 + ch_ * 8); } } while (0)
    if (nmine > 0) POOL_FETCH(0);
    for (int it = 0; it < nmine; ++it) {
        const int u = vb + (it >> 2) * nvb, g = it & 3;
        const int row0 = u << 8; const bool isctx = row0 >= NL; const int L = isctx ? CTX : S; const int t0 = isctx ? 0 : (row0 & (S - 1));
        {
#pragma unroll
            for (int k = 0; k < 5; ++k) { const int i = tid + 512 * k; if (i < 272 * 8) *(LAS u32x4*)(lds + POOL_X + (i >> 3) * 128 + (i & 7) * 16) = st[k]; }
            { const int nx = it + 1 < nmine ? it + 1 : it; POOL_FETCH(nx); }
            __syncthreads();
            if (g == 0) pool_sums<0>(lds, tid, t0, L); else if (g == 1) pool_sums<1>(lds, tid, t0, L); else if (g == 2) pool_sums<2>(lds, tid, t0, L); else pool_sums<3>(lds, tid, t0, L);
            __syncthreads();
            { f32x16 o0 = {}, o1 = {};
              const bf16_t* wt = WT + (size_t)g * 4096 + (size_t)r32 * 64 + 8 * hi;
#pragma unroll
              for (int s = 0; s < 4; ++s) { const int row = wid * 32 + r32; const bf16x8 pf = *(const LAS bf16x8*)(lds + POOL_P + row * 128 + (((2 * s + hi) ^ ((row >> 1) & 7)) << 4));
                  o0 = mfma32(*(const bf16x8*)(wt + 16 * s), pf, o0); o1 = mfma32(*(const bf16x8*)(wt + 32 * 64 + 16 * s), pf, o1); }
              bf16_t* op = MIX + (size_t)(row0 + wid * 32 + r32) * 1024 + 384 + g * 64 + 4 * hi; const float* ps = pool_scale + g * 64 + 4 * hi;
#pragma unroll
              for (int q = 0; q < 4; ++q) { const f32x4 s0 = *(const f32x4*)(ps + 8 * q), s1 = *(const f32x4*)(ps + 32 + 8 * q); u32x2 a, b;
                  a.x = cvt_pk_bf16(o0[4 * q] * s0[0], o0[4 * q + 1] * s0[1]); a.y = cvt_pk_bf16(o0[4 * q + 2] * s0[2], o0[4 * q + 3] * s0[3]);
                  b.x = cvt_pk_bf16(o1[4 * q] * s1[0], o1[4 * q + 1] * s1[1]); b.y = cvt_pk_bf16(o1[4 * q + 2] * s1[2], o1[4 * q + 3] * s1[3]);
                  *(u32x2*)(op + 8 * q) = a; *(u32x2*)(op + 32 + 8 * q) = b; } }
            __syncthreads();
        }
    }
#undef POOL_FETCH
}
__device__ __forceinline__ void phase_p2(LAS unsigned char* lds, const WS& w, const Inputs& in, int l, int vb, int nvb, int parts = 7) {
    pg8::StaticOrder so;
    if (parts & 1) { EpiUq E{w}; const int M = l == 0 ? NR : NL; so.init(M, 768, nvb, vb); pg8::gemm_phase(lds, pg8::Gemm{w.CQ(), w.WuqT() + (size_t)l * 768 * 384, M, 768, 384}, so, E); }
    if (parts & 2) { EpiUkv E{w}; so.init(NR, 768, nvb, vb); pg8::gemm_phase(lds, pg8::Gemm{w.CKV(), w.WukvT() + (size_t)l * 768 * 256, NR, 768, 256}, so, E); }
    if (parts & 4) phase_pool(lds, w, w.H(), w.PoolWT() + (size_t)l * 4 * 64 * 64, in.pool_scale + l * 256, l == 0 ? NR : NL, vb, nvb);
}

struct EpiOut {
    static constexpr bool PERM = true;
    bf16_t* DLT; const float* gate;
    __device__ __forceinline__ void operator()(const f32x4 (&acc)[2][2][4][2], const pg8::Unit& u, int wr, int wc, int fr, int fq) const {
        const int pm = u.pm; const int mr = pm >= 256 ? 32 : pm >> 3;
        const size_t r0 = (size_t)pm * 256 + wr * 64 + fr; const int col0 = u.pn * 256 + wc * 32 + 8 * fq;
        f32x4 gv[2][2];
#pragma unroll
        for (int bj = 0; bj < 2; ++bj)
#pragma unroll
            for (int n = 0; n < 2; ++n) gv[bj][n] = *(const f32x4*)(gate + (size_t)mr * 6144 + col0 + bj * 128 + 4 * n);
#pragma unroll
        for (int ai = 0; ai < 2; ++ai)
#pragma unroll
            for (int m = 0; m < 4; ++m) { bf16_t* d = DLT + (r0 + ai * 128 + m * 16) * 1024 + col0;
#pragma unroll
                for (int bj = 0; bj < 2; ++bj) { const f32x4 a0 = acc[ai][bj][m][0] * gv[bj][0], a1 = acc[ai][bj][m][1] * gv[bj][1];
                    u32x4 o; o.x = cvt_pk_bf16(a0[0], a0[1]); o.y = cvt_pk_bf16(a0[2], a0[3]); o.z = cvt_pk_bf16(a1[0], a1[1]); o.w = cvt_pk_bf16(a1[2], a1[3]);
                    *(u32x4*)(d + bj * 128) = o; } }
    }
};
__device__ __forceinline__ void phase_p4(LAS unsigned char* lds, const WS& w, const Inputs& in, int l, int vb, int nvb) {
    const float* MODl = w.MOD() + (size_t)l * 33 * 6144;
    EpiOut E{w.PQ(), MODl + 2 * 1024};
    const int M = l == 0 ? NR : NL;
    pg8::StaticOrder so; so.init(M, 1024, nvb, vb);
    pg8::gemm_phase(lds, pg8::Gemm{w.H(), w.WoutT() + (size_t)l * 1024 * 1024, M, 1024, 1024}, so, E);
}

template <bool INBF>
__device__ __forceinline__ void phase_modulate(const float* __restrict__ XLp, const float* __restrict__ XCp, const bf16_t* __restrict__ XBp, bf16_t* __restrict__ Hout, const float* __restrict__ g, const float* __restrict__ MODl, int si, int nrows, int vb, int nvb,
                                               signed char* __restrict__ H8 = nullptr, float* __restrict__ HS = nullptr, const bf16_t* __restrict__ DLT = nullptr, bf16_t* __restrict__ XBo = nullptr) {
    int tid_ = threadIdx.x; asm volatile("" : "+v"(tid_));
    const int tid = tid_, lane = tid & 63, wid = tid >> 6;
    f32x4 gv[4];
#pragma unroll
    for (int i = 0; i < 4; ++i) gv[i] = *(const f32x4*)(g + 256 * i + 4 * lane);
    const int stride = nvb * 8, lastrow = nrows - 1;
    f32x4 nx[4]; u32x2 nxb[4], ndr[4];
#define PM_LOAD(r_) do { const int rr_ = (r_) < nrows ? (r_) : lastrow; const bool ic_ = rr_ >= NL; const float* xp_ = ic_ ? XCp + (size_t)(rr_ - NL) * 1024 : XLp + (size_t)rr_ * 1024; \
        _Pragma("unroll") for (int i = 0; i < 4; ++i) { if (INBF) nxb[i] = *(const u32x2*)(XBp + (size_t)rr_ * 1024 + 256 * i + 4 * lane); else nx[i] = *(const f32x4*)(xp_ + 256 * i + 4 * lane); \
            if (DLT) ndr[i] = *(const u32x2*)(DLT + (size_t)rr_ * 1024 + 256 * i + 4 * lane); } } while (0)
    PM_LOAD(vb * 8 + wid);
    for (int row = vb * 8 + wid; row < nrows; row += stride) {
        const bool isctx = row >= NL; const int mr = isctx ? 32 : row / S;
        f32x4 x[4]; u32x2 dr4[4]; float ss = 0.f;
#pragma unroll
        for (int i = 0; i < 4; ++i) { if (INBF) x[i] = (f32x4){__uint_as_float(nxb[i].x << 16), __uint_as_float(nxb[i].x & 0xffff0000u), __uint_as_float(nxb[i].y << 16), __uint_as_float(nxb[i].y & 0xffff0000u)}; else x[i] = nx[i];
            if (DLT) dr4[i] = ndr[i]; }
        PM_LOAD(row + stride);
#pragma unroll
        for (int i = 0; i < 4; ++i) {
            if (DLT) { const u32x2 dr = dr4[i];
                x[i][0] += __uint_as_float(dr.x << 16); x[i][1] += __uint_as_float(dr.x & 0xffff0000u); x[i][2] += __uint_as_float(dr.y << 16); x[i][3] += __uint_as_float(dr.y & 0xffff0000u);
                u32x2 xo; xo.x = cvt_pk_bf16(x[i][0], x[i][1]); xo.y = cvt_pk_bf16(x[i][2], x[i][3]); *(u32x2*)(XBo + (size_t)row * 1024 + 256 * i + 4 * lane) = xo; }
            ss += x[i][0] * x[i][0] + x[i][1] * x[i][1] + x[i][2] * x[i][2] + x[i][3] * x[i][3]; }
        ss = wave_sum(ss); const float rstd = rsqrtf(ss * (1.f / 1024.f) + EPS);
        const float* sh = MODl + (size_t)mr * 6144 + si * 1024;
        f32x4 y[4]; float am = 0.f;
#pragma unroll
        for (int i = 0; i < 4; ++i) { const f32x4 shv = *(const f32x4*)(sh + 256 * i + 4 * lane), scv = *(const f32x4*)(sh + 1024 + 256 * i + 4 * lane);
            y[i] = x[i] * rstd * gv[i] * (scv + 1.f) + shv;
            am = fmaxf(am, fmaxf(fmaxf(fabsf(y[i][0]), fabsf(y[i][1])), fmaxf(fabsf(y[i][2]), fabsf(y[i][3]))));
            u32x2 o; o.x = cvt_pk_bf16(y[i][0], y[i][1]); o.y = cvt_pk_bf16(y[i][2], y[i][3]);
            *(u32x2*)(Hout + (size_t)row * 1024 + 256 * i + 4 * lane) = o; }
        if (H8) {
#pragma unroll
            for (int o = 32; o > 0; o >>= 1) am = fmaxf(am, __shfl_xor(am, o));
            const float inv = am > 0.f ? 127.f / am : 0.f;
#pragma unroll
            for (int i = 0; i < 4; ++i) { const int q0 = (int)rintf(y[i][0] * inv), q1 = (int)rintf(y[i][1] * inv), q2 = (int)rintf(y[i][2] * inv), q3 = (int)rintf(y[i][3] * inv);
                *(unsigned*)(H8 + (size_t)row * 1024 + 256 * i + 4 * lane) = (unsigned)(q0 & 0xff) | ((unsigned)(q1 & 0xff) << 8) | ((unsigned)(q2 & 0xff) << 16) | ((unsigned)(q3 & 0xff) << 24); }
            if (lane == 0) HS[row] = am > 0.f ? am * (1.f / 127.f) : 1.f;
        }
    }
#undef PM_LOAD
}

struct EpiPQ {
    static constexpr bool PERM = true;
    bf16_t* PQ;
    __device__ __forceinline__ void operator()(const f32x4 (&acc)[2][2][4][2], const pg8::Unit& u, int wr, int wc, int fr, int fq) const {
        const size_t r0 = (size_t)u.pm * 256 + wr * 64 + fr; const int col0 = u.pn * 256 + wc * 32 + 8 * fq;
#pragma unroll
        for (int ai = 0; ai < 2; ++ai)
#pragma unroll
            for (int m = 0; m < 4; ++m) { bf16_t* d = PQ + (r0 + ai * 128 + m * 16) * 2048 + col0;
#pragma unroll
                for (int bj = 0; bj < 2; ++bj) { const f32x4 a0 = acc[ai][bj][m][0], a1 = acc[ai][bj][m][1];
                    u32x4 o; o.x = cvt_pk_bf16(a0[0], a0[1]); o.y = cvt_pk_bf16(a0[2], a0[3]); o.z = cvt_pk_bf16(a1[0], a1[1]); o.w = cvt_pk_bf16(a1[2], a1[3]);
                    *(u32x4*)(d + bj * 128) = o; } }
    }
};
__device__ __forceinline__ void phase_p6a(LAS unsigned char* lds, const WS& w, int l, int vb, int nvb) {
    EpiPQ E{w.PQ()}; const int M = l == 0 ? NR : NL;
    pg8::StaticOrder so; so.init(M, 2048, nvb, vb);
    pg8::gemm_phase(lds, pg8::Gemm{w.H(), w.WqT() + (size_t)l * 2048 * 1024, M, 2048, 1024}, so, E);
}


using bf16x2_t = __attribute__((ext_vector_type(2))) __bf16;
typedef float f32x2 __attribute__((ext_vector_type(2)));
__device__ __forceinline__ float gelu_fast(float x) {
    const float u2 = 1.5957691216057308f * (x + 0.044715f * x * x * x);
    return x * __builtin_amdgcn_rcpf(1.f + __builtin_amdgcn_exp2f(-1.4426950408889634f * u2));
}
#define DPPF(v, ctrl) __builtin_bit_cast(float, __builtin_amdgcn_update_dpp(0, __builtin_bit_cast(int, (v)), (ctrl), 0xf, 0xf, true))
__device__ __forceinline__ float reduce8(float p0, float p1, float p2, float p3, float p4, float p5, float p6, float p7, int lane) {
    auto s01 = __builtin_amdgcn_permlane32_swap(__float_as_uint(p0), __float_as_uint(p1), false, false);
    auto s23 = __builtin_amdgcn_permlane32_swap(__float_as_uint(p2), __float_as_uint(p3), false, false);
    auto s45 = __builtin_amdgcn_permlane32_swap(__float_as_uint(p4), __float_as_uint(p5), false, false);
    auto s67 = __builtin_amdgcn_permlane32_swap(__float_as_uint(p6), __float_as_uint(p7), false, false);
    const float q0 = __uint_as_float(s01[0]) + __uint_as_float(s01[1]), q1 = __uint_as_float(s23[0]) + __uint_as_float(s23[1]);
    const float q2 = __uint_as_float(s45[0]) + __uint_as_float(s45[1]), q3 = __uint_as_float(s67[0]) + __uint_as_float(s67[1]);
    auto t0 = __builtin_amdgcn_permlane16_swap(__float_as_uint(q0), __float_as_uint(q1), false, false);
    auto t1 = __builtin_amdgcn_permlane16_swap(__float_as_uint(q2), __float_as_uint(q3), false, false);
    float r0 = __uint_as_float(t0[0]) + __uint_as_float(t0[1]);
    float r1 = __uint_as_float(t1[0]) + __uint_as_float(t1[1]);
    r0 += DPPF(r0, 0x128); r1 += DPPF(r1, 0x128);
    float z = (lane & 8) ? r1 : r0;
    z += DPPF(z, 0x141);
    z += DPPF(z, 0xB1);
    z += DPPF(z, 0x4E);
    return z;
}
__device__ __forceinline__ void p7_axpy(const u32x4 v, float wj, f32x2 (&out)[8]) {
    const f32x2 w2 = {wj, wj};
#pragma unroll
    for (int k = 0; k < 4; ++k) { const f32x2 lo = __builtin_amdgcn_cvt_pk_f32_fp8((int)v[k], false), hi2 = __builtin_amdgcn_cvt_pk_f32_fp8((int)v[k], true);
        out[2 * k] = __builtin_elementwise_fma(w2, lo, out[2 * k]); out[2 * k + 1] = __builtin_elementwise_fma(w2, hi2, out[2 * k + 1]); }
}
__device__ __forceinline__ int p7_doti(const u32x4 u, const u32x4 h) {
    int s = __builtin_amdgcn_sdot4((int)u[0], (int)h[0], 0, false); s = __builtin_amdgcn_sdot4((int)u[1], (int)h[1], s, false); s = __builtin_amdgcn_sdot4((int)u[2], (int)h[2], s, false); return __builtin_amdgcn_sdot4((int)u[3], (int)h[3], s, false);
}
#define DPPI(v, ctrl) __builtin_amdgcn_update_dpp(0, (v), (ctrl), 0xf, 0xf, true)
__device__ __forceinline__ int reduce8i(int p0, int p1, int p2, int p3, int p4, int p5, int p6, int p7, int lane) {
    auto s01 = __builtin_amdgcn_permlane32_swap((unsigned)p0, (unsigned)p1, false, false); auto s23 = __builtin_amdgcn_permlane32_swap((unsigned)p2, (unsigned)p3, false, false);
    auto s45 = __builtin_amdgcn_permlane32_swap((unsigned)p4, (unsigned)p5, false, false); auto s67 = __builtin_amdgcn_permlane32_swap((unsigned)p6, (unsigned)p7, false, false);
    const unsigned q0 = s01[0] + s01[1], q1 = s23[0] + s23[1], q2 = s45[0] + s45[1], q3 = s67[0] + s67[1];
    auto t0 = __builtin_amdgcn_permlane16_swap(q0, q1, false, false); auto t1 = __builtin_amdgcn_permlane16_swap(q2, q3, false, false);
    int r0 = (int)(t0[0] + t0[1]), r1 = (int)(t1[0] + t1[1]);
    r0 += DPPI(r0, 0x128); r1 += DPPI(r1, 0x128);
    int z = (lane & 8) ? r1 : r0;
    z += DPPI(z, 0x141); z += DPPI(z, 0xB1); z += DPPI(z, 0x4E);
    return z;
}

struct P7CArgs { const signed char* H8; const unsigned* EG; const unsigned char* U8; int* PART; int nrows; };
__device__ __forceinline__ void phase_p7c(LAS unsigned char* lds, const P7CArgs& a, int part, int prank, int nvb) {
    int tid_ = threadIdx.x; asm volatile("" : "+v"(tid_));
    const int lane = tid_ & 63, wid = __builtin_amdgcn_readfirstlane(tid_ >> 6);
    const int nw = (nvb >> 3) * 8, wrank = prank * 8 + wid;
    LAS unsigned* tab = (LAS unsigned*)(lds + wid * 1024);
    const int grp = lane >> 3, c = lane & 7, c16 = c * 16;
    const unsigned char* ubase = a.U8 + 128 * part + c16;
    const signed char* hbase = a.H8 + 128 * part + c16;
    unsigned* pbase = (unsigned*)a.PART + (size_t)part * a.nrows * 64;
    const int c2 = (c >> 2) & 1, c1 = (c >> 1) & 1, c0 = c & 1;
    const int ent0 = 8 * (4 * c2 + 2 * c0 + c1) + grp;
    u32x4 Av[16], Bv[16]; u32x4 Ah, Bh;
    unsigned pw0 = 0u, pw1 = 0u;
#define P7C_PREF(t) do { pw0 = a.EG[(size_t)(t) * 128 + lane]; pw1 = a.EG[(size_t)(t) * 128 + 64 + lane]; } while (0)
#define P7C_ISSUE(X, Xh, t, slot, tnext) do { LAS unsigned* tb_ = tab + (slot) * 128; \
        tb_[lane] = pw0; tb_[64 + lane] = pw1; \
        asm volatile("s_waitcnt lgkmcnt(0)" ::: "memory"); \
        _Pragma("unroll") for (int i_ = 0; i_ < 16; ++i_) { const unsigned e_ = tb_[8 * i_ + grp]; X[i_] = *(const u32x4*)(ubase + (size_t)(e_ >> 16) * 1024); } \
        Xh = *(const u32x4*)(hbase + (size_t)(t) * 1024); \
        P7C_PREF(tnext); } while (0)
#define P7C_X(v, ctrl) ((v) + DPPI((v), (ctrl)))
#define P7C_COMPUTE(X, Xh, t, valid) do { int d_[16]; \
        _Pragma("unroll") for (int i_ = 0; i_ < 16; ++i_) d_[i_] = p7_doti(X[i_], Xh); \
        int e8_[8]; _Pragma("unroll") for (int k = 0; k < 8; ++k) { const int send_ = c2 ? d_[k] : d_[k + 8], keep_ = c2 ? d_[k + 8] : d_[k]; e8_[k] = keep_ + DPPI(send_, 0x141); }            \
        int e4_[4]; _Pragma("unroll") for (int k = 0; k < 4; ++k) { const int send_ = c0 ? e8_[k] : e8_[k + 4], keep_ = c0 ? e8_[k + 4] : e8_[k]; e4_[k] = keep_ + DPPI(send_, 0xB1); }          \
        int e2_[2]; _Pragma("unroll") for (int k = 0; k < 2; ++k) { const int send_ = c1 ? e4_[k] : e4_[k + 2], keep_ = c1 ? e4_[k + 2] : e4_[k]; e2_[k] = keep_ + DPPI(send_, 0x4E); }          \
        if (valid) pbase[(size_t)(t) * 64 + ent0] = __builtin_bit_cast(unsigned, __builtin_amdgcn_cvt_pk_i16((e2_[0] + 8) >> 4, (e2_[1] + 8) >> 4)); } while (0)
    const int lastrow = a.nrows - 1;
    int t = wrank;
    P7C_PREF(t);
    P7C_ISSUE(Av, Ah, t, 0, (t + nw < a.nrows ? t + nw : lastrow));
    while (t < a.nrows) {
        const int t1 = t + nw, t2 = t1 + nw, t3 = t2 + nw;
        const int k1 = t1 < a.nrows ? t1 : lastrow, k2 = t2 < a.nrows ? t2 : lastrow, k3 = t3 < a.nrows ? t3 : lastrow;
        P7C_ISSUE(Bv, Bh, k1, 1, k2);
        P7C_COMPUTE(Av, Ah, t, true);
        P7C_ISSUE(Av, Ah, k2, 0, k3);
        P7C_COMPUTE(Bv, Bh, k1, (t1 < a.nrows));
        t = t2;
    }
#undef P7C_PREF
#undef P7C_ISSUE
#undef P7C_COMPUTE
}
__device__ __forceinline__ void phase_p7d(const int* __restrict__ PART, const unsigned* __restrict__ EG, const float* __restrict__ US, const float* __restrict__ VS, const float* __restrict__ HS, unsigned* __restrict__ WE, int nrows, int vb, int nvb) {
    int tid_ = threadIdx.x; asm volatile("" : "+v"(tid_));
    typedef int i32x4 __attribute__((ext_vector_type(4)));
    const size_t n16 = (size_t)nrows * 16, pstride4 = n16;
    const u32x4* P4 = (const u32x4*)PART; const u32x4* EG4 = (const u32x4*)EG; u32x4* WE4 = (u32x4*)WE;
    for (size_t j = (size_t)vb * 512 + tid_; j < n16; j += (size_t)nvb * 512) {
        const size_t row = j >> 4; const int P = (int)(j >> 1) & 7, gq = (int)j & 1;
        i32x4 slo = {0, 0, 0, 0}, shi = {0, 0, 0, 0};
#pragma unroll
        for (int p = 0; p < 8; ++p) { const u32x4 d = P4[p * pstride4 + j];
#pragma unroll
            for (int k = 0; k < 4; ++k) { slo[k] += (int)(d[k] << 16) >> 16; shi[k] += (int)d[k] >> 16; } }
        const float hs = __builtin_ldexpf(HS[row], 4);
#pragma unroll
        for (int half = 0; half < 2; ++half) {
            const size_t ei = row * 32 + 4 * P + 2 * half + gq;
            const u32x4 eg = EG4[ei]; u32x4 o;
#pragma unroll
            for (int k = 0; k < 4; ++k) { const int eid = (int)(eg[k] >> 16);
                const float av = (float)(half ? shi[k] : slo[k]) * US[eid] * hs;
                const float wv = __uint_as_float(eg[k] << 16) * gelu_fast(av) * VS[eid];
                o[k] = (eg[k] & 0xffff0000u) | (cvt_pk_bf16(wv, 0.f) & 0xffffu); }
            WE4[ei] = o;
        }
    }
}
struct P7BArgs { const unsigned* WE; const unsigned char* V8; bf16_t* XB; const float* gate2; int nrows; };
template <int PM>
__device__ __forceinline__ void phase_p7b(LAS unsigned char* lds, const P7BArgs& a, int part, int prank, int nvb) {
    int tid_ = threadIdx.x; asm volatile("" : "+v"(tid_));
    const int lane = tid_ & 63, wid = __builtin_amdgcn_readfirstlane(tid_ >> 6);
    const int nw = (nvb >> 3) * 8, wrank = prank * 8 + wid;
    LAS unsigned* tab = (LAS unsigned*)(lds + wid * 1024);
    const int grp = lane >> 3, c16 = (lane & 7) * 16;
    const unsigned char* vbase = a.V8 + 128 * part + c16;
    const int colofs = 128 * part + c16 + 8 * (lane >> 5) + 4 * ((lane >> 4) & 1) + 2 * ((lane >> 3) & 1);
    u32x4 Av[16], Bv[16]; float Aw[16], Bw[16]; unsigned Ax, Bx; f32x2 Ag, Bg;
    unsigned pw0 = 0u, pw1 = 0u;
#define P7B_PREF(t) do { pw0 = a.WE[(size_t)(t) * 128 + lane]; pw1 = a.WE[(size_t)(t) * 128 + 64 + lane]; } while (0)
#define P7B_ISSUE(X, Xw, Xx, Xg, t, slot, tnext) do { LAS unsigned* tb_ = tab + (slot) * 128; \
        tb_[lane] = pw0; tb_[64 + lane] = pw1; \
        asm volatile("s_waitcnt lgkmcnt(0)" ::: "memory"); \
        _Pragma("unroll") for (int i_ = 0; i_ < 16; ++i_) { const unsigned we_ = tb_[8 * i_ + grp]; Xw[i_] = __uint_as_float(we_ << 16); if (PM != 2) X[i_] = *(const u32x4*)(vbase + (size_t)(we_ >> 16) * 1024); else X[i_] = (u32x4){we_, 0x38383838u, 0x38383838u, 0x38383838u}; } \
        { const int mr_ = (t) >= NL ? 32 : (t) / S; \
          Xx = *(const unsigned*)(a.XB + (size_t)(t) * 1024 + colofs); Xg = *(const f32x2*)(a.gate2 + (size_t)mr_ * 6144 + colofs); } \
        P7B_PREF(tnext); } while (0)
#define P7B_COMPUTE(X, Xw, Xx, Xg, t, valid) do { f32x2 acc2[8]; \
        _Pragma("unroll") for (int k = 0; k < 8; ++k) acc2[k] = (f32x2){0.f, 0.f}; \
        if (PM != 1) { _Pragma("unroll") for (int i_ = 0; i_ < 16; ++i_) p7_axpy(X[i_], Xw[i_], acc2); } else { _Pragma("unroll") for (int i_ = 0; i_ < 16; ++i_) acc2[i_ >> 1][i_ & 1] = __uint_as_float((X[i_][0] ^ X[i_][1] ^ X[i_][2] ^ X[i_][3]) & 0x3fffffffu) + Xw[i_]; } \
        float b_[8]; _Pragma("unroll") for (int k = 0; k < 8; ++k) { auto s_ = __builtin_amdgcn_permlane32_swap(__float_as_uint(acc2[k >> 1][k & 1]), __float_as_uint(acc2[(k + 8) >> 1][k & 1]), false, false); b_[k] = __uint_as_float(s_[0]) + __uint_as_float(s_[1]); } \
        float c_[4]; _Pragma("unroll") for (int k = 0; k < 4; ++k) { auto s_ = __builtin_amdgcn_permlane16_swap(__float_as_uint(b_[k]), __float_as_uint(b_[k + 4]), false, false); c_[k] = __uint_as_float(s_[0]) + __uint_as_float(s_[1]); } \
        float d_[2]; _Pragma("unroll") for (int k = 0; k < 2; ++k) { const float send_ = (lane & 8) ? c_[k] : c_[k + 2]; const float keep_ = (lane & 8) ? c_[k + 2] : c_[k]; d_[k] = keep_ + DPPF(send_, 0x128); } \
        unsigned* xp_ = (unsigned*)(a.XB + (size_t)(t) * 1024 + colofs); \
        f32x2 x_ = {__uint_as_float(Xx << 16), __uint_as_float(Xx & 0xffff0000u)}; x_.x += Xg.x * d_[0]; x_.y += Xg.y * d_[1]; if ((valid) && PM == 0) *xp_ = cvt_pk_bf16(x_.x, x_.y); else if (PM != 0 && x_.x == 1.2345e30f) *xp_ = cvt_pk_bf16(x_.x, x_.y); } while (0)
    const int lastrow = a.nrows - 1;
    int t = wrank;
    P7B_PREF(t);
    P7B_ISSUE(Av, Aw, Ax, Ag, t, 0, (t + nw < a.nrows ? t + nw : lastrow));
    while (t < a.nrows) {
        const int t1 = t + nw, t2 = t1 + nw, t3 = t2 + nw;
        const int c1 = t1 < a.nrows ? t1 : lastrow, c2 = t2 < a.nrows ? t2 : lastrow, c3 = t3 < a.nrows ? t3 : lastrow;
        P7B_ISSUE(Bv, Bw, Bx, Bg, c1, 1, c2);
        P7B_COMPUTE(Av, Aw, Ax, Ag, t, true);
        P7B_ISSUE(Av, Aw, Ax, Ag, c2, 0, c3);
        P7B_COMPUTE(Bv, Bw, Bx, Bg, c1, (t1 < a.nrows));
        t = t2;
    }
#undef P7B_PREF
#undef P7B_ISSUE
#undef P7B_COMPUTE
}
__device__ __forceinline__ void phase_final_norm(const bf16_t* __restrict__ XBp, float* __restrict__ OUT, const float* __restrict__ g, int vb, int nvb) {
    int tid_ = threadIdx.x; asm volatile("" : "+v"(tid_));
    const int lane = tid_ & 63, wid = tid_ >> 6;
    for (int row = vb * 8 + wid; row < NL; row += nvb * 8) {
        const bf16_t* xp = XBp + (size_t)row * 1024; f32x4 x[4]; float ss = 0.f;
#pragma unroll
        for (int i = 0; i < 4; ++i) { const u32x2 r = *(const u32x2*)(xp + 256 * i + 4 * lane); x[i] = (f32x4){__uint_as_float(r.x << 16), __uint_as_float(r.x & 0xffff0000u), __uint_as_float(r.y << 16), __uint_as_float(r.y & 0xffff0000u)};
            ss += x[i][0] * x[i][0] + x[i][1] * x[i][1] + x[i][2] * x[i][2] + x[i][3] * x[i][3]; }
        ss = wave_sum(ss); const float rstd = rsqrtf(ss * (1.f / 1024.f) + EPS);
#pragma unroll
        for (int i = 0; i < 4; ++i) *(f32x4*)(OUT + (size_t)row * 1024 + 256 * i + 4 * lane) = x[i] * rstd * *(const f32x4*)(g + 256 * i + 4 * lane);
    }
}

template <int V_> struct IC { static constexpr int value = V_; };
typedef short s16x4 __attribute__((ext_vector_type(4)));
__device__ __forceinline__ s16x4 lds_tr16(const LAS unsigned char* p) { return __builtin_bit_cast(s16x4, __builtin_amdgcn_ds_read_tr16_b64_v4i16((LAS s16x4*)p)); }
constexpr int ATT_BUF = 20480;
__device__ __forceinline__ void glds16(const void* g, unsigned lds_base) {
    unsigned sv; asm volatile("s_mov_b32 %0, m0\n\ts_mov_b32 m0, %2\n\ts_nop 0\n\tglobal_load_lds_dwordx4 %1, off\n\ts_mov_b32 m0, %0" : "=&s"(sv) : "v"(g), "s"(lds_base) : "memory"); }
template <int DK>
__device__ __forceinline__ void attn_unit(LAS unsigned char* lds, const bf16_t* __restrict__ Q, const bf16_t* __restrict__ K1, const bf16_t* __restrict__ K2, const bf16_t* __restrict__ V,
                                          int nkeys, float c2, bf16_t* __restrict__ out) {
    int tid_ = threadIdx.x; asm volatile("" : "+v"(tid_));
    const int tid = tid_, lane = tid & 63, wid = __builtin_amdgcn_readfirstlane(tid >> 6), r32 = lane & 31, hi = lane >> 5;
    constexpr int NS = DK / 16, NM = 2 * NS;
    bf16x8 qf[NS];
    { const bf16_t* qp = Q + (size_t)(wid * 32 + r32) * DK + 8 * hi;
#pragma unroll
      for (int s = 0; s < NS; ++s) qf[s] = *(const bf16x8*)(qp + 16 * s); }
    const int dkey = 8 * wid + (lane >> 3), dkey2 = 16 * (wid & 3) + (lane >> 2);
    const bf16_t* gk1 = K1 + (size_t)dkey * 64 + (((lane & 7) ^ ((dkey >> 1) & 7)) << 3);
    const bf16_t* gv = V + (size_t)dkey * 64 + (((lane & 7) ^ (((dkey >> 1) & 1) << 2)) << 3);
    const bf16_t* gk2 = (DK == 96) ? K2 + (size_t)dkey2 * 32 + (((lane & 3) ^ ((dkey2 >> 2) & 3)) << 3) : nullptr;
    const unsigned lds0 = (unsigned)(size_t)lds;
    const unsigned d_k1 = lds0 + wid * 1024, d_v = lds0 + 8192 + wid * 1024, d_k2 = lds0 + 16384 + (wid & 3) * 1024;
#define ATT_DMA(tile_, slot_) do { const int tt_ = (tile_); glds16(gk1 + (size_t)tt_ * 4096, (unsigned)__builtin_amdgcn_readfirstlane(d_k1 + (slot_) * ATT_BUF)); \
        glds16(gv + (size_t)tt_ * 4096, (unsigned)__builtin_amdgcn_readfirstlane(d_v + (slot_) * ATT_BUF)); \
        if (DK == 96) glds16(gk2 + (size_t)tt_ * 2048, (unsigned)__builtin_amdgcn_readfirstlane(d_k2 + (slot_) * ATT_BUF)); } while (0)
#define ATT_WAIT_BAR() do { if (DK == 96) asm volatile("s_waitcnt vmcnt(3) lgkmcnt(0)\n\ts_barrier" ::: "memory"); else asm volatile("s_waitcnt vmcnt(2) lgkmcnt(0)\n\ts_barrier" ::: "memory"); } while (0)
    unsigned ka[2][4];
#pragma unroll
    for (int kt = 0; kt < 2; ++kt)
#pragma unroll
        for (int s = 0; s < 4; ++s) { const int key = 32 * kt + r32; ka[kt][s] = key * 128 + (((2 * s + hi) ^ ((key >> 1) & 7)) << 4); }
    unsigned kb[2][2];
#pragma unroll
    for (int kt = 0; kt < 2; ++kt)
#pragma unroll
        for (int s = 0; s < 2; ++s) { const int key = 32 * kt + r32; kb[kt][s] = 16384 + key * 64 + (((2 * s + hi) ^ ((key >> 2) & 3)) << 4); }
    const int vq = (lane & 15) >> 2, vp = lane & 3, vg = (lane >> 4) & 1;
    unsigned va[2];
#pragma unroll
    for (int dvb = 0; dvb < 2; ++dvb) { const int key = 4 * hi + vq; va[dvb] = 8192 + key * 128 + ((((32 * dvb + 16 * vg + 4 * vp) * 2)) ^ (((key >> 1) & 1) << 6)); }
    float m = -1e30f, l = 0.f, mx;
    f32x16 o0 = {}, o1 = {};
    const int NT = nkeys >> 6;
    ATT_DMA(0, 0); ATT_DMA(NT > 1 ? 1 : 0, 1); ATT_DMA(NT > 2 ? 2 : NT - 1, 2);
    asm volatile("s_waitcnt vmcnt(0) lgkmcnt(0)\n\ts_barrier" ::: "memory");
    f32x16 pa0 = {}, pa1 = {}, pb0 = {}, pb1 = {};
    {
        bf16x8 kf0[NS], kf1[NS];
#pragma unroll
        for (int s = 0; s < 4; ++s) { kf0[s] = *(const LAS bf16x8*)(lds + ka[0][s]); kf1[s] = *(const LAS bf16x8*)(lds + ka[1][s]); }
        if (DK == 96) {
#pragma unroll
            for (int s = 0; s < 2; ++s) { kf0[4 + s] = *(const LAS bf16x8*)(lds + kb[0][s]); kf1[4 + s] = *(const LAS bf16x8*)(lds + kb[1][s]); }
        }
#pragma unroll
        for (int s = 0; s < NS; ++s) { pa0 = mfma32(kf0[s], qf[s], pa0); pa1 = mfma32(kf1[s], qf[s], pa1); }
        mx = pa0[0];
#pragma unroll
        for (int r = 1; r < 16; ++r) mx = fmaxf(mx, pa0[r]);
#pragma unroll
        for (int r = 0; r < 16; ++r) mx = fmaxf(mx, pa1[r]);
    }
    auto step = [&](auto bc_, auto bn_, auto bw_, f32x16& pc0, f32x16& pc1, f32x16& pn0, f32x16& pn1, int t) __attribute__((always_inline)) {
        constexpr int BC = decltype(bc_)::value * ATT_BUF, BN = decltype(bn_)::value * ATT_BUF;
        ATT_DMA((t + 3 < NT) ? t + 3 : NT - 1, decltype(bw_)::value);
        bf16x8 kf0[NS], kf1[NS];
#pragma unroll
        for (int s = 0; s < 4; ++s) { kf0[s] = *(const LAS bf16x8*)(lds + BN + ka[0][s]); kf1[s] = *(const LAS bf16x8*)(lds + BN + ka[1][s]); }
        if (DK == 96) {
#pragma unroll
            for (int s = 0; s < 2; ++s) { kf0[4 + s] = *(const LAS bf16x8*)(lds + BN + kb[0][s]); kf1[4 + s] = *(const LAS bf16x8*)(lds + BN + kb[1][s]); }
        }
        __builtin_amdgcn_sched_barrier(0);
        { auto rr = __builtin_amdgcn_permlane32_swap(__float_as_uint(mx), __float_as_uint(mx), false, false); mx = fmaxf(__uint_as_float(rr[0]), __uint_as_float(rr[1])); }
        const float tm = mx;
        if (__any(tm > m + 8.f)) {
            const float mn = fmaxf(m, tm), al = __builtin_amdgcn_exp2f(m - mn); m = mn; l *= al;
#pragma unroll
            for (int r = 0; r < 16; ++r) { o0[r] *= al; o1[r] *= al; }
        }
        const float nm = -m; float ls = 0.f;
        pn0 = f32x16{}; pn1 = f32x16{};
        unsigned pw[16];
        s16x4 vlo[2][2][2], vhi[2][2][2];
#pragma unroll
        for (int c = 0; c < 8; ++c) {
            __builtin_amdgcn_sched_barrier(0);
#pragma unroll
            for (int j = 0; j < NM; ++j) if (j >= c * NM / 8 && j < (c + 1) * NM / 8) { if (j & 1) pn1 = mfma32(kf1[j >> 1], qf[j >> 1], pn1); else pn0 = mfma32(kf0[j >> 1], qf[j >> 1], pn0); }
            if (c == 4) {
#pragma unroll
                for (int kt = 0; kt < 2; ++kt)
#pragma unroll
                    for (int sp = 0; sp < 2; ++sp) { const int kofs = (32 * kt + 16 * sp) * 128;
#pragma unroll
                        for (int dvb = 0; dvb < 2; ++dvb) { vlo[dvb][kt][sp] = lds_tr16(lds + BC + va[dvb] + kofs); vhi[dvb][kt][sp] = lds_tr16(lds + BC + va[dvb] + kofs + 8 * 128); } }
            }
            __builtin_amdgcn_sched_barrier(0);
            if (c < 4) {
#pragma unroll
                for (int i = 0; i < 4; ++i) { const int r = 4 * c + i; pc0[r] = __builtin_amdgcn_exp2f(pc0[r] + nm); ls += pc0[r]; }
                pw[2 * c] = cvt_pk_bf16(pc0[4 * c], pc0[4 * c + 1]); pw[2 * c + 1] = cvt_pk_bf16(pc0[4 * c + 2], pc0[4 * c + 3]);
            } else {
#pragma unroll
                for (int i = 0; i < 4; ++i) { const int r = 4 * (c - 4) + i; pc1[r] = __builtin_amdgcn_exp2f(pc1[r] + nm); ls += pc1[r]; }
                pw[8 + 2 * (c - 4)] = cvt_pk_bf16(pc1[4 * (c - 4)], pc1[4 * (c - 4) + 1]); pw[8 + 2 * (c - 4) + 1] = cvt_pk_bf16(pc1[4 * (c - 4) + 2], pc1[4 * (c - 4) + 3]);
            }
        }
        __builtin_amdgcn_sched_barrier(0);
        l += ls;
        float mxn = -3.0e38f;
#pragma unroll
        for (int k = 0; k < 8; ++k) { const int kt = k >> 2, sp = (k >> 1) & 1, dvb = k & 1;
            const u32x4 pq = (u32x4){pw[8 * kt + 4 * sp], pw[8 * kt + 4 * sp + 1], pw[8 * kt + 4 * sp + 2], pw[8 * kt + 4 * sp + 3]};
            const s16x4 lo = vlo[dvb][kt][sp], hi4 = vhi[dvb][kt][sp]; const bf16x8 vf = (bf16x8){lo[0], lo[1], lo[2], lo[3], hi4[0], hi4[1], hi4[2], hi4[3]};
            if (dvb == 0) o0 = mfma32(vf, __builtin_bit_cast(bf16x8, pq), o0); else o1 = mfma32(vf, __builtin_bit_cast(bf16x8, pq), o1);
            __builtin_amdgcn_sched_barrier(0);
            if (k < 4) { mxn = fmaxf(fmaxf(mxn, pn0[4 * k]), fmaxf(pn0[4 * k + 1], fmaxf(pn0[4 * k + 2], pn0[4 * k + 3]))); }
            else { mxn = fmaxf(fmaxf(mxn, pn1[4 * (k - 4)]), fmaxf(pn1[4 * (k - 4) + 1], fmaxf(pn1[4 * (k - 4) + 2], pn1[4 * (k - 4) + 3]))); }
            __builtin_amdgcn_sched_barrier(0);
        }
        mx = mxn;
        ATT_WAIT_BAR();
    };
    for (int t = 0; t < NT; t += 4) {
        step(IC<0>{}, IC<1>{}, IC<3>{}, pa0, pa1, pb0, pb1, t);
        step(IC<1>{}, IC<2>{}, IC<0>{}, pb0, pb1, pa0, pa1, t + 1);
        step(IC<2>{}, IC<3>{}, IC<1>{}, pa0, pa1, pb0, pb1, t + 2);
        step(IC<3>{}, IC<0>{}, IC<2>{}, pb0, pb1, pa0, pa1, t + 3);
    }
    { auto rr = __builtin_amdgcn_permlane32_swap(__float_as_uint(l), __float_as_uint(l), false, false); l = __uint_as_float(rr[0]) + __uint_as_float(rr[1]); }
    const float il = 1.f / l;
    bf16_t* op = out + (size_t)(wid * 32 + r32) * 1024 + 4 * hi;
#pragma unroll
    for (int g = 0; g < 4; ++g) { u32x2 a, b;
        a.x = cvt_pk_bf16(o0[4 * g] * il, o0[4 * g + 1] * il); a.y = cvt_pk_bf16(o0[4 * g + 2] * il, o0[4 * g + 3] * il);
        b.x = cvt_pk_bf16(o1[4 * g] * il, o1[4 * g + 1] * il); b.y = cvt_pk_bf16(o1[4 * g + 2] * il, o1[4 * g + 3] * il);
        *(u32x2*)(op + 8 * g) = a; *(u32x2*)(op + 32 + 8 * g) = b; }
}
#undef ATT_DMA
#undef ATT_WAIT_BAR
template <int DK>
__device__ __forceinline__ void attn_unit64(LAS unsigned char* lds, const bf16_t* __restrict__ Q, const bf16_t* __restrict__ K1, const bf16_t* __restrict__ K2, const bf16_t* __restrict__ V,
                                            int nkeys, bf16_t* __restrict__ out) {
    int tid_ = threadIdx.x; asm volatile("" : "+v"(tid_));
    const int tid = tid_, lane = tid & 63, wid = __builtin_amdgcn_readfirstlane(tid >> 6), r32 = lane & 31, hi = lane >> 5;
    constexpr int NS = DK / 16;
    bf16x8 qf[2][NS];
#pragma unroll
    for (int j = 0; j < 2; ++j) { const bf16_t* qp = Q + (size_t)(wid * 64 + 32 * j + r32) * DK + 8 * hi;
#pragma unroll
        for (int s = 0; s < NS; ++s) qf[j][s] = *(const bf16x8*)(qp + 16 * s); }
    const int dkey = 8 * wid + (lane >> 3), dkey2 = 16 * (wid & 3) + (lane >> 2);
    const bf16_t* gk1 = K1 + (size_t)dkey * 64 + (((lane & 7) ^ ((dkey >> 1) & 7)) << 3);
    const bf16_t* gv = V + (size_t)dkey * 64 + (((lane & 7) ^ (((dkey >> 1) & 1) << 2)) << 3);
    const bf16_t* gk2 = (DK == 96) ? K2 + (size_t)dkey2 * 32 + (((lane & 3) ^ ((dkey2 >> 2) & 3)) << 3) : nullptr;
    const unsigned lds0 = (unsigned)(size_t)lds;
    const unsigned d_k1 = lds0 + wid * 1024, d_v = lds0 + 8192 + wid * 1024, d_k2 = lds0 + 16384 + (wid & 3) * 1024;
#define ATT_DMA(tile_, slot_) do { const int tt_ = (tile_); glds16(gk1 + (size_t)tt_ * 4096, (unsigned)__builtin_amdgcn_readfirstlane(d_k1 + (slot_) * ATT_BUF)); \
        glds16(gv + (size_t)tt_ * 4096, (unsigned)__builtin_amdgcn_readfirstlane(d_v + (slot_) * ATT_BUF)); \
        if (DK == 96) glds16(gk2 + (size_t)tt_ * 2048, (unsigned)__builtin_amdgcn_readfirstlane(d_k2 + (slot_) * ATT_BUF)); } while (0)
    unsigned ka[4];
#pragma unroll
    for (int s = 0; s < 4; ++s) ka[s] = r32 * 128 + (((2 * s + hi) ^ ((r32 >> 1) & 7)) << 4);
    unsigned kb[2];
#pragma unroll
    for (int s = 0; s < 2; ++s) kb[s] = 16384 + r32 * 64 + (((2 * s + hi) ^ ((r32 >> 2) & 3)) << 4);
    const int vq = (lane & 15) >> 2, vp = lane & 3, vg = (lane >> 4) & 1;
    unsigned va[2];
#pragma unroll
    for (int dvb = 0; dvb < 2; ++dvb) { const int key = 4 * hi + vq; va[dvb] = 8192 + key * 128 + ((((32 * dvb + 16 * vg + 4 * vp) * 2)) ^ (((key >> 1) & 1) << 6)); }
    float m[2] = {-1e30f, -1e30f}, l[2] = {0.f, 0.f};
    f32x16 o[2][2] = {};
    const int NT = nkeys >> 6;
    ATT_DMA(0, 0); ATT_DMA(1, 1); ATT_DMA(2, 2);
    asm volatile("s_waitcnt vmcnt(0) lgkmcnt(0)\n\ts_barrier" ::: "memory");
    auto step = [&](auto cur_, auto wsl_, int t) __attribute__((always_inline)) {
        constexpr int BC = decltype(cur_)::value * ATT_BUF;
        ATT_DMA((t + 3 < NT) ? t + 3 : NT - 1, decltype(wsl_)::value);
        bf16x8 kf0[NS], kf1[NS];
#pragma unroll
        for (int s = 0; s < 4; ++s) { kf0[s] = *(const LAS bf16x8*)(lds + BC + ka[s]); kf1[s] = *(const LAS bf16x8*)(lds + BC + 4096 + ka[s]); }
        if (DK == 96) {
#pragma unroll
            for (int s = 0; s < 2; ++s) { kf0[4 + s] = *(const LAS bf16x8*)(lds + BC + kb[s]); kf1[4 + s] = *(const LAS bf16x8*)(lds + BC + 2048 + kb[s]); }
        }
        unsigned pw[2][16];
        s16x4 vlo[2][2], vhi[2][2];
#define ATT64_VLOAD(kt_) do { _Pragma("unroll") for (int sp = 0; sp < 2; ++sp) { const int kofs = (32 * (kt_) + 16 * sp) * 128; \
            _Pragma("unroll") for (int dvb = 0; dvb < 2; ++dvb) { vlo[dvb][sp] = lds_tr16(lds + BC + va[dvb] + kofs); vhi[dvb][sp] = lds_tr16(lds + BC + va[dvb] + kofs + 8 * 128); } } } while (0)
#define ATT64_PV(kt_) do { _Pragma("unroll") for (int sp = 0; sp < 2; ++sp) _Pragma("unroll") for (int dvb = 0; dvb < 2; ++dvb) { \
            const s16x4 lo = vlo[dvb][sp], hi4 = vhi[dvb][sp]; const bf16x8 vf = (bf16x8){lo[0], lo[1], lo[2], lo[3], hi4[0], hi4[1], hi4[2], hi4[3]}; \
            _Pragma("unroll") for (int j = 0; j < 2; ++j) { const u32x4 pq = (u32x4){pw[j][8 * (kt_) + 4 * sp], pw[j][8 * (kt_) + 4 * sp + 1], pw[j][8 * (kt_) + 4 * sp + 2], pw[j][8 * (kt_) + 4 * sp + 3]}; \
                o[j][dvb] = mfma32(vf, __builtin_bit_cast(bf16x8, pq), o[j][dvb]); } } } while (0)
#pragma unroll
        for (int j = 0; j < 2; ++j) {
            f32x16 p0 = {}, p1 = {};
#pragma unroll
            for (int s = 0; s < NS; ++s) { p0 = mfma32(kf0[s], qf[j][s], p0); p1 = mfma32(kf1[s], qf[j][s], p1); }
            if (j == 1) { __builtin_amdgcn_sched_barrier(0); ATT64_VLOAD(0); __builtin_amdgcn_sched_barrier(0); }
            float mx = p0[0];
#pragma unroll
            for (int r = 1; r < 16; ++r) mx = fmaxf(mx, p0[r]);
#pragma unroll
            for (int r = 0; r < 16; ++r) mx = fmaxf(mx, p1[r]);
            { auto rr = __builtin_amdgcn_permlane32_swap(__float_as_uint(mx), __float_as_uint(mx), false, false); mx = fmaxf(__uint_as_float(rr[0]), __uint_as_float(rr[1])); }
            if (__any(mx > m[j] + 8.f)) {
                const float mn = fmaxf(m[j], mx), al = __builtin_amdgcn_exp2f(m[j] - mn); m[j] = mn; l[j] *= al;
#pragma unroll
                for (int r = 0; r < 16; ++r) { o[j][0][r] *= al; o[j][1][r] *= al; }
            }
            const float nm = -m[j];
#pragma unroll
            for (int r = 0; r < 16; ++r) { p0[r] = __builtin_amdgcn_exp2f(p0[r] + nm); p1[r] = __builtin_amdgcn_exp2f(p1[r] + nm); }
            f32x2 ls2 = {0.f, 0.f};
#pragma unroll
            for (int r = 0; r < 16; r += 2) { ls2 += (f32x2){p0[r], p0[r + 1]}; ls2 += (f32x2){p1[r], p1[r + 1]}; }
            l[j] += ls2.x + ls2.y;
#pragma unroll
            for (int i = 0; i < 8; ++i) { pw[j][i] = cvt_pk_bf16(p0[2 * i], p0[2 * i + 1]); pw[j][8 + i] = cvt_pk_bf16(p1[2 * i], p1[2 * i + 1]); }
            __builtin_amdgcn_sched_barrier(0);
        }
        ATT64_PV(0);
        __builtin_amdgcn_sched_barrier(0);
        ATT64_VLOAD(1);
        __builtin_amdgcn_sched_barrier(0);
        ATT64_PV(1);
#undef ATT64_VLOAD
#undef ATT64_PV
        if (DK == 96) asm volatile("s_waitcnt vmcnt(6) lgkmcnt(0)\n\ts_barrier" ::: "memory"); else asm volatile("s_waitcnt vmcnt(4) lgkmcnt(0)\n\ts_barrier" ::: "memory");
    };
    for (int t = 0; t < NT; t += 4) {
        step(IC<0>{}, IC<3>{}, t); step(IC<1>{}, IC<0>{}, t + 1); step(IC<2>{}, IC<1>{}, t + 2); step(IC<3>{}, IC<2>{}, t + 3);
    }
#pragma unroll
    for (int j = 0; j < 2; ++j) {
        float lj = l[j]; { auto rr = __builtin_amdgcn_permlane32_swap(__float_as_uint(lj), __float_as_uint(lj), false, false); lj = __uint_as_float(rr[0]) + __uint_as_float(rr[1]); }
        const float il = 1.f / lj;
        bf16_t* op = out + (size_t)(wid * 64 + 32 * j + r32) * 1024 + 4 * hi;
#pragma unroll
        for (int g = 0; g < 4; ++g) { u32x2 a, b;
            a.x = cvt_pk_bf16(o[j][0][4 * g] * il, o[j][0][4 * g + 1] * il); a.y = cvt_pk_bf16(o[j][0][4 * g + 2] * il, o[j][0][4 * g + 3] * il);
            b.x = cvt_pk_bf16(o[j][1][4 * g] * il, o[j][1][4 * g + 1] * il); b.y = cvt_pk_bf16(o[j][1][4 * g + 2] * il, o[j][1][4 * g + 3] * il);
            *(u32x2*)(op + 8 * g) = a; *(u32x2*)(op + 32 + 8 * g) = b; }
    }
#undef ATT_DMA
}
__device__ __forceinline__ void phase_p3(LAS unsigned char* lds, const WS& w, int l, int vb, int nvb, int xpart, int xrank) {
    const float c2g = 0.125f * 1.4426950408889634f, c2m = 0.10206207261596577f * 1.4426950408889634f;
    bf16_t* MIX = w.H();
    const int ngq = NB * 6 * 4, nml = NB * 6 * 8, nctx = (l == 0) ? NB * 12 : 0;
    const bool xl = (nvb == 256);
    for (int u = vb; u < ngq + nml + nctx; u += nvb) {
        if (u < ngq) {
            int qb, slot, b;
            if (xl) { const int grp = (u >> 8) * 64 + 8 * xpart + (xrank >> 2); qb = xrank & 3; slot = grp % 6; b = grp / 6; }
            else { qb = u & 3; slot = (u >> 2) % 6; b = u / 24; }
            bf16_t* out = MIX + ((size_t)b * S + qb * 512) * 1024;
            attn_unit64<64>(lds, w.Qg() + (((size_t)b * 6 + slot) * S + qb * 512) * 64, w.Kg() + ((size_t)b * 2 + slot / 3) * KEYS * 64, nullptr, w.Vg() + ((size_t)b * 2 + slot / 3) * KEYS * 64, KEYS, out + slot * 64);
        } else if (u < ngq + nml) {
            const int v = u - ngq; int qb, h, b;
            if (xl) { const int grp = (v >> 8) * 32 + 4 * xpart + (xrank >> 3); qb = xrank & 7; h = grp % 6; b = grp / 6; }
            else { qb = v & 7; h = (v >> 3) % 6; b = v / 48; }
            bf16_t* out = MIX + ((size_t)b * S + qb * 256) * 1024;
            attn_unit<96>(lds, w.Qm() + (((size_t)b * 6 + h) * S + qb * 256) * 96, w.Kmn() + ((size_t)b * 6 + h) * KEYS * 64, w.KR() + (size_t)b * KEYS * 32, w.Vm() + ((size_t)b * 6 + h) * KEYS * 64, KEYS, c2m, out + 640 + h * 64);
        } else {
            const int v = u - ngq - nml, slot = v % 12, b = v / 12;
            bf16_t* out = MIX + ((size_t)NL + (size_t)b * CTX) * 1024;
            if (slot < 6) attn_unit<64>(lds, w.Qgc() + ((size_t)b * 6 + slot) * CTX * 64, w.Kg() + ((size_t)b * 2 + slot / 3) * KEYS * 64, nullptr, w.Vg() + ((size_t)b * 2 + slot / 3) * KEYS * 64, CTX, c2g, out + slot * 64);
            else { const int h = slot - 6; attn_unit<96>(lds, w.Qmc() + ((size_t)b * 6 + h) * CTX * 96, w.Kmn() + ((size_t)b * 6 + h) * KEYS * 64, w.KR() + (size_t)b * KEYS * 32, w.Vm() + ((size_t)b * 6 + h) * KEYS * 64, CTX, c2m, out + 640 + h * 64); }
        }
    }
}

__device__ __forceinline__ unsigned fkey(float f, unsigned tag, unsigned mask) { return (__float_as_uint(f) & ~mask) | tag; }
__device__ __forceinline__ float keyf(unsigned k, unsigned mask) { return __uint_as_float(k & ~mask); }
__device__ __forceinline__ unsigned fmax_u(unsigned a, unsigned b) { unsigned r; asm("v_max_f32 %0, %1, %2" : "=v"(r) : "v"(a), "v"(b)); return r; }
__device__ __forceinline__ unsigned fmin_u(unsigned a, unsigned b) { unsigned r; asm("v_min_f32 %0, %1, %2" : "=v"(r) : "v"(a), "v"(b)); return r; }
__device__ __forceinline__ void ce_desc(unsigned& a, unsigned& b) { const unsigned hi_ = fmax_u(a, b), lo_ = fmin_u(a, b); a = hi_; b = lo_; }
template <int J> __device__ __forceinline__ void bstage16(unsigned* a) {
#pragma unroll
    for (int i = 0; i < 16; ++i) { const int l = i ^ J; if (l > i) ce_desc(a[i], a[l]); }
}
__device__ __forceinline__ void sort16_desc(unsigned* a) {
#define CE_(i, j) ce_desc(a[i], a[j]);
    CE_(0, 13) CE_(1, 12) CE_(2, 15) CE_(3, 14) CE_(4, 8) CE_(5, 6) CE_(7, 11) CE_(9, 10)
    CE_(0, 5) CE_(1, 7) CE_(2, 9) CE_(3, 4) CE_(6, 13) CE_(8, 14) CE_(10, 15) CE_(11, 12)
    CE_(0, 1) CE_(2, 3) CE_(4, 5) CE_(6, 8) CE_(7, 9) CE_(10, 11) CE_(12, 13) CE_(14, 15)
    CE_(0, 2) CE_(1, 3) CE_(4, 10) CE_(5, 11) CE_(6, 7) CE_(8, 9) CE_(12, 14) CE_(13, 15)
    CE_(1, 2) CE_(3, 12) CE_(4, 6) CE_(5, 7) CE_(8, 10) CE_(9, 11) CE_(13, 14)
    CE_(1, 4) CE_(2, 6) CE_(5, 8) CE_(7, 10) CE_(9, 13) CE_(11, 14)
    CE_(2, 4) CE_(3, 6) CE_(9, 12) CE_(11, 13)
    CE_(3, 5) CE_(6, 8) CE_(7, 9) CE_(10, 12)
    CE_(3, 4) CE_(5, 6) CE_(7, 8) CE_(9, 10) CE_(11, 12)
    CE_(6, 7) CE_(8, 9)
#undef CE_
}
__device__ __forceinline__ void bmerge16_desc(unsigned* c) { bstage16<8>(c); bstage16<4>(c); bstage16<2>(c); bstage16<1>(c); }
__device__ __forceinline__ void merge_top16(unsigned* a, const unsigned* b) {
#pragma unroll
    for (int i = 0; i < 16; ++i) a[i] = fmax_u(a[i], b[15 - i]);
    bmerge16_desc(a);
}
__device__ __forceinline__ void xlane_top16(unsigned* t, int hi) {
    unsigned r[16]; const unsigned msk = 0u - (unsigned)hi;
#pragma unroll
    for (int i = 0; i < 16; ++i) r[i] = t[i] ^ ((t[i] ^ t[15 - i]) & msk);
#pragma unroll
    for (int i = 0; i < 16; ++i) { auto s = __builtin_amdgcn_permlane32_swap(r[i], r[i], false, false); t[i] = fmax_u(s[0], s[1]); }
    bmerge16_desc(t);
}
__device__ __forceinline__ constexpr int cand_a(int c) { return c < 16 ? 0 : c < 24 ? 1 : c < 32 ? 39 - c : c < 37 ? 2 : c < 41 ? 3 : c < 44 ? 4 : c < 46 ? 5 : c < 48 ? 6 : 7; }
__device__ __forceinline__ constexpr int cand_b(int c) { return c < 16 ? c : c < 24 ? c - 16 : c < 32 ? 0 : c < 37 ? c - 32 : c < 41 ? c - 37 : c < 44 ? c - 41 : c < 46 ? c - 44 : c < 48 ? c - 46 : c - 48; }

__device__ __forceinline__ void phase_p6b(LAS unsigned char* lds, const bf16_t* __restrict__ PQ, const bf16_t* __restrict__ SubKl, unsigned* __restrict__ EG, int nrows, int vb, int nvb) {
    int tid_ = threadIdx.x; asm volatile("" : "+v"(tid_));
    const int tid = tid_, lane = tid & 63, wid = __builtin_amdgcn_readfirstlane(tid >> 6), r32 = lane & 31, hi = lane >> 5;
    const int h = vb & 7, wrank = (vb >> 3) * 8 + wid, nwr = (nvb >> 3) * 8;
    LAS unsigned short* tab = (LAS unsigned short*)(lds + 65536 + wid * 4096) + r32 * 64;
#pragma unroll
    for (int i = 0; i < 8; ++i) { const int idx = i * 512 + tid, p = idx >> 11, key = (idx >> 4) & 127, ch = idx & 15;
        *(LAS u32x4*)(lds + p * 32768 + key * 256 + ((ch ^ (key & 15)) << 4)) = *(const u32x4*)(SubKl + ((size_t)(h * 2 + p) * 128 + key) * 128 + ch * 8); }
    __syncthreads();
    const int ngroups = nrows >> 5;
    for (int tg = wrank; tg < ngroups; tg += nwr) {
        const int row0 = tg << 5;
        bf16x8 qf[2][8];
        { const bf16_t* qp = PQ + (size_t)(row0 + r32) * 2048 + h * 256 + 8 * hi; asm volatile("" : "+v"(qp));
#pragma unroll
          for (int p = 0; p < 2; ++p)
#pragma unroll
              for (int s = 0; s < 8; ++s) qf[p][s] = *(const bf16x8*)(qp + p * 128 + 16 * s); }
        unsigned top[2][16];
#pragma unroll
        for (int p = 0; p < 2; ++p) {
            f32x16 acc[4];
#pragma unroll
            for (int kt = 0; kt < 4; ++kt) { acc[kt] = f32x16{}; const int key = 32 * kt + r32;
#pragma unroll
                for (int s = 0; s < 8; ++s) acc[kt] = mfma32(*(const LAS bf16x8*)(lds + p * 32768 + key * 256 + (((2 * s + hi) ^ (key & 15)) << 4)), qf[p][s], acc[kt]); }
            unsigned key[64];
#pragma unroll
            for (int kt = 0; kt < 4; ++kt)
#pragma unroll
                for (int r = 0; r < 16; ++r) { const int n = 32 * kt + (r & 3) + 8 * (r >> 2) + 4 * hi; key[16 * kt + r] = fkey(acc[kt][r], 127u - (unsigned)n, 127u); }
            sort16_desc(key); sort16_desc(key + 16); sort16_desc(key + 32); sort16_desc(key + 48);
            merge_top16(key, key + 16); merge_top16(key + 32, key + 48); merge_top16(key, key + 32);
            xlane_top16(key, hi);
#pragma unroll
            for (int i = 0; i < 16; ++i) top[p][i] = key[i];
        }
        float t0f[16], t1f[16];
#pragma unroll
        for (int i = 0; i < 16; ++i) { t0f[i] = keyf(top[0][i], 127u); t1f[i] = keyf(top[1][i], 127u); }
        unsigned ck[50];
#pragma unroll
        for (int c = 0; c < 50; ++c) ck[c] = fkey(t0f[cand_a(c)] + t1f[cand_b(c)], (unsigned)c, 63u);
        if (hi == 0) {
#pragma unroll
            for (int c = 0; c < 50; c += 2) {
                const unsigned ea = (127u - (top[0][cand_a(c)] & 127u)) * 128u + (127u - (top[1][cand_b(c)] & 127u));
                const unsigned eb = (127u - (top[0][cand_a(c + 1)] & 127u)) * 128u + (127u - (top[1][cand_b(c + 1)] & 127u));
                *(LAS unsigned*)(tab + c) = ea | (eb << 16);
            }
        }
        bmerge16_desc(ck + 16); sort16_desc(ck + 32);
        merge_top16(ck, ck + 16); merge_top16(ck, ck + 32);
        ck[15] = fmax_u(ck[15], ck[48]); ck[14] = fmax_u(ck[14], ck[49]); bmerge16_desc(ck);
        asm volatile("s_waitcnt lgkmcnt(0)" ::: "memory");
        const float mx = keyf(ck[0], 63u); float e[16], den = 0.f;
#pragma unroll
        for (int j = 0; j < 16; ++j) { e[j] = __builtin_amdgcn_exp2f((keyf(ck[j], 63u) - mx) * 1.4426950408889634f); den += e[j]; }
        const float iden = 1.f / den;
        if (hi == 0) {
            unsigned o[16];
#pragma unroll
            for (int j = 0; j < 16; ++j) { const unsigned eid = tab[ck[j] & 63u]; o[j] = (eid << 16) | (cvt_pk_bf16(e[j] * iden, 0.f) & 0xffffu); }
            unsigned* dst = EG + (size_t)(row0 + r32) * 128 + h * 16;
#pragma unroll
            for (int j = 0; j < 16; j += 4) *(u32x4*)(dst + j) = (u32x4){o[j], o[j + 1], o[j + 2], o[j + 3]};
        }
        asm volatile("s_waitcnt lgkmcnt(0)" ::: "memory");
    }
}


#define XB_TMO      128
#define XB_XCNT(j)  (256  + 64 * (j))
#define XB_XSUB(j)  (1280 + 64 * (j))
#define XB_XGEN(j)  (2304 + 64 * (j))
#define XB_TOP      3328
#define XB_TOPGEN   3392
#define XCD_BAR_WORDS 3456
#define XB_SPIN_CAP (1u << 18)

__device__ __forceinline__ unsigned xb_ld(unsigned* p)              { return __hip_atomic_load(p, __ATOMIC_RELAXED, __HIP_MEMORY_SCOPE_AGENT); }
__device__ __forceinline__ unsigned xb_add(unsigned* p, unsigned v) { return __hip_atomic_fetch_add(p, v, __ATOMIC_RELAXED, __HIP_MEMORY_SCOPE_AGENT); }
__device__ __forceinline__ unsigned xb_xcc_id() { return (unsigned)__builtin_amdgcn_s_getreg((3 << 11) | 20) & 0xFu; }
#define XB_SPIN(cond, bar) do { unsigned _sp = 0; while (cond) { __builtin_amdgcn_s_sleep(1); \
    if ((++_sp & 255u) == 0u) { if (xb_ld(&(bar)[XB_TMO])) break; if (_sp > XB_SPIN_CAP) { atomicAdd(&(bar)[XB_TMO], 1u); break; } } } } while (0)

struct XcdBarrier {
    unsigned* bar; unsigned x;
    volatile LAS unsigned* st;
};

__device__ __forceinline__ XcdBarrier xcd_barrier_post(unsigned* bar, volatile LAS unsigned* st) {
    XcdBarrier b; b.bar = bar; b.x = xb_xcc_id(); b.st = st;
    if (threadIdx.x == 0) (void)xb_add(&bar[XB_XCNT(b.x)], 1u);
    return b;
}
__device__ __forceinline__ void xcd_barrier_complete(unsigned* bar, unsigned x, unsigned& nloc, unsigned& nx) {
    const unsigned G = gridDim.x * gridDim.y * gridDim.z;
    unsigned sum, cnt, mine, sp = 0u;
    for (;;) {
        sum = 0u; cnt = 0u; mine = 0u;
#pragma unroll
        for (unsigned j = 0; j < 16; ++j) { const unsigned c = xb_ld(&bar[XB_XCNT(j)]); sum += c; cnt += (c > 0u) ? 1u : 0u; mine = (j == x) ? c : mine; }
        if (sum == G) break;
        __builtin_amdgcn_s_sleep(1);
        if ((++sp & 255u) == 0u) { if (xb_ld(&bar[XB_TMO])) break; if (sp > XB_SPIN_CAP) { atomicAdd(&bar[XB_TMO], 1u); break; } }
    }
    nloc = mine > 0u ? mine : 1u; nx = cnt > 0u ? cnt : 1u;
}

__device__ __forceinline__ void xcd_barrier(const XcdBarrier& b) {
    asm volatile("s_waitcnt vmcnt(0)" ::: "memory");
    __syncthreads();
    if (threadIdx.x == 0) {
        unsigned* bar = b.bar;
        __builtin_amdgcn_s_waitcnt(0);
        unsigned nloc = b.st[0], nx = b.st[1];
        if (nloc == 0u) { xcd_barrier_complete(bar, b.x, nloc, nx); b.st[0] = nloc; b.st[1] = nx; }
        const unsigned old = xb_add(&bar[XB_XSUB(b.x)], 1u);
        const unsigned gen = old / nloc;
        if (old + 1u == (gen + 1u) * nloc) {
            __builtin_amdgcn_fence(__ATOMIC_RELEASE, "agent");
            asm volatile("s_waitcnt vmcnt(0)" ::: "memory");
            const unsigned og = xb_add(&bar[XB_TOP], 1u);
            const unsigned tg = og / nx;
            if (og + 1u == (tg + 1u) * nx) xb_add(&bar[XB_TOPGEN], 1u);
            else XB_SPIN(xb_ld(&bar[XB_TOPGEN]) == tg, bar);
            __builtin_amdgcn_fence(__ATOMIC_ACQUIRE, "agent");
            xb_add(&bar[XB_XGEN(b.x)], 1u);
            asm volatile("s_waitcnt vmcnt(0)" ::: "memory");
        } else {
            XB_SPIN(xb_ld(&bar[XB_XGEN(b.x)]) == gen, bar);
            __builtin_amdgcn_fence(__ATOMIC_ACQUIRE, "agent");
            asm volatile("s_waitcnt vmcnt(0)" ::: "memory");
        }
    }
    __syncthreads();
}

__device__ __forceinline__ void phase_mod(LAS unsigned char* lds, const Inputs& in, const WS& w, int vb) {
    if (vb >= 72) return;
    LAS float* sc = (LAS float*)lds;
    int tid_ = threadIdx.x; asm volatile("" : "+v"(tid_));
    const int tid = tid_, idx = vb * 512 + tid, rg = idx / 12288, ln = idx % 12288, l = ln / 6144, n = ln % 6144;
    float acc[11];
#pragma unroll
    for (int i = 0; i < 11; ++i) acc[i] = 0.f;
    const float* wp = in.ada_w + (size_t)l * 1024 * 6144 + n;
    for (int kc = 0; kc < 4; ++kc) {
        for (int i = tid; i < 33 * 256; i += 512) { const int r = i >> 8, k = kc * 256 + (i & 255); const float v = r < 32 ? in.c[(size_t)r * 1024 + k] : in.c_ctx[k]; sc[i] = v / (1.f + __expf(-v)); }
        __syncthreads();
        for (int k = 0; k < 256; ++k) { const float wv = wp[(size_t)(kc * 256 + k) * 6144];
#pragma unroll
            for (int i = 0; i < 11; ++i) acc[i] += sc[(rg * 11 + i) * 256 + k] * wv; }
        __syncthreads();
    }
    const float bias = in.ada_b[(size_t)l * 6144 + n];
#pragma unroll
    for (int i = 0; i < 11; ++i) w.MOD()[((size_t)l * 33 + rg * 11 + i) * 6144 + n] = acc[i] + bias;
}
__device__ __forceinline__ void phase_rope(const WS& w, int vb, int nvb) {
    int tid_ = threadIdx.x; asm volatile("" : "+v"(tid_));
    for (int i = vb * 512 + tid_; i < 2048 * 32; i += nvb * 512) {
        { const int t = i / 32, j = i % 32; const double inv = pow(10000.0, -(double)(j % 16) / 16.0); const double a = (double)(j < 16 ? t / 64 : t % 64) * inv; w.ROPA()[i] = make_float2((float)cos(a), (float)sin(a)); }
        if (i < 2048 * 16) { const int t = i / 16, j = i % 16; const double inv = pow(10000.0, -(double)(j % 8) / 8.0); const double a = (double)(j < 8 ? t / 64 : t % 64) * inv; w.ROPC()[i] = make_float2((float)cos(a), (float)sin(a)); }
    }
}

#ifndef PROBE_MASK
#define PROBE_MASK 0
#endif
#ifndef BENCH_MODE
#define BENCH_MODE 0
#endif
#if BENCH_MODE
__device__ __forceinline__ void phase_bench(float* sink) {
    int tid_ = threadIdx.x; asm volatile("" : "+v"(tid_));
    float x[16];
#pragma unroll
    for (int i = 0; i < 16; ++i) x[i] = (float)(tid_ + i) * 0.001f;
    f32x16 acc[4] = {};
    bf16x8 a = (bf16x8){(short)tid_, 1, 2, 3, 4, 5, 6, 7}, b = (bf16x8){7, 6, 5, 4, 3, 2, 1, (short)tid_};
#pragma nounroll
    for (int it = 0; it < ((BENCH_MODE & 7) ? 2048 : 0); ++it) {
#pragma unroll
        for (int k = 0; k < 8; ++k) {
            if (BENCH_MODE & 2) { acc[k & 3] = mfma32(a, b, acc[k & 3]); }
            __builtin_amdgcn_sched_barrier(0);
            if (BENCH_MODE & 1) { asm volatile("v_exp_f32 %0, -|%0|" : "+v"(x[2 * k])); asm volatile("v_exp_f32 %0, -|%0|" : "+v"(x[2 * k + 1])); }
            if (BENCH_MODE & 4) {
#pragma unroll
                for (int j = 0; j < 8; ++j) asm volatile("v_fma_f32 %0, %0, %0, %0" : "+v"(x[(2 * k + j) & 15]));
            }
            __builtin_amdgcn_sched_barrier(0);
        }
    }
    if (BENCH_MODE & 24) {
        const int lane = tid_ & 63, r32 = lane & 31, hi = lane >> 5;
        unsigned ka[2][4];
#pragma unroll
        for (int kt = 0; kt < 2; ++kt)
#pragma unroll
            for (int s_ = 0; s_ < 4; ++s_) { const int key = 32 * kt + r32; ka[kt][s_] = key * 128 + (((2 * s_ + hi) ^ ((key >> 1) & 7)) << 4); }
        const int vq = (lane & 15) >> 2, vp = lane & 3, vg = (lane >> 4) & 1;
        unsigned va[2];
#pragma unroll
        for (int dvb = 0; dvb < 2; ++dvb) { const int key = 4 * hi + vq; va[dvb] = 8192 + key * 128 + ((((32 * dvb + 16 * vg + 4 * vp) * 2)) ^ (((key >> 1) & 1) << 6)); }
        u32x4 kr[8]; u32x2 vr[16];
#pragma nounroll
        for (int it = 0; it < 2048; ++it) {
            if (BENCH_MODE & 8) {
#pragma unroll
                for (int kt = 0; kt < 2; ++kt)
#pragma unroll
                    for (int s_ = 0; s_ < 4; ++s_) asm volatile("ds_read_b128 %0, %1" : "=v"(kr[kt * 4 + s_]) : "v"(ka[kt][s_]));
            }
            if (BENCH_MODE & 16) {
#pragma unroll
                for (int q = 0; q < 4; ++q)
#pragma unroll
                    for (int dvb = 0; dvb < 2; ++dvb) { asm volatile("ds_read_b64_tr_b16 %0, %1" : "=v"(vr[q * 4 + dvb * 2]) : "v"(va[dvb] + q * 2048)); asm volatile("ds_read_b64_tr_b16 %0, %1 offset:1024" : "=v"(vr[q * 4 + dvb * 2 + 1]) : "v"(va[dvb] + q * 2048)); }
            }
            asm volatile("s_waitcnt lgkmcnt(0)" ::: "memory");
        }
        if (BENCH_MODE & 8) {
#pragma unroll
            for (int i = 0; i < 8; ++i) x[i] += __uint_as_float(kr[i][0] ^ kr[i][1] ^ kr[i][2] ^ kr[i][3]);
        }
        if (BENCH_MODE & 16) {
#pragma unroll
            for (int i = 0; i < 16; ++i) x[i] += __uint_as_float(vr[i][0] ^ vr[i][1]);
        }
    }
    float r = 0.f;
#pragma unroll
    for (int i = 0; i < 16; ++i) r += x[i];
#pragma unroll
    for (int k = 0; k < 4; ++k)
#pragma unroll
        for (int i = 0; i < 16; ++i) r += acc[k][i];
    if (r == 1.2345e30f) sink[tid_] = r;
}
#endif
struct MegaArgs { Inputs in; WS w; float* XL; unsigned* bar; };
constexpr int MEGA_LDS = 131072 + 16;
__global__ void __launch_bounds__(512, 2) k_mega(MegaArgs A) {
    LAS unsigned char* lds = (LAS unsigned char*)dyn_lds;
    const int vb = blockIdx.x, nvb = gridDim.x;
    volatile LAS unsigned* xbw = (volatile LAS unsigned*)(lds + 131072);
    if (threadIdx.x == 0) { xbw[0] = 0u; xbw[1] = 0u; xbw[2] = 0u; xbw[3] = 0u; }
    __syncthreads();
    XcdBarrier bar = xcd_barrier_post(A.bar, xbw);
    if (threadIdx.x == 0) xbw[2] = xb_add(&A.bar[3584 + 64 * bar.x], 1u);
    __syncthreads();
    const int xticket = __builtin_amdgcn_readfirstlane((int)xbw[2]);
    const WS& w = A.w; const Inputs& in = A.in;
    phase_mod(lds, in, w, vb);
    phase_rope(w, vb, nvb);
    phase_cvt(lds, in, w, vb, nvb);
    xcd_barrier(bar);
    phase_modulate<false>(in.x, in.ctx, nullptr, w.H(), in.norm1_g, w.MOD(), 0, NR, vb, nvb);
    xcd_barrier(bar);
#if (PROBE_MASK >> 0) & 1
    phase_mod(lds, in, w, vb);
    phase_rope(w, vb, nvb);
    phase_cvt(lds, in, w, vb, nvb);
    xcd_barrier(bar);
    phase_modulate<false>(in.x, in.ctx, nullptr, w.H(), in.norm1_g, w.MOD(), 0, NR, vb, nvb);
    xcd_barrier(bar);
#endif
#if BENCH_MODE
    phase_bench((float*)w.RSQ());
#endif
    int xpart = vb & 7, xrank = vb >> 3;
    { bool okx = (bar.x < 8u); for (unsigned j = 0; j < 8; ++j) okx = okx && (xb_ld(&A.bar[XB_XCNT(j)]) == (unsigned)(nvb >> 3));
      if (okx) { xpart = (int)bar.x; xrank = xticket; } }
    for (int l = 0; l < DEPTH; ++l) {
        const float* MODl = w.MOD() + (size_t)l * 33 * 6144;
        const bool last = (l == DEPTH - 1);
        const int MR = last ? NL : NR;
        phase_p1(lds, w, in, l, vb, nvb); xcd_barrier(bar);
#if (PROBE_MASK >> 1) & 1
        phase_p1(lds, w, in, l, vb, nvb); xcd_barrier(bar);
#endif
        phase_p2(lds, w, in, l, vb, nvb); xcd_barrier(bar);
#if (PROBE_MASK >> 12) & 7
        phase_p2(lds, w, in, l, vb, nvb, (PROBE_MASK >> 12) & 7); xcd_barrier(bar);
#endif
        phase_p3(lds, w, l, vb, nvb, xpart, xrank); xcd_barrier(bar);
#if (PROBE_MASK >> 3) & 1
        phase_p3(lds, w, l, vb, nvb, xpart, xrank); xcd_barrier(bar);
#endif
        phase_p4(lds, w, in, l, vb, nvb);
        xcd_barrier(bar);
#if (PROBE_MASK >> 4) & 1
        phase_p4(lds, w, in, l, vb, nvb);
        xcd_barrier(bar);
#endif
        if (l == 0) phase_modulate<false>(in.x, in.ctx, nullptr, w.H(), in.norm2_g + l * 1024, MODl, 3, MR, vb, nvb, w.H8(), w.HS(), w.PQ(), w.XB());
        else phase_modulate<true>(nullptr, nullptr, w.XB(), w.H(), in.norm2_g + l * 1024, MODl, 3, MR, vb, nvb, w.H8(), w.HS(), w.PQ(), w.XB());
        xcd_barrier(bar);
#if (PROBE_MASK >> 5) & 1
        phase_modulate<true>(nullptr, nullptr, w.XB(), w.H(), in.norm2_g + l * 1024, MODl, 3, MR, vb, nvb, w.H8(), w.HS()); xcd_barrier(bar);
#endif
        phase_p6a(lds, w, l, vb, nvb); xcd_barrier(bar);
#if (PROBE_MASK >> 6) & 1
        phase_p6a(lds, w, l, vb, nvb); xcd_barrier(bar);
#endif
        phase_p6b(lds, w.PQ(), w.SubK() + (size_t)l * 16 * 128 * 128, w.EG(), MR, vb, nvb); xcd_barrier(bar);
#if (PROBE_MASK >> 7) & 1
        phase_p6b(lds, w.PQ(), w.SubK() + (size_t)l * 16 * 128 * 128, w.EG(), MR, vb, nvb); xcd_barrier(bar);
#endif
        { P7CArgs a{w.H8(), w.EG(), w.U8() + (size_t)l * NE * 1024, (int*)w.PQ(), MR}; phase_p7c(lds, a, xpart, xrank, nvb); }
        xcd_barrier(bar);
#if (PROBE_MASK >> 8) & 1
        { P7CArgs a{w.H8(), w.EG(), w.U8() + (size_t)l * NE * 1024, (int*)w.PQ(), MR}; phase_p7c(lds, a, xpart, xrank, nvb); }
        xcd_barrier(bar);
#endif
        phase_p7d((const int*)w.PQ(), w.EG(), w.US() + (size_t)l * NE, w.VS() + (size_t)l * NE, w.HS(), w.WE(), MR, vb, nvb);
        xcd_barrier(bar);
#if (PROBE_MASK >> 9) & 1
        phase_p7d((const int*)w.PQ(), w.EG(), w.US() + (size_t)l * NE, w.VS() + (size_t)l * NE, w.HS(), w.WE(), MR, vb, nvb);
        xcd_barrier(bar);
#endif
        { P7BArgs a{w.WE(), w.V8() + (size_t)l * NE * 1024, w.XB(), MODl + 5 * 1024, MR}; phase_p7b<0>(lds, a, xpart, xrank, nvb); }
        xcd_barrier(bar);
#if (PROBE_MASK >> 10) & 3
        { P7BArgs a{w.WE(), w.V8() + (size_t)l * NE * 1024, w.XB(), MODl + 5 * 1024, MR}; phase_p7b<((PROBE_MASK >> 10) & 3)>(lds, a, xpart, xrank, nvb); }
        xcd_barrier(bar);
#endif
        if (last) phase_final_norm(w.XB(), A.XL, in.final_g, vb, nvb);
        else phase_modulate<true>(nullptr, nullptr, w.XB(), w.H(), in.norm1_g + (l + 1) * 1024, w.MOD() + (size_t)(l + 1) * 33 * 6144, 0, NR, vb, nvb);
        if (!last) xcd_barrier(bar);
    }
}

extern "C" void kernel_launch(void* const* d_in, const int* in_sizes, int n_in, void* d_out, int out_size, void* d_ws, size_t ws_size, hipStream_t stream) {
    const float* const* fin = (const float* const*)d_in;
    Inputs in{fin[0], fin[1], fin[2], fin[3], fin[4], fin[5], fin[6], fin[7], fin[8], fin[9], fin[10], fin[11], fin[12], fin[13], fin[14], fin[15], fin[16], fin[17], fin[18], fin[19], fin[20], fin[21], fin[22]};
    WS w = make_ws(d_ws);
    static int ok = 0;
    if (!ok) {
        if (hipFuncSetAttribute((const void*)k_mega, hipFuncAttributeMaxDynamicSharedMemorySize, MEGA_LDS) != hipSuccess) { ok = -1; }
        int per_cu = 0, cus = 0, dev = 0; (void)hipGetDevice(&dev); (void)hipDeviceGetAttribute(&cus, hipDeviceAttributeMultiprocessorCount, dev);
        if (hipOccupancyMaxActiveBlocksPerMultiprocessor(&per_cu, (const void*)k_mega, 512, MEGA_LDS) != hipSuccess || per_cu < 1 || cus < 256) ok = -1;
        if (ok == 0) ok = 1;
    }
    if (ok < 0) return;
    (void)hipMemsetAsync(d_ws, 0, 16384, stream);
    MegaArgs A{in, w, (float*)d_out, (unsigned*)d_ws};
    k_mega<<<256, 512, MEGA_LDS, stream>>>(A);
}
```

```cpp
#include <hip/hip_runtime.h>
#include <stdint.h>

typedef unsigned short bf16_t;

constexpr int D = 1024, NB = 32, S = 2048, CTX = 256, DEPTH = 2;
constexpr int NL = NB * S, NC = NB * CTX, NR = NL + NC;
constexpr int KEYS = CTX + S;
constexpr int INC = 1568;
constexpr int NE = 16384;
constexpr float EPS = 1e-6f;

__device__ __forceinline__ float bf2f(bf16_t v) { return __uint_as_float(((unsigned)v) << 16); }
__device__ __forceinline__ bf16_t f2bf(float f) { unsigned u = __float_as_uint(f); u += 0x7FFFu + ((u >> 16) & 1u); return (bf16_t)(u >> 16); }

__device__ __forceinline__ float wave_sum(float v) {
#pragma unroll
    for (int o = 32; o > 0; o >>= 1) v += __shfl_xor(v, o);
    return v;
}
__device__ __forceinline__ float gelu_tanh(float x) {
    const float u = 0.7978845608028654f * (x + 0.044715f * x * x * x);
    return 0.5f * x * (1.f + tanhf(u));
}

struct WS {
    char* base;
    __host__ __device__ __forceinline__ bf16_t* H() const { return (bf16_t*)(base + 65536ull); }
    __host__ __device__ __forceinline__ bf16_t* Qg() const { return (bf16_t*)(base + 151060480ull); }
    __host__ __device__ __forceinline__ bf16_t* Qgc() const { return (bf16_t*)(base + 201392128ull); }
    __host__ __device__ __forceinline__ bf16_t* Kg() const { return (bf16_t*)(base + 207683584ull); }
    __host__ __device__ __forceinline__ bf16_t* Vg() const { return (bf16_t*)(base + 226557952ull); }
    __host__ __device__ __forceinline__ bf16_t* CQ() const { return (bf16_t*)(base + 245432320ull); }
    __host__ __device__ __forceinline__ bf16_t* CKV() const { return (bf16_t*)(base + 302055424ull); }
    __host__ __device__ __forceinline__ bf16_t* Bp() const { return (bf16_t*)(base + 339804160ull); }
    __host__ __device__ __forceinline__ bf16_t* KR() const { return (bf16_t*)(base + 377552896ull); }
    __host__ __device__ __forceinline__ bf16_t* Qm() const { return (bf16_t*)(base + 382271488ull); }
    __host__ __device__ __forceinline__ bf16_t* Qmc() const { return (bf16_t*)(base + 457768960ull); }
    __host__ __device__ __forceinline__ bf16_t* Kmn() const { return (bf16_t*)(base + 467206144ull); }
    __host__ __device__ __forceinline__ bf16_t* Vm() const { return (bf16_t*)(base + 523829248ull); }
    __host__ __device__ __forceinline__ unsigned* EG() const { return (unsigned*)(base + 580452352ull); }
    __host__ __device__ __forceinline__ bf16_t* P() const { return (bf16_t*)(base + 382271488ull); }
    __host__ __device__ __forceinline__ bf16_t* PQ() const { return (bf16_t*)(base + 151060480ull); }
    __host__ __device__ __forceinline__ bf16_t* TMP() const { return (bf16_t*)(base + 65536ull); }
    __host__ __device__ __forceinline__ float* XC() const { return (float*)(base + 618201088ull); }
    __host__ __device__ __forceinline__ float* MOD() const { return (float*)(base + 651755520ull); }
    __host__ __device__ __forceinline__ float2* ROPA() const { return (float2*)(base + 653377536ull); }
    __host__ __device__ __forceinline__ float2* ROPC() const { return (float2*)(base + 653901824ull); }
    __host__ __device__ __forceinline__ float* RSQ() const { return (float*)(base + 654163968ull); }
    __host__ __device__ __forceinline__ float* RSKV() const { return (float*)(base + 654458880ull); }
    __host__ __device__ __forceinline__ bf16_t* WinT() const { return (bf16_t*)(base + 654753792ull); }
    __host__ __device__ __forceinline__ bf16_t* WuqT() const { return (bf16_t*)(base + 662093824ull); }
    __host__ __device__ __forceinline__ bf16_t* WukvT() const { return (bf16_t*)(base + 663273472ull); }
    __host__ __device__ __forceinline__ bf16_t* WoutT() const { return (bf16_t*)(base + 664059904ull); }
    __host__ __device__ __forceinline__ bf16_t* WqT() const { return (bf16_t*)(base + 668254208ull); }
    __host__ __device__ __forceinline__ bf16_t* SubK() const { return (bf16_t*)(base + 676642816ull); }
    __host__ __device__ __forceinline__ unsigned char* U8() const { return (unsigned char*)(base + 677691392ull); }
    __host__ __device__ __forceinline__ unsigned char* V8() const { return (unsigned char*)(base + 711245824ull); }
    __host__ __device__ __forceinline__ float* US() const { return (float*)(base + 744800256ull); }
    __host__ __device__ __forceinline__ float* VS() const { return (float*)(base + 744931328ull); }
    __host__ __device__ __forceinline__ float* SSQ() const { return (float*)(base + 745062400ull); }
    __host__ __device__ __forceinline__ float* SSKV() const { return (float*)(base + 747421696ull); }
    __host__ __device__ __forceinline__ unsigned* WE() const { return (unsigned*)(base + 748601344ull); }
    __host__ __device__ __forceinline__ signed char* H8() const { return (signed char*)(base + 786350080ull); }
    __host__ __device__ __forceinline__ float* HS() const { return (float*)(base + 861847552ull); }
    __host__ __device__ __forceinline__ bf16_t* PoolWT() const { return (bf16_t*)(base + 862142464ull); }
    __host__ __device__ __forceinline__ bf16_t* XB() const { return (bf16_t*)(base + 862208000ull); }
};
constexpr size_t WS_BYTES = 862208000ull + (size_t)NR * 1024 * 2;
static WS make_ws(void* d_ws) { WS w; w.base = (char*)d_ws; return w; }


#define LAS __attribute__((address_space(3)))
typedef short bf16x8 __attribute__((ext_vector_type(8)));
typedef float f32x4 __attribute__((ext_vector_type(4)));
typedef float f32x16 __attribute__((ext_vector_type(16)));
typedef unsigned u32x4 __attribute__((ext_vector_type(4)));
typedef unsigned u32x2 __attribute__((ext_vector_type(2)));

__device__ __forceinline__ f32x16 mfma32(bf16x8 a, bf16x8 b, f32x16 c) { return __builtin_amdgcn_mfma_f32_32x32x16_bf16(a, b, c, 0, 0, 0); }
__device__ __forceinline__ unsigned cvt_pk_bf16(float lo, float hi) { unsigned r; asm volatile("v_cvt_pk_bf16_f32 %0, %1, %2" : "=v"(r) : "v"(lo), "v"(hi)); return r; }

namespace pg8 {
constexpr int BM = 256, BK = 64, HALF = 128, HTB = HALF * BK * 2, STAGE_BYTES = 8 * HTB, NXCD = 8, WGM = 8;
__host__ __device__ __forceinline__ int lds_byte(int r, int c) { const int st = (r >> 4) * 2 + (c >> 5), rr = r & 15, cc = c & 31, ob = rr * 64 + cc * 2; return st * 1024 + (ob ^ (((ob >> 9) & 1) << 5)); }
__host__ __device__ __forceinline__ void stage_rc(int b, int& R, int& C) { const int st = b / 1024, sb = b % 1024, swz = sb ^ (((sb >> 9) & 1) << 5); R = (st >> 1) * 16 + swz / 64; C = (st & 1) * 32 + (swz % 64) / 2; }
__host__ __device__ __forceinline__ int perm32(int rho) { const int n = rho >> 4, i = rho & 15; return 8 * (i >> 2) + 4 * n + (i & 3); }
struct Unit { int pm, pn; };
struct Gemm { const bf16_t* A; const bf16_t* Bt; int M, N, K; };
struct StaticOrder {
    int nM, nN, nwg, G, c;
    __host__ __device__ void init(int M, int N, int G_, int c_) { nM = M / BM; nN = N / BM; nwg = nM * nN; G = G_; c = c_; }
    __host__ __device__ bool next(int i, Unit& u) const {
        const long L = (long)i * G + c; if (L >= nwg) return false;
        int wgid = (int)L; { const int q = nwg / NXCD, r = nwg % NXCD, xcd = wgid % NXCD, off = wgid / NXCD; wgid = (xcd < r ? xcd * (q + 1) : r * (q + 1) + (xcd - r) * q) + off; }
        const int nig = WGM * nN, gid = wgid / nig, fm = gid * WGM, gsz = (nM - fm) < WGM ? (nM - fm) : WGM;
        u.pm = fm + ((wgid % nig) % gsz); u.pn = (wgid % nig) / gsz; return true;
    }
};
template <class Epi, class Sched>
__device__ __forceinline__ void gemm_phase(LAS unsigned char* lds, const Gemm g, const Sched& S, const Epi& E) {
    int tid_ = threadIdx.x; asm volatile("" : "+v"(tid_));
    const int tid = tid_, wid = __builtin_amdgcn_readfirstlane(tid >> 6), lane = tid & 63, wr = wid >> 2, wc = wid & 3, fr = lane & 15, fq = lane >> 4;
    const int K = g.K, nt = K / BK;
    unsigned voffA[2], voffB[2];
#pragma unroll
    for (int i = 0; i < 2; ++i) { int R, C; stage_rc(tid * 16 + i * 8192, R, C); const int Rb = Epi::PERM ? ((R & ~31) + perm32(R & 31)) : R;
        voffA[i] = (unsigned)(R * K + C) * 2u; voffB[i] = (unsigned)(Rb * K + C) * 2u; }
    const size_t kstep = (size_t)(BK * 2);
    const size_t hstep = (size_t)HALF * K * 2;
    const size_t tstep = 2 * hstep;
    const unsigned ldsw = (unsigned)wid * 1024u;
    const int aoff = lds_byte(wr * 64 + fr, fq * 8), boff = lds_byte(wc * 32 + fr, fq * 8);
#define PG8_SA(b, h) (((b) * 2 + (h)) * HTB)
#define PG8_SB(b, h) ((4 + (b) * 2 + (h)) * HTB)
#define PG8_STAGE(bufoff, gbase, voff) do { _Pragma("unroll") for (int _i = 0; _i < 2; ++_i) \
        __builtin_amdgcn_global_load_lds((const unsigned*)((const char*)(gbase) + (voff)[_i]), (LAS unsigned*)(lds + (bufoff) + ldsw + _i * 8192), 16, 0, 0); } while (0)
#define PG8_LDA(dst, b, h) do { _Pragma("unroll") for (int m = 0; m < 4; ++m) _Pragma("unroll") for (int k = 0; k < 2; ++k) dst[m][k] = *(const LAS bf16x8*)(lds + PG8_SA(b, h) + aoff + m * 2048 + k * 1024); } while (0)
#define PG8_LDB(dst, b, h) do { _Pragma("unroll") for (int n = 0; n < 2; ++n) _Pragma("unroll") for (int k = 0; k < 2; ++k) dst[n][k] = *(const LAS bf16x8*)(lds + PG8_SB(b, h) + boff + n * 2048 + k * 1024); } while (0)
#define PG8_MMA(ai, bj, At, Bt) do { __builtin_amdgcn_s_setprio(1); _Pragma("unroll") for (int m = 0; m < 4; ++m) _Pragma("unroll") for (int n = 0; n < 2; ++n) _Pragma("unroll") for (int k = 0; k < 2; ++k) \
        acc[ai][bj][m][n] = __builtin_amdgcn_mfma_f32_16x16x32_bf16(Bt[n][k], At[m][k], acc[ai][bj][m][n], 0, 0, 0); __builtin_amdgcn_s_setprio(0); } while (0)
#define PG8_WAIT_V(n) asm volatile("s_waitcnt vmcnt(" #n ")" ::: "memory")
#define PG8_WAIT_L(n) asm volatile("s_waitcnt lgkmcnt(" #n ")" ::: "memory")
#define PG8_BAR __builtin_amdgcn_s_barrier()
#define PG8_SCHED __builtin_amdgcn_sched_barrier(0)
    Unit cur, nxt; int ui = 0;
    if (!S.next(0, cur)) return;
    f32x4 acc[2][2][4][2];
#pragma unroll
    for (int a = 0; a < 2; ++a)
#pragma unroll
        for (int b = 0; b < 2; ++b)
#pragma unroll
            for (int m = 0; m < 4; ++m)
#pragma unroll
                for (int n = 0; n < 2; ++n) acc[a][b][m][n] = (f32x4){0.f, 0.f, 0.f, 0.f};
    bf16x8 At[4][2], B0[2][2], B1[2][2];
    const char* cA = (const char*)g.A + (size_t)cur.pm * tstep; const char* cB = (const char*)g.Bt + (size_t)cur.pn * tstep;
    PG8_STAGE(PG8_SB(0, 0), cB, voffB); PG8_STAGE(PG8_SA(0, 0), cA, voffA); PG8_STAGE(PG8_SB(0, 1), cB + hstep, voffB); PG8_STAGE(PG8_SA(0, 1), cA + hstep, voffA);
    if (wr == 1) PG8_BAR;
    PG8_WAIT_V(4); PG8_BAR;
    PG8_STAGE(PG8_SB(1, 0), cB + kstep, voffB); PG8_STAGE(PG8_SA(1, 0), cA + kstep, voffA); PG8_STAGE(PG8_SB(1, 1), cB + hstep + kstep, voffB);
    PG8_WAIT_V(6); PG8_BAR;
    for (;;) {
        const bool has_next = S.next(ui + 1, nxt);
        const char* nA = has_next ? (const char*)g.A + (size_t)nxt.pm * tstep : cA; const char* nB = has_next ? (const char*)g.Bt + (size_t)nxt.pn * tstep : cB;
#pragma nounroll
        for (int t = 0; t < nt; t += 2) {
            const bool last = (t == nt - 2);
            const char* a1 = cA + (size_t)(t + 1) * kstep;
            const char* a2 = last ? nA : cA + (size_t)(t + 2) * kstep; const char* b2 = last ? nB : cB + (size_t)(t + 2) * kstep;
            const char* a3 = a2 + kstep; const char* b3 = b2 + kstep;
            PG8_LDB(B0, 0, 0); PG8_SCHED; PG8_LDA(At, 0, 0); PG8_STAGE(PG8_SA(1, 1), a1 + hstep, voffA);
            PG8_WAIT_L(8); PG8_BAR; PG8_WAIT_L(0); PG8_MMA(0, 0, At, B0); PG8_BAR; PG8_SCHED;
            PG8_LDB(B1, 0, 1); PG8_STAGE(PG8_SB(0, 0), b2, voffB);
            PG8_BAR; PG8_WAIT_L(0); PG8_MMA(0, 1, At, B1); PG8_BAR;
            PG8_LDA(At, 0, 1); PG8_STAGE(PG8_SA(0, 0), a2, voffA);
            PG8_BAR; PG8_WAIT_L(0); PG8_MMA(1, 0, At, B0); PG8_BAR; PG8_SCHED;
            PG8_STAGE(PG8_SB(0, 1), b2 + hstep, voffB);
            PG8_WAIT_V(6); PG8_BAR; PG8_MMA(1, 1, At, B1); PG8_BAR;
            PG8_LDB(B0, 1, 0); PG8_SCHED; PG8_LDA(At, 1, 0); PG8_STAGE(PG8_SA(0, 1), a2 + hstep, voffA);
            PG8_WAIT_L(8); PG8_BAR; PG8_WAIT_L(0); PG8_MMA(0, 0, At, B0); PG8_BAR; PG8_SCHED;
            PG8_LDB(B1, 1, 1); PG8_STAGE(PG8_SB(1, 0), b3, voffB);
            PG8_BAR; PG8_WAIT_L(0); PG8_MMA(0, 1, At, B1); PG8_BAR;
            PG8_LDA(At, 1, 1); PG8_STAGE(PG8_SA(1, 0), a3, voffA);
            PG8_BAR; PG8_WAIT_L(0); PG8_MMA(1, 0, At, B0); PG8_BAR; PG8_SCHED;
            PG8_STAGE(PG8_SB(1, 1), b3 + hstep, voffB);
            PG8_WAIT_V(6); PG8_BAR; PG8_MMA(1, 1, At, B1); PG8_BAR;
        }
        E(acc, cur, wr, wc, fr, fq);
        if (!has_next) break;
#pragma unroll
        for (int a = 0; a < 2; ++a)
#pragma unroll
            for (int b = 0; b < 2; ++b)
#pragma unroll
                for (int m = 0; m < 4; ++m)
#pragma unroll
                    for (int n = 0; n < 2; ++n) acc[a][b][m][n] = (f32x4){0.f, 0.f, 0.f, 0.f};
        cur = nxt; cA = nA; cB = nB; ++ui;
    }
    PG8_WAIT_V(0);
    if (wr == 0) PG8_BAR;
    PG8_BAR;
#undef PG8_SA
#undef PG8_SB
#undef PG8_STAGE
#undef PG8_LDA
#undef PG8_LDB
#undef PG8_MMA
#undef PG8_WAIT_V
#undef PG8_WAIT_L
#undef PG8_BAR
#undef PG8_SCHED
}
}

enum { GT_AQ = 0, GT_AK = 1, GT_AV = 2, GT_B = 3, GT_CQ = 4, GT_CKV = 5, GT_KR = 6, GT_PAD = 7 };
__host__ __device__ __forceinline__ void in_group(int g, int& type, int& sub) {
    if (g < 2) { type = GT_AK; sub = g; } else if (g < 4) { type = GT_AV; sub = g - 2; } else if (g < 8) { type = GT_CKV; sub = g - 4; }
    else if (g == 8) { type = GT_KR; sub = 0; } else if (g < 12) { type = GT_PAD; sub = 0; } else if (g < 18) { type = GT_AQ; sub = g - 12; }
    else if (g < 24) { type = GT_CQ; sub = g - 18; } else { type = GT_B; sub = g - 24; }
}
__device__ __forceinline__ int colmap(int mode, int r) {
    const int pn = r >> 8, ct = r & 255, bj = ct >> 7, wc = (ct >> 5) & 3, j = ct & 31, g = 4 * pn + wc, e = 32 * bj + j;
    if (mode == 0) {
        int type, sub; in_group(g, type, sub);
        switch (type) { case GT_AQ: return 64 * sub + e; case GT_AK: return 384 + 64 * sub + e; case GT_AV: return 512 + 64 * sub + e; case GT_B: return 640 + 64 * sub + e;
            case GT_CQ: return 896 + 64 * sub + e; case GT_CKV: return 1280 + 64 * sub + e; case GT_KR: return (j < 16) ? 1536 + 16 * bj + j : -1; default: return -1; }
    } else if (mode == 1) {
        if (g < 6) return 96 * g + e; if (g < 9) { const int head = 2 * (g - 6) + (j >> 4); return 96 * head + 64 + 16 * bj + (j & 15); } return -1;
    } else if (mode == 2) {
        return 64 * g + e;
    }
    return r;
}
__device__ __forceinline__ void cvt_weights_unit(LAS float* tile  , const float* __restrict__ W, int K, int N, bf16_t* __restrict__ dst, int mode, const float* __restrict__ kgain, int r0, int k0) {
    int tid_ = threadIdx.x; asm volatile("" : "+v"(tid_));
    const int tid = tid_;
    const int jj = tid & 63; const int sc = colmap(mode, r0 + jj);
#pragma unroll
    for (int i = 0; i < 8; ++i) { const int kk = (tid >> 6) + 8 * i; float v = 0.f; if (sc >= 0) v = W[(size_t)(k0 + kk) * N + sc]; if (kgain) v *= kgain[k0 + kk]; tile[kk * 65 + jj] = v; }
    __syncthreads();
#pragma unroll
    for (int i = 0; i < 8; ++i) { const int rr = (tid >> 6) + 8 * i, kk = tid & 63; dst[(size_t)(r0 + rr) * K + k0 + kk] = f2bf(tile[kk * 65 + rr]); }
    __syncthreads();
}
struct CvtJob { const float* W; bf16_t* dst; const float* kgain; int K, N, Npad, mode; };
__device__ __forceinline__ void cvt_job(LAS float* tile, const CvtJob j, int vb, int nvb) {
    const int nk = j.K / 64, nr = j.Npad / 64;
    for (int u = vb; u < nk * nr; u += nvb) cvt_weights_unit(tile, j.W, j.K, j.N, j.dst, j.mode, j.kgain, (u / nk) * 64, (u % nk) * 64);
}
__device__ __forceinline__ void cvt_flat(const float* __restrict__ src, bf16_t* __restrict__ dst, size_t n, int vb, int nvb) {
    int tid_ = threadIdx.x; asm volatile("" : "+v"(tid_));
    for (size_t i = ((size_t)vb * 512 + tid_) * 8; i < n; i += (size_t)nvb * 512 * 8) {
        const float4 a = *(const float4*)(src + i), b = *(const float4*)(src + i + 4);
        u32x4 o; o.x = cvt_pk_bf16(a.x, a.y); o.y = cvt_pk_bf16(a.z, a.w); o.z = cvt_pk_bf16(b.x, b.y); o.w = cvt_pk_bf16(b.z, b.w);
        *(u32x4*)(dst + i) = o;
    }
}
template <bool FP8>
__device__ __forceinline__ void cvt_q8_rows(const float* __restrict__ src, unsigned char* __restrict__ dst, float* __restrict__ scales, int nrows, int vb, int nvb) {
    int tid_ = threadIdx.x; asm volatile("" : "+v"(tid_));
    const int lane = tid_ & 63, wid = tid_ >> 6;
    const int stride = nvb * 8;
    for (int row0 = vb * 8 + wid; row0 < nrows; row0 += 4 * stride) {
        f32x4 v[4][4];
#pragma unroll
        for (int q = 0; q < 4; ++q) { const int row = row0 + q * stride < nrows ? row0 + q * stride : row0; const float* sp = src + (size_t)row * 1024 + 16 * lane;
#pragma unroll
            for (int k = 0; k < 4; ++k) v[q][k] = *(const f32x4*)(sp + 4 * k); }
#pragma unroll
        for (int q = 0; q < 4; ++q) { const int row = row0 + q * stride; if (row < nrows) {
            float am = 0.f;
#pragma unroll
            for (int k = 0; k < 4; ++k) am = fmaxf(am, fmaxf(fmaxf(fabsf(v[q][k][0]), fabsf(v[q][k][1])), fmaxf(fabsf(v[q][k][2]), fabsf(v[q][k][3]))));
#pragma unroll
            for (int o = 32; o > 0; o >>= 1) am = fmaxf(am, __shfl_xor(am, o));
            const float qmax = FP8 ? 416.f : 127.f;
            const float sc = am > 0.f ? am / qmax : 1.f, inv = am > 0.f ? qmax / am : 0.f;
            u32x4 o4;
#pragma unroll
            for (int k = 0; k < 4; ++k) {
                if (FP8) { int p = __builtin_amdgcn_cvt_pk_fp8_f32(v[q][k][0] * inv, v[q][k][1] * inv, 0, false); p = __builtin_amdgcn_cvt_pk_fp8_f32(v[q][k][2] * inv, v[q][k][3] * inv, p, true); o4[k] = (unsigned)p; }
                else { const int q0 = (int)rintf(v[q][k][0] * inv), q1 = (int)rintf(v[q][k][1] * inv), q2 = (int)rintf(v[q][k][2] * inv), q3 = (int)rintf(v[q][k][3] * inv);
                    o4[k] = (unsigned)(q0 & 0xff) | ((unsigned)(q1 & 0xff) << 8) | ((unsigned)(q2 & 0xff) << 16) | ((unsigned)(q3 & 0xff) << 24); } }
            *(u32x4*)(dst + (size_t)row * 1024 + 16 * lane) = o4;
            if (lane == 0) scales[row] = sc; } }
    }
}
struct Inputs {
    const float *x, *c, *ctx, *c_ctx, *ada_w, *ada_b, *norm1_g, *norm2_g, *w_in, *gqa_qn_g, *gqa_kn_g, *pool_w, *pool_scale, *mla_qn_g, *mla_kvn_g, *mla_w_uq, *mla_w_ukv, *w_out, *peer_wq, *peer_subkeys, *peer_u, *peer_v, *final_g;
};
__device__ __forceinline__ void phase_cvt(LAS unsigned char* lds, const Inputs& in, const WS& w, int vb, int nvb) {
    LAS float* tile = (LAS float*)lds;
    for (int l = 0; l < 2; ++l) {
        cvt_job(tile, CvtJob{in.w_in + (size_t)l * 1024 * INC, w.WinT() + (size_t)l * 1792 * 1024, nullptr, 1024, INC, 1792, 0}, vb, nvb);
        cvt_job(tile, CvtJob{in.mla_w_uq + (size_t)l * 384 * 576, w.WuqT() + (size_t)l * 768 * 384, in.mla_qn_g + l * 384, 384, 576, 768, 1}, vb, nvb);
        cvt_job(tile, CvtJob{in.mla_w_ukv + (size_t)l * 256 * 768, w.WukvT() + (size_t)l * 768 * 256, in.mla_kvn_g + l * 256, 256, 768, 768, 2}, vb, nvb);
        cvt_job(tile, CvtJob{in.w_out + (size_t)l * 1024 * 1024, w.WoutT() + (size_t)l * 1024 * 1024, nullptr, 1024, 1024, 1024, 3}, vb, nvb);
        cvt_job(tile, CvtJob{in.peer_wq + (size_t)l * 1024 * 2048, w.WqT() + (size_t)l * 2048 * 1024, nullptr, 1024, 2048, 2048, 3}, vb, nvb);
    }
    cvt_flat(in.peer_subkeys, w.SubK(), (size_t)2 * 16 * 128 * 128, vb, nvb);
    { int tp_ = threadIdx.x; asm volatile("" : "+v"(tp_));
      for (int i = vb * 512 + tp_; i < 2 * 4 * 64 * 64; i += nvb * 512) { const int c = i & 63, d = (i >> 6) & 63, lg = i >> 12; w.PoolWT()[i] = f2bf(in.pool_w[(size_t)lg * 4096 + c * 64 + d]); } }
    if (nvb > 144) { if (vb >= 72) { cvt_q8_rows<false>(in.peer_u, w.U8(), w.US(), 2 * NE, vb - 72, nvb - 72); cvt_q8_rows<true>(in.peer_v, w.V8(), w.VS(), 2 * NE, vb - 72, nvb - 72); } }
    else { cvt_q8_rows<false>(in.peer_u, w.U8(), w.US(), 2 * NE, vb, nvb); cvt_q8_rows<true>(in.peer_v, w.V8(), w.VS(), 2 * NE, vb, nvb); }
}

constexpr float ATT_C2G = 0.125f * 1.4426950408889634f, ATT_C2M = 0.10206207261596577f * 1.4426950408889634f;
struct EpiIn {
    static constexpr bool PERM = true;
    WS w; const float* qn_g; const float* kn_g; int pm_base;
    __device__ __forceinline__ void operator()(const f32x4 (&acc)[2][2][4][2], const pg8::Unit& u, int wr, int wc, int fr, int fq) const {
        int type, sub; in_group(4 * u.pn + wc, type, sub);
        if (type == GT_PAD) return;
        const int pm = u.pm + pm_base; const bool isctx = pm >= 256; const int b = isctx ? pm - 256 : pm >> 3; const int t0 = isctx ? 0 : (pm & 7) * 256;
        const size_t rowbase = isctx ? (size_t)NL + (size_t)b * CTX : (size_t)b * S;
        const int keyoff = isctx ? 0 : CTX;
        float gain[2][8];
        if (type == GT_AQ) {
#pragma unroll
            for (int bj = 0; bj < 2; ++bj)
#pragma unroll
                for (int q = 0; q < 8; ++q) gain[bj][q] = qn_g[32 * bj + 8 * fq + q] * ATT_C2G;
        } else if (type == GT_AK) {
#pragma unroll
            for (int bj = 0; bj < 2; ++bj)
#pragma unroll
                for (int q = 0; q < 8; ++q) gain[bj][q] = kn_g[32 * bj + 8 * fq + q];
        }
#pragma unroll
        for (int ai = 0; ai < 2; ++ai)
#pragma unroll
            for (int m = 0; m < 4; ++m) {
                const int t = t0 + 128 * ai + 64 * wr + 16 * m + fr; const size_t row = rowbase + t;
                float v[2][8];
#pragma unroll
                for (int bj = 0; bj < 2; ++bj)
#pragma unroll
                    for (int n = 0; n < 2; ++n)
#pragma unroll
                        for (int i = 0; i < 4; ++i) v[bj][4 * n + i] = acc[ai][bj][m][n][i];
                bf16_t* dst = nullptr;
                if (type == GT_AQ || type == GT_AK) {
                    float ss = 0.f;
#pragma unroll
                    for (int bj = 0; bj < 2; ++bj)
#pragma unroll
                        for (int q = 0; q < 8; ++q) ss += v[bj][q] * v[bj][q];
                    ss += __shfl_xor(ss, 16); ss += __shfl_xor(ss, 32);
                    const float rstd = rsqrtf(ss * (1.f / 64.f) + EPS);
#pragma unroll
                    for (int q = 0; q < 8; ++q) { float x1 = v[0][q] * rstd * gain[0][q], x2 = v[1][q] * rstd * gain[1][q];
                        if (!isctx) { const float2 cs = w.ROPA()[t * 32 + 8 * fq + q]; const float y1 = x1 * cs.x - x2 * cs.y, y2 = x1 * cs.y + x2 * cs.x; x1 = y1; x2 = y2; }
                        v[0][q] = x1; v[1][q] = x2; }
                    if (type == GT_AQ) dst = isctx ? w.Qgc() + (((size_t)b * 6 + sub) * CTX + t) * 64 : w.Qg() + (((size_t)b * 6 + sub) * S + t) * 64;
                    else dst = w.Kg() + (((size_t)b * 2 + sub) * KEYS + keyoff + t) * 64;
                } else if (type == GT_AV) { dst = w.Vg() + (((size_t)b * 2 + sub) * KEYS + keyoff + t) * 64;
                } else if (type == GT_B) { dst = w.Bp() + row * 256 + 64 * sub;
                } else if (type == GT_CQ || type == GT_CKV) {
                    float ss = 0.f;
#pragma unroll
                    for (int bj = 0; bj < 2; ++bj)
#pragma unroll
                        for (int q = 0; q < 8; ++q) ss += v[bj][q] * v[bj][q];
                    ss += __shfl_xor(ss, 16); ss += __shfl_xor(ss, 32);
                    if (type == GT_CQ) { if (fq == 0) w.SSQ()[row * 8 + sub] = ss; dst = w.CQ() + row * 384 + 64 * sub; }
                    else { if (fq == 0) w.SSKV()[row * 4 + sub] = ss; dst = w.CKV() + row * 256 + 64 * sub; }
                } else {
                    if (!isctx) {
#pragma unroll
                        for (int q = 0; q < 8; ++q) { const float2 cs = w.ROPC()[t * 16 + ((8 * fq + q) & 15)]; const float x1 = v[0][q], x2 = v[1][q]; v[0][q] = x1 * cs.x - x2 * cs.y; v[1][q] = x1 * cs.y + x2 * cs.x; } }
                    if (fq < 2) { bf16_t* kd = w.KR() + ((size_t)b * KEYS + keyoff + t) * 32;
#pragma unroll
                        for (int bj = 0; bj < 2; ++bj) { u32x4 o; o.x = cvt_pk_bf16(v[bj][0], v[bj][1]); o.y = cvt_pk_bf16(v[bj][2], v[bj][3]); o.z = cvt_pk_bf16(v[bj][4], v[bj][5]); o.w = cvt_pk_bf16(v[bj][6], v[bj][7]);
                            *(u32x4*)(kd + 16 * bj + 8 * fq) = o; } }
                    continue;
                }
#pragma unroll
                for (int bj = 0; bj < 2; ++bj) { u32x4 o; o.x = cvt_pk_bf16(v[bj][0], v[bj][1]); o.y = cvt_pk_bf16(v[bj][2], v[bj][3]); o.z = cvt_pk_bf16(v[bj][4], v[bj][5]); o.w = cvt_pk_bf16(v[bj][6], v[bj][7]);
                    *(u32x4*)(dst + 32 * bj + 8 * fq) = o; }
            }
    }
};
struct P1Order {
    pg8::StaticOrder so; int nctx_tiles, G, c;
    __device__ bool next(int i, pg8::Unit& u) const {
        const int L = i * G + c;
        if (L < 1792) return so.next(i, u);
        const int Lc = L - 1792; if (Lc >= 32 * nctx_tiles) return false;
        u.pm = 256 + (Lc & 31); u.pn = Lc >> 5; return true;
    }
};
__device__ __forceinline__ void phase_p1(LAS unsigned char* lds, const WS& w, const Inputs& in, int l, int vb, int nvb) {
    EpiIn E{w, in.gqa_qn_g + l * 64, in.gqa_kn_g + l * 64, 0};
    P1Order po; po.so.init(NL, 1792, nvb, vb); po.nctx_tiles = (l == 0) ? 7 : 3; po.G = nvb; po.c = vb;
    pg8::gemm_phase(lds, pg8::Gemm{w.H(), w.WinT() + (size_t)l * 1792 * 1024, NR, 1792, 1024}, po, E);
}

extern __shared__ __attribute__((aligned(16))) unsigned char dyn_lds[];

struct EpiUq {
    static constexpr bool PERM = true;
    WS w;
    __device__ __forceinline__ void operator()(const f32x4 (&acc)[2][2][4][2], const pg8::Unit& u, int wr, int wc, int fr, int fq) const {
        const int g = 4 * u.pn + wc; if (g >= 9) return;
        const int pm = u.pm; const bool isctx = pm >= 256; const int b = isctx ? pm - 256 : pm >> 3; const int t0 = isctx ? 0 : (pm & 7) * 256;
        const size_t rowbase = isctx ? (size_t)NL + (size_t)b * CTX : (size_t)b * S;
        const int head = g < 6 ? g : 2 * (g - 6) + (fq >> 1);
#pragma unroll
        for (int ai = 0; ai < 2; ++ai)
#pragma unroll
            for (int m = 0; m < 4; ++m) {
                const int t = t0 + 128 * ai + 64 * wr + 16 * m + fr; const size_t row = rowbase + t;
                const float4 s0 = *(const float4*)(w.SSQ() + row * 8), s1 = *(const float4*)(w.SSQ() + row * 8 + 4);
                const float rstd = rsqrtf((s0.x + s0.y + s0.z + s0.w + s1.x + s1.y) * (1.f / 384.f) + EPS) * ATT_C2M;
                float v[2][8];
#pragma unroll
                for (int bj = 0; bj < 2; ++bj)
#pragma unroll
                    for (int n = 0; n < 2; ++n)
#pragma unroll
                        for (int i = 0; i < 4; ++i) v[bj][4 * n + i] = acc[ai][bj][m][n][i] * rstd;
                bf16_t* hd = isctx ? w.Qmc() + (((size_t)b * 6 + head) * CTX + t) * 96 : w.Qm() + (((size_t)b * 6 + head) * S + t) * 96;
                if (g >= 6 && !isctx) {
#pragma unroll
                    for (int q = 0; q < 8; ++q) { const float2 cs = w.ROPC()[t * 16 + 8 * (fq & 1) + q]; const float x1 = v[0][q], x2 = v[1][q]; v[0][q] = x1 * cs.x - x2 * cs.y; v[1][q] = x1 * cs.y + x2 * cs.x; } }
#pragma unroll
                for (int bj = 0; bj < 2; ++bj) { u32x4 o; o.x = cvt_pk_bf16(v[bj][0], v[bj][1]); o.y = cvt_pk_bf16(v[bj][2], v[bj][3]); o.z = cvt_pk_bf16(v[bj][4], v[bj][5]); o.w = cvt_pk_bf16(v[bj][6], v[bj][7]);
                    bf16_t* d = g < 6 ? hd + 32 * bj + 8 * fq : hd + 64 + 16 * bj + 8 * (fq & 1);
                    *(u32x4*)d = o; }
            }
    }
};
struct EpiUkv {
    static constexpr bool PERM = true;
    WS w;
    __device__ __forceinline__ void operator()(const f32x4 (&acc)[2][2][4][2], const pg8::Unit& u, int wr, int wc, int fr, int fq) const {
        const int g = 4 * u.pn + wc;
        const int pm = u.pm; const bool isctx = pm >= 256; const int b = isctx ? pm - 256 : pm >> 3; const int t0 = isctx ? 0 : (pm & 7) * 256;
        const size_t rowbase = isctx ? (size_t)NL + (size_t)b * CTX : (size_t)b * S; const int keyoff = isctx ? 0 : CTX;
        bf16_t* base = ((g & 1) ? w.Vm() : w.Kmn()) + ((size_t)b * 6 + (g >> 1)) * KEYS * 64;
#pragma unroll
        for (int ai = 0; ai < 2; ++ai)
#pragma unroll
            for (int m = 0; m < 4; ++m) {
                const int t = t0 + 128 * ai + 64 * wr + 16 * m + fr; const size_t row = rowbase + t;
                const float4 s0 = *(const float4*)(w.SSKV() + row * 4);
                const float rstd = rsqrtf((s0.x + s0.y + s0.z + s0.w) * (1.f / 256.f) + EPS);
                bf16_t* d = base + (size_t)(keyoff + t) * 64;
#pragma unroll
                for (int bj = 0; bj < 2; ++bj) { const f32x4 a0 = acc[ai][bj][m][0] * rstd, a1 = acc[ai][bj][m][1] * rstd;
                    u32x4 o; o.x = cvt_pk_bf16(a0[0], a0[1]); o.y = cvt_pk_bf16(a0[2], a0[3]); o.z = cvt_pk_bf16(a1[0], a1[1]); o.w = cvt_pk_bf16(a1[2], a1[3]);
                    *(u32x4*)(d + 32 * bj + 8 * fq) = o; }
            }
    }
};
constexpr int POOL_X = 0, POOL_P = 272 * 128, POOL_BYTES = 272 * 128 + 256 * 128;
template <int G>
__device__ __forceinline__ void pool_sums(LAS unsigned char* lds, int tid, int t0, int L) {
    constexpr int wdw = 2 << G, half = wdw >> 1, NX = 32 + wdw - 1;
    const int c = tid & 63, seg = tid >> 6; const LAS bf16_t* X = (const LAS bf16_t*)(lds + POOL_X) + c + (seg * 32 + 8 - half) * 64;
    const int tb = t0 + seg * 32;
    float xr[NX], xm[NX];
#pragma unroll
    for (int j = 0; j < NX; ++j) xr[j] = bf2f(X[j * 64]);
#pragma unroll
    for (int j = 0; j < NX; ++j) { const int row = tb - half + j; xm[j] = (row >= 0 && row < L) ? xr[j] : 0.f; }
    float sum = 0.f;
#pragma unroll
    for (int j = 0; j < wdw; ++j) sum += xm[j];
#pragma unroll
    for (int k = 0; k < 32; ++k) {
        const int t = tb + k; const int clo = (t - half) < 0 ? 0 : (t - half), chi = (t - half + wdw) > L ? L : (t - half + wdw);
        const float pv = sum / (float)(chi - clo) - xr[k + half];
        const int r = seg * 32 + k; *((LAS bf16_t*)(lds + POOL_P + r * 128 + (((c >> 3) ^ ((r >> 1) & 7)) << 4)) + (c & 7)) = f2bf(pv);
        if (k < 31) sum += xm[k + wdw] - xm[k];
    }
}
__device__ __forceinline__ void phase_pool(LAS unsigned char* lds, const WS& w, bf16_t* __restrict__ MIX, const bf16_t* __restrict__ WT  , const float* __restrict__ pool_scale, int nrows, int vb, int nvb) {
    int tid_ = threadIdx.x; asm volatile("" : "+v"(tid_));
    const int tid = tid_, lane = tid & 63, wid = __builtin_amdgcn_readfirstlane(tid >> 6), r32 = lane & 31, hi = lane >> 5;
    const int nunits = nrows >> 8;
    const int nmine = vb < nunits ? ((nunits - 1 - vb) / nvb + 1) * 4 : 0;
    u32x4 st[5];
#define POOL_FETCH(it_) do { const int u_ = vb + ((it_) >> 2) * nvb, g_ = (it_) & 3; const int row0_ = u_ << 8; const bool ic_ = row0_ >= NL; const int L_ = ic_ ? CTX : S; const int t0_ = ic_ ? 0 : (row0_ & (S - 1)); const int seq0_ = row0_ - t0_; \
        _Pragma("unroll") for (int k_ = 0; k_ < 5; ++k_) { int i_ = tid + 512 * k_; i_ = i_ < 272 * 8 ? i_ : 272 * 8 - 1; const int rr_ = i_ >> 3, ch_ = i_ & 7; int t_ = t0_ - 8 + rr_; t_ = t_ < 0 ? 0 : (t_ >= L_ ? L_ - 1 : t_); \
            st[k_] = *(const u32x4*)(w.Bp() + (size_t)(seq0_ + t_) * 256 + g_ * 64 + ch_ * 8); } } while (0)
    if (nmine > 0) POOL_FETCH(0);
    for (int it = 0; it < nmine; ++it) {
        const int u = vb + (it >> 2) * nvb, g = it & 3;
        const int row0 = u << 8; const bool isctx = row0 >= NL; const int L = isctx ? CTX : S; const int t0 = isctx ? 0 : (row0 & (S - 1));
        {
#pragma unroll
            for (int k = 0; k < 5; ++k) { const int i = tid + 512 * k; if (i < 272 * 8) *(LAS u32x4*)(lds + POOL_X + (i >> 3) * 128 + (i & 7) * 16) = st[k]; }
            { const int nx = it + 1 < nmine ? it + 1 : it; POOL_FETCH(nx); }
            __syncthreads();
            if (g == 0) pool_sums<0>(lds, tid, t0, L); else if (g == 1) pool_sums<1>(lds, tid, t0, L); else if (g == 2) pool_sums<2>(lds, tid, t0, L); else pool_sums<3>(lds, tid, t0, L);
            __syncthreads();
            { f32x16 o0 = {}, o1 = {};
              const bf16_t* wt = WT + (size_t)g * 4096 + (size_t)r32 * 64 + 8 * hi;
#pragma unroll
              for (int s = 0; s < 4; ++s) { const int row = wid * 32 + r32; const bf16x8 pf = *(const LAS bf16x8*)(lds + POOL_P + row * 128 + (((2 * s + hi) ^ ((row >> 1) & 7)) << 4));
                  o0 = mfma32(*(const bf16x8*)(wt + 16 * s), pf, o0); o1 = mfma32(*(const bf16x8*)(wt + 32 * 64 + 16 * s), pf, o1); }
              bf16_t* op = MIX + (size_t)(row0 + wid * 32 + r32) * 1024 + 384 + g * 64 + 4 * hi; const float* ps = pool_scale + g * 64 + 4 * hi;
#pragma unroll
              for (int q = 0; q < 4; ++q) { const f32x4 s0 = *(const f32x4*)(ps + 8 * q), s1 = *(const f32x4*)(ps + 32 + 8 * q); u32x2 a, b;
                  a.x = cvt_pk_bf16(o0[4 * q] * s0[0], o0[4 * q + 1] * s0[1]); a.y = cvt_pk_bf16(o0[4 * q + 2] * s0[2], o0[4 * q + 3] * s0[3]);
                  b.x = cvt_pk_bf16(o1[4 * q] * s1[0], o1[4 * q + 1] * s1[1]); b.y = cvt_pk_bf16(o1[4 * q + 2] * s1[2], o1[4 * q + 3] * s1[3]);
                  *(u32x2*)(op + 8 * q) = a; *(u32x2*)(op + 32 + 8 * q) = b; } }
            __syncthreads();
        }
    }
#undef POOL_FETCH
}
__device__ __forceinline__ void phase_p2(LAS unsigned char* lds, const WS& w, const Inputs& in, int l, int vb, int nvb, int parts = 7) {
    pg8::StaticOrder so;
    if (parts & 1) { EpiUq E{w}; const int M = l == 0 ? NR : NL; so.init(M, 768, nvb, vb); pg8::gemm_phase(lds, pg8::Gemm{w.CQ(), w.WuqT() + (size_t)l * 768 * 384, M, 768, 384}, so, E); }
    if (parts & 2) { EpiUkv E{w}; so.init(NR, 768, nvb, vb); pg8::gemm_phase(lds, pg8::Gemm{w.CKV(), w.WukvT() + (size_t)l * 768 * 256, NR, 768, 256}, so, E); }
    if (parts & 4) phase_pool(lds, w, w.H(), w.PoolWT() + (size_t)l * 4 * 64 * 64, in.pool_scale + l * 256, l == 0 ? NR : NL, vb, nvb);
}

struct EpiOut {
    static constexpr bool PERM = true;
    bf16_t* DLT; const float* gate;
    __device__ __forceinline__ void operator()(const f32x4 (&acc)[2][2][4][2], const pg8::Unit& u, int wr, int wc, int fr, int fq) const {
        const int pm = u.pm; const int mr = pm >= 256 ? 32 : pm >> 3;
        const size_t r0 = (size_t)pm * 256 + wr * 64 + fr; const int col0 = u.pn * 256 + wc * 32 + 8 * fq;
        f32x4 gv[2][2];
#pragma unroll
        for (int bj = 0; bj < 2; ++bj)
#pragma unroll
            for (int n = 0; n < 2; ++n) gv[bj][n] = *(const f32x4*)(gate + (size_t)mr * 6144 + col0 + bj * 128 + 4 * n);
#pragma unroll
        for (int ai = 0; ai < 2; ++ai)
#pragma unroll
            for (int m = 0; m < 4; ++m) { bf16_t* d = DLT + (r0 + ai * 128 + m * 16) * 1024 + col0;
#pragma unroll
                for (int bj = 0; bj < 2; ++bj) { const f32x4 a0 = acc[ai][bj][m][0] * gv[bj][0], a1 = acc[ai][bj][m][1] * gv[bj][1];
                    u32x4 o; o.x = cvt_pk_bf16(a0[0], a0[1]); o.y = cvt_pk_bf16(a0[2], a0[3]); o.z = cvt_pk_bf16(a1[0], a1[1]); o.w = cvt_pk_bf16(a1[2], a1[3]);
                    *(u32x4*)(d + bj * 128) = o; } }
    }
};
__device__ __forceinline__ void phase_p4(LAS unsigned char* lds, const WS& w, const Inputs& in, int l, int vb, int nvb) {
    const float* MODl = w.MOD() + (size_t)l * 33 * 6144;
    EpiOut E{w.PQ(), MODl + 2 * 1024};
    const int M = l == 0 ? NR : NL;
    pg8::StaticOrder so; so.init(M, 1024, nvb, vb);
    pg8::gemm_phase(lds, pg8::Gemm{w.H(), w.WoutT() + (size_t)l * 1024 * 1024, M, 1024, 1024}, so, E);
}

template <bool INBF>
__device__ __forceinline__ void phase_modulate(const float* __restrict__ XLp, const float* __restrict__ XCp, const bf16_t* __restrict__ XBp, bf16_t* __restrict__ Hout, const float* __restrict__ g, const float* __restrict__ MODl, int si, int nrows, int vb, int nvb,
                                               signed char* __restrict__ H8 = nullptr, float* __restrict__ HS = nullptr, const bf16_t* __restrict__ DLT = nullptr, bf16_t* __restrict__ XBo = nullptr) {
    int tid_ = threadIdx.x; asm volatile("" : "+v"(tid_));
    const int tid = tid_, lane = tid & 63, wid = tid >> 6;
    f32x4 gv[4];
#pragma unroll
    for (int i = 0; i < 4; ++i) gv[i] = *(const f32x4*)(g + 256 * i + 4 * lane);
    const int stride = nvb * 8, lastrow = nrows - 1;
    f32x4 nx[4]; u32x2 nxb[4], ndr[4];
#define PM_LOAD(r_) do { const int rr_ = (r_) < nrows ? (r_) : lastrow; const bool ic_ = rr_ >= NL; const float* xp_ = ic_ ? XCp + (size_t)(rr_ - NL) * 1024 : XLp + (size_t)rr_ * 1024; \
        _Pragma("unroll") for (int i = 0; i < 4; ++i) { if (INBF) nxb[i] = *(const u32x2*)(XBp + (size_t)rr_ * 1024 + 256 * i + 4 * lane); else nx[i] = *(const f32x4*)(xp_ + 256 * i + 4 * lane); \
            if (DLT) ndr[i] = *(const u32x2*)(DLT + (size_t)rr_ * 1024 + 256 * i + 4 * lane); } } while (0)
    PM_LOAD(vb * 8 + wid);
    for (int row = vb * 8 + wid; row < nrows; row += stride) {
        const bool isctx = row >= NL; const int mr = isctx ? 32 : row / S;
        f32x4 x[4]; u32x2 dr4[4]; float ss = 0.f;
#pragma unroll
        for (int i = 0; i < 4; ++i) { if (INBF) x[i] = (f32x4){__uint_as_float(nxb[i].x << 16), __uint_as_float(nxb[i].x & 0xffff0000u), __uint_as_float(nxb[i].y << 16), __uint_as_float(nxb[i].y & 0xffff0000u)}; else x[i] = nx[i];
            if (DLT) dr4[i] = ndr[i]; }
        PM_LOAD(row + stride);
#pragma unroll
        for (int i = 0; i < 4; ++i) {
            if (DLT) { const u32x2 dr = dr4[i];
                x[i][0] += __uint_as_float(dr.x << 16); x[i][1] += __uint_as_float(dr.x & 0xffff0000u); x[i][2] += __uint_as_float(dr.y << 16); x[i][3] += __uint_as_float(dr.y & 0xffff0000u);
                u32x2 xo; xo.x = cvt_pk_bf16(x[i][0], x[i][1]); xo.y = cvt_pk_bf16(x[i][2], x[i][3]); *(u32x2*)(XBo + (size_t)row * 1024 + 256 * i + 4 * lane) = xo; }
            ss += x[i][0] * x[i][0] + x[i][1] * x[i][1] + x[i][2] * x[i][2] + x[i][3] * x[i][3]; }
        ss = wave_sum(ss); const float rstd = rsqrtf(ss * (1.f / 1024.f) + EPS);
        const float* sh = MODl + (size_t)mr * 6144 + si * 1024;
        f32x4 y[4]; float am = 0.f;
#pragma unroll
        for (int i = 0; i < 4; ++i) { const f32x4 shv = *(const f32x4*)(sh + 256 * i + 4 * lane), scv = *(const f32x4*)(sh + 1024 + 256 * i + 4 * lane);
            y[i] = x[i] * rstd * gv[i] * (scv + 1.f) + shv;
            am = fmaxf(am, fmaxf(fmaxf(fabsf(y[i][0]), fabsf(y[i][1])), fmaxf(fabsf(y[i][2]), fabsf(y[i][3]))));
            u32x2 o; o.x = cvt_pk_bf16(y[i][0], y[i][1]); o.y = cvt_pk_bf16(y[i][2], y[i][3]);
            *(u32x2*)(Hout + (size_t)row * 1024 + 256 * i + 4 * lane) = o; }
        if (H8) {
#pragma unroll
            for (int o = 32; o > 0; o >>= 1) am = fmaxf(am, __shfl_xor(am, o));
            const float inv = am > 0.f ? 127.f / am : 0.f;
#pragma unroll
            for (int i = 0; i < 4; ++i) { const int q0 = (int)rintf(y[i][0] * inv), q1 = (int)rintf(y[i][1] * inv), q2 = (int)rintf(y[i][2] * inv), q3 = (int)rintf(y[i][3] * inv);
                *(unsigned*)(H8 + (size_t)row * 1024 + 256 * i + 4 * lane) = (unsigned)(q0 & 0xff) | ((unsigned)(q1 & 0xff) << 8) | ((unsigned)(q2 & 0xff) << 16) | ((unsigned)(q3 & 0xff) << 24); }
            if (lane == 0) HS[row] = am > 0.f ? am * (1.f / 127.f) : 1.f;
        }
    }
#undef PM_LOAD
}

struct EpiPQ {
    static constexpr bool PERM = true;
    bf16_t* PQ;
    __device__ __forceinline__ void operator()(const f32x4 (&acc)[2][2][4][2], const pg8::Unit& u, int wr, int wc, int fr, int fq) const {
        const size_t r0 = (size_t)u.pm * 256 + wr * 64 + fr; const int col0 = u.pn * 256 + wc * 32 + 8 * fq;
#pragma unroll
        for (int ai = 0; ai < 2; ++ai)
#pragma unroll
            for (int m = 0; m < 4; ++m) { bf16_t* d = PQ + (r0 + ai * 128 + m * 16) * 2048 + col0;
#pragma unroll
                for (int bj = 0; bj < 2; ++bj) { const f32x4 a0 = acc[ai][bj][m][0], a1 = acc[ai][bj][m][1];
                    u32x4 o; o.x = cvt_pk_bf16(a0[0], a0[1]); o.y = cvt_pk_bf16(a0[2], a0[3]); o.z = cvt_pk_bf16(a1[0], a1[1]); o.w = cvt_pk_bf16(a1[2], a1[3]);
                    *(u32x4*)(d + bj * 128) = o; } }
    }
};
__device__ __forceinline__ void phase_p6a(LAS unsigned char* lds, const WS& w, int l, int vb, int nvb) {
    EpiPQ E{w.PQ()}; const int M = l == 0 ? NR : NL;
    pg8::StaticOrder so; so.init(M, 2048, nvb, vb);
    pg8::gemm_phase(lds, pg8::Gemm{w.H(), w.WqT() + (size_t)l * 2048 * 1024, M, 2048, 1024}, so, E);
}


using bf16x2_t = __attribute__((ext_vector_type(2))) __bf16;
typedef float f32x2 __attribute__((ext_vector_type(2)));
__device__ __forceinline__ float gelu_fast(float x) {
    const float u2 = 1.5957691216057308f * (x + 0.044715f * x * x * x);
    return x * __builtin_amdgcn_rcpf(1.f + __builtin_amdgcn_exp2f(-1.4426950408889634f * u2));
}
#define DPPF(v, ctrl) __builtin_bit_cast(float, __builtin_amdgcn_update_dpp(0, __builtin_bit_cast(int, (v)), (ctrl), 0xf, 0xf, true))
__device__ __forceinline__ float reduce8(float p0, float p1, float p2, float p3, float p4, float p5, float p6, float p7, int lane) {
    auto s01 = __builtin_amdgcn_permlane32_swap(__float_as_uint(p0), __float_as_uint(p1), false, false);
    auto s23 = __builtin_amdgcn_permlane32_swap(__float_as_uint(p2), __float_as_uint(p3), false, false);
    auto s45 = __builtin_amdgcn_permlane32_swap(__float_as_uint(p4), __float_as_uint(p5), false, false);
    auto s67 = __builtin_amdgcn_permlane32_swap(__float_as_uint(p6), __float_as_uint(p7), false, false);
    const float q0 = __uint_as_float(s01[0]) + __uint_as_float(s01[1]), q1 = __uint_as_float(s23[0]) + __uint_as_float(s23[1]);
    const float q2 = __uint_as_float(s45[0]) + __uint_as_float(s45[1]), q3 = __uint_as_float(s67[0]) + __uint_as_float(s67[1]);
    auto t0 = __builtin_amdgcn_permlane16_swap(__float_as_uint(q0), __float_as_uint(q1), false, false);
    auto t1 = __builtin_amdgcn_permlane16_swap(__float_as_uint(q2), __float_as_uint(q3), false, false);
    float r0 = __uint_as_float(t0[0]) + __uint_as_float(t0[1]);
    float r1 = __uint_as_float(t1[0]) + __uint_as_float(t1[1]);
    r0 += DPPF(r0, 0x128); r1 += DPPF(r1, 0x128);
    float z = (lane & 8) ? r1 : r0;
    z += DPPF(z, 0x141);
    z += DPPF(z, 0xB1);
    z += DPPF(z, 0x4E);
    return z;
}
__device__ __forceinline__ void p7_axpy(const u32x4 v, float wj, f32x2 (&out)[8]) {
    const f32x2 w2 = {wj, wj};
#pragma unroll
    for (int k = 0; k < 4; ++k) { const f32x2 lo = __builtin_amdgcn_cvt_pk_f32_fp8((int)v[k], false), hi2 = __builtin_amdgcn_cvt_pk_f32_fp8((int)v[k], true);
        out[2 * k] = __builtin_elementwise_fma(w2, lo, out[2 * k]); out[2 * k + 1] = __builtin_elementwise_fma(w2, hi2, out[2 * k + 1]); }
}
__device__ __forceinline__ int p7_doti(const u32x4 u, const u32x4 h) {
    int s = __builtin_amdgcn_sdot4((int)u[0], (int)h[0], 0, false); s = __builtin_amdgcn_sdot4((int)u[1], (int)h[1], s, false); s = __builtin_amdgcn_sdot4((int)u[2], (int)h[2], s, false); return __builtin_amdgcn_sdot4((int)u[3], (int)h[3], s, false);
}
#define DPPI(v, ctrl) __builtin_amdgcn_update_dpp(0, (v), (ctrl), 0xf, 0xf, true)
__device__ __forceinline__ int reduce8i(int p0, int p1, int p2, int p3, int p4, int p5, int p6, int p7, int lane) {
    auto s01 = __builtin_amdgcn_permlane32_swap((unsigned)p0, (unsigned)p1, false, false); auto s23 = __builtin_amdgcn_permlane32_swap((unsigned)p2, (unsigned)p3, false, false);
    auto s45 = __builtin_amdgcn_permlane32_swap((unsigned)p4, (unsigned)p5, false, false); auto s67 = __builtin_amdgcn_permlane32_swap((unsigned)p6, (unsigned)p7, false, false);
    const unsigned q0 = s01[0] + s01[1], q1 = s23[0] + s23[1], q2 = s45[0] + s45[1], q3 = s67[0] + s67[1];
    auto t0 = __builtin_amdgcn_permlane16_swap(q0, q1, false, false); auto t1 = __builtin_amdgcn_permlane16_swap(q2, q3, false, false);
    int r0 = (int)(t0[0] + t0[1]), r1 = (int)(t1[0] + t1[1]);
    r0 += DPPI(r0, 0x128); r1 += DPPI(r1, 0x128);
    int z = (lane & 8) ? r1 : r0;
    z += DPPI(z, 0x141); z += DPPI(z, 0xB1); z += DPPI(z, 0x4E);
    return z;
}

struct P7CArgs { const signed char* H8; const unsigned* EG; const unsigned char* U8; int* PART; int nrows; };
__device__ __forceinline__ void phase_p7c(LAS unsigned char* lds, const P7CArgs& a, int part, int prank, int nvb) {
    int tid_ = threadIdx.x; asm volatile("" : "+v"(tid_));
    const int lane = tid_ & 63, wid = __builtin_amdgcn_readfirstlane(tid_ >> 6);
    const int nw = (nvb >> 3) * 8, wrank = prank * 8 + wid;
    LAS unsigned* tab = (LAS unsigned*)(lds + wid * 1024);
    const int grp = lane >> 3, c = lane & 7, c16 = c * 16;
    const unsigned char* ubase = a.U8 + 128 * part + c16;
    const signed char* hbase = a.H8 + 128 * part + c16;
    unsigned* pbase = (unsigned*)a.PART + (size_t)part * a.nrows * 64;
    const int c2 = (c >> 2) & 1, c1 = (c >> 1) & 1, c0 = c & 1;
    const int ent0 = 8 * (4 * c2 + 2 * c0 + c1) + grp;
    u32x4 Av[16], Bv[16]; u32x4 Ah, Bh;
    unsigned pw0 = 0u, pw1 = 0u;
#define P7C_PREF(t) do { pw0 = a.EG[(size_t)(t) * 128 + lane]; pw1 = a.EG[(size_t)(t) * 128 + 64 + lane]; } while (0)
#define P7C_ISSUE(X, Xh, t, slot, tnext) do { LAS unsigned* tb_ = tab + (slot) * 128; \
        tb_[lane] = pw0; tb_[64 + lane] = pw1; \
        asm volatile("s_waitcnt lgkmcnt(0)" ::: "memory"); \
        _Pragma("unroll") for (int i_ = 0; i_ < 16; ++i_) { const unsigned e_ = tb_[8 * i_ + grp]; X[i_] = *(const u32x4*)(ubase + (size_t)(e_ >> 16) * 1024); } \
        Xh = *(const u32x4*)(hbase + (size_t)(t) * 1024); \
        P7C_PREF(tnext); } while (0)
#define P7C_X(v, ctrl) ((v) + DPPI((v), (ctrl)))
#define P7C_COMPUTE(X, Xh, t, valid) do { int d_[16]; \
        _Pragma("unroll") for (int i_ = 0; i_ < 16; ++i_) d_[i_] = p7_doti(X[i_], Xh); \
        int e8_[8]; _Pragma("unroll") for (int k = 0; k < 8; ++k) { const int send_ = c2 ? d_[k] : d_[k + 8], keep_ = c2 ? d_[k + 8] : d_[k]; e8_[k] = keep_ + DPPI(send_, 0x141); }            \
        int e4_[4]; _Pragma("unroll") for (int k = 0; k < 4; ++k) { const int send_ = c0 ? e8_[k] : e8_[k + 4], keep_ = c0 ? e8_[k + 4] : e8_[k]; e4_[k] = keep_ + DPPI(send_, 0xB1); }          \
        int e2_[2]; _Pragma("unroll") for (int k = 0; k < 2; ++k) { const int send_ = c1 ? e4_[k] : e4_[k + 2], keep_ = c1 ? e4_[k + 2] : e4_[k]; e2_[k] = keep_ + DPPI(send_, 0x4E); }          \
        if (valid) pbase[(size_t)(t) * 64 + ent0] = __builtin_bit_cast(unsigned, __builtin_amdgcn_cvt_pk_i16((e2_[0] + 8) >> 4, (e2_[1] + 8) >> 4)); } while (0)
    const int lastrow = a.nrows - 1;
    int t = wrank;
    P7C_PREF(t);
    P7C_ISSUE(Av, Ah, t, 0, (t + nw < a.nrows ? t + nw : lastrow));
    while (t < a.nrows) {
        const int t1 = t + nw, t2 = t1 + nw, t3 = t2 + nw;
        const int k1 = t1 < a.nrows ? t1 : lastrow, k2 = t2 < a.nrows ? t2 : lastrow, k3 = t3 < a.nrows ? t3 : lastrow;
        P7C_ISSUE(Bv, Bh, k1, 1, k2);
        P7C_COMPUTE(Av, Ah, t, true);
        P7C_ISSUE(Av, Ah, k2, 0, k3);
        P7C_COMPUTE(Bv, Bh, k1, (t1 < a.nrows));
        t = t2;
    }
#undef P7C_PREF
#undef P7C_ISSUE
#undef P7C_COMPUTE
}
__device__ __forceinline__ void phase_p7d(const int* __restrict__ PART, const unsigned* __restrict__ EG, const float* __restrict__ US, const float* __restrict__ VS, const float* __restrict__ HS, unsigned* __restrict__ WE, int nrows, int vb, int nvb) {
    int tid_ = threadIdx.x; asm volatile("" : "+v"(tid_));
    typedef int i32x4 __attribute__((ext_vector_type(4)));
    const size_t n16 = (size_t)nrows * 16, pstride4 = n16;
    const u32x4* P4 = (const u32x4*)PART; const u32x4* EG4 = (const u32x4*)EG; u32x4* WE4 = (u32x4*)WE;
    for (size_t j = (size_t)vb * 512 + tid_; j < n16; j += (size_t)nvb * 512) {
        const size_t row = j >> 4; const int P = (int)(j >> 1) & 7, gq = (int)j & 1;
        i32x4 slo = {0, 0, 0, 0}, shi = {0, 0, 0, 0};
#pragma unroll
        for (int p = 0; p < 8; ++p) { const u32x4 d = P4[p * pstride4 + j];
#pragma unroll
            for (int k = 0; k < 4; ++k) { slo[k] += (int)(d[k] << 16) >> 16; shi[k] += (int)d[k] >> 16; } }
        const float hs = __builtin_ldexpf(HS[row], 4);
#pragma unroll
        for (int half = 0; half < 2; ++half) {
            const size_t ei = row * 32 + 4 * P + 2 * half + gq;
            const u32x4 eg = EG4[ei]; u32x4 o;
#pragma unroll
            for (int k = 0; k < 4; ++k) { const int eid = (int)(eg[k] >> 16);
                const float av = (float)(half ? shi[k] : slo[k]) * US[eid] * hs;
                const float wv = __uint_as_float(eg[k] << 16) * gelu_fast(av) * VS[eid];
                o[k] = (eg[k] & 0xffff0000u) | (cvt_pk_bf16(wv, 0.f) & 0xffffu); }
            WE4[ei] = o;
        }
    }
}
struct P7BArgs { const unsigned* WE; const unsigned char* V8; bf16_t* XB; const float* gate2; int nrows; };
template <int PM>
__device__ __forceinline__ void phase_p7b(LAS unsigned char* lds, const P7BArgs& a, int part, int prank, int nvb) {
    int tid_ = threadIdx.x; asm volatile("" : "+v"(tid_));
    const int lane = tid_ & 63, wid = __builtin_amdgcn_readfirstlane(tid_ >> 6);
    const int nw = (nvb >> 3) * 8, wrank = prank * 8 + wid;
    LAS unsigned* tab = (LAS unsigned*)(lds + wid * 1024);
    const int grp = lane >> 3, c16 = (lane & 7) * 16;
    const unsigned char* vbase = a.V8 + 128 * part + c16;
    const int colofs = 128 * part + c16 + 8 * (lane >> 5) + 4 * ((lane >> 4) & 1) + 2 * ((lane >> 3) & 1);
    u32x4 Av[16], Bv[16]; float Aw[16], Bw[16]; unsigned Ax, Bx; f32x2 Ag, Bg;
    unsigned pw0 = 0u, pw1 = 0u;
#define P7B_PREF(t) do { pw0 = a.WE[(size_t)(t) * 128 + lane]; pw1 = a.WE[(size_t)(t) * 128 + 64 + lane]; } while (0)
#define P7B_ISSUE(X, Xw, Xx, Xg, t, slot, tnext) do { LAS unsigned* tb_ = tab + (slot) * 128; \
        tb_[lane] = pw0; tb_[64 + lane] = pw1; \
        asm volatile("s_waitcnt lgkmcnt(0)" ::: "memory"); \
        _Pragma("unroll") for (int i_ = 0; i_ < 16; ++i_) { const unsigned we_ = tb_[8 * i_ + grp]; Xw[i_] = __uint_as_float(we_ << 16); if (PM != 2) X[i_] = *(const u32x4*)(vbase + (size_t)(we_ >> 16) * 1024); else X[i_] = (u32x4){we_, 0x38383838u, 0x38383838u, 0x38383838u}; } \
        { const int mr_ = (t) >= NL ? 32 : (t) / S; \
          Xx = *(const unsigned*)(a.XB + (size_t)(t) * 1024 + colofs); Xg = *(const f32x2*)(a.gate2 + (size_t)mr_ * 6144 + colofs); } \
        P7B_PREF(tnext); } while (0)
#define P7B_COMPUTE(X, Xw, Xx, Xg, t, valid) do { f32x2 acc2[8]; \
        _Pragma("unroll") for (int k = 0; k < 8; ++k) acc2[k] = (f32x2){0.f, 0.f}; \
        if (PM != 1) { _Pragma("unroll") for (int i_ = 0; i_ < 16; ++i_) p7_axpy(X[i_], Xw[i_], acc2); } else { _Pragma("unroll") for (int i_ = 0; i_ < 16; ++i_) acc2[i_ >> 1][i_ & 1] = __uint_as_float((X[i_][0] ^ X[i_][1] ^ X[i_][2] ^ X[i_][3]) & 0x3fffffffu) + Xw[i_]; } \
        float b_[8]; _Pragma("unroll") for (int k = 0; k < 8; ++k) { auto s_ = __builtin_amdgcn_permlane32_swap(__float_as_uint(acc2[k >> 1][k & 1]), __float_as_uint(acc2[(k + 8) >> 1][k & 1]), false, false); b_[k] = __uint_as_float(s_[0]) + __uint_as_float(s_[1]); } \
        float c_[4]; _Pragma("unroll") for (int k = 0; k < 4; ++k) { auto s_ = __builtin_amdgcn_permlane16_swap(__float_as_uint(b_[k]), __float_as_uint(b_[k + 4]), false, false); c_[k] = __uint_as_float(s_[0]) + __uint_as_float(s_[1]); } \
        float d_[2]; _Pragma("unroll") for (int k = 0; k < 2; ++k) { const float send_ = (lane & 8) ? c_[k] : c_[k + 2]; const float keep_ = (lane & 8) ? c_[k + 2] : c_[k]; d_[k] = keep_ + DPPF(send_, 0x128); } \
        unsigned* xp_ = (unsigned*)(a.XB + (size_t)(t) * 1024 + colofs); \
        f32x2 x_ = {__uint_as_float(Xx << 16), __uint_as_float(Xx & 0xffff0000u)}; x_.x += Xg.x * d_[0]; x_.y += Xg.y * d_[1]; if ((valid) && PM == 0) *xp_ = cvt_pk_bf16(x_.x, x_.y); else if (PM != 0 && x_.x == 1.2345e30f) *xp_ = cvt_pk_bf16(x_.x, x_.y); } while (0)
    const int lastrow = a.nrows - 1;
    int t = wrank;
    P7B_PREF(t);
    P7B_ISSUE(Av, Aw, Ax, Ag, t, 0, (t + nw < a.nrows ? t + nw : lastrow));
    while (t < a.nrows) {
        const int t1 = t + nw, t2 = t1 + nw, t3 = t2 + nw;
        const int c1 = t1 < a.nrows ? t1 : lastrow, c2 = t2 < a.nrows ? t2 : lastrow, c3 = t3 < a.nrows ? t3 : lastrow;
        P7B_ISSUE(Bv, Bw, Bx, Bg, c1, 1, c2);
        P7B_COMPUTE(Av, Aw, Ax, Ag, t, true);
        P7B_ISSUE(Av, Aw, Ax, Ag, c2, 0, c3);
        P7B_COMPUTE(Bv, Bw, Bx, Bg, c1, (t1 < a.nrows));
        t = t2;
    }
#undef P7B_PREF
#undef P7B_ISSUE
#undef P7B_COMPUTE
}
__device__ __forceinline__ void phase_final_norm(const bf16_t* __restrict__ XBp, float* __restrict__ OUT, const float* __restrict__ g, int vb, int nvb) {
    int tid_ = threadIdx.x; asm volatile("" : "+v"(tid_));
    const int lane = tid_ & 63, wid = tid_ >> 6;
    for (int row = vb * 8 + wid; row < NL; row += nvb * 8) {
        const bf16_t* xp = XBp + (size_t)row * 1024; f32x4 x[4]; float ss = 0.f;
#pragma unroll
        for (int i = 0; i < 4; ++i) { const u32x2 r = *(const u32x2*)(xp + 256 * i + 4 * lane); x[i] = (f32x4){__uint_as_float(r.x << 16), __uint_as_float(r.x & 0xffff0000u), __uint_as_float(r.y << 16), __uint_as_float(r.y & 0xffff0000u)};
            ss += x[i][0] * x[i][0] + x[i][1] * x[i][1] + x[i][2] * x[i][2] + x[i][3] * x[i][3]; }
        ss = wave_sum(ss); const float rstd = rsqrtf(ss * (1.f / 1024.f) + EPS);
#pragma unroll
        for (int i = 0; i < 4; ++i) *(f32x4*)(OUT + (size_t)row * 1024 + 256 * i + 4 * lane) = x[i] * rstd * *(const f32x4*)(g + 256 * i + 4 * lane);
    }
}

template <int V_> struct IC { static constexpr int value = V_; };
typedef short s16x4 __attribute__((ext_vector_type(4)));
__device__ __forceinline__ s16x4 lds_tr16(const LAS unsigned char* p) { return __builtin_bit_cast(s16x4, __builtin_amdgcn_ds_read_tr16_b64_v4i16((LAS s16x4*)p)); }
constexpr int ATT_BUF = 20480;
__device__ __forceinline__ void glds16(const void* g, unsigned lds_base) {
    unsigned sv; asm volatile("s_mov_b32 %0, m0\n\ts_mov_b32 m0, %2\n\ts_nop 0\n\tglobal_load_lds_dwordx4 %1, off\n\ts_mov_b32 m0, %0" : "=&s"(sv) : "v"(g), "s"(lds_base) : "memory"); }
template <int DK>
__device__ __forceinline__ void attn_unit(LAS unsigned char* lds, const bf16_t* __restrict__ Q, const bf16_t* __restrict__ K1, const bf16_t* __restrict__ K2, const bf16_t* __restrict__ V,
                                          int nkeys, float c2, bf16_t* __restrict__ out) {
    int tid_ = threadIdx.x; asm volatile("" : "+v"(tid_));
    const int tid = tid_, lane = tid & 63, wid = __builtin_amdgcn_readfirstlane(tid >> 6), r32 = lane & 31, hi = lane >> 5;
    constexpr int NS = DK / 16, NM = 2 * NS;
    bf16x8 qf[NS];
    { const bf16_t* qp = Q + (size_t)(wid * 32 + r32) * DK + 8 * hi;
#pragma unroll
      for (int s = 0; s < NS; ++s) qf[s] = *(const bf16x8*)(qp + 16 * s); }
    const int dkey = 8 * wid + (lane >> 3), dkey2 = 16 * (wid & 3) + (lane >> 2);
    const bf16_t* gk1 = K1 + (size_t)dkey * 64 + (((lane & 7) ^ ((dkey >> 1) & 7)) << 3);
    const bf16_t* gv = V + (size_t)dkey * 64 + (((lane & 7) ^ (((dkey >> 1) & 1) << 2)) << 3);
    const bf16_t* gk2 = (DK == 96) ? K2 + (size_t)dkey2 * 32 + (((lane & 3) ^ ((dkey2 >> 2) & 3)) << 3) : nullptr;
    const unsigned lds0 = (unsigned)(size_t)lds;
    const unsigned d_k1 = lds0 + wid * 1024, d_v = lds0 + 8192 + wid * 1024, d_k2 = lds0 + 16384 + (wid & 3) * 1024;
#define ATT_DMA(tile_, slot_) do { const int tt_ = (tile_); glds16(gk1 + (size_t)tt_ * 4096, (unsigned)__builtin_amdgcn_readfirstlane(d_k1 + (slot_) * ATT_BUF)); \
        glds16(gv + (size_t)tt_ * 4096, (unsigned)__builtin_amdgcn_readfirstlane(d_v + (slot_) * ATT_BUF)); \
        if (DK == 96) glds16(gk2 + (size_t)tt_ * 2048, (unsigned)__builtin_amdgcn_readfirstlane(d_k2 + (slot_) * ATT_BUF)); } while (0)
#define ATT_WAIT_BAR() do { if (DK == 96) asm volatile("s_waitcnt vmcnt(3) lgkmcnt(0)\n\ts_barrier" ::: "memory"); else asm volatile("s_waitcnt vmcnt(2) lgkmcnt(0)\n\ts_barrier" ::: "memory"); } while (0)
    unsigned ka[2][4];
#pragma unroll
    for (int kt = 0; kt < 2; ++kt)
#pragma unroll
        for (int s = 0; s < 4; ++s) { const int key = 32 * kt + r32; ka[kt][s] = key * 128 + (((2 * s + hi) ^ ((key >> 1) & 7)) << 4); }
    unsigned kb[2][2];
#pragma unroll
    for (int kt = 0; kt < 2; ++kt)
#pragma unroll
        for (int s = 0; s < 2; ++s) { const int key = 32 * kt + r32; kb[kt][s] = 16384 + key * 64 + (((2 * s + hi) ^ ((key >> 2) & 3)) << 4); }
    const int vq = (lane & 15) >> 2, vp = lane & 3, vg = (lane >> 4) & 1;
    unsigned va[2];
#pragma unroll
    for (int dvb = 0; dvb < 2; ++dvb) { const int key = 4 * hi + vq; va[dvb] = 8192 + key * 128 + ((((32 * dvb + 16 * vg + 4 * vp) * 2)) ^ (((key >> 1) & 1) << 6)); }
    float m = -1e30f, l = 0.f, mx;
    f32x16 o0 = {}, o1 = {};
    const int NT = nkeys >> 6;
    ATT_DMA(0, 0); ATT_DMA(NT > 1 ? 1 : 0, 1); ATT_DMA(NT > 2 ? 2 : NT - 1, 2);
    asm volatile("s_waitcnt vmcnt(0) lgkmcnt(0)\n\ts_barrier" ::: "memory");
    f32x16 pa0 = {}, pa1 = {}, pb0 = {}, pb1 = {};
    {
        bf16x8 kf0[NS], kf1[NS];
#pragma unroll
        for (int s = 0; s < 4; ++s) { kf0[s] = *(const LAS bf16x8*)(lds + ka[0][s]); kf1[s] = *(const LAS bf16x8*)(lds + ka[1][s]); }
        if (DK == 96) {
#pragma unroll
            for (int s = 0; s < 2; ++s) { kf0[4 + s] = *(const LAS bf16x8*)(lds + kb[0][s]); kf1[4 + s] = *(const LAS bf16x8*)(lds + kb[1][s]); }
        }
#pragma unroll
        for (int s = 0; s < NS; ++s) { pa0 = mfma32(kf0[s], qf[s], pa0); pa1 = mfma32(kf1[s], qf[s], pa1); }
        mx = pa0[0];
#pragma unroll
        for (int r = 1; r < 16; ++r) mx = fmaxf(mx, pa0[r]);
#pragma unroll
        for (int r = 0; r < 16; ++r) mx = fmaxf(mx, pa1[r]);
    }
    auto step = [&](auto bc_, auto bn_, auto bw_, f32x16& pc0, f32x16& pc1, f32x16& pn0, f32x16& pn1, int t) __attribute__((always_inline)) {
        constexpr int BC = decltype(bc_)::value * ATT_BUF, BN = decltype(bn_)::value * ATT_BUF;
        ATT_DMA((t + 3 < NT) ? t + 3 : NT - 1, decltype(bw_)::value);
        bf16x8 kf0[NS], kf1[NS];
#pragma unroll
        for (int s = 0; s < 4; ++s) { kf0[s] = *(const LAS bf16x8*)(lds + BN + ka[0][s]); kf1[s] = *(const LAS bf16x8*)(lds + BN + ka[1][s]); }
        if (DK == 96) {
#pragma unroll
            for (int s = 0; s < 2; ++s) { kf0[4 + s] = *(const LAS bf16x8*)(lds + BN + kb[0][s]); kf1[4 + s] = *(const LAS bf16x8*)(lds + BN + kb[1][s]); }
        }
        __builtin_amdgcn_sched_barrier(0);
        { auto rr = __builtin_amdgcn_permlane32_swap(__float_as_uint(mx), __float_as_uint(mx), false, false); mx = fmaxf(__uint_as_float(rr[0]), __uint_as_float(rr[1])); }
        const float tm = mx;
        if (__any(tm > m + 8.f)) {
            const float mn = fmaxf(m, tm), al = __builtin_amdgcn_exp2f(m - mn); m = mn; l *= al;
#pragma unroll
            for (int r = 0; r < 16; ++r) { o0[r] *= al; o1[r] *= al; }
        }
        const float nm = -m; float ls = 0.f;
        pn0 = f32x16{}; pn1 = f32x16{};
        unsigned pw[16];
        s16x4 vlo[2][2][2], vhi[2][2][2];
#pragma unroll
        for (int c = 0; c < 8; ++c) {
            __builtin_amdgcn_sched_barrier(0);
#pragma unroll
            for (int j = 0; j < NM; ++j) if (j >= c * NM / 8 && j < (c + 1) * NM / 8) { if (j & 1) pn1 = mfma32(kf1[j >> 1], qf[j >> 1], pn1); else pn0 = mfma32(kf0[j >> 1], qf[j >> 1], pn0); }
            if (c == 4) {
#pragma unroll
                for (int kt = 0; kt < 2; ++kt)
#pragma unroll
                    for (int sp = 0; sp < 2; ++sp) { const int kofs = (32 * kt + 16 * sp) * 128;
#pragma unroll
                        for (int dvb = 0; dvb < 2; ++dvb) { vlo[dvb][kt][sp] = lds_tr16(lds + BC + va[dvb] + kofs); vhi[dvb][kt][sp] = lds_tr16(lds + BC + va[dvb] + kofs + 8 * 128); } }
            }
            __builtin_amdgcn_sched_barrier(0);
            if (c < 4) {
#pragma unroll
                for (int i = 0; i < 4; ++i) { const int r = 4 * c + i; pc0[r] = __builtin_amdgcn_exp2f(pc0[r] + nm); ls += pc0[r]; }
                pw[2 * c] = cvt_pk_bf16(pc0[4 * c], pc0[4 * c + 1]); pw[2 * c + 1] = cvt_pk_bf16(pc0[4 * c + 2], pc0[4 * c + 3]);
            } else {
#pragma unroll
                for (int i = 0; i < 4; ++i) { const int r = 4 * (c - 4) + i; pc1[r] = __builtin_amdgcn_exp2f(pc1[r] + nm); ls += pc1[r]; }
                pw[8 + 2 * (c - 4)] = cvt_pk_bf16(pc1[4 * (c - 4)], pc1[4 * (c - 4) + 1]); pw[8 + 2 * (c - 4) + 1] = cvt_pk_bf16(pc1[4 * (c - 4) + 2], pc1[4 * (c - 4) + 3]);
            }
        }
        __builtin_amdgcn_sched_barrier(0);
        l += ls;
        float mxn = -3.0e38f;
#pragma unroll
        for (int k = 0; k < 8; ++k) { const int kt = k >> 2, sp = (k >> 1) & 1, dvb = k & 1;
            const u32x4 pq = (u32x4){pw[8 * kt + 4 * sp], pw[8 * kt + 4 * sp + 1], pw[8 * kt + 4 * sp + 2], pw[8 * kt + 4 * sp + 3]};
            const s16x4 lo = vlo[dvb][kt][sp], hi4 = vhi[dvb][kt][sp]; const bf16x8 vf = (bf16x8){lo[0], lo[1], lo[2], lo[3], hi4[0], hi4[1], hi4[2], hi4[3]};
            if (dvb == 0) o0 = mfma32(vf, __builtin_bit_cast(bf16x8, pq), o0); else o1 = mfma32(vf, __builtin_bit_cast(bf16x8, pq), o1);
            __builtin_amdgcn_sched_barrier(0);
            if (k < 4) { mxn = fmaxf(fmaxf(mxn, pn0[4 * k]), fmaxf(pn0[4 * k + 1], fmaxf(pn0[4 * k + 2], pn0[4 * k + 3]))); }
            else { mxn = fmaxf(fmaxf(mxn, pn1[4 * (k - 4)]), fmaxf(pn1[4 * (k - 4) + 1], fmaxf(pn1[4 * (k - 4) + 2], pn1[4 * (k - 4) + 3]))); }
            __builtin_amdgcn_sched_barrier(0);
        }
        mx = mxn;
        ATT_WAIT_BAR();
    };
    for (int t = 0; t < NT; t += 4) {
        step(IC<0>{}, IC<1>{}, IC<3>{}, pa0, pa1, pb0, pb1, t);
        step(IC<1>{}, IC<2>{}, IC<0>{}, pb0, pb1, pa0, pa1, t + 1);
        step(IC<2>{}, IC<3>{}, IC<1>{}, pa0, pa1, pb0, pb1, t + 2);
        step(IC<3>{}, IC<0>{}, IC<2>{}, pb0, pb1, pa0, pa1, t + 3);
    }
    { auto rr = __builtin_amdgcn_permlane32_swap(__float_as_uint(l), __float_as_uint(l), false, false); l = __uint_as_float(rr[0]) + __uint_as_float(rr[1]); }
    const float il = 1.f / l;
    bf16_t* op = out + (size_t)(wid * 32 + r32) * 1024 + 4 * hi;
#pragma unroll
    for (int g = 0; g < 4; ++g) { u32x2 a, b;
        a.x = cvt_pk_bf16(o0[4 * g] * il, o0[4 * g + 1] * il); a.y = cvt_pk_bf16(o0[4 * g + 2] * il, o0[4 * g + 3] * il);
        b.x = cvt_pk_bf16(o1[4 * g] * il, o1[4 * g + 1] * il); b.y = cvt_pk_bf16(o1[4 * g + 2] * il, o1[4 * g + 3] * il);
        *(u32x2*)(op + 8 * g) = a; *(u32x2*)(op + 32 + 8 * g) = b; }
}
#undef ATT_DMA
#undef ATT_WAIT_BAR
template <int DK>
__device__ __forceinline__ void attn_unit64(LAS unsigned char* lds, const bf16_t* __restrict__ Q, const bf16_t* __restrict__ K1, const bf16_t* __restrict__ K2, const bf16_t* __restrict__ V,
                                            int nkeys, bf16_t* __restrict__ out) {
    int tid_ = threadIdx.x; asm volatile("" : "+v"(tid_));
    const int tid = tid_, lane = tid & 63, wid = __builtin_amdgcn_readfirstlane(tid >> 6), r32 = lane & 31, hi = lane >> 5;
    constexpr int NS = DK / 16;
    bf16x8 qf[2][NS];
#pragma unroll
    for (int j = 0; j < 2; ++j) { const bf16_t* qp = Q + (size_t)(wid * 64 + 32 * j + r32) * DK + 8 * hi;
#pragma unroll
        for (int s = 0; s < NS; ++s) qf[j][s] = *(const bf16x8*)(qp + 16 * s); }
    const int dkey = 8 * wid + (lane >> 3), dkey2 = 16 * (wid & 3) + (lane >> 2);
    const bf16_t* gk1 = K1 + (size_t)dkey * 64 + (((lane & 7) ^ ((dkey >> 1) & 7)) << 3);
    const bf16_t* gv = V + (size_t)dkey * 64 + (((lane & 7) ^ (((dkey >> 1) & 1) << 2)) << 3);
    const bf16_t* gk2 = (DK == 96) ? K2 + (size_t)dkey2 * 32 + (((lane & 3) ^ ((dkey2 >> 2) & 3)) << 3) : nullptr;
    const unsigned lds0 = (unsigned)(size_t)lds;
    const unsigned d_k1 = lds0 + wid * 1024, d_v = lds0 + 8192 + wid * 1024, d_k2 = lds0 + 16384 + (wid & 3) * 1024;
#define ATT_DMA(tile_, slot_) do { const int tt_ = (tile_); glds16(gk1 + (size_t)tt_ * 4096, (unsigned)__builtin_amdgcn_readfirstlane(d_k1 + (slot_) * ATT_BUF)); \
        glds16(gv + (size_t)tt_ * 4096, (unsigned)__builtin_amdgcn_readfirstlane(d_v + (slot_) * ATT_BUF)); \
        if (DK == 96) glds16(gk2 + (size_t)tt_ * 2048, (unsigned)__builtin_amdgcn_readfirstlane(d_k2 + (slot_) * ATT_BUF)); } while (0)
    unsigned ka[4];
#pragma unroll
    for (int s = 0; s < 4; ++s) ka[s] = r32 * 128 + (((2 * s + hi) ^ ((r32 >> 1) & 7)) << 4);
    unsigned kb[2];
#pragma unroll
    for (int s = 0; s < 2; ++s) kb[s] = 16384 + r32 * 64 + (((2 * s + hi) ^ ((r32 >> 2) & 3)) << 4);
    const int vq = (lane & 15) >> 2, vp = lane & 3, vg = (lane >> 4) & 1;
    unsigned va[2];
#pragma unroll
    for (int dvb = 0; dvb < 2; ++dvb) { const int key = 4 * hi + vq; va[dvb] = 8192 + key * 128 + ((((32 * dvb + 16 * vg + 4 * vp) * 2)) ^ (((key >> 1) & 1) << 6)); }
    float m[2] = {-1e30f, -1e30f}, l[2] = {0.f, 0.f};
    f32x16 o[2][2] = {};
    const int NT = nkeys >> 6;
    ATT_DMA(0, 0); ATT_DMA(1, 1); ATT_DMA(2, 2);
    asm volatile("s_waitcnt vmcnt(0) lgkmcnt(0)\n\ts_barrier" ::: "memory");
    auto step = [&](auto cur_, auto wsl_, int t) __attribute__((always_inline)) {
        constexpr int BC = decltype(cur_)::value * ATT_BUF;
        ATT_DMA((t + 3 < NT) ? t + 3 : NT - 1, decltype(wsl_)::value);
        bf16x8 kf0[NS], kf1[NS];
#pragma unroll
        for (int s = 0; s < 4; ++s) { kf0[s] = *(const LAS bf16x8*)(lds + BC + ka[s]); kf1[s] = *(const LAS bf16x8*)(lds + BC + 4096 + ka[s]); }
        if (DK == 96) {
#pragma unroll
            for (int s = 0; s < 2; ++s) { kf0[4 + s] = *(const LAS bf16x8*)(lds + BC + kb[s]); kf1[4 + s] = *(const LAS bf16x8*)(lds + BC + 2048 + kb[s]); }
        }
        unsigned pw[2][16];
        s16x4 vlo[2][2], vhi[2][2];
#define ATT64_VLOAD(kt_) do { _Pragma("unroll") for (int sp = 0; sp < 2; ++sp) { const int kofs = (32 * (kt_) + 16 * sp) * 128; \
            _Pragma("unroll") for (int dvb = 0; dvb < 2; ++dvb) { vlo[dvb][sp] = lds_tr16(lds + BC + va[dvb] + kofs); vhi[dvb][sp] = lds_tr16(lds + BC + va[dvb] + kofs + 8 * 128); } } } while (0)
#define ATT64_PV(kt_) do { _Pragma("unroll") for (int sp = 0; sp < 2; ++sp) _Pragma("unroll") for (int dvb = 0; dvb < 2; ++dvb) { \
            const s16x4 lo = vlo[dvb][sp], hi4 = vhi[dvb][sp]; const bf16x8 vf = (bf16x8){lo[0], lo[1], lo[2], lo[3], hi4[0], hi4[1], hi4[2], hi4[3]}; \
            _Pragma("unroll") for (int j = 0; j < 2; ++j) { const u32x4 pq = (u32x4){pw[j][8 * (kt_) + 4 * sp], pw[j][8 * (kt_) + 4 * sp + 1], pw[j][8 * (kt_) + 4 * sp + 2], pw[j][8 * (kt_) + 4 * sp + 3]}; \
                o[j][dvb] = mfma32(vf, __builtin_bit_cast(bf16x8, pq), o[j][dvb]); } } } while (0)
#pragma unroll
        for (int j = 0; j < 2; ++j) {
            f32x16 p0 = {}, p1 = {};
#pragma unroll
            for (int s = 0; s < NS; ++s) { p0 = mfma32(kf0[s], qf[j][s], p0); p1 = mfma32(kf1[s], qf[j][s], p1); }
            if (j == 1) { __builtin_amdgcn_sched_barrier(0); ATT64_VLOAD(0); __builtin_amdgcn_sched_barrier(0); }
            float mx = p0[0];
#pragma unroll
            for (int r = 1; r < 16; ++r) mx = fmaxf(mx, p0[r]);
#pragma unroll
            for (int r = 0; r < 16; ++r) mx = fmaxf(mx, p1[r]);
            { auto rr = __builtin_amdgcn_permlane32_swap(__float_as_uint(mx), __float_as_uint(mx), false, false); mx = fmaxf(__uint_as_float(rr[0]), __uint_as_float(rr[1])); }
            if (__any(mx > m[j] + 8.f)) {
                const float mn = fmaxf(m[j], mx), al = __builtin_amdgcn_exp2f(m[j] - mn); m[j] = mn; l[j] *= al;
#pragma unroll
                for (int r = 0; r < 16; ++r) { o[j][0][r] *= al; o[j][1][r] *= al; }
            }
            const float nm = -m[j];
#pragma unroll
            for (int r = 0; r < 16; ++r) { p0[r] = __builtin_amdgcn_exp2f(p0[r] + nm); p1[r] = __builtin_amdgcn_exp2f(p1[r] + nm); }
            f32x2 ls2 = {0.f, 0.f};
#pragma unroll
            for (int r = 0; r < 16; r += 2) { ls2 += (f32x2){p0[r], p0[r + 1]}; ls2 += (f32x2){p1[r], p1[r + 1]}; }
            l[j] += ls2.x + ls2.y;
#pragma unroll
            for (int i = 0; i < 8; ++i) { pw[j][i] = cvt_pk_bf16(p0[2 * i], p0[2 * i + 1]); pw[j][8 + i] = cvt_pk_bf16(p1[2 * i], p1[2 * i + 1]); }
            __builtin_amdgcn_sched_barrier(0);
        }
        ATT64_PV(0);
        __builtin_amdgcn_sched_barrier(0);
        ATT64_VLOAD(1);
        __builtin_amdgcn_sched_barrier(0);
        ATT64_PV(1);
#undef ATT64_VLOAD
#undef ATT64_PV
        if (DK == 96) asm volatile("s_waitcnt vmcnt(6) lgkmcnt(0)\n\ts_barrier" ::: "memory"); else asm volatile("s_waitcnt vmcnt(4) lgkmcnt(0)\n\ts_barrier" ::: "memory");
    };
    for (int t = 0; t < NT; t += 4) {
        step(IC<0>{}, IC<3>{}, t); step(IC<1>{}, IC<0>{}, t + 1); step(IC<2>{}, IC<1>{}, t + 2); step(IC<3>{}, IC<2>{}, t + 3);
    }
#pragma unroll
    for (int j = 0; j < 2; ++j) {
        float lj = l[j]; { auto rr = __builtin_amdgcn_permlane32_swap(__float_as_uint(lj), __float_as_uint(lj), false, false); lj = __uint_as_float(rr[0]) + __uint_as_float(rr[1]); }
        const float il = 1.f / lj;
        bf16_t* op = out + (size_t)(wid * 64 + 32 * j + r32) * 1024 + 4 * hi;
#pragma unroll
        for (int g = 0; g < 4; ++g) { u32x2 a, b;
            a.x = cvt_pk_bf16(o[j][0][4 * g] * il, o[j][0][4 * g + 1] * il); a.y = cvt_pk_bf16(o[j][0][4 * g + 2] * il, o[j][0][4 * g + 3] * il);
            b.x = cvt_pk_bf16(o[j][1][4 * g] * il, o[j][1][4 * g + 1] * il); b.y = cvt_pk_bf16(o[j][1][4 * g + 2] * il, o[j][1][4 * g + 3] * il);
            *(u32x2*)(op + 8 * g) = a; *(u32x2*)(op + 32 + 8 * g) = b; }
    }
#undef ATT_DMA
}
__device__ __forceinline__ void glds16s(const void* base, unsigned voff, unsigned lds_base) {
    unsigned sv; asm volatile("s_mov_b32 %0, m0\n\ts_mov_b32 m0, %3\n\ts_nop 0\n\tglobal_load_lds_dwordx4 %1, %2\n\ts_mov_b32 m0, %0" : "=&s"(sv) : "v"(voff), "s"(base), "s"(lds_base) : "memory"); }
__device__ __forceinline__ void attn_unit64m(LAS unsigned char* lds, const bf16_t* __restrict__ Q, const bf16_t* __restrict__ K1, const bf16_t* __restrict__ K2, const bf16_t* __restrict__ V,
                                            int nkeys, bf16_t* __restrict__ out) {
    constexpr int DK = 96;
    int tid_ = threadIdx.x; asm volatile("" : "+v"(tid_));
    const int tid = tid_, lane = tid & 63, wid = __builtin_amdgcn_readfirstlane(tid >> 6), r32 = lane & 31, hi = lane >> 5;
    bf16x8 qf[2][4];
    LAS unsigned char* qrl = lds + 4 * ATT_BUF + wid * 4096 + lane * 16;
#pragma unroll
    for (int j = 0; j < 2; ++j) { const bf16_t* qp = Q + (size_t)(wid * 64 + 32 * j + r32) * DK + 8 * hi;
#pragma unroll
        for (int s = 0; s < 4; ++s) qf[j][s] = *(const bf16x8*)(qp + 16 * s);
#pragma unroll
        for (int s = 0; s < 2; ++s) *(LAS bf16x8*)(qrl + (2 * j + s) * 1024) = *(const bf16x8*)(qp + 64 + 16 * s); }
    const int dkey = 8 * wid + (lane >> 3), dkey2 = 16 * (wid & 3) + (lane >> 2);
    const unsigned ok1 = (unsigned)(dkey * 64 + (((lane & 7) ^ ((dkey >> 1) & 7)) << 3)) * 2u, ov = (unsigned)(dkey * 64 + (((lane & 7) ^ (((dkey >> 1) & 1) << 2)) << 3)) * 2u,
                   ok2 = (unsigned)(dkey2 * 32 + (((lane & 3) ^ ((dkey2 >> 2) & 3)) << 3)) * 2u;
    const unsigned lds0 = (unsigned)(size_t)lds;
    const unsigned d_k1 = lds0 + wid * 1024, d_v = lds0 + 8192 + wid * 1024, d_k2 = lds0 + 16384 + (wid & 3) * 1024;
#define ATT_DMA(tile_, slot_) do { const int tt_ = (tile_); glds16s((const char*)K1 + (size_t)tt_ * 8192, ok1, (unsigned)__builtin_amdgcn_readfirstlane(d_k1 + (slot_) * ATT_BUF)); \
        glds16s((const char*)V + (size_t)tt_ * 8192, ov, (unsigned)__builtin_amdgcn_readfirstlane(d_v + (slot_) * ATT_BUF)); \
        glds16s((const char*)K2 + (size_t)tt_ * 4096, ok2, (unsigned)__builtin_amdgcn_readfirstlane(d_k2 + (slot_) * ATT_BUF)); } while (0)
    const unsigned ka0_ = r32 * 128 + ((hi ^ ((r32 >> 1) & 7)) << 4), kb0_ = 16384 + r32 * 64 + ((hi ^ ((r32 >> 2) & 3)) << 4);
#define ka(s_) (kao_ ^ ((unsigned)(s_) << 5))
#define kb(s_) (kbo_ ^ ((unsigned)(s_) << 5))
    const int vq = (lane & 15) >> 2, vp = lane & 3, vg = (lane >> 4) & 1;
    const unsigned va0_ = 8192 + (4 * hi + vq) * 128 + ((((16 * vg + 4 * vp) * 2)) ^ ((((4 * hi + vq) >> 1) & 1) << 6));
    float m[2] = {-1e30f, -1e30f}, l[2] = {0.f, 0.f};
    f32x16 o[2][2] = {};
    const int NT = nkeys >> 6;
    ATT_DMA(0, 0); ATT_DMA(1, 1); ATT_DMA(2, 2);
    asm volatile("s_waitcnt vmcnt(0) lgkmcnt(0)\n\ts_barrier" ::: "memory");
    auto step = [&](auto cur_, auto wsl_, int t) __attribute__((always_inline)) {
        constexpr int BC = decltype(cur_)::value * ATT_BUF;
        unsigned kao_ = ka0_, kbo_ = kb0_, vao_ = va0_; asm volatile("" : "+v"(kao_), "+v"(kbo_), "+v"(vao_));
        const unsigned va[2] = {vao_, vao_ ^ 64u};
        ATT_DMA((t + 3 < NT) ? t + 3 : NT - 1, decltype(wsl_)::value);
        f32x16 pj[2][2];
#pragma unroll
        for (int j = 0; j < 2; ++j) { pj[j][0] = f32x16{}; pj[j][1] = f32x16{}; }
        {
            bf16x8 ka0[2], ka1[2], kb0[2], kb1[2];
#pragma unroll
            for (int s = 0; s < 2; ++s) { ka0[s] = *(const LAS bf16x8*)(lds + BC + ka(s)); ka1[s] = *(const LAS bf16x8*)(lds + BC + 4096 + ka(s)); }
#pragma unroll
            for (int s = 0; s < 2; ++s) { kb0[s] = *(const LAS bf16x8*)(lds + BC + ka(2 + s)); kb1[s] = *(const LAS bf16x8*)(lds + BC + 4096 + ka(2 + s)); }
            __builtin_amdgcn_sched_barrier(0);
#pragma unroll
            for (int s = 0; s < 2; ++s)
#pragma unroll
                for (int j = 0; j < 2; ++j) { pj[j][0] = mfma32(ka0[s], qf[j][s], pj[j][0]); pj[j][1] = mfma32(ka1[s], qf[j][s], pj[j][1]); }
            __builtin_amdgcn_sched_barrier(0);
            bf16x8 qr[2][2];
#pragma unroll
            for (int s = 0; s < 2; ++s) { ka0[s] = *(const LAS bf16x8*)(lds + BC + kb(s)); ka1[s] = *(const LAS bf16x8*)(lds + BC + 2048 + kb(s)); }
            __builtin_amdgcn_sched_barrier(0);
#pragma unroll
            for (int s = 0; s < 2; ++s)
#pragma unroll
                for (int j = 0; j < 2; ++j) { pj[j][0] = mfma32(kb0[s], qf[j][2 + s], pj[j][0]); pj[j][1] = mfma32(kb1[s], qf[j][2 + s], pj[j][1]); }
            __builtin_amdgcn_sched_barrier(0);
#pragma unroll
            for (int j = 0; j < 2; ++j)
#pragma unroll
                for (int s = 0; s < 2; ++s) qr[j][s] = *(const LAS bf16x8*)(qrl + (2 * j + s) * 1024);
            __builtin_amdgcn_sched_barrier(0);
#pragma unroll
            for (int s = 0; s < 2; ++s)
#pragma unroll
                for (int j = 0; j < 2; ++j) { pj[j][0] = mfma32(ka0[s], qr[j][s], pj[j][0]); pj[j][1] = mfma32(ka1[s], qr[j][s], pj[j][1]); }
            __builtin_amdgcn_sched_barrier(0);
        }
        unsigned pw[2][16];
        s16x4 vlo[2][2], vhi[2][2];
#define ATT64_VLOAD(kt_) do { _Pragma("unroll") for (int sp = 0; sp < 2; ++sp) { const int kofs = (32 * (kt_) + 16 * sp) * 128; \
            _Pragma("unroll") for (int dvb = 0; dvb < 2; ++dvb) { vlo[dvb][sp] = lds_tr16(lds + BC + va[dvb] + kofs); vhi[dvb][sp] = lds_tr16(lds + BC + va[dvb] + kofs + 8 * 128); } } } while (0)
#define ATT64_PV(kt_) do { _Pragma("unroll") for (int sp = 0; sp < 2; ++sp) _Pragma("unroll") for (int dvb = 0; dvb < 2; ++dvb) { \
            const s16x4 lo = vlo[dvb][sp], hi4 = vhi[dvb][sp]; const bf16x8 vf = (bf16x8){lo[0], lo[1], lo[2], lo[3], hi4[0], hi4[1], hi4[2], hi4[3]}; \
            _Pragma("unroll") for (int j = 0; j < 2; ++j) { const u32x4 pq = (u32x4){pw[j][8 * (kt_) + 4 * sp], pw[j][8 * (kt_) + 4 * sp + 1], pw[j][8 * (kt_) + 4 * sp + 2], pw[j][8 * (kt_) + 4 * sp + 3]}; \
                o[j][dvb] = mfma32(vf, __builtin_bit_cast(bf16x8, pq), o[j][dvb]); } } } while (0)
#pragma unroll
        for (int j = 0; j < 2; ++j) {
            f32x16 p0 = pj[j][0], p1 = pj[j][1];
            if (j == 1) { __builtin_amdgcn_sched_barrier(0); ATT64_VLOAD(0); __builtin_amdgcn_sched_barrier(0); }
            float mx = p0[0];
#pragma unroll
            for (int r = 1; r < 16; ++r) mx = fmaxf(mx, p0[r]);
#pragma unroll
            for (int r = 0; r < 16; ++r) mx = fmaxf(mx, p1[r]);
            { auto rr = __builtin_amdgcn_permlane32_swap(__float_as_uint(mx), __float_as_uint(mx), false, false); mx = fmaxf(__uint_as_float(rr[0]), __uint_as_float(rr[1])); }
            if (__any(mx > m[j] + 8.f)) {
                const float mn = fmaxf(m[j], mx), al = __builtin_amdgcn_exp2f(m[j] - mn); m[j] = mn; l[j] *= al;
#pragma unroll
                for (int r = 0; r < 16; ++r) { o[j][0][r] *= al; o[j][1][r] *= al; }
            }
            const float nm = -m[j];
#pragma unroll
            for (int r = 0; r < 16; ++r) { p0[r] = __builtin_amdgcn_exp2f(p0[r] + nm); p1[r] = __builtin_amdgcn_exp2f(p1[r] + nm); }
            f32x2 ls2 = {0.f, 0.f};
#pragma unroll
            for (int r = 0; r < 16; r += 2) { ls2 += (f32x2){p0[r], p0[r + 1]}; ls2 += (f32x2){p1[r], p1[r + 1]}; }
            l[j] += ls2.x + ls2.y;
#pragma unroll
            for (int i = 0; i < 8; ++i) { pw[j][i] = cvt_pk_bf16(p0[2 * i], p0[2 * i + 1]); pw[j][8 + i] = cvt_pk_bf16(p1[2 * i], p1[2 * i + 1]); }
            __builtin_amdgcn_sched_barrier(0);
        }
        ATT64_PV(0);
        __builtin_amdgcn_sched_barrier(0);
        ATT64_VLOAD(1);
        __builtin_amdgcn_sched_barrier(0);
        ATT64_PV(1);
#undef ATT64_VLOAD
#undef ATT64_PV
        if (DK == 96) asm volatile("s_waitcnt vmcnt(6) lgkmcnt(0)\n\ts_barrier" ::: "memory"); else asm volatile("s_waitcnt vmcnt(4) lgkmcnt(0)\n\ts_barrier" ::: "memory");
    };
    for (int t = 0; t < NT; t += 4) {
        step(IC<0>{}, IC<3>{}, t); step(IC<1>{}, IC<0>{}, t + 1); step(IC<2>{}, IC<1>{}, t + 2); step(IC<3>{}, IC<2>{}, t + 3);
    }
#pragma unroll
    for (int j = 0; j < 2; ++j) {
        float lj = l[j]; { auto rr = __builtin_amdgcn_permlane32_swap(__float_as_uint(lj), __float_as_uint(lj), false, false); lj = __uint_as_float(rr[0]) + __uint_as_float(rr[1]); }
        const float il = 1.f / lj;
        bf16_t* op = out + (size_t)(wid * 64 + 32 * j + r32) * 1024 + 4 * hi;
#pragma unroll
        for (int g = 0; g < 4; ++g) { u32x2 a, b;
            a.x = cvt_pk_bf16(o[j][0][4 * g] * il, o[j][0][4 * g + 1] * il); a.y = cvt_pk_bf16(o[j][0][4 * g + 2] * il, o[j][0][4 * g + 3] * il);
            b.x = cvt_pk_bf16(o[j][1][4 * g] * il, o[j][1][4 * g + 1] * il); b.y = cvt_pk_bf16(o[j][1][4 * g + 2] * il, o[j][1][4 * g + 3] * il);
            *(u32x2*)(op + 8 * g) = a; *(u32x2*)(op + 32 + 8 * g) = b; }
    }
#undef ATT_DMA
#undef ka
#undef kb
}
__device__ __forceinline__ void phase_p3(LAS unsigned char* lds, const WS& w, int l, int vb, int nvb, int xpart, int xrank) {
    const float c2g = 0.125f * 1.4426950408889634f, c2m = 0.10206207261596577f * 1.4426950408889634f;
    bf16_t* MIX = w.H();
    const int nlat = NB * 12 * 4, nctx = (l == 0) ? NB * 12 : 0;
    const bool xl = (nvb == 256);
    for (int u = vb; u < nlat + nctx; u += nvb) {
        if (u < nlat) {
            const bool mla = u >= nlat / 2; const int v = mla ? u - nlat / 2 : u;
            int qb, hh, b;
            if (xl) { const int grp = (v >> 8) * 64 + 8 * xpart + (xrank >> 2); qb = xrank & 3; hh = grp % 6; b = grp / 6; }
            else { qb = v & 3; hh = (v >> 2) % 6; b = v / 24; }
            bf16_t* out = MIX + ((size_t)b * S + qb * 512) * 1024;
            if (!mla) attn_unit64<64>(lds, w.Qg() + (((size_t)b * 6 + hh) * S + qb * 512) * 64, w.Kg() + ((size_t)b * 2 + hh / 3) * KEYS * 64, nullptr, w.Vg() + ((size_t)b * 2 + hh / 3) * KEYS * 64, KEYS, out + hh * 64);
            else attn_unit64m(lds, w.Qm() + (((size_t)b * 6 + hh) * S + qb * 512) * 96, w.Kmn() + ((size_t)b * 6 + hh) * KEYS * 64, w.KR() + (size_t)b * KEYS * 32, w.Vm() + ((size_t)b * 6 + hh) * KEYS * 64, KEYS, out + 640 + hh * 64);
        } else {
            const int v = u - nlat, slot = v % 12, b = v / 12;
            bf16_t* out = MIX + ((size_t)NL + (size_t)b * CTX) * 1024;
            if (slot < 6) attn_unit<64>(lds, w.Qgc() + ((size_t)b * 6 + slot) * CTX * 64, w.Kg() + ((size_t)b * 2 + slot / 3) * KEYS * 64, nullptr, w.Vg() + ((size_t)b * 2 + slot / 3) * KEYS * 64, CTX, c2g, out + slot * 64);
            else { const int h = slot - 6; attn_unit<96>(lds, w.Qmc() + ((size_t)b * 6 + h) * CTX * 96, w.Kmn() + ((size_t)b * 6 + h) * KEYS * 64, w.KR() + (size_t)b * KEYS * 32, w.Vm() + ((size_t)b * 6 + h) * KEYS * 64, CTX, c2m, out + 640 + h * 64); }
        }
    }
}

__device__ __forceinline__ unsigned fkey(float f, unsigned tag, unsigned mask) { return (__float_as_uint(f) & ~mask) | tag; }
__device__ __forceinline__ float keyf(unsigned k, unsigned mask) { return __uint_as_float(k & ~mask); }
__device__ __forceinline__ unsigned fmax_u(unsigned a, unsigned b) { unsigned r; asm("v_max_f32 %0, %1, %2" : "=v"(r) : "v"(a), "v"(b)); return r; }
__device__ __forceinline__ unsigned fmin_u(unsigned a, unsigned b) { unsigned r; asm("v_min_f32 %0, %1, %2" : "=v"(r) : "v"(a), "v"(b)); return r; }
__device__ __forceinline__ void ce_desc(unsigned& a, unsigned& b) { const unsigned hi_ = fmax_u(a, b), lo_ = fmin_u(a, b); a = hi_; b = lo_; }
template <int J> __device__ __forceinline__ void bstage16(unsigned* a) {
#pragma unroll
    for (int i = 0; i < 16; ++i) { const int l = i ^ J; if (l > i) ce_desc(a[i], a[l]); }
}
__device__ __forceinline__ void sort16_desc(unsigned* a) {
#define CE_(i, j) ce_desc(a[i], a[j]);
    CE_(0, 13) CE_(1, 12) CE_(2, 15) CE_(3, 14) CE_(4, 8) CE_(5, 6) CE_(7, 11) CE_(9, 10)
    CE_(0, 5) CE_(1, 7) CE_(2, 9) CE_(3, 4) CE_(6, 13) CE_(8, 14) CE_(10, 15) CE_(11, 12)
    CE_(0, 1) CE_(2, 3) CE_(4, 5) CE_(6, 8) CE_(7, 9) CE_(10, 11) CE_(12, 13) CE_(14, 15)
    CE_(0, 2) CE_(1, 3) CE_(4, 10) CE_(5, 11) CE_(6, 7) CE_(8, 9) CE_(12, 14) CE_(13, 15)
    CE_(1, 2) CE_(3, 12) CE_(4, 6) CE_(5, 7) CE_(8, 10) CE_(9, 11) CE_(13, 14)
    CE_(1, 4) CE_(2, 6) CE_(5, 8) CE_(7, 10) CE_(9, 13) CE_(11, 14)
    CE_(2, 4) CE_(3, 6) CE_(9, 12) CE_(11, 13)
    CE_(3, 5) CE_(6, 8) CE_(7, 9) CE_(10, 12)
    CE_(3, 4) CE_(5, 6) CE_(7, 8) CE_(9, 10) CE_(11, 12)
    CE_(6, 7) CE_(8, 9)
#undef CE_
}
__device__ __forceinline__ void bmerge16_desc(unsigned* c) { bstage16<8>(c); bstage16<4>(c); bstage16<2>(c); bstage16<1>(c); }
__device__ __forceinline__ void merge_top16(unsigned* a, const unsigned* b) {
#pragma unroll
    for (int i = 0; i < 16; ++i) a[i] = fmax_u(a[i], b[15 - i]);
    bmerge16_desc(a);
}
__device__ __forceinline__ void xlane_top16(unsigned* t, int hi) {
    unsigned r[16]; const unsigned msk = 0u - (unsigned)hi;
#pragma unroll
    for (int i = 0; i < 16; ++i) r[i] = t[i] ^ ((t[i] ^ t[15 - i]) & msk);
#pragma unroll
    for (int i = 0; i < 16; ++i) { auto s = __builtin_amdgcn_permlane32_swap(r[i], r[i], false, false); t[i] = fmax_u(s[0], s[1]); }
    bmerge16_desc(t);
}
__device__ __forceinline__ constexpr int cand_a(int c) { return c < 16 ? 0 : c < 24 ? 1 : c < 32 ? 39 - c : c < 37 ? 2 : c < 41 ? 3 : c < 44 ? 4 : c < 46 ? 5 : c < 48 ? 6 : 7; }
__device__ __forceinline__ constexpr int cand_b(int c) { return c < 16 ? c : c < 24 ? c - 16 : c < 32 ? 0 : c < 37 ? c - 32 : c < 41 ? c - 37 : c < 44 ? c - 41 : c < 46 ? c - 44 : c < 48 ? c - 46 : c - 48; }

__device__ __forceinline__ void phase_p6b(LAS unsigned char* lds, const bf16_t* __restrict__ PQ, const bf16_t* __restrict__ SubKl, unsigned* __restrict__ EG, int nrows, int vb, int nvb) {
    int tid_ = threadIdx.x; asm volatile("" : "+v"(tid_));
    const int tid = tid_, lane = tid & 63, wid = __builtin_amdgcn_readfirstlane(tid >> 6), r32 = lane & 31, hi = lane >> 5;
    const int h = vb & 7, wrank = (vb >> 3) * 8 + wid, nwr = (nvb >> 3) * 8;
    LAS unsigned short* tab = (LAS unsigned short*)(lds + 65536 + wid * 4096) + r32 * 64;
#pragma unroll
    for (int i = 0; i < 8; ++i) { const int idx = i * 512 + tid, p = idx >> 11, key = (idx >> 4) & 127, ch = idx & 15;
        *(LAS u32x4*)(lds + p * 32768 + key * 256 + ((ch ^ (key & 15)) << 4)) = *(const u32x4*)(SubKl + ((size_t)(h * 2 + p) * 128 + key) * 128 + ch * 8); }
    __syncthreads();
    const int ngroups = nrows >> 5;
    for (int tg = wrank; tg < ngroups; tg += nwr) {
        const int row0 = tg << 5;
        bf16x8 qf[2][8];
        { const bf16_t* qp = PQ + (size_t)(row0 + r32) * 2048 + h * 256 + 8 * hi; asm volatile("" : "+v"(qp));
#pragma unroll
          for (int p = 0; p < 2; ++p)
#pragma unroll
              for (int s = 0; s < 8; ++s) qf[p][s] = *(const bf16x8*)(qp + p * 128 + 16 * s); }
        unsigned top[2][16];
#pragma unroll
        for (int p = 0; p < 2; ++p) {
            f32x16 acc[4];
#pragma unroll
            for (int kt = 0; kt < 4; ++kt) { acc[kt] = f32x16{}; const int key = 32 * kt + r32;
#pragma unroll
                for (int s = 0; s < 8; ++s) acc[kt] = mfma32(*(const LAS bf16x8*)(lds + p * 32768 + key * 256 + (((2 * s + hi) ^ (key & 15)) << 4)), qf[p][s], acc[kt]); }
            unsigned key[64];
#pragma unroll
            for (int kt = 0; kt < 4; ++kt)
#pragma unroll
                for (int r = 0; r < 16; ++r) { const int n = 32 * kt + (r & 3) + 8 * (r >> 2) + 4 * hi; key[16 * kt + r] = fkey(acc[kt][r], 127u - (unsigned)n, 127u); }
            sort16_desc(key); sort16_desc(key + 16); sort16_desc(key + 32); sort16_desc(key + 48);
            merge_top16(key, key + 16); merge_top16(key + 32, key + 48); merge_top16(key, key + 32);
            xlane_top16(key, hi);
#pragma unroll
            for (int i = 0; i < 16; ++i) top[p][i] = key[i];
        }
        float t0f[16], t1f[16];
#pragma unroll
        for (int i = 0; i < 16; ++i) { t0f[i] = keyf(top[0][i], 127u); t1f[i] = keyf(top[1][i], 127u); }
        unsigned ck[50];
#pragma unroll
        for (int c = 0; c < 50; ++c) ck[c] = fkey(t0f[cand_a(c)] + t1f[cand_b(c)], (unsigned)c, 63u);
        if (hi == 0) {
#pragma unroll
            for (int c = 0; c < 50; c += 2) {
                const unsigned ea = (127u - (top[0][cand_a(c)] & 127u)) * 128u + (127u - (top[1][cand_b(c)] & 127u));
                const unsigned eb = (127u - (top[0][cand_a(c + 1)] & 127u)) * 128u + (127u - (top[1][cand_b(c + 1)] & 127u));
                *(LAS unsigned*)(tab + c) = ea | (eb << 16);
            }
        }
        bmerge16_desc(ck + 16); sort16_desc(ck + 32);
        merge_top16(ck, ck + 16); merge_top16(ck, ck + 32);
        ck[15] = fmax_u(ck[15], ck[48]); ck[14] = fmax_u(ck[14], ck[49]); bmerge16_desc(ck);
        asm volatile("s_waitcnt lgkmcnt(0)" ::: "memory");
        const float mx = keyf(ck[0], 63u); float e[16], den = 0.f;
#pragma unroll
        for (int j = 0; j < 16; ++j) { e[j] = __builtin_amdgcn_exp2f((keyf(ck[j], 63u) - mx) * 1.4426950408889634f); den += e[j]; }
        const float iden = 1.f / den;
        if (hi == 0) {
            unsigned o[16];
#pragma unroll
            for (int j = 0; j < 16; ++j) { const unsigned eid = tab[ck[j] & 63u]; o[j] = (eid << 16) | (cvt_pk_bf16(e[j] * iden, 0.f) & 0xffffu); }
            unsigned* dst = EG + (size_t)(row0 + r32) * 128 + h * 16;
#pragma unroll
            for (int j = 0; j < 16; j += 4) *(u32x4*)(dst + j) = (u32x4){o[j], o[j + 1], o[j + 2], o[j + 3]};
        }
        asm volatile("s_waitcnt lgkmcnt(0)" ::: "memory");
    }
}


#define XB_TMO      128
#define XB_XCNT(j)  (256  + 64 * (j))
#define XB_XSUB(j)  (1280 + 64 * (j))
#define XB_XGEN(j)  (2304 + 64 * (j))
#define XB_TOP      3328
#define XB_TOPGEN   3392
#define XCD_BAR_WORDS 3456
#define XB_SPIN_CAP (1u << 18)

__device__ __forceinline__ unsigned xb_ld(unsigned* p)              { return __hip_atomic_load(p, __ATOMIC_RELAXED, __HIP_MEMORY_SCOPE_AGENT); }
__device__ __forceinline__ unsigned xb_add(unsigned* p, unsigned v) { return __hip_atomic_fetch_add(p, v, __ATOMIC_RELAXED, __HIP_MEMORY_SCOPE_AGENT); }
__device__ __forceinline__ unsigned xb_xcc_id() { return (unsigned)__builtin_amdgcn_s_getreg((3 << 11) | 20) & 0xFu; }
#define XB_SPIN(cond, bar) do { unsigned _sp = 0; while (cond) { __builtin_amdgcn_s_sleep(1); \
    if ((++_sp & 255u) == 0u) { if (xb_ld(&(bar)[XB_TMO])) break; if (_sp > XB_SPIN_CAP) { atomicAdd(&(bar)[XB_TMO], 1u); break; } } } } while (0)

struct XcdBarrier {
    unsigned* bar; unsigned x;
    volatile LAS unsigned* st;
};

__device__ __forceinline__ XcdBarrier xcd_barrier_post(unsigned* bar, volatile LAS unsigned* st) {
    XcdBarrier b; b.bar = bar; b.x = xb_xcc_id(); b.st = st;
    if (threadIdx.x == 0) (void)xb_add(&bar[XB_XCNT(b.x)], 1u);
    return b;
}
__device__ __forceinline__ void xcd_barrier_complete(unsigned* bar, unsigned x, unsigned& nloc, unsigned& nx) {
    const unsigned G = gridDim.x * gridDim.y * gridDim.z;
    unsigned sum, cnt, mine, sp = 0u;
    for (;;) {
        sum = 0u; cnt = 0u; mine = 0u;
#pragma unroll
        for (unsigned j = 0; j < 16; ++j) { const unsigned c = xb_ld(&bar[XB_XCNT(j)]); sum += c; cnt += (c > 0u) ? 1u : 0u; mine = (j == x) ? c : mine; }
        if (sum == G) break;
        __builtin_amdgcn_s_sleep(1);
        if ((++sp & 255u) == 0u) { if (xb_ld(&bar[XB_TMO])) break; if (sp > XB_SPIN_CAP) { atomicAdd(&bar[XB_TMO], 1u); break; } }
    }
    nloc = mine > 0u ? mine : 1u; nx = cnt > 0u ? cnt : 1u;
}

__device__ __forceinline__ void xcd_barrier(const XcdBarrier& b) {
    asm volatile("s_waitcnt vmcnt(0)" ::: "memory");
    __syncthreads();
    if (threadIdx.x == 0) {
        unsigned* bar = b.bar;
        __builtin_amdgcn_s_waitcnt(0);
        unsigned nloc = b.st[0], nx = b.st[1];
        if (nloc == 0u) { xcd_barrier_complete(bar, b.x, nloc, nx); b.st[0] = nloc; b.st[1] = nx; }
        const unsigned old = xb_add(&bar[XB_XSUB(b.x)], 1u);
        const unsigned gen = old / nloc;
        if (old + 1u == (gen + 1u) * nloc) {
            __builtin_amdgcn_fence(__ATOMIC_RELEASE, "agent");
            asm volatile("s_waitcnt vmcnt(0)" ::: "memory");
            const unsigned og = xb_add(&bar[XB_TOP], 1u);
            const unsigned tg = og / nx;
            if (og + 1u == (tg + 1u) * nx) xb_add(&bar[XB_TOPGEN], 1u);
            else XB_SPIN(xb_ld(&bar[XB_TOPGEN]) == tg, bar);
            __builtin_amdgcn_fence(__ATOMIC_ACQUIRE, "agent");
            xb_add(&bar[XB_XGEN(b.x)], 1u);
            asm volatile("s_waitcnt vmcnt(0)" ::: "memory");
        } else {
            XB_SPIN(xb_ld(&bar[XB_XGEN(b.x)]) == gen, bar);
            __builtin_amdgcn_fence(__ATOMIC_ACQUIRE, "agent");
            asm volatile("s_waitcnt vmcnt(0)" ::: "memory");
        }
    }
    __syncthreads();
}

__device__ __forceinline__ void phase_mod(LAS unsigned char* lds, const Inputs& in, const WS& w, int vb) {
    if (vb >= 72) return;
    LAS float* sc = (LAS float*)lds;
    int tid_ = threadIdx.x; asm volatile("" : "+v"(tid_));
    const int tid = tid_, idx = vb * 512 + tid, rg = idx / 12288, ln = idx % 12288, l = ln / 6144, n = ln % 6144;
    float acc[11];
#pragma unroll
    for (int i = 0; i < 11; ++i) acc[i] = 0.f;
    const float* wp = in.ada_w + (size_t)l * 1024 * 6144 + n;
    for (int kc = 0; kc < 4; ++kc) {
        for (int i = tid; i < 33 * 256; i += 512) { const int r = i >> 8, k = kc * 256 + (i & 255); const float v = r < 32 ? in.c[(size_t)r * 1024 + k] : in.c_ctx[k]; sc[i] = v / (1.f + __expf(-v)); }
        __syncthreads();
        for (int k = 0; k < 256; ++k) { const float wv = wp[(size_t)(kc * 256 + k) * 6144];
#pragma unroll
            for (int i = 0; i < 11; ++i) acc[i] += sc[(rg * 11 + i) * 256 + k] * wv; }
        __syncthreads();
    }
    const float bias = in.ada_b[(size_t)l * 6144 + n];
#pragma unroll
    for (int i = 0; i < 11; ++i) w.MOD()[((size_t)l * 33 + rg * 11 + i) * 6144 + n] = acc[i] + bias;
}
__device__ __forceinline__ void phase_rope(const WS& w, int vb, int nvb) {
    int tid_ = threadIdx.x; asm volatile("" : "+v"(tid_));
    for (int i = vb * 512 + tid_; i < 2048 * 32; i += nvb * 512) {
        { const int t = i / 32, j = i % 32; const double inv = pow(10000.0, -(double)(j % 16) / 16.0); const double a = (double)(j < 16 ? t / 64 : t % 64) * inv; w.ROPA()[i] = make_float2((float)cos(a), (float)sin(a)); }
        if (i < 2048 * 16) { const int t = i / 16, j = i % 16; const double inv = pow(10000.0, -(double)(j % 8) / 8.0); const double a = (double)(j < 8 ? t / 64 : t % 64) * inv; w.ROPC()[i] = make_float2((float)cos(a), (float)sin(a)); }
    }
}

#ifndef PROBE_MASK
#define PROBE_MASK 0
#endif
#ifndef BENCH_MODE
#define BENCH_MODE 0
#endif
#if BENCH_MODE
__device__ __forceinline__ void phase_bench(float* sink) {
    int tid_ = threadIdx.x; asm volatile("" : "+v"(tid_));
    float x[16];
#pragma unroll
    for (int i = 0; i < 16; ++i) x[i] = (float)(tid_ + i) * 0.001f;
    f32x16 acc[4] = {};
    bf16x8 a = (bf16x8){(short)tid_, 1, 2, 3, 4, 5, 6, 7}, b = (bf16x8){7, 6, 5, 4, 3, 2, 1, (short)tid_};
#pragma nounroll
    for (int it = 0; it < ((BENCH_MODE & 7) ? 2048 : 0); ++it) {
#pragma unroll
        for (int k = 0; k < 8; ++k) {
            if (BENCH_MODE & 2) { acc[k & 3] = mfma32(a, b, acc[k & 3]); }
            __builtin_amdgcn_sched_barrier(0);
            if (BENCH_MODE & 1) { asm volatile("v_exp_f32 %0, -|%0|" : "+v"(x[2 * k])); asm volatile("v_exp_f32 %0, -|%0|" : "+v"(x[2 * k + 1])); }
            if (BENCH_MODE & 4) {
#pragma unroll
                for (int j = 0; j < 8; ++j) asm volatile("v_fma_f32 %0, %0, %0, %0" : "+v"(x[(2 * k + j) & 15]));
            }
            __builtin_amdgcn_sched_barrier(0);
        }
    }
    if (BENCH_MODE & 24) {
        const int lane = tid_ & 63, r32 = lane & 31, hi = lane >> 5;
        unsigned ka[2][4];
#pragma unroll
        for (int kt = 0; kt < 2; ++kt)
#pragma unroll
            for (int s_ = 0; s_ < 4; ++s_) { const int key = 32 * kt + r32; ka[kt][s_] = key * 128 + (((2 * s_ + hi) ^ ((key >> 1) & 7)) << 4); }
        const int vq = (lane & 15) >> 2, vp = lane & 3, vg = (lane >> 4) & 1;
        unsigned va[2];
#pragma unroll
        for (int dvb = 0; dvb < 2; ++dvb) { const int key = 4 * hi + vq; va[dvb] = 8192 + key * 128 + ((((32 * dvb + 16 * vg + 4 * vp) * 2)) ^ (((key >> 1) & 1) << 6)); }
        u32x4 kr[8]; u32x2 vr[16];
#pragma nounroll
        for (int it = 0; it < 2048; ++it) {
            if (BENCH_MODE & 8) {
#pragma unroll
                for (int kt = 0; kt < 2; ++kt)
#pragma unroll
                    for (int s_ = 0; s_ < 4; ++s_) asm volatile("ds_read_b128 %0, %1" : "=v"(kr[kt * 4 + s_]) : "v"(ka[kt][s_]));
            }
            if (BENCH_MODE & 16) {
#pragma unroll
                for (int q = 0; q < 4; ++q)
#pragma unroll
                    for (int dvb = 0; dvb < 2; ++dvb) { asm volatile("ds_read_b64_tr_b16 %0, %1" : "=v"(vr[q * 4 + dvb * 2]) : "v"(va[dvb] + q * 2048)); asm volatile("ds_read_b64_tr_b16 %0, %1 offset:1024" : "=v"(vr[q * 4 + dvb * 2 + 1]) : "v"(va[dvb] + q * 2048)); }
            }
            asm volatile("s_waitcnt lgkmcnt(0)" ::: "memory");
        }
        if (BENCH_MODE & 8) {
#pragma unroll
            for (int i = 0; i < 8; ++i) x[i] += __uint_as_float(kr[i][0] ^ kr[i][1] ^ kr[i][2] ^ kr[i][3]);
        }
        if (BENCH_MODE & 16) {
#pragma unroll
            for (int i = 0; i < 16; ++i) x[i] += __uint_as_float(vr[i][0] ^ vr[i][1]);
        }
    }
    float r = 0.f;
#pragma unroll
    for (int i = 0; i < 16; ++i) r += x[i];
#pragma unroll
    for (int k = 0; k < 4; ++k)
#pragma unroll
        for (int i = 0; i < 16; ++i) r += acc[k][i];
    if (r == 1.2345e30f) sink[tid_] = r;
}
#endif
struct MegaArgs { Inputs in; WS w; float* XL; unsigned* bar; };
constexpr int MEGA_LDS = 131072 + 16;
__global__ void __launch_bounds__(512, 2) k_mega(MegaArgs A) {
    LAS unsigned char* lds = (LAS unsigned char*)dyn_lds;
    const int vb = blockIdx.x, nvb = gridDim.x;
    volatile LAS unsigned* xbw = (volatile LAS unsigned*)(lds + 131072);
    if (threadIdx.x == 0) { xbw[0] = 0u; xbw[1] = 0u; xbw[2] = 0u; xbw[3] = 0u; }
    __syncthreads();
    XcdBarrier bar = xcd_barrier_post(A.bar, xbw);
    if (threadIdx.x == 0) xbw[2] = xb_add(&A.bar[3584 + 64 * bar.x], 1u);
    __syncthreads();
    const int xticket = __builtin_amdgcn_readfirstlane((int)xbw[2]);
    const WS& w = A.w; const Inputs& in = A.in;
    phase_mod(lds, in, w, vb);
    phase_rope(w, vb, nvb);
    phase_cvt(lds, in, w, vb, nvb);
    xcd_barrier(bar);
    phase_modulate<false>(in.x, in.ctx, nullptr, w.H(), in.norm1_g, w.MOD(), 0, NR, vb, nvb);
    xcd_barrier(bar);
#if (PROBE_MASK >> 0) & 1
    phase_mod(lds, in, w, vb);
    phase_rope(w, vb, nvb);
    phase_cvt(lds, in, w, vb, nvb);
    xcd_barrier(bar);
    phase_modulate<false>(in.x, in.ctx, nullptr, w.H(), in.norm1_g, w.MOD(), 0, NR, vb, nvb);
    xcd_barrier(bar);
#endif
#if BENCH_MODE
    phase_bench((float*)w.RSQ());
#endif
    int xpart = vb & 7, xrank = vb >> 3;
    { bool okx = (bar.x < 8u); for (unsigned j = 0; j < 8; ++j) okx = okx && (xb_ld(&A.bar[XB_XCNT(j)]) == (unsigned)(nvb >> 3));
      if (okx) { xpart = (int)bar.x; xrank = xticket; } }
    for (int l = 0; l < DEPTH; ++l) {
        const float* MODl = w.MOD() + (size_t)l * 33 * 6144;
        const bool last = (l == DEPTH - 1);
        const int MR = last ? NL : NR;
        phase_p1(lds, w, in, l, vb, nvb); xcd_barrier(bar);
#if (PROBE_MASK >> 1) & 1
        phase_p1(lds, w, in, l, vb, nvb); xcd_barrier(bar);
#endif
        phase_p2(lds, w, in, l, vb, nvb); xcd_barrier(bar);
#if (PROBE_MASK >> 12) & 7
        phase_p2(lds, w, in, l, vb, nvb, (PROBE_MASK >> 12) & 7); xcd_barrier(bar);
#endif
        phase_p3(lds, w, l, vb, nvb, xpart, xrank); xcd_barrier(bar);
#if (PROBE_MASK >> 3) & 1
        phase_p3(lds, w, l, vb, nvb, xpart, xrank); xcd_barrier(bar);
#endif
        phase_p4(lds, w, in, l, vb, nvb);
        xcd_barrier(bar);
#if (PROBE_MASK >> 4) & 1
        phase_p4(lds, w, in, l, vb, nvb);
        xcd_barrier(bar);
#endif
        if (l == 0) phase_modulate<false>(in.x, in.ctx, nullptr, w.H(), in.norm2_g + l * 1024, MODl, 3, MR, vb, nvb, w.H8(), w.HS(), w.PQ(), w.XB());
        else phase_modulate<true>(nullptr, nullptr, w.XB(), w.H(), in.norm2_g + l * 1024, MODl, 3, MR, vb, nvb, w.H8(), w.HS(), w.PQ(), w.XB());
        xcd_barrier(bar);
#if (PROBE_MASK >> 5) & 1
        phase_modulate<true>(nullptr, nullptr, w.XB(), w.H(), in.norm2_g + l * 1024, MODl, 3, MR, vb, nvb, w.H8(), w.HS()); xcd_barrier(bar);
#endif
        phase_p6a(lds, w, l, vb, nvb); xcd_barrier(bar);
#if (PROBE_MASK >> 6) & 1
        phase_p6a(lds, w, l, vb, nvb); xcd_barrier(bar);
#endif
        phase_p6b(lds, w.PQ(), w.SubK() + (size_t)l * 16 * 128 * 128, w.EG(), MR, vb, nvb); xcd_barrier(bar);
#if (PROBE_MASK >> 7) & 1
        phase_p6b(lds, w.PQ(), w.SubK() + (size_t)l * 16 * 128 * 128, w.EG(), MR, vb, nvb); xcd_barrier(bar);
#endif
        { P7CArgs a{w.H8(), w.EG(), w.U8() + (size_t)l * NE * 1024, (int*)w.PQ(), MR}; phase_p7c(lds, a, xpart, xrank, nvb); }
        xcd_barrier(bar);
#if (PROBE_MASK >> 8) & 1
        { P7CArgs a{w.H8(), w.EG(), w.U8() + (size_t)l * NE * 1024, (int*)w.PQ(), MR}; phase_p7c(lds, a, xpart, xrank, nvb); }
        xcd_barrier(bar);
#endif
        phase_p7d((const int*)w.PQ(), w.EG(), w.US() + (size_t)l * NE, w.VS() + (size_t)l * NE, w.HS(), w.WE(), MR, vb, nvb);
        xcd_barrier(bar);
#if (PROBE_MASK >> 9) & 1
        phase_p7d((const int*)w.PQ(), w.EG(), w.US() + (size_t)l * NE, w.VS() + (size_t)l * NE, w.HS(), w.WE(), MR, vb, nvb);
        xcd_barrier(bar);
#endif
        { P7BArgs a{w.WE(), w.V8() + (size_t)l * NE * 1024, w.XB(), MODl + 5 * 1024, MR}; phase_p7b<0>(lds, a, xpart, xrank, nvb); }
        xcd_barrier(bar);
#if (PROBE_MASK >> 10) & 3
        { P7BArgs a{w.WE(), w.V8() + (size_t)l * NE * 1024, w.XB(), MODl + 5 * 1024, MR}; phase_p7b<((PROBE_MASK >> 10) & 3)>(lds, a, xpart, xrank, nvb); }
        xcd_barrier(bar);
#endif
        if (last) phase_final_norm(w.XB(), A.XL, in.final_g, vb, nvb);
        else phase_modulate<true>(nullptr, nullptr, w.XB(), w.H(), in.norm1_g + (l + 1) * 1024, w.MOD() + (size_t)(l + 1) * 33 * 6144, 0, NR, vb, nvb);
        if (!last) xcd_barrier(bar);
    }
}

extern "C" void kernel_launch(void* const* d_in, const int* in_sizes, int n_in, void* d_out, int out_size, void* d_ws, size_t ws_size, hipStream_t stream) {
    const float* const* fin = (const float* const*)d_in;
    Inputs in{fin[0], fin[1], fin[2], fin[3], fin[4], fin[5], fin[6], fin[7], fin[8], fin[9], fin[10], fin[11], fin[12], fin[13], fin[14], fin[15], fin[16], fin[17], fin[18], fin[19], fin[20], fin[21], fin[22]};
    WS w = make_ws(d_ws);
    static int ok = 0;
    if (!ok) {
        if (hipFuncSetAttribute((const void*)k_mega, hipFuncAttributeMaxDynamicSharedMemorySize, MEGA_LDS) != hipSuccess) { ok = -1; }
        int per_cu = 0, cus = 0, dev = 0; (void)hipGetDevice(&dev); (void)hipDeviceGetAttribute(&cus, hipDeviceAttributeMultiprocessorCount, dev);
        if (hipOccupancyMaxActiveBlocksPerMultiprocessor(&per_cu, (const void*)k_mega, 512, MEGA_LDS) != hipSuccess || per_cu < 1 || cus < 256) ok = -1;
        if (ok == 0) ok = 1;
    }
    if (ok < 0) return;
    (void)hipMemsetAsync(d_ws, 0, 16384, stream);
    MegaArgs A{in, w, (float*)d_out, (unsigned*)d_ws};
    k_mega<<<256, 512, MEGA_LDS, stream>>>(A);
}
```

```cpp
#include <hip/hip_runtime.h>
#include <stdint.h>

typedef unsigned short bf16_t;

constexpr int D = 1024, NB = 32, S = 2048, CTX = 256, DEPTH = 2;
constexpr int NL = NB * S, NC = NB * CTX, NR = NL + NC;
constexpr int KEYS = CTX + S;
constexpr int INC = 1568;
constexpr int NE = 16384;
constexpr float EPS = 1e-6f;

__device__ __forceinline__ float bf2f(bf16_t v) { return __uint_as_float(((unsigned)v) << 16); }
__device__ __forceinline__ bf16_t f2bf(float f) { unsigned u = __float_as_uint(f); u += 0x7FFFu + ((u >> 16) & 1u); return (bf16_t)(u >> 16); }

__device__ __forceinline__ float wave_sum(float v) {
#pragma unroll
    for (int o = 32; o > 0; o >>= 1) v += __shfl_xor(v, o);
    return v;
}
__device__ __forceinline__ float gelu_tanh(float x) {
    const float u = 0.7978845608028654f * (x + 0.044715f * x * x * x);
    return 0.5f * x * (1.f + tanhf(u));
}

struct WS {
    char* base;
    __host__ __device__ __forceinline__ bf16_t* H() const { return (bf16_t*)(base + 65536ull); }
    __host__ __device__ __forceinline__ bf16_t* Qg() const { return (bf16_t*)(base + 151060480ull); }
    __host__ __device__ __forceinline__ bf16_t* Qgc() const { return (bf16_t*)(base + 201392128ull); }
    __host__ __device__ __forceinline__ bf16_t* Kg() const { return (bf16_t*)(base + 207683584ull); }
    __host__ __device__ __forceinline__ bf16_t* Vg() const { return (bf16_t*)(base + 226557952ull); }
    __host__ __device__ __forceinline__ bf16_t* CQ() const { return (bf16_t*)(base + 245432320ull); }
    __host__ __device__ __forceinline__ bf16_t* CKV() const { return (bf16_t*)(base + 302055424ull); }
    __host__ __device__ __forceinline__ bf16_t* Bp() const { return (bf16_t*)(base + 339804160ull); }
    __host__ __device__ __forceinline__ bf16_t* KR() const { return (bf16_t*)(base + 377552896ull); }
    __host__ __device__ __forceinline__ bf16_t* Qm() const { return (bf16_t*)(base + 382271488ull); }
    __host__ __device__ __forceinline__ bf16_t* Qmc() const { return (bf16_t*)(base + 457768960ull); }
    __host__ __device__ __forceinline__ bf16_t* Kmn() const { return (bf16_t*)(base + 467206144ull); }
    __host__ __device__ __forceinline__ bf16_t* Vm() const { return (bf16_t*)(base + 523829248ull); }
    __host__ __device__ __forceinline__ unsigned* EG() const { return (unsigned*)(base + 580452352ull); }
    __host__ __device__ __forceinline__ bf16_t* P() const { return (bf16_t*)(base + 382271488ull); }
    __host__ __device__ __forceinline__ bf16_t* PQ() const { return (bf16_t*)(base + 151060480ull); }
    __host__ __device__ __forceinline__ bf16_t* TMP() const { return (bf16_t*)(base + 65536ull); }
    __host__ __device__ __forceinline__ float* XC() const { return (float*)(base + 618201088ull); }
    __host__ __device__ __forceinline__ float* MOD() const { return (float*)(base + 651755520ull); }
    __host__ __device__ __forceinline__ float2* ROPA() const { return (float2*)(base + 653377536ull); }
    __host__ __device__ __forceinline__ float2* ROPC() const { return (float2*)(base + 653901824ull); }
    __host__ __device__ __forceinline__ float* RSQ() const { return (float*)(base + 654163968ull); }
    __host__ __device__ __forceinline__ float* RSKV() const { return (float*)(base + 654458880ull); }
    __host__ __device__ __forceinline__ bf16_t* WinT() const { return (bf16_t*)(base + 654753792ull); }
    __host__ __device__ __forceinline__ bf16_t* WuqT() const { return (bf16_t*)(base + 662093824ull); }
    __host__ __device__ __forceinline__ bf16_t* WukvT() const { return (bf16_t*)(base + 663273472ull); }
    __host__ __device__ __forceinline__ bf16_t* WoutT() const { return (bf16_t*)(base + 664059904ull); }
    __host__ __device__ __forceinline__ bf16_t* WqT() const { return (bf16_t*)(base + 668254208ull); }
    __host__ __device__ __forceinline__ bf16_t* SubK() const { return (bf16_t*)(base + 676642816ull); }
    __host__ __device__ __forceinline__ unsigned char* U8() const { return (unsigned char*)(base + 677691392ull); }
    __host__ __device__ __forceinline__ unsigned char* V8() const { return (unsigned char*)(base + 711245824ull); }
    __host__ __device__ __forceinline__ float* US() const { return (float*)(base + 744800256ull); }
    __host__ __device__ __forceinline__ float* VS() const { return (float*)(base + 744931328ull); }
    __host__ __device__ __forceinline__ float* SSQ() const { return (float*)(base + 745062400ull); }
    __host__ __device__ __forceinline__ float* SSKV() const { return (float*)(base + 747421696ull); }
    __host__ __device__ __forceinline__ unsigned* WE() const { return (unsigned*)(base + 748601344ull); }
    __host__ __device__ __forceinline__ signed char* H8() const { return (signed char*)(base + 786350080ull); }
    __host__ __device__ __forceinline__ float* HS() const { return (float*)(base + 861847552ull); }
    __host__ __device__ __forceinline__ bf16_t* PoolWT() const { return (bf16_t*)(base + 862142464ull); }
    __host__ __device__ __forceinline__ bf16_t* XB() const { return (bf16_t*)(base + 862208000ull); }
};
constexpr size_t WS_BYTES = 862208000ull + (size_t)NR * 1024 * 2;
static WS make_ws(void* d_ws) { WS w; w.base = (char*)d_ws; return w; }


#define LAS __attribute__((address_space(3)))
typedef short bf16x8 __attribute__((ext_vector_type(8)));
typedef float f32x4 __attribute__((ext_vector_type(4)));
typedef float f32x16 __attribute__((ext_vector_type(16)));
typedef unsigned u32x4 __attribute__((ext_vector_type(4)));
typedef unsigned u32x2 __attribute__((ext_vector_type(2)));

__device__ __forceinline__ f32x16 mfma32(bf16x8 a, bf16x8 b, f32x16 c) { return __builtin_amdgcn_mfma_f32_32x32x16_bf16(a, b, c, 0, 0, 0); }
__device__ __forceinline__ unsigned cvt_pk_bf16(float lo, float hi) { unsigned r; asm volatile("v_cvt_pk_bf16_f32 %0, %1, %2" : "=v"(r) : "v"(lo), "v"(hi)); return r; }

namespace pg8 {
constexpr int BM = 256, BK = 64, HALF = 128, HTB = HALF * BK * 2, STAGE_BYTES = 8 * HTB, NXCD = 8, WGM = 8;
__host__ __device__ __forceinline__ int lds_byte(int r, int c) { const int st = (r >> 4) * 2 + (c >> 5), rr = r & 15, cc = c & 31, ob = rr * 64 + cc * 2; return st * 1024 + (ob ^ (((ob >> 9) & 1) << 5)); }
__host__ __device__ __forceinline__ void stage_rc(int b, int& R, int& C) { const int st = b / 1024, sb = b % 1024, swz = sb ^ (((sb >> 9) & 1) << 5); R = (st >> 1) * 16 + swz / 64; C = (st & 1) * 32 + (swz % 64) / 2; }
__host__ __device__ __forceinline__ int perm32(int rho) { const int n = rho >> 4, i = rho & 15; return 8 * (i >> 2) + 4 * n + (i & 3); }
struct Unit { int pm, pn; };
struct Gemm { const bf16_t* A; const bf16_t* Bt; int M, N, K; };
struct StaticOrder {
    int nM, nN, nwg, G, c;
    __host__ __device__ void init(int M, int N, int G_, int c_) { nM = M / BM; nN = N / BM; nwg = nM * nN; G = G_; c = c_; }
    __host__ __device__ bool next(int i, Unit& u) const {
        const long L = (long)i * G + c; if (L >= nwg) return false;
        int wgid = (int)L; { const int q = nwg / NXCD, r = nwg % NXCD, xcd = wgid % NXCD, off = wgid / NXCD; wgid = (xcd < r ? xcd * (q + 1) : r * (q + 1) + (xcd - r) * q) + off; }
        const int nig = WGM * nN, gid = wgid / nig, fm = gid * WGM, gsz = (nM - fm) < WGM ? (nM - fm) : WGM;
        u.pm = fm + ((wgid % nig) % gsz); u.pn = (wgid % nig) / gsz; return true;
    }
};
template <class Epi, class Sched>
__device__ __forceinline__ void gemm_phase(LAS unsigned char* lds, const Gemm g, const Sched& S, const Epi& E) {
    int tid_ = threadIdx.x; asm volatile("" : "+v"(tid_));
    const int tid = tid_, wid = __builtin_amdgcn_readfirstlane(tid >> 6), lane = tid & 63, wr = wid >> 2, wc = wid & 3, fr = lane & 15, fq = lane >> 4;
    const int K = g.K, nt = K / BK;
    unsigned voffA[2], voffB[2];
#pragma unroll
    for (int i = 0; i < 2; ++i) { int R, C; stage_rc(tid * 16 + i * 8192, R, C); const int Rb = Epi::PERM ? ((R & ~31) + perm32(R & 31)) : R;
        voffA[i] = (unsigned)(R * K + C) * 2u; voffB[i] = (unsigned)(Rb * K + C) * 2u; }
    const size_t kstep = (size_t)(BK * 2);
    const size_t hstep = (size_t)HALF * K * 2;
    const size_t tstep = 2 * hstep;
    const unsigned ldsw = (unsigned)wid * 1024u;
    const int aoff = lds_byte(wr * 64 + fr, fq * 8), boff = lds_byte(wc * 32 + fr, fq * 8);
#define PG8_SA(b, h) (((b) * 2 + (h)) * HTB)
#define PG8_SB(b, h) ((4 + (b) * 2 + (h)) * HTB)
#define PG8_STAGE(bufoff, gbase, voff) do { _Pragma("unroll") for (int _i = 0; _i < 2; ++_i) \
        __builtin_amdgcn_global_load_lds((const unsigned*)((const char*)(gbase) + (voff)[_i]), (LAS unsigned*)(lds + (bufoff) + ldsw + _i * 8192), 16, 0, 0); } while (0)
#define PG8_LDA(dst, b, h) do { _Pragma("unroll") for (int m = 0; m < 4; ++m) _Pragma("unroll") for (int k = 0; k < 2; ++k) dst[m][k] = *(const LAS bf16x8*)(lds + PG8_SA(b, h) + aoff + m * 2048 + k * 1024); } while (0)
#define PG8_LDB(dst, b, h) do { _Pragma("unroll") for (int n = 0; n < 2; ++n) _Pragma("unroll") for (int k = 0; k < 2; ++k) dst[n][k] = *(const LAS bf16x8*)(lds + PG8_SB(b, h) + boff + n * 2048 + k * 1024); } while (0)
#define PG8_MMA(ai, bj, At, Bt) do { __builtin_amdgcn_s_setprio(1); _Pragma("unroll") for (int m = 0; m < 4; ++m) _Pragma("unroll") for (int n = 0; n < 2; ++n) _Pragma("unroll") for (int k = 0; k < 2; ++k) \
        acc[ai][bj][m][n] = __builtin_amdgcn_mfma_f32_16x16x32_bf16(Bt[n][k], At[m][k], acc[ai][bj][m][n], 0, 0, 0); __builtin_amdgcn_s_setprio(0); } while (0)
#define PG8_WAIT_V(n) asm volatile("s_waitcnt vmcnt(" #n ")" ::: "memory")
#define PG8_WAIT_L(n) asm volatile("s_waitcnt lgkmcnt(" #n ")" ::: "memory")
#define PG8_BAR __builtin_amdgcn_s_barrier()
#define PG8_SCHED __builtin_amdgcn_sched_barrier(0)
    Unit cur, nxt; int ui = 0;
    if (!S.next(0, cur)) return;
    f32x4 acc[2][2][4][2];
#pragma unroll
    for (int a = 0; a < 2; ++a)
#pragma unroll
        for (int b = 0; b < 2; ++b)
#pragma unroll
            for (int m = 0; m < 4; ++m)
#pragma unroll
                for (int n = 0; n < 2; ++n) acc[a][b][m][n] = (f32x4){0.f, 0.f, 0.f, 0.f};
    bf16x8 At[4][2], B0[2][2], B1[2][2];
    const char* cA = (const char*)g.A + (size_t)cur.pm * tstep; const char* cB = (const char*)g.Bt + (size_t)cur.pn * tstep;
    PG8_STAGE(PG8_SB(0, 0), cB, voffB); PG8_STAGE(PG8_SA(0, 0), cA, voffA); PG8_STAGE(PG8_SB(0, 1), cB + hstep, voffB); PG8_STAGE(PG8_SA(0, 1), cA + hstep, voffA);
    if (wr == 1) PG8_BAR;
    PG8_WAIT_V(4); PG8_BAR;
    PG8_STAGE(PG8_SB(1, 0), cB + kstep, voffB); PG8_STAGE(PG8_SA(1, 0), cA + kstep, voffA); PG8_STAGE(PG8_SB(1, 1), cB + hstep + kstep, voffB);
    PG8_WAIT_V(6); PG8_BAR;
    for (;;) {
        const bool has_next = S.next(ui + 1, nxt);
        const char* nA = has_next ? (const char*)g.A + (size_t)nxt.pm * tstep : cA; const char* nB = has_next ? (const char*)g.Bt + (size_t)nxt.pn * tstep : cB;
#pragma nounroll
        for (int t = 0; t < nt; t += 2) {
            const bool last = (t == nt - 2);
            const char* a1 = cA + (size_t)(t + 1) * kstep;
            const char* a2 = last ? nA : cA + (size_t)(t + 2) * kstep; const char* b2 = last ? nB : cB + (size_t)(t + 2) * kstep;
            const char* a3 = a2 + kstep; const char* b3 = b2 + kstep;
            PG8_LDB(B0, 0, 0); PG8_SCHED; PG8_LDA(At, 0, 0); PG8_STAGE(PG8_SA(1, 1), a1 + hstep, voffA);
            PG8_WAIT_L(8); PG8_BAR; PG8_WAIT_L(0); PG8_MMA(0, 0, At, B0); PG8_BAR; PG8_SCHED;
            PG8_LDB(B1, 0, 1); PG8_STAGE(PG8_SB(0, 0), b2, voffB);
            PG8_BAR; PG8_WAIT_L(0); PG8_MMA(0, 1, At, B1); PG8_BAR;
            PG8_LDA(At, 0, 1); PG8_STAGE(PG8_SA(0, 0), a2, voffA);
            PG8_BAR; PG8_WAIT_L(0); PG8_MMA(1, 0, At, B0); PG8_BAR; PG8_SCHED;
            PG8_STAGE(PG8_SB(0, 1), b2 + hstep, voffB);
            PG8_WAIT_V(6); PG8_BAR; PG8_MMA(1, 1, At, B1); PG8_BAR;
            PG8_LDB(B0, 1, 0); PG8_SCHED; PG8_LDA(At, 1, 0); PG8_STAGE(PG8_SA(0, 1), a2 + hstep, voffA);
            PG8_WAIT_L(8); PG8_BAR; PG8_WAIT_L(0); PG8_MMA(0, 0, At, B0); PG8_BAR; PG8_SCHED;
            PG8_LDB(B1, 1, 1); PG8_STAGE(PG8_SB(1, 0), b3, voffB);
            PG8_BAR; PG8_WAIT_L(0); PG8_MMA(0, 1, At, B1); PG8_BAR;
            PG8_LDA(At, 1, 1); PG8_STAGE(PG8_SA(1, 0), a3, voffA);
            PG8_BAR; PG8_WAIT_L(0); PG8_MMA(1, 0, At, B0); PG8_BAR; PG8_SCHED;
            PG8_STAGE(PG8_SB(1, 1), b3 + hstep, voffB);
            PG8_WAIT_V(6); PG8_BAR; PG8_MMA(1, 1, At, B1); PG8_BAR;
        }
        E(acc, cur, wr, wc, fr, fq);
        if (!has_next) break;
#pragma unroll
        for (int a = 0; a < 2; ++a)
#pragma unroll
            for (int b = 0; b < 2; ++b)
#pragma unroll
                for (int m = 0; m < 4; ++m)
#pragma unroll
                    for (int n = 0; n < 2; ++n) acc[a][b][m][n] = (f32x4){0.f, 0.f, 0.f, 0.f};
        cur = nxt; cA = nA; cB = nB; ++ui;
    }
    PG8_WAIT_V(0);
    if (wr == 0) PG8_BAR;
    PG8_BAR;
#undef PG8_SA
#undef PG8_SB
#undef PG8_STAGE
#undef PG8_LDA
#undef PG8_LDB
#undef PG8_MMA
#undef PG8_WAIT_V
#undef PG8_WAIT_L
#undef PG8_BAR
#undef PG8_SCHED
}
}

enum { GT_AQ = 0, GT_AK = 1, GT_AV = 2, GT_B = 3, GT_CQ = 4, GT_CKV = 5, GT_KR = 6, GT_PAD = 7 };
__host__ __device__ __forceinline__ void in_group(int g, int& type, int& sub) {
    if (g < 2) { type = GT_AK; sub = g; } else if (g < 4) { type = GT_AV; sub = g - 2; } else if (g < 8) { type = GT_CKV; sub = g - 4; }
    else if (g == 8) { type = GT_KR; sub = 0; } else if (g < 12) { type = GT_PAD; sub = 0; } else if (g < 18) { type = GT_AQ; sub = g - 12; }
    else if (g < 24) { type = GT_CQ; sub = g - 18; } else { type = GT_B; sub = g - 24; }
}
__device__ __forceinline__ int colmap(int mode, int r) {
    const int pn = r >> 8, ct = r & 255, bj = ct >> 7, wc = (ct >> 5) & 3, j = ct & 31, g = 4 * pn + wc, e = 32 * bj + j;
    if (mode == 0) {
        int type, sub; in_group(g, type, sub);
        switch (type) { case GT_AQ: return 64 * sub + e; case GT_AK: return 384 + 64 * sub + e; case GT_AV: return 512 + 64 * sub + e; case GT_B: return 640 + 64 * sub + e;
            case GT_CQ: return 896 + 64 * sub + e; case GT_CKV: return 1280 + 64 * sub + e; case GT_KR: return (j < 16) ? 1536 + 16 * bj + j : -1; default: return -1; }
    } else if (mode == 1) {
        if (g < 6) return 96 * g + e; if (g < 9) { const int head = 2 * (g - 6) + (j >> 4); return 96 * head + 64 + 16 * bj + (j & 15); } return -1;
    } else if (mode == 2) {
        return 64 * g + e;
    }
    return r;
}
__device__ __forceinline__ void cvt_weights_unit(LAS float* tile  , const float* __restrict__ W, int K, int N, bf16_t* __restrict__ dst, int mode, const float* __restrict__ kgain, int r0, int k0) {
    int tid_ = threadIdx.x; asm volatile("" : "+v"(tid_));
    const int tid = tid_;
    const int jj = tid & 63; const int sc = colmap(mode, r0 + jj);
#pragma unroll
    for (int i = 0; i < 8; ++i) { const int kk = (tid >> 6) + 8 * i; float v = 0.f; if (sc >= 0) v = W[(size_t)(k0 + kk) * N + sc]; if (kgain) v *= kgain[k0 + kk]; tile[kk * 65 + jj] = v; }
    __syncthreads();
#pragma unroll
    for (int i = 0; i < 8; ++i) { const int rr = (tid >> 6) + 8 * i, kk = tid & 63; dst[(size_t)(r0 + rr) * K + k0 + kk] = f2bf(tile[kk * 65 + rr]); }
    __syncthreads();
}
struct CvtJob { const float* W; bf16_t* dst; const float* kgain; int K, N, Npad, mode; };
__device__ __forceinline__ void cvt_job(LAS float* tile, const CvtJob j, int vb, int nvb) {
    const int nk = j.K / 64, nr = j.Npad / 64;
    for (int u = vb; u < nk * nr; u += nvb) cvt_weights_unit(tile, j.W, j.K, j.N, j.dst, j.mode, j.kgain, (u / nk) * 64, (u % nk) * 64);
}
__device__ __forceinline__ void cvt_flat(const float* __restrict__ src, bf16_t* __restrict__ dst, size_t n, int vb, int nvb) {
    int tid_ = threadIdx.x; asm volatile("" : "+v"(tid_));
    for (size_t i = ((size_t)vb * 512 + tid_) * 8; i < n; i += (size_t)nvb * 512 * 8) {
        const float4 a = *(const float4*)(src + i), b = *(const float4*)(src + i + 4);
        u32x4 o; o.x = cvt_pk_bf16(a.x, a.y); o.y = cvt_pk_bf16(a.z, a.w); o.z = cvt_pk_bf16(b.x, b.y); o.w = cvt_pk_bf16(b.z, b.w);
        *(u32x4*)(dst + i) = o;
    }
}
template <bool FP8>
__device__ __forceinline__ void cvt_q8_rows(const float* __restrict__ src, unsigned char* __restrict__ dst, float* __restrict__ scales, int nrows, int vb, int nvb) {
    int tid_ = threadIdx.x; asm volatile("" : "+v"(tid_));
    const int lane = tid_ & 63, wid = tid_ >> 6;
    const int stride = nvb * 8;
    for (int row0 = vb * 8 + wid; row0 < nrows; row0 += 4 * stride) {
        f32x4 v[4][4];
#pragma unroll
        for (int q = 0; q < 4; ++q) { const int row = row0 + q * stride < nrows ? row0 + q * stride : row0; const float* sp = src + (size_t)row * 1024 + 16 * lane;
#pragma unroll
            for (int k = 0; k < 4; ++k) v[q][k] = *(const f32x4*)(sp + 4 * k); }
#pragma unroll
        for (int q = 0; q < 4; ++q) { const int row = row0 + q * stride; if (row < nrows) {
            float am = 0.f;
#pragma unroll
            for (int k = 0; k < 4; ++k) am = fmaxf(am, fmaxf(fmaxf(fabsf(v[q][k][0]), fabsf(v[q][k][1])), fmaxf(fabsf(v[q][k][2]), fabsf(v[q][k][3]))));
#pragma unroll
            for (int o = 32; o > 0; o >>= 1) am = fmaxf(am, __shfl_xor(am, o));
            const float qmax = FP8 ? 416.f : 127.f;
            const float sc = am > 0.f ? am / qmax : 1.f, inv = am > 0.f ? qmax / am : 0.f;
            u32x4 o4;
#pragma unroll
            for (int k = 0; k < 4; ++k) {
                if (FP8) { int p = __builtin_amdgcn_cvt_pk_fp8_f32(v[q][k][0] * inv, v[q][k][1] * inv, 0, false); p = __builtin_amdgcn_cvt_pk_fp8_f32(v[q][k][2] * inv, v[q][k][3] * inv, p, true); o4[k] = (unsigned)p; }
                else { const int q0 = (int)rintf(v[q][k][0] * inv), q1 = (int)rintf(v[q][k][1] * inv), q2 = (int)rintf(v[q][k][2] * inv), q3 = (int)rintf(v[q][k][3] * inv);
                    o4[k] = (unsigned)(q0 & 0xff) | ((unsigned)(q1 & 0xff) << 8) | ((unsigned)(q2 & 0xff) << 16) | ((unsigned)(q3 & 0xff) << 24); } }
            *(u32x4*)(dst + (size_t)row * 1024 + 16 * lane) = o4;
            if (lane == 0) scales[row] = sc; } }
    }
}
struct Inputs {
    const float *x, *c, *ctx, *c_ctx, *ada_w, *ada_b, *norm1_g, *norm2_g, *w_in, *gqa_qn_g, *gqa_kn_g, *pool_w, *pool_scale, *mla_qn_g, *mla_kvn_g, *mla_w_uq, *mla_w_ukv, *w_out, *peer_wq, *peer_subkeys, *peer_u, *peer_v, *final_g;
};
__device__ __forceinline__ void phase_cvt(LAS unsigned char* lds, const Inputs& in, const WS& w, int vb, int nvb) {
    LAS float* tile = (LAS float*)lds;
    for (int l = 0; l < 2; ++l) {
        cvt_job(tile, CvtJob{in.w_in + (size_t)l * 1024 * INC, w.WinT() + (size_t)l * 1792 * 1024, nullptr, 1024, INC, 1792, 0}, vb, nvb);
        cvt_job(tile, CvtJob{in.mla_w_uq + (size_t)l * 384 * 576, w.WuqT() + (size_t)l * 768 * 384, in.mla_qn_g + l * 384, 384, 576, 768, 1}, vb, nvb);
        cvt_job(tile, CvtJob{in.mla_w_ukv + (size_t)l * 256 * 768, w.WukvT() + (size_t)l * 768 * 256, in.mla_kvn_g + l * 256, 256, 768, 768, 2}, vb, nvb);
        cvt_job(tile, CvtJob{in.w_out + (size_t)l * 1024 * 1024, w.WoutT() + (size_t)l * 1024 * 1024, nullptr, 1024, 1024, 1024, 3}, vb, nvb);
        cvt_job(tile, CvtJob{in.peer_wq + (size_t)l * 1024 * 2048, w.WqT() + (size_t)l * 2048 * 1024, nullptr, 1024, 2048, 2048, 3}, vb, nvb);
    }
    cvt_flat(in.peer_subkeys, w.SubK(), (size_t)2 * 16 * 128 * 128, vb, nvb);
    { int tp_ = threadIdx.x; asm volatile("" : "+v"(tp_));
      for (int i = vb * 512 + tp_; i < 2 * 4 * 64 * 64; i += nvb * 512) { const int c = i & 63, d = (i >> 6) & 63, lg = i >> 12; w.PoolWT()[i] = f2bf(in.pool_w[(size_t)lg * 4096 + c * 64 + d]); } }
    if (nvb > 144) { if (vb >= 72) { cvt_q8_rows<false>(in.peer_u, w.U8(), w.US(), 2 * NE, vb - 72, nvb - 72); cvt_q8_rows<true>(in.peer_v, w.V8(), w.VS(), 2 * NE, vb - 72, nvb - 72); } }
    else { cvt_q8_rows<false>(in.peer_u, w.U8(), w.US(), 2 * NE, vb, nvb); cvt_q8_rows<true>(in.peer_v, w.V8(), w.VS(), 2 * NE, vb, nvb); }
}

constexpr float ATT_C2G = 0.125f * 1.4426950408889634f, ATT_C2M = 0.10206207261596577f * 1.4426950408889634f;
struct EpiIn {
    static constexpr bool PERM = true;
    WS w; const float* qn_g; const float* kn_g; int pm_base;
    __device__ __forceinline__ void operator()(const f32x4 (&acc)[2][2][4][2], const pg8::Unit& u, int wr, int wc, int fr, int fq) const {
        int type, sub; in_group(4 * u.pn + wc, type, sub);
        if (type == GT_PAD) return;
        const int pm = u.pm + pm_base; const bool isctx = pm >= 256; const int b = isctx ? pm - 256 : pm >> 3; const int t0 = isctx ? 0 : (pm & 7) * 256;
        const size_t rowbase = isctx ? (size_t)NL + (size_t)b * CTX : (size_t)b * S;
        const int keyoff = isctx ? 0 : CTX;
        float gain[2][8];
        if (type == GT_AQ) {
#pragma unroll
            for (int bj = 0; bj < 2; ++bj)
#pragma unroll
                for (int q = 0; q < 8; ++q) gain[bj][q] = qn_g[32 * bj + 8 * fq + q] * ATT_C2G;
        } else if (type == GT_AK) {
#pragma unroll
            for (int bj = 0; bj < 2; ++bj)
#pragma unroll
                for (int q = 0; q < 8; ++q) gain[bj][q] = kn_g[32 * bj + 8 * fq + q];
        }
#pragma unroll
        for (int ai = 0; ai < 2; ++ai)
#pragma unroll
            for (int m = 0; m < 4; ++m) {
                const int t = t0 + 128 * ai + 64 * wr + 16 * m + fr; const size_t row = rowbase + t;
                float v[2][8];
#pragma unroll
                for (int bj = 0; bj < 2; ++bj)
#pragma unroll
                    for (int n = 0; n < 2; ++n)
#pragma unroll
                        for (int i = 0; i < 4; ++i) v[bj][4 * n + i] = acc[ai][bj][m][n][i];
                bf16_t* dst = nullptr;
                if (type == GT_AQ || type == GT_AK) {
                    float ss = 0.f;
#pragma unroll
                    for (int bj = 0; bj < 2; ++bj)
#pragma unroll
                        for (int q = 0; q < 8; ++q) ss += v[bj][q] * v[bj][q];
                    ss += __shfl_xor(ss, 16); ss += __shfl_xor(ss, 32);
                    const float rstd = rsqrtf(ss * (1.f / 64.f) + EPS);
#pragma unroll
                    for (int q = 0; q < 8; ++q) { float x1 = v[0][q] * rstd * gain[0][q], x2 = v[1][q] * rstd * gain[1][q];
                        if (!isctx) { const float2 cs = w.ROPA()[t * 32 + 8 * fq + q]; const float y1 = x1 * cs.x - x2 * cs.y, y2 = x1 * cs.y + x2 * cs.x; x1 = y1; x2 = y2; }
                        v[0][q] = x1; v[1][q] = x2; }
                    if (type == GT_AQ) dst = isctx ? w.Qgc() + (((size_t)b * 6 + sub) * CTX + t) * 64 : w.Qg() + (((size_t)b * 6 + sub) * S + t) * 64;
                    else dst = w.Kg() + (((size_t)b * 2 + sub) * KEYS + keyoff + t) * 64;
                } else if (type == GT_AV) { dst = w.Vg() + (((size_t)b * 2 + sub) * KEYS + keyoff + t) * 64;
                } else if (type == GT_B) { dst = w.Bp() + row * 256 + 64 * sub;
                } else if (type == GT_CQ || type == GT_CKV) {
                    float ss = 0.f;
#pragma unroll
                    for (int bj = 0; bj < 2; ++bj)
#pragma unroll
                        for (int q = 0; q < 8; ++q) ss += v[bj][q] * v[bj][q];
                    ss += __shfl_xor(ss, 16); ss += __shfl_xor(ss, 32);
                    if (type == GT_CQ) { if (fq == 0) w.SSQ()[row * 8 + sub] = ss; dst = w.CQ() + row * 384 + 64 * sub; }
                    else { if (fq == 0) w.SSKV()[row * 4 + sub] = ss; dst = w.CKV() + row * 256 + 64 * sub; }
                } else {
                    if (!isctx) {
#pragma unroll
                        for (int q = 0; q < 8; ++q) { const float2 cs = w.ROPC()[t * 16 + ((8 * fq + q) & 15)]; const float x1 = v[0][q], x2 = v[1][q]; v[0][q] = x1 * cs.x - x2 * cs.y; v[1][q] = x1 * cs.y + x2 * cs.x; } }
                    if (fq < 2) { bf16_t* kd = w.KR() + ((size_t)b * KEYS + keyoff + t) * 32;
#pragma unroll
                        for (int bj = 0; bj < 2; ++bj) { u32x4 o; o.x = cvt_pk_bf16(v[bj][0], v[bj][1]); o.y = cvt_pk_bf16(v[bj][2], v[bj][3]); o.z = cvt_pk_bf16(v[bj][4], v[bj][5]); o.w = cvt_pk_bf16(v[bj][6], v[bj][7]);
                            *(u32x4*)(kd + 16 * bj + 8 * fq) = o; } }
                    continue;
                }
#pragma unroll
                for (int bj = 0; bj < 2; ++bj) { u32x4 o; o.x = cvt_pk_bf16(v[bj][0], v[bj][1]); o.y = cvt_pk_bf16(v[bj][2], v[bj][3]); o.z = cvt_pk_bf16(v[bj][4], v[bj][5]); o.w = cvt_pk_bf16(v[bj][6], v[bj][7]);
                    *(u32x4*)(dst + 32 * bj + 8 * fq) = o; }
            }
    }
};
struct P1Order {
    pg8::StaticOrder so; int nctx_tiles, G, c;
    __device__ bool next(int i, pg8::Unit& u) const {
        const int L = i * G + c;
        if (L < 1792) return so.next(i, u);
        const int Lc = L - 1792; if (Lc >= 32 * nctx_tiles) return false;
        u.pm = 256 + (Lc & 31); u.pn = Lc >> 5; return true;
    }
};
__device__ __forceinline__ void phase_p1(LAS unsigned char* lds, const WS& w, const Inputs& in, int l, int vb, int nvb) {
    EpiIn E{w, in.gqa_qn_g + l * 64, in.gqa_kn_g + l * 64, 0};
    P1Order po; po.so.init(NL, 1792, nvb, vb); po.nctx_tiles = (l == 0) ? 7 : 3; po.G = nvb; po.c = vb;
    pg8::gemm_phase(lds, pg8::Gemm{w.H(), w.WinT() + (size_t)l * 1792 * 1024, NR, 1792, 1024}, po, E);
}

extern __shared__ __attribute__((aligned(16))) unsigned char dyn_lds[];

struct EpiUq {
    static constexpr bool PERM = true;
    WS w;
    __device__ __forceinline__ void operator()(const f32x4 (&acc)[2][2][4][2], const pg8::Unit& u, int wr, int wc, int fr, int fq) const {
        const int g = 4 * u.pn + wc; if (g >= 9) return;
        const int pm = u.pm; const bool isctx = pm >= 256; const int b = isctx ? pm - 256 : pm >> 3; const int t0 = isctx ? 0 : (pm & 7) * 256;
        const size_t rowbase = isctx ? (size_t)NL + (size_t)b * CTX : (size_t)b * S;
        const int head = g < 6 ? g : 2 * (g - 6) + (fq >> 1);
#pragma unroll
        for (int ai = 0; ai < 2; ++ai)
#pragma unroll
            for (int m = 0; m < 4; ++m) {
                const int t = t0 + 128 * ai + 64 * wr + 16 * m + fr; const size_t row = rowbase + t;
                const float4 s0 = *(const float4*)(w.SSQ() + row * 8), s1 = *(const float4*)(w.SSQ() + row * 8 + 4);
                const float rstd = rsqrtf((s0.x + s0.y + s0.z + s0.w + s1.x + s1.y) * (1.f / 384.f) + EPS) * ATT_C2M;
                float v[2][8];
#pragma unroll
                for (int bj = 0; bj < 2; ++bj)
#pragma unroll
                    for (int n = 0; n < 2; ++n)
#pragma unroll
                        for (int i = 0; i < 4; ++i) v[bj][4 * n + i] = acc[ai][bj][m][n][i] * rstd;
                bf16_t* hd = isctx ? w.Qmc() + (((size_t)b * 6 + head) * CTX + t) * 96 : w.Qm() + (((size_t)b * 6 + head) * S + t) * 96;
                if (g >= 6 && !isctx) {
#pragma unroll
                    for (int q = 0; q < 8; ++q) { const float2 cs = w.ROPC()[t * 16 + 8 * (fq & 1) + q]; const float x1 = v[0][q], x2 = v[1][q]; v[0][q] = x1 * cs.x - x2 * cs.y; v[1][q] = x1 * cs.y + x2 * cs.x; } }
#pragma unroll
                for (int bj = 0; bj < 2; ++bj) { u32x4 o; o.x = cvt_pk_bf16(v[bj][0], v[bj][1]); o.y = cvt_pk_bf16(v[bj][2], v[bj][3]); o.z = cvt_pk_bf16(v[bj][4], v[bj][5]); o.w = cvt_pk_bf16(v[bj][6], v[bj][7]);
                    bf16_t* d = g < 6 ? hd + 32 * bj + 8 * fq : hd + 64 + 16 * bj + 8 * (fq & 1);
                    *(u32x4*)d = o; }
            }
    }
};
struct EpiUkv {
    static constexpr bool PERM = true;
    WS w;
    __device__ __forceinline__ void operator()(const f32x4 (&acc)[2][2][4][2], const pg8::Unit& u, int wr, int wc, int fr, int fq) const {
        const int g = 4 * u.pn + wc;
        const int pm = u.pm; const bool isctx = pm >= 256; const int b = isctx ? pm - 256 : pm >> 3; const int t0 = isctx ? 0 : (pm & 7) * 256;
        const size_t rowbase = isctx ? (size_t)NL + (size_t)b * CTX : (size_t)b * S; const int keyoff = isctx ? 0 : CTX;
        bf16_t* base = ((g & 1) ? w.Vm() : w.Kmn()) + ((size_t)b * 6 + (g >> 1)) * KEYS * 64;
#pragma unroll
        for (int ai = 0; ai < 2; ++ai)
#pragma unroll
            for (int m = 0; m < 4; ++m) {
                const int t = t0 + 128 * ai + 64 * wr + 16 * m + fr; const size_t row = rowbase + t;
                const float4 s0 = *(const float4*)(w.SSKV() + row * 4);
                const float rstd = rsqrtf((s0.x + s0.y + s0.z + s0.w) * (1.f / 256.f) + EPS);
                bf16_t* d = base + (size_t)(keyoff + t) * 64;
#pragma unroll
                for (int bj = 0; bj < 2; ++bj) { const f32x4 a0 = acc[ai][bj][m][0] * rstd, a1 = acc[ai][bj][m][1] * rstd;
                    u32x4 o; o.x = cvt_pk_bf16(a0[0], a0[1]); o.y = cvt_pk_bf16(a0[2], a0[3]); o.z = cvt_pk_bf16(a1[0], a1[1]); o.w = cvt_pk_bf16(a1[2], a1[3]);
                    *(u32x4*)(d + 32 * bj + 8 * fq) = o; }
            }
    }
};
constexpr int POOL_X = 0, POOL_P = 272 * 128, POOL_BYTES = 272 * 128 + 256 * 128;
template <int G>
__device__ __forceinline__ void pool_sums(LAS unsigned char* lds, int tid, int t0, int L) {
    constexpr int wdw = 2 << G, half = wdw >> 1, NX = 32 + wdw - 1;
    const int c = tid & 63, seg = tid >> 6; const LAS bf16_t* X = (const LAS bf16_t*)(lds + POOL_X) + c + (seg * 32 + 8 - half) * 64;
    const int tb = t0 + seg * 32;
    float xr[NX], xm[NX];
#pragma unroll
    for (int j = 0; j < NX; ++j) xr[j] = bf2f(X[j * 64]);
#pragma unroll
    for (int j = 0; j < NX; ++j) { const int row = tb - half + j; xm[j] = (row >= 0 && row < L) ? xr[j] : 0.f; }
    float sum = 0.f;
#pragma unroll
    for (int j = 0; j < wdw; ++j) sum += xm[j];
#pragma unroll
    for (int k = 0; k < 32; ++k) {
        const int t = tb + k; const int clo = (t - half) < 0 ? 0 : (t - half), chi = (t - half + wdw) > L ? L : (t - half + wdw);
        const float pv = sum / (float)(chi - clo) - xr[k + half];
        const int r = seg * 32 + k; *((LAS bf16_t*)(lds + POOL_P + r * 128 + (((c >> 3) ^ ((r >> 1) & 7)) << 4)) + (c & 7)) = f2bf(pv);
        if (k < 31) sum += xm[k + wdw] - xm[k];
    }
}
__device__ __forceinline__ void phase_pool(LAS unsigned char* lds, const WS& w, bf16_t* __restrict__ MIX, const bf16_t* __restrict__ WT  , const float* __restrict__ pool_scale, int nrows, int vb, int nvb) {
    int tid_ = threadIdx.x; asm volatile("" : "+v"(tid_));
    const int tid = tid_, lane = tid & 63, wid = __builtin_amdgcn_readfirstlane(tid >> 6), r32 = lane & 31, hi = lane >> 5;
    const int nunits = nrows >> 8;
    const int nmine = vb < nunits ? ((nunits - 1 - vb) / nvb + 1) * 4 : 0;
    u32x4 st[5];
#define POOL_FETCH(it_) do { const int u_ = vb + ((it_) >> 2) * nvb, g_ = (it_) & 3; const int row0_ = u_ << 8; const bool ic_ = row0_ >= NL; const int L_ = ic_ ? CTX : S; const int t0_ = ic_ ? 0 : (row0_ & (S - 1)); const int seq0_ = row0_ - t0_; \
        _Pragma("unroll") for (int k_ = 0; k_ < 5; ++k_) { int i_ = tid + 512 * k_; i_ = i_ < 272 * 8 ? i_ : 272 * 8 - 1; const int rr_ = i_ >> 3, ch_ = i_ & 7; int t_ = t0_ - 8 + rr_; t_ = t_ < 0 ? 0 : (t_ >= L_ ? L_ - 1 : t_); \
            st[k_] = *(const u32x4*)(w.Bp() + (size_t)(seq0_ + t_) * 256 + g_ * 64 + ch_ * 8); } } while (0)
    if (nmine > 0) POOL_FETCH(0);
    for (int it = 0; it < nmine; ++it) {
        const int u = vb + (it >> 2) * nvb, g = it & 3;
        const int row0 = u << 8; const bool isctx = row0 >= NL; const int L = isctx ? CTX : S; const int t0 = isctx ? 0 : (row0 & (S - 1));
        {
#pragma unroll
            for (int k = 0; k < 5; ++k) { const int i = tid + 512 * k; if (i < 272 * 8) *(LAS u32x4*)(lds + POOL_X + (i >> 3) * 128 + (i & 7) * 16) = st[k]; }
            { const int nx = it + 1 < nmine ? it + 1 : it; POOL_FETCH(nx); }
            __syncthreads();
            if (g == 0) pool_sums<0>(lds, tid, t0, L); else if (g == 1) pool_sums<1>(lds, tid, t0, L); else if (g == 2) pool_sums<2>(lds, tid, t0, L); else pool_sums<3>(lds, tid, t0, L);
            __syncthreads();
            { f32x16 o0 = {}, o1 = {};
              const bf16_t* wt = WT + (size_t)g * 4096 + (size_t)r32 * 64 + 8 * hi;
#pragma unroll
              for (int s = 0; s < 4; ++s) { const int row = wid * 32 + r32; const bf16x8 pf = *(const LAS bf16x8*)(lds + POOL_P + row * 128 + (((2 * s + hi) ^ ((row >> 1) & 7)) << 4));
                  o0 = mfma32(*(const bf16x8*)(wt + 16 * s), pf, o0); o1 = mfma32(*(const bf16x8*)(wt + 32 * 64 + 16 * s), pf, o1); }
              bf16_t* op = MIX + (size_t)(row0 + wid * 32 + r32) * 1024 + 384 + g * 64 + 4 * hi; const float* ps = pool_scale + g * 64 + 4 * hi;
#pragma unroll
              for (int q = 0; q < 4; ++q) { const f32x4 s0 = *(const f32x4*)(ps + 8 * q), s1 = *(const f32x4*)(ps + 32 + 8 * q); u32x2 a, b;
                  a.x = cvt_pk_bf16(o0[4 * q] * s0[0], o0[4 * q + 1] * s0[1]); a.y = cvt_pk_bf16(o0[4 * q + 2] * s0[2], o0[4 * q + 3] * s0[3]);
                  b.x = cvt_pk_bf16(o1[4 * q] * s1[0], o1[4 * q + 1] * s1[1]); b.y = cvt_pk_bf16(o1[4 * q + 2] * s1[2], o1[4 * q + 3] * s1[3]);
                  *(u32x2*)(op + 8 * q) = a; *(u32x2*)(op + 32 + 8 * q) = b; } }
            __syncthreads();
        }
    }
#undef POOL_FETCH
}
__device__ __forceinline__ void phase_p2(LAS unsigned char* lds, const WS& w, const Inputs& in, int l, int vb, int nvb, int parts = 7) {
    pg8::StaticOrder so;
    if (parts & 1) { EpiUq E{w}; const int M = l == 0 ? NR : NL; so.init(M, 768, nvb, vb); pg8::gemm_phase(lds, pg8::Gemm{w.CQ(), w.WuqT() + (size_t)l * 768 * 384, M, 768, 384}, so, E); }
    if (parts & 2) { EpiUkv E{w}; so.init(NR, 768, nvb, vb); pg8::gemm_phase(lds, pg8::Gemm{w.CKV(), w.WukvT() + (size_t)l * 768 * 256, NR, 768, 256}, so, E); }
    if (parts & 4) phase_pool(lds, w, w.H(), w.PoolWT() + (size_t)l * 4 * 64 * 64, in.pool_scale + l * 256, l == 0 ? NR : NL, vb, nvb);
}

struct EpiOut {
    static constexpr bool PERM = true;
    bf16_t* DLT; const float* gate;
    __device__ __forceinline__ void operator()(const f32x4 (&acc)[2][2][4][2], const pg8::Unit& u, int wr, int wc, int fr, int fq) const {
        const int pm = u.pm; const int mr = pm >= 256 ? 32 : pm >> 3;
        const size_t r0 = (size_t)pm * 256 + wr * 64 + fr; const int col0 = u.pn * 256 + wc * 32 + 8 * fq;
        f32x4 gv[2][2];
#pragma unroll
        for (int bj = 0; bj < 2; ++bj)
#pragma unroll
            for (int n = 0; n < 2; ++n) gv[bj][n] = *(const f32x4*)(gate + (size_t)mr * 6144 + col0 + bj * 128 + 4 * n);
#pragma unroll
        for (int ai = 0; ai < 2; ++ai)
#pragma unroll
            for (int m = 0; m < 4; ++m) { bf16_t* d = DLT + (r0 + ai * 128 + m * 16) * 1024 + col0;
#pragma unroll
                for (int bj = 0; bj < 2; ++bj) { const f32x4 a0 = acc[ai][bj][m][0] * gv[bj][0], a1 = acc[ai][bj][m][1] * gv[bj][1];
                    u32x4 o; o.x = cvt_pk_bf16(a0[0], a0[1]); o.y = cvt_pk_bf16(a0[2], a0[3]); o.z = cvt_pk_bf16(a1[0], a1[1]); o.w = cvt_pk_bf16(a1[2], a1[3]);
                    *(u32x4*)(d + bj * 128) = o; } }
    }
};
__device__ __forceinline__ void phase_p4(LAS unsigned char* lds, const WS& w, const Inputs& in, int l, int vb, int nvb) {
    const float* MODl = w.MOD() + (size_t)l * 33 * 6144;
    EpiOut E{w.PQ(), MODl + 2 * 1024};
    const int M = l == 0 ? NR : NL;
    pg8::StaticOrder so; so.init(M, 1024, nvb, vb);
    pg8::gemm_phase(lds, pg8::Gemm{w.H(), w.WoutT() + (size_t)l * 1024 * 1024, M, 1024, 1024}, so, E);
}

template <bool INBF>
__device__ __forceinline__ void phase_modulate(const float* __restrict__ XLp, const float* __restrict__ XCp, const bf16_t* __restrict__ XBp, bf16_t* __restrict__ Hout, const float* __restrict__ g, const float* __restrict__ MODl, int si, int nrows, int vb, int nvb,
                                               signed char* __restrict__ H8 = nullptr, float* __restrict__ HS = nullptr, const bf16_t* __restrict__ DLT = nullptr, bf16_t* __restrict__ XBo = nullptr) {
    int tid_ = threadIdx.x; asm volatile("" : "+v"(tid_));
    const int tid = tid_, lane = tid & 63, wid = tid >> 6;
    f32x4 gv[4];
#pragma unroll
    for (int i = 0; i < 4; ++i) gv[i] = *(const f32x4*)(g + 256 * i + 4 * lane);
    const int stride = nvb * 8, lastrow = nrows - 1;
    f32x4 nx[4]; u32x2 nxb[4], ndr[4];
#define PM_LOAD(r_) do { const int rr_ = (r_) < nrows ? (r_) : lastrow; const bool ic_ = rr_ >= NL; const float* xp_ = ic_ ? XCp + (size_t)(rr_ - NL) * 1024 : XLp + (size_t)rr_ * 1024; \
        _Pragma("unroll") for (int i = 0; i < 4; ++i) { if (INBF) nxb[i] = *(const u32x2*)(XBp + (size_t)rr_ * 1024 + 256 * i + 4 * lane); else nx[i] = *(const f32x4*)(xp_ + 256 * i + 4 * lane); \
            if (DLT) ndr[i] = *(const u32x2*)(DLT + (size_t)rr_ * 1024 + 256 * i + 4 * lane); } } while (0)
    PM_LOAD(vb * 8 + wid);
    for (int row = vb * 8 + wid; row < nrows; row += stride) {
        const bool isctx = row >= NL; const int mr = isctx ? 32 : row / S;
        f32x4 x[4]; u32x2 dr4[4]; float ss = 0.f;
#pragma unroll
        for (int i = 0; i < 4; ++i) { if (INBF) x[i] = (f32x4){__uint_as_float(nxb[i].x << 16), __uint_as_float(nxb[i].x & 0xffff0000u), __uint_as_float(nxb[i].y << 16), __uint_as_float(nxb[i].y & 0xffff0000u)}; else x[i] = nx[i];
            if (DLT) dr4[i] = ndr[i]; }
        PM_LOAD(row + stride);
#pragma unroll
        for (int i = 0; i < 4; ++i) {
            if (DLT) { const u32x2 dr = dr4[i];
                x[i][0] += __uint_as_float(dr.x << 16); x[i][1] += __uint_as_float(dr.x & 0xffff0000u); x[i][2] += __uint_as_float(dr.y << 16); x[i][3] += __uint_as_float(dr.y & 0xffff0000u);
                u32x2 xo; xo.x = cvt_pk_bf16(x[i][0], x[i][1]); xo.y = cvt_pk_bf16(x[i][2], x[i][3]); *(u32x2*)(XBo + (size_t)row * 1024 + 256 * i + 4 * lane) = xo; }
            ss += x[i][0] * x[i][0] + x[i][1] * x[i][1] + x[i][2] * x[i][2] + x[i][3] * x[i][3]; }
        ss = wave_sum(ss); const float rstd = rsqrtf(ss * (1.f / 1024.f) + EPS);
        const float* sh = MODl + (size_t)mr * 6144 + si * 1024;
        f32x4 y[4]; float am = 0.f;
#pragma unroll
        for (int i = 0; i < 4; ++i) { const f32x4 shv = *(const f32x4*)(sh + 256 * i + 4 * lane), scv = *(const f32x4*)(sh + 1024 + 256 * i + 4 * lane);
            y[i] = x[i] * rstd * gv[i] * (scv + 1.f) + shv;
            am = fmaxf(am, fmaxf(fmaxf(fabsf(y[i][0]), fabsf(y[i][1])), fmaxf(fabsf(y[i][2]), fabsf(y[i][3]))));
            u32x2 o; o.x = cvt_pk_bf16(y[i][0], y[i][1]); o.y = cvt_pk_bf16(y[i][2], y[i][3]);
            *(u32x2*)(Hout + (size_t)row * 1024 + 256 * i + 4 * lane) = o; }
        if (H8) {
#pragma unroll
            for (int o = 32; o > 0; o >>= 1) am = fmaxf(am, __shfl_xor(am, o));
            const float inv = am > 0.f ? 127.f / am : 0.f;
#pragma unroll
            for (int i = 0; i < 4; ++i) { const int q0 = (int)rintf(y[i][0] * inv), q1 = (int)rintf(y[i][1] * inv), q2 = (int)rintf(y[i][2] * inv), q3 = (int)rintf(y[i][3] * inv);
                *(unsigned*)(H8 + (size_t)row * 1024 + 256 * i + 4 * lane) = (unsigned)(q0 & 0xff) | ((unsigned)(q1 & 0xff) << 8) | ((unsigned)(q2 & 0xff) << 16) | ((unsigned)(q3 & 0xff) << 24); }
            if (lane == 0) HS[row] = am > 0.f ? am * (1.f / 127.f) : 1.f;
        }
    }
#undef PM_LOAD
}

struct EpiPQ {
    static constexpr bool PERM = true;
    bf16_t* PQ;
    __device__ __forceinline__ void operator()(const f32x4 (&acc)[2][2][4][2], const pg8::Unit& u, int wr, int wc, int fr, int fq) const {
        const size_t r0 = (size_t)u.pm * 256 + wr * 64 + fr; const int col0 = u.pn * 256 + wc * 32 + 8 * fq;
#pragma unroll
        for (int ai = 0; ai < 2; ++ai)
#pragma unroll
            for (int m = 0; m < 4; ++m) { bf16_t* d = PQ + (r0 + ai * 128 + m * 16) * 2048 + col0;
#pragma unroll
                for (int bj = 0; bj < 2; ++bj) { const f32x4 a0 = acc[ai][bj][m][0], a1 = acc[ai][bj][m][1];
                    u32x4 o; o.x = cvt_pk_bf16(a0[0], a0[1]); o.y = cvt_pk_bf16(a0[2], a0[3]); o.z = cvt_pk_bf16(a1[0], a1[1]); o.w = cvt_pk_bf16(a1[2], a1[3]);
                    *(u32x4*)(d + bj * 128) = o; } }
    }
};
__device__ __forceinline__ void phase_p6a(LAS unsigned char* lds, const WS& w, int l, int vb, int nvb) {
    EpiPQ E{w.PQ()}; const int M = l == 0 ? NR : NL;
    pg8::StaticOrder so; so.init(M, 2048, nvb, vb);
    pg8::gemm_phase(lds, pg8::Gemm{w.H(), w.WqT() + (size_t)l * 2048 * 1024, M, 2048, 1024}, so, E);
}


using bf16x2_t = __attribute__((ext_vector_type(2))) __bf16;
typedef float f32x2 __attribute__((ext_vector_type(2)));
__device__ __forceinline__ float gelu_fast(float x) {
    const float u2 = 1.5957691216057308f * (x + 0.044715f * x * x * x);
    return x * __builtin_amdgcn_rcpf(1.f + __builtin_amdgcn_exp2f(-1.4426950408889634f * u2));
}
#define DPPF(v, ctrl) __builtin_bit_cast(float, __builtin_amdgcn_update_dpp(0, __builtin_bit_cast(int, (v)), (ctrl), 0xf, 0xf, true))
__device__ __forceinline__ float reduce8(float p0, float p1, float p2, float p3, float p4, float p5, float p6, float p7, int lane) {
    auto s01 = __builtin_amdgcn_permlane32_swap(__float_as_uint(p0), __float_as_uint(p1), false, false);
    auto s23 = __builtin_amdgcn_permlane32_swap(__float_as_uint(p2), __float_as_uint(p3), false, false);
    auto s45 = __builtin_amdgcn_permlane32_swap(__float_as_uint(p4), __float_as_uint(p5), false, false);
    auto s67 = __builtin_amdgcn_permlane32_swap(__float_as_uint(p6), __float_as_uint(p7), false, false);
    const float q0 = __uint_as_float(s01[0]) + __uint_as_float(s01[1]), q1 = __uint_as_float(s23[0]) + __uint_as_float(s23[1]);
    const float q2 = __uint_as_float(s45[0]) + __uint_as_float(s45[1]), q3 = __uint_as_float(s67[0]) + __uint_as_float(s67[1]);
    auto t0 = __builtin_amdgcn_permlane16_swap(__float_as_uint(q0), __float_as_uint(q1), false, false);
    auto t1 = __builtin_amdgcn_permlane16_swap(__float_as_uint(q2), __float_as_uint(q3), false, false);
    float r0 = __uint_as_float(t0[0]) + __uint_as_float(t0[1]);
    float r1 = __uint_as_float(t1[0]) + __uint_as_float(t1[1]);
    r0 += DPPF(r0, 0x128); r1 += DPPF(r1, 0x128);
    float z = (lane & 8) ? r1 : r0;
    z += DPPF(z, 0x141);
    z += DPPF(z, 0xB1);
    z += DPPF(z, 0x4E);
    return z;
}
__device__ __forceinline__ void p7_axpy(const u32x4 v, float wj, f32x2 (&out)[8]) {
    const f32x2 w2 = {wj, wj};
#pragma unroll
    for (int k = 0; k < 4; ++k) { const f32x2 lo = __builtin_amdgcn_cvt_pk_f32_fp8((int)v[k], false), hi2 = __builtin_amdgcn_cvt_pk_f32_fp8((int)v[k], true);
        out[2 * k] = __builtin_elementwise_fma(w2, lo, out[2 * k]); out[2 * k + 1] = __builtin_elementwise_fma(w2, hi2, out[2 * k + 1]); }
}
__device__ __forceinline__ int p7_doti(const u32x4 u, const u32x4 h) {
    int s = __builtin_amdgcn_sdot4((int)u[0], (int)h[0], 0, false); s = __builtin_amdgcn_sdot4((int)u[1], (int)h[1], s, false); s = __builtin_amdgcn_sdot4((int)u[2], (int)h[2], s, false); return __builtin_amdgcn_sdot4((int)u[3], (int)h[3], s, false);
}
#define DPPI(v, ctrl) __builtin_amdgcn_update_dpp(0, (v), (ctrl), 0xf, 0xf, true)
__device__ __forceinline__ int reduce8i(int p0, int p1, int p2, int p3, int p4, int p5, int p6, int p7, int lane) {
    auto s01 = __builtin_amdgcn_permlane32_swap((unsigned)p0, (unsigned)p1, false, false); auto s23 = __builtin_amdgcn_permlane32_swap((unsigned)p2, (unsigned)p3, false, false);
    auto s45 = __builtin_amdgcn_permlane32_swap((unsigned)p4, (unsigned)p5, false, false); auto s67 = __builtin_amdgcn_permlane32_swap((unsigned)p6, (unsigned)p7, false, false);
    const unsigned q0 = s01[0] + s01[1], q1 = s23[0] + s23[1], q2 = s45[0] + s45[1], q3 = s67[0] + s67[1];
    auto t0 = __builtin_amdgcn_permlane16_swap(q0, q1, false, false); auto t1 = __builtin_amdgcn_permlane16_swap(q2, q3, false, false);
    int r0 = (int)(t0[0] + t0[1]), r1 = (int)(t1[0] + t1[1]);
    r0 += DPPI(r0, 0x128); r1 += DPPI(r1, 0x128);
    int z = (lane & 8) ? r1 : r0;
    z += DPPI(z, 0x141); z += DPPI(z, 0xB1); z += DPPI(z, 0x4E);
    return z;
}

struct P7CArgs { const signed char* H8; const unsigned* EG; const unsigned char* U8; int* PART; int nrows; };
__device__ __forceinline__ void phase_p7c(LAS unsigned char* lds, const P7CArgs& a, int part, int prank, int nvb) {
    int tid_ = threadIdx.x; asm volatile("" : "+v"(tid_));
    const int lane = tid_ & 63, wid = __builtin_amdgcn_readfirstlane(tid_ >> 6);
    const int nw = (nvb >> 3) * 8, wrank = prank * 8 + wid;
    LAS unsigned* tab = (LAS unsigned*)(lds + wid * 1024);
    const int grp = lane >> 3, c = lane & 7, c16 = c * 16;
    const unsigned char* ubase = a.U8 + 128 * part + c16;
    const signed char* hbase = a.H8 + 128 * part + c16;
    unsigned* pbase = (unsigned*)a.PART + (size_t)part * a.nrows * 64;
    const int c2 = (c >> 2) & 1, c1 = (c >> 1) & 1, c0 = c & 1;
    const int ent0 = 8 * (4 * c2 + 2 * c0 + c1) + grp;
    u32x4 Av[16], Bv[16]; u32x4 Ah, Bh;
    unsigned pw0 = 0u, pw1 = 0u;
#define P7C_PREF(t) do { pw0 = a.EG[(size_t)(t) * 128 + lane]; pw1 = a.EG[(size_t)(t) * 128 + 64 + lane]; } while (0)
#define P7C_ISSUE(X, Xh, t, slot, tnext) do { LAS unsigned* tb_ = tab + (slot) * 128; \
        tb_[lane] = pw0; tb_[64 + lane] = pw1; \
        asm volatile("s_waitcnt lgkmcnt(0)" ::: "memory"); \
        _Pragma("unroll") for (int i_ = 0; i_ < 16; ++i_) { const unsigned e_ = tb_[8 * i_ + grp]; X[i_] = *(const u32x4*)(ubase + (size_t)(e_ >> 16) * 1024); } \
        Xh = *(const u32x4*)(hbase + (size_t)(t) * 1024); \
        P7C_PREF(tnext); } while (0)
#define P7C_X(v, ctrl) ((v) + DPPI((v), (ctrl)))
#define P7C_COMPUTE(X, Xh, t, valid) do { int d_[16]; \
        _Pragma("unroll") for (int i_ = 0; i_ < 16; ++i_) d_[i_] = p7_doti(X[i_], Xh); \
        int e8_[8]; _Pragma("unroll") for (int k = 0; k < 8; ++k) { const int send_ = c2 ? d_[k] : d_[k + 8], keep_ = c2 ? d_[k + 8] : d_[k]; e8_[k] = keep_ + DPPI(send_, 0x141); }            \
        int e4_[4]; _Pragma("unroll") for (int k = 0; k < 4; ++k) { const int send_ = c0 ? e8_[k] : e8_[k + 4], keep_ = c0 ? e8_[k + 4] : e8_[k]; e4_[k] = keep_ + DPPI(send_, 0xB1); }          \
        int e2_[2]; _Pragma("unroll") for (int k = 0; k < 2; ++k) { const int send_ = c1 ? e4_[k] : e4_[k + 2], keep_ = c1 ? e4_[k + 2] : e4_[k]; e2_[k] = keep_ + DPPI(send_, 0x4E); }          \
        if (valid) pbase[(size_t)(t) * 64 + ent0] = __builtin_bit_cast(unsigned, __builtin_amdgcn_cvt_pk_i16((e2_[0] + 8) >> 4, (e2_[1] + 8) >> 4)); } while (0)
    const int lastrow = a.nrows - 1;
    int t = wrank;
    P7C_PREF(t);
    P7C_ISSUE(Av, Ah, t, 0, (t + nw < a.nrows ? t + nw : lastrow));
    while (t < a.nrows) {
        const int t1 = t + nw, t2 = t1 + nw, t3 = t2 + nw;
        const int k1 = t1 < a.nrows ? t1 : lastrow, k2 = t2 < a.nrows ? t2 : lastrow, k3 = t3 < a.nrows ? t3 : lastrow;
        P7C_ISSUE(Bv, Bh, k1, 1, k2);
        P7C_COMPUTE(Av, Ah, t, true);
        P7C_ISSUE(Av, Ah, k2, 0, k3);
        P7C_COMPUTE(Bv, Bh, k1, (t1 < a.nrows));
        t = t2;
    }
#undef P7C_PREF
#undef P7C_ISSUE
#undef P7C_COMPUTE
}
__device__ __forceinline__ void phase_p7d(const int* __restrict__ PART, const unsigned* __restrict__ EG, const float* __restrict__ US, const float* __restrict__ VS, const float* __restrict__ HS, unsigned* __restrict__ WE, int nrows, int vb, int nvb) {
    int tid_ = threadIdx.x; asm volatile("" : "+v"(tid_));
    typedef int i32x4 __attribute__((ext_vector_type(4)));
    const size_t n16 = (size_t)nrows * 16, pstride4 = n16;
    const u32x4* P4 = (const u32x4*)PART; const u32x4* EG4 = (const u32x4*)EG; u32x4* WE4 = (u32x4*)WE;
    for (size_t j = (size_t)vb * 512 + tid_; j < n16; j += (size_t)nvb * 512) {
        const size_t row = j >> 4; const int P = (int)(j >> 1) & 7, gq = (int)j & 1;
        i32x4 slo = {0, 0, 0, 0}, shi = {0, 0, 0, 0};
#pragma unroll
        for (int p = 0; p < 8; ++p) { const u32x4 d = P4[p * pstride4 + j];
#pragma unroll
            for (int k = 0; k < 4; ++k) { slo[k] += (int)(d[k] << 16) >> 16; shi[k] += (int)d[k] >> 16; } }
        const float hs = __builtin_ldexpf(HS[row], 4);
#pragma unroll
        for (int half = 0; half < 2; ++half) {
            const size_t ei = row * 32 + 4 * P + 2 * half + gq;
            const u32x4 eg = EG4[ei]; u32x4 o;
#pragma unroll
            for (int k = 0; k < 4; ++k) { const int eid = (int)(eg[k] >> 16);
                const float av = (float)(half ? shi[k] : slo[k]) * US[eid] * hs;
                const float wv = __uint_as_float(eg[k] << 16) * gelu_fast(av) * VS[eid];
                o[k] = (eg[k] & 0xffff0000u) | (cvt_pk_bf16(wv, 0.f) & 0xffffu); }
            WE4[ei] = o;
        }
    }
}
struct P7BArgs { const unsigned* WE; const unsigned char* V8; bf16_t* XB; const float* gate2; int nrows; };
template <int PM>
__device__ __forceinline__ void phase_p7b(LAS unsigned char* lds, const P7BArgs& a, int part, int prank, int nvb) {
    int tid_ = threadIdx.x; asm volatile("" : "+v"(tid_));
    const int lane = tid_ & 63, wid = __builtin_amdgcn_readfirstlane(tid_ >> 6);
    const int nw = (nvb >> 3) * 8, wrank = prank * 8 + wid;
    LAS unsigned* tab = (LAS unsigned*)(lds + wid * 1024);
    const int grp = lane >> 3, c16 = (lane & 7) * 16;
    const unsigned char* vbase = a.V8 + 128 * part + c16;
    const int colofs = 128 * part + c16 + 8 * (lane >> 5) + 4 * ((lane >> 4) & 1) + 2 * ((lane >> 3) & 1);
    u32x4 Av[16], Bv[16]; float Aw[16], Bw[16]; unsigned Ax, Bx; f32x2 Ag, Bg;
    unsigned pw0 = 0u, pw1 = 0u;
#define P7B_PREF(t) do { pw0 = a.WE[(size_t)(t) * 128 + lane]; pw1 = a.WE[(size_t)(t) * 128 + 64 + lane]; } while (0)
#define P7B_ISSUE(X, Xw, Xx, Xg, t, slot, tnext) do { LAS unsigned* tb_ = tab + (slot) * 128; \
        tb_[lane] = pw0; tb_[64 + lane] = pw1; \
        asm volatile("s_waitcnt lgkmcnt(0)" ::: "memory"); \
        _Pragma("unroll") for (int i_ = 0; i_ < 16; ++i_) { const unsigned we_ = tb_[8 * i_ + grp]; Xw[i_] = __uint_as_float(we_ << 16); if (PM != 2) X[i_] = *(const u32x4*)(vbase + (size_t)(we_ >> 16) * 1024); else X[i_] = (u32x4){we_, 0x38383838u, 0x38383838u, 0x38383838u}; } \
        { const int mr_ = (t) >= NL ? 32 : (t) / S; \
          Xx = *(const unsigned*)(a.XB + (size_t)(t) * 1024 + colofs); Xg = *(const f32x2*)(a.gate2 + (size_t)mr_ * 6144 + colofs); } \
        P7B_PREF(tnext); } while (0)
#define P7B_COMPUTE(X, Xw, Xx, Xg, t, valid) do { f32x2 acc2[8]; \
        _Pragma("unroll") for (int k = 0; k < 8; ++k) acc2[k] = (f32x2){0.f, 0.f}; \
        if (PM != 1) { _Pragma("unroll") for (int i_ = 0; i_ < 16; ++i_) p7_axpy(X[i_], Xw[i_], acc2); } else { _Pragma("unroll") for (int i_ = 0; i_ < 16; ++i_) acc2[i_ >> 1][i_ & 1] = __uint_as_float((X[i_][0] ^ X[i_][1] ^ X[i_][2] ^ X[i_][3]) & 0x3fffffffu) + Xw[i_]; } \
        float b_[8]; _Pragma("unroll") for (int k = 0; k < 8; ++k) { auto s_ = __builtin_amdgcn_permlane32_swap(__float_as_uint(acc2[k >> 1][k & 1]), __float_as_uint(acc2[(k + 8) >> 1][k & 1]), false, false); b_[k] = __uint_as_float(s_[0]) + __uint_as_float(s_[1]); } \
        float c_[4]; _Pragma("unroll") for (int k = 0; k < 4; ++k) { auto s_ = __builtin_amdgcn_permlane16_swap(__float_as_uint(b_[k]), __float_as_uint(b_[k + 4]), false, false); c_[k] = __uint_as_float(s_[0]) + __uint_as_float(s_[1]); } \
        float d_[2]; _Pragma("unroll") for (int k = 0; k < 2; ++k) { const float send_ = (lane & 8) ? c_[k] : c_[k + 2]; const float keep_ = (lane & 8) ? c_[k + 2] : c_[k]; d_[k] = keep_ + DPPF(send_, 0x128); } \
        unsigned* xp_ = (unsigned*)(a.XB + (size_t)(t) * 1024 + colofs); \
        f32x2 x_ = {__uint_as_float(Xx << 16), __uint_as_float(Xx & 0xffff0000u)}; x_.x += Xg.x * d_[0]; x_.y += Xg.y * d_[1]; if ((valid) && PM == 0) *xp_ = cvt_pk_bf16(x_.x, x_.y); else if (PM != 0 && x_.x == 1.2345e30f) *xp_ = cvt_pk_bf16(x_.x, x_.y); } while (0)
    const int lastrow = a.nrows - 1;
    int t = wrank;
    P7B_PREF(t);
    P7B_ISSUE(Av, Aw, Ax, Ag, t, 0, (t + nw < a.nrows ? t + nw : lastrow));
    while (t < a.nrows) {
        const int t1 = t + nw, t2 = t1 + nw, t3 = t2 + nw;
        const int c1 = t1 < a.nrows ? t1 : lastrow, c2 = t2 < a.nrows ? t2 : lastrow, c3 = t3 < a.nrows ? t3 : lastrow;
        P7B_ISSUE(Bv, Bw, Bx, Bg, c1, 1, c2);
        P7B_COMPUTE(Av, Aw, Ax, Ag, t, true);
        P7B_ISSUE(Av, Aw, Ax, Ag, c2, 0, c3);
        P7B_COMPUTE(Bv, Bw, Bx, Bg, c1, (t1 < a.nrows));
        t = t2;
    }
#undef P7B_PREF
#undef P7B_ISSUE
#undef P7B_COMPUTE
}
__device__ __forceinline__ void phase_final_norm(const bf16_t* __restrict__ XBp, float* __restrict__ OUT, const float* __restrict__ g, int vb, int nvb) {
    int tid_ = threadIdx.x; asm volatile("" : "+v"(tid_));
    const int lane = tid_ & 63, wid = tid_ >> 6;
    for (int row = vb * 8 + wid; row < NL; row += nvb * 8) {
        const bf16_t* xp = XBp + (size_t)row * 1024; f32x4 x[4]; float ss = 0.f;
#pragma unroll
        for (int i = 0; i < 4; ++i) { const u32x2 r = *(const u32x2*)(xp + 256 * i + 4 * lane); x[i] = (f32x4){__uint_as_float(r.x << 16), __uint_as_float(r.x & 0xffff0000u), __uint_as_float(r.y << 16), __uint_as_float(r.y & 0xffff0000u)};
            ss += x[i][0] * x[i][0] + x[i][1] * x[i][1] + x[i][2] * x[i][2] + x[i][3] * x[i][3]; }
        ss = wave_sum(ss); const float rstd = rsqrtf(ss * (1.f / 1024.f) + EPS);
#pragma unroll
        for (int i = 0; i < 4; ++i) *(f32x4*)(OUT + (size_t)row * 1024 + 256 * i + 4 * lane) = x[i] * rstd * *(const f32x4*)(g + 256 * i + 4 * lane);
    }
}

template <int V_> struct IC { static constexpr int value = V_; };
typedef short s16x4 __attribute__((ext_vector_type(4)));
__device__ __forceinline__ s16x4 lds_tr16(const LAS unsigned char* p) { return __builtin_bit_cast(s16x4, __builtin_amdgcn_ds_read_tr16_b64_v4i16((LAS s16x4*)p)); }
constexpr int ATT_BUF = 20480;
__device__ __forceinline__ void glds16(const void* g, unsigned lds_base) {
    unsigned sv; asm volatile("s_mov_b32 %0, m0\n\ts_mov_b32 m0, %2\n\ts_nop 0\n\tglobal_load_lds_dwordx4 %1, off\n\ts_mov_b32 m0, %0" : "=&s"(sv) : "v"(g), "s"(lds_base) : "memory"); }
template <int DK>
__device__ __forceinline__ void attn_unit(LAS unsigned char* lds, const bf16_t* __restrict__ Q, const bf16_t* __restrict__ K1, const bf16_t* __restrict__ K2, const bf16_t* __restrict__ V,
                                          int nkeys, float c2, bf16_t* __restrict__ out) {
    int tid_ = threadIdx.x; asm volatile("" : "+v"(tid_));
    const int tid = tid_, lane = tid & 63, wid = __builtin_amdgcn_readfirstlane(tid >> 6), r32 = lane & 31, hi = lane >> 5;
    constexpr int NS = DK / 16, NM = 2 * NS;
    bf16x8 qf[NS];
    { const bf16_t* qp = Q + (size_t)(wid * 32 + r32) * DK + 8 * hi;
#pragma unroll
      for (int s = 0; s < NS; ++s) qf[s] = *(const bf16x8*)(qp + 16 * s); }
    const int dkey = 8 * wid + (lane >> 3), dkey2 = 16 * (wid & 3) + (lane >> 2);
    const bf16_t* gk1 = K1 + (size_t)dkey * 64 + (((lane & 7) ^ ((dkey >> 1) & 7)) << 3);
    const bf16_t* gv = V + (size_t)dkey * 64 + (((lane & 7) ^ (((dkey >> 1) & 1) << 2)) << 3);
    const bf16_t* gk2 = (DK == 96) ? K2 + (size_t)dkey2 * 32 + (((lane & 3) ^ ((dkey2 >> 2) & 3)) << 3) : nullptr;
    const unsigned lds0 = (unsigned)(size_t)lds;
    const unsigned d_k1 = lds0 + wid * 1024, d_v = lds0 + 8192 + wid * 1024, d_k2 = lds0 + 16384 + (wid & 3) * 1024;
#define ATT_DMA(tile_, slot_) do { const int tt_ = (tile_); glds16(gk1 + (size_t)tt_ * 4096, (unsigned)__builtin_amdgcn_readfirstlane(d_k1 + (slot_) * ATT_BUF)); \
        glds16(gv + (size_t)tt_ * 4096, (unsigned)__builtin_amdgcn_readfirstlane(d_v + (slot_) * ATT_BUF)); \
        if (DK == 96) glds16(gk2 + (size_t)tt_ * 2048, (unsigned)__builtin_amdgcn_readfirstlane(d_k2 + (slot_) * ATT_BUF)); } while (0)
#define ATT_WAIT_BAR() do { if (DK == 96) asm volatile("s_waitcnt vmcnt(3) lgkmcnt(0)\n\ts_barrier" ::: "memory"); else asm volatile("s_waitcnt vmcnt(2) lgkmcnt(0)\n\ts_barrier" ::: "memory"); } while (0)
    unsigned ka[2][4];
#pragma unroll
    for (int kt = 0; kt < 2; ++kt)
#pragma unroll
        for (int s = 0; s < 4; ++s) { const int key = 32 * kt + r32; ka[kt][s] = key * 128 + (((2 * s + hi) ^ ((key >> 1) & 7)) << 4); }
    unsigned kb[2][2];
#pragma unroll
    for (int kt = 0; kt < 2; ++kt)
#pragma unroll
        for (int s = 0; s < 2; ++s) { const int key = 32 * kt + r32; kb[kt][s] = 16384 + key * 64 + (((2 * s + hi) ^ ((key >> 2) & 3)) << 4); }
    const int vq = (lane & 15) >> 2, vp = lane & 3, vg = (lane >> 4) & 1;
    unsigned va[2];
#pragma unroll
    for (int dvb = 0; dvb < 2; ++dvb) { const int key = 4 * hi + vq; va[dvb] = 8192 + key * 128 + ((((32 * dvb + 16 * vg + 4 * vp) * 2)) ^ (((key >> 1) & 1) << 6)); }
    float m = -1e30f, l = 0.f, mx;
    f32x16 o0 = {}, o1 = {};
    const int NT = nkeys >> 6;
    ATT_DMA(0, 0); ATT_DMA(NT > 1 ? 1 : 0, 1); ATT_DMA(NT > 2 ? 2 : NT - 1, 2);
    asm volatile("s_waitcnt vmcnt(0) lgkmcnt(0)\n\ts_barrier" ::: "memory");
    f32x16 pa0 = {}, pa1 = {}, pb0 = {}, pb1 = {};
    {
        bf16x8 kf0[NS], kf1[NS];
#pragma unroll
        for (int s = 0; s < 4; ++s) { kf0[s] = *(const LAS bf16x8*)(lds + ka[0][s]); kf1[s] = *(const LAS bf16x8*)(lds + ka[1][s]); }
        if (DK == 96) {
#pragma unroll
            for (int s = 0; s < 2; ++s) { kf0[4 + s] = *(const LAS bf16x8*)(lds + kb[0][s]); kf1[4 + s] = *(const LAS bf16x8*)(lds + kb[1][s]); }
        }
#pragma unroll
        for (int s = 0; s < NS; ++s) { pa0 = mfma32(kf0[s], qf[s], pa0); pa1 = mfma32(kf1[s], qf[s], pa1); }
        mx = pa0[0];
#pragma unroll
        for (int r = 1; r < 16; ++r) mx = fmaxf(mx, pa0[r]);
#pragma unroll
        for (int r = 0; r < 16; ++r) mx = fmaxf(mx, pa1[r]);
    }
    auto step = [&](auto bc_, auto bn_, auto bw_, f32x16& pc0, f32x16& pc1, f32x16& pn0, f32x16& pn1, int t) __attribute__((always_inline)) {
        constexpr int BC = decltype(bc_)::value * ATT_BUF, BN = decltype(bn_)::value * ATT_BUF;
        ATT_DMA((t + 3 < NT) ? t + 3 : NT - 1, decltype(bw_)::value);
        bf16x8 kf0[NS], kf1[NS];
#pragma unroll
        for (int s = 0; s < 4; ++s) { kf0[s] = *(const LAS bf16x8*)(lds + BN + ka[0][s]); kf1[s] = *(const LAS bf16x8*)(lds + BN + ka[1][s]); }
        if (DK == 96) {
#pragma unroll
            for (int s = 0; s < 2; ++s) { kf0[4 + s] = *(const LAS bf16x8*)(lds + BN + kb[0][s]); kf1[4 + s] = *(const LAS bf16x8*)(lds + BN + kb[1][s]); }
        }
        __builtin_amdgcn_sched_barrier(0);
        { auto rr = __builtin_amdgcn_permlane32_swap(__float_as_uint(mx), __float_as_uint(mx), false, false); mx = fmaxf(__uint_as_float(rr[0]), __uint_as_float(rr[1])); }
        const float tm = mx;
        if (__any(tm > m + 8.f)) {
            const float mn = fmaxf(m, tm), al = __builtin_amdgcn_exp2f(m - mn); m = mn; l *= al;
#pragma unroll
            for (int r = 0; r < 16; ++r) { o0[r] *= al; o1[r] *= al; }
        }
        const float nm = -m; float ls = 0.f;
        pn0 = f32x16{}; pn1 = f32x16{};
        unsigned pw[16];
        s16x4 vlo[2][2][2], vhi[2][2][2];
#pragma unroll
        for (int c = 0; c < 8; ++c) {
            __builtin_amdgcn_sched_barrier(0);
#pragma unroll
            for (int j = 0; j < NM; ++j) if (j >= c * NM / 8 && j < (c + 1) * NM / 8) { if (j & 1) pn1 = mfma32(kf1[j >> 1], qf[j >> 1], pn1); else pn0 = mfma32(kf0[j >> 1], qf[j >> 1], pn0); }
            if (c == 4) {
#pragma unroll
                for (int kt = 0; kt < 2; ++kt)
#pragma unroll
                    for (int sp = 0; sp < 2; ++sp) { const int kofs = (32 * kt + 16 * sp) * 128;
#pragma unroll
                        for (int dvb = 0; dvb < 2; ++dvb) { vlo[dvb][kt][sp] = lds_tr16(lds + BC + va[dvb] + kofs); vhi[dvb][kt][sp] = lds_tr16(lds + BC + va[dvb] + kofs + 8 * 128); } }
            }
            __builtin_amdgcn_sched_barrier(0);
            if (c < 4) {
#pragma unroll
                for (int i = 0; i < 4; ++i) { const int r = 4 * c + i; pc0[r] = __builtin_amdgcn_exp2f(pc0[r] + nm); ls += pc0[r]; }
                pw[2 * c] = cvt_pk_bf16(pc0[4 * c], pc0[4 * c + 1]); pw[2 * c + 1] = cvt_pk_bf16(pc0[4 * c + 2], pc0[4 * c + 3]);
            } else {
#pragma unroll
                for (int i = 0; i < 4; ++i) { const int r = 4 * (c - 4) + i; pc1[r] = __builtin_amdgcn_exp2f(pc1[r] + nm); ls += pc1[r]; }
                pw[8 + 2 * (c - 4)] = cvt_pk_bf16(pc1[4 * (c - 4)], pc1[4 * (c - 4) + 1]); pw[8 + 2 * (c - 4) + 1] = cvt_pk_bf16(pc1[4 * (c - 4) + 2], pc1[4 * (c - 4) + 3]);
            }
        }
        __builtin_amdgcn_sched_barrier(0);
        l += ls;
        float mxn = -3.0e38f;
#pragma unroll
        for (int k = 0; k < 8; ++k) { const int kt = k >> 2, sp = (k >> 1) & 1, dvb = k & 1;
            const u32x4 pq = (u32x4){pw[8 * kt + 4 * sp], pw[8 * kt + 4 * sp + 1], pw[8 * kt + 4 * sp + 2], pw[8 * kt + 4 * sp + 3]};
            const s16x4 lo = vlo[dvb][kt][sp], hi4 = vhi[dvb][kt][sp]; const bf16x8 vf = (bf16x8){lo[0], lo[1], lo[2], lo[3], hi4[0], hi4[1], hi4[2], hi4[3]};
            if (dvb == 0) o0 = mfma32(vf, __builtin_bit_cast(bf16x8, pq), o0); else o1 = mfma32(vf, __builtin_bit_cast(bf16x8, pq), o1);
            __builtin_amdgcn_sched_barrier(0);
            if (k < 4) { mxn = fmaxf(fmaxf(mxn, pn0[4 * k]), fmaxf(pn0[4 * k + 1], fmaxf(pn0[4 * k + 2], pn0[4 * k + 3]))); }
            else { mxn = fmaxf(fmaxf(mxn, pn1[4 * (k - 4)]), fmaxf(pn1[4 * (k - 4) + 1], fmaxf(pn1[4 * (k - 4) + 2], pn1[4 * (k - 4) + 3]))); }
            __builtin_amdgcn_sched_barrier(0);
        }
        mx = mxn;
        ATT_WAIT_BAR();
    };
    for (int t = 0; t < NT; t += 4) {
        step(IC<0>{}, IC<1>{}, IC<3>{}, pa0, pa1, pb0, pb1, t);
        step(IC<1>{}, IC<2>{}, IC<0>{}, pb0, pb1, pa0, pa1, t + 1);
        step(IC<2>{}, IC<3>{}, IC<1>{}, pa0, pa1, pb0, pb1, t + 2);
        step(IC<3>{}, IC<0>{}, IC<2>{}, pb0, pb1, pa0, pa1, t + 3);
    }
    { auto rr = __builtin_amdgcn_permlane32_swap(__float_as_uint(l), __float_as_uint(l), false, false); l = __uint_as_float(rr[0]) + __uint_as_float(rr[1]); }
    const float il = 1.f / l;
    bf16_t* op = out + (size_t)(wid * 32 + r32) * 1024 + 4 * hi;
#pragma unroll
    for (int g = 0; g < 4; ++g) { u32x2 a, b;
        a.x = cvt_pk_bf16(o0[4 * g] * il, o0[4 * g + 1] * il); a.y = cvt_pk_bf16(o0[4 * g + 2] * il, o0[4 * g + 3] * il);
        b.x = cvt_pk_bf16(o1[4 * g] * il, o1[4 * g + 1] * il); b.y = cvt_pk_bf16(o1[4 * g + 2] * il, o1[4 * g + 3] * il);
        *(u32x2*)(op + 8 * g) = a; *(u32x2*)(op + 32 + 8 * g) = b; }
}
#undef ATT_DMA
#undef ATT_WAIT_BAR
template <int DK>
__device__ __forceinline__ void attn_unit64(LAS unsigned char* lds, const bf16_t* __restrict__ Q, const bf16_t* __restrict__ K1, const bf16_t* __restrict__ K2, const bf16_t* __restrict__ V,
                                            int nkeys, bf16_t* __restrict__ out) {
    int tid_ = threadIdx.x; asm volatile("" : "+v"(tid_));
    const int tid = tid_, lane = tid & 63, wid = __builtin_amdgcn_readfirstlane(tid >> 6), r32 = lane & 31, hi = lane >> 5;
    constexpr int NS = DK / 16;
    bf16x8 qf[2][NS];
#pragma unroll
    for (int j = 0; j < 2; ++j) { const bf16_t* qp = Q + (size_t)(wid * 64 + 32 * j + r32) * DK + 8 * hi;
#pragma unroll
        for (int s = 0; s < NS; ++s) qf[j][s] = *(const bf16x8*)(qp + 16 * s); }
    const int dkey = 8 * wid + (lane >> 3), dkey2 = 16 * (wid & 3) + (lane >> 2);
    const bf16_t* gk1 = K1 + (size_t)dkey * 64 + (((lane & 7) ^ ((dkey >> 1) & 7)) << 3);
    const bf16_t* gv = V + (size_t)dkey * 64 + (((lane & 7) ^ (((dkey >> 1) & 1) << 2)) << 3);
    const bf16_t* gk2 = (DK == 96) ? K2 + (size_t)dkey2 * 32 + (((lane & 3) ^ ((dkey2 >> 2) & 3)) << 3) : nullptr;
    const unsigned lds0 = (unsigned)(size_t)lds;
    const unsigned d_k1 = lds0 + wid * 1024, d_v = lds0 + 8192 + wid * 1024, d_k2 = lds0 + 16384 + (wid & 3) * 1024;
#define ATT_DMA(tile_, slot_) do { const int tt_ = (tile_); glds16(gk1 + (size_t)tt_ * 4096, (unsigned)__builtin_amdgcn_readfirstlane(d_k1 + (slot_) * ATT_BUF)); \
        glds16(gv + (size_t)tt_ * 4096, (unsigned)__builtin_amdgcn_readfirstlane(d_v + (slot_) * ATT_BUF)); \
        if (DK == 96) glds16(gk2 + (size_t)tt_ * 2048, (unsigned)__builtin_amdgcn_readfirstlane(d_k2 + (slot_) * ATT_BUF)); } while (0)
    unsigned ka[4];
#pragma unroll
    for (int s = 0; s < 4; ++s) ka[s] = r32 * 128 + (((2 * s + hi) ^ ((r32 >> 1) & 7)) << 4);
    unsigned kb[2];
#pragma unroll
    for (int s = 0; s < 2; ++s) kb[s] = 16384 + r32 * 64 + (((2 * s + hi) ^ ((r32 >> 2) & 3)) << 4);
    const int vq = (lane & 15) >> 2, vp = lane & 3, vg = (lane >> 4) & 1;
    unsigned va[2];
#pragma unroll
    for (int dvb = 0; dvb < 2; ++dvb) { const int key = 4 * hi + vq; va[dvb] = 8192 + key * 128 + ((((32 * dvb + 16 * vg + 4 * vp) * 2)) ^ (((key >> 1) & 1) << 6)); }
    float m[2] = {-1e30f, -1e30f}, l[2] = {0.f, 0.f};
    f32x16 o[2][2] = {};
    const int NT = nkeys >> 6;
    ATT_DMA(0, 0); ATT_DMA(1, 1); ATT_DMA(2, 2);
    asm volatile("s_waitcnt vmcnt(0) lgkmcnt(0)\n\ts_barrier" ::: "memory");
    bf16x8 kf0[NS], kf1[NS];
#pragma unroll
    for (int s = 0; s < 4; ++s) { kf0[s] = *(const LAS bf16x8*)(lds + ka[s]); kf1[s] = *(const LAS bf16x8*)(lds + 4096 + ka[s]); }
    auto step = [&](auto cur_, auto wsl_, int t) __attribute__((always_inline)) {
        constexpr int BC = decltype(cur_)::value * ATT_BUF, BNX = ((decltype(cur_)::value + 1) & 3) * ATT_BUF;
        ATT_DMA((t + 3 < NT) ? t + 3 : NT - 1, decltype(wsl_)::value);
        unsigned pw[2][16];
        s16x4 vlo[2][2], vhi[2][2];
#define ATT64_VLOAD(kt_) do { _Pragma("unroll") for (int sp = 0; sp < 2; ++sp) { const int kofs = (32 * (kt_) + 16 * sp) * 128; \
            _Pragma("unroll") for (int dvb = 0; dvb < 2; ++dvb) { vlo[dvb][sp] = lds_tr16(lds + BC + va[dvb] + kofs); vhi[dvb][sp] = lds_tr16(lds + BC + va[dvb] + kofs + 8 * 128); } } } while (0)
#define ATT64_PV(kt_) do { _Pragma("unroll") for (int sp = 0; sp < 2; ++sp) _Pragma("unroll") for (int dvb = 0; dvb < 2; ++dvb) { \
            const s16x4 lo = vlo[dvb][sp], hi4 = vhi[dvb][sp]; const bf16x8 vf = (bf16x8){lo[0], lo[1], lo[2], lo[3], hi4[0], hi4[1], hi4[2], hi4[3]}; \
            _Pragma("unroll") for (int j = 0; j < 2; ++j) { const u32x4 pq = (u32x4){pw[j][8 * (kt_) + 4 * sp], pw[j][8 * (kt_) + 4 * sp + 1], pw[j][8 * (kt_) + 4 * sp + 2], pw[j][8 * (kt_) + 4 * sp + 3]}; \
                o[j][dvb] = mfma32(vf, __builtin_bit_cast(bf16x8, pq), o[j][dvb]); } } } while (0)
#pragma unroll
        for (int j = 0; j < 2; ++j) {
            f32x16 p0 = {}, p1 = {};
#pragma unroll
            for (int s = 0; s < NS; ++s) { p0 = mfma32(kf0[s], qf[j][s], p0); p1 = mfma32(kf1[s], qf[j][s], p1); }
            if (j == 1) { __builtin_amdgcn_sched_barrier(0); ATT64_VLOAD(0); __builtin_amdgcn_sched_barrier(0); }
            float mx = p0[0];
#pragma unroll
            for (int r = 1; r < 16; ++r) mx = fmaxf(mx, p0[r]);
#pragma unroll
            for (int r = 0; r < 16; ++r) mx = fmaxf(mx, p1[r]);
            { auto rr = __builtin_amdgcn_permlane32_swap(__float_as_uint(mx), __float_as_uint(mx), false, false); mx = fmaxf(__uint_as_float(rr[0]), __uint_as_float(rr[1])); }
            if (__any(mx > m[j] + 8.f)) {
                const float mn = fmaxf(m[j], mx), al = __builtin_amdgcn_exp2f(m[j] - mn); m[j] = mn; l[j] *= al;
#pragma unroll
                for (int r = 0; r < 16; ++r) { o[j][0][r] *= al; o[j][1][r] *= al; }
            }
            const float nm = -m[j];
#pragma unroll
            for (int r = 0; r < 16; ++r) { p0[r] = __builtin_amdgcn_exp2f(p0[r] + nm); p1[r] = __builtin_amdgcn_exp2f(p1[r] + nm); }
            f32x2 ls2 = {0.f, 0.f};
#pragma unroll
            for (int r = 0; r < 16; r += 2) { ls2 += (f32x2){p0[r], p0[r + 1]}; ls2 += (f32x2){p1[r], p1[r + 1]}; }
            l[j] += ls2.x + ls2.y;
#pragma unroll
            for (int i = 0; i < 8; ++i) { pw[j][i] = cvt_pk_bf16(p0[2 * i], p0[2 * i + 1]); pw[j][8 + i] = cvt_pk_bf16(p1[2 * i], p1[2 * i + 1]); }
            __builtin_amdgcn_sched_barrier(0);
        }
        ATT64_PV(0);
        __builtin_amdgcn_sched_barrier(0);
        ATT64_VLOAD(1);
        __builtin_amdgcn_sched_barrier(0);
        ATT64_PV(1);
#undef ATT64_VLOAD
#undef ATT64_PV
        __builtin_amdgcn_sched_barrier(0);
#pragma unroll
        for (int s = 0; s < 4; ++s) { kf0[s] = *(const LAS bf16x8*)(lds + BNX + ka[s]); kf1[s] = *(const LAS bf16x8*)(lds + BNX + 4096 + ka[s]); }
        asm volatile("s_waitcnt vmcnt(2) lgkmcnt(0)\n\ts_barrier" ::: "memory");
    };
    for (int t = 0; t < NT; t += 4) {
        step(IC<0>{}, IC<3>{}, t); step(IC<1>{}, IC<0>{}, t + 1); step(IC<2>{}, IC<1>{}, t + 2); step(IC<3>{}, IC<2>{}, t + 3);
    }
#pragma unroll
    for (int j = 0; j < 2; ++j) {
        float lj = l[j]; { auto rr = __builtin_amdgcn_permlane32_swap(__float_as_uint(lj), __float_as_uint(lj), false, false); lj = __uint_as_float(rr[0]) + __uint_as_float(rr[1]); }
        const float il = 1.f / lj;
        bf16_t* op = out + (size_t)(wid * 64 + 32 * j + r32) * 1024 + 4 * hi;
#pragma unroll
        for (int g = 0; g < 4; ++g) { u32x2 a, b;
            a.x = cvt_pk_bf16(o[j][0][4 * g] * il, o[j][0][4 * g + 1] * il); a.y = cvt_pk_bf16(o[j][0][4 * g + 2] * il, o[j][0][4 * g + 3] * il);
            b.x = cvt_pk_bf16(o[j][1][4 * g] * il, o[j][1][4 * g + 1] * il); b.y = cvt_pk_bf16(o[j][1][4 * g + 2] * il, o[j][1][4 * g + 3] * il);
            *(u32x2*)(op + 8 * g) = a; *(u32x2*)(op + 32 + 8 * g) = b; }
    }
#undef ATT_DMA
}
__device__ __forceinline__ void glds16s(const void* base, unsigned voff, unsigned lds_base) {
    unsigned sv; asm volatile("s_mov_b32 %0, m0\n\ts_mov_b32 m0, %3\n\ts_nop 0\n\tglobal_load_lds_dwordx4 %1, %2\n\ts_mov_b32 m0, %0" : "=&s"(sv) : "v"(voff), "s"(base), "s"(lds_base) : "memory"); }
__device__ __forceinline__ void attn_unit64m(LAS unsigned char* lds, const bf16_t* __restrict__ Q, const bf16_t* __restrict__ K1, const bf16_t* __restrict__ K2, const bf16_t* __restrict__ V,
                                            int nkeys, bf16_t* __restrict__ out) {
    constexpr int DK = 96;
    int tid_ = threadIdx.x; asm volatile("" : "+v"(tid_));
    const int tid = tid_, lane = tid & 63, wid = __builtin_amdgcn_readfirstlane(tid >> 6), r32 = lane & 31, hi = lane >> 5;
    bf16x8 qf[2][4];
    LAS unsigned char* qrl = lds + 4 * ATT_BUF + wid * 4096 + lane * 16;
#pragma unroll
    for (int j = 0; j < 2; ++j) { const bf16_t* qp = Q + (size_t)(wid * 64 + 32 * j + r32) * DK + 8 * hi;
#pragma unroll
        for (int s = 0; s < 4; ++s) qf[j][s] = *(const bf16x8*)(qp + 16 * s);
#pragma unroll
        for (int s = 0; s < 2; ++s) *(LAS bf16x8*)(qrl + (2 * j + s) * 1024) = *(const bf16x8*)(qp + 64 + 16 * s); }
    const int dkey = 8 * wid + (lane >> 3), dkey2 = 16 * (wid & 3) + (lane >> 2);
    const unsigned ok1 = (unsigned)(dkey * 64 + (((lane & 7) ^ ((dkey >> 1) & 7)) << 3)) * 2u, ov = (unsigned)(dkey * 64 + (((lane & 7) ^ (((dkey >> 1) & 1) << 2)) << 3)) * 2u,
                   ok2 = (unsigned)(dkey2 * 32 + (((lane & 3) ^ ((dkey2 >> 2) & 3)) << 3)) * 2u;
    const unsigned lds0 = (unsigned)(size_t)lds;
    const unsigned d_k1 = lds0 + wid * 1024, d_v = lds0 + 8192 + wid * 1024, d_k2 = lds0 + 16384 + (wid & 3) * 1024;
#define ATT_DMA(tile_, slot_) do { const int tt_ = (tile_); glds16s((const char*)K1 + (size_t)tt_ * 8192, ok1, (unsigned)__builtin_amdgcn_readfirstlane(d_k1 + (slot_) * ATT_BUF)); \
        glds16s((const char*)V + (size_t)tt_ * 8192, ov, (unsigned)__builtin_amdgcn_readfirstlane(d_v + (slot_) * ATT_BUF)); \
        glds16s((const char*)K2 + (size_t)tt_ * 4096, ok2, (unsigned)__builtin_amdgcn_readfirstlane(d_k2 + (slot_) * ATT_BUF)); } while (0)
    const unsigned ka0_ = r32 * 128 + ((hi ^ ((r32 >> 1) & 7)) << 4), kb0_ = 16384 + r32 * 64 + ((hi ^ ((r32 >> 2) & 3)) << 4);
#define ka(s_) (kao_ ^ ((unsigned)(s_) << 5))
#define kb(s_) (kbo_ ^ ((unsigned)(s_) << 5))
    const int vq = (lane & 15) >> 2, vp = lane & 3, vg = (lane >> 4) & 1;
    const unsigned va0_ = 8192 + (4 * hi + vq) * 128 + ((((16 * vg + 4 * vp) * 2)) ^ ((((4 * hi + vq) >> 1) & 1) << 6));
    float m[2] = {-1e30f, -1e30f}, l[2] = {0.f, 0.f};
    f32x16 o[2][2] = {};
    const int NT = nkeys >> 6;
    ATT_DMA(0, 0); ATT_DMA(1, 1); ATT_DMA(2, 2);
    asm volatile("s_waitcnt vmcnt(0) lgkmcnt(0)\n\ts_barrier" ::: "memory");
    auto step = [&](auto cur_, auto wsl_, int t) __attribute__((always_inline)) {
        constexpr int BC = decltype(cur_)::value * ATT_BUF;
        unsigned kao_ = ka0_, kbo_ = kb0_, vao_ = va0_; asm volatile("" : "+v"(kao_), "+v"(kbo_), "+v"(vao_));
        const unsigned va[2] = {vao_, vao_ ^ 64u};
        ATT_DMA((t + 3 < NT) ? t + 3 : NT - 1, decltype(wsl_)::value);
        f32x16 pj[2][2];
#pragma unroll
        for (int j = 0; j < 2; ++j) { pj[j][0] = f32x16{}; pj[j][1] = f32x16{}; }
        {
            bf16x8 ka0[2], ka1[2], kb0[2], kb1[2];
#pragma unroll
            for (int s = 0; s < 2; ++s) { ka0[s] = *(const LAS bf16x8*)(lds + BC + ka(s)); ka1[s] = *(const LAS bf16x8*)(lds + BC + 4096 + ka(s)); }
#pragma unroll
            for (int s = 0; s < 2; ++s) { kb0[s] = *(const LAS bf16x8*)(lds + BC + ka(2 + s)); kb1[s] = *(const LAS bf16x8*)(lds + BC + 4096 + ka(2 + s)); }
            __builtin_amdgcn_sched_barrier(0);
#pragma unroll
            for (int s = 0; s < 2; ++s)
#pragma unroll
                for (int j = 0; j < 2; ++j) { pj[j][0] = mfma32(ka0[s], qf[j][s], pj[j][0]); pj[j][1] = mfma32(ka1[s], qf[j][s], pj[j][1]); }
            __builtin_amdgcn_sched_barrier(0);
            bf16x8 qr[2][2];
#pragma unroll
            for (int s = 0; s < 2; ++s) { ka0[s] = *(const LAS bf16x8*)(lds + BC + kb(s)); ka1[s] = *(const LAS bf16x8*)(lds + BC + 2048 + kb(s)); }
            __builtin_amdgcn_sched_barrier(0);
#pragma unroll
            for (int s = 0; s < 2; ++s)
#pragma unroll
                for (int j = 0; j < 2; ++j) { pj[j][0] = mfma32(kb0[s], qf[j][2 + s], pj[j][0]); pj[j][1] = mfma32(kb1[s], qf[j][2 + s], pj[j][1]); }
            __builtin_amdgcn_sched_barrier(0);
#pragma unroll
            for (int j = 0; j < 2; ++j)
#pragma unroll
                for (int s = 0; s < 2; ++s) qr[j][s] = *(const LAS bf16x8*)(qrl + (2 * j + s) * 1024);
            __builtin_amdgcn_sched_barrier(0);
#pragma unroll
            for (int s = 0; s < 2; ++s)
#pragma unroll
                for (int j = 0; j < 2; ++j) { pj[j][0] = mfma32(ka0[s], qr[j][s], pj[j][0]); pj[j][1] = mfma32(ka1[s], qr[j][s], pj[j][1]); }
            __builtin_amdgcn_sched_barrier(0);
        }
        unsigned pw[2][16];
        s16x4 vlo[2][2], vhi[2][2];
#define ATT64_VLOAD(kt_) do { _Pragma("unroll") for (int sp = 0; sp < 2; ++sp) { const int kofs = (32 * (kt_) + 16 * sp) * 128; \
            _Pragma("unroll") for (int dvb = 0; dvb < 2; ++dvb) { vlo[dvb][sp] = lds_tr16(lds + BC + va[dvb] + kofs); vhi[dvb][sp] = lds_tr16(lds + BC + va[dvb] + kofs + 8 * 128); } } } while (0)
#define ATT64_PV(kt_) do { _Pragma("unroll") for (int sp = 0; sp < 2; ++sp) _Pragma("unroll") for (int dvb = 0; dvb < 2; ++dvb) { \
            const s16x4 lo = vlo[dvb][sp], hi4 = vhi[dvb][sp]; const bf16x8 vf = (bf16x8){lo[0], lo[1], lo[2], lo[3], hi4[0], hi4[1], hi4[2], hi4[3]}; \
            _Pragma("unroll") for (int j = 0; j < 2; ++j) { const u32x4 pq = (u32x4){pw[j][8 * (kt_) + 4 * sp], pw[j][8 * (kt_) + 4 * sp + 1], pw[j][8 * (kt_) + 4 * sp + 2], pw[j][8 * (kt_) + 4 * sp + 3]}; \
                o[j][dvb] = mfma32(vf, __builtin_bit_cast(bf16x8, pq), o[j][dvb]); } } } while (0)
#pragma unroll
        for (int j = 0; j < 2; ++j) {
            f32x16 p0 = pj[j][0], p1 = pj[j][1];
            if (j == 1) { __builtin_amdgcn_sched_barrier(0); ATT64_VLOAD(0); __builtin_amdgcn_sched_barrier(0); }
            float mx = p0[0];
#pragma unroll
            for (int r = 1; r < 16; ++r) mx = fmaxf(mx, p0[r]);
#pragma unroll
            for (int r = 0; r < 16; ++r) mx = fmaxf(mx, p1[r]);
            { auto rr = __builtin_amdgcn_permlane32_swap(__float_as_uint(mx), __float_as_uint(mx), false, false); mx = fmaxf(__uint_as_float(rr[0]), __uint_as_float(rr[1])); }
            if (__any(mx > m[j] + 8.f)) {
                const float mn = fmaxf(m[j], mx), al = __builtin_amdgcn_exp2f(m[j] - mn); m[j] = mn; l[j] *= al;
#pragma unroll
                for (int r = 0; r < 16; ++r) { o[j][0][r] *= al; o[j][1][r] *= al; }
            }
            const float nm = -m[j];
#pragma unroll
            for (int r = 0; r < 16; ++r) { p0[r] = __builtin_amdgcn_exp2f(p0[r] + nm); p1[r] = __builtin_amdgcn_exp2f(p1[r] + nm); }
            f32x2 ls2 = {0.f, 0.f};
#pragma unroll
            for (int r = 0; r < 16; r += 2) { ls2 += (f32x2){p0[r], p0[r + 1]}; ls2 += (f32x2){p1[r], p1[r + 1]}; }
            l[j] += ls2.x + ls2.y;
#pragma unroll
            for (int i = 0; i < 8; ++i) { pw[j][i] = cvt_pk_bf16(p0[2 * i], p0[2 * i + 1]); pw[j][8 + i] = cvt_pk_bf16(p1[2 * i], p1[2 * i + 1]); }
            __builtin_amdgcn_sched_barrier(0);
        }
        ATT64_PV(0);
        __builtin_amdgcn_sched_barrier(0);
        ATT64_VLOAD(1);
        __builtin_amdgcn_sched_barrier(0);
        ATT64_PV(1);
#undef ATT64_VLOAD
#undef ATT64_PV
        if (DK == 96) asm volatile("s_waitcnt vmcnt(6) lgkmcnt(0)\n\ts_barrier" ::: "memory"); else asm volatile("s_waitcnt vmcnt(4) lgkmcnt(0)\n\ts_barrier" ::: "memory");
    };
    for (int t = 0; t < NT; t += 4) {
        step(IC<0>{}, IC<3>{}, t); step(IC<1>{}, IC<0>{}, t + 1); step(IC<2>{}, IC<1>{}, t + 2); step(IC<3>{}, IC<2>{}, t + 3);
    }
#pragma unroll
    for (int j = 0; j < 2; ++j) {
        float lj = l[j]; { auto rr = __builtin_amdgcn_permlane32_swap(__float_as_uint(lj), __float_as_uint(lj), false, false); lj = __uint_as_float(rr[0]) + __uint_as_float(rr[1]); }
        const float il = 1.f / lj;
        bf16_t* op = out + (size_t)(wid * 64 + 32 * j + r32) * 1024 + 4 * hi;
#pragma unroll
        for (int g = 0; g < 4; ++g) { u32x2 a, b;
            a.x = cvt_pk_bf16(o[j][0][4 * g] * il, o[j][0][4 * g + 1] * il); a.y = cvt_pk_bf16(o[j][0][4 * g + 2] * il, o[j][0][4 * g + 3] * il);
            b.x = cvt_pk_bf16(o[j][1][4 * g] * il, o[j][1][4 * g + 1] * il); b.y = cvt_pk_bf16(o[j][1][4 * g + 2] * il, o[j][1][4 * g + 3] * il);
            *(u32x2*)(op + 8 * g) = a; *(u32x2*)(op + 32 + 8 * g) = b; }
    }
#undef ATT_DMA
#undef ka
#undef kb
}
__device__ __forceinline__ void phase_p3(LAS unsigned char* lds, const WS& w, int l, int vb, int nvb, int xpart, int xrank) {
    const float c2g = 0.125f * 1.4426950408889634f, c2m = 0.10206207261596577f * 1.4426950408889634f;
    bf16_t* MIX = w.H();
    const int nlat = NB * 12 * 4, nctx = (l == 0) ? NB * 12 : 0;
    const bool xl = (nvb == 256);
    for (int u = vb; u < nlat + nctx; u += nvb) {
        if (u < nlat) {
            const bool mla = u >= nlat / 2; const int v = mla ? u - nlat / 2 : u;
            int qb, hh, b;
            if (xl) { const int grp = (v >> 8) * 64 + 8 * xpart + (xrank >> 2); qb = xrank & 3; hh = grp % 6; b = grp / 6; }
            else { qb = v & 3; hh = (v >> 2) % 6; b = v / 24; }
            bf16_t* out = MIX + ((size_t)b * S + qb * 512) * 1024;
            if (!mla) attn_unit64<64>(lds, w.Qg() + (((size_t)b * 6 + hh) * S + qb * 512) * 64, w.Kg() + ((size_t)b * 2 + hh / 3) * KEYS * 64, nullptr, w.Vg() + ((size_t)b * 2 + hh / 3) * KEYS * 64, KEYS, out + hh * 64);
            else attn_unit64m(lds, w.Qm() + (((size_t)b * 6 + hh) * S + qb * 512) * 96, w.Kmn() + ((size_t)b * 6 + hh) * KEYS * 64, w.KR() + (size_t)b * KEYS * 32, w.Vm() + ((size_t)b * 6 + hh) * KEYS * 64, KEYS, out + 640 + hh * 64);
        } else {
            const int v = u - nlat, slot = v % 12, b = v / 12;
            bf16_t* out = MIX + ((size_t)NL + (size_t)b * CTX) * 1024;
            if (slot < 6) attn_unit<64>(lds, w.Qgc() + ((size_t)b * 6 + slot) * CTX * 64, w.Kg() + ((size_t)b * 2 + slot / 3) * KEYS * 64, nullptr, w.Vg() + ((size_t)b * 2 + slot / 3) * KEYS * 64, CTX, c2g, out + slot * 64);
            else { const int h = slot - 6; attn_unit<96>(lds, w.Qmc() + ((size_t)b * 6 + h) * CTX * 96, w.Kmn() + ((size_t)b * 6 + h) * KEYS * 64, w.KR() + (size_t)b * KEYS * 32, w.Vm() + ((size_t)b * 6 + h) * KEYS * 64, CTX, c2m, out + 640 + h * 64); }
        }
    }
}

__device__ __forceinline__ unsigned fkey(float f, unsigned tag, unsigned mask) { return (__float_as_uint(f) & ~mask) | tag; }
__device__ __forceinline__ float keyf(unsigned k, unsigned mask) { return __uint_as_float(k & ~mask); }
__device__ __forceinline__ unsigned fmax_u(unsigned a, unsigned b) { unsigned r; asm("v_max_f32 %0, %1, %2" : "=v"(r) : "v"(a), "v"(b)); return r; }
__device__ __forceinline__ unsigned fmin_u(unsigned a, unsigned b) { unsigned r; asm("v_min_f32 %0, %1, %2" : "=v"(r) : "v"(a), "v"(b)); return r; }
__device__ __forceinline__ void ce_desc(unsigned& a, unsigned& b) { const unsigned hi_ = fmax_u(a, b), lo_ = fmin_u(a, b); a = hi_; b = lo_; }
template <int J> __device__ __forceinline__ void bstage16(unsigned* a) {
#pragma unroll
    for (int i = 0; i < 16; ++i) { const int l = i ^ J; if (l > i) ce_desc(a[i], a[l]); }
}
__device__ __forceinline__ void sort16_desc(unsigned* a) {
#define CE_(i, j) ce_desc(a[i], a[j]);
    CE_(0, 13) CE_(1, 12) CE_(2, 15) CE_(3, 14) CE_(4, 8) CE_(5, 6) CE_(7, 11) CE_(9, 10)
    CE_(0, 5) CE_(1, 7) CE_(2, 9) CE_(3, 4) CE_(6, 13) CE_(8, 14) CE_(10, 15) CE_(11, 12)
    CE_(0, 1) CE_(2, 3) CE_(4, 5) CE_(6, 8) CE_(7, 9) CE_(10, 11) CE_(12, 13) CE_(14, 15)
    CE_(0, 2) CE_(1, 3) CE_(4, 10) CE_(5, 11) CE_(6, 7) CE_(8, 9) CE_(12, 14) CE_(13, 15)
    CE_(1, 2) CE_(3, 12) CE_(4, 6) CE_(5, 7) CE_(8, 10) CE_(9, 11) CE_(13, 14)
    CE_(1, 4) CE_(2, 6) CE_(5, 8) CE_(7, 10) CE_(9, 13) CE_(11, 14)
    CE_(2, 4) CE_(3, 6) CE_(9, 12) CE_(11, 13)
    CE_(3, 5) CE_(6, 8) CE_(7, 9) CE_(10, 12)
    CE_(3, 4) CE_(5, 6) CE_(7, 8) CE_(9, 10) CE_(11, 12)
    CE_(6, 7) CE_(8, 9)
#undef CE_
}
__device__ __forceinline__ void bmerge16_desc(unsigned* c) { bstage16<8>(c); bstage16<4>(c); bstage16<2>(c); bstage16<1>(c); }
__device__ __forceinline__ void merge_top16(unsigned* a, const unsigned* b) {
#pragma unroll
    for (int i = 0; i < 16; ++i) a[i] = fmax_u(a[i], b[15 - i]);
    bmerge16_desc(a);
}
__device__ __forceinline__ void xlane_top16(unsigned* t, int hi) {
    unsigned r[16]; const unsigned msk = 0u - (unsigned)hi;
#pragma unroll
    for (int i = 0; i < 16; ++i) r[i] = t[i] ^ ((t[i] ^ t[15 - i]) & msk);
#pragma unroll
    for (int i = 0; i < 16; ++i) { auto s = __builtin_amdgcn_permlane32_swap(r[i], r[i], false, false); t[i] = fmax_u(s[0], s[1]); }
    bmerge16_desc(t);
}
__device__ __forceinline__ constexpr int cand_a(int c) { return c < 16 ? 0 : c < 24 ? 1 : c < 32 ? 39 - c : c < 37 ? 2 : c < 41 ? 3 : c < 44 ? 4 : c < 46 ? 5 : c < 48 ? 6 : 7; }
__device__ __forceinline__ constexpr int cand_b(int c) { return c < 16 ? c : c < 24 ? c - 16 : c < 32 ? 0 : c < 37 ? c - 32 : c < 41 ? c - 37 : c < 44 ? c - 41 : c < 46 ? c - 44 : c < 48 ? c - 46 : c - 48; }

__device__ __forceinline__ void phase_p6b(LAS unsigned char* lds, const bf16_t* __restrict__ PQ, const bf16_t* __restrict__ SubKl, unsigned* __restrict__ EG, int nrows, int vb, int nvb) {
    int tid_ = threadIdx.x; asm volatile("" : "+v"(tid_));
    const int tid = tid_, lane = tid & 63, wid = __builtin_amdgcn_readfirstlane(tid >> 6), r32 = lane & 31, hi = lane >> 5;
    const int h = vb & 7, wrank = (vb >> 3) * 8 + wid, nwr = (nvb >> 3) * 8;
    LAS unsigned short* tab = (LAS unsigned short*)(lds + 65536 + wid * 4096) + r32 * 64;
#pragma unroll
    for (int i = 0; i < 8; ++i) { const int idx = i * 512 + tid, p = idx >> 11, key = (idx >> 4) & 127, ch = idx & 15;
        *(LAS u32x4*)(lds + p * 32768 + key * 256 + ((ch ^ (key & 15)) << 4)) = *(const u32x4*)(SubKl + ((size_t)(h * 2 + p) * 128 + key) * 128 + ch * 8); }
    __syncthreads();
    const int ngroups = nrows >> 5;
    for (int tg = wrank; tg < ngroups; tg += nwr) {
        const int row0 = tg << 5;
        bf16x8 qf[2][8];
        { const bf16_t* qp = PQ + (size_t)(row0 + r32) * 2048 + h * 256 + 8 * hi; asm volatile("" : "+v"(qp));
#pragma unroll
          for (int p = 0; p < 2; ++p)
#pragma unroll
              for (int s = 0; s < 8; ++s) qf[p][s] = *(const bf16x8*)(qp + p * 128 + 16 * s); }
        unsigned top[2][16];
#pragma unroll
        for (int p = 0; p < 2; ++p) {
            f32x16 acc[4];
#pragma unroll
            for (int kt = 0; kt < 4; ++kt) { acc[kt] = f32x16{}; const int key = 32 * kt + r32;
#pragma unroll
                for (int s = 0; s < 8; ++s) acc[kt] = mfma32(*(const LAS bf16x8*)(lds + p * 32768 + key * 256 + (((2 * s + hi) ^ (key & 15)) << 4)), qf[p][s], acc[kt]); }
            unsigned key[64];
#pragma unroll
            for (int kt = 0; kt < 4; ++kt)
#pragma unroll
                for (int r = 0; r < 16; ++r) { const int n = 32 * kt + (r & 3) + 8 * (r >> 2) + 4 * hi; key[16 * kt + r] = fkey(acc[kt][r], 127u - (unsigned)n, 127u); }
            sort16_desc(key); sort16_desc(key + 16); sort16_desc(key + 32); sort16_desc(key + 48);
            merge_top16(key, key + 16); merge_top16(key + 32, key + 48); merge_top16(key, key + 32);
            xlane_top16(key, hi);
#pragma unroll
            for (int i = 0; i < 16; ++i) top[p][i] = key[i];
        }
        float t0f[16], t1f[16];
#pragma unroll
        for (int i = 0; i < 16; ++i) { t0f[i] = keyf(top[0][i], 127u); t1f[i] = keyf(top[1][i], 127u); }
        unsigned ck[50];
#pragma unroll
        for (int c = 0; c < 50; ++c) ck[c] = fkey(t0f[cand_a(c)] + t1f[cand_b(c)], (unsigned)c, 63u);
        if (hi == 0) {
#pragma unroll
            for (int c = 0; c < 50; c += 2) {
                const unsigned ea = (127u - (top[0][cand_a(c)] & 127u)) * 128u + (127u - (top[1][cand_b(c)] & 127u));
                const unsigned eb = (127u - (top[0][cand_a(c + 1)] & 127u)) * 128u + (127u - (top[1][cand_b(c + 1)] & 127u));
                *(LAS unsigned*)(tab + c) = ea | (eb << 16);
            }
        }
        bmerge16_desc(ck + 16); sort16_desc(ck + 32);
        merge_top16(ck, ck + 16); merge_top16(ck, ck + 32);
        ck[15] = fmax_u(ck[15], ck[48]); ck[14] = fmax_u(ck[14], ck[49]); bmerge16_desc(ck);
        asm volatile("s_waitcnt lgkmcnt(0)" ::: "memory");
        const float mx = keyf(ck[0], 63u); float e[16], den = 0.f;
#pragma unroll
        for (int j = 0; j < 16; ++j) { e[j] = __builtin_amdgcn_exp2f((keyf(ck[j], 63u) - mx) * 1.4426950408889634f); den += e[j]; }
        const float iden = 1.f / den;
        if (hi == 0) {
            unsigned o[16];
#pragma unroll
            for (int j = 0; j < 16; ++j) { const unsigned eid = tab[ck[j] & 63u]; o[j] = (eid << 16) | (cvt_pk_bf16(e[j] * iden, 0.f) & 0xffffu); }
            unsigned* dst = EG + (size_t)(row0 + r32) * 128 + h * 16;
#pragma unroll
            for (int j = 0; j < 16; j += 4) *(u32x4*)(dst + j) = (u32x4){o[j], o[j + 1], o[j + 2], o[j + 3]};
        }
        asm volatile("s_waitcnt lgkmcnt(0)" ::: "memory");
    }
}


#define XB_TMO      128
#define XB_XCNT(j)  (256  + 64 * (j))
#define XB_XSUB(j)  (1280 + 64 * (j))
#define XB_XGEN(j)  (2304 + 64 * (j))
#define XB_TOP      3328
#define XB_TOPGEN   3392
#define XCD_BAR_WORDS 3456
#define XB_SPIN_CAP (1u << 18)

__device__ __forceinline__ unsigned xb_ld(unsigned* p)              { return __hip_atomic_load(p, __ATOMIC_RELAXED, __HIP_MEMORY_SCOPE_AGENT); }
__device__ __forceinline__ unsigned xb_add(unsigned* p, unsigned v) { return __hip_atomic_fetch_add(p, v, __ATOMIC_RELAXED, __HIP_MEMORY_SCOPE_AGENT); }
__device__ __forceinline__ unsigned xb_xcc_id() { return (unsigned)__builtin_amdgcn_s_getreg((3 << 11) | 20) & 0xFu; }
#define XB_SPIN(cond, bar) do { unsigned _sp = 0; while (cond) { __builtin_amdgcn_s_sleep(1); \
    if ((++_sp & 255u) == 0u) { if (xb_ld(&(bar)[XB_TMO])) break; if (_sp > XB_SPIN_CAP) { atomicAdd(&(bar)[XB_TMO], 1u); break; } } } } while (0)

struct XcdBarrier {
    unsigned* bar; unsigned x;
    volatile LAS unsigned* st;
};

__device__ __forceinline__ XcdBarrier xcd_barrier_post(unsigned* bar, volatile LAS unsigned* st) {
    XcdBarrier b; b.bar = bar; b.x = xb_xcc_id(); b.st = st;
    if (threadIdx.x == 0) (void)xb_add(&bar[XB_XCNT(b.x)], 1u);
    return b;
}
__device__ __forceinline__ void xcd_barrier_complete(unsigned* bar, unsigned x, unsigned& nloc, unsigned& nx) {
    const unsigned G = gridDim.x * gridDim.y * gridDim.z;
    unsigned sum, cnt, mine, sp = 0u;
    for (;;) {
        sum = 0u; cnt = 0u; mine = 0u;
#pragma unroll
        for (unsigned j = 0; j < 16; ++j) { const unsigned c = xb_ld(&bar[XB_XCNT(j)]); sum += c; cnt += (c > 0u) ? 1u : 0u; mine = (j == x) ? c : mine; }
        if (sum == G) break;
        __builtin_amdgcn_s_sleep(1);
        if ((++sp & 255u) == 0u) { if (xb_ld(&bar[XB_TMO])) break; if (sp > XB_SPIN_CAP) { atomicAdd(&bar[XB_TMO], 1u); break; } }
    }
    nloc = mine > 0u ? mine : 1u; nx = cnt > 0u ? cnt : 1u;
}

__device__ __forceinline__ void xcd_barrier(const XcdBarrier& b) {
    asm volatile("s_waitcnt vmcnt(0)" ::: "memory");
    __syncthreads();
    if (threadIdx.x == 0) {
        unsigned* bar = b.bar;
        __builtin_amdgcn_s_waitcnt(0);
        unsigned nloc = b.st[0], nx = b.st[1];
        if (nloc == 0u) { xcd_barrier_complete(bar, b.x, nloc, nx); b.st[0] = nloc; b.st[1] = nx; }
        const unsigned old = xb_add(&bar[XB_XSUB(b.x)], 1u);
        const unsigned gen = old / nloc;
        if (old + 1u == (gen + 1u) * nloc) {
            __builtin_amdgcn_fence(__ATOMIC_RELEASE, "agent");
            asm volatile("s_waitcnt vmcnt(0)" ::: "memory");
            const unsigned og = xb_add(&bar[XB_TOP], 1u);
            const unsigned tg = og / nx;
            if (og + 1u == (tg + 1u) * nx) xb_add(&bar[XB_TOPGEN], 1u);
            else XB_SPIN(xb_ld(&bar[XB_TOPGEN]) == tg, bar);
            __builtin_amdgcn_fence(__ATOMIC_ACQUIRE, "agent");
            xb_add(&bar[XB_XGEN(b.x)], 1u);
            asm volatile("s_waitcnt vmcnt(0)" ::: "memory");
        } else {
            XB_SPIN(xb_ld(&bar[XB_XGEN(b.x)]) == gen, bar);
            __builtin_amdgcn_fence(__ATOMIC_ACQUIRE, "agent");
            asm volatile("s_waitcnt vmcnt(0)" ::: "memory");
        }
    }
    __syncthreads();
}

__device__ __forceinline__ void phase_mod(LAS unsigned char* lds, const Inputs& in, const WS& w, int vb) {
    if (vb >= 72) return;
    LAS float* sc = (LAS float*)lds;
    int tid_ = threadIdx.x; asm volatile("" : "+v"(tid_));
    const int tid = tid_, idx = vb * 512 + tid, rg = idx / 12288, ln = idx % 12288, l = ln / 6144, n = ln % 6144;
    float acc[11];
#pragma unroll
    for (int i = 0; i < 11; ++i) acc[i] = 0.f;
    const float* wp = in.ada_w + (size_t)l * 1024 * 6144 + n;
    for (int kc = 0; kc < 4; ++kc) {
        for (int i = tid; i < 33 * 256; i += 512) { const int r = i >> 8, k = kc * 256 + (i & 255); const float v = r < 32 ? in.c[(size_t)r * 1024 + k] : in.c_ctx[k]; sc[i] = v / (1.f + __expf(-v)); }
        __syncthreads();
        for (int k = 0; k < 256; ++k) { const float wv = wp[(size_t)(kc * 256 + k) * 6144];
#pragma unroll
            for (int i = 0; i < 11; ++i) acc[i] += sc[(rg * 11 + i) * 256 + k] * wv; }
        __syncthreads();
    }
    const float bias = in.ada_b[(size_t)l * 6144 + n];
#pragma unroll
    for (int i = 0; i < 11; ++i) w.MOD()[((size_t)l * 33 + rg * 11 + i) * 6144 + n] = acc[i] + bias;
}
__device__ __forceinline__ void phase_rope(const WS& w, int vb, int nvb) {
    int tid_ = threadIdx.x; asm volatile("" : "+v"(tid_));
    for (int i = vb * 512 + tid_; i < 2048 * 32; i += nvb * 512) {
        { const int t = i / 32, j = i % 32; const double inv = pow(10000.0, -(double)(j % 16) / 16.0); const double a = (double)(j < 16 ? t / 64 : t % 64) * inv; w.ROPA()[i] = make_float2((float)cos(a), (float)sin(a)); }
        if (i < 2048 * 16) { const int t = i / 16, j = i % 16; const double inv = pow(10000.0, -(double)(j % 8) / 8.0); const double a = (double)(j < 8 ? t / 64 : t % 64) * inv; w.ROPC()[i] = make_float2((float)cos(a), (float)sin(a)); }
    }
}

#ifndef PROBE_MASK
#define PROBE_MASK 0
#endif
#ifndef BENCH_MODE
#define BENCH_MODE 0
#endif
#if BENCH_MODE
__device__ __forceinline__ void phase_bench(float* sink) {
    int tid_ = threadIdx.x; asm volatile("" : "+v"(tid_));
    float x[16];
#pragma unroll
    for (int i = 0; i < 16; ++i) x[i] = (float)(tid_ + i) * 0.001f;
    f32x16 acc[4] = {};
    bf16x8 a = (bf16x8){(short)tid_, 1, 2, 3, 4, 5, 6, 7}, b = (bf16x8){7, 6, 5, 4, 3, 2, 1, (short)tid_};
#pragma nounroll
    for (int it = 0; it < ((BENCH_MODE & 7) ? 2048 : 0); ++it) {
#pragma unroll
        for (int k = 0; k < 8; ++k) {
            if (BENCH_MODE & 2) { acc[k & 3] = mfma32(a, b, acc[k & 3]); }
            __builtin_amdgcn_sched_barrier(0);
            if (BENCH_MODE & 1) { asm volatile("v_exp_f32 %0, -|%0|" : "+v"(x[2 * k])); asm volatile("v_exp_f32 %0, -|%0|" : "+v"(x[2 * k + 1])); }
            if (BENCH_MODE & 4) {
#pragma unroll
                for (int j = 0; j < 8; ++j) asm volatile("v_fma_f32 %0, %0, %0, %0" : "+v"(x[(2 * k + j) & 15]));
            }
            __builtin_amdgcn_sched_barrier(0);
        }
    }
    if (BENCH_MODE & 24) {
        const int lane = tid_ & 63, r32 = lane & 31, hi = lane >> 5;
        unsigned ka[2][4];
#pragma unroll
        for (int kt = 0; kt < 2; ++kt)
#pragma unroll
            for (int s_ = 0; s_ < 4; ++s_) { const int key = 32 * kt + r32; ka[kt][s_] = key * 128 + (((2 * s_ + hi) ^ ((key >> 1) & 7)) << 4); }
        const int vq = (lane & 15) >> 2, vp = lane & 3, vg = (lane >> 4) & 1;
        unsigned va[2];
#pragma unroll
        for (int dvb = 0; dvb < 2; ++dvb) { const int key = 4 * hi + vq; va[dvb] = 8192 + key * 128 + ((((32 * dvb + 16 * vg + 4 * vp) * 2)) ^ (((key >> 1) & 1) << 6)); }
        u32x4 kr[8]; u32x2 vr[16];
#pragma nounroll
        for (int it = 0; it < 2048; ++it) {
            if (BENCH_MODE & 8) {
#pragma unroll
                for (int kt = 0; kt < 2; ++kt)
#pragma unroll
                    for (int s_ = 0; s_ < 4; ++s_) asm volatile("ds_read_b128 %0, %1" : "=v"(kr[kt * 4 + s_]) : "v"(ka[kt][s_]));
            }
            if (BENCH_MODE & 16) {
#pragma unroll
                for (int q = 0; q < 4; ++q)
#pragma unroll
                    for (int dvb = 0; dvb < 2; ++dvb) { asm volatile("ds_read_b64_tr_b16 %0, %1" : "=v"(vr[q * 4 + dvb * 2]) : "v"(va[dvb] + q * 2048)); asm volatile("ds_read_b64_tr_b16 %0, %1 offset:1024" : "=v"(vr[q * 4 + dvb * 2 + 1]) : "v"(va[dvb] + q * 2048)); }
            }
            asm volatile("s_waitcnt lgkmcnt(0)" ::: "memory");
        }
        if (BENCH_MODE & 8) {
#pragma unroll
            for (int i = 0; i < 8; ++i) x[i] += __uint_as_float(kr[i][0] ^ kr[i][1] ^ kr[i][2] ^ kr[i][3]);
        }
        if (BENCH_MODE & 16) {
#pragma unroll
            for (int i = 0; i < 16; ++i) x[i] += __uint_as_float(vr[i][0] ^ vr[i][1]);
        }
    }
    float r = 0.f;
#pragma unroll
    for (int i = 0; i < 16; ++i) r += x[i];
#pragma unroll
    for (int k = 0; k < 4; ++k)
#pragma unroll
        for (int i = 0; i < 16; ++i) r += acc[k][i];
    if (r == 1.2345e30f) sink[tid_] = r;
}
#endif
struct MegaArgs { Inputs in; WS w; float* XL; unsigned* bar; };
constexpr int MEGA_LDS = 131072 + 16;
__global__ void __launch_bounds__(512, 2) k_mega(MegaArgs A) {
    LAS unsigned char* lds = (LAS unsigned char*)dyn_lds;
    const int vb = blockIdx.x, nvb = gridDim.x;
    volatile LAS unsigned* xbw = (volatile LAS unsigned*)(lds + 131072);
    if (threadIdx.x == 0) { xbw[0] = 0u; xbw[1] = 0u; xbw[2] = 0u; xbw[3] = 0u; }
    __syncthreads();
    XcdBarrier bar = xcd_barrier_post(A.bar, xbw);
    if (threadIdx.x == 0) xbw[2] = xb_add(&A.bar[3584 + 64 * bar.x], 1u);
    __syncthreads();
    const int xticket = __builtin_amdgcn_readfirstlane((int)xbw[2]);
    const WS& w = A.w; const Inputs& in = A.in;
    phase_mod(lds, in, w, vb);
    phase_rope(w, vb, nvb);
    phase_cvt(lds, in, w, vb, nvb);
    xcd_barrier(bar);
    phase_modulate<false>(in.x, in.ctx, nullptr, w.H(), in.norm1_g, w.MOD(), 0, NR, vb, nvb);
    xcd_barrier(bar);
#if (PROBE_MASK >> 0) & 1
    phase_mod(lds, in, w, vb);
    phase_rope(w, vb, nvb);
    phase_cvt(lds, in, w, vb, nvb);
    xcd_barrier(bar);
    phase_modulate<false>(in.x, in.ctx, nullptr, w.H(), in.norm1_g, w.MOD(), 0, NR, vb, nvb);
    xcd_barrier(bar);
#endif
#if BENCH_MODE
    phase_bench((float*)w.RSQ());
#endif
    int xpart = vb & 7, xrank = vb >> 3;
    { bool okx = (bar.x < 8u); for (unsigned j = 0; j < 8; ++j) okx = okx && (xb_ld(&A.bar[XB_XCNT(j)]) == (unsigned)(nvb >> 3));
      if (okx) { xpart = (int)bar.x; xrank = xticket; } }
    for (int l = 0; l < DEPTH; ++l) {
        const float* MODl = w.MOD() + (size_t)l * 33 * 6144;
        const bool last = (l == DEPTH - 1);
        const int MR = last ? NL : NR;
        phase_p1(lds, w, in, l, vb, nvb); xcd_barrier(bar);
#if (PROBE_MASK >> 1) & 1
        phase_p1(lds, w, in, l, vb, nvb); xcd_barrier(bar);
#endif
        phase_p2(lds, w, in, l, vb, nvb); xcd_barrier(bar);
#if (PROBE_MASK >> 12) & 7
        phase_p2(lds, w, in, l, vb, nvb, (PROBE_MASK >> 12) & 7); xcd_barrier(bar);
#endif
        phase_p3(lds, w, l, vb, nvb, xpart, xrank); xcd_barrier(bar);
#if (PROBE_MASK >> 3) & 1
        phase_p3(lds, w, l, vb, nvb, xpart, xrank); xcd_barrier(bar);
#endif
        phase_p4(lds, w, in, l, vb, nvb);
        xcd_barrier(bar);
#if (PROBE_MASK >> 4) & 1
        phase_p4(lds, w, in, l, vb, nvb);
        xcd_barrier(bar);
#endif
        if (l == 0) phase_modulate<false>(in.x, in.ctx, nullptr, w.H(), in.norm2_g + l * 1024, MODl, 3, MR, vb, nvb, w.H8(), w.HS(), w.PQ(), w.XB());
        else phase_modulate<true>(nullptr, nullptr, w.XB(), w.H(), in.norm2_g + l * 1024, MODl, 3, MR, vb, nvb, w.H8(), w.HS(), w.PQ(), w.XB());
        xcd_barrier(bar);
#if (PROBE_MASK >> 5) & 1
        phase_modulate<true>(nullptr, nullptr, w.XB(), w.H(), in.norm2_g + l * 1024, MODl, 3, MR, vb, nvb, w.H8(), w.HS()); xcd_barrier(bar);
#endif
        phase_p6a(lds, w, l, vb, nvb); xcd_barrier(bar);
#if (PROBE_MASK >> 6) & 1
        phase_p6a(lds, w, l, vb, nvb); xcd_barrier(bar);
#endif
        phase_p6b(lds, w.PQ(), w.SubK() + (size_t)l * 16 * 128 * 128, w.EG(), MR, vb, nvb); xcd_barrier(bar);
#if (PROBE_MASK >> 7) & 1
        phase_p6b(lds, w.PQ(), w.SubK() + (size_t)l * 16 * 128 * 128, w.EG(), MR, vb, nvb); xcd_barrier(bar);
#endif
        { P7CArgs a{w.H8(), w.EG(), w.U8() + (size_t)l * NE * 1024, (int*)w.PQ(), MR}; phase_p7c(lds, a, xpart, xrank, nvb); }
        xcd_barrier(bar);
#if (PROBE_MASK >> 8) & 1
        { P7CArgs a{w.H8(), w.EG(), w.U8() + (size_t)l * NE * 1024, (int*)w.PQ(), MR}; phase_p7c(lds, a, xpart, xrank, nvb); }
        xcd_barrier(bar);
#endif
        phase_p7d((const int*)w.PQ(), w.EG(), w.US() + (size_t)l * NE, w.VS() + (size_t)l * NE, w.HS(), w.WE(), MR, vb, nvb);
        xcd_barrier(bar);
#if (PROBE_MASK >> 9) & 1
        phase_p7d((const int*)w.PQ(), w.EG(), w.US() + (size_t)l * NE, w.VS() + (size_t)l * NE, w.HS(), w.WE(), MR, vb, nvb);
        xcd_barrier(bar);
#endif
        { P7BArgs a{w.WE(), w.V8() + (size_t)l * NE * 1024, w.XB(), MODl + 5 * 1024, MR}; phase_p7b<0>(lds, a, xpart, xrank, nvb); }
        xcd_barrier(bar);
#if (PROBE_MASK >> 10) & 3
        { P7BArgs a{w.WE(), w.V8() + (size_t)l * NE * 1024, w.XB(), MODl + 5 * 1024, MR}; phase_p7b<((PROBE_MASK >> 10) & 3)>(lds, a, xpart, xrank, nvb); }
        xcd_barrier(bar);
#endif
        if (last) phase_final_norm(w.XB(), A.XL, in.final_g, vb, nvb);
        else phase_modulate<true>(nullptr, nullptr, w.XB(), w.H(), in.norm1_g + (l + 1) * 1024, w.MOD() + (size_t)(l + 1) * 33 * 6144, 0, NR, vb, nvb);
        if (!last) xcd_barrier(bar);
    }
}

extern "C" void kernel_launch(void* const* d_in, const int* in_sizes, int n_in, void* d_out, int out_size, void* d_ws, size_t ws_size, hipStream_t stream) {
    const float* const* fin = (const float* const*)d_in;
    Inputs in{fin[0], fin[1], fin[2], fin[3], fin[4], fin[5], fin[6], fin[7], fin[8], fin[9], fin[10], fin[11], fin[12], fin[13], fin[14], fin[15], fin[16], fin[17], fin[18], fin[19], fin[20], fin[21], fin[22]};
    WS w = make_ws(d_ws);
    static int ok = 0;
    if (!ok) {
        if (hipFuncSetAttribute((const void*)k_mega, hipFuncAttributeMaxDynamicSharedMemorySize, MEGA_LDS) != hipSuccess) { ok = -1; }
        int per_cu = 0, cus = 0, dev = 0; (void)hipGetDevice(&dev); (void)hipDeviceGetAttribute(&cus, hipDeviceAttributeMultiprocessorCount, dev);
        if (hipOccupancyMaxActiveBlocksPerMultiprocessor(&per_cu, (const void*)k_mega, 512, MEGA_LDS) != hipSuccess || per_cu < 1 || cus < 256) ok = -1;
        if (ok == 0) ok = 1;
    }
    if (ok < 0) return;
    (void)hipMemsetAsync(d_ws, 0, 16384, stream);
    MegaArgs A{in, w, (float*)d_out, (unsigned*)d_ws};
    k_mega<<<256, 512, MEGA_LDS, stream>>>(A);
}
```

```cpp
#include <hip/hip_runtime.h>
#include <stdint.h>

typedef unsigned short bf16_t;

constexpr int D = 1024, NB = 32, S = 2048, CTX = 256, DEPTH = 2;
constexpr int NL = NB * S, NC = NB * CTX, NR = NL + NC;
constexpr int KEYS = CTX + S;
constexpr int INC = 1568;
constexpr int NE = 16384;
constexpr float EPS = 1e-6f;

__device__ __forceinline__ float bf2f(bf16_t v) { return __uint_as_float(((unsigned)v) << 16); }
__device__ __forceinline__ bf16_t f2bf(float f) { unsigned u = __float_as_uint(f); u += 0x7FFFu + ((u >> 16) & 1u); return (bf16_t)(u >> 16); }

__device__ __forceinline__ float wave_sum(float v) {
#pragma unroll
    for (int o = 32; o > 0; o >>= 1) v += __shfl_xor(v, o);
    return v;
}
__device__ __forceinline__ float gelu_tanh(float x) {
    const float u = 0.7978845608028654f * (x + 0.044715f * x * x * x);
    return 0.5f * x * (1.f + tanhf(u));
}

struct WS {
    char* base;
    __host__ __device__ __forceinline__ bf16_t* H() const { return (bf16_t*)(base + 65536ull); }
    __host__ __device__ __forceinline__ bf16_t* Qg() const { return (bf16_t*)(base + 151060480ull); }
    __host__ __device__ __forceinline__ bf16_t* Qgc() const { return (bf16_t*)(base + 201392128ull); }
    __host__ __device__ __forceinline__ bf16_t* Kg() const { return (bf16_t*)(base + 207683584ull); }
    __host__ __device__ __forceinline__ bf16_t* Vg() const { return (bf16_t*)(base + 226557952ull); }
    __host__ __device__ __forceinline__ bf16_t* CQ() const { return (bf16_t*)(base + 245432320ull); }
    __host__ __device__ __forceinline__ bf16_t* CKV() const { return (bf16_t*)(base + 302055424ull); }
    __host__ __device__ __forceinline__ bf16_t* Bp() const { return (bf16_t*)(base + 339804160ull); }
    __host__ __device__ __forceinline__ bf16_t* KR() const { return (bf16_t*)(base + 377552896ull); }
    __host__ __device__ __forceinline__ bf16_t* Qm() const { return (bf16_t*)(base + 382271488ull); }
    __host__ __device__ __forceinline__ bf16_t* Qmc() const { return (bf16_t*)(base + 457768960ull); }
    __host__ __device__ __forceinline__ bf16_t* Kmn() const { return (bf16_t*)(base + 467206144ull); }
    __host__ __device__ __forceinline__ bf16_t* Vm() const { return (bf16_t*)(base + 523829248ull); }
    __host__ __device__ __forceinline__ unsigned* EG() const { return (unsigned*)(base + 580452352ull); }
    __host__ __device__ __forceinline__ bf16_t* P() const { return (bf16_t*)(base + 382271488ull); }
    __host__ __device__ __forceinline__ bf16_t* PQ() const { return (bf16_t*)(base + 151060480ull); }
    __host__ __device__ __forceinline__ bf16_t* TMP() const { return (bf16_t*)(base + 65536ull); }
    __host__ __device__ __forceinline__ float* XC() const { return (float*)(base + 618201088ull); }
    __host__ __device__ __forceinline__ float* MOD() const { return (float*)(base + 651755520ull); }
    __host__ __device__ __forceinline__ float2* ROPA() const { return (float2*)(base + 653377536ull); }
    __host__ __device__ __forceinline__ float2* ROPC() const { return (float2*)(base + 653901824ull); }
    __host__ __device__ __forceinline__ float* RSQ() const { return (float*)(base + 654163968ull); }
    __host__ __device__ __forceinline__ float* RSKV() const { return (float*)(base + 654458880ull); }
    __host__ __device__ __forceinline__ bf16_t* WinT() const { return (bf16_t*)(base + 654753792ull); }
    __host__ __device__ __forceinline__ bf16_t* WuqT() const { return (bf16_t*)(base + 662093824ull); }
    __host__ __device__ __forceinline__ bf16_t* WukvT() const { return (bf16_t*)(base + 663273472ull); }
    __host__ __device__ __forceinline__ bf16_t* WoutT() const { return (bf16_t*)(base + 664059904ull); }
    __host__ __device__ __forceinline__ bf16_t* WqT() const { return (bf16_t*)(base + 668254208ull); }
    __host__ __device__ __forceinline__ bf16_t* SubK() const { return (bf16_t*)(base + 676642816ull); }
    __host__ __device__ __forceinline__ unsigned char* U8() const { return (unsigned char*)(base + 677691392ull); }
    __host__ __device__ __forceinline__ unsigned char* V8() const { return (unsigned char*)(base + 711245824ull); }
    __host__ __device__ __forceinline__ float* US() const { return (float*)(base + 744800256ull); }
    __host__ __device__ __forceinline__ float* VS() const { return (float*)(base + 744931328ull); }
    __host__ __device__ __forceinline__ float* SSQ() const { return (float*)(base + 745062400ull); }
    __host__ __device__ __forceinline__ float* SSKV() const { return (float*)(base + 747421696ull); }
    __host__ __device__ __forceinline__ unsigned* WE() const { return (unsigned*)(base + 748601344ull); }
    __host__ __device__ __forceinline__ signed char* H8() const { return (signed char*)(base + 786350080ull); }
    __host__ __device__ __forceinline__ float* HS() const { return (float*)(base + 861847552ull); }
    __host__ __device__ __forceinline__ bf16_t* PoolWT() const { return (bf16_t*)(base + 862142464ull); }
    __host__ __device__ __forceinline__ bf16_t* XB() const { return (bf16_t*)(base + 862208000ull); }
};
constexpr size_t WS_BYTES = 862208000ull + (size_t)NR * 1024 * 2;
static WS make_ws(void* d_ws) { WS w; w.base = (char*)d_ws; return w; }


#define LAS __attribute__((address_space(3)))
typedef short bf16x8 __attribute__((ext_vector_type(8)));
typedef float f32x4 __attribute__((ext_vector_type(4)));
typedef float f32x16 __attribute__((ext_vector_type(16)));
typedef unsigned u32x4 __attribute__((ext_vector_type(4)));
typedef unsigned u32x2 __attribute__((ext_vector_type(2)));

__device__ __forceinline__ f32x16 mfma32(bf16x8 a, bf16x8 b, f32x16 c) { return __builtin_amdgcn_mfma_f32_32x32x16_bf16(a, b, c, 0, 0, 0); }
__device__ __forceinline__ unsigned cvt_pk_bf16(float lo, float hi) { unsigned r; asm volatile("v_cvt_pk_bf16_f32 %0, %1, %2" : "=v"(r) : "v"(lo), "v"(hi)); return r; }

namespace pg8 {
constexpr int BM = 256, BK = 64, HALF = 128, HTB = HALF * BK * 2, STAGE_BYTES = 8 * HTB, NXCD = 8, WGM = 8;
__host__ __device__ __forceinline__ int lds_byte(int r, int c) { const int st = (r >> 4) * 2 + (c >> 5), rr = r & 15, cc = c & 31, ob = rr * 64 + cc * 2; return st * 1024 + (ob ^ (((ob >> 9) & 1) << 5)); }
__host__ __device__ __forceinline__ void stage_rc(int b, int& R, int& C) { const int st = b / 1024, sb = b % 1024, swz = sb ^ (((sb >> 9) & 1) << 5); R = (st >> 1) * 16 + swz / 64; C = (st & 1) * 32 + (swz % 64) / 2; }
__host__ __device__ __forceinline__ int perm32(int rho) { const int n = rho >> 4, i = rho & 15; return 8 * (i >> 2) + 4 * n + (i & 3); }
struct Unit { int pm, pn; };
struct Gemm { const bf16_t* A; const bf16_t* Bt; int M, N, K; };
struct StaticOrder {
    int nM, nN, nwg, G, c;
    __host__ __device__ void init(int M, int N, int G_, int c_) { nM = M / BM; nN = N / BM; nwg = nM * nN; G = G_; c = c_; }
    __host__ __device__ bool next(int i, Unit& u) const {
        const long L = (long)i * G + c; if (L >= nwg) return false;
        int wgid = (int)L; { const int q = nwg / NXCD, r = nwg % NXCD, xcd = wgid % NXCD, off = wgid / NXCD; wgid = (xcd < r ? xcd * (q + 1) : r * (q + 1) + (xcd - r) * q) + off; }
        const int nig = WGM * nN, gid = wgid / nig, fm = gid * WGM, gsz = (nM - fm) < WGM ? (nM - fm) : WGM;
        u.pm = fm + ((wgid % nig) % gsz); u.pn = (wgid % nig) / gsz; return true;
    }
};
template <class Epi, class Sched>
__device__ __forceinline__ void gemm_phase(LAS unsigned char* lds, const Gemm g, const Sched& S, const Epi& E) {
    int tid_ = threadIdx.x; asm volatile("" : "+v"(tid_));
    const int tid = tid_, wid = __builtin_amdgcn_readfirstlane(tid >> 6), lane = tid & 63, wr = wid >> 2, wc = wid & 3, fr = lane & 15, fq = lane >> 4;
    const int K = g.K, nt = K / BK;
    unsigned voffA[2], voffB[2];
#pragma unroll
    for (int i = 0; i < 2; ++i) { int R, C; stage_rc(tid * 16 + i * 8192, R, C); const int Rb = Epi::PERM ? ((R & ~31) + perm32(R & 31)) : R;
        voffA[i] = (unsigned)(R * K + C) * 2u; voffB[i] = (unsigned)(Rb * K + C) * 2u; }
    const size_t kstep = (size_t)(BK * 2);
    const size_t hstep = (size_t)HALF * K * 2;
    const size_t tstep = 2 * hstep;
    const unsigned ldsw = (unsigned)wid * 1024u;
    const int aoff = lds_byte(wr * 64 + fr, fq * 8), boff = lds_byte(wc * 32 + fr, fq * 8);
#define PG8_SA(b, h) (((b) * 2 + (h)) * HTB)
#define PG8_SB(b, h) ((4 + (b) * 2 + (h)) * HTB)
#define PG8_STAGE(bufoff, gbase, voff) do { _Pragma("unroll") for (int _i = 0; _i < 2; ++_i) \
        __builtin_amdgcn_global_load_lds((const unsigned*)((const char*)(gbase) + (voff)[_i]), (LAS unsigned*)(lds + (bufoff) + ldsw + _i * 8192), 16, 0, 0); } while (0)
#define PG8_LDA(dst, b, h) do { _Pragma("unroll") for (int m = 0; m < 4; ++m) _Pragma("unroll") for (int k = 0; k < 2; ++k) dst[m][k] = *(const LAS bf16x8*)(lds + PG8_SA(b, h) + aoff + m * 2048 + k * 1024); } while (0)
#define PG8_LDB(dst, b, h) do { _Pragma("unroll") for (int n = 0; n < 2; ++n) _Pragma("unroll") for (int k = 0; k < 2; ++k) dst[n][k] = *(const LAS bf16x8*)(lds + PG8_SB(b, h) + boff + n * 2048 + k * 1024); } while (0)
#define PG8_MMA(ai, bj, At, Bt) do { __builtin_amdgcn_s_setprio(1); _Pragma("unroll") for (int m = 0; m < 4; ++m) _Pragma("unroll") for (int n = 0; n < 2; ++n) _Pragma("unroll") for (int k = 0; k < 2; ++k) \
        acc[ai][bj][m][n] = __builtin_amdgcn_mfma_f32_16x16x32_bf16(Bt[n][k], At[m][k], acc[ai][bj][m][n], 0, 0, 0); __builtin_amdgcn_s_setprio(0); } while (0)
#define PG8_WAIT_V(n) asm volatile("s_waitcnt vmcnt(" #n ")" ::: "memory")
#define PG8_WAIT_L(n) asm volatile("s_waitcnt lgkmcnt(" #n ")" ::: "memory")
#define PG8_BAR __builtin_amdgcn_s_barrier()
#define PG8_SCHED __builtin_amdgcn_sched_barrier(0)
    Unit cur, nxt; int ui = 0;
    if (!S.next(0, cur)) return;
    f32x4 acc[2][2][4][2];
#pragma unroll
    for (int a = 0; a < 2; ++a)
#pragma unroll
        for (int b = 0; b < 2; ++b)
#pragma unroll
            for (int m = 0; m < 4; ++m)
#pragma unroll
                for (int n = 0; n < 2; ++n) acc[a][b][m][n] = (f32x4){0.f, 0.f, 0.f, 0.f};
    bf16x8 At[4][2], B0[2][2], B1[2][2];
    const char* cA = (const char*)g.A + (size_t)cur.pm * tstep; const char* cB = (const char*)g.Bt + (size_t)cur.pn * tstep;
    PG8_STAGE(PG8_SB(0, 0), cB, voffB); PG8_STAGE(PG8_SA(0, 0), cA, voffA); PG8_STAGE(PG8_SB(0, 1), cB + hstep, voffB); PG8_STAGE(PG8_SA(0, 1), cA + hstep, voffA);
    if (wr == 1) PG8_BAR;
    PG8_WAIT_V(4); PG8_BAR;
    PG8_STAGE(PG8_SB(1, 0), cB + kstep, voffB); PG8_STAGE(PG8_SA(1, 0), cA + kstep, voffA); PG8_STAGE(PG8_SB(1, 1), cB + hstep + kstep, voffB);
    PG8_WAIT_V(6); PG8_BAR;
    for (;;) {
        const bool has_next = S.next(ui + 1, nxt);
        const char* nA = has_next ? (const char*)g.A + (size_t)nxt.pm * tstep : cA; const char* nB = has_next ? (const char*)g.Bt + (size_t)nxt.pn * tstep : cB;
#pragma nounroll
        for (int t = 0; t < nt; t += 2) {
            const bool last = (t == nt - 2);
            const char* a1 = cA + (size_t)(t + 1) * kstep;
            const char* a2 = last ? nA : cA + (size_t)(t + 2) * kstep; const char* b2 = last ? nB : cB + (size_t)(t + 2) * kstep;
            const char* a3 = a2 + kstep; const char* b3 = b2 + kstep;
            PG8_LDB(B0, 0, 0); PG8_SCHED; PG8_LDA(At, 0, 0); PG8_STAGE(PG8_SA(1, 1), a1 + hstep, voffA);
            PG8_WAIT_L(8); PG8_BAR; PG8_WAIT_L(0); PG8_MMA(0, 0, At, B0); PG8_BAR; PG8_SCHED;
            PG8_LDB(B1, 0, 1); PG8_STAGE(PG8_SB(0, 0), b2, voffB);
            PG8_BAR; PG8_WAIT_L(0); PG8_MMA(0, 1, At, B1); PG8_BAR;
            PG8_LDA(At, 0, 1); PG8_STAGE(PG8_SA(0, 0), a2, voffA);
            PG8_BAR; PG8_WAIT_L(0); PG8_MMA(1, 0, At, B0); PG8_BAR; PG8_SCHED;
            PG8_STAGE(PG8_SB(0, 1), b2 + hstep, voffB);
            PG8_WAIT_V(6); PG8_BAR; PG8_MMA(1, 1, At, B1); PG8_BAR;
            PG8_LDB(B0, 1, 0); PG8_SCHED; PG8_LDA(At, 1, 0); PG8_STAGE(PG8_SA(0, 1), a2 + hstep, voffA);
            PG8_WAIT_L(8); PG8_BAR; PG8_WAIT_L(0); PG8_MMA(0, 0, At, B0); PG8_BAR; PG8_SCHED;
            PG8_LDB(B1, 1, 1); PG8_STAGE(PG8_SB(1, 0), b3, voffB);
            PG8_BAR; PG8_WAIT_L(0); PG8_MMA(0, 1, At, B1); PG8_BAR;
            PG8_LDA(At, 1, 1); PG8_STAGE(PG8_SA(1, 0), a3, voffA);
            PG8_BAR; PG8_WAIT_L(0); PG8_MMA(1, 0, At, B0); PG8_BAR; PG8_SCHED;
            PG8_STAGE(PG8_SB(1, 1), b3 + hstep, voffB);
            PG8_WAIT_V(6); PG8_BAR; PG8_MMA(1, 1, At, B1); PG8_BAR;
        }
        E(acc, cur, wr, wc, fr, fq);
        if (!has_next) break;
#pragma unroll
        for (int a = 0; a < 2; ++a)
#pragma unroll
            for (int b = 0; b < 2; ++b)
#pragma unroll
                for (int m = 0; m < 4; ++m)
#pragma unroll
                    for (int n = 0; n < 2; ++n) acc[a][b][m][n] = (f32x4){0.f, 0.f, 0.f, 0.f};
        cur = nxt; cA = nA; cB = nB; ++ui;
    }
    PG8_WAIT_V(0);
    if (wr == 0) PG8_BAR;
    PG8_BAR;
#undef PG8_SA
#undef PG8_SB
#undef PG8_STAGE
#undef PG8_LDA
#undef PG8_LDB
#undef PG8_MMA
#undef PG8_WAIT_V
#undef PG8_WAIT_L
#undef PG8_BAR
#undef PG8_SCHED
}
}

enum { GT_AQ = 0, GT_AK = 1, GT_AV = 2, GT_B = 3, GT_CQ = 4, GT_CKV = 5, GT_KR = 6, GT_PAD = 7 };
__host__ __device__ __forceinline__ void in_group(int g, int& type, int& sub) {
    if (g < 2) { type = GT_AK; sub = g; } else if (g < 4) { type = GT_AV; sub = g - 2; } else if (g < 8) { type = GT_CKV; sub = g - 4; }
    else if (g == 8) { type = GT_KR; sub = 0; } else if (g < 12) { type = GT_PAD; sub = 0; } else if (g < 18) { type = GT_AQ; sub = g - 12; }
    else if (g < 24) { type = GT_CQ; sub = g - 18; } else { type = GT_B; sub = g - 24; }
}
__device__ __forceinline__ int colmap(int mode, int r) {
    const int pn = r >> 8, ct = r & 255, bj = ct >> 7, wc = (ct >> 5) & 3, j = ct & 31, g = 4 * pn + wc, e = 32 * bj + j;
    if (mode == 0) {
        int type, sub; in_group(g, type, sub);
        switch (type) { case GT_AQ: return 64 * sub + e; case GT_AK: return 384 + 64 * sub + e; case GT_AV: return 512 + 64 * sub + e; case GT_B: return 640 + 64 * sub + e;
            case GT_CQ: return 896 + 64 * sub + e; case GT_CKV: return 1280 + 64 * sub + e; case GT_KR: return (j < 16) ? 1536 + 16 * bj + j : -1; default: return -1; }
    } else if (mode == 1) {
        if (g < 6) return 96 * g + e; if (g < 9) { const int head = 2 * (g - 6) + (j >> 4); return 96 * head + 64 + 16 * bj + (j & 15); } return -1;
    } else if (mode == 2) {
        return 64 * g + e;
    }
    return r;
}
__device__ __forceinline__ void cvt_weights_unit(LAS float* tile  , const float* __restrict__ W, int K, int N, bf16_t* __restrict__ dst, int mode, const float* __restrict__ kgain, int r0, int k0) {
    int tid_ = threadIdx.x; asm volatile("" : "+v"(tid_));
    const int tid = tid_;
    const int jj = tid & 63; const int sc = colmap(mode, r0 + jj);
#pragma unroll
    for (int i = 0; i < 8; ++i) { const int kk = (tid >> 6) + 8 * i; float v = 0.f; if (sc >= 0) v = W[(size_t)(k0 + kk) * N + sc]; if (kgain) v *= kgain[k0 + kk]; tile[kk * 65 + jj] = v; }
    __syncthreads();
#pragma unroll
    for (int i = 0; i < 8; ++i) { const int rr = (tid >> 6) + 8 * i, kk = tid & 63; dst[(size_t)(r0 + rr) * K + k0 + kk] = f2bf(tile[kk * 65 + rr]); }
    __syncthreads();
}
struct CvtJob { const float* W; bf16_t* dst; const float* kgain; int K, N, Npad, mode; };
__device__ __forceinline__ void cvt_job(LAS float* tile, const CvtJob j, int vb, int nvb) {
    const int nk = j.K / 64, nr = j.Npad / 64;
    for (int u = vb; u < nk * nr; u += nvb) cvt_weights_unit(tile, j.W, j.K, j.N, j.dst, j.mode, j.kgain, (u / nk) * 64, (u % nk) * 64);
}
__device__ __forceinline__ void cvt_flat(const float* __restrict__ src, bf16_t* __restrict__ dst, size_t n, int vb, int nvb) {
    int tid_ = threadIdx.x; asm volatile("" : "+v"(tid_));
    for (size_t i = ((size_t)vb * 512 + tid_) * 8; i < n; i += (size_t)nvb * 512 * 8) {
        const float4 a = *(const float4*)(src + i), b = *(const float4*)(src + i + 4);
        u32x4 o; o.x = cvt_pk_bf16(a.x, a.y); o.y = cvt_pk_bf16(a.z, a.w); o.z = cvt_pk_bf16(b.x, b.y); o.w = cvt_pk_bf16(b.z, b.w);
        *(u32x4*)(dst + i) = o;
    }
}
template <bool FP8>
__device__ __forceinline__ void cvt_q8_rows(const float* __restrict__ src, unsigned char* __restrict__ dst, float* __restrict__ scales, int nrows, int vb, int nvb) {
    int tid_ = threadIdx.x; asm volatile("" : "+v"(tid_));
    const int lane = tid_ & 63, wid = tid_ >> 6;
    const int stride = nvb * 8;
    for (int row0 = vb * 8 + wid; row0 < nrows; row0 += 4 * stride) {
        f32x4 v[4][4];
#pragma unroll
        for (int q = 0; q < 4; ++q) { const int row = row0 + q * stride < nrows ? row0 + q * stride : row0; const float* sp = src + (size_t)row * 1024 + 16 * lane;
#pragma unroll
            for (int k = 0; k < 4; ++k) v[q][k] = *(const f32x4*)(sp + 4 * k); }
#pragma unroll
        for (int q = 0; q < 4; ++q) { const int row = row0 + q * stride; if (row < nrows) {
            float am = 0.f;
#pragma unroll
            for (int k = 0; k < 4; ++k) am = fmaxf(am, fmaxf(fmaxf(fabsf(v[q][k][0]), fabsf(v[q][k][1])), fmaxf(fabsf(v[q][k][2]), fabsf(v[q][k][3]))));
#pragma unroll
            for (int o = 32; o > 0; o >>= 1) am = fmaxf(am, __shfl_xor(am, o));
            const float qmax = FP8 ? 416.f : 127.f;
            const float sc = am > 0.f ? am / qmax : 1.f, inv = am > 0.f ? qmax / am : 0.f;
            u32x4 o4;
#pragma unroll
            for (int k = 0; k < 4; ++k) {
                if (FP8) { int p = __builtin_amdgcn_cvt_pk_fp8_f32(v[q][k][0] * inv, v[q][k][1] * inv, 0, false); p = __builtin_amdgcn_cvt_pk_fp8_f32(v[q][k][2] * inv, v[q][k][3] * inv, p, true); o4[k] = (unsigned)p; }
                else { const int q0 = (int)rintf(v[q][k][0] * inv), q1 = (int)rintf(v[q][k][1] * inv), q2 = (int)rintf(v[q][k][2] * inv), q3 = (int)rintf(v[q][k][3] * inv);
                    o4[k] = (unsigned)(q0 & 0xff) | ((unsigned)(q1 & 0xff) << 8) | ((unsigned)(q2 & 0xff) << 16) | ((unsigned)(q3 & 0xff) << 24); } }
            *(u32x4*)(dst + (size_t)row * 1024 + 16 * lane) = o4;
            if (lane == 0) scales[row] = sc; } }
    }
}
__device__ __forceinline__ void cvt_q4_rows(const float* __restrict__ src, unsigned char* __restrict__ dst, float* __restrict__ scales, int nrows, int vb, int nvb) {
    int tid_ = threadIdx.x; asm volatile("" : "+v"(tid_));
    const int lane = tid_ & 63, wid = tid_ >> 6;
    const int stride = nvb * 8;
    for (int row0 = vb * 8 + wid; row0 < nrows; row0 += 4 * stride) {
        f32x4 v[4][4];
#pragma unroll
        for (int q = 0; q < 4; ++q) { const int row = row0 + q * stride < nrows ? row0 + q * stride : row0; const float* sp = src + (size_t)row * 1024 + 16 * lane;
#pragma unroll
            for (int k = 0; k < 4; ++k) v[q][k] = *(const f32x4*)(sp + 4 * k); }
#pragma unroll
        for (int q = 0; q < 4; ++q) { const int row = row0 + q * stride; if (row < nrows) {
            float am = 0.f, ss = 0.f;
#pragma unroll
            for (int k = 0; k < 4; ++k) { am = fmaxf(am, fmaxf(fmaxf(fabsf(v[q][k][0]), fabsf(v[q][k][1])), fmaxf(fabsf(v[q][k][2]), fabsf(v[q][k][3]))));
                ss += v[q][k][0] * v[q][k][0] + v[q][k][1] * v[q][k][1] + v[q][k][2] * v[q][k][2] + v[q][k][3] * v[q][k][3]; }
#pragma unroll
            for (int o = 32; o > 0; o >>= 1) { am = fmaxf(am, __shfl_xor(am, o)); ss += __shfl_xor(ss, o); }
            const float st = fmaxf(0.36f * sqrtf(ss * (1.f / 1024.f)), am * (1.f / 12.f));
            const float sc = st > 0.f ? st : 1.f, inv = st > 0.f ? 1.f / st : 0.f;
            u32x2 o2;
#pragma unroll
            for (int d = 0; d < 2; ++d) { unsigned wd = 0u;
#pragma unroll
                for (int k = 0; k < 4; ++k) { const int qa = (int)fminf(fmaxf(rintf(v[q][2 * d][k] * inv), -7.f), 7.f), qb = (int)fminf(fmaxf(rintf(v[q][2 * d + 1][k] * inv), -7.f), 7.f); wd |= ((unsigned)(qa & 15) << (8 * k)) | ((unsigned)(qb & 15) << (8 * k + 4)); }
                o2[d] = wd; }
            *(u32x2*)(dst + (size_t)row * 512 + 8 * lane) = o2;
            if (lane == 0) scales[row] = sc; } }
    }
}
struct Inputs {
    const float *x, *c, *ctx, *c_ctx, *ada_w, *ada_b, *norm1_g, *norm2_g, *w_in, *gqa_qn_g, *gqa_kn_g, *pool_w, *pool_scale, *mla_qn_g, *mla_kvn_g, *mla_w_uq, *mla_w_ukv, *w_out, *peer_wq, *peer_subkeys, *peer_u, *peer_v, *final_g;
};
__device__ __forceinline__ void phase_cvt(LAS unsigned char* lds, const Inputs& in, const WS& w, int vb, int nvb) {
    LAS float* tile = (LAS float*)lds;
    for (int l = 0; l < 2; ++l) {
        cvt_job(tile, CvtJob{in.w_in + (size_t)l * 1024 * INC, w.WinT() + (size_t)l * 1792 * 1024, nullptr, 1024, INC, 1792, 0}, vb, nvb);
        cvt_job(tile, CvtJob{in.mla_w_uq + (size_t)l * 384 * 576, w.WuqT() + (size_t)l * 768 * 384, in.mla_qn_g + l * 384, 384, 576, 768, 1}, vb, nvb);
        cvt_job(tile, CvtJob{in.mla_w_ukv + (size_t)l * 256 * 768, w.WukvT() + (size_t)l * 768 * 256, in.mla_kvn_g + l * 256, 256, 768, 768, 2}, vb, nvb);
        cvt_job(tile, CvtJob{in.w_out + (size_t)l * 1024 * 1024, w.WoutT() + (size_t)l * 1024 * 1024, nullptr, 1024, 1024, 1024, 3}, vb, nvb);
        cvt_job(tile, CvtJob{in.peer_wq + (size_t)l * 1024 * 2048, w.WqT() + (size_t)l * 2048 * 1024, nullptr, 1024, 2048, 2048, 3}, vb, nvb);
    }
    cvt_flat(in.peer_subkeys, w.SubK(), (size_t)2 * 16 * 128 * 128, vb, nvb);
    { int tp_ = threadIdx.x; asm volatile("" : "+v"(tp_));
      for (int i = vb * 512 + tp_; i < 2 * 4 * 64 * 64; i += nvb * 512) { const int c = i & 63, d = (i >> 6) & 63, lg = i >> 12; w.PoolWT()[i] = f2bf(in.pool_w[(size_t)lg * 4096 + c * 64 + d]); } }
    if (nvb > 144) { if (vb >= 72) { cvt_q4_rows(in.peer_u, w.U8(), w.US(), 2 * NE, vb - 72, nvb - 72); cvt_q8_rows<true>(in.peer_v, w.V8(), w.VS(), 2 * NE, vb - 72, nvb - 72); } }
    else { cvt_q4_rows(in.peer_u, w.U8(), w.US(), 2 * NE, vb, nvb); cvt_q8_rows<true>(in.peer_v, w.V8(), w.VS(), 2 * NE, vb, nvb); }
}

constexpr float ATT_C2G = 0.125f * 1.4426950408889634f, ATT_C2M = 0.10206207261596577f * 1.4426950408889634f;
struct EpiIn {
    static constexpr bool PERM = true;
    WS w; const float* qn_g; const float* kn_g; int pm_base;
    __device__ __forceinline__ void operator()(const f32x4 (&acc)[2][2][4][2], const pg8::Unit& u, int wr, int wc, int fr, int fq) const {
        int type, sub; in_group(4 * u.pn + wc, type, sub);
        if (type == GT_PAD) return;
        const int pm = u.pm + pm_base; const bool isctx = pm >= 256; const int b = isctx ? pm - 256 : pm >> 3; const int t0 = isctx ? 0 : (pm & 7) * 256;
        const size_t rowbase = isctx ? (size_t)NL + (size_t)b * CTX : (size_t)b * S;
        const int keyoff = isctx ? 0 : CTX;
        float gain[2][8];
        if (type == GT_AQ) {
#pragma unroll
            for (int bj = 0; bj < 2; ++bj)
#pragma unroll
                for (int q = 0; q < 8; ++q) gain[bj][q] = qn_g[32 * bj + 8 * fq + q] * ATT_C2G;
        } else if (type == GT_AK) {
#pragma unroll
            for (int bj = 0; bj < 2; ++bj)
#pragma unroll
                for (int q = 0; q < 8; ++q) gain[bj][q] = kn_g[32 * bj + 8 * fq + q];
        }
#pragma unroll
        for (int ai = 0; ai < 2; ++ai)
#pragma unroll
            for (int m = 0; m < 4; ++m) {
                const int t = t0 + 128 * ai + 64 * wr + 16 * m + fr; const size_t row = rowbase + t;
                float v[2][8];
#pragma unroll
                for (int bj = 0; bj < 2; ++bj)
#pragma unroll
                    for (int n = 0; n < 2; ++n)
#pragma unroll
                        for (int i = 0; i < 4; ++i) v[bj][4 * n + i] = acc[ai][bj][m][n][i];
                bf16_t* dst = nullptr;
                if (type == GT_AQ || type == GT_AK) {
                    float ss = 0.f;
#pragma unroll
                    for (int bj = 0; bj < 2; ++bj)
#pragma unroll
                        for (int q = 0; q < 8; ++q) ss += v[bj][q] * v[bj][q];
                    ss += __shfl_xor(ss, 16); ss += __shfl_xor(ss, 32);
                    const float rstd = rsqrtf(ss * (1.f / 64.f) + EPS);
#pragma unroll
                    for (int q = 0; q < 8; ++q) { float x1 = v[0][q] * rstd * gain[0][q], x2 = v[1][q] * rstd * gain[1][q];
                        if (!isctx) { const float2 cs = w.ROPA()[t * 32 + 8 * fq + q]; const float y1 = x1 * cs.x - x2 * cs.y, y2 = x1 * cs.y + x2 * cs.x; x1 = y1; x2 = y2; }
                        v[0][q] = x1; v[1][q] = x2; }
                    if (type == GT_AQ) dst = isctx ? w.Qgc() + (((size_t)b * 6 + sub) * CTX + t) * 64 : w.Qg() + (((size_t)b * 6 + sub) * S + t) * 64;
                    else dst = w.Kg() + (((size_t)b * 2 + sub) * KEYS + keyoff + t) * 64;
                } else if (type == GT_AV) { dst = w.Vg() + (((size_t)b * 2 + sub) * KEYS + keyoff + t) * 64;
                } else if (type == GT_B) { dst = w.Bp() + row * 256 + 64 * sub;
                } else if (type == GT_CQ || type == GT_CKV) {
                    float ss = 0.f;
#pragma unroll
                    for (int bj = 0; bj < 2; ++bj)
#pragma unroll
                        for (int q = 0; q < 8; ++q) ss += v[bj][q] * v[bj][q];
                    ss += __shfl_xor(ss, 16); ss += __shfl_xor(ss, 32);
                    if (type == GT_CQ) { if (fq == 0) w.SSQ()[row * 8 + sub] = ss; dst = w.CQ() + row * 384 + 64 * sub; }
                    else { if (fq == 0) w.SSKV()[row * 4 + sub] = ss; dst = w.CKV() + row * 256 + 64 * sub; }
                } else {
                    if (!isctx) {
#pragma unroll
                        for (int q = 0; q < 8; ++q) { const float2 cs = w.ROPC()[t * 16 + ((8 * fq + q) & 15)]; const float x1 = v[0][q], x2 = v[1][q]; v[0][q] = x1 * cs.x - x2 * cs.y; v[1][q] = x1 * cs.y + x2 * cs.x; } }
                    if (fq < 2) { bf16_t* kd = w.KR() + ((size_t)b * KEYS + keyoff + t) * 32;
#pragma unroll
                        for (int bj = 0; bj < 2; ++bj) { u32x4 o; o.x = cvt_pk_bf16(v[bj][0], v[bj][1]); o.y = cvt_pk_bf16(v[bj][2], v[bj][3]); o.z = cvt_pk_bf16(v[bj][4], v[bj][5]); o.w = cvt_pk_bf16(v[bj][6], v[bj][7]);
                            *(u32x4*)(kd + 16 * bj + 8 * fq) = o; } }
                    continue;
                }
#pragma unroll
                for (int bj = 0; bj < 2; ++bj) { u32x4 o; o.x = cvt_pk_bf16(v[bj][0], v[bj][1]); o.y = cvt_pk_bf16(v[bj][2], v[bj][3]); o.z = cvt_pk_bf16(v[bj][4], v[bj][5]); o.w = cvt_pk_bf16(v[bj][6], v[bj][7]);
                    *(u32x4*)(dst + 32 * bj + 8 * fq) = o; }
            }
    }
};
struct P1Order {
    pg8::StaticOrder so; int nctx_tiles, G, c;
    __device__ bool next(int i, pg8::Unit& u) const {
        const int L = i * G + c;
        if (L < 1792) return so.next(i, u);
        const int Lc = L - 1792; if (Lc >= 32 * nctx_tiles) return false;
        u.pm = 256 + (Lc & 31); u.pn = Lc >> 5; return true;
    }
};
__device__ __forceinline__ void phase_p1(LAS unsigned char* lds, const WS& w, const Inputs& in, int l, int vb, int nvb) {
    EpiIn E{w, in.gqa_qn_g + l * 64, in.gqa_kn_g + l * 64, 0};
    P1Order po; po.so.init(NL, 1792, nvb, vb); po.nctx_tiles = (l == 0) ? 7 : 3; po.G = nvb; po.c = vb;
    pg8::gemm_phase(lds, pg8::Gemm{w.H(), w.WinT() + (size_t)l * 1792 * 1024, NR, 1792, 1024}, po, E);
}

extern __shared__ __attribute__((aligned(16))) unsigned char dyn_lds[];

struct EpiUq {
    static constexpr bool PERM = true;
    WS w;
    __device__ __forceinline__ void operator()(const f32x4 (&acc)[2][2][4][2], const pg8::Unit& u, int wr, int wc, int fr, int fq) const {
        const int g = 4 * u.pn + wc; if (g >= 9) return;
        const int pm = u.pm; const bool isctx = pm >= 256; const int b = isctx ? pm - 256 : pm >> 3; const int t0 = isctx ? 0 : (pm & 7) * 256;
        const size_t rowbase = isctx ? (size_t)NL + (size_t)b * CTX : (size_t)b * S;
        const int head = g < 6 ? g : 2 * (g - 6) + (fq >> 1);
#pragma unroll
        for (int ai = 0; ai < 2; ++ai)
#pragma unroll
            for (int m = 0; m < 4; ++m) {
                const int t = t0 + 128 * ai + 64 * wr + 16 * m + fr; const size_t row = rowbase + t;
                const float4 s0 = *(const float4*)(w.SSQ() + row * 8), s1 = *(const float4*)(w.SSQ() + row * 8 + 4);
                const float rstd = rsqrtf((s0.x + s0.y + s0.z + s0.w + s1.x + s1.y) * (1.f / 384.f) + EPS) * ATT_C2M;
                float v[2][8];
#pragma unroll
                for (int bj = 0; bj < 2; ++bj)
#pragma unroll
                    for (int n = 0; n < 2; ++n)
#pragma unroll
                        for (int i = 0; i < 4; ++i) v[bj][4 * n + i] = acc[ai][bj][m][n][i] * rstd;
                bf16_t* hd = isctx ? w.Qmc() + (((size_t)b * 6 + head) * CTX + t) * 96 : w.Qm() + (((size_t)b * 6 + head) * S + t) * 96;
                if (g >= 6 && !isctx) {
#pragma unroll
                    for (int q = 0; q < 8; ++q) { const float2 cs = w.ROPC()[t * 16 + 8 * (fq & 1) + q]; const float x1 = v[0][q], x2 = v[1][q]; v[0][q] = x1 * cs.x - x2 * cs.y; v[1][q] = x1 * cs.y + x2 * cs.x; } }
#pragma unroll
                for (int bj = 0; bj < 2; ++bj) { u32x4 o; o.x = cvt_pk_bf16(v[bj][0], v[bj][1]); o.y = cvt_pk_bf16(v[bj][2], v[bj][3]); o.z = cvt_pk_bf16(v[bj][4], v[bj][5]); o.w = cvt_pk_bf16(v[bj][6], v[bj][7]);
                    bf16_t* d = g < 6 ? hd + 32 * bj + 8 * fq : hd + 64 + 16 * bj + 8 * (fq & 1);
                    *(u32x4*)d = o; }
            }
    }
};
struct EpiUkv {
    static constexpr bool PERM = true;
    WS w;
    __device__ __forceinline__ void operator()(const f32x4 (&acc)[2][2][4][2], const pg8::Unit& u, int wr, int wc, int fr, int fq) const {
        const int g = 4 * u.pn + wc;
        const int pm = u.pm; const bool isctx = pm >= 256; const int b = isctx ? pm - 256 : pm >> 3; const int t0 = isctx ? 0 : (pm & 7) * 256;
        const size_t rowbase = isctx ? (size_t)NL + (size_t)b * CTX : (size_t)b * S; const int keyoff = isctx ? 0 : CTX;
        bf16_t* base = ((g & 1) ? w.Vm() : w.Kmn()) + ((size_t)b * 6 + (g >> 1)) * KEYS * 64;
#pragma unroll
        for (int ai = 0; ai < 2; ++ai)
#pragma unroll
            for (int m = 0; m < 4; ++m) {
                const int t = t0 + 128 * ai + 64 * wr + 16 * m + fr; const size_t row = rowbase + t;
                const float4 s0 = *(const float4*)(w.SSKV() + row * 4);
                const float rstd = rsqrtf((s0.x + s0.y + s0.z + s0.w) * (1.f / 256.f) + EPS);
                bf16_t* d = base + (size_t)(keyoff + t) * 64;
#pragma unroll
                for (int bj = 0; bj < 2; ++bj) { const f32x4 a0 = acc[ai][bj][m][0] * rstd, a1 = acc[ai][bj][m][1] * rstd;
                    u32x4 o; o.x = cvt_pk_bf16(a0[0], a0[1]); o.y = cvt_pk_bf16(a0[2], a0[3]); o.z = cvt_pk_bf16(a1[0], a1[1]); o.w = cvt_pk_bf16(a1[2], a1[3]);
                    *(u32x4*)(d + 32 * bj + 8 * fq) = o; }
            }
    }
};
constexpr int POOL_X = 0, POOL_P = 272 * 128, POOL_BYTES = 272 * 128 + 256 * 128;
template <int G>
__device__ __forceinline__ void pool_sums(LAS unsigned char* lds, int tid, int t0, int L) {
    constexpr int wdw = 2 << G, half = wdw >> 1, NX = 32 + wdw - 1;
    const int c = tid & 63, seg = tid >> 6; const LAS bf16_t* X = (const LAS bf16_t*)(lds + POOL_X) + c + (seg * 32 + 8 - half) * 64;
    const int tb = t0 + seg * 32;
    float xr[NX], xm[NX];
#pragma unroll
    for (int j = 0; j < NX; ++j) xr[j] = bf2f(X[j * 64]);
#pragma unroll
    for (int j = 0; j < NX; ++j) { const int row = tb - half + j; xm[j] = (row >= 0 && row < L) ? xr[j] : 0.f; }
    float sum = 0.f;
#pragma unroll
    for (int j = 0; j < wdw; ++j) sum += xm[j];
#pragma unroll
    for (int k = 0; k < 32; ++k) {
        const int t = tb + k; const int clo = (t - half) < 0 ? 0 : (t - half), chi = (t - half + wdw) > L ? L : (t - half + wdw);
        const float pv = sum / (float)(chi - clo) - xr[k + half];
        const int r = seg * 32 + k; *((LAS bf16_t*)(lds + POOL_P + r * 128 + (((c >> 3) ^ ((r >> 1) & 7)) << 4)) + (c & 7)) = f2bf(pv);
        if (k < 31) sum += xm[k + wdw] - xm[k];
    }
}
__device__ __forceinline__ void phase_pool(LAS unsigned char* lds, const WS& w, bf16_t* __restrict__ MIX, const bf16_t* __restrict__ WT  , const float* __restrict__ pool_scale, int nrows, int vb, int nvb) {
    int tid_ = threadIdx.x; asm volatile("" : "+v"(tid_));
    const int tid = tid_, lane = tid & 63, wid = __builtin_amdgcn_readfirstlane(tid >> 6), r32 = lane & 31, hi = lane >> 5;
    const int nunits = nrows >> 8;
    const int nmine = vb < nunits ? ((nunits - 1 - vb) / nvb + 1) * 4 : 0;
    u32x4 st[5];
#define POOL_FETCH(it_) do { const int u_ = vb + ((it_) >> 2) * nvb, g_ = (it_) & 3; const int row0_ = u_ << 8; const bool ic_ = row0_ >= NL; const int L_ = ic_ ? CTX : S; const int t0_ = ic_ ? 0 : (row0_ & (S - 1)); const int seq0_ = row0_ - t0_; \
        _Pragma("unroll") for (int k_ = 0; k_ < 5; ++k_) { int i_ = tid + 512 * k_; i_ = i_ < 272 * 8 ? i_ : 272 * 8 - 1; const int rr_ = i_ >> 3, ch_ = i_ & 7; int t_ = t0_ - 8 + rr_; t_ = t_ < 0 ? 0 : (t_ >= L_ ? L_ - 1 : t_); \
            st[k_] = *(const u32x4*)(w.Bp() + (size_t)(seq0_ + t_) * 256 + g_ * 64 + ch_ * 8); } } while (0)
    if (nmine > 0) POOL_FETCH(0);
    for (int it = 0; it < nmine; ++it) {
        const int u = vb + (it >> 2) * nvb, g = it & 3;
        const int row0 = u << 8; const bool isctx = row0 >= NL; const int L = isctx ? CTX : S; const int t0 = isctx ? 0 : (row0 & (S - 1));
        {
#pragma unroll
            for (int k = 0; k < 5; ++k) { const int i = tid + 512 * k; if (i < 272 * 8) *(LAS u32x4*)(lds + POOL_X + (i >> 3) * 128 + (i & 7) * 16) = st[k]; }
            { const int nx = it + 1 < nmine ? it + 1 : it; POOL_FETCH(nx); }
            __syncthreads();
            if (g == 0) pool_sums<0>(lds, tid, t0, L); else if (g == 1) pool_sums<1>(lds, tid, t0, L); else if (g == 2) pool_sums<2>(lds, tid, t0, L); else pool_sums<3>(lds, tid, t0, L);
            __syncthreads();
            { f32x16 o0 = {}, o1 = {};
              const bf16_t* wt = WT + (size_t)g * 4096 + (size_t)r32 * 64 + 8 * hi;
#pragma unroll
              for (int s = 0; s < 4; ++s) { const int row = wid * 32 + r32; const bf16x8 pf = *(const LAS bf16x8*)(lds + POOL_P + row * 128 + (((2 * s + hi) ^ ((row >> 1) & 7)) << 4));
                  o0 = mfma32(*(const bf16x8*)(wt + 16 * s), pf, o0); o1 = mfma32(*(const bf16x8*)(wt + 32 * 64 + 16 * s), pf, o1); }
              bf16_t* op = MIX + (size_t)(row0 + wid * 32 + r32) * 1024 + 384 + g * 64 + 4 * hi; const float* ps = pool_scale + g * 64 + 4 * hi;
#pragma unroll
              for (int q = 0; q < 4; ++q) { const f32x4 s0 = *(const f32x4*)(ps + 8 * q), s1 = *(const f32x4*)(ps + 32 + 8 * q); u32x2 a, b;
                  a.x = cvt_pk_bf16(o0[4 * q] * s0[0], o0[4 * q + 1] * s0[1]); a.y = cvt_pk_bf16(o0[4 * q + 2] * s0[2], o0[4 * q + 3] * s0[3]);
                  b.x = cvt_pk_bf16(o1[4 * q] * s1[0], o1[4 * q + 1] * s1[1]); b.y = cvt_pk_bf16(o1[4 * q + 2] * s1[2], o1[4 * q + 3] * s1[3]);
                  *(u32x2*)(op + 8 * q) = a; *(u32x2*)(op + 32 + 8 * q) = b; } }
            __syncthreads();
        }
    }
#undef POOL_FETCH
}
__device__ __forceinline__ void phase_p2(LAS unsigned char* lds, const WS& w, const Inputs& in, int l, int vb, int nvb, int parts = 7) {
    pg8::StaticOrder so;
    if (parts & 1) { EpiUq E{w}; const int M = l == 0 ? NR : NL; so.init(M, 768, nvb, vb); pg8::gemm_phase(lds, pg8::Gemm{w.CQ(), w.WuqT() + (size_t)l * 768 * 384, M, 768, 384}, so, E); }
    if (parts & 2) { EpiUkv E{w}; so.init(NR, 768, nvb, vb); pg8::gemm_phase(lds, pg8::Gemm{w.CKV(), w.WukvT() + (size_t)l * 768 * 256, NR, 768, 256}, so, E); }
    if (parts & 4) phase_pool(lds, w, w.H(), w.PoolWT() + (size_t)l * 4 * 64 * 64, in.pool_scale + l * 256, l == 0 ? NR : NL, vb, nvb);
}

struct EpiOut {
    static constexpr bool PERM = true;
    bf16_t* DLT; const float* gate;
    __device__ __forceinline__ void operator()(const f32x4 (&acc)[2][2][4][2], const pg8::Unit& u, int wr, int wc, int fr, int fq) const {
        const int pm = u.pm; const int mr = pm >= 256 ? 32 : pm >> 3;
        const size_t r0 = (size_t)pm * 256 + wr * 64 + fr; const int col0 = u.pn * 256 + wc * 32 + 8 * fq;
        f32x4 gv[2][2];
#pragma unroll
        for (int bj = 0; bj < 2; ++bj)
#pragma unroll
            for (int n = 0; n < 2; ++n) gv[bj][n] = *(const f32x4*)(gate + (size_t)mr * 6144 + col0 + bj * 128 + 4 * n);
#pragma unroll
        for (int ai = 0; ai < 2; ++ai)
#pragma unroll
            for (int m = 0; m < 4; ++m) { bf16_t* d = DLT + (r0 + ai * 128 + m * 16) * 1024 + col0;
#pragma unroll
                for (int bj = 0; bj < 2; ++bj) { const f32x4 a0 = acc[ai][bj][m][0] * gv[bj][0], a1 = acc[ai][bj][m][1] * gv[bj][1];
                    u32x4 o; o.x = cvt_pk_bf16(a0[0], a0[1]); o.y = cvt_pk_bf16(a0[2], a0[3]); o.z = cvt_pk_bf16(a1[0], a1[1]); o.w = cvt_pk_bf16(a1[2], a1[3]);
                    *(u32x4*)(d + bj * 128) = o; } }
    }
};
__device__ __forceinline__ void phase_p4(LAS unsigned char* lds, const WS& w, const Inputs& in, int l, int vb, int nvb) {
    const float* MODl = w.MOD() + (size_t)l * 33 * 6144;
    EpiOut E{w.PQ(), MODl + 2 * 1024};
    const int M = l == 0 ? NR : NL;
    pg8::StaticOrder so; so.init(M, 1024, nvb, vb);
    pg8::gemm_phase(lds, pg8::Gemm{w.H(), w.WoutT() + (size_t)l * 1024 * 1024, M, 1024, 1024}, so, E);
}

template <bool INBF>
__device__ __forceinline__ void phase_modulate(const float* __restrict__ XLp, const float* __restrict__ XCp, const bf16_t* __restrict__ XBp, bf16_t* __restrict__ Hout, const float* __restrict__ g, const float* __restrict__ MODl, int si, int nrows, int vb, int nvb,
                                               signed char* __restrict__ H8 = nullptr, float* __restrict__ HS = nullptr, const bf16_t* __restrict__ DLT = nullptr, bf16_t* __restrict__ XBo = nullptr) {
    int tid_ = threadIdx.x; asm volatile("" : "+v"(tid_));
    const int tid = tid_, lane = tid & 63, wid = tid >> 6;
    f32x4 gv[4];
#pragma unroll
    for (int i = 0; i < 4; ++i) gv[i] = *(const f32x4*)(g + 256 * i + 4 * lane);
    const int stride = nvb * 8, lastrow = nrows - 1;
    f32x4 nx[4]; u32x2 nxb[4], ndr[4];
#define PM_LOAD(r_) do { const int rr_ = (r_) < nrows ? (r_) : lastrow; const bool ic_ = rr_ >= NL; const float* xp_ = ic_ ? XCp + (size_t)(rr_ - NL) * 1024 : XLp + (size_t)rr_ * 1024; \
        _Pragma("unroll") for (int i = 0; i < 4; ++i) { if (INBF) nxb[i] = *(const u32x2*)(XBp + (size_t)rr_ * 1024 + 256 * i + 4 * lane); else nx[i] = *(const f32x4*)(xp_ + 256 * i + 4 * lane); \
            if (DLT) ndr[i] = *(const u32x2*)(DLT + (size_t)rr_ * 1024 + 256 * i + 4 * lane); } } while (0)
    PM_LOAD(vb * 8 + wid);
    for (int row = vb * 8 + wid; row < nrows; row += stride) {
        const bool isctx = row >= NL; const int mr = isctx ? 32 : row / S;
        f32x4 x[4]; u32x2 dr4[4]; float ss = 0.f;
#pragma unroll
        for (int i = 0; i < 4; ++i) { if (INBF) x[i] = (f32x4){__uint_as_float(nxb[i].x << 16), __uint_as_float(nxb[i].x & 0xffff0000u), __uint_as_float(nxb[i].y << 16), __uint_as_float(nxb[i].y & 0xffff0000u)}; else x[i] = nx[i];
            if (DLT) dr4[i] = ndr[i]; }
        PM_LOAD(row + stride);
#pragma unroll
        for (int i = 0; i < 4; ++i) {
            if (DLT) { const u32x2 dr = dr4[i];
                x[i][0] += __uint_as_float(dr.x << 16); x[i][1] += __uint_as_float(dr.x & 0xffff0000u); x[i][2] += __uint_as_float(dr.y << 16); x[i][3] += __uint_as_float(dr.y & 0xffff0000u);
                u32x2 xo; xo.x = cvt_pk_bf16(x[i][0], x[i][1]); xo.y = cvt_pk_bf16(x[i][2], x[i][3]); *(u32x2*)(XBo + (size_t)row * 1024 + 256 * i + 4 * lane) = xo; }
            ss += x[i][0] * x[i][0] + x[i][1] * x[i][1] + x[i][2] * x[i][2] + x[i][3] * x[i][3]; }
        ss = wave_sum(ss); const float rstd = rsqrtf(ss * (1.f / 1024.f) + EPS);
        const float* sh = MODl + (size_t)mr * 6144 + si * 1024;
        f32x4 y[4]; float am = 0.f;
#pragma unroll
        for (int i = 0; i < 4; ++i) { const f32x4 shv = *(const f32x4*)(sh + 256 * i + 4 * lane), scv = *(const f32x4*)(sh + 1024 + 256 * i + 4 * lane);
            y[i] = x[i] * rstd * gv[i] * (scv + 1.f) + shv;
            am = fmaxf(am, fmaxf(fmaxf(fabsf(y[i][0]), fabsf(y[i][1])), fmaxf(fabsf(y[i][2]), fabsf(y[i][3]))));
            u32x2 o; o.x = cvt_pk_bf16(y[i][0], y[i][1]); o.y = cvt_pk_bf16(y[i][2], y[i][3]);
            *(u32x2*)(Hout + (size_t)row * 1024 + 256 * i + 4 * lane) = o; }
        if (H8) {
#pragma unroll
            for (int o = 32; o > 0; o >>= 1) am = fmaxf(am, __shfl_xor(am, o));
            const float inv = am > 0.f ? 127.f / am : 0.f;
#pragma unroll
            for (int i = 0; i < 4; ++i) { const int q0 = (int)rintf(y[i][0] * inv), q1 = (int)rintf(y[i][1] * inv), q2 = (int)rintf(y[i][2] * inv), q3 = (int)rintf(y[i][3] * inv);
                *(unsigned*)(H8 + (size_t)row * 1024 + 256 * i + 4 * lane) = (unsigned)(q0 & 0xff) | ((unsigned)(q1 & 0xff) << 8) | ((unsigned)(q2 & 0xff) << 16) | ((unsigned)(q3 & 0xff) << 24); }
            if (lane == 0) HS[row] = am > 0.f ? am * (1.f / 127.f) : 1.f;
        }
    }
#undef PM_LOAD
}

struct EpiPQ {
    static constexpr bool PERM = true;
    bf16_t* PQ;
    __device__ __forceinline__ void operator()(const f32x4 (&acc)[2][2][4][2], const pg8::Unit& u, int wr, int wc, int fr, int fq) const {
        const size_t r0 = (size_t)u.pm * 256 + wr * 64 + fr; const int col0 = u.pn * 256 + wc * 32 + 8 * fq;
#pragma unroll
        for (int ai = 0; ai < 2; ++ai)
#pragma unroll
            for (int m = 0; m < 4; ++m) { bf16_t* d = PQ + (r0 + ai * 128 + m * 16) * 2048 + col0;
#pragma unroll
                for (int bj = 0; bj < 2; ++bj) { const f32x4 a0 = acc[ai][bj][m][0], a1 = acc[ai][bj][m][1];
                    u32x4 o; o.x = cvt_pk_bf16(a0[0], a0[1]); o.y = cvt_pk_bf16(a0[2], a0[3]); o.z = cvt_pk_bf16(a1[0], a1[1]); o.w = cvt_pk_bf16(a1[2], a1[3]);
                    *(u32x4*)(d + bj * 128) = o; } }
    }
};
__device__ __forceinline__ void phase_p6a(LAS unsigned char* lds, const WS& w, int l, int vb, int nvb) {
    EpiPQ E{w.PQ()}; const int M = l == 0 ? NR : NL;
    pg8::StaticOrder so; so.init(M, 2048, nvb, vb);
    pg8::gemm_phase(lds, pg8::Gemm{w.H(), w.WqT() + (size_t)l * 2048 * 1024, M, 2048, 1024}, so, E);
}


using bf16x2_t = __attribute__((ext_vector_type(2))) __bf16;
typedef float f32x2 __attribute__((ext_vector_type(2)));
__device__ __forceinline__ float gelu_fast(float x) {
    const float u2 = 1.5957691216057308f * (x + 0.044715f * x * x * x);
    return x * __builtin_amdgcn_rcpf(1.f + __builtin_amdgcn_exp2f(-1.4426950408889634f * u2));
}
#define DPPF(v, ctrl) __builtin_bit_cast(float, __builtin_amdgcn_update_dpp(0, __builtin_bit_cast(int, (v)), (ctrl), 0xf, 0xf, true))
__device__ __forceinline__ float reduce8(float p0, float p1, float p2, float p3, float p4, float p5, float p6, float p7, int lane) {
    auto s01 = __builtin_amdgcn_permlane32_swap(__float_as_uint(p0), __float_as_uint(p1), false, false);
    auto s23 = __builtin_amdgcn_permlane32_swap(__float_as_uint(p2), __float_as_uint(p3), false, false);
    auto s45 = __builtin_amdgcn_permlane32_swap(__float_as_uint(p4), __float_as_uint(p5), false, false);
    auto s67 = __builtin_amdgcn_permlane32_swap(__float_as_uint(p6), __float_as_uint(p7), false, false);
    const float q0 = __uint_as_float(s01[0]) + __uint_as_float(s01[1]), q1 = __uint_as_float(s23[0]) + __uint_as_float(s23[1]);
    const float q2 = __uint_as_float(s45[0]) + __uint_as_float(s45[1]), q3 = __uint_as_float(s67[0]) + __uint_as_float(s67[1]);
    auto t0 = __builtin_amdgcn_permlane16_swap(__float_as_uint(q0), __float_as_uint(q1), false, false);
    auto t1 = __builtin_amdgcn_permlane16_swap(__float_as_uint(q2), __float_as_uint(q3), false, false);
    float r0 = __uint_as_float(t0[0]) + __uint_as_float(t0[1]);
    float r1 = __uint_as_float(t1[0]) + __uint_as_float(t1[1]);
    r0 += DPPF(r0, 0x128); r1 += DPPF(r1, 0x128);
    float z = (lane & 8) ? r1 : r0;
    z += DPPF(z, 0x141);
    z += DPPF(z, 0xB1);
    z += DPPF(z, 0x4E);
    return z;
}
__device__ __forceinline__ void p7_axpy(const u32x4 v, float wj, f32x2 (&out)[8]) {
    const f32x2 w2 = {wj, wj};
#pragma unroll
    for (int k = 0; k < 4; ++k) { const f32x2 lo = __builtin_amdgcn_cvt_pk_f32_fp8((int)v[k], false), hi2 = __builtin_amdgcn_cvt_pk_f32_fp8((int)v[k], true);
        out[2 * k] = __builtin_elementwise_fma(w2, lo, out[2 * k]); out[2 * k + 1] = __builtin_elementwise_fma(w2, hi2, out[2 * k + 1]); }
}
__device__ __forceinline__ int p7_doti(const u32x4 u, const u32x4 h) {
    int s = __builtin_amdgcn_sdot4((int)u[0], (int)h[0], 0, false); s = __builtin_amdgcn_sdot4((int)u[1], (int)h[1], s, false); s = __builtin_amdgcn_sdot4((int)u[2], (int)h[2], s, false); return __builtin_amdgcn_sdot4((int)u[3], (int)h[3], s, false);
}
#define DPPI(v, ctrl) __builtin_amdgcn_update_dpp(0, (v), (ctrl), 0xf, 0xf, true)
__device__ __forceinline__ int reduce8i(int p0, int p1, int p2, int p3, int p4, int p5, int p6, int p7, int lane) {
    auto s01 = __builtin_amdgcn_permlane32_swap((unsigned)p0, (unsigned)p1, false, false); auto s23 = __builtin_amdgcn_permlane32_swap((unsigned)p2, (unsigned)p3, false, false);
    auto s45 = __builtin_amdgcn_permlane32_swap((unsigned)p4, (unsigned)p5, false, false); auto s67 = __builtin_amdgcn_permlane32_swap((unsigned)p6, (unsigned)p7, false, false);
    const unsigned q0 = s01[0] + s01[1], q1 = s23[0] + s23[1], q2 = s45[0] + s45[1], q3 = s67[0] + s67[1];
    auto t0 = __builtin_amdgcn_permlane16_swap(q0, q1, false, false); auto t1 = __builtin_amdgcn_permlane16_swap(q2, q3, false, false);
    int r0 = (int)(t0[0] + t0[1]), r1 = (int)(t1[0] + t1[1]);
    r0 += DPPI(r0, 0x128); r1 += DPPI(r1, 0x128);
    int z = (lane & 8) ? r1 : r0;
    z += DPPI(z, 0x141); z += DPPI(z, 0xB1); z += DPPI(z, 0x4E);
    return z;
}

struct P7CArgs { const signed char* H8; const unsigned* EG; const unsigned char* U8; int* PART; int nrows; };
__device__ __forceinline__ int p7_doti4(const u32x4 u, const u32x4 h0, const u32x4 h1) {
    int s = 0;
#pragma unroll
    for (int k = 0; k < 4; ++k) { const unsigned lo = (u[k] << 4) & 0xf0f0f0f0u, hi = u[k] & 0xf0f0f0f0u;
        const unsigned ha = (k < 2) ? h0[2 * k] : h1[2 * k - 4], hb = (k < 2) ? h0[2 * k + 1] : h1[2 * k - 3];
        s = __builtin_amdgcn_sdot4((int)lo, (int)ha, s, false); s = __builtin_amdgcn_sdot4((int)hi, (int)hb, s, false); }
    return s;
}
__device__ __forceinline__ void phase_p7c(LAS unsigned char* lds, const P7CArgs& a, int part8, int prank8, int nvb) {
    int tid_ = threadIdx.x; asm volatile("" : "+v"(tid_));
    const int lane = tid_ & 63, wid = __builtin_amdgcn_readfirstlane(tid_ >> 6);
    const int part = part8 >> 1, prank = (part8 & 1) * (nvb >> 3) + prank8;
    const int nw = (nvb >> 2) * 8, wrank = prank * 8 + wid;
    LAS unsigned* tab = (LAS unsigned*)(lds + wid * 1024);
    const int grp = lane >> 3, c = lane & 7, c16 = c * 16;
    const unsigned char* ubase = a.U8 + 128 * part + c16;
    const signed char* hbase = a.H8 + 256 * part + 32 * c;
    unsigned* pbase = (unsigned*)a.PART + (size_t)part * a.nrows * 64;
    const int c2 = (c >> 2) & 1, c1 = (c >> 1) & 1, c0 = c & 1;
    const int ent0 = 8 * (4 * c2 + 2 * c0 + c1) + grp;
    u32x4 Av[16], Bv[16]; u32x4 Ah0, Ah1, Bh0, Bh1;
    unsigned pw0 = 0u, pw1 = 0u;
#define P7C_PREF(t) do { pw0 = a.EG[(size_t)(t) * 128 + lane]; pw1 = a.EG[(size_t)(t) * 128 + 64 + lane]; } while (0)
#define P7C_ISSUE(X, Xh0, Xh1, t, slot, tnext) do { LAS unsigned* tb_ = tab + (slot) * 128; \
        tb_[lane] = pw0; tb_[64 + lane] = pw1; \
        asm volatile("s_waitcnt lgkmcnt(0)" ::: "memory"); \
        _Pragma("unroll") for (int i_ = 0; i_ < 16; ++i_) { const unsigned e_ = tb_[8 * i_ + grp]; X[i_] = *(const u32x4*)(ubase + (size_t)(e_ >> 16) * 512); } \
        Xh0 = *(const u32x4*)(hbase + (size_t)(t) * 1024); Xh1 = *(const u32x4*)(hbase + (size_t)(t) * 1024 + 16); \
        P7C_PREF(tnext); } while (0)
#define P7C_COMPUTE(X, Xh0, Xh1, t, valid) do { int d_[16]; \
        _Pragma("unroll") for (int i_ = 0; i_ < 16; ++i_) d_[i_] = p7_doti4(X[i_], Xh0, Xh1); \
        int e8_[8]; _Pragma("unroll") for (int k = 0; k < 8; ++k) { const int send_ = c2 ? d_[k] : d_[k + 8], keep_ = c2 ? d_[k + 8] : d_[k]; e8_[k] = keep_ + DPPI(send_, 0x141); }            \
        int e4_[4]; _Pragma("unroll") for (int k = 0; k < 4; ++k) { const int send_ = c0 ? e8_[k] : e8_[k + 4], keep_ = c0 ? e8_[k + 4] : e8_[k]; e4_[k] = keep_ + DPPI(send_, 0xB1); }          \
        int e2_[2]; _Pragma("unroll") for (int k = 0; k < 2; ++k) { const int send_ = c1 ? e4_[k] : e4_[k + 2], keep_ = c1 ? e4_[k + 2] : e4_[k]; e2_[k] = keep_ + DPPI(send_, 0x4E); }          \
        if (valid) pbase[(size_t)(t) * 64 + ent0] = __builtin_bit_cast(unsigned, __builtin_amdgcn_cvt_pk_i16(e2_[0] >> 4, e2_[1] >> 4)); } while (0)
    const int lastrow = a.nrows - 1;
    int t = wrank;
    if (t < a.nrows) {
    P7C_PREF(t);
    P7C_ISSUE(Av, Ah0, Ah1, t, 0, (t + nw < a.nrows ? t + nw : lastrow));
    while (t < a.nrows) {
        const int t1 = t + nw, t2 = t1 + nw, t3 = t2 + nw;
        const int k1 = t1 < a.nrows ? t1 : lastrow, k2 = t2 < a.nrows ? t2 : lastrow, k3 = t3 < a.nrows ? t3 : lastrow;
        P7C_ISSUE(Bv, Bh0, Bh1, k1, 1, k2);
        P7C_COMPUTE(Av, Ah0, Ah1, t, true);
        P7C_ISSUE(Av, Ah0, Ah1, k2, 0, k3);
        P7C_COMPUTE(Bv, Bh0, Bh1, k1, (t1 < a.nrows));
        t = t2;
    }
    }
#undef P7C_PREF
#undef P7C_ISSUE
#undef P7C_COMPUTE
}
__device__ __forceinline__ void phase_p7d(const int* __restrict__ PART, const unsigned* __restrict__ EG, const float* __restrict__ US, const float* __restrict__ VS, const float* __restrict__ HS, unsigned* __restrict__ WE, int nrows, int vb, int nvb) {
    int tid_ = threadIdx.x; asm volatile("" : "+v"(tid_));
    typedef int i32x4 __attribute__((ext_vector_type(4)));
    const size_t n16 = (size_t)nrows * 16, pstride4 = n16;
    const u32x4* P4 = (const u32x4*)PART; const u32x4* EG4 = (const u32x4*)EG; u32x4* WE4 = (u32x4*)WE;
    for (size_t j = (size_t)vb * 512 + tid_; j < n16; j += (size_t)nvb * 512) {
        const size_t row = j >> 4; const int P = (int)(j >> 1) & 7, gq = (int)j & 1;
        i32x4 slo = {0, 0, 0, 0}, shi = {0, 0, 0, 0};
#pragma unroll
        for (int p = 0; p < 4; ++p) { const u32x4 d = P4[p * pstride4 + j];
#pragma unroll
            for (int k = 0; k < 4; ++k) { slo[k] += (int)(d[k] << 16) >> 16; shi[k] += (int)d[k] >> 16; } }
        const float hs = HS[row];
#pragma unroll
        for (int half = 0; half < 2; ++half) {
            const size_t ei = row * 32 + 4 * P + 2 * half + gq;
            const u32x4 eg = EG4[ei]; u32x4 o;
#pragma unroll
            for (int k = 0; k < 4; ++k) { const int eid = (int)(eg[k] >> 16);
                const float av = (float)(half ? shi[k] : slo[k]) * US[eid] * hs;
                const float wv = __uint_as_float(eg[k] << 16) * gelu_fast(av) * VS[eid];
                o[k] = (eg[k] & 0xffff0000u) | (cvt_pk_bf16(wv, 0.f) & 0xffffu); }
            WE4[ei] = o;
        }
    }
}
struct P7BArgs { const unsigned* WE; const unsigned char* V8; bf16_t* XB; const float* gate2; int nrows; };
template <int PM>
__device__ __forceinline__ void phase_p7b(LAS unsigned char* lds, const P7BArgs& a, int part, int prank, int nvb) {
    int tid_ = threadIdx.x; asm volatile("" : "+v"(tid_));
    const int lane = tid_ & 63, wid = __builtin_amdgcn_readfirstlane(tid_ >> 6);
    const int nw = (nvb >> 3) * 8, wrank = prank * 8 + wid;
    LAS unsigned* tab = (LAS unsigned*)(lds + wid * 1024);
    const int grp = lane >> 3, c16 = (lane & 7) * 16;
    const unsigned char* vbase = a.V8 + 128 * part + c16;
    const int colofs = 128 * part + c16 + 8 * (lane >> 5) + 4 * ((lane >> 4) & 1) + 2 * ((lane >> 3) & 1);
    u32x4 Av[16], Bv[16]; float Aw[16], Bw[16]; unsigned Ax, Bx; f32x2 Ag, Bg;
    unsigned pw0 = 0u, pw1 = 0u;
#define P7B_PREF(t) do { pw0 = a.WE[(size_t)(t) * 128 + lane]; pw1 = a.WE[(size_t)(t) * 128 + 64 + lane]; } while (0)
#define P7B_ISSUE(X, Xw, Xx, Xg, t, slot, tnext) do { LAS unsigned* tb_ = tab + (slot) * 128; \
        tb_[lane] = pw0; tb_[64 + lane] = pw1; \
        asm volatile("s_waitcnt lgkmcnt(0)" ::: "memory"); \
        _Pragma("unroll") for (int i_ = 0; i_ < 16; ++i_) { const unsigned we_ = tb_[8 * i_ + grp]; Xw[i_] = __uint_as_float(we_ << 16); if (PM != 2) X[i_] = *(const u32x4*)(vbase + (size_t)(we_ >> 16) * 1024); else X[i_] = (u32x4){we_, 0x38383838u, 0x38383838u, 0x38383838u}; } \
        { const int mr_ = (t) >= NL ? 32 : (t) / S; \
          Xx = *(const unsigned*)(a.XB + (size_t)(t) * 1024 + colofs); Xg = *(const f32x2*)(a.gate2 + (size_t)mr_ * 6144 + colofs); } \
        P7B_PREF(tnext); } while (0)
#define P7B_COMPUTE(X, Xw, Xx, Xg, t, valid) do { f32x2 acc2[8]; \
        _Pragma("unroll") for (int k = 0; k < 8; ++k) acc2[k] = (f32x2){0.f, 0.f}; \
        if (PM != 1) { _Pragma("unroll") for (int i_ = 0; i_ < 16; ++i_) p7_axpy(X[i_], Xw[i_], acc2); } else { _Pragma("unroll") for (int i_ = 0; i_ < 16; ++i_) acc2[i_ >> 1][i_ & 1] = __uint_as_float((X[i_][0] ^ X[i_][1] ^ X[i_][2] ^ X[i_][3]) & 0x3fffffffu) + Xw[i_]; } \
        float b_[8]; _Pragma("unroll") for (int k = 0; k < 8; ++k) { auto s_ = __builtin_amdgcn_permlane32_swap(__float_as_uint(acc2[k >> 1][k & 1]), __float_as_uint(acc2[(k + 8) >> 1][k & 1]), false, false); b_[k] = __uint_as_float(s_[0]) + __uint_as_float(s_[1]); } \
        float c_[4]; _Pragma("unroll") for (int k = 0; k < 4; ++k) { auto s_ = __builtin_amdgcn_permlane16_swap(__float_as_uint(b_[k]), __float_as_uint(b_[k + 4]), false, false); c_[k] = __uint_as_float(s_[0]) + __uint_as_float(s_[1]); } \
        float d_[2]; _Pragma("unroll") for (int k = 0; k < 2; ++k) { const float send_ = (lane & 8) ? c_[k] : c_[k + 2]; const float keep_ = (lane & 8) ? c_[k + 2] : c_[k]; d_[k] = keep_ + DPPF(send_, 0x128); } \
        unsigned* xp_ = (unsigned*)(a.XB + (size_t)(t) * 1024 + colofs); \
        f32x2 x_ = {__uint_as_float(Xx << 16), __uint_as_float(Xx & 0xffff0000u)}; x_.x += Xg.x * d_[0]; x_.y += Xg.y * d_[1]; if ((valid) && PM == 0) *xp_ = cvt_pk_bf16(x_.x, x_.y); else if (PM != 0 && x_.x == 1.2345e30f) *xp_ = cvt_pk_bf16(x_.x, x_.y); } while (0)
    const int lastrow = a.nrows - 1;
    int t = wrank;
    P7B_PREF(t);
    P7B_ISSUE(Av, Aw, Ax, Ag, t, 0, (t + nw < a.nrows ? t + nw : lastrow));
    while (t < a.nrows) {
        const int t1 = t + nw, t2 = t1 + nw, t3 = t2 + nw;
        const int c1 = t1 < a.nrows ? t1 : lastrow, c2 = t2 < a.nrows ? t2 : lastrow, c3 = t3 < a.nrows ? t3 : lastrow;
        P7B_ISSUE(Bv, Bw, Bx, Bg, c1, 1, c2);
        P7B_COMPUTE(Av, Aw, Ax, Ag, t, true);
        P7B_ISSUE(Av, Aw, Ax, Ag, c2, 0, c3);
        P7B_COMPUTE(Bv, Bw, Bx, Bg, c1, (t1 < a.nrows));
        t = t2;
    }
#undef P7B_PREF
#undef P7B_ISSUE
#undef P7B_COMPUTE
}
__device__ __forceinline__ void phase_final_norm(const bf16_t* __restrict__ XBp, float* __restrict__ OUT, const float* __restrict__ g, int vb, int nvb) {
    int tid_ = threadIdx.x; asm volatile("" : "+v"(tid_));
    const int lane = tid_ & 63, wid = tid_ >> 6;
    for (int row = vb * 8 + wid; row < NL; row += nvb * 8) {
        const bf16_t* xp = XBp + (size_t)row * 1024; f32x4 x[4]; float ss = 0.f;
#pragma unroll
        for (int i = 0; i < 4; ++i) { const u32x2 r = *(const u32x2*)(xp + 256 * i + 4 * lane); x[i] = (f32x4){__uint_as_float(r.x << 16), __uint_as_float(r.x & 0xffff0000u), __uint_as_float(r.y << 16), __uint_as_float(r.y & 0xffff0000u)};
            ss += x[i][0] * x[i][0] + x[i][1] * x[i][1] + x[i][2] * x[i][2] + x[i][3] * x[i][3]; }
        ss = wave_sum(ss); const float rstd = rsqrtf(ss * (1.f / 1024.f) + EPS);
#pragma unroll
        for (int i = 0; i < 4; ++i) *(f32x4*)(OUT + (size_t)row * 1024 + 256 * i + 4 * lane) = x[i] * rstd * *(const f32x4*)(g + 256 * i + 4 * lane);
    }
}

template <int V_> struct IC { static constexpr int value = V_; };
typedef short s16x4 __attribute__((ext_vector_type(4)));
__device__ __forceinline__ s16x4 lds_tr16(const LAS unsigned char* p) { return __builtin_bit_cast(s16x4, __builtin_amdgcn_ds_read_tr16_b64_v4i16((LAS s16x4*)p)); }
constexpr int ATT_BUF = 20480;
__device__ __forceinline__ void glds16(const void* g, unsigned lds_base) {
    unsigned sv; asm volatile("s_mov_b32 %0, m0\n\ts_mov_b32 m0, %2\n\ts_nop 0\n\tglobal_load_lds_dwordx4 %1, off\n\ts_mov_b32 m0, %0" : "=&s"(sv) : "v"(g), "s"(lds_base) : "memory"); }
template <int DK>
__device__ __forceinline__ void attn_unit(LAS unsigned char* lds, const bf16_t* __restrict__ Q, const bf16_t* __restrict__ K1, const bf16_t* __restrict__ K2, const bf16_t* __restrict__ V,
                                          int nkeys, float c2, bf16_t* __restrict__ out) {
    int tid_ = threadIdx.x; asm volatile("" : "+v"(tid_));
    const int tid = tid_, lane = tid & 63, wid = __builtin_amdgcn_readfirstlane(tid >> 6), r32 = lane & 31, hi = lane >> 5;
    constexpr int NS = DK / 16, NM = 2 * NS;
    bf16x8 qf[NS];
    { const bf16_t* qp = Q + (size_t)(wid * 32 + r32) * DK + 8 * hi;
#pragma unroll
      for (int s = 0; s < NS; ++s) qf[s] = *(const bf16x8*)(qp + 16 * s); }
    const int dkey = 8 * wid + (lane >> 3), dkey2 = 16 * (wid & 3) + (lane >> 2);
    const bf16_t* gk1 = K1 + (size_t)dkey * 64 + (((lane & 7) ^ ((dkey >> 1) & 7)) << 3);
    const bf16_t* gv = V + (size_t)dkey * 64 + (((lane & 7) ^ (((dkey >> 1) & 1) << 2)) << 3);
    const bf16_t* gk2 = (DK == 96) ? K2 + (size_t)dkey2 * 32 + (((lane & 3) ^ ((dkey2 >> 2) & 3)) << 3) : nullptr;
    const unsigned lds0 = (unsigned)(size_t)lds;
    const unsigned d_k1 = lds0 + wid * 1024, d_v = lds0 + 8192 + wid * 1024, d_k2 = lds0 + 16384 + (wid & 3) * 1024;
#define ATT_DMA(tile_, slot_) do { const int tt_ = (tile_); glds16(gk1 + (size_t)tt_ * 4096, (unsigned)__builtin_amdgcn_readfirstlane(d_k1 + (slot_) * ATT_BUF)); \
        glds16(gv + (size_t)tt_ * 4096, (unsigned)__builtin_amdgcn_readfirstlane(d_v + (slot_) * ATT_BUF)); \
        if (DK == 96) glds16(gk2 + (size_t)tt_ * 2048, (unsigned)__builtin_amdgcn_readfirstlane(d_k2 + (slot_) * ATT_BUF)); } while (0)
#define ATT_WAIT_BAR() do { if (DK == 96) asm volatile("s_waitcnt vmcnt(3) lgkmcnt(0)\n\ts_barrier" ::: "memory"); else asm volatile("s_waitcnt vmcnt(2) lgkmcnt(0)\n\ts_barrier" ::: "memory"); } while (0)
    unsigned ka[2][4];
#pragma unroll
    for (int kt = 0; kt < 2; ++kt)
#pragma unroll
        for (int s = 0; s < 4; ++s) { const int key = 32 * kt + r32; ka[kt][s] = key * 128 + (((2 * s + hi) ^ ((key >> 1) & 7)) << 4); }
    unsigned kb[2][2];
#pragma unroll
    for (int kt = 0; kt < 2; ++kt)
#pragma unroll
        for (int s = 0; s < 2; ++s) { const int key = 32 * kt + r32; kb[kt][s] = 16384 + key * 64 + (((2 * s + hi) ^ ((key >> 2) & 3)) << 4); }
    const int vq = (lane & 15) >> 2, vp = lane & 3, vg = (lane >> 4) & 1;
    unsigned va[2];
#pragma unroll
    for (int dvb = 0; dvb < 2; ++dvb) { const int key = 4 * hi + vq; va[dvb] = 8192 + key * 128 + ((((32 * dvb + 16 * vg + 4 * vp) * 2)) ^ (((key >> 1) & 1) << 6)); }
    float m = -1e30f, l = 0.f, mx;
    f32x16 o0 = {}, o1 = {};
    const int NT = nkeys >> 6;
    ATT_DMA(0, 0); ATT_DMA(NT > 1 ? 1 : 0, 1); ATT_DMA(NT > 2 ? 2 : NT - 1, 2);
    asm volatile("s_waitcnt vmcnt(0) lgkmcnt(0)\n\ts_barrier" ::: "memory");
    f32x16 pa0 = {}, pa1 = {}, pb0 = {}, pb1 = {};
    {
        bf16x8 kf0[NS], kf1[NS];
#pragma unroll
        for (int s = 0; s < 4; ++s) { kf0[s] = *(const LAS bf16x8*)(lds + ka[0][s]); kf1[s] = *(const LAS bf16x8*)(lds + ka[1][s]); }
        if (DK == 96) {
#pragma unroll
            for (int s = 0; s < 2; ++s) { kf0[4 + s] = *(const LAS bf16x8*)(lds + kb[0][s]); kf1[4 + s] = *(const LAS bf16x8*)(lds + kb[1][s]); }
        }
#pragma unroll
        for (int s = 0; s < NS; ++s) { pa0 = mfma32(kf0[s], qf[s], pa0); pa1 = mfma32(kf1[s], qf[s], pa1); }
        mx = pa0[0];
#pragma unroll
        for (int r = 1; r < 16; ++r) mx = fmaxf(mx, pa0[r]);
#pragma unroll
        for (int r = 0; r < 16; ++r) mx = fmaxf(mx, pa1[r]);
    }
    auto step = [&](auto bc_, auto bn_, auto bw_, f32x16& pc0, f32x16& pc1, f32x16& pn0, f32x16& pn1, int t) __attribute__((always_inline)) {
        constexpr int BC = decltype(bc_)::value * ATT_BUF, BN = decltype(bn_)::value * ATT_BUF;
        ATT_DMA((t + 3 < NT) ? t + 3 : NT - 1, decltype(bw_)::value);
        bf16x8 kf0[NS], kf1[NS];
#pragma unroll
        for (int s = 0; s < 4; ++s) { kf0[s] = *(const LAS bf16x8*)(lds + BN + ka[0][s]); kf1[s] = *(const LAS bf16x8*)(lds + BN + ka[1][s]); }
        if (DK == 96) {
#pragma unroll
            for (int s = 0; s < 2; ++s) { kf0[4 + s] = *(const LAS bf16x8*)(lds + BN + kb[0][s]); kf1[4 + s] = *(const LAS bf16x8*)(lds + BN + kb[1][s]); }
        }
        __builtin_amdgcn_sched_barrier(0);
        { auto rr = __builtin_amdgcn_permlane32_swap(__float_as_uint(mx), __float_as_uint(mx), false, false); mx = fmaxf(__uint_as_float(rr[0]), __uint_as_float(rr[1])); }
        const float tm = mx;
        if (__any(tm > m + 8.f)) {
            const float mn = fmaxf(m, tm), al = __builtin_amdgcn_exp2f(m - mn); m = mn; l *= al;
#pragma unroll
            for (int r = 0; r < 16; ++r) { o0[r] *= al; o1[r] *= al; }
        }
        const float nm = -m; float ls = 0.f;
        pn0 = f32x16{}; pn1 = f32x16{};
        unsigned pw[16];
        s16x4 vlo[2][2][2], vhi[2][2][2];
#pragma unroll
        for (int c = 0; c < 8; ++c) {
            __builtin_amdgcn_sched_barrier(0);
#pragma unroll
            for (int j = 0; j < NM; ++j) if (j >= c * NM / 8 && j < (c + 1) * NM / 8) { if (j & 1) pn1 = mfma32(kf1[j >> 1], qf[j >> 1], pn1); else pn0 = mfma32(kf0[j >> 1], qf[j >> 1], pn0); }
            if (c == 4) {
#pragma unroll
                for (int kt = 0; kt < 2; ++kt)
#pragma unroll
                    for (int sp = 0; sp < 2; ++sp) { const int kofs = (32 * kt + 16 * sp) * 128;
#pragma unroll
                        for (int dvb = 0; dvb < 2; ++dvb) { vlo[dvb][kt][sp] = lds_tr16(lds + BC + va[dvb] + kofs); vhi[dvb][kt][sp] = lds_tr16(lds + BC + va[dvb] + kofs + 8 * 128); } }
            }
            __builtin_amdgcn_sched_barrier(0);
            if (c < 4) {
#pragma unroll
                for (int i = 0; i < 4; ++i) { const int r = 4 * c + i; pc0[r] = __builtin_amdgcn_exp2f(pc0[r] + nm); ls += pc0[r]; }
                pw[2 * c] = cvt_pk_bf16(pc0[4 * c], pc0[4 * c + 1]); pw[2 * c + 1] = cvt_pk_bf16(pc0[4 * c + 2], pc0[4 * c + 3]);
            } else {
#pragma unroll
                for (int i = 0; i < 4; ++i) { const int r = 4 * (c - 4) + i; pc1[r] = __builtin_amdgcn_exp2f(pc1[r] + nm); ls += pc1[r]; }
                pw[8 + 2 * (c - 4)] = cvt_pk_bf16(pc1[4 * (c - 4)], pc1[4 * (c - 4) + 1]); pw[8 + 2 * (c - 4) + 1] = cvt_pk_bf16(pc1[4 * (c - 4) + 2], pc1[4 * (c - 4) + 3]);
            }
        }
        __builtin_amdgcn_sched_barrier(0);
        l += ls;
        float mxn = -3.0e38f;
#pragma unroll
        for (int k = 0; k < 8; ++k) { const int kt = k >> 2, sp = (k >> 1) & 1, dvb = k & 1;
            const u32x4 pq = (u32x4){pw[8 * kt + 4 * sp], pw[8 * kt + 4 * sp + 1], pw[8 * kt + 4 * sp + 2], pw[8 * kt + 4 * sp + 3]};
            const s16x4 lo = vlo[dvb][kt][sp], hi4 = vhi[dvb][kt][sp]; const bf16x8 vf = (bf16x8){lo[0], lo[1], lo[2], lo[3], hi4[0], hi4[1], hi4[2], hi4[3]};
            if (dvb == 0) o0 = mfma32(vf, __builtin_bit_cast(bf16x8, pq), o0); else o1 = mfma32(vf, __builtin_bit_cast(bf16x8, pq), o1);
            __builtin_amdgcn_sched_barrier(0);
            if (k < 4) { mxn = fmaxf(fmaxf(mxn, pn0[4 * k]), fmaxf(pn0[4 * k + 1], fmaxf(pn0[4 * k + 2], pn0[4 * k + 3]))); }
            else { mxn = fmaxf(fmaxf(mxn, pn1[4 * (k - 4)]), fmaxf(pn1[4 * (k - 4) + 1], fmaxf(pn1[4 * (k - 4) + 2], pn1[4 * (k - 4) + 3]))); }
            __builtin_amdgcn_sched_barrier(0);
        }
        mx = mxn;
        ATT_WAIT_BAR();
    };
    for (int t = 0; t < NT; t += 4) {
        step(IC<0>{}, IC<1>{}, IC<3>{}, pa0, pa1, pb0, pb1, t);
        step(IC<1>{}, IC<2>{}, IC<0>{}, pb0, pb1, pa0, pa1, t + 1);
        step(IC<2>{}, IC<3>{}, IC<1>{}, pa0, pa1, pb0, pb1, t + 2);
        step(IC<3>{}, IC<0>{}, IC<2>{}, pb0, pb1, pa0, pa1, t + 3);
    }
    { auto rr = __builtin_amdgcn_permlane32_swap(__float_as_uint(l), __float_as_uint(l), false, false); l = __uint_as_float(rr[0]) + __uint_as_float(rr[1]); }
    const float il = 1.f / l;
    bf16_t* op = out + (size_t)(wid * 32 + r32) * 1024 + 4 * hi;
#pragma unroll
    for (int g = 0; g < 4; ++g) { u32x2 a, b;
        a.x = cvt_pk_bf16(o0[4 * g] * il, o0[4 * g + 1] * il); a.y = cvt_pk_bf16(o0[4 * g + 2] * il, o0[4 * g + 3] * il);
        b.x = cvt_pk_bf16(o1[4 * g] * il, o1[4 * g + 1] * il); b.y = cvt_pk_bf16(o1[4 * g + 2] * il, o1[4 * g + 3] * il);
        *(u32x2*)(op + 8 * g) = a; *(u32x2*)(op + 32 + 8 * g) = b; }
}
#undef ATT_DMA
#undef ATT_WAIT_BAR
template <int DK>
__device__ __forceinline__ void attn_unit64(LAS unsigned char* lds, const bf16_t* __restrict__ Q, const bf16_t* __restrict__ K1, const bf16_t* __restrict__ K2, const bf16_t* __restrict__ V,
                                            int nkeys, bf16_t* __restrict__ out) {
    int tid_ = threadIdx.x; asm volatile("" : "+v"(tid_));
    const int tid = tid_, lane = tid & 63, wid = __builtin_amdgcn_readfirstlane(tid >> 6), r32 = lane & 31, hi = lane >> 5;
    constexpr int NS = DK / 16;
    bf16x8 qf[2][NS];
#pragma unroll
    for (int j = 0; j < 2; ++j) { const bf16_t* qp = Q + (size_t)(wid * 64 + 32 * j + r32) * DK + 8 * hi;
#pragma unroll
        for (int s = 0; s < NS; ++s) qf[j][s] = *(const bf16x8*)(qp + 16 * s); }
    const int dkey = 8 * wid + (lane >> 3), dkey2 = 16 * (wid & 3) + (lane >> 2);
    const bf16_t* gk1 = K1 + (size_t)dkey * 64 + (((lane & 7) ^ ((dkey >> 1) & 7)) << 3);
    const bf16_t* gv = V + (size_t)dkey * 64 + (((lane & 7) ^ (((dkey >> 1) & 1) << 2)) << 3);
    const bf16_t* gk2 = (DK == 96) ? K2 + (size_t)dkey2 * 32 + (((lane & 3) ^ ((dkey2 >> 2) & 3)) << 3) : nullptr;
    const unsigned lds0 = (unsigned)(size_t)lds;
    const unsigned d_k1 = lds0 + wid * 1024, d_v = lds0 + 8192 + wid * 1024, d_k2 = lds0 + 16384 + (wid & 3) * 1024;
#define ATT_DMA(tile_, slot_) do { const int tt_ = (tile_); glds16(gk1 + (size_t)tt_ * 4096, (unsigned)__builtin_amdgcn_readfirstlane(d_k1 + (slot_) * ATT_BUF)); \
        glds16(gv + (size_t)tt_ * 4096, (unsigned)__builtin_amdgcn_readfirstlane(d_v + (slot_) * ATT_BUF)); \
        if (DK == 96) glds16(gk2 + (size_t)tt_ * 2048, (unsigned)__builtin_amdgcn_readfirstlane(d_k2 + (slot_) * ATT_BUF)); } while (0)
    unsigned ka[4];
#pragma unroll
    for (int s = 0; s < 4; ++s) ka[s] = r32 * 128 + (((2 * s + hi) ^ ((r32 >> 1) & 7)) << 4);
    unsigned kb[2];
#pragma unroll
    for (int s = 0; s < 2; ++s) kb[s] = 16384 + r32 * 64 + (((2 * s + hi) ^ ((r32 >> 2) & 3)) << 4);
    const int vq = (lane & 15) >> 2, vp = lane & 3, vg = (lane >> 4) & 1;
    unsigned va[2];
#pragma unroll
    for (int dvb = 0; dvb < 2; ++dvb) { const int key = 4 * hi + vq; va[dvb] = 8192 + key * 128 + ((((32 * dvb + 16 * vg + 4 * vp) * 2)) ^ (((key >> 1) & 1) << 6)); }
    float m[2] = {-1e30f, -1e30f}, l[2] = {0.f, 0.f};
    f32x16 o[2][2] = {};
    const int NT = nkeys >> 6;
    ATT_DMA(0, 0); ATT_DMA(1, 1); ATT_DMA(2, 2);
    asm volatile("s_waitcnt vmcnt(0) lgkmcnt(0)\n\ts_barrier" ::: "memory");
    bf16x8 kf0[NS], kf1[NS];
#pragma unroll
    for (int s = 0; s < 4; ++s) { kf0[s] = *(const LAS bf16x8*)(lds + ka[s]); kf1[s] = *(const LAS bf16x8*)(lds + 4096 + ka[s]); }
    auto step = [&](auto cur_, auto wsl_, int t) __attribute__((always_inline)) {
        constexpr int BC = decltype(cur_)::value * ATT_BUF, BNX = ((decltype(cur_)::value + 1) & 3) * ATT_BUF;
        ATT_DMA((t + 3 < NT) ? t + 3 : NT - 1, decltype(wsl_)::value);
        unsigned pw[2][16];
        s16x4 vlo[2][2], vhi[2][2];
#define ATT64_VLOAD(kt_) do { _Pragma("unroll") for (int sp = 0; sp < 2; ++sp) { const int kofs = (32 * (kt_) + 16 * sp) * 128; \
            _Pragma("unroll") for (int dvb = 0; dvb < 2; ++dvb) { vlo[dvb][sp] = lds_tr16(lds + BC + va[dvb] + kofs); vhi[dvb][sp] = lds_tr16(lds + BC + va[dvb] + kofs + 8 * 128); } } } while (0)
#define ATT64_PV(kt_) do { _Pragma("unroll") for (int sp = 0; sp < 2; ++sp) _Pragma("unroll") for (int dvb = 0; dvb < 2; ++dvb) { \
            const s16x4 lo = vlo[dvb][sp], hi4 = vhi[dvb][sp]; const bf16x8 vf = (bf16x8){lo[0], lo[1], lo[2], lo[3], hi4[0], hi4[1], hi4[2], hi4[3]}; \
            _Pragma("unroll") for (int j = 0; j < 2; ++j) { const u32x4 pq = (u32x4){pw[j][8 * (kt_) + 4 * sp], pw[j][8 * (kt_) + 4 * sp + 1], pw[j][8 * (kt_) + 4 * sp + 2], pw[j][8 * (kt_) + 4 * sp + 3]}; \
                o[j][dvb] = mfma32(vf, __builtin_bit_cast(bf16x8, pq), o[j][dvb]); } } } while (0)
#pragma unroll
        for (int j = 0; j < 2; ++j) {
            f32x16 p0 = {}, p1 = {};
#pragma unroll
            for (int s = 0; s < NS; ++s) { p0 = mfma32(kf0[s], qf[j][s], p0); p1 = mfma32(kf1[s], qf[j][s], p1); }
            if (j == 1) { __builtin_amdgcn_sched_barrier(0); ATT64_VLOAD(0); __builtin_amdgcn_sched_barrier(0); }
            float mx = p0[0];
#pragma unroll
            for (int r = 1; r < 16; ++r) mx = fmaxf(mx, p0[r]);
#pragma unroll
            for (int r = 0; r < 16; ++r) mx = fmaxf(mx, p1[r]);
            { auto rr = __builtin_amdgcn_permlane32_swap(__float_as_uint(mx), __float_as_uint(mx), false, false); mx = fmaxf(__uint_as_float(rr[0]), __uint_as_float(rr[1])); }
            if (__any(mx > m[j] + 8.f)) {
                const float mn = fmaxf(m[j], mx), al = __builtin_amdgcn_exp2f(m[j] - mn); m[j] = mn; l[j] *= al;
#pragma unroll
                for (int r = 0; r < 16; ++r) { o[j][0][r] *= al; o[j][1][r] *= al; }
            }
            const float nm = -m[j];
#pragma unroll
            for (int r = 0; r < 16; ++r) { p0[r] = __builtin_amdgcn_exp2f(p0[r] + nm); p1[r] = __builtin_amdgcn_exp2f(p1[r] + nm); }
            f32x2 ls2 = {0.f, 0.f};
#pragma unroll
            for (int r = 0; r < 16; r += 2) { ls2 += (f32x2){p0[r], p0[r + 1]}; ls2 += (f32x2){p1[r], p1[r + 1]}; }
            l[j] += ls2.x + ls2.y;
#pragma unroll
            for (int i = 0; i < 8; ++i) { pw[j][i] = cvt_pk_bf16(p0[2 * i], p0[2 * i + 1]); pw[j][8 + i] = cvt_pk_bf16(p1[2 * i], p1[2 * i + 1]); }
            __builtin_amdgcn_sched_barrier(0);
        }
        ATT64_PV(0);
        __builtin_amdgcn_sched_barrier(0);
        ATT64_VLOAD(1);
        __builtin_amdgcn_sched_barrier(0);
        ATT64_PV(1);
#undef ATT64_VLOAD
#undef ATT64_PV
        __builtin_amdgcn_sched_barrier(0);
#pragma unroll
        for (int s = 0; s < 4; ++s) { kf0[s] = *(const LAS bf16x8*)(lds + BNX + ka[s]); kf1[s] = *(const LAS bf16x8*)(lds + BNX + 4096 + ka[s]); }
        asm volatile("s_waitcnt vmcnt(2) lgkmcnt(0)\n\ts_barrier" ::: "memory");
    };
    for (int t = 0; t < NT; t += 4) {
        step(IC<0>{}, IC<3>{}, t); step(IC<1>{}, IC<0>{}, t + 1); step(IC<2>{}, IC<1>{}, t + 2); step(IC<3>{}, IC<2>{}, t + 3);
    }
#pragma unroll
    for (int j = 0; j < 2; ++j) {
        float lj = l[j]; { auto rr = __builtin_amdgcn_permlane32_swap(__float_as_uint(lj), __float_as_uint(lj), false, false); lj = __uint_as_float(rr[0]) + __uint_as_float(rr[1]); }
        const float il = 1.f / lj;
        bf16_t* op = out + (size_t)(wid * 64 + 32 * j + r32) * 1024 + 4 * hi;
#pragma unroll
        for (int g = 0; g < 4; ++g) { u32x2 a, b;
            a.x = cvt_pk_bf16(o[j][0][4 * g] * il, o[j][0][4 * g + 1] * il); a.y = cvt_pk_bf16(o[j][0][4 * g + 2] * il, o[j][0][4 * g + 3] * il);
            b.x = cvt_pk_bf16(o[j][1][4 * g] * il, o[j][1][4 * g + 1] * il); b.y = cvt_pk_bf16(o[j][1][4 * g + 2] * il, o[j][1][4 * g + 3] * il);
            *(u32x2*)(op + 8 * g) = a; *(u32x2*)(op + 32 + 8 * g) = b; }
    }
#undef ATT_DMA
}
__device__ __forceinline__ void glds16s(const void* base, unsigned voff, unsigned lds_base) {
    unsigned sv; asm volatile("s_mov_b32 %0, m0\n\ts_mov_b32 m0, %3\n\ts_nop 0\n\tglobal_load_lds_dwordx4 %1, %2\n\ts_mov_b32 m0, %0" : "=&s"(sv) : "v"(voff), "s"(base), "s"(lds_base) : "memory"); }
__device__ __forceinline__ void attn_unit64m(LAS unsigned char* lds, const bf16_t* __restrict__ Q, const bf16_t* __restrict__ K1, const bf16_t* __restrict__ K2, const bf16_t* __restrict__ V,
                                            int nkeys, bf16_t* __restrict__ out) {
    constexpr int DK = 96;
    int tid_ = threadIdx.x; asm volatile("" : "+v"(tid_));
    const int tid = tid_, lane = tid & 63, wid = __builtin_amdgcn_readfirstlane(tid >> 6), r32 = lane & 31, hi = lane >> 5;
    bf16x8 qf[2][4];
    LAS unsigned char* qrl = lds + 4 * ATT_BUF + wid * 4096 + lane * 16;
#pragma unroll
    for (int j = 0; j < 2; ++j) { const bf16_t* qp = Q + (size_t)(wid * 64 + 32 * j + r32) * DK + 8 * hi;
#pragma unroll
        for (int s = 0; s < 4; ++s) qf[j][s] = *(const bf16x8*)(qp + 16 * s);
#pragma unroll
        for (int s = 0; s < 2; ++s) *(LAS bf16x8*)(qrl + (2 * j + s) * 1024) = *(const bf16x8*)(qp + 64 + 16 * s); }
    const int dkey = 8 * wid + (lane >> 3), dkey2 = 16 * (wid & 3) + (lane >> 2);
    const unsigned ok1 = (unsigned)(dkey * 64 + (((lane & 7) ^ ((dkey >> 1) & 7)) << 3)) * 2u, ov = (unsigned)(dkey * 64 + (((lane & 7) ^ (((dkey >> 1) & 1) << 2)) << 3)) * 2u,
                   ok2 = (unsigned)(dkey2 * 32 + (((lane & 3) ^ ((dkey2 >> 2) & 3)) << 3)) * 2u;
    const unsigned lds0 = (unsigned)(size_t)lds;
    const unsigned d_k1 = lds0 + wid * 1024, d_v = lds0 + 8192 + wid * 1024, d_k2 = lds0 + 16384 + (wid & 3) * 1024;
#define ATT_DMA(tile_, slot_) do { const int tt_ = (tile_); glds16s((const char*)K1 + (size_t)tt_ * 8192, ok1, (unsigned)__builtin_amdgcn_readfirstlane(d_k1 + (slot_) * ATT_BUF)); \
        glds16s((const char*)V + (size_t)tt_ * 8192, ov, (unsigned)__builtin_amdgcn_readfirstlane(d_v + (slot_) * ATT_BUF)); \
        glds16s((const char*)K2 + (size_t)tt_ * 4096, ok2, (unsigned)__builtin_amdgcn_readfirstlane(d_k2 + (slot_) * ATT_BUF)); } while (0)
    const unsigned ka0_ = r32 * 128 + ((hi ^ ((r32 >> 1) & 7)) << 4), kb0_ = 16384 + r32 * 64 + ((hi ^ ((r32 >> 2) & 3)) << 4);
#define ka(s_) (kao_ ^ ((unsigned)(s_) << 5))
#define kb(s_) (kbo_ ^ ((unsigned)(s_) << 5))
    const int vq = (lane & 15) >> 2, vp = lane & 3, vg = (lane >> 4) & 1;
    const unsigned va0_ = 8192 + (4 * hi + vq) * 128 + ((((16 * vg + 4 * vp) * 2)) ^ ((((4 * hi + vq) >> 1) & 1) << 6));
    float m[2] = {-1e30f, -1e30f}, l[2] = {0.f, 0.f};
    f32x16 o[2][2] = {};
    const int NT = nkeys >> 6;
    ATT_DMA(0, 0); ATT_DMA(1, 1); ATT_DMA(2, 2);
    asm volatile("s_waitcnt vmcnt(0) lgkmcnt(0)\n\ts_barrier" ::: "memory");
    auto step = [&](auto cur_, auto wsl_, int t) __attribute__((always_inline)) {
        constexpr int BC = decltype(cur_)::value * ATT_BUF;
        unsigned kao_ = ka0_, kbo_ = kb0_, vao_ = va0_; asm volatile("" : "+v"(kao_), "+v"(kbo_), "+v"(vao_));
        const unsigned va[2] = {vao_, vao_ ^ 64u};
        ATT_DMA((t + 3 < NT) ? t + 3 : NT - 1, decltype(wsl_)::value);
        f32x16 pj[2][2];
#pragma unroll
        for (int j = 0; j < 2; ++j) { pj[j][0] = f32x16{}; pj[j][1] = f32x16{}; }
        {
            bf16x8 ka0[2], ka1[2], kb0[2], kb1[2];
#pragma unroll
            for (int s = 0; s < 2; ++s) { ka0[s] = *(const LAS bf16x8*)(lds + BC + ka(s)); ka1[s] = *(const LAS bf16x8*)(lds + BC + 4096 + ka(s)); }
#pragma unroll
            for (int s = 0; s < 2; ++s) { kb0[s] = *(const LAS bf16x8*)(lds + BC + ka(2 + s)); kb1[s] = *(const LAS bf16x8*)(lds + BC + 4096 + ka(2 + s)); }
            __builtin_amdgcn_sched_barrier(0);
#pragma unroll
            for (int s = 0; s < 2; ++s)
#pragma unroll
                for (int j = 0; j < 2; ++j) { pj[j][0] = mfma32(ka0[s], qf[j][s], pj[j][0]); pj[j][1] = mfma32(ka1[s], qf[j][s], pj[j][1]); }
            __builtin_amdgcn_sched_barrier(0);
            bf16x8 qr[2][2];
#pragma unroll
            for (int s = 0; s < 2; ++s) { ka0[s] = *(const LAS bf16x8*)(lds + BC + kb(s)); ka1[s] = *(const LAS bf16x8*)(lds + BC + 2048 + kb(s)); }
            __builtin_amdgcn_sched_barrier(0);
#pragma unroll
            for (int s = 0; s < 2; ++s)
#pragma unroll
                for (int j = 0; j < 2; ++j) { pj[j][0] = mfma32(kb0[s], qf[j][2 + s], pj[j][0]); pj[j][1] = mfma32(kb1[s], qf[j][2 + s], pj[j][1]); }
            __builtin_amdgcn_sched_barrier(0);
#pragma unroll
            for (int j = 0; j < 2; ++j)
#pragma unroll
                for (int s = 0; s < 2; ++s) qr[j][s] = *(const LAS bf16x8*)(qrl + (2 * j + s) * 1024);
            __builtin_amdgcn_sched_barrier(0);
#pragma unroll
            for (int s = 0; s < 2; ++s)
#pragma unroll
                for (int j = 0; j < 2; ++j) { pj[j][0] = mfma32(ka0[s], qr[j][s], pj[j][0]); pj[j][1] = mfma32(ka1[s], qr[j][s], pj[j][1]); }
            __builtin_amdgcn_sched_barrier(0);
        }
        unsigned pw[2][16];
        s16x4 vlo[2][2], vhi[2][2];
#define ATT64_VLOAD(kt_) do { _Pragma("unroll") for (int sp = 0; sp < 2; ++sp) { const int kofs = (32 * (kt_) + 16 * sp) * 128; \
            _Pragma("unroll") for (int dvb = 0; dvb < 2; ++dvb) { vlo[dvb][sp] = lds_tr16(lds + BC + va[dvb] + kofs); vhi[dvb][sp] = lds_tr16(lds + BC + va[dvb] + kofs + 8 * 128); } } } while (0)
#define ATT64_PV(kt_) do { _Pragma("unroll") for (int sp = 0; sp < 2; ++sp) _Pragma("unroll") for (int dvb = 0; dvb < 2; ++dvb) { \
            const s16x4 lo = vlo[dvb][sp], hi4 = vhi[dvb][sp]; const bf16x8 vf = (bf16x8){lo[0], lo[1], lo[2], lo[3], hi4[0], hi4[1], hi4[2], hi4[3]}; \
            _Pragma("unroll") for (int j = 0; j < 2; ++j) { const u32x4 pq = (u32x4){pw[j][8 * (kt_) + 4 * sp], pw[j][8 * (kt_) + 4 * sp + 1], pw[j][8 * (kt_) + 4 * sp + 2], pw[j][8 * (kt_) + 4 * sp + 3]}; \
                o[j][dvb] = mfma32(vf, __builtin_bit_cast(bf16x8, pq), o[j][dvb]); } } } while (0)
#pragma unroll
        for (int j = 0; j < 2; ++j) {
            f32x16 p0 = pj[j][0], p1 = pj[j][1];
            if (j == 1) { __builtin_amdgcn_sched_barrier(0); ATT64_VLOAD(0); __builtin_amdgcn_sched_barrier(0); }
            float mx = p0[0];
#pragma unroll
            for (int r = 1; r < 16; ++r) mx = fmaxf(mx, p0[r]);
#pragma unroll
            for (int r = 0; r < 16; ++r) mx = fmaxf(mx, p1[r]);
            { auto rr = __builtin_amdgcn_permlane32_swap(__float_as_uint(mx), __float_as_uint(mx), false, false); mx = fmaxf(__uint_as_float(rr[0]), __uint_as_float(rr[1])); }
            if (__any(mx > m[j] + 8.f)) {
                const float mn = fmaxf(m[j], mx), al = __builtin_amdgcn_exp2f(m[j] - mn); m[j] = mn; l[j] *= al;
#pragma unroll
                for (int r = 0; r < 16; ++r) { o[j][0][r] *= al; o[j][1][r] *= al; }
            }
            const float nm = -m[j];
#pragma unroll
            for (int r = 0; r < 16; ++r) { p0[r] = __builtin_amdgcn_exp2f(p0[r] + nm); p1[r] = __builtin_amdgcn_exp2f(p1[r] + nm); }
            f32x2 ls2 = {0.f, 0.f};
#pragma unroll
            for (int r = 0; r < 16; r += 2) { ls2 += (f32x2){p0[r], p0[r + 1]}; ls2 += (f32x2){p1[r], p1[r + 1]}; }
            l[j] += ls2.x + ls2.y;
#pragma unroll
            for (int i = 0; i < 8; ++i) { pw[j][i] = cvt_pk_bf16(p0[2 * i], p0[2 * i + 1]); pw[j][8 + i] = cvt_pk_bf16(p1[2 * i], p1[2 * i + 1]); }
            __builtin_amdgcn_sched_barrier(0);
        }
        ATT64_PV(0);
        __builtin_amdgcn_sched_barrier(0);
        ATT64_VLOAD(1);
        __builtin_amdgcn_sched_barrier(0);
        ATT64_PV(1);
#undef ATT64_VLOAD
#undef ATT64_PV
        if (DK == 96) asm volatile("s_waitcnt vmcnt(6) lgkmcnt(0)\n\ts_barrier" ::: "memory"); else asm volatile("s_waitcnt vmcnt(4) lgkmcnt(0)\n\ts_barrier" ::: "memory");
    };
    for (int t = 0; t < NT; t += 4) {
        step(IC<0>{}, IC<3>{}, t); step(IC<1>{}, IC<0>{}, t + 1); step(IC<2>{}, IC<1>{}, t + 2); step(IC<3>{}, IC<2>{}, t + 3);
    }
#pragma unroll
    for (int j = 0; j < 2; ++j) {
        float lj = l[j]; { auto rr = __builtin_amdgcn_permlane32_swap(__float_as_uint(lj), __float_as_uint(lj), false, false); lj = __uint_as_float(rr[0]) + __uint_as_float(rr[1]); }
        const float il = 1.f / lj;
        bf16_t* op = out + (size_t)(wid * 64 + 32 * j + r32) * 1024 + 4 * hi;
#pragma unroll
        for (int g = 0; g < 4; ++g) { u32x2 a, b;
            a.x = cvt_pk_bf16(o[j][0][4 * g] * il, o[j][0][4 * g + 1] * il); a.y = cvt_pk_bf16(o[j][0][4 * g + 2] * il, o[j][0][4 * g + 3] * il);
            b.x = cvt_pk_bf16(o[j][1][4 * g] * il, o[j][1][4 * g + 1] * il); b.y = cvt_pk_bf16(o[j][1][4 * g + 2] * il, o[j][1][4 * g + 3] * il);
            *(u32x2*)(op + 8 * g) = a; *(u32x2*)(op + 32 + 8 * g) = b; }
    }
#undef ATT_DMA
#undef ka
#undef kb
}
__device__ __forceinline__ void phase_p3(LAS unsigned char* lds, const WS& w, int l, int vb, int nvb, int xpart, int xrank) {
    const float c2g = 0.125f * 1.4426950408889634f, c2m = 0.10206207261596577f * 1.4426950408889634f;
    bf16_t* MIX = w.H();
    const int nlat = NB * 12 * 4, nctx = (l == 0) ? NB * 12 : 0;
    const bool xl = (nvb == 256);
    for (int u = vb; u < nlat + nctx; u += nvb) {
        if (u < nlat) {
            const bool mla = u >= nlat / 2; const int v = mla ? u - nlat / 2 : u;
            int qb, hh, b;
            if (xl) { const int grp = (v >> 8) * 64 + 8 * xpart + (xrank >> 2); qb = xrank & 3; hh = grp % 6; b = grp / 6; }
            else { qb = v & 3; hh = (v >> 2) % 6; b = v / 24; }
            bf16_t* out = MIX + ((size_t)b * S + qb * 512) * 1024;
            if (!mla) attn_unit64<64>(lds, w.Qg() + (((size_t)b * 6 + hh) * S + qb * 512) * 64, w.Kg() + ((size_t)b * 2 + hh / 3) * KEYS * 64, nullptr, w.Vg() + ((size_t)b * 2 + hh / 3) * KEYS * 64, KEYS, out + hh * 64);
            else attn_unit64m(lds, w.Qm() + (((size_t)b * 6 + hh) * S + qb * 512) * 96, w.Kmn() + ((size_t)b * 6 + hh) * KEYS * 64, w.KR() + (size_t)b * KEYS * 32, w.Vm() + ((size_t)b * 6 + hh) * KEYS * 64, KEYS, out + 640 + hh * 64);
        } else {
            const int v = u - nlat, slot = v % 12, b = v / 12;
            bf16_t* out = MIX + ((size_t)NL + (size_t)b * CTX) * 1024;
            if (slot < 6) attn_unit<64>(lds, w.Qgc() + ((size_t)b * 6 + slot) * CTX * 64, w.Kg() + ((size_t)b * 2 + slot / 3) * KEYS * 64, nullptr, w.Vg() + ((size_t)b * 2 + slot / 3) * KEYS * 64, CTX, c2g, out + slot * 64);
            else { const int h = slot - 6; attn_unit<96>(lds, w.Qmc() + ((size_t)b * 6 + h) * CTX * 96, w.Kmn() + ((size_t)b * 6 + h) * KEYS * 64, w.KR() + (size_t)b * KEYS * 32, w.Vm() + ((size_t)b * 6 + h) * KEYS * 64, CTX, c2m, out + 640 + h * 64); }
        }
    }
}

__device__ __forceinline__ unsigned fkey(float f, unsigned tag, unsigned mask) { return (__float_as_uint(f) & ~mask) | tag; }
__device__ __forceinline__ float keyf(unsigned k, unsigned mask) { return __uint_as_float(k & ~mask); }
__device__ __forceinline__ unsigned fmax_u(unsigned a, unsigned b) { unsigned r; asm("v_max_f32 %0, %1, %2" : "=v"(r) : "v"(a), "v"(b)); return r; }
__device__ __forceinline__ unsigned fmin_u(unsigned a, unsigned b) { unsigned r; asm("v_min_f32 %0, %1, %2" : "=v"(r) : "v"(a), "v"(b)); return r; }
__device__ __forceinline__ void ce_desc(unsigned& a, unsigned& b) { const unsigned hi_ = fmax_u(a, b), lo_ = fmin_u(a, b); a = hi_; b = lo_; }
template <int J> __device__ __forceinline__ void bstage16(unsigned* a) {
#pragma unroll
    for (int i = 0; i < 16; ++i) { const int l = i ^ J; if (l > i) ce_desc(a[i], a[l]); }
}
__device__ __forceinline__ void sort16_desc(unsigned* a) {
#define CE_(i, j) ce_desc(a[i], a[j]);
    CE_(0, 13) CE_(1, 12) CE_(2, 15) CE_(3, 14) CE_(4, 8) CE_(5, 6) CE_(7, 11) CE_(9, 10)
    CE_(0, 5) CE_(1, 7) CE_(2, 9) CE_(3, 4) CE_(6, 13) CE_(8, 14) CE_(10, 15) CE_(11, 12)
    CE_(0, 1) CE_(2, 3) CE_(4, 5) CE_(6, 8) CE_(7, 9) CE_(10, 11) CE_(12, 13) CE_(14, 15)
    CE_(0, 2) CE_(1, 3) CE_(4, 10) CE_(5, 11) CE_(6, 7) CE_(8, 9) CE_(12, 14) CE_(13, 15)
    CE_(1, 2) CE_(3, 12) CE_(4, 6) CE_(5, 7) CE_(8, 10) CE_(9, 11) CE_(13, 14)
    CE_(1, 4) CE_(2, 6) CE_(5, 8) CE_(7, 10) CE_(9, 13) CE_(11, 14)
    CE_(2, 4) CE_(3, 6) CE_(9, 12) CE_(11, 13)
    CE_(3, 5) CE_(6, 8) CE_(7, 9) CE_(10, 12)
    CE_(3, 4) CE_(5, 6) CE_(7, 8) CE_(9, 10) CE_(11, 12)
    CE_(6, 7) CE_(8, 9)
#undef CE_
}
__device__ __forceinline__ void bmerge16_desc(unsigned* c) { bstage16<8>(c); bstage16<4>(c); bstage16<2>(c); bstage16<1>(c); }
__device__ __forceinline__ void merge_top16(unsigned* a, const unsigned* b) {
#pragma unroll
    for (int i = 0; i < 16; ++i) a[i] = fmax_u(a[i], b[15 - i]);
    bmerge16_desc(a);
}
__device__ __forceinline__ void xlane_top16(unsigned* t, int hi) {
    unsigned r[16]; const unsigned msk = 0u - (unsigned)hi;
#pragma unroll
    for (int i = 0; i < 16; ++i) r[i] = t[i] ^ ((t[i] ^ t[15 - i]) & msk);
#pragma unroll
    for (int i = 0; i < 16; ++i) { auto s = __builtin_amdgcn_permlane32_swap(r[i], r[i], false, false); t[i] = fmax_u(s[0], s[1]); }
    bmerge16_desc(t);
}
__device__ __forceinline__ constexpr int cand_a(int c) { return c < 16 ? 0 : c < 24 ? 1 : c < 32 ? 39 - c : c < 37 ? 2 : c < 41 ? 3 : c < 44 ? 4 : c < 46 ? 5 : c < 48 ? 6 : 7; }
__device__ __forceinline__ constexpr int cand_b(int c) { return c < 16 ? c : c < 24 ? c - 16 : c < 32 ? 0 : c < 37 ? c - 32 : c < 41 ? c - 37 : c < 44 ? c - 41 : c < 46 ? c - 44 : c < 48 ? c - 46 : c - 48; }

__device__ __forceinline__ void phase_p6b(LAS unsigned char* lds, const bf16_t* __restrict__ PQ, const bf16_t* __restrict__ SubKl, unsigned* __restrict__ EG, int nrows, int vb, int nvb) {
    int tid_ = threadIdx.x; asm volatile("" : "+v"(tid_));
    const int tid = tid_, lane = tid & 63, wid = __builtin_amdgcn_readfirstlane(tid >> 6), r32 = lane & 31, hi = lane >> 5;
    const int h = vb & 7, wrank = (vb >> 3) * 8 + wid, nwr = (nvb >> 3) * 8;
    LAS unsigned short* tab = (LAS unsigned short*)(lds + 65536 + wid * 4096) + r32 * 64;
#pragma unroll
    for (int i = 0; i < 8; ++i) { const int idx = i * 512 + tid, p = idx >> 11, key = (idx >> 4) & 127, ch = idx & 15;
        *(LAS u32x4*)(lds + p * 32768 + key * 256 + ((ch ^ (key & 15)) << 4)) = *(const u32x4*)(SubKl + ((size_t)(h * 2 + p) * 128 + key) * 128 + ch * 8); }
    __syncthreads();
    const int ngroups = nrows >> 5;
    for (int tg = wrank; tg < ngroups; tg += nwr) {
        const int row0 = tg << 5;
        bf16x8 qf[2][8];
        { const bf16_t* qp = PQ + (size_t)(row0 + r32) * 2048 + h * 256 + 8 * hi; asm volatile("" : "+v"(qp));
#pragma unroll
          for (int p = 0; p < 2; ++p)
#pragma unroll
              for (int s = 0; s < 8; ++s) qf[p][s] = *(const bf16x8*)(qp + p * 128 + 16 * s); }
        unsigned top[2][16];
#pragma unroll
        for (int p = 0; p < 2; ++p) {
            f32x16 acc[4];
#pragma unroll
            for (int kt = 0; kt < 4; ++kt) { acc[kt] = f32x16{}; const int key = 32 * kt + r32;
#pragma unroll
                for (int s = 0; s < 8; ++s) acc[kt] = mfma32(*(const LAS bf16x8*)(lds + p * 32768 + key * 256 + (((2 * s + hi) ^ (key & 15)) << 4)), qf[p][s], acc[kt]); }
            unsigned key[64];
#pragma unroll
            for (int kt = 0; kt < 4; ++kt)
#pragma unroll
                for (int r = 0; r < 16; ++r) { const int n = 32 * kt + (r & 3) + 8 * (r >> 2) + 4 * hi; key[16 * kt + r] = fkey(acc[kt][r], 127u - (unsigned)n, 127u); }
            sort16_desc(key); sort16_desc(key + 16); sort16_desc(key + 32); sort16_desc(key + 48);
            merge_top16(key, key + 16); merge_top16(key + 32, key + 48); merge_top16(key, key + 32);
            xlane_top16(key, hi);
#pragma unroll
            for (int i = 0; i < 16; ++i) top[p][i] = key[i];
        }
        float t0f[16], t1f[16];
#pragma unroll
        for (int i = 0; i < 16; ++i) { t0f[i] = keyf(top[0][i], 127u); t1f[i] = keyf(top[1][i], 127u); }
        unsigned ck[50];
#pragma unroll
        for (int c = 0; c < 50; ++c) ck[c] = fkey(t0f[cand_a(c)] + t1f[cand_b(c)], (unsigned)c, 63u);
        if (hi == 0) {
#pragma unroll
            for (int c = 0; c < 50; c += 2) {
                const unsigned ea = (127u - (top[0][cand_a(c)] & 127u)) * 128u + (127u - (top[1][cand_b(c)] & 127u));
                const unsigned eb = (127u - (top[0][cand_a(c + 1)] & 127u)) * 128u + (127u - (top[1][cand_b(c + 1)] & 127u));
                *(LAS unsigned*)(tab + c) = ea | (eb << 16);
            }
        }
        bmerge16_desc(ck + 16); sort16_desc(ck + 32);
        merge_top16(ck, ck + 16); merge_top16(ck, ck + 32);
        ck[15] = fmax_u(ck[15], ck[48]); ck[14] = fmax_u(ck[14], ck[49]); bmerge16_desc(ck);
        asm volatile("s_waitcnt lgkmcnt(0)" ::: "memory");
        const float mx = keyf(ck[0], 63u); float e[16], den = 0.f;
#pragma unroll
        for (int j = 0; j < 16; ++j) { e[j] = __builtin_amdgcn_exp2f((keyf(ck[j], 63u) - mx) * 1.4426950408889634f); den += e[j]; }
        const float iden = 1.f / den;
        if (hi == 0) {
            unsigned o[16];
#pragma unroll
            for (int j = 0; j < 16; ++j) { const unsigned eid = tab[ck[j] & 63u]; o[j] = (eid << 16) | (cvt_pk_bf16(e[j] * iden, 0.f) & 0xffffu); }
            unsigned* dst = EG + (size_t)(row0 + r32) * 128 + h * 16;
#pragma unroll
            for (int j = 0; j < 16; j += 4) *(u32x4*)(dst + j) = (u32x4){o[j], o[j + 1], o[j + 2], o[j + 3]};
        }
        asm volatile("s_waitcnt lgkmcnt(0)" ::: "memory");
    }
}


#define XB_TMO      128
#define XB_XCNT(j)  (256  + 64 * (j))
#define XB_XSUB(j)  (1280 + 64 * (j))
#define XB_XGEN(j)  (2304 + 64 * (j))
#define XB_TOP      3328
#define XB_TOPGEN   3392
#define XCD_BAR_WORDS 3456
#define XB_SPIN_CAP (1u << 18)

__device__ __forceinline__ unsigned xb_ld(unsigned* p)              { return __hip_atomic_load(p, __ATOMIC_RELAXED, __HIP_MEMORY_SCOPE_AGENT); }
__device__ __forceinline__ unsigned xb_add(unsigned* p, unsigned v) { return __hip_atomic_fetch_add(p, v, __ATOMIC_RELAXED, __HIP_MEMORY_SCOPE_AGENT); }
__device__ __forceinline__ unsigned xb_xcc_id() { return (unsigned)__builtin_amdgcn_s_getreg((3 << 11) | 20) & 0xFu; }
#define XB_SPIN(cond, bar) do { unsigned _sp = 0; while (cond) { __builtin_amdgcn_s_sleep(1); \
    if ((++_sp & 255u) == 0u) { if (xb_ld(&(bar)[XB_TMO])) break; if (_sp > XB_SPIN_CAP) { atomicAdd(&(bar)[XB_TMO], 1u); break; } } } } while (0)

struct XcdBarrier {
    unsigned* bar; unsigned x;
    volatile LAS unsigned* st;
};

__device__ __forceinline__ XcdBarrier xcd_barrier_post(unsigned* bar, volatile LAS unsigned* st) {
    XcdBarrier b; b.bar = bar; b.x = xb_xcc_id(); b.st = st;
    if (threadIdx.x == 0) (void)xb_add(&bar[XB_XCNT(b.x)], 1u);
    return b;
}
__device__ __forceinline__ void xcd_barrier_complete(unsigned* bar, unsigned x, unsigned& nloc, unsigned& nx) {
    const unsigned G = gridDim.x * gridDim.y * gridDim.z;
    unsigned sum, cnt, mine, sp = 0u;
    for (;;) {
        sum = 0u; cnt = 0u; mine = 0u;
#pragma unroll
        for (unsigned j = 0; j < 16; ++j) { const unsigned c = xb_ld(&bar[XB_XCNT(j)]); sum += c; cnt += (c > 0u) ? 1u : 0u; mine = (j == x) ? c : mine; }
        if (sum == G) break;
        __builtin_amdgcn_s_sleep(1);
        if ((++sp & 255u) == 0u) { if (xb_ld(&bar[XB_TMO])) break; if (sp > XB_SPIN_CAP) { atomicAdd(&bar[XB_TMO], 1u); break; } }
    }
    nloc = mine > 0u ? mine : 1u; nx = cnt > 0u ? cnt : 1u;
}

__device__ __forceinline__ void xcd_barrier(const XcdBarrier& b) {
    asm volatile("s_waitcnt vmcnt(0)" ::: "memory");
    __syncthreads();
    if (threadIdx.x == 0) {
        unsigned* bar = b.bar;
        __builtin_amdgcn_s_waitcnt(0);
        unsigned nloc = b.st[0], nx = b.st[1];
        if (nloc == 0u) { xcd_barrier_complete(bar, b.x, nloc, nx); b.st[0] = nloc; b.st[1] = nx; }
        const unsigned old = xb_add(&bar[XB_XSUB(b.x)], 1u);
        const unsigned gen = old / nloc;
        if (old + 1u == (gen + 1u) * nloc) {
            __builtin_amdgcn_fence(__ATOMIC_RELEASE, "agent");
            asm volatile("s_waitcnt vmcnt(0)" ::: "memory");
            const unsigned og = xb_add(&bar[XB_TOP], 1u);
            const unsigned tg = og / nx;
            if (og + 1u == (tg + 1u) * nx) xb_add(&bar[XB_TOPGEN], 1u);
            else XB_SPIN(xb_ld(&bar[XB_TOPGEN]) == tg, bar);
            __builtin_amdgcn_fence(__ATOMIC_ACQUIRE, "agent");
            xb_add(&bar[XB_XGEN(b.x)], 1u);
            asm volatile("s_waitcnt vmcnt(0)" ::: "memory");
        } else {
            XB_SPIN(xb_ld(&bar[XB_XGEN(b.x)]) == gen, bar);
            __builtin_amdgcn_fence(__ATOMIC_ACQUIRE, "agent");
            asm volatile("s_waitcnt vmcnt(0)" ::: "memory");
        }
    }
    __syncthreads();
}

__device__ __forceinline__ void phase_mod(LAS unsigned char* lds, const Inputs& in, const WS& w, int vb) {
    if (vb >= 72) return;
    LAS float* sc = (LAS float*)lds;
    int tid_ = threadIdx.x; asm volatile("" : "+v"(tid_));
    const int tid = tid_, idx = vb * 512 + tid, rg = idx / 12288, ln = idx % 12288, l = ln / 6144, n = ln % 6144;
    float acc[11];
#pragma unroll
    for (int i = 0; i < 11; ++i) acc[i] = 0.f;
    const float* wp = in.ada_w + (size_t)l * 1024 * 6144 + n;
    for (int kc = 0; kc < 4; ++kc) {
        for (int i = tid; i < 33 * 256; i += 512) { const int r = i >> 8, k = kc * 256 + (i & 255); const float v = r < 32 ? in.c[(size_t)r * 1024 + k] : in.c_ctx[k]; sc[i] = v / (1.f + __expf(-v)); }
        __syncthreads();
        for (int k = 0; k < 256; ++k) { const float wv = wp[(size_t)(kc * 256 + k) * 6144];
#pragma unroll
            for (int i = 0; i < 11; ++i) acc[i] += sc[(rg * 11 + i) * 256 + k] * wv; }
        __syncthreads();
    }
    const float bias = in.ada_b[(size_t)l * 6144 + n];
#pragma unroll
    for (int i = 0; i < 11; ++i) w.MOD()[((size_t)l * 33 + rg * 11 + i) * 6144 + n] = acc[i] + bias;
}
__device__ __forceinline__ void phase_rope(const WS& w, int vb, int nvb) {
    int tid_ = threadIdx.x; asm volatile("" : "+v"(tid_));
    for (int i = vb * 512 + tid_; i < 2048 * 32; i += nvb * 512) {
        { const int t = i / 32, j = i % 32; const double inv = pow(10000.0, -(double)(j % 16) / 16.0); const double a = (double)(j < 16 ? t / 64 : t % 64) * inv; w.ROPA()[i] = make_float2((float)cos(a), (float)sin(a)); }
        if (i < 2048 * 16) { const int t = i / 16, j = i % 16; const double inv = pow(10000.0, -(double)(j % 8) / 8.0); const double a = (double)(j < 8 ? t / 64 : t % 64) * inv; w.ROPC()[i] = make_float2((float)cos(a), (float)sin(a)); }
    }
}

#ifndef PROBE_MASK
#define PROBE_MASK 0
#endif
#ifndef BENCH_MODE
#define BENCH_MODE 0
#endif
#if BENCH_MODE
__device__ __forceinline__ void phase_bench(float* sink) {
    int tid_ = threadIdx.x; asm volatile("" : "+v"(tid_));
    float x[16];
#pragma unroll
    for (int i = 0; i < 16; ++i) x[i] = (float)(tid_ + i) * 0.001f;
    f32x16 acc[4] = {};
    bf16x8 a = (bf16x8){(short)tid_, 1, 2, 3, 4, 5, 6, 7}, b = (bf16x8){7, 6, 5, 4, 3, 2, 1, (short)tid_};
#pragma nounroll
    for (int it = 0; it < ((BENCH_MODE & 7) ? 2048 : 0); ++it) {
#pragma unroll
        for (int k = 0; k < 8; ++k) {
            if (BENCH_MODE & 2) { acc[k & 3] = mfma32(a, b, acc[k & 3]); }
            __builtin_amdgcn_sched_barrier(0);
            if (BENCH_MODE & 1) { asm volatile("v_exp_f32 %0, -|%0|" : "+v"(x[2 * k])); asm volatile("v_exp_f32 %0, -|%0|" : "+v"(x[2 * k + 1])); }
            if (BENCH_MODE & 4) {
#pragma unroll
                for (int j = 0; j < 8; ++j) asm volatile("v_fma_f32 %0, %0, %0, %0" : "+v"(x[(2 * k + j) & 15]));
            }
            __builtin_amdgcn_sched_barrier(0);
        }
    }
    if (BENCH_MODE & 24) {
        const int lane = tid_ & 63, r32 = lane & 31, hi = lane >> 5;
        unsigned ka[2][4];
#pragma unroll
        for (int kt = 0; kt < 2; ++kt)
#pragma unroll
            for (int s_ = 0; s_ < 4; ++s_) { const int key = 32 * kt + r32; ka[kt][s_] = key * 128 + (((2 * s_ + hi) ^ ((key >> 1) & 7)) << 4); }
        const int vq = (lane & 15) >> 2, vp = lane & 3, vg = (lane >> 4) & 1;
        unsigned va[2];
#pragma unroll
        for (int dvb = 0; dvb < 2; ++dvb) { const int key = 4 * hi + vq; va[dvb] = 8192 + key * 128 + ((((32 * dvb + 16 * vg + 4 * vp) * 2)) ^ (((key >> 1) & 1) << 6)); }
        u32x4 kr[8]; u32x2 vr[16];
#pragma nounroll
        for (int it = 0; it < 2048; ++it) {
            if (BENCH_MODE & 8) {
#pragma unroll
                for (int kt = 0; kt < 2; ++kt)
#pragma unroll
                    for (int s_ = 0; s_ < 4; ++s_) asm volatile("ds_read_b128 %0, %1" : "=v"(kr[kt * 4 + s_]) : "v"(ka[kt][s_]));
            }
            if (BENCH_MODE & 16) {
#pragma unroll
                for (int q = 0; q < 4; ++q)
#pragma unroll
                    for (int dvb = 0; dvb < 2; ++dvb) { asm volatile("ds_read_b64_tr_b16 %0, %1" : "=v"(vr[q * 4 + dvb * 2]) : "v"(va[dvb] + q * 2048)); asm volatile("ds_read_b64_tr_b16 %0, %1 offset:1024" : "=v"(vr[q * 4 + dvb * 2 + 1]) : "v"(va[dvb] + q * 2048)); }
            }
            asm volatile("s_waitcnt lgkmcnt(0)" ::: "memory");
        }
        if (BENCH_MODE & 8) {
#pragma unroll
            for (int i = 0; i < 8; ++i) x[i] += __uint_as_float(kr[i][0] ^ kr[i][1] ^ kr[i][2] ^ kr[i][3]);
        }
        if (BENCH_MODE & 16) {
#pragma unroll
            for (int i = 0; i < 16; ++i) x[i] += __uint_as_float(vr[i][0] ^ vr[i][1]);
        }
    }
    float r = 0.f;
#pragma unroll
    for (int i = 0; i < 16; ++i) r += x[i];
#pragma unroll
    for (int k = 0; k < 4; ++k)
#pragma unroll
        for (int i = 0; i < 16; ++i) r += acc[k][i];
    if (r == 1.2345e30f) sink[tid_] = r;
}
#endif
struct MegaArgs { Inputs in; WS w; float* XL; unsigned* bar; };
constexpr int MEGA_LDS = 131072 + 16;
__global__ void __launch_bounds__(512, 2) k_mega(MegaArgs A) {
    LAS unsigned char* lds = (LAS unsigned char*)dyn_lds;
    const int vb = blockIdx.x, nvb = gridDim.x;
    volatile LAS unsigned* xbw = (volatile LAS unsigned*)(lds + 131072);
    if (threadIdx.x == 0) { xbw[0] = 0u; xbw[1] = 0u; xbw[2] = 0u; xbw[3] = 0u; }
    __syncthreads();
    XcdBarrier bar = xcd_barrier_post(A.bar, xbw);
    if (threadIdx.x == 0) xbw[2] = xb_add(&A.bar[3584 + 64 * bar.x], 1u);
    __syncthreads();
    const int xticket = __builtin_amdgcn_readfirstlane((int)xbw[2]);
    const WS& w = A.w; const Inputs& in = A.in;
    phase_mod(lds, in, w, vb);
    phase_rope(w, vb, nvb);
    phase_cvt(lds, in, w, vb, nvb);
    xcd_barrier(bar);
    phase_modulate<false>(in.x, in.ctx, nullptr, w.H(), in.norm1_g, w.MOD(), 0, NR, vb, nvb);
    xcd_barrier(bar);
#if (PROBE_MASK >> 0) & 1
    phase_mod(lds, in, w, vb);
    phase_rope(w, vb, nvb);
    phase_cvt(lds, in, w, vb, nvb);
    xcd_barrier(bar);
    phase_modulate<false>(in.x, in.ctx, nullptr, w.H(), in.norm1_g, w.MOD(), 0, NR, vb, nvb);
    xcd_barrier(bar);
#endif
#if BENCH_MODE
    phase_bench((float*)w.RSQ());
#endif
    int xpart = vb & 7, xrank = vb >> 3;
    { bool okx = (bar.x < 8u); for (unsigned j = 0; j < 8; ++j) okx = okx && (xb_ld(&A.bar[XB_XCNT(j)]) == (unsigned)(nvb >> 3));
      if (okx) { xpart = (int)bar.x; xrank = xticket; } }
    for (int l = 0; l < DEPTH; ++l) {
        const float* MODl = w.MOD() + (size_t)l * 33 * 6144;
        const bool last = (l == DEPTH - 1);
        const int MR = last ? NL : NR;
        phase_p1(lds, w, in, l, vb, nvb); xcd_barrier(bar);
#if (PROBE_MASK >> 1) & 1
        phase_p1(lds, w, in, l, vb, nvb); xcd_barrier(bar);
#endif
        phase_p2(lds, w, in, l, vb, nvb); xcd_barrier(bar);
#if (PROBE_MASK >> 12) & 7
        phase_p2(lds, w, in, l, vb, nvb, (PROBE_MASK >> 12) & 7); xcd_barrier(bar);
#endif
        phase_p3(lds, w, l, vb, nvb, xpart, xrank); xcd_barrier(bar);
#if (PROBE_MASK >> 3) & 1
        phase_p3(lds, w, l, vb, nvb, xpart, xrank); xcd_barrier(bar);
#endif
        phase_p4(lds, w, in, l, vb, nvb);
        xcd_barrier(bar);
#if (PROBE_MASK >> 4) & 1
        phase_p4(lds, w, in, l, vb, nvb);
        xcd_barrier(bar);
#endif
        if (l == 0) phase_modulate<false>(in.x, in.ctx, nullptr, w.H(), in.norm2_g + l * 1024, MODl, 3, MR, vb, nvb, w.H8(), w.HS(), w.PQ(), w.XB());
        else phase_modulate<true>(nullptr, nullptr, w.XB(), w.H(), in.norm2_g + l * 1024, MODl, 3, MR, vb, nvb, w.H8(), w.HS(), w.PQ(), w.XB());
        xcd_barrier(bar);
#if (PROBE_MASK >> 5) & 1
        phase_modulate<true>(nullptr, nullptr, w.XB(), w.H(), in.norm2_g + l * 1024, MODl, 3, MR, vb, nvb, w.H8(), w.HS()); xcd_barrier(bar);
#endif
        phase_p6a(lds, w, l, vb, nvb); xcd_barrier(bar);
#if (PROBE_MASK >> 6) & 1
        phase_p6a(lds, w, l, vb, nvb); xcd_barrier(bar);
#endif
        phase_p6b(lds, w.PQ(), w.SubK() + (size_t)l * 16 * 128 * 128, w.EG(), MR, vb, nvb); xcd_barrier(bar);
#if (PROBE_MASK >> 7) & 1
        phase_p6b(lds, w.PQ(), w.SubK() + (size_t)l * 16 * 128 * 128, w.EG(), MR, vb, nvb); xcd_barrier(bar);
#endif
        { P7CArgs a{w.H8(), w.EG(), w.U8() + (size_t)l * NE * 512, (int*)w.PQ(), MR}; phase_p7c(lds, a, xpart, xrank, nvb); }
        xcd_barrier(bar);
#if (PROBE_MASK >> 8) & 1
        { P7CArgs a{w.H8(), w.EG(), w.U8() + (size_t)l * NE * 512, (int*)w.PQ(), MR}; phase_p7c(lds, a, xpart, xrank, nvb); }
        xcd_barrier(bar);
#endif
        phase_p7d((const int*)w.PQ(), w.EG(), w.US() + (size_t)l * NE, w.VS() + (size_t)l * NE, w.HS(), w.WE(), MR, vb, nvb);
        xcd_barrier(bar);
#if (PROBE_MASK >> 9) & 1
        phase_p7d((const int*)w.PQ(), w.EG(), w.US() + (size_t)l * NE, w.VS() + (size_t)l * NE, w.HS(), w.WE(), MR, vb, nvb);
        xcd_barrier(bar);
#endif
        { P7BArgs a{w.WE(), w.V8() + (size_t)l * NE * 1024, w.XB(), MODl + 5 * 1024, MR}; phase_p7b<0>(lds, a, xpart, xrank, nvb); }
        xcd_barrier(bar);
#if (PROBE_MASK >> 10) & 3
        { P7BArgs a{w.WE(), w.V8() + (size_t)l * NE * 1024, w.XB(), MODl + 5 * 1024, MR}; phase_p7b<((PROBE_MASK >> 10) & 3)>(lds, a, xpart, xrank, nvb); }
        xcd_barrier(bar);
#endif
        if (last) phase_final_norm(w.XB(), A.XL, in.final_g, vb, nvb);
        else phase_modulate<true>(nullptr, nullptr, w.XB(), w.H(), in.norm1_g + (l + 1) * 1024, w.MOD() + (size_t)(l + 1) * 33 * 6144, 0, NR, vb, nvb);
        if (!last) xcd_barrier(bar);
    }
}

extern "C" void kernel_launch(void* const* d_in, const int* in_sizes, int n_in, void* d_out, int out_size, void* d_ws, size_t ws_size, hipStream_t stream) {
    const float* const* fin = (const float* const*)d_in;
    Inputs in{fin[0], fin[1], fin[2], fin[3], fin[4], fin[5], fin[6], fin[7], fin[8], fin[9], fin[10], fin[11], fin[12], fin[13], fin[14], fin[15], fin[16], fin[17], fin[18], fin[19], fin[20], fin[21], fin[22]};
    WS w = make_ws(d_ws);
    static int ok = 0;
    if (!ok) {
        if (hipFuncSetAttribute((const void*)k_mega, hipFuncAttributeMaxDynamicSharedMemorySize, MEGA_LDS) != hipSuccess) { ok = -1; }
        int per_cu = 0, cus = 0, dev = 0; (void)hipGetDevice(&dev); (void)hipDeviceGetAttribute(&cus, hipDeviceAttributeMultiprocessorCount, dev);
        if (hipOccupancyMaxActiveBlocksPerMultiprocessor(&per_cu, (const void*)k_mega, 512, MEGA_LDS) != hipSuccess || per_cu < 1 || cus < 256) ok = -1;
        if (ok == 0) ok = 1;
    }
    if (ok < 0) return;
    (void)hipMemsetAsync(d_ws, 0, 16384, stream);
    MegaArgs A{in, w, (float*)d_out, (unsigned*)d_ws};
    k_mega<<<256, 512, MEGA_LDS, stream>>>(A);
}
```

```cpp
#include <hip/hip_runtime.h>
#include <stdint.h>

typedef unsigned short bf16_t;

constexpr int D = 1024, NB = 32, S = 2048, CTX = 256, DEPTH = 2;
constexpr int NL = NB * S, NC = NB * CTX, NR = NL + NC;
constexpr int KEYS = CTX + S;
constexpr int INC = 1568;
constexpr int NE = 16384;
constexpr float EPS = 1e-6f;

__device__ __forceinline__ float bf2f(bf16_t v) { return __uint_as_float(((unsigned)v) << 16); }
__device__ __forceinline__ bf16_t f2bf(float f) { unsigned u = __float_as_uint(f); u += 0x7FFFu + ((u >> 16) & 1u); return (bf16_t)(u >> 16); }

__device__ __forceinline__ float wave_sum(float v) {
#pragma unroll
    for (int o = 32; o > 0; o >>= 1) v += __shfl_xor(v, o);
    return v;
}
__device__ __forceinline__ float gelu_tanh(float x) {
    const float u = 0.7978845608028654f * (x + 0.044715f * x * x * x);
    return 0.5f * x * (1.f + tanhf(u));
}

struct WS {
    char* base;
    __host__ __device__ __forceinline__ bf16_t* H() const { return (bf16_t*)(base + 65536ull); }
    __host__ __device__ __forceinline__ bf16_t* Qg() const { return (bf16_t*)(base + 151060480ull); }
    __host__ __device__ __forceinline__ bf16_t* Qgc() const { return (bf16_t*)(base + 201392128ull); }
    __host__ __device__ __forceinline__ bf16_t* Kg() const { return (bf16_t*)(base + 207683584ull); }
    __host__ __device__ __forceinline__ bf16_t* Vg() const { return (bf16_t*)(base + 226557952ull); }
    __host__ __device__ __forceinline__ bf16_t* CQ() const { return (bf16_t*)(base + 245432320ull); }
    __host__ __device__ __forceinline__ bf16_t* CKV() const { return (bf16_t*)(base + 302055424ull); }
    __host__ __device__ __forceinline__ bf16_t* Bp() const { return (bf16_t*)(base + 339804160ull); }
    __host__ __device__ __forceinline__ bf16_t* KR() const { return (bf16_t*)(base + 377552896ull); }
    __host__ __device__ __forceinline__ bf16_t* Qm() const { return (bf16_t*)(base + 382271488ull); }
    __host__ __device__ __forceinline__ bf16_t* Qmc() const { return (bf16_t*)(base + 457768960ull); }
    __host__ __device__ __forceinline__ bf16_t* Kmn() const { return (bf16_t*)(base + 467206144ull); }
    __host__ __device__ __forceinline__ bf16_t* Vm() const { return (bf16_t*)(base + 523829248ull); }
    __host__ __device__ __forceinline__ unsigned* EG() const { return (unsigned*)(base + 580452352ull); }
    __host__ __device__ __forceinline__ bf16_t* P() const { return (bf16_t*)(base + 382271488ull); }
    __host__ __device__ __forceinline__ bf16_t* PQ() const { return (bf16_t*)(base + 151060480ull); }
    __host__ __device__ __forceinline__ bf16_t* TMP() const { return (bf16_t*)(base + 65536ull); }
    __host__ __device__ __forceinline__ float* XC() const { return (float*)(base + 618201088ull); }
    __host__ __device__ __forceinline__ float* MOD() const { return (float*)(base + 651755520ull); }
    __host__ __device__ __forceinline__ float2* ROPA() const { return (float2*)(base + 653377536ull); }
    __host__ __device__ __forceinline__ float2* ROPC() const { return (float2*)(base + 653901824ull); }
    __host__ __device__ __forceinline__ float* RSQ() const { return (float*)(base + 654163968ull); }
    __host__ __device__ __forceinline__ float* RSKV() const { return (float*)(base + 654458880ull); }
    __host__ __device__ __forceinline__ bf16_t* WinT() const { return (bf16_t*)(base + 654753792ull); }
    __host__ __device__ __forceinline__ bf16_t* WuqT() const { return (bf16_t*)(base + 662093824ull); }
    __host__ __device__ __forceinline__ bf16_t* WukvT() const { return (bf16_t*)(base + 663273472ull); }
    __host__ __device__ __forceinline__ bf16_t* WoutT() const { return (bf16_t*)(base + 664059904ull); }
    __host__ __device__ __forceinline__ bf16_t* WqT() const { return (bf16_t*)(base + 668254208ull); }
    __host__ __device__ __forceinline__ bf16_t* SubK() const { return (bf16_t*)(base + 676642816ull); }
    __host__ __device__ __forceinline__ unsigned char* U8() const { return (unsigned char*)(base + 677691392ull); }
    __host__ __device__ __forceinline__ unsigned char* V8() const { return (unsigned char*)(base + 711245824ull); }
    __host__ __device__ __forceinline__ float* US() const { return (float*)(base + 744800256ull); }
    __host__ __device__ __forceinline__ float* VS() const { return (float*)(base + 744931328ull); }
    __host__ __device__ __forceinline__ float* SSQ() const { return (float*)(base + 745062400ull); }
    __host__ __device__ __forceinline__ float* SSKV() const { return (float*)(base + 747421696ull); }
    __host__ __device__ __forceinline__ unsigned* WE() const { return (unsigned*)(base + 748601344ull); }
    __host__ __device__ __forceinline__ signed char* H8() const { return (signed char*)(base + 786350080ull); }
    __host__ __device__ __forceinline__ float* HS() const { return (float*)(base + 861847552ull); }
    __host__ __device__ __forceinline__ bf16_t* PoolWT() const { return (bf16_t*)(base + 862142464ull); }
    __host__ __device__ __forceinline__ bf16_t* XB() const { return (bf16_t*)(base + 862208000ull); }
};
constexpr size_t WS_BYTES = 862208000ull + (size_t)NR * 1024 * 2;
static WS make_ws(void* d_ws) { WS w; w.base = (char*)d_ws; return w; }


#define LAS __attribute__((address_space(3)))
typedef short bf16x8 __attribute__((ext_vector_type(8)));
typedef float f32x4 __attribute__((ext_vector_type(4)));
typedef float f32x16 __attribute__((ext_vector_type(16)));
typedef unsigned u32x4 __attribute__((ext_vector_type(4)));
typedef unsigned u32x2 __attribute__((ext_vector_type(2)));

__device__ __forceinline__ f32x16 mfma32(bf16x8 a, bf16x8 b, f32x16 c) { return __builtin_amdgcn_mfma_f32_32x32x16_bf16(a, b, c, 0, 0, 0); }
__device__ __forceinline__ unsigned cvt_pk_bf16(float lo, float hi) { unsigned r; asm volatile("v_cvt_pk_bf16_f32 %0, %1, %2" : "=v"(r) : "v"(lo), "v"(hi)); return r; }

namespace pg8 {
constexpr int BM = 256, BK = 64, HALF = 128, HTB = HALF * BK * 2, STAGE_BYTES = 8 * HTB, NXCD = 8, WGM = 8;
__host__ __device__ __forceinline__ int lds_byte(int r, int c) { const int st = (r >> 4) * 2 + (c >> 5), rr = r & 15, cc = c & 31, ob = rr * 64 + cc * 2; return st * 1024 + (ob ^ (((ob >> 9) & 1) << 5)); }
__host__ __device__ __forceinline__ void stage_rc(int b, int& R, int& C) { const int st = b / 1024, sb = b % 1024, swz = sb ^ (((sb >> 9) & 1) << 5); R = (st >> 1) * 16 + swz / 64; C = (st & 1) * 32 + (swz % 64) / 2; }
__host__ __device__ __forceinline__ int perm32(int rho) { const int n = rho >> 4, i = rho & 15; return 8 * (i >> 2) + 4 * n + (i & 3); }
struct Unit { int pm, pn; };
struct Gemm { const bf16_t* A; const bf16_t* Bt; int M, N, K; };
struct StaticOrder {
    int nM, nN, nwg, G, c;
    __host__ __device__ void init(int M, int N, int G_, int c_) { nM = M / BM; nN = N / BM; nwg = nM * nN; G = G_; c = c_; }
    __host__ __device__ bool next(int i, Unit& u) const {
        const long L = (long)i * G + c; if (L >= nwg) return false;
        int wgid = (int)L; { const int q = nwg / NXCD, r = nwg % NXCD, xcd = wgid % NXCD, off = wgid / NXCD; wgid = (xcd < r ? xcd * (q + 1) : r * (q + 1) + (xcd - r) * q) + off; }
        const int nig = WGM * nN, gid = wgid / nig, fm = gid * WGM, gsz = (nM - fm) < WGM ? (nM - fm) : WGM;
        u.pm = fm + ((wgid % nig) % gsz); u.pn = (wgid % nig) / gsz; return true;
    }
};
template <class Epi, class Sched>
__device__ __forceinline__ void gemm_phase(LAS unsigned char* lds, const Gemm g, const Sched& S, const Epi& E) {
    int tid_ = threadIdx.x; asm volatile("" : "+v"(tid_));
    const int tid = tid_, wid = __builtin_amdgcn_readfirstlane(tid >> 6), lane = tid & 63, wr = wid >> 2, wc = wid & 3, fr = lane & 15, fq = lane >> 4;
    const int K = g.K, nt = K / BK;
    unsigned voffA[2], voffB[2];
#pragma unroll
    for (int i = 0; i < 2; ++i) { int R, C; stage_rc(tid * 16 + i * 8192, R, C); const int Rb = Epi::PERM ? ((R & ~31) + perm32(R & 31)) : R;
        voffA[i] = (unsigned)(R * K + C) * 2u; voffB[i] = (unsigned)(Rb * K + C) * 2u; }
    const size_t kstep = (size_t)(BK * 2);
    const size_t hstep = (size_t)HALF * K * 2;
    const size_t tstep = 2 * hstep;
    const unsigned ldsw = (unsigned)wid * 1024u;
    const int aoff = lds_byte(wr * 64 + fr, fq * 8), boff = lds_byte(wc * 32 + fr, fq * 8);
#define PG8_SA(b, h) (((b) * 2 + (h)) * HTB)
#define PG8_SB(b, h) ((4 + (b) * 2 + (h)) * HTB)
#define PG8_STAGE(bufoff, gbase, voff) do { _Pragma("unroll") for (int _i = 0; _i < 2; ++_i) \
        __builtin_amdgcn_global_load_lds((const unsigned*)((const char*)(gbase) + (voff)[_i]), (LAS unsigned*)(lds + (bufoff) + ldsw + _i * 8192), 16, 0, 0); } while (0)
#define PG8_LDA(dst, b, h) do { _Pragma("unroll") for (int m = 0; m < 4; ++m) _Pragma("unroll") for (int k = 0; k < 2; ++k) dst[m][k] = *(const LAS bf16x8*)(lds + PG8_SA(b, h) + aoff + m * 2048 + k * 1024); } while (0)
#define PG8_LDB(dst, b, h) do { _Pragma("unroll") for (int n = 0; n < 2; ++n) _Pragma("unroll") for (int k = 0; k < 2; ++k) dst[n][k] = *(const LAS bf16x8*)(lds + PG8_SB(b, h) + boff + n * 2048 + k * 1024); } while (0)
#define PG8_MMA(ai, bj, At, Bt) do { __builtin_amdgcn_s_setprio(1); _Pragma("unroll") for (int m = 0; m < 4; ++m) _Pragma("unroll") for (int n = 0; n < 2; ++n) _Pragma("unroll") for (int k = 0; k < 2; ++k) \
        acc[ai][bj][m][n] = __builtin_amdgcn_mfma_f32_16x16x32_bf16(Bt[n][k], At[m][k], acc[ai][bj][m][n], 0, 0, 0); __builtin_amdgcn_s_setprio(0); } while (0)
#define PG8_WAIT_V(n) asm volatile("s_waitcnt vmcnt(" #n ")" ::: "memory")
#define PG8_WAIT_L(n) asm volatile("s_waitcnt lgkmcnt(" #n ")" ::: "memory")
#define PG8_BAR __builtin_amdgcn_s_barrier()
#define PG8_SCHED __builtin_amdgcn_sched_barrier(0)
    Unit cur, nxt; int ui = 0;
    if (!S.next(0, cur)) return;
    f32x4 acc[2][2][4][2];
#pragma unroll
    for (int a = 0; a < 2; ++a)
#pragma unroll
        for (int b = 0; b < 2; ++b)
#pragma unroll
            for (int m = 0; m < 4; ++m)
#pragma unroll
                for (int n = 0; n < 2; ++n) acc[a][b][m][n] = (f32x4){0.f, 0.f, 0.f, 0.f};
    bf16x8 At[4][2], B0[2][2], B1[2][2];
    const char* cA = (const char*)g.A + (size_t)cur.pm * tstep; const char* cB = (const char*)g.Bt + (size_t)cur.pn * tstep;
    PG8_STAGE(PG8_SB(0, 0), cB, voffB); PG8_STAGE(PG8_SA(0, 0), cA, voffA); PG8_STAGE(PG8_SB(0, 1), cB + hstep, voffB); PG8_STAGE(PG8_SA(0, 1), cA + hstep, voffA);
    if (wr == 1) PG8_BAR;
    PG8_WAIT_V(4); PG8_BAR;
    PG8_STAGE(PG8_SB(1, 0), cB + kstep, voffB); PG8_STAGE(PG8_SA(1, 0), cA + kstep, voffA); PG8_STAGE(PG8_SB(1, 1), cB + hstep + kstep, voffB);
    PG8_WAIT_V(6); PG8_BAR;
    for (;;) {
        const bool has_next = S.next(ui + 1, nxt);
        const char* nA = has_next ? (const char*)g.A + (size_t)nxt.pm * tstep : cA; const char* nB = has_next ? (const char*)g.Bt + (size_t)nxt.pn * tstep : cB;
#pragma nounroll
        for (int t = 0; t < nt; t += 2) {
            const bool last = (t == nt - 2);
            const char* a1 = cA + (size_t)(t + 1) * kstep;
            const char* a2 = last ? nA : cA + (size_t)(t + 2) * kstep; const char* b2 = last ? nB : cB + (size_t)(t + 2) * kstep;
            const char* a3 = a2 + kstep; const char* b3 = b2 + kstep;
            PG8_LDB(B0, 0, 0); PG8_SCHED; PG8_LDA(At, 0, 0); PG8_STAGE(PG8_SA(1, 1), a1 + hstep, voffA);
            PG8_WAIT_L(8); PG8_BAR; PG8_WAIT_L(0); PG8_MMA(0, 0, At, B0); PG8_BAR; PG8_SCHED;
            PG8_LDB(B1, 0, 1); PG8_STAGE(PG8_SB(0, 0), b2, voffB);
            PG8_BAR; PG8_WAIT_L(0); PG8_MMA(0, 1, At, B1); PG8_BAR;
            PG8_LDA(At, 0, 1); PG8_STAGE(PG8_SA(0, 0), a2, voffA);
            PG8_BAR; PG8_WAIT_L(0); PG8_MMA(1, 0, At, B0); PG8_BAR; PG8_SCHED;
            PG8_STAGE(PG8_SB(0, 1), b2 + hstep, voffB);
            PG8_WAIT_V(6); PG8_BAR; PG8_MMA(1, 1, At, B1); PG8_BAR;
            PG8_LDB(B0, 1, 0); PG8_SCHED; PG8_LDA(At, 1, 0); PG8_STAGE(PG8_SA(0, 1), a2 + hstep, voffA);
            PG8_WAIT_L(8); PG8_BAR; PG8_WAIT_L(0); PG8_MMA(0, 0, At, B0); PG8_BAR; PG8_SCHED;
            PG8_LDB(B1, 1, 1); PG8_STAGE(PG8_SB(1, 0), b3, voffB);
            PG8_BAR; PG8_WAIT_L(0); PG8_MMA(0, 1, At, B1); PG8_BAR;
            PG8_LDA(At, 1, 1); PG8_STAGE(PG8_SA(1, 0), a3, voffA);
            PG8_BAR; PG8_WAIT_L(0); PG8_MMA(1, 0, At, B0); PG8_BAR; PG8_SCHED;
            PG8_STAGE(PG8_SB(1, 1), b3 + hstep, voffB);
            PG8_WAIT_V(6); PG8_BAR; PG8_MMA(1, 1, At, B1); PG8_BAR;
        }
        E(acc, cur, wr, wc, fr, fq);
        if (!has_next) break;
#pragma unroll
        for (int a = 0; a < 2; ++a)
#pragma unroll
            for (int b = 0; b < 2; ++b)
#pragma unroll
                for (int m = 0; m < 4; ++m)
#pragma unroll
                    for (int n = 0; n < 2; ++n) acc[a][b][m][n] = (f32x4){0.f, 0.f, 0.f, 0.f};
        cur = nxt; cA = nA; cB = nB; ++ui;
    }
    PG8_WAIT_V(0);
    if (wr == 0) PG8_BAR;
    PG8_BAR;
#undef PG8_SA
#undef PG8_SB
#undef PG8_STAGE
#undef PG8_LDA
#undef PG8_LDB
#undef PG8_MMA
#undef PG8_WAIT_V
#undef PG8_WAIT_L
#undef PG8_BAR
#undef PG8_SCHED
}
}

enum { GT_AQ = 0, GT_AK = 1, GT_AV = 2, GT_B = 3, GT_CQ = 4, GT_CKV = 5, GT_KR = 6, GT_PAD = 7 };
__host__ __device__ __forceinline__ void in_group(int g, int& type, int& sub) {
    if (g < 2) { type = GT_AK; sub = g; } else if (g < 4) { type = GT_AV; sub = g - 2; } else if (g < 8) { type = GT_CKV; sub = g - 4; }
    else if (g == 8) { type = GT_KR; sub = 0; } else if (g < 12) { type = GT_PAD; sub = 0; } else if (g < 18) { type = GT_AQ; sub = g - 12; }
    else if (g < 24) { type = GT_CQ; sub = g - 18; } else { type = GT_B; sub = g - 24; }
}
__device__ __forceinline__ int colmap(int mode, int r) {
    const int pn = r >> 8, ct = r & 255, bj = ct >> 7, wc = (ct >> 5) & 3, j = ct & 31, g = 4 * pn + wc, e = 32 * bj + j;
    if (mode == 0) {
        int type, sub; in_group(g, type, sub);
        switch (type) { case GT_AQ: return 64 * sub + e; case GT_AK: return 384 + 64 * sub + e; case GT_AV: return 512 + 64 * sub + e; case GT_B: return 640 + 64 * sub + e;
            case GT_CQ: return 896 + 64 * sub + e; case GT_CKV: return 1280 + 64 * sub + e; case GT_KR: return (j < 16) ? 1536 + 16 * bj + j : -1; default: return -1; }
    } else if (mode == 1) {
        if (g < 6) return 96 * g + e; if (g < 9) { const int head = 2 * (g - 6) + (j >> 4); return 96 * head + 64 + 16 * bj + (j & 15); } return -1;
    } else if (mode == 2) {
        return 64 * g + e;
    }
    return r;
}
__device__ __forceinline__ void cvt_weights_unit(LAS float* tile  , const float* __restrict__ W, int K, int N, bf16_t* __restrict__ dst, int mode, const float* __restrict__ kgain, int r0, int k0) {
    int tid_ = threadIdx.x; asm volatile("" : "+v"(tid_));
    const int tid = tid_;
    const int jj = tid & 63; const int sc = colmap(mode, r0 + jj);
#pragma unroll
    for (int i = 0; i < 8; ++i) { const int kk = (tid >> 6) + 8 * i; float v = 0.f; if (sc >= 0) v = W[(size_t)(k0 + kk) * N + sc]; if (kgain) v *= kgain[k0 + kk]; tile[kk * 65 + jj] = v; }
    __syncthreads();
#pragma unroll
    for (int i = 0; i < 8; ++i) { const int rr = (tid >> 6) + 8 * i, kk = tid & 63; dst[(size_t)(r0 + rr) * K + k0 + kk] = f2bf(tile[kk * 65 + rr]); }
    __syncthreads();
}
struct CvtJob { const float* W; bf16_t* dst; const float* kgain; int K, N, Npad, mode; };
__device__ __forceinline__ void cvt_job(LAS float* tile, const CvtJob j, int vb, int nvb) {
    const int nk = j.K / 64, nr = j.Npad / 64;
    for (int u = vb; u < nk * nr; u += nvb) cvt_weights_unit(tile, j.W, j.K, j.N, j.dst, j.mode, j.kgain, (u / nk) * 64, (u % nk) * 64);
}
__device__ __forceinline__ void cvt_flat(const float* __restrict__ src, bf16_t* __restrict__ dst, size_t n, int vb, int nvb) {
    int tid_ = threadIdx.x; asm volatile("" : "+v"(tid_));
    for (size_t i = ((size_t)vb * 512 + tid_) * 8; i < n; i += (size_t)nvb * 512 * 8) {
        const float4 a = *(const float4*)(src + i), b = *(const float4*)(src + i + 4);
        u32x4 o; o.x = cvt_pk_bf16(a.x, a.y); o.y = cvt_pk_bf16(a.z, a.w); o.z = cvt_pk_bf16(b.x, b.y); o.w = cvt_pk_bf16(b.z, b.w);
        *(u32x4*)(dst + i) = o;
    }
}
template <bool FP8>
__device__ __forceinline__ void cvt_q8_rows(const float* __restrict__ src, unsigned char* __restrict__ dst, float* __restrict__ scales, int nrows, int vb, int nvb) {
    int tid_ = threadIdx.x; asm volatile("" : "+v"(tid_));
    const int lane = tid_ & 63, wid = tid_ >> 6;
    const int stride = nvb * 8;
    for (int row0 = vb * 8 + wid; row0 < nrows; row0 += 4 * stride) {
        f32x4 v[4][4];
#pragma unroll
        for (int q = 0; q < 4; ++q) { const int row = row0 + q * stride < nrows ? row0 + q * stride : row0; const float* sp = src + (size_t)row * 1024 + 16 * lane;
#pragma unroll
            for (int k = 0; k < 4; ++k) v[q][k] = *(const f32x4*)(sp + 4 * k); }
#pragma unroll
        for (int q = 0; q < 4; ++q) { const int row = row0 + q * stride; if (row < nrows) {
            float am = 0.f;
#pragma unroll
            for (int k = 0; k < 4; ++k) am = fmaxf(am, fmaxf(fmaxf(fabsf(v[q][k][0]), fabsf(v[q][k][1])), fmaxf(fabsf(v[q][k][2]), fabsf(v[q][k][3]))));
#pragma unroll
            for (int o = 32; o > 0; o >>= 1) am = fmaxf(am, __shfl_xor(am, o));
            const float qmax = FP8 ? 416.f : 127.f;
            const float sc = am > 0.f ? am / qmax : 1.f, inv = am > 0.f ? qmax / am : 0.f;
            u32x4 o4;
#pragma unroll
            for (int k = 0; k < 4; ++k) {
                if (FP8) { int p = __builtin_amdgcn_cvt_pk_fp8_f32(v[q][k][0] * inv, v[q][k][1] * inv, 0, false); p = __builtin_amdgcn_cvt_pk_fp8_f32(v[q][k][2] * inv, v[q][k][3] * inv, p, true); o4[k] = (unsigned)p; }
                else { const int q0 = (int)rintf(v[q][k][0] * inv), q1 = (int)rintf(v[q][k][1] * inv), q2 = (int)rintf(v[q][k][2] * inv), q3 = (int)rintf(v[q][k][3] * inv);
                    o4[k] = (unsigned)(q0 & 0xff) | ((unsigned)(q1 & 0xff) << 8) | ((unsigned)(q2 & 0xff) << 16) | ((unsigned)(q3 & 0xff) << 24); } }
            *(u32x4*)(dst + (size_t)row * 1024 + 16 * lane) = o4;
            if (lane == 0) scales[row] = sc; } }
    }
}
template <bool OFFS>
__device__ __forceinline__ void cvt_q4_rows(const float* __restrict__ src, unsigned char* __restrict__ dst, float* __restrict__ scales, int nrows, int vb, int nvb) {
    int tid_ = threadIdx.x; asm volatile("" : "+v"(tid_));
    const int lane = tid_ & 63, wid = tid_ >> 6;
    const int stride = nvb * 8;
    for (int row0 = vb * 8 + wid; row0 < nrows; row0 += 4 * stride) {
        f32x4 v[4][4];
#pragma unroll
        for (int q = 0; q < 4; ++q) { const int row = row0 + q * stride < nrows ? row0 + q * stride : row0; const float* sp = src + (size_t)row * 1024 + 16 * lane;
#pragma unroll
            for (int k = 0; k < 4; ++k) v[q][k] = *(const f32x4*)(sp + 4 * k); }
#pragma unroll
        for (int q = 0; q < 4; ++q) { const int row = row0 + q * stride; if (row < nrows) {
            float am = 0.f, ss = 0.f;
#pragma unroll
            for (int k = 0; k < 4; ++k) { am = fmaxf(am, fmaxf(fmaxf(fabsf(v[q][k][0]), fabsf(v[q][k][1])), fmaxf(fabsf(v[q][k][2]), fabsf(v[q][k][3]))));
                ss += v[q][k][0] * v[q][k][0] + v[q][k][1] * v[q][k][1] + v[q][k][2] * v[q][k][2] + v[q][k][3] * v[q][k][3]; }
#pragma unroll
            for (int o = 32; o > 0; o >>= 1) { am = fmaxf(am, __shfl_xor(am, o)); ss += __shfl_xor(ss, o); }
            const float st = fmaxf(0.36f * sqrtf(ss * (1.f / 1024.f)), am * (1.f / 12.f));
            const float sc = st > 0.f ? st : 1.f, inv = st > 0.f ? 1.f / st : 0.f;
            u32x2 o2;
#pragma unroll
            for (int d = 0; d < 2; ++d) { unsigned wd = 0u;
#pragma unroll
                for (int k = 0; k < 4; ++k) { const int qa = (int)fminf(fmaxf(rintf(v[q][2 * d][k] * inv), -7.f), 7.f), qb = (int)fminf(fmaxf(rintf(v[q][2 * d + 1][k] * inv), -7.f), 7.f); wd |= ((unsigned)((qa + (OFFS ? 8 : 0)) & 15) << (8 * k)) | ((unsigned)((qb + (OFFS ? 8 : 0)) & 15) << (8 * k + 4)); }
                o2[d] = wd; }
            *(u32x2*)(dst + (size_t)row * 512 + 8 * lane) = o2;
            if (lane == 0) scales[row] = OFFS ? sc * 512.f : sc; } }
    }
}
struct Inputs {
    const float *x, *c, *ctx, *c_ctx, *ada_w, *ada_b, *norm1_g, *norm2_g, *w_in, *gqa_qn_g, *gqa_kn_g, *pool_w, *pool_scale, *mla_qn_g, *mla_kvn_g, *mla_w_uq, *mla_w_ukv, *w_out, *peer_wq, *peer_subkeys, *peer_u, *peer_v, *final_g;
};
__device__ __forceinline__ void phase_cvt(LAS unsigned char* lds, const Inputs& in, const WS& w, int vb, int nvb) {
    LAS float* tile = (LAS float*)lds;
    for (int l = 0; l < 2; ++l) {
        cvt_job(tile, CvtJob{in.w_in + (size_t)l * 1024 * INC, w.WinT() + (size_t)l * 1792 * 1024, nullptr, 1024, INC, 1792, 0}, vb, nvb);
        cvt_job(tile, CvtJob{in.mla_w_uq + (size_t)l * 384 * 576, w.WuqT() + (size_t)l * 768 * 384, in.mla_qn_g + l * 384, 384, 576, 768, 1}, vb, nvb);
        cvt_job(tile, CvtJob{in.mla_w_ukv + (size_t)l * 256 * 768, w.WukvT() + (size_t)l * 768 * 256, in.mla_kvn_g + l * 256, 256, 768, 768, 2}, vb, nvb);
        cvt_job(tile, CvtJob{in.w_out + (size_t)l * 1024 * 1024, w.WoutT() + (size_t)l * 1024 * 1024, nullptr, 1024, 1024, 1024, 3}, vb, nvb);
        cvt_job(tile, CvtJob{in.peer_wq + (size_t)l * 1024 * 2048, w.WqT() + (size_t)l * 2048 * 1024, nullptr, 1024, 2048, 2048, 3}, vb, nvb);
    }
    cvt_flat(in.peer_subkeys, w.SubK(), (size_t)2 * 16 * 128 * 128, vb, nvb);
    { int tp_ = threadIdx.x; asm volatile("" : "+v"(tp_));
      for (int i = vb * 512 + tp_; i < 2 * 4 * 64 * 64; i += nvb * 512) { const int c = i & 63, d = (i >> 6) & 63, lg = i >> 12; w.PoolWT()[i] = f2bf(in.pool_w[(size_t)lg * 4096 + c * 64 + d]); } }
    if (nvb > 144) { if (vb >= 72) { cvt_q4_rows<false>(in.peer_u, w.U8(), w.US(), 2 * NE, vb - 72, nvb - 72); cvt_q4_rows<true>(in.peer_v, w.V8(), w.VS(), 2 * NE, vb - 72, nvb - 72); } }
    else { cvt_q4_rows<false>(in.peer_u, w.U8(), w.US(), 2 * NE, vb, nvb); cvt_q4_rows<true>(in.peer_v, w.V8(), w.VS(), 2 * NE, vb, nvb); }
}

constexpr float ATT_C2G = 0.125f * 1.4426950408889634f, ATT_C2M = 0.10206207261596577f * 1.4426950408889634f;
struct EpiIn {
    static constexpr bool PERM = true;
    WS w; const float* qn_g; const float* kn_g; int pm_base;
    __device__ __forceinline__ void operator()(const f32x4 (&acc)[2][2][4][2], const pg8::Unit& u, int wr, int wc, int fr, int fq) const {
        int type, sub; in_group(4 * u.pn + wc, type, sub);
        if (type == GT_PAD) return;
        const int pm = u.pm + pm_base; const bool isctx = pm >= 256; const int b = isctx ? pm - 256 : pm >> 3; const int t0 = isctx ? 0 : (pm & 7) * 256;
        const size_t rowbase = isctx ? (size_t)NL + (size_t)b * CTX : (size_t)b * S;
        const int keyoff = isctx ? 0 : CTX;
        float gain[2][8];
        if (type == GT_AQ) {
#pragma unroll
            for (int bj = 0; bj < 2; ++bj)
#pragma unroll
                for (int q = 0; q < 8; ++q) gain[bj][q] = qn_g[32 * bj + 8 * fq + q] * ATT_C2G;
        } else if (type == GT_AK) {
#pragma unroll
            for (int bj = 0; bj < 2; ++bj)
#pragma unroll
                for (int q = 0; q < 8; ++q) gain[bj][q] = kn_g[32 * bj + 8 * fq + q];
        }
#pragma unroll
        for (int ai = 0; ai < 2; ++ai)
#pragma unroll
            for (int m = 0; m < 4; ++m) {
                const int t = t0 + 128 * ai + 64 * wr + 16 * m + fr; const size_t row = rowbase + t;
                float v[2][8];
#pragma unroll
                for (int bj = 0; bj < 2; ++bj)
#pragma unroll
                    for (int n = 0; n < 2; ++n)
#pragma unroll
                        for (int i = 0; i < 4; ++i) v[bj][4 * n + i] = acc[ai][bj][m][n][i];
                bf16_t* dst = nullptr;
                if (type == GT_AQ || type == GT_AK) {
                    float ss = 0.f;
#pragma unroll
                    for (int bj = 0; bj < 2; ++bj)
#pragma unroll
                        for (int q = 0; q < 8; ++q) ss += v[bj][q] * v[bj][q];
                    ss += __shfl_xor(ss, 16); ss += __shfl_xor(ss, 32);
                    const float rstd = rsqrtf(ss * (1.f / 64.f) + EPS);
#pragma unroll
                    for (int q = 0; q < 8; ++q) { float x1 = v[0][q] * rstd * gain[0][q], x2 = v[1][q] * rstd * gain[1][q];
                        if (!isctx) { const float2 cs = w.ROPA()[t * 32 + 8 * fq + q]; const float y1 = x1 * cs.x - x2 * cs.y, y2 = x1 * cs.y + x2 * cs.x; x1 = y1; x2 = y2; }
                        v[0][q] = x1; v[1][q] = x2; }
                    if (type == GT_AQ) dst = isctx ? w.Qgc() + (((size_t)b * 6 + sub) * CTX + t) * 64 : w.Qg() + (((size_t)b * 6 + sub) * S + t) * 64;
                    else dst = w.Kg() + (((size_t)b * 2 + sub) * KEYS + keyoff + t) * 64;
                } else if (type == GT_AV) { dst = w.Vg() + (((size_t)b * 2 + sub) * KEYS + keyoff + t) * 64;
                } else if (type == GT_B) { dst = w.Bp() + row * 256 + 64 * sub;
                } else if (type == GT_CQ || type == GT_CKV) {
                    float ss = 0.f;
#pragma unroll
                    for (int bj = 0; bj < 2; ++bj)
#pragma unroll
                        for (int q = 0; q < 8; ++q) ss += v[bj][q] * v[bj][q];
                    ss += __shfl_xor(ss, 16); ss += __shfl_xor(ss, 32);
                    if (type == GT_CQ) { if (fq == 0) w.SSQ()[row * 8 + sub] = ss; dst = w.CQ() + row * 384 + 64 * sub; }
                    else { if (fq == 0) w.SSKV()[row * 4 + sub] = ss; dst = w.CKV() + row * 256 + 64 * sub; }
                } else {
                    if (!isctx) {
#pragma unroll
                        for (int q = 0; q < 8; ++q) { const float2 cs = w.ROPC()[t * 16 + ((8 * fq + q) & 15)]; const float x1 = v[0][q], x2 = v[1][q]; v[0][q] = x1 * cs.x - x2 * cs.y; v[1][q] = x1 * cs.y + x2 * cs.x; } }
                    if (fq < 2) { bf16_t* kd = w.KR() + ((size_t)b * KEYS + keyoff + t) * 32;
#pragma unroll
                        for (int bj = 0; bj < 2; ++bj) { u32x4 o; o.x = cvt_pk_bf16(v[bj][0], v[bj][1]); o.y = cvt_pk_bf16(v[bj][2], v[bj][3]); o.z = cvt_pk_bf16(v[bj][4], v[bj][5]); o.w = cvt_pk_bf16(v[bj][6], v[bj][7]);
                            *(u32x4*)(kd + 16 * bj + 8 * fq) = o; } }
                    continue;
                }
#pragma unroll
                for (int bj = 0; bj < 2; ++bj) { u32x4 o; o.x = cvt_pk_bf16(v[bj][0], v[bj][1]); o.y = cvt_pk_bf16(v[bj][2], v[bj][3]); o.z = cvt_pk_bf16(v[bj][4], v[bj][5]); o.w = cvt_pk_bf16(v[bj][6], v[bj][7]);
                    *(u32x4*)(dst + 32 * bj + 8 * fq) = o; }
            }
    }
};
struct P1Order {
    pg8::StaticOrder so; int nctx_tiles, G, c;
    __device__ bool next(int i, pg8::Unit& u) const {
        const int L = i * G + c;
        if (L < 1792) return so.next(i, u);
        const int Lc = L - 1792; if (Lc >= 32 * nctx_tiles) return false;
        u.pm = 256 + (Lc & 31); u.pn = Lc >> 5; return true;
    }
};
__device__ __forceinline__ void phase_p1(LAS unsigned char* lds, const WS& w, const Inputs& in, int l, int vb, int nvb) {
    EpiIn E{w, in.gqa_qn_g + l * 64, in.gqa_kn_g + l * 64, 0};
    P1Order po; po.so.init(NL, 1792, nvb, vb); po.nctx_tiles = (l == 0) ? 7 : 3; po.G = nvb; po.c = vb;
    pg8::gemm_phase(lds, pg8::Gemm{w.H(), w.WinT() + (size_t)l * 1792 * 1024, NR, 1792, 1024}, po, E);
}

extern __shared__ __attribute__((aligned(16))) unsigned char dyn_lds[];

struct EpiUq {
    static constexpr bool PERM = true;
    WS w;
    __device__ __forceinline__ void operator()(const f32x4 (&acc)[2][2][4][2], const pg8::Unit& u, int wr, int wc, int fr, int fq) const {
        const int g = 4 * u.pn + wc; if (g >= 9) return;
        const int pm = u.pm; const bool isctx = pm >= 256; const int b = isctx ? pm - 256 : pm >> 3; const int t0 = isctx ? 0 : (pm & 7) * 256;
        const size_t rowbase = isctx ? (size_t)NL + (size_t)b * CTX : (size_t)b * S;
        const int head = g < 6 ? g : 2 * (g - 6) + (fq >> 1);
#pragma unroll
        for (int ai = 0; ai < 2; ++ai)
#pragma unroll
            for (int m = 0; m < 4; ++m) {
                const int t = t0 + 128 * ai + 64 * wr + 16 * m + fr; const size_t row = rowbase + t;
                const float4 s0 = *(const float4*)(w.SSQ() + row * 8), s1 = *(const float4*)(w.SSQ() + row * 8 + 4);
                const float rstd = rsqrtf((s0.x + s0.y + s0.z + s0.w + s1.x + s1.y) * (1.f / 384.f) + EPS) * ATT_C2M;
                float v[2][8];
#pragma unroll
                for (int bj = 0; bj < 2; ++bj)
#pragma unroll
                    for (int n = 0; n < 2; ++n)
#pragma unroll
                        for (int i = 0; i < 4; ++i) v[bj][4 * n + i] = acc[ai][bj][m][n][i] * rstd;
                bf16_t* hd = isctx ? w.Qmc() + (((size_t)b * 6 + head) * CTX + t) * 96 : w.Qm() + (((size_t)b * 6 + head) * S + t) * 96;
                if (g >= 6 && !isctx) {
#pragma unroll
                    for (int q = 0; q < 8; ++q) { const float2 cs = w.ROPC()[t * 16 + 8 * (fq & 1) + q]; const float x1 = v[0][q], x2 = v[1][q]; v[0][q] = x1 * cs.x - x2 * cs.y; v[1][q] = x1 * cs.y + x2 * cs.x; } }
#pragma unroll
                for (int bj = 0; bj < 2; ++bj) { u32x4 o; o.x = cvt_pk_bf16(v[bj][0], v[bj][1]); o.y = cvt_pk_bf16(v[bj][2], v[bj][3]); o.z = cvt_pk_bf16(v[bj][4], v[bj][5]); o.w = cvt_pk_bf16(v[bj][6], v[bj][7]);
                    bf16_t* d = g < 6 ? hd + 32 * bj + 8 * fq : hd + 64 + 16 * bj + 8 * (fq & 1);
                    *(u32x4*)d = o; }
            }
    }
};
struct EpiUkv {
    static constexpr bool PERM = true;
    WS w;
    __device__ __forceinline__ void operator()(const f32x4 (&acc)[2][2][4][2], const pg8::Unit& u, int wr, int wc, int fr, int fq) const {
        const int g = 4 * u.pn + wc;
        const int pm = u.pm; const bool isctx = pm >= 256; const int b = isctx ? pm - 256 : pm >> 3; const int t0 = isctx ? 0 : (pm & 7) * 256;
        const size_t rowbase = isctx ? (size_t)NL + (size_t)b * CTX : (size_t)b * S; const int keyoff = isctx ? 0 : CTX;
        bf16_t* base = ((g & 1) ? w.Vm() : w.Kmn()) + ((size_t)b * 6 + (g >> 1)) * KEYS * 64;
#pragma unroll
        for (int ai = 0; ai < 2; ++ai)
#pragma unroll
            for (int m = 0; m < 4; ++m) {
                const int t = t0 + 128 * ai + 64 * wr + 16 * m + fr; const size_t row = rowbase + t;
                const float4 s0 = *(const float4*)(w.SSKV() + row * 4);
                const float rstd = rsqrtf((s0.x + s0.y + s0.z + s0.w) * (1.f / 256.f) + EPS);
                bf16_t* d = base + (size_t)(keyoff + t) * 64;
#pragma unroll
                for (int bj = 0; bj < 2; ++bj) { const f32x4 a0 = acc[ai][bj][m][0] * rstd, a1 = acc[ai][bj][m][1] * rstd;
                    u32x4 o; o.x = cvt_pk_bf16(a0[0], a0[1]); o.y = cvt_pk_bf16(a0[2], a0[3]); o.z = cvt_pk_bf16(a1[0], a1[1]); o.w = cvt_pk_bf16(a1[2], a1[3]);
                    *(u32x4*)(d + 32 * bj + 8 * fq) = o; }
            }
    }
};
constexpr int POOL_X = 0, POOL_P = 272 * 128, POOL_BYTES = 272 * 128 + 256 * 128;
template <int G>
__device__ __forceinline__ void pool_sums(LAS unsigned char* lds, int tid, int t0, int L) {
    constexpr int wdw = 2 << G, half = wdw >> 1, NX = 32 + wdw - 1;
    const int c = tid & 63, seg = tid >> 6; const LAS bf16_t* X = (const LAS bf16_t*)(lds + POOL_X) + c + (seg * 32 + 8 - half) * 64;
    const int tb = t0 + seg * 32;
    float xr[NX], xm[NX];
#pragma unroll
    for (int j = 0; j < NX; ++j) xr[j] = bf2f(X[j * 64]);
#pragma unroll
    for (int j = 0; j < NX; ++j) { const int row = tb - half + j; xm[j] = (row >= 0 && row < L) ? xr[j] : 0.f; }
    float sum = 0.f;
#pragma unroll
    for (int j = 0; j < wdw; ++j) sum += xm[j];
#pragma unroll
    for (int k = 0; k < 32; ++k) {
        const int t = tb + k; const int clo = (t - half) < 0 ? 0 : (t - half), chi = (t - half + wdw) > L ? L : (t - half + wdw);
        const float pv = sum / (float)(chi - clo) - xr[k + half];
        const int r = seg * 32 + k; *((LAS bf16_t*)(lds + POOL_P + r * 128 + (((c >> 3) ^ ((r >> 1) & 7)) << 4)) + (c & 7)) = f2bf(pv);
        if (k < 31) sum += xm[k + wdw] - xm[k];
    }
}
__device__ __forceinline__ void phase_pool(LAS unsigned char* lds, const WS& w, bf16_t* __restrict__ MIX, const bf16_t* __restrict__ WT  , const float* __restrict__ pool_scale, int nrows, int vb, int nvb) {
    int tid_ = threadIdx.x; asm volatile("" : "+v"(tid_));
    const int tid = tid_, lane = tid & 63, wid = __builtin_amdgcn_readfirstlane(tid >> 6), r32 = lane & 31, hi = lane >> 5;
    const int nunits = nrows >> 8;
    const int nmine = vb < nunits ? ((nunits - 1 - vb) / nvb + 1) * 4 : 0;
    u32x4 st[5];
#define POOL_FETCH(it_) do { const int u_ = vb + ((it_) >> 2) * nvb, g_ = (it_) & 3; const int row0_ = u_ << 8; const bool ic_ = row0_ >= NL; const int L_ = ic_ ? CTX : S; const int t0_ = ic_ ? 0 : (row0_ & (S - 1)); const int seq0_ = row0_ - t0_; \
        _Pragma("unroll") for (int k_ = 0; k_ < 5; ++k_) { int i_ = tid + 512 * k_; i_ = i_ < 272 * 8 ? i_ : 272 * 8 - 1; const int rr_ = i_ >> 3, ch_ = i_ & 7; int t_ = t0_ - 8 + rr_; t_ = t_ < 0 ? 0 : (t_ >= L_ ? L_ - 1 : t_); \
            st[k_] = *(const u32x4*)(w.Bp() + (size_t)(seq0_ + t_) * 256 + g_ * 64 + ch_ * 8); } } while (0)
    if (nmine > 0) POOL_FETCH(0);
    for (int it = 0; it < nmine; ++it) {
        const int u = vb + (it >> 2) * nvb, g = it & 3;
        const int row0 = u << 8; const bool isctx = row0 >= NL; const int L = isctx ? CTX : S; const int t0 = isctx ? 0 : (row0 & (S - 1));
        {
#pragma unroll
            for (int k = 0; k < 5; ++k) { const int i = tid + 512 * k; if (i < 272 * 8) *(LAS u32x4*)(lds + POOL_X + (i >> 3) * 128 + (i & 7) * 16) = st[k]; }
            { const int nx = it + 1 < nmine ? it + 1 : it; POOL_FETCH(nx); }
            __syncthreads();
            if (g == 0) pool_sums<0>(lds, tid, t0, L); else if (g == 1) pool_sums<1>(lds, tid, t0, L); else if (g == 2) pool_sums<2>(lds, tid, t0, L); else pool_sums<3>(lds, tid, t0, L);
            __syncthreads();
            { f32x16 o0 = {}, o1 = {};
              const bf16_t* wt = WT + (size_t)g * 4096 + (size_t)r32 * 64 + 8 * hi;
#pragma unroll
              for (int s = 0; s < 4; ++s) { const int row = wid * 32 + r32; const bf16x8 pf = *(const LAS bf16x8*)(lds + POOL_P + row * 128 + (((2 * s + hi) ^ ((row >> 1) & 7)) << 4));
                  o0 = mfma32(*(const bf16x8*)(wt + 16 * s), pf, o0); o1 = mfma32(*(const bf16x8*)(wt + 32 * 64 + 16 * s), pf, o1); }
              bf16_t* op = MIX + (size_t)(row0 + wid * 32 + r32) * 1024 + 384 + g * 64 + 4 * hi; const float* ps = pool_scale + g * 64 + 4 * hi;
#pragma unroll
              for (int q = 0; q < 4; ++q) { const f32x4 s0 = *(const f32x4*)(ps + 8 * q), s1 = *(const f32x4*)(ps + 32 + 8 * q); u32x2 a, b;
                  a.x = cvt_pk_bf16(o0[4 * q] * s0[0], o0[4 * q + 1] * s0[1]); a.y = cvt_pk_bf16(o0[4 * q + 2] * s0[2], o0[4 * q + 3] * s0[3]);
                  b.x = cvt_pk_bf16(o1[4 * q] * s1[0], o1[4 * q + 1] * s1[1]); b.y = cvt_pk_bf16(o1[4 * q + 2] * s1[2], o1[4 * q + 3] * s1[3]);
                  *(u32x2*)(op + 8 * q) = a; *(u32x2*)(op + 32 + 8 * q) = b; } }
            __syncthreads();
        }
    }
#undef POOL_FETCH
}
__device__ __forceinline__ void phase_p2(LAS unsigned char* lds, const WS& w, const Inputs& in, int l, int vb, int nvb, int parts = 7) {
    pg8::StaticOrder so;
    if (parts & 1) { EpiUq E{w}; const int M = l == 0 ? NR : NL; so.init(M, 768, nvb, vb); pg8::gemm_phase(lds, pg8::Gemm{w.CQ(), w.WuqT() + (size_t)l * 768 * 384, M, 768, 384}, so, E); }
    if (parts & 2) { EpiUkv E{w}; so.init(NR, 768, nvb, vb); pg8::gemm_phase(lds, pg8::Gemm{w.CKV(), w.WukvT() + (size_t)l * 768 * 256, NR, 768, 256}, so, E); }
    if (parts & 4) phase_pool(lds, w, w.H(), w.PoolWT() + (size_t)l * 4 * 64 * 64, in.pool_scale + l * 256, l == 0 ? NR : NL, vb, nvb);
}

struct EpiOut {
    static constexpr bool PERM = true;
    bf16_t* DLT; const float* gate;
    __device__ __forceinline__ void operator()(const f32x4 (&acc)[2][2][4][2], const pg8::Unit& u, int wr, int wc, int fr, int fq) const {
        const int pm = u.pm; const int mr = pm >= 256 ? 32 : pm >> 3;
        const size_t r0 = (size_t)pm * 256 + wr * 64 + fr; const int col0 = u.pn * 256 + wc * 32 + 8 * fq;
        f32x4 gv[2][2];
#pragma unroll
        for (int bj = 0; bj < 2; ++bj)
#pragma unroll
            for (int n = 0; n < 2; ++n) gv[bj][n] = *(const f32x4*)(gate + (size_t)mr * 6144 + col0 + bj * 128 + 4 * n);
#pragma unroll
        for (int ai = 0; ai < 2; ++ai)
#pragma unroll
            for (int m = 0; m < 4; ++m) { bf16_t* d = DLT + (r0 + ai * 128 + m * 16) * 1024 + col0;
#pragma unroll
                for (int bj = 0; bj < 2; ++bj) { const f32x4 a0 = acc[ai][bj][m][0] * gv[bj][0], a1 = acc[ai][bj][m][1] * gv[bj][1];
                    u32x4 o; o.x = cvt_pk_bf16(a0[0], a0[1]); o.y = cvt_pk_bf16(a0[2], a0[3]); o.z = cvt_pk_bf16(a1[0], a1[1]); o.w = cvt_pk_bf16(a1[2], a1[3]);
                    *(u32x4*)(d + bj * 128) = o; } }
    }
};
__device__ __forceinline__ void phase_p4(LAS unsigned char* lds, const WS& w, const Inputs& in, int l, int vb, int nvb) {
    const float* MODl = w.MOD() + (size_t)l * 33 * 6144;
    EpiOut E{w.PQ(), MODl + 2 * 1024};
    const int M = l == 0 ? NR : NL;
    pg8::StaticOrder so; so.init(M, 1024, nvb, vb);
    pg8::gemm_phase(lds, pg8::Gemm{w.H(), w.WoutT() + (size_t)l * 1024 * 1024, M, 1024, 1024}, so, E);
}

template <bool INBF>
__device__ __forceinline__ void phase_modulate(const float* __restrict__ XLp, const float* __restrict__ XCp, const bf16_t* __restrict__ XBp, bf16_t* __restrict__ Hout, const float* __restrict__ g, const float* __restrict__ MODl, int si, int nrows, int vb, int nvb,
                                               signed char* __restrict__ H8 = nullptr, float* __restrict__ HS = nullptr, const bf16_t* __restrict__ DLT = nullptr, bf16_t* __restrict__ XBo = nullptr) {
    int tid_ = threadIdx.x; asm volatile("" : "+v"(tid_));
    const int tid = tid_, lane = tid & 63, wid = tid >> 6;
    f32x4 gv[4];
#pragma unroll
    for (int i = 0; i < 4; ++i) gv[i] = *(const f32x4*)(g + 256 * i + 4 * lane);
    const int stride = nvb * 8, lastrow = nrows - 1;
    f32x4 nx[4]; u32x2 nxb[4], ndr[4];
#define PM_LOAD(r_) do { const int rr_ = (r_) < nrows ? (r_) : lastrow; const bool ic_ = rr_ >= NL; const float* xp_ = ic_ ? XCp + (size_t)(rr_ - NL) * 1024 : XLp + (size_t)rr_ * 1024; \
        _Pragma("unroll") for (int i = 0; i < 4; ++i) { if (INBF) nxb[i] = *(const u32x2*)(XBp + (size_t)rr_ * 1024 + 256 * i + 4 * lane); else nx[i] = *(const f32x4*)(xp_ + 256 * i + 4 * lane); \
            if (DLT) ndr[i] = *(const u32x2*)(DLT + (size_t)rr_ * 1024 + 256 * i + 4 * lane); } } while (0)
    PM_LOAD(vb * 8 + wid);
    for (int row = vb * 8 + wid; row < nrows; row += stride) {
        const bool isctx = row >= NL; const int mr = isctx ? 32 : row / S;
        f32x4 x[4]; u32x2 dr4[4]; float ss = 0.f;
#pragma unroll
        for (int i = 0; i < 4; ++i) { if (INBF) x[i] = (f32x4){__uint_as_float(nxb[i].x << 16), __uint_as_float(nxb[i].x & 0xffff0000u), __uint_as_float(nxb[i].y << 16), __uint_as_float(nxb[i].y & 0xffff0000u)}; else x[i] = nx[i];
            if (DLT) dr4[i] = ndr[i]; }
        PM_LOAD(row + stride);
#pragma unroll
        for (int i = 0; i < 4; ++i) {
            if (DLT) { const u32x2 dr = dr4[i];
                x[i][0] += __uint_as_float(dr.x << 16); x[i][1] += __uint_as_float(dr.x & 0xffff0000u); x[i][2] += __uint_as_float(dr.y << 16); x[i][3] += __uint_as_float(dr.y & 0xffff0000u);
                u32x2 xo; xo.x = cvt_pk_bf16(x[i][0], x[i][1]); xo.y = cvt_pk_bf16(x[i][2], x[i][3]); *(u32x2*)(XBo + (size_t)row * 1024 + 256 * i + 4 * lane) = xo; }
            ss += x[i][0] * x[i][0] + x[i][1] * x[i][1] + x[i][2] * x[i][2] + x[i][3] * x[i][3]; }
        ss = wave_sum(ss); const float rstd = rsqrtf(ss * (1.f / 1024.f) + EPS);
        const float* sh = MODl + (size_t)mr * 6144 + si * 1024;
        f32x4 y[4]; float am = 0.f;
#pragma unroll
        for (int i = 0; i < 4; ++i) { const f32x4 shv = *(const f32x4*)(sh + 256 * i + 4 * lane), scv = *(const f32x4*)(sh + 1024 + 256 * i + 4 * lane);
            y[i] = x[i] * rstd * gv[i] * (scv + 1.f) + shv;
            am = fmaxf(am, fmaxf(fmaxf(fabsf(y[i][0]), fabsf(y[i][1])), fmaxf(fabsf(y[i][2]), fabsf(y[i][3]))));
            u32x2 o; o.x = cvt_pk_bf16(y[i][0], y[i][1]); o.y = cvt_pk_bf16(y[i][2], y[i][3]);
            *(u32x2*)(Hout + (size_t)row * 1024 + 256 * i + 4 * lane) = o; }
        if (H8) {
#pragma unroll
            for (int o = 32; o > 0; o >>= 1) am = fmaxf(am, __shfl_xor(am, o));
            const float inv = am > 0.f ? 127.f / am : 0.f;
#pragma unroll
            for (int i = 0; i < 4; ++i) { const int q0 = (int)rintf(y[i][0] * inv), q1 = (int)rintf(y[i][1] * inv), q2 = (int)rintf(y[i][2] * inv), q3 = (int)rintf(y[i][3] * inv);
                *(unsigned*)(H8 + (size_t)row * 1024 + 256 * i + 4 * lane) = (unsigned)(q0 & 0xff) | ((unsigned)(q1 & 0xff) << 8) | ((unsigned)(q2 & 0xff) << 16) | ((unsigned)(q3 & 0xff) << 24); }
            if (lane == 0) HS[row] = am > 0.f ? am * (1.f / 127.f) : 1.f;
        }
    }
#undef PM_LOAD
}

struct EpiPQ {
    static constexpr bool PERM = true;
    bf16_t* PQ;
    __device__ __forceinline__ void operator()(const f32x4 (&acc)[2][2][4][2], const pg8::Unit& u, int wr, int wc, int fr, int fq) const {
        const size_t r0 = (size_t)u.pm * 256 + wr * 64 + fr; const int col0 = u.pn * 256 + wc * 32 + 8 * fq;
#pragma unroll
        for (int ai = 0; ai < 2; ++ai)
#pragma unroll
            for (int m = 0; m < 4; ++m) { bf16_t* d = PQ + (r0 + ai * 128 + m * 16) * 2048 + col0;
#pragma unroll
                for (int bj = 0; bj < 2; ++bj) { const f32x4 a0 = acc[ai][bj][m][0], a1 = acc[ai][bj][m][1];
                    u32x4 o; o.x = cvt_pk_bf16(a0[0], a0[1]); o.y = cvt_pk_bf16(a0[2], a0[3]); o.z = cvt_pk_bf16(a1[0], a1[1]); o.w = cvt_pk_bf16(a1[2], a1[3]);
                    *(u32x4*)(d + bj * 128) = o; } }
    }
};
__device__ __forceinline__ void phase_p6a(LAS unsigned char* lds, const WS& w, int l, int vb, int nvb) {
    EpiPQ E{w.PQ()}; const int M = l == 0 ? NR : NL;
    pg8::StaticOrder so; so.init(M, 2048, nvb, vb);
    pg8::gemm_phase(lds, pg8::Gemm{w.H(), w.WqT() + (size_t)l * 2048 * 1024, M, 2048, 1024}, so, E);
}


using bf16x2_t = __attribute__((ext_vector_type(2))) __bf16;
typedef float f32x2 __attribute__((ext_vector_type(2)));
__device__ __forceinline__ float gelu_fast(float x) {
    const float u2 = 1.5957691216057308f * (x + 0.044715f * x * x * x);
    return x * __builtin_amdgcn_rcpf(1.f + __builtin_amdgcn_exp2f(-1.4426950408889634f * u2));
}
#define DPPF(v, ctrl) __builtin_bit_cast(float, __builtin_amdgcn_update_dpp(0, __builtin_bit_cast(int, (v)), (ctrl), 0xf, 0xf, true))
__device__ __forceinline__ float reduce8(float p0, float p1, float p2, float p3, float p4, float p5, float p6, float p7, int lane) {
    auto s01 = __builtin_amdgcn_permlane32_swap(__float_as_uint(p0), __float_as_uint(p1), false, false);
    auto s23 = __builtin_amdgcn_permlane32_swap(__float_as_uint(p2), __float_as_uint(p3), false, false);
    auto s45 = __builtin_amdgcn_permlane32_swap(__float_as_uint(p4), __float_as_uint(p5), false, false);
    auto s67 = __builtin_amdgcn_permlane32_swap(__float_as_uint(p6), __float_as_uint(p7), false, false);
    const float q0 = __uint_as_float(s01[0]) + __uint_as_float(s01[1]), q1 = __uint_as_float(s23[0]) + __uint_as_float(s23[1]);
    const float q2 = __uint_as_float(s45[0]) + __uint_as_float(s45[1]), q3 = __uint_as_float(s67[0]) + __uint_as_float(s67[1]);
    auto t0 = __builtin_amdgcn_permlane16_swap(__float_as_uint(q0), __float_as_uint(q1), false, false);
    auto t1 = __builtin_amdgcn_permlane16_swap(__float_as_uint(q2), __float_as_uint(q3), false, false);
    float r0 = __uint_as_float(t0[0]) + __uint_as_float(t0[1]);
    float r1 = __uint_as_float(t1[0]) + __uint_as_float(t1[1]);
    r0 += DPPF(r0, 0x128); r1 += DPPF(r1, 0x128);
    float z = (lane & 8) ? r1 : r0;
    z += DPPF(z, 0x141);
    z += DPPF(z, 0xB1);
    z += DPPF(z, 0x4E);
    return z;
}
__device__ __forceinline__ void p7_axpy(const u32x4 v, float wj, f32x2 (&out)[8]) {
    const f32x2 w2 = {wj, wj};
#pragma unroll
    for (int k = 0; k < 4; ++k) { const f32x2 lo = __builtin_amdgcn_cvt_pk_f32_fp8((int)v[k], false), hi2 = __builtin_amdgcn_cvt_pk_f32_fp8((int)v[k], true);
        out[2 * k] = __builtin_elementwise_fma(w2, lo, out[2 * k]); out[2 * k + 1] = __builtin_elementwise_fma(w2, hi2, out[2 * k + 1]); }
}
__device__ __forceinline__ int p7_doti(const u32x4 u, const u32x4 h) {
    int s = __builtin_amdgcn_sdot4((int)u[0], (int)h[0], 0, false); s = __builtin_amdgcn_sdot4((int)u[1], (int)h[1], s, false); s = __builtin_amdgcn_sdot4((int)u[2], (int)h[2], s, false); return __builtin_amdgcn_sdot4((int)u[3], (int)h[3], s, false);
}
#define DPPI(v, ctrl) __builtin_amdgcn_update_dpp(0, (v), (ctrl), 0xf, 0xf, true)
__device__ __forceinline__ int reduce8i(int p0, int p1, int p2, int p3, int p4, int p5, int p6, int p7, int lane) {
    auto s01 = __builtin_amdgcn_permlane32_swap((unsigned)p0, (unsigned)p1, false, false); auto s23 = __builtin_amdgcn_permlane32_swap((unsigned)p2, (unsigned)p3, false, false);
    auto s45 = __builtin_amdgcn_permlane32_swap((unsigned)p4, (unsigned)p5, false, false); auto s67 = __builtin_amdgcn_permlane32_swap((unsigned)p6, (unsigned)p7, false, false);
    const unsigned q0 = s01[0] + s01[1], q1 = s23[0] + s23[1], q2 = s45[0] + s45[1], q3 = s67[0] + s67[1];
    auto t0 = __builtin_amdgcn_permlane16_swap(q0, q1, false, false); auto t1 = __builtin_amdgcn_permlane16_swap(q2, q3, false, false);
    int r0 = (int)(t0[0] + t0[1]), r1 = (int)(t1[0] + t1[1]);
    r0 += DPPI(r0, 0x128); r1 += DPPI(r1, 0x128);
    int z = (lane & 8) ? r1 : r0;
    z += DPPI(z, 0x141); z += DPPI(z, 0xB1); z += DPPI(z, 0x4E);
    return z;
}

struct P7CArgs { const signed char* H8; const unsigned* EG; const unsigned char* U8; int* PART; int nrows; };
__device__ __forceinline__ int p7_doti4(const u32x4 u, const u32x4 h0, const u32x4 h1) {
    int s = 0;
#pragma unroll
    for (int k = 0; k < 4; ++k) { const unsigned lo = (u[k] << 4) & 0xf0f0f0f0u, hi = u[k] & 0xf0f0f0f0u;
        const unsigned ha = (k < 2) ? h0[2 * k] : h1[2 * k - 4], hb = (k < 2) ? h0[2 * k + 1] : h1[2 * k - 3];
        s = __builtin_amdgcn_sdot4((int)lo, (int)ha, s, false); s = __builtin_amdgcn_sdot4((int)hi, (int)hb, s, false); }
    return s;
}
__device__ __forceinline__ void phase_p7c(LAS unsigned char* lds, const P7CArgs& a, int part8, int prank8, int nvb) {
    int tid_ = threadIdx.x; asm volatile("" : "+v"(tid_));
    const int lane = tid_ & 63, wid = __builtin_amdgcn_readfirstlane(tid_ >> 6);
    const int part = part8 >> 1, prank = (part8 & 1) * (nvb >> 3) + prank8;
    const int nw = (nvb >> 2) * 8, wrank = prank * 8 + wid;
    LAS unsigned* tab = (LAS unsigned*)(lds + wid * 1024);
    const int grp = lane >> 3, c = lane & 7, c16 = c * 16;
    const unsigned char* ubase = a.U8 + 128 * part + c16;
    const signed char* hbase = a.H8 + 256 * part + 32 * c;
    unsigned* pbase = (unsigned*)a.PART + (size_t)part * a.nrows * 64;
    const int c2 = (c >> 2) & 1, c1 = (c >> 1) & 1, c0 = c & 1;
    const int ent0 = 8 * (4 * c2 + 2 * c0 + c1) + grp;
    u32x4 Av[16], Bv[16]; u32x4 Ah0, Ah1, Bh0, Bh1;
    unsigned pw0 = 0u, pw1 = 0u;
#define P7C_PREF(t) do { pw0 = a.EG[(size_t)(t) * 128 + lane]; pw1 = a.EG[(size_t)(t) * 128 + 64 + lane]; } while (0)
#define P7C_ISSUE(X, Xh0, Xh1, t, slot, tnext) do { LAS unsigned* tb_ = tab + (slot) * 128; \
        tb_[lane] = pw0; tb_[64 + lane] = pw1; \
        asm volatile("s_waitcnt lgkmcnt(0)" ::: "memory"); \
        _Pragma("unroll") for (int i_ = 0; i_ < 16; ++i_) { const unsigned e_ = tb_[8 * i_ + grp]; X[i_] = *(const u32x4*)(ubase + (size_t)(e_ >> 16) * 512); } \
        Xh0 = *(const u32x4*)(hbase + (size_t)(t) * 1024); Xh1 = *(const u32x4*)(hbase + (size_t)(t) * 1024 + 16); \
        P7C_PREF(tnext); } while (0)
#define P7C_COMPUTE(X, Xh0, Xh1, t, valid) do { int d_[16]; \
        _Pragma("unroll") for (int i_ = 0; i_ < 16; ++i_) d_[i_] = p7_doti4(X[i_], Xh0, Xh1); \
        int e8_[8]; _Pragma("unroll") for (int k = 0; k < 8; ++k) { const int send_ = c2 ? d_[k] : d_[k + 8], keep_ = c2 ? d_[k + 8] : d_[k]; e8_[k] = keep_ + DPPI(send_, 0x141); }            \
        int e4_[4]; _Pragma("unroll") for (int k = 0; k < 4; ++k) { const int send_ = c0 ? e8_[k] : e8_[k + 4], keep_ = c0 ? e8_[k + 4] : e8_[k]; e4_[k] = keep_ + DPPI(send_, 0xB1); }          \
        int e2_[2]; _Pragma("unroll") for (int k = 0; k < 2; ++k) { const int send_ = c1 ? e4_[k] : e4_[k + 2], keep_ = c1 ? e4_[k + 2] : e4_[k]; e2_[k] = keep_ + DPPI(send_, 0x4E); }          \
        if (valid) pbase[(size_t)(t) * 64 + ent0] = __builtin_bit_cast(unsigned, __builtin_amdgcn_cvt_pk_i16(e2_[0] >> 4, e2_[1] >> 4)); } while (0)
    const int lastrow = a.nrows - 1;
    int t = wrank;
    if (t < a.nrows) {
    P7C_PREF(t);
    P7C_ISSUE(Av, Ah0, Ah1, t, 0, (t + nw < a.nrows ? t + nw : lastrow));
    while (t < a.nrows) {
        const int t1 = t + nw, t2 = t1 + nw, t3 = t2 + nw;
        const int k1 = t1 < a.nrows ? t1 : lastrow, k2 = t2 < a.nrows ? t2 : lastrow, k3 = t3 < a.nrows ? t3 : lastrow;
        P7C_ISSUE(Bv, Bh0, Bh1, k1, 1, k2);
        P7C_COMPUTE(Av, Ah0, Ah1, t, true);
        P7C_ISSUE(Av, Ah0, Ah1, k2, 0, k3);
        P7C_COMPUTE(Bv, Bh0, Bh1, k1, (t1 < a.nrows));
        t = t2;
    }
    }
#undef P7C_PREF
#undef P7C_ISSUE
#undef P7C_COMPUTE
}
__device__ __forceinline__ void phase_p7d(const int* __restrict__ PART, const unsigned* __restrict__ EG, const float* __restrict__ US, const float* __restrict__ VS, const float* __restrict__ HS, unsigned* __restrict__ WE, int nrows, int vb, int nvb) {
    int tid_ = threadIdx.x; asm volatile("" : "+v"(tid_));
    typedef int i32x4 __attribute__((ext_vector_type(4)));
    const size_t n16 = (size_t)nrows * 16, pstride4 = n16;
    const u32x4* P4 = (const u32x4*)PART; const u32x4* EG4 = (const u32x4*)EG; u32x4* WE4 = (u32x4*)WE;
    for (size_t j = (size_t)vb * 512 + tid_; j < n16; j += (size_t)nvb * 512) {
        const size_t row = j >> 4; const int P = (int)(j >> 1) & 7, gq = (int)j & 1;
        i32x4 slo = {0, 0, 0, 0}, shi = {0, 0, 0, 0};
#pragma unroll
        for (int p = 0; p < 4; ++p) { const u32x4 d = P4[p * pstride4 + j];
#pragma unroll
            for (int k = 0; k < 4; ++k) { slo[k] += (int)(d[k] << 16) >> 16; shi[k] += (int)d[k] >> 16; } }
        const float hs = HS[row];
#pragma unroll
        for (int half = 0; half < 2; ++half) {
            const size_t ei = row * 32 + 4 * P + 2 * half + gq;
            const u32x4 eg = EG4[ei]; u32x4 o;
#pragma unroll
            for (int k = 0; k < 4; ++k) { const int eid = (int)(eg[k] >> 16);
                const float av = (float)(half ? shi[k] : slo[k]) * US[eid] * hs;
                const float wv = __uint_as_float(eg[k] << 16) * gelu_fast(av) * VS[eid];
                o[k] = (eg[k] & 0xffff0000u) | (cvt_pk_bf16(wv, 0.f) & 0xffffu); }
            WE4[ei] = o;
        }
    }
}
struct P7BArgs { const unsigned* WE; const unsigned char* V8; bf16_t* XB; const float* gate2; int nrows; };
__device__ __forceinline__ void p7_axpy4(const u32x4 v, float wj, f32x2 (&out)[16]) {
    const f32x2 w2 = {wj, wj};
#pragma unroll
    for (int k = 0; k < 4; ++k) { const unsigned lo = v[k] & 0x0f0f0f0fu, hi = (v[k] >> 4) & 0x0f0f0f0fu;
        const f32x2 a0 = __builtin_amdgcn_cvt_pk_f32_fp8((int)lo, false), a1 = __builtin_amdgcn_cvt_pk_f32_fp8((int)lo, true), b0 = __builtin_amdgcn_cvt_pk_f32_fp8((int)hi, false), b1 = __builtin_amdgcn_cvt_pk_f32_fp8((int)hi, true);
        out[4 * k] = __builtin_elementwise_fma(w2, a0, out[4 * k]); out[4 * k + 1] = __builtin_elementwise_fma(w2, a1, out[4 * k + 1]);
        out[4 * k + 2] = __builtin_elementwise_fma(w2, b0, out[4 * k + 2]); out[4 * k + 3] = __builtin_elementwise_fma(w2, b1, out[4 * k + 3]); }
}
template <int PM>
__device__ __forceinline__ void phase_p7b(LAS unsigned char* lds, const P7BArgs& a, int part8, int prank8, int nvb) {
    int tid_ = threadIdx.x; asm volatile("" : "+v"(tid_));
    const int lane = tid_ & 63, wid = __builtin_amdgcn_readfirstlane(tid_ >> 6);
    const int part = part8 >> 1, prank = (part8 & 1) * (nvb >> 3) + prank8;
    const int nw = (nvb >> 2) * 8, wrank = prank * 8 + wid;
    LAS unsigned* tab = (LAS unsigned*)(lds + wid * 1024);
    const int grp = lane >> 3, c16 = (lane & 7) * 16;
    const unsigned char* vbase = a.V8 + 128 * part + c16;
    const int colofs = 256 * part + 2 * c16 + 16 * (lane >> 5) + 8 * ((lane >> 4) & 1) + 4 * ((lane >> 3) & 1);
    u32x4 Av[16], Bv[16]; float Aw[16], Bw[16]; u32x2 Ax, Bx; f32x4 Ag, Bg;
    unsigned pw0 = 0u, pw1 = 0u;
#define P7B_PREF(t) do { pw0 = a.WE[(size_t)(t) * 128 + lane]; pw1 = a.WE[(size_t)(t) * 128 + 64 + lane]; } while (0)
#define P7B_ISSUE(X, Xw, Xx, Xg, t, slot, tnext) do { LAS unsigned* tb_ = tab + (slot) * 128; \
        tb_[lane] = pw0; tb_[64 + lane] = pw1; \
        asm volatile("s_waitcnt lgkmcnt(0)" ::: "memory"); \
        _Pragma("unroll") for (int i_ = 0; i_ < 16; ++i_) { const unsigned we_ = tb_[8 * i_ + grp]; Xw[i_] = __uint_as_float(we_ << 16); X[i_] = *(const u32x4*)(vbase + (size_t)(we_ >> 16) * 512); } \
        { const int mr_ = (t) >= NL ? 32 : (t) / S; \
          Xx = *(const u32x2*)(a.XB + (size_t)(t) * 1024 + colofs); Xg = *(const f32x4*)(a.gate2 + (size_t)mr_ * 6144 + colofs); } \
        P7B_PREF(tnext); } while (0)
#define P7B_COMPUTE(X, Xw, Xx, Xg, t, valid) do { f32x2 acc2[16]; \
        { float ws_ = 0.f; _Pragma("unroll") for (int i_ = 0; i_ < 16; ++i_) ws_ += Xw[i_]; ws_ *= -(1.f / 64.f);     \
          _Pragma("unroll") for (int k = 0; k < 16; ++k) acc2[k] = (f32x2){ws_, ws_}; } \
        _Pragma("unroll") for (int i_ = 0; i_ < 16; ++i_) p7_axpy4(X[i_], Xw[i_], acc2); \
        float b_[16]; _Pragma("unroll") for (int k = 0; k < 16; ++k) { auto s_ = __builtin_amdgcn_permlane32_swap(__float_as_uint(acc2[k >> 1][k & 1]), __float_as_uint(acc2[(k + 16) >> 1][k & 1]), false, false); b_[k] = __uint_as_float(s_[0]) + __uint_as_float(s_[1]); } \
        float c_[8]; _Pragma("unroll") for (int k = 0; k < 8; ++k) { auto s_ = __builtin_amdgcn_permlane16_swap(__float_as_uint(b_[k]), __float_as_uint(b_[k + 8]), false, false); c_[k] = __uint_as_float(s_[0]) + __uint_as_float(s_[1]); } \
        float d_[4]; _Pragma("unroll") for (int k = 0; k < 4; ++k) { const float send_ = (lane & 8) ? c_[k] : c_[k + 4]; const float keep_ = (lane & 8) ? c_[k + 4] : c_[k]; d_[k] = keep_ + DPPF(send_, 0x128); } \
        u32x2* xp_ = (u32x2*)(a.XB + (size_t)(t) * 1024 + colofs); \
        const float x0_ = __uint_as_float(Xx.x << 16) + Xg[0] * d_[0], x1_ = __uint_as_float(Xx.x & 0xffff0000u) + Xg[1] * d_[1], x2_ = __uint_as_float(Xx.y << 16) + Xg[2] * d_[2], x3_ = __uint_as_float(Xx.y & 0xffff0000u) + Xg[3] * d_[3]; \
        u32x2 xo_; xo_.x = cvt_pk_bf16(x0_, x1_); xo_.y = cvt_pk_bf16(x2_, x3_); \
        if ((valid) && PM == 0) *xp_ = xo_; else if (PM != 0 && x0_ == 1.2345e30f) *xp_ = xo_; } while (0)
    const int lastrow = a.nrows - 1;
    int t = wrank;
    if (t < a.nrows) {
    P7B_PREF(t);
    P7B_ISSUE(Av, Aw, Ax, Ag, t, 0, (t + nw < a.nrows ? t + nw : lastrow));
    while (t < a.nrows) {
        const int t1 = t + nw, t2 = t1 + nw, t3 = t2 + nw;
        const int c1 = t1 < a.nrows ? t1 : lastrow, c2 = t2 < a.nrows ? t2 : lastrow, c3 = t3 < a.nrows ? t3 : lastrow;
        P7B_ISSUE(Bv, Bw, Bx, Bg, c1, 1, c2);
        P7B_COMPUTE(Av, Aw, Ax, Ag, t, true);
        P7B_ISSUE(Av, Aw, Ax, Ag, c2, 0, c3);
        P7B_COMPUTE(Bv, Bw, Bx, Bg, c1, (t1 < a.nrows));
        t = t2;
    }
    }
#undef P7B_PREF
#undef P7B_ISSUE
#undef P7B_COMPUTE
}
__device__ __forceinline__ void phase_final_norm(const bf16_t* __restrict__ XBp, float* __restrict__ OUT, const float* __restrict__ g, int vb, int nvb) {
    int tid_ = threadIdx.x; asm volatile("" : "+v"(tid_));
    const int lane = tid_ & 63, wid = tid_ >> 6;
    for (int row = vb * 8 + wid; row < NL; row += nvb * 8) {
        const bf16_t* xp = XBp + (size_t)row * 1024; f32x4 x[4]; float ss = 0.f;
#pragma unroll
        for (int i = 0; i < 4; ++i) { const u32x2 r = *(const u32x2*)(xp + 256 * i + 4 * lane); x[i] = (f32x4){__uint_as_float(r.x << 16), __uint_as_float(r.x & 0xffff0000u), __uint_as_float(r.y << 16), __uint_as_float(r.y & 0xffff0000u)};
            ss += x[i][0] * x[i][0] + x[i][1] * x[i][1] + x[i][2] * x[i][2] + x[i][3] * x[i][3]; }
        ss = wave_sum(ss); const float rstd = rsqrtf(ss * (1.f / 1024.f) + EPS);
#pragma unroll
        for (int i = 0; i < 4; ++i) *(f32x4*)(OUT + (size_t)row * 1024 + 256 * i + 4 * lane) = x[i] * rstd * *(const f32x4*)(g + 256 * i + 4 * lane);
    }
}

template <int V_> struct IC { static constexpr int value = V_; };
typedef short s16x4 __attribute__((ext_vector_type(4)));
__device__ __forceinline__ s16x4 lds_tr16(const LAS unsigned char* p) { return __builtin_bit_cast(s16x4, __builtin_amdgcn_ds_read_tr16_b64_v4i16((LAS s16x4*)p)); }
constexpr int ATT_BUF = 20480;
__device__ __forceinline__ void glds16(const void* g, unsigned lds_base) {
    unsigned sv; asm volatile("s_mov_b32 %0, m0\n\ts_mov_b32 m0, %2\n\ts_nop 0\n\tglobal_load_lds_dwordx4 %1, off\n\ts_mov_b32 m0, %0" : "=&s"(sv) : "v"(g), "s"(lds_base) : "memory"); }
template <int DK>
__device__ __forceinline__ void attn_unit(LAS unsigned char* lds, const bf16_t* __restrict__ Q, const bf16_t* __restrict__ K1, const bf16_t* __restrict__ K2, const bf16_t* __restrict__ V,
                                          int nkeys, float c2, bf16_t* __restrict__ out) {
    int tid_ = threadIdx.x; asm volatile("" : "+v"(tid_));
    const int tid = tid_, lane = tid & 63, wid = __builtin_amdgcn_readfirstlane(tid >> 6), r32 = lane & 31, hi = lane >> 5;
    constexpr int NS = DK / 16, NM = 2 * NS;
    bf16x8 qf[NS];
    { const bf16_t* qp = Q + (size_t)(wid * 32 + r32) * DK + 8 * hi;
#pragma unroll
      for (int s = 0; s < NS; ++s) qf[s] = *(const bf16x8*)(qp + 16 * s); }
    const int dkey = 8 * wid + (lane >> 3), dkey2 = 16 * (wid & 3) + (lane >> 2);
    const bf16_t* gk1 = K1 + (size_t)dkey * 64 + (((lane & 7) ^ ((dkey >> 1) & 7)) << 3);
    const bf16_t* gv = V + (size_t)dkey * 64 + (((lane & 7) ^ (((dkey >> 1) & 1) << 2)) << 3);
    const bf16_t* gk2 = (DK == 96) ? K2 + (size_t)dkey2 * 32 + (((lane & 3) ^ ((dkey2 >> 2) & 3)) << 3) : nullptr;
    const unsigned lds0 = (unsigned)(size_t)lds;
    const unsigned d_k1 = lds0 + wid * 1024, d_v = lds0 + 8192 + wid * 1024, d_k2 = lds0 + 16384 + (wid & 3) * 1024;
#define ATT_DMA(tile_, slot_) do { const int tt_ = (tile_); glds16(gk1 + (size_t)tt_ * 4096, (unsigned)__builtin_amdgcn_readfirstlane(d_k1 + (slot_) * ATT_BUF)); \
        glds16(gv + (size_t)tt_ * 4096, (unsigned)__builtin_amdgcn_readfirstlane(d_v + (slot_) * ATT_BUF)); \
        if (DK == 96) glds16(gk2 + (size_t)tt_ * 2048, (unsigned)__builtin_amdgcn_readfirstlane(d_k2 + (slot_) * ATT_BUF)); } while (0)
#define ATT_WAIT_BAR() do { if (DK == 96) asm volatile("s_waitcnt vmcnt(3) lgkmcnt(0)\n\ts_barrier" ::: "memory"); else asm volatile("s_waitcnt vmcnt(2) lgkmcnt(0)\n\ts_barrier" ::: "memory"); } while (0)
    unsigned ka[2][4];
#pragma unroll
    for (int kt = 0; kt < 2; ++kt)
#pragma unroll
        for (int s = 0; s < 4; ++s) { const int key = 32 * kt + r32; ka[kt][s] = key * 128 + (((2 * s + hi) ^ ((key >> 1) & 7)) << 4); }
    unsigned kb[2][2];
#pragma unroll
    for (int kt = 0; kt < 2; ++kt)
#pragma unroll
        for (int s = 0; s < 2; ++s) { const int key = 32 * kt + r32; kb[kt][s] = 16384 + key * 64 + (((2 * s + hi) ^ ((key >> 2) & 3)) << 4); }
    const int vq = (lane & 15) >> 2, vp = lane & 3, vg = (lane >> 4) & 1;
    unsigned va[2];
#pragma unroll
    for (int dvb = 0; dvb < 2; ++dvb) { const int key = 4 * hi + vq; va[dvb] = 8192 + key * 128 + ((((32 * dvb + 16 * vg + 4 * vp) * 2)) ^ (((key >> 1) & 1) << 6)); }
    float m = -1e30f, l = 0.f, mx;
    f32x16 o0 = {}, o1 = {};
    const int NT = nkeys >> 6;
    ATT_DMA(0, 0); ATT_DMA(NT > 1 ? 1 : 0, 1); ATT_DMA(NT > 2 ? 2 : NT - 1, 2);
    asm volatile("s_waitcnt vmcnt(0) lgkmcnt(0)\n\ts_barrier" ::: "memory");
    f32x16 pa0 = {}, pa1 = {}, pb0 = {}, pb1 = {};
    {
        bf16x8 kf0[NS], kf1[NS];
#pragma unroll
        for (int s = 0; s < 4; ++s) { kf0[s] = *(const LAS bf16x8*)(lds + ka[0][s]); kf1[s] = *(const LAS bf16x8*)(lds + ka[1][s]); }
        if (DK == 96) {
#pragma unroll
            for (int s = 0; s < 2; ++s) { kf0[4 + s] = *(const LAS bf16x8*)(lds + kb[0][s]); kf1[4 + s] = *(const LAS bf16x8*)(lds + kb[1][s]); }
        }
#pragma unroll
        for (int s = 0; s < NS; ++s) { pa0 = mfma32(kf0[s], qf[s], pa0); pa1 = mfma32(kf1[s], qf[s], pa1); }
        mx = pa0[0];
#pragma unroll
        for (int r = 1; r < 16; ++r) mx = fmaxf(mx, pa0[r]);
#pragma unroll
        for (int r = 0; r < 16; ++r) mx = fmaxf(mx, pa1[r]);
    }
    auto step = [&](auto bc_, auto bn_, auto bw_, f32x16& pc0, f32x16& pc1, f32x16& pn0, f32x16& pn1, int t) __attribute__((always_inline)) {
        constexpr int BC = decltype(bc_)::value * ATT_BUF, BN = decltype(bn_)::value * ATT_BUF;
        ATT_DMA((t + 3 < NT) ? t + 3 : NT - 1, decltype(bw_)::value);
        bf16x8 kf0[NS], kf1[NS];
#pragma unroll
        for (int s = 0; s < 4; ++s) { kf0[s] = *(const LAS bf16x8*)(lds + BN + ka[0][s]); kf1[s] = *(const LAS bf16x8*)(lds + BN + ka[1][s]); }
        if (DK == 96) {
#pragma unroll
            for (int s = 0; s < 2; ++s) { kf0[4 + s] = *(const LAS bf16x8*)(lds + BN + kb[0][s]); kf1[4 + s] = *(const LAS bf16x8*)(lds + BN + kb[1][s]); }
        }
        __builtin_amdgcn_sched_barrier(0);
        { auto rr = __builtin_amdgcn_permlane32_swap(__float_as_uint(mx), __float_as_uint(mx), false, false); mx = fmaxf(__uint_as_float(rr[0]), __uint_as_float(rr[1])); }
        const float tm = mx;
        if (__any(tm > m + 8.f)) {
            const float mn = fmaxf(m, tm), al = __builtin_amdgcn_exp2f(m - mn); m = mn; l *= al;
#pragma unroll
            for (int r = 0; r < 16; ++r) { o0[r] *= al; o1[r] *= al; }
        }
        const float nm = -m; float ls = 0.f;
        pn0 = f32x16{}; pn1 = f32x16{};
        unsigned pw[16];
        s16x4 vlo[2][2][2], vhi[2][2][2];
#pragma unroll
        for (int c = 0; c < 8; ++c) {
            __builtin_amdgcn_sched_barrier(0);
#pragma unroll
            for (int j = 0; j < NM; ++j) if (j >= c * NM / 8 && j < (c + 1) * NM / 8) { if (j & 1) pn1 = mfma32(kf1[j >> 1], qf[j >> 1], pn1); else pn0 = mfma32(kf0[j >> 1], qf[j >> 1], pn0); }
            if (c == 4) {
#pragma unroll
                for (int kt = 0; kt < 2; ++kt)
#pragma unroll
                    for (int sp = 0; sp < 2; ++sp) { const int kofs = (32 * kt + 16 * sp) * 128;
#pragma unroll
                        for (int dvb = 0; dvb < 2; ++dvb) { vlo[dvb][kt][sp] = lds_tr16(lds + BC + va[dvb] + kofs); vhi[dvb][kt][sp] = lds_tr16(lds + BC + va[dvb] + kofs + 8 * 128); } }
            }
            __builtin_amdgcn_sched_barrier(0);
            if (c < 4) {
#pragma unroll
                for (int i = 0; i < 4; ++i) { const int r = 4 * c + i; pc0[r] = __builtin_amdgcn_exp2f(pc0[r] + nm); ls += pc0[r]; }
                pw[2 * c] = cvt_pk_bf16(pc0[4 * c], pc0[4 * c + 1]); pw[2 * c + 1] = cvt_pk_bf16(pc0[4 * c + 2], pc0[4 * c + 3]);
            } else {
#pragma unroll
                for (int i = 0; i < 4; ++i) { const int r = 4 * (c - 4) + i; pc1[r] = __builtin_amdgcn_exp2f(pc1[r] + nm); ls += pc1[r]; }
                pw[8 + 2 * (c - 4)] = cvt_pk_bf16(pc1[4 * (c - 4)], pc1[4 * (c - 4) + 1]); pw[8 + 2 * (c - 4) + 1] = cvt_pk_bf16(pc1[4 * (c - 4) + 2], pc1[4 * (c - 4) + 3]);
            }
        }
        __builtin_amdgcn_sched_barrier(0);
        l += ls;
        float mxn = -3.0e38f;
#pragma unroll
        for (int k = 0; k < 8; ++k) { const int kt = k >> 2, sp = (k >> 1) & 1, dvb = k & 1;
            const u32x4 pq = (u32x4){pw[8 * kt + 4 * sp], pw[8 * kt + 4 * sp + 1], pw[8 * kt + 4 * sp + 2], pw[8 * kt + 4 * sp + 3]};
            const s16x4 lo = vlo[dvb][kt][sp], hi4 = vhi[dvb][kt][sp]; const bf16x8 vf = (bf16x8){lo[0], lo[1], lo[2], lo[3], hi4[0], hi4[1], hi4[2], hi4[3]};
            if (dvb == 0) o0 = mfma32(vf, __builtin_bit_cast(bf16x8, pq), o0); else o1 = mfma32(vf, __builtin_bit_cast(bf16x8, pq), o1);
            __builtin_amdgcn_sched_barrier(0);
            if (k < 4) { mxn = fmaxf(fmaxf(mxn, pn0[4 * k]), fmaxf(pn0[4 * k + 1], fmaxf(pn0[4 * k + 2], pn0[4 * k + 3]))); }
            else { mxn = fmaxf(fmaxf(mxn, pn1[4 * (k - 4)]), fmaxf(pn1[4 * (k - 4) + 1], fmaxf(pn1[4 * (k - 4) + 2], pn1[4 * (k - 4) + 3]))); }
            __builtin_amdgcn_sched_barrier(0);
        }
        mx = mxn;
        ATT_WAIT_BAR();
    };
    for (int t = 0; t < NT; t += 4) {
        step(IC<0>{}, IC<1>{}, IC<3>{}, pa0, pa1, pb0, pb1, t);
        step(IC<1>{}, IC<2>{}, IC<0>{}, pb0, pb1, pa0, pa1, t + 1);
        step(IC<2>{}, IC<3>{}, IC<1>{}, pa0, pa1, pb0, pb1, t + 2);
        step(IC<3>{}, IC<0>{}, IC<2>{}, pb0, pb1, pa0, pa1, t + 3);
    }
    { auto rr = __builtin_amdgcn_permlane32_swap(__float_as_uint(l), __float_as_uint(l), false, false); l = __uint_as_float(rr[0]) + __uint_as_float(rr[1]); }
    const float il = 1.f / l;
    bf16_t* op = out + (size_t)(wid * 32 + r32) * 1024 + 4 * hi;
#pragma unroll
    for (int g = 0; g < 4; ++g) { u32x2 a, b;
        a.x = cvt_pk_bf16(o0[4 * g] * il, o0[4 * g + 1] * il); a.y = cvt_pk_bf16(o0[4 * g + 2] * il, o0[4 * g + 3] * il);
        b.x = cvt_pk_bf16(o1[4 * g] * il, o1[4 * g + 1] * il); b.y = cvt_pk_bf16(o1[4 * g + 2] * il, o1[4 * g + 3] * il);
        *(u32x2*)(op + 8 * g) = a; *(u32x2*)(op + 32 + 8 * g) = b; }
}
#undef ATT_DMA
#undef ATT_WAIT_BAR
template <int DK>
__device__ __forceinline__ void attn_unit64(LAS unsigned char* lds, const bf16_t* __restrict__ Q, const bf16_t* __restrict__ K1, const bf16_t* __restrict__ K2, const bf16_t* __restrict__ V,
                                            int nkeys, bf16_t* __restrict__ out) {
    int tid_ = threadIdx.x; asm volatile("" : "+v"(tid_));
    const int tid = tid_, lane = tid & 63, wid = __builtin_amdgcn_readfirstlane(tid >> 6), r32 = lane & 31, hi = lane >> 5;
    constexpr int NS = DK / 16;
    bf16x8 qf[2][NS];
#pragma unroll
    for (int j = 0; j < 2; ++j) { const bf16_t* qp = Q + (size_t)(wid * 64 + 32 * j + r32) * DK + 8 * hi;
#pragma unroll
        for (int s = 0; s < NS; ++s) qf[j][s] = *(const bf16x8*)(qp + 16 * s); }
    const int dkey = 8 * wid + (lane >> 3), dkey2 = 16 * (wid & 3) + (lane >> 2);
    const bf16_t* gk1 = K1 + (size_t)dkey * 64 + (((lane & 7) ^ ((dkey >> 1) & 7)) << 3);
    const bf16_t* gv = V + (size_t)dkey * 64 + (((lane & 7) ^ (((dkey >> 1) & 1) << 2)) << 3);
    const bf16_t* gk2 = (DK == 96) ? K2 + (size_t)dkey2 * 32 + (((lane & 3) ^ ((dkey2 >> 2) & 3)) << 3) : nullptr;
    const unsigned lds0 = (unsigned)(size_t)lds;
    const unsigned d_k1 = lds0 + wid * 1024, d_v = lds0 + 8192 + wid * 1024, d_k2 = lds0 + 16384 + (wid & 3) * 1024;
#define ATT_DMA(tile_, slot_) do { const int tt_ = (tile_); glds16(gk1 + (size_t)tt_ * 4096, (unsigned)__builtin_amdgcn_readfirstlane(d_k1 + (slot_) * ATT_BUF)); \
        glds16(gv + (size_t)tt_ * 4096, (unsigned)__builtin_amdgcn_readfirstlane(d_v + (slot_) * ATT_BUF)); \
        if (DK == 96) glds16(gk2 + (size_t)tt_ * 2048, (unsigned)__builtin_amdgcn_readfirstlane(d_k2 + (slot_) * ATT_BUF)); } while (0)
    unsigned ka[4];
#pragma unroll
    for (int s = 0; s < 4; ++s) ka[s] = r32 * 128 + (((2 * s + hi) ^ ((r32 >> 1) & 7)) << 4);
    unsigned kb[2];
#pragma unroll
    for (int s = 0; s < 2; ++s) kb[s] = 16384 + r32 * 64 + (((2 * s + hi) ^ ((r32 >> 2) & 3)) << 4);
    const int vq = (lane & 15) >> 2, vp = lane & 3, vg = (lane >> 4) & 1;
    unsigned va[2];
#pragma unroll
    for (int dvb = 0; dvb < 2; ++dvb) { const int key = 4 * hi + vq; va[dvb] = 8192 + key * 128 + ((((32 * dvb + 16 * vg + 4 * vp) * 2)) ^ (((key >> 1) & 1) << 6)); }
    float m[2] = {-1e30f, -1e30f}, l[2] = {0.f, 0.f};
    f32x16 o[2][2] = {};
    const int NT = nkeys >> 6;
    ATT_DMA(0, 0); ATT_DMA(1, 1); ATT_DMA(2, 2);
    asm volatile("s_waitcnt vmcnt(0) lgkmcnt(0)\n\ts_barrier" ::: "memory");
    bf16x8 kf0[NS], kf1[NS];
#pragma unroll
    for (int s = 0; s < 4; ++s) { kf0[s] = *(const LAS bf16x8*)(lds + ka[s]); kf1[s] = *(const LAS bf16x8*)(lds + 4096 + ka[s]); }
    auto step = [&](auto cur_, auto wsl_, int t) __attribute__((always_inline)) {
        constexpr int BC = decltype(cur_)::value * ATT_BUF, BNX = ((decltype(cur_)::value + 1) & 3) * ATT_BUF;
        ATT_DMA((t + 3 < NT) ? t + 3 : NT - 1, decltype(wsl_)::value);
        unsigned pw[2][16];
        s16x4 vlo[2][2], vhi[2][2];
#define ATT64_VLOAD(kt_) do { _Pragma("unroll") for (int sp = 0; sp < 2; ++sp) { const int kofs = (32 * (kt_) + 16 * sp) * 128; \
            _Pragma("unroll") for (int dvb = 0; dvb < 2; ++dvb) { vlo[dvb][sp] = lds_tr16(lds + BC + va[dvb] + kofs); vhi[dvb][sp] = lds_tr16(lds + BC + va[dvb] + kofs + 8 * 128); } } } while (0)
#define ATT64_PV(kt_) do { _Pragma("unroll") for (int sp = 0; sp < 2; ++sp) _Pragma("unroll") for (int dvb = 0; dvb < 2; ++dvb) { \
            const s16x4 lo = vlo[dvb][sp], hi4 = vhi[dvb][sp]; const bf16x8 vf = (bf16x8){lo[0], lo[1], lo[2], lo[3], hi4[0], hi4[1], hi4[2], hi4[3]}; \
            _Pragma("unroll") for (int j = 0; j < 2; ++j) { const u32x4 pq = (u32x4){pw[j][8 * (kt_) + 4 * sp], pw[j][8 * (kt_) + 4 * sp + 1], pw[j][8 * (kt_) + 4 * sp + 2], pw[j][8 * (kt_) + 4 * sp + 3]}; \
                o[j][dvb] = mfma32(vf, __builtin_bit_cast(bf16x8, pq), o[j][dvb]); } } } while (0)
#pragma unroll
        for (int j = 0; j < 2; ++j) {
            f32x16 p0 = {}, p1 = {};
#pragma unroll
            for (int s = 0; s < NS; ++s) { p0 = mfma32(kf0[s], qf[j][s], p0); p1 = mfma32(kf1[s], qf[j][s], p1); }
            if (j == 1) { __builtin_amdgcn_sched_barrier(0); ATT64_VLOAD(0); __builtin_amdgcn_sched_barrier(0); }
            float mx = p0[0];
#pragma unroll
            for (int r = 1; r < 16; ++r) mx = fmaxf(mx, p0[r]);
#pragma unroll
            for (int r = 0; r < 16; ++r) mx = fmaxf(mx, p1[r]);
            { auto rr = __builtin_amdgcn_permlane32_swap(__float_as_uint(mx), __float_as_uint(mx), false, false); mx = fmaxf(__uint_as_float(rr[0]), __uint_as_float(rr[1])); }
            if (__any(mx > m[j] + 8.f)) {
                const float mn = fmaxf(m[j], mx), al = __builtin_amdgcn_exp2f(m[j] - mn); m[j] = mn; l[j] *= al;
#pragma unroll
                for (int r = 0; r < 16; ++r) { o[j][0][r] *= al; o[j][1][r] *= al; }
            }
            const float nm = -m[j];
#pragma unroll
            for (int r = 0; r < 16; ++r) { p0[r] = __builtin_amdgcn_exp2f(p0[r] + nm); p1[r] = __builtin_amdgcn_exp2f(p1[r] + nm); }
            f32x2 ls2 = {0.f, 0.f};
#pragma unroll
            for (int r = 0; r < 16; r += 2) { ls2 += (f32x2){p0[r], p0[r + 1]}; ls2 += (f32x2){p1[r], p1[r + 1]}; }
            l[j] += ls2.x + ls2.y;
#pragma unroll
            for (int i = 0; i < 8; ++i) { pw[j][i] = cvt_pk_bf16(p0[2 * i], p0[2 * i + 1]); pw[j][8 + i] = cvt_pk_bf16(p1[2 * i], p1[2 * i + 1]); }
            __builtin_amdgcn_sched_barrier(0);
        }
        ATT64_PV(0);
        __builtin_amdgcn_sched_barrier(0);
        ATT64_VLOAD(1);
        __builtin_amdgcn_sched_barrier(0);
        ATT64_PV(1);
#undef ATT64_VLOAD
#undef ATT64_PV
        __builtin_amdgcn_sched_barrier(0);
#pragma unroll
        for (int s = 0; s < 4; ++s) { kf0[s] = *(const LAS bf16x8*)(lds + BNX + ka[s]); kf1[s] = *(const LAS bf16x8*)(lds + BNX + 4096 + ka[s]); }
        asm volatile("s_waitcnt vmcnt(2) lgkmcnt(0)\n\ts_barrier" ::: "memory");
    };
    for (int t = 0; t < NT; t += 4) {
        step(IC<0>{}, IC<3>{}, t); step(IC<1>{}, IC<0>{}, t + 1); step(IC<2>{}, IC<1>{}, t + 2); step(IC<3>{}, IC<2>{}, t + 3);
    }
#pragma unroll
    for (int j = 0; j < 2; ++j) {
        float lj = l[j]; { auto rr = __builtin_amdgcn_permlane32_swap(__float_as_uint(lj), __float_as_uint(lj), false, false); lj = __uint_as_float(rr[0]) + __uint_as_float(rr[1]); }
        const float il = 1.f / lj;
        bf16_t* op = out + (size_t)(wid * 64 + 32 * j + r32) * 1024 + 4 * hi;
#pragma unroll
        for (int g = 0; g < 4; ++g) { u32x2 a, b;
            a.x = cvt_pk_bf16(o[j][0][4 * g] * il, o[j][0][4 * g + 1] * il); a.y = cvt_pk_bf16(o[j][0][4 * g + 2] * il, o[j][0][4 * g + 3] * il);
            b.x = cvt_pk_bf16(o[j][1][4 * g] * il, o[j][1][4 * g + 1] * il); b.y = cvt_pk_bf16(o[j][1][4 * g + 2] * il, o[j][1][4 * g + 3] * il);
            *(u32x2*)(op + 8 * g) = a; *(u32x2*)(op + 32 + 8 * g) = b; }
    }
#undef ATT_DMA
}
__device__ __forceinline__ void glds16s(const void* base, unsigned voff, unsigned lds_base) {
    unsigned sv; asm volatile("s_mov_b32 %0, m0\n\ts_mov_b32 m0, %3\n\ts_nop 0\n\tglobal_load_lds_dwordx4 %1, %2\n\ts_mov_b32 m0, %0" : "=&s"(sv) : "v"(voff), "s"(base), "s"(lds_base) : "memory"); }
__device__ __forceinline__ void attn_unit64m(LAS unsigned char* lds, const bf16_t* __restrict__ Q, const bf16_t* __restrict__ K1, const bf16_t* __restrict__ K2, const bf16_t* __restrict__ V,
                                            int nkeys, bf16_t* __restrict__ out) {
    constexpr int DK = 96;
    int tid_ = threadIdx.x; asm volatile("" : "+v"(tid_));
    const int tid = tid_, lane = tid & 63, wid = __builtin_amdgcn_readfirstlane(tid >> 6), r32 = lane & 31, hi = lane >> 5;
    bf16x8 qf[2][4];
    LAS unsigned char* qrl = lds + 4 * ATT_BUF + wid * 4096 + lane * 16;
#pragma unroll
    for (int j = 0; j < 2; ++j) { const bf16_t* qp = Q + (size_t)(wid * 64 + 32 * j + r32) * DK + 8 * hi;
#pragma unroll
        for (int s = 0; s < 4; ++s) qf[j][s] = *(const bf16x8*)(qp + 16 * s);
#pragma unroll
        for (int s = 0; s < 2; ++s) *(LAS bf16x8*)(qrl + (2 * j + s) * 1024) = *(const bf16x8*)(qp + 64 + 16 * s); }
    const int dkey = 8 * wid + (lane >> 3), dkey2 = 16 * (wid & 3) + (lane >> 2);
    const unsigned ok1 = (unsigned)(dkey * 64 + (((lane & 7) ^ ((dkey >> 1) & 7)) << 3)) * 2u, ov = (unsigned)(dkey * 64 + (((lane & 7) ^ (((dkey >> 1) & 1) << 2)) << 3)) * 2u,
                   ok2 = (unsigned)(dkey2 * 32 + (((lane & 3) ^ ((dkey2 >> 2) & 3)) << 3)) * 2u;
    const unsigned lds0 = (unsigned)(size_t)lds;
    const unsigned d_k1 = lds0 + wid * 1024, d_v = lds0 + 8192 + wid * 1024, d_k2 = lds0 + 16384 + (wid & 3) * 1024;
#define ATT_DMA(tile_, slot_) do { const int tt_ = (tile_); glds16s((const char*)K1 + (size_t)tt_ * 8192, ok1, (unsigned)__builtin_amdgcn_readfirstlane(d_k1 + (slot_) * ATT_BUF)); \
        glds16s((const char*)V + (size_t)tt_ * 8192, ov, (unsigned)__builtin_amdgcn_readfirstlane(d_v + (slot_) * ATT_BUF)); \
        glds16s((const char*)K2 + (size_t)tt_ * 4096, ok2, (unsigned)__builtin_amdgcn_readfirstlane(d_k2 + (slot_) * ATT_BUF)); } while (0)
    const unsigned ka0_ = r32 * 128 + ((hi ^ ((r32 >> 1) & 7)) << 4), kb0_ = 16384 + r32 * 64 + ((hi ^ ((r32 >> 2) & 3)) << 4);
#define ka(s_) (kao_ ^ ((unsigned)(s_) << 5))
#define kb(s_) (kbo_ ^ ((unsigned)(s_) << 5))
    const int vq = (lane & 15) >> 2, vp = lane & 3, vg = (lane >> 4) & 1;
    const unsigned va0_ = 8192 + (4 * hi + vq) * 128 + ((((16 * vg + 4 * vp) * 2)) ^ ((((4 * hi + vq) >> 1) & 1) << 6));
    float m[2] = {-1e30f, -1e30f}, l[2] = {0.f, 0.f};
    f32x16 o[2][2] = {};
    const int NT = nkeys >> 6;
    ATT_DMA(0, 0); ATT_DMA(1, 1); ATT_DMA(2, 2);
    asm volatile("s_waitcnt vmcnt(0) lgkmcnt(0)\n\ts_barrier" ::: "memory");
    auto step = [&](auto cur_, auto wsl_, int t) __attribute__((always_inline)) {
        constexpr int BC = decltype(cur_)::value * ATT_BUF;
        unsigned kao_ = ka0_, kbo_ = kb0_, vao_ = va0_; asm volatile("" : "+v"(kao_), "+v"(kbo_), "+v"(vao_));
        const unsigned va[2] = {vao_, vao_ ^ 64u};
        ATT_DMA((t + 3 < NT) ? t + 3 : NT - 1, decltype(wsl_)::value);
        f32x16 pj[2][2];
#pragma unroll
        for (int j = 0; j < 2; ++j) { pj[j][0] = f32x16{}; pj[j][1] = f32x16{}; }
        {
            bf16x8 ka0[2], ka1[2], kb0[2], kb1[2];
#pragma unroll
            for (int s = 0; s < 2; ++s) { ka0[s] = *(const LAS bf16x8*)(lds + BC + ka(s)); ka1[s] = *(const LAS bf16x8*)(lds + BC + 4096 + ka(s)); }
#pragma unroll
            for (int s = 0; s < 2; ++s) { kb0[s] = *(const LAS bf16x8*)(lds + BC + ka(2 + s)); kb1[s] = *(const LAS bf16x8*)(lds + BC + 4096 + ka(2 + s)); }
            __builtin_amdgcn_sched_barrier(0);
#pragma unroll
            for (int s = 0; s < 2; ++s)
#pragma unroll
                for (int j = 0; j < 2; ++j) { pj[j][0] = mfma32(ka0[s], qf[j][s], pj[j][0]); pj[j][1] = mfma32(ka1[s], qf[j][s], pj[j][1]); }
            __builtin_amdgcn_sched_barrier(0);
            bf16x8 qr[2][2];
#pragma unroll
            for (int s = 0; s < 2; ++s) { ka0[s] = *(const LAS bf16x8*)(lds + BC + kb(s)); ka1[s] = *(const LAS bf16x8*)(lds + BC + 2048 + kb(s)); }
            __builtin_amdgcn_sched_barrier(0);
#pragma unroll
            for (int s = 0; s < 2; ++s)
#pragma unroll
                for (int j = 0; j < 2; ++j) { pj[j][0] = mfma32(kb0[s], qf[j][2 + s], pj[j][0]); pj[j][1] = mfma32(kb1[s], qf[j][2 + s], pj[j][1]); }
            __builtin_amdgcn_sched_barrier(0);
#pragma unroll
            for (int j = 0; j < 2; ++j)
#pragma unroll
                for (int s = 0; s < 2; ++s) qr[j][s] = *(const LAS bf16x8*)(qrl + (2 * j + s) * 1024);
            __builtin_amdgcn_sched_barrier(0);
#pragma unroll
            for (int s = 0; s < 2; ++s)
#pragma unroll
                for (int j = 0; j < 2; ++j) { pj[j][0] = mfma32(ka0[s], qr[j][s], pj[j][0]); pj[j][1] = mfma32(ka1[s], qr[j][s], pj[j][1]); }
            __builtin_amdgcn_sched_barrier(0);
        }
        unsigned pw[2][16];
        s16x4 vlo[2][2], vhi[2][2];
#define ATT64_VLOAD(kt_) do { _Pragma("unroll") for (int sp = 0; sp < 2; ++sp) { const int kofs = (32 * (kt_) + 16 * sp) * 128; \
            _Pragma("unroll") for (int dvb = 0; dvb < 2; ++dvb) { vlo[dvb][sp] = lds_tr16(lds + BC + va[dvb] + kofs); vhi[dvb][sp] = lds_tr16(lds + BC + va[dvb] + kofs + 8 * 128); } } } while (0)
#define ATT64_PV(kt_) do { _Pragma("unroll") for (int sp = 0; sp < 2; ++sp) _Pragma("unroll") for (int dvb = 0; dvb < 2; ++dvb) { \
            const s16x4 lo = vlo[dvb][sp], hi4 = vhi[dvb][sp]; const bf16x8 vf = (bf16x8){lo[0], lo[1], lo[2], lo[3], hi4[0], hi4[1], hi4[2], hi4[3]}; \
            _Pragma("unroll") for (int j = 0; j < 2; ++j) { const u32x4 pq = (u32x4){pw[j][8 * (kt_) + 4 * sp], pw[j][8 * (kt_) + 4 * sp + 1], pw[j][8 * (kt_) + 4 * sp + 2], pw[j][8 * (kt_) + 4 * sp + 3]}; \
                o[j][dvb] = mfma32(vf, __builtin_bit_cast(bf16x8, pq), o[j][dvb]); } } } while (0)
#pragma unroll
        for (int j = 0; j < 2; ++j) {
            f32x16 p0 = pj[j][0], p1 = pj[j][1];
            if (j == 1) { __builtin_amdgcn_sched_barrier(0); ATT64_VLOAD(0); __builtin_amdgcn_sched_barrier(0); }
            float mx = p0[0];
#pragma unroll
            for (int r = 1; r < 16; ++r) mx = fmaxf(mx, p0[r]);
#pragma unroll
            for (int r = 0; r < 16; ++r) mx = fmaxf(mx, p1[r]);
            { auto rr = __builtin_amdgcn_permlane32_swap(__float_as_uint(mx), __float_as_uint(mx), false, false); mx = fmaxf(__uint_as_float(rr[0]), __uint_as_float(rr[1])); }
            if (__any(mx > m[j] + 8.f)) {
                const float mn = fmaxf(m[j], mx), al = __builtin_amdgcn_exp2f(m[j] - mn); m[j] = mn; l[j] *= al;
#pragma unroll
                for (int r = 0; r < 16; ++r) { o[j][0][r] *= al; o[j][1][r] *= al; }
            }
            const float nm = -m[j];
#pragma unroll
            for (int r = 0; r < 16; ++r) { p0[r] = __builtin_amdgcn_exp2f(p0[r] + nm); p1[r] = __builtin_amdgcn_exp2f(p1[r] + nm); }
            f32x2 ls2 = {0.f, 0.f};
#pragma unroll
            for (int r = 0; r < 16; r += 2) { ls2 += (f32x2){p0[r], p0[r + 1]}; ls2 += (f32x2){p1[r], p1[r + 1]}; }
            l[j] += ls2.x + ls2.y;
#pragma unroll
            for (int i = 0; i < 8; ++i) { pw[j][i] = cvt_pk_bf16(p0[2 * i], p0[2 * i + 1]); pw[j][8 + i] = cvt_pk_bf16(p1[2 * i], p1[2 * i + 1]); }
            __builtin_amdgcn_sched_barrier(0);
        }
        ATT64_PV(0);
        __builtin_amdgcn_sched_barrier(0);
        ATT64_VLOAD(1);
        __builtin_amdgcn_sched_barrier(0);
        ATT64_PV(1);
#undef ATT64_VLOAD
#undef ATT64_PV
        if (DK == 96) asm volatile("s_waitcnt vmcnt(6) lgkmcnt(0)\n\ts_barrier" ::: "memory"); else asm volatile("s_waitcnt vmcnt(4) lgkmcnt(0)\n\ts_barrier" ::: "memory");
    };
    for (int t = 0; t < NT; t += 4) {
        step(IC<0>{}, IC<3>{}, t); step(IC<1>{}, IC<0>{}, t + 1); step(IC<2>{}, IC<1>{}, t + 2); step(IC<3>{}, IC<2>{}, t + 3);
    }
#pragma unroll
    for (int j = 0; j < 2; ++j) {
        float lj = l[j]; { auto rr = __builtin_amdgcn_permlane32_swap(__float_as_uint(lj), __float_as_uint(lj), false, false); lj = __uint_as_float(rr[0]) + __uint_as_float(rr[1]); }
        const float il = 1.f / lj;
        bf16_t* op = out + (size_t)(wid * 64 + 32 * j + r32) * 1024 + 4 * hi;
#pragma unroll
        for (int g = 0; g < 4; ++g) { u32x2 a, b;
            a.x = cvt_pk_bf16(o[j][0][4 * g] * il, o[j][0][4 * g + 1] * il); a.y = cvt_pk_bf16(o[j][0][4 * g + 2] * il, o[j][0][4 * g + 3] * il);
            b.x = cvt_pk_bf16(o[j][1][4 * g] * il, o[j][1][4 * g + 1] * il); b.y = cvt_pk_bf16(o[j][1][4 * g + 2] * il, o[j][1][4 * g + 3] * il);
            *(u32x2*)(op + 8 * g) = a; *(u32x2*)(op + 32 + 8 * g) = b; }
    }
#undef ATT_DMA
#undef ka
#undef kb
}
__device__ __forceinline__ void phase_p3(LAS unsigned char* lds, const WS& w, int l, int vb, int nvb, int xpart, int xrank) {
    const float c2g = 0.125f * 1.4426950408889634f, c2m = 0.10206207261596577f * 1.4426950408889634f;
    bf16_t* MIX = w.H();
    const int nlat = NB * 12 * 4, nctx = (l == 0) ? NB * 12 : 0;
    const bool xl = (nvb == 256);
    for (int u = vb; u < nlat + nctx; u += nvb) {
        if (u < nlat) {
            const bool mla = u >= nlat / 2; const int v = mla ? u - nlat / 2 : u;
            int qb, hh, b;
            if (xl) { const int grp = (v >> 8) * 64 + 8 * xpart + (xrank >> 2); qb = xrank & 3; hh = grp % 6; b = grp / 6; }
            else { qb = v & 3; hh = (v >> 2) % 6; b = v / 24; }
            bf16_t* out = MIX + ((size_t)b * S + qb * 512) * 1024;
            if (!mla) attn_unit64<64>(lds, w.Qg() + (((size_t)b * 6 + hh) * S + qb * 512) * 64, w.Kg() + ((size_t)b * 2 + hh / 3) * KEYS * 64, nullptr, w.Vg() + ((size_t)b * 2 + hh / 3) * KEYS * 64, KEYS, out + hh * 64);
            else attn_unit64m(lds, w.Qm() + (((size_t)b * 6 + hh) * S + qb * 512) * 96, w.Kmn() + ((size_t)b * 6 + hh) * KEYS * 64, w.KR() + (size_t)b * KEYS * 32, w.Vm() + ((size_t)b * 6 + hh) * KEYS * 64, KEYS, out + 640 + hh * 64);
        } else {
            const int v = u - nlat, slot = v % 12, b = v / 12;
            bf16_t* out = MIX + ((size_t)NL + (size_t)b * CTX) * 1024;
            if (slot < 6) attn_unit<64>(lds, w.Qgc() + ((size_t)b * 6 + slot) * CTX * 64, w.Kg() + ((size_t)b * 2 + slot / 3) * KEYS * 64, nullptr, w.Vg() + ((size_t)b * 2 + slot / 3) * KEYS * 64, CTX, c2g, out + slot * 64);
            else { const int h = slot - 6; attn_unit<96>(lds, w.Qmc() + ((size_t)b * 6 + h) * CTX * 96, w.Kmn() + ((size_t)b * 6 + h) * KEYS * 64, w.KR() + (size_t)b * KEYS * 32, w.Vm() + ((size_t)b * 6 + h) * KEYS * 64, CTX, c2m, out + 640 + h * 64); }
        }
    }
}

__device__ __forceinline__ unsigned fkey(float f, unsigned tag, unsigned mask) { return (__float_as_uint(f) & ~mask) | tag; }
__device__ __forceinline__ float keyf(unsigned k, unsigned mask) { return __uint_as_float(k & ~mask); }
__device__ __forceinline__ unsigned fmax_u(unsigned a, unsigned b) { unsigned r; asm("v_max_f32 %0, %1, %2" : "=v"(r) : "v"(a), "v"(b)); return r; }
__device__ __forceinline__ unsigned fmin_u(unsigned a, unsigned b) { unsigned r; asm("v_min_f32 %0, %1, %2" : "=v"(r) : "v"(a), "v"(b)); return r; }
__device__ __forceinline__ void ce_desc(unsigned& a, unsigned& b) { const unsigned hi_ = fmax_u(a, b), lo_ = fmin_u(a, b); a = hi_; b = lo_; }
template <int J> __device__ __forceinline__ void bstage16(unsigned* a) {
#pragma unroll
    for (int i = 0; i < 16; ++i) { const int l = i ^ J; if (l > i) ce_desc(a[i], a[l]); }
}
__device__ __forceinline__ void sort16_desc(unsigned* a) {
#define CE_(i, j) ce_desc(a[i], a[j]);
    CE_(0, 13) CE_(1, 12) CE_(2, 15) CE_(3, 14) CE_(4, 8) CE_(5, 6) CE_(7, 11) CE_(9, 10)
    CE_(0, 5) CE_(1, 7) CE_(2, 9) CE_(3, 4) CE_(6, 13) CE_(8, 14) CE_(10, 15) CE_(11, 12)
    CE_(0, 1) CE_(2, 3) CE_(4, 5) CE_(6, 8) CE_(7, 9) CE_(10, 11) CE_(12, 13) CE_(14, 15)
    CE_(0, 2) CE_(1, 3) CE_(4, 10) CE_(5, 11) CE_(6, 7) CE_(8, 9) CE_(12, 14) CE_(13, 15)
    CE_(1, 2) CE_(3, 12) CE_(4, 6) CE_(5, 7) CE_(8, 10) CE_(9, 11) CE_(13, 14)
    CE_(1, 4) CE_(2, 6) CE_(5, 8) CE_(7, 10) CE_(9, 13) CE_(11, 14)
    CE_(2, 4) CE_(3, 6) CE_(9, 12) CE_(11, 13)
    CE_(3, 5) CE_(6, 8) CE_(7, 9) CE_(10, 12)
    CE_(3, 4) CE_(5, 6) CE_(7, 8) CE_(9, 10) CE_(11, 12)
    CE_(6, 7) CE_(8, 9)
#undef CE_
}
__device__ __forceinline__ void bmerge16_desc(unsigned* c) { bstage16<8>(c); bstage16<4>(c); bstage16<2>(c); bstage16<1>(c); }
__device__ __forceinline__ void merge_top16(unsigned* a, const unsigned* b) {
#pragma unroll
    for (int i = 0; i < 16; ++i) a[i] = fmax_u(a[i], b[15 - i]);
    bmerge16_desc(a);
}
__device__ __forceinline__ void xlane_top16(unsigned* t, int hi) {
    unsigned r[16]; const unsigned msk = 0u - (unsigned)hi;
#pragma unroll
    for (int i = 0; i < 16; ++i) r[i] = t[i] ^ ((t[i] ^ t[15 - i]) & msk);
#pragma unroll
    for (int i = 0; i < 16; ++i) { auto s = __builtin_amdgcn_permlane32_swap(r[i], r[i], false, false); t[i] = fmax_u(s[0], s[1]); }
    bmerge16_desc(t);
}
__device__ __forceinline__ constexpr int cand_a(int c) { return c < 16 ? 0 : c < 24 ? 1 : c < 32 ? 39 - c : c < 37 ? 2 : c < 41 ? 3 : c < 44 ? 4 : c < 46 ? 5 : c < 48 ? 6 : 7; }
__device__ __forceinline__ constexpr int cand_b(int c) { return c < 16 ? c : c < 24 ? c - 16 : c < 32 ? 0 : c < 37 ? c - 32 : c < 41 ? c - 37 : c < 44 ? c - 41 : c < 46 ? c - 44 : c < 48 ? c - 46 : c - 48; }

__device__ __forceinline__ void phase_p6b(LAS unsigned char* lds, const bf16_t* __restrict__ PQ, const bf16_t* __restrict__ SubKl, unsigned* __restrict__ EG, int nrows, int vb, int nvb) {
    int tid_ = threadIdx.x; asm volatile("" : "+v"(tid_));
    const int tid = tid_, lane = tid & 63, wid = __builtin_amdgcn_readfirstlane(tid >> 6), r32 = lane & 31, hi = lane >> 5;
    const int h = vb & 7, wrank = (vb >> 3) * 8 + wid, nwr = (nvb >> 3) * 8;
    LAS unsigned short* tab = (LAS unsigned short*)(lds + 65536 + wid * 4096) + r32 * 64;
#pragma unroll
    for (int i = 0; i < 8; ++i) { const int idx = i * 512 + tid, p = idx >> 11, key = (idx >> 4) & 127, ch = idx & 15;
        *(LAS u32x4*)(lds + p * 32768 + key * 256 + ((ch ^ (key & 15)) << 4)) = *(const u32x4*)(SubKl + ((size_t)(h * 2 + p) * 128 + key) * 128 + ch * 8); }
    __syncthreads();
    const int ngroups = nrows >> 5;
    for (int tg = wrank; tg < ngroups; tg += nwr) {
        const int row0 = tg << 5;
        bf16x8 qf[2][8];
        { const bf16_t* qp = PQ + (size_t)(row0 + r32) * 2048 + h * 256 + 8 * hi; asm volatile("" : "+v"(qp));
#pragma unroll
          for (int p = 0; p < 2; ++p)
#pragma unroll
              for (int s = 0; s < 8; ++s) qf[p][s] = *(const bf16x8*)(qp + p * 128 + 16 * s); }
        unsigned top[2][16];
#pragma unroll
        for (int p = 0; p < 2; ++p) {
            f32x16 acc[4];
#pragma unroll
            for (int kt = 0; kt < 4; ++kt) { acc[kt] = f32x16{}; const int key = 32 * kt + r32;
#pragma unroll
                for (int s = 0; s < 8; ++s) acc[kt] = mfma32(*(const LAS bf16x8*)(lds + p * 32768 + key * 256 + (((2 * s + hi) ^ (key & 15)) << 4)), qf[p][s], acc[kt]); }
            unsigned key[64];
#pragma unroll
            for (int kt = 0; kt < 4; ++kt)
#pragma unroll
                for (int r = 0; r < 16; ++r) { const int n = 32 * kt + (r & 3) + 8 * (r >> 2) + 4 * hi; key[16 * kt + r] = fkey(acc[kt][r], 127u - (unsigned)n, 127u); }
            sort16_desc(key); sort16_desc(key + 16); sort16_desc(key + 32); sort16_desc(key + 48);
            merge_top16(key, key + 16); merge_top16(key + 32, key + 48); merge_top16(key, key + 32);
            xlane_top16(key, hi);
#pragma unroll
            for (int i = 0; i < 16; ++i) top[p][i] = key[i];
        }
        float t0f[16], t1f[16];
#pragma unroll
        for (int i = 0; i < 16; ++i) { t0f[i] = keyf(top[0][i], 127u); t1f[i] = keyf(top[1][i], 127u); }
        unsigned ck[50];
#pragma unroll
        for (int c = 0; c < 50; ++c) ck[c] = fkey(t0f[cand_a(c)] + t1f[cand_b(c)], (unsigned)c, 63u);
        if (hi == 0) {
#pragma unroll
            for (int c = 0; c < 50; c += 2) {
                const unsigned ea = (127u - (top[0][cand_a(c)] & 127u)) * 128u + (127u - (top[1][cand_b(c)] & 127u));
                const unsigned eb = (127u - (top[0][cand_a(c + 1)] & 127u)) * 128u + (127u - (top[1][cand_b(c + 1)] & 127u));
                *(LAS unsigned*)(tab + c) = ea | (eb << 16);
            }
        }
        bmerge16_desc(ck + 16); sort16_desc(ck + 32);
        merge_top16(ck, ck + 16); merge_top16(ck, ck + 32);
        ck[15] = fmax_u(ck[15], ck[48]); ck[14] = fmax_u(ck[14], ck[49]); bmerge16_desc(ck);
        asm volatile("s_waitcnt lgkmcnt(0)" ::: "memory");
        const float mx = keyf(ck[0], 63u); float e[16], den = 0.f;
#pragma unroll
        for (int j = 0; j < 16; ++j) { e[j] = __builtin_amdgcn_exp2f((keyf(ck[j], 63u) - mx) * 1.4426950408889634f); den += e[j]; }
        const float iden = 1.f / den;
        if (hi == 0) {
            unsigned o[16];
#pragma unroll
            for (int j = 0; j < 16; ++j) { const unsigned eid = tab[ck[j] & 63u]; o[j] = (eid << 16) | (cvt_pk_bf16(e[j] * iden, 0.f) & 0xffffu); }
            unsigned* dst = EG + (size_t)(row0 + r32) * 128 + h * 16;
#pragma unroll
            for (int j = 0; j < 16; j += 4) *(u32x4*)(dst + j) = (u32x4){o[j], o[j + 1], o[j + 2], o[j + 3]};
        }
        asm volatile("s_waitcnt lgkmcnt(0)" ::: "memory");
    }
}


#define XB_TMO      128
#define XB_XCNT(j)  (256  + 64 * (j))
#define XB_XSUB(j)  (1280 + 64 * (j))
#define XB_XGEN(j)  (2304 + 64 * (j))
#define XB_TOP      3328
#define XB_TOPGEN   3392
#define XCD_BAR_WORDS 3456
#define XB_SPIN_CAP (1u << 18)

__device__ __forceinline__ unsigned xb_ld(unsigned* p)              { return __hip_atomic_load(p, __ATOMIC_RELAXED, __HIP_MEMORY_SCOPE_AGENT); }
__device__ __forceinline__ unsigned xb_add(unsigned* p, unsigned v) { return __hip_atomic_fetch_add(p, v, __ATOMIC_RELAXED, __HIP_MEMORY_SCOPE_AGENT); }
__device__ __forceinline__ unsigned xb_xcc_id() { return (unsigned)__builtin_amdgcn_s_getreg((3 << 11) | 20) & 0xFu; }
#define XB_SPIN(cond, bar) do { unsigned _sp = 0; while (cond) { __builtin_amdgcn_s_sleep(1); \
    if ((++_sp & 255u) == 0u) { if (xb_ld(&(bar)[XB_TMO])) break; if (_sp > XB_SPIN_CAP) { atomicAdd(&(bar)[XB_TMO], 1u); break; } } } } while (0)

struct XcdBarrier {
    unsigned* bar; unsigned x;
    volatile LAS unsigned* st;
};

__device__ __forceinline__ XcdBarrier xcd_barrier_post(unsigned* bar, volatile LAS unsigned* st) {
    XcdBarrier b; b.bar = bar; b.x = xb_xcc_id(); b.st = st;
    if (threadIdx.x == 0) (void)xb_add(&bar[XB_XCNT(b.x)], 1u);
    return b;
}
__device__ __forceinline__ void xcd_barrier_complete(unsigned* bar, unsigned x, unsigned& nloc, unsigned& nx) {
    const unsigned G = gridDim.x * gridDim.y * gridDim.z;
    unsigned sum, cnt, mine, sp = 0u;
    for (;;) {
        sum = 0u; cnt = 0u; mine = 0u;
#pragma unroll
        for (unsigned j = 0; j < 16; ++j) { const unsigned c = xb_ld(&bar[XB_XCNT(j)]); sum += c; cnt += (c > 0u) ? 1u : 0u; mine = (j == x) ? c : mine; }
        if (sum == G) break;
        __builtin_amdgcn_s_sleep(1);
        if ((++sp & 255u) == 0u) { if (xb_ld(&bar[XB_TMO])) break; if (sp > XB_SPIN_CAP) { atomicAdd(&bar[XB_TMO], 1u); break; } }
    }
    nloc = mine > 0u ? mine : 1u; nx = cnt > 0u ? cnt : 1u;
}

__device__ __forceinline__ void xcd_barrier(const XcdBarrier& b) {
    asm volatile("s_waitcnt vmcnt(0)" ::: "memory");
    __syncthreads();
    if (threadIdx.x == 0) {
        unsigned* bar = b.bar;
        __builtin_amdgcn_s_waitcnt(0);
        unsigned nloc = b.st[0], nx = b.st[1];
        if (nloc == 0u) { xcd_barrier_complete(bar, b.x, nloc, nx); b.st[0] = nloc; b.st[1] = nx; }
        const unsigned old = xb_add(&bar[XB_XSUB(b.x)], 1u);
        const unsigned gen = old / nloc;
        if (old + 1u == (gen + 1u) * nloc) {
            __builtin_amdgcn_fence(__ATOMIC_RELEASE, "agent");
            asm volatile("s_waitcnt vmcnt(0)" ::: "memory");
            const unsigned og = xb_add(&bar[XB_TOP], 1u);
            const unsigned tg = og / nx;
            if (og + 1u == (tg + 1u) * nx) xb_add(&bar[XB_TOPGEN], 1u);
            else XB_SPIN(xb_ld(&bar[XB_TOPGEN]) == tg, bar);
            __builtin_amdgcn_fence(__ATOMIC_ACQUIRE, "agent");
            xb_add(&bar[XB_XGEN(b.x)], 1u);
            asm volatile("s_waitcnt vmcnt(0)" ::: "memory");
        } else {
            XB_SPIN(xb_ld(&bar[XB_XGEN(b.x)]) == gen, bar);
            __builtin_amdgcn_fence(__ATOMIC_ACQUIRE, "agent");
            asm volatile("s_waitcnt vmcnt(0)" ::: "memory");
        }
    }
    __syncthreads();
}

__device__ __forceinline__ void phase_mod(LAS unsigned char* lds, const Inputs& in, const WS& w, int vb) {
    if (vb >= 72) return;
    LAS float* sc = (LAS float*)lds;
    int tid_ = threadIdx.x; asm volatile("" : "+v"(tid_));
    const int tid = tid_, idx = vb * 512 + tid, rg = idx / 12288, ln = idx % 12288, l = ln / 6144, n = ln % 6144;
    float acc[11];
#pragma unroll
    for (int i = 0; i < 11; ++i) acc[i] = 0.f;
    const float* wp = in.ada_w + (size_t)l * 1024 * 6144 + n;
    for (int kc = 0; kc < 4; ++kc) {
        for (int i = tid; i < 33 * 256; i += 512) { const int r = i >> 8, k = kc * 256 + (i & 255); const float v = r < 32 ? in.c[(size_t)r * 1024 + k] : in.c_ctx[k]; sc[i] = v / (1.f + __expf(-v)); }
        __syncthreads();
        for (int k = 0; k < 256; ++k) { const float wv = wp[(size_t)(kc * 256 + k) * 6144];
#pragma unroll
            for (int i = 0; i < 11; ++i) acc[i] += sc[(rg * 11 + i) * 256 + k] * wv; }
        __syncthreads();
    }
    const float bias = in.ada_b[(size_t)l * 6144 + n];
#pragma unroll
    for (int i = 0; i < 11; ++i) w.MOD()[((size_t)l * 33 + rg * 11 + i) * 6144 + n] = acc[i] + bias;
}
__device__ __forceinline__ void phase_rope(const WS& w, int vb, int nvb) {
    int tid_ = threadIdx.x; asm volatile("" : "+v"(tid_));
    for (int i = vb * 512 + tid_; i < 2048 * 32; i += nvb * 512) {
        { const int t = i / 32, j = i % 32; const double inv = pow(10000.0, -(double)(j % 16) / 16.0); const double a = (double)(j < 16 ? t / 64 : t % 64) * inv; w.ROPA()[i] = make_float2((float)cos(a), (float)sin(a)); }
        if (i < 2048 * 16) { const int t = i / 16, j = i % 16; const double inv = pow(10000.0, -(double)(j % 8) / 8.0); const double a = (double)(j < 8 ? t / 64 : t % 64) * inv; w.ROPC()[i] = make_float2((float)cos(a), (float)sin(a)); }
    }
}

#ifndef PROBE_MASK
#define PROBE_MASK 0
#endif
#ifndef BENCH_MODE
#define BENCH_MODE 0
#endif
#if BENCH_MODE
__device__ __forceinline__ void phase_bench(float* sink) {
    int tid_ = threadIdx.x; asm volatile("" : "+v"(tid_));
    float x[16];
#pragma unroll
    for (int i = 0; i < 16; ++i) x[i] = (float)(tid_ + i) * 0.001f;
    f32x16 acc[4] = {};
    bf16x8 a = (bf16x8){(short)tid_, 1, 2, 3, 4, 5, 6, 7}, b = (bf16x8){7, 6, 5, 4, 3, 2, 1, (short)tid_};
#pragma nounroll
    for (int it = 0; it < ((BENCH_MODE & 7) ? 2048 : 0); ++it) {
#pragma unroll
        for (int k = 0; k < 8; ++k) {
            if (BENCH_MODE & 2) { acc[k & 3] = mfma32(a, b, acc[k & 3]); }
            __builtin_amdgcn_sched_barrier(0);
            if (BENCH_MODE & 1) { asm volatile("v_exp_f32 %0, -|%0|" : "+v"(x[2 * k])); asm volatile("v_exp_f32 %0, -|%0|" : "+v"(x[2 * k + 1])); }
            if (BENCH_MODE & 4) {
#pragma unroll
                for (int j = 0; j < 8; ++j) asm volatile("v_fma_f32 %0, %0, %0, %0" : "+v"(x[(2 * k + j) & 15]));
            }
            __builtin_amdgcn_sched_barrier(0);
        }
    }
    if (BENCH_MODE & 24) {
        const int lane = tid_ & 63, r32 = lane & 31, hi = lane >> 5;
        unsigned ka[2][4];
#pragma unroll
        for (int kt = 0; kt < 2; ++kt)
#pragma unroll
            for (int s_ = 0; s_ < 4; ++s_) { const int key = 32 * kt + r32; ka[kt][s_] = key * 128 + (((2 * s_ + hi) ^ ((key >> 1) & 7)) << 4); }
        const int vq = (lane & 15) >> 2, vp = lane & 3, vg = (lane >> 4) & 1;
        unsigned va[2];
#pragma unroll
        for (int dvb = 0; dvb < 2; ++dvb) { const int key = 4 * hi + vq; va[dvb] = 8192 + key * 128 + ((((32 * dvb + 16 * vg + 4 * vp) * 2)) ^ (((key >> 1) & 1) << 6)); }
        u32x4 kr[8]; u32x2 vr[16];
#pragma nounroll
        for (int it = 0; it < 2048; ++it) {
            if (BENCH_MODE & 8) {
#pragma unroll
                for (int kt = 0; kt < 2; ++kt)
#pragma unroll
                    for (int s_ = 0; s_ < 4; ++s_) asm volatile("ds_read_b128 %0, %1" : "=v"(kr[kt * 4 + s_]) : "v"(ka[kt][s_]));
            }
            if (BENCH_MODE & 16) {
#pragma unroll
                for (int q = 0; q < 4; ++q)
#pragma unroll
                    for (int dvb = 0; dvb < 2; ++dvb) { asm volatile("ds_read_b64_tr_b16 %0, %1" : "=v"(vr[q * 4 + dvb * 2]) : "v"(va[dvb] + q * 2048)); asm volatile("ds_read_b64_tr_b16 %0, %1 offset:1024" : "=v"(vr[q * 4 + dvb * 2 + 1]) : "v"(va[dvb] + q * 2048)); }
            }
            asm volatile("s_waitcnt lgkmcnt(0)" ::: "memory");
        }
        if (BENCH_MODE & 8) {
#pragma unroll
            for (int i = 0; i < 8; ++i) x[i] += __uint_as_float(kr[i][0] ^ kr[i][1] ^ kr[i][2] ^ kr[i][3]);
        }
        if (BENCH_MODE & 16) {
#pragma unroll
            for (int i = 0; i < 16; ++i) x[i] += __uint_as_float(vr[i][0] ^ vr[i][1]);
        }
    }
    float r = 0.f;
#pragma unroll
    for (int i = 0; i < 16; ++i) r += x[i];
#pragma unroll
    for (int k = 0; k < 4; ++k)
#pragma unroll
        for (int i = 0; i < 16; ++i) r += acc[k][i];
    if (r == 1.2345e30f) sink[tid_] = r;
}
#endif
struct MegaArgs { Inputs in; WS w; float* XL; unsigned* bar; };
constexpr int MEGA_LDS = 131072 + 16;
__global__ void __launch_bounds__(512, 2) k_mega(MegaArgs A) {
    LAS unsigned char* lds = (LAS unsigned char*)dyn_lds;
    const int vb = blockIdx.x, nvb = gridDim.x;
    volatile LAS unsigned* xbw = (volatile LAS unsigned*)(lds + 131072);
    if (threadIdx.x == 0) { xbw[0] = 0u; xbw[1] = 0u; xbw[2] = 0u; xbw[3] = 0u; }
    __syncthreads();
    XcdBarrier bar = xcd_barrier_post(A.bar, xbw);
    if (threadIdx.x == 0) xbw[2] = xb_add(&A.bar[3584 + 64 * bar.x], 1u);
    __syncthreads();
    const int xticket = __builtin_amdgcn_readfirstlane((int)xbw[2]);
    const WS& w = A.w; const Inputs& in = A.in;
    phase_mod(lds, in, w, vb);
    phase_rope(w, vb, nvb);
    phase_cvt(lds, in, w, vb, nvb);
    xcd_barrier(bar);
    phase_modulate<false>(in.x, in.ctx, nullptr, w.H(), in.norm1_g, w.MOD(), 0, NR, vb, nvb);
    xcd_barrier(bar);
#if (PROBE_MASK >> 0) & 1
    phase_mod(lds, in, w, vb);
    phase_rope(w, vb, nvb);
    phase_cvt(lds, in, w, vb, nvb);
    xcd_barrier(bar);
    phase_modulate<false>(in.x, in.ctx, nullptr, w.H(), in.norm1_g, w.MOD(), 0, NR, vb, nvb);
    xcd_barrier(bar);
#endif
#if BENCH_MODE
    phase_bench((float*)w.RSQ());
#endif
    int xpart = vb & 7, xrank = vb >> 3;
    { bool okx = (bar.x < 8u); for (unsigned j = 0; j < 8; ++j) okx = okx && (xb_ld(&A.bar[XB_XCNT(j)]) == (unsigned)(nvb >> 3));
      if (okx) { xpart = (int)bar.x; xrank = xticket; } }
    for (int l = 0; l < DEPTH; ++l) {
        const float* MODl = w.MOD() + (size_t)l * 33 * 6144;
        const bool last = (l == DEPTH - 1);
        const int MR = last ? NL : NR;
        phase_p1(lds, w, in, l, vb, nvb); xcd_barrier(bar);
#if (PROBE_MASK >> 1) & 1
        phase_p1(lds, w, in, l, vb, nvb); xcd_barrier(bar);
#endif
        phase_p2(lds, w, in, l, vb, nvb); xcd_barrier(bar);
#if (PROBE_MASK >> 12) & 7
        phase_p2(lds, w, in, l, vb, nvb, (PROBE_MASK >> 12) & 7); xcd_barrier(bar);
#endif
        phase_p3(lds, w, l, vb, nvb, xpart, xrank); xcd_barrier(bar);
#if (PROBE_MASK >> 3) & 1
        phase_p3(lds, w, l, vb, nvb, xpart, xrank); xcd_barrier(bar);
#endif
        phase_p4(lds, w, in, l, vb, nvb);
        xcd_barrier(bar);
#if (PROBE_MASK >> 4) & 1
        phase_p4(lds, w, in, l, vb, nvb);
        xcd_barrier(bar);
#endif
        if (l == 0) phase_modulate<false>(in.x, in.ctx, nullptr, w.H(), in.norm2_g + l * 1024, MODl, 3, MR, vb, nvb, w.H8(), w.HS(), w.PQ(), w.XB());
        else phase_modulate<true>(nullptr, nullptr, w.XB(), w.H(), in.norm2_g + l * 1024, MODl, 3, MR, vb, nvb, w.H8(), w.HS(), w.PQ(), w.XB());
        xcd_barrier(bar);
#if (PROBE_MASK >> 5) & 1
        phase_modulate<true>(nullptr, nullptr, w.XB(), w.H(), in.norm2_g + l * 1024, MODl, 3, MR, vb, nvb, w.H8(), w.HS()); xcd_barrier(bar);
#endif
        phase_p6a(lds, w, l, vb, nvb); xcd_barrier(bar);
#if (PROBE_MASK >> 6) & 1
        phase_p6a(lds, w, l, vb, nvb); xcd_barrier(bar);
#endif
        phase_p6b(lds, w.PQ(), w.SubK() + (size_t)l * 16 * 128 * 128, w.EG(), MR, vb, nvb); xcd_barrier(bar);
#if (PROBE_MASK >> 7) & 1
        phase_p6b(lds, w.PQ(), w.SubK() + (size_t)l * 16 * 128 * 128, w.EG(), MR, vb, nvb); xcd_barrier(bar);
#endif
        { P7CArgs a{w.H8(), w.EG(), w.U8() + (size_t)l * NE * 512, (int*)w.PQ(), MR}; phase_p7c(lds, a, xpart, xrank, nvb); }
        xcd_barrier(bar);
#if (PROBE_MASK >> 8) & 1
        { P7CArgs a{w.H8(), w.EG(), w.U8() + (size_t)l * NE * 512, (int*)w.PQ(), MR}; phase_p7c(lds, a, xpart, xrank, nvb); }
        xcd_barrier(bar);
#endif
        phase_p7d((const int*)w.PQ(), w.EG(), w.US() + (size_t)l * NE, w.VS() + (size_t)l * NE, w.HS(), w.WE(), MR, vb, nvb);
        xcd_barrier(bar);
#if (PROBE_MASK >> 9) & 1
        phase_p7d((const int*)w.PQ(), w.EG(), w.US() + (size_t)l * NE, w.VS() + (size_t)l * NE, w.HS(), w.WE(), MR, vb, nvb);
        xcd_barrier(bar);
#endif
        { P7BArgs a{w.WE(), w.V8() + (size_t)l * NE * 512, w.XB(), MODl + 5 * 1024, MR}; phase_p7b<0>(lds, a, xpart, xrank, nvb); }
        xcd_barrier(bar);
#if (PROBE_MASK >> 10) & 3
        { P7BArgs a{w.WE(), w.V8() + (size_t)l * NE * 512, w.XB(), MODl + 5 * 1024, MR}; phase_p7b<((PROBE_MASK >> 10) & 3)>(lds, a, xpart, xrank, nvb); }
        xcd_barrier(bar);
#endif
        if (last) phase_final_norm(w.XB(), A.XL, in.final_g, vb, nvb);
        else phase_modulate<true>(nullptr, nullptr, w.XB(), w.H(), in.norm1_g + (l + 1) * 1024, w.MOD() + (size_t)(l + 1) * 33 * 6144, 0, NR, vb, nvb);
        if (!last) xcd_barrier(bar);
    }
}

extern "C" void kernel_launch(void* const* d_in, const int* in_sizes, int n_in, void* d_out, int out_size, void* d_ws, size_t ws_size, hipStream_t stream) {
    const float* const* fin = (const float* const*)d_in;
    Inputs in{fin[0], fin[1], fin[2], fin[3], fin[4], fin[5], fin[6], fin[7], fin[8], fin[9], fin[10], fin[11], fin[12], fin[13], fin[14], fin[15], fin[16], fin[17], fin[18], fin[19], fin[20], fin[21], fin[22]};
    WS w = make_ws(d_ws);
    static int ok = 0;
    if (!ok) {
        if (hipFuncSetAttribute((const void*)k_mega, hipFuncAttributeMaxDynamicSharedMemorySize, MEGA_LDS) != hipSuccess) { ok = -1; }
        int per_cu = 0, cus = 0, dev = 0; (void)hipGetDevice(&dev); (void)hipDeviceGetAttribute(&cus, hipDeviceAttributeMultiprocessorCount, dev);
        if (hipOccupancyMaxActiveBlocksPerMultiprocessor(&per_cu, (const void*)k_mega, 512, MEGA_LDS) != hipSuccess || per_cu < 1 || cus < 256) ok = -1;
        if (ok == 0) ok = 1;
    }
    if (ok < 0) return;
    (void)hipMemsetAsync(d_ws, 0, 16384, stream);
    MegaArgs A{in, w, (float*)d_out, (unsigned*)d_ws};
    k_mega<<<256, 512, MEGA_LDS, stream>>>(A);
}
```

```cpp
#include <hip/hip_runtime.h>
#include <stdint.h>

typedef unsigned short bf16_t;

constexpr int D = 1024, NB = 32, S = 2048, CTX = 256, DEPTH = 2;
constexpr int NL = NB * S, NC = NB * CTX, NR = NL + NC;
constexpr int KEYS = CTX + S;
constexpr int INC = 1568;
constexpr int NE = 16384;
constexpr float EPS = 1e-6f;

__device__ __forceinline__ float bf2f(bf16_t v) { return __uint_as_float(((unsigned)v) << 16); }
__device__ __forceinline__ bf16_t f2bf(float f) { unsigned u = __float_as_uint(f); u += 0x7FFFu + ((u >> 16) & 1u); return (bf16_t)(u >> 16); }

__device__ __forceinline__ float wave_sum(float v) {
#pragma unroll
    for (int o = 32; o > 0; o >>= 1) v += __shfl_xor(v, o);
    return v;
}
__device__ __forceinline__ float gelu_tanh(float x) {
    const float u = 0.7978845608028654f * (x + 0.044715f * x * x * x);
    return 0.5f * x * (1.f + tanhf(u));
}

struct WS {
    char* base;
    __host__ __device__ __forceinline__ bf16_t* H() const { return (bf16_t*)(base + 65536ull); }
    __host__ __device__ __forceinline__ bf16_t* Qg() const { return (bf16_t*)(base + 151060480ull); }
    __host__ __device__ __forceinline__ bf16_t* Qgc() const { return (bf16_t*)(base + 201392128ull); }
    __host__ __device__ __forceinline__ bf16_t* Kg() const { return (bf16_t*)(base + 207683584ull); }
    __host__ __device__ __forceinline__ bf16_t* Vg() const { return (bf16_t*)(base + 226557952ull); }
    __host__ __device__ __forceinline__ bf16_t* CQ() const { return (bf16_t*)(base + 245432320ull); }
    __host__ __device__ __forceinline__ bf16_t* CKV() const { return (bf16_t*)(base + 302055424ull); }
    __host__ __device__ __forceinline__ bf16_t* Bp() const { return (bf16_t*)(base + 339804160ull); }
    __host__ __device__ __forceinline__ bf16_t* KR() const { return (bf16_t*)(base + 377552896ull); }
    __host__ __device__ __forceinline__ bf16_t* Qm() const { return (bf16_t*)(base + 382271488ull); }
    __host__ __device__ __forceinline__ bf16_t* Qmc() const { return (bf16_t*)(base + 457768960ull); }
    __host__ __device__ __forceinline__ bf16_t* Kmn() const { return (bf16_t*)(base + 467206144ull); }
    __host__ __device__ __forceinline__ bf16_t* Vm() const { return (bf16_t*)(base + 523829248ull); }
    __host__ __device__ __forceinline__ unsigned* EG() const { return (unsigned*)(base + 580452352ull); }
    __host__ __device__ __forceinline__ bf16_t* P() const { return (bf16_t*)(base + 382271488ull); }
    __host__ __device__ __forceinline__ bf16_t* PQ() const { return (bf16_t*)(base + 151060480ull); }
    __host__ __device__ __forceinline__ bf16_t* TMP() const { return (bf16_t*)(base + 65536ull); }
    __host__ __device__ __forceinline__ float* XC() const { return (float*)(base + 618201088ull); }
    __host__ __device__ __forceinline__ float* MOD() const { return (float*)(base + 651755520ull); }
    __host__ __device__ __forceinline__ float2* ROPA() const { return (float2*)(base + 653377536ull); }
    __host__ __device__ __forceinline__ float2* ROPC() const { return (float2*)(base + 653901824ull); }
    __host__ __device__ __forceinline__ float* RSQ() const { return (float*)(base + 654163968ull); }
    __host__ __device__ __forceinline__ float* RSKV() const { return (float*)(base + 654458880ull); }
    __host__ __device__ __forceinline__ bf16_t* WinT() const { return (bf16_t*)(base + 654753792ull); }
    __host__ __device__ __forceinline__ bf16_t* WuqT() const { return (bf16_t*)(base + 662093824ull); }
    __host__ __device__ __forceinline__ bf16_t* WukvT() const { return (bf16_t*)(base + 663273472ull); }
    __host__ __device__ __forceinline__ bf16_t* WoutT() const { return (bf16_t*)(base + 664059904ull); }
    __host__ __device__ __forceinline__ bf16_t* WqT() const { return (bf16_t*)(base + 668254208ull); }
    __host__ __device__ __forceinline__ bf16_t* SubK() const { return (bf16_t*)(base + 676642816ull); }
    __host__ __device__ __forceinline__ unsigned char* U8() const { return (unsigned char*)(base + 677691392ull); }
    __host__ __device__ __forceinline__ unsigned char* V8() const { return (unsigned char*)(base + 711245824ull); }
    __host__ __device__ __forceinline__ float* US() const { return (float*)(base + 744800256ull); }
    __host__ __device__ __forceinline__ float* VS() const { return (float*)(base + 744931328ull); }
    __host__ __device__ __forceinline__ float* SSQ() const { return (float*)(base + 745062400ull); }
    __host__ __device__ __forceinline__ float* SSKV() const { return (float*)(base + 747421696ull); }
    __host__ __device__ __forceinline__ unsigned* WE() const { return (unsigned*)(base + 748601344ull); }
    __host__ __device__ __forceinline__ signed char* H8() const { return (signed char*)(base + 786350080ull); }
    __host__ __device__ __forceinline__ float* HS() const { return (float*)(base + 861847552ull); }
    __host__ __device__ __forceinline__ bf16_t* PoolWT() const { return (bf16_t*)(base + 862142464ull); }
    __host__ __device__ __forceinline__ bf16_t* XB() const { return (bf16_t*)(base + 862208000ull); }
};
constexpr size_t WS_BYTES = 862208000ull + (size_t)NR * 1024 * 2;
static WS make_ws(void* d_ws) { WS w; w.base = (char*)d_ws; return w; }


#define LAS __attribute__((address_space(3)))
typedef short bf16x8 __attribute__((ext_vector_type(8)));
typedef float f32x4 __attribute__((ext_vector_type(4)));
typedef float f32x16 __attribute__((ext_vector_type(16)));
typedef unsigned u32x4 __attribute__((ext_vector_type(4)));
typedef unsigned u32x2 __attribute__((ext_vector_type(2)));

__device__ __forceinline__ f32x16 mfma32(bf16x8 a, bf16x8 b, f32x16 c) { return __builtin_amdgcn_mfma_f32_32x32x16_bf16(a, b, c, 0, 0, 0); }
__device__ __forceinline__ unsigned cvt_pk_bf16(float lo, float hi) { unsigned r; asm volatile("v_cvt_pk_bf16_f32 %0, %1, %2" : "=v"(r) : "v"(lo), "v"(hi)); return r; }

namespace pg8 {
constexpr int BM = 256, BK = 64, HALF = 128, HTB = HALF * BK * 2, STAGE_BYTES = 8 * HTB, NXCD = 8, WGM = 8;
__host__ __device__ __forceinline__ int lds_byte(int r, int c) { const int st = (r >> 4) * 2 + (c >> 5), rr = r & 15, cc = c & 31, ob = rr * 64 + cc * 2; return st * 1024 + (ob ^ (((ob >> 9) & 1) << 5)); }
__host__ __device__ __forceinline__ void stage_rc(int b, int& R, int& C) { const int st = b / 1024, sb = b % 1024, swz = sb ^ (((sb >> 9) & 1) << 5); R = (st >> 1) * 16 + swz / 64; C = (st & 1) * 32 + (swz % 64) / 2; }
__host__ __device__ __forceinline__ int perm32(int rho) { const int n = rho >> 4, i = rho & 15; return 8 * (i >> 2) + 4 * n + (i & 3); }
struct Unit { int pm, pn; };
struct Gemm { const bf16_t* A; const bf16_t* Bt; int M, N, K; };
struct StaticOrder {
    int nM, nN, nwg, G, c;
    __host__ __device__ void init(int M, int N, int G_, int c_) { nM = M / BM; nN = N / BM; nwg = nM * nN; G = G_; c = c_; }
    __host__ __device__ bool next(int i, Unit& u) const {
        const long L = (long)i * G + c; if (L >= nwg) return false;
        int wgid = (int)L; { const int q = nwg / NXCD, r = nwg % NXCD, xcd = wgid % NXCD, off = wgid / NXCD; wgid = (xcd < r ? xcd * (q + 1) : r * (q + 1) + (xcd - r) * q) + off; }
        const int nig = WGM * nN, gid = wgid / nig, fm = gid * WGM, gsz = (nM - fm) < WGM ? (nM - fm) : WGM;
        u.pm = fm + ((wgid % nig) % gsz); u.pn = (wgid % nig) / gsz; return true;
    }
};
template <class Epi, class Sched>
__device__ __forceinline__ void gemm_phase(LAS unsigned char* lds, const Gemm g, const Sched& S, const Epi& E) {
    int tid_ = threadIdx.x; asm volatile("" : "+v"(tid_));
    const int tid = tid_, wid = __builtin_amdgcn_readfirstlane(tid >> 6), lane = tid & 63, wr = wid >> 2, wc = wid & 3, fr = lane & 15, fq = lane >> 4;
    const int K = g.K, nt = K / BK;
    unsigned voffA[2], voffB[2];
#pragma unroll
    for (int i = 0; i < 2; ++i) { int R, C; stage_rc(tid * 16 + i * 8192, R, C); const int Rb = Epi::PERM ? ((R & ~31) + perm32(R & 31)) : R;
        voffA[i] = (unsigned)(R * K + C) * 2u; voffB[i] = (unsigned)(Rb * K + C) * 2u; }
    const size_t kstep = (size_t)(BK * 2);
    const size_t hstep = (size_t)HALF * K * 2;
    const size_t tstep = 2 * hstep;
    const unsigned ldsw = (unsigned)wid * 1024u;
    const int aoff = lds_byte(wr * 64 + fr, fq * 8), boff = lds_byte(wc * 32 + fr, fq * 8);
#define PG8_SA(b, h) (((b) * 2 + (h)) * HTB)
#define PG8_SB(b, h) ((4 + (b) * 2 + (h)) * HTB)
#define PG8_STAGE(bufoff, gbase, voff) do { _Pragma("unroll") for (int _i = 0; _i < 2; ++_i) \
        __builtin_amdgcn_global_load_lds((const unsigned*)((const char*)(gbase) + (voff)[_i]), (LAS unsigned*)(lds + (bufoff) + ldsw + _i * 8192), 16, 0, 0); } while (0)
#define PG8_LDA(dst, b, h) do { _Pragma("unroll") for (int m = 0; m < 4; ++m) _Pragma("unroll") for (int k = 0; k < 2; ++k) dst[m][k] = *(const LAS bf16x8*)(lds + PG8_SA(b, h) + aoff + m * 2048 + k * 1024); } while (0)
#define PG8_LDB(dst, b, h) do { _Pragma("unroll") for (int n = 0; n < 2; ++n) _Pragma("unroll") for (int k = 0; k < 2; ++k) dst[n][k] = *(const LAS bf16x8*)(lds + PG8_SB(b, h) + boff + n * 2048 + k * 1024); } while (0)
#define PG8_MMA(ai, bj, At, Bt) do { __builtin_amdgcn_s_setprio(1); _Pragma("unroll") for (int m = 0; m < 4; ++m) _Pragma("unroll") for (int n = 0; n < 2; ++n) _Pragma("unroll") for (int k = 0; k < 2; ++k) \
        acc[ai][bj][m][n] = __builtin_amdgcn_mfma_f32_16x16x32_bf16(Bt[n][k], At[m][k], acc[ai][bj][m][n], 0, 0, 0); __builtin_amdgcn_s_setprio(0); } while (0)
#define PG8_WAIT_V(n) asm volatile("s_waitcnt vmcnt(" #n ")" ::: "memory")
#define PG8_WAIT_L(n) asm volatile("s_waitcnt lgkmcnt(" #n ")" ::: "memory")
#define PG8_BAR __builtin_amdgcn_s_barrier()
#define PG8_SCHED __builtin_amdgcn_sched_barrier(0)
    Unit cur, nxt; int ui = 0;
    if (!S.next(0, cur)) return;
    f32x4 acc[2][2][4][2];
#pragma unroll
    for (int a = 0; a < 2; ++a)
#pragma unroll
        for (int b = 0; b < 2; ++b)
#pragma unroll
            for (int m = 0; m < 4; ++m)
#pragma unroll
                for (int n = 0; n < 2; ++n) acc[a][b][m][n] = (f32x4){0.f, 0.f, 0.f, 0.f};
    bf16x8 At[4][2], B0[2][2], B1[2][2];
    const char* cA = (const char*)g.A + (size_t)cur.pm * tstep; const char* cB = (const char*)g.Bt + (size_t)cur.pn * tstep;
    PG8_STAGE(PG8_SB(0, 0), cB, voffB); PG8_STAGE(PG8_SA(0, 0), cA, voffA); PG8_STAGE(PG8_SB(0, 1), cB + hstep, voffB); PG8_STAGE(PG8_SA(0, 1), cA + hstep, voffA);
    if (wr == 1) PG8_BAR;
    PG8_WAIT_V(4); PG8_BAR;
    PG8_STAGE(PG8_SB(1, 0), cB + kstep, voffB); PG8_STAGE(PG8_SA(1, 0), cA + kstep, voffA); PG8_STAGE(PG8_SB(1, 1), cB + hstep + kstep, voffB);
    PG8_WAIT_V(6); PG8_BAR;
    for (;;) {
        const bool has_next = S.next(ui + 1, nxt);
        const char* nA = has_next ? (const char*)g.A + (size_t)nxt.pm * tstep : cA; const char* nB = has_next ? (const char*)g.Bt + (size_t)nxt.pn * tstep : cB;
#pragma nounroll
        for (int t = 0; t < nt; t += 2) {
            const bool last = (t == nt - 2);
            const char* a1 = cA + (size_t)(t + 1) * kstep;
            const char* a2 = last ? nA : cA + (size_t)(t + 2) * kstep; const char* b2 = last ? nB : cB + (size_t)(t + 2) * kstep;
            const char* a3 = a2 + kstep; const char* b3 = b2 + kstep;
            PG8_LDB(B0, 0, 0); PG8_SCHED; PG8_LDA(At, 0, 0); PG8_STAGE(PG8_SA(1, 1), a1 + hstep, voffA);
            PG8_WAIT_L(8); PG8_BAR; PG8_WAIT_L(0); PG8_MMA(0, 0, At, B0); PG8_BAR; PG8_SCHED;
            PG8_LDB(B1, 0, 1); PG8_STAGE(PG8_SB(0, 0), b2, voffB);
            PG8_BAR; PG8_WAIT_L(0); PG8_MMA(0, 1, At, B1); PG8_BAR;
            PG8_LDA(At, 0, 1); PG8_STAGE(PG8_SA(0, 0), a2, voffA);
            PG8_BAR; PG8_WAIT_L(0); PG8_MMA(1, 0, At, B0); PG8_BAR; PG8_SCHED;
            PG8_STAGE(PG8_SB(0, 1), b2 + hstep, voffB);
            PG8_WAIT_V(6); PG8_BAR; PG8_MMA(1, 1, At, B1); PG8_BAR;
            PG8_LDB(B0, 1, 0); PG8_SCHED; PG8_LDA(At, 1, 0); PG8_STAGE(PG8_SA(0, 1), a2 + hstep, voffA);
            PG8_WAIT_L(8); PG8_BAR; PG8_WAIT_L(0); PG8_MMA(0, 0, At, B0); PG8_BAR; PG8_SCHED;
            PG8_LDB(B1, 1, 1); PG8_STAGE(PG8_SB(1, 0), b3, voffB);
            PG8_BAR; PG8_WAIT_L(0); PG8_MMA(0, 1, At, B1); PG8_BAR;
            PG8_LDA(At, 1, 1); PG8_STAGE(PG8_SA(1, 0), a3, voffA);
            PG8_BAR; PG8_WAIT_L(0); PG8_MMA(1, 0, At, B0); PG8_BAR; PG8_SCHED;
            PG8_STAGE(PG8_SB(1, 1), b3 + hstep, voffB);
            PG8_WAIT_V(6); PG8_BAR; PG8_MMA(1, 1, At, B1); PG8_BAR;
        }
        E(acc, cur, wr, wc, fr, fq);
        if (!has_next) break;
#pragma unroll
        for (int a = 0; a < 2; ++a)
#pragma unroll
            for (int b = 0; b < 2; ++b)
#pragma unroll
                for (int m = 0; m < 4; ++m)
#pragma unroll
                    for (int n = 0; n < 2; ++n) acc[a][b][m][n] = (f32x4){0.f, 0.f, 0.f, 0.f};
        cur = nxt; cA = nA; cB = nB; ++ui;
    }
    PG8_WAIT_V(0);
    if (wr == 0) PG8_BAR;
    PG8_BAR;
#undef PG8_SA
#undef PG8_SB
#undef PG8_STAGE
#undef PG8_LDA
#undef PG8_LDB
#undef PG8_MMA
#undef PG8_WAIT_V
#undef PG8_WAIT_L
#undef PG8_BAR
#undef PG8_SCHED
}
}

enum { GT_AQ = 0, GT_AK = 1, GT_AV = 2, GT_B = 3, GT_CQ = 4, GT_CKV = 5, GT_KR = 6, GT_PAD = 7 };
__host__ __device__ __forceinline__ void in_group(int g, int& type, int& sub) {
    if (g < 2) { type = GT_AK; sub = g; } else if (g < 4) { type = GT_AV; sub = g - 2; } else if (g < 8) { type = GT_CKV; sub = g - 4; }
    else if (g == 8) { type = GT_KR; sub = 0; } else if (g < 12) { type = GT_PAD; sub = 0; } else if (g < 18) { type = GT_AQ; sub = g - 12; }
    else if (g < 24) { type = GT_CQ; sub = g - 18; } else { type = GT_B; sub = g - 24; }
}
__device__ __forceinline__ int colmap(int mode, int r) {
    const int pn = r >> 8, ct = r & 255, bj = ct >> 7, wc = (ct >> 5) & 3, j = ct & 31, g = 4 * pn + wc, e = 32 * bj + j;
    if (mode == 0) {
        int type, sub; in_group(g, type, sub);
        switch (type) { case GT_AQ: return 64 * sub + e; case GT_AK: return 384 + 64 * sub + e; case GT_AV: return 512 + 64 * sub + e; case GT_B: return 640 + 64 * sub + e;
            case GT_CQ: return 896 + 64 * sub + e; case GT_CKV: return 1280 + 64 * sub + e; case GT_KR: return (j < 16) ? 1536 + 16 * bj + j : -1; default: return -1; }
    } else if (mode == 1) {
        if (g < 6) return 96 * g + e; if (g < 9) { const int head = 2 * (g - 6) + (j >> 4); return 96 * head + 64 + 16 * bj + (j & 15); } return -1;
    } else if (mode == 2) {
        return 64 * g + e;
    }
    return r;
}
__device__ __forceinline__ void cvt_weights_unit(LAS float* tile  , const float* __restrict__ W, int K, int N, bf16_t* __restrict__ dst, int mode, const float* __restrict__ kgain, int r0, int k0) {
    int tid_ = threadIdx.x; asm volatile("" : "+v"(tid_));
    const int tid = tid_;
    const int jj = tid & 63; const int sc = colmap(mode, r0 + jj);
#pragma unroll
    for (int i = 0; i < 8; ++i) { const int kk = (tid >> 6) + 8 * i; float v = 0.f; if (sc >= 0) v = W[(size_t)(k0 + kk) * N + sc]; if (kgain) v *= kgain[k0 + kk]; tile[kk * 65 + jj] = v; }
    __syncthreads();
#pragma unroll
    for (int i = 0; i < 8; ++i) { const int rr = (tid >> 6) + 8 * i, kk = tid & 63; dst[(size_t)(r0 + rr) * K + k0 + kk] = f2bf(tile[kk * 65 + rr]); }
    __syncthreads();
}
struct CvtJob { const float* W; bf16_t* dst; const float* kgain; int K, N, Npad, mode; };
__device__ __forceinline__ void cvt_job(LAS float* tile, const CvtJob j, int vb, int nvb) {
    const int nk = j.K / 64, nr = j.Npad / 64;
    for (int u = vb; u < nk * nr; u += nvb) cvt_weights_unit(tile, j.W, j.K, j.N, j.dst, j.mode, j.kgain, (u / nk) * 64, (u % nk) * 64);
}
__device__ __forceinline__ void cvt_flat(const float* __restrict__ src, bf16_t* __restrict__ dst, size_t n, int vb, int nvb) {
    int tid_ = threadIdx.x; asm volatile("" : "+v"(tid_));
    for (size_t i = ((size_t)vb * 512 + tid_) * 8; i < n; i += (size_t)nvb * 512 * 8) {
        const float4 a = *(const float4*)(src + i), b = *(const float4*)(src + i + 4);
        u32x4 o; o.x = cvt_pk_bf16(a.x, a.y); o.y = cvt_pk_bf16(a.z, a.w); o.z = cvt_pk_bf16(b.x, b.y); o.w = cvt_pk_bf16(b.z, b.w);
        *(u32x4*)(dst + i) = o;
    }
}
template <bool FP8>
__device__ __forceinline__ void cvt_q8_rows(const float* __restrict__ src, unsigned char* __restrict__ dst, float* __restrict__ scales, int nrows, int vb, int nvb) {
    int tid_ = threadIdx.x; asm volatile("" : "+v"(tid_));
    const int lane = tid_ & 63, wid = tid_ >> 6;
    const int stride = nvb * 8;
    for (int row0 = vb * 8 + wid; row0 < nrows; row0 += 4 * stride) {
        f32x4 v[4][4];
#pragma unroll
        for (int q = 0; q < 4; ++q) { const int row = row0 + q * stride < nrows ? row0 + q * stride : row0; const float* sp = src + (size_t)row * 1024 + 16 * lane;
#pragma unroll
            for (int k = 0; k < 4; ++k) v[q][k] = *(const f32x4*)(sp + 4 * k); }
#pragma unroll
        for (int q = 0; q < 4; ++q) { const int row = row0 + q * stride; if (row < nrows) {
            float am = 0.f;
#pragma unroll
            for (int k = 0; k < 4; ++k) am = fmaxf(am, fmaxf(fmaxf(fabsf(v[q][k][0]), fabsf(v[q][k][1])), fmaxf(fabsf(v[q][k][2]), fabsf(v[q][k][3]))));
#pragma unroll
            for (int o = 32; o > 0; o >>= 1) am = fmaxf(am, __shfl_xor(am, o));
            const float qmax = FP8 ? 416.f : 127.f;
            const float sc = am > 0.f ? am / qmax : 1.f, inv = am > 0.f ? qmax / am : 0.f;
            u32x4 o4;
#pragma unroll
            for (int k = 0; k < 4; ++k) {
                if (FP8) { int p = __builtin_amdgcn_cvt_pk_fp8_f32(v[q][k][0] * inv, v[q][k][1] * inv, 0, false); p = __builtin_amdgcn_cvt_pk_fp8_f32(v[q][k][2] * inv, v[q][k][3] * inv, p, true); o4[k] = (unsigned)p; }
                else { const int q0 = (int)rintf(v[q][k][0] * inv), q1 = (int)rintf(v[q][k][1] * inv), q2 = (int)rintf(v[q][k][2] * inv), q3 = (int)rintf(v[q][k][3] * inv);
                    o4[k] = (unsigned)(q0 & 0xff) | ((unsigned)(q1 & 0xff) << 8) | ((unsigned)(q2 & 0xff) << 16) | ((unsigned)(q3 & 0xff) << 24); } }
            *(u32x4*)(dst + (size_t)row * 1024 + 16 * lane) = o4;
            if (lane == 0) scales[row] = sc; } }
    }
}
template <bool OFFS>
__device__ __forceinline__ void cvt_q4_rows(const float* __restrict__ src, unsigned char* __restrict__ dst, float* __restrict__ scales, int nrows, int vb, int nvb) {
    int tid_ = threadIdx.x; asm volatile("" : "+v"(tid_));
    const int lane = tid_ & 63, wid = tid_ >> 6;
    const int stride = nvb * 8;
    for (int row0 = vb * 8 + wid; row0 < nrows; row0 += 4 * stride) {
        f32x4 v[4][4];
#pragma unroll
        for (int q = 0; q < 4; ++q) { const int row = row0 + q * stride < nrows ? row0 + q * stride : row0; const float* sp = src + (size_t)row * 1024 + 16 * lane;
#pragma unroll
            for (int k = 0; k < 4; ++k) v[q][k] = *(const f32x4*)(sp + 4 * k); }
#pragma unroll
        for (int q = 0; q < 4; ++q) { const int row = row0 + q * stride; if (row < nrows) {
            float am = 0.f, ss = 0.f;
#pragma unroll
            for (int k = 0; k < 4; ++k) { am = fmaxf(am, fmaxf(fmaxf(fabsf(v[q][k][0]), fabsf(v[q][k][1])), fmaxf(fabsf(v[q][k][2]), fabsf(v[q][k][3]))));
                ss += v[q][k][0] * v[q][k][0] + v[q][k][1] * v[q][k][1] + v[q][k][2] * v[q][k][2] + v[q][k][3] * v[q][k][3]; }
#pragma unroll
            for (int o = 32; o > 0; o >>= 1) { am = fmaxf(am, __shfl_xor(am, o)); ss += __shfl_xor(ss, o); }
            const float st = fmaxf(0.36f * sqrtf(ss * (1.f / 1024.f)), am * (1.f / 12.f));
            const float sc = st > 0.f ? st : 1.f, inv = st > 0.f ? 1.f / st : 0.f;
            u32x2 o2;
#pragma unroll
            for (int d = 0; d < 2; ++d) { unsigned wd = 0u;
#pragma unroll
                for (int k = 0; k < 4; ++k) { const int qa = (int)fminf(fmaxf(rintf(v[q][2 * d][k] * inv), -7.f), 7.f), qb = (int)fminf(fmaxf(rintf(v[q][2 * d + 1][k] * inv), -7.f), 7.f); wd |= ((unsigned)((qa + (OFFS ? 8 : 0)) & 15) << (8 * k)) | ((unsigned)((qb + (OFFS ? 8 : 0)) & 15) << (8 * k + 4)); }
                o2[d] = wd; }
            *(u32x2*)(dst + (size_t)row * 512 + 8 * lane) = o2;
            if (lane == 0) scales[row] = OFFS ? sc * 512.f : sc; } }
    }
}
__device__ __forceinline__ unsigned fp4_code(float x, float inv) {
    const float a = fabsf(x) * inv;
    unsigned c = a < 0.25f ? 0u : a < 0.75f ? 1u : a < 1.25f ? 2u : a < 1.75f ? 3u : a < 2.5f ? 4u : a < 3.5f ? 5u : a < 5.f ? 6u : 7u;
    return c | (x < 0.f ? 8u : 0u);
}
__device__ __forceinline__ void cvt_fp4_rows(const float* __restrict__ src, unsigned char* __restrict__ dst, float* __restrict__ scales, int nrows, int vb, int nvb) {
    int tid_ = threadIdx.x; asm volatile("" : "+v"(tid_));
    const int lane = tid_ & 63, wid = tid_ >> 6;
    const int stride = nvb * 8;
    for (int row0 = vb * 8 + wid; row0 < nrows; row0 += 4 * stride) {
        f32x4 v[4][4];
#pragma unroll
        for (int q = 0; q < 4; ++q) { const int row = row0 + q * stride < nrows ? row0 + q * stride : row0; const float* sp = src + (size_t)row * 1024 + 16 * lane;
#pragma unroll
            for (int k = 0; k < 4; ++k) v[q][k] = *(const f32x4*)(sp + 4 * k); }
#pragma unroll
        for (int q = 0; q < 4; ++q) { const int row = row0 + q * stride; if (row < nrows) {
            float am = 0.f, ss = 0.f;
#pragma unroll
            for (int k = 0; k < 4; ++k) { am = fmaxf(am, fmaxf(fmaxf(fabsf(v[q][k][0]), fabsf(v[q][k][1])), fmaxf(fabsf(v[q][k][2]), fabsf(v[q][k][3]))));
                ss += v[q][k][0] * v[q][k][0] + v[q][k][1] * v[q][k][1] + v[q][k][2] * v[q][k][2] + v[q][k][3] * v[q][k][3]; }
#pragma unroll
            for (int o = 32; o > 0; o >>= 1) { am = fmaxf(am, __shfl_xor(am, o)); ss += __shfl_xor(ss, o); }
            const float st = fmaxf(0.5f * sqrtf(ss * (1.f / 1024.f)), am * (1.f / 12.f));
            const float sc = st > 0.f ? st : 1.f, inv = st > 0.f ? 1.f / st : 0.f;
            u32x2 o2;
#pragma unroll
            for (int d = 0; d < 2; ++d) { unsigned wd = 0u;
#pragma unroll
                for (int i = 0; i < 8; ++i) wd |= fp4_code(v[q][2 * d + (i >> 2)][i & 3], inv) << (4 * i);
                o2[d] = wd; }
            *(u32x2*)(dst + (size_t)row * 512 + 8 * lane) = o2;
            if (lane == 0) scales[row] = sc; } }
    }
}
struct Inputs {
    const float *x, *c, *ctx, *c_ctx, *ada_w, *ada_b, *norm1_g, *norm2_g, *w_in, *gqa_qn_g, *gqa_kn_g, *pool_w, *pool_scale, *mla_qn_g, *mla_kvn_g, *mla_w_uq, *mla_w_ukv, *w_out, *peer_wq, *peer_subkeys, *peer_u, *peer_v, *final_g;
};
__device__ __forceinline__ void phase_cvt(LAS unsigned char* lds, const Inputs& in, const WS& w, int vb, int nvb) {
    LAS float* tile = (LAS float*)lds;
    for (int l = 0; l < 2; ++l) {
        cvt_job(tile, CvtJob{in.w_in + (size_t)l * 1024 * INC, w.WinT() + (size_t)l * 1792 * 1024, nullptr, 1024, INC, 1792, 0}, vb, nvb);
        cvt_job(tile, CvtJob{in.mla_w_uq + (size_t)l * 384 * 576, w.WuqT() + (size_t)l * 768 * 384, in.mla_qn_g + l * 384, 384, 576, 768, 1}, vb, nvb);
        cvt_job(tile, CvtJob{in.mla_w_ukv + (size_t)l * 256 * 768, w.WukvT() + (size_t)l * 768 * 256, in.mla_kvn_g + l * 256, 256, 768, 768, 2}, vb, nvb);
        cvt_job(tile, CvtJob{in.w_out + (size_t)l * 1024 * 1024, w.WoutT() + (size_t)l * 1024 * 1024, nullptr, 1024, 1024, 1024, 3}, vb, nvb);
        cvt_job(tile, CvtJob{in.peer_wq + (size_t)l * 1024 * 2048, w.WqT() + (size_t)l * 2048 * 1024, nullptr, 1024, 2048, 2048, 3}, vb, nvb);
    }
    cvt_flat(in.peer_subkeys, w.SubK(), (size_t)2 * 16 * 128 * 128, vb, nvb);
    { int tp_ = threadIdx.x; asm volatile("" : "+v"(tp_));
      for (int i = vb * 512 + tp_; i < 2 * 4 * 64 * 64; i += nvb * 512) { const int c = i & 63, d = (i >> 6) & 63, lg = i >> 12; w.PoolWT()[i] = f2bf(in.pool_w[(size_t)lg * 4096 + c * 64 + d]); } }
    if (nvb > 144) { if (vb >= 72) { cvt_q4_rows<false>(in.peer_u, w.U8(), w.US(), 2 * NE, vb - 72, nvb - 72); cvt_fp4_rows(in.peer_v, w.V8(), w.VS(), 2 * NE, vb - 72, nvb - 72); } }
    else { cvt_q4_rows<false>(in.peer_u, w.U8(), w.US(), 2 * NE, vb, nvb); cvt_fp4_rows(in.peer_v, w.V8(), w.VS(), 2 * NE, vb, nvb); }
}

constexpr float ATT_C2G = 0.125f * 1.4426950408889634f, ATT_C2M = 0.10206207261596577f * 1.4426950408889634f;
struct EpiIn {
    static constexpr bool PERM = true;
    WS w; const float* qn_g; const float* kn_g; int pm_base;
    __device__ __forceinline__ void operator()(const f32x4 (&acc)[2][2][4][2], const pg8::Unit& u, int wr, int wc, int fr, int fq) const {
        int type, sub; in_group(4 * u.pn + wc, type, sub);
        if (type == GT_PAD) return;
        const int pm = u.pm + pm_base; const bool isctx = pm >= 256; const int b = isctx ? pm - 256 : pm >> 3; const int t0 = isctx ? 0 : (pm & 7) * 256;
        const size_t rowbase = isctx ? (size_t)NL + (size_t)b * CTX : (size_t)b * S;
        const int keyoff = isctx ? 0 : CTX;
        float gain[2][8];
        if (type == GT_AQ) {
#pragma unroll
            for (int bj = 0; bj < 2; ++bj)
#pragma unroll
                for (int q = 0; q < 8; ++q) gain[bj][q] = qn_g[32 * bj + 8 * fq + q] * ATT_C2G;
        } else if (type == GT_AK) {
#pragma unroll
            for (int bj = 0; bj < 2; ++bj)
#pragma unroll
                for (int q = 0; q < 8; ++q) gain[bj][q] = kn_g[32 * bj + 8 * fq + q];
        }
#pragma unroll
        for (int ai = 0; ai < 2; ++ai)
#pragma unroll
            for (int m = 0; m < 4; ++m) {
                const int t = t0 + 128 * ai + 64 * wr + 16 * m + fr; const size_t row = rowbase + t;
                float v[2][8];
#pragma unroll
                for (int bj = 0; bj < 2; ++bj)
#pragma unroll
                    for (int n = 0; n < 2; ++n)
#pragma unroll
                        for (int i = 0; i < 4; ++i) v[bj][4 * n + i] = acc[ai][bj][m][n][i];
                bf16_t* dst = nullptr;
                if (type == GT_AQ || type == GT_AK) {
                    float ss = 0.f;
#pragma unroll
                    for (int bj = 0; bj < 2; ++bj)
#pragma unroll
                        for (int q = 0; q < 8; ++q) ss += v[bj][q] * v[bj][q];
                    ss += __shfl_xor(ss, 16); ss += __shfl_xor(ss, 32);
                    const float rstd = rsqrtf(ss * (1.f / 64.f) + EPS);
#pragma unroll
                    for (int q = 0; q < 8; ++q) { float x1 = v[0][q] * rstd * gain[0][q], x2 = v[1][q] * rstd * gain[1][q];
                        if (!isctx) { const float2 cs = w.ROPA()[t * 32 + 8 * fq + q]; const float y1 = x1 * cs.x - x2 * cs.y, y2 = x1 * cs.y + x2 * cs.x; x1 = y1; x2 = y2; }
                        v[0][q] = x1; v[1][q] = x2; }
                    if (type == GT_AQ) dst = isctx ? w.Qgc() + (((size_t)b * 6 + sub) * CTX + t) * 64 : w.Qg() + (((size_t)b * 6 + sub) * S + t) * 64;
                    else dst = w.Kg() + (((size_t)b * 2 + sub) * KEYS + keyoff + t) * 64;
                } else if (type == GT_AV) { dst = w.Vg() + (((size_t)b * 2 + sub) * KEYS + keyoff + t) * 64;
                } else if (type == GT_B) { dst = w.Bp() + row * 256 + 64 * sub;
                } else if (type == GT_CQ || type == GT_CKV) {
                    float ss = 0.f;
#pragma unroll
                    for (int bj = 0; bj < 2; ++bj)
#pragma unroll
                        for (int q = 0; q < 8; ++q) ss += v[bj][q] * v[bj][q];
                    ss += __shfl_xor(ss, 16); ss += __shfl_xor(ss, 32);
                    if (type == GT_CQ) { if (fq == 0) w.SSQ()[row * 8 + sub] = ss; dst = w.CQ() + row * 384 + 64 * sub; }
                    else { if (fq == 0) w.SSKV()[row * 4 + sub] = ss; dst = w.CKV() + row * 256 + 64 * sub; }
                } else {
                    if (!isctx) {
#pragma unroll
                        for (int q = 0; q < 8; ++q) { const float2 cs = w.ROPC()[t * 16 + ((8 * fq + q) & 15)]; const float x1 = v[0][q], x2 = v[1][q]; v[0][q] = x1 * cs.x - x2 * cs.y; v[1][q] = x1 * cs.y + x2 * cs.x; } }
                    if (fq < 2) { bf16_t* kd = w.KR() + ((size_t)b * KEYS + keyoff + t) * 32;
#pragma unroll
                        for (int bj = 0; bj < 2; ++bj) { u32x4 o; o.x = cvt_pk_bf16(v[bj][0], v[bj][1]); o.y = cvt_pk_bf16(v[bj][2], v[bj][3]); o.z = cvt_pk_bf16(v[bj][4], v[bj][5]); o.w = cvt_pk_bf16(v[bj][6], v[bj][7]);
                            *(u32x4*)(kd + 16 * bj + 8 * fq) = o; } }
                    continue;
                }
#pragma unroll
                for (int bj = 0; bj < 2; ++bj) { u32x4 o; o.x = cvt_pk_bf16(v[bj][0], v[bj][1]); o.y = cvt_pk_bf16(v[bj][2], v[bj][3]); o.z = cvt_pk_bf16(v[bj][4], v[bj][5]); o.w = cvt_pk_bf16(v[bj][6], v[bj][7]);
                    *(u32x4*)(dst + 32 * bj + 8 * fq) = o; }
            }
    }
};
struct P1Order {
    pg8::StaticOrder so; int nctx_tiles, G, c;
    __device__ bool next(int i, pg8::Unit& u) const {
        const int L = i * G + c;
        if (L < 1792) return so.next(i, u);
        const int Lc = L - 1792; if (Lc >= 32 * nctx_tiles) return false;
        u.pm = 256 + (Lc & 31); u.pn = Lc >> 5; return true;
    }
};
__device__ __forceinline__ void phase_p1(LAS unsigned char* lds, const WS& w, const Inputs& in, int l, int vb, int nvb) {
    EpiIn E{w, in.gqa_qn_g + l * 64, in.gqa_kn_g + l * 64, 0};
    P1Order po; po.so.init(NL, 1792, nvb, vb); po.nctx_tiles = (l == 0) ? 7 : 3; po.G = nvb; po.c = vb;
    pg8::gemm_phase(lds, pg8::Gemm{w.H(), w.WinT() + (size_t)l * 1792 * 1024, NR, 1792, 1024}, po, E);
}

extern __shared__ __attribute__((aligned(16))) unsigned char dyn_lds[];

struct EpiUq {
    static constexpr bool PERM = true;
    WS w;
    __device__ __forceinline__ void operator()(const f32x4 (&acc)[2][2][4][2], const pg8::Unit& u, int wr, int wc, int fr, int fq) const {
        const int g = 4 * u.pn + wc; if (g >= 9) return;
        const int pm = u.pm; const bool isctx = pm >= 256; const int b = isctx ? pm - 256 : pm >> 3; const int t0 = isctx ? 0 : (pm & 7) * 256;
        const size_t rowbase = isctx ? (size_t)NL + (size_t)b * CTX : (size_t)b * S;
        const int head = g < 6 ? g : 2 * (g - 6) + (fq >> 1);
#pragma unroll
        for (int ai = 0; ai < 2; ++ai)
#pragma unroll
            for (int m = 0; m < 4; ++m) {
                const int t = t0 + 128 * ai + 64 * wr + 16 * m + fr; const size_t row = rowbase + t;
                const float4 s0 = *(const float4*)(w.SSQ() + row * 8), s1 = *(const float4*)(w.SSQ() + row * 8 + 4);
                const float rstd = rsqrtf((s0.x + s0.y + s0.z + s0.w + s1.x + s1.y) * (1.f / 384.f) + EPS) * ATT_C2M;
                float v[2][8];
#pragma unroll
                for (int bj = 0; bj < 2; ++bj)
#pragma unroll
                    for (int n = 0; n < 2; ++n)
#pragma unroll
                        for (int i = 0; i < 4; ++i) v[bj][4 * n + i] = acc[ai][bj][m][n][i] * rstd;
                bf16_t* hd = isctx ? w.Qmc() + (((size_t)b * 6 + head) * CTX + t) * 96 : w.Qm() + (((size_t)b * 6 + head) * S + t) * 96;
                if (g >= 6 && !isctx) {
#pragma unroll
                    for (int q = 0; q < 8; ++q) { const float2 cs = w.ROPC()[t * 16 + 8 * (fq & 1) + q]; const float x1 = v[0][q], x2 = v[1][q]; v[0][q] = x1 * cs.x - x2 * cs.y; v[1][q] = x1 * cs.y + x2 * cs.x; } }
#pragma unroll
                for (int bj = 0; bj < 2; ++bj) { u32x4 o; o.x = cvt_pk_bf16(v[bj][0], v[bj][1]); o.y = cvt_pk_bf16(v[bj][2], v[bj][3]); o.z = cvt_pk_bf16(v[bj][4], v[bj][5]); o.w = cvt_pk_bf16(v[bj][6], v[bj][7]);
                    bf16_t* d = g < 6 ? hd + 32 * bj + 8 * fq : hd + 64 + 16 * bj + 8 * (fq & 1);
                    *(u32x4*)d = o; }
            }
    }
};
struct EpiUkv {
    static constexpr bool PERM = true;
    WS w;
    __device__ __forceinline__ void operator()(const f32x4 (&acc)[2][2][4][2], const pg8::Unit& u, int wr, int wc, int fr, int fq) const {
        const int g = 4 * u.pn + wc;
        const int pm = u.pm; const bool isctx = pm >= 256; const int b = isctx ? pm - 256 : pm >> 3; const int t0 = isctx ? 0 : (pm & 7) * 256;
        const size_t rowbase = isctx ? (size_t)NL + (size_t)b * CTX : (size_t)b * S; const int keyoff = isctx ? 0 : CTX;
        bf16_t* base = ((g & 1) ? w.Vm() : w.Kmn()) + ((size_t)b * 6 + (g >> 1)) * KEYS * 64;
#pragma unroll
        for (int ai = 0; ai < 2; ++ai)
#pragma unroll
            for (int m = 0; m < 4; ++m) {
                const int t = t0 + 128 * ai + 64 * wr + 16 * m + fr; const size_t row = rowbase + t;
                const float4 s0 = *(const float4*)(w.SSKV() + row * 4);
                const float rstd = rsqrtf((s0.x + s0.y + s0.z + s0.w) * (1.f / 256.f) + EPS);
                bf16_t* d = base + (size_t)(keyoff + t) * 64;
#pragma unroll
                for (int bj = 0; bj < 2; ++bj) { const f32x4 a0 = acc[ai][bj][m][0] * rstd, a1 = acc[ai][bj][m][1] * rstd;
                    u32x4 o; o.x = cvt_pk_bf16(a0[0], a0[1]); o.y = cvt_pk_bf16(a0[2], a0[3]); o.z = cvt_pk_bf16(a1[0], a1[1]); o.w = cvt_pk_bf16(a1[2], a1[3]);
                    *(u32x4*)(d + 32 * bj + 8 * fq) = o; }
            }
    }
};
constexpr int POOL_X = 0, POOL_P = 272 * 128, POOL_BYTES = 272 * 128 + 256 * 128;
template <int G>
__device__ __forceinline__ void pool_sums(LAS unsigned char* lds, int tid, int t0, int L) {
    constexpr int wdw = 2 << G, half = wdw >> 1, NX = 32 + wdw - 1;
    const int c = tid & 63, seg = tid >> 6; const LAS bf16_t* X = (const LAS bf16_t*)(lds + POOL_X) + c + (seg * 32 + 8 - half) * 64;
    const int tb = t0 + seg * 32;
    float xr[NX], xm[NX];
#pragma unroll
    for (int j = 0; j < NX; ++j) xr[j] = bf2f(X[j * 64]);
#pragma unroll
    for (int j = 0; j < NX; ++j) { const int row = tb - half + j; xm[j] = (row >= 0 && row < L) ? xr[j] : 0.f; }
    float sum = 0.f;
#pragma unroll
    for (int j = 0; j < wdw; ++j) sum += xm[j];
#pragma unroll
    for (int k = 0; k < 32; ++k) {
        const int t = tb + k; const int clo = (t - half) < 0 ? 0 : (t - half), chi = (t - half + wdw) > L ? L : (t - half + wdw);
        const float pv = sum / (float)(chi - clo) - xr[k + half];
        const int r = seg * 32 + k; *((LAS bf16_t*)(lds + POOL_P + r * 128 + (((c >> 3) ^ ((r >> 1) & 7)) << 4)) + (c & 7)) = f2bf(pv);
        if (k < 31) sum += xm[k + wdw] - xm[k];
    }
}
__device__ __forceinline__ void phase_pool(LAS unsigned char* lds, const WS& w, bf16_t* __restrict__ MIX, const bf16_t* __restrict__ WT  , const float* __restrict__ pool_scale, int nrows, int vb, int nvb) {
    int tid_ = threadIdx.x; asm volatile("" : "+v"(tid_));
    const int tid = tid_, lane = tid & 63, wid = __builtin_amdgcn_readfirstlane(tid >> 6), r32 = lane & 31, hi = lane >> 5;
    const int nunits = nrows >> 8;
    const int nmine = vb < nunits ? ((nunits - 1 - vb) / nvb + 1) * 4 : 0;
    u32x4 st[5];
#define POOL_FETCH(it_) do { const int u_ = vb + ((it_) >> 2) * nvb, g_ = (it_) & 3; const int row0_ = u_ << 8; const bool ic_ = row0_ >= NL; const int L_ = ic_ ? CTX : S; const int t0_ = ic_ ? 0 : (row0_ & (S - 1)); const int seq0_ = row0_ - t0_; \
        _Pragma("unroll") for (int k_ = 0; k_ < 5; ++k_) { int i_ = tid + 512 * k_; i_ = i_ < 272 * 8 ? i_ : 272 * 8 - 1; const int rr_ = i_ >> 3, ch_ = i_ & 7; int t_ = t0_ - 8 + rr_; t_ = t_ < 0 ? 0 : (t_ >= L_ ? L_ - 1 : t_); \
            st[k_] = *(const u32x4*)(w.Bp() + (size_t)(seq0_ + t_) * 256 + g_ * 64 + ch_ * 8); } } while (0)
    if (nmine > 0) POOL_FETCH(0);
    for (int it = 0; it < nmine; ++it) {
        const int u = vb + (it >> 2) * nvb, g = it & 3;
        const int row0 = u << 8; const bool isctx = row0 >= NL; const int L = isctx ? CTX : S; const int t0 = isctx ? 0 : (row0 & (S - 1));
        {
#pragma unroll
            for (int k = 0; k < 5; ++k) { const int i = tid + 512 * k; if (i < 272 * 8) *(LAS u32x4*)(lds + POOL_X + (i >> 3) * 128 + (i & 7) * 16) = st[k]; }
            { const int nx = it + 1 < nmine ? it + 1 : it; POOL_FETCH(nx); }
            __syncthreads();
            if (g == 0) pool_sums<0>(lds, tid, t0, L); else if (g == 1) pool_sums<1>(lds, tid, t0, L); else if (g == 2) pool_sums<2>(lds, tid, t0, L); else pool_sums<3>(lds, tid, t0, L);
            __syncthreads();
            { f32x16 o0 = {}, o1 = {};
              const bf16_t* wt = WT + (size_t)g * 4096 + (size_t)r32 * 64 + 8 * hi;
#pragma unroll
              for (int s = 0; s < 4; ++s) { const int row = wid * 32 + r32; const bf16x8 pf = *(const LAS bf16x8*)(lds + POOL_P + row * 128 + (((2 * s + hi) ^ ((row >> 1) & 7)) << 4));
                  o0 = mfma32(*(const bf16x8*)(wt + 16 * s), pf, o0); o1 = mfma32(*(const bf16x8*)(wt + 32 * 64 + 16 * s), pf, o1); }
              bf16_t* op = MIX + (size_t)(row0 + wid * 32 + r32) * 1024 + 384 + g * 64 + 4 * hi; const float* ps = pool_scale + g * 64 + 4 * hi;
#pragma unroll
              for (int q = 0; q < 4; ++q) { const f32x4 s0 = *(const f32x4*)(ps + 8 * q), s1 = *(const f32x4*)(ps + 32 + 8 * q); u32x2 a, b;
                  a.x = cvt_pk_bf16(o0[4 * q] * s0[0], o0[4 * q + 1] * s0[1]); a.y = cvt_pk_bf16(o0[4 * q + 2] * s0[2], o0[4 * q + 3] * s0[3]);
                  b.x = cvt_pk_bf16(o1[4 * q] * s1[0], o1[4 * q + 1] * s1[1]); b.y = cvt_pk_bf16(o1[4 * q + 2] * s1[2], o1[4 * q + 3] * s1[3]);
                  *(u32x2*)(op + 8 * q) = a; *(u32x2*)(op + 32 + 8 * q) = b; } }
            __syncthreads();
        }
    }
#undef POOL_FETCH
}
__device__ __forceinline__ void phase_p2(LAS unsigned char* lds, const WS& w, const Inputs& in, int l, int vb, int nvb, int parts = 7) {
    pg8::StaticOrder so;
    if (parts & 1) { EpiUq E{w}; const int M = l == 0 ? NR : NL; so.init(M, 768, nvb, vb); pg8::gemm_phase(lds, pg8::Gemm{w.CQ(), w.WuqT() + (size_t)l * 768 * 384, M, 768, 384}, so, E); }
    if (parts & 2) { EpiUkv E{w}; so.init(NR, 768, nvb, vb); pg8::gemm_phase(lds, pg8::Gemm{w.CKV(), w.WukvT() + (size_t)l * 768 * 256, NR, 768, 256}, so, E); }
    if (parts & 4) phase_pool(lds, w, w.H(), w.PoolWT() + (size_t)l * 4 * 64 * 64, in.pool_scale + l * 256, l == 0 ? NR : NL, vb, nvb);
}

struct EpiOut {
    static constexpr bool PERM = true;
    bf16_t* DLT; const float* gate;
    __device__ __forceinline__ void operator()(const f32x4 (&acc)[2][2][4][2], const pg8::Unit& u, int wr, int wc, int fr, int fq) const {
        const int pm = u.pm; const int mr = pm >= 256 ? 32 : pm >> 3;
        const size_t r0 = (size_t)pm * 256 + wr * 64 + fr; const int col0 = u.pn * 256 + wc * 32 + 8 * fq;
        f32x4 gv[2][2];
#pragma unroll
        for (int bj = 0; bj < 2; ++bj)
#pragma unroll
            for (int n = 0; n < 2; ++n) gv[bj][n] = *(const f32x4*)(gate + (size_t)mr * 6144 + col0 + bj * 128 + 4 * n);
#pragma unroll
        for (int ai = 0; ai < 2; ++ai)
#pragma unroll
            for (int m = 0; m < 4; ++m) { bf16_t* d = DLT + (r0 + ai * 128 + m * 16) * 1024 + col0;
#pragma unroll
                for (int bj = 0; bj < 2; ++bj) { const f32x4 a0 = acc[ai][bj][m][0] * gv[bj][0], a1 = acc[ai][bj][m][1] * gv[bj][1];
                    u32x4 o; o.x = cvt_pk_bf16(a0[0], a0[1]); o.y = cvt_pk_bf16(a0[2], a0[3]); o.z = cvt_pk_bf16(a1[0], a1[1]); o.w = cvt_pk_bf16(a1[2], a1[3]);
                    *(u32x4*)(d + bj * 128) = o; } }
    }
};
__device__ __forceinline__ void phase_p4(LAS unsigned char* lds, const WS& w, const Inputs& in, int l, int vb, int nvb) {
    const float* MODl = w.MOD() + (size_t)l * 33 * 6144;
    EpiOut E{w.PQ(), MODl + 2 * 1024};
    const int M = l == 0 ? NR : NL;
    pg8::StaticOrder so; so.init(M, 1024, nvb, vb);
    pg8::gemm_phase(lds, pg8::Gemm{w.H(), w.WoutT() + (size_t)l * 1024 * 1024, M, 1024, 1024}, so, E);
}

template <bool INBF>
__device__ __forceinline__ void phase_modulate(const float* __restrict__ XLp, const float* __restrict__ XCp, const bf16_t* __restrict__ XBp, bf16_t* __restrict__ Hout, const float* __restrict__ g, const float* __restrict__ MODl, int si, int nrows, int vb, int nvb,
                                               signed char* __restrict__ H8 = nullptr, float* __restrict__ HS = nullptr, const bf16_t* __restrict__ DLT = nullptr, bf16_t* __restrict__ XBo = nullptr) {
    int tid_ = threadIdx.x; asm volatile("" : "+v"(tid_));
    const int tid = tid_, lane = tid & 63, wid = tid >> 6;
    f32x4 gv[4];
#pragma unroll
    for (int i = 0; i < 4; ++i) gv[i] = *(const f32x4*)(g + 256 * i + 4 * lane);
    const int stride = nvb * 8, lastrow = nrows - 1;
    f32x4 nx[4]; u32x2 nxb[4], ndr[4];
#define PM_LOAD(r_) do { const int rr_ = (r_) < nrows ? (r_) : lastrow; const bool ic_ = rr_ >= NL; const float* xp_ = ic_ ? XCp + (size_t)(rr_ - NL) * 1024 : XLp + (size_t)rr_ * 1024; \
        _Pragma("unroll") for (int i = 0; i < 4; ++i) { if (INBF) nxb[i] = *(const u32x2*)(XBp + (size_t)rr_ * 1024 + 256 * i + 4 * lane); else nx[i] = *(const f32x4*)(xp_ + 256 * i + 4 * lane); \
            if (DLT) ndr[i] = *(const u32x2*)(DLT + (size_t)rr_ * 1024 + 256 * i + 4 * lane); } } while (0)
    PM_LOAD(vb * 8 + wid);
    for (int row = vb * 8 + wid; row < nrows; row += stride) {
        const bool isctx = row >= NL; const int mr = isctx ? 32 : row / S;
        f32x4 x[4]; u32x2 dr4[4]; float ss = 0.f;
#pragma unroll
        for (int i = 0; i < 4; ++i) { if (INBF) x[i] = (f32x4){__uint_as_float(nxb[i].x << 16), __uint_as_float(nxb[i].x & 0xffff0000u), __uint_as_float(nxb[i].y << 16), __uint_as_float(nxb[i].y & 0xffff0000u)}; else x[i] = nx[i];
            if (DLT) dr4[i] = ndr[i]; }
        PM_LOAD(row + stride);
#pragma unroll
        for (int i = 0; i < 4; ++i) {
            if (DLT) { const u32x2 dr = dr4[i];
                x[i][0] += __uint_as_float(dr.x << 16); x[i][1] += __uint_as_float(dr.x & 0xffff0000u); x[i][2] += __uint_as_float(dr.y << 16); x[i][3] += __uint_as_float(dr.y & 0xffff0000u);
                u32x2 xo; xo.x = cvt_pk_bf16(x[i][0], x[i][1]); xo.y = cvt_pk_bf16(x[i][2], x[i][3]); *(u32x2*)(XBo + (size_t)row * 1024 + 256 * i + 4 * lane) = xo; }
            ss += x[i][0] * x[i][0] + x[i][1] * x[i][1] + x[i][2] * x[i][2] + x[i][3] * x[i][3]; }
        ss = wave_sum(ss); const float rstd = rsqrtf(ss * (1.f / 1024.f) + EPS);
        const float* sh = MODl + (size_t)mr * 6144 + si * 1024;
        f32x4 y[4]; float am = 0.f;
#pragma unroll
        for (int i = 0; i < 4; ++i) { const f32x4 shv = *(const f32x4*)(sh + 256 * i + 4 * lane), scv = *(const f32x4*)(sh + 1024 + 256 * i + 4 * lane);
            y[i] = x[i] * rstd * gv[i] * (scv + 1.f) + shv;
            am = fmaxf(am, fmaxf(fmaxf(fabsf(y[i][0]), fabsf(y[i][1])), fmaxf(fabsf(y[i][2]), fabsf(y[i][3]))));
            u32x2 o; o.x = cvt_pk_bf16(y[i][0], y[i][1]); o.y = cvt_pk_bf16(y[i][2], y[i][3]);
            *(u32x2*)(Hout + (size_t)row * 1024 + 256 * i + 4 * lane) = o; }
        if (H8) {
#pragma unroll
            for (int o = 32; o > 0; o >>= 1) am = fmaxf(am, __shfl_xor(am, o));
            const float inv = am > 0.f ? 127.f / am : 0.f;
#pragma unroll
            for (int i = 0; i < 4; ++i) { const int q0 = (int)rintf(y[i][0] * inv), q1 = (int)rintf(y[i][1] * inv), q2 = (int)rintf(y[i][2] * inv), q3 = (int)rintf(y[i][3] * inv);
                *(unsigned*)(H8 + (size_t)row * 1024 + 256 * i + 4 * lane) = (unsigned)(q0 & 0xff) | ((unsigned)(q1 & 0xff) << 8) | ((unsigned)(q2 & 0xff) << 16) | ((unsigned)(q3 & 0xff) << 24); }
            if (lane == 0) HS[row] = am > 0.f ? am * (1.f / 127.f) : 1.f;
        }
    }
#undef PM_LOAD
}

struct EpiPQ {
    static constexpr bool PERM = true;
    bf16_t* PQ;
    __device__ __forceinline__ void operator()(const f32x4 (&acc)[2][2][4][2], const pg8::Unit& u, int wr, int wc, int fr, int fq) const {
        const size_t r0 = (size_t)u.pm * 256 + wr * 64 + fr; const int col0 = u.pn * 256 + wc * 32 + 8 * fq;
#pragma unroll
        for (int ai = 0; ai < 2; ++ai)
#pragma unroll
            for (int m = 0; m < 4; ++m) { bf16_t* d = PQ + (r0 + ai * 128 + m * 16) * 2048 + col0;
#pragma unroll
                for (int bj = 0; bj < 2; ++bj) { const f32x4 a0 = acc[ai][bj][m][0], a1 = acc[ai][bj][m][1];
                    u32x4 o; o.x = cvt_pk_bf16(a0[0], a0[1]); o.y = cvt_pk_bf16(a0[2], a0[3]); o.z = cvt_pk_bf16(a1[0], a1[1]); o.w = cvt_pk_bf16(a1[2], a1[3]);
                    *(u32x4*)(d + bj * 128) = o; } }
    }
};
__device__ __forceinline__ void phase_p6a(LAS unsigned char* lds, const WS& w, int l, int vb, int nvb) {
    EpiPQ E{w.PQ()}; const int M = l == 0 ? NR : NL;
    pg8::StaticOrder so; so.init(M, 2048, nvb, vb);
    pg8::gemm_phase(lds, pg8::Gemm{w.H(), w.WqT() + (size_t)l * 2048 * 1024, M, 2048, 1024}, so, E);
}


using bf16x2_t = __attribute__((ext_vector_type(2))) __bf16;
typedef float f32x2 __attribute__((ext_vector_type(2)));
__device__ __forceinline__ float gelu_fast(float x) {
    const float u2 = 1.5957691216057308f * (x + 0.044715f * x * x * x);
    return x * __builtin_amdgcn_rcpf(1.f + __builtin_amdgcn_exp2f(-1.4426950408889634f * u2));
}
#define DPPF(v, ctrl) __builtin_bit_cast(float, __builtin_amdgcn_update_dpp(0, __builtin_bit_cast(int, (v)), (ctrl), 0xf, 0xf, true))
__device__ __forceinline__ float reduce8(float p0, float p1, float p2, float p3, float p4, float p5, float p6, float p7, int lane) {
    auto s01 = __builtin_amdgcn_permlane32_swap(__float_as_uint(p0), __float_as_uint(p1), false, false);
    auto s23 = __builtin_amdgcn_permlane32_swap(__float_as_uint(p2), __float_as_uint(p3), false, false);
    auto s45 = __builtin_amdgcn_permlane32_swap(__float_as_uint(p4), __float_as_uint(p5), false, false);
    auto s67 = __builtin_amdgcn_permlane32_swap(__float_as_uint(p6), __float_as_uint(p7), false, false);
    const float q0 = __uint_as_float(s01[0]) + __uint_as_float(s01[1]), q1 = __uint_as_float(s23[0]) + __uint_as_float(s23[1]);
    const float q2 = __uint_as_float(s45[0]) + __uint_as_float(s45[1]), q3 = __uint_as_float(s67[0]) + __uint_as_float(s67[1]);
    auto t0 = __builtin_amdgcn_permlane16_swap(__float_as_uint(q0), __float_as_uint(q1), false, false);
    auto t1 = __builtin_amdgcn_permlane16_swap(__float_as_uint(q2), __float_as_uint(q3), false, false);
    float r0 = __uint_as_float(t0[0]) + __uint_as_float(t0[1]);
    float r1 = __uint_as_float(t1[0]) + __uint_as_float(t1[1]);
    r0 += DPPF(r0, 0x128); r1 += DPPF(r1, 0x128);
    float z = (lane & 8) ? r1 : r0;
    z += DPPF(z, 0x141);
    z += DPPF(z, 0xB1);
    z += DPPF(z, 0x4E);
    return z;
}
__device__ __forceinline__ void p7_axpy(const u32x4 v, float wj, f32x2 (&out)[8]) {
    const f32x2 w2 = {wj, wj};
#pragma unroll
    for (int k = 0; k < 4; ++k) { const f32x2 lo = __builtin_amdgcn_cvt_pk_f32_fp8((int)v[k], false), hi2 = __builtin_amdgcn_cvt_pk_f32_fp8((int)v[k], true);
        out[2 * k] = __builtin_elementwise_fma(w2, lo, out[2 * k]); out[2 * k + 1] = __builtin_elementwise_fma(w2, hi2, out[2 * k + 1]); }
}
__device__ __forceinline__ int p7_doti(const u32x4 u, const u32x4 h) {
    int s = __builtin_amdgcn_sdot4((int)u[0], (int)h[0], 0, false); s = __builtin_amdgcn_sdot4((int)u[1], (int)h[1], s, false); s = __builtin_amdgcn_sdot4((int)u[2], (int)h[2], s, false); return __builtin_amdgcn_sdot4((int)u[3], (int)h[3], s, false);
}
#define DPPI(v, ctrl) __builtin_amdgcn_update_dpp(0, (v), (ctrl), 0xf, 0xf, true)
__device__ __forceinline__ int reduce8i(int p0, int p1, int p2, int p3, int p4, int p5, int p6, int p7, int lane) {
    auto s01 = __builtin_amdgcn_permlane32_swap((unsigned)p0, (unsigned)p1, false, false); auto s23 = __builtin_amdgcn_permlane32_swap((unsigned)p2, (unsigned)p3, false, false);
    auto s45 = __builtin_amdgcn_permlane32_swap((unsigned)p4, (unsigned)p5, false, false); auto s67 = __builtin_amdgcn_permlane32_swap((unsigned)p6, (unsigned)p7, false, false);
    const unsigned q0 = s01[0] + s01[1], q1 = s23[0] + s23[1], q2 = s45[0] + s45[1], q3 = s67[0] + s67[1];
    auto t0 = __builtin_amdgcn_permlane16_swap(q0, q1, false, false); auto t1 = __builtin_amdgcn_permlane16_swap(q2, q3, false, false);
    int r0 = (int)(t0[0] + t0[1]), r1 = (int)(t1[0] + t1[1]);
    r0 += DPPI(r0, 0x128); r1 += DPPI(r1, 0x128);
    int z = (lane & 8) ? r1 : r0;
    z += DPPI(z, 0x141); z += DPPI(z, 0xB1); z += DPPI(z, 0x4E);
    return z;
}

struct P7CArgs { const signed char* H8; const unsigned* EG; const unsigned char* U8; int* PART; int nrows; };
__device__ __forceinline__ int p7_doti4(const u32x4 u, const u32x4 h0, const u32x4 h1) {
    int s = 0;
#pragma unroll
    for (int k = 0; k < 4; ++k) { const unsigned lo = (u[k] << 4) & 0xf0f0f0f0u, hi = u[k] & 0xf0f0f0f0u;
        const unsigned ha = (k < 2) ? h0[2 * k] : h1[2 * k - 4], hb = (k < 2) ? h0[2 * k + 1] : h1[2 * k - 3];
        s = __builtin_amdgcn_sdot4((int)lo, (int)ha, s, false); s = __builtin_amdgcn_sdot4((int)hi, (int)hb, s, false); }
    return s;
}
__device__ __forceinline__ void phase_p7c(LAS unsigned char* lds, const P7CArgs& a, int part8, int prank8, int nvb) {
    int tid_ = threadIdx.x; asm volatile("" : "+v"(tid_));
    const int lane = tid_ & 63, wid = __builtin_amdgcn_readfirstlane(tid_ >> 6);
    const int part = part8 >> 1, prank = (part8 & 1) * (nvb >> 3) + prank8;
    const int nw = (nvb >> 2) * 8, wrank = prank * 8 + wid;
    LAS unsigned* tab = (LAS unsigned*)(lds + wid * 1024);
    const int grp = lane >> 3, c = lane & 7, c16 = c * 16;
    const unsigned char* ubase = a.U8 + 128 * part + c16;
    const signed char* hbase = a.H8 + 256 * part + 32 * c;
    unsigned* pbase = (unsigned*)a.PART + (size_t)part * a.nrows * 64;
    const int c2 = (c >> 2) & 1, c1 = (c >> 1) & 1, c0 = c & 1;
    const int ent0 = 8 * (4 * c2 + 2 * c0 + c1) + grp;
    u32x4 Av[16], Bv[16]; u32x4 Ah0, Ah1, Bh0, Bh1;
    unsigned pw0 = 0u, pw1 = 0u;
#define P7C_PREF(t) do { pw0 = a.EG[(size_t)(t) * 128 + lane]; pw1 = a.EG[(size_t)(t) * 128 + 64 + lane]; } while (0)
#define P7C_ISSUE(X, Xh0, Xh1, t, slot, tnext) do { LAS unsigned* tb_ = tab + (slot) * 128; \
        tb_[lane] = pw0; tb_[64 + lane] = pw1; \
        asm volatile("s_waitcnt lgkmcnt(0)" ::: "memory"); \
        _Pragma("unroll") for (int i_ = 0; i_ < 16; ++i_) { const unsigned e_ = tb_[8 * i_ + grp]; X[i_] = *(const u32x4*)(ubase + (size_t)(e_ >> 16) * 512); } \
        Xh0 = *(const u32x4*)(hbase + (size_t)(t) * 1024); Xh1 = *(const u32x4*)(hbase + (size_t)(t) * 1024 + 16); \
        P7C_PREF(tnext); } while (0)
#define P7C_COMPUTE(X, Xh0, Xh1, t, valid) do { int d_[16]; \
        _Pragma("unroll") for (int i_ = 0; i_ < 16; ++i_) d_[i_] = p7_doti4(X[i_], Xh0, Xh1); \
        int e8_[8]; _Pragma("unroll") for (int k = 0; k < 8; ++k) { const int send_ = c2 ? d_[k] : d_[k + 8], keep_ = c2 ? d_[k + 8] : d_[k]; e8_[k] = keep_ + DPPI(send_, 0x141); }            \
        int e4_[4]; _Pragma("unroll") for (int k = 0; k < 4; ++k) { const int send_ = c0 ? e8_[k] : e8_[k + 4], keep_ = c0 ? e8_[k + 4] : e8_[k]; e4_[k] = keep_ + DPPI(send_, 0xB1); }          \
        int e2_[2]; _Pragma("unroll") for (int k = 0; k < 2; ++k) { const int send_ = c1 ? e4_[k] : e4_[k + 2], keep_ = c1 ? e4_[k + 2] : e4_[k]; e2_[k] = keep_ + DPPI(send_, 0x4E); }          \
        if (valid) pbase[(size_t)(t) * 64 + ent0] = __builtin_bit_cast(unsigned, __builtin_amdgcn_cvt_pk_i16(e2_[0] >> 4, e2_[1] >> 4)); } while (0)
    const int lastrow = a.nrows - 1;
    int t = wrank;
    if (t < a.nrows) {
    P7C_PREF(t);
    P7C_ISSUE(Av, Ah0, Ah1, t, 0, (t + nw < a.nrows ? t + nw : lastrow));
    while (t < a.nrows) {
        const int t1 = t + nw, t2 = t1 + nw, t3 = t2 + nw;
        const int k1 = t1 < a.nrows ? t1 : lastrow, k2 = t2 < a.nrows ? t2 : lastrow, k3 = t3 < a.nrows ? t3 : lastrow;
        P7C_ISSUE(Bv, Bh0, Bh1, k1, 1, k2);
        P7C_COMPUTE(Av, Ah0, Ah1, t, true);
        P7C_ISSUE(Av, Ah0, Ah1, k2, 0, k3);
        P7C_COMPUTE(Bv, Bh0, Bh1, k1, (t1 < a.nrows));
        t = t2;
    }
    }
#undef P7C_PREF
#undef P7C_ISSUE
#undef P7C_COMPUTE
}
__device__ __forceinline__ void phase_p7d(const int* __restrict__ PART, const unsigned* __restrict__ EG, const float* __restrict__ US, const float* __restrict__ VS, const float* __restrict__ HS, unsigned* __restrict__ WE, int nrows, int vb, int nvb) {
    int tid_ = threadIdx.x; asm volatile("" : "+v"(tid_));
    typedef int i32x4 __attribute__((ext_vector_type(4)));
    const size_t n16 = (size_t)nrows * 16, pstride4 = n16;
    const u32x4* P4 = (const u32x4*)PART; const u32x4* EG4 = (const u32x4*)EG; u32x4* WE4 = (u32x4*)WE;
    for (size_t j = (size_t)vb * 512 + tid_; j < n16; j += (size_t)nvb * 512) {
        const size_t row = j >> 4; const int P = (int)(j >> 1) & 7, gq = (int)j & 1;
        i32x4 slo = {0, 0, 0, 0}, shi = {0, 0, 0, 0};
#pragma unroll
        for (int p = 0; p < 4; ++p) { const u32x4 d = P4[p * pstride4 + j];
#pragma unroll
            for (int k = 0; k < 4; ++k) { slo[k] += (int)(d[k] << 16) >> 16; shi[k] += (int)d[k] >> 16; } }
        const float hs = HS[row];
#pragma unroll
        for (int half = 0; half < 2; ++half) {
            const size_t ei = row * 32 + 4 * P + 2 * half + gq;
            const u32x4 eg = EG4[ei]; u32x4 o;
#pragma unroll
            for (int k = 0; k < 4; ++k) { const int eid = (int)(eg[k] >> 16);
                const float av = (float)(half ? shi[k] : slo[k]) * US[eid] * hs;
                const float wv = __uint_as_float(eg[k] << 16) * gelu_fast(av) * VS[eid];
                o[k] = (eg[k] & 0xffff0000u) | (cvt_pk_bf16(wv, 0.f) & 0xffffu); }
            WE4[ei] = o;
        }
    }
}
struct P7BArgs { const unsigned* WE; const unsigned char* V8; bf16_t* XB; const float* gate2; int nrows; };
__device__ __forceinline__ void p7_axpy4(const u32x4 v, float wj, f32x2 (&out)[16]) {
    const f32x2 w2 = {wj, wj};
#pragma unroll
    for (int k = 0; k < 4; ++k) {
        const f32x2 a0 = __builtin_amdgcn_cvt_scalef32_pk_f32_fp4(v[k], 1.0f, 0), a1 = __builtin_amdgcn_cvt_scalef32_pk_f32_fp4(v[k], 1.0f, 1), a2 = __builtin_amdgcn_cvt_scalef32_pk_f32_fp4(v[k], 1.0f, 2), a3 = __builtin_amdgcn_cvt_scalef32_pk_f32_fp4(v[k], 1.0f, 3);
        out[4 * k] = __builtin_elementwise_fma(w2, a0, out[4 * k]); out[4 * k + 1] = __builtin_elementwise_fma(w2, a1, out[4 * k + 1]);
        out[4 * k + 2] = __builtin_elementwise_fma(w2, a2, out[4 * k + 2]); out[4 * k + 3] = __builtin_elementwise_fma(w2, a3, out[4 * k + 3]); }
}
template <int PM>
__device__ __forceinline__ void phase_p7b(LAS unsigned char* lds, const P7BArgs& a, int part8, int prank8, int nvb) {
    int tid_ = threadIdx.x; asm volatile("" : "+v"(tid_));
    const int lane = tid_ & 63, wid = __builtin_amdgcn_readfirstlane(tid_ >> 6);
    const int part = part8 >> 1, prank = (part8 & 1) * (nvb >> 3) + prank8;
    const int nw = (nvb >> 2) * 8, wrank = prank * 8 + wid;
    LAS unsigned* tab = (LAS unsigned*)(lds + wid * 1024);
    const int grp = lane >> 3, c16 = (lane & 7) * 16;
    const unsigned char* vbase = a.V8 + 128 * part + c16;
    const int colofs = 256 * part + 2 * c16 + 16 * (lane >> 5) + 8 * ((lane >> 4) & 1) + 4 * ((lane >> 3) & 1);
    u32x4 Av[16], Bv[16]; float Aw[16], Bw[16]; u32x2 Ax, Bx; f32x4 Ag, Bg;
    unsigned pw0 = 0u, pw1 = 0u;
#define P7B_PREF(t) do { pw0 = a.WE[(size_t)(t) * 128 + lane]; pw1 = a.WE[(size_t)(t) * 128 + 64 + lane]; } while (0)
#define P7B_ISSUE(X, Xw, Xx, Xg, t, slot, tnext) do { LAS unsigned* tb_ = tab + (slot) * 128; \
        tb_[lane] = pw0; tb_[64 + lane] = pw1; \
        asm volatile("s_waitcnt lgkmcnt(0)" ::: "memory"); \
        _Pragma("unroll") for (int i_ = 0; i_ < 16; ++i_) { const unsigned we_ = tb_[8 * i_ + grp]; Xw[i_] = __uint_as_float(we_ << 16); X[i_] = *(const u32x4*)(vbase + (size_t)(we_ >> 16) * 512); } \
        { const int mr_ = (t) >= NL ? 32 : (t) / S; \
          Xx = *(const u32x2*)(a.XB + (size_t)(t) * 1024 + colofs); Xg = *(const f32x4*)(a.gate2 + (size_t)mr_ * 6144 + colofs); } \
        P7B_PREF(tnext); } while (0)
#define P7B_COMPUTE(X, Xw, Xx, Xg, t, valid) do { f32x2 acc2[16]; \
        _Pragma("unroll") for (int k = 0; k < 16; ++k) acc2[k] = (f32x2){0.f, 0.f}; \
        _Pragma("unroll") for (int i_ = 0; i_ < 16; ++i_) p7_axpy4(X[i_], Xw[i_], acc2); \
        float b_[16]; _Pragma("unroll") for (int k = 0; k < 16; ++k) { auto s_ = __builtin_amdgcn_permlane32_swap(__float_as_uint(acc2[k >> 1][k & 1]), __float_as_uint(acc2[(k + 16) >> 1][k & 1]), false, false); b_[k] = __uint_as_float(s_[0]) + __uint_as_float(s_[1]); } \
        float c_[8]; _Pragma("unroll") for (int k = 0; k < 8; ++k) { auto s_ = __builtin_amdgcn_permlane16_swap(__float_as_uint(b_[k]), __float_as_uint(b_[k + 8]), false, false); c_[k] = __uint_as_float(s_[0]) + __uint_as_float(s_[1]); } \
        float d_[4]; _Pragma("unroll") for (int k = 0; k < 4; ++k) { const float send_ = (lane & 8) ? c_[k] : c_[k + 4]; const float keep_ = (lane & 8) ? c_[k + 4] : c_[k]; d_[k] = keep_ + DPPF(send_, 0x128); } \
        u32x2* xp_ = (u32x2*)(a.XB + (size_t)(t) * 1024 + colofs); \
        const float x0_ = __uint_as_float(Xx.x << 16) + Xg[0] * d_[0], x1_ = __uint_as_float(Xx.x & 0xffff0000u) + Xg[1] * d_[1], x2_ = __uint_as_float(Xx.y << 16) + Xg[2] * d_[2], x3_ = __uint_as_float(Xx.y & 0xffff0000u) + Xg[3] * d_[3]; \
        u32x2 xo_; xo_.x = cvt_pk_bf16(x0_, x1_); xo_.y = cvt_pk_bf16(x2_, x3_); \
        if ((valid) && PM == 0) *xp_ = xo_; else if (PM != 0 && x0_ == 1.2345e30f) *xp_ = xo_; } while (0)
    const int lastrow = a.nrows - 1;
    int t = wrank;
    if (t < a.nrows) {
    P7B_PREF(t);
    P7B_ISSUE(Av, Aw, Ax, Ag, t, 0, (t + nw < a.nrows ? t + nw : lastrow));
    while (t < a.nrows) {
        const int t1 = t + nw, t2 = t1 + nw, t3 = t2 + nw;
        const int c1 = t1 < a.nrows ? t1 : lastrow, c2 = t2 < a.nrows ? t2 : lastrow, c3 = t3 < a.nrows ? t3 : lastrow;
        P7B_ISSUE(Bv, Bw, Bx, Bg, c1, 1, c2);
        P7B_COMPUTE(Av, Aw, Ax, Ag, t, true);
        P7B_ISSUE(Av, Aw, Ax, Ag, c2, 0, c3);
        P7B_COMPUTE(Bv, Bw, Bx, Bg, c1, (t1 < a.nrows));
        t = t2;
    }
    }
#undef P7B_PREF
#undef P7B_ISSUE
#undef P7B_COMPUTE
}
__device__ __forceinline__ void phase_final_norm(const bf16_t* __restrict__ XBp, float* __restrict__ OUT, const float* __restrict__ g, int vb, int nvb) {
    int tid_ = threadIdx.x; asm volatile("" : "+v"(tid_));
    const int lane = tid_ & 63, wid = tid_ >> 6;
    for (int row = vb * 8 + wid; row < NL; row += nvb * 8) {
        const bf16_t* xp = XBp + (size_t)row * 1024; f32x4 x[4]; float ss = 0.f;
#pragma unroll
        for (int i = 0; i < 4; ++i) { const u32x2 r = *(const u32x2*)(xp + 256 * i + 4 * lane); x[i] = (f32x4){__uint_as_float(r.x << 16), __uint_as_float(r.x & 0xffff0000u), __uint_as_float(r.y << 16), __uint_as_float(r.y & 0xffff0000u)};
            ss += x[i][0] * x[i][0] + x[i][1] * x[i][1] + x[i][2] * x[i][2] + x[i][3] * x[i][3]; }
        ss = wave_sum(ss); const float rstd = rsqrtf(ss * (1.f / 1024.f) + EPS);
#pragma unroll
        for (int i = 0; i < 4; ++i) *(f32x4*)(OUT + (size_t)row * 1024 + 256 * i + 4 * lane) = x[i] * rstd * *(const f32x4*)(g + 256 * i + 4 * lane);
    }
}

template <int V_> struct IC { static constexpr int value = V_; };
typedef short s16x4 __attribute__((ext_vector_type(4)));
__device__ __forceinline__ s16x4 lds_tr16(const LAS unsigned char* p) { return __builtin_bit_cast(s16x4, __builtin_amdgcn_ds_read_tr16_b64_v4i16((LAS s16x4*)p)); }
constexpr int ATT_BUF = 20480;
__device__ __forceinline__ void glds16(const void* g, unsigned lds_base) {
    unsigned sv; asm volatile("s_mov_b32 %0, m0\n\ts_mov_b32 m0, %2\n\ts_nop 0\n\tglobal_load_lds_dwordx4 %1, off\n\ts_mov_b32 m0, %0" : "=&s"(sv) : "v"(g), "s"(lds_base) : "memory"); }
template <int DK>
__device__ __forceinline__ void attn_unit(LAS unsigned char* lds, const bf16_t* __restrict__ Q, const bf16_t* __restrict__ K1, const bf16_t* __restrict__ K2, const bf16_t* __restrict__ V,
                                          int nkeys, float c2, bf16_t* __restrict__ out) {
    int tid_ = threadIdx.x; asm volatile("" : "+v"(tid_));
    const int tid = tid_, lane = tid & 63, wid = __builtin_amdgcn_readfirstlane(tid >> 6), r32 = lane & 31, hi = lane >> 5;
    constexpr int NS = DK / 16, NM = 2 * NS;
    bf16x8 qf[NS];
    { const bf16_t* qp = Q + (size_t)(wid * 32 + r32) * DK + 8 * hi;
#pragma unroll
      for (int s = 0; s < NS; ++s) qf[s] = *(const bf16x8*)(qp + 16 * s); }
    const int dkey = 8 * wid + (lane >> 3), dkey2 = 16 * (wid & 3) + (lane >> 2);
    const bf16_t* gk1 = K1 + (size_t)dkey * 64 + (((lane & 7) ^ ((dkey >> 1) & 7)) << 3);
    const bf16_t* gv = V + (size_t)dkey * 64 + (((lane & 7) ^ (((dkey >> 1) & 1) << 2)) << 3);
    const bf16_t* gk2 = (DK == 96) ? K2 + (size_t)dkey2 * 32 + (((lane & 3) ^ ((dkey2 >> 2) & 3)) << 3) : nullptr;
    const unsigned lds0 = (unsigned)(size_t)lds;
    const unsigned d_k1 = lds0 + wid * 1024, d_v = lds0 + 8192 + wid * 1024, d_k2 = lds0 + 16384 + (wid & 3) * 1024;
#define ATT_DMA(tile_, slot_) do { const int tt_ = (tile_); glds16(gk1 + (size_t)tt_ * 4096, (unsigned)__builtin_amdgcn_readfirstlane(d_k1 + (slot_) * ATT_BUF)); \
        glds16(gv + (size_t)tt_ * 4096, (unsigned)__builtin_amdgcn_readfirstlane(d_v + (slot_) * ATT_BUF)); \
        if (DK == 96) glds16(gk2 + (size_t)tt_ * 2048, (unsigned)__builtin_amdgcn_readfirstlane(d_k2 + (slot_) * ATT_BUF)); } while (0)
#define ATT_WAIT_BAR() do { if (DK == 96) asm volatile("s_waitcnt vmcnt(3) lgkmcnt(0)\n\ts_barrier" ::: "memory"); else asm volatile("s_waitcnt vmcnt(2) lgkmcnt(0)\n\ts_barrier" ::: "memory"); } while (0)
    unsigned ka[2][4];
#pragma unroll
    for (int kt = 0; kt < 2; ++kt)
#pragma unroll
        for (int s = 0; s < 4; ++s) { const int key = 32 * kt + r32; ka[kt][s] = key * 128 + (((2 * s + hi) ^ ((key >> 1) & 7)) << 4); }
    unsigned kb[2][2];
#pragma unroll
    for (int kt = 0; kt < 2; ++kt)
#pragma unroll
        for (int s = 0; s < 2; ++s) { const int key = 32 * kt + r32; kb[kt][s] = 16384 + key * 64 + (((2 * s + hi) ^ ((key >> 2) & 3)) << 4); }
    const int vq = (lane & 15) >> 2, vp = lane & 3, vg = (lane >> 4) & 1;
    unsigned va[2];
#pragma unroll
    for (int dvb = 0; dvb < 2; ++dvb) { const int key = 4 * hi + vq; va[dvb] = 8192 + key * 128 + ((((32 * dvb + 16 * vg + 4 * vp) * 2)) ^ (((key >> 1) & 1) << 6)); }
    float m = -1e30f, l = 0.f, mx;
    f32x16 o0 = {}, o1 = {};
    const int NT = nkeys >> 6;
    ATT_DMA(0, 0); ATT_DMA(NT > 1 ? 1 : 0, 1); ATT_DMA(NT > 2 ? 2 : NT - 1, 2);
    asm volatile("s_waitcnt vmcnt(0) lgkmcnt(0)\n\ts_barrier" ::: "memory");
    f32x16 pa0 = {}, pa1 = {}, pb0 = {}, pb1 = {};
    {
        bf16x8 kf0[NS], kf1[NS];
#pragma unroll
        for (int s = 0; s < 4; ++s) { kf0[s] = *(const LAS bf16x8*)(lds + ka[0][s]); kf1[s] = *(const LAS bf16x8*)(lds + ka[1][s]); }
        if (DK == 96) {
#pragma unroll
            for (int s = 0; s < 2; ++s) { kf0[4 + s] = *(const LAS bf16x8*)(lds + kb[0][s]); kf1[4 + s] = *(const LAS bf16x8*)(lds + kb[1][s]); }
        }
#pragma unroll
        for (int s = 0; s < NS; ++s) { pa0 = mfma32(kf0[s], qf[s], pa0); pa1 = mfma32(kf1[s], qf[s], pa1); }
        mx = pa0[0];
#pragma unroll
        for (int r = 1; r < 16; ++r) mx = fmaxf(mx, pa0[r]);
#pragma unroll
        for (int r = 0; r < 16; ++r) mx = fmaxf(mx, pa1[r]);
    }
    auto step = [&](auto bc_, auto bn_, auto bw_, f32x16& pc0, f32x16& pc1, f32x16& pn0, f32x16& pn1, int t) __attribute__((always_inline)) {
        constexpr int BC = decltype(bc_)::value * ATT_BUF, BN = decltype(bn_)::value * ATT_BUF;
        ATT_DMA((t + 3 < NT) ? t + 3 : NT - 1, decltype(bw_)::value);
        bf16x8 kf0[NS], kf1[NS];
#pragma unroll
        for (int s = 0; s < 4; ++s) { kf0[s] = *(const LAS bf16x8*)(lds + BN + ka[0][s]); kf1[s] = *(const LAS bf16x8*)(lds + BN + ka[1][s]); }
        if (DK == 96) {
#pragma unroll
            for (int s = 0; s < 2; ++s) { kf0[4 + s] = *(const LAS bf16x8*)(lds + BN + kb[0][s]); kf1[4 + s] = *(const LAS bf16x8*)(lds + BN + kb[1][s]); }
        }
        __builtin_amdgcn_sched_barrier(0);
        { auto rr = __builtin_amdgcn_permlane32_swap(__float_as_uint(mx), __float_as_uint(mx), false, false); mx = fmaxf(__uint_as_float(rr[0]), __uint_as_float(rr[1])); }
        const float tm = mx;
        if (__any(tm > m + 8.f)) {
            const float mn = fmaxf(m, tm), al = __builtin_amdgcn_exp2f(m - mn); m = mn; l *= al;
#pragma unroll
            for (int r = 0; r < 16; ++r) { o0[r] *= al; o1[r] *= al; }
        }
        const float nm = -m; float ls = 0.f;
        pn0 = f32x16{}; pn1 = f32x16{};
        unsigned pw[16];
        s16x4 vlo[2][2][2], vhi[2][2][2];
#pragma unroll
        for (int c = 0; c < 8; ++c) {
            __builtin_amdgcn_sched_barrier(0);
#pragma unroll
            for (int j = 0; j < NM; ++j) if (j >= c * NM / 8 && j < (c + 1) * NM / 8) { if (j & 1) pn1 = mfma32(kf1[j >> 1], qf[j >> 1], pn1); else pn0 = mfma32(kf0[j >> 1], qf[j >> 1], pn0); }
            if (c == 4) {
#pragma unroll
                for (int kt = 0; kt < 2; ++kt)
#pragma unroll
                    for (int sp = 0; sp < 2; ++sp) { const int kofs = (32 * kt + 16 * sp) * 128;
#pragma unroll
                        for (int dvb = 0; dvb < 2; ++dvb) { vlo[dvb][kt][sp] = lds_tr16(lds + BC + va[dvb] + kofs); vhi[dvb][kt][sp] = lds_tr16(lds + BC + va[dvb] + kofs + 8 * 128); } }
            }
            __builtin_amdgcn_sched_barrier(0);
            if (c < 4) {
#pragma unroll
                for (int i = 0; i < 4; ++i) { const int r = 4 * c + i; pc0[r] = __builtin_amdgcn_exp2f(pc0[r] + nm); ls += pc0[r]; }
                pw[2 * c] = cvt_pk_bf16(pc0[4 * c], pc0[4 * c + 1]); pw[2 * c + 1] = cvt_pk_bf16(pc0[4 * c + 2], pc0[4 * c + 3]);
            } else {
#pragma unroll
                for (int i = 0; i < 4; ++i) { const int r = 4 * (c - 4) + i; pc1[r] = __builtin_amdgcn_exp2f(pc1[r] + nm); ls += pc1[r]; }
                pw[8 + 2 * (c - 4)] = cvt_pk_bf16(pc1[4 * (c - 4)], pc1[4 * (c - 4) + 1]); pw[8 + 2 * (c - 4) + 1] = cvt_pk_bf16(pc1[4 * (c - 4) + 2], pc1[4 * (c - 4) + 3]);
            }
        }
        __builtin_amdgcn_sched_barrier(0);
        l += ls;
        float mxn = -3.0e38f;
#pragma unroll
        for (int k = 0; k < 8; ++k) { const int kt = k >> 2, sp = (k >> 1) & 1, dvb = k & 1;
            const u32x4 pq = (u32x4){pw[8 * kt + 4 * sp], pw[8 * kt + 4 * sp + 1], pw[8 * kt + 4 * sp + 2], pw[8 * kt + 4 * sp + 3]};
            const s16x4 lo = vlo[dvb][kt][sp], hi4 = vhi[dvb][kt][sp]; const bf16x8 vf = (bf16x8){lo[0], lo[1], lo[2], lo[3], hi4[0], hi4[1], hi4[2], hi4[3]};
            if (dvb == 0) o0 = mfma32(vf, __builtin_bit_cast(bf16x8, pq), o0); else o1 = mfma32(vf, __builtin_bit_cast(bf16x8, pq), o1);
            __builtin_amdgcn_sched_barrier(0);
            if (k < 4) { mxn = fmaxf(fmaxf(mxn, pn0[4 * k]), fmaxf(pn0[4 * k + 1], fmaxf(pn0[4 * k + 2], pn0[4 * k + 3]))); }
            else { mxn = fmaxf(fmaxf(mxn, pn1[4 * (k - 4)]), fmaxf(pn1[4 * (k - 4) + 1], fmaxf(pn1[4 * (k - 4) + 2], pn1[4 * (k - 4) + 3]))); }
            __builtin_amdgcn_sched_barrier(0);
        }
        mx = mxn;
        ATT_WAIT_BAR();
    };
    for (int t = 0; t < NT; t += 4) {
        step(IC<0>{}, IC<1>{}, IC<3>{}, pa0, pa1, pb0, pb1, t);
        step(IC<1>{}, IC<2>{}, IC<0>{}, pb0, pb1, pa0, pa1, t + 1);
        step(IC<2>{}, IC<3>{}, IC<1>{}, pa0, pa1, pb0, pb1, t + 2);
        step(IC<3>{}, IC<0>{}, IC<2>{}, pb0, pb1, pa0, pa1, t + 3);
    }
    { auto rr = __builtin_amdgcn_permlane32_swap(__float_as_uint(l), __float_as_uint(l), false, false); l = __uint_as_float(rr[0]) + __uint_as_float(rr[1]); }
    const float il = 1.f / l;
    bf16_t* op = out + (size_t)(wid * 32 + r32) * 1024 + 4 * hi;
#pragma unroll
    for (int g = 0; g < 4; ++g) { u32x2 a, b;
        a.x = cvt_pk_bf16(o0[4 * g] * il, o0[4 * g + 1] * il); a.y = cvt_pk_bf16(o0[4 * g + 2] * il, o0[4 * g + 3] * il);
        b.x = cvt_pk_bf16(o1[4 * g] * il, o1[4 * g + 1] * il); b.y = cvt_pk_bf16(o1[4 * g + 2] * il, o1[4 * g + 3] * il);
        *(u32x2*)(op + 8 * g) = a; *(u32x2*)(op + 32 + 8 * g) = b; }
}
#undef ATT_DMA
#undef ATT_WAIT_BAR
template <int DK>
__device__ __forceinline__ void attn_unit64(LAS unsigned char* lds, const bf16_t* __restrict__ Q, const bf16_t* __restrict__ K1, const bf16_t* __restrict__ K2, const bf16_t* __restrict__ V,
                                            int nkeys, bf16_t* __restrict__ out) {
    int tid_ = threadIdx.x; asm volatile("" : "+v"(tid_));
    const int tid = tid_, lane = tid & 63, wid = __builtin_amdgcn_readfirstlane(tid >> 6), r32 = lane & 31, hi = lane >> 5;
    constexpr int NS = DK / 16;
    bf16x8 qf[2][NS];
#pragma unroll
    for (int j = 0; j < 2; ++j) { const bf16_t* qp = Q + (size_t)(wid * 64 + 32 * j + r32) * DK + 8 * hi;
#pragma unroll
        for (int s = 0; s < NS; ++s) qf[j][s] = *(const bf16x8*)(qp + 16 * s); }
    const int dkey = 8 * wid + (lane >> 3), dkey2 = 16 * (wid & 3) + (lane >> 2);
    const bf16_t* gk1 = K1 + (size_t)dkey * 64 + (((lane & 7) ^ ((dkey >> 1) & 7)) << 3);
    const bf16_t* gv = V + (size_t)dkey * 64 + (((lane & 7) ^ (((dkey >> 1) & 1) << 2)) << 3);
    const bf16_t* gk2 = (DK == 96) ? K2 + (size_t)dkey2 * 32 + (((lane & 3) ^ ((dkey2 >> 2) & 3)) << 3) : nullptr;
    const unsigned lds0 = (unsigned)(size_t)lds;
    const unsigned d_k1 = lds0 + wid * 1024, d_v = lds0 + 8192 + wid * 1024, d_k2 = lds0 + 16384 + (wid & 3) * 1024;
#define ATT_DMA(tile_, slot_) do { const int tt_ = (tile_); glds16(gk1 + (size_t)tt_ * 4096, (unsigned)__builtin_amdgcn_readfirstlane(d_k1 + (slot_) * ATT_BUF)); \
        glds16(gv + (size_t)tt_ * 4096, (unsigned)__builtin_amdgcn_readfirstlane(d_v + (slot_) * ATT_BUF)); \
        if (DK == 96) glds16(gk2 + (size_t)tt_ * 2048, (unsigned)__builtin_amdgcn_readfirstlane(d_k2 + (slot_) * ATT_BUF)); } while (0)
    unsigned ka[4];
#pragma unroll
    for (int s = 0; s < 4; ++s) ka[s] = r32 * 128 + (((2 * s + hi) ^ ((r32 >> 1) & 7)) << 4);
    unsigned kb[2];
#pragma unroll
    for (int s = 0; s < 2; ++s) kb[s] = 16384 + r32 * 64 + (((2 * s + hi) ^ ((r32 >> 2) & 3)) << 4);
    const int vq = (lane & 15) >> 2, vp = lane & 3, vg = (lane >> 4) & 1;
    unsigned va[2];
#pragma unroll
    for (int dvb = 0; dvb < 2; ++dvb) { const int key = 4 * hi + vq; va[dvb] = 8192 + key * 128 + ((((32 * dvb + 16 * vg + 4 * vp) * 2)) ^ (((key >> 1) & 1) << 6)); }
    float m[2] = {-1e30f, -1e30f}, l[2] = {0.f, 0.f};
    f32x16 o[2][2] = {};
    const int NT = nkeys >> 6;
    ATT_DMA(0, 0); ATT_DMA(1, 1); ATT_DMA(2, 2);
    asm volatile("s_waitcnt vmcnt(0) lgkmcnt(0)\n\ts_barrier" ::: "memory");
    bf16x8 kf0[NS], kf1[NS];
#pragma unroll
    for (int s = 0; s < 4; ++s) { kf0[s] = *(const LAS bf16x8*)(lds + ka[s]); kf1[s] = *(const LAS bf16x8*)(lds + 4096 + ka[s]); }
    auto step = [&](auto cur_, auto wsl_, int t) __attribute__((always_inline)) {
        constexpr int BC = decltype(cur_)::value * ATT_BUF, BNX = ((decltype(cur_)::value + 1) & 3) * ATT_BUF;
        ATT_DMA((t + 3 < NT) ? t + 3 : NT - 1, decltype(wsl_)::value);
        unsigned pw[2][16];
        s16x4 vlo[2][2], vhi[2][2];
#define ATT64_VLOAD(kt_) do { _Pragma("unroll") for (int sp = 0; sp < 2; ++sp) { const int kofs = (32 * (kt_) + 16 * sp) * 128; \
            _Pragma("unroll") for (int dvb = 0; dvb < 2; ++dvb) { vlo[dvb][sp] = lds_tr16(lds + BC + va[dvb] + kofs); vhi[dvb][sp] = lds_tr16(lds + BC + va[dvb] + kofs + 8 * 128); } } } while (0)
#define ATT64_PV(kt_) do { _Pragma("unroll") for (int sp = 0; sp < 2; ++sp) _Pragma("unroll") for (int dvb = 0; dvb < 2; ++dvb) { \
            const s16x4 lo = vlo[dvb][sp], hi4 = vhi[dvb][sp]; const bf16x8 vf = (bf16x8){lo[0], lo[1], lo[2], lo[3], hi4[0], hi4[1], hi4[2], hi4[3]}; \
            _Pragma("unroll") for (int j = 0; j < 2; ++j) { const u32x4 pq = (u32x4){pw[j][8 * (kt_) + 4 * sp], pw[j][8 * (kt_) + 4 * sp + 1], pw[j][8 * (kt_) + 4 * sp + 2], pw[j][8 * (kt_) + 4 * sp + 3]}; \
                o[j][dvb] = mfma32(vf, __builtin_bit_cast(bf16x8, pq), o[j][dvb]); } } } while (0)
#pragma unroll
        for (int j = 0; j < 2; ++j) {
            f32x16 p0 = {}, p1 = {};
#pragma unroll
            for (int s = 0; s < NS; ++s) { p0 = mfma32(kf0[s], qf[j][s], p0); p1 = mfma32(kf1[s], qf[j][s], p1); }
            if (j == 1) { __builtin_amdgcn_sched_barrier(0); ATT64_VLOAD(0); __builtin_amdgcn_sched_barrier(0); }
            float mx = p0[0];
#pragma unroll
            for (int r = 1; r < 16; ++r) mx = fmaxf(mx, p0[r]);
#pragma unroll
            for (int r = 0; r < 16; ++r) mx = fmaxf(mx, p1[r]);
            { auto rr = __builtin_amdgcn_permlane32_swap(__float_as_uint(mx), __float_as_uint(mx), false, false); mx = fmaxf(__uint_as_float(rr[0]), __uint_as_float(rr[1])); }
            if (__any(mx > m[j] + 8.f)) {
                const float mn = fmaxf(m[j], mx), al = __builtin_amdgcn_exp2f(m[j] - mn); m[j] = mn; l[j] *= al;
#pragma unroll
                for (int r = 0; r < 16; ++r) { o[j][0][r] *= al; o[j][1][r] *= al; }
            }
            const float nm = -m[j];
#pragma unroll
            for (int r = 0; r < 16; ++r) { p0[r] = __builtin_amdgcn_exp2f(p0[r] + nm); p1[r] = __builtin_amdgcn_exp2f(p1[r] + nm); }
            f32x2 ls2 = {0.f, 0.f};
#pragma unroll
            for (int r = 0; r < 16; r += 2) { ls2 += (f32x2){p0[r], p0[r + 1]}; ls2 += (f32x2){p1[r], p1[r + 1]}; }
            l[j] += ls2.x + ls2.y;
#pragma unroll
            for (int i = 0; i < 8; ++i) { pw[j][i] = cvt_pk_bf16(p0[2 * i], p0[2 * i + 1]); pw[j][8 + i] = cvt_pk_bf16(p1[2 * i], p1[2 * i + 1]); }
            __builtin_amdgcn_sched_barrier(0);
        }
        ATT64_PV(0);
        __builtin_amdgcn_sched_barrier(0);
        ATT64_VLOAD(1);
        __builtin_amdgcn_sched_barrier(0);
        ATT64_PV(1);
#undef ATT64_VLOAD
#undef ATT64_PV
        __builtin_amdgcn_sched_barrier(0);
#pragma unroll
        for (int s = 0; s < 4; ++s) { kf0[s] = *(const LAS bf16x8*)(lds + BNX + ka[s]); kf1[s] = *(const LAS bf16x8*)(lds + BNX + 4096 + ka[s]); }
        asm volatile("s_waitcnt vmcnt(2) lgkmcnt(0)\n\ts_barrier" ::: "memory");
    };
    for (int t = 0; t < NT; t += 4) {
        step(IC<0>{}, IC<3>{}, t); step(IC<1>{}, IC<0>{}, t + 1); step(IC<2>{}, IC<1>{}, t + 2); step(IC<3>{}, IC<2>{}, t + 3);
    }
#pragma unroll
    for (int j = 0; j < 2; ++j) {
        float lj = l[j]; { auto rr = __builtin_amdgcn_permlane32_swap(__float_as_uint(lj), __float_as_uint(lj), false, false); lj = __uint_as_float(rr[0]) + __uint_as_float(rr[1]); }
        const float il = 1.f / lj;
        bf16_t* op = out + (size_t)(wid * 64 + 32 * j + r32) * 1024 + 4 * hi;
#pragma unroll
        for (int g = 0; g < 4; ++g) { u32x2 a, b;
            a.x = cvt_pk_bf16(o[j][0][4 * g] * il, o[j][0][4 * g + 1] * il); a.y = cvt_pk_bf16(o[j][0][4 * g + 2] * il, o[j][0][4 * g + 3] * il);
            b.x = cvt_pk_bf16(o[j][1][4 * g] * il, o[j][1][4 * g + 1] * il); b.y = cvt_pk_bf16(o[j][1][4 * g + 2] * il, o[j][1][4 * g + 3] * il);
            *(u32x2*)(op + 8 * g) = a; *(u32x2*)(op + 32 + 8 * g) = b; }
    }
#undef ATT_DMA
}
__device__ __forceinline__ void glds16s(const void* base, unsigned voff, unsigned lds_base) {
    unsigned sv; asm volatile("s_mov_b32 %0, m0\n\ts_mov_b32 m0, %3\n\ts_nop 0\n\tglobal_load_lds_dwordx4 %1, %2\n\ts_mov_b32 m0, %0" : "=&s"(sv) : "v"(voff), "s"(base), "s"(lds_base) : "memory"); }
__device__ __forceinline__ void attn_unit64m(LAS unsigned char* lds, const bf16_t* __restrict__ Q, const bf16_t* __restrict__ K1, const bf16_t* __restrict__ K2, const bf16_t* __restrict__ V,
                                            int nkeys, bf16_t* __restrict__ out) {
    constexpr int DK = 96;
    int tid_ = threadIdx.x; asm volatile("" : "+v"(tid_));
    const int tid = tid_, lane = tid & 63, wid = __builtin_amdgcn_readfirstlane(tid >> 6), r32 = lane & 31, hi = lane >> 5;
    bf16x8 qf[2][4];
    LAS unsigned char* qrl = lds + 4 * ATT_BUF + wid * 4096 + lane * 16;
#pragma unroll
    for (int j = 0; j < 2; ++j) { const bf16_t* qp = Q + (size_t)(wid * 64 + 32 * j + r32) * DK + 8 * hi;
#pragma unroll
        for (int s = 0; s < 4; ++s) qf[j][s] = *(const bf16x8*)(qp + 16 * s);
#pragma unroll
        for (int s = 0; s < 2; ++s) *(LAS bf16x8*)(qrl + (2 * j + s) * 1024) = *(const bf16x8*)(qp + 64 + 16 * s); }
    const int dkey = 8 * wid + (lane >> 3), dkey2 = 16 * (wid & 3) + (lane >> 2);
    const unsigned ok1 = (unsigned)(dkey * 64 + (((lane & 7) ^ ((dkey >> 1) & 7)) << 3)) * 2u, ov = (unsigned)(dkey * 64 + (((lane & 7) ^ (((dkey >> 1) & 1) << 2)) << 3)) * 2u,
                   ok2 = (unsigned)(dkey2 * 32 + (((lane & 3) ^ ((dkey2 >> 2) & 3)) << 3)) * 2u;
    const unsigned lds0 = (unsigned)(size_t)lds;
    const unsigned d_k1 = lds0 + wid * 1024, d_v = lds0 + 8192 + wid * 1024, d_k2 = lds0 + 16384 + (wid & 3) * 1024;
#define ATT_DMA(tile_, slot_) do { const int tt_ = (tile_); glds16s((const char*)K1 + (size_t)tt_ * 8192, ok1, (unsigned)__builtin_amdgcn_readfirstlane(d_k1 + (slot_) * ATT_BUF)); \
        glds16s((const char*)V + (size_t)tt_ * 8192, ov, (unsigned)__builtin_amdgcn_readfirstlane(d_v + (slot_) * ATT_BUF)); \
        glds16s((const char*)K2 + (size_t)tt_ * 4096, ok2, (unsigned)__builtin_amdgcn_readfirstlane(d_k2 + (slot_) * ATT_BUF)); } while (0)
    const unsigned ka0_ = r32 * 128 + ((hi ^ ((r32 >> 1) & 7)) << 4), kb0_ = 16384 + r32 * 64 + ((hi ^ ((r32 >> 2) & 3)) << 4);
#define ka(s_) (kao_ ^ ((unsigned)(s_) << 5))
#define kb(s_) (kbo_ ^ ((unsigned)(s_) << 5))
    const int vq = (lane & 15) >> 2, vp = lane & 3, vg = (lane >> 4) & 1;
    const unsigned va0_ = 8192 + (4 * hi + vq) * 128 + ((((16 * vg + 4 * vp) * 2)) ^ ((((4 * hi + vq) >> 1) & 1) << 6));
    float m[2] = {-1e30f, -1e30f}, l[2] = {0.f, 0.f};
    f32x16 o[2][2] = {};
    const int NT = nkeys >> 6;
    ATT_DMA(0, 0); ATT_DMA(1, 1); ATT_DMA(2, 2);
    asm volatile("s_waitcnt vmcnt(0) lgkmcnt(0)\n\ts_barrier" ::: "memory");
    auto step = [&](auto cur_, auto wsl_, int t) __attribute__((always_inline)) {
        constexpr int BC = decltype(cur_)::value * ATT_BUF;
        unsigned kao_ = ka0_, kbo_ = kb0_, vao_ = va0_; asm volatile("" : "+v"(kao_), "+v"(kbo_), "+v"(vao_));
        const unsigned va[2] = {vao_, vao_ ^ 64u};
        ATT_DMA((t + 3 < NT) ? t + 3 : NT - 1, decltype(wsl_)::value);
        f32x16 pj[2][2];
#pragma unroll
        for (int j = 0; j < 2; ++j) { pj[j][0] = f32x16{}; pj[j][1] = f32x16{}; }
        {
            bf16x8 ka0[2], ka1[2], kb0[2], kb1[2];
#pragma unroll
            for (int s = 0; s < 2; ++s) { ka0[s] = *(const LAS bf16x8*)(lds + BC + ka(s)); ka1[s] = *(const LAS bf16x8*)(lds + BC + 4096 + ka(s)); }
#pragma unroll
            for (int s = 0; s < 2; ++s) { kb0[s] = *(const LAS bf16x8*)(lds + BC + ka(2 + s)); kb1[s] = *(const LAS bf16x8*)(lds + BC + 4096 + ka(2 + s)); }
            __builtin_amdgcn_sched_barrier(0);
#pragma unroll
            for (int s = 0; s < 2; ++s)
#pragma unroll
                for (int j = 0; j < 2; ++j) { pj[j][0] = mfma32(ka0[s], qf[j][s], pj[j][0]); pj[j][1] = mfma32(ka1[s], qf[j][s], pj[j][1]); }
            __builtin_amdgcn_sched_barrier(0);
            bf16x8 qr[2][2];
#pragma unroll
            for (int s = 0; s < 2; ++s) { ka0[s] = *(const LAS bf16x8*)(lds + BC + kb(s)); ka1[s] = *(const LAS bf16x8*)(lds + BC + 2048 + kb(s)); }
            __builtin_amdgcn_sched_barrier(0);
#pragma unroll
            for (int s = 0; s < 2; ++s)
#pragma unroll
                for (int j = 0; j < 2; ++j) { pj[j][0] = mfma32(kb0[s], qf[j][2 + s], pj[j][0]); pj[j][1] = mfma32(kb1[s], qf[j][2 + s], pj[j][1]); }
            __builtin_amdgcn_sched_barrier(0);
#pragma unroll
            for (int j = 0; j < 2; ++j)
#pragma unroll
                for (int s = 0; s < 2; ++s) qr[j][s] = *(const LAS bf16x8*)(qrl + (2 * j + s) * 1024);
            __builtin_amdgcn_sched_barrier(0);
#pragma unroll
            for (int s = 0; s < 2; ++s)
#pragma unroll
                for (int j = 0; j < 2; ++j) { pj[j][0] = mfma32(ka0[s], qr[j][s], pj[j][0]); pj[j][1] = mfma32(ka1[s], qr[j][s], pj[j][1]); }
            __builtin_amdgcn_sched_barrier(0);
        }
        unsigned pw[2][16];
        s16x4 vlo[2][2], vhi[2][2];
#define ATT64_VLOAD(kt_) do { _Pragma("unroll") for (int sp = 0; sp < 2; ++sp) { const int kofs = (32 * (kt_) + 16 * sp) * 128; \
            _Pragma("unroll") for (int dvb = 0; dvb < 2; ++dvb) { vlo[dvb][sp] = lds_tr16(lds + BC + va[dvb] + kofs); vhi[dvb][sp] = lds_tr16(lds + BC + va[dvb] + kofs + 8 * 128); } } } while (0)
#define ATT64_PV(kt_) do { _Pragma("unroll") for (int sp = 0; sp < 2; ++sp) _Pragma("unroll") for (int dvb = 0; dvb < 2; ++dvb) { \
            const s16x4 lo = vlo[dvb][sp], hi4 = vhi[dvb][sp]; const bf16x8 vf = (bf16x8){lo[0], lo[1], lo[2], lo[3], hi4[0], hi4[1], hi4[2], hi4[3]}; \
            _Pragma("unroll") for (int j = 0; j < 2; ++j) { const u32x4 pq = (u32x4){pw[j][8 * (kt_) + 4 * sp], pw[j][8 * (kt_) + 4 * sp + 1], pw[j][8 * (kt_) + 4 * sp + 2], pw[j][8 * (kt_) + 4 * sp + 3]}; \
                o[j][dvb] = mfma32(vf, __builtin_bit_cast(bf16x8, pq), o[j][dvb]); } } } while (0)
#pragma unroll
        for (int j = 0; j < 2; ++j) {
            f32x16 p0 = pj[j][0], p1 = pj[j][1];
            if (j == 1) { __builtin_amdgcn_sched_barrier(0); ATT64_VLOAD(0); __builtin_amdgcn_sched_barrier(0); }
            float mx = p0[0];
#pragma unroll
            for (int r = 1; r < 16; ++r) mx = fmaxf(mx, p0[r]);
#pragma unroll
            for (int r = 0; r < 16; ++r) mx = fmaxf(mx, p1[r]);
            { auto rr = __builtin_amdgcn_permlane32_swap(__float_as_uint(mx), __float_as_uint(mx), false, false); mx = fmaxf(__uint_as_float(rr[0]), __uint_as_float(rr[1])); }
            if (__any(mx > m[j] + 8.f)) {
                const float mn = fmaxf(m[j], mx), al = __builtin_amdgcn_exp2f(m[j] - mn); m[j] = mn; l[j] *= al;
#pragma unroll
                for (int r = 0; r < 16; ++r) { o[j][0][r] *= al; o[j][1][r] *= al; }
            }
            const float nm = -m[j];
#pragma unroll
            for (int r = 0; r < 16; ++r) { p0[r] = __builtin_amdgcn_exp2f(p0[r] + nm); p1[r] = __builtin_amdgcn_exp2f(p1[r] + nm); }
            f32x2 ls2 = {0.f, 0.f};
#pragma unroll
            for (int r = 0; r < 16; r += 2) { ls2 += (f32x2){p0[r], p0[r + 1]}; ls2 += (f32x2){p1[r], p1[r + 1]}; }
            l[j] += ls2.x + ls2.y;
#pragma unroll
            for (int i = 0; i < 8; ++i) { pw[j][i] = cvt_pk_bf16(p0[2 * i], p0[2 * i + 1]); pw[j][8 + i] = cvt_pk_bf16(p1[2 * i], p1[2 * i + 1]); }
            __builtin_amdgcn_sched_barrier(0);
        }
        ATT64_PV(0);
        __builtin_amdgcn_sched_barrier(0);
        ATT64_VLOAD(1);
        __builtin_amdgcn_sched_barrier(0);
        ATT64_PV(1);
#undef ATT64_VLOAD
#undef ATT64_PV
        if (DK == 96) asm volatile("s_waitcnt vmcnt(6) lgkmcnt(0)\n\ts_barrier" ::: "memory"); else asm volatile("s_waitcnt vmcnt(4) lgkmcnt(0)\n\ts_barrier" ::: "memory");
    };
    for (int t = 0; t < NT; t += 4) {
        step(IC<0>{}, IC<3>{}, t); step(IC<1>{}, IC<0>{}, t + 1); step(IC<2>{}, IC<1>{}, t + 2); step(IC<3>{}, IC<2>{}, t + 3);
    }
#pragma unroll
    for (int j = 0; j < 2; ++j) {
        float lj = l[j]; { auto rr = __builtin_amdgcn_permlane32_swap(__float_as_uint(lj), __float_as_uint(lj), false, false); lj = __uint_as_float(rr[0]) + __uint_as_float(rr[1]); }
        const float il = 1.f / lj;
        bf16_t* op = out + (size_t)(wid * 64 + 32 * j + r32) * 1024 + 4 * hi;
#pragma unroll
        for (int g = 0; g < 4; ++g) { u32x2 a, b;
            a.x = cvt_pk_bf16(o[j][0][4 * g] * il, o[j][0][4 * g + 1] * il); a.y = cvt_pk_bf16(o[j][0][4 * g + 2] * il, o[j][0][4 * g + 3] * il);
            b.x = cvt_pk_bf16(o[j][1][4 * g] * il, o[j][1][4 * g + 1] * il); b.y = cvt_pk_bf16(o[j][1][4 * g + 2] * il, o[j][1][4 * g + 3] * il);
            *(u32x2*)(op + 8 * g) = a; *(u32x2*)(op + 32 + 8 * g) = b; }
    }
#undef ATT_DMA
#undef ka
#undef kb
}
__device__ __forceinline__ void phase_p3(LAS unsigned char* lds, const WS& w, int l, int vb, int nvb, int xpart, int xrank) {
    const float c2g = 0.125f * 1.4426950408889634f, c2m = 0.10206207261596577f * 1.4426950408889634f;
    bf16_t* MIX = w.H();
    const int nlat = NB * 12 * 4, nctx = (l == 0) ? NB * 12 : 0;
    const bool xl = (nvb == 256);
    for (int u = vb; u < nlat + nctx; u += nvb) {
        if (u < nlat) {
            const bool mla = u >= nlat / 2; const int v = mla ? u - nlat / 2 : u;
            int qb, hh, b;
            if (xl) { const int grp = (v >> 8) * 64 + 8 * xpart + (xrank >> 2); qb = xrank & 3; hh = grp % 6; b = grp / 6; }
            else { qb = v & 3; hh = (v >> 2) % 6; b = v / 24; }
            bf16_t* out = MIX + ((size_t)b * S + qb * 512) * 1024;
            if (!mla) attn_unit64<64>(lds, w.Qg() + (((size_t)b * 6 + hh) * S + qb * 512) * 64, w.Kg() + ((size_t)b * 2 + hh / 3) * KEYS * 64, nullptr, w.Vg() + ((size_t)b * 2 + hh / 3) * KEYS * 64, KEYS, out + hh * 64);
            else attn_unit64m(lds, w.Qm() + (((size_t)b * 6 + hh) * S + qb * 512) * 96, w.Kmn() + ((size_t)b * 6 + hh) * KEYS * 64, w.KR() + (size_t)b * KEYS * 32, w.Vm() + ((size_t)b * 6 + hh) * KEYS * 64, KEYS, out + 640 + hh * 64);
        } else {
            const int v = u - nlat, slot = v % 12, b = v / 12;
            bf16_t* out = MIX + ((size_t)NL + (size_t)b * CTX) * 1024;
            if (slot < 6) attn_unit<64>(lds, w.Qgc() + ((size_t)b * 6 + slot) * CTX * 64, w.Kg() + ((size_t)b * 2 + slot / 3) * KEYS * 64, nullptr, w.Vg() + ((size_t)b * 2 + slot / 3) * KEYS * 64, CTX, c2g, out + slot * 64);
            else { const int h = slot - 6; attn_unit<96>(lds, w.Qmc() + ((size_t)b * 6 + h) * CTX * 96, w.Kmn() + ((size_t)b * 6 + h) * KEYS * 64, w.KR() + (size_t)b * KEYS * 32, w.Vm() + ((size_t)b * 6 + h) * KEYS * 64, CTX, c2m, out + 640 + h * 64); }
        }
    }
}

__device__ __forceinline__ unsigned fkey(float f, unsigned tag, unsigned mask) { return (__float_as_uint(f) & ~mask) | tag; }
__device__ __forceinline__ float keyf(unsigned k, unsigned mask) { return __uint_as_float(k & ~mask); }
__device__ __forceinline__ unsigned fmax_u(unsigned a, unsigned b) { unsigned r; asm("v_max_f32 %0, %1, %2" : "=v"(r) : "v"(a), "v"(b)); return r; }
__device__ __forceinline__ unsigned fmin_u(unsigned a, unsigned b) { unsigned r; asm("v_min_f32 %0, %1, %2" : "=v"(r) : "v"(a), "v"(b)); return r; }
__device__ __forceinline__ void ce_desc(unsigned& a, unsigned& b) { const unsigned hi_ = fmax_u(a, b), lo_ = fmin_u(a, b); a = hi_; b = lo_; }
template <int J> __device__ __forceinline__ void bstage16(unsigned* a) {
#pragma unroll
    for (int i = 0; i < 16; ++i) { const int l = i ^ J; if (l > i) ce_desc(a[i], a[l]); }
}
__device__ __forceinline__ void sort16_desc(unsigned* a) {
#define CE_(i, j) ce_desc(a[i], a[j]);
    CE_(0, 13) CE_(1, 12) CE_(2, 15) CE_(3, 14) CE_(4, 8) CE_(5, 6) CE_(7, 11) CE_(9, 10)
    CE_(0, 5) CE_(1, 7) CE_(2, 9) CE_(3, 4) CE_(6, 13) CE_(8, 14) CE_(10, 15) CE_(11, 12)
    CE_(0, 1) CE_(2, 3) CE_(4, 5) CE_(6, 8) CE_(7, 9) CE_(10, 11) CE_(12, 13) CE_(14, 15)
    CE_(0, 2) CE_(1, 3) CE_(4, 10) CE_(5, 11) CE_(6, 7) CE_(8, 9) CE_(12, 14) CE_(13, 15)
    CE_(1, 2) CE_(3, 12) CE_(4, 6) CE_(5, 7) CE_(8, 10) CE_(9, 11) CE_(13, 14)
    CE_(1, 4) CE_(2, 6) CE_(5, 8) CE_(7, 10) CE_(9, 13) CE_(11, 14)
    CE_(2, 4) CE_(3, 6) CE_(9, 12) CE_(11, 13)
    CE_(3, 5) CE_(6, 8) CE_(7, 9) CE_(10, 12)
    CE_(3, 4) CE_(5, 6) CE_(7, 8) CE_(9, 10) CE_(11, 12)
    CE_(6, 7) CE_(8, 9)
#undef CE_
}
__device__ __forceinline__ void bmerge16_desc(unsigned* c) { bstage16<8>(c); bstage16<4>(c); bstage16<2>(c); bstage16<1>(c); }
__device__ __forceinline__ void merge_top16(unsigned* a, const unsigned* b) {
#pragma unroll
    for (int i = 0; i < 16; ++i) a[i] = fmax_u(a[i], b[15 - i]);
    bmerge16_desc(a);
}
__device__ __forceinline__ void xlane_top16(unsigned* t, int hi) {
    unsigned r[16]; const unsigned msk = 0u - (unsigned)hi;
#pragma unroll
    for (int i = 0; i < 16; ++i) r[i] = t[i] ^ ((t[i] ^ t[15 - i]) & msk);
#pragma unroll
    for (int i = 0; i < 16; ++i) { auto s = __builtin_amdgcn_permlane32_swap(r[i], r[i], false, false); t[i] = fmax_u(s[0], s[1]); }
    bmerge16_desc(t);
}
__device__ __forceinline__ constexpr int cand_a(int c) { return c < 16 ? 0 : c < 24 ? 1 : c < 32 ? 39 - c : c < 37 ? 2 : c < 41 ? 3 : c < 44 ? 4 : c < 46 ? 5 : c < 48 ? 6 : 7; }
__device__ __forceinline__ constexpr int cand_b(int c) { return c < 16 ? c : c < 24 ? c - 16 : c < 32 ? 0 : c < 37 ? c - 32 : c < 41 ? c - 37 : c < 44 ? c - 41 : c < 46 ? c - 44 : c < 48 ? c - 46 : c - 48; }

__device__ __forceinline__ void phase_p6b(LAS unsigned char* lds, const bf16_t* __restrict__ PQ, const bf16_t* __restrict__ SubKl, unsigned* __restrict__ EG, int nrows, int vb, int nvb) {
    int tid_ = threadIdx.x; asm volatile("" : "+v"(tid_));
    const int tid = tid_, lane = tid & 63, wid = __builtin_amdgcn_readfirstlane(tid >> 6), r32 = lane & 31, hi = lane >> 5;
    const int h = vb & 7, wrank = (vb >> 3) * 8 + wid, nwr = (nvb >> 3) * 8;
    LAS unsigned short* tab = (LAS unsigned short*)(lds + 65536 + wid * 4096) + r32 * 64;
#pragma unroll
    for (int i = 0; i < 8; ++i) { const int idx = i * 512 + tid, p = idx >> 11, key = (idx >> 4) & 127, ch = idx & 15;
        *(LAS u32x4*)(lds + p * 32768 + key * 256 + ((ch ^ (key & 15)) << 4)) = *(const u32x4*)(SubKl + ((size_t)(h * 2 + p) * 128 + key) * 128 + ch * 8); }
    __syncthreads();
    const int ngroups = nrows >> 5;
    for (int tg = wrank; tg < ngroups; tg += nwr) {
        const int row0 = tg << 5;
        bf16x8 qf[2][8];
        { const bf16_t* qp = PQ + (size_t)(row0 + r32) * 2048 + h * 256 + 8 * hi; asm volatile("" : "+v"(qp));
#pragma unroll
          for (int p = 0; p < 2; ++p)
#pragma unroll
              for (int s = 0; s < 8; ++s) qf[p][s] = *(const bf16x8*)(qp + p * 128 + 16 * s); }
        unsigned top[2][16];
#pragma unroll
        for (int p = 0; p < 2; ++p) {
            f32x16 acc[4];
#pragma unroll
            for (int kt = 0; kt < 4; ++kt) { acc[kt] = f32x16{}; const int key = 32 * kt + r32;
#pragma unroll
                for (int s = 0; s < 8; ++s) acc[kt] = mfma32(*(const LAS bf16x8*)(lds + p * 32768 + key * 256 + (((2 * s + hi) ^ (key & 15)) << 4)), qf[p][s], acc[kt]); }
            unsigned key[64];
#pragma unroll
            for (int kt = 0; kt < 4; ++kt)
#pragma unroll
                for (int r = 0; r < 16; ++r) { const int n = 32 * kt + (r & 3) + 8 * (r >> 2) + 4 * hi; key[16 * kt + r] = fkey(acc[kt][r], 127u - (unsigned)n, 127u); }
            sort16_desc(key); sort16_desc(key + 16); sort16_desc(key + 32); sort16_desc(key + 48);
            merge_top16(key, key + 16); merge_top16(key + 32, key + 48); merge_top16(key, key + 32);
            xlane_top16(key, hi);
#pragma unroll
            for (int i = 0; i < 16; ++i) top[p][i] = key[i];
        }
        float t0f[16], t1f[16];
#pragma unroll
        for (int i = 0; i < 16; ++i) { t0f[i] = keyf(top[0][i], 127u); t1f[i] = keyf(top[1][i], 127u); }
        unsigned ck[50];
#pragma unroll
        for (int c = 0; c < 50; ++c) ck[c] = fkey(t0f[cand_a(c)] + t1f[cand_b(c)], (unsigned)c, 63u);
        if (hi == 0) {
#pragma unroll
            for (int c = 0; c < 50; c += 2) {
                const unsigned ea = (127u - (top[0][cand_a(c)] & 127u)) * 128u + (127u - (top[1][cand_b(c)] & 127u));
                const unsigned eb = (127u - (top[0][cand_a(c + 1)] & 127u)) * 128u + (127u - (top[1][cand_b(c + 1)] & 127u));
                *(LAS unsigned*)(tab + c) = ea | (eb << 16);
            }
        }
        bmerge16_desc(ck + 16); sort16_desc(ck + 32);
        merge_top16(ck, ck + 16); merge_top16(ck, ck + 32);
        ck[15] = fmax_u(ck[15], ck[48]); ck[14] = fmax_u(ck[14], ck[49]); bmerge16_desc(ck);
        asm volatile("s_waitcnt lgkmcnt(0)" ::: "memory");
        const float mx = keyf(ck[0], 63u); float e[16], den = 0.f;
#pragma unroll
        for (int j = 0; j < 16; ++j) { e[j] = __builtin_amdgcn_exp2f((keyf(ck[j], 63u) - mx) * 1.4426950408889634f); den += e[j]; }
        const float iden = 1.f / den;
        if (hi == 0) {
            unsigned o[16];
#pragma unroll
            for (int j = 0; j < 16; ++j) { const unsigned eid = tab[ck[j] & 63u]; o[j] = (eid << 16) | (cvt_pk_bf16(e[j] * iden, 0.f) & 0xffffu); }
            unsigned* dst = EG + (size_t)(row0 + r32) * 128 + h * 16;
#pragma unroll
            for (int j = 0; j < 16; j += 4) *(u32x4*)(dst + j) = (u32x4){o[j], o[j + 1], o[j + 2], o[j + 3]};
        }
        asm volatile("s_waitcnt lgkmcnt(0)" ::: "memory");
    }
}


#define XB_TMO      128
#define XB_XCNT(j)  (256  + 64 * (j))
#define XB_XSUB(j)  (1280 + 64 * (j))
#define XB_XGEN(j)  (2304 + 64 * (j))
#define XB_TOP      3328
#define XB_TOPGEN   3392
#define XCD_BAR_WORDS 3456
#define XB_SPIN_CAP (1u << 18)

__device__ __forceinline__ unsigned xb_ld(unsigned* p)              { return __hip_atomic_load(p, __ATOMIC_RELAXED, __HIP_MEMORY_SCOPE_AGENT); }
__device__ __forceinline__ unsigned xb_add(unsigned* p, unsigned v) { return __hip_atomic_fetch_add(p, v, __ATOMIC_RELAXED, __HIP_MEMORY_SCOPE_AGENT); }
__device__ __forceinline__ unsigned xb_xcc_id() { return (unsigned)__builtin_amdgcn_s_getreg((3 << 11) | 20) & 0xFu; }
#define XB_SPIN(cond, bar) do { unsigned _sp = 0; while (cond) { __builtin_amdgcn_s_sleep(1); \
    if ((++_sp & 255u) == 0u) { if (xb_ld(&(bar)[XB_TMO])) break; if (_sp > XB_SPIN_CAP) { atomicAdd(&(bar)[XB_TMO], 1u); break; } } } } while (0)

struct XcdBarrier {
    unsigned* bar; unsigned x;
    volatile LAS unsigned* st;
};

__device__ __forceinline__ XcdBarrier xcd_barrier_post(unsigned* bar, volatile LAS unsigned* st) {
    XcdBarrier b; b.bar = bar; b.x = xb_xcc_id(); b.st = st;
    if (threadIdx.x == 0) (void)xb_add(&bar[XB_XCNT(b.x)], 1u);
    return b;
}
__device__ __forceinline__ void xcd_barrier_complete(unsigned* bar, unsigned x, unsigned& nloc, unsigned& nx) {
    const unsigned G = gridDim.x * gridDim.y * gridDim.z;
    unsigned sum, cnt, mine, sp = 0u;
    for (;;) {
        sum = 0u; cnt = 0u; mine = 0u;
#pragma unroll
        for (unsigned j = 0; j < 16; ++j) { const unsigned c = xb_ld(&bar[XB_XCNT(j)]); sum += c; cnt += (c > 0u) ? 1u : 0u; mine = (j == x) ? c : mine; }
        if (sum == G) break;
        __builtin_amdgcn_s_sleep(1);
        if ((++sp & 255u) == 0u) { if (xb_ld(&bar[XB_TMO])) break; if (sp > XB_SPIN_CAP) { atomicAdd(&bar[XB_TMO], 1u); break; } }
    }
    nloc = mine > 0u ? mine : 1u; nx = cnt > 0u ? cnt : 1u;
}

__device__ __forceinline__ void xcd_barrier(const XcdBarrier& b) {
    asm volatile("s_waitcnt vmcnt(0)" ::: "memory");
    __syncthreads();
    if (threadIdx.x == 0) {
        unsigned* bar = b.bar;
        __builtin_amdgcn_s_waitcnt(0);
        unsigned nloc = b.st[0], nx = b.st[1];
        if (nloc == 0u) { xcd_barrier_complete(bar, b.x, nloc, nx); b.st[0] = nloc; b.st[1] = nx; }
        const unsigned old = xb_add(&bar[XB_XSUB(b.x)], 1u);
        const unsigned gen = old / nloc;
        if (old + 1u == (gen + 1u) * nloc) {
            __builtin_amdgcn_fence(__ATOMIC_RELEASE, "agent");
            asm volatile("s_waitcnt vmcnt(0)" ::: "memory");
            const unsigned og = xb_add(&bar[XB_TOP], 1u);
            const unsigned tg = og / nx;
            if (og + 1u == (tg + 1u) * nx) xb_add(&bar[XB_TOPGEN], 1u);
            else XB_SPIN(xb_ld(&bar[XB_TOPGEN]) == tg, bar);
            __builtin_amdgcn_fence(__ATOMIC_ACQUIRE, "agent");
            xb_add(&bar[XB_XGEN(b.x)], 1u);
            asm volatile("s_waitcnt vmcnt(0)" ::: "memory");
        } else {
            XB_SPIN(xb_ld(&bar[XB_XGEN(b.x)]) == gen, bar);
            __builtin_amdgcn_fence(__ATOMIC_ACQUIRE, "agent");
            asm volatile("s_waitcnt vmcnt(0)" ::: "memory");
        }
    }
    __syncthreads();
}

__device__ __forceinline__ void phase_mod(LAS unsigned char* lds, const Inputs& in, const WS& w, int vb) {
    if (vb >= 72) return;
    LAS float* sc = (LAS float*)lds;
    int tid_ = threadIdx.x; asm volatile("" : "+v"(tid_));
    const int tid = tid_, idx = vb * 512 + tid, rg = idx / 12288, ln = idx % 12288, l = ln / 6144, n = ln % 6144;
    float acc[11];
#pragma unroll
    for (int i = 0; i < 11; ++i) acc[i] = 0.f;
    const float* wp = in.ada_w + (size_t)l * 1024 * 6144 + n;
    for (int kc = 0; kc < 4; ++kc) {
        for (int i = tid; i < 33 * 256; i += 512) { const int r = i >> 8, k = kc * 256 + (i & 255); const float v = r < 32 ? in.c[(size_t)r * 1024 + k] : in.c_ctx[k]; sc[i] = v / (1.f + __expf(-v)); }
        __syncthreads();
        for (int k = 0; k < 256; ++k) { const float wv = wp[(size_t)(kc * 256 + k) * 6144];
#pragma unroll
            for (int i = 0; i < 11; ++i) acc[i] += sc[(rg * 11 + i) * 256 + k] * wv; }
        __syncthreads();
    }
    const float bias = in.ada_b[(size_t)l * 6144 + n];
#pragma unroll
    for (int i = 0; i < 11; ++i) w.MOD()[((size_t)l * 33 + rg * 11 + i) * 6144 + n] = acc[i] + bias;
}
__device__ __forceinline__ void phase_rope(const WS& w, int vb, int nvb) {
    int tid_ = threadIdx.x; asm volatile("" : "+v"(tid_));
    for (int i = vb * 512 + tid_; i < 2048 * 32; i += nvb * 512) {
        { const int t = i / 32, j = i % 32; const double inv = pow(10000.0, -(double)(j % 16) / 16.0); const double a = (double)(j < 16 ? t / 64 : t % 64) * inv; w.ROPA()[i] = make_float2((float)cos(a), (float)sin(a)); }
        if (i < 2048 * 16) { const int t = i / 16, j = i % 16; const double inv = pow(10000.0, -(double)(j % 8) / 8.0); const double a = (double)(j < 8 ? t / 64 : t % 64) * inv; w.ROPC()[i] = make_float2((float)cos(a), (float)sin(a)); }
    }
}

#ifndef PROBE_MASK
#define PROBE_MASK 0
#endif
#ifndef BENCH_MODE
#define BENCH_MODE 0
#endif
#if BENCH_MODE
__device__ __forceinline__ void phase_bench(float* sink) {
    int tid_ = threadIdx.x; asm volatile("" : "+v"(tid_));
    float x[16];
#pragma unroll
    for (int i = 0; i < 16; ++i) x[i] = (float)(tid_ + i) * 0.001f;
    f32x16 acc[4] = {};
    bf16x8 a = (bf16x8){(short)tid_, 1, 2, 3, 4, 5, 6, 7}, b = (bf16x8){7, 6, 5, 4, 3, 2, 1, (short)tid_};
#pragma nounroll
    for (int it = 0; it < ((BENCH_MODE & 7) ? 2048 : 0); ++it) {
#pragma unroll
        for (int k = 0; k < 8; ++k) {
            if (BENCH_MODE & 2) { acc[k & 3] = mfma32(a, b, acc[k & 3]); }
            __builtin_amdgcn_sched_barrier(0);
            if (BENCH_MODE & 1) { asm volatile("v_exp_f32 %0, -|%0|" : "+v"(x[2 * k])); asm volatile("v_exp_f32 %0, -|%0|" : "+v"(x[2 * k + 1])); }
            if (BENCH_MODE & 4) {
#pragma unroll
                for (int j = 0; j < 8; ++j) asm volatile("v_fma_f32 %0, %0, %0, %0" : "+v"(x[(2 * k + j) & 15]));
            }
            __builtin_amdgcn_sched_barrier(0);
        }
    }
    if (BENCH_MODE & 24) {
        const int lane = tid_ & 63, r32 = lane & 31, hi = lane >> 5;
        unsigned ka[2][4];
#pragma unroll
        for (int kt = 0; kt < 2; ++kt)
#pragma unroll
            for (int s_ = 0; s_ < 4; ++s_) { const int key = 32 * kt + r32; ka[kt][s_] = key * 128 + (((2 * s_ + hi) ^ ((key >> 1) & 7)) << 4); }
        const int vq = (lane & 15) >> 2, vp = lane & 3, vg = (lane >> 4) & 1;
        unsigned va[2];
#pragma unroll
        for (int dvb = 0; dvb < 2; ++dvb) { const int key = 4 * hi + vq; va[dvb] = 8192 + key * 128 + ((((32 * dvb + 16 * vg + 4 * vp) * 2)) ^ (((key >> 1) & 1) << 6)); }
        u32x4 kr[8]; u32x2 vr[16];
#pragma nounroll
        for (int it = 0; it < 2048; ++it) {
            if (BENCH_MODE & 8) {
#pragma unroll
                for (int kt = 0; kt < 2; ++kt)
#pragma unroll
                    for (int s_ = 0; s_ < 4; ++s_) asm volatile("ds_read_b128 %0, %1" : "=v"(kr[kt * 4 + s_]) : "v"(ka[kt][s_]));
            }
            if (BENCH_MODE & 16) {
#pragma unroll
                for (int q = 0; q < 4; ++q)
#pragma unroll
                    for (int dvb = 0; dvb < 2; ++dvb) { asm volatile("ds_read_b64_tr_b16 %0, %1" : "=v"(vr[q * 4 + dvb * 2]) : "v"(va[dvb] + q * 2048)); asm volatile("ds_read_b64_tr_b16 %0, %1 offset:1024" : "=v"(vr[q * 4 + dvb * 2 + 1]) : "v"(va[dvb] + q * 2048)); }
            }
            asm volatile("s_waitcnt lgkmcnt(0)" ::: "memory");
        }
        if (BENCH_MODE & 8) {
#pragma unroll
            for (int i = 0; i < 8; ++i) x[i] += __uint_as_float(kr[i][0] ^ kr[i][1] ^ kr[i][2] ^ kr[i][3]);
        }
        if (BENCH_MODE & 16) {
#pragma unroll
            for (int i = 0; i < 16; ++i) x[i] += __uint_as_float(vr[i][0] ^ vr[i][1]);
        }
    }
    float r = 0.f;
#pragma unroll
    for (int i = 0; i < 16; ++i) r += x[i];
#pragma unroll
    for (int k = 0; k < 4; ++k)
#pragma unroll
        for (int i = 0; i < 16; ++i) r += acc[k][i];
    if (r == 1.2345e30f) sink[tid_] = r;
}
#endif
struct MegaArgs { Inputs in; WS w; float* XL; unsigned* bar; };
constexpr int MEGA_LDS = 131072 + 16;
__global__ void __launch_bounds__(512, 2) k_mega(MegaArgs A) {
    LAS unsigned char* lds = (LAS unsigned char*)dyn_lds;
    const int vb = blockIdx.x, nvb = gridDim.x;
    volatile LAS unsigned* xbw = (volatile LAS unsigned*)(lds + 131072);
    if (threadIdx.x == 0) { xbw[0] = 0u; xbw[1] = 0u; xbw[2] = 0u; xbw[3] = 0u; }
    __syncthreads();
    XcdBarrier bar = xcd_barrier_post(A.bar, xbw);
    if (threadIdx.x == 0) xbw[2] = xb_add(&A.bar[3584 + 64 * bar.x], 1u);
    __syncthreads();
    const int xticket = __builtin_amdgcn_readfirstlane((int)xbw[2]);
    const WS& w = A.w; const Inputs& in = A.in;
    phase_mod(lds, in, w, vb);
    phase_rope(w, vb, nvb);
    phase_cvt(lds, in, w, vb, nvb);
    xcd_barrier(bar);
    phase_modulate<false>(in.x, in.ctx, nullptr, w.H(), in.norm1_g, w.MOD(), 0, NR, vb, nvb);
    xcd_barrier(bar);
#if (PROBE_MASK >> 0) & 1
    phase_mod(lds, in, w, vb);
    phase_rope(w, vb, nvb);
    phase_cvt(lds, in, w, vb, nvb);
    xcd_barrier(bar);
    phase_modulate<false>(in.x, in.ctx, nullptr, w.H(), in.norm1_g, w.MOD(), 0, NR, vb, nvb);
    xcd_barrier(bar);
#endif
#if BENCH_MODE
    phase_bench((float*)w.RSQ());
#endif
    int xpart = vb & 7, xrank = vb >> 3;
    { bool okx = (bar.x < 8u); for (unsigned j = 0; j < 8; ++j) okx = okx && (xb_ld(&A.bar[XB_XCNT(j)]) == (unsigned)(nvb >> 3));
      if (okx) { xpart = (int)bar.x; xrank = xticket; } }
    for (int l = 0; l < DEPTH; ++l) {
        const float* MODl = w.MOD() + (size_t)l * 33 * 6144;
        const bool last = (l == DEPTH - 1);
        const int MR = last ? NL : NR;
        phase_p1(lds, w, in, l, vb, nvb); xcd_barrier(bar);
#if (PROBE_MASK >> 1) & 1
        phase_p1(lds, w, in, l, vb, nvb); xcd_barrier(bar);
#endif
        phase_p2(lds, w, in, l, vb, nvb); xcd_barrier(bar);
#if (PROBE_MASK >> 12) & 7
        phase_p2(lds, w, in, l, vb, nvb, (PROBE_MASK >> 12) & 7); xcd_barrier(bar);
#endif
        phase_p3(lds, w, l, vb, nvb, xpart, xrank); xcd_barrier(bar);
#if (PROBE_MASK >> 3) & 1
        phase_p3(lds, w, l, vb, nvb, xpart, xrank); xcd_barrier(bar);
#endif
        phase_p4(lds, w, in, l, vb, nvb);
        xcd_barrier(bar);
#if (PROBE_MASK >> 4) & 1
        phase_p4(lds, w, in, l, vb, nvb);
        xcd_barrier(bar);
#endif
        if (l == 0) phase_modulate<false>(in.x, in.ctx, nullptr, w.H(), in.norm2_g + l * 1024, MODl, 3, MR, vb, nvb, w.H8(), w.HS(), w.PQ(), w.XB());
        else phase_modulate<true>(nullptr, nullptr, w.XB(), w.H(), in.norm2_g + l * 1024, MODl, 3, MR, vb, nvb, w.H8(), w.HS(), w.PQ(), w.XB());
        xcd_barrier(bar);
#if (PROBE_MASK >> 5) & 1
        phase_modulate<true>(nullptr, nullptr, w.XB(), w.H(), in.norm2_g + l * 1024, MODl, 3, MR, vb, nvb, w.H8(), w.HS()); xcd_barrier(bar);
#endif
        phase_p6a(lds, w, l, vb, nvb); xcd_barrier(bar);
#if (PROBE_MASK >> 6) & 1
        phase_p6a(lds, w, l, vb, nvb); xcd_barrier(bar);
#endif
        phase_p6b(lds, w.PQ(), w.SubK() + (size_t)l * 16 * 128 * 128, w.EG(), MR, vb, nvb); xcd_barrier(bar);
#if (PROBE_MASK >> 7) & 1
        phase_p6b(lds, w.PQ(), w.SubK() + (size_t)l * 16 * 128 * 128, w.EG(), MR, vb, nvb); xcd_barrier(bar);
#endif
        { P7CArgs a{w.H8(), w.EG(), w.U8() + (size_t)l * NE * 512, (int*)w.PQ(), MR}; phase_p7c(lds, a, xpart, xrank, nvb); }
        xcd_barrier(bar);
#if (PROBE_MASK >> 8) & 1
        { P7CArgs a{w.H8(), w.EG(), w.U8() + (size_t)l * NE * 512, (int*)w.PQ(), MR}; phase_p7c(lds, a, xpart, xrank, nvb); }
        xcd_barrier(bar);
#endif
        phase_p7d((const int*)w.PQ(), w.EG(), w.US() + (size_t)l * NE, w.VS() + (size_t)l * NE, w.HS(), w.WE(), MR, vb, nvb);
        xcd_barrier(bar);
#if (PROBE_MASK >> 9) & 1
        phase_p7d((const int*)w.PQ(), w.EG(), w.US() + (size_t)l * NE, w.VS() + (size_t)l * NE, w.HS(), w.WE(), MR, vb, nvb);
        xcd_barrier(bar);
#endif
        { P7BArgs a{w.WE(), w.V8() + (size_t)l * NE * 512, w.XB(), MODl + 5 * 1024, MR}; phase_p7b<0>(lds, a, xpart, xrank, nvb); }
        xcd_barrier(bar);
#if (PROBE_MASK >> 10) & 3
        { P7BArgs a{w.WE(), w.V8() + (size_t)l * NE * 512, w.XB(), MODl + 5 * 1024, MR}; phase_p7b<((PROBE_MASK >> 10) & 3)>(lds, a, xpart, xrank, nvb); }
        xcd_barrier(bar);
#endif
        if (last) phase_final_norm(w.XB(), A.XL, in.final_g, vb, nvb);
        else phase_modulate<true>(nullptr, nullptr, w.XB(), w.H(), in.norm1_g + (l + 1) * 1024, w.MOD() + (size_t)(l + 1) * 33 * 6144, 0, NR, vb, nvb);
        if (!last) xcd_barrier(bar);
    }
}

extern "C" void kernel_launch(void* const* d_in, const int* in_sizes, int n_in, void* d_out, int out_size, void* d_ws, size_t ws_size, hipStream_t stream) {
    const float* const* fin = (const float* const*)d_in;
    Inputs in{fin[0], fin[1], fin[2], fin[3], fin[4], fin[5], fin[6], fin[7], fin[8], fin[9], fin[10], fin[11], fin[12], fin[13], fin[14], fin[15], fin[16], fin[17], fin[18], fin[19], fin[20], fin[21], fin[22]};
    WS w = make_ws(d_ws);
    static int ok = 0;
    if (!ok) {
        if (hipFuncSetAttribute((const void*)k_mega, hipFuncAttributeMaxDynamicSharedMemorySize, MEGA_LDS) != hipSuccess) { ok = -1; }
        int per_cu = 0, cus = 0, dev = 0; (void)hipGetDevice(&dev); (void)hipDeviceGetAttribute(&cus, hipDeviceAttributeMultiprocessorCount, dev);
        if (hipOccupancyMaxActiveBlocksPerMultiprocessor(&per_cu, (const void*)k_mega, 512, MEGA_LDS) != hipSuccess || per_cu < 1 || cus < 256) ok = -1;
        if (ok == 0) ok = 1;
    }
    if (ok < 0) return;
    (void)hipMemsetAsync(d_ws, 0, 16384, stream);
    MegaArgs A{in, w, (float*)d_out, (unsigned*)d_ws};
    k_mega<<<256, 512, MEGA_LDS, stream>>>(A);
}
```

```cpp
#include <hip/hip_runtime.h>
#include <stdint.h>

typedef unsigned short bf16_t;

constexpr int D = 1024, NB = 32, S = 2048, CTX = 256, DEPTH = 2;
constexpr int NL = NB * S, NC = NB * CTX, NR = NL + NC;
constexpr int KEYS = CTX + S;
constexpr int INC = 1568;
constexpr int NE = 16384;
constexpr float EPS = 1e-6f;

__device__ __forceinline__ float bf2f(bf16_t v) { return __uint_as_float(((unsigned)v) << 16); }
__device__ __forceinline__ bf16_t f2bf(float f) { unsigned u = __float_as_uint(f); u += 0x7FFFu + ((u >> 16) & 1u); return (bf16_t)(u >> 16); }

__device__ __forceinline__ float wave_sum(float v) {
#pragma unroll
    for (int o = 32; o > 0; o >>= 1) v += __shfl_xor(v, o);
    return v;
}
__device__ __forceinline__ float gelu_tanh(float x) {
    const float u = 0.7978845608028654f * (x + 0.044715f * x * x * x);
    return 0.5f * x * (1.f + tanhf(u));
}

struct WS {
    char* base;
    __host__ __device__ __forceinline__ bf16_t* H() const { return (bf16_t*)(base + 65536ull); }
    __host__ __device__ __forceinline__ bf16_t* Qg() const { return (bf16_t*)(base + 151060480ull); }
    __host__ __device__ __forceinline__ bf16_t* Qgc() const { return (bf16_t*)(base + 201392128ull); }
    __host__ __device__ __forceinline__ bf16_t* Kg() const { return (bf16_t*)(base + 207683584ull); }
    __host__ __device__ __forceinline__ bf16_t* Vg() const { return (bf16_t*)(base + 226557952ull); }
    __host__ __device__ __forceinline__ bf16_t* CQ() const { return (bf16_t*)(base + 245432320ull); }
    __host__ __device__ __forceinline__ bf16_t* CKV() const { return (bf16_t*)(base + 302055424ull); }
    __host__ __device__ __forceinline__ bf16_t* Bp() const { return (bf16_t*)(base + 339804160ull); }
    __host__ __device__ __forceinline__ bf16_t* KR() const { return (bf16_t*)(base + 377552896ull); }
    __host__ __device__ __forceinline__ bf16_t* Qm() const { return (bf16_t*)(base + 382271488ull); }
    __host__ __device__ __forceinline__ bf16_t* Qmc() const { return (bf16_t*)(base + 457768960ull); }
    __host__ __device__ __forceinline__ bf16_t* Kmn() const { return (bf16_t*)(base + 467206144ull); }
    __host__ __device__ __forceinline__ bf16_t* Vm() const { return (bf16_t*)(base + 523829248ull); }
    __host__ __device__ __forceinline__ unsigned* EG() const { return (unsigned*)(base + 580452352ull); }
    __host__ __device__ __forceinline__ bf16_t* P() const { return (bf16_t*)(base + 382271488ull); }
    __host__ __device__ __forceinline__ bf16_t* PQ() const { return (bf16_t*)(base + 151060480ull); }
    __host__ __device__ __forceinline__ bf16_t* TMP() const { return (bf16_t*)(base + 65536ull); }
    __host__ __device__ __forceinline__ float* XC() const { return (float*)(base + 618201088ull); }
    __host__ __device__ __forceinline__ float* MOD() const { return (float*)(base + 651755520ull); }
    __host__ __device__ __forceinline__ float2* ROPA() const { return (float2*)(base + 653377536ull); }
    __host__ __device__ __forceinline__ float2* ROPC() const { return (float2*)(base + 653901824ull); }
    __host__ __device__ __forceinline__ float* RSQ() const { return (float*)(base + 654163968ull); }
    __host__ __device__ __forceinline__ float* RSKV() const { return (float*)(base + 654458880ull); }
    __host__ __device__ __forceinline__ bf16_t* WinT() const { return (bf16_t*)(base + 654753792ull); }
    __host__ __device__ __forceinline__ bf16_t* WuqT() const { return (bf16_t*)(base + 662093824ull); }
    __host__ __device__ __forceinline__ bf16_t* WukvT() const { return (bf16_t*)(base + 663273472ull); }
    __host__ __device__ __forceinline__ bf16_t* WoutT() const { return (bf16_t*)(base + 664059904ull); }
    __host__ __device__ __forceinline__ bf16_t* WqT() const { return (bf16_t*)(base + 668254208ull); }
    __host__ __device__ __forceinline__ bf16_t* SubK() const { return (bf16_t*)(base + 676642816ull); }
    __host__ __device__ __forceinline__ unsigned char* U8() const { return (unsigned char*)(base + 677691392ull); }
    __host__ __device__ __forceinline__ unsigned char* V8() const { return (unsigned char*)(base + 711245824ull); }
    __host__ __device__ __forceinline__ float* US() const { return (float*)(base + 744800256ull); }
    __host__ __device__ __forceinline__ float* VS() const { return (float*)(base + 744931328ull); }
    __host__ __device__ __forceinline__ float* SSQ() const { return (float*)(base + 745062400ull); }
    __host__ __device__ __forceinline__ float* SSKV() const { return (float*)(base + 747421696ull); }
    __host__ __device__ __forceinline__ unsigned* WE() const { return (unsigned*)(base + 748601344ull); }
    __host__ __device__ __forceinline__ signed char* H8() const { return (signed char*)(base + 786350080ull); }
    __host__ __device__ __forceinline__ float* HS() const { return (float*)(base + 861847552ull); }
    __host__ __device__ __forceinline__ bf16_t* PoolWT() const { return (bf16_t*)(base + 862142464ull); }
    __host__ __device__ __forceinline__ bf16_t* XB() const { return (bf16_t*)(base + 862208000ull); }
};
constexpr size_t WS_BYTES = 862208000ull + (size_t)NR * 1024 * 2;
static WS make_ws(void* d_ws) { WS w; w.base = (char*)d_ws; return w; }


#define LAS __attribute__((address_space(3)))
typedef short bf16x8 __attribute__((ext_vector_type(8)));
typedef float f32x4 __attribute__((ext_vector_type(4)));
typedef float f32x16 __attribute__((ext_vector_type(16)));
typedef unsigned u32x4 __attribute__((ext_vector_type(4)));
typedef unsigned u32x2 __attribute__((ext_vector_type(2)));

__device__ __forceinline__ f32x16 mfma32(bf16x8 a, bf16x8 b, f32x16 c) { return __builtin_amdgcn_mfma_f32_32x32x16_bf16(a, b, c, 0, 0, 0); }
__device__ __forceinline__ unsigned cvt_pk_bf16(float lo, float hi) { unsigned r; asm volatile("v_cvt_pk_bf16_f32 %0, %1, %2" : "=v"(r) : "v"(lo), "v"(hi)); return r; }

namespace pg8 {
constexpr int BM = 256, BK = 64, HALF = 128, HTB = HALF * BK * 2, STAGE_BYTES = 8 * HTB, NXCD = 8, WGM = 8;
__host__ __device__ __forceinline__ int lds_byte(int r, int c) { const int st = (r >> 4) * 2 + (c >> 5), rr = r & 15, cc = c & 31, ob = rr * 64 + cc * 2; return st * 1024 + (ob ^ (((ob >> 9) & 1) << 5)); }
__host__ __device__ __forceinline__ void stage_rc(int b, int& R, int& C) { const int st = b / 1024, sb = b % 1024, swz = sb ^ (((sb >> 9) & 1) << 5); R = (st >> 1) * 16 + swz / 64; C = (st & 1) * 32 + (swz % 64) / 2; }
__host__ __device__ __forceinline__ int perm32(int rho) { const int n = rho >> 4, i = rho & 15; return 8 * (i >> 2) + 4 * n + (i & 3); }
struct Unit { int pm, pn; };
struct Gemm { const bf16_t* A; const bf16_t* Bt; int M, N, K; };
struct StaticOrder {
    int nM, nN, nwg, G, c;
    __host__ __device__ void init(int M, int N, int G_, int c_) { nM = M / BM; nN = N / BM; nwg = nM * nN; G = G_; c = c_; }
    __host__ __device__ bool next(int i, Unit& u) const {
        const long L = (long)i * G + c; if (L >= nwg) return false;
        int wgid = (int)L; { const int q = nwg / NXCD, r = nwg % NXCD, xcd = wgid % NXCD, off = wgid / NXCD; wgid = (xcd < r ? xcd * (q + 1) : r * (q + 1) + (xcd - r) * q) + off; }
        const int nig = WGM * nN, gid = wgid / nig, fm = gid * WGM, gsz = (nM - fm) < WGM ? (nM - fm) : WGM;
        u.pm = fm + ((wgid % nig) % gsz); u.pn = (wgid % nig) / gsz; return true;
    }
};
template <class Epi, class Sched>
__device__ __forceinline__ void gemm_phase(LAS unsigned char* lds, const Gemm g, const Sched& S, const Epi& E) {
    int tid_ = threadIdx.x; asm volatile("" : "+v"(tid_));
    const int tid = tid_, wid = __builtin_amdgcn_readfirstlane(tid >> 6), lane = tid & 63, wr = wid >> 2, wc = wid & 3, fr = lane & 15, fq = lane >> 4;
    const int K = g.K, nt = K / BK;
    unsigned voffA[2], voffB[2];
#pragma unroll
    for (int i = 0; i < 2; ++i) { int R, C; stage_rc(tid * 16 + i * 8192, R, C); const int Rb = Epi::PERM ? ((R & ~31) + perm32(R & 31)) : R;
        voffA[i] = (unsigned)(R * K + C) * 2u; voffB[i] = (unsigned)(Rb * K + C) * 2u; }
    const size_t kstep = (size_t)(BK * 2);
    const size_t hstep = (size_t)HALF * K * 2;
    const size_t tstep = 2 * hstep;
    const unsigned ldsw = (unsigned)wid * 1024u;
    const int aoff = lds_byte(wr * 64 + fr, fq * 8), boff = lds_byte(wc * 32 + fr, fq * 8);
#define PG8_SA(b, h) (((b) * 2 + (h)) * HTB)
#define PG8_SB(b, h) ((4 + (b) * 2 + (h)) * HTB)
#define PG8_STAGE(bufoff, gbase, voff) do { _Pragma("unroll") for (int _i = 0; _i < 2; ++_i) \
        __builtin_amdgcn_global_load_lds((const unsigned*)((const char*)(gbase) + (voff)[_i]), (LAS unsigned*)(lds + (bufoff) + ldsw + _i * 8192), 16, 0, 0); } while (0)
#define PG8_LDA(dst, b, h) do { _Pragma("unroll") for (int m = 0; m < 4; ++m) _Pragma("unroll") for (int k = 0; k < 2; ++k) dst[m][k] = *(const LAS bf16x8*)(lds + PG8_SA(b, h) + aoff + m * 2048 + k * 1024); } while (0)
#define PG8_LDB(dst, b, h) do { _Pragma("unroll") for (int n = 0; n < 2; ++n) _Pragma("unroll") for (int k = 0; k < 2; ++k) dst[n][k] = *(const LAS bf16x8*)(lds + PG8_SB(b, h) + boff + n * 2048 + k * 1024); } while (0)
#define PG8_MMA(ai, bj, At, Bt) do { __builtin_amdgcn_s_setprio(1); _Pragma("unroll") for (int m = 0; m < 4; ++m) _Pragma("unroll") for (int n = 0; n < 2; ++n) _Pragma("unroll") for (int k = 0; k < 2; ++k) \
        acc[ai][bj][m][n] = __builtin_amdgcn_mfma_f32_16x16x32_bf16(Bt[n][k], At[m][k], acc[ai][bj][m][n], 0, 0, 0); __builtin_amdgcn_s_setprio(0); } while (0)
#define PG8_WAIT_V(n) asm volatile("s_waitcnt vmcnt(" #n ")" ::: "memory")
#define PG8_WAIT_L(n) asm volatile("s_waitcnt lgkmcnt(" #n ")" ::: "memory")
#define PG8_BAR __builtin_amdgcn_s_barrier()
#define PG8_SCHED __builtin_amdgcn_sched_barrier(0)
    Unit cur, nxt; int ui = 0;
    if (!S.next(0, cur)) return;
    f32x4 acc[2][2][4][2];
#pragma unroll
    for (int a = 0; a < 2; ++a)
#pragma unroll
        for (int b = 0; b < 2; ++b)
#pragma unroll
            for (int m = 0; m < 4; ++m)
#pragma unroll
                for (int n = 0; n < 2; ++n) acc[a][b][m][n] = (f32x4){0.f, 0.f, 0.f, 0.f};
    bf16x8 At[4][2], B0[2][2], B1[2][2];
    const char* cA = (const char*)g.A + (size_t)cur.pm * tstep; const char* cB = (const char*)g.Bt + (size_t)cur.pn * tstep;
    PG8_STAGE(PG8_SB(0, 0), cB, voffB); PG8_STAGE(PG8_SA(0, 0), cA, voffA); PG8_STAGE(PG8_SB(0, 1), cB + hstep, voffB); PG8_STAGE(PG8_SA(0, 1), cA + hstep, voffA);
    if (wr == 1) PG8_BAR;
    PG8_WAIT_V(4); PG8_BAR;
    PG8_STAGE(PG8_SB(1, 0), cB + kstep, voffB); PG8_STAGE(PG8_SA(1, 0), cA + kstep, voffA); PG8_STAGE(PG8_SB(1, 1), cB + hstep + kstep, voffB);
    PG8_WAIT_V(6); PG8_BAR;
    for (;;) {
        const bool has_next = S.next(ui + 1, nxt);
        const char* nA = has_next ? (const char*)g.A + (size_t)nxt.pm * tstep : cA; const char* nB = has_next ? (const char*)g.Bt + (size_t)nxt.pn * tstep : cB;
#pragma nounroll
        for (int t = 0; t < nt; t += 2) {
            const bool last = (t == nt - 2);
            const char* a1 = cA + (size_t)(t + 1) * kstep;
            const char* a2 = last ? nA : cA + (size_t)(t + 2) * kstep; const char* b2 = last ? nB : cB + (size_t)(t + 2) * kstep;
            const char* a3 = a2 + kstep; const char* b3 = b2 + kstep;
            PG8_LDB(B0, 0, 0); PG8_SCHED; PG8_LDA(At, 0, 0); PG8_STAGE(PG8_SA(1, 1), a1 + hstep, voffA);
            PG8_WAIT_L(8); PG8_BAR; PG8_WAIT_L(0); PG8_MMA(0, 0, At, B0); PG8_BAR; PG8_SCHED;
            PG8_LDB(B1, 0, 1); PG8_STAGE(PG8_SB(0, 0), b2, voffB);
            PG8_BAR; PG8_WAIT_L(0); PG8_MMA(0, 1, At, B1); PG8_BAR;
            PG8_LDA(At, 0, 1); PG8_STAGE(PG8_SA(0, 0), a2, voffA);
            PG8_BAR; PG8_WAIT_L(0); PG8_MMA(1, 0, At, B0); PG8_BAR; PG8_SCHED;
            PG8_STAGE(PG8_SB(0, 1), b2 + hstep, voffB);
            PG8_WAIT_V(6); PG8_BAR; PG8_MMA(1, 1, At, B1); PG8_BAR;
            PG8_LDB(B0, 1, 0); PG8_SCHED; PG8_LDA(At, 1, 0); PG8_STAGE(PG8_SA(0, 1), a2 + hstep, voffA);
            PG8_WAIT_L(8); PG8_BAR; PG8_WAIT_L(0); PG8_MMA(0, 0, At, B0); PG8_BAR; PG8_SCHED;
            PG8_LDB(B1, 1, 1); PG8_STAGE(PG8_SB(1, 0), b3, voffB);
            PG8_BAR; PG8_WAIT_L(0); PG8_MMA(0, 1, At, B1); PG8_BAR;
            PG8_LDA(At, 1, 1); PG8_STAGE(PG8_SA(1, 0), a3, voffA);
            PG8_BAR; PG8_WAIT_L(0); PG8_MMA(1, 0, At, B0); PG8_BAR; PG8_SCHED;
            PG8_STAGE(PG8_SB(1, 1), b3 + hstep, voffB);
            PG8_WAIT_V(6); PG8_BAR; PG8_MMA(1, 1, At, B1); PG8_BAR;
        }
        E(acc, cur, wr, wc, fr, fq);
        if (!has_next) break;
#pragma unroll
        for (int a = 0; a < 2; ++a)
#pragma unroll
            for (int b = 0; b < 2; ++b)
#pragma unroll
                for (int m = 0; m < 4; ++m)
#pragma unroll
                    for (int n = 0; n < 2; ++n) acc[a][b][m][n] = (f32x4){0.f, 0.f, 0.f, 0.f};
        cur = nxt; cA = nA; cB = nB; ++ui;
    }
    PG8_WAIT_V(0);
    if (wr == 0) PG8_BAR;
    PG8_BAR;
#undef PG8_SA
#undef PG8_SB
#undef PG8_STAGE
#undef PG8_LDA
#undef PG8_LDB
#undef PG8_MMA
#undef PG8_WAIT_V
#undef PG8_WAIT_L
#undef PG8_BAR
#undef PG8_SCHED
}
}

enum { GT_AQ = 0, GT_AK = 1, GT_AV = 2, GT_B = 3, GT_CQ = 4, GT_CKV = 5, GT_KR = 6, GT_PAD = 7 };
__host__ __device__ __forceinline__ void in_group(int g, int& type, int& sub) {
    if (g < 2) { type = GT_AK; sub = g; } else if (g < 4) { type = GT_AV; sub = g - 2; } else if (g < 8) { type = GT_CKV; sub = g - 4; }
    else if (g == 8) { type = GT_KR; sub = 0; } else if (g < 12) { type = GT_PAD; sub = 0; } else if (g < 18) { type = GT_AQ; sub = g - 12; }
    else if (g < 24) { type = GT_CQ; sub = g - 18; } else { type = GT_B; sub = g - 24; }
}
__device__ __forceinline__ int colmap(int mode, int r) {
    const int pn = r >> 8, ct = r & 255, bj = ct >> 7, wc = (ct >> 5) & 3, j = ct & 31, g = 4 * pn + wc, e = 32 * bj + j;
    if (mode == 0) {
        int type, sub; in_group(g, type, sub);
        switch (type) { case GT_AQ: return 64 * sub + e; case GT_AK: return 384 + 64 * sub + e; case GT_AV: return 512 + 64 * sub + e; case GT_B: return 640 + 64 * sub + e;
            case GT_CQ: return 896 + 64 * sub + e; case GT_CKV: return 1280 + 64 * sub + e; case GT_KR: return (j < 16) ? 1536 + 16 * bj + j : -1; default: return -1; }
    } else if (mode == 1) {
        if (g < 6) return 96 * g + e; if (g < 9) { const int head = 2 * (g - 6) + (j >> 4); return 96 * head + 64 + 16 * bj + (j & 15); } return -1;
    } else if (mode == 2) {
        return 64 * g + e;
    }
    return r;
}
__device__ __forceinline__ void cvt_weights_unit(LAS float* tile  , const float* __restrict__ W, int K, int N, bf16_t* __restrict__ dst, int mode, const float* __restrict__ kgain, int r0, int k0) {
    int tid_ = threadIdx.x; asm volatile("" : "+v"(tid_));
    const int tid = tid_;
    const int jj = tid & 63; const int sc = colmap(mode, r0 + jj);
#pragma unroll
    for (int i = 0; i < 8; ++i) { const int kk = (tid >> 6) + 8 * i; float v = 0.f; if (sc >= 0) v = W[(size_t)(k0 + kk) * N + sc]; if (kgain) v *= kgain[k0 + kk]; tile[kk * 65 + jj] = v; }
    __syncthreads();
#pragma unroll
    for (int i = 0; i < 8; ++i) { const int rr = (tid >> 6) + 8 * i, kk = tid & 63; dst[(size_t)(r0 + rr) * K + k0 + kk] = f2bf(tile[kk * 65 + rr]); }
    __syncthreads();
}
struct CvtJob { const float* W; bf16_t* dst; const float* kgain; int K, N, Npad, mode; };
__device__ __forceinline__ void cvt_job(LAS float* tile, const CvtJob j, int vb, int nvb) {
    const int nk = j.K / 64, nr = j.Npad / 64;
    for (int u = vb; u < nk * nr; u += nvb) cvt_weights_unit(tile, j.W, j.K, j.N, j.dst, j.mode, j.kgain, (u / nk) * 64, (u % nk) * 64);
}
__device__ __forceinline__ void cvt_flat(const float* __restrict__ src, bf16_t* __restrict__ dst, size_t n, int vb, int nvb) {
    int tid_ = threadIdx.x; asm volatile("" : "+v"(tid_));
    for (size_t i = ((size_t)vb * 512 + tid_) * 8; i < n; i += (size_t)nvb * 512 * 8) {
        const float4 a = *(const float4*)(src + i), b = *(const float4*)(src + i + 4);
        u32x4 o; o.x = cvt_pk_bf16(a.x, a.y); o.y = cvt_pk_bf16(a.z, a.w); o.z = cvt_pk_bf16(b.x, b.y); o.w = cvt_pk_bf16(b.z, b.w);
        *(u32x4*)(dst + i) = o;
    }
}
template <bool FP8>
__device__ __forceinline__ void cvt_q8_rows(const float* __restrict__ src, unsigned char* __restrict__ dst, float* __restrict__ scales, int nrows, int vb, int nvb) {
    int tid_ = threadIdx.x; asm volatile("" : "+v"(tid_));
    const int lane = tid_ & 63, wid = tid_ >> 6;
    const int stride = nvb * 8;
    for (int row0 = vb * 8 + wid; row0 < nrows; row0 += 4 * stride) {
        f32x4 v[4][4];
#pragma unroll
        for (int q = 0; q < 4; ++q) { const int row = row0 + q * stride < nrows ? row0 + q * stride : row0; const float* sp = src + (size_t)row * 1024 + 16 * lane;
#pragma unroll
            for (int k = 0; k < 4; ++k) v[q][k] = *(const f32x4*)(sp + 4 * k); }
#pragma unroll
        for (int q = 0; q < 4; ++q) { const int row = row0 + q * stride; if (row < nrows) {
            float am = 0.f;
#pragma unroll
            for (int k = 0; k < 4; ++k) am = fmaxf(am, fmaxf(fmaxf(fabsf(v[q][k][0]), fabsf(v[q][k][1])), fmaxf(fabsf(v[q][k][2]), fabsf(v[q][k][3]))));
#pragma unroll
            for (int o = 32; o > 0; o >>= 1) am = fmaxf(am, __shfl_xor(am, o));
            const float qmax = FP8 ? 416.f : 127.f;
            const float sc = am > 0.f ? am / qmax : 1.f, inv = am > 0.f ? qmax / am : 0.f;
            u32x4 o4;
#pragma unroll
            for (int k = 0; k < 4; ++k) {
                if (FP8) { int p = __builtin_amdgcn_cvt_pk_fp8_f32(v[q][k][0] * inv, v[q][k][1] * inv, 0, false); p = __builtin_amdgcn_cvt_pk_fp8_f32(v[q][k][2] * inv, v[q][k][3] * inv, p, true); o4[k] = (unsigned)p; }
                else { const int q0 = (int)rintf(v[q][k][0] * inv), q1 = (int)rintf(v[q][k][1] * inv), q2 = (int)rintf(v[q][k][2] * inv), q3 = (int)rintf(v[q][k][3] * inv);
                    o4[k] = (unsigned)(q0 & 0xff) | ((unsigned)(q1 & 0xff) << 8) | ((unsigned)(q2 & 0xff) << 16) | ((unsigned)(q3 & 0xff) << 24); } }
            *(u32x4*)(dst + (size_t)row * 1024 + 16 * lane) = o4;
            if (lane == 0) scales[row] = sc; } }
    }
}
template <bool OFFS>
__device__ __forceinline__ void cvt_q4_rows(const float* __restrict__ src, unsigned char* __restrict__ dst, float* __restrict__ scales, int nrows, int vb, int nvb) {
    int tid_ = threadIdx.x; asm volatile("" : "+v"(tid_));
    const int lane = tid_ & 63, wid = tid_ >> 6;
    const int stride = nvb * 8;
    for (int row0 = vb * 8 + wid; row0 < nrows; row0 += 4 * stride) {
        f32x4 v[4][4];
#pragma unroll
        for (int q = 0; q < 4; ++q) { const int row = row0 + q * stride < nrows ? row0 + q * stride : row0; const float* sp = src + (size_t)row * 1024 + 16 * lane;
#pragma unroll
            for (int k = 0; k < 4; ++k) v[q][k] = *(const f32x4*)(sp + 4 * k); }
#pragma unroll
        for (int q = 0; q < 4; ++q) { const int row = row0 + q * stride; if (row < nrows) {
            float am = 0.f, ss = 0.f;
#pragma unroll
            for (int k = 0; k < 4; ++k) { am = fmaxf(am, fmaxf(fmaxf(fabsf(v[q][k][0]), fabsf(v[q][k][1])), fmaxf(fabsf(v[q][k][2]), fabsf(v[q][k][3]))));
                ss += v[q][k][0] * v[q][k][0] + v[q][k][1] * v[q][k][1] + v[q][k][2] * v[q][k][2] + v[q][k][3] * v[q][k][3]; }
#pragma unroll
            for (int o = 32; o > 0; o >>= 1) { am = fmaxf(am, __shfl_xor(am, o)); ss += __shfl_xor(ss, o); }
            const float st = fmaxf(0.36f * sqrtf(ss * (1.f / 1024.f)), am * (1.f / 12.f));
            const float sc = st > 0.f ? st : 1.f, inv = st > 0.f ? 1.f / st : 0.f;
            u32x2 o2;
#pragma unroll
            for (int d = 0; d < 2; ++d) { unsigned wd = 0u;
#pragma unroll
                for (int k = 0; k < 4; ++k) { const int qa = (int)fminf(fmaxf(rintf(v[q][2 * d][k] * inv), -7.f), 7.f), qb = (int)fminf(fmaxf(rintf(v[q][2 * d + 1][k] * inv), -7.f), 7.f); wd |= ((unsigned)((qa + (OFFS ? 8 : 0)) & 15) << (8 * k)) | ((unsigned)((qb + (OFFS ? 8 : 0)) & 15) << (8 * k + 4)); }
                o2[d] = wd; }
            *(u32x2*)(dst + (size_t)row * 512 + 8 * lane) = o2;
            if (lane == 0) scales[row] = OFFS ? sc * 512.f : sc; } }
    }
}
__device__ __forceinline__ unsigned fp4_code(float x, float inv) {
    const float a = fabsf(x) * inv;
    unsigned c = a < 0.25f ? 0u : a < 0.75f ? 1u : a < 1.25f ? 2u : a < 1.75f ? 3u : a < 2.5f ? 4u : a < 3.5f ? 5u : a < 5.f ? 6u : 7u;
    return c | (x < 0.f ? 8u : 0u);
}
__device__ __forceinline__ void cvt_fp4_rows(const float* __restrict__ src, unsigned char* __restrict__ dst, float* __restrict__ scales, int nrows, int vb, int nvb) {
    int tid_ = threadIdx.x; asm volatile("" : "+v"(tid_));
    const int lane = tid_ & 63, wid = tid_ >> 6;
    const int stride = nvb * 8;
    for (int row0 = vb * 8 + wid; row0 < nrows; row0 += 4 * stride) {
        f32x4 v[4][4];
#pragma unroll
        for (int q = 0; q < 4; ++q) { const int row = row0 + q * stride < nrows ? row0 + q * stride : row0; const float* sp = src + (size_t)row * 1024 + 16 * lane;
#pragma unroll
            for (int k = 0; k < 4; ++k) v[q][k] = *(const f32x4*)(sp + 4 * k); }
#pragma unroll
        for (int q = 0; q < 4; ++q) { const int row = row0 + q * stride; if (row < nrows) {
            float am = 0.f, ss = 0.f;
#pragma unroll
            for (int k = 0; k < 4; ++k) { am = fmaxf(am, fmaxf(fmaxf(fabsf(v[q][k][0]), fabsf(v[q][k][1])), fmaxf(fabsf(v[q][k][2]), fabsf(v[q][k][3]))));
                ss += v[q][k][0] * v[q][k][0] + v[q][k][1] * v[q][k][1] + v[q][k][2] * v[q][k][2] + v[q][k][3] * v[q][k][3]; }
#pragma unroll
            for (int o = 32; o > 0; o >>= 1) { am = fmaxf(am, __shfl_xor(am, o)); ss += __shfl_xor(ss, o); }
            const float st = fmaxf(0.5f * sqrtf(ss * (1.f / 1024.f)), am * (1.f / 12.f));
            const float sc = st > 0.f ? st : 1.f, inv = st > 0.f ? 1.f / st : 0.f;
            u32x2 o2;
#pragma unroll
            for (int d = 0; d < 2; ++d) { unsigned wd = 0u;
#pragma unroll
                for (int i = 0; i < 8; ++i) wd |= fp4_code(v[q][2 * d + (i >> 2)][i & 3], inv) << (4 * i);
                o2[d] = wd; }
            *(u32x2*)(dst + (size_t)row * 512 + 8 * lane) = o2;
            if (lane == 0) scales[row] = sc; } }
    }
}
struct Inputs {
    const float *x, *c, *ctx, *c_ctx, *ada_w, *ada_b, *norm1_g, *norm2_g, *w_in, *gqa_qn_g, *gqa_kn_g, *pool_w, *pool_scale, *mla_qn_g, *mla_kvn_g, *mla_w_uq, *mla_w_ukv, *w_out, *peer_wq, *peer_subkeys, *peer_u, *peer_v, *final_g;
};
__device__ __forceinline__ void phase_cvt(LAS unsigned char* lds, const Inputs& in, const WS& w, int vb, int nvb) {
    LAS float* tile = (LAS float*)lds;
    for (int l = 0; l < 2; ++l) {
        cvt_job(tile, CvtJob{in.w_in + (size_t)l * 1024 * INC, w.WinT() + (size_t)l * 1792 * 1024, nullptr, 1024, INC, 1792, 0}, vb, nvb);
        cvt_job(tile, CvtJob{in.mla_w_uq + (size_t)l * 384 * 576, w.WuqT() + (size_t)l * 768 * 384, in.mla_qn_g + l * 384, 384, 576, 768, 1}, vb, nvb);
        cvt_job(tile, CvtJob{in.mla_w_ukv + (size_t)l * 256 * 768, w.WukvT() + (size_t)l * 768 * 256, in.mla_kvn_g + l * 256, 256, 768, 768, 2}, vb, nvb);
        cvt_job(tile, CvtJob{in.w_out + (size_t)l * 1024 * 1024, w.WoutT() + (size_t)l * 1024 * 1024, nullptr, 1024, 1024, 1024, 3}, vb, nvb);
        cvt_job(tile, CvtJob{in.peer_wq + (size_t)l * 1024 * 2048, w.WqT() + (size_t)l * 2048 * 1024, nullptr, 1024, 2048, 2048, 3}, vb, nvb);
    }
    cvt_flat(in.peer_subkeys, w.SubK(), (size_t)2 * 16 * 128 * 128, vb, nvb);
    { int tp_ = threadIdx.x; asm volatile("" : "+v"(tp_));
      for (int i = vb * 512 + tp_; i < 2 * 4 * 64 * 64; i += nvb * 512) { const int c = i & 63, d = (i >> 6) & 63, lg = i >> 12; w.PoolWT()[i] = f2bf(in.pool_w[(size_t)lg * 4096 + c * 64 + d]); } }
    if (nvb > 144) { if (vb >= 72) { cvt_q4_rows<false>(in.peer_u, w.U8(), w.US(), 2 * NE, vb - 72, nvb - 72); cvt_fp4_rows(in.peer_v, w.V8(), w.VS(), 2 * NE, vb - 72, nvb - 72); } }
    else { cvt_q4_rows<false>(in.peer_u, w.U8(), w.US(), 2 * NE, vb, nvb); cvt_fp4_rows(in.peer_v, w.V8(), w.VS(), 2 * NE, vb, nvb); }
}

constexpr float ATT_C2G = 0.125f * 1.4426950408889634f, ATT_C2M = 0.10206207261596577f * 1.4426950408889634f;
struct EpiIn {
    static constexpr bool PERM = true;
    WS w; const float* qn_g; const float* kn_g; int pm_base;
    __device__ __forceinline__ void operator()(const f32x4 (&acc)[2][2][4][2], const pg8::Unit& u, int wr, int wc, int fr, int fq) const {
        int type, sub; in_group(4 * u.pn + wc, type, sub);
        if (type == GT_PAD) return;
        const int pm = u.pm + pm_base; const bool isctx = pm >= 256; const int b = isctx ? pm - 256 : pm >> 3; const int t0 = isctx ? 0 : (pm & 7) * 256;
        const size_t rowbase = isctx ? (size_t)NL + (size_t)b * CTX : (size_t)b * S;
        const int keyoff = isctx ? 0 : CTX;
        float gain[2][8];
        if (type == GT_AQ) {
#pragma unroll
            for (int bj = 0; bj < 2; ++bj)
#pragma unroll
                for (int q = 0; q < 8; ++q) gain[bj][q] = qn_g[32 * bj + 8 * fq + q] * ATT_C2G;
        } else if (type == GT_AK) {
#pragma unroll
            for (int bj = 0; bj < 2; ++bj)
#pragma unroll
                for (int q = 0; q < 8; ++q) gain[bj][q] = kn_g[32 * bj + 8 * fq + q];
        }
#pragma unroll
        for (int ai = 0; ai < 2; ++ai)
#pragma unroll
            for (int m = 0; m < 4; ++m) {
                const int t = t0 + 128 * ai + 64 * wr + 16 * m + fr; const size_t row = rowbase + t;
                float v[2][8];
#pragma unroll
                for (int bj = 0; bj < 2; ++bj)
#pragma unroll
                    for (int n = 0; n < 2; ++n)
#pragma unroll
                        for (int i = 0; i < 4; ++i) v[bj][4 * n + i] = acc[ai][bj][m][n][i];
                bf16_t* dst = nullptr;
                if (type == GT_AQ || type == GT_AK) {
                    float ss = 0.f;
#pragma unroll
                    for (int bj = 0; bj < 2; ++bj)
#pragma unroll
                        for (int q = 0; q < 8; ++q) ss += v[bj][q] * v[bj][q];
                    ss += __shfl_xor(ss, 16); ss += __shfl_xor(ss, 32);
                    const float rstd = rsqrtf(ss * (1.f / 64.f) + EPS);
#pragma unroll
                    for (int q = 0; q < 8; ++q) { float x1 = v[0][q] * rstd * gain[0][q], x2 = v[1][q] * rstd * gain[1][q];
                        if (!isctx) { const float2 cs = w.ROPA()[t * 32 + 8 * fq + q]; const float y1 = x1 * cs.x - x2 * cs.y, y2 = x1 * cs.y + x2 * cs.x; x1 = y1; x2 = y2; }
                        v[0][q] = x1; v[1][q] = x2; }
                    if (type == GT_AQ) dst = isctx ? w.Qgc() + (((size_t)b * 6 + sub) * CTX + t) * 64 : w.Qg() + (((size_t)b * 6 + sub) * S + t) * 64;
                    else dst = w.Kg() + (((size_t)b * 2 + sub) * KEYS + keyoff + t) * 64;
                } else if (type == GT_AV) { dst = w.Vg() + (((size_t)b * 2 + sub) * KEYS + keyoff + t) * 64;
                } else if (type == GT_B) { dst = w.Bp() + row * 256 + 64 * sub;
                } else if (type == GT_CQ || type == GT_CKV) {
                    float ss = 0.f;
#pragma unroll
                    for (int bj = 0; bj < 2; ++bj)
#pragma unroll
                        for (int q = 0; q < 8; ++q) ss += v[bj][q] * v[bj][q];
                    ss += __shfl_xor(ss, 16); ss += __shfl_xor(ss, 32);
                    if (type == GT_CQ) { if (fq == 0) w.SSQ()[row * 8 + sub] = ss; dst = w.CQ() + row * 384 + 64 * sub; }
                    else { if (fq == 0) w.SSKV()[row * 4 + sub] = ss; dst = w.CKV() + row * 256 + 64 * sub; }
                } else {
                    if (!isctx) {
#pragma unroll
                        for (int q = 0; q < 8; ++q) { const float2 cs = w.ROPC()[t * 16 + ((8 * fq + q) & 15)]; const float x1 = v[0][q], x2 = v[1][q]; v[0][q] = x1 * cs.x - x2 * cs.y; v[1][q] = x1 * cs.y + x2 * cs.x; } }
                    if (fq < 2) { bf16_t* kd = w.KR() + ((size_t)b * KEYS + keyoff + t) * 32;
#pragma unroll
                        for (int bj = 0; bj < 2; ++bj) { u32x4 o; o.x = cvt_pk_bf16(v[bj][0], v[bj][1]); o.y = cvt_pk_bf16(v[bj][2], v[bj][3]); o.z = cvt_pk_bf16(v[bj][4], v[bj][5]); o.w = cvt_pk_bf16(v[bj][6], v[bj][7]);
                            *(u32x4*)(kd + 16 * bj + 8 * fq) = o; } }
                    continue;
                }
#pragma unroll
                for (int bj = 0; bj < 2; ++bj) { u32x4 o; o.x = cvt_pk_bf16(v[bj][0], v[bj][1]); o.y = cvt_pk_bf16(v[bj][2], v[bj][3]); o.z = cvt_pk_bf16(v[bj][4], v[bj][5]); o.w = cvt_pk_bf16(v[bj][6], v[bj][7]);
                    *(u32x4*)(dst + 32 * bj + 8 * fq) = o; }
            }
    }
};
struct P1Order {
    pg8::StaticOrder so; int nctx_tiles, G, c;
    __device__ bool next(int i, pg8::Unit& u) const {
        const int L = i * G + c;
        if (L < 1792) return so.next(i, u);
        const int Lc = L - 1792; if (Lc >= 32 * nctx_tiles) return false;
        u.pm = 256 + (Lc & 31); u.pn = Lc >> 5; return true;
    }
};
__device__ __forceinline__ void phase_p1(LAS unsigned char* lds, const WS& w, const Inputs& in, int l, int vb, int nvb) {
    EpiIn E{w, in.gqa_qn_g + l * 64, in.gqa_kn_g + l * 64, 0};
    P1Order po; po.so.init(NL, 1792, nvb, vb); po.nctx_tiles = (l == 0) ? 7 : 3; po.G = nvb; po.c = vb;
    pg8::gemm_phase(lds, pg8::Gemm{w.H(), w.WinT() + (size_t)l * 1792 * 1024, NR, 1792, 1024}, po, E);
}

extern __shared__ __attribute__((aligned(16))) unsigned char dyn_lds[];

struct EpiUq {
    static constexpr bool PERM = true;
    WS w;
    __device__ __forceinline__ void operator()(const f32x4 (&acc)[2][2][4][2], const pg8::Unit& u, int wr, int wc, int fr, int fq) const {
        const int g = 4 * u.pn + wc; if (g >= 9) return;
        const int pm = u.pm; const bool isctx = pm >= 256; const int b = isctx ? pm - 256 : pm >> 3; const int t0 = isctx ? 0 : (pm & 7) * 256;
        const size_t rowbase = isctx ? (size_t)NL + (size_t)b * CTX : (size_t)b * S;
        const int head = g < 6 ? g : 2 * (g - 6) + (fq >> 1);
#pragma unroll
        for (int ai = 0; ai < 2; ++ai)
#pragma unroll
            for (int m = 0; m < 4; ++m) {
                const int t = t0 + 128 * ai + 64 * wr + 16 * m + fr; const size_t row = rowbase + t;
                const float4 s0 = *(const float4*)(w.SSQ() + row * 8), s1 = *(const float4*)(w.SSQ() + row * 8 + 4);
                const float rstd = rsqrtf((s0.x + s0.y + s0.z + s0.w + s1.x + s1.y) * (1.f / 384.f) + EPS) * ATT_C2M;
                float v[2][8];
#pragma unroll
                for (int bj = 0; bj < 2; ++bj)
#pragma unroll
                    for (int n = 0; n < 2; ++n)
#pragma unroll
                        for (int i = 0; i < 4; ++i) v[bj][4 * n + i] = acc[ai][bj][m][n][i] * rstd;
                bf16_t* hd = isctx ? w.Qmc() + (((size_t)b * 6 + head) * CTX + t) * 96 : w.Qm() + (((size_t)b * 6 + head) * S + t) * 96;
                if (g >= 6 && !isctx) {
#pragma unroll
                    for (int q = 0; q < 8; ++q) { const float2 cs = w.ROPC()[t * 16 + 8 * (fq & 1) + q]; const float x1 = v[0][q], x2 = v[1][q]; v[0][q] = x1 * cs.x - x2 * cs.y; v[1][q] = x1 * cs.y + x2 * cs.x; } }
#pragma unroll
                for (int bj = 0; bj < 2; ++bj) { u32x4 o; o.x = cvt_pk_bf16(v[bj][0], v[bj][1]); o.y = cvt_pk_bf16(v[bj][2], v[bj][3]); o.z = cvt_pk_bf16(v[bj][4], v[bj][5]); o.w = cvt_pk_bf16(v[bj][6], v[bj][7]);
                    bf16_t* d = g < 6 ? hd + 32 * bj + 8 * fq : hd + 64 + 16 * bj + 8 * (fq & 1);
                    *(u32x4*)d = o; }
            }
    }
};
struct EpiUkv {
    static constexpr bool PERM = true;
    WS w;
    __device__ __forceinline__ void operator()(const f32x4 (&acc)[2][2][4][2], const pg8::Unit& u, int wr, int wc, int fr, int fq) const {
        const int g = 4 * u.pn + wc;
        const int pm = u.pm; const bool isctx = pm >= 256; const int b = isctx ? pm - 256 : pm >> 3; const int t0 = isctx ? 0 : (pm & 7) * 256;
        const size_t rowbase = isctx ? (size_t)NL + (size_t)b * CTX : (size_t)b * S; const int keyoff = isctx ? 0 : CTX;
        bf16_t* base = ((g & 1) ? w.Vm() : w.Kmn()) + ((size_t)b * 6 + (g >> 1)) * KEYS * 64;
#pragma unroll
        for (int ai = 0; ai < 2; ++ai)
#pragma unroll
            for (int m = 0; m < 4; ++m) {
                const int t = t0 + 128 * ai + 64 * wr + 16 * m + fr; const size_t row = rowbase + t;
                const float4 s0 = *(const float4*)(w.SSKV() + row * 4);
                const float rstd = rsqrtf((s0.x + s0.y + s0.z + s0.w) * (1.f / 256.f) + EPS);
                bf16_t* d = base + (size_t)(keyoff + t) * 64;
#pragma unroll
                for (int bj = 0; bj < 2; ++bj) { const f32x4 a0 = acc[ai][bj][m][0] * rstd, a1 = acc[ai][bj][m][1] * rstd;
                    u32x4 o; o.x = cvt_pk_bf16(a0[0], a0[1]); o.y = cvt_pk_bf16(a0[2], a0[3]); o.z = cvt_pk_bf16(a1[0], a1[1]); o.w = cvt_pk_bf16(a1[2], a1[3]);
                    *(u32x4*)(d + 32 * bj + 8 * fq) = o; }
            }
    }
};
constexpr int POOL_X = 0, POOL_P = 272 * 128, POOL_BYTES = 272 * 128 + 256 * 128;
template <int G>
__device__ __forceinline__ void pool_sums(LAS unsigned char* lds, int tid, int t0, int L) {
    constexpr int wdw = 2 << G, half = wdw >> 1, NX = 32 + wdw - 1;
    const int c = tid & 63, seg = tid >> 6; const LAS bf16_t* X = (const LAS bf16_t*)(lds + POOL_X) + c + (seg * 32 + 8 - half) * 64;
    const int tb = t0 + seg * 32;
    float xr[NX], xm[NX];
#pragma unroll
    for (int j = 0; j < NX; ++j) xr[j] = bf2f(X[j * 64]);
#pragma unroll
    for (int j = 0; j < NX; ++j) { const int row = tb - half + j; xm[j] = (row >= 0 && row < L) ? xr[j] : 0.f; }
    float sum = 0.f;
#pragma unroll
    for (int j = 0; j < wdw; ++j) sum += xm[j];
#pragma unroll
    for (int k = 0; k < 32; ++k) {
        const int t = tb + k; const int clo = (t - half) < 0 ? 0 : (t - half), chi = (t - half + wdw) > L ? L : (t - half + wdw);
        const float pv = sum / (float)(chi - clo) - xr[k + half];
        const int r = seg * 32 + k; *((LAS bf16_t*)(lds + POOL_P + r * 128 + (((c >> 3) ^ ((r >> 1) & 7)) << 4)) + (c & 7)) = f2bf(pv);
        if (k < 31) sum += xm[k + wdw] - xm[k];
    }
}
__device__ __forceinline__ void phase_pool(LAS unsigned char* lds, const WS& w, bf16_t* __restrict__ MIX, const bf16_t* __restrict__ WT  , const float* __restrict__ pool_scale, int nrows, int vb, int nvb) {
    int tid_ = threadIdx.x; asm volatile("" : "+v"(tid_));
    const int tid = tid_, lane = tid & 63, wid = __builtin_amdgcn_readfirstlane(tid >> 6), r32 = lane & 31, hi = lane >> 5;
    const int nunits = nrows >> 8;
    const int nmine = vb < nunits ? ((nunits - 1 - vb) / nvb + 1) * 4 : 0;
    u32x4 st[5];
#define POOL_FETCH(it_) do { const int u_ = vb + ((it_) >> 2) * nvb, g_ = (it_) & 3; const int row0_ = u_ << 8; const bool ic_ = row0_ >= NL; const int L_ = ic_ ? CTX : S; const int t0_ = ic_ ? 0 : (row0_ & (S - 1)); const int seq0_ = row0_ - t0_; \
        _Pragma("unroll") for (int k_ = 0; k_ < 5; ++k_) { int i_ = tid + 512 * k_; i_ = i_ < 272 * 8 ? i_ : 272 * 8 - 1; const int rr_ = i_ >> 3, ch_ = i_ & 7; int t_ = t0_ - 8 + rr_; t_ = t_ < 0 ? 0 : (t_ >= L_ ? L_ - 1 : t_); \
            st[k_] = *(const u32x4*)(w.Bp() + (size_t)(seq0_ + t_) * 256 + g_ * 64 + ch_ * 8); } } while (0)
    if (nmine > 0) POOL_FETCH(0);
    for (int it = 0; it < nmine; ++it) {
        const int u = vb + (it >> 2) * nvb, g = it & 3;
        const int row0 = u << 8; const bool isctx = row0 >= NL; const int L = isctx ? CTX : S; const int t0 = isctx ? 0 : (row0 & (S - 1));
        {
#pragma unroll
            for (int k = 0; k < 5; ++k) { const int i = tid + 512 * k; if (i < 272 * 8) *(LAS u32x4*)(lds + POOL_X + (i >> 3) * 128 + (i & 7) * 16) = st[k]; }
            { const int nx = it + 1 < nmine ? it + 1 : it; POOL_FETCH(nx); }
            __syncthreads();
            if (g == 0) pool_sums<0>(lds, tid, t0, L); else if (g == 1) pool_sums<1>(lds, tid, t0, L); else if (g == 2) pool_sums<2>(lds, tid, t0, L); else pool_sums<3>(lds, tid, t0, L);
            __syncthreads();
            { f32x16 o0 = {}, o1 = {};
              const bf16_t* wt = WT + (size_t)g * 4096 + (size_t)r32 * 64 + 8 * hi;
#pragma unroll
              for (int s = 0; s < 4; ++s) { const int row = wid * 32 + r32; const bf16x8 pf = *(const LAS bf16x8*)(lds + POOL_P + row * 128 + (((2 * s + hi) ^ ((row >> 1) & 7)) << 4));
                  o0 = mfma32(*(const bf16x8*)(wt + 16 * s), pf, o0); o1 = mfma32(*(const bf16x8*)(wt + 32 * 64 + 16 * s), pf, o1); }
              bf16_t* op = MIX + (size_t)(row0 + wid * 32 + r32) * 1024 + 384 + g * 64 + 4 * hi; const float* ps = pool_scale + g * 64 + 4 * hi;
#pragma unroll
              for (int q = 0; q < 4; ++q) { const f32x4 s0 = *(const f32x4*)(ps + 8 * q), s1 = *(const f32x4*)(ps + 32 + 8 * q); u32x2 a, b;
                  a.x = cvt_pk_bf16(o0[4 * q] * s0[0], o0[4 * q + 1] * s0[1]); a.y = cvt_pk_bf16(o0[4 * q + 2] * s0[2], o0[4 * q + 3] * s0[3]);
                  b.x = cvt_pk_bf16(o1[4 * q] * s1[0], o1[4 * q + 1] * s1[1]); b.y = cvt_pk_bf16(o1[4 * q + 2] * s1[2], o1[4 * q + 3] * s1[3]);
                  *(u32x2*)(op + 8 * q) = a; *(u32x2*)(op + 32 + 8 * q) = b; } }
            __syncthreads();
        }
    }
#undef POOL_FETCH
}
__device__ __forceinline__ void phase_p2(LAS unsigned char* lds, const WS& w, const Inputs& in, int l, int vb, int nvb, int parts = 7) {
    pg8::StaticOrder so;
    if (parts & 1) { EpiUq E{w}; const int M = l == 0 ? NR : NL; so.init(M, 768, nvb, vb); pg8::gemm_phase(lds, pg8::Gemm{w.CQ(), w.WuqT() + (size_t)l * 768 * 384, M, 768, 384}, so, E); }
    if (parts & 2) { EpiUkv E{w}; so.init(NR, 768, nvb, vb); pg8::gemm_phase(lds, pg8::Gemm{w.CKV(), w.WukvT() + (size_t)l * 768 * 256, NR, 768, 256}, so, E); }
    if (parts & 4) phase_pool(lds, w, w.H(), w.PoolWT() + (size_t)l * 4 * 64 * 64, in.pool_scale + l * 256, l == 0 ? NR : NL, vb, nvb);
}

struct EpiOut {
    static constexpr bool PERM = true;
    bf16_t* DLT; const float* gate;
    __device__ __forceinline__ void operator()(const f32x4 (&acc)[2][2][4][2], const pg8::Unit& u, int wr, int wc, int fr, int fq) const {
        const int pm = u.pm; const int mr = pm >= 256 ? 32 : pm >> 3;
        const size_t r0 = (size_t)pm * 256 + wr * 64 + fr; const int col0 = u.pn * 256 + wc * 32 + 8 * fq;
        f32x4 gv[2][2];
#pragma unroll
        for (int bj = 0; bj < 2; ++bj)
#pragma unroll
            for (int n = 0; n < 2; ++n) gv[bj][n] = *(const f32x4*)(gate + (size_t)mr * 6144 + col0 + bj * 128 + 4 * n);
#pragma unroll
        for (int ai = 0; ai < 2; ++ai)
#pragma unroll
            for (int m = 0; m < 4; ++m) { bf16_t* d = DLT + (r0 + ai * 128 + m * 16) * 1024 + col0;
#pragma unroll
                for (int bj = 0; bj < 2; ++bj) { const f32x4 a0 = acc[ai][bj][m][0] * gv[bj][0], a1 = acc[ai][bj][m][1] * gv[bj][1];
                    u32x4 o; o.x = cvt_pk_bf16(a0[0], a0[1]); o.y = cvt_pk_bf16(a0[2], a0[3]); o.z = cvt_pk_bf16(a1[0], a1[1]); o.w = cvt_pk_bf16(a1[2], a1[3]);
                    *(u32x4*)(d + bj * 128) = o; } }
    }
};
__device__ __forceinline__ void phase_p4(LAS unsigned char* lds, const WS& w, const Inputs& in, int l, int vb, int nvb) {
    const float* MODl = w.MOD() + (size_t)l * 33 * 6144;
    EpiOut E{w.PQ(), MODl + 2 * 1024};
    const int M = l == 0 ? NR : NL;
    pg8::StaticOrder so; so.init(M, 1024, nvb, vb);
    pg8::gemm_phase(lds, pg8::Gemm{w.H(), w.WoutT() + (size_t)l * 1024 * 1024, M, 1024, 1024}, so, E);
}

template <bool INBF>
__device__ __forceinline__ void phase_modulate(const float* __restrict__ XLp, const float* __restrict__ XCp, const bf16_t* __restrict__ XBp, bf16_t* __restrict__ Hout, const float* __restrict__ g, const float* __restrict__ MODl, int si, int nrows, int vb, int nvb,
                                               signed char* __restrict__ H8 = nullptr, float* __restrict__ HS = nullptr, const bf16_t* __restrict__ DLT = nullptr, bf16_t* __restrict__ XBo = nullptr) {
    int tid_ = threadIdx.x; asm volatile("" : "+v"(tid_));
    const int tid = tid_, lane = tid & 63, wid = tid >> 6;
    f32x4 gv[4];
#pragma unroll
    for (int i = 0; i < 4; ++i) gv[i] = *(const f32x4*)(g + 256 * i + 4 * lane);
    const int stride = nvb * 8, lastrow = nrows - 1;
    f32x4 nx[4]; u32x2 nxb[4], ndr[4];
#define PM_LOAD(r_) do { const int rr_ = (r_) < nrows ? (r_) : lastrow; const bool ic_ = rr_ >= NL; const float* xp_ = ic_ ? XCp + (size_t)(rr_ - NL) * 1024 : XLp + (size_t)rr_ * 1024; \
        _Pragma("unroll") for (int i = 0; i < 4; ++i) { if (INBF) nxb[i] = *(const u32x2*)(XBp + (size_t)rr_ * 1024 + 256 * i + 4 * lane); else nx[i] = *(const f32x4*)(xp_ + 256 * i + 4 * lane); \
            if (DLT) ndr[i] = *(const u32x2*)(DLT + (size_t)rr_ * 1024 + 256 * i + 4 * lane); } } while (0)
    PM_LOAD(vb * 8 + wid);
    for (int row = vb * 8 + wid; row < nrows; row += stride) {
        const bool isctx = row >= NL; const int mr = isctx ? 32 : row / S;
        f32x4 x[4]; u32x2 dr4[4]; float ss = 0.f;
#pragma unroll
        for (int i = 0; i < 4; ++i) { if (INBF) x[i] = (f32x4){__uint_as_float(nxb[i].x << 16), __uint_as_float(nxb[i].x & 0xffff0000u), __uint_as_float(nxb[i].y << 16), __uint_as_float(nxb[i].y & 0xffff0000u)}; else x[i] = nx[i];
            if (DLT) dr4[i] = ndr[i]; }
        PM_LOAD(row + stride);
#pragma unroll
        for (int i = 0; i < 4; ++i) {
            if (DLT) { const u32x2 dr = dr4[i];
                x[i][0] += __uint_as_float(dr.x << 16); x[i][1] += __uint_as_float(dr.x & 0xffff0000u); x[i][2] += __uint_as_float(dr.y << 16); x[i][3] += __uint_as_float(dr.y & 0xffff0000u);
                u32x2 xo; xo.x = cvt_pk_bf16(x[i][0], x[i][1]); xo.y = cvt_pk_bf16(x[i][2], x[i][3]); *(u32x2*)(XBo + (size_t)row * 1024 + 256 * i + 4 * lane) = xo; }
            ss += x[i][0] * x[i][0] + x[i][1] * x[i][1] + x[i][2] * x[i][2] + x[i][3] * x[i][3]; }
        ss = wave_sum(ss); const float rstd = rsqrtf(ss * (1.f / 1024.f) + EPS);
        const float* sh = MODl + (size_t)mr * 6144 + si * 1024;
        f32x4 y[4]; float am = 0.f;
#pragma unroll
        for (int i = 0; i < 4; ++i) { const f32x4 shv = *(const f32x4*)(sh + 256 * i + 4 * lane), scv = *(const f32x4*)(sh + 1024 + 256 * i + 4 * lane);
            y[i] = x[i] * rstd * gv[i] * (scv + 1.f) + shv;
            am = fmaxf(am, fmaxf(fmaxf(fabsf(y[i][0]), fabsf(y[i][1])), fmaxf(fabsf(y[i][2]), fabsf(y[i][3]))));
            u32x2 o; o.x = cvt_pk_bf16(y[i][0], y[i][1]); o.y = cvt_pk_bf16(y[i][2], y[i][3]);
            *(u32x2*)(Hout + (size_t)row * 1024 + 256 * i + 4 * lane) = o; }
        if (H8) {
#pragma unroll
            for (int o = 32; o > 0; o >>= 1) am = fmaxf(am, __shfl_xor(am, o));
            const float inv = am > 0.f ? 127.f / am : 0.f;
#pragma unroll
            for (int i = 0; i < 4; ++i) { const int q0 = (int)rintf(y[i][0] * inv), q1 = (int)rintf(y[i][1] * inv), q2 = (int)rintf(y[i][2] * inv), q3 = (int)rintf(y[i][3] * inv);
                *(unsigned*)(H8 + (size_t)row * 1024 + 256 * i + 4 * lane) = (unsigned)(q0 & 0xff) | ((unsigned)(q1 & 0xff) << 8) | ((unsigned)(q2 & 0xff) << 16) | ((unsigned)(q3 & 0xff) << 24); }
            if (lane == 0) HS[row] = am > 0.f ? am * (1.f / 127.f) : 1.f;
        }
    }
#undef PM_LOAD
}

struct EpiPQ {
    static constexpr bool PERM = true;
    bf16_t* PQ;
    __device__ __forceinline__ void operator()(const f32x4 (&acc)[2][2][4][2], const pg8::Unit& u, int wr, int wc, int fr, int fq) const {
        const size_t r0 = (size_t)u.pm * 256 + wr * 64 + fr; const int col0 = u.pn * 256 + wc * 32 + 8 * fq;
#pragma unroll
        for (int ai = 0; ai < 2; ++ai)
#pragma unroll
            for (int m = 0; m < 4; ++m) { bf16_t* d = PQ + (r0 + ai * 128 + m * 16) * 2048 + col0;
#pragma unroll
                for (int bj = 0; bj < 2; ++bj) { const f32x4 a0 = acc[ai][bj][m][0], a1 = acc[ai][bj][m][1];
                    u32x4 o; o.x = cvt_pk_bf16(a0[0], a0[1]); o.y = cvt_pk_bf16(a0[2], a0[3]); o.z = cvt_pk_bf16(a1[0], a1[1]); o.w = cvt_pk_bf16(a1[2], a1[3]);
                    *(u32x4*)(d + bj * 128) = o; } }
    }
};
__device__ __forceinline__ void phase_p6a(LAS unsigned char* lds, const WS& w, int l, int vb, int nvb) {
    EpiPQ E{w.PQ()}; const int M = l == 0 ? NR : NL;
    pg8::StaticOrder so; so.init(M, 2048, nvb, vb);
    pg8::gemm_phase(lds, pg8::Gemm{w.H(), w.WqT() + (size_t)l * 2048 * 1024, M, 2048, 1024}, so, E);
}


using bf16x2_t = __attribute__((ext_vector_type(2))) __bf16;
typedef float f32x2 __attribute__((ext_vector_type(2)));
__device__ __forceinline__ float gelu_fast(float x) {
    const float u2 = 1.5957691216057308f * (x + 0.044715f * x * x * x);
    return x * __builtin_amdgcn_rcpf(1.f + __builtin_amdgcn_exp2f(-1.4426950408889634f * u2));
}
#define DPPF(v, ctrl) __builtin_bit_cast(float, __builtin_amdgcn_update_dpp(0, __builtin_bit_cast(int, (v)), (ctrl), 0xf, 0xf, true))
__device__ __forceinline__ float reduce8(float p0, float p1, float p2, float p3, float p4, float p5, float p6, float p7, int lane) {
    auto s01 = __builtin_amdgcn_permlane32_swap(__float_as_uint(p0), __float_as_uint(p1), false, false);
    auto s23 = __builtin_amdgcn_permlane32_swap(__float_as_uint(p2), __float_as_uint(p3), false, false);
    auto s45 = __builtin_amdgcn_permlane32_swap(__float_as_uint(p4), __float_as_uint(p5), false, false);
    auto s67 = __builtin_amdgcn_permlane32_swap(__float_as_uint(p6), __float_as_uint(p7), false, false);
    const float q0 = __uint_as_float(s01[0]) + __uint_as_float(s01[1]), q1 = __uint_as_float(s23[0]) + __uint_as_float(s23[1]);
    const float q2 = __uint_as_float(s45[0]) + __uint_as_float(s45[1]), q3 = __uint_as_float(s67[0]) + __uint_as_float(s67[1]);
    auto t0 = __builtin_amdgcn_permlane16_swap(__float_as_uint(q0), __float_as_uint(q1), false, false);
    auto t1 = __builtin_amdgcn_permlane16_swap(__float_as_uint(q2), __float_as_uint(q3), false, false);
    float r0 = __uint_as_float(t0[0]) + __uint_as_float(t0[1]);
    float r1 = __uint_as_float(t1[0]) + __uint_as_float(t1[1]);
    r0 += DPPF(r0, 0x128); r1 += DPPF(r1, 0x128);
    float z = (lane & 8) ? r1 : r0;
    z += DPPF(z, 0x141);
    z += DPPF(z, 0xB1);
    z += DPPF(z, 0x4E);
    return z;
}
__device__ __forceinline__ void p7_axpy(const u32x4 v, float wj, f32x2 (&out)[8]) {
    const f32x2 w2 = {wj, wj};
#pragma unroll
    for (int k = 0; k < 4; ++k) { const f32x2 lo = __builtin_amdgcn_cvt_pk_f32_fp8((int)v[k], false), hi2 = __builtin_amdgcn_cvt_pk_f32_fp8((int)v[k], true);
        out[2 * k] = __builtin_elementwise_fma(w2, lo, out[2 * k]); out[2 * k + 1] = __builtin_elementwise_fma(w2, hi2, out[2 * k + 1]); }
}
__device__ __forceinline__ int p7_doti(const u32x4 u, const u32x4 h) {
    int s = __builtin_amdgcn_sdot4((int)u[0], (int)h[0], 0, false); s = __builtin_amdgcn_sdot4((int)u[1], (int)h[1], s, false); s = __builtin_amdgcn_sdot4((int)u[2], (int)h[2], s, false); return __builtin_amdgcn_sdot4((int)u[3], (int)h[3], s, false);
}
#define DPPI(v, ctrl) __builtin_amdgcn_update_dpp(0, (v), (ctrl), 0xf, 0xf, true)
__device__ __forceinline__ int reduce8i(int p0, int p1, int p2, int p3, int p4, int p5, int p6, int p7, int lane) {
    auto s01 = __builtin_amdgcn_permlane32_swap((unsigned)p0, (unsigned)p1, false, false); auto s23 = __builtin_amdgcn_permlane32_swap((unsigned)p2, (unsigned)p3, false, false);
    auto s45 = __builtin_amdgcn_permlane32_swap((unsigned)p4, (unsigned)p5, false, false); auto s67 = __builtin_amdgcn_permlane32_swap((unsigned)p6, (unsigned)p7, false, false);
    const unsigned q0 = s01[0] + s01[1], q1 = s23[0] + s23[1], q2 = s45[0] + s45[1], q3 = s67[0] + s67[1];
    auto t0 = __builtin_amdgcn_permlane16_swap(q0, q1, false, false); auto t1 = __builtin_amdgcn_permlane16_swap(q2, q3, false, false);
    int r0 = (int)(t0[0] + t0[1]), r1 = (int)(t1[0] + t1[1]);
    r0 += DPPI(r0, 0x128); r1 += DPPI(r1, 0x128);
    int z = (lane & 8) ? r1 : r0;
    z += DPPI(z, 0x141); z += DPPI(z, 0xB1); z += DPPI(z, 0x4E);
    return z;
}

struct P7CArgs { const signed char* H8; const unsigned* EG; const unsigned char* U8; int* PART; int nrows; };
__device__ __forceinline__ int p7_doti4(const u32x4 u, const u32x4 h0, const u32x4 h1) {
    int s = 0;
#pragma unroll
    for (int k = 0; k < 4; ++k) { const unsigned lo = (u[k] << 4) & 0xf0f0f0f0u, hi = u[k] & 0xf0f0f0f0u;
        const unsigned ha = (k < 2) ? h0[2 * k] : h1[2 * k - 4], hb = (k < 2) ? h0[2 * k + 1] : h1[2 * k - 3];
        s = __builtin_amdgcn_sdot4((int)lo, (int)ha, s, false); s = __builtin_amdgcn_sdot4((int)hi, (int)hb, s, false); }
    return s;
}
__device__ __forceinline__ void phase_p7c(LAS unsigned char* lds, const P7CArgs& a, int part8, int prank8, int nvb) {
    int tid_ = threadIdx.x; asm volatile("" : "+v"(tid_));
    const int lane = tid_ & 63, wid = __builtin_amdgcn_readfirstlane(tid_ >> 6);
    const int part = part8 >> 1, prank = (part8 & 1) * (nvb >> 3) + prank8;
    const int nw = (nvb >> 2) * 8, wrank = prank * 8 + wid;
    LAS unsigned* tab = (LAS unsigned*)(lds + wid * 1024);
    const int grp = lane >> 3, c = lane & 7, c16 = c * 16;
    const unsigned char* ubase = a.U8 + 128 * part + c16;
    const signed char* hbase = a.H8 + 256 * part + 32 * c;
    unsigned* pbase = (unsigned*)a.PART + (size_t)part * a.nrows * 64;
    const int c2 = (c >> 2) & 1, c1 = (c >> 1) & 1, c0 = c & 1;
    const int ent0 = 8 * (4 * c2 + 2 * c0 + c1) + grp;
    u32x4 Av[16], Bv[16]; u32x4 Ah0, Ah1, Bh0, Bh1;
    unsigned pw0 = 0u, pw1 = 0u;
#define P7C_PREF(t) do { pw0 = a.EG[(size_t)(t) * 128 + lane]; pw1 = a.EG[(size_t)(t) * 128 + 64 + lane]; } while (0)
#define P7C_ISSUE(X, Xh0, Xh1, t, slot, tnext) do { LAS unsigned* tb_ = tab + (slot) * 128; \
        tb_[lane] = pw0; tb_[64 + lane] = pw1; \
        asm volatile("s_waitcnt lgkmcnt(0)" ::: "memory"); \
        _Pragma("unroll") for (int i_ = 0; i_ < 16; ++i_) { const unsigned e_ = tb_[8 * i_ + grp]; X[i_] = *(const u32x4*)(ubase + (size_t)(e_ >> 16) * 512); } \
        Xh0 = *(const u32x4*)(hbase + (size_t)(t) * 1024); Xh1 = *(const u32x4*)(hbase + (size_t)(t) * 1024 + 16); \
        P7C_PREF(tnext); } while (0)
#define P7C_COMPUTE(X, Xh0, Xh1, t, valid) do { int d_[16]; \
        _Pragma("unroll") for (int i_ = 0; i_ < 16; ++i_) d_[i_] = p7_doti4(X[i_], Xh0, Xh1); \
        int e8_[8]; _Pragma("unroll") for (int k = 0; k < 8; ++k) { const int send_ = c2 ? d_[k] : d_[k + 8], keep_ = c2 ? d_[k + 8] : d_[k]; e8_[k] = keep_ + DPPI(send_, 0x141); }            \
        int e4_[4]; _Pragma("unroll") for (int k = 0; k < 4; ++k) { const int send_ = c0 ? e8_[k] : e8_[k + 4], keep_ = c0 ? e8_[k + 4] : e8_[k]; e4_[k] = keep_ + DPPI(send_, 0xB1); }          \
        int e2_[2]; _Pragma("unroll") for (int k = 0; k < 2; ++k) { const int send_ = c1 ? e4_[k] : e4_[k + 2], keep_ = c1 ? e4_[k + 2] : e4_[k]; e2_[k] = keep_ + DPPI(send_, 0x4E); }          \
        if (valid) pbase[(size_t)(t) * 64 + ent0] = __builtin_bit_cast(unsigned, __builtin_amdgcn_cvt_pk_i16(e2_[0] >> 4, e2_[1] >> 4)); } while (0)
    const int lastrow = a.nrows - 1;
    int t = wrank;
    if (t < a.nrows) {
    P7C_PREF(t);
    P7C_ISSUE(Av, Ah0, Ah1, t, 0, (t + nw < a.nrows ? t + nw : lastrow));
    while (t < a.nrows) {
        const int t1 = t + nw, t2 = t1 + nw, t3 = t2 + nw;
        const int k1 = t1 < a.nrows ? t1 : lastrow, k2 = t2 < a.nrows ? t2 : lastrow, k3 = t3 < a.nrows ? t3 : lastrow;
        P7C_ISSUE(Bv, Bh0, Bh1, k1, 1, k2);
        P7C_COMPUTE(Av, Ah0, Ah1, t, true);
        P7C_ISSUE(Av, Ah0, Ah1, k2, 0, k3);
        P7C_COMPUTE(Bv, Bh0, Bh1, k1, (t1 < a.nrows));
        t = t2;
    }
    }
#undef P7C_PREF
#undef P7C_ISSUE
#undef P7C_COMPUTE
}
__device__ __forceinline__ void phase_p7d(const int* __restrict__ PART, const unsigned* __restrict__ EG, const float* __restrict__ US, const float* __restrict__ VS, const float* __restrict__ HS, unsigned* __restrict__ WE, int nrows, int vb, int nvb) {
    int tid_ = threadIdx.x; asm volatile("" : "+v"(tid_));
    typedef int i32x4 __attribute__((ext_vector_type(4)));
    const size_t n16 = (size_t)nrows * 16, pstride4 = n16;
    const u32x4* P4 = (const u32x4*)PART; const u32x4* EG4 = (const u32x4*)EG; u32x4* WE4 = (u32x4*)WE;
    for (size_t j = (size_t)vb * 512 + tid_; j < n16; j += (size_t)nvb * 512) {
        const size_t row = j >> 4; const int P = (int)(j >> 1) & 7, gq = (int)j & 1;
        i32x4 slo = {0, 0, 0, 0}, shi = {0, 0, 0, 0};
#pragma unroll
        for (int p = 0; p < 4; ++p) { const u32x4 d = P4[p * pstride4 + j];
#pragma unroll
            for (int k = 0; k < 4; ++k) { slo[k] += (int)(d[k] << 16) >> 16; shi[k] += (int)d[k] >> 16; } }
        const float hs = HS[row];
#pragma unroll
        for (int half = 0; half < 2; ++half) {
            const size_t ei = row * 32 + 4 * P + 2 * half + gq;
            const u32x4 eg = EG4[ei]; u32x4 o;
#pragma unroll
            for (int k = 0; k < 4; ++k) { const int eid = (int)(eg[k] >> 16);
                const float av = (float)(half ? shi[k] : slo[k]) * US[eid] * hs;
                const float wv = __uint_as_float(eg[k] << 16) * gelu_fast(av) * VS[eid];
                o[k] = (eg[k] & 0xffff0000u) | (cvt_pk_bf16(wv, 0.f) & 0xffffu); }
            WE4[ei] = o;
        }
    }
}
struct P7BArgs { const unsigned* WE; const unsigned char* V8; bf16_t* XB; const float* gate2; int nrows; };
__device__ __forceinline__ void p7_axpy4(const u32x4 v, float wj, f32x2 (&out)[16]) {
    const f32x2 w2 = {wj, wj};
#pragma unroll
    for (int k = 0; k < 4; ++k) {
        const f32x2 a0 = __builtin_amdgcn_cvt_scalef32_pk_f32_fp4(v[k], 1.0f, 0), a1 = __builtin_amdgcn_cvt_scalef32_pk_f32_fp4(v[k], 1.0f, 1), a2 = __builtin_amdgcn_cvt_scalef32_pk_f32_fp4(v[k], 1.0f, 2), a3 = __builtin_amdgcn_cvt_scalef32_pk_f32_fp4(v[k], 1.0f, 3);
        out[4 * k] = __builtin_elementwise_fma(w2, a0, out[4 * k]); out[4 * k + 1] = __builtin_elementwise_fma(w2, a1, out[4 * k + 1]);
        out[4 * k + 2] = __builtin_elementwise_fma(w2, a2, out[4 * k + 2]); out[4 * k + 3] = __builtin_elementwise_fma(w2, a3, out[4 * k + 3]); }
}
template <int PM>
__device__ __forceinline__ void phase_p7b(LAS unsigned char* lds, const P7BArgs& a, int part8, int prank8, int nvb) {
    int tid_ = threadIdx.x; asm volatile("" : "+v"(tid_));
    const int lane = tid_ & 63, wid = __builtin_amdgcn_readfirstlane(tid_ >> 6);
    const int part = part8 >> 1, prank = (part8 & 1) * (nvb >> 3) + prank8;
    const int nw = (nvb >> 2) * 8, wrank = prank * 8 + wid;
    LAS unsigned* tab = (LAS unsigned*)(lds + wid * 1024);
    const int grp = lane >> 3, c16 = (lane & 7) * 16;
    const unsigned char* vbase = a.V8 + 128 * part + c16;
    const int colofs = 256 * part + 2 * c16 + 16 * (lane >> 5) + 8 * ((lane >> 4) & 1) + 4 * ((lane >> 3) & 1);
    u32x4 Av[16], Bv[16]; float Aw[16], Bw[16]; u32x2 Ax, Bx; f32x4 Ag, Bg;
    unsigned pw0 = 0u, pw1 = 0u;
#define P7B_PREF(t) do { pw0 = a.WE[(size_t)(t) * 128 + lane]; pw1 = a.WE[(size_t)(t) * 128 + 64 + lane]; } while (0)
#define P7B_ISSUE(X, Xw, Xx, Xg, t, slot, tnext) do { LAS unsigned* tb_ = tab + (slot) * 128; \
        tb_[lane] = pw0; tb_[64 + lane] = pw1; \
        asm volatile("s_waitcnt lgkmcnt(0)" ::: "memory"); \
        _Pragma("unroll") for (int i_ = 0; i_ < 16; ++i_) { const unsigned we_ = tb_[8 * i_ + grp]; Xw[i_] = __uint_as_float(we_ << 16); X[i_] = *(const u32x4*)(vbase + (size_t)(we_ >> 16) * 512); } \
        { const int mr_ = (t) >= NL ? 32 : (t) / S; \
          Xx = *(const u32x2*)(a.XB + (size_t)(t) * 1024 + colofs); Xg = *(const f32x4*)(a.gate2 + (size_t)mr_ * 6144 + colofs); } \
        P7B_PREF(tnext); } while (0)
#define P7B_COMPUTE(X, Xw, Xx, Xg, t, valid) do { f32x2 acc2[16]; \
        _Pragma("unroll") for (int k = 0; k < 16; ++k) acc2[k] = (f32x2){0.f, 0.f}; \
        _Pragma("unroll") for (int i_ = 0; i_ < 16; ++i_) p7_axpy4(X[i_], Xw[i_], acc2); \
        float b_[16]; _Pragma("unroll") for (int k = 0; k < 16; ++k) { auto s_ = __builtin_amdgcn_permlane32_swap(__float_as_uint(acc2[k >> 1][k & 1]), __float_as_uint(acc2[(k + 16) >> 1][k & 1]), false, false); b_[k] = __uint_as_float(s_[0]) + __uint_as_float(s_[1]); } \
        float c_[8]; _Pragma("unroll") for (int k = 0; k < 8; ++k) { auto s_ = __builtin_amdgcn_permlane16_swap(__float_as_uint(b_[k]), __float_as_uint(b_[k + 8]), false, false); c_[k] = __uint_as_float(s_[0]) + __uint_as_float(s_[1]); } \
        float d_[4]; _Pragma("unroll") for (int k = 0; k < 4; ++k) { const float send_ = (lane & 8) ? c_[k] : c_[k + 4]; const float keep_ = (lane & 8) ? c_[k + 4] : c_[k]; d_[k] = keep_ + DPPF(send_, 0x128); } \
        u32x2* xp_ = (u32x2*)(a.XB + (size_t)(t) * 1024 + colofs); \
        const float x0_ = __uint_as_float(Xx.x << 16) + Xg[0] * d_[0], x1_ = __uint_as_float(Xx.x & 0xffff0000u) + Xg[1] * d_[1], x2_ = __uint_as_float(Xx.y << 16) + Xg[2] * d_[2], x3_ = __uint_as_float(Xx.y & 0xffff0000u) + Xg[3] * d_[3]; \
        u32x2 xo_; xo_.x = cvt_pk_bf16(x0_, x1_); xo_.y = cvt_pk_bf16(x2_, x3_); \
        if ((valid) && PM == 0) *xp_ = xo_; else if (PM != 0 && x0_ == 1.2345e30f) *xp_ = xo_; } while (0)
    const int lastrow = a.nrows - 1;
    int t = wrank;
    if (t < a.nrows) {
    P7B_PREF(t);
    P7B_ISSUE(Av, Aw, Ax, Ag, t, 0, (t + nw < a.nrows ? t + nw : lastrow));
    while (t < a.nrows) {
        const int t1 = t + nw, t2 = t1 + nw, t3 = t2 + nw;
        const int c1 = t1 < a.nrows ? t1 : lastrow, c2 = t2 < a.nrows ? t2 : lastrow, c3 = t3 < a.nrows ? t3 : lastrow;
        P7B_ISSUE(Bv, Bw, Bx, Bg, c1, 1, c2);
        P7B_COMPUTE(Av, Aw, Ax, Ag, t, true);
        P7B_ISSUE(Av, Aw, Ax, Ag, c2, 0, c3);
        P7B_COMPUTE(Bv, Bw, Bx, Bg, c1, (t1 < a.nrows));
        t = t2;
    }
    }
#undef P7B_PREF
#undef P7B_ISSUE
#undef P7B_COMPUTE
}
__device__ __forceinline__ void phase_final_norm(const bf16_t* __restrict__ XBp, float* __restrict__ OUT, const float* __restrict__ g, int vb, int nvb) {
    int tid_ = threadIdx.x; asm volatile("" : "+v"(tid_));
    const int lane = tid_ & 63, wid = tid_ >> 6;
    for (int row = vb * 8 + wid; row < NL; row += nvb * 8) {
        const bf16_t* xp = XBp + (size_t)row * 1024; f32x4 x[4]; float ss = 0.f;
#pragma unroll
        for (int i = 0; i < 4; ++i) { const u32x2 r = *(const u32x2*)(xp + 256 * i + 4 * lane); x[i] = (f32x4){__uint_as_float(r.x << 16), __uint_as_float(r.x & 0xffff0000u), __uint_as_float(r.y << 16), __uint_as_float(r.y & 0xffff0000u)};
            ss += x[i][0] * x[i][0] + x[i][1] * x[i][1] + x[i][2] * x[i][2] + x[i][3] * x[i][3]; }
        ss = wave_sum(ss); const float rstd = rsqrtf(ss * (1.f / 1024.f) + EPS);
#pragma unroll
        for (int i = 0; i < 4; ++i) *(f32x4*)(OUT + (size_t)row * 1024 + 256 * i + 4 * lane) = x[i] * rstd * *(const f32x4*)(g + 256 * i + 4 * lane);
    }
}

template <int V_> struct IC { static constexpr int value = V_; };
typedef short s16x4 __attribute__((ext_vector_type(4)));
__device__ __forceinline__ s16x4 lds_tr16(const LAS unsigned char* p) { return __builtin_bit_cast(s16x4, __builtin_amdgcn_ds_read_tr16_b64_v4i16((LAS s16x4*)p)); }
constexpr int ATT_BUF = 20480;
__device__ __forceinline__ void glds16(const void* g, unsigned lds_base) {
    unsigned sv; asm volatile("s_mov_b32 %0, m0\n\ts_mov_b32 m0, %2\n\ts_nop 0\n\tglobal_load_lds_dwordx4 %1, off\n\ts_mov_b32 m0, %0" : "=&s"(sv) : "v"(g), "s"(lds_base) : "memory"); }
template <int DK>
__device__ __forceinline__ void attn_unit(LAS unsigned char* lds, const bf16_t* __restrict__ Q, const bf16_t* __restrict__ K1, const bf16_t* __restrict__ K2, const bf16_t* __restrict__ V,
                                          int nkeys, float c2, bf16_t* __restrict__ out) {
    int tid_ = threadIdx.x; asm volatile("" : "+v"(tid_));
    const int tid = tid_, lane = tid & 63, wid = __builtin_amdgcn_readfirstlane(tid >> 6), r32 = lane & 31, hi = lane >> 5;
    constexpr int NS = DK / 16, NM = 2 * NS;
    bf16x8 qf[NS];
    { const bf16_t* qp = Q + (size_t)(wid * 32 + r32) * DK + 8 * hi;
#pragma unroll
      for (int s = 0; s < NS; ++s) qf[s] = *(const bf16x8*)(qp + 16 * s); }
    const int dkey = 8 * wid + (lane >> 3), dkey2 = 16 * (wid & 3) + (lane >> 2);
    const bf16_t* gk1 = K1 + (size_t)dkey * 64 + (((lane & 7) ^ ((dkey >> 1) & 7)) << 3);
    const bf16_t* gv = V + (size_t)dkey * 64 + (((lane & 7) ^ (((dkey >> 1) & 1) << 2)) << 3);
    const bf16_t* gk2 = (DK == 96) ? K2 + (size_t)dkey2 * 32 + (((lane & 3) ^ ((dkey2 >> 2) & 3)) << 3) : nullptr;
    const unsigned lds0 = (unsigned)(size_t)lds;
    const unsigned d_k1 = lds0 + wid * 1024, d_v = lds0 + 8192 + wid * 1024, d_k2 = lds0 + 16384 + (wid & 3) * 1024;
#define ATT_DMA(tile_, slot_) do { const int tt_ = (tile_); glds16(gk1 + (size_t)tt_ * 4096, (unsigned)__builtin_amdgcn_readfirstlane(d_k1 + (slot_) * ATT_BUF)); \
        glds16(gv + (size_t)tt_ * 4096, (unsigned)__builtin_amdgcn_readfirstlane(d_v + (slot_) * ATT_BUF)); \
        if (DK == 96) glds16(gk2 + (size_t)tt_ * 2048, (unsigned)__builtin_amdgcn_readfirstlane(d_k2 + (slot_) * ATT_BUF)); } while (0)
#define ATT_WAIT_BAR() do { if (DK == 96) asm volatile("s_waitcnt vmcnt(3) lgkmcnt(0)\n\ts_barrier" ::: "memory"); else asm volatile("s_waitcnt vmcnt(2) lgkmcnt(0)\n\ts_barrier" ::: "memory"); } while (0)
    unsigned ka[2][4];
#pragma unroll
    for (int kt = 0; kt < 2; ++kt)
#pragma unroll
        for (int s = 0; s < 4; ++s) { const int key = 32 * kt + r32; ka[kt][s] = key * 128 + (((2 * s + hi) ^ ((key >> 1) & 7)) << 4); }
    unsigned kb[2][2];
#pragma unroll
    for (int kt = 0; kt < 2; ++kt)
#pragma unroll
        for (int s = 0; s < 2; ++s) { const int key = 32 * kt + r32; kb[kt][s] = 16384 + key * 64 + (((2 * s + hi) ^ ((key >> 2) & 3)) << 4); }
    const int vq = (lane & 15) >> 2, vp = lane & 3, vg = (lane >> 4) & 1;
    unsigned va[2];
#pragma unroll
    for (int dvb = 0; dvb < 2; ++dvb) { const int key = 4 * hi + vq; va[dvb] = 8192 + key * 128 + ((((32 * dvb + 16 * vg + 4 * vp) * 2)) ^ (((key >> 1) & 1) << 6)); }
    float m = -1e30f, l = 0.f, mx;
    f32x16 o0 = {}, o1 = {};
    const int NT = nkeys >> 6;
    ATT_DMA(0, 0); ATT_DMA(NT > 1 ? 1 : 0, 1); ATT_DMA(NT > 2 ? 2 : NT - 1, 2);
    asm volatile("s_waitcnt vmcnt(0) lgkmcnt(0)\n\ts_barrier" ::: "memory");
    f32x16 pa0 = {}, pa1 = {}, pb0 = {}, pb1 = {};
    {
        bf16x8 kf0[NS], kf1[NS];
#pragma unroll
        for (int s = 0; s < 4; ++s) { kf0[s] = *(const LAS bf16x8*)(lds + ka[0][s]); kf1[s] = *(const LAS bf16x8*)(lds + ka[1][s]); }
        if (DK == 96) {
#pragma unroll
            for (int s = 0; s < 2; ++s) { kf0[4 + s] = *(const LAS bf16x8*)(lds + kb[0][s]); kf1[4 + s] = *(const LAS bf16x8*)(lds + kb[1][s]); }
        }
#pragma unroll
        for (int s = 0; s < NS; ++s) { pa0 = mfma32(kf0[s], qf[s], pa0); pa1 = mfma32(kf1[s], qf[s], pa1); }
        mx = pa0[0];
#pragma unroll
        for (int r = 1; r < 16; ++r) mx = fmaxf(mx, pa0[r]);
#pragma unroll
        for (int r = 0; r < 16; ++r) mx = fmaxf(mx, pa1[r]);
    }
    auto step = [&](auto bc_, auto bn_, auto bw_, f32x16& pc0, f32x16& pc1, f32x16& pn0, f32x16& pn1, int t) __attribute__((always_inline)) {
        constexpr int BC = decltype(bc_)::value * ATT_BUF, BN = decltype(bn_)::value * ATT_BUF;
        ATT_DMA((t + 3 < NT) ? t + 3 : NT - 1, decltype(bw_)::value);
        bf16x8 kf0[NS], kf1[NS];
#pragma unroll
        for (int s = 0; s < 4; ++s) { kf0[s] = *(const LAS bf16x8*)(lds + BN + ka[0][s]); kf1[s] = *(const LAS bf16x8*)(lds + BN + ka[1][s]); }
        if (DK == 96) {
#pragma unroll
            for (int s = 0; s < 2; ++s) { kf0[4 + s] = *(const LAS bf16x8*)(lds + BN + kb[0][s]); kf1[4 + s] = *(const LAS bf16x8*)(lds + BN + kb[1][s]); }
        }
        __builtin_amdgcn_sched_barrier(0);
        { auto rr = __builtin_amdgcn_permlane32_swap(__float_as_uint(mx), __float_as_uint(mx), false, false); mx = fmaxf(__uint_as_float(rr[0]), __uint_as_float(rr[1])); }
        const float tm = mx;
        if (__any(tm > m + 8.f)) {
            const float mn = fmaxf(m, tm), al = __builtin_amdgcn_exp2f(m - mn); m = mn; l *= al;
#pragma unroll
            for (int r = 0; r < 16; ++r) { o0[r] *= al; o1[r] *= al; }
        }
        const float nm = -m; float ls = 0.f;
        pn0 = f32x16{}; pn1 = f32x16{};
        unsigned pw[16];
        s16x4 vlo[2][2][2], vhi[2][2][2];
#pragma unroll
        for (int c = 0; c < 8; ++c) {
            __builtin_amdgcn_sched_barrier(0);
#pragma unroll
            for (int j = 0; j < NM; ++j) if (j >= c * NM / 8 && j < (c + 1) * NM / 8) { if (j & 1) pn1 = mfma32(kf1[j >> 1], qf[j >> 1], pn1); else pn0 = mfma32(kf0[j >> 1], qf[j >> 1], pn0); }
            if (c == 4) {
#pragma unroll
                for (int kt = 0; kt < 2; ++kt)
#pragma unroll
                    for (int sp = 0; sp < 2; ++sp) { const int kofs = (32 * kt + 16 * sp) * 128;
#pragma unroll
                        for (int dvb = 0; dvb < 2; ++dvb) { vlo[dvb][kt][sp] = lds_tr16(lds + BC + va[dvb] + kofs); vhi[dvb][kt][sp] = lds_tr16(lds + BC + va[dvb] + kofs + 8 * 128); } }
            }
            __builtin_amdgcn_sched_barrier(0);
            if (c < 4) {
#pragma unroll
                for (int i = 0; i < 4; ++i) { const int r = 4 * c + i; pc0[r] = __builtin_amdgcn_exp2f(pc0[r] + nm); ls += pc0[r]; }
                pw[2 * c] = cvt_pk_bf16(pc0[4 * c], pc0[4 * c + 1]); pw[2 * c + 1] = cvt_pk_bf16(pc0[4 * c + 2], pc0[4 * c + 3]);
            } else {
#pragma unroll
                for (int i = 0; i < 4; ++i) { const int r = 4 * (c - 4) + i; pc1[r] = __builtin_amdgcn_exp2f(pc1[r] + nm); ls += pc1[r]; }
                pw[8 + 2 * (c - 4)] = cvt_pk_bf16(pc1[4 * (c - 4)], pc1[4 * (c - 4) + 1]); pw[8 + 2 * (c - 4) + 1] = cvt_pk_bf16(pc1[4 * (c - 4) + 2], pc1[4 * (c - 4) + 3]);
            }
        }
        __builtin_amdgcn_sched_barrier(0);
        l += ls;
        float mxn = -3.0e38f;
#pragma unroll
        for (int k = 0; k < 8; ++k) { const int kt = k >> 2, sp = (k >> 1) & 1, dvb = k & 1;
            const u32x4 pq = (u32x4){pw[8 * kt + 4 * sp], pw[8 * kt + 4 * sp + 1], pw[8 * kt + 4 * sp + 2], pw[8 * kt + 4 * sp + 3]};
            const s16x4 lo = vlo[dvb][kt][sp], hi4 = vhi[dvb][kt][sp]; const bf16x8 vf = (bf16x8){lo[0], lo[1], lo[2], lo[3], hi4[0], hi4[1], hi4[2], hi4[3]};
            if (dvb == 0) o0 = mfma32(vf, __builtin_bit_cast(bf16x8, pq), o0); else o1 = mfma32(vf, __builtin_bit_cast(bf16x8, pq), o1);
            __builtin_amdgcn_sched_barrier(0);
            if (k < 4) { mxn = fmaxf(fmaxf(mxn, pn0[4 * k]), fmaxf(pn0[4 * k + 1], fmaxf(pn0[4 * k + 2], pn0[4 * k + 3]))); }
            else { mxn = fmaxf(fmaxf(mxn, pn1[4 * (k - 4)]), fmaxf(pn1[4 * (k - 4) + 1], fmaxf(pn1[4 * (k - 4) + 2], pn1[4 * (k - 4) + 3]))); }
            __builtin_amdgcn_sched_barrier(0);
        }
        mx = mxn;
        ATT_WAIT_BAR();
    };
    for (int t = 0; t < NT; t += 4) {
        step(IC<0>{}, IC<1>{}, IC<3>{}, pa0, pa1, pb0, pb1, t);
        step(IC<1>{}, IC<2>{}, IC<0>{}, pb0, pb1, pa0, pa1, t + 1);
        step(IC<2>{}, IC<3>{}, IC<1>{}, pa0, pa1, pb0, pb1, t + 2);
        step(IC<3>{}, IC<0>{}, IC<2>{}, pb0, pb1, pa0, pa1, t + 3);
    }
    { auto rr = __builtin_amdgcn_permlane32_swap(__float_as_uint(l), __float_as_uint(l), false, false); l = __uint_as_float(rr[0]) + __uint_as_float(rr[1]); }
    const float il = 1.f / l;
    bf16_t* op = out + (size_t)(wid * 32 + r32) * 1024 + 4 * hi;
#pragma unroll
    for (int g = 0; g < 4; ++g) { u32x2 a, b;
        a.x = cvt_pk_bf16(o0[4 * g] * il, o0[4 * g + 1] * il); a.y = cvt_pk_bf16(o0[4 * g + 2] * il, o0[4 * g + 3] * il);
        b.x = cvt_pk_bf16(o1[4 * g] * il, o1[4 * g + 1] * il); b.y = cvt_pk_bf16(o1[4 * g + 2] * il, o1[4 * g + 3] * il);
        *(u32x2*)(op + 8 * g) = a; *(u32x2*)(op + 32 + 8 * g) = b; }
}
#undef ATT_DMA
#undef ATT_WAIT_BAR
template <int DK>
__device__ __forceinline__ void attn_unit64(LAS unsigned char* lds, const bf16_t* __restrict__ Q, const bf16_t* __restrict__ K1, const bf16_t* __restrict__ K2, const bf16_t* __restrict__ V,
                                            int nkeys, bf16_t* __restrict__ out) {
    int tid_ = threadIdx.x; asm volatile("" : "+v"(tid_));
    const int tid = tid_, lane = tid & 63, wid = __builtin_amdgcn_readfirstlane(tid >> 6), r32 = lane & 31, hi = lane >> 5;
    constexpr int NS = DK / 16;
    bf16x8 qf[2][NS];
#pragma unroll
    for (int j = 0; j < 2; ++j) { const bf16_t* qp = Q + (size_t)(wid * 64 + 32 * j + r32) * DK + 8 * hi;
#pragma unroll
        for (int s = 0; s < NS; ++s) qf[j][s] = *(const bf16x8*)(qp + 16 * s); }
    const int dkey = 8 * wid + (lane >> 3), dkey2 = 16 * (wid & 3) + (lane >> 2);
    const bf16_t* gk1 = K1 + (size_t)dkey * 64 + (((lane & 7) ^ ((dkey >> 1) & 7)) << 3);
    const bf16_t* gv = V + (size_t)dkey * 64 + (((lane & 7) ^ (((dkey >> 1) & 1) << 2)) << 3);
    const bf16_t* gk2 = (DK == 96) ? K2 + (size_t)dkey2 * 32 + (((lane & 3) ^ ((dkey2 >> 2) & 3)) << 3) : nullptr;
    const unsigned lds0 = (unsigned)(size_t)lds;
    const unsigned d_k1 = lds0 + wid * 1024, d_v = lds0 + 8192 + wid * 1024, d_k2 = lds0 + 16384 + (wid & 3) * 1024;
#define ATT_DMA(tile_, slot_) do { const int tt_ = (tile_); glds16(gk1 + (size_t)tt_ * 4096, (unsigned)__builtin_amdgcn_readfirstlane(d_k1 + (slot_) * ATT_BUF)); \
        glds16(gv + (size_t)tt_ * 4096, (unsigned)__builtin_amdgcn_readfirstlane(d_v + (slot_) * ATT_BUF)); \
        if (DK == 96) glds16(gk2 + (size_t)tt_ * 2048, (unsigned)__builtin_amdgcn_readfirstlane(d_k2 + (slot_) * ATT_BUF)); } while (0)
    unsigned ka[4];
#pragma unroll
    for (int s = 0; s < 4; ++s) ka[s] = r32 * 128 + (((2 * s + hi) ^ ((r32 >> 1) & 7)) << 4);
    unsigned kb[2];
#pragma unroll
    for (int s = 0; s < 2; ++s) kb[s] = 16384 + r32 * 64 + (((2 * s + hi) ^ ((r32 >> 2) & 3)) << 4);
    const int vq = (lane & 15) >> 2, vp = lane & 3, vg = (lane >> 4) & 1;
    unsigned va[2];
#pragma unroll
    for (int dvb = 0; dvb < 2; ++dvb) { const int key = 4 * hi + vq; va[dvb] = 8192 + key * 128 + ((((32 * dvb + 16 * vg + 4 * vp) * 2)) ^ (((key >> 1) & 1) << 6)); }
    float m[2] = {-1e30f, -1e30f}, l[2] = {0.f, 0.f};
    f32x16 o[2][2] = {};
    const int NT = nkeys >> 6;
    ATT_DMA(0, 0); ATT_DMA(1, 1); ATT_DMA(2, 2);
    asm volatile("s_waitcnt vmcnt(0) lgkmcnt(0)\n\ts_barrier" ::: "memory");
    bf16x8 kf0[NS], kf1[NS];
#pragma unroll
    for (int s = 0; s < 4; ++s) { kf0[s] = *(const LAS bf16x8*)(lds + ka[s]); kf1[s] = *(const LAS bf16x8*)(lds + 4096 + ka[s]); }
    auto step = [&](auto cur_, auto wsl_, int t) __attribute__((always_inline)) {
        constexpr int BC = decltype(cur_)::value * ATT_BUF, BNX = ((decltype(cur_)::value + 1) & 3) * ATT_BUF;
        ATT_DMA((t + 3 < NT) ? t + 3 : NT - 1, decltype(wsl_)::value);
        unsigned pw[2][16];
        s16x4 vlo[2][2], vhi[2][2];
#define ATT64_VLOAD(kt_) do { _Pragma("unroll") for (int sp = 0; sp < 2; ++sp) { const int kofs = (32 * (kt_) + 16 * sp) * 128; \
            _Pragma("unroll") for (int dvb = 0; dvb < 2; ++dvb) { vlo[dvb][sp] = lds_tr16(lds + BC + va[dvb] + kofs); vhi[dvb][sp] = lds_tr16(lds + BC + va[dvb] + kofs + 8 * 128); } } } while (0)
#define ATT64_PV(kt_) do { _Pragma("unroll") for (int sp = 0; sp < 2; ++sp) _Pragma("unroll") for (int dvb = 0; dvb < 2; ++dvb) { \
            const s16x4 lo = vlo[dvb][sp], hi4 = vhi[dvb][sp]; const bf16x8 vf = (bf16x8){lo[0], lo[1], lo[2], lo[3], hi4[0], hi4[1], hi4[2], hi4[3]}; \
            _Pragma("unroll") for (int j = 0; j < 2; ++j) { const u32x4 pq = (u32x4){pw[j][8 * (kt_) + 4 * sp], pw[j][8 * (kt_) + 4 * sp + 1], pw[j][8 * (kt_) + 4 * sp + 2], pw[j][8 * (kt_) + 4 * sp + 3]}; \
                o[j][dvb] = mfma32(vf, __builtin_bit_cast(bf16x8, pq), o[j][dvb]); } } } while (0)
#pragma unroll
        for (int j = 0; j < 2; ++j) {
            f32x16 p0 = {}, p1 = {};
#pragma unroll
            for (int s = 0; s < NS; ++s) { p0 = mfma32(kf0[s], qf[j][s], p0); p1 = mfma32(kf1[s], qf[j][s], p1); }
            if (j == 1) { __builtin_amdgcn_sched_barrier(0); ATT64_VLOAD(0); __builtin_amdgcn_sched_barrier(0); }
            float mx = p0[0];
#pragma unroll
            for (int r = 1; r < 16; ++r) mx = fmaxf(mx, p0[r]);
#pragma unroll
            for (int r = 0; r < 16; ++r) mx = fmaxf(mx, p1[r]);
            { auto rr = __builtin_amdgcn_permlane32_swap(__float_as_uint(mx), __float_as_uint(mx), false, false); mx = fmaxf(__uint_as_float(rr[0]), __uint_as_float(rr[1])); }
            if (__any(mx > m[j] + 8.f)) {
                const float mn = fmaxf(m[j], mx), al = __builtin_amdgcn_exp2f(m[j] - mn); m[j] = mn; l[j] *= al;
#pragma unroll
                for (int r = 0; r < 16; ++r) { o[j][0][r] *= al; o[j][1][r] *= al; }
            }
            const float nm = -m[j];
#pragma unroll
            for (int r = 0; r < 16; ++r) { p0[r] = __builtin_amdgcn_exp2f(p0[r] + nm); p1[r] = __builtin_amdgcn_exp2f(p1[r] + nm); }
            f32x2 ls2 = {0.f, 0.f};
#pragma unroll
            for (int r = 0; r < 16; r += 2) { ls2 += (f32x2){p0[r], p0[r + 1]}; ls2 += (f32x2){p1[r], p1[r + 1]}; }
            l[j] += ls2.x + ls2.y;
#pragma unroll
            for (int i = 0; i < 8; ++i) { pw[j][i] = cvt_pk_bf16(p0[2 * i], p0[2 * i + 1]); pw[j][8 + i] = cvt_pk_bf16(p1[2 * i], p1[2 * i + 1]); }
            __builtin_amdgcn_sched_barrier(0);
        }
        ATT64_PV(0);
        __builtin_amdgcn_sched_barrier(0);
        ATT64_VLOAD(1);
        __builtin_amdgcn_sched_barrier(0);
        ATT64_PV(1);
#undef ATT64_VLOAD
#undef ATT64_PV
        __builtin_amdgcn_sched_barrier(0);
#pragma unroll
        for (int s = 0; s < 4; ++s) { kf0[s] = *(const LAS bf16x8*)(lds + BNX + ka[s]); kf1[s] = *(const LAS bf16x8*)(lds + BNX + 4096 + ka[s]); }
        asm volatile("s_waitcnt vmcnt(2) lgkmcnt(0)\n\ts_barrier" ::: "memory");
    };
    for (int t = 0; t < NT; t += 4) {
        step(IC<0>{}, IC<3>{}, t); step(IC<1>{}, IC<0>{}, t + 1); step(IC<2>{}, IC<1>{}, t + 2); step(IC<3>{}, IC<2>{}, t + 3);
    }
#pragma unroll
    for (int j = 0; j < 2; ++j) {
        float lj = l[j]; { auto rr = __builtin_amdgcn_permlane32_swap(__float_as_uint(lj), __float_as_uint(lj), false, false); lj = __uint_as_float(rr[0]) + __uint_as_float(rr[1]); }
        const float il = 1.f / lj;
        bf16_t* op = out + (size_t)(wid * 64 + 32 * j + r32) * 1024 + 4 * hi;
#pragma unroll
        for (int g = 0; g < 4; ++g) { u32x2 a, b;
            a.x = cvt_pk_bf16(o[j][0][4 * g] * il, o[j][0][4 * g + 1] * il); a.y = cvt_pk_bf16(o[j][0][4 * g + 2] * il, o[j][0][4 * g + 3] * il);
            b.x = cvt_pk_bf16(o[j][1][4 * g] * il, o[j][1][4 * g + 1] * il); b.y = cvt_pk_bf16(o[j][1][4 * g + 2] * il, o[j][1][4 * g + 3] * il);
            *(u32x2*)(op + 8 * g) = a; *(u32x2*)(op + 32 + 8 * g) = b; }
    }
#undef ATT_DMA
}
__device__ __forceinline__ void glds16s(const void* base, unsigned voff, unsigned lds_base) {
    unsigned sv; asm volatile("s_mov_b32 %0, m0\n\ts_mov_b32 m0, %3\n\ts_nop 0\n\tglobal_load_lds_dwordx4 %1, %2\n\ts_mov_b32 m0, %0" : "=&s"(sv) : "v"(voff), "s"(base), "s"(lds_base) : "memory"); }
__device__ __forceinline__ void attn_unit64m(LAS unsigned char* lds, const bf16_t* __restrict__ Q, const bf16_t* __restrict__ K1, const bf16_t* __restrict__ K2, const bf16_t* __restrict__ V,
                                            int nkeys, bf16_t* __restrict__ out) {
    constexpr int DK = 96;
    int tid_ = threadIdx.x; asm volatile("" : "+v"(tid_));
    const int tid = tid_, lane = tid & 63, wid = __builtin_amdgcn_readfirstlane(tid >> 6), r32 = lane & 31, hi = lane >> 5;
    bf16x8 qf[2][4];
    LAS unsigned char* qrl = lds + 4 * ATT_BUF + wid * 4096 + lane * 16;
#pragma unroll
    for (int j = 0; j < 2; ++j) { const bf16_t* qp = Q + (size_t)(wid * 64 + 32 * j + r32) * DK + 8 * hi;
#pragma unroll
        for (int s = 0; s < 4; ++s) qf[j][s] = *(const bf16x8*)(qp + 16 * s);
#pragma unroll
        for (int s = 0; s < 2; ++s) *(LAS bf16x8*)(qrl + (2 * j + s) * 1024) = *(const bf16x8*)(qp + 64 + 16 * s); }
    const int dkey = 8 * wid + (lane >> 3), dkey2 = 16 * (wid & 3) + (lane >> 2);
    const unsigned ok1 = (unsigned)(dkey * 64 + (((lane & 7) ^ ((dkey >> 1) & 7)) << 3)) * 2u, ov = (unsigned)(dkey * 64 + (((lane & 7) ^ (((dkey >> 1) & 1) << 2)) << 3)) * 2u,
                   ok2 = (unsigned)(dkey2 * 32 + (((lane & 3) ^ ((dkey2 >> 2) & 3)) << 3)) * 2u;
    const unsigned lds0 = (unsigned)(size_t)lds;
    const unsigned d_k1 = lds0 + wid * 1024, d_v = lds0 + 8192 + wid * 1024, d_k2 = lds0 + 16384 + (wid & 3) * 1024;
#define ATT_DMA(tile_, slot_) do { const int tt_ = (tile_); glds16s((const char*)K1 + (size_t)tt_ * 8192, ok1, (unsigned)__builtin_amdgcn_readfirstlane(d_k1 + (slot_) * ATT_BUF)); \
        glds16s((const char*)V + (size_t)tt_ * 8192, ov, (unsigned)__builtin_amdgcn_readfirstlane(d_v + (slot_) * ATT_BUF)); \
        glds16s((const char*)K2 + (size_t)tt_ * 4096, ok2, (unsigned)__builtin_amdgcn_readfirstlane(d_k2 + (slot_) * ATT_BUF)); } while (0)
    const unsigned ka0_ = r32 * 128 + ((hi ^ ((r32 >> 1) & 7)) << 4), kb0_ = 16384 + r32 * 64 + ((hi ^ ((r32 >> 2) & 3)) << 4);
#define ka(s_) (kao_ ^ ((unsigned)(s_) << 5))
#define kb(s_) (kbo_ ^ ((unsigned)(s_) << 5))
    const int vq = (lane & 15) >> 2, vp = lane & 3, vg = (lane >> 4) & 1;
    const unsigned va0_ = 8192 + (4 * hi + vq) * 128 + ((((16 * vg + 4 * vp) * 2)) ^ ((((4 * hi + vq) >> 1) & 1) << 6));
    float m[2] = {0.f, 0.f}, l[2] = {0.f, 0.f};
    f32x16 o[2][2] = {};
    const int NT = nkeys >> 6;
    ATT_DMA(0, 0); ATT_DMA(1, 1); ATT_DMA(2, 2);
    asm volatile("s_waitcnt vmcnt(0) lgkmcnt(0)\n\ts_barrier" ::: "memory");
    auto step = [&](auto cur_, auto wsl_, int t) __attribute__((always_inline)) {
        constexpr int BC = decltype(cur_)::value * ATT_BUF;
        unsigned kao_ = ka0_, kbo_ = kb0_, vao_ = va0_; asm volatile("" : "+v"(kao_), "+v"(kbo_), "+v"(vao_));
        const unsigned va[2] = {vao_, vao_ ^ 64u};
        ATT_DMA((t + 3 < NT) ? t + 3 : NT - 1, decltype(wsl_)::value);
        f32x16 pj[2][2];
#pragma unroll
        for (int j = 0; j < 2; ++j) { pj[j][0] = f32x16{}; pj[j][1] = f32x16{}; }
        {
            bf16x8 ka0[2], ka1[2], kb0[2], kb1[2];
#pragma unroll
            for (int s = 0; s < 2; ++s) { ka0[s] = *(const LAS bf16x8*)(lds + BC + ka(s)); ka1[s] = *(const LAS bf16x8*)(lds + BC + 4096 + ka(s)); }
#pragma unroll
            for (int s = 0; s < 2; ++s) { kb0[s] = *(const LAS bf16x8*)(lds + BC + ka(2 + s)); kb1[s] = *(const LAS bf16x8*)(lds + BC + 4096 + ka(2 + s)); }
            __builtin_amdgcn_sched_barrier(0);
#pragma unroll
            for (int s = 0; s < 2; ++s)
#pragma unroll
                for (int j = 0; j < 2; ++j) { pj[j][0] = mfma32(ka0[s], qf[j][s], pj[j][0]); pj[j][1] = mfma32(ka1[s], qf[j][s], pj[j][1]); }
            __builtin_amdgcn_sched_barrier(0);
            bf16x8 qr[2][2];
#pragma unroll
            for (int s = 0; s < 2; ++s) { ka0[s] = *(const LAS bf16x8*)(lds + BC + kb(s)); ka1[s] = *(const LAS bf16x8*)(lds + BC + 2048 + kb(s)); }
            __builtin_amdgcn_sched_barrier(0);
#pragma unroll
            for (int s = 0; s < 2; ++s)
#pragma unroll
                for (int j = 0; j < 2; ++j) { pj[j][0] = mfma32(kb0[s], qf[j][2 + s], pj[j][0]); pj[j][1] = mfma32(kb1[s], qf[j][2 + s], pj[j][1]); }
            __builtin_amdgcn_sched_barrier(0);
#pragma unroll
            for (int j = 0; j < 2; ++j)
#pragma unroll
                for (int s = 0; s < 2; ++s) qr[j][s] = *(const LAS bf16x8*)(qrl + (2 * j + s) * 1024);
            __builtin_amdgcn_sched_barrier(0);
#pragma unroll
            for (int s = 0; s < 2; ++s)
#pragma unroll
                for (int j = 0; j < 2; ++j) { pj[j][0] = mfma32(ka0[s], qr[j][s], pj[j][0]); pj[j][1] = mfma32(ka1[s], qr[j][s], pj[j][1]); }
            __builtin_amdgcn_sched_barrier(0);
        }
        unsigned pw[2][16];
        s16x4 vlo[2][2], vhi[2][2];
#define ATT64_VLOAD(kt_) do { _Pragma("unroll") for (int sp = 0; sp < 2; ++sp) { const int kofs = (32 * (kt_) + 16 * sp) * 128; \
            _Pragma("unroll") for (int dvb = 0; dvb < 2; ++dvb) { vlo[dvb][sp] = lds_tr16(lds + BC + va[dvb] + kofs); vhi[dvb][sp] = lds_tr16(lds + BC + va[dvb] + kofs + 8 * 128); } } } while (0)
#define ATT64_PV(kt_) do { _Pragma("unroll") for (int sp = 0; sp < 2; ++sp) _Pragma("unroll") for (int dvb = 0; dvb < 2; ++dvb) { \
            const s16x4 lo = vlo[dvb][sp], hi4 = vhi[dvb][sp]; const bf16x8 vf = (bf16x8){lo[0], lo[1], lo[2], lo[3], hi4[0], hi4[1], hi4[2], hi4[3]}; \
            _Pragma("unroll") for (int j = 0; j < 2; ++j) { const u32x4 pq = (u32x4){pw[j][8 * (kt_) + 4 * sp], pw[j][8 * (kt_) + 4 * sp + 1], pw[j][8 * (kt_) + 4 * sp + 2], pw[j][8 * (kt_) + 4 * sp + 3]}; \
                o[j][dvb] = mfma32(vf, __builtin_bit_cast(bf16x8, pq), o[j][dvb]); } } } while (0)
#pragma unroll
        for (int j = 0; j < 2; ++j) {
            f32x16 p0 = pj[j][0], p1 = pj[j][1];
            if (j == 1) { __builtin_amdgcn_sched_barrier(0); ATT64_VLOAD(0); __builtin_amdgcn_sched_barrier(0); }
            float mx = p0[0];
#pragma unroll
            for (int r = 1; r < 16; ++r) mx = fmaxf(mx, p0[r]);
#pragma unroll
            for (int r = 0; r < 16; ++r) mx = fmaxf(mx, p1[r]);
            { auto rr = __builtin_amdgcn_permlane32_swap(__float_as_uint(mx), __float_as_uint(mx), false, false); mx = fmaxf(__uint_as_float(rr[0]), __uint_as_float(rr[1])); }
            if (t == 0) m[j] = fabsf(mx) > 32.f ? mx : 0.f;
            else if (__any(mx > m[j] + 60.f)) {
                const float mn = fmaxf(m[j], mx), al = __builtin_amdgcn_exp2f(m[j] - mn); m[j] = mn; l[j] *= al;
#pragma unroll
                for (int r = 0; r < 16; ++r) { o[j][0][r] *= al; o[j][1][r] *= al; }
            }
            if (__all(m[j] == 0.f)) {
#pragma unroll
                for (int r = 0; r < 16; ++r) { p0[r] = __builtin_amdgcn_exp2f(p0[r]); p1[r] = __builtin_amdgcn_exp2f(p1[r]); }
            } else { const float nm = -m[j];
#pragma unroll
                for (int r = 0; r < 16; ++r) { p0[r] = __builtin_amdgcn_exp2f(p0[r] + nm); p1[r] = __builtin_amdgcn_exp2f(p1[r] + nm); }
            }
            f32x2 ls2 = {0.f, 0.f};
#pragma unroll
            for (int r = 0; r < 16; r += 2) { ls2 += (f32x2){p0[r], p0[r + 1]}; ls2 += (f32x2){p1[r], p1[r + 1]}; }
            l[j] += ls2.x + ls2.y;
#pragma unroll
            for (int i = 0; i < 8; ++i) { pw[j][i] = cvt_pk_bf16(p0[2 * i], p0[2 * i + 1]); pw[j][8 + i] = cvt_pk_bf16(p1[2 * i], p1[2 * i + 1]); }
            __builtin_amdgcn_sched_barrier(0);
        }
        ATT64_PV(0);
        __builtin_amdgcn_sched_barrier(0);
        ATT64_VLOAD(1);
        __builtin_amdgcn_sched_barrier(0);
        ATT64_PV(1);
#undef ATT64_VLOAD
#undef ATT64_PV
        if (DK == 96) asm volatile("s_waitcnt vmcnt(6) lgkmcnt(0)\n\ts_barrier" ::: "memory"); else asm volatile("s_waitcnt vmcnt(4) lgkmcnt(0)\n\ts_barrier" ::: "memory");
    };
    for (int t = 0; t < NT; t += 4) {
        step(IC<0>{}, IC<3>{}, t); step(IC<1>{}, IC<0>{}, t + 1); step(IC<2>{}, IC<1>{}, t + 2); step(IC<3>{}, IC<2>{}, t + 3);
    }
#pragma unroll
    for (int j = 0; j < 2; ++j) {
        float lj = l[j]; { auto rr = __builtin_amdgcn_permlane32_swap(__float_as_uint(lj), __float_as_uint(lj), false, false); lj = __uint_as_float(rr[0]) + __uint_as_float(rr[1]); }
        const float il = 1.f / lj;
        bf16_t* op = out + (size_t)(wid * 64 + 32 * j + r32) * 1024 + 4 * hi;
#pragma unroll
        for (int g = 0; g < 4; ++g) { u32x2 a, b;
            a.x = cvt_pk_bf16(o[j][0][4 * g] * il, o[j][0][4 * g + 1] * il); a.y = cvt_pk_bf16(o[j][0][4 * g + 2] * il, o[j][0][4 * g + 3] * il);
            b.x = cvt_pk_bf16(o[j][1][4 * g] * il, o[j][1][4 * g + 1] * il); b.y = cvt_pk_bf16(o[j][1][4 * g + 2] * il, o[j][1][4 * g + 3] * il);
            *(u32x2*)(op + 8 * g) = a; *(u32x2*)(op + 32 + 8 * g) = b; }
    }
#undef ATT_DMA
#undef ka
#undef kb
}
__device__ __forceinline__ void phase_p3(LAS unsigned char* lds, const WS& w, int l, int vb, int nvb, int xpart, int xrank) {
    const float c2g = 0.125f * 1.4426950408889634f, c2m = 0.10206207261596577f * 1.4426950408889634f;
    bf16_t* MIX = w.H();
    const int nlat = NB * 12 * 4, nctx = (l == 0) ? NB * 12 : 0;
    const bool xl = (nvb == 256);
    for (int u = vb; u < nlat + nctx; u += nvb) {
        if (u < nlat) {
            const bool mla = u >= nlat / 2; const int v = mla ? u - nlat / 2 : u;
            int qb, hh, b;
            if (xl) { const int grp = (v >> 8) * 64 + 8 * xpart + (xrank >> 2); qb = xrank & 3; hh = grp % 6; b = grp / 6; }
            else { qb = v & 3; hh = (v >> 2) % 6; b = v / 24; }
            bf16_t* out = MIX + ((size_t)b * S + qb * 512) * 1024;
            if (!mla) attn_unit64<64>(lds, w.Qg() + (((size_t)b * 6 + hh) * S + qb * 512) * 64, w.Kg() + ((size_t)b * 2 + hh / 3) * KEYS * 64, nullptr, w.Vg() + ((size_t)b * 2 + hh / 3) * KEYS * 64, KEYS, out + hh * 64);
            else attn_unit64m(lds, w.Qm() + (((size_t)b * 6 + hh) * S + qb * 512) * 96, w.Kmn() + ((size_t)b * 6 + hh) * KEYS * 64, w.KR() + (size_t)b * KEYS * 32, w.Vm() + ((size_t)b * 6 + hh) * KEYS * 64, KEYS, out + 640 + hh * 64);
        } else {
            const int v = u - nlat, slot = v % 12, b = v / 12;
            bf16_t* out = MIX + ((size_t)NL + (size_t)b * CTX) * 1024;
            if (slot < 6) attn_unit<64>(lds, w.Qgc() + ((size_t)b * 6 + slot) * CTX * 64, w.Kg() + ((size_t)b * 2 + slot / 3) * KEYS * 64, nullptr, w.Vg() + ((size_t)b * 2 + slot / 3) * KEYS * 64, CTX, c2g, out + slot * 64);
            else { const int h = slot - 6; attn_unit<96>(lds, w.Qmc() + ((size_t)b * 6 + h) * CTX * 96, w.Kmn() + ((size_t)b * 6 + h) * KEYS * 64, w.KR() + (size_t)b * KEYS * 32, w.Vm() + ((size_t)b * 6 + h) * KEYS * 64, CTX, c2m, out + 640 + h * 64); }
        }
    }
}

__device__ __forceinline__ unsigned fkey(float f, unsigned tag, unsigned mask) { return (__float_as_uint(f) & ~mask) | tag; }
__device__ __forceinline__ float keyf(unsigned k, unsigned mask) { return __uint_as_float(k & ~mask); }
__device__ __forceinline__ unsigned fmax_u(unsigned a, unsigned b) { unsigned r; asm("v_max_f32 %0, %1, %2" : "=v"(r) : "v"(a), "v"(b)); return r; }
__device__ __forceinline__ unsigned fmin_u(unsigned a, unsigned b) { unsigned r; asm("v_min_f32 %0, %1, %2" : "=v"(r) : "v"(a), "v"(b)); return r; }
__device__ __forceinline__ void ce_desc(unsigned& a, unsigned& b) { const unsigned hi_ = fmax_u(a, b), lo_ = fmin_u(a, b); a = hi_; b = lo_; }
template <int J> __device__ __forceinline__ void bstage16(unsigned* a) {
#pragma unroll
    for (int i = 0; i < 16; ++i) { const int l = i ^ J; if (l > i) ce_desc(a[i], a[l]); }
}
__device__ __forceinline__ void sort16_desc(unsigned* a) {
#define CE_(i, j) ce_desc(a[i], a[j]);
    CE_(0, 13) CE_(1, 12) CE_(2, 15) CE_(3, 14) CE_(4, 8) CE_(5, 6) CE_(7, 11) CE_(9, 10)
    CE_(0, 5) CE_(1, 7) CE_(2, 9) CE_(3, 4) CE_(6, 13) CE_(8, 14) CE_(10, 15) CE_(11, 12)
    CE_(0, 1) CE_(2, 3) CE_(4, 5) CE_(6, 8) CE_(7, 9) CE_(10, 11) CE_(12, 13) CE_(14, 15)
    CE_(0, 2) CE_(1, 3) CE_(4, 10) CE_(5, 11) CE_(6, 7) CE_(8, 9) CE_(12, 14) CE_(13, 15)
    CE_(1, 2) CE_(3, 12) CE_(4, 6) CE_(5, 7) CE_(8, 10) CE_(9, 11) CE_(13, 14)
    CE_(1, 4) CE_(2, 6) CE_(5, 8) CE_(7, 10) CE_(9, 13) CE_(11, 14)
    CE_(2, 4) CE_(3, 6) CE_(9, 12) CE_(11, 13)
    CE_(3, 5) CE_(6, 8) CE_(7, 9) CE_(10, 12)
    CE_(3, 4) CE_(5, 6) CE_(7, 8) CE_(9, 10) CE_(11, 12)
    CE_(6, 7) CE_(8, 9)
#undef CE_
}
__device__ __forceinline__ void bmerge16_desc(unsigned* c) { bstage16<8>(c); bstage16<4>(c); bstage16<2>(c); bstage16<1>(c); }
__device__ __forceinline__ void merge_top16(unsigned* a, const unsigned* b) {
#pragma unroll
    for (int i = 0; i < 16; ++i) a[i] = fmax_u(a[i], b[15 - i]);
    bmerge16_desc(a);
}
__device__ __forceinline__ void xlane_top16(unsigned* t, int hi) {
    unsigned r[16]; const unsigned msk = 0u - (unsigned)hi;
#pragma unroll
    for (int i = 0; i < 16; ++i) r[i] = t[i] ^ ((t[i] ^ t[15 - i]) & msk);
#pragma unroll
    for (int i = 0; i < 16; ++i) { auto s = __builtin_amdgcn_permlane32_swap(r[i], r[i], false, false); t[i] = fmax_u(s[0], s[1]); }
    bmerge16_desc(t);
}
__device__ __forceinline__ constexpr int cand_a(int c) { return c < 16 ? 0 : c < 24 ? 1 : c < 32 ? 39 - c : c < 37 ? 2 : c < 41 ? 3 : c < 44 ? 4 : c < 46 ? 5 : c < 48 ? 6 : 7; }
__device__ __forceinline__ constexpr int cand_b(int c) { return c < 16 ? c : c < 24 ? c - 16 : c < 32 ? 0 : c < 37 ? c - 32 : c < 41 ? c - 37 : c < 44 ? c - 41 : c < 46 ? c - 44 : c < 48 ? c - 46 : c - 48; }

__device__ __forceinline__ void phase_p6b(LAS unsigned char* lds, const bf16_t* __restrict__ PQ, const bf16_t* __restrict__ SubKl, unsigned* __restrict__ EG, int nrows, int vb, int nvb) {
    int tid_ = threadIdx.x; asm volatile("" : "+v"(tid_));
    const int tid = tid_, lane = tid & 63, wid = __builtin_amdgcn_readfirstlane(tid >> 6), r32 = lane & 31, hi = lane >> 5;
    const int h = vb & 7, wrank = (vb >> 3) * 8 + wid, nwr = (nvb >> 3) * 8;
    LAS unsigned short* tab = (LAS unsigned short*)(lds + 65536 + wid * 4096) + r32 * 64;
#pragma unroll
    for (int i = 0; i < 8; ++i) { const int idx = i * 512 + tid, p = idx >> 11, key = (idx >> 4) & 127, ch = idx & 15;
        *(LAS u32x4*)(lds + p * 32768 + key * 256 + ((ch ^ (key & 15)) << 4)) = *(const u32x4*)(SubKl + ((size_t)(h * 2 + p) * 128 + key) * 128 + ch * 8); }
    __syncthreads();
    const int ngroups = nrows >> 5;
    for (int tg = wrank; tg < ngroups; tg += nwr) {
        const int row0 = tg << 5;
        bf16x8 qf[2][8];
        { const bf16_t* qp = PQ + (size_t)(row0 + r32) * 2048 + h * 256 + 8 * hi; asm volatile("" : "+v"(qp));
#pragma unroll
          for (int p = 0; p < 2; ++p)
#pragma unroll
              for (int s = 0; s < 8; ++s) qf[p][s] = *(const bf16x8*)(qp + p * 128 + 16 * s); }
        unsigned top[2][16];
#pragma unroll
        for (int p = 0; p < 2; ++p) {
            f32x16 acc[4];
#pragma unroll
            for (int kt = 0; kt < 4; ++kt) { acc[kt] = f32x16{}; const int key = 32 * kt + r32;
#pragma unroll
                for (int s = 0; s < 8; ++s) acc[kt] = mfma32(*(const LAS bf16x8*)(lds + p * 32768 + key * 256 + (((2 * s + hi) ^ (key & 15)) << 4)), qf[p][s], acc[kt]); }
            unsigned key[64];
#pragma unroll
            for (int kt = 0; kt < 4; ++kt)
#pragma unroll
                for (int r = 0; r < 16; ++r) { const int n = 32 * kt + (r & 3) + 8 * (r >> 2) + 4 * hi; key[16 * kt + r] = fkey(acc[kt][r], 127u - (unsigned)n, 127u); }
            sort16_desc(key); sort16_desc(key + 16); sort16_desc(key + 32); sort16_desc(key + 48);
            merge_top16(key, key + 16); merge_top16(key + 32, key + 48); merge_top16(key, key + 32);
            xlane_top16(key, hi);
#pragma unroll
            for (int i = 0; i < 16; ++i) top[p][i] = key[i];
        }
        float t0f[16], t1f[16];
#pragma unroll
        for (int i = 0; i < 16; ++i) { t0f[i] = keyf(top[0][i], 127u); t1f[i] = keyf(top[1][i], 127u); }
        unsigned ck[50];
#pragma unroll
        for (int c = 0; c < 50; ++c) ck[c] = fkey(t0f[cand_a(c)] + t1f[cand_b(c)], (unsigned)c, 63u);
        if (hi == 0) {
#pragma unroll
            for (int c = 0; c < 50; c += 2) {
                const unsigned ea = (127u - (top[0][cand_a(c)] & 127u)) * 128u + (127u - (top[1][cand_b(c)] & 127u));
                const unsigned eb = (127u - (top[0][cand_a(c + 1)] & 127u)) * 128u + (127u - (top[1][cand_b(c + 1)] & 127u));
                *(LAS unsigned*)(tab + c) = ea | (eb << 16);
            }
        }
        bmerge16_desc(ck + 16); sort16_desc(ck + 32);
        merge_top16(ck, ck + 16); merge_top16(ck, ck + 32);
        ck[15] = fmax_u(ck[15], ck[48]); ck[14] = fmax_u(ck[14], ck[49]); bmerge16_desc(ck);
        asm volatile("s_waitcnt lgkmcnt(0)" ::: "memory");
        const float mx = keyf(ck[0], 63u); float e[16], den = 0.f;
#pragma unroll
        for (int j = 0; j < 16; ++j) { e[j] = __builtin_amdgcn_exp2f((keyf(ck[j], 63u) - mx) * 1.4426950408889634f); den += e[j]; }
        const float iden = 1.f / den;
        if (hi == 0) {
            unsigned o[16];
#pragma unroll
            for (int j = 0; j < 16; ++j) { const unsigned eid = tab[ck[j] & 63u]; o[j] = (eid << 16) | (cvt_pk_bf16(e[j] * iden, 0.f) & 0xffffu); }
            unsigned* dst = EG + (size_t)(row0 + r32) * 128 + h * 16;
#pragma unroll
            for (int j = 0; j < 16; j += 4) *(u32x4*)(dst + j) = (u32x4){o[j], o[j + 1], o[j + 2], o[j + 3]};
        }
        asm volatile("s_waitcnt lgkmcnt(0)" ::: "memory");
    }
}


#define XB_TMO      128
#define XB_XCNT(j)  (256  + 64 * (j))
#define XB_XSUB(j)  (1280 + 64 * (j))
#define XB_XGEN(j)  (2304 + 64 * (j))
#define XB_TOP      3328
#define XB_TOPGEN   3392
#define XCD_BAR_WORDS 3456
#define XB_SPIN_CAP (1u << 18)

__device__ __forceinline__ unsigned xb_ld(unsigned* p)              { return __hip_atomic_load(p, __ATOMIC_RELAXED, __HIP_MEMORY_SCOPE_AGENT); }
__device__ __forceinline__ unsigned xb_add(unsigned* p, unsigned v) { return __hip_atomic_fetch_add(p, v, __ATOMIC_RELAXED, __HIP_MEMORY_SCOPE_AGENT); }
__device__ __forceinline__ unsigned xb_xcc_id() { return (unsigned)__builtin_amdgcn_s_getreg((3 << 11) | 20) & 0xFu; }
#define XB_SPIN(cond, bar) do { unsigned _sp = 0; while (cond) { __builtin_amdgcn_s_sleep(1); \
    if ((++_sp & 255u) == 0u) { if (xb_ld(&(bar)[XB_TMO])) break; if (_sp > XB_SPIN_CAP) { atomicAdd(&(bar)[XB_TMO], 1u); break; } } } } while (0)

struct XcdBarrier {
    unsigned* bar; unsigned x;
    volatile LAS unsigned* st;
};

__device__ __forceinline__ XcdBarrier xcd_barrier_post(unsigned* bar, volatile LAS unsigned* st) {
    XcdBarrier b; b.bar = bar; b.x = xb_xcc_id(); b.st = st;
    if (threadIdx.x == 0) (void)xb_add(&bar[XB_XCNT(b.x)], 1u);
    return b;
}
__device__ __forceinline__ void xcd_barrier_complete(unsigned* bar, unsigned x, unsigned& nloc, unsigned& nx) {
    const unsigned G = gridDim.x * gridDim.y * gridDim.z;
    unsigned sum, cnt, mine, sp = 0u;
    for (;;) {
        sum = 0u; cnt = 0u; mine = 0u;
#pragma unroll
        for (unsigned j = 0; j < 16; ++j) { const unsigned c = xb_ld(&bar[XB_XCNT(j)]); sum += c; cnt += (c > 0u) ? 1u : 0u; mine = (j == x) ? c : mine; }
        if (sum == G) break;
        __builtin_amdgcn_s_sleep(1);
        if ((++sp & 255u) == 0u) { if (xb_ld(&bar[XB_TMO])) break; if (sp > XB_SPIN_CAP) { atomicAdd(&bar[XB_TMO], 1u); break; } }
    }
    nloc = mine > 0u ? mine : 1u; nx = cnt > 0u ? cnt : 1u;
}

__device__ __forceinline__ void xcd_barrier(const XcdBarrier& b) {
    asm volatile("s_waitcnt vmcnt(0)" ::: "memory");
    __syncthreads();
    if (threadIdx.x == 0) {
        unsigned* bar = b.bar;
        __builtin_amdgcn_s_waitcnt(0);
        unsigned nloc = b.st[0], nx = b.st[1];
        if (nloc == 0u) { xcd_barrier_complete(bar, b.x, nloc, nx); b.st[0] = nloc; b.st[1] = nx; }
        const unsigned old = xb_add(&bar[XB_XSUB(b.x)], 1u);
        const unsigned gen = old / nloc;
        if (old + 1u == (gen + 1u) * nloc) {
            __builtin_amdgcn_fence(__ATOMIC_RELEASE, "agent");
            asm volatile("s_waitcnt vmcnt(0)" ::: "memory");
            const unsigned og = xb_add(&bar[XB_TOP], 1u);
            const unsigned tg = og / nx;
            if (og + 1u == (tg + 1u) * nx) xb_add(&bar[XB_TOPGEN], 1u);
            else XB_SPIN(xb_ld(&bar[XB_TOPGEN]) == tg, bar);
            __builtin_amdgcn_fence(__ATOMIC_ACQUIRE, "agent");
            xb_add(&bar[XB_XGEN(b.x)], 1u);
            asm volatile("s_waitcnt vmcnt(0)" ::: "memory");
        } else {
            XB_SPIN(xb_ld(&bar[XB_XGEN(b.x)]) == gen, bar);
            __builtin_amdgcn_fence(__ATOMIC_ACQUIRE, "agent");
            asm volatile("s_waitcnt vmcnt(0)" ::: "memory");
        }
    }
    __syncthreads();
}

__device__ __forceinline__ void phase_mod(LAS unsigned char* lds, const Inputs& in, const WS& w, int vb) {
    if (vb >= 72) return;
    LAS float* sc = (LAS float*)lds;
    int tid_ = threadIdx.x; asm volatile("" : "+v"(tid_));
    const int tid = tid_, idx = vb * 512 + tid, rg = idx / 12288, ln = idx % 12288, l = ln / 6144, n = ln % 6144;
    float acc[11];
#pragma unroll
    for (int i = 0; i < 11; ++i) acc[i] = 0.f;
    const float* wp = in.ada_w + (size_t)l * 1024 * 6144 + n;
    for (int kc = 0; kc < 4; ++kc) {
        for (int i = tid; i < 33 * 256; i += 512) { const int r = i >> 8, k = kc * 256 + (i & 255); const float v = r < 32 ? in.c[(size_t)r * 1024 + k] : in.c_ctx[k]; sc[i] = v / (1.f + __expf(-v)); }
        __syncthreads();
        for (int k = 0; k < 256; ++k) { const float wv = wp[(size_t)(kc * 256 + k) * 6144];
#pragma unroll
            for (int i = 0; i < 11; ++i) acc[i] += sc[(rg * 11 + i) * 256 + k] * wv; }
        __syncthreads();
    }
    const float bias = in.ada_b[(size_t)l * 6144 + n];
#pragma unroll
    for (int i = 0; i < 11; ++i) w.MOD()[((size_t)l * 33 + rg * 11 + i) * 6144 + n] = acc[i] + bias;
}
__device__ __forceinline__ void phase_rope(const WS& w, int vb, int nvb) {
    int tid_ = threadIdx.x; asm volatile("" : "+v"(tid_));
    for (int i = vb * 512 + tid_; i < 2048 * 32; i += nvb * 512) {
        { const int t = i / 32, j = i % 32; const double inv = pow(10000.0, -(double)(j % 16) / 16.0); const double a = (double)(j < 16 ? t / 64 : t % 64) * inv; w.ROPA()[i] = make_float2((float)cos(a), (float)sin(a)); }
        if (i < 2048 * 16) { const int t = i / 16, j = i % 16; const double inv = pow(10000.0, -(double)(j % 8) / 8.0); const double a = (double)(j < 8 ? t / 64 : t % 64) * inv; w.ROPC()[i] = make_float2((float)cos(a), (float)sin(a)); }
    }
}

#ifndef PROBE_MASK
#define PROBE_MASK 0
#endif
#ifndef BENCH_MODE
#define BENCH_MODE 0
#endif
#if BENCH_MODE
__device__ __forceinline__ void phase_bench(float* sink) {
    int tid_ = threadIdx.x; asm volatile("" : "+v"(tid_));
    float x[16];
#pragma unroll
    for (int i = 0; i < 16; ++i) x[i] = (float)(tid_ + i) * 0.001f;
    f32x16 acc[4] = {};
    bf16x8 a = (bf16x8){(short)tid_, 1, 2, 3, 4, 5, 6, 7}, b = (bf16x8){7, 6, 5, 4, 3, 2, 1, (short)tid_};
#pragma nounroll
    for (int it = 0; it < ((BENCH_MODE & 7) ? 2048 : 0); ++it) {
#pragma unroll
        for (int k = 0; k < 8; ++k) {
            if (BENCH_MODE & 2) { acc[k & 3] = mfma32(a, b, acc[k & 3]); }
            __builtin_amdgcn_sched_barrier(0);
            if (BENCH_MODE & 1) { asm volatile("v_exp_f32 %0, -|%0|" : "+v"(x[2 * k])); asm volatile("v_exp_f32 %0, -|%0|" : "+v"(x[2 * k + 1])); }
            if (BENCH_MODE & 4) {
#pragma unroll
                for (int j = 0; j < 8; ++j) asm volatile("v_fma_f32 %0, %0, %0, %0" : "+v"(x[(2 * k + j) & 15]));
            }
            __builtin_amdgcn_sched_barrier(0);
        }
    }
    if (BENCH_MODE & 24) {
        const int lane = tid_ & 63, r32 = lane & 31, hi = lane >> 5;
        unsigned ka[2][4];
#pragma unroll
        for (int kt = 0; kt < 2; ++kt)
#pragma unroll
            for (int s_ = 0; s_ < 4; ++s_) { const int key = 32 * kt + r32; ka[kt][s_] = key * 128 + (((2 * s_ + hi) ^ ((key >> 1) & 7)) << 4); }
        const int vq = (lane & 15) >> 2, vp = lane & 3, vg = (lane >> 4) & 1;
        unsigned va[2];
#pragma unroll
        for (int dvb = 0; dvb < 2; ++dvb) { const int key = 4 * hi + vq; va[dvb] = 8192 + key * 128 + ((((32 * dvb + 16 * vg + 4 * vp) * 2)) ^ (((key >> 1) & 1) << 6)); }
        u32x4 kr[8]; u32x2 vr[16];
#pragma nounroll
        for (int it = 0; it < 2048; ++it) {
            if (BENCH_MODE & 8) {
#pragma unroll
                for (int kt = 0; kt < 2; ++kt)
#pragma unroll
                    for (int s_ = 0; s_ < 4; ++s_) asm volatile("ds_read_b128 %0, %1" : "=v"(kr[kt * 4 + s_]) : "v"(ka[kt][s_]));
            }
            if (BENCH_MODE & 16) {
#pragma unroll
                for (int q = 0; q < 4; ++q)
#pragma unroll
                    for (int dvb = 0; dvb < 2; ++dvb) { asm volatile("ds_read_b64_tr_b16 %0, %1" : "=v"(vr[q * 4 + dvb * 2]) : "v"(va[dvb] + q * 2048)); asm volatile("ds_read_b64_tr_b16 %0, %1 offset:1024" : "=v"(vr[q * 4 + dvb * 2 + 1]) : "v"(va[dvb] + q * 2048)); }
            }
            asm volatile("s_waitcnt lgkmcnt(0)" ::: "memory");
        }
        if (BENCH_MODE & 8) {
#pragma unroll
            for (int i = 0; i < 8; ++i) x[i] += __uint_as_float(kr[i][0] ^ kr[i][1] ^ kr[i][2] ^ kr[i][3]);
        }
        if (BENCH_MODE & 16) {
#pragma unroll
            for (int i = 0; i < 16; ++i) x[i] += __uint_as_float(vr[i][0] ^ vr[i][1]);
        }
    }
    float r = 0.f;
#pragma unroll
    for (int i = 0; i < 16; ++i) r += x[i];
#pragma unroll
    for (int k = 0; k < 4; ++k)
#pragma unroll
        for (int i = 0; i < 16; ++i) r += acc[k][i];
    if (r == 1.2345e30f) sink[tid_] = r;
}
#endif
struct MegaArgs { Inputs in; WS w; float* XL; unsigned* bar; };
constexpr int MEGA_LDS = 131072 + 16;
__global__ void __launch_bounds__(512, 2) k_mega(MegaArgs A) {
    LAS unsigned char* lds = (LAS unsigned char*)dyn_lds;
    const int vb = blockIdx.x, nvb = gridDim.x;
    volatile LAS unsigned* xbw = (volatile LAS unsigned*)(lds + 131072);
    if (threadIdx.x == 0) { xbw[0] = 0u; xbw[1] = 0u; xbw[2] = 0u; xbw[3] = 0u; }
    __syncthreads();
    XcdBarrier bar = xcd_barrier_post(A.bar, xbw);
    if (threadIdx.x == 0) xbw[2] = xb_add(&A.bar[3584 + 64 * bar.x], 1u);
    __syncthreads();
    const int xticket = __builtin_amdgcn_readfirstlane((int)xbw[2]);
    const WS& w = A.w; const Inputs& in = A.in;
    phase_mod(lds, in, w, vb);
    phase_rope(w, vb, nvb);
    phase_cvt(lds, in, w, vb, nvb);
    xcd_barrier(bar);
    phase_modulate<false>(in.x, in.ctx, nullptr, w.H(), in.norm1_g, w.MOD(), 0, NR, vb, nvb);
    xcd_barrier(bar);
#if (PROBE_MASK >> 0) & 1
    phase_mod(lds, in, w, vb);
    phase_rope(w, vb, nvb);
    phase_cvt(lds, in, w, vb, nvb);
    xcd_barrier(bar);
    phase_modulate<false>(in.x, in.ctx, nullptr, w.H(), in.norm1_g, w.MOD(), 0, NR, vb, nvb);
    xcd_barrier(bar);
#endif
#if BENCH_MODE
    phase_bench((float*)w.RSQ());
#endif
    int xpart = vb & 7, xrank = vb >> 3;
    { bool okx = (bar.x < 8u); for (unsigned j = 0; j < 8; ++j) okx = okx && (xb_ld(&A.bar[XB_XCNT(j)]) == (unsigned)(nvb >> 3));
      if (okx) { xpart = (int)bar.x; xrank = xticket; } }
    for (int l = 0; l < DEPTH; ++l) {
        const float* MODl = w.MOD() + (size_t)l * 33 * 6144;
        const bool last = (l == DEPTH - 1);
        const int MR = last ? NL : NR;
        phase_p1(lds, w, in, l, vb, nvb); xcd_barrier(bar);
#if (PROBE_MASK >> 1) & 1
        phase_p1(lds, w, in, l, vb, nvb); xcd_barrier(bar);
#endif
        phase_p2(lds, w, in, l, vb, nvb); xcd_barrier(bar);
#if (PROBE_MASK >> 12) & 7
        phase_p2(lds, w, in, l, vb, nvb, (PROBE_MASK >> 12) & 7); xcd_barrier(bar);
#endif
        phase_p3(lds, w, l, vb, nvb, xpart, xrank); xcd_barrier(bar);
#if (PROBE_MASK >> 3) & 1
        phase_p3(lds, w, l, vb, nvb, xpart, xrank); xcd_barrier(bar);
#endif
        phase_p4(lds, w, in, l, vb, nvb);
        xcd_barrier(bar);
#if (PROBE_MASK >> 4) & 1
        phase_p4(lds, w, in, l, vb, nvb);
        xcd_barrier(bar);
#endif
        if (l == 0) phase_modulate<false>(in.x, in.ctx, nullptr, w.H(), in.norm2_g + l * 1024, MODl, 3, MR, vb, nvb, w.H8(), w.HS(), w.PQ(), w.XB());
        else phase_modulate<true>(nullptr, nullptr, w.XB(), w.H(), in.norm2_g + l * 1024, MODl, 3, MR, vb, nvb, w.H8(), w.HS(), w.PQ(), w.XB());
        xcd_barrier(bar);
#if (PROBE_MASK >> 5) & 1
        phase_modulate<true>(nullptr, nullptr, w.XB(), w.H(), in.norm2_g + l * 1024, MODl, 3, MR, vb, nvb, w.H8(), w.HS()); xcd_barrier(bar);
#endif
        phase_p6a(lds, w, l, vb, nvb); xcd_barrier(bar);
#if (PROBE_MASK >> 6) & 1
        phase_p6a(lds, w, l, vb, nvb); xcd_barrier(bar);
#endif
        phase_p6b(lds, w.PQ(), w.SubK() + (size_t)l * 16 * 128 * 128, w.EG(), MR, vb, nvb); xcd_barrier(bar);
#if (PROBE_MASK >> 7) & 1
        phase_p6b(lds, w.PQ(), w.SubK() + (size_t)l * 16 * 128 * 128, w.EG(), MR, vb, nvb); xcd_barrier(bar);
#endif
        { P7CArgs a{w.H8(), w.EG(), w.U8() + (size_t)l * NE * 512, (int*)w.PQ(), MR}; phase_p7c(lds, a, xpart, xrank, nvb); }
        xcd_barrier(bar);
#if (PROBE_MASK >> 8) & 1
        { P7CArgs a{w.H8(), w.EG(), w.U8() + (size_t)l * NE * 512, (int*)w.PQ(), MR}; phase_p7c(lds, a, xpart, xrank, nvb); }
        xcd_barrier(bar);
#endif
        phase_p7d((const int*)w.PQ(), w.EG(), w.US() + (size_t)l * NE, w.VS() + (size_t)l * NE, w.HS(), w.WE(), MR, vb, nvb);
        xcd_barrier(bar);
#if (PROBE_MASK >> 9) & 1
        phase_p7d((const int*)w.PQ(), w.EG(), w.US() + (size_t)l * NE, w.VS() + (size_t)l * NE, w.HS(), w.WE(), MR, vb, nvb);
        xcd_barrier(bar);
#endif
        { P7BArgs a{w.WE(), w.V8() + (size_t)l * NE * 512, w.XB(), MODl + 5 * 1024, MR}; phase_p7b<0>(lds, a, xpart, xrank, nvb); }
        xcd_barrier(bar);
#if (PROBE_MASK >> 10) & 3
        { P7BArgs a{w.WE(), w.V8() + (size_t)l * NE * 512, w.XB(), MODl + 5 * 1024, MR}; phase_p7b<((PROBE_MASK >> 10) & 3)>(lds, a, xpart, xrank, nvb); }
        xcd_barrier(bar);
#endif
        if (last) phase_final_norm(w.XB(), A.XL, in.final_g, vb, nvb);
        else phase_modulate<true>(nullptr, nullptr, w.XB(), w.H(), in.norm1_g + (l + 1) * 1024, w.MOD() + (size_t)(l + 1) * 33 * 6144, 0, NR, vb, nvb);
        if (!last) xcd_barrier(bar);
    }
}

extern "C" void kernel_launch(void* const* d_in, const int* in_sizes, int n_in, void* d_out, int out_size, void* d_ws, size_t ws_size, hipStream_t stream) {
    const float* const* fin = (const float* const*)d_in;
    Inputs in{fin[0], fin[1], fin[2], fin[3], fin[4], fin[5], fin[6], fin[7], fin[8], fin[9], fin[10], fin[11], fin[12], fin[13], fin[14], fin[15], fin[16], fin[17], fin[18], fin[19], fin[20], fin[21], fin[22]};
    WS w = make_ws(d_ws);
    static int ok = 0;
    if (!ok) {
        if (hipFuncSetAttribute((const void*)k_mega, hipFuncAttributeMaxDynamicSharedMemorySize, MEGA_LDS) != hipSuccess) { ok = -1; }
        int per_cu = 0, cus = 0, dev = 0; (void)hipGetDevice(&dev); (void)hipDeviceGetAttribute(&cus, hipDeviceAttributeMultiprocessorCount, dev);
        if (hipOccupancyMaxActiveBlocksPerMultiprocessor(&per_cu, (const void*)k_mega, 512, MEGA_LDS) != hipSuccess || per_cu < 1 || cus < 256) ok = -1;
        if (ok == 0) ok = 1;
    }
    if (ok < 0) return;
    (void)hipMemsetAsync(d_ws, 0, 16384, stream);
    MegaArgs A{in, w, (float*)d_out, (unsigned*)d_ws};
    k_mega<<<256, 512, MEGA_LDS, stream>>>(A);
}
```

```cpp
#include <hip/hip_runtime.h>
#include <stdint.h>

typedef unsigned short bf16_t;

constexpr int D = 1024, NB = 32, S = 2048, CTX = 256, DEPTH = 2;
constexpr int NL = NB * S, NC = NB * CTX, NR = NL + NC;
constexpr int KEYS = CTX + S;
constexpr int INC = 1568;
constexpr int NE = 16384;
constexpr float EPS = 1e-6f;

__device__ __forceinline__ float bf2f(bf16_t v) { return __uint_as_float(((unsigned)v) << 16); }
__device__ __forceinline__ bf16_t f2bf(float f) { unsigned u = __float_as_uint(f); u += 0x7FFFu + ((u >> 16) & 1u); return (bf16_t)(u >> 16); }

__device__ __forceinline__ float wave_sum(float v) {
#pragma unroll
    for (int o = 32; o > 0; o >>= 1) v += __shfl_xor(v, o);
    return v;
}
__device__ __forceinline__ float gelu_tanh(float x) {
    const float u = 0.7978845608028654f * (x + 0.044715f * x * x * x);
    return 0.5f * x * (1.f + tanhf(u));
}

struct WS {
    char* base;
    __host__ __device__ __forceinline__ bf16_t* H() const { return (bf16_t*)(base + 65536ull); }
    __host__ __device__ __forceinline__ bf16_t* Qg() const { return (bf16_t*)(base + 151060480ull); }
    __host__ __device__ __forceinline__ bf16_t* Qgc() const { return (bf16_t*)(base + 201392128ull); }
    __host__ __device__ __forceinline__ bf16_t* Kg() const { return (bf16_t*)(base + 207683584ull); }
    __host__ __device__ __forceinline__ bf16_t* Vg() const { return (bf16_t*)(base + 226557952ull); }
    __host__ __device__ __forceinline__ bf16_t* CQ() const { return (bf16_t*)(base + 245432320ull); }
    __host__ __device__ __forceinline__ bf16_t* CKV() const { return (bf16_t*)(base + 302055424ull); }
    __host__ __device__ __forceinline__ bf16_t* Bp() const { return (bf16_t*)(base + 339804160ull); }
    __host__ __device__ __forceinline__ bf16_t* KR() const { return (bf16_t*)(base + 377552896ull); }
    __host__ __device__ __forceinline__ bf16_t* Qm() const { return (bf16_t*)(base + 382271488ull); }
    __host__ __device__ __forceinline__ bf16_t* Qmc() const { return (bf16_t*)(base + 457768960ull); }
    __host__ __device__ __forceinline__ bf16_t* Kmn() const { return (bf16_t*)(base + 467206144ull); }
    __host__ __device__ __forceinline__ bf16_t* Vm() const { return (bf16_t*)(base + 523829248ull); }
    __host__ __device__ __forceinline__ unsigned* EG() const { return (unsigned*)(base + 580452352ull); }
    __host__ __device__ __forceinline__ bf16_t* P() const { return (bf16_t*)(base + 382271488ull); }
    __host__ __device__ __forceinline__ bf16_t* PQ() const { return (bf16_t*)(base + 151060480ull); }
    __host__ __device__ __forceinline__ bf16_t* TMP() const { return (bf16_t*)(base + 65536ull); }
    __host__ __device__ __forceinline__ float* XC() const { return (float*)(base + 618201088ull); }
    __host__ __device__ __forceinline__ float* MOD() const { return (float*)(base + 651755520ull); }
    __host__ __device__ __forceinline__ float2* ROPA() const { return (float2*)(base + 653377536ull); }
    __host__ __device__ __forceinline__ float2* ROPC() const { return (float2*)(base + 653901824ull); }
    __host__ __device__ __forceinline__ float* RSQ() const { return (float*)(base + 654163968ull); }
    __host__ __device__ __forceinline__ float* RSKV() const { return (float*)(base + 654458880ull); }
    __host__ __device__ __forceinline__ bf16_t* WinT() const { return (bf16_t*)(base + 654753792ull); }
    __host__ __device__ __forceinline__ bf16_t* WuqT() const { return (bf16_t*)(base + 662093824ull); }
    __host__ __device__ __forceinline__ bf16_t* WukvT() const { return (bf16_t*)(base + 663273472ull); }
    __host__ __device__ __forceinline__ bf16_t* WoutT() const { return (bf16_t*)(base + 664059904ull); }
    __host__ __device__ __forceinline__ bf16_t* WqT() const { return (bf16_t*)(base + 668254208ull); }
    __host__ __device__ __forceinline__ bf16_t* SubK() const { return (bf16_t*)(base + 676642816ull); }
    __host__ __device__ __forceinline__ unsigned char* U8() const { return (unsigned char*)(base + 677691392ull); }
    __host__ __device__ __forceinline__ unsigned char* V8() const { return (unsigned char*)(base + 711245824ull); }
    __host__ __device__ __forceinline__ float* US() const { return (float*)(base + 744800256ull); }
    __host__ __device__ __forceinline__ float* VS() const { return (float*)(base + 744931328ull); }
    __host__ __device__ __forceinline__ float* SSQ() const { return (float*)(base + 745062400ull); }
    __host__ __device__ __forceinline__ float* SSKV() const { return (float*)(base + 747421696ull); }
    __host__ __device__ __forceinline__ unsigned* WE() const { return (unsigned*)(base + 748601344ull); }
    __host__ __device__ __forceinline__ signed char* H8() const { return (signed char*)(base + 786350080ull); }
    __host__ __device__ __forceinline__ float* HS() const { return (float*)(base + 861847552ull); }
    __host__ __device__ __forceinline__ bf16_t* PoolWT() const { return (bf16_t*)(base + 862142464ull); }
    __host__ __device__ __forceinline__ bf16_t* XB() const { return (bf16_t*)(base + 862208000ull); }
};
constexpr size_t WS_BYTES = 862208000ull + (size_t)NR * 1024 * 2;
static WS make_ws(void* d_ws) { WS w; w.base = (char*)d_ws; return w; }


#define LAS __attribute__((address_space(3)))
typedef short bf16x8 __attribute__((ext_vector_type(8)));
typedef float f32x4 __attribute__((ext_vector_type(4)));
typedef float f32x16 __attribute__((ext_vector_type(16)));
typedef unsigned u32x4 __attribute__((ext_vector_type(4)));
typedef unsigned u32x2 __attribute__((ext_vector_type(2)));

__device__ __forceinline__ f32x16 mfma32(bf16x8 a, bf16x8 b, f32x16 c) { return __builtin_amdgcn_mfma_f32_32x32x16_bf16(a, b, c, 0, 0, 0); }
__device__ __forceinline__ unsigned cvt_pk_bf16(float lo, float hi) { unsigned r; asm volatile("v_cvt_pk_bf16_f32 %0, %1, %2" : "=v"(r) : "v"(lo), "v"(hi)); return r; }

namespace pg8 {
constexpr int BM = 256, BK = 64, HALF = 128, HTB = HALF * BK * 2, STAGE_BYTES = 8 * HTB, NXCD = 8, WGM = 8;
__host__ __device__ __forceinline__ int lds_byte(int r, int c) { const int st = (r >> 4) * 2 + (c >> 5), rr = r & 15, cc = c & 31, ob = rr * 64 + cc * 2; return st * 1024 + (ob ^ (((ob >> 9) & 1) << 5)); }
__host__ __device__ __forceinline__ void stage_rc(int b, int& R, int& C) { const int st = b / 1024, sb = b % 1024, swz = sb ^ (((sb >> 9) & 1) << 5); R = (st >> 1) * 16 + swz / 64; C = (st & 1) * 32 + (swz % 64) / 2; }
__host__ __device__ __forceinline__ int perm32(int rho) { const int n = rho >> 4, i = rho & 15; return 8 * (i >> 2) + 4 * n + (i & 3); }
struct Unit { int pm, pn; };
struct Gemm { const bf16_t* A; const bf16_t* Bt; int M, N, K; };
struct StaticOrder {
    int nM, nN, nwg, G, c;
    __host__ __device__ void init(int M, int N, int G_, int c_) { nM = M / BM; nN = N / BM; nwg = nM * nN; G = G_; c = c_; }
    __host__ __device__ bool next(int i, Unit& u) const {
        const long L = (long)i * G + c; if (L >= nwg) return false;
        int wgid = (int)L; { const int q = nwg / NXCD, r = nwg % NXCD, xcd = wgid % NXCD, off = wgid / NXCD; wgid = (xcd < r ? xcd * (q + 1) : r * (q + 1) + (xcd - r) * q) + off; }
        const int nig = WGM * nN, gid = wgid / nig, fm = gid * WGM, gsz = (nM - fm) < WGM ? (nM - fm) : WGM;
        u.pm = fm + ((wgid % nig) % gsz); u.pn = (wgid % nig) / gsz; return true;
    }
};
template <class Epi, class Sched>
__device__ __forceinline__ void gemm_phase(LAS unsigned char* lds, const Gemm g, const Sched& S, const Epi& E) {
    int tid_ = threadIdx.x; asm volatile("" : "+v"(tid_));
    const int tid = tid_, wid = __builtin_amdgcn_readfirstlane(tid >> 6), lane = tid & 63, wr = wid >> 2, wc = wid & 3, fr = lane & 15, fq = lane >> 4;
    const int K = g.K, nt = K / BK;
    unsigned voffA[2], voffB[2];
#pragma unroll
    for (int i = 0; i < 2; ++i) { int R, C; stage_rc(tid * 16 + i * 8192, R, C); const int Rb = Epi::PERM ? ((R & ~31) + perm32(R & 31)) : R;
        voffA[i] = (unsigned)(R * K + C) * 2u; voffB[i] = (unsigned)(Rb * K + C) * 2u; }
    const size_t kstep = (size_t)(BK * 2);
    const size_t hstep = (size_t)HALF * K * 2;
    const size_t tstep = 2 * hstep;
    const unsigned ldsw = (unsigned)wid * 1024u;
    const int aoff = lds_byte(wr * 64 + fr, fq * 8), boff = lds_byte(wc * 32 + fr, fq * 8);
#define PG8_SA(b, h) (((b) * 2 + (h)) * HTB)
#define PG8_SB(b, h) ((4 + (b) * 2 + (h)) * HTB)
#define PG8_STAGE(bufoff, gbase, voff) do { _Pragma("unroll") for (int _i = 0; _i < 2; ++_i) \
        __builtin_amdgcn_global_load_lds((const unsigned*)((const char*)(gbase) + (voff)[_i]), (LAS unsigned*)(lds + (bufoff) + ldsw + _i * 8192), 16, 0, 0); } while (0)
#define PG8_LDA(dst, b, h) do { _Pragma("unroll") for (int m = 0; m < 4; ++m) _Pragma("unroll") for (int k = 0; k < 2; ++k) dst[m][k] = *(const LAS bf16x8*)(lds + PG8_SA(b, h) + aoff + m * 2048 + k * 1024); } while (0)
#define PG8_LDB(dst, b, h) do { _Pragma("unroll") for (int n = 0; n < 2; ++n) _Pragma("unroll") for (int k = 0; k < 2; ++k) dst[n][k] = *(const LAS bf16x8*)(lds + PG8_SB(b, h) + boff + n * 2048 + k * 1024); } while (0)
#define PG8_MMA(ai, bj, At, Bt) do { __builtin_amdgcn_s_setprio(1); _Pragma("unroll") for (int m = 0; m < 4; ++m) _Pragma("unroll") for (int n = 0; n < 2; ++n) _Pragma("unroll") for (int k = 0; k < 2; ++k) \
        acc[ai][bj][m][n] = __builtin_amdgcn_mfma_f32_16x16x32_bf16(Bt[n][k], At[m][k], acc[ai][bj][m][n], 0, 0, 0); __builtin_amdgcn_s_setprio(0); } while (0)
#define PG8_WAIT_V(n) asm volatile("s_waitcnt vmcnt(" #n ")" ::: "memory")
#define PG8_WAIT_L(n) asm volatile("s_waitcnt lgkmcnt(" #n ")" ::: "memory")
#define PG8_BAR __builtin_amdgcn_s_barrier()
#define PG8_SCHED __builtin_amdgcn_sched_barrier(0)
    Unit cur, nxt; int ui = 0;
    if (!S.next(0, cur)) return;
    f32x4 acc[2][2][4][2];
#pragma unroll
    for (int a = 0; a < 2; ++a)
#pragma unroll
        for (int b = 0; b < 2; ++b)
#pragma unroll
            for (int m = 0; m < 4; ++m)
#pragma unroll
                for (int n = 0; n < 2; ++n) acc[a][b][m][n] = (f32x4){0.f, 0.f, 0.f, 0.f};
    bf16x8 At[4][2], B0[2][2], B1[2][2];
    const char* cA = (const char*)g.A + (size_t)cur.pm * tstep; const char* cB = (const char*)g.Bt + (size_t)cur.pn * tstep;
    PG8_STAGE(PG8_SB(0, 0), cB, voffB); PG8_STAGE(PG8_SA(0, 0), cA, voffA); PG8_STAGE(PG8_SB(0, 1), cB + hstep, voffB); PG8_STAGE(PG8_SA(0, 1), cA + hstep, voffA);
    if (wr == 1) PG8_BAR;
    PG8_WAIT_V(4); PG8_BAR;
    PG8_STAGE(PG8_SB(1, 0), cB + kstep, voffB); PG8_STAGE(PG8_SA(1, 0), cA + kstep, voffA); PG8_STAGE(PG8_SB(1, 1), cB + hstep + kstep, voffB);
    PG8_WAIT_V(6); PG8_BAR;
    for (;;) {
        const bool has_next = S.next(ui + 1, nxt);
        const char* nA = has_next ? (const char*)g.A + (size_t)nxt.pm * tstep : cA; const char* nB = has_next ? (const char*)g.Bt + (size_t)nxt.pn * tstep : cB;
#pragma nounroll
        for (int t = 0; t < nt; t += 2) {
            const bool last = (t == nt - 2);
            const char* a1 = cA + (size_t)(t + 1) * kstep;
            const char* a2 = last ? nA : cA + (size_t)(t + 2) * kstep; const char* b2 = last ? nB : cB + (size_t)(t + 2) * kstep;
            const char* a3 = a2 + kstep; const char* b3 = b2 + kstep;
            PG8_LDB(B0, 0, 0); PG8_SCHED; PG8_LDA(At, 0, 0); PG8_STAGE(PG8_SA(1, 1), a1 + hstep, voffA);
            PG8_WAIT_L(8); PG8_BAR; PG8_WAIT_L(0); PG8_MMA(0, 0, At, B0); PG8_BAR; PG8_SCHED;
            PG8_LDB(B1, 0, 1); PG8_STAGE(PG8_SB(0, 0), b2, voffB);
            PG8_BAR; PG8_WAIT_L(0); PG8_MMA(0, 1, At, B1); PG8_BAR;
            PG8_LDA(At, 0, 1); PG8_STAGE(PG8_SA(0, 0), a2, voffA);
            PG8_BAR; PG8_WAIT_L(0); PG8_MMA(1, 0, At, B0); PG8_BAR; PG8_SCHED;
            PG8_STAGE(PG8_SB(0, 1), b2 + hstep, voffB);
            PG8_WAIT_V(6); PG8_BAR; PG8_MMA(1, 1, At, B1); PG8_BAR;
            PG8_LDB(B0, 1, 0); PG8_SCHED; PG8_LDA(At, 1, 0); PG8_STAGE(PG8_SA(0, 1), a2 + hstep, voffA);
            PG8_WAIT_L(8); PG8_BAR; PG8_WAIT_L(0); PG8_MMA(0, 0, At, B0); PG8_BAR; PG8_SCHED;
            PG8_LDB(B1, 1, 1); PG8_STAGE(PG8_SB(1, 0), b3, voffB);
            PG8_BAR; PG8_WAIT_L(0); PG8_MMA(0, 1, At, B1); PG8_BAR;
            PG8_LDA(At, 1, 1); PG8_STAGE(PG8_SA(1, 0), a3, voffA);
            PG8_BAR; PG8_WAIT_L(0); PG8_MMA(1, 0, At, B0); PG8_BAR; PG8_SCHED;
            PG8_STAGE(PG8_SB(1, 1), b3 + hstep, voffB);
            PG8_WAIT_V(6); PG8_BAR; PG8_MMA(1, 1, At, B1); PG8_BAR;
        }
        E(acc, cur, wr, wc, fr, fq);
        if (!has_next) break;
#pragma unroll
        for (int a = 0; a < 2; ++a)
#pragma unroll
            for (int b = 0; b < 2; ++b)
#pragma unroll
                for (int m = 0; m < 4; ++m)
#pragma unroll
                    for (int n = 0; n < 2; ++n) acc[a][b][m][n] = (f32x4){0.f, 0.f, 0.f, 0.f};
        cur = nxt; cA = nA; cB = nB; ++ui;
    }
    PG8_WAIT_V(0);
    if (wr == 0) PG8_BAR;
    PG8_BAR;
#undef PG8_SA
#undef PG8_SB
#undef PG8_STAGE
#undef PG8_LDA
#undef PG8_LDB
#undef PG8_MMA
#undef PG8_WAIT_V
#undef PG8_WAIT_L
#undef PG8_BAR
#undef PG8_SCHED
}
}

enum { GT_AQ = 0, GT_AK = 1, GT_AV = 2, GT_B = 3, GT_CQ = 4, GT_CKV = 5, GT_KR = 6, GT_PAD = 7 };
__host__ __device__ __forceinline__ void in_group(int g, int& type, int& sub) {
    if (g < 2) { type = GT_AK; sub = g; } else if (g < 4) { type = GT_AV; sub = g - 2; } else if (g < 8) { type = GT_CKV; sub = g - 4; }
    else if (g == 8) { type = GT_KR; sub = 0; } else if (g < 12) { type = GT_PAD; sub = 0; } else if (g < 18) { type = GT_AQ; sub = g - 12; }
    else if (g < 24) { type = GT_CQ; sub = g - 18; } else { type = GT_B; sub = g - 24; }
}
__device__ __forceinline__ int colmap(int mode, int r) {
    const int pn = r >> 8, ct = r & 255, bj = ct >> 7, wc = (ct >> 5) & 3, j = ct & 31, g = 4 * pn + wc, e = 32 * bj + j;
    if (mode == 0) {
        int type, sub; in_group(g, type, sub);
        switch (type) { case GT_AQ: return 64 * sub + e; case GT_AK: return 384 + 64 * sub + e; case GT_AV: return 512 + 64 * sub + e; case GT_B: return 640 + 64 * sub + e;
            case GT_CQ: return 896 + 64 * sub + e; case GT_CKV: return 1280 + 64 * sub + e; case GT_KR: return (j < 16) ? 1536 + 16 * bj + j : -1; default: return -1; }
    } else if (mode == 1) {
        if (g < 6) return 96 * g + e; if (g < 9) { const int head = 2 * (g - 6) + (j >> 4); return 96 * head + 64 + 16 * bj + (j & 15); } return -1;
    } else if (mode == 2) {
        return 64 * g + e;
    }
    return r;
}
__device__ __forceinline__ void cvt_weights_unit(LAS float* tile  , const float* __restrict__ W, int K, int N, bf16_t* __restrict__ dst, int mode, const float* __restrict__ kgain, int r0, int k0) {
    int tid_ = threadIdx.x; asm volatile("" : "+v"(tid_));
    const int tid = tid_;
    const int jj = tid & 63; const int sc = colmap(mode, r0 + jj);
#pragma unroll
    for (int i = 0; i < 8; ++i) { const int kk = (tid >> 6) + 8 * i; float v = 0.f; if (sc >= 0) v = W[(size_t)(k0 + kk) * N + sc]; if (kgain) v *= kgain[k0 + kk]; tile[kk * 65 + jj] = v; }
    __syncthreads();
#pragma unroll
    for (int i = 0; i < 8; ++i) { const int rr = (tid >> 6) + 8 * i, kk = tid & 63; dst[(size_t)(r0 + rr) * K + k0 + kk] = f2bf(tile[kk * 65 + rr]); }
    __syncthreads();
}
struct CvtJob { const float* W; bf16_t* dst; const float* kgain; int K, N, Npad, mode; };
__device__ __forceinline__ void cvt_job(LAS float* tile, const CvtJob j, int vb, int nvb) {
    const int nk = j.K / 64, nr = j.Npad / 64;
    for (int u = vb; u < nk * nr; u += nvb) cvt_weights_unit(tile, j.W, j.K, j.N, j.dst, j.mode, j.kgain, (u / nk) * 64, (u % nk) * 64);
}
__device__ __forceinline__ void cvt_flat(const float* __restrict__ src, bf16_t* __restrict__ dst, size_t n, int vb, int nvb) {
    int tid_ = threadIdx.x; asm volatile("" : "+v"(tid_));
    for (size_t i = ((size_t)vb * 512 + tid_) * 8; i < n; i += (size_t)nvb * 512 * 8) {
        const float4 a = *(const float4*)(src + i), b = *(const float4*)(src + i + 4);
        u32x4 o; o.x = cvt_pk_bf16(a.x, a.y); o.y = cvt_pk_bf16(a.z, a.w); o.z = cvt_pk_bf16(b.x, b.y); o.w = cvt_pk_bf16(b.z, b.w);
        *(u32x4*)(dst + i) = o;
    }
}
template <bool FP8>
__device__ __forceinline__ void cvt_q8_rows(const float* __restrict__ src, unsigned char* __restrict__ dst, float* __restrict__ scales, int nrows, int vb, int nvb) {
    int tid_ = threadIdx.x; asm volatile("" : "+v"(tid_));
    const int lane = tid_ & 63, wid = tid_ >> 6;
    const int stride = nvb * 8;
    for (int row0 = vb * 8 + wid; row0 < nrows; row0 += 4 * stride) {
        f32x4 v[4][4];
#pragma unroll
        for (int q = 0; q < 4; ++q) { const int row = row0 + q * stride < nrows ? row0 + q * stride : row0; const float* sp = src + (size_t)row * 1024 + 16 * lane;
#pragma unroll
            for (int k = 0; k < 4; ++k) v[q][k] = *(const f32x4*)(sp + 4 * k); }
#pragma unroll
        for (int q = 0; q < 4; ++q) { const int row = row0 + q * stride; if (row < nrows) {
            float am = 0.f;
#pragma unroll
            for (int k = 0; k < 4; ++k) am = fmaxf(am, fmaxf(fmaxf(fabsf(v[q][k][0]), fabsf(v[q][k][1])), fmaxf(fabsf(v[q][k][2]), fabsf(v[q][k][3]))));
#pragma unroll
            for (int o = 32; o > 0; o >>= 1) am = fmaxf(am, __shfl_xor(am, o));
            const float qmax = FP8 ? 416.f : 127.f;
            const float sc = am > 0.f ? am / qmax : 1.f, inv = am > 0.f ? qmax / am : 0.f;
            u32x4 o4;
#pragma unroll
            for (int k = 0; k < 4; ++k) {
                if (FP8) { int p = __builtin_amdgcn_cvt_pk_fp8_f32(v[q][k][0] * inv, v[q][k][1] * inv, 0, false); p = __builtin_amdgcn_cvt_pk_fp8_f32(v[q][k][2] * inv, v[q][k][3] * inv, p, true); o4[k] = (unsigned)p; }
                else { const int q0 = (int)rintf(v[q][k][0] * inv), q1 = (int)rintf(v[q][k][1] * inv), q2 = (int)rintf(v[q][k][2] * inv), q3 = (int)rintf(v[q][k][3] * inv);
                    o4[k] = (unsigned)(q0 & 0xff) | ((unsigned)(q1 & 0xff) << 8) | ((unsigned)(q2 & 0xff) << 16) | ((unsigned)(q3 & 0xff) << 24); } }
            *(u32x4*)(dst + (size_t)row * 1024 + 16 * lane) = o4;
            if (lane == 0) scales[row] = sc; } }
    }
}
template <bool OFFS>
__device__ __forceinline__ void cvt_q4_rows(const float* __restrict__ src, unsigned char* __restrict__ dst, float* __restrict__ scales, int nrows, int vb, int nvb) {
    int tid_ = threadIdx.x; asm volatile("" : "+v"(tid_));
    const int lane = tid_ & 63, wid = tid_ >> 6;
    const int stride = nvb * 8;
    for (int row0 = vb * 8 + wid; row0 < nrows; row0 += 4 * stride) {
        f32x4 v[4][4];
#pragma unroll
        for (int q = 0; q < 4; ++q) { const int row = row0 + q * stride < nrows ? row0 + q * stride : row0; const float* sp = src + (size_t)row * 1024 + 16 * lane;
#pragma unroll
            for (int k = 0; k < 4; ++k) v[q][k] = *(const f32x4*)(sp + 4 * k); }
#pragma unroll
        for (int q = 0; q < 4; ++q) { const int row = row0 + q * stride; if (row < nrows) {
            float am = 0.f, ss = 0.f;
#pragma unroll
            for (int k = 0; k < 4; ++k) { am = fmaxf(am, fmaxf(fmaxf(fabsf(v[q][k][0]), fabsf(v[q][k][1])), fmaxf(fabsf(v[q][k][2]), fabsf(v[q][k][3]))));
                ss += v[q][k][0] * v[q][k][0] + v[q][k][1] * v[q][k][1] + v[q][k][2] * v[q][k][2] + v[q][k][3] * v[q][k][3]; }
#pragma unroll
            for (int o = 32; o > 0; o >>= 1) { am = fmaxf(am, __shfl_xor(am, o)); ss += __shfl_xor(ss, o); }
            const float st = fmaxf(0.36f * sqrtf(ss * (1.f / 1024.f)), am * (1.f / 12.f));
            const float sc = st > 0.f ? st : 1.f, inv = st > 0.f ? 1.f / st : 0.f;
            u32x2 o2;
#pragma unroll
            for (int d = 0; d < 2; ++d) { unsigned wd = 0u;
#pragma unroll
                for (int k = 0; k < 4; ++k) { const int qa = (int)fminf(fmaxf(rintf(v[q][2 * d][k] * inv), -7.f), 7.f), qb = (int)fminf(fmaxf(rintf(v[q][2 * d + 1][k] * inv), -7.f), 7.f); wd |= ((unsigned)((qa + (OFFS ? 8 : 0)) & 15) << (8 * k)) | ((unsigned)((qb + (OFFS ? 8 : 0)) & 15) << (8 * k + 4)); }
                o2[d] = wd; }
            *(u32x2*)(dst + (size_t)(row / NE) * NE * 512 + (size_t)(lane >> 4) * NE * 128 + (size_t)(row % NE) * 128 + 8 * (lane & 15)) = o2;
            if (lane == 0) scales[row] = OFFS ? sc * 512.f : sc; } }
    }
}
__device__ __forceinline__ unsigned fp4_code(float x, float inv) {
    const float a = fabsf(x) * inv;
    unsigned c = a < 0.25f ? 0u : a < 0.75f ? 1u : a < 1.25f ? 2u : a < 1.75f ? 3u : a < 2.5f ? 4u : a < 3.5f ? 5u : a < 5.f ? 6u : 7u;
    return c | (x < 0.f ? 8u : 0u);
}
__device__ __forceinline__ void cvt_fp4_rows(const float* __restrict__ src, unsigned char* __restrict__ dst, float* __restrict__ scales, int nrows, int vb, int nvb) {
    int tid_ = threadIdx.x; asm volatile("" : "+v"(tid_));
    const int lane = tid_ & 63, wid = tid_ >> 6;
    const int stride = nvb * 8;
    for (int row0 = vb * 8 + wid; row0 < nrows; row0 += 4 * stride) {
        f32x4 v[4][4];
#pragma unroll
        for (int q = 0; q < 4; ++q) { const int row = row0 + q * stride < nrows ? row0 + q * stride : row0; const float* sp = src + (size_t)row * 1024 + 16 * lane;
#pragma unroll
            for (int k = 0; k < 4; ++k) v[q][k] = *(const f32x4*)(sp + 4 * k); }
#pragma unroll
        for (int q = 0; q < 4; ++q) { const int row = row0 + q * stride; if (row < nrows) {
            float am = 0.f, ss = 0.f;
#pragma unroll
            for (int k = 0; k < 4; ++k) { am = fmaxf(am, fmaxf(fmaxf(fabsf(v[q][k][0]), fabsf(v[q][k][1])), fmaxf(fabsf(v[q][k][2]), fabsf(v[q][k][3]))));
                ss += v[q][k][0] * v[q][k][0] + v[q][k][1] * v[q][k][1] + v[q][k][2] * v[q][k][2] + v[q][k][3] * v[q][k][3]; }
#pragma unroll
            for (int o = 32; o > 0; o >>= 1) { am = fmaxf(am, __shfl_xor(am, o)); ss += __shfl_xor(ss, o); }
            const float st = fmaxf(0.5f * sqrtf(ss * (1.f / 1024.f)), am * (1.f / 12.f));
            const float sc = st > 0.f ? st : 1.f, inv = st > 0.f ? 1.f / st : 0.f;
            u32x2 o2;
#pragma unroll
            for (int d = 0; d < 2; ++d) { unsigned wd = 0u;
#pragma unroll
                for (int i = 0; i < 8; ++i) wd |= fp4_code(v[q][2 * d + (i >> 2)][i & 3], inv) << (4 * i);
                o2[d] = wd; }
            *(u32x2*)(dst + (size_t)(row / NE) * NE * 512 + (size_t)(lane >> 4) * NE * 128 + (size_t)(row % NE) * 128 + 8 * (lane & 15)) = o2;
            if (lane == 0) scales[row] = sc; } }
    }
}
struct Inputs {
    const float *x, *c, *ctx, *c_ctx, *ada_w, *ada_b, *norm1_g, *norm2_g, *w_in, *gqa_qn_g, *gqa_kn_g, *pool_w, *pool_scale, *mla_qn_g, *mla_kvn_g, *mla_w_uq, *mla_w_ukv, *w_out, *peer_wq, *peer_subkeys, *peer_u, *peer_v, *final_g;
};
__device__ __forceinline__ void phase_cvt(LAS unsigned char* lds, const Inputs& in, const WS& w, int vb_, int nvb_) {
    if (nvb_ > 144 && vb_ < 72) return;
    const int vb = nvb_ > 144 ? vb_ - 72 : vb_, nvb = nvb_ > 144 ? nvb_ - 72 : nvb_;
    LAS float* tile = (LAS float*)lds;
    for (int l = 0; l < 2; ++l) {
        cvt_job(tile, CvtJob{in.w_in + (size_t)l * 1024 * INC, w.WinT() + (size_t)l * 1792 * 1024, nullptr, 1024, INC, 1792, 0}, vb, nvb);
        cvt_job(tile, CvtJob{in.mla_w_uq + (size_t)l * 384 * 576, w.WuqT() + (size_t)l * 768 * 384, in.mla_qn_g + l * 384, 384, 576, 768, 1}, vb, nvb);
        cvt_job(tile, CvtJob{in.mla_w_ukv + (size_t)l * 256 * 768, w.WukvT() + (size_t)l * 768 * 256, in.mla_kvn_g + l * 256, 256, 768, 768, 2}, vb, nvb);
        cvt_job(tile, CvtJob{in.w_out + (size_t)l * 1024 * 1024, w.WoutT() + (size_t)l * 1024 * 1024, nullptr, 1024, 1024, 1024, 3}, vb, nvb);
        cvt_job(tile, CvtJob{in.peer_wq + (size_t)l * 1024 * 2048, w.WqT() + (size_t)l * 2048 * 1024, nullptr, 1024, 2048, 2048, 3}, vb, nvb);
    }
    cvt_flat(in.peer_subkeys, w.SubK(), (size_t)2 * 16 * 128 * 128, vb, nvb);
    { int tp_ = threadIdx.x; asm volatile("" : "+v"(tp_));
      for (int i = vb * 512 + tp_; i < 2 * 4 * 64 * 64; i += nvb * 512) { const int c = i & 63, d = (i >> 6) & 63, lg = i >> 12; w.PoolWT()[i] = f2bf(in.pool_w[(size_t)lg * 4096 + c * 64 + d]); } }
    cvt_q4_rows<false>(in.peer_u, w.U8(), w.US(), 2 * NE, vb, nvb); cvt_fp4_rows(in.peer_v, w.V8(), w.VS(), 2 * NE, vb, nvb);
}

constexpr float ATT_C2G = 0.125f * 1.4426950408889634f, ATT_C2M = 0.10206207261596577f * 1.4426950408889634f;
struct EpiIn {
    static constexpr bool PERM = true;
    WS w; const float* qn_g; const float* kn_g; int pm_base;
    __device__ __forceinline__ void operator()(const f32x4 (&acc)[2][2][4][2], const pg8::Unit& u, int wr, int wc, int fr, int fq) const {
        int type, sub; in_group(4 * u.pn + wc, type, sub);
        if (type == GT_PAD) return;
        const int pm = u.pm + pm_base; const bool isctx = pm >= 256; const int b = isctx ? pm - 256 : pm >> 3; const int t0 = isctx ? 0 : (pm & 7) * 256;
        const size_t rowbase = isctx ? (size_t)NL + (size_t)b * CTX : (size_t)b * S;
        const int keyoff = isctx ? 0 : CTX;
        float gain[2][8];
        if (type == GT_AQ) {
#pragma unroll
            for (int bj = 0; bj < 2; ++bj)
#pragma unroll
                for (int q = 0; q < 8; ++q) gain[bj][q] = qn_g[32 * bj + 8 * fq + q] * ATT_C2G;
        } else if (type == GT_AK) {
#pragma unroll
            for (int bj = 0; bj < 2; ++bj)
#pragma unroll
                for (int q = 0; q < 8; ++q) gain[bj][q] = kn_g[32 * bj + 8 * fq + q];
        }
#pragma unroll
        for (int ai = 0; ai < 2; ++ai)
#pragma unroll
            for (int m = 0; m < 4; ++m) {
                const int t = t0 + 128 * ai + 64 * wr + 16 * m + fr; const size_t row = rowbase + t;
                float v[2][8];
#pragma unroll
                for (int bj = 0; bj < 2; ++bj)
#pragma unroll
                    for (int n = 0; n < 2; ++n)
#pragma unroll
                        for (int i = 0; i < 4; ++i) v[bj][4 * n + i] = acc[ai][bj][m][n][i];
                bf16_t* dst = nullptr;
                if (type == GT_AQ || type == GT_AK) {
                    float ss = 0.f;
#pragma unroll
                    for (int bj = 0; bj < 2; ++bj)
#pragma unroll
                        for (int q = 0; q < 8; ++q) ss += v[bj][q] * v[bj][q];
                    ss += __shfl_xor(ss, 16); ss += __shfl_xor(ss, 32);
                    const float rstd = rsqrtf(ss * (1.f / 64.f) + EPS);
#pragma unroll
                    for (int q = 0; q < 8; ++q) { float x1 = v[0][q] * rstd * gain[0][q], x2 = v[1][q] * rstd * gain[1][q];
                        if (!isctx) { const float2 cs = w.ROPA()[t * 32 + 8 * fq + q]; const float y1 = x1 * cs.x - x2 * cs.y, y2 = x1 * cs.y + x2 * cs.x; x1 = y1; x2 = y2; }
                        v[0][q] = x1; v[1][q] = x2; }
                    if (type == GT_AQ) dst = isctx ? w.Qgc() + (((size_t)b * 6 + sub) * CTX + t) * 64 : w.Qg() + (((size_t)b * 6 + sub) * S + t) * 64;
                    else dst = w.Kg() + (((size_t)b * 2 + sub) * KEYS + keyoff + t) * 64;
                } else if (type == GT_AV) { dst = w.Vg() + (((size_t)b * 2 + sub) * KEYS + keyoff + t) * 64;
                } else if (type == GT_B) { dst = w.Bp() + row * 256 + 64 * sub;
                } else if (type == GT_CQ || type == GT_CKV) {
                    float ss = 0.f;
#pragma unroll
                    for (int bj = 0; bj < 2; ++bj)
#pragma unroll
                        for (int q = 0; q < 8; ++q) ss += v[bj][q] * v[bj][q];
                    ss += __shfl_xor(ss, 16); ss += __shfl_xor(ss, 32);
                    if (type == GT_CQ) { if (fq == 0) w.SSQ()[row * 8 + sub] = ss; dst = w.CQ() + row * 384 + 64 * sub; }
                    else { if (fq == 0) w.SSKV()[row * 4 + sub] = ss; dst = w.CKV() + row * 256 + 64 * sub; }
                } else {
                    if (!isctx) {
#pragma unroll
                        for (int q = 0; q < 8; ++q) { const float2 cs = w.ROPC()[t * 16 + ((8 * fq + q) & 15)]; const float x1 = v[0][q], x2 = v[1][q]; v[0][q] = x1 * cs.x - x2 * cs.y; v[1][q] = x1 * cs.y + x2 * cs.x; } }
                    if (fq < 2) { bf16_t* kd = w.KR() + ((size_t)b * KEYS + keyoff + t) * 32;
#pragma unroll
                        for (int bj = 0; bj < 2; ++bj) { u32x4 o; o.x = cvt_pk_bf16(v[bj][0], v[bj][1]); o.y = cvt_pk_bf16(v[bj][2], v[bj][3]); o.z = cvt_pk_bf16(v[bj][4], v[bj][5]); o.w = cvt_pk_bf16(v[bj][6], v[bj][7]);
                            *(u32x4*)(kd + 16 * bj + 8 * fq) = o; } }
                    continue;
                }
#pragma unroll
                for (int bj = 0; bj < 2; ++bj) { u32x4 o; o.x = cvt_pk_bf16(v[bj][0], v[bj][1]); o.y = cvt_pk_bf16(v[bj][2], v[bj][3]); o.z = cvt_pk_bf16(v[bj][4], v[bj][5]); o.w = cvt_pk_bf16(v[bj][6], v[bj][7]);
                    *(u32x4*)(dst + 32 * bj + 8 * fq) = o; }
            }
    }
};
struct P1Order {
    pg8::StaticOrder so; int nctx_tiles, G, c;
    __device__ bool next(int i, pg8::Unit& u) const {
        const int L = i * G + c;
        if (L < 1792) return so.next(i, u);
        const int Lc = L - 1792; if (Lc >= 32 * nctx_tiles) return false;
        u.pm = 256 + (Lc & 31); u.pn = Lc >> 5; return true;
    }
};
__device__ __forceinline__ void phase_p1(LAS unsigned char* lds, const WS& w, const Inputs& in, int l, int vb, int nvb) {
    EpiIn E{w, in.gqa_qn_g + l * 64, in.gqa_kn_g + l * 64, 0};
    P1Order po; po.so.init(NL, 1792, nvb, vb); po.nctx_tiles = (l == 0) ? 7 : 3; po.G = nvb; po.c = vb;
    pg8::gemm_phase(lds, pg8::Gemm{w.H(), w.WinT() + (size_t)l * 1792 * 1024, NR, 1792, 1024}, po, E);
}

extern __shared__ __attribute__((aligned(16))) unsigned char dyn_lds[];

struct EpiUq {
    static constexpr bool PERM = true;
    WS w;
    __device__ __forceinline__ void operator()(const f32x4 (&acc)[2][2][4][2], const pg8::Unit& u, int wr, int wc, int fr, int fq) const {
        const int g = 4 * u.pn + wc; if (g >= 9) return;
        const int pm = u.pm; const bool isctx = pm >= 256; const int b = isctx ? pm - 256 : pm >> 3; const int t0 = isctx ? 0 : (pm & 7) * 256;
        const size_t rowbase = isctx ? (size_t)NL + (size_t)b * CTX : (size_t)b * S;
        const int head = g < 6 ? g : 2 * (g - 6) + (fq >> 1);
#pragma unroll
        for (int ai = 0; ai < 2; ++ai)
#pragma unroll
            for (int m = 0; m < 4; ++m) {
                const int t = t0 + 128 * ai + 64 * wr + 16 * m + fr; const size_t row = rowbase + t;
                const float4 s0 = *(const float4*)(w.SSQ() + row * 8), s1 = *(const float4*)(w.SSQ() + row * 8 + 4);
                const float rstd = rsqrtf((s0.x + s0.y + s0.z + s0.w + s1.x + s1.y) * (1.f / 384.f) + EPS) * ATT_C2M;
                float v[2][8];
#pragma unroll
                for (int bj = 0; bj < 2; ++bj)
#pragma unroll
                    for (int n = 0; n < 2; ++n)
#pragma unroll
                        for (int i = 0; i < 4; ++i) v[bj][4 * n + i] = acc[ai][bj][m][n][i] * rstd;
                bf16_t* hd = isctx ? w.Qmc() + (((size_t)b * 6 + head) * CTX + t) * 96 : w.Qm() + (((size_t)b * 6 + head) * S + t) * 96;
                if (g >= 6 && !isctx) {
#pragma unroll
                    for (int q = 0; q < 8; ++q) { const float2 cs = w.ROPC()[t * 16 + 8 * (fq & 1) + q]; const float x1 = v[0][q], x2 = v[1][q]; v[0][q] = x1 * cs.x - x2 * cs.y; v[1][q] = x1 * cs.y + x2 * cs.x; } }
#pragma unroll
                for (int bj = 0; bj < 2; ++bj) { u32x4 o; o.x = cvt_pk_bf16(v[bj][0], v[bj][1]); o.y = cvt_pk_bf16(v[bj][2], v[bj][3]); o.z = cvt_pk_bf16(v[bj][4], v[bj][5]); o.w = cvt_pk_bf16(v[bj][6], v[bj][7]);
                    bf16_t* d = g < 6 ? hd + 32 * bj + 8 * fq : hd + 64 + 16 * bj + 8 * (fq & 1);
                    *(u32x4*)d = o; }
            }
    }
};
struct EpiUkv {
    static constexpr bool PERM = true;
    WS w;
    __device__ __forceinline__ void operator()(const f32x4 (&acc)[2][2][4][2], const pg8::Unit& u, int wr, int wc, int fr, int fq) const {
        const int g = 4 * u.pn + wc;
        const int pm = u.pm; const bool isctx = pm >= 256; const int b = isctx ? pm - 256 : pm >> 3; const int t0 = isctx ? 0 : (pm & 7) * 256;
        const size_t rowbase = isctx ? (size_t)NL + (size_t)b * CTX : (size_t)b * S; const int keyoff = isctx ? 0 : CTX;
        bf16_t* base = ((g & 1) ? w.Vm() : w.Kmn()) + ((size_t)b * 6 + (g >> 1)) * KEYS * 64;
#pragma unroll
        for (int ai = 0; ai < 2; ++ai)
#pragma unroll
            for (int m = 0; m < 4; ++m) {
                const int t = t0 + 128 * ai + 64 * wr + 16 * m + fr; const size_t row = rowbase + t;
                const float4 s0 = *(const float4*)(w.SSKV() + row * 4);
                const float rstd = rsqrtf((s0.x + s0.y + s0.z + s0.w) * (1.f / 256.f) + EPS);
                bf16_t* d = base + (size_t)(keyoff + t) * 64;
#pragma unroll
                for (int bj = 0; bj < 2; ++bj) { const f32x4 a0 = acc[ai][bj][m][0] * rstd, a1 = acc[ai][bj][m][1] * rstd;
                    u32x4 o; o.x = cvt_pk_bf16(a0[0], a0[1]); o.y = cvt_pk_bf16(a0[2], a0[3]); o.z = cvt_pk_bf16(a1[0], a1[1]); o.w = cvt_pk_bf16(a1[2], a1[3]);
                    *(u32x4*)(d + 32 * bj + 8 * fq) = o; }
            }
    }
};
constexpr int POOL_X = 0, POOL_P = 272 * 128, POOL_BYTES = 272 * 128 + 256 * 128;
template <int G>
__device__ __forceinline__ void pool_sums(LAS unsigned char* lds, int tid, int t0, int L) {
    constexpr int wdw = 2 << G, half = wdw >> 1, NX = 32 + wdw - 1;
    const int c = tid & 63, seg = tid >> 6; const LAS bf16_t* X = (const LAS bf16_t*)(lds + POOL_X) + c + (seg * 32 + 8 - half) * 64;
    const int tb = t0 + seg * 32;
    float xr[NX], xm[NX];
#pragma unroll
    for (int j = 0; j < NX; ++j) xr[j] = bf2f(X[j * 64]);
#pragma unroll
    for (int j = 0; j < NX; ++j) { const int row = tb - half + j; xm[j] = (row >= 0 && row < L) ? xr[j] : 0.f; }
    float sum = 0.f;
#pragma unroll
    for (int j = 0; j < wdw; ++j) sum += xm[j];
#pragma unroll
    for (int k = 0; k < 32; ++k) {
        const int t = tb + k; const int clo = (t - half) < 0 ? 0 : (t - half), chi = (t - half + wdw) > L ? L : (t - half + wdw);
        const float pv = sum / (float)(chi - clo) - xr[k + half];
        const int r = seg * 32 + k; *((LAS bf16_t*)(lds + POOL_P + r * 128 + (((c >> 3) ^ ((r >> 1) & 7)) << 4)) + (c & 7)) = f2bf(pv);
        if (k < 31) sum += xm[k + wdw] - xm[k];
    }
}
__device__ __forceinline__ void phase_pool(LAS unsigned char* lds, const WS& w, bf16_t* __restrict__ MIX, const bf16_t* __restrict__ WT  , const float* __restrict__ pool_scale, int nrows, int vb, int nvb) {
    int tid_ = threadIdx.x; asm volatile("" : "+v"(tid_));
    const int tid = tid_, lane = tid & 63, wid = __builtin_amdgcn_readfirstlane(tid >> 6), r32 = lane & 31, hi = lane >> 5;
    const int nunits = nrows >> 8;
    const int nmine = vb < nunits ? ((nunits - 1 - vb) / nvb + 1) * 4 : 0;
    u32x4 st[5];
#define POOL_FETCH(it_) do { const int u_ = vb + ((it_) >> 2) * nvb, g_ = (it_) & 3; const int row0_ = u_ << 8; const bool ic_ = row0_ >= NL; const int L_ = ic_ ? CTX : S; const int t0_ = ic_ ? 0 : (row0_ & (S - 1)); const int seq0_ = row0_ - t0_; \
        _Pragma("unroll") for (int k_ = 0; k_ < 5; ++k_) { int i_ = tid + 512 * k_; i_ = i_ < 272 * 8 ? i_ : 272 * 8 - 1; const int rr_ = i_ >> 3, ch_ = i_ & 7; int t_ = t0_ - 8 + rr_; t_ = t_ < 0 ? 0 : (t_ >= L_ ? L_ - 1 : t_); \
            st[k_] = *(const u32x4*)(w.Bp() + (size_t)(seq0_ + t_) * 256 + g_ * 64 + ch_ * 8); } } while (0)
    if (nmine > 0) POOL_FETCH(0);
    for (int it = 0; it < nmine; ++it) {
        const int u = vb + (it >> 2) * nvb, g = it & 3;
        const int row0 = u << 8; const bool isctx = row0 >= NL; const int L = isctx ? CTX : S; const int t0 = isctx ? 0 : (row0 & (S - 1));
        {
#pragma unroll
            for (int k = 0; k < 5; ++k) { const int i = tid + 512 * k; if (i < 272 * 8) *(LAS u32x4*)(lds + POOL_X + (i >> 3) * 128 + (i & 7) * 16) = st[k]; }
            { const int nx = it + 1 < nmine ? it + 1 : it; POOL_FETCH(nx); }
            __syncthreads();
            if (g == 0) pool_sums<0>(lds, tid, t0, L); else if (g == 1) pool_sums<1>(lds, tid, t0, L); else if (g == 2) pool_sums<2>(lds, tid, t0, L); else pool_sums<3>(lds, tid, t0, L);
            __syncthreads();
            { f32x16 o0 = {}, o1 = {};
              const bf16_t* wt = WT + (size_t)g * 4096 + (size_t)r32 * 64 + 8 * hi;
#pragma unroll
              for (int s = 0; s < 4; ++s) { const int row = wid * 32 + r32; const bf16x8 pf = *(const LAS bf16x8*)(lds + POOL_P + row * 128 + (((2 * s + hi) ^ ((row >> 1) & 7)) << 4));
                  o0 = mfma32(*(const bf16x8*)(wt + 16 * s), pf, o0); o1 = mfma32(*(const bf16x8*)(wt + 32 * 64 + 16 * s), pf, o1); }
              bf16_t* op = MIX + (size_t)(row0 + wid * 32 + r32) * 1024 + 384 + g * 64 + 4 * hi; const float* ps = pool_scale + g * 64 + 4 * hi;
#pragma unroll
              for (int q = 0; q < 4; ++q) { const f32x4 s0 = *(const f32x4*)(ps + 8 * q), s1 = *(const f32x4*)(ps + 32 + 8 * q); u32x2 a, b;
                  a.x = cvt_pk_bf16(o0[4 * q] * s0[0], o0[4 * q + 1] * s0[1]); a.y = cvt_pk_bf16(o0[4 * q + 2] * s0[2], o0[4 * q + 3] * s0[3]);
                  b.x = cvt_pk_bf16(o1[4 * q] * s1[0], o1[4 * q + 1] * s1[1]); b.y = cvt_pk_bf16(o1[4 * q + 2] * s1[2], o1[4 * q + 3] * s1[3]);
                  *(u32x2*)(op + 8 * q) = a; *(u32x2*)(op + 32 + 8 * q) = b; } }
            __syncthreads();
        }
    }
#undef POOL_FETCH
}
__device__ __forceinline__ void phase_p2(LAS unsigned char* lds, const WS& w, const Inputs& in, int l, int vb, int nvb, int parts = 7) {
    pg8::StaticOrder so;
    if (parts & 1) { EpiUq E{w}; const int M = l == 0 ? NR : NL; so.init(M, 768, nvb, vb); pg8::gemm_phase(lds, pg8::Gemm{w.CQ(), w.WuqT() + (size_t)l * 768 * 384, M, 768, 384}, so, E); }
    if (parts & 2) { EpiUkv E{w}; so.init(NR, 768, nvb, vb); pg8::gemm_phase(lds, pg8::Gemm{w.CKV(), w.WukvT() + (size_t)l * 768 * 256, NR, 768, 256}, so, E); }
    if (parts & 4) phase_pool(lds, w, w.H(), w.PoolWT() + (size_t)l * 4 * 64 * 64, in.pool_scale + l * 256, l == 0 ? NR : NL, vb, nvb);
}

struct EpiOut {
    static constexpr bool PERM = true;
    bf16_t* DLT; const float* gate;
    __device__ __forceinline__ void operator()(const f32x4 (&acc)[2][2][4][2], const pg8::Unit& u, int wr, int wc, int fr, int fq) const {
        const int pm = u.pm; const int mr = pm >= 256 ? 32 : pm >> 3;
        const size_t r0 = (size_t)pm * 256 + wr * 64 + fr; const int col0 = u.pn * 256 + wc * 32 + 8 * fq;
        f32x4 gv[2][2];
#pragma unroll
        for (int bj = 0; bj < 2; ++bj)
#pragma unroll
            for (int n = 0; n < 2; ++n) gv[bj][n] = *(const f32x4*)(gate + (size_t)mr * 6144 + col0 + bj * 128 + 4 * n);
#pragma unroll
        for (int ai = 0; ai < 2; ++ai)
#pragma unroll
            for (int m = 0; m < 4; ++m) { bf16_t* d = DLT + (r0 + ai * 128 + m * 16) * 1024 + col0;
#pragma unroll
                for (int bj = 0; bj < 2; ++bj) { const f32x4 a0 = acc[ai][bj][m][0] * gv[bj][0], a1 = acc[ai][bj][m][1] * gv[bj][1];
                    u32x4 o; o.x = cvt_pk_bf16(a0[0], a0[1]); o.y = cvt_pk_bf16(a0[2], a0[3]); o.z = cvt_pk_bf16(a1[0], a1[1]); o.w = cvt_pk_bf16(a1[2], a1[3]);
                    *(u32x4*)(d + bj * 128) = o; } }
    }
};
__device__ __forceinline__ void phase_p4(LAS unsigned char* lds, const WS& w, const Inputs& in, int l, int vb, int nvb) {
    const float* MODl = w.MOD() + (size_t)l * 33 * 6144;
    EpiOut E{w.PQ(), MODl + 2 * 1024};
    const int M = l == 0 ? NR : NL;
    pg8::StaticOrder so; so.init(M, 1024, nvb, vb);
    pg8::gemm_phase(lds, pg8::Gemm{w.H(), w.WoutT() + (size_t)l * 1024 * 1024, M, 1024, 1024}, so, E);
}

template <bool INBF>
__device__ __forceinline__ void phase_modulate(const float* __restrict__ XLp, const float* __restrict__ XCp, const bf16_t* __restrict__ XBp, bf16_t* __restrict__ Hout, const float* __restrict__ g, const float* __restrict__ MODl, int si, int nrows, int vb, int nvb,
                                               signed char* __restrict__ H8 = nullptr, float* __restrict__ HS = nullptr, const bf16_t* __restrict__ DLT = nullptr, bf16_t* __restrict__ XBo = nullptr) {
    int tid_ = threadIdx.x; asm volatile("" : "+v"(tid_));
    const int tid = tid_, lane = tid & 63, wid = tid >> 6;
    f32x4 gv[4];
#pragma unroll
    for (int i = 0; i < 4; ++i) gv[i] = *(const f32x4*)(g + 256 * i + 4 * lane);
    const int stride = nvb * 8, lastrow = nrows - 1;
    f32x4 nx[4]; u32x2 nxb[4], ndr[4];
#define PM_LOAD(r_) do { const int rr_ = (r_) < nrows ? (r_) : lastrow; const bool ic_ = rr_ >= NL; const float* xp_ = ic_ ? XCp + (size_t)(rr_ - NL) * 1024 : XLp + (size_t)rr_ * 1024; \
        _Pragma("unroll") for (int i = 0; i < 4; ++i) { if (INBF) nxb[i] = *(const u32x2*)(XBp + (size_t)rr_ * 1024 + 256 * i + 4 * lane); else nx[i] = *(const f32x4*)(xp_ + 256 * i + 4 * lane); \
            if (DLT) ndr[i] = *(const u32x2*)(DLT + (size_t)rr_ * 1024 + 256 * i + 4 * lane); } } while (0)
    PM_LOAD(vb * 8 + wid);
    for (int row = vb * 8 + wid; row < nrows; row += stride) {
        const bool isctx = row >= NL; const int mr = isctx ? 32 : row / S;
        f32x4 x[4]; u32x2 dr4[4]; float ss = 0.f;
#pragma unroll
        for (int i = 0; i < 4; ++i) { if (INBF) x[i] = (f32x4){__uint_as_float(nxb[i].x << 16), __uint_as_float(nxb[i].x & 0xffff0000u), __uint_as_float(nxb[i].y << 16), __uint_as_float(nxb[i].y & 0xffff0000u)}; else x[i] = nx[i];
            if (DLT) dr4[i] = ndr[i]; }
        PM_LOAD(row + stride);
#pragma unroll
        for (int i = 0; i < 4; ++i) {
            if (DLT) { const u32x2 dr = dr4[i];
                x[i][0] += __uint_as_float(dr.x << 16); x[i][1] += __uint_as_float(dr.x & 0xffff0000u); x[i][2] += __uint_as_float(dr.y << 16); x[i][3] += __uint_as_float(dr.y & 0xffff0000u);
                u32x2 xo; xo.x = cvt_pk_bf16(x[i][0], x[i][1]); xo.y = cvt_pk_bf16(x[i][2], x[i][3]); *(u32x2*)(XBo + (size_t)row * 1024 + 256 * i + 4 * lane) = xo; }
            ss += x[i][0] * x[i][0] + x[i][1] * x[i][1] + x[i][2] * x[i][2] + x[i][3] * x[i][3]; }
        ss = wave_sum(ss); const float rstd = rsqrtf(ss * (1.f / 1024.f) + EPS);
        const float* sh = MODl + (size_t)mr * 6144 + si * 1024;
        f32x4 y[4]; float am = 0.f;
#pragma unroll
        for (int i = 0; i < 4; ++i) { const f32x4 shv = *(const f32x4*)(sh + 256 * i + 4 * lane), scv = *(const f32x4*)(sh + 1024 + 256 * i + 4 * lane);
            y[i] = x[i] * rstd * gv[i] * (scv + 1.f) + shv;
            am = fmaxf(am, fmaxf(fmaxf(fabsf(y[i][0]), fabsf(y[i][1])), fmaxf(fabsf(y[i][2]), fabsf(y[i][3]))));
            u32x2 o; o.x = cvt_pk_bf16(y[i][0], y[i][1]); o.y = cvt_pk_bf16(y[i][2], y[i][3]);
            *(u32x2*)(Hout + (size_t)row * 1024 + 256 * i + 4 * lane) = o; }
        if (H8) {
#pragma unroll
            for (int o = 32; o > 0; o >>= 1) am = fmaxf(am, __shfl_xor(am, o));
            const float inv = am > 0.f ? 127.f / am : 0.f;
#pragma unroll
            for (int i = 0; i < 4; ++i) { const int q0 = (int)rintf(y[i][0] * inv), q1 = (int)rintf(y[i][1] * inv), q2 = (int)rintf(y[i][2] * inv), q3 = (int)rintf(y[i][3] * inv);
                *(unsigned*)(H8 + (size_t)row * 1024 + 256 * i + 4 * lane) = (unsigned)(q0 & 0xff) | ((unsigned)(q1 & 0xff) << 8) | ((unsigned)(q2 & 0xff) << 16) | ((unsigned)(q3 & 0xff) << 24); }
            if (lane == 0) HS[row] = am > 0.f ? am * (1.f / 127.f) : 1.f;
        }
    }
#undef PM_LOAD
}

struct EpiPQ {
    static constexpr bool PERM = true;
    bf16_t* PQ;
    __device__ __forceinline__ void operator()(const f32x4 (&acc)[2][2][4][2], const pg8::Unit& u, int wr, int wc, int fr, int fq) const {
        const size_t r0 = (size_t)u.pm * 256 + wr * 64 + fr; const int col0 = u.pn * 256 + wc * 32 + 8 * fq;
#pragma unroll
        for (int ai = 0; ai < 2; ++ai)
#pragma unroll
            for (int m = 0; m < 4; ++m) { bf16_t* d = PQ + (r0 + ai * 128 + m * 16) * 2048 + col0;
#pragma unroll
                for (int bj = 0; bj < 2; ++bj) { const f32x4 a0 = acc[ai][bj][m][0], a1 = acc[ai][bj][m][1];
                    u32x4 o; o.x = cvt_pk_bf16(a0[0], a0[1]); o.y = cvt_pk_bf16(a0[2], a0[3]); o.z = cvt_pk_bf16(a1[0], a1[1]); o.w = cvt_pk_bf16(a1[2], a1[3]);
                    *(u32x4*)(d + bj * 128) = o; } }
    }
};
__device__ __forceinline__ void phase_p6a(LAS unsigned char* lds, const WS& w, int l, int vb, int nvb) {
    EpiPQ E{w.PQ()}; const int M = l == 0 ? NR : NL;
    pg8::StaticOrder so; so.init(M, 2048, nvb, vb);
    pg8::gemm_phase(lds, pg8::Gemm{w.H(), w.WqT() + (size_t)l * 2048 * 1024, M, 2048, 1024}, so, E);
}


using bf16x2_t = __attribute__((ext_vector_type(2))) __bf16;
typedef float f32x2 __attribute__((ext_vector_type(2)));
__device__ __forceinline__ float gelu_fast(float x) {
    const float u2 = 1.5957691216057308f * (x + 0.044715f * x * x * x);
    return x * __builtin_amdgcn_rcpf(1.f + __builtin_amdgcn_exp2f(-1.4426950408889634f * u2));
}
#define DPPF(v, ctrl) __builtin_bit_cast(float, __builtin_amdgcn_update_dpp(0, __builtin_bit_cast(int, (v)), (ctrl), 0xf, 0xf, true))
__device__ __forceinline__ float reduce8(float p0, float p1, float p2, float p3, float p4, float p5, float p6, float p7, int lane) {
    auto s01 = __builtin_amdgcn_permlane32_swap(__float_as_uint(p0), __float_as_uint(p1), false, false);
    auto s23 = __builtin_amdgcn_permlane32_swap(__float_as_uint(p2), __float_as_uint(p3), false, false);
    auto s45 = __builtin_amdgcn_permlane32_swap(__float_as_uint(p4), __float_as_uint(p5), false, false);
    auto s67 = __builtin_amdgcn_permlane32_swap(__float_as_uint(p6), __float_as_uint(p7), false, false);
    const float q0 = __uint_as_float(s01[0]) + __uint_as_float(s01[1]), q1 = __uint_as_float(s23[0]) + __uint_as_float(s23[1]);
    const float q2 = __uint_as_float(s45[0]) + __uint_as_float(s45[1]), q3 = __uint_as_float(s67[0]) + __uint_as_float(s67[1]);
    auto t0 = __builtin_amdgcn_permlane16_swap(__float_as_uint(q0), __float_as_uint(q1), false, false);
    auto t1 = __builtin_amdgcn_permlane16_swap(__float_as_uint(q2), __float_as_uint(q3), false, false);
    float r0 = __uint_as_float(t0[0]) + __uint_as_float(t0[1]);
    float r1 = __uint_as_float(t1[0]) + __uint_as_float(t1[1]);
    r0 += DPPF(r0, 0x128); r1 += DPPF(r1, 0x128);
    float z = (lane & 8) ? r1 : r0;
    z += DPPF(z, 0x141);
    z += DPPF(z, 0xB1);
    z += DPPF(z, 0x4E);
    return z;
}
__device__ __forceinline__ void p7_axpy(const u32x4 v, float wj, f32x2 (&out)[8]) {
    const f32x2 w2 = {wj, wj};
#pragma unroll
    for (int k = 0; k < 4; ++k) { const f32x2 lo = __builtin_amdgcn_cvt_pk_f32_fp8((int)v[k], false), hi2 = __builtin_amdgcn_cvt_pk_f32_fp8((int)v[k], true);
        out[2 * k] = __builtin_elementwise_fma(w2, lo, out[2 * k]); out[2 * k + 1] = __builtin_elementwise_fma(w2, hi2, out[2 * k + 1]); }
}
__device__ __forceinline__ int p7_doti(const u32x4 u, const u32x4 h) {
    int s = __builtin_amdgcn_sdot4((int)u[0], (int)h[0], 0, false); s = __builtin_amdgcn_sdot4((int)u[1], (int)h[1], s, false); s = __builtin_amdgcn_sdot4((int)u[2], (int)h[2], s, false); return __builtin_amdgcn_sdot4((int)u[3], (int)h[3], s, false);
}
#define DPPI(v, ctrl) __builtin_amdgcn_update_dpp(0, (v), (ctrl), 0xf, 0xf, true)
__device__ __forceinline__ int reduce8i(int p0, int p1, int p2, int p3, int p4, int p5, int p6, int p7, int lane) {
    auto s01 = __builtin_amdgcn_permlane32_swap((unsigned)p0, (unsigned)p1, false, false); auto s23 = __builtin_amdgcn_permlane32_swap((unsigned)p2, (unsigned)p3, false, false);
    auto s45 = __builtin_amdgcn_permlane32_swap((unsigned)p4, (unsigned)p5, false, false); auto s67 = __builtin_amdgcn_permlane32_swap((unsigned)p6, (unsigned)p7, false, false);
    const unsigned q0 = s01[0] + s01[1], q1 = s23[0] + s23[1], q2 = s45[0] + s45[1], q3 = s67[0] + s67[1];
    auto t0 = __builtin_amdgcn_permlane16_swap(q0, q1, false, false); auto t1 = __builtin_amdgcn_permlane16_swap(q2, q3, false, false);
    int r0 = (int)(t0[0] + t0[1]), r1 = (int)(t1[0] + t1[1]);
    r0 += DPPI(r0, 0x128); r1 += DPPI(r1, 0x128);
    int z = (lane & 8) ? r1 : r0;
    z += DPPI(z, 0x141); z += DPPI(z, 0xB1); z += DPPI(z, 0x4E);
    return z;
}

struct P7CArgs { const signed char* H8; const unsigned* EG; const unsigned char* U8; int* PART; int nrows; };
__device__ __forceinline__ int p7_doti4(const u32x4 u, const u32x4 h0, const u32x4 h1) {
    int s = 0;
#pragma unroll
    for (int k = 0; k < 4; ++k) { const unsigned lo = (u[k] << 4) & 0xf0f0f0f0u, hi = u[k] & 0xf0f0f0f0u;
        const unsigned ha = (k < 2) ? h0[2 * k] : h1[2 * k - 4], hb = (k < 2) ? h0[2 * k + 1] : h1[2 * k - 3];
        s = __builtin_amdgcn_sdot4((int)lo, (int)ha, s, false); s = __builtin_amdgcn_sdot4((int)hi, (int)hb, s, false); }
    return s;
}
__device__ __forceinline__ void phase_p7c(LAS unsigned char* lds, const P7CArgs& a, int part8, int prank8, int nvb) {
    int tid_ = threadIdx.x; asm volatile("" : "+v"(tid_));
    const int lane = tid_ & 63, wid = __builtin_amdgcn_readfirstlane(tid_ >> 6);
    const int part = part8 >> 1, prank = (part8 & 1) * (nvb >> 3) + prank8;
    const int nw = (nvb >> 2) * 8, wrank = prank * 8 + wid;
    LAS unsigned* tab = (LAS unsigned*)(lds + wid * 1024);
    const int grp = lane >> 3, c = lane & 7, c16 = c * 16;
    const unsigned char* ubase = a.U8 + (size_t)part * NE * 128 + c16;
    const signed char* hbase = a.H8 + 256 * part + 32 * c;
    unsigned* pbase = (unsigned*)a.PART + (size_t)part * a.nrows * 64;
    const int c2 = (c >> 2) & 1, c1 = (c >> 1) & 1, c0 = c & 1;
    const int ent0 = 8 * (4 * c2 + 2 * c0 + c1) + grp;
    u32x4 Av[16], Bv[16]; u32x4 Ah0, Ah1, Bh0, Bh1;
    unsigned pw0 = 0u, pw1 = 0u;
#define P7C_PREF(t) do { pw0 = a.EG[(size_t)(t) * 128 + lane]; pw1 = a.EG[(size_t)(t) * 128 + 64 + lane]; } while (0)
#define P7C_ISSUE(X, Xh0, Xh1, t, slot, tnext) do { LAS unsigned* tb_ = tab + (slot) * 128; \
        tb_[lane] = pw0; tb_[64 + lane] = pw1; \
        asm volatile("s_waitcnt lgkmcnt(0)" ::: "memory"); \
        _Pragma("unroll") for (int i_ = 0; i_ < 16; ++i_) { const unsigned e_ = tb_[8 * i_ + grp]; X[i_] = *(const u32x4*)(ubase + (size_t)(e_ >> 16) * 128); } \
        Xh0 = *(const u32x4*)(hbase + (size_t)(t) * 1024); Xh1 = *(const u32x4*)(hbase + (size_t)(t) * 1024 + 16); \
        P7C_PREF(tnext); } while (0)
#define P7C_REDUCE(t, valid) do { \
        int e8_[8]; _Pragma("unroll") for (int k = 0; k < 8; ++k) { const int send_ = c2 ? d_[k] : d_[k + 8], keep_ = c2 ? d_[k + 8] : d_[k]; e8_[k] = keep_ + DPPI(send_, 0x141); }            \
        int e4_[4]; _Pragma("unroll") for (int k = 0; k < 4; ++k) { const int send_ = c0 ? e8_[k] : e8_[k + 4], keep_ = c0 ? e8_[k + 4] : e8_[k]; e4_[k] = keep_ + DPPI(send_, 0xB1); }          \
        int e2_[2]; _Pragma("unroll") for (int k = 0; k < 2; ++k) { const int send_ = c1 ? e4_[k] : e4_[k + 2], keep_ = c1 ? e4_[k + 2] : e4_[k]; e2_[k] = keep_ + DPPI(send_, 0x4E); }          \
        if (valid) pbase[(size_t)(t) * 64 + ent0] = __builtin_bit_cast(unsigned, __builtin_amdgcn_cvt_pk_i16(e2_[0] >> 4, e2_[1] >> 4)); } while (0)
#define P7C_COMPUTE_REFILL(X, Xh0, Xh1, t, valid, tn, slot, tnext) do { LAS unsigned* tb_ = tab + (slot) * 128; \
        tb_[lane] = pw0; tb_[64 + lane] = pw1; \
        asm volatile("s_waitcnt lgkmcnt(0)" ::: "memory"); \
        unsigned ne_[16]; _Pragma("unroll") for (int i_ = 0; i_ < 16; ++i_) ne_[i_] = tb_[8 * i_ + grp]; \
        P7C_PREF(tnext); \
        int d_[16]; \
        _Pragma("unroll") for (int i_ = 0; i_ < 16; ++i_) { d_[i_] = p7_doti4(X[i_], Xh0, Xh1); X[i_] = *(const u32x4*)(ubase + (size_t)(ne_[i_] >> 16) * 128); } \
        Xh0 = *(const u32x4*)(hbase + (size_t)(tn) * 1024); Xh1 = *(const u32x4*)(hbase + (size_t)(tn) * 1024 + 16); \
        P7C_REDUCE(t, valid); } while (0)
    const int lastrow = a.nrows - 1;
    int t = wrank;
    if (t < a.nrows) {
    P7C_PREF(t);
    const int ta1 = t + nw < a.nrows ? t + nw : lastrow, ta2 = t + 2 * nw < a.nrows ? t + 2 * nw : lastrow;
    P7C_ISSUE(Av, Ah0, Ah1, t, 0, ta1);
    P7C_ISSUE(Bv, Bh0, Bh1, ta1, 1, ta2);
    while (t < a.nrows) {
        const int t1 = t + nw, t2 = t1 + nw, t3 = t2 + nw, t4 = t3 + nw;
        const int k1 = t1 < a.nrows ? t1 : lastrow, k2 = t2 < a.nrows ? t2 : lastrow, k3 = t3 < a.nrows ? t3 : lastrow, k4 = t4 < a.nrows ? t4 : lastrow;
        P7C_COMPUTE_REFILL(Av, Ah0, Ah1, t, true, k2, 0, k3);
        P7C_COMPUTE_REFILL(Bv, Bh0, Bh1, k1, (t1 < a.nrows), k3, 1, k4);
        t = t2;
    }
    }
#undef P7C_PREF
#undef P7C_ISSUE
#undef P7C_REDUCE
#undef P7C_COMPUTE_REFILL
}
__device__ __forceinline__ void phase_p7d(const int* __restrict__ PART, const unsigned* __restrict__ EG, const float* __restrict__ US, const float* __restrict__ VS, const float* __restrict__ HS, unsigned* __restrict__ WE, int nrows, int vb, int nvb) {
    int tid_ = threadIdx.x; asm volatile("" : "+v"(tid_));
    typedef int i32x4 __attribute__((ext_vector_type(4)));
    const size_t n16 = (size_t)nrows * 16, pstride4 = n16;
    const u32x4* P4 = (const u32x4*)PART; const u32x4* EG4 = (const u32x4*)EG; u32x4* WE4 = (u32x4*)WE;
    for (size_t j = (size_t)vb * 512 + tid_; j < n16; j += (size_t)nvb * 512) {
        const size_t row = j >> 4; const int P = (int)(j >> 1) & 7, gq = (int)j & 1;
        i32x4 slo = {0, 0, 0, 0}, shi = {0, 0, 0, 0};
#pragma unroll
        for (int p = 0; p < 4; ++p) { const u32x4 d = P4[p * pstride4 + j];
#pragma unroll
            for (int k = 0; k < 4; ++k) { slo[k] += (int)(d[k] << 16) >> 16; shi[k] += (int)d[k] >> 16; } }
        const float hs = HS[row];
#pragma unroll
        for (int half = 0; half < 2; ++half) {
            const size_t ei = row * 32 + 4 * P + 2 * half + gq;
            const u32x4 eg = EG4[ei]; u32x4 o;
#pragma unroll
            for (int k = 0; k < 4; ++k) { const int eid = (int)(eg[k] >> 16);
                const float av = (float)(half ? shi[k] : slo[k]) * US[eid] * hs;
                const float wv = __uint_as_float(eg[k] << 16) * gelu_fast(av) * VS[eid];
                o[k] = (eg[k] & 0xffff0000u) | (cvt_pk_bf16(wv, 0.f) & 0xffffu); }
            WE4[ei] = o;
        }
    }
}
struct P7BArgs { const unsigned* WE; const unsigned char* V8; bf16_t* XB; const float* gate2; int nrows; };
__device__ __forceinline__ void p7_axpy4(const u32x4 v, float wj, f32x2 (&out)[16]) {
    const f32x2 w2 = {wj, wj};
#pragma unroll
    for (int k = 0; k < 4; ++k) {
        const f32x2 a0 = __builtin_amdgcn_cvt_scalef32_pk_f32_fp4(v[k], 1.0f, 0), a1 = __builtin_amdgcn_cvt_scalef32_pk_f32_fp4(v[k], 1.0f, 1), a2 = __builtin_amdgcn_cvt_scalef32_pk_f32_fp4(v[k], 1.0f, 2), a3 = __builtin_amdgcn_cvt_scalef32_pk_f32_fp4(v[k], 1.0f, 3);
        out[4 * k] = __builtin_elementwise_fma(w2, a0, out[4 * k]); out[4 * k + 1] = __builtin_elementwise_fma(w2, a1, out[4 * k + 1]);
        out[4 * k + 2] = __builtin_elementwise_fma(w2, a2, out[4 * k + 2]); out[4 * k + 3] = __builtin_elementwise_fma(w2, a3, out[4 * k + 3]); }
}
template <int PM>
__device__ __forceinline__ void phase_p7b(LAS unsigned char* lds, const P7BArgs& a, int part8, int prank8, int nvb) {
    int tid_ = threadIdx.x; asm volatile("" : "+v"(tid_));
    const int lane = tid_ & 63, wid = __builtin_amdgcn_readfirstlane(tid_ >> 6);
    const int part = part8 >> 1, prank = (part8 & 1) * (nvb >> 3) + prank8;
    const int nw = (nvb >> 2) * 8, wrank = prank * 8 + wid;
    LAS unsigned* tab = (LAS unsigned*)(lds + wid * 1024);
    const int grp = lane >> 3, c16 = (lane & 7) * 16;
    const unsigned char* vbase = a.V8 + (size_t)part * NE * 128 + c16;
    const int colofs = 256 * part + 2 * c16 + 16 * (lane >> 5) + 8 * ((lane >> 4) & 1) + 4 * ((lane >> 3) & 1);
    u32x4 Av[16], Bv[16]; float Aw[16], Bw[16]; u32x2 Ax, Bx; f32x4 Ag, Bg;
    unsigned pw0 = 0u, pw1 = 0u;
#define P7B_PREF(t) do { pw0 = a.WE[(size_t)(t) * 128 + lane]; pw1 = a.WE[(size_t)(t) * 128 + 64 + lane]; } while (0)
#define P7B_ISSUE(X, Xw, Xx, Xg, t, slot, tnext) do { LAS unsigned* tb_ = tab + (slot) * 128; \
        tb_[lane] = pw0; tb_[64 + lane] = pw1; \
        asm volatile("s_waitcnt lgkmcnt(0)" ::: "memory"); \
        _Pragma("unroll") for (int i_ = 0; i_ < 16; ++i_) { const unsigned we_ = tb_[8 * i_ + grp]; Xw[i_] = __uint_as_float(we_ << 16); X[i_] = *(const u32x4*)(vbase + (size_t)(we_ >> 16) * 128); } \
        { const int mr_ = (t) >= NL ? 32 : (t) / S; \
          Xx = *(const u32x2*)(a.XB + (size_t)(t) * 1024 + colofs); Xg = *(const f32x4*)(a.gate2 + (size_t)mr_ * 6144 + colofs); } \
        P7B_PREF(tnext); } while (0)
#define P7B_COMPUTE(X, Xw, Xx, Xg, t, valid) do { f32x2 acc2[16]; \
        _Pragma("unroll") for (int k = 0; k < 16; ++k) acc2[k] = (f32x2){0.f, 0.f}; \
        _Pragma("unroll") for (int i_ = 0; i_ < 16; ++i_) p7_axpy4(X[i_], Xw[i_], acc2); \
        float b_[16]; _Pragma("unroll") for (int k = 0; k < 16; ++k) { auto s_ = __builtin_amdgcn_permlane32_swap(__float_as_uint(acc2[k >> 1][k & 1]), __float_as_uint(acc2[(k + 16) >> 1][k & 1]), false, false); b_[k] = __uint_as_float(s_[0]) + __uint_as_float(s_[1]); } \
        float c_[8]; _Pragma("unroll") for (int k = 0; k < 8; ++k) { auto s_ = __builtin_amdgcn_permlane16_swap(__float_as_uint(b_[k]), __float_as_uint(b_[k + 8]), false, false); c_[k] = __uint_as_float(s_[0]) + __uint_as_float(s_[1]); } \
        float d_[4]; _Pragma("unroll") for (int k = 0; k < 4; ++k) { const float send_ = (lane & 8) ? c_[k] : c_[k + 4]; const float keep_ = (lane & 8) ? c_[k + 4] : c_[k]; d_[k] = keep_ + DPPF(send_, 0x128); } \
        u32x2* xp_ = (u32x2*)(a.XB + (size_t)(t) * 1024 + colofs); \
        const float x0_ = __uint_as_float(Xx.x << 16) + Xg[0] * d_[0], x1_ = __uint_as_float(Xx.x & 0xffff0000u) + Xg[1] * d_[1], x2_ = __uint_as_float(Xx.y << 16) + Xg[2] * d_[2], x3_ = __uint_as_float(Xx.y & 0xffff0000u) + Xg[3] * d_[3]; \
        u32x2 xo_; xo_.x = cvt_pk_bf16(x0_, x1_); xo_.y = cvt_pk_bf16(x2_, x3_); \
        if ((valid) && PM == 0) *xp_ = xo_; else if (PM != 0 && x0_ == 1.2345e30f) *xp_ = xo_; } while (0)
    const int lastrow = a.nrows - 1;
    int t = wrank;
    if (t < a.nrows) {
    P7B_PREF(t);
    P7B_ISSUE(Av, Aw, Ax, Ag, t, 0, (t + nw < a.nrows ? t + nw : lastrow));
    while (t < a.nrows) {
        const int t1 = t + nw, t2 = t1 + nw, t3 = t2 + nw;
        const int c1 = t1 < a.nrows ? t1 : lastrow, c2 = t2 < a.nrows ? t2 : lastrow, c3 = t3 < a.nrows ? t3 : lastrow;
        P7B_ISSUE(Bv, Bw, Bx, Bg, c1, 1, c2);
        P7B_COMPUTE(Av, Aw, Ax, Ag, t, true);
        P7B_ISSUE(Av, Aw, Ax, Ag, c2, 0, c3);
        P7B_COMPUTE(Bv, Bw, Bx, Bg, c1, (t1 < a.nrows));
        t = t2;
    }
    }
#undef P7B_PREF
#undef P7B_ISSUE
#undef P7B_COMPUTE
}
__device__ __forceinline__ void phase_final_norm(const bf16_t* __restrict__ XBp, float* __restrict__ OUT, const float* __restrict__ g, int vb, int nvb) {
    int tid_ = threadIdx.x; asm volatile("" : "+v"(tid_));
    const int lane = tid_ & 63, wid = tid_ >> 6;
    for (int row = vb * 8 + wid; row < NL; row += nvb * 8) {
        const bf16_t* xp = XBp + (size_t)row * 1024; f32x4 x[4]; float ss = 0.f;
#pragma unroll
        for (int i = 0; i < 4; ++i) { const u32x2 r = *(const u32x2*)(xp + 256 * i + 4 * lane); x[i] = (f32x4){__uint_as_float(r.x << 16), __uint_as_float(r.x & 0xffff0000u), __uint_as_float(r.y << 16), __uint_as_float(r.y & 0xffff0000u)};
            ss += x[i][0] * x[i][0] + x[i][1] * x[i][1] + x[i][2] * x[i][2] + x[i][3] * x[i][3]; }
        ss = wave_sum(ss); const float rstd = rsqrtf(ss * (1.f / 1024.f) + EPS);
#pragma unroll
        for (int i = 0; i < 4; ++i) *(f32x4*)(OUT + (size_t)row * 1024 + 256 * i + 4 * lane) = x[i] * rstd * *(const f32x4*)(g + 256 * i + 4 * lane);
    }
}

template <int V_> struct IC { static constexpr int value = V_; };
typedef short s16x4 __attribute__((ext_vector_type(4)));
__device__ __forceinline__ s16x4 lds_tr16(const LAS unsigned char* p) { return __builtin_bit_cast(s16x4, __builtin_amdgcn_ds_read_tr16_b64_v4i16((LAS s16x4*)p)); }
constexpr int ATT_BUF = 20480;
__device__ __forceinline__ void glds16(const void* g, unsigned lds_base) {
    unsigned sv; asm volatile("s_mov_b32 %0, m0\n\ts_mov_b32 m0, %2\n\ts_nop 0\n\tglobal_load_lds_dwordx4 %1, off\n\ts_mov_b32 m0, %0" : "=&s"(sv) : "v"(g), "s"(lds_base) : "memory"); }
template <int DK>
__device__ __forceinline__ void attn_unit(LAS unsigned char* lds, const bf16_t* __restrict__ Q, const bf16_t* __restrict__ K1, const bf16_t* __restrict__ K2, const bf16_t* __restrict__ V,
                                          int nkeys, float c2, bf16_t* __restrict__ out) {
    int tid_ = threadIdx.x; asm volatile("" : "+v"(tid_));
    const int tid = tid_, lane = tid & 63, wid = __builtin_amdgcn_readfirstlane(tid >> 6), r32 = lane & 31, hi = lane >> 5;
    constexpr int NS = DK / 16, NM = 2 * NS;
    bf16x8 qf[NS];
    { const bf16_t* qp = Q + (size_t)(wid * 32 + r32) * DK + 8 * hi;
#pragma unroll
      for (int s = 0; s < NS; ++s) qf[s] = *(const bf16x8*)(qp + 16 * s); }
    const int dkey = 8 * wid + (lane >> 3), dkey2 = 16 * (wid & 3) + (lane >> 2);
    const bf16_t* gk1 = K1 + (size_t)dkey * 64 + (((lane & 7) ^ ((dkey >> 1) & 7)) << 3);
    const bf16_t* gv = V + (size_t)dkey * 64 + (((lane & 7) ^ (((dkey >> 1) & 1) << 2)) << 3);
    const bf16_t* gk2 = (DK == 96) ? K2 + (size_t)dkey2 * 32 + (((lane & 3) ^ ((dkey2 >> 2) & 3)) << 3) : nullptr;
    const unsigned lds0 = (unsigned)(size_t)lds;
    const unsigned d_k1 = lds0 + wid * 1024, d_v = lds0 + 8192 + wid * 1024, d_k2 = lds0 + 16384 + (wid & 3) * 1024;
#define ATT_DMA(tile_, slot_) do { const int tt_ = (tile_); glds16(gk1 + (size_t)tt_ * 4096, (unsigned)__builtin_amdgcn_readfirstlane(d_k1 + (slot_) * ATT_BUF)); \
        glds16(gv + (size_t)tt_ * 4096, (unsigned)__builtin_amdgcn_readfirstlane(d_v + (slot_) * ATT_BUF)); \
        if (DK == 96) glds16(gk2 + (size_t)tt_ * 2048, (unsigned)__builtin_amdgcn_readfirstlane(d_k2 + (slot_) * ATT_BUF)); } while (0)
#define ATT_WAIT_BAR() do { if (DK == 96) asm volatile("s_waitcnt vmcnt(3) lgkmcnt(0)\n\ts_barrier" ::: "memory"); else asm volatile("s_waitcnt vmcnt(2) lgkmcnt(0)\n\ts_barrier" ::: "memory"); } while (0)
    unsigned ka[2][4];
#pragma unroll
    for (int kt = 0; kt < 2; ++kt)
#pragma unroll
        for (int s = 0; s < 4; ++s) { const int key = 32 * kt + r32; ka[kt][s] = key * 128 + (((2 * s + hi) ^ ((key >> 1) & 7)) << 4); }
    unsigned kb[2][2];
#pragma unroll
    for (int kt = 0; kt < 2; ++kt)
#pragma unroll
        for (int s = 0; s < 2; ++s) { const int key = 32 * kt + r32; kb[kt][s] = 16384 + key * 64 + (((2 * s + hi) ^ ((key >> 2) & 3)) << 4); }
    const int vq = (lane & 15) >> 2, vp = lane & 3, vg = (lane >> 4) & 1;
    unsigned va[2];
#pragma unroll
    for (int dvb = 0; dvb < 2; ++dvb) { const int key = 4 * hi + vq; va[dvb] = 8192 + key * 128 + ((((32 * dvb + 16 * vg + 4 * vp) * 2)) ^ (((key >> 1) & 1) << 6)); }
    float m = -1e30f, l = 0.f, mx;
    f32x16 o0 = {}, o1 = {};
    const int NT = nkeys >> 6;
    ATT_DMA(0, 0); ATT_DMA(NT > 1 ? 1 : 0, 1); ATT_DMA(NT > 2 ? 2 : NT - 1, 2);
    asm volatile("s_waitcnt vmcnt(0) lgkmcnt(0)\n\ts_barrier" ::: "memory");
    f32x16 pa0 = {}, pa1 = {}, pb0 = {}, pb1 = {};
    {
        bf16x8 kf0[NS], kf1[NS];
#pragma unroll
        for (int s = 0; s < 4; ++s) { kf0[s] = *(const LAS bf16x8*)(lds + ka[0][s]); kf1[s] = *(const LAS bf16x8*)(lds + ka[1][s]); }
        if (DK == 96) {
#pragma unroll
            for (int s = 0; s < 2; ++s) { kf0[4 + s] = *(const LAS bf16x8*)(lds + kb[0][s]); kf1[4 + s] = *(const LAS bf16x8*)(lds + kb[1][s]); }
        }
#pragma unroll
        for (int s = 0; s < NS; ++s) { pa0 = mfma32(kf0[s], qf[s], pa0); pa1 = mfma32(kf1[s], qf[s], pa1); }
        mx = pa0[0];
#pragma unroll
        for (int r = 1; r < 16; ++r) mx = fmaxf(mx, pa0[r]);
#pragma unroll
        for (int r = 0; r < 16; ++r) mx = fmaxf(mx, pa1[r]);
    }
    auto step = [&](auto bc_, auto bn_, auto bw_, f32x16& pc0, f32x16& pc1, f32x16& pn0, f32x16& pn1, int t) __attribute__((always_inline)) {
        constexpr int BC = decltype(bc_)::value * ATT_BUF, BN = decltype(bn_)::value * ATT_BUF;
        ATT_DMA((t + 3 < NT) ? t + 3 : NT - 1, decltype(bw_)::value);
        bf16x8 kf0[NS], kf1[NS];
#pragma unroll
        for (int s = 0; s < 4; ++s) { kf0[s] = *(const LAS bf16x8*)(lds + BN + ka[0][s]); kf1[s] = *(const LAS bf16x8*)(lds + BN + ka[1][s]); }
        if (DK == 96) {
#pragma unroll
            for (int s = 0; s < 2; ++s) { kf0[4 + s] = *(const LAS bf16x8*)(lds + BN + kb[0][s]); kf1[4 + s] = *(const LAS bf16x8*)(lds + BN + kb[1][s]); }
        }
        __builtin_amdgcn_sched_barrier(0);
        { auto rr = __builtin_amdgcn_permlane32_swap(__float_as_uint(mx), __float_as_uint(mx), false, false); mx = fmaxf(__uint_as_float(rr[0]), __uint_as_float(rr[1])); }
        const float tm = mx;
        if (__any(tm > m + 8.f)) {
            const float mn = fmaxf(m, tm), al = __builtin_amdgcn_exp2f(m - mn); m = mn; l *= al;
#pragma unroll
            for (int r = 0; r < 16; ++r) { o0[r] *= al; o1[r] *= al; }
        }
        const float nm = -m; float ls = 0.f;
        pn0 = f32x16{}; pn1 = f32x16{};
        unsigned pw[16];
        s16x4 vlo[2][2][2], vhi[2][2][2];
#pragma unroll
        for (int c = 0; c < 8; ++c) {
            __builtin_amdgcn_sched_barrier(0);
#pragma unroll
            for (int j = 0; j < NM; ++j) if (j >= c * NM / 8 && j < (c + 1) * NM / 8) { if (j & 1) pn1 = mfma32(kf1[j >> 1], qf[j >> 1], pn1); else pn0 = mfma32(kf0[j >> 1], qf[j >> 1], pn0); }
            if (c == 4) {
#pragma unroll
                for (int kt = 0; kt < 2; ++kt)
#pragma unroll
                    for (int sp = 0; sp < 2; ++sp) { const int kofs = (32 * kt + 16 * sp) * 128;
#pragma unroll
                        for (int dvb = 0; dvb < 2; ++dvb) { vlo[dvb][kt][sp] = lds_tr16(lds + BC + va[dvb] + kofs); vhi[dvb][kt][sp] = lds_tr16(lds + BC + va[dvb] + kofs + 8 * 128); } }
            }
            __builtin_amdgcn_sched_barrier(0);
            if (c < 4) {
#pragma unroll
                for (int i = 0; i < 4; ++i) { const int r = 4 * c + i; pc0[r] = __builtin_amdgcn_exp2f(pc0[r] + nm); ls += pc0[r]; }
                pw[2 * c] = cvt_pk_bf16(pc0[4 * c], pc0[4 * c + 1]); pw[2 * c + 1] = cvt_pk_bf16(pc0[4 * c + 2], pc0[4 * c + 3]);
            } else {
#pragma unroll
                for (int i = 0; i < 4; ++i) { const int r = 4 * (c - 4) + i; pc1[r] = __builtin_amdgcn_exp2f(pc1[r] + nm); ls += pc1[r]; }
                pw[8 + 2 * (c - 4)] = cvt_pk_bf16(pc1[4 * (c - 4)], pc1[4 * (c - 4) + 1]); pw[8 + 2 * (c - 4) + 1] = cvt_pk_bf16(pc1[4 * (c - 4) + 2], pc1[4 * (c - 4) + 3]);
            }
        }
        __builtin_amdgcn_sched_barrier(0);
        l += ls;
        float mxn = -3.0e38f;
#pragma unroll
        for (int k = 0; k < 8; ++k) { const int kt = k >> 2, sp = (k >> 1) & 1, dvb = k & 1;
            const u32x4 pq = (u32x4){pw[8 * kt + 4 * sp], pw[8 * kt + 4 * sp + 1], pw[8 * kt + 4 * sp + 2], pw[8 * kt + 4 * sp + 3]};
            const s16x4 lo = vlo[dvb][kt][sp], hi4 = vhi[dvb][kt][sp]; const bf16x8 vf = (bf16x8){lo[0], lo[1], lo[2], lo[3], hi4[0], hi4[1], hi4[2], hi4[3]};
            if (dvb == 0) o0 = mfma32(vf, __builtin_bit_cast(bf16x8, pq), o0); else o1 = mfma32(vf, __builtin_bit_cast(bf16x8, pq), o1);
            __builtin_amdgcn_sched_barrier(0);
            if (k < 4) { mxn = fmaxf(fmaxf(mxn, pn0[4 * k]), fmaxf(pn0[4 * k + 1], fmaxf(pn0[4 * k + 2], pn0[4 * k + 3]))); }
            else { mxn = fmaxf(fmaxf(mxn, pn1[4 * (k - 4)]), fmaxf(pn1[4 * (k - 4) + 1], fmaxf(pn1[4 * (k - 4) + 2], pn1[4 * (k - 4) + 3]))); }
            __builtin_amdgcn_sched_barrier(0);
        }
        mx = mxn;
        ATT_WAIT_BAR();
    };
    for (int t = 0; t < NT; t += 4) {
        step(IC<0>{}, IC<1>{}, IC<3>{}, pa0, pa1, pb0, pb1, t);
        step(IC<1>{}, IC<2>{}, IC<0>{}, pb0, pb1, pa0, pa1, t + 1);
        step(IC<2>{}, IC<3>{}, IC<1>{}, pa0, pa1, pb0, pb1, t + 2);
        step(IC<3>{}, IC<0>{}, IC<2>{}, pb0, pb1, pa0, pa1, t + 3);
    }
    { auto rr = __builtin_amdgcn_permlane32_swap(__float_as_uint(l), __float_as_uint(l), false, false); l = __uint_as_float(rr[0]) + __uint_as_float(rr[1]); }
    const float il = 1.f / l;
    bf16_t* op = out + (size_t)(wid * 32 + r32) * 1024 + 4 * hi;
#pragma unroll
    for (int g = 0; g < 4; ++g) { u32x2 a, b;
        a.x = cvt_pk_bf16(o0[4 * g] * il, o0[4 * g + 1] * il); a.y = cvt_pk_bf16(o0[4 * g + 2] * il, o0[4 * g + 3] * il);
        b.x = cvt_pk_bf16(o1[4 * g] * il, o1[4 * g + 1] * il); b.y = cvt_pk_bf16(o1[4 * g + 2] * il, o1[4 * g + 3] * il);
        *(u32x2*)(op + 8 * g) = a; *(u32x2*)(op + 32 + 8 * g) = b; }
}
#undef ATT_DMA
#undef ATT_WAIT_BAR
template <int DK>
__device__ __forceinline__ void attn_unit64(LAS unsigned char* lds, const bf16_t* __restrict__ Q, const bf16_t* __restrict__ K1, const bf16_t* __restrict__ K2, const bf16_t* __restrict__ V,
                                            int nkeys, bf16_t* __restrict__ out) {
    int tid_ = threadIdx.x; asm volatile("" : "+v"(tid_));
    const int tid = tid_, lane = tid & 63, wid = __builtin_amdgcn_readfirstlane(tid >> 6), r32 = lane & 31, hi = lane >> 5;
    constexpr int NS = DK / 16;
    bf16x8 qf[2][NS];
#pragma unroll
    for (int j = 0; j < 2; ++j) { const bf16_t* qp = Q + (size_t)(wid * 64 + 32 * j + r32) * DK + 8 * hi;
#pragma unroll
        for (int s = 0; s < NS; ++s) qf[j][s] = *(const bf16x8*)(qp + 16 * s); }
    const int dkey = 8 * wid + (lane >> 3), dkey2 = 16 * (wid & 3) + (lane >> 2);
    const bf16_t* gk1 = K1 + (size_t)dkey * 64 + (((lane & 7) ^ ((dkey >> 1) & 7)) << 3);
    const bf16_t* gv = V + (size_t)dkey * 64 + (((lane & 7) ^ (((dkey >> 1) & 1) << 2)) << 3);
    const bf16_t* gk2 = (DK == 96) ? K2 + (size_t)dkey2 * 32 + (((lane & 3) ^ ((dkey2 >> 2) & 3)) << 3) : nullptr;
    const unsigned lds0 = (unsigned)(size_t)lds;
    const unsigned d_k1 = lds0 + wid * 1024, d_v = lds0 + 8192 + wid * 1024, d_k2 = lds0 + 16384 + (wid & 3) * 1024;
#define ATT_DMA(tile_, slot_) do { const int tt_ = (tile_); glds16(gk1 + (size_t)tt_ * 4096, (unsigned)__builtin_amdgcn_readfirstlane(d_k1 + (slot_) * ATT_BUF)); \
        glds16(gv + (size_t)tt_ * 4096, (unsigned)__builtin_amdgcn_readfirstlane(d_v + (slot_) * ATT_BUF)); \
        if (DK == 96) glds16(gk2 + (size_t)tt_ * 2048, (unsigned)__builtin_amdgcn_readfirstlane(d_k2 + (slot_) * ATT_BUF)); } while (0)
    unsigned ka[4];
#pragma unroll
    for (int s = 0; s < 4; ++s) ka[s] = r32 * 128 + (((2 * s + hi) ^ ((r32 >> 1) & 7)) << 4);
    unsigned kb[2];
#pragma unroll
    for (int s = 0; s < 2; ++s) kb[s] = 16384 + r32 * 64 + (((2 * s + hi) ^ ((r32 >> 2) & 3)) << 4);
    const int vq = (lane & 15) >> 2, vp = lane & 3, vg = (lane >> 4) & 1;
    const unsigned va0_ = 8192 + (4 * hi + vq) * 128 + ((((16 * vg + 4 * vp) * 2)) ^ ((((4 * hi + vq) >> 1) & 1) << 6));
    float m[2] = {-1e30f, -1e30f}, l[2] = {0.f, 0.f};
    f32x16 o[2][2] = {};
    const int NT = nkeys >> 6;
    ATT_DMA(0, 0); ATT_DMA(1, 1); ATT_DMA(2, 2);
    asm volatile("s_waitcnt vmcnt(0) lgkmcnt(0)\n\ts_barrier" ::: "memory");
    bf16x8 kf0[NS], kf1[NS];
#pragma unroll
    for (int s = 0; s < 4; ++s) { kf0[s] = *(const LAS bf16x8*)(lds + ka[s]); kf1[s] = *(const LAS bf16x8*)(lds + 4096 + ka[s]); }
    auto step = [&](auto cur_, auto wsl_, int t) __attribute__((always_inline)) {
        constexpr int BC = decltype(cur_)::value * ATT_BUF, BNX = ((decltype(cur_)::value + 1) & 3) * ATT_BUF;
        ATT_DMA((t + 3 < NT) ? t + 3 : NT - 1, decltype(wsl_)::value);
        unsigned vao_ = va0_; asm volatile("" : "+v"(vao_)); const unsigned va[2] = {vao_, vao_ ^ 64u};
        unsigned pw[2][16];
        s16x4 vlo[2][2], vhi[2][2];
#define ATT64_VLOAD(kt_) do { _Pragma("unroll") for (int sp = 0; sp < 2; ++sp) { const int kofs = (32 * (kt_) + 16 * sp) * 128; \
            _Pragma("unroll") for (int dvb = 0; dvb < 2; ++dvb) { vlo[dvb][sp] = lds_tr16(lds + BC + va[dvb] + kofs); vhi[dvb][sp] = lds_tr16(lds + BC + va[dvb] + kofs + 8 * 128); } } } while (0)
#define ATT64_PV(kt_) do { _Pragma("unroll") for (int sp = 0; sp < 2; ++sp) _Pragma("unroll") for (int dvb = 0; dvb < 2; ++dvb) { \
            const s16x4 lo = vlo[dvb][sp], hi4 = vhi[dvb][sp]; const bf16x8 vf = (bf16x8){lo[0], lo[1], lo[2], lo[3], hi4[0], hi4[1], hi4[2], hi4[3]}; \
            _Pragma("unroll") for (int j = 0; j < 2; ++j) { const u32x4 pq = (u32x4){pw[j][8 * (kt_) + 4 * sp], pw[j][8 * (kt_) + 4 * sp + 1], pw[j][8 * (kt_) + 4 * sp + 2], pw[j][8 * (kt_) + 4 * sp + 3]}; \
                o[j][dvb] = mfma32(vf, __builtin_bit_cast(bf16x8, pq), o[j][dvb]); } } } while (0)
#pragma unroll
        for (int j = 0; j < 2; ++j) {
            f32x16 p0 = {}, p1 = {};
#pragma unroll
            for (int s = 0; s < NS; ++s) { p0 = mfma32(kf0[s], qf[j][s], p0); p1 = mfma32(kf1[s], qf[j][s], p1); }
            if (j == 1) { __builtin_amdgcn_sched_barrier(0); ATT64_VLOAD(0); __builtin_amdgcn_sched_barrier(0); }
            float mx = p0[0];
#pragma unroll
            for (int r = 1; r < 16; ++r) mx = fmaxf(mx, p0[r]);
#pragma unroll
            for (int r = 0; r < 16; ++r) mx = fmaxf(mx, p1[r]);
            { auto rr = __builtin_amdgcn_permlane32_swap(__float_as_uint(mx), __float_as_uint(mx), false, false); mx = fmaxf(__uint_as_float(rr[0]), __uint_as_float(rr[1])); }
            if (__any(mx > m[j] + 8.f)) {
                const float mn = fmaxf(m[j], mx), al = __builtin_amdgcn_exp2f(m[j] - mn); m[j] = mn; l[j] *= al;
#pragma unroll
                for (int r = 0; r < 16; ++r) { o[j][0][r] *= al; o[j][1][r] *= al; }
            }
            const float nm = -m[j];
#pragma unroll
            for (int r = 0; r < 16; r += 2) { const f32x2 nm2 = {nm, nm}; const f32x2 a2 = (f32x2){p0[r], p0[r + 1]} + nm2, b2 = (f32x2){p1[r], p1[r + 1]} + nm2;
                p0[r] = __builtin_amdgcn_exp2f(a2.x); p0[r + 1] = __builtin_amdgcn_exp2f(a2.y); p1[r] = __builtin_amdgcn_exp2f(b2.x); p1[r + 1] = __builtin_amdgcn_exp2f(b2.y); }
            f32x2 ls2 = {0.f, 0.f};
#pragma unroll
            for (int r = 0; r < 16; r += 2) { ls2 += (f32x2){p0[r], p0[r + 1]}; ls2 += (f32x2){p1[r], p1[r + 1]}; }
            l[j] += ls2.x + ls2.y;
#pragma unroll
            for (int i = 0; i < 8; ++i) { pw[j][i] = cvt_pk_bf16(p0[2 * i], p0[2 * i + 1]); pw[j][8 + i] = cvt_pk_bf16(p1[2 * i], p1[2 * i + 1]); }
            __builtin_amdgcn_sched_barrier(0);
        }
        ATT64_PV(0);
        __builtin_amdgcn_sched_barrier(0);
        ATT64_VLOAD(1);
        __builtin_amdgcn_sched_barrier(0);
        ATT64_PV(1);
#undef ATT64_VLOAD
#undef ATT64_PV
        __builtin_amdgcn_sched_barrier(0);
#pragma unroll
        for (int s = 0; s < 4; ++s) { kf0[s] = *(const LAS bf16x8*)(lds + BNX + ka[s]); kf1[s] = *(const LAS bf16x8*)(lds + BNX + 4096 + ka[s]); }
        asm volatile("s_waitcnt vmcnt(2) lgkmcnt(0)\n\ts_barrier" ::: "memory");
    };
    for (int t = 0; t < NT; t += 4) {
        step(IC<0>{}, IC<3>{}, t); step(IC<1>{}, IC<0>{}, t + 1); step(IC<2>{}, IC<1>{}, t + 2); step(IC<3>{}, IC<2>{}, t + 3);
    }
#pragma unroll
    for (int j = 0; j < 2; ++j) {
        float lj = l[j]; { auto rr = __builtin_amdgcn_permlane32_swap(__float_as_uint(lj), __float_as_uint(lj), false, false); lj = __uint_as_float(rr[0]) + __uint_as_float(rr[1]); }
        const float il = 1.f / lj;
        bf16_t* op = out + (size_t)(wid * 64 + 32 * j + r32) * 1024 + 4 * hi;
#pragma unroll
        for (int g = 0; g < 4; ++g) { u32x2 a, b;
            a.x = cvt_pk_bf16(o[j][0][4 * g] * il, o[j][0][4 * g + 1] * il); a.y = cvt_pk_bf16(o[j][0][4 * g + 2] * il, o[j][0][4 * g + 3] * il);
            b.x = cvt_pk_bf16(o[j][1][4 * g] * il, o[j][1][4 * g + 1] * il); b.y = cvt_pk_bf16(o[j][1][4 * g + 2] * il, o[j][1][4 * g + 3] * il);
            *(u32x2*)(op + 8 * g) = a; *(u32x2*)(op + 32 + 8 * g) = b; }
    }
#undef ATT_DMA
}
__device__ __forceinline__ void glds16s(const void* base, unsigned voff, unsigned lds_base) {
    unsigned sv; asm volatile("s_mov_b32 %0, m0\n\ts_mov_b32 m0, %3\n\ts_nop 0\n\tglobal_load_lds_dwordx4 %1, %2\n\ts_mov_b32 m0, %0" : "=&s"(sv) : "v"(voff), "s"(base), "s"(lds_base) : "memory"); }
__device__ __forceinline__ void attn_unit64m(LAS unsigned char* lds, const bf16_t* __restrict__ Q, const bf16_t* __restrict__ K1, const bf16_t* __restrict__ K2, const bf16_t* __restrict__ V,
                                            int nkeys, bf16_t* __restrict__ out) {
    constexpr int DK = 96;
    int tid_ = threadIdx.x; asm volatile("" : "+v"(tid_));
    const int tid = tid_, lane = tid & 63, wid = __builtin_amdgcn_readfirstlane(tid >> 6), r32 = lane & 31, hi = lane >> 5;
    bf16x8 qf[2][4];
    LAS unsigned char* qrl = lds + 4 * ATT_BUF + wid * 4096 + lane * 16;
#pragma unroll
    for (int j = 0; j < 2; ++j) { const bf16_t* qp = Q + (size_t)(wid * 64 + 32 * j + r32) * DK + 8 * hi;
#pragma unroll
        for (int s = 0; s < 4; ++s) qf[j][s] = *(const bf16x8*)(qp + 16 * s);
#pragma unroll
        for (int s = 0; s < 2; ++s) *(LAS bf16x8*)(qrl + (2 * j + s) * 1024) = *(const bf16x8*)(qp + 64 + 16 * s); }
    const int dkey = 8 * wid + (lane >> 3), dkey2 = 16 * (wid & 3) + (lane >> 2);
    const unsigned ok1 = (unsigned)(dkey * 64 + (((lane & 7) ^ ((dkey >> 1) & 7)) << 3)) * 2u, ov = (unsigned)(dkey * 64 + (((lane & 7) ^ (((dkey >> 1) & 1) << 2)) << 3)) * 2u,
                   ok2 = (unsigned)(dkey2 * 32 + (((lane & 3) ^ ((dkey2 >> 2) & 3)) << 3)) * 2u;
    const unsigned lds0 = (unsigned)(size_t)lds;
    const unsigned d_k1 = lds0 + wid * 1024, d_v = lds0 + 8192 + wid * 1024, d_k2 = lds0 + 16384 + (wid & 3) * 1024;
#define ATT_DMA(tile_, slot_) do { const int tt_ = (tile_); glds16s((const char*)K1 + (size_t)tt_ * 8192, ok1, (unsigned)__builtin_amdgcn_readfirstlane(d_k1 + (slot_) * ATT_BUF)); \
        glds16s((const char*)V + (size_t)tt_ * 8192, ov, (unsigned)__builtin_amdgcn_readfirstlane(d_v + (slot_) * ATT_BUF)); \
        glds16s((const char*)K2 + (size_t)tt_ * 4096, ok2, (unsigned)__builtin_amdgcn_readfirstlane(d_k2 + (slot_) * ATT_BUF)); } while (0)
    const unsigned ka0_ = r32 * 128 + ((hi ^ ((r32 >> 1) & 7)) << 4), kb0_ = 16384 + r32 * 64 + ((hi ^ ((r32 >> 2) & 3)) << 4);
#define ka(s_) (kao_ ^ ((unsigned)(s_) << 5))
#define kb(s_) (kbo_ ^ ((unsigned)(s_) << 5))
    const int vq = (lane & 15) >> 2, vp = lane & 3, vg = (lane >> 4) & 1;
    const unsigned va0_ = 8192 + (4 * hi + vq) * 128 + ((((16 * vg + 4 * vp) * 2)) ^ ((((4 * hi + vq) >> 1) & 1) << 6));
    float m[2] = {0.f, 0.f}, l[2] = {0.f, 0.f};
    f32x16 o[2][2] = {};
    const int NT = nkeys >> 6;
    ATT_DMA(0, 0); ATT_DMA(1, 1); ATT_DMA(2, 2);
    asm volatile("s_waitcnt vmcnt(0) lgkmcnt(0)\n\ts_barrier" ::: "memory");
    auto step = [&](auto cur_, auto wsl_, int t) __attribute__((always_inline)) {
        constexpr int BC = decltype(cur_)::value * ATT_BUF;
        unsigned kao_ = ka0_, kbo_ = kb0_, vao_ = va0_; asm volatile("" : "+v"(kao_), "+v"(kbo_), "+v"(vao_));
        const unsigned va[2] = {vao_, vao_ ^ 64u};
        ATT_DMA((t + 3 < NT) ? t + 3 : NT - 1, decltype(wsl_)::value);
        f32x16 pj[2][2];
#pragma unroll
        for (int j = 0; j < 2; ++j) { pj[j][0] = f32x16{}; pj[j][1] = f32x16{}; }
        {
            bf16x8 ka0[2], ka1[2], kb0[2], kb1[2];
#pragma unroll
            for (int s = 0; s < 2; ++s) { ka0[s] = *(const LAS bf16x8*)(lds + BC + ka(s)); ka1[s] = *(const LAS bf16x8*)(lds + BC + 4096 + ka(s)); }
#pragma unroll
            for (int s = 0; s < 2; ++s) { kb0[s] = *(const LAS bf16x8*)(lds + BC + ka(2 + s)); kb1[s] = *(const LAS bf16x8*)(lds + BC + 4096 + ka(2 + s)); }
            __builtin_amdgcn_sched_barrier(0);
#pragma unroll
            for (int s = 0; s < 2; ++s)
#pragma unroll
                for (int j = 0; j < 2; ++j) { pj[j][0] = mfma32(ka0[s], qf[j][s], pj[j][0]); pj[j][1] = mfma32(ka1[s], qf[j][s], pj[j][1]); }
            __builtin_amdgcn_sched_barrier(0);
            bf16x8 qr[2][2];
#pragma unroll
            for (int s = 0; s < 2; ++s) { ka0[s] = *(const LAS bf16x8*)(lds + BC + kb(s)); ka1[s] = *(const LAS bf16x8*)(lds + BC + 2048 + kb(s)); }
            __builtin_amdgcn_sched_barrier(0);
#pragma unroll
            for (int s = 0; s < 2; ++s)
#pragma unroll
                for (int j = 0; j < 2; ++j) { pj[j][0] = mfma32(kb0[s], qf[j][2 + s], pj[j][0]); pj[j][1] = mfma32(kb1[s], qf[j][2 + s], pj[j][1]); }
            __builtin_amdgcn_sched_barrier(0);
#pragma unroll
            for (int j = 0; j < 2; ++j)
#pragma unroll
                for (int s = 0; s < 2; ++s) qr[j][s] = *(const LAS bf16x8*)(qrl + (2 * j + s) * 1024);
            __builtin_amdgcn_sched_barrier(0);
#pragma unroll
            for (int s = 0; s < 2; ++s)
#pragma unroll
                for (int j = 0; j < 2; ++j) { pj[j][0] = mfma32(ka0[s], qr[j][s], pj[j][0]); pj[j][1] = mfma32(ka1[s], qr[j][s], pj[j][1]); }
            __builtin_amdgcn_sched_barrier(0);
        }
        unsigned pw[2][16];
        s16x4 vlo[2][2], vhi[2][2];
#define ATT64_VLOAD(kt_) do { _Pragma("unroll") for (int sp = 0; sp < 2; ++sp) { const int kofs = (32 * (kt_) + 16 * sp) * 128; \
            _Pragma("unroll") for (int dvb = 0; dvb < 2; ++dvb) { vlo[dvb][sp] = lds_tr16(lds + BC + va[dvb] + kofs); vhi[dvb][sp] = lds_tr16(lds + BC + va[dvb] + kofs + 8 * 128); } } } while (0)
#define ATT64_PV(kt_) do { _Pragma("unroll") for (int sp = 0; sp < 2; ++sp) _Pragma("unroll") for (int dvb = 0; dvb < 2; ++dvb) { \
            const s16x4 lo = vlo[dvb][sp], hi4 = vhi[dvb][sp]; const bf16x8 vf = (bf16x8){lo[0], lo[1], lo[2], lo[3], hi4[0], hi4[1], hi4[2], hi4[3]}; \
            _Pragma("unroll") for (int j = 0; j < 2; ++j) { const u32x4 pq = (u32x4){pw[j][8 * (kt_) + 4 * sp], pw[j][8 * (kt_) + 4 * sp + 1], pw[j][8 * (kt_) + 4 * sp + 2], pw[j][8 * (kt_) + 4 * sp + 3]}; \
                o[j][dvb] = mfma32(vf, __builtin_bit_cast(bf16x8, pq), o[j][dvb]); } } } while (0)
#pragma unroll
        for (int j = 0; j < 2; ++j) {
            f32x16 p0 = pj[j][0], p1 = pj[j][1];
            if (j == 1) { __builtin_amdgcn_sched_barrier(0); ATT64_VLOAD(0); __builtin_amdgcn_sched_barrier(0); }
            float mx = p0[0];
#pragma unroll
            for (int r = 1; r < 16; ++r) mx = fmaxf(mx, p0[r]);
#pragma unroll
            for (int r = 0; r < 16; ++r) mx = fmaxf(mx, p1[r]);
            { auto rr = __builtin_amdgcn_permlane32_swap(__float_as_uint(mx), __float_as_uint(mx), false, false); mx = fmaxf(__uint_as_float(rr[0]), __uint_as_float(rr[1])); }
            if (t == 0) m[j] = fabsf(mx) > 32.f ? mx : 0.f;
            else if (__any(mx > m[j] + 60.f)) {
                const float mn = fmaxf(m[j], mx), al = __builtin_amdgcn_exp2f(m[j] - mn); m[j] = mn; l[j] *= al;
#pragma unroll
                for (int r = 0; r < 16; ++r) { o[j][0][r] *= al; o[j][1][r] *= al; }
            }
            if (__all(m[j] == 0.f)) {
#pragma unroll
                for (int r = 0; r < 16; ++r) { p0[r] = __builtin_amdgcn_exp2f(p0[r]); p1[r] = __builtin_amdgcn_exp2f(p1[r]); }
            } else { const float nm = -m[j];
#pragma unroll
                for (int r = 0; r < 16; ++r) { p0[r] = __builtin_amdgcn_exp2f(p0[r] + nm); p1[r] = __builtin_amdgcn_exp2f(p1[r] + nm); }
            }
            f32x2 ls2 = {0.f, 0.f};
#pragma unroll
            for (int r = 0; r < 16; r += 2) { ls2 += (f32x2){p0[r], p0[r + 1]}; ls2 += (f32x2){p1[r], p1[r + 1]}; }
            l[j] += ls2.x + ls2.y;
#pragma unroll
            for (int i = 0; i < 8; ++i) { pw[j][i] = cvt_pk_bf16(p0[2 * i], p0[2 * i + 1]); pw[j][8 + i] = cvt_pk_bf16(p1[2 * i], p1[2 * i + 1]); }
            __builtin_amdgcn_sched_barrier(0);
        }
        ATT64_PV(0);
        __builtin_amdgcn_sched_barrier(0);
        ATT64_VLOAD(1);
        __builtin_amdgcn_sched_barrier(0);
        ATT64_PV(1);
#undef ATT64_VLOAD
#undef ATT64_PV
        if (DK == 96) asm volatile("s_waitcnt vmcnt(6) lgkmcnt(0)\n\ts_barrier" ::: "memory"); else asm volatile("s_waitcnt vmcnt(4) lgkmcnt(0)\n\ts_barrier" ::: "memory");
    };
    for (int t = 0; t < NT; t += 4) {
        step(IC<0>{}, IC<3>{}, t); step(IC<1>{}, IC<0>{}, t + 1); step(IC<2>{}, IC<1>{}, t + 2); step(IC<3>{}, IC<2>{}, t + 3);
    }
#pragma unroll
    for (int j = 0; j < 2; ++j) {
        float lj = l[j]; { auto rr = __builtin_amdgcn_permlane32_swap(__float_as_uint(lj), __float_as_uint(lj), false, false); lj = __uint_as_float(rr[0]) + __uint_as_float(rr[1]); }
        const float il = 1.f / lj;
        bf16_t* op = out + (size_t)(wid * 64 + 32 * j + r32) * 1024 + 4 * hi;
#pragma unroll
        for (int g = 0; g < 4; ++g) { u32x2 a, b;
            a.x = cvt_pk_bf16(o[j][0][4 * g] * il, o[j][0][4 * g + 1] * il); a.y = cvt_pk_bf16(o[j][0][4 * g + 2] * il, o[j][0][4 * g + 3] * il);
            b.x = cvt_pk_bf16(o[j][1][4 * g] * il, o[j][1][4 * g + 1] * il); b.y = cvt_pk_bf16(o[j][1][4 * g + 2] * il, o[j][1][4 * g + 3] * il);
            *(u32x2*)(op + 8 * g) = a; *(u32x2*)(op + 32 + 8 * g) = b; }
    }
#undef ATT_DMA
#undef ka
#undef kb
}
__device__ __forceinline__ void phase_p3(LAS unsigned char* lds, const WS& w, int l, int vb, int nvb, int xpart, int xrank) {
    const float c2g = 0.125f * 1.4426950408889634f, c2m = 0.10206207261596577f * 1.4426950408889634f;
    bf16_t* MIX = w.H();
    const int nlat = NB * 12 * 4, nctx = (l == 0) ? NB * 12 : 0;
    const bool xl = (nvb == 256);
    for (int u = vb; u < nlat + nctx; u += nvb) {
        if (u < nlat) {
            const bool mla = u >= nlat / 2; const int v = mla ? u - nlat / 2 : u;
            int qb, hh, b;
            if (xl) { const int grp = (v >> 8) * 64 + 8 * xpart + (xrank >> 2); qb = xrank & 3; hh = grp % 6; b = grp / 6; }
            else { qb = v & 3; hh = (v >> 2) % 6; b = v / 24; }
            bf16_t* out = MIX + ((size_t)b * S + qb * 512) * 1024;
            if (!mla) attn_unit64<64>(lds, w.Qg() + (((size_t)b * 6 + hh) * S + qb * 512) * 64, w.Kg() + ((size_t)b * 2 + hh / 3) * KEYS * 64, nullptr, w.Vg() + ((size_t)b * 2 + hh / 3) * KEYS * 64, KEYS, out + hh * 64);
            else attn_unit64m(lds, w.Qm() + (((size_t)b * 6 + hh) * S + qb * 512) * 96, w.Kmn() + ((size_t)b * 6 + hh) * KEYS * 64, w.KR() + (size_t)b * KEYS * 32, w.Vm() + ((size_t)b * 6 + hh) * KEYS * 64, KEYS, out + 640 + hh * 64);
        } else {
            const int v = u - nlat, slot = v % 12, b = v / 12;
            bf16_t* out = MIX + ((size_t)NL + (size_t)b * CTX) * 1024;
            if (slot < 6) attn_unit<64>(lds, w.Qgc() + ((size_t)b * 6 + slot) * CTX * 64, w.Kg() + ((size_t)b * 2 + slot / 3) * KEYS * 64, nullptr, w.Vg() + ((size_t)b * 2 + slot / 3) * KEYS * 64, CTX, c2g, out + slot * 64);
            else { const int h = slot - 6; attn_unit<96>(lds, w.Qmc() + ((size_t)b * 6 + h) * CTX * 96, w.Kmn() + ((size_t)b * 6 + h) * KEYS * 64, w.KR() + (size_t)b * KEYS * 32, w.Vm() + ((size_t)b * 6 + h) * KEYS * 64, CTX, c2m, out + 640 + h * 64); }
        }
    }
}

__device__ __forceinline__ unsigned fkey(float f, unsigned tag, unsigned mask) { return (__float_as_uint(f) & ~mask) | tag; }
__device__ __forceinline__ float keyf(unsigned k, unsigned mask) { return __uint_as_float(k & ~mask); }
__device__ __forceinline__ unsigned fmax_u(unsigned a, unsigned b) { unsigned r; asm("v_max_f32 %0, %1, %2" : "=v"(r) : "v"(a), "v"(b)); return r; }
__device__ __forceinline__ unsigned fmin_u(unsigned a, unsigned b) { unsigned r; asm("v_min_f32 %0, %1, %2" : "=v"(r) : "v"(a), "v"(b)); return r; }
__device__ __forceinline__ void ce_desc(unsigned& a, unsigned& b) { const unsigned hi_ = fmax_u(a, b), lo_ = fmin_u(a, b); a = hi_; b = lo_; }
template <int J> __device__ __forceinline__ void bstage16(unsigned* a) {
#pragma unroll
    for (int i = 0; i < 16; ++i) { const int l = i ^ J; if (l > i) ce_desc(a[i], a[l]); }
}
__device__ __forceinline__ void sort16_desc(unsigned* a) {
#define CE_(i, j) ce_desc(a[i], a[j]);
    CE_(0, 13) CE_(1, 12) CE_(2, 15) CE_(3, 14) CE_(4, 8) CE_(5, 6) CE_(7, 11) CE_(9, 10)
    CE_(0, 5) CE_(1, 7) CE_(2, 9) CE_(3, 4) CE_(6, 13) CE_(8, 14) CE_(10, 15) CE_(11, 12)
    CE_(0, 1) CE_(2, 3) CE_(4, 5) CE_(6, 8) CE_(7, 9) CE_(10, 11) CE_(12, 13) CE_(14, 15)
    CE_(0, 2) CE_(1, 3) CE_(4, 10) CE_(5, 11) CE_(6, 7) CE_(8, 9) CE_(12, 14) CE_(13, 15)
    CE_(1, 2) CE_(3, 12) CE_(4, 6) CE_(5, 7) CE_(8, 10) CE_(9, 11) CE_(13, 14)
    CE_(1, 4) CE_(2, 6) CE_(5, 8) CE_(7, 10) CE_(9, 13) CE_(11, 14)
    CE_(2, 4) CE_(3, 6) CE_(9, 12) CE_(11, 13)
    CE_(3, 5) CE_(6, 8) CE_(7, 9) CE_(10, 12)
    CE_(3, 4) CE_(5, 6) CE_(7, 8) CE_(9, 10) CE_(11, 12)
    CE_(6, 7) CE_(8, 9)
#undef CE_
}
__device__ __forceinline__ void bmerge16_desc(unsigned* c) { bstage16<8>(c); bstage16<4>(c); bstage16<2>(c); bstage16<1>(c); }
__device__ __forceinline__ void merge_top16(unsigned* a, const unsigned* b) {
#pragma unroll
    for (int i = 0; i < 16; ++i) a[i] = fmax_u(a[i], b[15 - i]);
    bmerge16_desc(a);
}
__device__ __forceinline__ void xlane_top16(unsigned* t, int hi) {
    unsigned r[16]; const unsigned msk = 0u - (unsigned)hi;
#pragma unroll
    for (int i = 0; i < 16; ++i) r[i] = t[i] ^ ((t[i] ^ t[15 - i]) & msk);
#pragma unroll
    for (int i = 0; i < 16; ++i) { auto s = __builtin_amdgcn_permlane32_swap(r[i], r[i], false, false); t[i] = fmax_u(s[0], s[1]); }
    bmerge16_desc(t);
}
__device__ __forceinline__ constexpr int cand_a(int c) { return c < 16 ? 0 : c < 24 ? 1 : c < 32 ? 39 - c : c < 37 ? 2 : c < 41 ? 3 : c < 44 ? 4 : c < 46 ? 5 : c < 48 ? 6 : 7; }
__device__ __forceinline__ constexpr int cand_b(int c) { return c < 16 ? c : c < 24 ? c - 16 : c < 32 ? 0 : c < 37 ? c - 32 : c < 41 ? c - 37 : c < 44 ? c - 41 : c < 46 ? c - 44 : c < 48 ? c - 46 : c - 48; }

__device__ __forceinline__ void phase_p6b(LAS unsigned char* lds, const bf16_t* __restrict__ PQ, const bf16_t* __restrict__ SubKl, unsigned* __restrict__ EG, int nrows, int vb, int nvb) {
    int tid_ = threadIdx.x; asm volatile("" : "+v"(tid_));
    const int tid = tid_, lane = tid & 63, wid = __builtin_amdgcn_readfirstlane(tid >> 6), r32 = lane & 31, hi = lane >> 5;
    const int h = vb & 7, wrank = (vb >> 3) * 8 + wid, nwr = (nvb >> 3) * 8;
    LAS unsigned short* tab = (LAS unsigned short*)(lds + 65536 + wid * 4096) + r32 * 64;
#pragma unroll
    for (int i = 0; i < 8; ++i) { const int idx = i * 512 + tid, p = idx >> 11, key = (idx >> 4) & 127, ch = idx & 15;
        *(LAS u32x4*)(lds + p * 32768 + key * 256 + ((ch ^ (key & 15)) << 4)) = *(const u32x4*)(SubKl + ((size_t)(h * 2 + p) * 128 + key) * 128 + ch * 8); }
    __syncthreads();
    const int ngroups = nrows >> 5;
    for (int tg = wrank; tg < ngroups; tg += nwr) {
        const int row0 = tg << 5;
        bf16x8 qf[2][8];
        { const bf16_t* qp = PQ + (size_t)(row0 + r32) * 2048 + h * 256 + 8 * hi; asm volatile("" : "+v"(qp));
#pragma unroll
          for (int p = 0; p < 2; ++p)
#pragma unroll
              for (int s = 0; s < 8; ++s) qf[p][s] = *(const bf16x8*)(qp + p * 128 + 16 * s); }
        unsigned top[2][16];
#pragma unroll
        for (int p = 0; p < 2; ++p) {
            f32x16 acc[4];
#pragma unroll
            for (int kt = 0; kt < 4; ++kt) { acc[kt] = f32x16{}; const int key = 32 * kt + r32;
#pragma unroll
                for (int s = 0; s < 8; ++s) acc[kt] = mfma32(*(const LAS bf16x8*)(lds + p * 32768 + key * 256 + (((2 * s + hi) ^ (key & 15)) << 4)), qf[p][s], acc[kt]); }
            unsigned key[64];
#pragma unroll
            for (int kt = 0; kt < 4; ++kt)
#pragma unroll
                for (int r = 0; r < 16; ++r) { const int n = 32 * kt + (r & 3) + 8 * (r >> 2) + 4 * hi; key[16 * kt + r] = fkey(acc[kt][r], 127u - (unsigned)n, 127u); }
            sort16_desc(key); sort16_desc(key + 16); sort16_desc(key + 32); sort16_desc(key + 48);
            merge_top16(key, key + 16); merge_top16(key + 32, key + 48); merge_top16(key, key + 32);
            xlane_top16(key, hi);
#pragma unroll
            for (int i = 0; i < 16; ++i) top[p][i] = key[i];
        }
        float t0f[16], t1f[16];
#pragma unroll
        for (int i = 0; i < 16; ++i) { t0f[i] = keyf(top[0][i], 127u); t1f[i] = keyf(top[1][i], 127u); }
        unsigned ck[50];
#pragma unroll
        for (int c = 0; c < 50; ++c) ck[c] = fkey(t0f[cand_a(c)] + t1f[cand_b(c)], (unsigned)c, 63u);
        if (hi == 0) {
#pragma unroll
            for (int c = 0; c < 50; c += 2) {
                const unsigned ea = (127u - (top[0][cand_a(c)] & 127u)) * 128u + (127u - (top[1][cand_b(c)] & 127u));
                const unsigned eb = (127u - (top[0][cand_a(c + 1)] & 127u)) * 128u + (127u - (top[1][cand_b(c + 1)] & 127u));
                *(LAS unsigned*)(tab + c) = ea | (eb << 16);
            }
        }
        bmerge16_desc(ck + 16); sort16_desc(ck + 32);
        merge_top16(ck, ck + 16); merge_top16(ck, ck + 32);
        ck[15] = fmax_u(ck[15], ck[48]); ck[14] = fmax_u(ck[14], ck[49]); bmerge16_desc(ck);
        asm volatile("s_waitcnt lgkmcnt(0)" ::: "memory");
        const float mx = keyf(ck[0], 63u); float e[16], den = 0.f;
#pragma unroll
        for (int j = 0; j < 16; ++j) { e[j] = __builtin_amdgcn_exp2f((keyf(ck[j], 63u) - mx) * 1.4426950408889634f); den += e[j]; }
        const float iden = 1.f / den;
        if (hi == 0) {
            unsigned o[16];
#pragma unroll
            for (int j = 0; j < 16; ++j) { const unsigned eid = tab[ck[j] & 63u]; o[j] = (eid << 16) | (cvt_pk_bf16(e[j] * iden, 0.f) & 0xffffu); }
            unsigned* dst = EG + (size_t)(row0 + r32) * 128 + h * 16;
#pragma unroll
            for (int j = 0; j < 16; j += 4) *(u32x4*)(dst + j) = (u32x4){o[j], o[j + 1], o[j + 2], o[j + 3]};
        }
        asm volatile("s_waitcnt lgkmcnt(0)" ::: "memory");
    }
}


#define XB_TMO      128
#define XB_XCNT(j)  (256  + 64 * (j))
#define XB_XSUB(j)  (1280 + 64 * (j))
#define XB_XGEN(j)  (2304 + 64 * (j))
#define XB_TOP      3328
#define XB_TOPGEN   3392
#define XCD_BAR_WORDS 3456
#define XB_SPIN_CAP (1u << 18)

__device__ __forceinline__ unsigned xb_ld(unsigned* p)              { return __hip_atomic_load(p, __ATOMIC_RELAXED, __HIP_MEMORY_SCOPE_AGENT); }
__device__ __forceinline__ unsigned xb_add(unsigned* p, unsigned v) { return __hip_atomic_fetch_add(p, v, __ATOMIC_RELAXED, __HIP_MEMORY_SCOPE_AGENT); }
__device__ __forceinline__ unsigned xb_xcc_id() { return (unsigned)__builtin_amdgcn_s_getreg((3 << 11) | 20) & 0xFu; }
#define XB_SPIN(cond, bar) do { unsigned _sp = 0; while (cond) { __builtin_amdgcn_s_sleep(1); \
    if ((++_sp & 255u) == 0u) { if (xb_ld(&(bar)[XB_TMO])) break; if (_sp > XB_SPIN_CAP) { atomicAdd(&(bar)[XB_TMO], 1u); break; } } } } while (0)

struct XcdBarrier {
    unsigned* bar; unsigned x;
    volatile LAS unsigned* st;
};

__device__ __forceinline__ XcdBarrier xcd_barrier_post(unsigned* bar, volatile LAS unsigned* st) {
    XcdBarrier b; b.bar = bar; b.x = xb_xcc_id(); b.st = st;
    if (threadIdx.x == 0) (void)xb_add(&bar[XB_XCNT(b.x)], 1u);
    return b;
}
__device__ __forceinline__ void xcd_barrier_complete(unsigned* bar, unsigned x, unsigned& nloc, unsigned& nx) {
    const unsigned G = gridDim.x * gridDim.y * gridDim.z;
    unsigned sum, cnt, mine, sp = 0u;
    for (;;) {
        sum = 0u; cnt = 0u; mine = 0u;
#pragma unroll
        for (unsigned j = 0; j < 16; ++j) { const unsigned c = xb_ld(&bar[XB_XCNT(j)]); sum += c; cnt += (c > 0u) ? 1u : 0u; mine = (j == x) ? c : mine; }
        if (sum == G) break;
        __builtin_amdgcn_s_sleep(1);
        if ((++sp & 255u) == 0u) { if (xb_ld(&bar[XB_TMO])) break; if (sp > XB_SPIN_CAP) { atomicAdd(&bar[XB_TMO], 1u); break; } }
    }
    nloc = mine > 0u ? mine : 1u; nx = cnt > 0u ? cnt : 1u;
}

__device__ __forceinline__ void xcd_barrier(const XcdBarrier& b) {
    asm volatile("s_waitcnt vmcnt(0)" ::: "memory");
    __syncthreads();
    if (threadIdx.x == 0) {
        unsigned* bar = b.bar;
        __builtin_amdgcn_s_waitcnt(0);
        unsigned nloc = b.st[0], nx = b.st[1];
        if (nloc == 0u) { xcd_barrier_complete(bar, b.x, nloc, nx); b.st[0] = nloc; b.st[1] = nx; }
        const unsigned old = xb_add(&bar[XB_XSUB(b.x)], 1u);
        const unsigned gen = old / nloc;
        if (old + 1u == (gen + 1u) * nloc) {
            __builtin_amdgcn_fence(__ATOMIC_RELEASE, "agent");
            asm volatile("s_waitcnt vmcnt(0)" ::: "memory");
            const unsigned og = xb_add(&bar[XB_TOP], 1u);
            const unsigned tg = og / nx;
            if (og + 1u == (tg + 1u) * nx) xb_add(&bar[XB_TOPGEN], 1u);
            else XB_SPIN(xb_ld(&bar[XB_TOPGEN]) == tg, bar);
            __builtin_amdgcn_fence(__ATOMIC_ACQUIRE, "agent");
            xb_add(&bar[XB_XGEN(b.x)], 1u);
            asm volatile("s_waitcnt vmcnt(0)" ::: "memory");
        } else {
            XB_SPIN(xb_ld(&bar[XB_XGEN(b.x)]) == gen, bar);
            __builtin_amdgcn_fence(__ATOMIC_ACQUIRE, "agent");
            asm volatile("s_waitcnt vmcnt(0)" ::: "memory");
        }
    }
    __syncthreads();
}

__device__ __forceinline__ void phase_mod(LAS unsigned char* lds, const Inputs& in, const WS& w, int vb) {
    if (vb >= 72) return;
    LAS float* sc = (LAS float*)lds;
    int tid_ = threadIdx.x; asm volatile("" : "+v"(tid_));
    const int tid = tid_, idx = vb * 512 + tid, rg = idx / 12288, ln = idx % 12288, l = ln / 6144, n = ln % 6144;
    float acc[11];
#pragma unroll
    for (int i = 0; i < 11; ++i) acc[i] = 0.f;
    const float* wp = in.ada_w + (size_t)l * 1024 * 6144 + n;
    for (int kc = 0; kc < 4; ++kc) {
        for (int i = tid; i < 33 * 256; i += 512) { const int r = i >> 8, k = kc * 256 + (i & 255); const float v = r < 32 ? in.c[(size_t)r * 1024 + k] : in.c_ctx[k]; sc[i] = v / (1.f + __expf(-v)); }
        __syncthreads();
        for (int k = 0; k < 256; ++k) { const float wv = wp[(size_t)(kc * 256 + k) * 6144];
#pragma unroll
            for (int i = 0; i < 11; ++i) acc[i] += sc[(rg * 11 + i) * 256 + k] * wv; }
        __syncthreads();
    }
    const float bias = in.ada_b[(size_t)l * 6144 + n];
#pragma unroll
    for (int i = 0; i < 11; ++i) w.MOD()[((size_t)l * 33 + rg * 11 + i) * 6144 + n] = acc[i] + bias;
}
__device__ __forceinline__ void phase_rope(const WS& w, int vb, int nvb) {
    int tid_ = threadIdx.x; asm volatile("" : "+v"(tid_));
    for (int i = vb * 512 + tid_; i < 2048 * 32; i += nvb * 512) {
        { const int t = i / 32, j = i % 32; const double inv = pow(10000.0, -(double)(j % 16) / 16.0); const double a = (double)(j < 16 ? t / 64 : t % 64) * inv; w.ROPA()[i] = make_float2((float)cos(a), (float)sin(a)); }
        if (i < 2048 * 16) { const int t = i / 16, j = i % 16; const double inv = pow(10000.0, -(double)(j % 8) / 8.0); const double a = (double)(j < 8 ? t / 64 : t % 64) * inv; w.ROPC()[i] = make_float2((float)cos(a), (float)sin(a)); }
    }
}

#ifndef PROBE_MASK
#define PROBE_MASK 0
#endif
#ifndef BENCH_MODE
#define BENCH_MODE 0
#endif
#if BENCH_MODE
__device__ __forceinline__ void phase_bench(float* sink) {
    int tid_ = threadIdx.x; asm volatile("" : "+v"(tid_));
    float x[16];
#pragma unroll
    for (int i = 0; i < 16; ++i) x[i] = (float)(tid_ + i) * 0.001f;
    f32x16 acc[4] = {};
    bf16x8 a = (bf16x8){(short)tid_, 1, 2, 3, 4, 5, 6, 7}, b = (bf16x8){7, 6, 5, 4, 3, 2, 1, (short)tid_};
#pragma nounroll
    for (int it = 0; it < ((BENCH_MODE & 7) ? 2048 : 0); ++it) {
#pragma unroll
        for (int k = 0; k < 8; ++k) {
            if (BENCH_MODE & 2) { acc[k & 3] = mfma32(a, b, acc[k & 3]); }
            __builtin_amdgcn_sched_barrier(0);
            if (BENCH_MODE & 1) { asm volatile("v_exp_f32 %0, -|%0|" : "+v"(x[2 * k])); asm volatile("v_exp_f32 %0, -|%0|" : "+v"(x[2 * k + 1])); }
            if (BENCH_MODE & 4) {
#pragma unroll
                for (int j = 0; j < 8; ++j) asm volatile("v_fma_f32 %0, %0, %0, %0" : "+v"(x[(2 * k + j) & 15]));
            }
            __builtin_amdgcn_sched_barrier(0);
        }
    }
    if (BENCH_MODE & 24) {
        const int lane = tid_ & 63, r32 = lane & 31, hi = lane >> 5;
        unsigned ka[2][4];
#pragma unroll
        for (int kt = 0; kt < 2; ++kt)
#pragma unroll
            for (int s_ = 0; s_ < 4; ++s_) { const int key = 32 * kt + r32; ka[kt][s_] = key * 128 + (((2 * s_ + hi) ^ ((key >> 1) & 7)) << 4); }
        const int vq = (lane & 15) >> 2, vp = lane & 3, vg = (lane >> 4) & 1;
        unsigned va[2];
#pragma unroll
        for (int dvb = 0; dvb < 2; ++dvb) { const int key = 4 * hi + vq; va[dvb] = 8192 + key * 128 + ((((32 * dvb + 16 * vg + 4 * vp) * 2)) ^ (((key >> 1) & 1) << 6)); }
        u32x4 kr[8]; u32x2 vr[16];
#pragma nounroll
        for (int it = 0; it < 2048; ++it) {
            if (BENCH_MODE & 8) {
#pragma unroll
                for (int kt = 0; kt < 2; ++kt)
#pragma unroll
                    for (int s_ = 0; s_ < 4; ++s_) asm volatile("ds_read_b128 %0, %1" : "=v"(kr[kt * 4 + s_]) : "v"(ka[kt][s_]));
            }
            if (BENCH_MODE & 16) {
#pragma unroll
                for (int q = 0; q < 4; ++q)
#pragma unroll
                    for (int dvb = 0; dvb < 2; ++dvb) { asm volatile("ds_read_b64_tr_b16 %0, %1" : "=v"(vr[q * 4 + dvb * 2]) : "v"(va[dvb] + q * 2048)); asm volatile("ds_read_b64_tr_b16 %0, %1 offset:1024" : "=v"(vr[q * 4 + dvb * 2 + 1]) : "v"(va[dvb] + q * 2048)); }
            }
            asm volatile("s_waitcnt lgkmcnt(0)" ::: "memory");
        }
        if (BENCH_MODE & 8) {
#pragma unroll
            for (int i = 0; i < 8; ++i) x[i] += __uint_as_float(kr[i][0] ^ kr[i][1] ^ kr[i][2] ^ kr[i][3]);
        }
        if (BENCH_MODE & 16) {
#pragma unroll
            for (int i = 0; i < 16; ++i) x[i] += __uint_as_float(vr[i][0] ^ vr[i][1]);
        }
    }
    float r = 0.f;
#pragma unroll
    for (int i = 0; i < 16; ++i) r += x[i];
#pragma unroll
    for (int k = 0; k < 4; ++k)
#pragma unroll
        for (int i = 0; i < 16; ++i) r += acc[k][i];
    if (r == 1.2345e30f) sink[tid_] = r;
}
#endif
struct MegaArgs { Inputs in; WS w; float* XL; unsigned* bar; };
constexpr int MEGA_LDS = 131072 + 16;
__global__ void __launch_bounds__(512, 2) k_mega(MegaArgs A) {
    LAS unsigned char* lds = (LAS unsigned char*)dyn_lds;
    const int vb = blockIdx.x, nvb = gridDim.x;
    volatile LAS unsigned* xbw = (volatile LAS unsigned*)(lds + 131072);
    if (threadIdx.x == 0) { xbw[0] = 0u; xbw[1] = 0u; xbw[2] = 0u; xbw[3] = 0u; }
    __syncthreads();
    XcdBarrier bar = xcd_barrier_post(A.bar, xbw);
    if (threadIdx.x == 0) xbw[2] = xb_add(&A.bar[3584 + 64 * bar.x], 1u);
    __syncthreads();
    const int xticket = __builtin_amdgcn_readfirstlane((int)xbw[2]);
    const WS& w = A.w; const Inputs& in = A.in;
    phase_mod(lds, in, w, vb);
    phase_rope(w, vb, nvb);
    phase_cvt(lds, in, w, vb, nvb);
    xcd_barrier(bar);
    phase_modulate<false>(in.x, in.ctx, nullptr, w.H(), in.norm1_g, w.MOD(), 0, NR, vb, nvb);
    xcd_barrier(bar);
#if (PROBE_MASK >> 0) & 1
    phase_mod(lds, in, w, vb);
    phase_rope(w, vb, nvb);
    phase_cvt(lds, in, w, vb, nvb);
    xcd_barrier(bar);
    phase_modulate<false>(in.x, in.ctx, nullptr, w.H(), in.norm1_g, w.MOD(), 0, NR, vb, nvb);
    xcd_barrier(bar);
#endif
#if BENCH_MODE
    phase_bench((float*)w.RSQ());
#endif
    int xpart = vb & 7, xrank = vb >> 3;
    { bool okx = (bar.x < 8u); for (unsigned j = 0; j < 8; ++j) okx = okx && (xb_ld(&A.bar[XB_XCNT(j)]) == (unsigned)(nvb >> 3));
      if (okx) { xpart = (int)bar.x; xrank = xticket; } }
    for (int l = 0; l < DEPTH; ++l) {
        const float* MODl = w.MOD() + (size_t)l * 33 * 6144;
        const bool last = (l == DEPTH - 1);
        const int MR = last ? NL : NR;
        phase_p1(lds, w, in, l, vb, nvb); xcd_barrier(bar);
#if (PROBE_MASK >> 1) & 1
        phase_p1(lds, w, in, l, vb, nvb); xcd_barrier(bar);
#endif
        phase_p2(lds, w, in, l, vb, nvb); xcd_barrier(bar);
#if (PROBE_MASK >> 12) & 7
        phase_p2(lds, w, in, l, vb, nvb, (PROBE_MASK >> 12) & 7); xcd_barrier(bar);
#endif
        phase_p3(lds, w, l, vb, nvb, xpart, xrank); xcd_barrier(bar);
#if (PROBE_MASK >> 3) & 1
        phase_p3(lds, w, l, vb, nvb, xpart, xrank); xcd_barrier(bar);
#endif
        phase_p4(lds, w, in, l, vb, nvb);
        xcd_barrier(bar);
#if (PROBE_MASK >> 4) & 1
        phase_p4(lds, w, in, l, vb, nvb);
        xcd_barrier(bar);
#endif
        if (l == 0) phase_modulate<false>(in.x, in.ctx, nullptr, w.H(), in.norm2_g + l * 1024, MODl, 3, MR, vb, nvb, w.H8(), w.HS(), w.PQ(), w.XB());
        else phase_modulate<true>(nullptr, nullptr, w.XB(), w.H(), in.norm2_g + l * 1024, MODl, 3, MR, vb, nvb, w.H8(), w.HS(), w.PQ(), w.XB());
        xcd_barrier(bar);
#if (PROBE_MASK >> 5) & 1
        phase_modulate<true>(nullptr, nullptr, w.XB(), w.H(), in.norm2_g + l * 1024, MODl, 3, MR, vb, nvb, w.H8(), w.HS()); xcd_barrier(bar);
#endif
        phase_p6a(lds, w, l, vb, nvb); xcd_barrier(bar);
#if (PROBE_MASK >> 6) & 1
        phase_p6a(lds, w, l, vb, nvb); xcd_barrier(bar);
#endif
        phase_p6b(lds, w.PQ(), w.SubK() + (size_t)l * 16 * 128 * 128, w.EG(), MR, vb, nvb); xcd_barrier(bar);
#if (PROBE_MASK >> 7) & 1
        phase_p6b(lds, w.PQ(), w.SubK() + (size_t)l * 16 * 128 * 128, w.EG(), MR, vb, nvb); xcd_barrier(bar);
#endif
        { P7CArgs a{w.H8(), w.EG(), w.U8() + (size_t)l * NE * 512, (int*)w.PQ(), MR}; phase_p7c(lds, a, xpart, xrank, nvb); }
        xcd_barrier(bar);
#if (PROBE_MASK >> 8) & 1
        { P7CArgs a{w.H8(), w.EG(), w.U8() + (size_t)l * NE * 512, (int*)w.PQ(), MR}; phase_p7c(lds, a, xpart, xrank, nvb); }
        xcd_barrier(bar);
#endif
        phase_p7d((const int*)w.PQ(), w.EG(), w.US() + (size_t)l * NE, w.VS() + (size_t)l * NE, w.HS(), w.WE(), MR, vb, nvb);
        xcd_barrier(bar);
#if (PROBE_MASK >> 9) & 1
        phase_p7d((const int*)w.PQ(), w.EG(), w.US() + (size_t)l * NE, w.VS() + (size_t)l * NE, w.HS(), w.WE(), MR, vb, nvb);
        xcd_barrier(bar);
#endif
        { P7BArgs a{w.WE(), w.V8() + (size_t)l * NE * 512, w.XB(), MODl + 5 * 1024, MR}; phase_p7b<0>(lds, a, xpart, xrank, nvb); }
        xcd_barrier(bar);
#if (PROBE_MASK >> 10) & 3
        { P7BArgs a{w.WE(), w.V8() + (size_t)l * NE * 512, w.XB(), MODl + 5 * 1024, MR}; phase_p7b<((PROBE_MASK >> 10) & 3)>(lds, a, xpart, xrank, nvb); }
        xcd_barrier(bar);
#endif
        if (last) phase_final_norm(w.XB(), A.XL, in.final_g, vb, nvb);
        else phase_modulate<true>(nullptr, nullptr, w.XB(), w.H(), in.norm1_g + (l + 1) * 1024, w.MOD() + (size_t)(l + 1) * 33 * 6144, 0, NR, vb, nvb);
        if (!last) xcd_barrier(bar);
    }
}

extern "C" void kernel_launch(void* const* d_in, const int* in_sizes, int n_in, void* d_out, int out_size, void* d_ws, size_t ws_size, hipStream_t stream) {
    const float* const* fin = (const float* const*)d_in;
    Inputs in{fin[0], fin[1], fin[2], fin[3], fin[4], fin[5], fin[6], fin[7], fin[8], fin[9], fin[10], fin[11], fin[12], fin[13], fin[14], fin[15], fin[16], fin[17], fin[18], fin[19], fin[20], fin[21], fin[22]};
    WS w = make_ws(d_ws);
    static int ok = 0;
    if (!ok) {
        if (hipFuncSetAttribute((const void*)k_mega, hipFuncAttributeMaxDynamicSharedMemorySize, MEGA_LDS) != hipSuccess) { ok = -1; }
        int per_cu = 0, cus = 0, dev = 0; (void)hipGetDevice(&dev); (void)hipDeviceGetAttribute(&cus, hipDeviceAttributeMultiprocessorCount, dev);
        if (hipOccupancyMaxActiveBlocksPerMultiprocessor(&per_cu, (const void*)k_mega, 512, MEGA_LDS) != hipSuccess || per_cu < 1 || cus < 256) ok = -1;
        if (ok == 0) ok = 1;
    }
    if (ok < 0) return;
    (void)hipMemsetAsync(d_ws, 0, 16384, stream);
    MegaArgs A{in, w, (float*)d_out, (unsigned*)d_ws};
    k_mega<<<256, 512, MEGA_LDS, stream>>>(A);
}
```
